# Optimizing an MI355X kernel written in HIP

```python
import math
import jax
import jax.numpy as jnp
from jax import lax
import numpy as np

D_MODEL = 1024
BATCH = 8
SEQ = 2048
DEPTH = 1

MEM_LEN = 256
NSA_HEAD_DIM = 64
NSA_WIDTH = D_MODEL // 2
NSA_HEADS = NSA_WIDTH // NSA_HEAD_DIM
NSA_KV_GROUPS = 2
NSA_Q_PER_KV = NSA_HEADS // NSA_KV_GROUPS
CMP_BLOCK = 32
CMP_STRIDE = 16
CMP_HIDDEN = 2 * NSA_HEAD_DIM
SLC_BLOCK = 64
SLC_TOPN = 16
SLC_QBLOCK = 64
WIN = 512
WIN_QBLOCK = 128
FORCE_SCORE = 1e4
HG_DK = 128
HG_DV = HG_DK
HG_HEADS = (D_MODEL - NSA_WIDTH) // HG_DK
HG_CHUNK = 64
XA_HEADS = 4
XA_HEAD_DIM = D_MODEL // XA_HEADS
PEER_HEADS = 8
PEER_NKEYS = 128
PEER_N_EXPERTS = PEER_NKEYS * PEER_NKEYS
PEER_DKEY = 128
PEER_TOPK = 16
PEER_TOKEN_BLOCK = 128
IN_SPLITS = (NSA_WIDTH,) + (NSA_KV_GROUPS * NSA_HEAD_DIM,) * 6 + (NSA_HEADS * 3,) + (HG_HEADS * HG_DK, HG_HEADS * HG_DK, HG_HEADS * HG_DV, HG_HEADS * HG_DV)
IN_COLS = sum(IN_SPLITS)
LN_EPS = 1e-5
NEG_INF = -1e30
DEEPNORM_ALPHA = (2.0 * DEPTH) ** 0.25
DEEPNORM_BETA = (8.0 * DEPTH) ** -0.25

kernel_name = 'nsa_hgrn2_peer_deepnorm_hybrid'


def _layer_norm(x, g, b):
    xf = x.astype(jnp.float32)
    mu = jnp.mean(xf, axis=-1, keepdims=True)
    var = jnp.mean(jnp.square(xf - mu), axis=-1, keepdims=True)
    y = (xf - mu) * lax.rsqrt(var + LN_EPS)
    return (y * g.astype(jnp.float32) + b.astype(jnp.float32)).astype(x.dtype)


def _masked_softmax(s, mask):
    return jax.nn.softmax(jnp.where(mask, s, NEG_INF), axis=-1)


def _compress(blocks, pos_emb, w1, w2):
    b, nc, l, g, dh = blocks.shape
    h = (blocks + pos_emb[None, None, :, None, :]).transpose(0, 1, 3, 2, 4).reshape(b, nc, g, l * dh)
    return jax.nn.gelu(h @ w1) @ w2


def _nsa(q, k_cmp, v_cmp, k_slc, v_slc, k_win, v_win, gate_logits, cmp_pos, cmp_w1, cmp_w2):
    B, S = q.shape[0], q.shape[1]
    G, R, Dh = NSA_KV_GROUPS, NSA_Q_PER_KV, NSA_HEAD_DIM
    scale = Dh ** -0.5
    qg = q.reshape(B, S, G, R, Dh)
    pos = np.arange(S)

    n_cmp = (S - CMP_BLOCK) // CMP_STRIDE + 1
    cmp_idx = np.arange(n_cmp)[:, None] * CMP_STRIDE + np.arange(CMP_BLOCK)[None, :]
    kc = _compress(k_cmp[:, cmp_idx], cmp_pos[0], cmp_w1[0], cmp_w2[0])
    vc = _compress(v_cmp[:, cmp_idx], cmp_pos[1], cmp_w1[1], cmp_w2[1])
    cmp_valid = cmp_idx[:, -1][None, :] <= pos[:, None]
    s_cmp = jnp.einsum('bsgrd,bngd->bgrsn', qg, kc).astype(jnp.float32) * scale
    p_cmp = _masked_softmax(s_cmp, cmp_valid) * cmp_valid.any(-1)[:, None]
    o_cmp = jnp.einsum('bgrsn,bngd->bsgrd', p_cmp.astype(vc.dtype), vc)

    n_slc = S // SLC_BLOCK
    n_top = min(SLC_TOPN, n_slc)
    slc_start = np.arange(n_slc) * SLC_BLOCK
    cmp_start = np.arange(n_cmp) * CMP_STRIDE
    overlap = ((cmp_start[:, None] < slc_start[None, :] + SLC_BLOCK)
               & (cmp_start[:, None] + CMP_BLOCK > slc_start[None, :])).astype(np.float32)
    imp = jnp.einsum('bgrsn,nj->bsgj', p_cmp, jnp.asarray(overlap))
    cur = pos // SLC_BLOCK
    jb = np.arange(n_slc)
    forced = (jb[None] == 0) | (jb[None] == cur[:, None]) | (jb[None] == cur[:, None] - 1)
    future = jb[None] > cur[:, None]
    sel_score = jnp.where(future[None, :, None, :], -jnp.inf,
                          jnp.where(forced[None, :, None, :], FORCE_SCORE, imp))
    _, sel_idx = lax.top_k(sel_score, n_top)

    ks_b = k_slc.reshape(B, n_slc, SLC_BLOCK, G, Dh).transpose(0, 3, 1, 2, 4)
    vs_b = v_slc.reshape(B, n_slc, SLC_BLOCK, G, Dh).transpose(0, 3, 1, 2, 4)
    nqb = S // SLC_QBLOCK
    q_blocks = qg.reshape(B, nqb, SLC_QBLOCK, G, R, Dh).swapaxes(0, 1)
    i_blocks = sel_idx.reshape(B, nqb, SLC_QBLOCK, G, n_top).swapaxes(0, 1)
    p_blocks = jnp.asarray(pos.reshape(nqb, SLC_QBLOCK))
    b_ix = jnp.arange(B)[:, None, None, None]
    g_ix = jnp.arange(G)[None, None, :, None]

    def slc_block(args):
        qb, ib, pb = args
        kg = ks_b[b_ix, g_ix, ib]
        vg = vs_b[b_ix, g_ix, ib]
        s = jnp.einsum('bqgrd,bqgnld->bqgrnl', qb, kg).astype(jnp.float32) * scale
        key_pos = ib[..., None] * SLC_BLOCK + jnp.arange(SLC_BLOCK)
        ok = (key_pos <= pb[None, :, None, None, None])[:, :, :, None]
        s = jnp.where(ok, s, NEG_INF)
        p = jax.nn.softmax(s.reshape(B, SLC_QBLOCK, G, R, n_top * SLC_BLOCK), axis=-1).reshape(s.shape)
        return jnp.einsum('bqgrnl,bqgnld->bqgrd', p.astype(vg.dtype), vg)

    o_slc = lax.map(slc_block, (q_blocks, i_blocks, p_blocks)).swapaxes(0, 1).reshape(B, S, G, R, Dh)

    nwb = S // WIN_QBLOCK
    band = np.arange(nwb)[:, None] * WIN_QBLOCK + np.arange(WIN + WIN_QBLOCK)[None, :]
    key_pos_w = band - WIN
    q_pos_w = pos.reshape(nwb, WIN_QBLOCK)
    win_ok = ((key_pos_w[:, None, :] <= q_pos_w[:, :, None])
              & (key_pos_w[:, None, :] > q_pos_w[:, :, None] - WIN)
              & (key_pos_w[:, None, :] >= 0))
    pad = ((0, 0), (WIN, 0), (0, 0), (0, 0))
    kband = jnp.pad(k_win, pad)[:, band].swapaxes(0, 1)
    vband = jnp.pad(v_win, pad)[:, band].swapaxes(0, 1)
    qw = qg.reshape(B, nwb, WIN_QBLOCK, G, R, Dh).swapaxes(0, 1)

    def win_block(args):
        qb, kb, vb, mb = args
        s = jnp.einsum('bqgrd,bkgd->bgrqk', qb, kb).astype(jnp.float32) * scale
        p = _masked_softmax(s, mb[None, None, None])
        return jnp.einsum('bgrqk,bkgd->bqgrd', p.astype(vb.dtype), vb)

    o_win = lax.map(win_block, (qw, kband, vband, jnp.asarray(win_ok))).swapaxes(0, 1).reshape(B, S, G, R, Dh)

    gates = jax.nn.sigmoid(gate_logits.astype(jnp.float32)).reshape(B, S, G, R, 3).astype(q.dtype)
    o = gates[..., 0:1] * o_cmp + gates[..., 1:2] * o_slc + gates[..., 2:3] * o_win
    return o.reshape(B, S, NSA_WIDTH)


def _hgrn2(q, f_logits, i, g, lower_bound, norm_w):
    B, S = q.shape[0], q.shape[1]
    H, Dk, Dv, C = HG_HEADS, HG_DK, HG_DV, HG_CHUNK
    nc = S // C
    lb = lower_bound[None, None]
    f = lb + (1.0 - lb) * jax.nn.sigmoid(f_logits.astype(jnp.float32).reshape(B, S, H, Dk))
    k = 1.0 - f
    log_f = jnp.log(f)

    def chunks(a, d):
        return a.astype(jnp.float32).reshape(B, nc, C, H, d).transpose(1, 0, 3, 2, 4)

    causal = np.tril(np.ones((C, C), dtype=bool))[None, None, :, :, None]

    def step(state, inp):
        qc, kc, vc, gc = inp
        b = jnp.cumsum(gc, axis=2)
        decay = jnp.exp(jnp.where(causal, b[:, :, :, None, :] - b[:, :, None, :, :], -jnp.inf))
        attn = jnp.einsum('bhtd,bhsd,bhtsd->bhts', qc, kc, decay)
        o = jnp.einsum('bhts,bhse->bhte', attn, vc) + jnp.einsum('bhtd,bhde->bhte', qc * jnp.exp(b), state)
        b_last = b[:, :, -1:, :]
        new_state = (jnp.exp(b_last[:, :, 0, :])[..., None] * state
                     + jnp.einsum('bhsd,bhse->bhde', kc * jnp.exp(b_last - b), vc))
        return new_state, o

    state0 = jnp.zeros((B, H, Dk, Dv), jnp.float32)
    _, o = lax.scan(step, state0, (chunks(q, Dk), chunks(k, Dk), chunks(i, Dv), chunks(log_f, Dk)))
    o = o.transpose(1, 0, 3, 2, 4).reshape(B, S, H, Dv)
    o = o * lax.rsqrt(jnp.mean(jnp.square(o), axis=-1, keepdims=True) + LN_EPS) * norm_w.astype(jnp.float32)
    o = o * jax.nn.silu(g.astype(jnp.float32).reshape(B, S, H, Dv))
    return o.reshape(B, S, H * Dv).astype(q.dtype)


def _hybrid_mixer(x, w_in, cmp_pos, cmp_w1, cmp_w2, lower_bound, norm_w, w_out):
    B, S, _ = x.shape
    h = x @ w_in
    offs = [int(o) for o in np.cumsum(IN_SPLITS)[:-1]]
    q_a, kc, vc, ks, vs, kw, vw, gate_a, q_b, f_b, i_b, g_b = jnp.split(h, offs, axis=-1)

    def kv(a):
        return a.reshape(B, S, NSA_KV_GROUPS, NSA_HEAD_DIM)

    o_a = _nsa(q_a.reshape(B, S, NSA_HEADS, NSA_HEAD_DIM), kv(kc), kv(vc), kv(ks), kv(vs), kv(kw), kv(vw),
               gate_a, cmp_pos, cmp_w1, cmp_w2)
    o_b = _hgrn2(q_b, f_b, i_b, g_b, lower_bound, norm_w)
    return jnp.concatenate([o_a, o_b], axis=-1) @ w_out


def _memory_cross_attention(x, mem, wq, wkv, wo):
    B, S, _ = x.shape
    M = mem.shape[1]
    q = (x @ wq).reshape(B, S, XA_HEADS, XA_HEAD_DIM)
    kvm = (mem @ wkv).reshape(B, M, 2, XA_HEADS, XA_HEAD_DIM)
    k, v = kvm[:, :, 0], kvm[:, :, 1]
    s = jnp.einsum('bshd,bmhd->bhsm', q, k).astype(jnp.float32) * XA_HEAD_DIM ** -0.5
    p = jax.nn.softmax(s, axis=-1)
    o = jnp.einsum('bhsm,bmhd->bshd', p.astype(v.dtype), v).reshape(B, S, XA_HEADS * XA_HEAD_DIM)
    return o @ wo


def _peer(x, wq, sub_keys, down, up):
    B, S, D = x.shape
    T = B * S
    t = x.reshape(T, D)
    qry = (t @ wq).reshape(T, PEER_HEADS, 2, PEER_DKEY // 2)
    s = jnp.einsum('thcd,hcnd->thcn', qry, sub_keys).astype(jnp.float32)
    s1, i1 = lax.top_k(s[:, :, 0], PEER_TOPK)
    s2, i2 = lax.top_k(s[:, :, 1], PEER_TOPK)
    cand_s = (s1[..., :, None] + s2[..., None, :]).reshape(T, PEER_HEADS, PEER_TOPK * PEER_TOPK)
    cand_i = (i1[..., :, None] * PEER_NKEYS + i2[..., None, :]).reshape(T, PEER_HEADS, PEER_TOPK * PEER_TOPK)
    top_s, top_pos = lax.top_k(cand_s, PEER_TOPK)
    expert = jnp.take_along_axis(cand_i, top_pos, axis=-1)
    gate = jax.nn.softmax(top_s, axis=-1)
    nb = T // PEER_TOKEN_BLOCK
    E = PEER_HEADS * PEER_TOPK

    def block(args):
        tb, eb, gb = args
        a = jax.nn.gelu(jnp.einsum('ted,td->te', down[eb], tb).astype(jnp.float32), approximate=False)
        return jnp.einsum('te,ted->td', (a * gb).astype(up.dtype), up[eb])

    out = lax.map(block, (t.reshape(nb, PEER_TOKEN_BLOCK, D), expert.reshape(nb, PEER_TOKEN_BLOCK, E),
                          gate.reshape(nb, PEER_TOKEN_BLOCK, E)))
    return out.reshape(B, S, D)


def setup_inputs(seed: int = 0) -> dict:
    key = jax.random.key(seed)
    ks = jax.random.split(key, 18)

    def nrm(k, shape, scale):
        return jax.random.normal(k, shape, jnp.float32) * scale

    D = D_MODEL
    return {
        'x': nrm(ks[0], (BATCH, SEQ, D), 1.0),
        'mem': nrm(ks[1], (BATCH, MEM_LEN, D), 1.0),
        'w_in': nrm(ks[2], (DEPTH, D, IN_COLS), D ** -0.5),
        'cmp_pos': nrm(ks[3], (DEPTH, 2, CMP_BLOCK, NSA_HEAD_DIM), 0.1),
        'cmp_w1': nrm(ks[4], (DEPTH, 2, CMP_BLOCK * NSA_HEAD_DIM, CMP_HIDDEN), (CMP_BLOCK * NSA_HEAD_DIM) ** -0.5),
        'cmp_w2': nrm(ks[5], (DEPTH, 2, CMP_HIDDEN, NSA_HEAD_DIM), CMP_HIDDEN ** -0.5),
        'hgrn_lb_logits': nrm(ks[6], (DEPTH + 1, HG_HEADS, HG_DK), 0.5),
        'hgrn_norm_w': 1.0 + nrm(ks[7], (DEPTH, HG_HEADS, HG_DV), 0.02),
        'w_out': nrm(ks[8], (DEPTH, D, D), D ** -0.5 * DEEPNORM_BETA),
        'xa_wq': nrm(ks[9], (DEPTH, D, D), D ** -0.5),
        'xa_wkv': nrm(ks[10], (DEPTH, D, 2 * D), D ** -0.5),
        'xa_wo': nrm(ks[11], (DEPTH, D, D), D ** -0.5 * DEEPNORM_BETA),
        'peer_wq': nrm(ks[12], (DEPTH, D, PEER_HEADS * PEER_DKEY), D ** -0.5),
        'peer_subkeys': nrm(ks[13], (DEPTH, PEER_HEADS, 2, PEER_NKEYS, PEER_DKEY // 2), (PEER_DKEY // 2) ** -0.5),
        'peer_down': nrm(ks[14], (DEPTH, PEER_N_EXPERTS, D), D ** -0.5),
        'peer_up': nrm(ks[15], (DEPTH, PEER_N_EXPERTS, D), DEEPNORM_BETA),
        'ln_g': 1.0 + nrm(ks[16], (DEPTH, 3, D), 0.02),
        'ln_b': nrm(ks[17], (DEPTH, 3, D), 0.02),
    }


def reference(x, mem, w_in, cmp_pos, cmp_w1, cmp_w2, hgrn_lb_logits, hgrn_norm_w, w_out,
              xa_wq, xa_wkv, xa_wo, peer_wq, peer_subkeys, peer_down, peer_up, ln_g, ln_b):
    lower_bounds = jnp.cumsum(jax.nn.softmax(hgrn_lb_logits.astype(jnp.float32), axis=0), axis=0)
    for l in range(DEPTH):
        mix = _hybrid_mixer(x, w_in[l], cmp_pos[l], cmp_w1[l], cmp_w2[l], lower_bounds[l], hgrn_norm_w[l], w_out[l])
        x = _layer_norm(DEEPNORM_ALPHA * x + mix, ln_g[l, 0], ln_b[l, 0])
        xa = _memory_cross_attention(x, mem, xa_wq[l], xa_wkv[l], xa_wo[l])
        x = _layer_norm(DEEPNORM_ALPHA * x + xa, ln_g[l, 1], ln_b[l, 1])
        ff = _peer(x, peer_wq[l], peer_subkeys[l], peer_down[l], peer_up[l])
        x = _layer_norm(DEEPNORM_ALPHA * x + ff, ln_g[l, 2], ln_b[l, 2])
    return x
```

```cpp
#include <hip/hip_runtime.h>
#include <hip/hip_cooperative_groups.h>
#include <cstdio>
#include <cstdint>
namespace cg = cooperative_groups;

#ifndef ONE_LAUNCH
#define ONE_LAUNCH 0
#endif

typedef unsigned short bf16_t;
#define DEV __device__ __forceinline__

constexpr int D_ = 1024, B_ = 8, S_ = 2048, T_ = B_ * S_, ML_ = 256, INC = 3352;
constexpr int NCMP = 127;
constexpr float ALPHA = 1.189207115002721f;
constexpr float LN_EPS = 1e-5f;
constexpr int C_QA = 0, C_KC = 512, C_VC = 640, C_KS = 768, C_VS = 896, C_KW = 1024, C_VW = 1152, C_GATE = 1280,
              C_HQ = 1304, C_HF = 1816, C_HI = 2328, C_HG = 2840;
constexpr size_t WS_HB = 0;
constexpr size_t SZ_HB = (size_t)T_ * INC * 2;
constexpr size_t WS_OM = WS_HB + SZ_HB;
constexpr size_t WS_KVM = WS_OM + (size_t)T_ * 1024 * 2;
constexpr size_t WS_KC = WS_KVM + (size_t)2048 * 2048 * 2;
constexpr size_t WS_END = WS_KC + (1u << 20);
constexpr size_t WS_QX = 0;
constexpr size_t WS_OX = (size_t)T_ * 1024 * 2;
constexpr size_t WS_QP = 0;

struct P {
    const float *x, *mem, *w_in, *cmp_pos, *cmp_w1, *cmp_w2, *lb_logits, *hg_norm_w, *w_out, *xa_wq, *xa_wkv, *xa_wo,
        *peer_wq, *peer_keys, *peer_down, *peer_up, *ln_g, *ln_b;
    float* out;
    unsigned char* ws;
};

DEV unsigned short f2bf(float f) {
    unsigned u = __float_as_uint(f);
    u += 0x7fffu + ((u >> 16) & 1u);
    return (unsigned short)(u >> 16);
}
DEV float bf2f(unsigned short h) { return __uint_as_float(((unsigned)h) << 16); }
DEV float bflo(unsigned u) { return __uint_as_float(u << 16); }
DEV float bfhi(unsigned u) { return __uint_as_float(u & 0xffff0000u); }
DEV float wsum(float v) {
#pragma unroll
    for (int o = 32; o > 0; o >>= 1) v += __shfl_xor(v, o);
    return v;
}
DEV float wmax(float v) {
#pragma unroll
    for (int o = 32; o > 0; o >>= 1) v = fmaxf(v, __shfl_xor(v, o));
    return v;
}
DEV float sigmoidf_(float x) { return 1.f / (1.f + expf(-x)); }

template <int MODE>
DEV void gemm_tile(const P& p, int tile, float* smem) {
    constexpr bool ABF = (MODE == 2 || MODE == 4);
    constexpr int K = 1024;
    constexpr int N = MODE == 0 ? INC : (MODE == 1 ? 2048 : 1024);
    constexpr int NTN = (N + 63) / 64;
    const int tm = tile / NTN, tn = tile % NTN;
    const float* Af = nullptr;
    const bf16_t* Ab = nullptr;
    const float* Bm = nullptr;
    if (MODE == 0) { Af = p.x; Bm = p.w_in; }
    if (MODE == 1) { Af = p.mem; Bm = p.xa_wkv; }
    if (MODE == 2) { Ab = (const bf16_t*)(p.ws + WS_OM); Bm = p.w_out; }
    if (MODE == 3) { Af = p.out; Bm = p.xa_wq; }
    if (MODE == 4) { Ab = (const bf16_t*)(p.ws + WS_OX); Bm = p.xa_wo; }
    if (MODE == 5) { Af = p.out; Bm = p.peer_wq; }
    float(*sA)[68] = (float(*)[68])smem;
    float(*sB)[68] = (float(*)[68])(smem + 16 * 68);
    const int tid = threadIdx.x, tx = tid & 15, ty = tid >> 4;
    const int ar = tid >> 2, ak = (tid & 3) * 4;
    const int bk = tid >> 4, bn = (tid & 15) * 4;
    float acc[4][4];
#pragma unroll
    for (int i = 0; i < 4; ++i)
#pragma unroll
        for (int j = 0; j < 4; ++j) acc[i][j] = 0.f;
    const int gn = tn * 64 + bn;
    for (int k0 = 0; k0 < K; k0 += 16) {
        float4 av;
        if (ABF) {
            uint2 u = *(const uint2*)(Ab + (size_t)(tm * 64 + ar) * K + k0 + ak);
            av.x = bflo(u.x); av.y = bfhi(u.x); av.z = bflo(u.y); av.w = bfhi(u.y);
        } else {
            av = *(const float4*)(Af + (size_t)(tm * 64 + ar) * K + k0 + ak);
        }
        float4 bv = make_float4(0.f, 0.f, 0.f, 0.f);
        if (gn < N) bv = *(const float4*)(Bm + (size_t)(k0 + bk) * N + gn);
        sA[ak + 0][ar] = av.x; sA[ak + 1][ar] = av.y; sA[ak + 2][ar] = av.z; sA[ak + 3][ar] = av.w;
        *(float4*)&sB[bk][bn] = bv;
        __syncthreads();
#pragma unroll
        for (int kk = 0; kk < 16; ++kk) {
            float4 a = *(const float4*)&sA[kk][ty * 4];
            float4 b = *(const float4*)&sB[kk][tx * 4];
            float aa[4] = {a.x, a.y, a.z, a.w}, bb[4] = {b.x, b.y, b.z, b.w};
#pragma unroll
            for (int i = 0; i < 4; ++i)
#pragma unroll
                for (int j = 0; j < 4; ++j) acc[i][j] += aa[i] * bb[j];
        }
        __syncthreads();
    }
    const int col = tn * 64 + tx * 4;
#pragma unroll
    for (int i = 0; i < 4; ++i) {
        const size_t row = (size_t)tm * 64 + ty * 4 + i;
        if (MODE == 0 || MODE == 1 || MODE == 3) {
            bf16_t* O = (bf16_t*)(p.ws + (MODE == 0 ? WS_HB : (MODE == 1 ? WS_KVM : WS_QX)));
            if (col < N) {
                uint2 u;
                u.x = (unsigned)f2bf(acc[i][0]) | ((unsigned)f2bf(acc[i][1]) << 16);
                u.y = (unsigned)f2bf(acc[i][2]) | ((unsigned)f2bf(acc[i][3]) << 16);
                *(uint2*)(O + row * N + col) = u;
            }
        } else if (MODE == 2) {
            float4 xv = *(const float4*)(p.x + row * 1024 + col);
            float4 o = make_float4(ALPHA * xv.x + acc[i][0], ALPHA * xv.y + acc[i][1], ALPHA * xv.z + acc[i][2], ALPHA * xv.w + acc[i][3]);
            *(float4*)(p.out + row * 1024 + col) = o;
        } else if (MODE == 4) {
            float4 xv = *(const float4*)(p.out + row * 1024 + col);
            float4 o = make_float4(ALPHA * xv.x + acc[i][0], ALPHA * xv.y + acc[i][1], ALPHA * xv.z + acc[i][2], ALPHA * xv.w + acc[i][3]);
            *(float4*)(p.out + row * 1024 + col) = o;
        } else {
            float* O = (float*)(p.ws + WS_QP);
            *(float4*)(O + row * 1024 + col) = make_float4(acc[i][0], acc[i][1], acc[i][2], acc[i][3]);
        }
    }
}

DEV void compress_item(const P& p, int item, float* smem) {
    const int tid = threadIdx.x;
    const int g = item & 1;
    int r = item >> 1;
    const int n = r % NCMP;
    r /= NCMP;
    const int b = r & 7, kind = r >> 3;
    const bf16_t* HB = (const bf16_t*)(p.ws + WS_HB);
    float* KC = (float*)(p.ws + WS_KC);
    float* su = smem;
    float* sp = smem + 2048;
    float* sh = smem + 2304;
    const int col = (kind ? C_VC : C_KC) + g * 64;
    for (int i = tid; i < 2048; i += 256) {
        const int l = i >> 6, d = i & 63;
        su[i] = bf2f(HB[(size_t)(b * S_ + 16 * n + l) * INC + col + d]) + p.cmp_pos[(kind * 32 + l) * 64 + d];
    }
    __syncthreads();
    {
        const int j = tid & 127, hf = tid >> 7;
        const float* w1 = p.cmp_w1 + (size_t)kind * 2048 * 128;
        float acc = 0.f;
        for (int i = hf * 1024; i < hf * 1024 + 1024; ++i) acc += su[i] * w1[(size_t)i * 128 + j];
        sp[hf * 128 + j] = acc;
    }
    __syncthreads();
    if (tid < 128) {
        const float v = sp[tid] + sp[128 + tid];
        const float u = 0.7978845608028654f * (v + 0.044715f * v * v * v);
        sh[tid] = 0.5f * v * (1.f + tanhf(u));
    }
    __syncthreads();
    if (tid < 64) {
        const float* w2 = p.cmp_w2 + (size_t)kind * 128 * 64;
        float acc = 0.f;
        for (int j = 0; j < 128; ++j) acc += sh[j] * w2[j * 64 + tid];
        KC[((((size_t)kind * B_ + b) * NCMP + n) * 2 + g) * 64 + tid] = acc;
    }
    __syncthreads();
}

DEV void load_q64_bf(float (&q)[64], const bf16_t* src) {
    const uint4* s4 = (const uint4*)src;
#pragma unroll
    for (int i = 0; i < 8; ++i) {
        const uint4 u = s4[i];
        q[i * 8 + 0] = bflo(u.x); q[i * 8 + 1] = bfhi(u.x); q[i * 8 + 2] = bflo(u.y); q[i * 8 + 3] = bfhi(u.y);
        q[i * 8 + 4] = bflo(u.z); q[i * 8 + 5] = bfhi(u.z); q[i * 8 + 6] = bflo(u.w); q[i * 8 + 7] = bfhi(u.w);
    }
}
DEV float dot64_bf(const float (&q)[64], const bf16_t* kr) {
    const uint4* k4 = (const uint4*)kr;
    float acc = 0.f;
#pragma unroll
    for (int i = 0; i < 8; ++i) {
        const uint4 u = k4[i];
        acc += q[i * 8 + 0] * bflo(u.x) + q[i * 8 + 1] * bfhi(u.x) + q[i * 8 + 2] * bflo(u.y) + q[i * 8 + 3] * bfhi(u.y) +
               q[i * 8 + 4] * bflo(u.z) + q[i * 8 + 5] * bfhi(u.z) + q[i * 8 + 6] * bflo(u.w) + q[i * 8 + 7] * bfhi(u.w);
    }
    return acc;
}
DEV float dot64_f(const float (&q)[64], const float* kr) {
    const float4* k4 = (const float4*)kr;
    float acc = 0.f;
#pragma unroll
    for (int i = 0; i < 16; ++i) {
        const float4 u = k4[i];
        acc += q[i * 4 + 0] * u.x + q[i * 4 + 1] * u.y + q[i * 4 + 2] * u.z + q[i * 4 + 3] * u.w;
    }
    return acc;
}

DEV void attn_block(const float (&q)[64], const bf16_t* krow_lane, const bf16_t* vbase_lane, bool valid, float& m, float& l, float& o) {
    float sc = dot64_bf(q, krow_lane) * 0.125f;
    sc = valid ? sc : -1e30f;
    const float mb = wmax(sc);
    const float mn = fmaxf(m, mb);
    const float corr = expf(m - mn);
    const float e = valid ? expf(sc - mn) : 0.f;
    l = l * corr + wsum(e);
    o *= corr;
#pragma unroll 8
    for (int k = 0; k < 64; ++k) o += __shfl(e, k) * bf2f(vbase_lane[(size_t)k * INC]);
    m = mn;
}

DEV void nsa_item(const P& p, int item) {
    const int lane = threadIdx.x & 63;
    const int g = item & 1;
    const int t = item >> 1;
    const int b = t >> 11, s = t & 2047;
    const bf16_t* HB = (const bf16_t*)(p.ws + WS_HB);
    const float* KC = (const float*)(p.ws + WS_KC);
    bf16_t* OM = (bf16_t*)(p.ws + WS_OM);
    const int cur = s >> 6;
    const int nvalid = (s >= 31) ? (((s - 31) >> 4) + 1) : 0;
    const size_t rowt = (size_t)t * INC;
    float ocmp0 = 0.f, ocmp1 = 0.f, ocmp2 = 0.f, ocmp3 = 0.f;
    float psum0 = 0.f, psum1 = 0.f;
    if (nvalid > 0) {
#pragma unroll 1
        for (int r = 0; r < 4; ++r) {
            const int h = g * 4 + r;
            float q[64];
            load_q64_bf(q, HB + rowt + C_QA + h * 64);
            float sc0 = -1e30f, sc1 = -1e30f;
            if (lane < nvalid) sc0 = dot64_f(q, KC + ((((size_t)0 * B_ + b) * NCMP + lane) * 2 + g) * 64) * 0.125f;
            if (lane + 64 < nvalid) sc1 = dot64_f(q, KC + ((((size_t)0 * B_ + b) * NCMP + lane + 64) * 2 + g) * 64) * 0.125f;
            const float m = wmax(fmaxf(sc0, sc1));
            const float e0 = (lane < nvalid) ? expf(sc0 - m) : 0.f;
            const float e1 = (lane + 64 < nvalid) ? expf(sc1 - m) : 0.f;
            const float l = wsum(e0 + e1);
            const float p0 = e0 / l, p1 = e1 / l;
            psum0 += p0;
            psum1 += p1;
            float oc = 0.f;
            const float* vcb = KC + ((((size_t)1 * B_ + b) * NCMP) * 2 + g) * 64 + lane;
            for (int n = 0; n < nvalid; ++n) {
                const float pn = (n < 64) ? __shfl(p0, n) : __shfl(p1, n - 64);
                oc += pn * vcb[(size_t)n * 128];
            }
            if (r == 0) ocmp0 = oc;
            if (r == 1) ocmp1 = oc;
            if (r == 2) ocmp2 = oc;
            if (r == 3) ocmp3 = oc;
        }
    }
    float imp = 0.f;
#pragma unroll
    for (int dn = -1; dn <= 3; ++dn) {
        const int n = 4 * lane + dn;
        const int nn = n < 0 ? 0 : (n > 127 ? 127 : n);
        const float v0 = __shfl(psum0, nn & 63);
        const float v1 = __shfl(psum1, nn & 63);
        const float v = (nn < 64) ? v0 : v1;
        if (n >= 0 && n <= 126) imp += v;
    }
    float score;
    if (lane > cur) score = -INFINITY;
    else if (lane == 0 || lane == cur || lane == cur - 1) score = 1e4f;
    else score = imp;
    int rank = 0;
#pragma unroll 8
    for (int i = 0; i < 32; ++i) {
        const float si = __shfl(score, i);
        rank += ((si > score) || (si == score && i < lane)) ? 1 : 0;
    }
    const bool sel = (lane <= cur) && (rank < 16);
    const unsigned mask = (unsigned)(__ballot(sel) & 0xffffffffull);
    const int wlo = (s - 511) > 0 ? (s - 511) : 0;
#pragma unroll 1
    for (int r = 0; r < 4; ++r) {
        const int h = g * 4 + r;
        float q[64];
        load_q64_bf(q, HB + rowt + C_QA + h * 64);
        float m = -1e30f, l = 0.f, o = 0.f;
        for (unsigned mm = mask; mm; mm &= mm - 1) {
            const int j = __builtin_ctz(mm);
            const int kpos = j * 64 + lane;
            attn_block(q, HB + (size_t)(b * S_ + kpos) * INC + C_KS + g * 64, HB + (size_t)(b * S_ + j * 64) * INC + C_VS + g * 64 + lane,
                       kpos <= s, m, l, o);
        }
        const float oslc = o / l;
        m = -1e30f; l = 0.f; o = 0.f;
        for (int j = wlo >> 6; j <= cur; ++j) {
            const int kpos = j * 64 + lane;
            attn_block(q, HB + (size_t)(b * S_ + kpos) * INC + C_KW + g * 64, HB + (size_t)(b * S_ + j * 64) * INC + C_VW + g * 64 + lane,
                       (kpos <= s) && (kpos >= wlo), m, l, o);
        }
        const float owin = o / l;
        const float oc = r == 0 ? ocmp0 : (r == 1 ? ocmp1 : (r == 2 ? ocmp2 : ocmp3));
        const float g0 = sigmoidf_(bf2f(HB[rowt + C_GATE + h * 3 + 0]));
        const float g1 = sigmoidf_(bf2f(HB[rowt + C_GATE + h * 3 + 1]));
        const float g2 = sigmoidf_(bf2f(HB[rowt + C_GATE + h * 3 + 2]));
        OM[(size_t)t * 1024 + h * 64 + lane] = f2bf(g0 * oc + g1 * oslc + g2 * owin);
    }
}

DEV void hgrn_item(const P& p, int item, float* smem) {
    const int b = item >> 2, hh = item & 3;
    const int tid = threadIdx.x, dv = tid & 127, half = tid >> 7;
    const bf16_t* HB = (const bf16_t*)(p.ws + WS_HB);
    bf16_t* OM = (bf16_t*)(p.ws + WS_OM);
    float* sf = smem;
    float* sq = smem + 1024;
    float* so = smem + 2048;
    float Sreg[64];
#pragma unroll
    for (int i = 0; i < 64; ++i) Sreg[i] = 0.f;
    const int d = tid & 127;
    float lbv;
    {
        const float l0 = p.lb_logits[hh * 128 + d], l1 = p.lb_logits[512 + hh * 128 + d];
        const float mx = fmaxf(l0, l1);
        const float e0 = expf(l0 - mx), e1 = expf(l1 - mx);
        lbv = e0 / (e0 + e1);
    }
    const int wave = tid >> 6, lane = tid & 63;
    const float nw0 = p.hg_norm_w[hh * 128 + lane], nw1 = p.hg_norm_w[hh * 128 + lane + 64];
    for (int t0 = 0; t0 < S_; t0 += 8) {
#pragma unroll
        for (int i = 0; i < 4; ++i) {
            const int st = (tid >> 7) + 2 * i;
            const size_t tt = (size_t)b * S_ + t0 + st;
            const float fl = bf2f(HB[tt * INC + C_HF + hh * 128 + d]);
            sf[st * 128 + d] = lbv + (1.f - lbv) * sigmoidf_(fl);
            sq[st * 128 + d] = bf2f(HB[tt * INC + C_HQ + hh * 128 + d]);
        }
        float vv[8];
#pragma unroll
        for (int st = 0; st < 8; ++st) vv[st] = bf2f(HB[((size_t)b * S_ + t0 + st) * INC + C_HI + hh * 128 + dv]);
        __syncthreads();
#pragma unroll
        for (int st = 0; st < 8; ++st) {
            float oacc = 0.f;
            const float* pf = sf + st * 128 + half * 64;
            const float* pq = sq + st * 128 + half * 64;
#pragma unroll
            for (int dk = 0; dk < 64; ++dk) {
                const float f = pf[dk];
                Sreg[dk] = f * Sreg[dk] + (1.f - f) * vv[st];
                oacc += pq[dk] * Sreg[dk];
            }
            so[(st * 2 + half) * 128 + dv] = oacc;
        }
        __syncthreads();
#pragma unroll
        for (int u = 0; u < 2; ++u) {
            const int st = wave * 2 + u;
            const float o0 = so[(st * 2 + 0) * 128 + lane] + so[(st * 2 + 1) * 128 + lane];
            const float o1 = so[(st * 2 + 0) * 128 + lane + 64] + so[(st * 2 + 1) * 128 + lane + 64];
            const float ss = wsum(o0 * o0 + o1 * o1);
            const float rs = rsqrtf(ss * (1.f / 128.f) + LN_EPS);
            const size_t tt = (size_t)b * S_ + t0 + st;
            const float gg0 = bf2f(HB[tt * INC + C_HG + hh * 128 + lane]);
            const float gg1 = bf2f(HB[tt * INC + C_HG + hh * 128 + lane + 64]);
            OM[tt * 1024 + 512 + hh * 128 + lane] = f2bf(o0 * rs * nw0 * (gg0 * sigmoidf_(gg0)));
            OM[tt * 1024 + 512 + hh * 128 + lane + 64] = f2bf(o1 * rs * nw1 * (gg1 * sigmoidf_(gg1)));
        }
    }
    __syncthreads();
}

DEV void ln_item(const P& p, int t, int which) {
    const int lane = threadIdx.x & 63;
    float* row = p.out + (size_t)t * 1024;
    float4 v[4];
    float s = 0.f;
#pragma unroll
    for (int i = 0; i < 4; ++i) {
        v[i] = *(const float4*)(row + (i * 64 + lane) * 4);
        s += v[i].x + v[i].y + v[i].z + v[i].w;
    }
    const float mean = wsum(s) * (1.f / 1024.f);
    float ss = 0.f;
#pragma unroll
    for (int i = 0; i < 4; ++i) {
        v[i].x -= mean; v[i].y -= mean; v[i].z -= mean; v[i].w -= mean;
        ss += v[i].x * v[i].x + v[i].y * v[i].y + v[i].z * v[i].z + v[i].w * v[i].w;
    }
    const float rs = rsqrtf(wsum(ss) * (1.f / 1024.f) + LN_EPS);
#pragma unroll
    for (int i = 0; i < 4; ++i) {
        const int c = (i * 64 + lane) * 4;
        const float4 gg = *(const float4*)(p.ln_g + which * 1024 + c);
        const float4 bb = *(const float4*)(p.ln_b + which * 1024 + c);
        float4 o;
        o.x = v[i].x * rs * gg.x + bb.x; o.y = v[i].y * rs * gg.y + bb.y; o.z = v[i].z * rs * gg.z + bb.z; o.w = v[i].w * rs * gg.w + bb.w;
        *(float4*)(row + c) = o;
    }
}

DEV void xattn_item(const P& p, int item) {
    const int lane = threadIdx.x & 63;
    const int hh = item & 3, t = item >> 2, b = t >> 11;
    const bf16_t* QX = (const bf16_t*)(p.ws + WS_QX);
    const bf16_t* KVM = (const bf16_t*)(p.ws + WS_KVM);
    bf16_t* OX = (bf16_t*)(p.ws + WS_OX);
    float sc[4] = {0.f, 0.f, 0.f, 0.f};
#pragma unroll 1
    for (int c = 0; c < 4; ++c) {
        float q[64];
        load_q64_bf(q, QX + (size_t)t * 1024 + hh * 256 + c * 64);
#pragma unroll
        for (int k = 0; k < 4; ++k) sc[k] += dot64_bf(q, KVM + (size_t)(b * ML_ + lane + 64 * k) * 2048 + hh * 256 + c * 64);
    }
    float mx = -1e30f;
#pragma unroll
    for (int k = 0; k < 4; ++k) { sc[k] *= 0.0625f; mx = fmaxf(mx, sc[k]); }
    mx = wmax(mx);
    float pr[4], ls = 0.f;
#pragma unroll
    for (int k = 0; k < 4; ++k) { pr[k] = expf(sc[k] - mx); ls += pr[k]; }
    ls = wsum(ls);
    const float inv = 1.f / ls;
    float o[4] = {0.f, 0.f, 0.f, 0.f};
#pragma unroll
    for (int k = 0; k < 4; ++k) {
        const bf16_t* vb = KVM + (size_t)(b * ML_ + k * 64) * 2048 + 1024 + hh * 256 + lane;
#pragma unroll 4
        for (int mm = 0; mm < 64; ++mm) {
            const float pm = __shfl(pr[k], mm);
#pragma unroll
            for (int c = 0; c < 4; ++c) o[c] += pm * bf2f(vb[(size_t)mm * 2048 + c * 64]);
        }
    }
#pragma unroll
    for (int c = 0; c < 4; ++c) OX[(size_t)t * 1024 + hh * 256 + c * 64 + lane] = f2bf(o[c] * inv);
}

DEV void wave_argmax(float v, int i, float& bv, int& bi) {
#pragma unroll
    for (int o = 32; o > 0; o >>= 1) {
        const float ov = __shfl_xor(v, o);
        const int oi = __shfl_xor(i, o);
        if (ov > v || (ov == v && oi < i)) { v = ov; i = oi; }
    }
    bv = v; bi = i;
}

DEV void peer_item(const P& p, int t) {
    const int lane = threadIdx.x & 63;
    const float* QP = (const float*)(p.ws + WS_QP);
    float* row = p.out + (size_t)t * 1024;
    float4 xr[4], oacc[4];
#pragma unroll
    for (int i = 0; i < 4; ++i) {
        xr[i] = *(const float4*)(row + (i * 64 + lane) * 4);
        oacc[i] = make_float4(0.f, 0.f, 0.f, 0.f);
    }
#pragma unroll 1
    for (int hh = 0; hh < 8; ++hh) {
        float ts1 = 0.f, ts2 = 0.f;
        int ti1 = 0, ti2 = 0;
#pragma unroll 1
        for (int c = 0; c < 2; ++c) {
            float q[64];
            {
                const float4* q4 = (const float4*)(QP + (size_t)t * 1024 + hh * 128 + c * 64);
#pragma unroll
                for (int i = 0; i < 16; ++i) { const float4 u = q4[i]; q[i * 4] = u.x; q[i * 4 + 1] = u.y; q[i * 4 + 2] = u.z; q[i * 4 + 3] = u.w; }
            }
            const float* kb = p.peer_keys + ((size_t)(hh * 2 + c) * 128) * 64;
            float a0 = dot64_f(q, kb + (size_t)lane * 64);
            float a1 = dot64_f(q, kb + (size_t)(lane + 64) * 64);
            float ts = 0.f;
            int ti = 0;
#pragma unroll 1
            for (int k = 0; k < 16; ++k) {
                float v; int i;
                if (a0 >= a1) { v = a0; i = lane; } else { v = a1; i = lane + 64; }
                float bv; int bi;
                wave_argmax(v, i, bv, bi);
                if (lane == k) { ts = bv; ti = bi; }
                if (bi == lane) a0 = -INFINITY;
                if (bi == lane + 64) a1 = -INFINITY;
            }
            if (c == 0) { ts1 = ts; ti1 = ti; } else { ts2 = ts; ti2 = ti; }
        }
        float cs[4];
        const float s1v = __shfl(ts1, lane >> 2);
#pragma unroll
        for (int u = 0; u < 4; ++u) cs[u] = s1v + __shfl(ts2, (lane & 3) * 4 + u);
        float fs = 0.f;
        int fidx = 0;
#pragma unroll 1
        for (int k = 0; k < 16; ++k) {
            float v = cs[0]; int i = lane * 4;
#pragma unroll
            for (int u = 1; u < 4; ++u) if (cs[u] > v) { v = cs[u]; i = lane * 4 + u; }
            float bv; int bi;
            wave_argmax(v, i, bv, bi);
            if (lane == k) { fs = bv; fidx = bi; }
#pragma unroll
            for (int u = 0; u < 4; ++u) if (bi == lane * 4 + u) cs[u] = -INFINITY;
        }
        const int e1i = __shfl(ti1, fidx >> 4);
        const int e2i = __shfl(ti2, fidx & 15);
        const int eid = e1i * 128 + e2i;
        const float mx = __shfl(fs, 0);
        const float w = (lane < 16) ? expf(fs - mx) : 0.f;
        const float gate = w / wsum(w);
#pragma unroll 1
        for (int k = 0; k < 16; ++k) {
            const int e = __shfl(eid, k);
            const float gt = __shfl(gate, k);
            const float* dr = p.peer_down + (size_t)e * 1024;
            const float* ur = p.peer_up + (size_t)e * 1024;
            float hd = 0.f;
#pragma unroll
            for (int i = 0; i < 4; ++i) {
                const float4 dvv = *(const float4*)(dr + (i * 64 + lane) * 4);
                hd += dvv.x * xr[i].x + dvv.y * xr[i].y + dvv.z * xr[i].z + dvv.w * xr[i].w;
            }
            hd = wsum(hd);
            const float a = 0.5f * hd * (1.f + erff(hd * 0.7071067811865476f)) * gt;
#pragma unroll
            for (int i = 0; i < 4; ++i) {
                const float4 uv = *(const float4*)(ur + (i * 64 + lane) * 4);
                oacc[i].x += a * uv.x; oacc[i].y += a * uv.y; oacc[i].z += a * uv.z; oacc[i].w += a * uv.w;
            }
        }
    }
    float s = 0.f;
    float4 v[4];
#pragma unroll
    for (int i = 0; i < 4; ++i) {
        v[i].x = ALPHA * xr[i].x + oacc[i].x; v[i].y = ALPHA * xr[i].y + oacc[i].y;
        v[i].z = ALPHA * xr[i].z + oacc[i].z; v[i].w = ALPHA * xr[i].w + oacc[i].w;
        s += v[i].x + v[i].y + v[i].z + v[i].w;
    }
    const float mean = wsum(s) * (1.f / 1024.f);
    float ss = 0.f;
#pragma unroll
    for (int i = 0; i < 4; ++i) {
        v[i].x -= mean; v[i].y -= mean; v[i].z -= mean; v[i].w -= mean;
        ss += v[i].x * v[i].x + v[i].y * v[i].y + v[i].z * v[i].z + v[i].w * v[i].w;
    }
    const float rs = rsqrtf(wsum(ss) * (1.f / 1024.f) + LN_EPS);
#pragma unroll
    for (int i = 0; i < 4; ++i) {
        const int c = (i * 64 + lane) * 4;
        const float4 gg = *(const float4*)(p.ln_g + 2 * 1024 + c);
        const float4 bb = *(const float4*)(p.ln_b + 2 * 1024 + c);
        float4 o;
        o.x = v[i].x * rs * gg.x + bb.x; o.y = v[i].y * rs * gg.y + bb.y; o.z = v[i].z * rs * gg.z + bb.z; o.w = v[i].w * rs * gg.w + bb.w;
        *(float4*)(row + c) = o;
    }
}

constexpr int NSTAGES = 11;
template <int ST>
DEV void run_stage(const P& p, float* smem) {
    const int nb = gridDim.x, bid = blockIdx.x;
    const int wave = threadIdx.x >> 6;
    if (ST == 0) {
        constexpr int N0 = 256 * 53, N1 = 32 * 32;
        for (int it = bid; it < N0 + N1; it += nb) {
            if (it < N0) gemm_tile<0>(p, it, smem);
            else gemm_tile<1>(p, it - N0, smem);
        }
    } else if (ST == 1) {
        for (int it = bid; it < 2 * B_ * NCMP * 2; it += nb) compress_item(p, it, smem);
    } else if (ST == 2) {
        for (int it = bid; it < 32 + T_ * 2 / 4; it += nb) {
            if (it < 32) hgrn_item(p, it, smem);
            else nsa_item(p, (it - 32) * 4 + wave);
        }
    } else if (ST == 3) {
        for (int it = bid; it < 256 * 16; it += nb) gemm_tile<2>(p, it, smem);
    } else if (ST == 4 || ST == 8) {
        for (int it = bid; it < T_ / 4; it += nb) ln_item(p, it * 4 + wave, ST == 4 ? 0 : 1);
    } else if (ST == 5) {
        for (int it = bid; it < 256 * 16; it += nb) gemm_tile<3>(p, it, smem);
    } else if (ST == 6) {
        for (int it = bid; it < T_; it += nb) xattn_item(p, it * 4 + wave);
    } else if (ST == 7) {
        for (int it = bid; it < 256 * 16; it += nb) gemm_tile<4>(p, it, smem);
    } else if (ST == 9) {
        for (int it = bid; it < 256 * 16; it += nb) gemm_tile<5>(p, it, smem);
    } else if (ST == 10) {
        for (int it = bid; it < T_ / 4; it += nb) peer_item(p, it * 4 + wave);
    }
}

template <int ST>
__global__ void __launch_bounds__(256) stage_kernel(P p) {
    __shared__ __attribute__((aligned(16))) float smem[4096];
    run_stage<ST>(p, smem);
}

__global__ void __launch_bounds__(256) mega_kernel(P p) {
    __shared__ __attribute__((aligned(16))) float smem[4096];
    cg::grid_group grid = cg::this_grid();
    run_stage<0>(p, smem); grid.sync();
    run_stage<1>(p, smem); grid.sync();
    run_stage<2>(p, smem); grid.sync();
    run_stage<3>(p, smem); grid.sync();
    run_stage<4>(p, smem); grid.sync();
    run_stage<5>(p, smem); grid.sync();
    run_stage<6>(p, smem); grid.sync();
    run_stage<7>(p, smem); grid.sync();
    run_stage<8>(p, smem); grid.sync();
    run_stage<9>(p, smem); grid.sync();
    run_stage<10>(p, smem);
}

extern "C" void kernel_launch(void* const* d_in, const int* in_sizes, int n_in, void* d_out, int out_size, void* d_ws, size_t ws_size,
                              hipStream_t stream) {
    if (n_in != 18 || ws_size < WS_END) {
        fprintf(stderr, "kernel_launch: unexpected inputs (n_in %d, ws %zu, need %zu)\n", n_in, ws_size, (size_t)WS_END);
        return;
    }
    P p{};
    p.x = (const float*)d_in[0]; p.mem = (const float*)d_in[1]; p.w_in = (const float*)d_in[2]; p.cmp_pos = (const float*)d_in[3];
    p.cmp_w1 = (const float*)d_in[4]; p.cmp_w2 = (const float*)d_in[5]; p.lb_logits = (const float*)d_in[6];
    p.hg_norm_w = (const float*)d_in[7]; p.w_out = (const float*)d_in[8]; p.xa_wq = (const float*)d_in[9];
    p.xa_wkv = (const float*)d_in[10]; p.xa_wo = (const float*)d_in[11]; p.peer_wq = (const float*)d_in[12];
    p.peer_keys = (const float*)d_in[13]; p.peer_down = (const float*)d_in[14]; p.peer_up = (const float*)d_in[15];
    p.ln_g = (const float*)d_in[16]; p.ln_b = (const float*)d_in[17];
    p.out = (float*)d_out; p.ws = (unsigned char*)d_ws;
#if ONE_LAUNCH
    static int grid_blocks = 0;
    if (!grid_blocks) {
        int dev = 0, cus = 0, per_cu = 0;
        hipGetDevice(&dev);
        hipDeviceGetAttribute(&cus, hipDeviceAttributeMultiprocessorCount, dev);
        hipOccupancyMaxActiveBlocksPerMultiprocessor(&per_cu, mega_kernel, 256, 0);
        if (per_cu > 4) per_cu = 4;
        if (per_cu < 1) per_cu = 1;
        grid_blocks = cus * per_cu;
    }
    void* args[] = {&p};
    hipError_t e = hipLaunchCooperativeKernel((void*)mega_kernel, dim3(grid_blocks), dim3(256), args, 0, stream);
    if (e != hipSuccess) fprintf(stderr, "cooperative launch failed: %s (grid %d)\n", hipGetErrorString(e), grid_blocks);
#else
    const int G = 2048;
    stage_kernel<0><<<G, 256, 0, stream>>>(p);
    stage_kernel<1><<<G, 256, 0, stream>>>(p);
    stage_kernel<2><<<G, 256, 0, stream>>>(p);
    stage_kernel<3><<<G, 256, 0, stream>>>(p);
    stage_kernel<4><<<G, 256, 0, stream>>>(p);
    stage_kernel<5><<<G, 256, 0, stream>>>(p);
    stage_kernel<6><<<G, 256, 0, stream>>>(p);
    stage_kernel<7><<<G, 256, 0, stream>>>(p);
    stage_kernel<8><<<G, 256, 0, stream>>>(p);
    stage_kernel<9><<<G, 256, 0, stream>>>(p);
    stage_kernel<10><<<G, 256, 0, stream>>>(p);
#endif
}
```

```cpp
#include <hip/hip_runtime.h>
#include <hip/hip_cooperative_groups.h>
#include <cstdio>
#include <cstdint>
namespace cg = cooperative_groups;

#ifndef PROBE_REP
#define PROBE_REP -1
#endif
#ifndef ONE_LAUNCH
#define ONE_LAUNCH 1
#endif

typedef unsigned short bf16_t;
#define DEV __device__ __forceinline__

constexpr int D_ = 1024, B_ = 8, S_ = 2048, T_ = B_ * S_, ML_ = 256, INC = 3352;
constexpr int NCMP = 127;
constexpr int LDS_BYTES = 67584;
constexpr float ALPHA = 1.189207115002721f;
constexpr float LN_EPS = 1e-5f;
constexpr int C_QA = 0, C_KC = 512, C_VC = 640, C_KS = 768, C_VS = 896, C_KW = 1024, C_VW = 1152, C_GATE = 1280,
              C_HQ = 1304, C_HF = 1816, C_HI = 2328, C_HG = 2840;
constexpr size_t WS_HB = 0;
constexpr size_t SZ_HB = (size_t)T_ * INC * 2;
constexpr size_t WS_OM = WS_HB + SZ_HB;
constexpr size_t WS_KVM = WS_OM + (size_t)T_ * 1024 * 2;
constexpr size_t WS_KC = WS_KVM + (size_t)2048 * 2048 * 2;
constexpr size_t WS_XB = WS_KC + (1u << 20);
constexpr size_t WS_WIN_T = WS_XB + (size_t)T_ * 1024 * 2;
constexpr size_t WS_WOUT_T = WS_WIN_T + (size_t)3456 * 1024 * 2;
constexpr size_t WS_WQ_T = WS_WOUT_T + (size_t)1024 * 1024 * 2;
constexpr size_t WS_WKV_T = WS_WQ_T + (size_t)1024 * 1024 * 2;
constexpr size_t WS_WO_T = WS_WKV_T + (size_t)2048 * 1024 * 2;
constexpr size_t WS_PWQ_T = WS_WO_T + (size_t)1024 * 1024 * 2;
constexpr size_t WS_MEMB = WS_PWQ_T + (size_t)1024 * 1024 * 2;
constexpr size_t WS_PKEY = WS_MEMB + (size_t)2048 * 1024 * 2;
constexpr size_t WS_VT = WS_PKEY + (size_t)16 * 128 * 64 * 2;
constexpr size_t WS_KCB = WS_VT + (size_t)2 * B_ * 2 * 64 * 2048 * 2;
constexpr size_t WS_VCT = WS_KCB + (size_t)B_ * 2 * 128 * 64 * 2;
constexpr size_t WS_W1T = WS_VCT + (size_t)B_ * 2 * 128 * 64 * 2;
constexpr size_t WS_W2T = WS_W1T + (size_t)2 * 128 * 2048 * 2;
constexpr size_t WS_CB = WS_W2T + (size_t)2 * 64 * 128 * 2;
constexpr size_t WS_VMT = WS_CB + 1024;
constexpr size_t WS_BAR = WS_VMT + (size_t)B_ * 4 * 256 * 256 * 2;
constexpr size_t WS_PD = WS_BAR + 65536;
constexpr size_t WS_PU = WS_PD + (size_t)16384 * 1024;
constexpr size_t WS_PSD = WS_PU + (size_t)16384 * 1024;
constexpr size_t WS_PSU = WS_PSD + 65536;
constexpr size_t WS_PRS = WS_PSU + 65536;
constexpr size_t WS_END = WS_PRS + 65536;
static_assert(WS_END <= (size_t)268435456, "workspace budget");
constexpr size_t WS_EB = WS_KC;
constexpr size_t HS_QT = 0;
constexpr size_t HS_KT = (size_t)B_ * 4 * 2048 * 128 * 2;
constexpr size_t HS_KHT = 2 * HS_KT;
constexpr size_t HS_VIT = 3 * HS_KT;
constexpr size_t HS_DS = HS_KT;
constexpr size_t HS_OI = 3 * HS_KT;
constexpr size_t WS_QX = 0;
constexpr size_t WS_OX = (size_t)T_ * 1024 * 2;
constexpr size_t WS_QP = 0;
constexpr size_t WS_EIDP = (size_t)T_ * 1024 * 2;
constexpr size_t WS_GATEP = WS_EIDP + (size_t)T_ * 128 * 2;
constexpr size_t WS_COEFP = WS_GATEP + (size_t)T_ * 128 * 4;
constexpr size_t WS_XQ = WS_COEFP + (size_t)T_ * 128 * 4;
constexpr size_t WS_SXF = WS_XQ + (size_t)T_ * 1024;
constexpr size_t WS_SXI = WS_SXF + (size_t)T_ * 4;
constexpr size_t WS_ASUM = WS_SXI + (size_t)T_ * 4;
constexpr size_t WS_DP = WS_ASUM + (size_t)T_ * 4;
static_assert(WS_DP + (size_t)8 * T_ * 128 * 4 <= WS_KVM, "PEER intermediates must fit in the dead h/OM region");

struct P {
    const float *x, *mem, *w_in, *cmp_pos, *cmp_w1, *cmp_w2, *lb_logits, *hg_norm_w, *w_out, *xa_wq, *xa_wkv, *xa_wo,
        *peer_wq, *peer_keys, *peer_down, *peer_up, *ln_g, *ln_b;
    float* out;
    unsigned char* ws;
};

DEV unsigned short f2bf(float f) {
    unsigned u = __float_as_uint(f);
    u += 0x7fffu + ((u >> 16) & 1u);
    return (unsigned short)(u >> 16);
}
DEV float bf2f(unsigned short h) { return __uint_as_float(((unsigned)h) << 16); }
DEV float bflo(unsigned u) { return __uint_as_float(u << 16); }
DEV float bfhi(unsigned u) { return __uint_as_float(u & 0xffff0000u); }
typedef __bf16 bf16x2_t __attribute__((ext_vector_type(2)));
typedef float f32x2_t __attribute__((ext_vector_type(2)));
DEV unsigned pk_bf16(float a, float b) {
    f32x2_t v = {a, b};
    bf16x2_t r = __builtin_convertvector(v, bf16x2_t);
    return __builtin_bit_cast(unsigned, r);
}
DEV float wsum(float v) {
#pragma unroll
    for (int o = 32; o > 0; o >>= 1) v += __shfl_xor(v, o);
    return v;
}
DEV float wmax(float v) {
#pragma unroll
    for (int o = 32; o > 0; o >>= 1) v = fmaxf(v, __shfl_xor(v, o));
    return v;
}
DEV float sigmoidf_(float x) { return 1.f / (1.f + expf(-x)); }
DEV float fsigmoid(float x) { return __fdividef(1.f, 1.f + __expf(-x)); }

template <int MODE>
DEV void gemm_tile(const P& p, int tile, float* smem) {
    constexpr bool ABF = (MODE == 2 || MODE == 4);
    constexpr int K = 1024;
    constexpr int N = MODE == 0 ? INC : (MODE == 1 ? 2048 : 1024);
    constexpr int NTN = (N + 63) / 64;
    const int tm = tile / NTN, tn = tile % NTN;
    const float* Af = nullptr;
    const bf16_t* Ab = nullptr;
    const float* Bm = nullptr;
    if (MODE == 0) { Af = p.x; Bm = p.w_in; }
    if (MODE == 1) { Af = p.mem; Bm = p.xa_wkv; }
    if (MODE == 2) { Ab = (const bf16_t*)(p.ws + WS_OM); Bm = p.w_out; }
    if (MODE == 3) { Af = p.out; Bm = p.xa_wq; }
    if (MODE == 4) { Ab = (const bf16_t*)(p.ws + WS_OX); Bm = p.xa_wo; }
    if (MODE == 5) { Af = p.out; Bm = p.peer_wq; }
    float(*sA)[68] = (float(*)[68])smem;
    float(*sB)[68] = (float(*)[68])(smem + 16 * 68);
    const int tid = threadIdx.x, tx = tid & 15, ty = tid >> 4;
    const int ar = tid >> 2, ak = (tid & 3) * 4;
    const int bk = tid >> 4, bn = (tid & 15) * 4;
    float acc[4][4];
#pragma unroll
    for (int i = 0; i < 4; ++i)
#pragma unroll
        for (int j = 0; j < 4; ++j) acc[i][j] = 0.f;
    const int gn = tn * 64 + bn;
    for (int k0 = 0; k0 < K; k0 += 16) {
        float4 av;
        if (ABF) {
            uint2 u = *(const uint2*)(Ab + (size_t)(tm * 64 + ar) * K + k0 + ak);
            av.x = bflo(u.x); av.y = bfhi(u.x); av.z = bflo(u.y); av.w = bfhi(u.y);
        } else {
            av = *(const float4*)(Af + (size_t)(tm * 64 + ar) * K + k0 + ak);
        }
        float4 bv = make_float4(0.f, 0.f, 0.f, 0.f);
        if (gn < N) bv = *(const float4*)(Bm + (size_t)(k0 + bk) * N + gn);
        sA[ak + 0][ar] = av.x; sA[ak + 1][ar] = av.y; sA[ak + 2][ar] = av.z; sA[ak + 3][ar] = av.w;
        *(float4*)&sB[bk][bn] = bv;
        __syncthreads();
#pragma unroll
        for (int kk = 0; kk < 16; ++kk) {
            float4 a = *(const float4*)&sA[kk][ty * 4];
            float4 b = *(const float4*)&sB[kk][tx * 4];
            float aa[4] = {a.x, a.y, a.z, a.w}, bb[4] = {b.x, b.y, b.z, b.w};
#pragma unroll
            for (int i = 0; i < 4; ++i)
#pragma unroll
                for (int j = 0; j < 4; ++j) acc[i][j] += aa[i] * bb[j];
        }
        __syncthreads();
    }
    const int col = tn * 64 + tx * 4;
#pragma unroll
    for (int i = 0; i < 4; ++i) {
        const size_t row = (size_t)tm * 64 + ty * 4 + i;
        if (MODE == 0 || MODE == 1 || MODE == 3) {
            bf16_t* O = (bf16_t*)(p.ws + (MODE == 0 ? WS_HB : (MODE == 1 ? WS_KVM : WS_QX)));
            if (col < N) {
                uint2 u;
                u.x = (unsigned)f2bf(acc[i][0]) | ((unsigned)f2bf(acc[i][1]) << 16);
                u.y = (unsigned)f2bf(acc[i][2]) | ((unsigned)f2bf(acc[i][3]) << 16);
                *(uint2*)(O + row * N + col) = u;
            }
        } else if (MODE == 2) {
            float4 xv = *(const float4*)(p.x + row * 1024 + col);
            float4 o = make_float4(ALPHA * xv.x + acc[i][0], ALPHA * xv.y + acc[i][1], ALPHA * xv.z + acc[i][2], ALPHA * xv.w + acc[i][3]);
            *(float4*)(p.out + row * 1024 + col) = o;
        } else if (MODE == 4) {
            float4 xv = *(const float4*)(p.out + row * 1024 + col);
            float4 o = make_float4(ALPHA * xv.x + acc[i][0], ALPHA * xv.y + acc[i][1], ALPHA * xv.z + acc[i][2], ALPHA * xv.w + acc[i][3]);
            *(float4*)(p.out + row * 1024 + col) = o;
        } else {
            float* O = (float*)(p.ws + WS_QP);
            *(float4*)(O + row * 1024 + col) = make_float4(acc[i][0], acc[i][1], acc[i][2], acc[i][3]);
        }
    }
}


using bf16x8 = __attribute__((ext_vector_type(8))) short;
using f32x4 = __attribute__((ext_vector_type(4))) float;
using u32x4 = __attribute__((ext_vector_type(4))) unsigned;

template <int MODE>
DEV void gemm_mfma_tile(const P& p, int tm, int tn, unsigned char* lds) {
    const bf16_t* A;
    const bf16_t* W;
    if (MODE == 0) { A = (const bf16_t*)(p.ws + WS_XB); W = (const bf16_t*)(p.ws + WS_WIN_T); }
    if (MODE == 1) { A = (const bf16_t*)(p.ws + WS_MEMB); W = (const bf16_t*)(p.ws + WS_WKV_T); }
    if (MODE == 2) { A = (const bf16_t*)(p.ws + WS_OM); W = (const bf16_t*)(p.ws + WS_WOUT_T); }
    if (MODE == 3) { A = (const bf16_t*)(p.ws + WS_XB); W = (const bf16_t*)(p.ws + WS_WQ_T); }
    if (MODE == 4) { A = (const bf16_t*)(p.ws + WS_OX); W = (const bf16_t*)(p.ws + WS_WO_T); }
    if (MODE == 5) { A = (const bf16_t*)(p.ws + WS_XB); W = (const bf16_t*)(p.ws + WS_PWQ_T); }
    const int tid = threadIdx.x, lane = tid & 63, wid = tid >> 6, wm = wid >> 1, wn = wid & 1;
    const int m0 = tm * 128, n0 = tn * 128;
    const bf16_t* ga[2];
    const bf16_t* gw[2];
#pragma unroll
    for (int i = 0; i < 2; ++i) {
        const int r = (wid * 2 + i) * 16 + (lane >> 2);
        const int gsw = (0x1320 >> (((r >> 2) & 3) * 4)) & 3;
        const int c = (lane & 3) ^ gsw;
        ga[i] = A + (size_t)(m0 + r) * 1024 + c * 8;
        gw[i] = W + (size_t)(n0 + r) * 1024 + c * 8;
    }
    unsigned char* lbase = lds + wid * 2048;
#define GEMM_STAGE(slot, kt)                                                                                                   \
    do {                                                                                                                       \
        _Pragma("unroll") for (int i = 0; i < 2; ++i) {                                                                        \
            __builtin_amdgcn_global_load_lds((const unsigned*)(ga[i] + (kt) * 32), (unsigned*)(lbase + (slot) * 16384 + i * 1024), 16, 0, 0);         \
            __builtin_amdgcn_global_load_lds((const unsigned*)(gw[i] + (kt) * 32), (unsigned*)(lbase + (slot) * 16384 + 8192 + i * 1024), 16, 0, 0);  \
        }                                                                                                                      \
    } while (0)
    asm volatile("s_waitcnt vmcnt(0)" ::: "memory");
    GEMM_STAGE(0, 0);
    GEMM_STAGE(1, 1);
    GEMM_STAGE(2, 2);
    f32x4 acc[4][4];
#pragma unroll
    for (int i = 0; i < 4; ++i)
#pragma unroll
        for (int j = 0; j < 4; ++j) acc[i][j] = (f32x4){0.f, 0.f, 0.f, 0.f};
    const int fr = lane & 15, fq = lane >> 4;
    const int fsw = (0x1320 >> (((fr >> 2) & 3) * 4)) & 3;
    const int aoff = (wm * 64 + fr) * 64 + ((fq ^ fsw) << 4);
    const int boff = 8192 + (wn * 64 + fr) * 64 + ((fq ^ fsw) << 4);
#define GEMM_COMPUTE(slot)                                                                                                     \
    do {                                                                                                                       \
        const unsigned char* sb = lds + (slot) * 16384;                                                                        \
        bf16x8 af[4], wf[4];                                                                                                   \
        _Pragma("unroll") for (int t = 0; t < 4; ++t) {                                                                        \
            af[t] = *(const bf16x8*)(sb + aoff + t * 1024);                                                                    \
            wf[t] = *(const bf16x8*)(sb + boff + t * 1024);                                                                    \
        }                                                                                                                      \
        _Pragma("unroll") for (int nt = 0; nt < 4; ++nt)                                                                       \
            _Pragma("unroll") for (int mt = 0; mt < 4; ++mt)                                                                   \
                acc[nt][mt] = __builtin_amdgcn_mfma_f32_16x16x32_bf16(wf[nt], af[mt], acc[nt][mt], 0, 0, 0);                   \
    } while (0)
#pragma unroll 1
    for (int kt = 0; kt < 29; ++kt) {
        asm volatile("s_waitcnt vmcnt(8)\n\ts_waitcnt lgkmcnt(0)" ::: "memory");
        __builtin_amdgcn_s_barrier(); asm volatile("" ::: "memory");
        GEMM_STAGE((kt + 3) & 3, kt + 3);
        GEMM_COMPUTE(kt & 3);
    }
    asm volatile("s_waitcnt vmcnt(8)\n\ts_waitcnt lgkmcnt(0)" ::: "memory");
    __builtin_amdgcn_s_barrier(); asm volatile("" ::: "memory");
    GEMM_COMPUTE(29 & 3);
    asm volatile("s_waitcnt vmcnt(4)\n\ts_waitcnt lgkmcnt(0)" ::: "memory");
    __builtin_amdgcn_s_barrier(); asm volatile("" ::: "memory");
    GEMM_COMPUTE(30 & 3);
    asm volatile("s_waitcnt vmcnt(0)\n\ts_waitcnt lgkmcnt(0)" ::: "memory");
    __builtin_amdgcn_s_barrier(); asm volatile("" ::: "memory");
    GEMM_COMPUTE(31 & 3);
    asm volatile("s_waitcnt lgkmcnt(0)" ::: "memory");
    __builtin_amdgcn_s_barrier(); asm volatile("" ::: "memory");
#undef GEMM_STAGE
#undef GEMM_COMPUTE
#pragma unroll
    for (int mt = 0; mt < 4; ++mt) {
        const size_t m = (size_t)m0 + wm * 64 + mt * 16 + fr;
#pragma unroll
        for (int nt = 0; nt < 4; ++nt) {
            const int n = n0 + wn * 64 + nt * 16 + fq * 4;
            const f32x4 c = acc[nt][mt];
            if (MODE == 0 || MODE == 1 || MODE == 3 || MODE == 5) {
                constexpr int NS = MODE == 0 ? INC : (MODE == 1 ? 2048 : 1024);
                bf16_t* O = (bf16_t*)(p.ws + (MODE == 0 ? WS_HB : (MODE == 1 ? WS_KVM : (MODE == 3 ? WS_QX : WS_QP))));
                if (MODE == 1 && tn >= 8) {
                    bf16_t* VMT = (bf16_t*)(p.ws + WS_VMT);
                    const int nn = n - 1024;
                    const size_t base = (((size_t)(m >> 8) * 4 + (nn >> 8)) * 256 + (nn & 255)) * 256 + (m & 255);
#pragma unroll
                    for (int i = 0; i < 4; ++i) VMT[base + (size_t)i * 256] = f2bf(c[i]);
                } else if (MODE == 0 && (tn == 7 || tn == 9)) {
                    bf16_t* VT = (bf16_t*)(p.ws + WS_VT);
                    const int which = tn == 9 ? 1 : 0;
                    const size_t base = ((((size_t)which * B_ + (m >> 11)) * 2 + wn) * 64 + nt * 16 + fq * 4) * 2048 + (m & 2047);
#pragma unroll
                    for (int i = 0; i < 4; ++i) VT[base + (size_t)i * 2048] = f2bf(c[i]);
                } else if (MODE != 0 || n < INC) {
                    uint2 u;
                    u.x = pk_bf16(c[0], c[1]);
                    u.y = pk_bf16(c[2], c[3]);
                    *(uint2*)(O + m * NS + n) = u;
                }
            } else if (MODE == 2) {
                const float4 xv = *(const float4*)(p.x + m * 1024 + n);
                *(float4*)(p.out + m * 1024 + n) = make_float4(ALPHA * xv.x + c[0], ALPHA * xv.y + c[1], ALPHA * xv.z + c[2], ALPHA * xv.w + c[3]);
            } else if (MODE == 4) {
                const float4 xv = *(const float4*)(p.out + m * 1024 + n);
                *(float4*)(p.out + m * 1024 + n) = make_float4(ALPHA * xv.x + c[0], ALPHA * xv.y + c[1], ALPHA * xv.z + c[2], ALPHA * xv.w + c[3]);
            }
        }
    }
}

template <int MODE>
DEV void gemm_item(const P& p, int q, int j, unsigned char* lds) {
    int tm, tn;
    if (MODE == 0) {
        tm = q * 16 + (j & 7) + 8 * (j / 216);
        tn = (j >> 3) % 27;
    } else if (MODE == 1) {
        tm = q * 2 + (j >> 4); tn = j & 15;
    } else {
        tm = q * 16 + (j & 7) + 8 * (j >> 6);
        tn = (j >> 3) & 7;
    }
    gemm_mfma_tile<MODE>(p, tm, tn, lds);
}

DEV void transpose_tile(const float* W, int N, bf16_t* Wt, int tk, int tn, float* s, int ldk = 1024) {
    const int tid = threadIdx.x;
    const int k0 = tk * 64, n0 = tn * 64;
#pragma unroll
    for (int i = 0; i < 4; ++i) {
        const int k = (tid >> 4) + 16 * i, n = (tid & 15) * 4;
        float4 v = make_float4(0.f, 0.f, 0.f, 0.f);
        if (n0 + n < N) v = *(const float4*)(W + (size_t)(k0 + k) * N + n0 + n);
        s[k * 65 + n + 0] = v.x; s[k * 65 + n + 1] = v.y; s[k * 65 + n + 2] = v.z; s[k * 65 + n + 3] = v.w;
    }
    __syncthreads();
    {
        const int n = tid >> 2, kc = (tid & 3) * 16;
        unsigned u[8];
#pragma unroll
        for (int j = 0; j < 8; ++j)
            u[j] = (unsigned)f2bf(s[(kc + 2 * j) * 65 + n]) | ((unsigned)f2bf(s[(kc + 2 * j + 1) * 65 + n]) << 16);
        bf16_t* dst = Wt + (size_t)(n0 + n) * ldk + k0 + kc;
        *(uint4*)dst = make_uint4(u[0], u[1], u[2], u[3]);
        *(uint4*)(dst + 8) = make_uint4(u[4], u[5], u[6], u[7]);
    }
    __syncthreads();
}
DEV void convert_chunk(const float* src, bf16_t* dst, int item) {
    float4 a[4], b[4];
#pragma unroll
    for (int j = 0; j < 4; ++j) {
        const size_t e = (((size_t)item * 4 + j) * 256 + threadIdx.x) * 8;
        a[j] = *(const float4*)(src + e);
        b[j] = *(const float4*)(src + e + 4);
    }
#pragma unroll
    for (int j = 0; j < 4; ++j) {
        const size_t e = (((size_t)item * 4 + j) * 256 + threadIdx.x) * 8;
        uint4 u;
        u.x = pk_bf16(a[j].x, a[j].y);
        u.y = pk_bf16(a[j].z, a[j].w);
        u.z = pk_bf16(b[j].x, b[j].y);
        u.w = pk_bf16(b[j].z, b[j].w);
        *(uint4*)(dst + e) = u;
    }
}
constexpr int PREP_T0 = 16 * 54, PREP_T3 = PREP_T0 + 512, PREP_T5 = PREP_T3, PREP_X = PREP_T5 + T_ * 1024 / 8192, PREP_M = PREP_X + 2048 * 1024 / 8192, PREP_K = PREP_M + 16 * 128 * 64 / 8192, PREP_W1 = PREP_K + 128, PREP_W2 = PREP_W1 + 4,
              PREP_END = PREP_W2;
DEV void prep_item(const P& p, int it, float* smem) {
    if (it < PREP_T0) transpose_tile(p.w_in, INC, (bf16_t*)(p.ws + WS_WIN_T), it / 54, it % 54, smem);
    else if (it < PREP_T3) { it -= PREP_T0; transpose_tile(p.xa_wkv, 2048, (bf16_t*)(p.ws + WS_WKV_T), it >> 5, it & 31, smem); }
    else if (it < PREP_X) convert_chunk(p.x, (bf16_t*)(p.ws + WS_XB), it - PREP_T5);
    else if (it < PREP_M) convert_chunk(p.mem, (bf16_t*)(p.ws + WS_MEMB), it - PREP_X);
    else if (it < PREP_K) convert_chunk(p.peer_keys, (bf16_t*)(p.ws + WS_PKEY), it - PREP_M);
    else if (it < PREP_W1) {
        it -= PREP_K;
        const int kind = it >> 6, r = it & 63;
        transpose_tile(p.cmp_w1 + (size_t)kind * 2048 * 128, 128, (bf16_t*)(p.ws + WS_W1T) + (size_t)kind * 128 * 2048, r >> 1, r & 1, smem, 2048);
    } else if (it < PREP_W2) {
        it -= PREP_W1;
        const int kind = it >> 1;
        transpose_tile(p.cmp_w2 + (size_t)kind * 128 * 64, 64, (bf16_t*)(p.ws + WS_W2T) + (size_t)kind * 64 * 128, it & 1, 0, smem, 128);
    }
}

DEV void compress_item(const P& p, int item, float* smem) {
    const int tid = threadIdx.x;
    const int g = item & 1;
    int r = item >> 1;
    const int n = r % NCMP;
    r /= NCMP;
    const int b = r & 7, kind = r >> 3;
    const bf16_t* HB = (const bf16_t*)(p.ws + WS_HB);
    float* KC = (float*)(p.ws + WS_KC);
    float* su = smem;
    float* sp = smem + 2048;
    float* sh = smem + 2304;
    const int col = (kind ? C_VC : C_KC) + g * 64;
    for (int i = tid; i < 2048; i += 256) {
        const int l = i >> 6, d = i & 63;
        su[i] = bf2f(HB[(size_t)(b * S_ + 16 * n + l) * INC + col + d]) + p.cmp_pos[(kind * 32 + l) * 64 + d];
    }
    __syncthreads();
    {
        const int j = tid & 127, hf = tid >> 7;
        const float* w1 = p.cmp_w1 + (size_t)kind * 2048 * 128;
        float acc = 0.f;
        for (int i = hf * 1024; i < hf * 1024 + 1024; ++i) acc += su[i] * w1[(size_t)i * 128 + j];
        sp[hf * 128 + j] = acc;
    }
    __syncthreads();
    if (tid < 128) {
        const float v = sp[tid] + sp[128 + tid];
        const float u = 0.7978845608028654f * (v + 0.044715f * v * v * v);
        sh[tid] = 0.5f * v * (1.f + tanhf(u));
    }
    __syncthreads();
    if (tid < 64) {
        const float* w2 = p.cmp_w2 + (size_t)kind * 128 * 64;
        float acc = 0.f;
        for (int j = 0; j < 128; ++j) acc += sh[j] * w2[j * 64 + tid];
        KC[((((size_t)kind * B_ + b) * NCMP + n) * 2 + g) * 64 + tid] = acc;
    }
    __syncthreads();
}

DEV void load_q64_bf(float (&q)[64], const bf16_t* src) {
    const uint4* s4 = (const uint4*)src;
#pragma unroll
    for (int i = 0; i < 8; ++i) {
        const uint4 u = s4[i];
        q[i * 8 + 0] = bflo(u.x); q[i * 8 + 1] = bfhi(u.x); q[i * 8 + 2] = bflo(u.y); q[i * 8 + 3] = bfhi(u.y);
        q[i * 8 + 4] = bflo(u.z); q[i * 8 + 5] = bfhi(u.z); q[i * 8 + 6] = bflo(u.w); q[i * 8 + 7] = bfhi(u.w);
    }
}
DEV float dot64_bf(const float (&q)[64], const bf16_t* kr) {
    const uint4* k4 = (const uint4*)kr;
    float acc = 0.f;
#pragma unroll
    for (int i = 0; i < 8; ++i) {
        const uint4 u = k4[i];
        acc += q[i * 8 + 0] * bflo(u.x) + q[i * 8 + 1] * bfhi(u.x) + q[i * 8 + 2] * bflo(u.y) + q[i * 8 + 3] * bfhi(u.y) +
               q[i * 8 + 4] * bflo(u.z) + q[i * 8 + 5] * bfhi(u.z) + q[i * 8 + 6] * bflo(u.w) + q[i * 8 + 7] * bfhi(u.w);
    }
    return acc;
}
DEV float dot64_f(const float (&q)[64], const float* kr) {
    const float4* k4 = (const float4*)kr;
    float acc = 0.f;
#pragma unroll
    for (int i = 0; i < 16; ++i) {
        const float4 u = k4[i];
        acc += q[i * 4 + 0] * u.x + q[i * 4 + 1] * u.y + q[i * 4 + 2] * u.z + q[i * 4 + 3] * u.w;
    }
    return acc;
}

DEV void attn_block(const float (&q)[64], const bf16_t* krow_lane, const bf16_t* vbase_lane, bool valid, float& m, float& l, float& o) {
    float sc = dot64_bf(q, krow_lane) * 0.125f;
    sc = valid ? sc : -1e30f;
    const float mb = wmax(sc);
    const float mn = fmaxf(m, mb);
    const float corr = expf(m - mn);
    const float e = valid ? expf(sc - mn) : 0.f;
    l = l * corr + wsum(e);
    o *= corr;
#pragma unroll 8
    for (int k = 0; k < 64; ++k) o += __shfl(e, k) * bf2f(vbase_lane[(size_t)k * INC]);
    m = mn;
}

DEV void nsa_item(const P& p, int item) {
    const int lane = threadIdx.x & 63;
    const int g = item & 1;
    const int t = item >> 1;
    const int b = t >> 11, s = t & 2047;
    const bf16_t* HB = (const bf16_t*)(p.ws + WS_HB);
    const float* KC = (const float*)(p.ws + WS_KC);
    bf16_t* OM = (bf16_t*)(p.ws + WS_OM);
    const int cur = s >> 6;
    const int nvalid = (s >= 31) ? (((s - 31) >> 4) + 1) : 0;
    const size_t rowt = (size_t)t * INC;
    float ocmp0 = 0.f, ocmp1 = 0.f, ocmp2 = 0.f, ocmp3 = 0.f;
    float psum0 = 0.f, psum1 = 0.f;
    if (nvalid > 0) {
#pragma unroll 1
        for (int r = 0; r < 4; ++r) {
            const int h = g * 4 + r;
            float q[64];
            load_q64_bf(q, HB + rowt + C_QA + h * 64);
            float sc0 = -1e30f, sc1 = -1e30f;
            if (lane < nvalid) sc0 = dot64_f(q, KC + ((((size_t)0 * B_ + b) * NCMP + lane) * 2 + g) * 64) * 0.125f;
            if (lane + 64 < nvalid) sc1 = dot64_f(q, KC + ((((size_t)0 * B_ + b) * NCMP + lane + 64) * 2 + g) * 64) * 0.125f;
            const float m = wmax(fmaxf(sc0, sc1));
            const float e0 = (lane < nvalid) ? expf(sc0 - m) : 0.f;
            const float e1 = (lane + 64 < nvalid) ? expf(sc1 - m) : 0.f;
            const float l = wsum(e0 + e1);
            const float p0 = e0 / l, p1 = e1 / l;
            psum0 += p0;
            psum1 += p1;
            float oc = 0.f;
            const float* vcb = KC + ((((size_t)1 * B_ + b) * NCMP) * 2 + g) * 64 + lane;
            for (int n = 0; n < nvalid; ++n) {
                const float pn = (n < 64) ? __shfl(p0, n) : __shfl(p1, n - 64);
                oc += pn * vcb[(size_t)n * 128];
            }
            if (r == 0) ocmp0 = oc;
            if (r == 1) ocmp1 = oc;
            if (r == 2) ocmp2 = oc;
            if (r == 3) ocmp3 = oc;
        }
    }
    float imp = 0.f;
#pragma unroll
    for (int dn = -1; dn <= 3; ++dn) {
        const int n = 4 * lane + dn;
        const int nn = n < 0 ? 0 : (n > 127 ? 127 : n);
        const float v0 = __shfl(psum0, nn & 63);
        const float v1 = __shfl(psum1, nn & 63);
        const float v = (nn < 64) ? v0 : v1;
        if (n >= 0 && n <= 126) imp += v;
    }
    float score;
    if (lane > cur) score = -INFINITY;
    else if (lane == 0 || lane == cur || lane == cur - 1) score = 1e4f;
    else score = imp;
    int rank = 0;
#pragma unroll 8
    for (int i = 0; i < 32; ++i) {
        const float si = __shfl(score, i);
        rank += ((si > score) || (si == score && i < lane)) ? 1 : 0;
    }
    const bool sel = (lane <= cur) && (rank < 16);
    const unsigned mask = (unsigned)(__ballot(sel) & 0xffffffffull);
    const int wlo = (s - 511) > 0 ? (s - 511) : 0;
#pragma unroll 1
    for (int r = 0; r < 4; ++r) {
        const int h = g * 4 + r;
        float q[64];
        load_q64_bf(q, HB + rowt + C_QA + h * 64);
        float m = -1e30f, l = 0.f, o = 0.f;
        for (unsigned mm = mask; mm; mm &= mm - 1) {
            const int j = __builtin_ctz(mm);
            const int kpos = j * 64 + lane;
            attn_block(q, HB + (size_t)(b * S_ + kpos) * INC + C_KS + g * 64, HB + (size_t)(b * S_ + j * 64) * INC + C_VS + g * 64 + lane,
                       kpos <= s, m, l, o);
        }
        const float oslc = o / l;
        m = -1e30f; l = 0.f; o = 0.f;
        for (int j = wlo >> 6; j <= cur; ++j) {
            const int kpos = j * 64 + lane;
            attn_block(q, HB + (size_t)(b * S_ + kpos) * INC + C_KW + g * 64, HB + (size_t)(b * S_ + j * 64) * INC + C_VW + g * 64 + lane,
                       (kpos <= s) && (kpos >= wlo), m, l, o);
        }
        const float owin = o / l;
        const float oc = r == 0 ? ocmp0 : (r == 1 ? ocmp1 : (r == 2 ? ocmp2 : ocmp3));
        const float g0 = sigmoidf_(bf2f(HB[rowt + C_GATE + h * 3 + 0]));
        const float g1 = sigmoidf_(bf2f(HB[rowt + C_GATE + h * 3 + 1]));
        const float g2 = sigmoidf_(bf2f(HB[rowt + C_GATE + h * 3 + 2]));
        OM[(size_t)t * 1024 + h * 64 + lane] = f2bf(g0 * oc + g1 * oslc + g2 * owin);
    }
}

DEV void hgrn_item(const P& p, int item, float* smem) {
    const int b = item >> 2, hh = item & 3;
    const int tid = threadIdx.x, dv = tid & 127, half = tid >> 7;
    const bf16_t* HB = (const bf16_t*)(p.ws + WS_HB);
    bf16_t* OM = (bf16_t*)(p.ws + WS_OM);
    float* sf = smem;
    float* sq = smem + 1024;
    float* so = smem + 2048;
    float Sreg[64];
#pragma unroll
    for (int i = 0; i < 64; ++i) Sreg[i] = 0.f;
    const int d = tid & 127;
    float lbv;
    {
        const float l0 = p.lb_logits[hh * 128 + d], l1 = p.lb_logits[512 + hh * 128 + d];
        const float mx = fmaxf(l0, l1);
        const float e0 = expf(l0 - mx), e1 = expf(l1 - mx);
        lbv = e0 / (e0 + e1);
    }
    const int wave = tid >> 6, lane = tid & 63;
    const float nw0 = p.hg_norm_w[hh * 128 + lane], nw1 = p.hg_norm_w[hh * 128 + lane + 64];
    for (int t0 = 0; t0 < S_; t0 += 8) {
#pragma unroll
        for (int i = 0; i < 4; ++i) {
            const int st = (tid >> 7) + 2 * i;
            const size_t tt = (size_t)b * S_ + t0 + st;
            const float fl = bf2f(HB[tt * INC + C_HF + hh * 128 + d]);
            sf[st * 128 + d] = lbv + (1.f - lbv) * sigmoidf_(fl);
            sq[st * 128 + d] = bf2f(HB[tt * INC + C_HQ + hh * 128 + d]);
        }
        float vv[8];
#pragma unroll
        for (int st = 0; st < 8; ++st) vv[st] = bf2f(HB[((size_t)b * S_ + t0 + st) * INC + C_HI + hh * 128 + dv]);
        __syncthreads();
#pragma unroll
        for (int st = 0; st < 8; ++st) {
            float oacc = 0.f;
            const float* pf = sf + st * 128 + half * 64;
            const float* pq = sq + st * 128 + half * 64;
#pragma unroll
            for (int dk = 0; dk < 64; ++dk) {
                const float f = pf[dk];
                Sreg[dk] = f * Sreg[dk] + (1.f - f) * vv[st];
                oacc += pq[dk] * Sreg[dk];
            }
            so[(st * 2 + half) * 128 + dv] = oacc;
        }
        __syncthreads();
#pragma unroll
        for (int u = 0; u < 2; ++u) {
            const int st = wave * 2 + u;
            const float o0 = so[(st * 2 + 0) * 128 + lane] + so[(st * 2 + 1) * 128 + lane];
            const float o1 = so[(st * 2 + 0) * 128 + lane + 64] + so[(st * 2 + 1) * 128 + lane + 64];
            const float ss = wsum(o0 * o0 + o1 * o1);
            const float rs = rsqrtf(ss * (1.f / 128.f) + LN_EPS);
            const size_t tt = (size_t)b * S_ + t0 + st;
            const float gg0 = bf2f(HB[tt * INC + C_HG + hh * 128 + lane]);
            const float gg1 = bf2f(HB[tt * INC + C_HG + hh * 128 + lane + 64]);
            OM[tt * 1024 + 512 + hh * 128 + lane] = f2bf(o0 * rs * nw0 * (gg0 * sigmoidf_(gg0)));
            OM[tt * 1024 + 512 + hh * 128 + lane + 64] = f2bf(o1 * rs * nw1 * (gg1 * sigmoidf_(gg1)));
        }
    }
    __syncthreads();
}

DEV void ln_item(const P& p, int t, int which, int lane) {
    float* row = p.out + (size_t)t * 1024;
    float4 v[4];
    float s = 0.f;
#pragma unroll
    for (int i = 0; i < 4; ++i) {
        v[i] = *(const float4*)(row + (i * 64 + lane) * 4);
        s += v[i].x + v[i].y + v[i].z + v[i].w;
    }
    const float mean = wsum(s) * (1.f / 1024.f);
    float ss = 0.f;
#pragma unroll
    for (int i = 0; i < 4; ++i) {
        v[i].x -= mean; v[i].y -= mean; v[i].z -= mean; v[i].w -= mean;
        ss += v[i].x * v[i].x + v[i].y * v[i].y + v[i].z * v[i].z + v[i].w * v[i].w;
    }
    const float rs = rsqrtf(wsum(ss) * (1.f / 1024.f) + LN_EPS);
#pragma unroll
    for (int i = 0; i < 4; ++i) {
        const int c = (i * 64 + lane) * 4;
        const float4 gg = *(const float4*)(p.ln_g + which * 1024 + c);
        const float4 bb = *(const float4*)(p.ln_b + which * 1024 + c);
        float4 o;
        o.x = v[i].x * rs * gg.x + bb.x; o.y = v[i].y * rs * gg.y + bb.y; o.z = v[i].z * rs * gg.z + bb.z; o.w = v[i].w * rs * gg.w + bb.w;
        *(float4*)(row + c) = o;
        uint2 u;
        u.x = (unsigned)f2bf(o.x) | ((unsigned)f2bf(o.y) << 16);
        u.y = (unsigned)f2bf(o.z) | ((unsigned)f2bf(o.w) << 16);
        *(uint2*)((bf16_t*)(p.ws + WS_XB) + (size_t)t * 1024 + c) = u;
    }
}

DEV void xattn_item(const P& p, int item) {
    const int lane = threadIdx.x & 63;
    const int hh = item & 3, t = item >> 2, b = t >> 11;
    const bf16_t* QX = (const bf16_t*)(p.ws + WS_QX);
    const bf16_t* KVM = (const bf16_t*)(p.ws + WS_KVM);
    bf16_t* OX = (bf16_t*)(p.ws + WS_OX);
    float sc[4] = {0.f, 0.f, 0.f, 0.f};
#pragma unroll 1
    for (int c = 0; c < 4; ++c) {
        float q[64];
        load_q64_bf(q, QX + (size_t)t * 1024 + hh * 256 + c * 64);
#pragma unroll
        for (int k = 0; k < 4; ++k) sc[k] += dot64_bf(q, KVM + (size_t)(b * ML_ + lane + 64 * k) * 2048 + hh * 256 + c * 64);
    }
    float mx = -1e30f;
#pragma unroll
    for (int k = 0; k < 4; ++k) { sc[k] *= 0.0625f; mx = fmaxf(mx, sc[k]); }
    mx = wmax(mx);
    float pr[4], ls = 0.f;
#pragma unroll
    for (int k = 0; k < 4; ++k) { pr[k] = expf(sc[k] - mx); ls += pr[k]; }
    ls = wsum(ls);
    const float inv = 1.f / ls;
    float o[4] = {0.f, 0.f, 0.f, 0.f};
#pragma unroll
    for (int k = 0; k < 4; ++k) {
        const bf16_t* vb = KVM + (size_t)(b * ML_ + k * 64) * 2048 + 1024 + hh * 256 + lane;
#pragma unroll 4
        for (int mm = 0; mm < 64; ++mm) {
            const float pm = __shfl(pr[k], mm);
#pragma unroll
            for (int c = 0; c < 4; ++c) o[c] += pm * bf2f(vb[(size_t)mm * 2048 + c * 64]);
        }
    }
#pragma unroll
    for (int c = 0; c < 4; ++c) OX[(size_t)t * 1024 + hh * 256 + c * 64 + lane] = f2bf(o[c] * inv);
}

DEV void wave_argmax(float v, int i, float& bv, int& bi) {
#pragma unroll
    for (int o = 32; o > 0; o >>= 1) {
        const float ov = __shfl_xor(v, o);
        const int oi = __shfl_xor(i, o);
        if (ov > v || (ov == v && oi < i)) { v = ov; i = oi; }
    }
    bv = v; bi = i;
}

DEV void peer_item(const P& p, int t) {
    const int lane = threadIdx.x & 63;
    const float* QP = (const float*)(p.ws + WS_QP);
    float* row = p.out + (size_t)t * 1024;
    float4 xr[4], oacc[4];
#pragma unroll
    for (int i = 0; i < 4; ++i) {
        xr[i] = *(const float4*)(row + (i * 64 + lane) * 4);
        oacc[i] = make_float4(0.f, 0.f, 0.f, 0.f);
    }
#pragma unroll 1
    for (int hh = 0; hh < 8; ++hh) {
        float ts1 = 0.f, ts2 = 0.f;
        int ti1 = 0, ti2 = 0;
#pragma unroll 1
        for (int c = 0; c < 2; ++c) {
            float q[64];
            {
                const float4* q4 = (const float4*)(QP + (size_t)t * 1024 + hh * 128 + c * 64);
#pragma unroll
                for (int i = 0; i < 16; ++i) { const float4 u = q4[i]; q[i * 4] = u.x; q[i * 4 + 1] = u.y; q[i * 4 + 2] = u.z; q[i * 4 + 3] = u.w; }
            }
            const float* kb = p.peer_keys + ((size_t)(hh * 2 + c) * 128) * 64;
            float a0 = dot64_f(q, kb + (size_t)lane * 64);
            float a1 = dot64_f(q, kb + (size_t)(lane + 64) * 64);
            float ts = 0.f;
            int ti = 0;
#pragma unroll 1
            for (int k = 0; k < 16; ++k) {
                float v; int i;
                if (a0 >= a1) { v = a0; i = lane; } else { v = a1; i = lane + 64; }
                float bv; int bi;
                wave_argmax(v, i, bv, bi);
                if (lane == k) { ts = bv; ti = bi; }
                if (bi == lane) a0 = -INFINITY;
                if (bi == lane + 64) a1 = -INFINITY;
            }
            if (c == 0) { ts1 = ts; ti1 = ti; } else { ts2 = ts; ti2 = ti; }
        }
        float cs[4];
        const float s1v = __shfl(ts1, lane >> 2);
#pragma unroll
        for (int u = 0; u < 4; ++u) cs[u] = s1v + __shfl(ts2, (lane & 3) * 4 + u);
        float fs = 0.f;
        int fidx = 0;
#pragma unroll 1
        for (int k = 0; k < 16; ++k) {
            float v = cs[0]; int i = lane * 4;
#pragma unroll
            for (int u = 1; u < 4; ++u) if (cs[u] > v) { v = cs[u]; i = lane * 4 + u; }
            float bv; int bi;
            wave_argmax(v, i, bv, bi);
            if (lane == k) { fs = bv; fidx = bi; }
#pragma unroll
            for (int u = 0; u < 4; ++u) if (bi == lane * 4 + u) cs[u] = -INFINITY;
        }
        const int e1i = __shfl(ti1, fidx >> 4);
        const int e2i = __shfl(ti2, fidx & 15);
        const int eid = e1i * 128 + e2i;
        const float mx = __shfl(fs, 0);
        const float w = (lane < 16) ? expf(fs - mx) : 0.f;
        const float gate = w / wsum(w);
#pragma unroll 1
        for (int k = 0; k < 16; ++k) {
            const int e = __shfl(eid, k);
            const float gt = __shfl(gate, k);
            const float* dr = p.peer_down + (size_t)e * 1024;
            const float* ur = p.peer_up + (size_t)e * 1024;
            float hd = 0.f;
#pragma unroll
            for (int i = 0; i < 4; ++i) {
                const float4 dvv = *(const float4*)(dr + (i * 64 + lane) * 4);
                hd += dvv.x * xr[i].x + dvv.y * xr[i].y + dvv.z * xr[i].z + dvv.w * xr[i].w;
            }
            hd = wsum(hd);
            const float a = 0.5f * hd * (1.f + erff(hd * 0.7071067811865476f)) * gt;
#pragma unroll
            for (int i = 0; i < 4; ++i) {
                const float4 uv = *(const float4*)(ur + (i * 64 + lane) * 4);
                oacc[i].x += a * uv.x; oacc[i].y += a * uv.y; oacc[i].z += a * uv.z; oacc[i].w += a * uv.w;
            }
        }
    }
    float s = 0.f;
    float4 v[4];
#pragma unroll
    for (int i = 0; i < 4; ++i) {
        v[i].x = ALPHA * xr[i].x + oacc[i].x; v[i].y = ALPHA * xr[i].y + oacc[i].y;
        v[i].z = ALPHA * xr[i].z + oacc[i].z; v[i].w = ALPHA * xr[i].w + oacc[i].w;
        s += v[i].x + v[i].y + v[i].z + v[i].w;
    }
    const float mean = wsum(s) * (1.f / 1024.f);
    float ss = 0.f;
#pragma unroll
    for (int i = 0; i < 4; ++i) {
        v[i].x -= mean; v[i].y -= mean; v[i].z -= mean; v[i].w -= mean;
        ss += v[i].x * v[i].x + v[i].y * v[i].y + v[i].z * v[i].z + v[i].w * v[i].w;
    }
    const float rs = rsqrtf(wsum(ss) * (1.f / 1024.f) + LN_EPS);
#pragma unroll
    for (int i = 0; i < 4; ++i) {
        const int c = (i * 64 + lane) * 4;
        const float4 gg = *(const float4*)(p.ln_g + 2 * 1024 + c);
        const float4 bb = *(const float4*)(p.ln_b + 2 * 1024 + c);
        float4 o;
        o.x = v[i].x * rs * gg.x + bb.x; o.y = v[i].y * rs * gg.y + bb.y; o.z = v[i].z * rs * gg.z + bb.z; o.w = v[i].w * rs * gg.w + bb.w;
        *(float4*)(row + c) = o;
    }
}


DEV void compress_item2(const P& p, int item, unsigned char* lds) {
    const int nt8 = item & 7, g = (item >> 3) & 1, b = (item >> 4) & 7, kind = item >> 7;
    const int tid = threadIdx.x, lane = tid & 63, wid = tid >> 6, fr = lane & 15, fq = lane >> 4;
    const bf16_t* HB = (const bf16_t*)(p.ws + WS_HB);
    const bf16_t* W1T = (const bf16_t*)(p.ws + WS_W1T) + (size_t)kind * 128 * 2048;
    const bf16_t* W2T = (const bf16_t*)(p.ws + WS_W2T) + (size_t)kind * 64 * 128;
    const float* posb = p.cmp_pos + (size_t)kind * 2048 + fq * 8;
    const int n0 = nt8 * 16;
    const int kcol = (kind ? C_VC : C_KC) + g * 64;
    const bf16_t* abase = HB + (size_t)(b * S_ + 16 * (n0 + fr)) * INC + kcol + fq * 8;
    const bf16_t* wbase = W1T + (size_t)fr * 2048 + fq * 8;
    f32x4 acc[8];
#pragma unroll
    for (int jt = 0; jt < 8; ++jt) acc[jt] = (f32x4){0.f, 0.f, 0.f, 0.f};
#pragma unroll 4
    for (int k2 = 0; k2 < 16; ++k2) {
        const int ks = wid * 16 + k2;
        bf16x8 af;
        {
            const u32x4 raw = *(const u32x4*)(abase + (size_t)(ks >> 1) * INC + (ks & 1) * 32);
            const float* pp = posb + (ks >> 1) * 64 + (ks & 1) * 32;
            const float4 p0 = *(const float4*)pp, p1 = *(const float4*)(pp + 4);
            u32x4 w;
            w[0] = pk_bf16(bflo(raw[0]) + p0.x, bfhi(raw[0]) + p0.y);
            w[1] = pk_bf16(bflo(raw[1]) + p0.z, bfhi(raw[1]) + p0.w);
            w[2] = pk_bf16(bflo(raw[2]) + p1.x, bfhi(raw[2]) + p1.y);
            w[3] = pk_bf16(bflo(raw[3]) + p1.z, bfhi(raw[3]) + p1.w);
            af = __builtin_bit_cast(bf16x8, w);
        }
#pragma unroll
        for (int jt = 0; jt < 8; ++jt) {
            const bf16x8 wf = *(const bf16x8*)(wbase + (size_t)jt * 16 * 2048 + ks * 32);
            acc[jt] = __builtin_amdgcn_mfma_f32_16x16x32_bf16(wf, af, acc[jt], 0, 0, 0);
        }
    }
    float* PS = (float*)lds;
    bf16_t* HS = (bf16_t*)(lds + 4 * 16 * 132 * 4);
#pragma unroll
    for (int jt = 0; jt < 8; ++jt)
        *(float4*)(PS + (wid * 16 + fr) * 132 + jt * 16 + fq * 4) = make_float4(acc[jt][0], acc[jt][1], acc[jt][2], acc[jt][3]);
    __syncthreads();
    {
        const int r = tid >> 4, jb = (tid & 15) * 8;
        float hv[8];
#pragma unroll
        for (int h2 = 0; h2 < 2; ++h2) {
            float4 s = make_float4(0.f, 0.f, 0.f, 0.f);
#pragma unroll
            for (int w = 0; w < 4; ++w) {
                const float4 v = *(const float4*)(PS + (w * 16 + r) * 132 + jb + h2 * 4);
                s.x += v.x; s.y += v.y; s.z += v.z; s.w += v.w;
            }
            hv[h2 * 4 + 0] = s.x; hv[h2 * 4 + 1] = s.y; hv[h2 * 4 + 2] = s.z; hv[h2 * 4 + 3] = s.w;
        }
#pragma unroll
        for (int i = 0; i < 8; ++i) {
            const float v = hv[i];
            const float u = 0.7978845608028654f * (v + 0.044715f * v * v * v);
            hv[i] = 0.5f * v * (1.f + tanhf(u));
        }
        u32x4 w;
        w[0] = pk_bf16(hv[0], hv[1]); w[1] = pk_bf16(hv[2], hv[3]); w[2] = pk_bf16(hv[4], hv[5]); w[3] = pk_bf16(hv[6], hv[7]);
        *(u32x4*)(HS + r * 136 + jb) = w;
    }
    __syncthreads();
    f32x4 o = (f32x4){0.f, 0.f, 0.f, 0.f};
#pragma unroll
    for (int ks = 0; ks < 4; ++ks) {
        const bf16x8 hf = *(const bf16x8*)(HS + fr * 136 + ks * 32 + fq * 8);
        const bf16x8 wf = *(const bf16x8*)(W2T + (size_t)(wid * 16 + fr) * 128 + ks * 32 + fq * 8);
        if (kind == 0) o = __builtin_amdgcn_mfma_f32_16x16x32_bf16(wf, hf, o, 0, 0, 0);
        else o = __builtin_amdgcn_mfma_f32_16x16x32_bf16(hf, wf, o, 0, 0, 0);
    }
    if (kind == 0) {
        const int n = n0 + fr, e = wid * 16 + fq * 4;
        uint2 u2;
        u2.x = pk_bf16(o[0], o[1]);
        u2.y = pk_bf16(o[2], o[3]);
        if (n == 127) u2 = make_uint2(0u, 0u);
        *(uint2*)((bf16_t*)(p.ws + WS_KCB) + ((size_t)(b * 2 + g) * 128 + n) * 64 + e) = u2;
    } else {
        const int e = wid * 16 + fr, n = n0 + fq * 4;
        const float o3 = (n + 3 == 127) ? 0.f : o[3];
        uint2 u2;
        u2.x = pk_bf16(o[0], o[1]);
        u2.y = pk_bf16(o[2], o3);
        *(uint2*)((bf16_t*)(p.ws + WS_VCT) + ((size_t)(b * 2 + g) * 64 + e) * 128 + n) = u2;
    }
    __syncthreads();
}

constexpr int NSA_IMP = 32768;
constexpr int NSA_SCORE = 49152;
constexpr int NSA_SELM = NSA_SCORE + 4224;

struct NsaTileRegs { u32x4 k[2], v[2]; };
DEV void nsa_load_tile(NsaTileRegs& r, const bf16_t* kbase, size_t kstride, const bf16_t* vbase, size_t vstride, int tid) {
    const int lc = tid & 7, lr = tid >> 3;
#pragma unroll
    for (int i = 0; i < 2; ++i) {
        r.k[i] = *(const u32x4*)(kbase + (size_t)(lr + 32 * i) * kstride + lc * 8);
        r.v[i] = *(const u32x4*)(vbase + (size_t)(lr + 32 * i) * vstride + lc * 8);
    }
}
DEV void nsa_store_tile(const NsaTileRegs& r, unsigned char* stage, int tid) {
    const int lc = tid & 7, lr = tid >> 3;
    const int woff = lr * 128 + ((lc ^ ((lr >> 1) & 7)) << 4);
#pragma unroll
    for (int i = 0; i < 2; ++i) {
        *(u32x4*)(stage + woff + i * 4096) = r.k[i];
        *(u32x4*)(stage + 8192 + woff + i * 4096) = r.v[i];
    }
}
DEV void nsa_dma_tile(const bf16_t* kbase, size_t kstride, const bf16_t* vbase, size_t vstride, unsigned char* stage, int lane, int wid) {
#pragma unroll
    for (int i = 0; i < 2; ++i) {
        const int pc = wid * 2 + i;
        const int r = pc * 8 + (lane >> 3);
        const int c = (lane & 7) ^ ((r >> 1) & 7);
        __builtin_amdgcn_global_load_lds((const unsigned*)(kbase + (size_t)r * kstride + c * 8), (unsigned*)(stage + pc * 1024), 16, 0, 0);
        __builtin_amdgcn_global_load_lds((const unsigned*)(vbase + (size_t)r * vstride + c * 8), (unsigned*)(stage + 8192 + pc * 1024), 16, 0, 0);
    }
}
DEV void nsa_scores(const unsigned char* stage, const bf16x8 (&qf)[2][2], f32x4 (&sc)[4][2], int fr, int fq) {
    const int sw = (fr >> 1) & 7;
    const int c0 = (fq ^ sw) << 4;
    const unsigned char* rowp = stage + fr * 128;
    const unsigned char* p0 = rowp + c0;
    const unsigned char* p1 = rowp + (c0 ^ 64);
#pragma unroll
    for (int kt = 0; kt < 4; ++kt) {
        const bf16x8 k0 = *(const bf16x8*)(p0 + kt * 2048);
        const bf16x8 k1 = *(const bf16x8*)(p1 + kt * 2048);
#pragma unroll
        for (int qt = 0; qt < 2; ++qt) {
            f32x4 a = (f32x4){0.f, 0.f, 0.f, 0.f};
            a = __builtin_amdgcn_mfma_f32_16x16x32_bf16(k0, qf[qt][0], a, 0, 0, 0);
            a = __builtin_amdgcn_mfma_f32_16x16x32_bf16(k1, qf[qt][1], a, 0, 0, 0);
            sc[kt][qt] = a;
        }
    }
}
DEV void nsa_pv(const unsigned char* stage, const f32x4 (&sc)[4][2], f32x4 (&o)[4][2], int fr, int fq) {
    const int sw = (fr >> 1) & 7;
    const int v0 = (((fq >> 1) ^ sw) << 4) + 8 * (fq & 1);
    const unsigned char* rowp = stage + 8192 + fr * 128;
#pragma unroll
    for (int s = 0; s < 2; ++s) {
        u32x4 pf[2];
#pragma unroll
        for (int qt = 0; qt < 2; ++qt) {
            pf[qt][0] = pk_bf16(sc[2 * s][qt][0], sc[2 * s][qt][1]);
            pf[qt][1] = pk_bf16(sc[2 * s][qt][2], sc[2 * s][qt][3]);
            pf[qt][2] = pk_bf16(sc[2 * s + 1][qt][0], sc[2 * s + 1][qt][1]);
            pf[qt][3] = pk_bf16(sc[2 * s + 1][qt][2], sc[2 * s + 1][qt][3]);
        }
        const unsigned char* plo = rowp + (v0 ^ (64 * s));
        const unsigned char* phi = rowp + (v0 ^ (64 * s) ^ 32);
#pragma unroll
        for (int dt = 0; dt < 4; ++dt) {
            const uint2 lo = *(const uint2*)(plo + dt * 2048);
            const uint2 hi = *(const uint2*)(phi + dt * 2048);
            u32x4 vv;
            vv[0] = lo.x; vv[1] = lo.y; vv[2] = hi.x; vv[3] = hi.y;
            const bf16x8 vf = __builtin_bit_cast(bf16x8, vv);
#pragma unroll
            for (int qt = 0; qt < 2; ++qt)
                o[dt][qt] = __builtin_amdgcn_mfma_f32_16x16x32_bf16(vf, __builtin_bit_cast(bf16x8, pf[qt]), o[dt][qt], 0, 0, 0);
        }
    }
}
DEV float xmax4(float v) { v = fmaxf(v, __shfl_xor(v, 16)); return fmaxf(v, __shfl_xor(v, 32)); }
DEV float xsum4(float v) { v += __shfl_xor(v, 16); return v + __shfl_xor(v, 32); }

DEV void nsa_branch(const int mode, const int BR, const int q0v, const unsigned char* wsb, unsigned char* lds, int b, int g, unsigned blocks, const bf16x8 (&qf)[2][2], const int (&qpos)[2],
                    const unsigned (&selm)[2], const float (&gate)[2], f32x4 (&fin)[4][2], int tid) {
    asm volatile("" : "+v"(tid));
    const int fr = tid & 15, fq = (tid >> 4) & 3;
    const bf16_t* HB = (const bf16_t*)(wsb + WS_HB);
    const bf16_t* VT = (const bf16_t*)(wsb + WS_VT);
    const bf16_t* kb0 = HB + (size_t)(b * S_) * INC + (BR == 0 ? C_KS : C_KW) + g * 64;
    const bf16_t* vb0 = VT + ((((size_t)BR * B_ + b) * 2 + g) * 64) * 2048;
    const bool fake = mode == 1;
    float m[2] = {-1e30f, -1e30f}, l[2] = {0.f, 0.f};
    f32x4 o[4][2];
#pragma unroll
    for (int dt = 0; dt < 4; ++dt)
#pragma unroll
        for (int qt = 0; qt < 2; ++qt) o[dt][qt] = (f32x4){0.f, 0.f, 0.f, 0.f};
    const int lane64 = tid & 63, widx = __builtin_amdgcn_readfirstlane(tid >> 6);
    int kb = __builtin_ctz(blocks);
    blocks &= blocks - 1;
    int kb1 = blocks ? __builtin_ctz(blocks) : -1;
    if (kb1 >= 0) blocks &= blocks - 1;
    nsa_dma_tile(kb0 + (size_t)(fake ? 0 : kb) * 64 * INC, INC, vb0 + (fake ? 0 : kb) * 64, 2048, lds, lane64, widx);
    if (kb1 >= 0) nsa_dma_tile(kb0 + (size_t)(fake ? 0 : kb1) * 64 * INC, INC, vb0 + (fake ? 0 : kb1) * 64, 2048, lds + 16384, lane64, widx);
    int slot = 0;
    while (true) {
        if (kb1 >= 0) asm volatile("s_waitcnt vmcnt(4)\n\ts_waitcnt lgkmcnt(0)" ::: "memory");
        else asm volatile("s_waitcnt vmcnt(0)\n\ts_waitcnt lgkmcnt(0)" ::: "memory");
        __builtin_amdgcn_s_barrier(); asm volatile("" ::: "memory");
        const int kb2 = blocks ? __builtin_ctz(blocks) : -1;
        if (kb2 >= 0) {
            blocks &= blocks - 1;
            const int s2 = slot >= 1 ? slot - 1 : 2;
            nsa_dma_tile(kb0 + (size_t)(fake ? 0 : kb2) * 64 * INC, INC, vb0 + (fake ? 0 : kb2) * 64, 2048, lds + s2 * 16384, lane64, widx);
        }
        const unsigned char* stage = lds + slot * 16384;
        f32x4 sc[4][2];
        nsa_scores(stage, qf, sc, fr, fq);
        constexpr float C1 = 0.125f * 1.4426950408889634f;
        const bool need_mask = (BR == 0) ? (kb == (q0v >> 6)) : !((kb * 64 + 63 <= q0v) && (kb * 64 + 511 >= q0v + 31));
        float alpha[2];
        if (!need_mask) {
#pragma unroll
            for (int qt = 0; qt < 2; ++qt) {
                const bool sel = BR == 0 ? ((selm[qt] >> kb) & 1u) != 0u : true;
                float bm = -1e30f;
#pragma unroll
                for (int kt = 0; kt < 4; ++kt)
#pragma unroll
                    for (int i = 0; i < 4; ++i) {
                        const float s = sel ? sc[kt][qt][i] * C1 : -1e30f;
                        sc[kt][qt][i] = s;
                        bm = fmaxf(bm, s);
                    }
                bm = xmax4(bm);
                const float mn = fmaxf(m[qt], bm);
                alpha[qt] = __builtin_amdgcn_exp2f(m[qt] - mn);
                float ps = 0.f;
#pragma unroll
                for (int kt = 0; kt < 4; ++kt)
#pragma unroll
                    for (int i = 0; i < 4; ++i) {
                        const float s = sc[kt][qt][i];
                        const float e = (s > -1e29f) ? __builtin_amdgcn_exp2f(s - mn) : 0.f;
                        sc[kt][qt][i] = e;
                        ps += e;
                    }
                l[qt] = l[qt] * alpha[qt] + ps;
                m[qt] = mn;
            }
        } else {
#pragma unroll
            for (int qt = 0; qt < 2; ++qt) {
                const bool sel = BR == 0 ? ((selm[qt] >> kb) & 1u) != 0u : true;
                float bm = -1e30f;
#pragma unroll
                for (int kt = 0; kt < 4; ++kt)
#pragma unroll
                    for (int i = 0; i < 4; ++i) {
                        const int key = kb * 64 + kt * 16 + fq * 4 + i;
                        bool valid = sel && (key <= qpos[qt]);
                        if (BR == 1) valid = valid && (key + 511 >= qpos[qt]);
                        const float s = valid ? sc[kt][qt][i] * C1 : -1e30f;
                        sc[kt][qt][i] = s;
                        bm = fmaxf(bm, s);
                    }
                bm = xmax4(bm);
                const float mn = fmaxf(m[qt], bm);
                alpha[qt] = __builtin_amdgcn_exp2f(m[qt] - mn);
                float ps = 0.f;
#pragma unroll
                for (int kt = 0; kt < 4; ++kt)
#pragma unroll
                    for (int i = 0; i < 4; ++i) {
                        const float s = sc[kt][qt][i];
                        const float e = (s > -1e29f) ? __builtin_amdgcn_exp2f(s - mn) : 0.f;
                        sc[kt][qt][i] = e;
                        ps += e;
                    }
                l[qt] = l[qt] * alpha[qt] + ps;
                m[qt] = mn;
            }
        }
        {
#pragma unroll
            for (int qt = 0; qt < 2; ++qt)
#pragma unroll
                for (int dt = 0; dt < 4; ++dt) o[dt][qt] *= alpha[qt];
        }
        if (mode != 3) nsa_pv(stage, sc, o, fr, fq);
        else { asm volatile("" :: "v"(sc[0][0][0]), "v"(sc[1][1][1]), "v"(sc[2][0][2]), "v"(sc[3][1][3])); }
        if (kb1 < 0) break;
        kb = kb1;
        kb1 = kb2;
        slot = slot == 2 ? 0 : slot + 1;
    }
#pragma unroll
    for (int qt = 0; qt < 2; ++qt) {
        const float lt = xsum4(l[qt]);
        const float sc2 = lt > 0.f ? gate[qt] / lt : 0.f;
#pragma unroll
        for (int dt = 0; dt < 4; ++dt) fin[dt][qt] += o[dt][qt] * sc2;
    }
    asm volatile("s_waitcnt lgkmcnt(0)" ::: "memory");
    __builtin_amdgcn_s_barrier(); asm volatile("" ::: "memory");
}

DEV void nsa_item2(const P& p, int b, int g, int qblk, unsigned char* lds, int fake = 0) {
    int tid = threadIdx.x;
    asm volatile("" : "+v"(tid));
    const int lane = tid & 63, wid = tid >> 6, fr = lane & 15, fq = lane >> 4;
    const int q0 = qblk * 32, cur = q0 >> 6, h = g * 4 + wid;
    unsigned char* wsb = p.ws;
    asm volatile("" : "+s"(wsb));
    const bf16_t* HB = (const bf16_t*)(wsb + WS_HB);
    float* IMPW = (float*)(lds + NSA_IMP);
    float* SCORE = (float*)(lds + NSA_SCORE);
    unsigned* SELM = (unsigned*)(lds + NSA_SELM);
    bf16x8 qf[2][2];
    int qpos[2];
#pragma unroll
    for (int qt = 0; qt < 2; ++qt) {
        qpos[qt] = q0 + qt * 16 + fr;
        const bf16_t* rowp = HB + (size_t)(b * S_ + qpos[qt]) * INC;
#pragma unroll
        for (int ks = 0; ks < 2; ++ks) qf[qt][ks] = *(const bf16x8*)(rowp + C_QA + h * 64 + ks * 32 + fq * 8);
    }
    if (tid < 33) SELM[tid] = 0u;
    f32x4 fin[4][2];
#pragma unroll
    for (int dt = 0; dt < 4; ++dt)
#pragma unroll
        for (int qt = 0; qt < 2; ++qt) fin[dt][qt] = (f32x4){0.f, 0.f, 0.f, 0.f};
    {
        const bf16_t* KCB = (const bf16_t*)(wsb + WS_KCB) + (size_t)(b * 2 + g) * 128 * 64;
        const bf16_t* VCT = (const bf16_t*)(wsb + WS_VCT) + (size_t)(b * 2 + g) * 64 * 128;
        {
            const int widx = __builtin_amdgcn_readfirstlane(wid);
            nsa_dma_tile(KCB, 64, VCT, 128, lds, lane, widx);
            nsa_dma_tile(KCB + 64 * 64, 64, VCT + 64, 128, lds + 16384, lane, widx);
            asm volatile("s_waitcnt vmcnt(0)" ::: "memory");
        }
        __syncthreads();
        int nv[2];
        float mx[2] = {-1e30f, -1e30f}, inv[2];
#pragma unroll
        for (int qt = 0; qt < 2; ++qt) nv[qt] = qpos[qt] >= 31 ? (((qpos[qt] - 31) >> 4) + 1) : 0;
#pragma unroll 1
        for (int kb = 0; kb < 2; ++kb) {
            f32x4 sc[4][2];
            nsa_scores(lds + kb * 16384, qf, sc, fr, fq);
#pragma unroll
            for (int qt = 0; qt < 2; ++qt)
#pragma unroll
                for (int kt = 0; kt < 4; ++kt)
#pragma unroll
                    for (int i = 0; i < 4; ++i) {
                        const int n = kb * 64 + kt * 16 + fq * 4 + i;
                        mx[qt] = fmaxf(mx[qt], (n < nv[qt]) ? sc[kt][qt][i] * 0.125f : -1e30f);
                    }
        }
        float ps[2] = {0.f, 0.f};
#pragma unroll
        for (int qt = 0; qt < 2; ++qt) mx[qt] = xmax4(mx[qt]);
#pragma unroll 1
        for (int kb = 0; kb < 2; ++kb) {
            f32x4 sc[4][2];
            nsa_scores(lds + kb * 16384, qf, sc, fr, fq);
#pragma unroll
            for (int qt = 0; qt < 2; ++qt)
#pragma unroll
                for (int kt = 0; kt < 4; ++kt)
#pragma unroll
                    for (int i = 0; i < 4; ++i) {
                        const int n = kb * 64 + kt * 16 + fq * 4 + i;
                        ps[qt] += (n < nv[qt]) ? __expf(sc[kt][qt][i] * 0.125f - mx[qt]) : 0.f;
                    }
        }
#pragma unroll
        for (int qt = 0; qt < 2; ++qt) {
            ps[qt] = xsum4(ps[qt]);
            inv[qt] = ps[qt] > 0.f ? 1.f / ps[qt] : 0.f;
        }
        float prev3[2] = {0.f, 0.f};
#pragma unroll 1
        for (int kb = 0; kb < 2; ++kb) {
            f32x4 sc[4][2];
            nsa_scores(lds + kb * 16384, qf, sc, fr, fq);
#pragma unroll
            for (int qt = 0; qt < 2; ++qt) {
                float* impw = IMPW + (wid * 32 + qt * 16 + fr) * 32 + kb * 16 + fq;
#pragma unroll
                for (int kt = 0; kt < 4; ++kt) {
                    f32x4 pv;
#pragma unroll
                    for (int i = 0; i < 4; ++i) {
                        const int n = kb * 64 + kt * 16 + fq * 4 + i;
                        pv[i] = (n < nv[qt]) ? __expf(sc[kt][qt][i] * 0.125f - mx[qt]) * inv[qt] : 0.f;
                    }
                    sc[kt][qt] = pv;
                    const float c1 = __shfl_up(pv[3], 16);
                    const float c0 = __shfl(prev3[qt], fr + 48);
                    impw[kt * 4] = pv[0] + pv[1] + pv[2] + pv[3] + (fq > 0 ? c1 : c0);
                    prev3[qt] = pv[3];
                }
            }
            nsa_pv(lds + kb * 16384, sc, fin, fr, fq);
        }
#pragma unroll
        for (int qt = 0; qt < 2; ++qt) {
            const float gc = fsigmoid(bf2f(HB[(size_t)(b * S_ + qpos[qt]) * INC + C_GATE + h * 3 + 0]));
#pragma unroll
            for (int dt = 0; dt < 4; ++dt) fin[dt][qt] *= gc;
        }
    }
    __syncthreads();
    {
        const int q = tid >> 3, jg = tid & 7;
#pragma unroll
        for (int u = 0; u < 4; ++u) {
            const int j = jg * 4 + u;
            const float imp = IMPW[(0 * 32 + q) * 32 + j] + IMPW[(1 * 32 + q) * 32 + j] + IMPW[(2 * 32 + q) * 32 + j] + IMPW[(3 * 32 + q) * 32 + j];
            float score;
            if (j > cur) score = -INFINITY;
            else if (j == 0 || j == cur || j == cur - 1) score = 1e4f;
            else score = imp;
            SCORE[q * 33 + j] = score;
        }
        __syncthreads();
        unsigned bits = 0u;
#pragma unroll
        for (int u = 0; u < 4; ++u) {
            const int j = jg * 4 + u;
            const float sj = SCORE[q * 33 + j];
            int rank = 0;
#pragma unroll 8
            for (int i = 0; i < 32; ++i) {
                const float si = SCORE[q * 33 + i];
                rank += ((si > sj) || (si == sj && i < j)) ? 1 : 0;
            }
            if (j <= cur && rank < 16) bits |= 1u << j;
        }
        atomicOr(&SELM[q], bits);
        atomicOr(&SELM[32], bits);
        __syncthreads();
    }
    unsigned selm[2];
    selm[0] = SELM[fr];
    selm[1] = SELM[16 + fr];
    const unsigned um = SELM[32];
    __syncthreads();
#pragma unroll 1
    for (int br = 0; br < 2; ++br) {
        const int wlo = (q0 - 511) > 0 ? ((q0 - 511) >> 6) : 0;
        const unsigned wmask = ((2u << cur) - 1u) & ~((1u << wlo) - 1u);
        float gs[2];
#pragma unroll
        for (int qt = 0; qt < 2; ++qt) gs[qt] = fsigmoid(bf2f(HB[(size_t)(b * S_ + qpos[qt]) * INC + C_GATE + h * 3 + 1 + br]));
        if (fake != 2) nsa_branch(fake, br, q0, wsb, lds, b, g, br ? wmask : um, qf, qpos, selm, gs, fin, tid);
    }
    bf16_t* OM = (bf16_t*)(wsb + WS_OM);
#pragma unroll
    for (int qt = 0; qt < 2; ++qt)
#pragma unroll
        for (int dt = 0; dt < 4; ++dt) {
            uint2 u2;
            u2.x = pk_bf16(fin[dt][qt][0], fin[dt][qt][1]);
            u2.y = pk_bf16(fin[dt][qt][2], fin[dt][qt][3]);
            *(uint2*)(OM + (size_t)(b * S_ + qpos[qt]) * 1024 + h * 64 + dt * 16 + fq * 4) = u2;
        }
}

DEV void hgrn_prep_item(const P& p, int item, float* smem) {
    const int c = item & 31, bh = item >> 5, hh = bh & 3, b = bh >> 2;
    const int tid = threadIdx.x, d = tid & 127, th = tid >> 7;
    const bf16_t* HB = (const bf16_t*)(p.ws + WS_HB);
    unsigned char* hs = (unsigned char*)p.out;
    bf16_t* QT = (bf16_t*)(hs + HS_QT);
    bf16_t* KT = (bf16_t*)(hs + HS_KT);
    bf16_t* KHT = (bf16_t*)(hs + HS_KHT);
    bf16_t* VIT = (bf16_t*)(hs + HS_VIT);
    float lbv;
    {
        const float l0 = p.lb_logits[hh * 128 + d], l1 = p.lb_logits[512 + hh * 128 + d];
        const float mx = fmaxf(l0, l1);
        const float e0 = expf(l0 - mx), e1 = expf(l1 - mx);
        lbv = e0 / (e0 + e1);
    }
    const size_t trow0 = (size_t)b * S_ + c * 64 + th * 32;
    float kk[32], bl[32];
    float run = 0.f;
#pragma unroll
    for (int i = 0; i < 32; ++i) {
        const float fl = bf2f(HB[(trow0 + i) * INC + C_HF + hh * 128 + d]);
        const float f = lbv + (1.f - lbv) * fsigmoid(fl);
        kk[i] = 1.f - f;
        run += __logf(f);
        bl[i] = run;
    }
    smem[th * 128 + d] = run;
    __syncthreads();
    const float off = th ? smem[d] : 0.f;
    const float blast = smem[d] + smem[128 + d];
    unsigned kh[16], vi[16];
#pragma unroll
    for (int i = 0; i < 32; i += 2) {
        float qv[2], kt[2], khv[2], vv[2];
#pragma unroll
        for (int u = 0; u < 2; ++u) {
            const float bb = bl[i + u] + off;
            const size_t tr = trow0 + i + u;
            const float q = bf2f(HB[tr * INC + C_HQ + hh * 128 + d]);
            vv[u] = bf2f(HB[tr * INC + C_HI + hh * 128 + d]);
            qv[u] = q * __expf(bb);
            kt[u] = kk[i + u] * __expf(fminf(-bb, 80.f));
            khv[u] = kk[i + u] * __expf(blast - bb);
            const size_t o = ((size_t)bh * 2048 + c * 64 + th * 32 + i + u) * 128 + d;
            QT[o] = f2bf(qv[u]);
            KT[o] = f2bf(kt[u]);
        }
        kh[i >> 1] = pk_bf16(khv[0], khv[1]);
        vi[i >> 1] = pk_bf16(vv[0], vv[1]);
    }
    {
        const size_t o = ((size_t)bh * 128 + d) * 2048 + c * 64 + th * 32;
#pragma unroll
        for (int j = 0; j < 4; ++j) {
            u32x4 a, bq;
            a[0] = kh[4 * j]; a[1] = kh[4 * j + 1]; a[2] = kh[4 * j + 2]; a[3] = kh[4 * j + 3];
            bq[0] = vi[4 * j]; bq[1] = vi[4 * j + 1]; bq[2] = vi[4 * j + 2]; bq[3] = vi[4 * j + 3];
            *(u32x4*)(KHT + o + j * 8) = a;
            *(u32x4*)(VIT + o + j * 8) = bq;
        }
    }
    if (th == 0) ((float*)(p.ws + WS_EB))[((size_t)bh * 32 + c) * 128 + d] = expf(blast);
    __syncthreads();
}

DEV bf16x8 ld2x8(const bf16_t* p0, const bf16_t* p1) {
    const uint2 lo = *(const uint2*)p0, hi = *(const uint2*)p1;
    u32x4 v;
    v[0] = lo.x; v[1] = lo.y; v[2] = hi.x; v[3] = hi.y;
    return __builtin_bit_cast(bf16x8, v);
}
struct HgRegs { u32x4 a[4], b[4]; };
DEV void hg_loadA(HgRegs& r, const bf16_t* KT, const bf16_t* QT, int s0, int tid) {
    const unsigned off = (unsigned)(((tid >> 4) * 128 + (tid & 15) * 8) * 2);
    const char* kb = (const char*)(KT + (size_t)s0 * 128);
    const char* qb = (const char*)(QT + (size_t)s0 * 128);
#pragma unroll
    for (int i = 0; i < 4; ++i) {
        r.a[i] = *(const u32x4*)(kb + i * 4096 + off);
        r.b[i] = *(const u32x4*)(qb + i * 4096 + off);
    }
}
DEV void hg_storeA(const HgRegs& r, unsigned char* lds, int tid) {
    const int c16 = tid & 15, r16 = tid >> 4;
    const int o16 = r16 * 256 + ((c16 ^ (r16 & 15)) << 4);
#pragma unroll
    for (int i = 0; i < 4; ++i) {
        *(u32x4*)(lds + o16 + i * 4096) = r.a[i];
        *(u32x4*)(lds + 16384 + o16 + i * 4096) = r.b[i];
    }
}
DEV void hg_loadB(HgRegs& r, const bf16_t* KHT, const bf16_t* VIT, int s0, int tid) {
    const unsigned off = (unsigned)(((tid >> 3) * 2048 + (tid & 7) * 8) * 2);
    const char* kb = (const char*)(KHT + s0);
    const char* vb = (const char*)(VIT + s0);
#pragma unroll
    for (int i = 0; i < 4; ++i) {
        r.a[i] = *(const u32x4*)(kb + (size_t)i * 131072 + off);
        r.b[i] = *(const u32x4*)(vb + (size_t)i * 131072 + off);
    }
}
DEV void hg_storeB(const HgRegs& r, unsigned char* lds, int tid) {
    const int c8 = tid & 7, r8 = tid >> 3;
    const int o8 = r8 * 128 + ((c8 ^ ((r8 >> 1) & 7)) << 4);
#pragma unroll
    for (int i = 0; i < 4; ++i) {
        *(u32x4*)(lds + 32768 + o8 + i * 4096) = r.a[i];
        *(u32x4*)(lds + 49152 + o8 + i * 4096) = r.b[i];
    }
}
DEV void hgrn_chain_item(const P& p, int bh, unsigned char* lds) {
    const int hh = bh & 3, b = bh >> 2;
    int tid = threadIdx.x;
    asm volatile("" : "+v"(tid));
    const int lane = tid & 63, wid = tid >> 6, fr = lane & 15, fq = lane >> 4;
    const unsigned char* hs = (const unsigned char*)p.out;
    const bf16_t* QT = (const bf16_t*)(hs + HS_QT) + (size_t)bh * 2048 * 128;
    const bf16_t* KT = (const bf16_t*)(hs + HS_KT) + (size_t)bh * 2048 * 128;
    const bf16_t* KHT = (const bf16_t*)(hs + HS_KHT) + (size_t)bh * 128 * 2048;
    const bf16_t* VIT = (const bf16_t*)(hs + HS_VIT) + (size_t)bh * 128 * 2048;
    const float* EB = (const float*)(p.ws + WS_EB) + (size_t)bh * 32 * 128;
    const bf16_t* HB = (const bf16_t*)(p.ws + WS_HB);
    bf16_t* OM = (bf16_t*)(p.ws + WS_OM);
    const unsigned char* sKT = lds;
    const unsigned char* sQT = lds + 16384;
    const unsigned char* sKH = lds + 32768;
    const unsigned char* sVI = lds + 49152;
    bf16_t* AT = (bf16_t*)lds;
    float* SS = (float*)(lds + 65536);
    f32x4 S[8][2];
#pragma unroll
    for (int i = 0; i < 8; ++i)
#pragma unroll
        for (int j = 0; j < 2; ++j) S[i][j] = (f32x4){0.f, 0.f, 0.f, 0.f};
    const int dv0 = wid * 32;
    const int sw8 = (fr >> 1) & 7;
    int b256[4];
#pragma unroll
    for (int ks = 0; ks < 4; ++ks) b256[ks] = fr * 256 + (((4 * ks + fq) ^ fr) << 4);
    int p256[4][2];
#pragma unroll
    for (int u = 0; u < 4; ++u)
#pragma unroll
        for (int h = 0; h < 2; ++h) p256[u][h] = fr * 256 + (((4 * u + 2 * h + (fq >> 1)) ^ fr) << 4) + 8 * (fq & 1);
    int b128[2];
#pragma unroll
    for (int ks = 0; ks < 2; ++ks) b128[ks] = fr * 128 + (((4 * ks + fq) ^ sw8) << 4);
    {
        HgRegs r;
        hg_loadA(r, KT, QT, 0, tid);
        hg_storeA(r, lds, tid);
        hg_loadB(r, KHT, VIT, 0, tid);
        hg_storeB(r, lds, tid);
    }
    __syncthreads();
#pragma unroll 1
    for (int c = 0; c < 32; ++c) {
        const int s0 = c * 64;
        HgRegs nx;
        if (c + 1 < 32) hg_loadA(nx, KT, QT, s0 + 64, tid);
        uint2 atp[4];
        {
            bf16x8 qf[4];
#pragma unroll
            for (int ks = 0; ks < 4; ++ks) qf[ks] = *(const bf16x8*)(sQT + wid * 4096 + b256[ks]);
#pragma unroll
            for (int st = 0; st < 4; ++st) {
                f32x4 a = (f32x4){0.f, 0.f, 0.f, 0.f};
#pragma unroll
                for (int ks = 0; ks < 4; ++ks) {
                    const bf16x8 kf = *(const bf16x8*)(sKT + st * 4096 + b256[ks]);
                    a = __builtin_amdgcn_mfma_f32_16x16x32_bf16(kf, qf[ks], a, 0, 0, 0);
                }
                const int t = wid * 16 + fr;
                float av[4];
#pragma unroll
                for (int i = 0; i < 4; ++i) av[i] = (st * 16 + fq * 4 + i <= t) ? a[i] : 0.f;
                atp[st].x = pk_bf16(av[0], av[1]);
                atp[st].y = pk_bf16(av[2], av[3]);
            }
        }
        __syncthreads();
#pragma unroll
        for (int st = 0; st < 4; ++st) *(uint2*)(AT + (wid * 16 + fr) * 72 + st * 16 + fq * 4) = atp[st];
        __syncthreads();
        f32x4 o[2][4];
#pragma unroll
        for (int i = 0; i < 2; ++i)
#pragma unroll
            for (int j = 0; j < 4; ++j) o[i][j] = (f32x4){0.f, 0.f, 0.f, 0.f};
        bf16x8 vf[2][2];
#pragma unroll
        for (int dvt = 0; dvt < 2; ++dvt)
#pragma unroll
            for (int ks = 0; ks < 2; ++ks) vf[dvt][ks] = *(const bf16x8*)(sVI + wid * 4096 + dvt * 2048 + b128[ks]);
#pragma unroll
        for (int ks = 0; ks < 2; ++ks)
#pragma unroll
            for (int tt = 0; tt < 4; ++tt) {
                const bf16x8 af = *(const bf16x8*)(AT + (tt * 16 + fr) * 72 + ks * 32 + fq * 8);
#pragma unroll
                for (int dvt = 0; dvt < 2; ++dvt) o[dvt][tt] = __builtin_amdgcn_mfma_f32_16x16x32_bf16(vf[dvt][ks], af, o[dvt][tt], 0, 0, 0);
            }
#pragma unroll
        for (int u = 0; u < 4; ++u) {
            bf16x8 sf[2];
#pragma unroll
            for (int dvt = 0; dvt < 2; ++dvt) {
                u32x4 w;
                w[0] = pk_bf16(S[2 * u][dvt][0], S[2 * u][dvt][1]);
                w[1] = pk_bf16(S[2 * u][dvt][2], S[2 * u][dvt][3]);
                w[2] = pk_bf16(S[2 * u + 1][dvt][0], S[2 * u + 1][dvt][1]);
                w[3] = pk_bf16(S[2 * u + 1][dvt][2], S[2 * u + 1][dvt][3]);
                sf[dvt] = __builtin_bit_cast(bf16x8, w);
            }
#pragma unroll
            for (int tt = 0; tt < 4; ++tt) {
                const uint2 lo = *(const uint2*)(sQT + tt * 4096 + p256[u][0]);
                const uint2 hi = *(const uint2*)(sQT + tt * 4096 + p256[u][1]);
                u32x4 w;
                w[0] = lo.x; w[1] = lo.y; w[2] = hi.x; w[3] = hi.y;
                const bf16x8 qf2 = __builtin_bit_cast(bf16x8, w);
#pragma unroll
                for (int dvt = 0; dvt < 2; ++dvt) o[dvt][tt] = __builtin_amdgcn_mfma_f32_16x16x32_bf16(sf[dvt], qf2, o[dvt][tt], 0, 0, 0);
            }
        }
        u32x4 op[4];
#pragma unroll
        for (int tt = 0; tt < 4; ++tt) {
            float ss = 0.f;
#pragma unroll
            for (int dvt = 0; dvt < 2; ++dvt)
#pragma unroll
                for (int i = 0; i < 4; ++i) ss += o[dvt][tt][i] * o[dvt][tt][i];
            ss = xsum4(ss);
            if (fq == 0) SS[wid * 64 + tt * 16 + fr] = ss;
            op[tt][0] = pk_bf16(o[0][tt][0], o[0][tt][1]);
            op[tt][1] = pk_bf16(o[0][tt][2], o[0][tt][3]);
            op[tt][2] = pk_bf16(o[1][tt][0], o[1][tt][1]);
            op[tt][3] = pk_bf16(o[1][tt][2], o[1][tt][3]);
        }
        __syncthreads();
        if (c + 1 < 32) { hg_storeA(nx, lds, tid); hg_loadB(nx, KHT, VIT, s0 + 64, tid); }
        uint2 gg[4][2];
#pragma unroll
        for (int tt = 0; tt < 4; ++tt)
#pragma unroll
            for (int dvt = 0; dvt < 2; ++dvt)
                gg[tt][dvt] = *(const uint2*)(HB + ((size_t)b * S_ + s0 + tt * 16 + fr) * INC + C_HG + hh * 128 + dv0 + dvt * 16 + fq * 4);
        {
            bf16x8 vf3[2][2];
#pragma unroll
            for (int dvt = 0; dvt < 2; ++dvt)
#pragma unroll
                for (int ks = 0; ks < 2; ++ks) vf3[dvt][ks] = *(const bf16x8*)(sVI + wid * 4096 + dvt * 2048 + b128[ks]);
#pragma unroll
            for (int dkt = 0; dkt < 8; ++dkt) {
                const float4 eb = *(const float4*)(EB + c * 128 + dkt * 16 + fq * 4);
                bf16x8 kf[2];
#pragma unroll
                for (int ks = 0; ks < 2; ++ks) kf[ks] = *(const bf16x8*)(sKH + dkt * 2048 + b128[ks]);
#pragma unroll
                for (int dvt = 0; dvt < 2; ++dvt) {
                    f32x4 a = S[dkt][dvt];
                    a[0] *= eb.x; a[1] *= eb.y; a[2] *= eb.z; a[3] *= eb.w;
                    a = __builtin_amdgcn_mfma_f32_16x16x32_bf16(kf[0], vf3[dvt][0], a, 0, 0, 0);
                    a = __builtin_amdgcn_mfma_f32_16x16x32_bf16(kf[1], vf3[dvt][1], a, 0, 0, 0);
                    S[dkt][dvt] = a;
                }
            }
        }
        __syncthreads();
        if (c + 1 < 32) hg_storeB(nx, lds, tid);
#pragma unroll
        for (int tt = 0; tt < 4; ++tt) {
            const int t = tt * 16 + fr;
            const float tot = SS[t] + SS[64 + t] + SS[128 + t] + SS[192 + t];
            const float rs = rsqrtf(tot * (1.f / 128.f) + LN_EPS);
            const size_t tg = (size_t)b * S_ + s0 + t;
#pragma unroll
            for (int dvt = 0; dvt < 2; ++dvt) {
                const int dv = dv0 + dvt * 16 + fq * 4;
                const float g0 = bflo(gg[tt][dvt].x), g1 = bfhi(gg[tt][dvt].x), g2 = bflo(gg[tt][dvt].y), g3 = bfhi(gg[tt][dvt].y);
                const float4 nwv = *(const float4*)(p.hg_norm_w + hh * 128 + dv);
                const unsigned w0 = op[tt][2 * dvt], w1 = op[tt][2 * dvt + 1];
                const float r0 = bflo(w0) * rs * nwv.x * (g0 * fsigmoid(g0));
                const float r1 = bfhi(w0) * rs * nwv.y * (g1 * fsigmoid(g1));
                const float r2 = bflo(w1) * rs * nwv.z * (g2 * fsigmoid(g2));
                const float r3 = bfhi(w1) * rs * nwv.w * (g3 * fsigmoid(g3));
                uint2 u2;
                u2.x = pk_bf16(r0, r1);
                u2.y = pk_bf16(r2, r3);
                *(uint2*)(OM + tg * 1024 + 512 + hh * 128 + dv) = u2;
            }
        }
        __syncthreads();
    }
}


DEV void hgrn_prep_item2(const P& p, int item, unsigned char* lds) {
    const int c = item & 31, bh = item >> 5, hh = bh & 3, b = bh >> 2;
    int tid = threadIdx.x;
    asm volatile("" : "+v"(tid));
    const int d = tid & 127, th = tid >> 7;
    const int lane = tid & 63, wid = tid >> 6, fr = lane & 15, fq = lane >> 4;
    const bf16_t* HB = (const bf16_t*)(p.ws + WS_HB);
    unsigned char* hs = (unsigned char*)p.out;
    bf16_t* QTg = (bf16_t*)(hs + HS_QT);
    bf16_t* OIg = (bf16_t*)(hs + HS_OI);
    uint2* DSg = (uint2*)(hs + HS_DS);
    float* tots = (float*)(lds + 65536);
    unsigned char* sKT = lds;
    unsigned char* sQT = lds + 16384;
    unsigned char* sKH = lds + 32768;
    unsigned char* sVI = lds + 49152;
    float lbv;
    {
        const float l0 = p.lb_logits[hh * 128 + d], l1 = p.lb_logits[512 + hh * 128 + d];
        const float mx = fmaxf(l0, l1);
        const float e0 = expf(l0 - mx), e1 = expf(l1 - mx);
        lbv = e0 / (e0 + e1);
    }
    const size_t trow0 = (size_t)b * S_ + c * 64 + th * 32;
    float bl[32];
    float run = 0.f;
#pragma unroll
    for (int i = 0; i < 32; ++i) {
        const float fl = bf2f(HB[(trow0 + i) * INC + C_HF + hh * 128 + d]);
        const float f = lbv + (1.f - lbv) * fsigmoid(fl);
        run += __logf(f);
        bl[i] = run;
    }
    tots[th * 128 + d] = run;
    __syncthreads();
    const float off = th ? tots[d] : 0.f;
    const float blast = tots[d] + tots[128 + d];
#pragma unroll
    for (int j = 0; j < 4; ++j) {
        u32x4 a, bq;
#pragma unroll
        for (int i2 = 0; i2 < 4; ++i2) {
            float khv[2], vv[2];
#pragma unroll
            for (int u = 0; u < 2; ++u) {
                const int i = j * 8 + i2 * 2 + u;
                const float bb = bl[i] + off;
                const float kki = 1.f - __expf(bl[i] - (i ? bl[i > 0 ? i - 1 : 0] : 0.f));
                const size_t tr = trow0 + i;
                const float q = bf2f(HB[tr * INC + C_HQ + hh * 128 + d]);
                vv[u] = bf2f(HB[tr * INC + C_HI + hh * 128 + d]);
                const bf16_t qv = f2bf(q * __expf(bb));
                const bf16_t kt = f2bf(kki * __expf(fminf(-bb, 80.f)));
                khv[u] = kki * __expf(blast - bb);
                const int t = th * 32 + i;
                QTg[((size_t)bh * 2048 + c * 64 + t) * 128 + d] = qv;
                const int off256 = t * 256 + ((((d >> 3) ^ (t & 15))) << 4) + (d & 7) * 2;
                *(bf16_t*)(sQT + off256) = qv;
                *(bf16_t*)(sKT + off256) = kt;
            }
            a[i2] = pk_bf16(khv[0], khv[1]);
            bq[i2] = pk_bf16(vv[0], vv[1]);
        }
        const int off128 = d * 128 + (((th * 4 + j) ^ ((d >> 1) & 7)) << 4);
        *(u32x4*)(sKH + off128) = a;
        *(u32x4*)(sVI + off128) = bq;
    }
    if (th == 0) ((float*)(p.ws + WS_EB))[((size_t)bh * 32 + c) * 128 + d] = __expf(blast);
    __syncthreads();
    const int sw8 = (fr >> 1) & 7;
    int b256[4];
#pragma unroll
    for (int ks = 0; ks < 4; ++ks) b256[ks] = fr * 256 + (((4 * ks + fq) ^ fr) << 4);
    int b128[2];
#pragma unroll
    for (int ks = 0; ks < 2; ++ks) b128[ks] = fr * 128 + (((4 * ks + fq) ^ sw8) << 4);
    uint2 atp[4];
    {
        bf16x8 qf[4];
#pragma unroll
        for (int ks = 0; ks < 4; ++ks) qf[ks] = *(const bf16x8*)(sQT + wid * 4096 + b256[ks]);
#pragma unroll
        for (int st = 0; st < 4; ++st) {
            f32x4 a = (f32x4){0.f, 0.f, 0.f, 0.f};
#pragma unroll
            for (int ks = 0; ks < 4; ++ks) {
                const bf16x8 kf = *(const bf16x8*)(sKT + st * 4096 + b256[ks]);
                a = __builtin_amdgcn_mfma_f32_16x16x32_bf16(kf, qf[ks], a, 0, 0, 0);
            }
            const int t = wid * 16 + fr;
            float av[4];
#pragma unroll
            for (int i = 0; i < 4; ++i) av[i] = (st * 16 + fq * 4 + i <= t) ? a[i] : 0.f;
            atp[st].x = pk_bf16(av[0], av[1]);
            atp[st].y = pk_bf16(av[2], av[3]);
        }
    }
    __syncthreads();
    bf16_t* AT = (bf16_t*)lds;
#pragma unroll
    for (int st = 0; st < 4; ++st) *(uint2*)(AT + (wid * 16 + fr) * 72 + st * 16 + fq * 4) = atp[st];
    __syncthreads();
    const int dv0 = wid * 32;
    bf16x8 vf[2][2];
#pragma unroll
    for (int dvt = 0; dvt < 2; ++dvt)
#pragma unroll
        for (int ks = 0; ks < 2; ++ks) vf[dvt][ks] = *(const bf16x8*)(sVI + wid * 4096 + dvt * 2048 + b128[ks]);
#pragma unroll
    for (int tt = 0; tt < 4; ++tt) {
        f32x4 o0 = (f32x4){0.f, 0.f, 0.f, 0.f}, o1 = (f32x4){0.f, 0.f, 0.f, 0.f};
#pragma unroll
        for (int ks = 0; ks < 2; ++ks) {
            const bf16x8 af = *(const bf16x8*)(AT + (tt * 16 + fr) * 72 + ks * 32 + fq * 8);
            o0 = __builtin_amdgcn_mfma_f32_16x16x32_bf16(vf[0][ks], af, o0, 0, 0, 0);
            o1 = __builtin_amdgcn_mfma_f32_16x16x32_bf16(vf[1][ks], af, o1, 0, 0, 0);
        }
        bf16_t* op = OIg + ((size_t)bh * 2048 + c * 64 + tt * 16 + fr) * 128 + dv0 + fq * 4;
        *(uint2*)op = make_uint2(pk_bf16(o0[0], o0[1]), pk_bf16(o0[2], o0[3]));
        *(uint2*)(op + 16) = make_uint2(pk_bf16(o1[0], o1[1]), pk_bf16(o1[2], o1[3]));
    }
    uint2* dsp = DSg + ((((size_t)bh * 32 + c) * 4 + wid) * 16) * 64 + lane;
#pragma unroll
    for (int dkt = 0; dkt < 8; ++dkt) {
        bf16x8 kf[2];
#pragma unroll
        for (int ks = 0; ks < 2; ++ks) kf[ks] = *(const bf16x8*)(sKH + dkt * 2048 + b128[ks]);
#pragma unroll
        for (int dvt = 0; dvt < 2; ++dvt) {
            f32x4 a = (f32x4){0.f, 0.f, 0.f, 0.f};
            a = __builtin_amdgcn_mfma_f32_16x16x32_bf16(kf[0], vf[dvt][0], a, 0, 0, 0);
            a = __builtin_amdgcn_mfma_f32_16x16x32_bf16(kf[1], vf[dvt][1], a, 0, 0, 0);
            dsp[(dkt * 2 + dvt) * 64] = make_uint2(pk_bf16(a[0], a[1]), pk_bf16(a[2], a[3]));
        }
    }
    __syncthreads();
}

DEV void hgrn_chain_item2(const P& p, int bh, unsigned char* lds) {
    const int hh = bh & 3, b = bh >> 2;
    int tid = threadIdx.x;
    asm volatile("" : "+v"(tid));
    const int lane = tid & 63, wid = __builtin_amdgcn_readfirstlane(tid >> 6), fr = lane & 15, fq = lane >> 4;
    const unsigned char* hs = (const unsigned char*)p.out;
    const bf16_t* QTg = (const bf16_t*)(hs + HS_QT) + (size_t)bh * 2048 * 128;
    const char* OIb = (const char*)(hs + HS_OI) + ((size_t)bh * 2048 * 128 + wid * 32) * 2;
    const unsigned oioff = (unsigned)((fr * 128 + fq * 4) * 2);
    const char* DSb = (const char*)(hs + HS_DS) + (((size_t)bh * 32 * 4 + wid) * 16 * 64) * 8;
    const unsigned dsoff = (unsigned)(lane * 8);
    const char* GGb = (const char*)((const bf16_t*)(p.ws + WS_HB) + ((size_t)b * S_) * INC + C_HG + hh * 128 + wid * 32);
    const unsigned ggoff = (unsigned)((fr * INC + fq * 4) * 2);
    const float* EB = (const float*)(p.ws + WS_EB) + (size_t)bh * 32 * 128;
    const bf16_t* HB = (const bf16_t*)(p.ws + WS_HB);
    bf16_t* OM = (bf16_t*)(p.ws + WS_OM);
    float* EBL = (float*)(lds + 16384);
    float* SS = (float*)(lds + 16896);
    const int dv0 = wid * 32;
    int p256[4][2];
#pragma unroll
    for (int u = 0; u < 4; ++u)
#pragma unroll
        for (int h = 0; h < 2; ++h) p256[u][h] = fr * 256 + (((4 * u + 2 * h + (fq >> 1)) ^ fr) << 4) + 8 * (fq & 1);
    const int c16 = tid & 15, r16 = tid >> 4;
    const int o16 = r16 * 256 + ((c16 ^ (r16 & 15)) << 4);
    const unsigned qoff = (unsigned)((r16 * 128 + c16 * 8) * 2);
    f32x4 S[2][2];
    f32x4* SL = (f32x4*)(lds + 17920) + wid * 768 + lane;
#pragma unroll
    for (int i = 0; i < 2; ++i)
#pragma unroll
        for (int j = 0; j < 2; ++j) S[i][j] = (f32x4){0.f, 0.f, 0.f, 0.f};
#pragma unroll
    for (int i = 0; i < 12; ++i) SL[i * 64] = (f32x4){0.f, 0.f, 0.f, 0.f};
    uint2 oi[4][2], dsr[8][2];
    {
        const char* qb = (const char*)QTg;
#pragma unroll
        for (int i = 0; i < 4; ++i) *(u32x4*)(lds + o16 + i * 4096) = *(const u32x4*)(qb + i * 4096 + qoff);
        if (tid < 32) *(u32x4*)(EBL + tid * 4) = *(const u32x4*)(EB + tid * 4);
#pragma unroll
        for (int tt = 0; tt < 4; ++tt)
#pragma unroll
            for (int dvt = 0; dvt < 2; ++dvt) {
                oi[tt][dvt] = *(const uint2*)(OIb + tt * 4096 + dvt * 32 + oioff);
            }
#pragma unroll
        for (int dkt = 0; dkt < 8; ++dkt)
#pragma unroll
            for (int dvt = 0; dvt < 2; ++dvt) dsr[dkt][dvt] = *(const uint2*)(DSb + (dkt * 2 + dvt) * 512 + dsoff);
    }
    __syncthreads();
#pragma unroll 1
    for (int c = 0; c < 32; ++c) {
        const int s0 = c * 64;
        const bool more = c + 1 < 32;
        f32x4 o[2][4];
#pragma unroll
        for (int tt = 0; tt < 4; ++tt)
#pragma unroll
            for (int dvt = 0; dvt < 2; ++dvt) {
                o[dvt][tt] = (f32x4){bflo(oi[tt][dvt].x), bfhi(oi[tt][dvt].x), bflo(oi[tt][dvt].y), bfhi(oi[tt][dvt].y)};
                if (more) oi[tt][dvt] = *(const uint2*)(OIb + (size_t)(s0 + 64) * 256 + tt * 4096 + dvt * 32 + oioff);
            }
        const unsigned char* sQ = lds;
#pragma unroll
        for (int u = 0; u < 4; ++u) {
            bf16x8 sf[2];
#pragma unroll
            for (int dvt = 0; dvt < 2; ++dvt) {
                const f32x4 sa = u < 1 ? S[0][dvt] : SL[((2 * u - 2) * 2 + dvt) * 64];
                const f32x4 sb = u < 1 ? S[1][dvt] : SL[((2 * u - 1) * 2 + dvt) * 64];
                u32x4 w;
                w[0] = pk_bf16(sa[0], sa[1]);
                w[1] = pk_bf16(sa[2], sa[3]);
                w[2] = pk_bf16(sb[0], sb[1]);
                w[3] = pk_bf16(sb[2], sb[3]);
                sf[dvt] = __builtin_bit_cast(bf16x8, w);
            }
#pragma unroll
            for (int tt = 0; tt < 4; ++tt) {
                const uint2 lo = *(const uint2*)(sQ + tt * 4096 + p256[u][0]);
                const uint2 hi = *(const uint2*)(sQ + tt * 4096 + p256[u][1]);
                u32x4 w;
                w[0] = lo.x; w[1] = lo.y; w[2] = hi.x; w[3] = hi.y;
                const bf16x8 qf2 = __builtin_bit_cast(bf16x8, w);
#pragma unroll
                for (int dvt = 0; dvt < 2; ++dvt) o[dvt][tt] = __builtin_amdgcn_mfma_f32_16x16x32_bf16(sf[dvt], qf2, o[dvt][tt], 0, 0, 0);
            }
        }
        u32x4 qn[4], ebn;
        if (more) {
            const char* qb = (const char*)(QTg + (size_t)(s0 + 64) * 128);
#pragma unroll
            for (int i = 0; i < 4; ++i) qn[i] = *(const u32x4*)(qb + i * 4096 + qoff);
            if (tid < 32) ebn = *(const u32x4*)(EB + (c + 1) * 128 + tid * 4);
        }
        uint2 gg[4][2];
#pragma unroll
        for (int tt = 0; tt < 4; ++tt)
#pragma unroll
            for (int dvt = 0; dvt < 2; ++dvt) gg[tt][dvt] = *(const uint2*)(GGb + (size_t)(s0 + tt * 16) * INC * 2 + dvt * 32 + ggoff);
#pragma unroll
        for (int dkt = 0; dkt < 8; ++dkt) {
            const float4 eb = *(const float4*)(EBL + dkt * 16 + fq * 4);
#pragma unroll
            for (int dvt = 0; dvt < 2; ++dvt) {
                const uint2 dd = dsr[dkt][dvt];
                f32x4 sv = dkt < 2 ? S[dkt < 2 ? dkt : 0][dvt] : SL[((dkt - 2) * 2 + dvt) * 64];
                sv[0] = fmaf(sv[0], eb.x, bflo(dd.x));
                sv[1] = fmaf(sv[1], eb.y, bfhi(dd.x));
                sv[2] = fmaf(sv[2], eb.z, bflo(dd.y));
                sv[3] = fmaf(sv[3], eb.w, bfhi(dd.y));
                if (dkt < 2) S[dkt < 2 ? dkt : 0][dvt] = sv; else SL[((dkt - 2) * 2 + dvt) * 64] = sv;
                if (more) dsr[dkt][dvt] = *(const uint2*)(DSb + (size_t)(c + 1) * 32768 + (dkt * 2 + dvt) * 512 + dsoff);
            }
        }
#pragma unroll
        for (int tt = 0; tt < 4; ++tt) {
            float ss = 0.f;
#pragma unroll
            for (int dvt = 0; dvt < 2; ++dvt)
#pragma unroll
                for (int i = 0; i < 4; ++i) ss += o[dvt][tt][i] * o[dvt][tt][i];
            ss = xsum4(ss);
            if (fq == 0) SS[wid * 64 + tt * 16 + fr] = ss;
        }
        __syncthreads();
#pragma unroll
        for (int tt = 0; tt < 4; ++tt) {
            const int t = tt * 16 + fr;
            const float tot = SS[t] + SS[64 + t] + SS[128 + t] + SS[192 + t];
            const float rs = rsqrtf(tot * (1.f / 128.f) + LN_EPS);
            const size_t tg = (size_t)b * S_ + s0 + t;
#pragma unroll
            for (int dvt = 0; dvt < 2; ++dvt) {
                const int dv = dv0 + dvt * 16 + fq * 4;
                const float g0 = bflo(gg[tt][dvt].x), g1 = bfhi(gg[tt][dvt].x), g2 = bflo(gg[tt][dvt].y), g3 = bfhi(gg[tt][dvt].y);
                const float4 nwv = *(const float4*)(p.hg_norm_w + hh * 128 + dv);
                const float r0 = o[dvt][tt][0] * rs * nwv.x * (g0 * fsigmoid(g0));
                const float r1 = o[dvt][tt][1] * rs * nwv.y * (g1 * fsigmoid(g1));
                const float r2 = o[dvt][tt][2] * rs * nwv.z * (g2 * fsigmoid(g2));
                const float r3 = o[dvt][tt][3] * rs * nwv.w * (g3 * fsigmoid(g3));
                *(uint2*)(OM + tg * 1024 + 512 + hh * 128 + dv) = make_uint2(pk_bf16(r0, r1), pk_bf16(r2, r3));
            }
        }
        if (more) {
#pragma unroll
            for (int i = 0; i < 4; ++i) *(u32x4*)(lds + o16 + i * 4096) = qn[i];
            if (tid < 32) *(u32x4*)(EBL + tid * 4) = ebn;
        }
        __syncthreads();
    }
}

DEV void xattn_item2(const P& p, int item) {
    const int qt64 = item & 31, hh = (item >> 5) & 3, b = item >> 7;
    const int lane = threadIdx.x & 63, wid = threadIdx.x >> 6, fr = lane & 15, fq = lane >> 4;
    const bf16_t* QX = (const bf16_t*)(p.ws + WS_QX);
    const bf16_t* KVM = (const bf16_t*)(p.ws + WS_KVM);
    const bf16_t* VMT = (const bf16_t*)(p.ws + WS_VMT) + (size_t)(b * 4 + hh) * 256 * 256;
    bf16_t* OX = (bf16_t*)(p.ws + WS_OX);
    const size_t tq = (size_t)b * S_ + qt64 * 64 + wid * 16 + fr;
    bf16x8 qf[8];
#pragma unroll
    for (int ks = 0; ks < 8; ++ks) qf[ks] = *(const bf16x8*)(QX + tq * 1024 + hh * 256 + ks * 32 + fq * 8);
    f32x4 sc[16];
#pragma unroll
    for (int kt = 0; kt < 16; ++kt) {
        f32x4 a = (f32x4){0.f, 0.f, 0.f, 0.f};
        const bf16_t* kp = KVM + (size_t)(b * ML_ + kt * 16 + fr) * 2048 + hh * 256 + fq * 8;
#pragma unroll
        for (int ks = 0; ks < 8; ++ks) a = __builtin_amdgcn_mfma_f32_16x16x32_bf16(*(const bf16x8*)(kp + ks * 32), qf[ks], a, 0, 0, 0);
        sc[kt] = a;
    }
    float mx = -1e30f;
#pragma unroll
    for (int kt = 0; kt < 16; ++kt)
#pragma unroll
        for (int i = 0; i < 4; ++i) { sc[kt][i] *= 0.0625f; mx = fmaxf(mx, sc[kt][i]); }
    mx = xmax4(mx);
    float ps = 0.f;
#pragma unroll
    for (int kt = 0; kt < 16; ++kt)
#pragma unroll
        for (int i = 0; i < 4; ++i) { sc[kt][i] = __expf(sc[kt][i] - mx); ps += sc[kt][i]; }
    ps = xsum4(ps);
    const float inv = 1.f / ps;
    u32x4 pf[8];
#pragma unroll
    for (int s = 0; s < 8; ++s) {
        pf[s][0] = pk_bf16(sc[2 * s][0] * inv, sc[2 * s][1] * inv);
        pf[s][1] = pk_bf16(sc[2 * s][2] * inv, sc[2 * s][3] * inv);
        pf[s][2] = pk_bf16(sc[2 * s + 1][0] * inv, sc[2 * s + 1][1] * inv);
        pf[s][3] = pk_bf16(sc[2 * s + 1][2] * inv, sc[2 * s + 1][3] * inv);
    }
#pragma unroll 1
    for (int dh = 0; dh < 2; ++dh) {
        f32x4 o[8];
#pragma unroll
        for (int dt = 0; dt < 8; ++dt) o[dt] = (f32x4){0.f, 0.f, 0.f, 0.f};
#pragma unroll
        for (int s = 0; s < 8; ++s) {
#pragma unroll
            for (int dt = 0; dt < 8; ++dt) {
                const bf16_t* vp = VMT + (size_t)(dh * 128 + dt * 16 + fr) * 256 + 32 * s + 4 * fq;
                o[dt] = __builtin_amdgcn_mfma_f32_16x16x32_bf16(ld2x8(vp, vp + 16), __builtin_bit_cast(bf16x8, pf[s]), o[dt], 0, 0, 0);
            }
        }
#pragma unroll
        for (int dt = 0; dt < 8; ++dt) {
            uint2 u2;
            u2.x = pk_bf16(o[dt][0], o[dt][1]);
            u2.y = pk_bf16(o[dt][2], o[dt][3]);
            *(uint2*)(OX + tq * 1024 + hh * 256 + dh * 128 + dt * 16 + fq * 4) = u2;
        }
    }
}


struct XaRegs { u32x4 r[8]; };
DEV void xa_loadK(XaRegs& x, const bf16_t* kbase, int tid) {
    const int c = tid & 31, r0 = tid >> 5;
#pragma unroll
    for (int i = 0; i < 8; ++i) x.r[i] = *(const u32x4*)(kbase + (size_t)(r0 + 8 * i) * 2048 + c * 8);
}
DEV void xa_storeK(const XaRegs& x, unsigned char* lds, int tid) {
    const int c = tid & 31, r0 = tid >> 5;
#pragma unroll
    for (int i = 0; i < 8; ++i) {
        const int row = r0 + 8 * i;
        *(u32x4*)(lds + row * 512 + ((c ^ (row & 15)) << 4)) = x.r[i];
    }
}
DEV void xa_loadV(XaRegs& x, const bf16_t* vbase, int tid) {
    const int c = tid & 7, r0 = tid >> 3;
#pragma unroll
    for (int i = 0; i < 8; ++i) x.r[i] = *(const u32x4*)(vbase + (size_t)(r0 + 32 * i) * 256 + c * 8);
}
DEV void xa_storeV(const XaRegs& x, unsigned char* lds, int tid) {
    const int c = tid & 7, r0 = tid >> 3;
    const int o = r0 * 128 + ((c ^ ((r0 >> 1) & 7)) << 4);
#pragma unroll
    for (int i = 0; i < 8; ++i) *(u32x4*)(lds + 32768 + o + i * 4096) = x.r[i];
}
DEV void xattn_item3(const P& p, int item, unsigned char* lds) {
    const int qt64 = item & 31, hh = (item >> 5) & 3, b = item >> 7;
    int tid = threadIdx.x;
    asm volatile("" : "+v"(tid));
    const int lane = tid & 63, wid = tid >> 6, fr = lane & 15, fq = lane >> 4;
    const bf16_t* QX = (const bf16_t*)(p.ws + WS_QX);
    const bf16_t* KB = (const bf16_t*)(p.ws + WS_KVM) + (size_t)(b * ML_) * 2048 + hh * 256;
    const bf16_t* VB = (const bf16_t*)(p.ws + WS_VMT) + (size_t)(b * 4 + hh) * 256 * 256;
    bf16_t* OX = (bf16_t*)(p.ws + WS_OX);
    const size_t tq = (size_t)b * S_ + qt64 * 64 + wid * 16 + fr;
    bf16x8 qf[8];
#pragma unroll
    for (int ks = 0; ks < 8; ++ks) qf[ks] = *(const bf16x8*)(QX + tq * 1024 + hh * 256 + ks * 32 + fq * 8);
    f32x4 o[16];
#pragma unroll
    for (int dt = 0; dt < 16; ++dt) o[dt] = (f32x4){0.f, 0.f, 0.f, 0.f};
    float m = -1e30f, l = 0.f;
    {
        XaRegs x;
        xa_loadK(x, KB, tid);
        xa_storeK(x, lds, tid);
        xa_loadV(x, VB, tid);
        xa_storeV(x, lds, tid);
    }
    __syncthreads();
    const int sw8 = (fr >> 1) & 7;
#pragma unroll 1
    for (int j = 0; j < 4; ++j) {
        XaRegs nx;
        if (j + 1 < 4) xa_loadK(nx, KB + (size_t)(j + 1) * 64 * 2048, tid);
        f32x4 sc[4];
#pragma unroll
        for (int kt = 0; kt < 4; ++kt) {
            f32x4 a = (f32x4){0.f, 0.f, 0.f, 0.f};
            const unsigned char* rp = lds + (kt * 16 + fr) * 512;
#pragma unroll
            for (int ks = 0; ks < 8; ++ks) a = __builtin_amdgcn_mfma_f32_16x16x32_bf16(*(const bf16x8*)(rp + (((4 * ks + fq) ^ fr) << 4)), qf[ks], a, 0, 0, 0);
            sc[kt] = a;
        }
        __syncthreads();
        if (j + 1 < 4) { xa_storeK(nx, lds, tid); xa_loadV(nx, VB + (j + 1) * 64, tid); }
        float bm = -1e30f;
#pragma unroll
        for (int kt = 0; kt < 4; ++kt)
#pragma unroll
            for (int i = 0; i < 4; ++i) { sc[kt][i] *= 0.0625f; bm = fmaxf(bm, sc[kt][i]); }
        bm = xmax4(bm);
        const float mn = fmaxf(m, bm);
        const float alpha = __expf(m - mn);
        float ps = 0.f;
#pragma unroll
        for (int kt = 0; kt < 4; ++kt)
#pragma unroll
            for (int i = 0; i < 4; ++i) { sc[kt][i] = __expf(sc[kt][i] - mn); ps += sc[kt][i]; }
        l = l * alpha + ps;
        m = mn;
#pragma unroll
        for (int dt = 0; dt < 16; ++dt) o[dt] *= alpha;
#pragma unroll
        for (int s = 0; s < 2; ++s) {
            u32x4 w;
            w[0] = pk_bf16(sc[2 * s][0], sc[2 * s][1]);
            w[1] = pk_bf16(sc[2 * s][2], sc[2 * s][3]);
            w[2] = pk_bf16(sc[2 * s + 1][0], sc[2 * s + 1][1]);
            w[3] = pk_bf16(sc[2 * s + 1][2], sc[2 * s + 1][3]);
            const bf16x8 pf = __builtin_bit_cast(bf16x8, w);
#pragma unroll
            for (int dt = 0; dt < 16; ++dt) {
                const unsigned char* rp = lds + 32768 + (dt * 16 + fr) * 128 + 8 * (fq & 1);
                const uint2 lo = *(const uint2*)(rp + (((4 * s + (fq >> 1)) ^ sw8) << 4));
                const uint2 hi = *(const uint2*)(rp + (((4 * s + 2 + (fq >> 1)) ^ sw8) << 4));
                u32x4 vv;
                vv[0] = lo.x; vv[1] = lo.y; vv[2] = hi.x; vv[3] = hi.y;
                o[dt] = __builtin_amdgcn_mfma_f32_16x16x32_bf16(__builtin_bit_cast(bf16x8, vv), pf, o[dt], 0, 0, 0);
            }
        }
        __syncthreads();
        if (j + 1 < 4) xa_storeV(nx, lds, tid);
        __syncthreads();
    }
    const float inv = 1.f / xsum4(l);
#pragma unroll
    for (int dt = 0; dt < 16; ++dt) {
        uint2 u2;
        u2.x = pk_bf16(o[dt][0] * inv, o[dt][1] * inv);
        u2.y = pk_bf16(o[dt][2] * inv, o[dt][3] * inv);
        *(uint2*)(OX + tq * 1024 + hh * 256 + dt * 16 + fq * 4) = u2;
    }
}


DEV void peer_quant_row(const float* src, unsigned char* dst, float* scl, int row, int* rsum = nullptr) {
    const int lane = threadIdx.x & 63;
    const float* r = src + (size_t)row * 1024 + lane * 16;
    float v[16];
#pragma unroll
    for (int i = 0; i < 4; ++i) {
        const float4 a = *(const float4*)(r + 4 * i);
        v[4 * i] = a.x; v[4 * i + 1] = a.y; v[4 * i + 2] = a.z; v[4 * i + 3] = a.w;
    }
    float mx = 0.f;
#pragma unroll
    for (int i = 0; i < 16; ++i) mx = fmaxf(mx, fabsf(v[i]));
    mx = wmax(mx);
    const float q = mx > 0.f ? 127.f / mx : 0.f;
    u32x4 w;
    int usum = 0;
#pragma unroll
    for (int i = 0; i < 4; ++i) {
        unsigned pk = 0u;
#pragma unroll
        for (int k = 0; k < 4; ++k) {
            int qi = (int)rintf(v[4 * i + k] * q);
            qi = qi < -127 ? -127 : (qi > 127 ? 127 : qi);
            pk |= (unsigned)(qi + 128) << (8 * k);
            usum += qi + 128;
        }
        w[i] = pk;
    }
    *(u32x4*)(dst + ((size_t)(lane >> 3) * 16384 + row) * 128 + (lane & 7) * 16) = w;
    if (rsum) {
#pragma unroll
        for (int o = 32; o > 0; o >>= 1) usum += __shfl_xor(usum, o);
        if (lane == 0) rsum[row] = usum;
    }
    if (lane == 0) scl[row] = mx * (1.f / 127.f);
}

DEV unsigned f2ord(float f) { const unsigned b = __float_as_uint(f); return b ^ ((b >> 31) ? 0xffffffffu : 0x80000000u); }
DEV float ord2f(unsigned o) { return __uint_as_float((o & 0x80000000u) ? (o ^ 0x80000000u) : ~o); }
DEV void ins16(unsigned (&v)[16], unsigned x) {
#pragma unroll
    for (int k = 0; k < 16; ++k) {
        const unsigned t = v[k] > x ? v[k] : x;
        x = v[k] > x ? x : v[k];
        v[k] = t;
    }
}
constexpr int PEER_SC = 0;
constexpr int PEER_LST = 0;
constexpr int PEER_EID = 16384;
constexpr int PEER_GATE = 16384 + 4096;
DEV void peer_route_item(const P& p, int item, unsigned char* lds) {
    const int tid = threadIdx.x, lane = tid & 63, wid = tid >> 6;
    const int t0 = item * 16;
    const bf16_t* QP = (const bf16_t*)(p.ws + WS_QP);
    const bf16_t* PK = (const bf16_t*)(p.ws + WS_PKEY);
    unsigned* SC = (unsigned*)(lds + PEER_SC);
    const int fr = lane & 15, fq = lane >> 4;
    unsigned lst[16];
#pragma unroll
    for (int k = 0; k < 16; ++k) lst[k] = 0u;
    bf16x8 qf[4][2];
#pragma unroll
    for (int ci = 0; ci < 4; ++ci)
#pragma unroll
        for (int ks = 0; ks < 2; ++ks)
            qf[ci][ks] = *(const bf16x8*)(QP + (size_t)(t0 + fr) * 1024 + (4 * wid + ci) * 64 + ks * 32 + fq * 8);
#pragma unroll 1
    for (int pass = 0; pass < 2; ++pass) {
#pragma unroll
        for (int ci = 0; ci < 4; ++ci) {
            const int cb = 4 * wid + ci;
#pragma unroll
            for (int kt = 0; kt < 4; ++kt) {
                f32x4 acc = (f32x4){0.f, 0.f, 0.f, 0.f};
#pragma unroll
                for (int ks = 0; ks < 2; ++ks) {
                    const bf16x8 kf = *(const bf16x8*)(PK + ((size_t)cb * 128 + pass * 64 + kt * 16 + fr) * 64 + ks * 32 + fq * 8);
                    acc = __builtin_amdgcn_mfma_f32_16x16x32_bf16(kf, qf[ci][ks], acc, 0, 0, 0);
                }
                unsigned* dst = SC + (cb * 16 + fr) * 65 + kt * 16 + fq * 4;
#pragma unroll
                for (int i = 0; i < 4; ++i) {
                    const int kidx = pass * 64 + kt * 16 + fq * 4 + i;
                    dst[i] = (f2ord(acc[i]) & ~127u) | (unsigned)(127 - kidx);
                }
            }
        }
        __syncthreads();
        {
            const unsigned* row = SC + tid * 65;
#pragma unroll 4
            for (int k = 0; k < 64; ++k) ins16(lst, row[k]);
        }
        __syncthreads();
    }
    unsigned* LST = (unsigned*)(lds + PEER_LST);
#pragma unroll
    for (int k = 0; k < 16; ++k) LST[tid * 16 + k] = lst[k];
    __syncthreads();
    unsigned short* EID = (unsigned short*)(lds + PEER_EID);
    float* GATE = (float*)(lds + PEER_GATE);
    if (((tid >> 4) & 1) == 0) {
        const int tok = tid & 15, hh = tid >> 5;
        const unsigned* l2 = LST + (tid + 16) * 16;
        float s1[16], s2[16];
#pragma unroll
        for (int k = 0; k < 16; ++k) { s1[k] = ord2f(lst[k] & ~127u); s2[k] = ord2f(l2[k] & ~127u); }
        unsigned fin[16];
#pragma unroll
        for (int k = 0; k < 16; ++k) fin[k] = 0u;
#pragma unroll
        for (int i = 0; i < 16; ++i)
#pragma unroll
            for (int j = 0; j < 16; ++j)
                if ((i + 1) * (j + 1) <= 16) ins16(fin, (f2ord(s1[i] + s2[j]) & ~255u) | (unsigned)(255 - (i * 16 + j)));
        const float mx = ord2f(fin[0] & ~255u);
        float w[16], ws = 0.f;
#pragma unroll
        for (int k = 0; k < 16; ++k) { w[k] = expf(ord2f(fin[k] & ~255u) - mx); ws += w[k]; }
        const float inv = 1.f / ws;
#pragma unroll
        for (int k = 0; k < 16; ++k) {
            const int flat = 255 - (int)(fin[k] & 255u);
            const int i1 = 127 - (int)(LST[tid * 16 + (flat >> 4)] & 127u);
            const int i2 = 127 - (int)(l2[flat & 15] & 127u);
            EID[tok * 128 + hh * 16 + k] = (unsigned short)(i1 * 128 + i2);
            GATE[tok * 128 + hh * 16 + k] = w[k] * inv;
        }
    }
    __syncthreads();
    {
        unsigned short* EIDP = (unsigned short*)(p.ws + WS_EIDP);
        float* GATEP = (float*)(p.ws + WS_GATEP);
        for (int i = tid; i < 16 * 128; i += 256) {
            const int tok = i >> 7, pi = i & 127, eg = pi >> 4, k = pi & 15, slot = 8 * k + eg;
            EIDP[(size_t)(t0 + tok) * 128 + pi] = EID[tok * 128 + slot];
            GATEP[(size_t)(t0 + tok) * 128 + pi] = GATE[tok * 128 + slot];
        }
        unsigned char* XQ = p.ws + WS_XQ;
#pragma unroll 1
        for (int tt = 0; tt < 4; ++tt) {
            const size_t t = (size_t)t0 + wid * 4 + tt;
            const float* row = p.out + t * 1024 + lane * 16;
            float xr[16];
            float amax = 0.f;
#pragma unroll
            for (int i = 0; i < 4; ++i) {
                const float4 a4 = *(const float4*)(row + 4 * i);
                xr[4 * i] = a4.x; xr[4 * i + 1] = a4.y; xr[4 * i + 2] = a4.z; xr[4 * i + 3] = a4.w;
                amax = fmaxf(amax, fmaxf(fmaxf(fabsf(a4.x), fabsf(a4.y)), fmaxf(fabsf(a4.z), fabsf(a4.w))));
            }
            amax = wmax(amax);
            const float qx = amax > 0.f ? 127.f / amax : 0.f;
            u32x4 w;
            int s_ = 0;
#pragma unroll
            for (int i = 0; i < 4; ++i) {
                unsigned pk = 0u;
#pragma unroll
                for (int k = 0; k < 4; ++k) {
                    int qi = (int)rintf(xr[4 * i + k] * qx);
                    qi = qi < -127 ? -127 : (qi > 127 ? 127 : qi);
                    pk |= (unsigned)(qi + 128) << (8 * k);
                    s_ += qi + 128;
                }
                w[i] = pk;
            }
#pragma unroll
            for (int o = 32; o > 0; o >>= 1) s_ += __shfl_xor(s_, o);
            *(u32x4*)(XQ + t * 1024 + lane * 16) = w;
            if (lane == 0) {
                ((float*)(p.ws + WS_SXF))[t] = amax * (1.f / 127.f);
                ((int*)(p.ws + WS_SXI))[t] = s_;
            }
        }
    }
    __syncthreads();
}

DEV void peer_down_item(const P& p, int s, int tile, int lane, int wid) {
    const unsigned char* PD = p.ws + WS_PD + (size_t)s * 16384 * 128;
    const unsigned short* EIDP = (const unsigned short*)(p.ws + WS_EIDP);
    int* DP = (int*)(p.ws + WS_DP) + (size_t)s * T_ * 128;
    const int eg = lane >> 3, cg = lane & 7;
#pragma unroll 1
    for (int tt = 0; tt < 4; ++tt) {
        const size_t t = (size_t)tile * 16 + wid * 4 + tt;
        const u32x4 xu = *(const u32x4*)(p.ws + WS_XQ + t * 1024 + s * 128 + cg * 16);
        const u32x4 e0 = *(const u32x4*)(EIDP + t * 128 + eg * 16);
        const u32x4 e1 = *(const u32x4*)(EIDP + t * 128 + eg * 16 + 8);
        u32x4 rows[16];
#pragma unroll
        for (int k = 0; k < 16; ++k) {
            const unsigned ew = k < 8 ? e0[k >> 1] : e1[(k - 8) >> 1];
            const unsigned e = (k & 1) ? (ew >> 16) : (ew & 0xffffu);
            rows[k] = *(const u32x4*)(PD + (size_t)e * 128 + cg * 16);
        }
        unsigned v[16];
#pragma unroll
        for (int k = 0; k < 16; ++k) {
            unsigned a_ = 0u;
#pragma unroll
            for (int q = 0; q < 4; ++q) a_ = __builtin_amdgcn_udot4(rows[k][q], xu[q], a_, false);
            v[k] = a_;
        }
        unsigned w8[8], w4[4], w2[2];
        {
            const bool hi = (cg & 4) != 0;
#pragma unroll
            for (int j = 0; j < 8; ++j) {
                const unsigned send = hi ? v[j] : v[j + 8];
                const unsigned keep = hi ? v[j + 8] : v[j];
                w8[j] = keep + (unsigned)__shfl_xor((int)send, 4);
            }
        }
        {
            const bool hi = (cg & 2) != 0;
#pragma unroll
            for (int j = 0; j < 4; ++j) {
                const unsigned send = hi ? w8[j] : w8[j + 4];
                const unsigned keep = hi ? w8[j + 4] : w8[j];
                w4[j] = keep + (unsigned)__shfl_xor((int)send, 2);
            }
        }
        {
            const bool hi = (cg & 1) != 0;
#pragma unroll
            for (int j = 0; j < 2; ++j) {
                const unsigned send = hi ? w4[j] : w4[j + 2];
                const unsigned keep = hi ? w4[j + 2] : w4[j];
                w2[j] = keep + (unsigned)__shfl_xor((int)send, 1);
            }
        }
        *(uint2*)(DP + t * 128 + eg * 16 + 2 * cg) = make_uint2(w2[0], w2[1]);
    }
}

DEV void peer_coef_item(const P& p, int t, int lane) {
    const int* DP = (const int*)(p.ws + WS_DP);
    const unsigned short* EIDP = (const unsigned short*)(p.ws + WS_EIDP);
    const float* GATEP = (const float*)(p.ws + WS_GATEP);
    const float sx = ((const float*)(p.ws + WS_SXF))[t];
    const int sxu = ((const int*)(p.ws + WS_SXI))[t];
    float cs = 0.f;
#pragma unroll
    for (int h = 0; h < 2; ++h) {
        const int pi = lane + 64 * h;
        int tot = 0;
#pragma unroll
        for (int s = 0; s < 8; ++s) tot += DP[((size_t)s * T_ + t) * 128 + pi];
        const int e = EIDP[(size_t)t * 128 + pi];
        const int dotq = tot - 128 * ((const int*)(p.ws + WS_PRS))[e] - 128 * sxu + 128 * 128 * 1024;
        const float hv = ((const float*)(p.ws + WS_PSD))[e] * sx * (float)dotq;
        const float coef = 0.5f * hv * (1.f + erff(hv * 0.7071067811865476f)) * GATEP[(size_t)t * 128 + pi] * ((const float*)(p.ws + WS_PSU))[e];
        ((float*)(p.ws + WS_COEFP))[(size_t)t * 128 + pi] = coef;
        cs += coef;
    }
    cs = wsum(cs);
    if (lane == 0) ((float*)(p.ws + WS_ASUM))[t] = cs;
}

DEV void peer_up_item(const P& p, int s, int tile, int lane, int wid, bool dostore = true) {
    const unsigned char* PU = p.ws + WS_PU + (size_t)s * 16384 * 128;
    const unsigned short* EIDP = (const unsigned short*)(p.ws + WS_EIDP);
    const float* COEFP = (const float*)(p.ws + WS_COEFP);
    const int eg = lane >> 3, cg = lane & 7;
#pragma unroll 1
    for (int tt = 0; tt < 4; ++tt) {
        const size_t t = (size_t)tile * 16 + wid * 4 + tt;
        const u32x4 e0 = *(const u32x4*)(EIDP + t * 128 + eg * 16);
        const u32x4 e1 = *(const u32x4*)(EIDP + t * 128 + eg * 16 + 8);
        float cf[16];
#pragma unroll
        for (int i = 0; i < 4; ++i) {
            const float4 c4 = *(const float4*)(COEFP + t * 128 + eg * 16 + 4 * i);
            cf[4 * i] = c4.x; cf[4 * i + 1] = c4.y; cf[4 * i + 2] = c4.z; cf[4 * i + 3] = c4.w;
        }
        u32x4 rows[16];
#pragma unroll
        for (int k = 0; k < 16; ++k) {
            const unsigned ew = k < 8 ? e0[k >> 1] : e1[(k - 8) >> 1];
            const unsigned e = (k & 1) ? (ew >> 16) : (ew & 0xffffu);
            rows[k] = *(const u32x4*)(PU + (size_t)e * 128 + cg * 16);
        }
        float acc[16];
#pragma unroll
        for (int i = 0; i < 16; ++i) acc[i] = 0.f;
#pragma unroll
        for (int k = 0; k < 16; ++k)
#pragma unroll
            for (int q = 0; q < 4; ++q) {
                const unsigned w_ = rows[k][q];
                acc[4 * q] += cf[k] * (float)(w_ & 0xffu);
                acc[4 * q + 1] += cf[k] * (float)((w_ >> 8) & 0xffu);
                acc[4 * q + 2] += cf[k] * (float)((w_ >> 16) & 0xffu);
                acc[4 * q + 3] += cf[k] * (float)(w_ >> 24);
            }
        float a8[8], a4[4], a2[2];
        {
            const bool hi = (eg & 4) != 0;
#pragma unroll
            for (int j = 0; j < 8; ++j) {
                const float send = hi ? acc[j] : acc[j + 8];
                const float keep = hi ? acc[j + 8] : acc[j];
                a8[j] = keep + __shfl_xor(send, 32);
            }
        }
        {
            const bool hi = (eg & 2) != 0;
#pragma unroll
            for (int j = 0; j < 4; ++j) {
                const float send = hi ? a8[j] : a8[j + 4];
                const float keep = hi ? a8[j + 4] : a8[j];
                a4[j] = keep + __shfl_xor(send, 16);
            }
        }
        {
            const bool hi = (eg & 1) != 0;
#pragma unroll
            for (int j = 0; j < 2; ++j) {
                const float send = hi ? a4[j] : a4[j + 2];
                const float keep = hi ? a4[j + 2] : a4[j];
                a2[j] = keep + __shfl_xor(send, 8);
            }
        }
        const float asum = ((const float*)(p.ws + WS_ASUM))[t];
        float* yp = p.out + t * 1024 + s * 128 + cg * 16 + 2 * eg;
        const float2 xv = *(const float2*)yp;
        if (dostore) *(float2*)yp = make_float2(ALPHA * xv.x + (a2[0] - 128.f * asum), ALPHA * xv.y + (a2[1] - 128.f * asum));
    }
}

DEV void ln3_item(const P& p, int t, int lane) {
    float* row = p.out + (size_t)t * 1024;
    float4 v[4];
    float s = 0.f;
#pragma unroll
    for (int i = 0; i < 4; ++i) {
        v[i] = *(const float4*)(row + (i * 64 + lane) * 4);
        s += v[i].x + v[i].y + v[i].z + v[i].w;
    }
    const float mean = wsum(s) * (1.f / 1024.f);
    float ss = 0.f;
#pragma unroll
    for (int i = 0; i < 4; ++i) {
        v[i].x -= mean; v[i].y -= mean; v[i].z -= mean; v[i].w -= mean;
        ss += v[i].x * v[i].x + v[i].y * v[i].y + v[i].z * v[i].z + v[i].w * v[i].w;
    }
    const float rs = rsqrtf(wsum(ss) * (1.f / 1024.f) + LN_EPS);
#pragma unroll
    for (int i = 0; i < 4; ++i) {
        const int c = (i * 64 + lane) * 4;
        const float4 gg = *(const float4*)(p.ln_g + 2 * 1024 + c);
        const float4 bb = *(const float4*)(p.ln_b + 2 * 1024 + c);
        float4 o;
        o.x = v[i].x * rs * gg.x + bb.x; o.y = v[i].y * rs * gg.y + bb.y; o.z = v[i].z * rs * gg.z + bb.z; o.w = v[i].w * rs * gg.w + bb.w;
        *(float4*)(row + c) = o;
    }
}

#define XB_TMO      128
#define XB_XCNT(j)  (256  + 64 * (j))
#define XB_XSUB(j)  (1280 + 64 * (j))
#define XB_XGEN(j)  (2304 + 64 * (j))
#define XB_TOP      3328
#define XB_TOPGEN   3392
#define XCD_BAR_WORDS 3456
#define XB_SPIN_CAP (1u << 20)
#define LAS __attribute__((address_space(3)))
DEV unsigned xb_ld(unsigned* p) { return __hip_atomic_load(p, __ATOMIC_RELAXED, __HIP_MEMORY_SCOPE_AGENT); }
DEV unsigned xb_add(unsigned* p, unsigned v) { return __hip_atomic_fetch_add(p, v, __ATOMIC_RELAXED, __HIP_MEMORY_SCOPE_AGENT); }
DEV unsigned xb_xcc_id() { return (unsigned)__builtin_amdgcn_s_getreg((3 << 11) | 20) & 0xFu; }
#define XB_SPIN(cond, bar) do { unsigned _sp = 0; while (cond) { __builtin_amdgcn_s_sleep(1); \
    if ((++_sp & 255u) == 0u) { if (xb_ld(&(bar)[XB_TMO])) break; if (_sp > XB_SPIN_CAP) { atomicAdd(&(bar)[XB_TMO], 1u); break; } } } } while (0)
struct XcdBarrier { unsigned* bar; unsigned x; volatile LAS unsigned* st; };
DEV XcdBarrier xcd_barrier_post(unsigned* bar, volatile LAS unsigned* st) {
    XcdBarrier b; b.bar = bar; b.x = xb_xcc_id(); b.st = st;
    if (threadIdx.x == 0) (void)xb_add(&bar[XB_XCNT(b.x)], 1u);
    return b;
}
DEV void xcd_barrier_complete(unsigned* bar, unsigned x, unsigned& nloc, unsigned& nx) {
    const unsigned G = gridDim.x * gridDim.y * gridDim.z;
    unsigned sum, cnt, mine, sp = 0u;
    for (;;) {
        sum = 0u; cnt = 0u; mine = 0u;
#pragma unroll
        for (unsigned j = 0; j < 16; ++j) { const unsigned c = xb_ld(&bar[XB_XCNT(j)]); sum += c; cnt += (c > 0u) ? 1u : 0u; mine = (j == x) ? c : mine; }
        if (sum == G) break;
        __builtin_amdgcn_s_sleep(1);
        if ((++sp & 255u) == 0u) { if (xb_ld(&bar[XB_TMO])) break; if (sp > XB_SPIN_CAP) { atomicAdd(&bar[XB_TMO], 1u); break; } }
    }
    nloc = mine > 0u ? mine : 1u; nx = cnt > 0u ? cnt : 1u;
}
DEV void xcd_barrier(const XcdBarrier& b) {
    asm volatile("s_waitcnt vmcnt(0)" ::: "memory");
    __syncthreads();
    if (threadIdx.x == 0) {
        unsigned* bar = b.bar;
        __builtin_amdgcn_s_waitcnt(0);
        unsigned nloc = b.st[0], nx = b.st[1];
        if (nloc == 0u) { xcd_barrier_complete(bar, b.x, nloc, nx); b.st[0] = nloc; b.st[1] = nx; }
        const unsigned old = xb_add(&bar[XB_XSUB(b.x)], 1u);
        const unsigned gen = old / nloc;
        if (old + 1u == (gen + 1u) * nloc) {
            __builtin_amdgcn_fence(__ATOMIC_RELEASE, "agent");
            asm volatile("s_waitcnt vmcnt(0)" ::: "memory");
            const unsigned og = xb_add(&bar[XB_TOP], 1u);
            const unsigned tg = og / nx;
            if (og + 1u == (tg + 1u) * nx) xb_add(&bar[XB_TOPGEN], 1u);
            else XB_SPIN(xb_ld(&bar[XB_TOPGEN]) == tg, bar);
            __builtin_amdgcn_fence(__ATOMIC_ACQUIRE, "agent");
            xb_add(&bar[XB_XGEN(b.x)], 1u);
            asm volatile("s_waitcnt vmcnt(0)" ::: "memory");
        } else {
            XB_SPIN(xb_ld(&bar[XB_XGEN(b.x)]) == gen, bar);
            __builtin_amdgcn_fence(__ATOMIC_ACQUIRE, "agent");
            asm volatile("s_waitcnt vmcnt(0)" ::: "memory");
        }
    }
    __syncthreads();
}


DEV void late_transpose_item(const P& p, int it, float* smem) {
    const int m = it >> 8, t = it & 255;
    const float* W = m == 0 ? p.w_out : (m == 1 ? p.xa_wq : (m == 2 ? p.xa_wo : p.peer_wq));
    const size_t off = m == 0 ? WS_WOUT_T : (m == 1 ? WS_WQ_T : (m == 2 ? WS_WO_T : WS_PWQ_T));
    transpose_tile(W, 1024, (bf16_t*)(p.ws + off), t >> 4, t & 15, smem);
}

constexpr int WQ_WORD0 = 4096;
DEV int wq_next(unsigned* cnt, int nper, int xcc, unsigned char* lds) {
    volatile unsigned* slot = (volatile unsigned*)(lds + LDS_BYTES - 16);
    __syncthreads();
    if (threadIdx.x == 0) {
        int res = -1;
        int off = (int)slot[1];
        while (off < 8) {
            const int q = (xcc + off) & 7;
            const unsigned idx = atomicAdd(&cnt[q * 64], 1u);
            if (idx < (unsigned)nper) { res = q * nper + (int)idx; break; }
            ++off;
        }
        slot[0] = (unsigned)res;
        slot[1] = (unsigned)off;
    }
    __syncthreads();
    return (int)slot[0];
}
DEV void wq_begin(unsigned char* lds) {
    __syncthreads();
    if (threadIdx.x == 0) ((volatile unsigned*)(lds + LDS_BYTES - 16))[1] = 0u;
}

constexpr int NSTAGES = 12;
template <int ST>
DEV void run_stage(const P& p, unsigned char* lds, int xcc) {
    float* smem = (float*)lds;
    const int nb = gridDim.x, bid = blockIdx.x;
    int tidl = threadIdx.x;
    asm volatile("" : "+v"(tidl));
    const int wave = tidl >> 6;
    unsigned* wqc = (unsigned*)(p.ws + WS_BAR) + WQ_WORD0;
    if (ST == 0) {
        for (int it = bid; it < PREP_END; it += nb) prep_item(p, it, smem);
    } else if (ST == 1) {
        for (int it = bid; it < 3456 + 256; it += nb) {
            if (it < 3456) gemm_item<0>(p, it & 7, it >> 3, lds);
            else gemm_item<1>(p, (it - 3456) & 7, (it - 3456) >> 3, lds);
        }
    } else if (ST == 2) {
        if (PROBE_REP == 21) for (int it = bid; it < 256; it += nb) compress_item2(p, it, lds);
        if (PROBE_REP == 22) for (int it = bid; it < 1024; it += nb) hgrn_prep_item(p, it, smem);
        for (int it = bid; it < 256 + 1024; it += nb) {
            if (it < 256) compress_item2(p, it, lds);
            else hgrn_prep_item2(p, it - 256, lds);
        }
    } else if (ST == 3) {
        if (PROBE_REP == 31) { for (int it = bid; it < 32; it += nb) hgrn_chain_item(p, it, lds); }
        if (PROBE_REP == 32) {
            volatile unsigned* qs2 = (volatile unsigned*)(lds + LDS_BYTES - 16);
            for (;;) {
                __syncthreads();
                if (threadIdx.x == 0) *qs2 = atomicAdd(wqc + 64, 1u);
                __syncthreads();
                const int j = (int)*qs2;
                if (j >= 1024) break;
                nsa_item2(p, (j & 15) >> 1, j & 1, 63 - (j >> 4), lds, p.out != nullptr ? 4 : 0);
            }
        }
        volatile unsigned* qslot = (volatile unsigned*)(lds + LDS_BYTES - 16);
        for (;;) {
            __syncthreads();
            if (threadIdx.x == 0) *qslot = atomicAdd(wqc, 1u);
            __syncthreads();
            const int it = (int)*qslot;
            if (it >= 32 + 1024) break;
            if (it < 32) hgrn_chain_item2(p, it, lds);
            else { const int j = it - 32; nsa_item2(p, (j & 15) >> 1, j & 1, 63 - (j >> 4), lds); }
        }
        for (;;) {
            __syncthreads();
            if (threadIdx.x == 0) *qslot = atomicAdd(wqc + 128, 1u);
            __syncthreads();
            const int it = (int)*qslot;
            if (it >= 2048) break;
            if (it < 1024) late_transpose_item(p, it, smem);
            else {
                const int j = it - 1024, tb = j >> 9, r0 = (j & 511) * 32 + wave * 8;
                for (int r = 0; r < 8; ++r) {
                    if (tb == 0) peer_quant_row(p.peer_down, p.ws + WS_PD, (float*)(p.ws + WS_PSD), r0 + r, (int*)(p.ws + WS_PRS));
                    else peer_quant_row(p.peer_up, p.ws + WS_PU, (float*)(p.ws + WS_PSU), r0 + r);
                }
            }
        }
    } else if (ST == 4) {
        for (int it = bid; it < 1024; it += nb) gemm_item<2>(p, it & 7, it >> 3, lds);
    } else if (ST == 5) {
        for (int it = bid; it < T_ / 4; it += nb) ln_item(p, it * 4 + wave, 0, tidl & 63);
    } else if (ST == 9) {
        for (int it = bid; it < T_ / 4; it += nb) ln_item(p, it * 4 + wave, 1, tidl & 63);
    } else if (ST == 6) {
        for (int it = bid; it < 1024; it += nb) gemm_item<3>(p, it & 7, it >> 3, lds);
    } else if (ST == 7) {
        for (int it = bid; it < 1024; it += nb) xattn_item3(p, it, lds);
    } else if (ST == 8) {
        for (int it = bid; it < 1024; it += nb) gemm_item<4>(p, it & 7, it >> 3, lds);
    } else if (ST == 10) {
        for (int it = bid; it < 1024; it += nb) gemm_item<5>(p, it & 7, it >> 3, lds);
    } else if (ST == 11) {
        if (PROBE_REP == 11) for (int it = bid; it < T_ / 16; it += nb) peer_route_item(p, it, lds);
        for (int it = bid; it < T_ / 16; it += nb) peer_route_item(p, it, lds);
    } else if (ST == 12) {
        if (PROBE_REP == 12) { wq_begin(lds); for (int it; (it = wq_next(wqc + 4 * 512, 1024, xcc, lds)) >= 0;) peer_down_item(p, it >> 10, it & 1023, tidl & 63, wave); }
        wq_begin(lds);
        for (int it; (it = wq_next(wqc + 2 * 512, 1024, xcc, lds)) >= 0;) peer_down_item(p, it >> 10, it & 1023, tidl & 63, wave);
    } else if (ST == 13) {
        if (PROBE_REP == 13) for (int it = bid; it < T_ / 4; it += nb) peer_coef_item(p, it * 4 + wave, tidl & 63);
        for (int it = bid; it < T_ / 4; it += nb) peer_coef_item(p, it * 4 + wave, tidl & 63);
    } else if (ST == 14) {
        if (PROBE_REP == 14) { wq_begin(lds); for (int it; (it = wq_next(wqc + 5 * 512, 1024, xcc, lds)) >= 0;) peer_up_item(p, it >> 10, it & 1023, tidl & 63, wave, p.out == nullptr); }
        wq_begin(lds);
        for (int it; (it = wq_next(wqc + 3 * 512, 1024, xcc, lds)) >= 0;) peer_up_item(p, it >> 10, it & 1023, tidl & 63, wave);
    } else if (ST == 15) {
        for (int it = bid; it < T_ / 4; it += nb) ln3_item(p, it * 4 + wave, tidl & 63);
    }
}

template <int ST>
__global__ void __launch_bounds__(256, 2) stage_kernel(P p) {
    __shared__ __attribute__((aligned(16))) unsigned char lds[LDS_BYTES + 16];
    run_stage<ST>(p, lds, (int)xb_xcc_id() & 7);
}

__global__ void __launch_bounds__(256, 2) mega_kernel(P p) {
    __shared__ __attribute__((aligned(16))) unsigned char lds[LDS_BYTES + 16];
    if (threadIdx.x == 0) *(uint4*)(lds + LDS_BYTES) = make_uint4(0u, 0u, 0u, 0u);
    __syncthreads();
    const XcdBarrier xb = xcd_barrier_post((unsigned*)(p.ws + WS_BAR), (volatile LAS unsigned*)(lds + LDS_BYTES));
    const int xcc = (int)xb.x & 7;
    run_stage<0>(p, lds, xcc); xcd_barrier(xb);
    if (PROBE_REP == 0) { run_stage<0>(p, lds, xcc); xcd_barrier(xb); }
    run_stage<1>(p, lds, xcc); xcd_barrier(xb);
    if (PROBE_REP == 1) { run_stage<1>(p, lds, xcc); xcd_barrier(xb); }
    run_stage<2>(p, lds, xcc); xcd_barrier(xb);
    if (PROBE_REP == 2) { run_stage<2>(p, lds, xcc); xcd_barrier(xb); }
    if (PROBE_REP == 35) { if (blockIdx.x < 32) hgrn_chain_item2(p, blockIdx.x, lds); xcd_barrier(xb); }
    run_stage<3>(p, lds, xcc); xcd_barrier(xb);
    run_stage<4>(p, lds, xcc); xcd_barrier(xb);
    if (PROBE_REP == 4) { run_stage<4>(p, lds, xcc); xcd_barrier(xb); }
    if (PROBE_REP == 50) { xcd_barrier(xb); xcd_barrier(xb); xcd_barrier(xb); xcd_barrier(xb); xcd_barrier(xb); xcd_barrier(xb); xcd_barrier(xb); xcd_barrier(xb); }
    run_stage<5>(p, lds, xcc); xcd_barrier(xb);
    run_stage<6>(p, lds, xcc); xcd_barrier(xb);
    if (PROBE_REP == 6) { run_stage<6>(p, lds, xcc); xcd_barrier(xb); }
    run_stage<7>(p, lds, xcc); xcd_barrier(xb);
    if (PROBE_REP == 7) { run_stage<7>(p, lds, xcc); xcd_barrier(xb); }
    run_stage<8>(p, lds, xcc); xcd_barrier(xb);
    run_stage<9>(p, lds, xcc); xcd_barrier(xb);
    run_stage<10>(p, lds, xcc); xcd_barrier(xb);
    if (PROBE_REP == 10) { run_stage<10>(p, lds, xcc); xcd_barrier(xb); }
    run_stage<11>(p, lds, xcc); xcd_barrier(xb);
    run_stage<12>(p, lds, xcc); xcd_barrier(xb);
    run_stage<13>(p, lds, xcc); xcd_barrier(xb);
    run_stage<14>(p, lds, xcc); xcd_barrier(xb);
    run_stage<15>(p, lds, xcc);
}

extern "C" void kernel_launch(void* const* d_in, const int* in_sizes, int n_in, void* d_out, int out_size, void* d_ws, size_t ws_size,
                              hipStream_t stream) {
    if (n_in != 18 || ws_size < WS_END) {
        fprintf(stderr, "kernel_launch: unexpected inputs (n_in %d, ws %zu, need %zu)\n", n_in, ws_size, (size_t)WS_END);
        return;
    }
    P p{};
    p.x = (const float*)d_in[0]; p.mem = (const float*)d_in[1]; p.w_in = (const float*)d_in[2]; p.cmp_pos = (const float*)d_in[3];
    p.cmp_w1 = (const float*)d_in[4]; p.cmp_w2 = (const float*)d_in[5]; p.lb_logits = (const float*)d_in[6];
    p.hg_norm_w = (const float*)d_in[7]; p.w_out = (const float*)d_in[8]; p.xa_wq = (const float*)d_in[9];
    p.xa_wkv = (const float*)d_in[10]; p.xa_wo = (const float*)d_in[11]; p.peer_wq = (const float*)d_in[12];
    p.peer_keys = (const float*)d_in[13]; p.peer_down = (const float*)d_in[14]; p.peer_up = (const float*)d_in[15];
    p.ln_g = (const float*)d_in[16]; p.ln_b = (const float*)d_in[17];
    p.out = (float*)d_out; p.ws = (unsigned char*)d_ws;
#if ONE_LAUNCH
    static int grid_blocks = 0;
    if (!grid_blocks) {
        int dev = 0, cus = 0, per_cu = 0;
        hipGetDevice(&dev);
        hipDeviceGetAttribute(&cus, hipDeviceAttributeMultiprocessorCount, dev);
        hipOccupancyMaxActiveBlocksPerMultiprocessor(&per_cu, mega_kernel, 256, 0);
        if (per_cu > 2) per_cu = 2;
        if (per_cu < 1) per_cu = 1;
        grid_blocks = cus * per_cu;
    }
    (void)hipMemsetAsync((unsigned char*)d_ws + WS_BAR, 0, 65536, stream);
    void* args[] = {&p};
    hipError_t e = hipLaunchCooperativeKernel((void*)mega_kernel, dim3(grid_blocks), dim3(256), args, 0, stream);
    if (e != hipSuccess) fprintf(stderr, "cooperative launch failed: %s (grid %d)\n", hipGetErrorString(e), grid_blocks);
#else
    const int G = 2048;
    stage_kernel<0><<<G, 256, 0, stream>>>(p);
    stage_kernel<1><<<G, 256, 0, stream>>>(p);
    stage_kernel<2><<<G, 256, 0, stream>>>(p);
    stage_kernel<3><<<G, 256, 0, stream>>>(p);
    stage_kernel<4><<<G, 256, 0, stream>>>(p);
    stage_kernel<5><<<G, 256, 0, stream>>>(p);
    stage_kernel<6><<<G, 256, 0, stream>>>(p);
    stage_kernel<7><<<G, 256, 0, stream>>>(p);
    stage_kernel<8><<<G, 256, 0, stream>>>(p);
    stage_kernel<9><<<G, 256, 0, stream>>>(p);
    stage_kernel<10><<<G, 256, 0, stream>>>(p);
    stage_kernel<11><<<G, 256, 0, stream>>>(p);
#endif
}
```

```cpp
#include <hip/hip_runtime.h>
#include <hip/hip_cooperative_groups.h>
#include <cstdio>
#include <cstdint>
namespace cg = cooperative_groups;

#ifndef PROBE_REP
#define PROBE_REP -1
#endif
#ifndef ONE_LAUNCH
#define ONE_LAUNCH 1
#endif

typedef unsigned short bf16_t;
#define DEV __device__ __forceinline__

constexpr int D_ = 1024, B_ = 8, S_ = 2048, T_ = B_ * S_, ML_ = 256, INC = 3352;
constexpr int NCMP = 127;
constexpr int LDS_BYTES = 67584;
constexpr float ALPHA = 1.189207115002721f;
constexpr float LN_EPS = 1e-5f;
constexpr int C_QA = 0, C_KC = 512, C_VC = 640, C_KS = 768, C_VS = 896, C_KW = 1024, C_VW = 1152, C_GATE = 1280,
              C_HQ = 1304, C_HF = 1816, C_HI = 2328, C_HG = 2840;
constexpr size_t WS_HB = 0;
constexpr size_t SZ_HB = (size_t)T_ * INC * 2;
constexpr size_t WS_OM = WS_HB + SZ_HB;
constexpr size_t WS_KVM = WS_OM + (size_t)T_ * 1024 * 2;
constexpr size_t WS_KC = WS_KVM + (size_t)2048 * 2048 * 2;
constexpr size_t WS_XB = WS_KC + (1u << 20);
constexpr size_t WS_WIN_T = WS_XB + (size_t)T_ * 1024 * 2;
constexpr size_t WS_WOUT_T = WS_WIN_T + (size_t)3456 * 1024 * 2;
constexpr size_t WS_WQ_T = WS_WOUT_T + (size_t)1024 * 1024 * 2;
constexpr size_t WS_WKV_T = WS_WQ_T + (size_t)1024 * 1024 * 2;
constexpr size_t WS_WO_T = WS_WKV_T + (size_t)2048 * 1024 * 2;
constexpr size_t WS_PWQ_T = WS_WO_T + (size_t)1024 * 1024 * 2;
constexpr size_t WS_MEMB = WS_PWQ_T + (size_t)1024 * 1024 * 2;
constexpr size_t WS_PKEY = WS_MEMB + (size_t)2048 * 1024 * 2;
constexpr size_t WS_VT = WS_PKEY + (size_t)16 * 128 * 64 * 2;
constexpr size_t WS_KCB = WS_VT + (size_t)2 * B_ * 2 * 64 * 2048 * 2;
constexpr size_t WS_VCT = WS_KCB + (size_t)B_ * 2 * 128 * 64 * 2;
constexpr size_t WS_W1T = WS_VCT + (size_t)B_ * 2 * 128 * 64 * 2;
constexpr size_t WS_W2T = WS_W1T + (size_t)2 * 128 * 2048 * 2;
constexpr size_t WS_CB = WS_W2T + (size_t)2 * 64 * 128 * 2;
constexpr size_t WS_VMT = WS_CB + 1024;
constexpr size_t WS_BAR = WS_VMT + (size_t)B_ * 4 * 256 * 256 * 2;
constexpr size_t WS_PD = WS_BAR + 65536;
constexpr size_t WS_PU = WS_PD + (size_t)16384 * 1024;
constexpr size_t WS_PSD = WS_PU + (size_t)16384 * 1024;
constexpr size_t WS_PSU = WS_PSD + 65536;
constexpr size_t WS_PRS = WS_PSU + 65536;
constexpr size_t WS_END = WS_PRS + 65536;
static_assert(WS_END <= (size_t)268435456, "workspace budget");
constexpr size_t WS_EB = WS_KC;
constexpr size_t HS_QT = 0;
constexpr size_t HS_KT = (size_t)B_ * 4 * 2048 * 128 * 2;
constexpr size_t HS_KHT = 2 * HS_KT;
constexpr size_t HS_VIT = 3 * HS_KT;
constexpr size_t HS_DS = HS_KT;
constexpr size_t HS_OI = 3 * HS_KT;
constexpr size_t WS_QX = 0;
constexpr size_t WS_OX = (size_t)T_ * 1024 * 2;
constexpr size_t WS_QP = 0;
constexpr size_t WS_EIDP = (size_t)T_ * 1024 * 2;
constexpr size_t WS_GATEP = WS_EIDP + (size_t)T_ * 128 * 2;
constexpr size_t WS_COEFP = WS_GATEP + (size_t)T_ * 128 * 4;
constexpr size_t WS_XQ = WS_COEFP + (size_t)T_ * 128 * 4;
constexpr size_t WS_SXF = WS_XQ + (size_t)T_ * 1024;
constexpr size_t WS_SXI = WS_SXF + (size_t)T_ * 4;
constexpr size_t WS_ASUM = WS_SXI + (size_t)T_ * 4;
constexpr size_t WS_DP = WS_ASUM + (size_t)T_ * 4;
static_assert(WS_DP + (size_t)8 * T_ * 128 * 4 <= WS_KVM, "PEER intermediates must fit in the dead h/OM region");

struct P {
    const float *x, *mem, *w_in, *cmp_pos, *cmp_w1, *cmp_w2, *lb_logits, *hg_norm_w, *w_out, *xa_wq, *xa_wkv, *xa_wo,
        *peer_wq, *peer_keys, *peer_down, *peer_up, *ln_g, *ln_b;
    float* out;
    unsigned char* ws;
};

DEV unsigned short f2bf(float f) {
    unsigned u = __float_as_uint(f);
    u += 0x7fffu + ((u >> 16) & 1u);
    return (unsigned short)(u >> 16);
}
DEV float bf2f(unsigned short h) { return __uint_as_float(((unsigned)h) << 16); }
DEV float bflo(unsigned u) { return __uint_as_float(u << 16); }
DEV float bfhi(unsigned u) { return __uint_as_float(u & 0xffff0000u); }
typedef __bf16 bf16x2_t __attribute__((ext_vector_type(2)));
typedef float f32x2_t __attribute__((ext_vector_type(2)));
DEV unsigned pk_bf16(float a, float b) {
    f32x2_t v = {a, b};
    bf16x2_t r = __builtin_convertvector(v, bf16x2_t);
    return __builtin_bit_cast(unsigned, r);
}
DEV float wsum(float v) {
#pragma unroll
    for (int o = 32; o > 0; o >>= 1) v += __shfl_xor(v, o);
    return v;
}
DEV float wmax(float v) {
#pragma unroll
    for (int o = 32; o > 0; o >>= 1) v = fmaxf(v, __shfl_xor(v, o));
    return v;
}
DEV float sigmoidf_(float x) { return 1.f / (1.f + expf(-x)); }
DEV float fsigmoid(float x) { return __fdividef(1.f, 1.f + __expf(-x)); }

template <int MODE>
DEV void gemm_tile(const P& p, int tile, float* smem) {
    constexpr bool ABF = (MODE == 2 || MODE == 4);
    constexpr int K = 1024;
    constexpr int N = MODE == 0 ? INC : (MODE == 1 ? 2048 : 1024);
    constexpr int NTN = (N + 63) / 64;
    const int tm = tile / NTN, tn = tile % NTN;
    const float* Af = nullptr;
    const bf16_t* Ab = nullptr;
    const float* Bm = nullptr;
    if (MODE == 0) { Af = p.x; Bm = p.w_in; }
    if (MODE == 1) { Af = p.mem; Bm = p.xa_wkv; }
    if (MODE == 2) { Ab = (const bf16_t*)(p.ws + WS_OM); Bm = p.w_out; }
    if (MODE == 3) { Af = p.out; Bm = p.xa_wq; }
    if (MODE == 4) { Ab = (const bf16_t*)(p.ws + WS_OX); Bm = p.xa_wo; }
    if (MODE == 5) { Af = p.out; Bm = p.peer_wq; }
    float(*sA)[68] = (float(*)[68])smem;
    float(*sB)[68] = (float(*)[68])(smem + 16 * 68);
    const int tid = threadIdx.x, tx = tid & 15, ty = tid >> 4;
    const int ar = tid >> 2, ak = (tid & 3) * 4;
    const int bk = tid >> 4, bn = (tid & 15) * 4;
    float acc[4][4];
#pragma unroll
    for (int i = 0; i < 4; ++i)
#pragma unroll
        for (int j = 0; j < 4; ++j) acc[i][j] = 0.f;
    const int gn = tn * 64 + bn;
    for (int k0 = 0; k0 < K; k0 += 16) {
        float4 av;
        if (ABF) {
            uint2 u = *(const uint2*)(Ab + (size_t)(tm * 64 + ar) * K + k0 + ak);
            av.x = bflo(u.x); av.y = bfhi(u.x); av.z = bflo(u.y); av.w = bfhi(u.y);
        } else {
            av = *(const float4*)(Af + (size_t)(tm * 64 + ar) * K + k0 + ak);
        }
        float4 bv = make_float4(0.f, 0.f, 0.f, 0.f);
        if (gn < N) bv = *(const float4*)(Bm + (size_t)(k0 + bk) * N + gn);
        sA[ak + 0][ar] = av.x; sA[ak + 1][ar] = av.y; sA[ak + 2][ar] = av.z; sA[ak + 3][ar] = av.w;
        *(float4*)&sB[bk][bn] = bv;
        __syncthreads();
#pragma unroll
        for (int kk = 0; kk < 16; ++kk) {
            float4 a = *(const float4*)&sA[kk][ty * 4];
            float4 b = *(const float4*)&sB[kk][tx * 4];
            float aa[4] = {a.x, a.y, a.z, a.w}, bb[4] = {b.x, b.y, b.z, b.w};
#pragma unroll
            for (int i = 0; i < 4; ++i)
#pragma unroll
                for (int j = 0; j < 4; ++j) acc[i][j] += aa[i] * bb[j];
        }
        __syncthreads();
    }
    const int col = tn * 64 + tx * 4;
#pragma unroll
    for (int i = 0; i < 4; ++i) {
        const size_t row = (size_t)tm * 64 + ty * 4 + i;
        if (MODE == 0 || MODE == 1 || MODE == 3) {
            bf16_t* O = (bf16_t*)(p.ws + (MODE == 0 ? WS_HB : (MODE == 1 ? WS_KVM : WS_QX)));
            if (col < N) {
                uint2 u;
                u.x = (unsigned)f2bf(acc[i][0]) | ((unsigned)f2bf(acc[i][1]) << 16);
                u.y = (unsigned)f2bf(acc[i][2]) | ((unsigned)f2bf(acc[i][3]) << 16);
                *(uint2*)(O + row * N + col) = u;
            }
        } else if (MODE == 2) {
            float4 xv = *(const float4*)(p.x + row * 1024 + col);
            float4 o = make_float4(ALPHA * xv.x + acc[i][0], ALPHA * xv.y + acc[i][1], ALPHA * xv.z + acc[i][2], ALPHA * xv.w + acc[i][3]);
            *(float4*)(p.out + row * 1024 + col) = o;
        } else if (MODE == 4) {
            float4 xv = *(const float4*)(p.out + row * 1024 + col);
            float4 o = make_float4(ALPHA * xv.x + acc[i][0], ALPHA * xv.y + acc[i][1], ALPHA * xv.z + acc[i][2], ALPHA * xv.w + acc[i][3]);
            *(float4*)(p.out + row * 1024 + col) = o;
        } else {
            float* O = (float*)(p.ws + WS_QP);
            *(float4*)(O + row * 1024 + col) = make_float4(acc[i][0], acc[i][1], acc[i][2], acc[i][3]);
        }
    }
}


using bf16x8 = __attribute__((ext_vector_type(8))) short;
using f32x4 = __attribute__((ext_vector_type(4))) float;
using u32x4 = __attribute__((ext_vector_type(4))) unsigned;

template <int MODE>
DEV void gemm_mfma_tile(const P& p, int tm, int tn, unsigned char* lds) {
    const bf16_t* A;
    const bf16_t* W;
    if (MODE == 0) { A = (const bf16_t*)(p.ws + WS_XB); W = (const bf16_t*)(p.ws + WS_WIN_T); }
    if (MODE == 1) { A = (const bf16_t*)(p.ws + WS_MEMB); W = (const bf16_t*)(p.ws + WS_WKV_T); }
    if (MODE == 2) { A = (const bf16_t*)(p.ws + WS_OM); W = (const bf16_t*)(p.ws + WS_WOUT_T); }
    if (MODE == 3) { A = (const bf16_t*)(p.ws + WS_XB); W = (const bf16_t*)(p.ws + WS_WQ_T); }
    if (MODE == 4) { A = (const bf16_t*)(p.ws + WS_OX); W = (const bf16_t*)(p.ws + WS_WO_T); }
    if (MODE == 5) { A = (const bf16_t*)(p.ws + WS_XB); W = (const bf16_t*)(p.ws + WS_PWQ_T); }
    const int tid = threadIdx.x, lane = tid & 63, wid = tid >> 6, wm = wid >> 1, wn = wid & 1;
    const int m0 = tm * 128, n0 = tn * 128;
    const bf16_t* ga[2];
    const bf16_t* gw[2];
#pragma unroll
    for (int i = 0; i < 2; ++i) {
        const int r = (wid * 2 + i) * 16 + (lane >> 2);
        const int gsw = (0x1320 >> (((r >> 2) & 3) * 4)) & 3;
        const int c = (lane & 3) ^ gsw;
        ga[i] = A + (size_t)(m0 + r) * 1024 + c * 8;
        gw[i] = W + (size_t)(n0 + r) * 1024 + c * 8;
    }
    unsigned char* lbase = lds + wid * 2048;
#define GEMM_STAGE(slot, kt)                                                                                                   \
    do {                                                                                                                       \
        _Pragma("unroll") for (int i = 0; i < 2; ++i) {                                                                        \
            __builtin_amdgcn_global_load_lds((const unsigned*)(ga[i] + (kt) * 32), (unsigned*)(lbase + (slot) * 16384 + i * 1024), 16, 0, 0);         \
            __builtin_amdgcn_global_load_lds((const unsigned*)(gw[i] + (kt) * 32), (unsigned*)(lbase + (slot) * 16384 + 8192 + i * 1024), 16, 0, 0);  \
        }                                                                                                                      \
    } while (0)
    asm volatile("s_waitcnt vmcnt(0)" ::: "memory");
    GEMM_STAGE(0, 0);
    GEMM_STAGE(1, 1);
    GEMM_STAGE(2, 2);
    f32x4 acc[4][4];
#pragma unroll
    for (int i = 0; i < 4; ++i)
#pragma unroll
        for (int j = 0; j < 4; ++j) acc[i][j] = (f32x4){0.f, 0.f, 0.f, 0.f};
    const int fr = lane & 15, fq = lane >> 4;
    const int fsw = (0x1320 >> (((fr >> 2) & 3) * 4)) & 3;
    const int aoff = (wm * 64 + fr) * 64 + ((fq ^ fsw) << 4);
    const int boff = 8192 + (wn * 64 + fr) * 64 + ((fq ^ fsw) << 4);
#define GEMM_COMPUTE(slot)                                                                                                     \
    do {                                                                                                                       \
        const unsigned char* sb = lds + (slot) * 16384;                                                                        \
        bf16x8 af[4], wf[4];                                                                                                   \
        _Pragma("unroll") for (int t = 0; t < 4; ++t) {                                                                        \
            af[t] = *(const bf16x8*)(sb + aoff + t * 1024);                                                                    \
            wf[t] = *(const bf16x8*)(sb + boff + t * 1024);                                                                    \
        }                                                                                                                      \
        _Pragma("unroll") for (int nt = 0; nt < 4; ++nt)                                                                       \
            _Pragma("unroll") for (int mt = 0; mt < 4; ++mt)                                                                   \
                acc[nt][mt] = __builtin_amdgcn_mfma_f32_16x16x32_bf16(wf[nt], af[mt], acc[nt][mt], 0, 0, 0);                   \
    } while (0)
#pragma unroll 1
    for (int kt = 0; kt < 29; ++kt) {
        asm volatile("s_waitcnt vmcnt(8)\n\ts_waitcnt lgkmcnt(0)" ::: "memory");
        __builtin_amdgcn_s_barrier(); asm volatile("" ::: "memory");
        GEMM_STAGE((kt + 3) & 3, kt + 3);
        GEMM_COMPUTE(kt & 3);
    }
    asm volatile("s_waitcnt vmcnt(8)\n\ts_waitcnt lgkmcnt(0)" ::: "memory");
    __builtin_amdgcn_s_barrier(); asm volatile("" ::: "memory");
    GEMM_COMPUTE(29 & 3);
    asm volatile("s_waitcnt vmcnt(4)\n\ts_waitcnt lgkmcnt(0)" ::: "memory");
    __builtin_amdgcn_s_barrier(); asm volatile("" ::: "memory");
    GEMM_COMPUTE(30 & 3);
    asm volatile("s_waitcnt vmcnt(0)\n\ts_waitcnt lgkmcnt(0)" ::: "memory");
    __builtin_amdgcn_s_barrier(); asm volatile("" ::: "memory");
    GEMM_COMPUTE(31 & 3);
    asm volatile("s_waitcnt lgkmcnt(0)" ::: "memory");
    __builtin_amdgcn_s_barrier(); asm volatile("" ::: "memory");
#undef GEMM_STAGE
#undef GEMM_COMPUTE
#pragma unroll
    for (int mt = 0; mt < 4; ++mt) {
        const size_t m = (size_t)m0 + wm * 64 + mt * 16 + fr;
#pragma unroll
        for (int nt = 0; nt < 4; ++nt) {
            const int n = n0 + wn * 64 + nt * 16 + fq * 4;
            const f32x4 c = acc[nt][mt];
            if (MODE == 0 || MODE == 1 || MODE == 3 || MODE == 5) {
                constexpr int NS = MODE == 0 ? INC : (MODE == 1 ? 2048 : 1024);
                bf16_t* O = (bf16_t*)(p.ws + (MODE == 0 ? WS_HB : (MODE == 1 ? WS_KVM : (MODE == 3 ? WS_QX : WS_QP))));
                if (MODE == 1 && tn >= 8) {
                    bf16_t* VMT = (bf16_t*)(p.ws + WS_VMT);
                    const int nn = n - 1024;
                    const size_t base = (((size_t)(m >> 8) * 4 + (nn >> 8)) * 256 + (nn & 255)) * 256 + (m & 255);
#pragma unroll
                    for (int i = 0; i < 4; ++i) VMT[base + (size_t)i * 256] = f2bf(c[i]);
                } else if (MODE == 0 && (tn == 7 || tn == 9)) {
                    bf16_t* VT = (bf16_t*)(p.ws + WS_VT);
                    const int which = tn == 9 ? 1 : 0;
                    const size_t base = ((((size_t)which * B_ + (m >> 11)) * 2 + wn) * 64 + nt * 16 + fq * 4) * 2048 + (m & 2047);
#pragma unroll
                    for (int i = 0; i < 4; ++i) VT[base + (size_t)i * 2048] = f2bf(c[i]);
                } else if (MODE != 0 || n < INC) {
                    uint2 u;
                    u.x = pk_bf16(c[0], c[1]);
                    u.y = pk_bf16(c[2], c[3]);
                    *(uint2*)(O + m * NS + n) = u;
                }
            } else if (MODE == 2) {
                const float4 xv = *(const float4*)(p.x + m * 1024 + n);
                *(float4*)(p.out + m * 1024 + n) = make_float4(ALPHA * xv.x + c[0], ALPHA * xv.y + c[1], ALPHA * xv.z + c[2], ALPHA * xv.w + c[3]);
            } else if (MODE == 4) {
                const float4 xv = *(const float4*)(p.out + m * 1024 + n);
                *(float4*)(p.out + m * 1024 + n) = make_float4(ALPHA * xv.x + c[0], ALPHA * xv.y + c[1], ALPHA * xv.z + c[2], ALPHA * xv.w + c[3]);
            }
        }
    }
}


template <int MODE>
DEV void gemm_mfma_tile256(const P& p, int tm, int tn, unsigned char* lds) {
    const bf16_t* A;
    const bf16_t* W;
    if (MODE == 0) { A = (const bf16_t*)(p.ws + WS_XB); W = (const bf16_t*)(p.ws + WS_WIN_T); }
    if (MODE == 1) { A = (const bf16_t*)(p.ws + WS_MEMB); W = (const bf16_t*)(p.ws + WS_WKV_T); }
    if (MODE == 2) { A = (const bf16_t*)(p.ws + WS_OM); W = (const bf16_t*)(p.ws + WS_WOUT_T); }
    if (MODE == 3) { A = (const bf16_t*)(p.ws + WS_XB); W = (const bf16_t*)(p.ws + WS_WQ_T); }
    if (MODE == 4) { A = (const bf16_t*)(p.ws + WS_OX); W = (const bf16_t*)(p.ws + WS_WO_T); }
    if (MODE == 5) { A = (const bf16_t*)(p.ws + WS_XB); W = (const bf16_t*)(p.ws + WS_PWQ_T); }
    const int tid = threadIdx.x, lane = tid & 63, wid = tid >> 6, wm = wid >> 1, wn = wid & 1;
    const int m0 = tm * 256, n0 = tn * 128;
    const bf16_t* ga[4];
    const bf16_t* gw[2];
#pragma unroll
    for (int i = 0; i < 4; ++i) {
        const int r = (wid * 4 + i) * 16 + (lane >> 2);
        const int gsw = (0x1320 >> (((r >> 2) & 3) * 4)) & 3;
        ga[i] = A + (size_t)(m0 + r) * 1024 + ((lane & 3) ^ gsw) * 8;
    }
#pragma unroll
    for (int i = 0; i < 2; ++i) {
        const int r = (wid * 2 + i) * 16 + (lane >> 2);
        const int gsw = (0x1320 >> (((r >> 2) & 3) * 4)) & 3;
        gw[i] = W + (size_t)(n0 + r) * 1024 + ((lane & 3) ^ gsw) * 8;
    }
    unsigned char* lbA = lds + wid * 4096;
    unsigned char* lbW = lds + 16384 + wid * 2048;
#define GEMM_STAGE(slot, kt)                                                                                                   \
    do {                                                                                                                       \
        _Pragma("unroll") for (int i = 0; i < 4; ++i)                                                                          \
            __builtin_amdgcn_global_load_lds((const unsigned*)(ga[i] + (kt) * 32), (unsigned*)(lbA + (slot) * 24576 + i * 1024), 16, 0, 0);  \
        _Pragma("unroll") for (int i = 0; i < 2; ++i)                                                                          \
            __builtin_amdgcn_global_load_lds((const unsigned*)(gw[i] + (kt) * 32), (unsigned*)(lbW + (slot) * 24576 + i * 1024), 16, 0, 0);  \
    } while (0)
    GEMM_STAGE(0, 0);
    f32x4 acc[4][8];
#pragma unroll
    for (int i = 0; i < 4; ++i)
#pragma unroll
        for (int j = 0; j < 8; ++j) acc[i][j] = (f32x4){0.f, 0.f, 0.f, 0.f};
    const int fr = lane & 15, fq = lane >> 4;
    const int fsw = (0x1320 >> (((fr >> 2) & 3) * 4)) & 3;
    const int aoff = (wm * 128 + fr) * 64 + ((fq ^ fsw) << 4);
    const int boff = 16384 + (wn * 64 + fr) * 64 + ((fq ^ fsw) << 4);
#pragma unroll 1
    for (int kt = 0; kt < 32; ++kt) {
        asm volatile("s_waitcnt vmcnt(0)\n\ts_waitcnt lgkmcnt(0)" ::: "memory");
        __builtin_amdgcn_s_barrier(); asm volatile("" ::: "memory");
        if (kt + 1 < 32) { if (kt & 1) GEMM_STAGE(0, kt + 1); else GEMM_STAGE(1, kt + 1); }
        const unsigned char* sb = lds + (kt & 1) * 24576;
        bf16x8 af[8], wf[4];
#pragma unroll
        for (int t = 0; t < 8; ++t) af[t] = *(const bf16x8*)(sb + aoff + t * 1024);
#pragma unroll
        for (int t = 0; t < 4; ++t) wf[t] = *(const bf16x8*)(sb + boff + t * 1024);
#pragma unroll
        for (int nt = 0; nt < 4; ++nt)
#pragma unroll
            for (int mt = 0; mt < 8; ++mt) acc[nt][mt] = __builtin_amdgcn_mfma_f32_16x16x32_bf16(wf[nt], af[mt], acc[nt][mt], 0, 0, 0);
    }
    asm volatile("s_waitcnt lgkmcnt(0)" ::: "memory");
    __builtin_amdgcn_s_barrier(); asm volatile("" ::: "memory");
#undef GEMM_STAGE
#pragma unroll
    for (int mt = 0; mt < 8; ++mt) {
        const size_t m = (size_t)m0 + wm * 128 + mt * 16 + fr;
#pragma unroll
        for (int nt = 0; nt < 4; ++nt) {
            const int n = n0 + wn * 64 + nt * 16 + fq * 4;
            const f32x4 c = acc[nt][mt];
            if (MODE == 0 || MODE == 1 || MODE == 3 || MODE == 5) {
                constexpr int NS = MODE == 0 ? INC : (MODE == 1 ? 2048 : 1024);
                bf16_t* O = (bf16_t*)(p.ws + (MODE == 0 ? WS_HB : (MODE == 1 ? WS_KVM : (MODE == 3 ? WS_QX : WS_QP))));
                if (MODE == 1 && tn >= 8) {
                    bf16_t* VMT = (bf16_t*)(p.ws + WS_VMT);
                    const int nn = n - 1024;
                    const size_t base = (((size_t)(m >> 8) * 4 + (nn >> 8)) * 256 + (nn & 255)) * 256 + (m & 255);
#pragma unroll
                    for (int i = 0; i < 4; ++i) VMT[base + (size_t)i * 256] = f2bf(c[i]);
                } else if (MODE == 0 && (tn == 7 || tn == 9)) {
                    bf16_t* VT = (bf16_t*)(p.ws + WS_VT);
                    const int which = tn == 9 ? 1 : 0;
                    const size_t base = ((((size_t)which * B_ + (m >> 11)) * 2 + wn) * 64 + nt * 16 + fq * 4) * 2048 + (m & 2047);
#pragma unroll
                    for (int i = 0; i < 4; ++i) VT[base + (size_t)i * 2048] = f2bf(c[i]);
                } else if (MODE != 0 || n < INC) {
                    uint2 u;
                    u.x = pk_bf16(c[0], c[1]);
                    u.y = pk_bf16(c[2], c[3]);
                    *(uint2*)(O + m * NS + n) = u;
                }
            } else if (MODE == 2) {
                const float4 xv = *(const float4*)(p.x + m * 1024 + n);
                *(float4*)(p.out + m * 1024 + n) = make_float4(ALPHA * xv.x + c[0], ALPHA * xv.y + c[1], ALPHA * xv.z + c[2], ALPHA * xv.w + c[3]);
            } else if (MODE == 4) {
                const float4 xv = *(const float4*)(p.out + m * 1024 + n);
                *(float4*)(p.out + m * 1024 + n) = make_float4(ALPHA * xv.x + c[0], ALPHA * xv.y + c[1], ALPHA * xv.z + c[2], ALPHA * xv.w + c[3]);
            }
        }
    }
}


template <int MODE>
DEV void gemm_item(const P& p, int q, int j, unsigned char* lds) {
    int tm, tn;
    if (MODE == 0) {
        tm = q * 8 + (j & 7);
        tn = j >> 3;
    } else if (MODE == 1) {
        tm = q; tn = j;
    } else {
        tm = q * 8 + (j & 7);
        tn = j >> 3;
    }
    gemm_mfma_tile256<MODE>(p, tm, tn, lds);
}

DEV void transpose_tile(const float* W, int N, bf16_t* Wt, int tk, int tn, float* s, int ldk = 1024) {
    const int tid = threadIdx.x;
    const int k0 = tk * 64, n0 = tn * 64;
#pragma unroll
    for (int i = 0; i < 4; ++i) {
        const int k = (tid >> 4) + 16 * i, n = (tid & 15) * 4;
        float4 v = make_float4(0.f, 0.f, 0.f, 0.f);
        if (n0 + n < N) v = *(const float4*)(W + (size_t)(k0 + k) * N + n0 + n);
        s[k * 65 + n + 0] = v.x; s[k * 65 + n + 1] = v.y; s[k * 65 + n + 2] = v.z; s[k * 65 + n + 3] = v.w;
    }
    __syncthreads();
    {
        const int n = tid >> 2, kc = (tid & 3) * 16;
        unsigned u[8];
#pragma unroll
        for (int j = 0; j < 8; ++j)
            u[j] = (unsigned)f2bf(s[(kc + 2 * j) * 65 + n]) | ((unsigned)f2bf(s[(kc + 2 * j + 1) * 65 + n]) << 16);
        bf16_t* dst = Wt + (size_t)(n0 + n) * ldk + k0 + kc;
        *(uint4*)dst = make_uint4(u[0], u[1], u[2], u[3]);
        *(uint4*)(dst + 8) = make_uint4(u[4], u[5], u[6], u[7]);
    }
    __syncthreads();
}
DEV void convert_chunk(const float* src, bf16_t* dst, int item) {
    float4 a[4], b[4];
#pragma unroll
    for (int j = 0; j < 4; ++j) {
        const size_t e = (((size_t)item * 4 + j) * 256 + threadIdx.x) * 8;
        a[j] = *(const float4*)(src + e);
        b[j] = *(const float4*)(src + e + 4);
    }
#pragma unroll
    for (int j = 0; j < 4; ++j) {
        const size_t e = (((size_t)item * 4 + j) * 256 + threadIdx.x) * 8;
        uint4 u;
        u.x = pk_bf16(a[j].x, a[j].y);
        u.y = pk_bf16(a[j].z, a[j].w);
        u.z = pk_bf16(b[j].x, b[j].y);
        u.w = pk_bf16(b[j].z, b[j].w);
        *(uint4*)(dst + e) = u;
    }
}
constexpr int PREP_T0 = 16 * 54, PREP_T3 = PREP_T0 + 512, PREP_T5 = PREP_T3, PREP_X = PREP_T5 + T_ * 1024 / 8192, PREP_M = PREP_X + 2048 * 1024 / 8192, PREP_K = PREP_M + 16 * 128 * 64 / 8192, PREP_W1 = PREP_K + 128, PREP_W2 = PREP_W1 + 4,
              PREP_END = PREP_W2;
DEV void prep_item(const P& p, int it, float* smem) {
    if (it < PREP_T0) transpose_tile(p.w_in, INC, (bf16_t*)(p.ws + WS_WIN_T), it / 54, it % 54, smem);
    else if (it < PREP_T3) { it -= PREP_T0; transpose_tile(p.xa_wkv, 2048, (bf16_t*)(p.ws + WS_WKV_T), it >> 5, it & 31, smem); }
    else if (it < PREP_X) convert_chunk(p.x, (bf16_t*)(p.ws + WS_XB), it - PREP_T5);
    else if (it < PREP_M) convert_chunk(p.mem, (bf16_t*)(p.ws + WS_MEMB), it - PREP_X);
    else if (it < PREP_K) convert_chunk(p.peer_keys, (bf16_t*)(p.ws + WS_PKEY), it - PREP_M);
    else if (it < PREP_W1) {
        it -= PREP_K;
        const int kind = it >> 6, r = it & 63;
        transpose_tile(p.cmp_w1 + (size_t)kind * 2048 * 128, 128, (bf16_t*)(p.ws + WS_W1T) + (size_t)kind * 128 * 2048, r >> 1, r & 1, smem, 2048);
    } else if (it < PREP_W2) {
        it -= PREP_W1;
        const int kind = it >> 1;
        transpose_tile(p.cmp_w2 + (size_t)kind * 128 * 64, 64, (bf16_t*)(p.ws + WS_W2T) + (size_t)kind * 64 * 128, it & 1, 0, smem, 128);
    }
}

DEV void compress_item(const P& p, int item, float* smem) {
    const int tid = threadIdx.x;
    const int g = item & 1;
    int r = item >> 1;
    const int n = r % NCMP;
    r /= NCMP;
    const int b = r & 7, kind = r >> 3;
    const bf16_t* HB = (const bf16_t*)(p.ws + WS_HB);
    float* KC = (float*)(p.ws + WS_KC);
    float* su = smem;
    float* sp = smem + 2048;
    float* sh = smem + 2304;
    const int col = (kind ? C_VC : C_KC) + g * 64;
    for (int i = tid; i < 2048; i += 256) {
        const int l = i >> 6, d = i & 63;
        su[i] = bf2f(HB[(size_t)(b * S_ + 16 * n + l) * INC + col + d]) + p.cmp_pos[(kind * 32 + l) * 64 + d];
    }
    __syncthreads();
    {
        const int j = tid & 127, hf = tid >> 7;
        const float* w1 = p.cmp_w1 + (size_t)kind * 2048 * 128;
        float acc = 0.f;
        for (int i = hf * 1024; i < hf * 1024 + 1024; ++i) acc += su[i] * w1[(size_t)i * 128 + j];
        sp[hf * 128 + j] = acc;
    }
    __syncthreads();
    if (tid < 128) {
        const float v = sp[tid] + sp[128 + tid];
        const float u = 0.7978845608028654f * (v + 0.044715f * v * v * v);
        sh[tid] = 0.5f * v * (1.f + tanhf(u));
    }
    __syncthreads();
    if (tid < 64) {
        const float* w2 = p.cmp_w2 + (size_t)kind * 128 * 64;
        float acc = 0.f;
        for (int j = 0; j < 128; ++j) acc += sh[j] * w2[j * 64 + tid];
        KC[((((size_t)kind * B_ + b) * NCMP + n) * 2 + g) * 64 + tid] = acc;
    }
    __syncthreads();
}

DEV void load_q64_bf(float (&q)[64], const bf16_t* src) {
    const uint4* s4 = (const uint4*)src;
#pragma unroll
    for (int i = 0; i < 8; ++i) {
        const uint4 u = s4[i];
        q[i * 8 + 0] = bflo(u.x); q[i * 8 + 1] = bfhi(u.x); q[i * 8 + 2] = bflo(u.y); q[i * 8 + 3] = bfhi(u.y);
        q[i * 8 + 4] = bflo(u.z); q[i * 8 + 5] = bfhi(u.z); q[i * 8 + 6] = bflo(u.w); q[i * 8 + 7] = bfhi(u.w);
    }
}
DEV float dot64_bf(const float (&q)[64], const bf16_t* kr) {
    const uint4* k4 = (const uint4*)kr;
    float acc = 0.f;
#pragma unroll
    for (int i = 0; i < 8; ++i) {
        const uint4 u = k4[i];
        acc += q[i * 8 + 0] * bflo(u.x) + q[i * 8 + 1] * bfhi(u.x) + q[i * 8 + 2] * bflo(u.y) + q[i * 8 + 3] * bfhi(u.y) +
               q[i * 8 + 4] * bflo(u.z) + q[i * 8 + 5] * bfhi(u.z) + q[i * 8 + 6] * bflo(u.w) + q[i * 8 + 7] * bfhi(u.w);
    }
    return acc;
}
DEV float dot64_f(const float (&q)[64], const float* kr) {
    const float4* k4 = (const float4*)kr;
    float acc = 0.f;
#pragma unroll
    for (int i = 0; i < 16; ++i) {
        const float4 u = k4[i];
        acc += q[i * 4 + 0] * u.x + q[i * 4 + 1] * u.y + q[i * 4 + 2] * u.z + q[i * 4 + 3] * u.w;
    }
    return acc;
}

DEV void attn_block(const float (&q)[64], const bf16_t* krow_lane, const bf16_t* vbase_lane, bool valid, float& m, float& l, float& o) {
    float sc = dot64_bf(q, krow_lane) * 0.125f;
    sc = valid ? sc : -1e30f;
    const float mb = wmax(sc);
    const float mn = fmaxf(m, mb);
    const float corr = expf(m - mn);
    const float e = valid ? expf(sc - mn) : 0.f;
    l = l * corr + wsum(e);
    o *= corr;
#pragma unroll 8
    for (int k = 0; k < 64; ++k) o += __shfl(e, k) * bf2f(vbase_lane[(size_t)k * INC]);
    m = mn;
}

DEV void nsa_item(const P& p, int item) {
    const int lane = threadIdx.x & 63;
    const int g = item & 1;
    const int t = item >> 1;
    const int b = t >> 11, s = t & 2047;
    const bf16_t* HB = (const bf16_t*)(p.ws + WS_HB);
    const float* KC = (const float*)(p.ws + WS_KC);
    bf16_t* OM = (bf16_t*)(p.ws + WS_OM);
    const int cur = s >> 6;
    const int nvalid = (s >= 31) ? (((s - 31) >> 4) + 1) : 0;
    const size_t rowt = (size_t)t * INC;
    float ocmp0 = 0.f, ocmp1 = 0.f, ocmp2 = 0.f, ocmp3 = 0.f;
    float psum0 = 0.f, psum1 = 0.f;
    if (nvalid > 0) {
#pragma unroll 1
        for (int r = 0; r < 4; ++r) {
            const int h = g * 4 + r;
            float q[64];
            load_q64_bf(q, HB + rowt + C_QA + h * 64);
            float sc0 = -1e30f, sc1 = -1e30f;
            if (lane < nvalid) sc0 = dot64_f(q, KC + ((((size_t)0 * B_ + b) * NCMP + lane) * 2 + g) * 64) * 0.125f;
            if (lane + 64 < nvalid) sc1 = dot64_f(q, KC + ((((size_t)0 * B_ + b) * NCMP + lane + 64) * 2 + g) * 64) * 0.125f;
            const float m = wmax(fmaxf(sc0, sc1));
            const float e0 = (lane < nvalid) ? expf(sc0 - m) : 0.f;
            const float e1 = (lane + 64 < nvalid) ? expf(sc1 - m) : 0.f;
            const float l = wsum(e0 + e1);
            const float p0 = e0 / l, p1 = e1 / l;
            psum0 += p0;
            psum1 += p1;
            float oc = 0.f;
            const float* vcb = KC + ((((size_t)1 * B_ + b) * NCMP) * 2 + g) * 64 + lane;
            for (int n = 0; n < nvalid; ++n) {
                const float pn = (n < 64) ? __shfl(p0, n) : __shfl(p1, n - 64);
                oc += pn * vcb[(size_t)n * 128];
            }
            if (r == 0) ocmp0 = oc;
            if (r == 1) ocmp1 = oc;
            if (r == 2) ocmp2 = oc;
            if (r == 3) ocmp3 = oc;
        }
    }
    float imp = 0.f;
#pragma unroll
    for (int dn = -1; dn <= 3; ++dn) {
        const int n = 4 * lane + dn;
        const int nn = n < 0 ? 0 : (n > 127 ? 127 : n);
        const float v0 = __shfl(psum0, nn & 63);
        const float v1 = __shfl(psum1, nn & 63);
        const float v = (nn < 64) ? v0 : v1;
        if (n >= 0 && n <= 126) imp += v;
    }
    float score;
    if (lane > cur) score = -INFINITY;
    else if (lane == 0 || lane == cur || lane == cur - 1) score = 1e4f;
    else score = imp;
    int rank = 0;
#pragma unroll 8
    for (int i = 0; i < 32; ++i) {
        const float si = __shfl(score, i);
        rank += ((si > score) || (si == score && i < lane)) ? 1 : 0;
    }
    const bool sel = (lane <= cur) && (rank < 16);
    const unsigned mask = (unsigned)(__ballot(sel) & 0xffffffffull);
    const int wlo = (s - 511) > 0 ? (s - 511) : 0;
#pragma unroll 1
    for (int r = 0; r < 4; ++r) {
        const int h = g * 4 + r;
        float q[64];
        load_q64_bf(q, HB + rowt + C_QA + h * 64);
        float m = -1e30f, l = 0.f, o = 0.f;
        for (unsigned mm = mask; mm; mm &= mm - 1) {
            const int j = __builtin_ctz(mm);
            const int kpos = j * 64 + lane;
            attn_block(q, HB + (size_t)(b * S_ + kpos) * INC + C_KS + g * 64, HB + (size_t)(b * S_ + j * 64) * INC + C_VS + g * 64 + lane,
                       kpos <= s, m, l, o);
        }
        const float oslc = o / l;
        m = -1e30f; l = 0.f; o = 0.f;
        for (int j = wlo >> 6; j <= cur; ++j) {
            const int kpos = j * 64 + lane;
            attn_block(q, HB + (size_t)(b * S_ + kpos) * INC + C_KW + g * 64, HB + (size_t)(b * S_ + j * 64) * INC + C_VW + g * 64 + lane,
                       (kpos <= s) && (kpos >= wlo), m, l, o);
        }
        const float owin = o / l;
        const float oc = r == 0 ? ocmp0 : (r == 1 ? ocmp1 : (r == 2 ? ocmp2 : ocmp3));
        const float g0 = sigmoidf_(bf2f(HB[rowt + C_GATE + h * 3 + 0]));
        const float g1 = sigmoidf_(bf2f(HB[rowt + C_GATE + h * 3 + 1]));
        const float g2 = sigmoidf_(bf2f(HB[rowt + C_GATE + h * 3 + 2]));
        OM[(size_t)t * 1024 + h * 64 + lane] = f2bf(g0 * oc + g1 * oslc + g2 * owin);
    }
}

DEV void hgrn_item(const P& p, int item, float* smem) {
    const int b = item >> 2, hh = item & 3;
    const int tid = threadIdx.x, dv = tid & 127, half = tid >> 7;
    const bf16_t* HB = (const bf16_t*)(p.ws + WS_HB);
    bf16_t* OM = (bf16_t*)(p.ws + WS_OM);
    float* sf = smem;
    float* sq = smem + 1024;
    float* so = smem + 2048;
    float Sreg[64];
#pragma unroll
    for (int i = 0; i < 64; ++i) Sreg[i] = 0.f;
    const int d = tid & 127;
    float lbv;
    {
        const float l0 = p.lb_logits[hh * 128 + d], l1 = p.lb_logits[512 + hh * 128 + d];
        const float mx = fmaxf(l0, l1);
        const float e0 = expf(l0 - mx), e1 = expf(l1 - mx);
        lbv = e0 / (e0 + e1);
    }
    const int wave = tid >> 6, lane = tid & 63;
    const float nw0 = p.hg_norm_w[hh * 128 + lane], nw1 = p.hg_norm_w[hh * 128 + lane + 64];
    for (int t0 = 0; t0 < S_; t0 += 8) {
#pragma unroll
        for (int i = 0; i < 4; ++i) {
            const int st = (tid >> 7) + 2 * i;
            const size_t tt = (size_t)b * S_ + t0 + st;
            const float fl = bf2f(HB[tt * INC + C_HF + hh * 128 + d]);
            sf[st * 128 + d] = lbv + (1.f - lbv) * sigmoidf_(fl);
            sq[st * 128 + d] = bf2f(HB[tt * INC + C_HQ + hh * 128 + d]);
        }
        float vv[8];
#pragma unroll
        for (int st = 0; st < 8; ++st) vv[st] = bf2f(HB[((size_t)b * S_ + t0 + st) * INC + C_HI + hh * 128 + dv]);
        __syncthreads();
#pragma unroll
        for (int st = 0; st < 8; ++st) {
            float oacc = 0.f;
            const float* pf = sf + st * 128 + half * 64;
            const float* pq = sq + st * 128 + half * 64;
#pragma unroll
            for (int dk = 0; dk < 64; ++dk) {
                const float f = pf[dk];
                Sreg[dk] = f * Sreg[dk] + (1.f - f) * vv[st];
                oacc += pq[dk] * Sreg[dk];
            }
            so[(st * 2 + half) * 128 + dv] = oacc;
        }
        __syncthreads();
#pragma unroll
        for (int u = 0; u < 2; ++u) {
            const int st = wave * 2 + u;
            const float o0 = so[(st * 2 + 0) * 128 + lane] + so[(st * 2 + 1) * 128 + lane];
            const float o1 = so[(st * 2 + 0) * 128 + lane + 64] + so[(st * 2 + 1) * 128 + lane + 64];
            const float ss = wsum(o0 * o0 + o1 * o1);
            const float rs = rsqrtf(ss * (1.f / 128.f) + LN_EPS);
            const size_t tt = (size_t)b * S_ + t0 + st;
            const float gg0 = bf2f(HB[tt * INC + C_HG + hh * 128 + lane]);
            const float gg1 = bf2f(HB[tt * INC + C_HG + hh * 128 + lane + 64]);
            OM[tt * 1024 + 512 + hh * 128 + lane] = f2bf(o0 * rs * nw0 * (gg0 * sigmoidf_(gg0)));
            OM[tt * 1024 + 512 + hh * 128 + lane + 64] = f2bf(o1 * rs * nw1 * (gg1 * sigmoidf_(gg1)));
        }
    }
    __syncthreads();
}

DEV void ln_item(const P& p, int t, int which, int lane) {
    float* row = p.out + (size_t)t * 1024;
    float4 v[4];
    float s = 0.f;
#pragma unroll
    for (int i = 0; i < 4; ++i) {
        v[i] = *(const float4*)(row + (i * 64 + lane) * 4);
        s += v[i].x + v[i].y + v[i].z + v[i].w;
    }
    const float mean = wsum(s) * (1.f / 1024.f);
    float ss = 0.f;
#pragma unroll
    for (int i = 0; i < 4; ++i) {
        v[i].x -= mean; v[i].y -= mean; v[i].z -= mean; v[i].w -= mean;
        ss += v[i].x * v[i].x + v[i].y * v[i].y + v[i].z * v[i].z + v[i].w * v[i].w;
    }
    const float rs = rsqrtf(wsum(ss) * (1.f / 1024.f) + LN_EPS);
#pragma unroll
    for (int i = 0; i < 4; ++i) {
        const int c = (i * 64 + lane) * 4;
        const float4 gg = *(const float4*)(p.ln_g + which * 1024 + c);
        const float4 bb = *(const float4*)(p.ln_b + which * 1024 + c);
        float4 o;
        o.x = v[i].x * rs * gg.x + bb.x; o.y = v[i].y * rs * gg.y + bb.y; o.z = v[i].z * rs * gg.z + bb.z; o.w = v[i].w * rs * gg.w + bb.w;
        *(float4*)(row + c) = o;
        uint2 u;
        u.x = (unsigned)f2bf(o.x) | ((unsigned)f2bf(o.y) << 16);
        u.y = (unsigned)f2bf(o.z) | ((unsigned)f2bf(o.w) << 16);
        *(uint2*)((bf16_t*)(p.ws + WS_XB) + (size_t)t * 1024 + c) = u;
    }
}

DEV void xattn_item(const P& p, int item) {
    const int lane = threadIdx.x & 63;
    const int hh = item & 3, t = item >> 2, b = t >> 11;
    const bf16_t* QX = (const bf16_t*)(p.ws + WS_QX);
    const bf16_t* KVM = (const bf16_t*)(p.ws + WS_KVM);
    bf16_t* OX = (bf16_t*)(p.ws + WS_OX);
    float sc[4] = {0.f, 0.f, 0.f, 0.f};
#pragma unroll 1
    for (int c = 0; c < 4; ++c) {
        float q[64];
        load_q64_bf(q, QX + (size_t)t * 1024 + hh * 256 + c * 64);
#pragma unroll
        for (int k = 0; k < 4; ++k) sc[k] += dot64_bf(q, KVM + (size_t)(b * ML_ + lane + 64 * k) * 2048 + hh * 256 + c * 64);
    }
    float mx = -1e30f;
#pragma unroll
    for (int k = 0; k < 4; ++k) { sc[k] *= 0.0625f; mx = fmaxf(mx, sc[k]); }
    mx = wmax(mx);
    float pr[4], ls = 0.f;
#pragma unroll
    for (int k = 0; k < 4; ++k) { pr[k] = expf(sc[k] - mx); ls += pr[k]; }
    ls = wsum(ls);
    const float inv = 1.f / ls;
    float o[4] = {0.f, 0.f, 0.f, 0.f};
#pragma unroll
    for (int k = 0; k < 4; ++k) {
        const bf16_t* vb = KVM + (size_t)(b * ML_ + k * 64) * 2048 + 1024 + hh * 256 + lane;
#pragma unroll 4
        for (int mm = 0; mm < 64; ++mm) {
            const float pm = __shfl(pr[k], mm);
#pragma unroll
            for (int c = 0; c < 4; ++c) o[c] += pm * bf2f(vb[(size_t)mm * 2048 + c * 64]);
        }
    }
#pragma unroll
    for (int c = 0; c < 4; ++c) OX[(size_t)t * 1024 + hh * 256 + c * 64 + lane] = f2bf(o[c] * inv);
}

DEV void wave_argmax(float v, int i, float& bv, int& bi) {
#pragma unroll
    for (int o = 32; o > 0; o >>= 1) {
        const float ov = __shfl_xor(v, o);
        const int oi = __shfl_xor(i, o);
        if (ov > v || (ov == v && oi < i)) { v = ov; i = oi; }
    }
    bv = v; bi = i;
}

DEV void peer_item(const P& p, int t) {
    const int lane = threadIdx.x & 63;
    const float* QP = (const float*)(p.ws + WS_QP);
    float* row = p.out + (size_t)t * 1024;
    float4 xr[4], oacc[4];
#pragma unroll
    for (int i = 0; i < 4; ++i) {
        xr[i] = *(const float4*)(row + (i * 64 + lane) * 4);
        oacc[i] = make_float4(0.f, 0.f, 0.f, 0.f);
    }
#pragma unroll 1
    for (int hh = 0; hh < 8; ++hh) {
        float ts1 = 0.f, ts2 = 0.f;
        int ti1 = 0, ti2 = 0;
#pragma unroll 1
        for (int c = 0; c < 2; ++c) {
            float q[64];
            {
                const float4* q4 = (const float4*)(QP + (size_t)t * 1024 + hh * 128 + c * 64);
#pragma unroll
                for (int i = 0; i < 16; ++i) { const float4 u = q4[i]; q[i * 4] = u.x; q[i * 4 + 1] = u.y; q[i * 4 + 2] = u.z; q[i * 4 + 3] = u.w; }
            }
            const float* kb = p.peer_keys + ((size_t)(hh * 2 + c) * 128) * 64;
            float a0 = dot64_f(q, kb + (size_t)lane * 64);
            float a1 = dot64_f(q, kb + (size_t)(lane + 64) * 64);
            float ts = 0.f;
            int ti = 0;
#pragma unroll 1
            for (int k = 0; k < 16; ++k) {
                float v; int i;
                if (a0 >= a1) { v = a0; i = lane; } else { v = a1; i = lane + 64; }
                float bv; int bi;
                wave_argmax(v, i, bv, bi);
                if (lane == k) { ts = bv; ti = bi; }
                if (bi == lane) a0 = -INFINITY;
                if (bi == lane + 64) a1 = -INFINITY;
            }
            if (c == 0) { ts1 = ts; ti1 = ti; } else { ts2 = ts; ti2 = ti; }
        }
        float cs[4];
        const float s1v = __shfl(ts1, lane >> 2);
#pragma unroll
        for (int u = 0; u < 4; ++u) cs[u] = s1v + __shfl(ts2, (lane & 3) * 4 + u);
        float fs = 0.f;
        int fidx = 0;
#pragma unroll 1
        for (int k = 0; k < 16; ++k) {
            float v = cs[0]; int i = lane * 4;
#pragma unroll
            for (int u = 1; u < 4; ++u) if (cs[u] > v) { v = cs[u]; i = lane * 4 + u; }
            float bv; int bi;
            wave_argmax(v, i, bv, bi);
            if (lane == k) { fs = bv; fidx = bi; }
#pragma unroll
            for (int u = 0; u < 4; ++u) if (bi == lane * 4 + u) cs[u] = -INFINITY;
        }
        const int e1i = __shfl(ti1, fidx >> 4);
        const int e2i = __shfl(ti2, fidx & 15);
        const int eid = e1i * 128 + e2i;
        const float mx = __shfl(fs, 0);
        const float w = (lane < 16) ? expf(fs - mx) : 0.f;
        const float gate = w / wsum(w);
#pragma unroll 1
        for (int k = 0; k < 16; ++k) {
            const int e = __shfl(eid, k);
            const float gt = __shfl(gate, k);
            const float* dr = p.peer_down + (size_t)e * 1024;
            const float* ur = p.peer_up + (size_t)e * 1024;
            float hd = 0.f;
#pragma unroll
            for (int i = 0; i < 4; ++i) {
                const float4 dvv = *(const float4*)(dr + (i * 64 + lane) * 4);
                hd += dvv.x * xr[i].x + dvv.y * xr[i].y + dvv.z * xr[i].z + dvv.w * xr[i].w;
            }
            hd = wsum(hd);
            const float a = 0.5f * hd * (1.f + erff(hd * 0.7071067811865476f)) * gt;
#pragma unroll
            for (int i = 0; i < 4; ++i) {
                const float4 uv = *(const float4*)(ur + (i * 64 + lane) * 4);
                oacc[i].x += a * uv.x; oacc[i].y += a * uv.y; oacc[i].z += a * uv.z; oacc[i].w += a * uv.w;
            }
        }
    }
    float s = 0.f;
    float4 v[4];
#pragma unroll
    for (int i = 0; i < 4; ++i) {
        v[i].x = ALPHA * xr[i].x + oacc[i].x; v[i].y = ALPHA * xr[i].y + oacc[i].y;
        v[i].z = ALPHA * xr[i].z + oacc[i].z; v[i].w = ALPHA * xr[i].w + oacc[i].w;
        s += v[i].x + v[i].y + v[i].z + v[i].w;
    }
    const float mean = wsum(s) * (1.f / 1024.f);
    float ss = 0.f;
#pragma unroll
    for (int i = 0; i < 4; ++i) {
        v[i].x -= mean; v[i].y -= mean; v[i].z -= mean; v[i].w -= mean;
        ss += v[i].x * v[i].x + v[i].y * v[i].y + v[i].z * v[i].z + v[i].w * v[i].w;
    }
    const float rs = rsqrtf(wsum(ss) * (1.f / 1024.f) + LN_EPS);
#pragma unroll
    for (int i = 0; i < 4; ++i) {
        const int c = (i * 64 + lane) * 4;
        const float4 gg = *(const float4*)(p.ln_g + 2 * 1024 + c);
        const float4 bb = *(const float4*)(p.ln_b + 2 * 1024 + c);
        float4 o;
        o.x = v[i].x * rs * gg.x + bb.x; o.y = v[i].y * rs * gg.y + bb.y; o.z = v[i].z * rs * gg.z + bb.z; o.w = v[i].w * rs * gg.w + bb.w;
        *(float4*)(row + c) = o;
    }
}


DEV void compress_item2(const P& p, int item, unsigned char* lds) {
    const int nt8 = item & 7, g = (item >> 3) & 1, b = (item >> 4) & 7, kind = item >> 7;
    const int tid = threadIdx.x, lane = tid & 63, wid = tid >> 6, fr = lane & 15, fq = lane >> 4;
    const bf16_t* HB = (const bf16_t*)(p.ws + WS_HB);
    const bf16_t* W1T = (const bf16_t*)(p.ws + WS_W1T) + (size_t)kind * 128 * 2048;
    const bf16_t* W2T = (const bf16_t*)(p.ws + WS_W2T) + (size_t)kind * 64 * 128;
    const float* posb = p.cmp_pos + (size_t)kind * 2048 + fq * 8;
    const int n0 = nt8 * 16;
    const int kcol = (kind ? C_VC : C_KC) + g * 64;
    const bf16_t* abase = HB + (size_t)(b * S_ + 16 * (n0 + fr)) * INC + kcol + fq * 8;
    const bf16_t* wbase = W1T + (size_t)fr * 2048 + fq * 8;
    f32x4 acc[8];
#pragma unroll
    for (int jt = 0; jt < 8; ++jt) acc[jt] = (f32x4){0.f, 0.f, 0.f, 0.f};
#pragma unroll 4
    for (int k2 = 0; k2 < 16; ++k2) {
        const int ks = wid * 16 + k2;
        bf16x8 af;
        {
            const u32x4 raw = *(const u32x4*)(abase + (size_t)(ks >> 1) * INC + (ks & 1) * 32);
            const float* pp = posb + (ks >> 1) * 64 + (ks & 1) * 32;
            const float4 p0 = *(const float4*)pp, p1 = *(const float4*)(pp + 4);
            u32x4 w;
            w[0] = pk_bf16(bflo(raw[0]) + p0.x, bfhi(raw[0]) + p0.y);
            w[1] = pk_bf16(bflo(raw[1]) + p0.z, bfhi(raw[1]) + p0.w);
            w[2] = pk_bf16(bflo(raw[2]) + p1.x, bfhi(raw[2]) + p1.y);
            w[3] = pk_bf16(bflo(raw[3]) + p1.z, bfhi(raw[3]) + p1.w);
            af = __builtin_bit_cast(bf16x8, w);
        }
#pragma unroll
        for (int jt = 0; jt < 8; ++jt) {
            const bf16x8 wf = *(const bf16x8*)(wbase + (size_t)jt * 16 * 2048 + ks * 32);
            acc[jt] = __builtin_amdgcn_mfma_f32_16x16x32_bf16(wf, af, acc[jt], 0, 0, 0);
        }
    }
    float* PS = (float*)lds;
    bf16_t* HS = (bf16_t*)(lds + 4 * 16 * 132 * 4);
#pragma unroll
    for (int jt = 0; jt < 8; ++jt)
        *(float4*)(PS + (wid * 16 + fr) * 132 + jt * 16 + fq * 4) = make_float4(acc[jt][0], acc[jt][1], acc[jt][2], acc[jt][3]);
    __syncthreads();
    {
        const int r = tid >> 4, jb = (tid & 15) * 8;
        float hv[8];
#pragma unroll
        for (int h2 = 0; h2 < 2; ++h2) {
            float4 s = make_float4(0.f, 0.f, 0.f, 0.f);
#pragma unroll
            for (int w = 0; w < 4; ++w) {
                const float4 v = *(const float4*)(PS + (w * 16 + r) * 132 + jb + h2 * 4);
                s.x += v.x; s.y += v.y; s.z += v.z; s.w += v.w;
            }
            hv[h2 * 4 + 0] = s.x; hv[h2 * 4 + 1] = s.y; hv[h2 * 4 + 2] = s.z; hv[h2 * 4 + 3] = s.w;
        }
#pragma unroll
        for (int i = 0; i < 8; ++i) {
            const float v = hv[i];
            const float u = 0.7978845608028654f * (v + 0.044715f * v * v * v);
            hv[i] = 0.5f * v * (1.f + tanhf(u));
        }
        u32x4 w;
        w[0] = pk_bf16(hv[0], hv[1]); w[1] = pk_bf16(hv[2], hv[3]); w[2] = pk_bf16(hv[4], hv[5]); w[3] = pk_bf16(hv[6], hv[7]);
        *(u32x4*)(HS + r * 136 + jb) = w;
    }
    __syncthreads();
    f32x4 o = (f32x4){0.f, 0.f, 0.f, 0.f};
#pragma unroll
    for (int ks = 0; ks < 4; ++ks) {
        const bf16x8 hf = *(const bf16x8*)(HS + fr * 136 + ks * 32 + fq * 8);
        const bf16x8 wf = *(const bf16x8*)(W2T + (size_t)(wid * 16 + fr) * 128 + ks * 32 + fq * 8);
        if (kind == 0) o = __builtin_amdgcn_mfma_f32_16x16x32_bf16(wf, hf, o, 0, 0, 0);
        else o = __builtin_amdgcn_mfma_f32_16x16x32_bf16(hf, wf, o, 0, 0, 0);
    }
    if (kind == 0) {
        const int n = n0 + fr, e = wid * 16 + fq * 4;
        uint2 u2;
        u2.x = pk_bf16(o[0], o[1]);
        u2.y = pk_bf16(o[2], o[3]);
        if (n == 127) u2 = make_uint2(0u, 0u);
        *(uint2*)((bf16_t*)(p.ws + WS_KCB) + ((size_t)(b * 2 + g) * 128 + n) * 64 + e) = u2;
    } else {
        const int e = wid * 16 + fr, n = n0 + fq * 4;
        const float o3 = (n + 3 == 127) ? 0.f : o[3];
        uint2 u2;
        u2.x = pk_bf16(o[0], o[1]);
        u2.y = pk_bf16(o[2], o3);
        *(uint2*)((bf16_t*)(p.ws + WS_VCT) + ((size_t)(b * 2 + g) * 64 + e) * 128 + n) = u2;
    }
    __syncthreads();
}

constexpr int NSA_IMP = 32768;
constexpr int NSA_SCORE = 49152;
constexpr int NSA_SELM = NSA_SCORE + 4224;

struct NsaTileRegs { u32x4 k[2], v[2]; };
DEV void nsa_load_tile(NsaTileRegs& r, const bf16_t* kbase, size_t kstride, const bf16_t* vbase, size_t vstride, int tid) {
    const int lc = tid & 7, lr = tid >> 3;
#pragma unroll
    for (int i = 0; i < 2; ++i) {
        r.k[i] = *(const u32x4*)(kbase + (size_t)(lr + 32 * i) * kstride + lc * 8);
        r.v[i] = *(const u32x4*)(vbase + (size_t)(lr + 32 * i) * vstride + lc * 8);
    }
}
DEV void nsa_store_tile(const NsaTileRegs& r, unsigned char* stage, int tid) {
    const int lc = tid & 7, lr = tid >> 3;
    const int woff = lr * 128 + ((lc ^ ((lr >> 1) & 7)) << 4);
#pragma unroll
    for (int i = 0; i < 2; ++i) {
        *(u32x4*)(stage + woff + i * 4096) = r.k[i];
        *(u32x4*)(stage + 8192 + woff + i * 4096) = r.v[i];
    }
}
DEV void nsa_dma_tile(const bf16_t* kbase, size_t kstride, const bf16_t* vbase, size_t vstride, unsigned char* stage, int lane, int wid) {
#pragma unroll
    for (int i = 0; i < 2; ++i) {
        const int pc = wid * 2 + i;
        const int r = pc * 8 + (lane >> 3);
        const int c = (lane & 7) ^ ((r >> 1) & 7);
        __builtin_amdgcn_global_load_lds((const unsigned*)(kbase + (size_t)r * kstride + c * 8), (unsigned*)(stage + pc * 1024), 16, 0, 0);
        __builtin_amdgcn_global_load_lds((const unsigned*)(vbase + (size_t)r * vstride + c * 8), (unsigned*)(stage + 8192 + pc * 1024), 16, 0, 0);
    }
}
DEV void nsa_scores(const unsigned char* stage, const bf16x8 (&qf)[2][2], f32x4 (&sc)[4][2], int fr, int fq) {
    const int sw = (fr >> 1) & 7;
    const int c0 = (fq ^ sw) << 4;
    const unsigned char* rowp = stage + fr * 128;
    const unsigned char* p0 = rowp + c0;
    const unsigned char* p1 = rowp + (c0 ^ 64);
#pragma unroll
    for (int kt = 0; kt < 4; ++kt) {
        const bf16x8 k0 = *(const bf16x8*)(p0 + kt * 2048);
        const bf16x8 k1 = *(const bf16x8*)(p1 + kt * 2048);
#pragma unroll
        for (int qt = 0; qt < 2; ++qt) {
            f32x4 a = (f32x4){0.f, 0.f, 0.f, 0.f};
            a = __builtin_amdgcn_mfma_f32_16x16x32_bf16(k0, qf[qt][0], a, 0, 0, 0);
            a = __builtin_amdgcn_mfma_f32_16x16x32_bf16(k1, qf[qt][1], a, 0, 0, 0);
            sc[kt][qt] = a;
        }
    }
}
DEV void nsa_pv(const unsigned char* stage, const f32x4 (&sc)[4][2], f32x4 (&o)[4][2], int fr, int fq) {
    const int sw = (fr >> 1) & 7;
    const int v0 = (((fq >> 1) ^ sw) << 4) + 8 * (fq & 1);
    const unsigned char* rowp = stage + 8192 + fr * 128;
#pragma unroll
    for (int s = 0; s < 2; ++s) {
        u32x4 pf[2];
#pragma unroll
        for (int qt = 0; qt < 2; ++qt) {
            pf[qt][0] = pk_bf16(sc[2 * s][qt][0], sc[2 * s][qt][1]);
            pf[qt][1] = pk_bf16(sc[2 * s][qt][2], sc[2 * s][qt][3]);
            pf[qt][2] = pk_bf16(sc[2 * s + 1][qt][0], sc[2 * s + 1][qt][1]);
            pf[qt][3] = pk_bf16(sc[2 * s + 1][qt][2], sc[2 * s + 1][qt][3]);
        }
        const unsigned char* plo = rowp + (v0 ^ (64 * s));
        const unsigned char* phi = rowp + (v0 ^ (64 * s) ^ 32);
#pragma unroll
        for (int dt = 0; dt < 4; ++dt) {
            const uint2 lo = *(const uint2*)(plo + dt * 2048);
            const uint2 hi = *(const uint2*)(phi + dt * 2048);
            u32x4 vv;
            vv[0] = lo.x; vv[1] = lo.y; vv[2] = hi.x; vv[3] = hi.y;
            const bf16x8 vf = __builtin_bit_cast(bf16x8, vv);
#pragma unroll
            for (int qt = 0; qt < 2; ++qt)
                o[dt][qt] = __builtin_amdgcn_mfma_f32_16x16x32_bf16(vf, __builtin_bit_cast(bf16x8, pf[qt]), o[dt][qt], 0, 0, 0);
        }
    }
}
DEV float xmax4(float v) { v = fmaxf(v, __shfl_xor(v, 16)); return fmaxf(v, __shfl_xor(v, 32)); }
DEV float xsum4(float v) { v += __shfl_xor(v, 16); return v + __shfl_xor(v, 32); }

DEV void nsa_branch(const int mode, const int BR, const int q0v, const unsigned char* wsb, unsigned char* lds, int b, int g, unsigned blocks, const bf16x8 (&qf)[2][2], const int (&qpos)[2],
                    const unsigned (&selm)[2], const float (&gate)[2], f32x4 (&fin)[4][2], int tid) {
    asm volatile("" : "+v"(tid));
    const int fr = tid & 15, fq = (tid >> 4) & 3;
    const bf16_t* HB = (const bf16_t*)(wsb + WS_HB);
    const bf16_t* VT = (const bf16_t*)(wsb + WS_VT);
    const bf16_t* kb0 = HB + (size_t)(b * S_) * INC + (BR == 0 ? C_KS : C_KW) + g * 64;
    const bf16_t* vb0 = VT + ((((size_t)BR * B_ + b) * 2 + g) * 64) * 2048;
    const bool fake = mode == 1;
    float m[2] = {-1e30f, -1e30f}, l[2] = {0.f, 0.f};
    f32x4 o[4][2];
#pragma unroll
    for (int dt = 0; dt < 4; ++dt)
#pragma unroll
        for (int qt = 0; qt < 2; ++qt) o[dt][qt] = (f32x4){0.f, 0.f, 0.f, 0.f};
    const int lane64 = tid & 63, widx = __builtin_amdgcn_readfirstlane(tid >> 6);
    int kb = __builtin_ctz(blocks);
    blocks &= blocks - 1;
    int kb1 = blocks ? __builtin_ctz(blocks) : -1;
    if (kb1 >= 0) blocks &= blocks - 1;
    nsa_dma_tile(kb0 + (size_t)(fake ? 0 : kb) * 64 * INC, INC, vb0 + (fake ? 0 : kb) * 64, 2048, lds, lane64, widx);
    if (kb1 >= 0) nsa_dma_tile(kb0 + (size_t)(fake ? 0 : kb1) * 64 * INC, INC, vb0 + (fake ? 0 : kb1) * 64, 2048, lds + 16384, lane64, widx);
    int slot = 0;
    while (true) {
        if (kb1 >= 0) asm volatile("s_waitcnt vmcnt(4)\n\ts_waitcnt lgkmcnt(0)" ::: "memory");
        else asm volatile("s_waitcnt vmcnt(0)\n\ts_waitcnt lgkmcnt(0)" ::: "memory");
        __builtin_amdgcn_s_barrier(); asm volatile("" ::: "memory");
        const int kb2 = blocks ? __builtin_ctz(blocks) : -1;
        if (kb2 >= 0) {
            blocks &= blocks - 1;
            const int s2 = slot >= 1 ? slot - 1 : 2;
            nsa_dma_tile(kb0 + (size_t)(fake ? 0 : kb2) * 64 * INC, INC, vb0 + (fake ? 0 : kb2) * 64, 2048, lds + s2 * 16384, lane64, widx);
        }
        const unsigned char* stage = lds + slot * 16384;
        f32x4 sc[4][2];
        nsa_scores(stage, qf, sc, fr, fq);
        constexpr float C1 = 0.125f * 1.4426950408889634f;
        const bool need_mask = (BR == 0) ? (kb == (q0v >> 6)) : !((kb * 64 + 63 <= q0v) && (kb * 64 + 511 >= q0v + 31));
        float alpha[2];
        if (!need_mask) {
#pragma unroll
            for (int qt = 0; qt < 2; ++qt) {
                const bool sel = BR == 0 ? ((selm[qt] >> kb) & 1u) != 0u : true;
                float bm = -1e30f;
#pragma unroll
                for (int kt = 0; kt < 4; ++kt)
#pragma unroll
                    for (int i = 0; i < 4; ++i) {
                        const float s = sel ? sc[kt][qt][i] * C1 : -1e30f;
                        sc[kt][qt][i] = s;
                        bm = fmaxf(bm, s);
                    }
                bm = xmax4(bm);
                const float mn = fmaxf(m[qt], bm);
                alpha[qt] = __builtin_amdgcn_exp2f(m[qt] - mn);
                float ps = 0.f;
#pragma unroll
                for (int kt = 0; kt < 4; ++kt)
#pragma unroll
                    for (int i = 0; i < 4; ++i) {
                        const float s = sc[kt][qt][i];
                        const float e = (s > -1e29f) ? __builtin_amdgcn_exp2f(s - mn) : 0.f;
                        sc[kt][qt][i] = e;
                        ps += e;
                    }
                l[qt] = l[qt] * alpha[qt] + ps;
                m[qt] = mn;
            }
        } else {
#pragma unroll
            for (int qt = 0; qt < 2; ++qt) {
                const bool sel = BR == 0 ? ((selm[qt] >> kb) & 1u) != 0u : true;
                float bm = -1e30f;
#pragma unroll
                for (int kt = 0; kt < 4; ++kt)
#pragma unroll
                    for (int i = 0; i < 4; ++i) {
                        const int key = kb * 64 + kt * 16 + fq * 4 + i;
                        bool valid = sel && (key <= qpos[qt]);
                        if (BR == 1) valid = valid && (key + 511 >= qpos[qt]);
                        const float s = valid ? sc[kt][qt][i] * C1 : -1e30f;
                        sc[kt][qt][i] = s;
                        bm = fmaxf(bm, s);
                    }
                bm = xmax4(bm);
                const float mn = fmaxf(m[qt], bm);
                alpha[qt] = __builtin_amdgcn_exp2f(m[qt] - mn);
                float ps = 0.f;
#pragma unroll
                for (int kt = 0; kt < 4; ++kt)
#pragma unroll
                    for (int i = 0; i < 4; ++i) {
                        const float s = sc[kt][qt][i];
                        const float e = (s > -1e29f) ? __builtin_amdgcn_exp2f(s - mn) : 0.f;
                        sc[kt][qt][i] = e;
                        ps += e;
                    }
                l[qt] = l[qt] * alpha[qt] + ps;
                m[qt] = mn;
            }
        }
        {
#pragma unroll
            for (int qt = 0; qt < 2; ++qt)
#pragma unroll
                for (int dt = 0; dt < 4; ++dt) o[dt][qt] *= alpha[qt];
        }
        if (mode != 3) nsa_pv(stage, sc, o, fr, fq);
        else { asm volatile("" :: "v"(sc[0][0][0]), "v"(sc[1][1][1]), "v"(sc[2][0][2]), "v"(sc[3][1][3])); }
        if (kb1 < 0) break;
        kb = kb1;
        kb1 = kb2;
        slot = slot == 2 ? 0 : slot + 1;
    }
#pragma unroll
    for (int qt = 0; qt < 2; ++qt) {
        const float lt = xsum4(l[qt]);
        const float sc2 = lt > 0.f ? gate[qt] / lt : 0.f;
#pragma unroll
        for (int dt = 0; dt < 4; ++dt) fin[dt][qt] += o[dt][qt] * sc2;
    }
    asm volatile("s_waitcnt lgkmcnt(0)" ::: "memory");
    __builtin_amdgcn_s_barrier(); asm volatile("" ::: "memory");
}

DEV void nsa_item2(const P& p, int b, int g, int qblk, unsigned char* lds, int fake = 0) {
    int tid = threadIdx.x;
    asm volatile("" : "+v"(tid));
    const int lane = tid & 63, wid = tid >> 6, fr = lane & 15, fq = lane >> 4;
    const int q0 = qblk * 32, cur = q0 >> 6, h = g * 4 + wid;
    unsigned char* wsb = p.ws;
    asm volatile("" : "+s"(wsb));
    const bf16_t* HB = (const bf16_t*)(wsb + WS_HB);
    float* IMPW = (float*)(lds + NSA_IMP);
    float* SCORE = (float*)(lds + NSA_SCORE);
    unsigned* SELM = (unsigned*)(lds + NSA_SELM);
    bf16x8 qf[2][2];
    int qpos[2];
#pragma unroll
    for (int qt = 0; qt < 2; ++qt) {
        qpos[qt] = q0 + qt * 16 + fr;
        const bf16_t* rowp = HB + (size_t)(b * S_ + qpos[qt]) * INC;
#pragma unroll
        for (int ks = 0; ks < 2; ++ks) qf[qt][ks] = *(const bf16x8*)(rowp + C_QA + h * 64 + ks * 32 + fq * 8);
    }
    if (tid < 33) SELM[tid] = 0u;
    f32x4 fin[4][2];
#pragma unroll
    for (int dt = 0; dt < 4; ++dt)
#pragma unroll
        for (int qt = 0; qt < 2; ++qt) fin[dt][qt] = (f32x4){0.f, 0.f, 0.f, 0.f};
    {
        const bf16_t* KCB = (const bf16_t*)(wsb + WS_KCB) + (size_t)(b * 2 + g) * 128 * 64;
        const bf16_t* VCT = (const bf16_t*)(wsb + WS_VCT) + (size_t)(b * 2 + g) * 64 * 128;
        {
            const int widx = __builtin_amdgcn_readfirstlane(wid);
            nsa_dma_tile(KCB, 64, VCT, 128, lds, lane, widx);
            nsa_dma_tile(KCB + 64 * 64, 64, VCT + 64, 128, lds + 16384, lane, widx);
            asm volatile("s_waitcnt vmcnt(0)" ::: "memory");
        }
        __syncthreads();
        int nv[2];
        float mx[2] = {-1e30f, -1e30f}, inv[2];
#pragma unroll
        for (int qt = 0; qt < 2; ++qt) nv[qt] = qpos[qt] >= 31 ? (((qpos[qt] - 31) >> 4) + 1) : 0;
#pragma unroll 1
        for (int kb = 0; kb < 2; ++kb) {
            f32x4 sc[4][2];
            nsa_scores(lds + kb * 16384, qf, sc, fr, fq);
#pragma unroll
            for (int qt = 0; qt < 2; ++qt)
#pragma unroll
                for (int kt = 0; kt < 4; ++kt)
#pragma unroll
                    for (int i = 0; i < 4; ++i) {
                        const int n = kb * 64 + kt * 16 + fq * 4 + i;
                        mx[qt] = fmaxf(mx[qt], (n < nv[qt]) ? sc[kt][qt][i] * 0.125f : -1e30f);
                    }
        }
        float ps[2] = {0.f, 0.f};
#pragma unroll
        for (int qt = 0; qt < 2; ++qt) mx[qt] = xmax4(mx[qt]);
#pragma unroll 1
        for (int kb = 0; kb < 2; ++kb) {
            f32x4 sc[4][2];
            nsa_scores(lds + kb * 16384, qf, sc, fr, fq);
#pragma unroll
            for (int qt = 0; qt < 2; ++qt)
#pragma unroll
                for (int kt = 0; kt < 4; ++kt)
#pragma unroll
                    for (int i = 0; i < 4; ++i) {
                        const int n = kb * 64 + kt * 16 + fq * 4 + i;
                        ps[qt] += (n < nv[qt]) ? __expf(sc[kt][qt][i] * 0.125f - mx[qt]) : 0.f;
                    }
        }
#pragma unroll
        for (int qt = 0; qt < 2; ++qt) {
            ps[qt] = xsum4(ps[qt]);
            inv[qt] = ps[qt] > 0.f ? 1.f / ps[qt] : 0.f;
        }
        float prev3[2] = {0.f, 0.f};
#pragma unroll 1
        for (int kb = 0; kb < 2; ++kb) {
            f32x4 sc[4][2];
            nsa_scores(lds + kb * 16384, qf, sc, fr, fq);
#pragma unroll
            for (int qt = 0; qt < 2; ++qt) {
                float* impw = IMPW + (wid * 32 + qt * 16 + fr) * 32 + kb * 16 + fq;
#pragma unroll
                for (int kt = 0; kt < 4; ++kt) {
                    f32x4 pv;
#pragma unroll
                    for (int i = 0; i < 4; ++i) {
                        const int n = kb * 64 + kt * 16 + fq * 4 + i;
                        pv[i] = (n < nv[qt]) ? __expf(sc[kt][qt][i] * 0.125f - mx[qt]) * inv[qt] : 0.f;
                    }
                    sc[kt][qt] = pv;
                    const float c1 = __shfl_up(pv[3], 16);
                    const float c0 = __shfl(prev3[qt], fr + 48);
                    impw[kt * 4] = pv[0] + pv[1] + pv[2] + pv[3] + (fq > 0 ? c1 : c0);
                    prev3[qt] = pv[3];
                }
            }
            nsa_pv(lds + kb * 16384, sc, fin, fr, fq);
        }
#pragma unroll
        for (int qt = 0; qt < 2; ++qt) {
            const float gc = fsigmoid(bf2f(HB[(size_t)(b * S_ + qpos[qt]) * INC + C_GATE + h * 3 + 0]));
#pragma unroll
            for (int dt = 0; dt < 4; ++dt) fin[dt][qt] *= gc;
        }
    }
    __syncthreads();
    {
        const int q = tid >> 3, jg = tid & 7;
#pragma unroll
        for (int u = 0; u < 4; ++u) {
            const int j = jg * 4 + u;
            const float imp = IMPW[(0 * 32 + q) * 32 + j] + IMPW[(1 * 32 + q) * 32 + j] + IMPW[(2 * 32 + q) * 32 + j] + IMPW[(3 * 32 + q) * 32 + j];
            float score;
            if (j > cur) score = -INFINITY;
            else if (j == 0 || j == cur || j == cur - 1) score = 1e4f;
            else score = imp;
            SCORE[q * 33 + j] = score;
        }
        __syncthreads();
        unsigned bits = 0u;
#pragma unroll
        for (int u = 0; u < 4; ++u) {
            const int j = jg * 4 + u;
            const float sj = SCORE[q * 33 + j];
            int rank = 0;
#pragma unroll 8
            for (int i = 0; i < 32; ++i) {
                const float si = SCORE[q * 33 + i];
                rank += ((si > sj) || (si == sj && i < j)) ? 1 : 0;
            }
            if (j <= cur && rank < 16) bits |= 1u << j;
        }
        atomicOr(&SELM[q], bits);
        atomicOr(&SELM[32], bits);
        __syncthreads();
    }
    unsigned selm[2];
    selm[0] = SELM[fr];
    selm[1] = SELM[16 + fr];
    const unsigned um = SELM[32];
    __syncthreads();
#pragma unroll 1
    for (int br = 0; br < 2; ++br) {
        const int wlo = (q0 - 511) > 0 ? ((q0 - 511) >> 6) : 0;
        const unsigned wmask = ((2u << cur) - 1u) & ~((1u << wlo) - 1u);
        float gs[2];
#pragma unroll
        for (int qt = 0; qt < 2; ++qt) gs[qt] = fsigmoid(bf2f(HB[(size_t)(b * S_ + qpos[qt]) * INC + C_GATE + h * 3 + 1 + br]));
        if (fake != 2) nsa_branch(fake, br, q0, wsb, lds, b, g, br ? wmask : um, qf, qpos, selm, gs, fin, tid);
    }
    bf16_t* OM = (bf16_t*)(wsb + WS_OM);
#pragma unroll
    for (int qt = 0; qt < 2; ++qt)
#pragma unroll
        for (int dt = 0; dt < 4; ++dt) {
            uint2 u2;
            u2.x = pk_bf16(fin[dt][qt][0], fin[dt][qt][1]);
            u2.y = pk_bf16(fin[dt][qt][2], fin[dt][qt][3]);
            *(uint2*)(OM + (size_t)(b * S_ + qpos[qt]) * 1024 + h * 64 + dt * 16 + fq * 4) = u2;
        }
}

DEV void hgrn_prep_item(const P& p, int item, float* smem) {
    const int c = item & 31, bh = item >> 5, hh = bh & 3, b = bh >> 2;
    const int tid = threadIdx.x, d = tid & 127, th = tid >> 7;
    const bf16_t* HB = (const bf16_t*)(p.ws + WS_HB);
    unsigned char* hs = (unsigned char*)p.out;
    bf16_t* QT = (bf16_t*)(hs + HS_QT);
    bf16_t* KT = (bf16_t*)(hs + HS_KT);
    bf16_t* KHT = (bf16_t*)(hs + HS_KHT);
    bf16_t* VIT = (bf16_t*)(hs + HS_VIT);
    float lbv;
    {
        const float l0 = p.lb_logits[hh * 128 + d], l1 = p.lb_logits[512 + hh * 128 + d];
        const float mx = fmaxf(l0, l1);
        const float e0 = expf(l0 - mx), e1 = expf(l1 - mx);
        lbv = e0 / (e0 + e1);
    }
    const size_t trow0 = (size_t)b * S_ + c * 64 + th * 32;
    float kk[32], bl[32];
    float run = 0.f;
#pragma unroll
    for (int i = 0; i < 32; ++i) {
        const float fl = bf2f(HB[(trow0 + i) * INC + C_HF + hh * 128 + d]);
        const float f = lbv + (1.f - lbv) * fsigmoid(fl);
        kk[i] = 1.f - f;
        run += __logf(f);
        bl[i] = run;
    }
    smem[th * 128 + d] = run;
    __syncthreads();
    const float off = th ? smem[d] : 0.f;
    const float blast = smem[d] + smem[128 + d];
    unsigned kh[16], vi[16];
#pragma unroll
    for (int i = 0; i < 32; i += 2) {
        float qv[2], kt[2], khv[2], vv[2];
#pragma unroll
        for (int u = 0; u < 2; ++u) {
            const float bb = bl[i + u] + off;
            const size_t tr = trow0 + i + u;
            const float q = bf2f(HB[tr * INC + C_HQ + hh * 128 + d]);
            vv[u] = bf2f(HB[tr * INC + C_HI + hh * 128 + d]);
            qv[u] = q * __expf(bb);
            kt[u] = kk[i + u] * __expf(fminf(-bb, 80.f));
            khv[u] = kk[i + u] * __expf(blast - bb);
            const size_t o = ((size_t)bh * 2048 + c * 64 + th * 32 + i + u) * 128 + d;
            QT[o] = f2bf(qv[u]);
            KT[o] = f2bf(kt[u]);
        }
        kh[i >> 1] = pk_bf16(khv[0], khv[1]);
        vi[i >> 1] = pk_bf16(vv[0], vv[1]);
    }
    {
        const size_t o = ((size_t)bh * 128 + d) * 2048 + c * 64 + th * 32;
#pragma unroll
        for (int j = 0; j < 4; ++j) {
            u32x4 a, bq;
            a[0] = kh[4 * j]; a[1] = kh[4 * j + 1]; a[2] = kh[4 * j + 2]; a[3] = kh[4 * j + 3];
            bq[0] = vi[4 * j]; bq[1] = vi[4 * j + 1]; bq[2] = vi[4 * j + 2]; bq[3] = vi[4 * j + 3];
            *(u32x4*)(KHT + o + j * 8) = a;
            *(u32x4*)(VIT + o + j * 8) = bq;
        }
    }
    if (th == 0) ((float*)(p.ws + WS_EB))[((size_t)bh * 32 + c) * 128 + d] = expf(blast);
    __syncthreads();
}

DEV bf16x8 ld2x8(const bf16_t* p0, const bf16_t* p1) {
    const uint2 lo = *(const uint2*)p0, hi = *(const uint2*)p1;
    u32x4 v;
    v[0] = lo.x; v[1] = lo.y; v[2] = hi.x; v[3] = hi.y;
    return __builtin_bit_cast(bf16x8, v);
}
struct HgRegs { u32x4 a[4], b[4]; };
DEV void hg_loadA(HgRegs& r, const bf16_t* KT, const bf16_t* QT, int s0, int tid) {
    const unsigned off = (unsigned)(((tid >> 4) * 128 + (tid & 15) * 8) * 2);
    const char* kb = (const char*)(KT + (size_t)s0 * 128);
    const char* qb = (const char*)(QT + (size_t)s0 * 128);
#pragma unroll
    for (int i = 0; i < 4; ++i) {
        r.a[i] = *(const u32x4*)(kb + i * 4096 + off);
        r.b[i] = *(const u32x4*)(qb + i * 4096 + off);
    }
}
DEV void hg_storeA(const HgRegs& r, unsigned char* lds, int tid) {
    const int c16 = tid & 15, r16 = tid >> 4;
    const int o16 = r16 * 256 + ((c16 ^ (r16 & 15)) << 4);
#pragma unroll
    for (int i = 0; i < 4; ++i) {
        *(u32x4*)(lds + o16 + i * 4096) = r.a[i];
        *(u32x4*)(lds + 16384 + o16 + i * 4096) = r.b[i];
    }
}
DEV void hg_loadB(HgRegs& r, const bf16_t* KHT, const bf16_t* VIT, int s0, int tid) {
    const unsigned off = (unsigned)(((tid >> 3) * 2048 + (tid & 7) * 8) * 2);
    const char* kb = (const char*)(KHT + s0);
    const char* vb = (const char*)(VIT + s0);
#pragma unroll
    for (int i = 0; i < 4; ++i) {
        r.a[i] = *(const u32x4*)(kb + (size_t)i * 131072 + off);
        r.b[i] = *(const u32x4*)(vb + (size_t)i * 131072 + off);
    }
}
DEV void hg_storeB(const HgRegs& r, unsigned char* lds, int tid) {
    const int c8 = tid & 7, r8 = tid >> 3;
    const int o8 = r8 * 128 + ((c8 ^ ((r8 >> 1) & 7)) << 4);
#pragma unroll
    for (int i = 0; i < 4; ++i) {
        *(u32x4*)(lds + 32768 + o8 + i * 4096) = r.a[i];
        *(u32x4*)(lds + 49152 + o8 + i * 4096) = r.b[i];
    }
}
DEV void hgrn_chain_item(const P& p, int bh, unsigned char* lds) {
    const int hh = bh & 3, b = bh >> 2;
    int tid = threadIdx.x;
    asm volatile("" : "+v"(tid));
    const int lane = tid & 63, wid = tid >> 6, fr = lane & 15, fq = lane >> 4;
    const unsigned char* hs = (const unsigned char*)p.out;
    const bf16_t* QT = (const bf16_t*)(hs + HS_QT) + (size_t)bh * 2048 * 128;
    const bf16_t* KT = (const bf16_t*)(hs + HS_KT) + (size_t)bh * 2048 * 128;
    const bf16_t* KHT = (const bf16_t*)(hs + HS_KHT) + (size_t)bh * 128 * 2048;
    const bf16_t* VIT = (const bf16_t*)(hs + HS_VIT) + (size_t)bh * 128 * 2048;
    const float* EB = (const float*)(p.ws + WS_EB) + (size_t)bh * 32 * 128;
    const bf16_t* HB = (const bf16_t*)(p.ws + WS_HB);
    bf16_t* OM = (bf16_t*)(p.ws + WS_OM);
    const unsigned char* sKT = lds;
    const unsigned char* sQT = lds + 16384;
    const unsigned char* sKH = lds + 32768;
    const unsigned char* sVI = lds + 49152;
    bf16_t* AT = (bf16_t*)lds;
    float* SS = (float*)(lds + 65536);
    f32x4 S[8][2];
#pragma unroll
    for (int i = 0; i < 8; ++i)
#pragma unroll
        for (int j = 0; j < 2; ++j) S[i][j] = (f32x4){0.f, 0.f, 0.f, 0.f};
    const int dv0 = wid * 32;
    const int sw8 = (fr >> 1) & 7;
    int b256[4];
#pragma unroll
    for (int ks = 0; ks < 4; ++ks) b256[ks] = fr * 256 + (((4 * ks + fq) ^ fr) << 4);
    int p256[4][2];
#pragma unroll
    for (int u = 0; u < 4; ++u)
#pragma unroll
        for (int h = 0; h < 2; ++h) p256[u][h] = fr * 256 + (((4 * u + 2 * h + (fq >> 1)) ^ fr) << 4) + 8 * (fq & 1);
    int b128[2];
#pragma unroll
    for (int ks = 0; ks < 2; ++ks) b128[ks] = fr * 128 + (((4 * ks + fq) ^ sw8) << 4);
    {
        HgRegs r;
        hg_loadA(r, KT, QT, 0, tid);
        hg_storeA(r, lds, tid);
        hg_loadB(r, KHT, VIT, 0, tid);
        hg_storeB(r, lds, tid);
    }
    __syncthreads();
#pragma unroll 1
    for (int c = 0; c < 32; ++c) {
        const int s0 = c * 64;
        HgRegs nx;
        if (c + 1 < 32) hg_loadA(nx, KT, QT, s0 + 64, tid);
        uint2 atp[4];
        {
            bf16x8 qf[4];
#pragma unroll
            for (int ks = 0; ks < 4; ++ks) qf[ks] = *(const bf16x8*)(sQT + wid * 4096 + b256[ks]);
#pragma unroll
            for (int st = 0; st < 4; ++st) {
                f32x4 a = (f32x4){0.f, 0.f, 0.f, 0.f};
#pragma unroll
                for (int ks = 0; ks < 4; ++ks) {
                    const bf16x8 kf = *(const bf16x8*)(sKT + st * 4096 + b256[ks]);
                    a = __builtin_amdgcn_mfma_f32_16x16x32_bf16(kf, qf[ks], a, 0, 0, 0);
                }
                const int t = wid * 16 + fr;
                float av[4];
#pragma unroll
                for (int i = 0; i < 4; ++i) av[i] = (st * 16 + fq * 4 + i <= t) ? a[i] : 0.f;
                atp[st].x = pk_bf16(av[0], av[1]);
                atp[st].y = pk_bf16(av[2], av[3]);
            }
        }
        __syncthreads();
#pragma unroll
        for (int st = 0; st < 4; ++st) *(uint2*)(AT + (wid * 16 + fr) * 72 + st * 16 + fq * 4) = atp[st];
        __syncthreads();
        f32x4 o[2][4];
#pragma unroll
        for (int i = 0; i < 2; ++i)
#pragma unroll
            for (int j = 0; j < 4; ++j) o[i][j] = (f32x4){0.f, 0.f, 0.f, 0.f};
        bf16x8 vf[2][2];
#pragma unroll
        for (int dvt = 0; dvt < 2; ++dvt)
#pragma unroll
            for (int ks = 0; ks < 2; ++ks) vf[dvt][ks] = *(const bf16x8*)(sVI + wid * 4096 + dvt * 2048 + b128[ks]);
#pragma unroll
        for (int ks = 0; ks < 2; ++ks)
#pragma unroll
            for (int tt = 0; tt < 4; ++tt) {
                const bf16x8 af = *(const bf16x8*)(AT + (tt * 16 + fr) * 72 + ks * 32 + fq * 8);
#pragma unroll
                for (int dvt = 0; dvt < 2; ++dvt) o[dvt][tt] = __builtin_amdgcn_mfma_f32_16x16x32_bf16(vf[dvt][ks], af, o[dvt][tt], 0, 0, 0);
            }
#pragma unroll
        for (int u = 0; u < 4; ++u) {
            bf16x8 sf[2];
#pragma unroll
            for (int dvt = 0; dvt < 2; ++dvt) {
                u32x4 w;
                w[0] = pk_bf16(S[2 * u][dvt][0], S[2 * u][dvt][1]);
                w[1] = pk_bf16(S[2 * u][dvt][2], S[2 * u][dvt][3]);
                w[2] = pk_bf16(S[2 * u + 1][dvt][0], S[2 * u + 1][dvt][1]);
                w[3] = pk_bf16(S[2 * u + 1][dvt][2], S[2 * u + 1][dvt][3]);
                sf[dvt] = __builtin_bit_cast(bf16x8, w);
            }
#pragma unroll
            for (int tt = 0; tt < 4; ++tt) {
                const uint2 lo = *(const uint2*)(sQT + tt * 4096 + p256[u][0]);
                const uint2 hi = *(const uint2*)(sQT + tt * 4096 + p256[u][1]);
                u32x4 w;
                w[0] = lo.x; w[1] = lo.y; w[2] = hi.x; w[3] = hi.y;
                const bf16x8 qf2 = __builtin_bit_cast(bf16x8, w);
#pragma unroll
                for (int dvt = 0; dvt < 2; ++dvt) o[dvt][tt] = __builtin_amdgcn_mfma_f32_16x16x32_bf16(sf[dvt], qf2, o[dvt][tt], 0, 0, 0);
            }
        }
        u32x4 op[4];
#pragma unroll
        for (int tt = 0; tt < 4; ++tt) {
            float ss = 0.f;
#pragma unroll
            for (int dvt = 0; dvt < 2; ++dvt)
#pragma unroll
                for (int i = 0; i < 4; ++i) ss += o[dvt][tt][i] * o[dvt][tt][i];
            ss = xsum4(ss);
            if (fq == 0) SS[wid * 64 + tt * 16 + fr] = ss;
            op[tt][0] = pk_bf16(o[0][tt][0], o[0][tt][1]);
            op[tt][1] = pk_bf16(o[0][tt][2], o[0][tt][3]);
            op[tt][2] = pk_bf16(o[1][tt][0], o[1][tt][1]);
            op[tt][3] = pk_bf16(o[1][tt][2], o[1][tt][3]);
        }
        __syncthreads();
        if (c + 1 < 32) { hg_storeA(nx, lds, tid); hg_loadB(nx, KHT, VIT, s0 + 64, tid); }
        uint2 gg[4][2];
#pragma unroll
        for (int tt = 0; tt < 4; ++tt)
#pragma unroll
            for (int dvt = 0; dvt < 2; ++dvt)
                gg[tt][dvt] = *(const uint2*)(HB + ((size_t)b * S_ + s0 + tt * 16 + fr) * INC + C_HG + hh * 128 + dv0 + dvt * 16 + fq * 4);
        {
            bf16x8 vf3[2][2];
#pragma unroll
            for (int dvt = 0; dvt < 2; ++dvt)
#pragma unroll
                for (int ks = 0; ks < 2; ++ks) vf3[dvt][ks] = *(const bf16x8*)(sVI + wid * 4096 + dvt * 2048 + b128[ks]);
#pragma unroll
            for (int dkt = 0; dkt < 8; ++dkt) {
                const float4 eb = *(const float4*)(EB + c * 128 + dkt * 16 + fq * 4);
                bf16x8 kf[2];
#pragma unroll
                for (int ks = 0; ks < 2; ++ks) kf[ks] = *(const bf16x8*)(sKH + dkt * 2048 + b128[ks]);
#pragma unroll
                for (int dvt = 0; dvt < 2; ++dvt) {
                    f32x4 a = S[dkt][dvt];
                    a[0] *= eb.x; a[1] *= eb.y; a[2] *= eb.z; a[3] *= eb.w;
                    a = __builtin_amdgcn_mfma_f32_16x16x32_bf16(kf[0], vf3[dvt][0], a, 0, 0, 0);
                    a = __builtin_amdgcn_mfma_f32_16x16x32_bf16(kf[1], vf3[dvt][1], a, 0, 0, 0);
                    S[dkt][dvt] = a;
                }
            }
        }
        __syncthreads();
        if (c + 1 < 32) hg_storeB(nx, lds, tid);
#pragma unroll
        for (int tt = 0; tt < 4; ++tt) {
            const int t = tt * 16 + fr;
            const float tot = SS[t] + SS[64 + t] + SS[128 + t] + SS[192 + t];
            const float rs = rsqrtf(tot * (1.f / 128.f) + LN_EPS);
            const size_t tg = (size_t)b * S_ + s0 + t;
#pragma unroll
            for (int dvt = 0; dvt < 2; ++dvt) {
                const int dv = dv0 + dvt * 16 + fq * 4;
                const float g0 = bflo(gg[tt][dvt].x), g1 = bfhi(gg[tt][dvt].x), g2 = bflo(gg[tt][dvt].y), g3 = bfhi(gg[tt][dvt].y);
                const float4 nwv = *(const float4*)(p.hg_norm_w + hh * 128 + dv);
                const unsigned w0 = op[tt][2 * dvt], w1 = op[tt][2 * dvt + 1];
                const float r0 = bflo(w0) * rs * nwv.x * (g0 * fsigmoid(g0));
                const float r1 = bfhi(w0) * rs * nwv.y * (g1 * fsigmoid(g1));
                const float r2 = bflo(w1) * rs * nwv.z * (g2 * fsigmoid(g2));
                const float r3 = bfhi(w1) * rs * nwv.w * (g3 * fsigmoid(g3));
                uint2 u2;
                u2.x = pk_bf16(r0, r1);
                u2.y = pk_bf16(r2, r3);
                *(uint2*)(OM + tg * 1024 + 512 + hh * 128 + dv) = u2;
            }
        }
        __syncthreads();
    }
}


DEV void hgrn_prep_item2(const P& p, int item, unsigned char* lds) {
    const int c = item & 31, bh = item >> 5, hh = bh & 3, b = bh >> 2;
    int tid = threadIdx.x;
    asm volatile("" : "+v"(tid));
    const int d = tid & 127, th = tid >> 7;
    const int lane = tid & 63, wid = tid >> 6, fr = lane & 15, fq = lane >> 4;
    const bf16_t* HB = (const bf16_t*)(p.ws + WS_HB);
    unsigned char* hs = (unsigned char*)p.out;
    bf16_t* QTg = (bf16_t*)(hs + HS_QT);
    bf16_t* OIg = (bf16_t*)(hs + HS_OI);
    uint2* DSg = (uint2*)(hs + HS_DS);
    float* tots = (float*)(lds + 65536);
    unsigned char* sKT = lds;
    unsigned char* sQT = lds + 16384;
    unsigned char* sKH = lds + 32768;
    unsigned char* sVI = lds + 49152;
    float lbv;
    {
        const float l0 = p.lb_logits[hh * 128 + d], l1 = p.lb_logits[512 + hh * 128 + d];
        const float mx = fmaxf(l0, l1);
        const float e0 = expf(l0 - mx), e1 = expf(l1 - mx);
        lbv = e0 / (e0 + e1);
    }
    const size_t trow0 = (size_t)b * S_ + c * 64 + th * 32;
    float bl[32];
    float run = 0.f;
#pragma unroll
    for (int i = 0; i < 32; ++i) {
        const float fl = bf2f(HB[(trow0 + i) * INC + C_HF + hh * 128 + d]);
        const float f = lbv + (1.f - lbv) * fsigmoid(fl);
        run += __logf(f);
        bl[i] = run;
    }
    tots[th * 128 + d] = run;
    __syncthreads();
    const float off = th ? tots[d] : 0.f;
    const float blast = tots[d] + tots[128 + d];
#pragma unroll
    for (int j = 0; j < 4; ++j) {
        u32x4 a, bq;
#pragma unroll
        for (int i2 = 0; i2 < 4; ++i2) {
            float khv[2], vv[2];
#pragma unroll
            for (int u = 0; u < 2; ++u) {
                const int i = j * 8 + i2 * 2 + u;
                const float bb = bl[i] + off;
                const float kki = 1.f - __expf(bl[i] - (i ? bl[i > 0 ? i - 1 : 0] : 0.f));
                const size_t tr = trow0 + i;
                const float q = bf2f(HB[tr * INC + C_HQ + hh * 128 + d]);
                vv[u] = bf2f(HB[tr * INC + C_HI + hh * 128 + d]);
                const bf16_t qv = f2bf(q * __expf(bb));
                const bf16_t kt = f2bf(kki * __expf(fminf(-bb, 80.f)));
                khv[u] = kki * __expf(blast - bb);
                const int t = th * 32 + i;
                QTg[((size_t)bh * 2048 + c * 64 + t) * 128 + d] = qv;
                const int off256 = t * 256 + ((((d >> 3) ^ (t & 15))) << 4) + (d & 7) * 2;
                *(bf16_t*)(sQT + off256) = qv;
                *(bf16_t*)(sKT + off256) = kt;
            }
            a[i2] = pk_bf16(khv[0], khv[1]);
            bq[i2] = pk_bf16(vv[0], vv[1]);
        }
        const int off128 = d * 128 + (((th * 4 + j) ^ ((d >> 1) & 7)) << 4);
        *(u32x4*)(sKH + off128) = a;
        *(u32x4*)(sVI + off128) = bq;
    }
    if (th == 0) ((float*)(p.ws + WS_EB))[((size_t)bh * 32 + c) * 128 + d] = __expf(blast);
    __syncthreads();
    const int sw8 = (fr >> 1) & 7;
    int b256[4];
#pragma unroll
    for (int ks = 0; ks < 4; ++ks) b256[ks] = fr * 256 + (((4 * ks + fq) ^ fr) << 4);
    int b128[2];
#pragma unroll
    for (int ks = 0; ks < 2; ++ks) b128[ks] = fr * 128 + (((4 * ks + fq) ^ sw8) << 4);
    uint2 atp[4];
    {
        bf16x8 qf[4];
#pragma unroll
        for (int ks = 0; ks < 4; ++ks) qf[ks] = *(const bf16x8*)(sQT + wid * 4096 + b256[ks]);
#pragma unroll
        for (int st = 0; st < 4; ++st) {
            f32x4 a = (f32x4){0.f, 0.f, 0.f, 0.f};
#pragma unroll
            for (int ks = 0; ks < 4; ++ks) {
                const bf16x8 kf = *(const bf16x8*)(sKT + st * 4096 + b256[ks]);
                a = __builtin_amdgcn_mfma_f32_16x16x32_bf16(kf, qf[ks], a, 0, 0, 0);
            }
            const int t = wid * 16 + fr;
            float av[4];
#pragma unroll
            for (int i = 0; i < 4; ++i) av[i] = (st * 16 + fq * 4 + i <= t) ? a[i] : 0.f;
            atp[st].x = pk_bf16(av[0], av[1]);
            atp[st].y = pk_bf16(av[2], av[3]);
        }
    }
    __syncthreads();
    bf16_t* AT = (bf16_t*)lds;
#pragma unroll
    for (int st = 0; st < 4; ++st) *(uint2*)(AT + (wid * 16 + fr) * 72 + st * 16 + fq * 4) = atp[st];
    __syncthreads();
    const int dv0 = wid * 32;
    bf16x8 vf[2][2];
#pragma unroll
    for (int dvt = 0; dvt < 2; ++dvt)
#pragma unroll
        for (int ks = 0; ks < 2; ++ks) vf[dvt][ks] = *(const bf16x8*)(sVI + wid * 4096 + dvt * 2048 + b128[ks]);
#pragma unroll
    for (int tt = 0; tt < 4; ++tt) {
        f32x4 o0 = (f32x4){0.f, 0.f, 0.f, 0.f}, o1 = (f32x4){0.f, 0.f, 0.f, 0.f};
#pragma unroll
        for (int ks = 0; ks < 2; ++ks) {
            const bf16x8 af = *(const bf16x8*)(AT + (tt * 16 + fr) * 72 + ks * 32 + fq * 8);
            o0 = __builtin_amdgcn_mfma_f32_16x16x32_bf16(vf[0][ks], af, o0, 0, 0, 0);
            o1 = __builtin_amdgcn_mfma_f32_16x16x32_bf16(vf[1][ks], af, o1, 0, 0, 0);
        }
        bf16_t* op = OIg + ((size_t)bh * 2048 + c * 64 + tt * 16 + fr) * 128 + dv0 + fq * 4;
        *(uint2*)op = make_uint2(pk_bf16(o0[0], o0[1]), pk_bf16(o0[2], o0[3]));
        *(uint2*)(op + 16) = make_uint2(pk_bf16(o1[0], o1[1]), pk_bf16(o1[2], o1[3]));
    }
    uint2* dsp = DSg + ((((size_t)bh * 32 + c) * 4 + wid) * 16) * 64 + lane;
#pragma unroll
    for (int dkt = 0; dkt < 8; ++dkt) {
        bf16x8 kf[2];
#pragma unroll
        for (int ks = 0; ks < 2; ++ks) kf[ks] = *(const bf16x8*)(sKH + dkt * 2048 + b128[ks]);
#pragma unroll
        for (int dvt = 0; dvt < 2; ++dvt) {
            f32x4 a = (f32x4){0.f, 0.f, 0.f, 0.f};
            a = __builtin_amdgcn_mfma_f32_16x16x32_bf16(kf[0], vf[dvt][0], a, 0, 0, 0);
            a = __builtin_amdgcn_mfma_f32_16x16x32_bf16(kf[1], vf[dvt][1], a, 0, 0, 0);
            dsp[(dkt * 2 + dvt) * 64] = make_uint2(pk_bf16(a[0], a[1]), pk_bf16(a[2], a[3]));
        }
    }
    __syncthreads();
}

DEV void hgrn_chain_item2(const P& p, int bh, unsigned char* lds) {
    const int hh = bh & 3, b = bh >> 2;
    int tid = threadIdx.x;
    asm volatile("" : "+v"(tid));
    const int lane = tid & 63, wid = __builtin_amdgcn_readfirstlane(tid >> 6), fr = lane & 15, fq = lane >> 4;
    const unsigned char* hs = (const unsigned char*)p.out;
    const bf16_t* QTg = (const bf16_t*)(hs + HS_QT) + (size_t)bh * 2048 * 128;
    const char* OIb = (const char*)(hs + HS_OI) + ((size_t)bh * 2048 * 128 + wid * 32) * 2;
    const unsigned oioff = (unsigned)((fr * 128 + fq * 4) * 2);
    const char* DSb = (const char*)(hs + HS_DS) + (((size_t)bh * 32 * 4 + wid) * 16 * 64) * 8;
    const unsigned dsoff = (unsigned)(lane * 8);
    const char* GGb = (const char*)((const bf16_t*)(p.ws + WS_HB) + ((size_t)b * S_) * INC + C_HG + hh * 128 + wid * 32);
    const unsigned ggoff = (unsigned)((fr * INC + fq * 4) * 2);
    const float* EB = (const float*)(p.ws + WS_EB) + (size_t)bh * 32 * 128;
    const bf16_t* HB = (const bf16_t*)(p.ws + WS_HB);
    bf16_t* OM = (bf16_t*)(p.ws + WS_OM);
    float* EBL = (float*)(lds + 16384);
    float* SS = (float*)(lds + 16896);
    const int dv0 = wid * 32;
    int p256[4][2];
#pragma unroll
    for (int u = 0; u < 4; ++u)
#pragma unroll
        for (int h = 0; h < 2; ++h) p256[u][h] = fr * 256 + (((4 * u + 2 * h + (fq >> 1)) ^ fr) << 4) + 8 * (fq & 1);
    const int c16 = tid & 15, r16 = tid >> 4;
    const int o16 = r16 * 256 + ((c16 ^ (r16 & 15)) << 4);
    const unsigned qoff = (unsigned)((r16 * 128 + c16 * 8) * 2);
    f32x4 S[2][2];
    f32x4* SL = (f32x4*)(lds + 17920) + wid * 768 + lane;
#pragma unroll
    for (int i = 0; i < 2; ++i)
#pragma unroll
        for (int j = 0; j < 2; ++j) S[i][j] = (f32x4){0.f, 0.f, 0.f, 0.f};
#pragma unroll
    for (int i = 0; i < 12; ++i) SL[i * 64] = (f32x4){0.f, 0.f, 0.f, 0.f};
    uint2 oi[4][2], dsr[8][2];
    {
        const char* qb = (const char*)QTg;
#pragma unroll
        for (int i = 0; i < 4; ++i) *(u32x4*)(lds + o16 + i * 4096) = *(const u32x4*)(qb + i * 4096 + qoff);
        if (tid < 32) *(u32x4*)(EBL + tid * 4) = *(const u32x4*)(EB + tid * 4);
#pragma unroll
        for (int tt = 0; tt < 4; ++tt)
#pragma unroll
            for (int dvt = 0; dvt < 2; ++dvt) {
                oi[tt][dvt] = *(const uint2*)(OIb + tt * 4096 + dvt * 32 + oioff);
            }
#pragma unroll
        for (int dkt = 0; dkt < 8; ++dkt)
#pragma unroll
            for (int dvt = 0; dvt < 2; ++dvt) dsr[dkt][dvt] = *(const uint2*)(DSb + (dkt * 2 + dvt) * 512 + dsoff);
    }
    __syncthreads();
#pragma unroll 1
    for (int c = 0; c < 32; ++c) {
        const int s0 = c * 64;
        const bool more = c + 1 < 32;
        f32x4 o[2][4];
#pragma unroll
        for (int tt = 0; tt < 4; ++tt)
#pragma unroll
            for (int dvt = 0; dvt < 2; ++dvt) {
                o[dvt][tt] = (f32x4){bflo(oi[tt][dvt].x), bfhi(oi[tt][dvt].x), bflo(oi[tt][dvt].y), bfhi(oi[tt][dvt].y)};
                if (more) oi[tt][dvt] = *(const uint2*)(OIb + (size_t)(s0 + 64) * 256 + tt * 4096 + dvt * 32 + oioff);
            }
        const unsigned char* sQ = lds;
#pragma unroll
        for (int u = 0; u < 4; ++u) {
            bf16x8 sf[2];
#pragma unroll
            for (int dvt = 0; dvt < 2; ++dvt) {
                const f32x4 sa = u < 1 ? S[0][dvt] : SL[((2 * u - 2) * 2 + dvt) * 64];
                const f32x4 sb = u < 1 ? S[1][dvt] : SL[((2 * u - 1) * 2 + dvt) * 64];
                u32x4 w;
                w[0] = pk_bf16(sa[0], sa[1]);
                w[1] = pk_bf16(sa[2], sa[3]);
                w[2] = pk_bf16(sb[0], sb[1]);
                w[3] = pk_bf16(sb[2], sb[3]);
                sf[dvt] = __builtin_bit_cast(bf16x8, w);
            }
#pragma unroll
            for (int tt = 0; tt < 4; ++tt) {
                const uint2 lo = *(const uint2*)(sQ + tt * 4096 + p256[u][0]);
                const uint2 hi = *(const uint2*)(sQ + tt * 4096 + p256[u][1]);
                u32x4 w;
                w[0] = lo.x; w[1] = lo.y; w[2] = hi.x; w[3] = hi.y;
                const bf16x8 qf2 = __builtin_bit_cast(bf16x8, w);
#pragma unroll
                for (int dvt = 0; dvt < 2; ++dvt) o[dvt][tt] = __builtin_amdgcn_mfma_f32_16x16x32_bf16(sf[dvt], qf2, o[dvt][tt], 0, 0, 0);
            }
        }
        u32x4 qn[4], ebn;
        if (more) {
            const char* qb = (const char*)(QTg + (size_t)(s0 + 64) * 128);
#pragma unroll
            for (int i = 0; i < 4; ++i) qn[i] = *(const u32x4*)(qb + i * 4096 + qoff);
            if (tid < 32) ebn = *(const u32x4*)(EB + (c + 1) * 128 + tid * 4);
        }
        uint2 gg[4][2];
#pragma unroll
        for (int tt = 0; tt < 4; ++tt)
#pragma unroll
            for (int dvt = 0; dvt < 2; ++dvt) gg[tt][dvt] = *(const uint2*)(GGb + (size_t)(s0 + tt * 16) * INC * 2 + dvt * 32 + ggoff);
#pragma unroll
        for (int dkt = 0; dkt < 8; ++dkt) {
            const float4 eb = *(const float4*)(EBL + dkt * 16 + fq * 4);
#pragma unroll
            for (int dvt = 0; dvt < 2; ++dvt) {
                const uint2 dd = dsr[dkt][dvt];
                f32x4 sv = dkt < 2 ? S[dkt < 2 ? dkt : 0][dvt] : SL[((dkt - 2) * 2 + dvt) * 64];
                sv[0] = fmaf(sv[0], eb.x, bflo(dd.x));
                sv[1] = fmaf(sv[1], eb.y, bfhi(dd.x));
                sv[2] = fmaf(sv[2], eb.z, bflo(dd.y));
                sv[3] = fmaf(sv[3], eb.w, bfhi(dd.y));
                if (dkt < 2) S[dkt < 2 ? dkt : 0][dvt] = sv; else SL[((dkt - 2) * 2 + dvt) * 64] = sv;
                if (more) dsr[dkt][dvt] = *(const uint2*)(DSb + (size_t)(c + 1) * 32768 + (dkt * 2 + dvt) * 512 + dsoff);
            }
        }
#pragma unroll
        for (int tt = 0; tt < 4; ++tt) {
            float ss = 0.f;
#pragma unroll
            for (int dvt = 0; dvt < 2; ++dvt)
#pragma unroll
                for (int i = 0; i < 4; ++i) ss += o[dvt][tt][i] * o[dvt][tt][i];
            ss = xsum4(ss);
            if (fq == 0) SS[wid * 64 + tt * 16 + fr] = ss;
        }
        __syncthreads();
#pragma unroll
        for (int tt = 0; tt < 4; ++tt) {
            const int t = tt * 16 + fr;
            const float tot = SS[t] + SS[64 + t] + SS[128 + t] + SS[192 + t];
            const float rs = rsqrtf(tot * (1.f / 128.f) + LN_EPS);
            const size_t tg = (size_t)b * S_ + s0 + t;
#pragma unroll
            for (int dvt = 0; dvt < 2; ++dvt) {
                const int dv = dv0 + dvt * 16 + fq * 4;
                const float g0 = bflo(gg[tt][dvt].x), g1 = bfhi(gg[tt][dvt].x), g2 = bflo(gg[tt][dvt].y), g3 = bfhi(gg[tt][dvt].y);
                const float4 nwv = *(const float4*)(p.hg_norm_w + hh * 128 + dv);
                const float r0 = o[dvt][tt][0] * rs * nwv.x * (g0 * fsigmoid(g0));
                const float r1 = o[dvt][tt][1] * rs * nwv.y * (g1 * fsigmoid(g1));
                const float r2 = o[dvt][tt][2] * rs * nwv.z * (g2 * fsigmoid(g2));
                const float r3 = o[dvt][tt][3] * rs * nwv.w * (g3 * fsigmoid(g3));
                *(uint2*)(OM + tg * 1024 + 512 + hh * 128 + dv) = make_uint2(pk_bf16(r0, r1), pk_bf16(r2, r3));
            }
        }
        if (more) {
#pragma unroll
            for (int i = 0; i < 4; ++i) *(u32x4*)(lds + o16 + i * 4096) = qn[i];
            if (tid < 32) *(u32x4*)(EBL + tid * 4) = ebn;
        }
        __syncthreads();
    }
}

DEV void xattn_item2(const P& p, int item) {
    const int qt64 = item & 31, hh = (item >> 5) & 3, b = item >> 7;
    const int lane = threadIdx.x & 63, wid = threadIdx.x >> 6, fr = lane & 15, fq = lane >> 4;
    const bf16_t* QX = (const bf16_t*)(p.ws + WS_QX);
    const bf16_t* KVM = (const bf16_t*)(p.ws + WS_KVM);
    const bf16_t* VMT = (const bf16_t*)(p.ws + WS_VMT) + (size_t)(b * 4 + hh) * 256 * 256;
    bf16_t* OX = (bf16_t*)(p.ws + WS_OX);
    const size_t tq = (size_t)b * S_ + qt64 * 64 + wid * 16 + fr;
    bf16x8 qf[8];
#pragma unroll
    for (int ks = 0; ks < 8; ++ks) qf[ks] = *(const bf16x8*)(QX + tq * 1024 + hh * 256 + ks * 32 + fq * 8);
    f32x4 sc[16];
#pragma unroll
    for (int kt = 0; kt < 16; ++kt) {
        f32x4 a = (f32x4){0.f, 0.f, 0.f, 0.f};
        const bf16_t* kp = KVM + (size_t)(b * ML_ + kt * 16 + fr) * 2048 + hh * 256 + fq * 8;
#pragma unroll
        for (int ks = 0; ks < 8; ++ks) a = __builtin_amdgcn_mfma_f32_16x16x32_bf16(*(const bf16x8*)(kp + ks * 32), qf[ks], a, 0, 0, 0);
        sc[kt] = a;
    }
    float mx = -1e30f;
#pragma unroll
    for (int kt = 0; kt < 16; ++kt)
#pragma unroll
        for (int i = 0; i < 4; ++i) { sc[kt][i] *= 0.0625f; mx = fmaxf(mx, sc[kt][i]); }
    mx = xmax4(mx);
    float ps = 0.f;
#pragma unroll
    for (int kt = 0; kt < 16; ++kt)
#pragma unroll
        for (int i = 0; i < 4; ++i) { sc[kt][i] = __expf(sc[kt][i] - mx); ps += sc[kt][i]; }
    ps = xsum4(ps);
    const float inv = 1.f / ps;
    u32x4 pf[8];
#pragma unroll
    for (int s = 0; s < 8; ++s) {
        pf[s][0] = pk_bf16(sc[2 * s][0] * inv, sc[2 * s][1] * inv);
        pf[s][1] = pk_bf16(sc[2 * s][2] * inv, sc[2 * s][3] * inv);
        pf[s][2] = pk_bf16(sc[2 * s + 1][0] * inv, sc[2 * s + 1][1] * inv);
        pf[s][3] = pk_bf16(sc[2 * s + 1][2] * inv, sc[2 * s + 1][3] * inv);
    }
#pragma unroll 1
    for (int dh = 0; dh < 2; ++dh) {
        f32x4 o[8];
#pragma unroll
        for (int dt = 0; dt < 8; ++dt) o[dt] = (f32x4){0.f, 0.f, 0.f, 0.f};
#pragma unroll
        for (int s = 0; s < 8; ++s) {
#pragma unroll
            for (int dt = 0; dt < 8; ++dt) {
                const bf16_t* vp = VMT + (size_t)(dh * 128 + dt * 16 + fr) * 256 + 32 * s + 4 * fq;
                o[dt] = __builtin_amdgcn_mfma_f32_16x16x32_bf16(ld2x8(vp, vp + 16), __builtin_bit_cast(bf16x8, pf[s]), o[dt], 0, 0, 0);
            }
        }
#pragma unroll
        for (int dt = 0; dt < 8; ++dt) {
            uint2 u2;
            u2.x = pk_bf16(o[dt][0], o[dt][1]);
            u2.y = pk_bf16(o[dt][2], o[dt][3]);
            *(uint2*)(OX + tq * 1024 + hh * 256 + dh * 128 + dt * 16 + fq * 4) = u2;
        }
    }
}


struct XaRegs { u32x4 r[8]; };
DEV void xa_loadK(XaRegs& x, const bf16_t* kbase, int tid) {
    const int c = tid & 31, r0 = tid >> 5;
#pragma unroll
    for (int i = 0; i < 8; ++i) x.r[i] = *(const u32x4*)(kbase + (size_t)(r0 + 8 * i) * 2048 + c * 8);
}
DEV void xa_storeK(const XaRegs& x, unsigned char* lds, int tid) {
    const int c = tid & 31, r0 = tid >> 5;
#pragma unroll
    for (int i = 0; i < 8; ++i) {
        const int row = r0 + 8 * i;
        *(u32x4*)(lds + row * 512 + ((c ^ (row & 15)) << 4)) = x.r[i];
    }
}
DEV void xa_loadV(XaRegs& x, const bf16_t* vbase, int tid) {
    const int c = tid & 7, r0 = tid >> 3;
#pragma unroll
    for (int i = 0; i < 8; ++i) x.r[i] = *(const u32x4*)(vbase + (size_t)(r0 + 32 * i) * 256 + c * 8);
}
DEV void xa_storeV(const XaRegs& x, unsigned char* lds, int tid) {
    const int c = tid & 7, r0 = tid >> 3;
    const int o = r0 * 128 + ((c ^ ((r0 >> 1) & 7)) << 4);
#pragma unroll
    for (int i = 0; i < 8; ++i) *(u32x4*)(lds + 32768 + o + i * 4096) = x.r[i];
}
DEV void xattn_item3(const P& p, int item, unsigned char* lds) {
    const int qt64 = item & 31, hh = (item >> 5) & 3, b = item >> 7;
    int tid = threadIdx.x;
    asm volatile("" : "+v"(tid));
    const int lane = tid & 63, wid = tid >> 6, fr = lane & 15, fq = lane >> 4;
    const bf16_t* QX = (const bf16_t*)(p.ws + WS_QX);
    const bf16_t* KB = (const bf16_t*)(p.ws + WS_KVM) + (size_t)(b * ML_) * 2048 + hh * 256;
    const bf16_t* VB = (const bf16_t*)(p.ws + WS_VMT) + (size_t)(b * 4 + hh) * 256 * 256;
    bf16_t* OX = (bf16_t*)(p.ws + WS_OX);
    const size_t tq = (size_t)b * S_ + qt64 * 64 + wid * 16 + fr;
    bf16x8 qf[8];
#pragma unroll
    for (int ks = 0; ks < 8; ++ks) qf[ks] = *(const bf16x8*)(QX + tq * 1024 + hh * 256 + ks * 32 + fq * 8);
    f32x4 o[16];
#pragma unroll
    for (int dt = 0; dt < 16; ++dt) o[dt] = (f32x4){0.f, 0.f, 0.f, 0.f};
    float m = -1e30f, l = 0.f;
    {
        XaRegs x;
        xa_loadK(x, KB, tid);
        xa_storeK(x, lds, tid);
        xa_loadV(x, VB, tid);
        xa_storeV(x, lds, tid);
    }
    __syncthreads();
    const int sw8 = (fr >> 1) & 7;
#pragma unroll 1
    for (int j = 0; j < 4; ++j) {
        XaRegs nx;
        if (j + 1 < 4) xa_loadK(nx, KB + (size_t)(j + 1) * 64 * 2048, tid);
        f32x4 sc[4];
#pragma unroll
        for (int kt = 0; kt < 4; ++kt) {
            f32x4 a = (f32x4){0.f, 0.f, 0.f, 0.f};
            const unsigned char* rp = lds + (kt * 16 + fr) * 512;
#pragma unroll
            for (int ks = 0; ks < 8; ++ks) a = __builtin_amdgcn_mfma_f32_16x16x32_bf16(*(const bf16x8*)(rp + (((4 * ks + fq) ^ fr) << 4)), qf[ks], a, 0, 0, 0);
            sc[kt] = a;
        }
        __syncthreads();
        if (j + 1 < 4) { xa_storeK(nx, lds, tid); xa_loadV(nx, VB + (j + 1) * 64, tid); }
        float bm = -1e30f;
#pragma unroll
        for (int kt = 0; kt < 4; ++kt)
#pragma unroll
            for (int i = 0; i < 4; ++i) { sc[kt][i] *= 0.0625f; bm = fmaxf(bm, sc[kt][i]); }
        bm = xmax4(bm);
        const float mn = fmaxf(m, bm);
        const float alpha = __expf(m - mn);
        float ps = 0.f;
#pragma unroll
        for (int kt = 0; kt < 4; ++kt)
#pragma unroll
            for (int i = 0; i < 4; ++i) { sc[kt][i] = __expf(sc[kt][i] - mn); ps += sc[kt][i]; }
        l = l * alpha + ps;
        m = mn;
#pragma unroll
        for (int dt = 0; dt < 16; ++dt) o[dt] *= alpha;
#pragma unroll
        for (int s = 0; s < 2; ++s) {
            u32x4 w;
            w[0] = pk_bf16(sc[2 * s][0], sc[2 * s][1]);
            w[1] = pk_bf16(sc[2 * s][2], sc[2 * s][3]);
            w[2] = pk_bf16(sc[2 * s + 1][0], sc[2 * s + 1][1]);
            w[3] = pk_bf16(sc[2 * s + 1][2], sc[2 * s + 1][3]);
            const bf16x8 pf = __builtin_bit_cast(bf16x8, w);
#pragma unroll
            for (int dt = 0; dt < 16; ++dt) {
                const unsigned char* rp = lds + 32768 + (dt * 16 + fr) * 128 + 8 * (fq & 1);
                const uint2 lo = *(const uint2*)(rp + (((4 * s + (fq >> 1)) ^ sw8) << 4));
                const uint2 hi = *(const uint2*)(rp + (((4 * s + 2 + (fq >> 1)) ^ sw8) << 4));
                u32x4 vv;
                vv[0] = lo.x; vv[1] = lo.y; vv[2] = hi.x; vv[3] = hi.y;
                o[dt] = __builtin_amdgcn_mfma_f32_16x16x32_bf16(__builtin_bit_cast(bf16x8, vv), pf, o[dt], 0, 0, 0);
            }
        }
        __syncthreads();
        if (j + 1 < 4) xa_storeV(nx, lds, tid);
        __syncthreads();
    }
    const float inv = 1.f / xsum4(l);
#pragma unroll
    for (int dt = 0; dt < 16; ++dt) {
        uint2 u2;
        u2.x = pk_bf16(o[dt][0] * inv, o[dt][1] * inv);
        u2.y = pk_bf16(o[dt][2] * inv, o[dt][3] * inv);
        *(uint2*)(OX + tq * 1024 + hh * 256 + dt * 16 + fq * 4) = u2;
    }
}


DEV void peer_quant_row(const float* src, unsigned char* dst, float* scl, int row, int* rsum = nullptr) {
    const int lane = threadIdx.x & 63;
    const float* r = src + (size_t)row * 1024 + lane * 16;
    float v[16];
#pragma unroll
    for (int i = 0; i < 4; ++i) {
        const float4 a = *(const float4*)(r + 4 * i);
        v[4 * i] = a.x; v[4 * i + 1] = a.y; v[4 * i + 2] = a.z; v[4 * i + 3] = a.w;
    }
    float mx = 0.f;
#pragma unroll
    for (int i = 0; i < 16; ++i) mx = fmaxf(mx, fabsf(v[i]));
    mx = wmax(mx);
    const float q = mx > 0.f ? 127.f / mx : 0.f;
    u32x4 w;
    int usum = 0;
#pragma unroll
    for (int i = 0; i < 4; ++i) {
        unsigned pk = 0u;
#pragma unroll
        for (int k = 0; k < 4; ++k) {
            int qi = (int)rintf(v[4 * i + k] * q);
            qi = qi < -127 ? -127 : (qi > 127 ? 127 : qi);
            pk |= (unsigned)(qi + 128) << (8 * k);
            usum += qi + 128;
        }
        w[i] = pk;
    }
    *(u32x4*)(dst + ((size_t)(lane >> 3) * 16384 + row) * 128 + (lane & 7) * 16) = w;
    if (rsum) {
#pragma unroll
        for (int o = 32; o > 0; o >>= 1) usum += __shfl_xor(usum, o);
        if (lane == 0) rsum[row] = usum;
    }
    if (lane == 0) scl[row] = mx * (1.f / 127.f);
}

DEV unsigned f2ord(float f) { const unsigned b = __float_as_uint(f); return b ^ ((b >> 31) ? 0xffffffffu : 0x80000000u); }
DEV float ord2f(unsigned o) { return __uint_as_float((o & 0x80000000u) ? (o ^ 0x80000000u) : ~o); }
DEV void ins16(unsigned (&v)[16], unsigned x) {
#pragma unroll
    for (int k = 0; k < 16; ++k) {
        const unsigned t = v[k] > x ? v[k] : x;
        x = v[k] > x ? x : v[k];
        v[k] = t;
    }
}
constexpr int PEER_SC = 0;
constexpr int PEER_LST = 0;
constexpr int PEER_EID = 16384;
constexpr int PEER_GATE = 16384 + 4096;
DEV void peer_route_item(const P& p, int item, unsigned char* lds) {
    const int tid = threadIdx.x, lane = tid & 63, wid = tid >> 6;
    const int t0 = item * 16;
    const bf16_t* QP = (const bf16_t*)(p.ws + WS_QP);
    const bf16_t* PK = (const bf16_t*)(p.ws + WS_PKEY);
    unsigned* SC = (unsigned*)(lds + PEER_SC);
    const int fr = lane & 15, fq = lane >> 4;
    unsigned lst[16];
#pragma unroll
    for (int k = 0; k < 16; ++k) lst[k] = 0u;
    bf16x8 qf[4][2];
#pragma unroll
    for (int ci = 0; ci < 4; ++ci)
#pragma unroll
        for (int ks = 0; ks < 2; ++ks)
            qf[ci][ks] = *(const bf16x8*)(QP + (size_t)(t0 + fr) * 1024 + (4 * wid + ci) * 64 + ks * 32 + fq * 8);
#pragma unroll 1
    for (int pass = 0; pass < 2; ++pass) {
#pragma unroll
        for (int ci = 0; ci < 4; ++ci) {
            const int cb = 4 * wid + ci;
#pragma unroll
            for (int kt = 0; kt < 4; ++kt) {
                f32x4 acc = (f32x4){0.f, 0.f, 0.f, 0.f};
#pragma unroll
                for (int ks = 0; ks < 2; ++ks) {
                    const bf16x8 kf = *(const bf16x8*)(PK + ((size_t)cb * 128 + pass * 64 + kt * 16 + fr) * 64 + ks * 32 + fq * 8);
                    acc = __builtin_amdgcn_mfma_f32_16x16x32_bf16(kf, qf[ci][ks], acc, 0, 0, 0);
                }
                unsigned* dst = SC + (cb * 16 + fr) * 65 + kt * 16 + fq * 4;
#pragma unroll
                for (int i = 0; i < 4; ++i) {
                    const int kidx = pass * 64 + kt * 16 + fq * 4 + i;
                    dst[i] = (f2ord(acc[i]) & ~127u) | (unsigned)(127 - kidx);
                }
            }
        }
        __syncthreads();
        {
            const unsigned* row = SC + tid * 65;
#pragma unroll 4
            for (int k = 0; k < 64; ++k) ins16(lst, row[k]);
        }
        __syncthreads();
    }
    unsigned* LST = (unsigned*)(lds + PEER_LST);
#pragma unroll
    for (int k = 0; k < 16; ++k) LST[tid * 16 + k] = lst[k];
    __syncthreads();
    unsigned short* EID = (unsigned short*)(lds + PEER_EID);
    float* GATE = (float*)(lds + PEER_GATE);
    if (((tid >> 4) & 1) == 0) {
        const int tok = tid & 15, hh = tid >> 5;
        const unsigned* l2 = LST + (tid + 16) * 16;
        float s1[16], s2[16];
#pragma unroll
        for (int k = 0; k < 16; ++k) { s1[k] = ord2f(lst[k] & ~127u); s2[k] = ord2f(l2[k] & ~127u); }
        unsigned fin[16];
#pragma unroll
        for (int k = 0; k < 16; ++k) fin[k] = 0u;
#pragma unroll
        for (int i = 0; i < 16; ++i)
#pragma unroll
            for (int j = 0; j < 16; ++j)
                if ((i + 1) * (j + 1) <= 16) ins16(fin, (f2ord(s1[i] + s2[j]) & ~255u) | (unsigned)(255 - (i * 16 + j)));
        const float mx = ord2f(fin[0] & ~255u);
        float w[16], ws = 0.f;
#pragma unroll
        for (int k = 0; k < 16; ++k) { w[k] = expf(ord2f(fin[k] & ~255u) - mx); ws += w[k]; }
        const float inv = 1.f / ws;
#pragma unroll
        for (int k = 0; k < 16; ++k) {
            const int flat = 255 - (int)(fin[k] & 255u);
            const int i1 = 127 - (int)(LST[tid * 16 + (flat >> 4)] & 127u);
            const int i2 = 127 - (int)(l2[flat & 15] & 127u);
            EID[tok * 128 + hh * 16 + k] = (unsigned short)(i1 * 128 + i2);
            GATE[tok * 128 + hh * 16 + k] = w[k] * inv;
        }
    }
    __syncthreads();
    {
        unsigned short* EIDP = (unsigned short*)(p.ws + WS_EIDP);
        float* GATEP = (float*)(p.ws + WS_GATEP);
        for (int i = tid; i < 16 * 128; i += 256) {
            const int tok = i >> 7, pi = i & 127, eg = pi >> 4, k = pi & 15, slot = 8 * k + eg;
            EIDP[(size_t)(t0 + tok) * 128 + pi] = EID[tok * 128 + slot];
            GATEP[(size_t)(t0 + tok) * 128 + pi] = GATE[tok * 128 + slot];
        }
        unsigned char* XQ = p.ws + WS_XQ;
#pragma unroll 1
        for (int tt = 0; tt < 4; ++tt) {
            const size_t t = (size_t)t0 + wid * 4 + tt;
            const float* row = p.out + t * 1024 + lane * 16;
            float xr[16];
            float amax = 0.f;
#pragma unroll
            for (int i = 0; i < 4; ++i) {
                const float4 a4 = *(const float4*)(row + 4 * i);
                xr[4 * i] = a4.x; xr[4 * i + 1] = a4.y; xr[4 * i + 2] = a4.z; xr[4 * i + 3] = a4.w;
                amax = fmaxf(amax, fmaxf(fmaxf(fabsf(a4.x), fabsf(a4.y)), fmaxf(fabsf(a4.z), fabsf(a4.w))));
            }
            amax = wmax(amax);
            const float qx = amax > 0.f ? 127.f / amax : 0.f;
            u32x4 w;
            int s_ = 0;
#pragma unroll
            for (int i = 0; i < 4; ++i) {
                unsigned pk = 0u;
#pragma unroll
                for (int k = 0; k < 4; ++k) {
                    int qi = (int)rintf(xr[4 * i + k] * qx);
                    qi = qi < -127 ? -127 : (qi > 127 ? 127 : qi);
                    pk |= (unsigned)(qi + 128) << (8 * k);
                    s_ += qi + 128;
                }
                w[i] = pk;
            }
#pragma unroll
            for (int o = 32; o > 0; o >>= 1) s_ += __shfl_xor(s_, o);
            *(u32x4*)(XQ + t * 1024 + lane * 16) = w;
            if (lane == 0) {
                ((float*)(p.ws + WS_SXF))[t] = amax * (1.f / 127.f);
                ((int*)(p.ws + WS_SXI))[t] = s_;
            }
        }
    }
    __syncthreads();
}

DEV void peer_down_item(const P& p, int s, int tile, int lane, int wid) {
    const unsigned char* PD = p.ws + WS_PD + (size_t)s * 16384 * 128;
    const unsigned short* EIDP = (const unsigned short*)(p.ws + WS_EIDP);
    int* DP = (int*)(p.ws + WS_DP) + (size_t)s * T_ * 128;
    const int eg = lane >> 3, cg = lane & 7;
#pragma unroll 1
    for (int tt = 0; tt < 4; ++tt) {
        const size_t t = (size_t)tile * 16 + wid * 4 + tt;
        const u32x4 xu = *(const u32x4*)(p.ws + WS_XQ + t * 1024 + s * 128 + cg * 16);
        const u32x4 e0 = *(const u32x4*)(EIDP + t * 128 + eg * 16);
        const u32x4 e1 = *(const u32x4*)(EIDP + t * 128 + eg * 16 + 8);
        u32x4 rows[16];
#pragma unroll
        for (int k = 0; k < 16; ++k) {
            const unsigned ew = k < 8 ? e0[k >> 1] : e1[(k - 8) >> 1];
            const unsigned e = (k & 1) ? (ew >> 16) : (ew & 0xffffu);
            rows[k] = *(const u32x4*)(PD + (size_t)e * 128 + cg * 16);
        }
        unsigned v[16];
#pragma unroll
        for (int k = 0; k < 16; ++k) {
            unsigned a_ = 0u;
#pragma unroll
            for (int q = 0; q < 4; ++q) a_ = __builtin_amdgcn_udot4(rows[k][q], xu[q], a_, false);
            v[k] = a_;
        }
        unsigned w8[8], w4[4], w2[2];
        {
            const bool hi = (cg & 4) != 0;
#pragma unroll
            for (int j = 0; j < 8; ++j) {
                const unsigned send = hi ? v[j] : v[j + 8];
                const unsigned keep = hi ? v[j + 8] : v[j];
                w8[j] = keep + (unsigned)__shfl_xor((int)send, 4);
            }
        }
        {
            const bool hi = (cg & 2) != 0;
#pragma unroll
            for (int j = 0; j < 4; ++j) {
                const unsigned send = hi ? w8[j] : w8[j + 4];
                const unsigned keep = hi ? w8[j + 4] : w8[j];
                w4[j] = keep + (unsigned)__shfl_xor((int)send, 2);
            }
        }
        {
            const bool hi = (cg & 1) != 0;
#pragma unroll
            for (int j = 0; j < 2; ++j) {
                const unsigned send = hi ? w4[j] : w4[j + 2];
                const unsigned keep = hi ? w4[j + 2] : w4[j];
                w2[j] = keep + (unsigned)__shfl_xor((int)send, 1);
            }
        }
        *(uint2*)(DP + t * 128 + eg * 16 + 2 * cg) = make_uint2(w2[0], w2[1]);
    }
}

DEV void peer_coef_item(const P& p, int t, int lane) {
    const int* DP = (const int*)(p.ws + WS_DP);
    const unsigned short* EIDP = (const unsigned short*)(p.ws + WS_EIDP);
    const float* GATEP = (const float*)(p.ws + WS_GATEP);
    const float sx = ((const float*)(p.ws + WS_SXF))[t];
    const int sxu = ((const int*)(p.ws + WS_SXI))[t];
    float cs = 0.f;
#pragma unroll
    for (int h = 0; h < 2; ++h) {
        const int pi = lane + 64 * h;
        int tot = 0;
#pragma unroll
        for (int s = 0; s < 8; ++s) tot += DP[((size_t)s * T_ + t) * 128 + pi];
        const int e = EIDP[(size_t)t * 128 + pi];
        const int dotq = tot - 128 * ((const int*)(p.ws + WS_PRS))[e] - 128 * sxu + 128 * 128 * 1024;
        const float hv = ((const float*)(p.ws + WS_PSD))[e] * sx * (float)dotq;
        const float coef = 0.5f * hv * (1.f + erff(hv * 0.7071067811865476f)) * GATEP[(size_t)t * 128 + pi] * ((const float*)(p.ws + WS_PSU))[e];
        ((float*)(p.ws + WS_COEFP))[(size_t)t * 128 + pi] = coef;
        cs += coef;
    }
    cs = wsum(cs);
    if (lane == 0) ((float*)(p.ws + WS_ASUM))[t] = cs;
}

DEV void peer_up_item(const P& p, int s, int tile, int lane, int wid, bool dostore = true) {
    const unsigned char* PU = p.ws + WS_PU + (size_t)s * 16384 * 128;
    const unsigned short* EIDP = (const unsigned short*)(p.ws + WS_EIDP);
    const float* COEFP = (const float*)(p.ws + WS_COEFP);
    const int eg = lane >> 3, cg = lane & 7;
#pragma unroll 1
    for (int tt = 0; tt < 4; ++tt) {
        const size_t t = (size_t)tile * 16 + wid * 4 + tt;
        const u32x4 e0 = *(const u32x4*)(EIDP + t * 128 + eg * 16);
        const u32x4 e1 = *(const u32x4*)(EIDP + t * 128 + eg * 16 + 8);
        float cf[16];
#pragma unroll
        for (int i = 0; i < 4; ++i) {
            const float4 c4 = *(const float4*)(COEFP + t * 128 + eg * 16 + 4 * i);
            cf[4 * i] = c4.x; cf[4 * i + 1] = c4.y; cf[4 * i + 2] = c4.z; cf[4 * i + 3] = c4.w;
        }
        u32x4 rows[16];
#pragma unroll
        for (int k = 0; k < 16; ++k) {
            const unsigned ew = k < 8 ? e0[k >> 1] : e1[(k - 8) >> 1];
            const unsigned e = (k & 1) ? (ew >> 16) : (ew & 0xffffu);
            rows[k] = *(const u32x4*)(PU + (size_t)e * 128 + cg * 16);
        }
        float acc[16];
#pragma unroll
        for (int i = 0; i < 16; ++i) acc[i] = 0.f;
#pragma unroll
        for (int k = 0; k < 16; ++k)
#pragma unroll
            for (int q = 0; q < 4; ++q) {
                const unsigned w_ = rows[k][q];
                acc[4 * q] += cf[k] * (float)(w_ & 0xffu);
                acc[4 * q + 1] += cf[k] * (float)((w_ >> 8) & 0xffu);
                acc[4 * q + 2] += cf[k] * (float)((w_ >> 16) & 0xffu);
                acc[4 * q + 3] += cf[k] * (float)(w_ >> 24);
            }
        float a8[8], a4[4], a2[2];
        {
            const bool hi = (eg & 4) != 0;
#pragma unroll
            for (int j = 0; j < 8; ++j) {
                const float send = hi ? acc[j] : acc[j + 8];
                const float keep = hi ? acc[j + 8] : acc[j];
                a8[j] = keep + __shfl_xor(send, 32);
            }
        }
        {
            const bool hi = (eg & 2) != 0;
#pragma unroll
            for (int j = 0; j < 4; ++j) {
                const float send = hi ? a8[j] : a8[j + 4];
                const float keep = hi ? a8[j + 4] : a8[j];
                a4[j] = keep + __shfl_xor(send, 16);
            }
        }
        {
            const bool hi = (eg & 1) != 0;
#pragma unroll
            for (int j = 0; j < 2; ++j) {
                const float send = hi ? a4[j] : a4[j + 2];
                const float keep = hi ? a4[j + 2] : a4[j];
                a2[j] = keep + __shfl_xor(send, 8);
            }
        }
        const float asum = ((const float*)(p.ws + WS_ASUM))[t];
        float* yp = p.out + t * 1024 + s * 128 + cg * 16 + 2 * eg;
        const float2 xv = *(const float2*)yp;
        if (dostore) *(float2*)yp = make_float2(ALPHA * xv.x + (a2[0] - 128.f * asum), ALPHA * xv.y + (a2[1] - 128.f * asum));
    }
}

DEV void ln3_item(const P& p, int t, int lane) {
    float* row = p.out + (size_t)t * 1024;
    float4 v[4];
    float s = 0.f;
#pragma unroll
    for (int i = 0; i < 4; ++i) {
        v[i] = *(const float4*)(row + (i * 64 + lane) * 4);
        s += v[i].x + v[i].y + v[i].z + v[i].w;
    }
    const float mean = wsum(s) * (1.f / 1024.f);
    float ss = 0.f;
#pragma unroll
    for (int i = 0; i < 4; ++i) {
        v[i].x -= mean; v[i].y -= mean; v[i].z -= mean; v[i].w -= mean;
        ss += v[i].x * v[i].x + v[i].y * v[i].y + v[i].z * v[i].z + v[i].w * v[i].w;
    }
    const float rs = rsqrtf(wsum(ss) * (1.f / 1024.f) + LN_EPS);
#pragma unroll
    for (int i = 0; i < 4; ++i) {
        const int c = (i * 64 + lane) * 4;
        const float4 gg = *(const float4*)(p.ln_g + 2 * 1024 + c);
        const float4 bb = *(const float4*)(p.ln_b + 2 * 1024 + c);
        float4 o;
        o.x = v[i].x * rs * gg.x + bb.x; o.y = v[i].y * rs * gg.y + bb.y; o.z = v[i].z * rs * gg.z + bb.z; o.w = v[i].w * rs * gg.w + bb.w;
        *(float4*)(row + c) = o;
    }
}

#define XB_TMO      128
#define XB_XCNT(j)  (256  + 64 * (j))
#define XB_XSUB(j)  (1280 + 64 * (j))
#define XB_XGEN(j)  (2304 + 64 * (j))
#define XB_TOP      3328
#define XB_TOPGEN   3392
#define XCD_BAR_WORDS 3456
#define XB_SPIN_CAP (1u << 20)
#define LAS __attribute__((address_space(3)))
DEV unsigned xb_ld(unsigned* p) { return __hip_atomic_load(p, __ATOMIC_RELAXED, __HIP_MEMORY_SCOPE_AGENT); }
DEV unsigned xb_add(unsigned* p, unsigned v) { return __hip_atomic_fetch_add(p, v, __ATOMIC_RELAXED, __HIP_MEMORY_SCOPE_AGENT); }
DEV unsigned xb_xcc_id() { return (unsigned)__builtin_amdgcn_s_getreg((3 << 11) | 20) & 0xFu; }
#define XB_SPIN(cond, bar) do { unsigned _sp = 0; while (cond) { __builtin_amdgcn_s_sleep(1); \
    if ((++_sp & 255u) == 0u) { if (xb_ld(&(bar)[XB_TMO])) break; if (_sp > XB_SPIN_CAP) { atomicAdd(&(bar)[XB_TMO], 1u); break; } } } } while (0)
struct XcdBarrier { unsigned* bar; unsigned x; volatile LAS unsigned* st; };
DEV XcdBarrier xcd_barrier_post(unsigned* bar, volatile LAS unsigned* st) {
    XcdBarrier b; b.bar = bar; b.x = xb_xcc_id(); b.st = st;
    if (threadIdx.x == 0) (void)xb_add(&bar[XB_XCNT(b.x)], 1u);
    return b;
}
DEV void xcd_barrier_complete(unsigned* bar, unsigned x, unsigned& nloc, unsigned& nx) {
    const unsigned G = gridDim.x * gridDim.y * gridDim.z;
    unsigned sum, cnt, mine, sp = 0u;
    for (;;) {
        sum = 0u; cnt = 0u; mine = 0u;
#pragma unroll
        for (unsigned j = 0; j < 16; ++j) { const unsigned c = xb_ld(&bar[XB_XCNT(j)]); sum += c; cnt += (c > 0u) ? 1u : 0u; mine = (j == x) ? c : mine; }
        if (sum == G) break;
        __builtin_amdgcn_s_sleep(1);
        if ((++sp & 255u) == 0u) { if (xb_ld(&bar[XB_TMO])) break; if (sp > XB_SPIN_CAP) { atomicAdd(&bar[XB_TMO], 1u); break; } }
    }
    nloc = mine > 0u ? mine : 1u; nx = cnt > 0u ? cnt : 1u;
}
DEV void xcd_barrier(const XcdBarrier& b) {
    asm volatile("s_waitcnt vmcnt(0)" ::: "memory");
    __syncthreads();
    if (threadIdx.x == 0) {
        unsigned* bar = b.bar;
        __builtin_amdgcn_s_waitcnt(0);
        unsigned nloc = b.st[0], nx = b.st[1];
        if (nloc == 0u) { xcd_barrier_complete(bar, b.x, nloc, nx); b.st[0] = nloc; b.st[1] = nx; }
        const unsigned old = xb_add(&bar[XB_XSUB(b.x)], 1u);
        const unsigned gen = old / nloc;
        if (old + 1u == (gen + 1u) * nloc) {
            __builtin_amdgcn_fence(__ATOMIC_RELEASE, "agent");
            asm volatile("s_waitcnt vmcnt(0)" ::: "memory");
            const unsigned og = xb_add(&bar[XB_TOP], 1u);
            const unsigned tg = og / nx;
            if (og + 1u == (tg + 1u) * nx) xb_add(&bar[XB_TOPGEN], 1u);
            else XB_SPIN(xb_ld(&bar[XB_TOPGEN]) == tg, bar);
            __builtin_amdgcn_fence(__ATOMIC_ACQUIRE, "agent");
            xb_add(&bar[XB_XGEN(b.x)], 1u);
            asm volatile("s_waitcnt vmcnt(0)" ::: "memory");
        } else {
            XB_SPIN(xb_ld(&bar[XB_XGEN(b.x)]) == gen, bar);
            __builtin_amdgcn_fence(__ATOMIC_ACQUIRE, "agent");
            asm volatile("s_waitcnt vmcnt(0)" ::: "memory");
        }
    }
    __syncthreads();
}


DEV void late_transpose_item(const P& p, int it, float* smem) {
    const int m = it >> 8, t = it & 255;
    const float* W = m == 0 ? p.w_out : (m == 1 ? p.xa_wq : (m == 2 ? p.xa_wo : p.peer_wq));
    const size_t off = m == 0 ? WS_WOUT_T : (m == 1 ? WS_WQ_T : (m == 2 ? WS_WO_T : WS_PWQ_T));
    transpose_tile(W, 1024, (bf16_t*)(p.ws + off), t >> 4, t & 15, smem);
}

constexpr int WQ_WORD0 = 4096;
DEV int wq_next(unsigned* cnt, int nper, int xcc, unsigned char* lds) {
    volatile unsigned* slot = (volatile unsigned*)(lds + LDS_BYTES - 16);
    __syncthreads();
    if (threadIdx.x == 0) {
        int res = -1;
        int off = (int)slot[1];
        while (off < 8) {
            const int q = (xcc + off) & 7;
            const unsigned idx = atomicAdd(&cnt[q * 64], 1u);
            if (idx < (unsigned)nper) { res = q * nper + (int)idx; break; }
            ++off;
        }
        slot[0] = (unsigned)res;
        slot[1] = (unsigned)off;
    }
    __syncthreads();
    return (int)slot[0];
}
DEV void wq_begin(unsigned char* lds) {
    __syncthreads();
    if (threadIdx.x == 0) ((volatile unsigned*)(lds + LDS_BYTES - 16))[1] = 0u;
}

constexpr int NSTAGES = 12;
template <int ST>
DEV void run_stage(const P& p, unsigned char* lds, int xcc) {
    float* smem = (float*)lds;
    const int nb = gridDim.x, bid = blockIdx.x;
    int tidl = threadIdx.x;
    asm volatile("" : "+v"(tidl));
    const int wave = tidl >> 6;
    unsigned* wqc = (unsigned*)(p.ws + WS_BAR) + WQ_WORD0;
    if (ST == 0) {
        for (int it = bid; it < PREP_END; it += nb) prep_item(p, it, smem);
    } else if (ST == 1) {
        for (int it = bid; it < 1536 + 384 + 128; it += nb) {
            if (it < 1536) gemm_item<0>(p, it & 7, it >> 3, lds);
            else if (it < 1920) { const int i2 = it - 1536, q = i2 & 7, j = i2 >> 3; gemm_mfma_tile<0>(p, q * 16 + (j & 15), 24 + (j >> 4), lds); }
            else gemm_item<1>(p, (it - 1920) & 7, (it - 1920) >> 3, lds);
        }
    } else if (ST == 2) {
        if (PROBE_REP == 21) for (int it = bid; it < 256; it += nb) compress_item2(p, it, lds);
        if (PROBE_REP == 22) for (int it = bid; it < 1024; it += nb) hgrn_prep_item(p, it, smem);
        for (int it = bid; it < 256 + 1024; it += nb) {
            if (it < 256) compress_item2(p, it, lds);
            else hgrn_prep_item2(p, it - 256, lds);
        }
    } else if (ST == 3) {
        if (PROBE_REP == 31) { for (int it = bid; it < 32; it += nb) hgrn_chain_item(p, it, lds); }
        if (PROBE_REP == 32) {
            volatile unsigned* qs2 = (volatile unsigned*)(lds + LDS_BYTES - 16);
            for (;;) {
                __syncthreads();
                if (threadIdx.x == 0) *qs2 = atomicAdd(wqc + 64, 1u);
                __syncthreads();
                const int j = (int)*qs2;
                if (j >= 1024) break;
                nsa_item2(p, (j & 15) >> 1, j & 1, 63 - (j >> 4), lds, p.out != nullptr ? 4 : 0);
            }
        }
        volatile unsigned* qslot = (volatile unsigned*)(lds + LDS_BYTES - 16);
        for (;;) {
            __syncthreads();
            if (threadIdx.x == 0) *qslot = atomicAdd(wqc, 1u);
            __syncthreads();
            const int it = (int)*qslot;
            if (it >= 32 + 1024) break;
            if (it < 32) hgrn_chain_item2(p, it, lds);
            else { const int j = it - 32; nsa_item2(p, (j & 15) >> 1, j & 1, 63 - (j >> 4), lds); }
        }
        for (;;) {
            __syncthreads();
            if (threadIdx.x == 0) *qslot = atomicAdd(wqc + 128, 1u);
            __syncthreads();
            const int it = (int)*qslot;
            if (it >= 2048) break;
            if (it < 1024) late_transpose_item(p, it, smem);
            else {
                const int j = it - 1024, tb = j >> 9, r0 = (j & 511) * 32 + wave * 8;
                for (int r = 0; r < 8; ++r) {
                    if (tb == 0) peer_quant_row(p.peer_down, p.ws + WS_PD, (float*)(p.ws + WS_PSD), r0 + r, (int*)(p.ws + WS_PRS));
                    else peer_quant_row(p.peer_up, p.ws + WS_PU, (float*)(p.ws + WS_PSU), r0 + r);
                }
            }
        }
    } else if (ST == 4) {
        for (int it = bid; it < 512; it += nb) gemm_item<2>(p, it & 7, it >> 3, lds);
    } else if (ST == 5) {
        for (int it = bid; it < T_ / 4; it += nb) ln_item(p, it * 4 + wave, 0, tidl & 63);
    } else if (ST == 9) {
        for (int it = bid; it < T_ / 4; it += nb) ln_item(p, it * 4 + wave, 1, tidl & 63);
    } else if (ST == 6) {
        for (int it = bid; it < 512; it += nb) gemm_item<3>(p, it & 7, it >> 3, lds);
    } else if (ST == 7) {
        for (int it = bid; it < 1024; it += nb) xattn_item3(p, it, lds);
    } else if (ST == 8) {
        for (int it = bid; it < 512; it += nb) gemm_item<4>(p, it & 7, it >> 3, lds);
    } else if (ST == 10) {
        for (int it = bid; it < 512; it += nb) gemm_item<5>(p, it & 7, it >> 3, lds);
    } else if (ST == 11) {
        if (PROBE_REP == 11) for (int it = bid; it < T_ / 16; it += nb) peer_route_item(p, it, lds);
        for (int it = bid; it < T_ / 16; it += nb) peer_route_item(p, it, lds);
    } else if (ST == 12) {
        if (PROBE_REP == 12) { wq_begin(lds); for (int it; (it = wq_next(wqc + 4 * 512, 1024, xcc, lds)) >= 0;) peer_down_item(p, it >> 10, it & 1023, tidl & 63, wave); }
        wq_begin(lds);
        for (int it; (it = wq_next(wqc + 2 * 512, 1024, xcc, lds)) >= 0;) peer_down_item(p, it >> 10, it & 1023, tidl & 63, wave);
    } else if (ST == 13) {
        if (PROBE_REP == 13) for (int it = bid; it < T_ / 4; it += nb) peer_coef_item(p, it * 4 + wave, tidl & 63);
        for (int it = bid; it < T_ / 4; it += nb) peer_coef_item(p, it * 4 + wave, tidl & 63);
    } else if (ST == 14) {
        if (PROBE_REP == 14) { wq_begin(lds); for (int it; (it = wq_next(wqc + 5 * 512, 1024, xcc, lds)) >= 0;) peer_up_item(p, it >> 10, it & 1023, tidl & 63, wave, p.out == nullptr); }
        wq_begin(lds);
        for (int it; (it = wq_next(wqc + 3 * 512, 1024, xcc, lds)) >= 0;) peer_up_item(p, it >> 10, it & 1023, tidl & 63, wave);
    } else if (ST == 15) {
        for (int it = bid; it < T_ / 4; it += nb) ln3_item(p, it * 4 + wave, tidl & 63);
    }
}

template <int ST>
__global__ void __launch_bounds__(256, 2) stage_kernel(P p) {
    __shared__ __attribute__((aligned(16))) unsigned char lds[LDS_BYTES + 16];
    run_stage<ST>(p, lds, (int)xb_xcc_id() & 7);
}

__global__ void __launch_bounds__(256, 2) mega_kernel(P p) {
    __shared__ __attribute__((aligned(16))) unsigned char lds[LDS_BYTES + 16];
    if (threadIdx.x == 0) *(uint4*)(lds + LDS_BYTES) = make_uint4(0u, 0u, 0u, 0u);
    __syncthreads();
    const XcdBarrier xb = xcd_barrier_post((unsigned*)(p.ws + WS_BAR), (volatile LAS unsigned*)(lds + LDS_BYTES));
    const int xcc = (int)xb.x & 7;
    run_stage<0>(p, lds, xcc); xcd_barrier(xb);
    if (PROBE_REP == 0) { run_stage<0>(p, lds, xcc); xcd_barrier(xb); }
    run_stage<1>(p, lds, xcc); xcd_barrier(xb);
    if (PROBE_REP == 1) { run_stage<1>(p, lds, xcc); xcd_barrier(xb); }
    run_stage<2>(p, lds, xcc); xcd_barrier(xb);
    if (PROBE_REP == 2) { run_stage<2>(p, lds, xcc); xcd_barrier(xb); }
    if (PROBE_REP == 35) { if (blockIdx.x < 32) hgrn_chain_item2(p, blockIdx.x, lds); xcd_barrier(xb); }
    run_stage<3>(p, lds, xcc); xcd_barrier(xb);
    run_stage<4>(p, lds, xcc); xcd_barrier(xb);
    if (PROBE_REP == 4) { run_stage<4>(p, lds, xcc); xcd_barrier(xb); }
    if (PROBE_REP == 50) { xcd_barrier(xb); xcd_barrier(xb); xcd_barrier(xb); xcd_barrier(xb); xcd_barrier(xb); xcd_barrier(xb); xcd_barrier(xb); xcd_barrier(xb); }
    run_stage<5>(p, lds, xcc); xcd_barrier(xb);
    run_stage<6>(p, lds, xcc); xcd_barrier(xb);
    if (PROBE_REP == 6) { run_stage<6>(p, lds, xcc); xcd_barrier(xb); }
    run_stage<7>(p, lds, xcc); xcd_barrier(xb);
    if (PROBE_REP == 7) { run_stage<7>(p, lds, xcc); xcd_barrier(xb); }
    run_stage<8>(p, lds, xcc); xcd_barrier(xb);
    run_stage<9>(p, lds, xcc); xcd_barrier(xb);
    run_stage<10>(p, lds, xcc); xcd_barrier(xb);
    if (PROBE_REP == 10) { run_stage<10>(p, lds, xcc); xcd_barrier(xb); }
    run_stage<11>(p, lds, xcc); xcd_barrier(xb);
    run_stage<12>(p, lds, xcc); xcd_barrier(xb);
    run_stage<13>(p, lds, xcc); xcd_barrier(xb);
    run_stage<14>(p, lds, xcc); xcd_barrier(xb);
    run_stage<15>(p, lds, xcc);
}

extern "C" void kernel_launch(void* const* d_in, const int* in_sizes, int n_in, void* d_out, int out_size, void* d_ws, size_t ws_size,
                              hipStream_t stream) {
    if (n_in != 18 || ws_size < WS_END) {
        fprintf(stderr, "kernel_launch: unexpected inputs (n_in %d, ws %zu, need %zu)\n", n_in, ws_size, (size_t)WS_END);
        return;
    }
    P p{};
    p.x = (const float*)d_in[0]; p.mem = (const float*)d_in[1]; p.w_in = (const float*)d_in[2]; p.cmp_pos = (const float*)d_in[3];
    p.cmp_w1 = (const float*)d_in[4]; p.cmp_w2 = (const float*)d_in[5]; p.lb_logits = (const float*)d_in[6];
    p.hg_norm_w = (const float*)d_in[7]; p.w_out = (const float*)d_in[8]; p.xa_wq = (const float*)d_in[9];
    p.xa_wkv = (const float*)d_in[10]; p.xa_wo = (const float*)d_in[11]; p.peer_wq = (const float*)d_in[12];
    p.peer_keys = (const float*)d_in[13]; p.peer_down = (const float*)d_in[14]; p.peer_up = (const float*)d_in[15];
    p.ln_g = (const float*)d_in[16]; p.ln_b = (const float*)d_in[17];
    p.out = (float*)d_out; p.ws = (unsigned char*)d_ws;
#if ONE_LAUNCH
    static int grid_blocks = 0;
    if (!grid_blocks) {
        int dev = 0, cus = 0, per_cu = 0;
        hipGetDevice(&dev);
        hipDeviceGetAttribute(&cus, hipDeviceAttributeMultiprocessorCount, dev);
        hipOccupancyMaxActiveBlocksPerMultiprocessor(&per_cu, mega_kernel, 256, 0);
        if (per_cu > 2) per_cu = 2;
        if (per_cu < 1) per_cu = 1;
        grid_blocks = cus * per_cu;
    }
    (void)hipMemsetAsync((unsigned char*)d_ws + WS_BAR, 0, 65536, stream);
    void* args[] = {&p};
    hipError_t e = hipLaunchCooperativeKernel((void*)mega_kernel, dim3(grid_blocks), dim3(256), args, 0, stream);
    if (e != hipSuccess) fprintf(stderr, "cooperative launch failed: %s (grid %d)\n", hipGetErrorString(e), grid_blocks);
#else
    const int G = 2048;
    stage_kernel<0><<<G, 256, 0, stream>>>(p);
    stage_kernel<1><<<G, 256, 0, stream>>>(p);
    stage_kernel<2><<<G, 256, 0, stream>>>(p);
    stage_kernel<3><<<G, 256, 0, stream>>>(p);
    stage_kernel<4><<<G, 256, 0, stream>>>(p);
    stage_kernel<5><<<G, 256, 0, stream>>>(p);
    stage_kernel<6><<<G, 256, 0, stream>>>(p);
    stage_kernel<7><<<G, 256, 0, stream>>>(p);
    stage_kernel<8><<<G, 256, 0, stream>>>(p);
    stage_kernel<9><<<G, 256, 0, stream>>>(p);
    stage_kernel<10><<<G, 256, 0, stream>>>(p);
    stage_kernel<11><<<G, 256, 0, stream>>>(p);
#endif
}
```

```cpp
#include <hip/hip_runtime.h>
#include <hip/hip_cooperative_groups.h>
#include <cstdio>
#include <cstdint>
namespace cg = cooperative_groups;

#ifndef PROBE_REP
#define PROBE_REP -1
#endif
#ifndef ONE_LAUNCH
#define ONE_LAUNCH 1
#endif

typedef unsigned short bf16_t;
#define DEV __device__ __forceinline__

constexpr int D_ = 1024, B_ = 8, S_ = 2048, T_ = B_ * S_, ML_ = 256, INC = 3352;
constexpr int NCMP = 127;
constexpr int LDS_BYTES = 67584;
constexpr float ALPHA = 1.189207115002721f;
constexpr float LN_EPS = 1e-5f;
constexpr int C_QA = 0, C_KC = 512, C_VC = 640, C_KS = 768, C_VS = 896, C_KW = 1024, C_VW = 1152, C_GATE = 1280,
              C_HQ = 1304, C_HF = 1816, C_HI = 2328, C_HG = 2840;
constexpr size_t WS_HB = 0;
constexpr size_t SZ_HB = (size_t)T_ * INC * 2;
constexpr size_t WS_OM = WS_HB + SZ_HB;
constexpr size_t WS_KVM = WS_OM + (size_t)T_ * 1024 * 2;
constexpr size_t WS_KC = WS_KVM + (size_t)2048 * 2048 * 2;
constexpr size_t WS_XB = WS_KC + (1u << 20);
constexpr size_t WS_WIN_T = WS_XB + (size_t)T_ * 1024 * 2;
constexpr size_t WS_WOUT_T = WS_WIN_T + (size_t)3456 * 1024 * 2;
constexpr size_t WS_WQ_T = WS_WOUT_T + (size_t)1024 * 1024 * 2;
constexpr size_t WS_WKV_T = WS_WQ_T + (size_t)1024 * 1024 * 2;
constexpr size_t WS_WO_T = WS_WKV_T + (size_t)2048 * 1024 * 2;
constexpr size_t WS_PWQ_T = WS_WO_T + (size_t)1024 * 1024 * 2;
constexpr size_t WS_MEMB = WS_PWQ_T + (size_t)1024 * 1024 * 2;
constexpr size_t WS_PKEY = WS_MEMB + (size_t)2048 * 1024 * 2;
constexpr size_t WS_VT = WS_PKEY + (size_t)16 * 128 * 64 * 2;
constexpr size_t WS_KCB = WS_VT + (size_t)2 * B_ * 2 * 64 * 2048 * 2;
constexpr size_t WS_VCT = WS_KCB + (size_t)B_ * 2 * 128 * 64 * 2;
constexpr size_t WS_W1T = WS_VCT + (size_t)B_ * 2 * 128 * 64 * 2;
constexpr size_t WS_W2T = WS_W1T + (size_t)2 * 128 * 2048 * 2;
constexpr size_t WS_CB = WS_W2T + (size_t)2 * 64 * 128 * 2;
constexpr size_t WS_VMT = WS_CB + 1024;
constexpr size_t WS_BAR = WS_VMT + (size_t)B_ * 4 * 256 * 256 * 2;
constexpr size_t WS_PD = WS_BAR + 65536;
constexpr size_t WS_PU = WS_PD + (size_t)16384 * 1024;
constexpr size_t WS_PSD = WS_PU + (size_t)16384 * 1024;
constexpr size_t WS_PSU = WS_PSD + 65536;
constexpr size_t WS_PRS = WS_PSU + 65536;
constexpr size_t WS_END = WS_PRS + 65536;
static_assert(WS_END <= (size_t)268435456, "workspace budget");
constexpr size_t WS_EB = WS_KC;
constexpr size_t HS_QT = 0;
constexpr size_t HS_KT = (size_t)B_ * 4 * 2048 * 128 * 2;
constexpr size_t HS_KHT = 2 * HS_KT;
constexpr size_t HS_VIT = 3 * HS_KT;
constexpr size_t HS_DS = HS_KT;
constexpr size_t HS_OI = 3 * HS_KT;
constexpr size_t WS_QX = 0;
constexpr size_t WS_OX = (size_t)T_ * 1024 * 2;
constexpr size_t WS_QP = 0;
constexpr size_t WS_EIDP = (size_t)T_ * 1024 * 2;
constexpr size_t WS_GATEP = WS_EIDP + (size_t)T_ * 128 * 2;
constexpr size_t WS_COEFP = WS_GATEP + (size_t)T_ * 128 * 4;
constexpr size_t WS_XQ = WS_COEFP + (size_t)T_ * 128 * 4;
constexpr size_t WS_SXF = WS_XQ + (size_t)T_ * 1024;
constexpr size_t WS_SXI = WS_SXF + (size_t)T_ * 4;
constexpr size_t WS_ASUM = WS_SXI + (size_t)T_ * 4;
constexpr size_t WS_DP = WS_ASUM + (size_t)T_ * 4;
static_assert(WS_DP + (size_t)8 * T_ * 128 * 4 <= WS_KVM, "PEER intermediates must fit in the dead h/OM region");

struct P {
    const float *x, *mem, *w_in, *cmp_pos, *cmp_w1, *cmp_w2, *lb_logits, *hg_norm_w, *w_out, *xa_wq, *xa_wkv, *xa_wo,
        *peer_wq, *peer_keys, *peer_down, *peer_up, *ln_g, *ln_b;
    float* out;
    unsigned char* ws;
};

DEV unsigned short f2bf(float f) {
    unsigned u = __float_as_uint(f);
    u += 0x7fffu + ((u >> 16) & 1u);
    return (unsigned short)(u >> 16);
}
DEV float bf2f(unsigned short h) { return __uint_as_float(((unsigned)h) << 16); }
DEV float bflo(unsigned u) { return __uint_as_float(u << 16); }
DEV float bfhi(unsigned u) { return __uint_as_float(u & 0xffff0000u); }
typedef __bf16 bf16x2_t __attribute__((ext_vector_type(2)));
typedef float f32x2_t __attribute__((ext_vector_type(2)));
DEV unsigned pk_bf16(float a, float b) {
    f32x2_t v = {a, b};
    bf16x2_t r = __builtin_convertvector(v, bf16x2_t);
    return __builtin_bit_cast(unsigned, r);
}
DEV float wsum(float v) {
#pragma unroll
    for (int o = 32; o > 0; o >>= 1) v += __shfl_xor(v, o);
    return v;
}
DEV float wmax(float v) {
#pragma unroll
    for (int o = 32; o > 0; o >>= 1) v = fmaxf(v, __shfl_xor(v, o));
    return v;
}
DEV float sigmoidf_(float x) { return 1.f / (1.f + expf(-x)); }
DEV float fsigmoid(float x) { return __fdividef(1.f, 1.f + __expf(-x)); }

template <int MODE>
DEV void gemm_tile(const P& p, int tile, float* smem) {
    constexpr bool ABF = (MODE == 2 || MODE == 4);
    constexpr int K = 1024;
    constexpr int N = MODE == 0 ? INC : (MODE == 1 ? 2048 : 1024);
    constexpr int NTN = (N + 63) / 64;
    const int tm = tile / NTN, tn = tile % NTN;
    const float* Af = nullptr;
    const bf16_t* Ab = nullptr;
    const float* Bm = nullptr;
    if (MODE == 0) { Af = p.x; Bm = p.w_in; }
    if (MODE == 1) { Af = p.mem; Bm = p.xa_wkv; }
    if (MODE == 2) { Ab = (const bf16_t*)(p.ws + WS_OM); Bm = p.w_out; }
    if (MODE == 3) { Af = p.out; Bm = p.xa_wq; }
    if (MODE == 4) { Ab = (const bf16_t*)(p.ws + WS_OX); Bm = p.xa_wo; }
    if (MODE == 5) { Af = p.out; Bm = p.peer_wq; }
    float(*sA)[68] = (float(*)[68])smem;
    float(*sB)[68] = (float(*)[68])(smem + 16 * 68);
    const int tid = threadIdx.x, tx = tid & 15, ty = tid >> 4;
    const int ar = tid >> 2, ak = (tid & 3) * 4;
    const int bk = tid >> 4, bn = (tid & 15) * 4;
    float acc[4][4];
#pragma unroll
    for (int i = 0; i < 4; ++i)
#pragma unroll
        for (int j = 0; j < 4; ++j) acc[i][j] = 0.f;
    const int gn = tn * 64 + bn;
    for (int k0 = 0; k0 < K; k0 += 16) {
        float4 av;
        if (ABF) {
            uint2 u = *(const uint2*)(Ab + (size_t)(tm * 64 + ar) * K + k0 + ak);
            av.x = bflo(u.x); av.y = bfhi(u.x); av.z = bflo(u.y); av.w = bfhi(u.y);
        } else {
            av = *(const float4*)(Af + (size_t)(tm * 64 + ar) * K + k0 + ak);
        }
        float4 bv = make_float4(0.f, 0.f, 0.f, 0.f);
        if (gn < N) bv = *(const float4*)(Bm + (size_t)(k0 + bk) * N + gn);
        sA[ak + 0][ar] = av.x; sA[ak + 1][ar] = av.y; sA[ak + 2][ar] = av.z; sA[ak + 3][ar] = av.w;
        *(float4*)&sB[bk][bn] = bv;
        __syncthreads();
#pragma unroll
        for (int kk = 0; kk < 16; ++kk) {
            float4 a = *(const float4*)&sA[kk][ty * 4];
            float4 b = *(const float4*)&sB[kk][tx * 4];
            float aa[4] = {a.x, a.y, a.z, a.w}, bb[4] = {b.x, b.y, b.z, b.w};
#pragma unroll
            for (int i = 0; i < 4; ++i)
#pragma unroll
                for (int j = 0; j < 4; ++j) acc[i][j] += aa[i] * bb[j];
        }
        __syncthreads();
    }
    const int col = tn * 64 + tx * 4;
#pragma unroll
    for (int i = 0; i < 4; ++i) {
        const size_t row = (size_t)tm * 64 + ty * 4 + i;
        if (MODE == 0 || MODE == 1 || MODE == 3) {
            bf16_t* O = (bf16_t*)(p.ws + (MODE == 0 ? WS_HB : (MODE == 1 ? WS_KVM : WS_QX)));
            if (col < N) {
                uint2 u;
                u.x = (unsigned)f2bf(acc[i][0]) | ((unsigned)f2bf(acc[i][1]) << 16);
                u.y = (unsigned)f2bf(acc[i][2]) | ((unsigned)f2bf(acc[i][3]) << 16);
                *(uint2*)(O + row * N + col) = u;
            }
        } else if (MODE == 2) {
            float4 xv = *(const float4*)(p.x + row * 1024 + col);
            float4 o = make_float4(ALPHA * xv.x + acc[i][0], ALPHA * xv.y + acc[i][1], ALPHA * xv.z + acc[i][2], ALPHA * xv.w + acc[i][3]);
            *(float4*)(p.out + row * 1024 + col) = o;
        } else if (MODE == 4) {
            float4 xv = *(const float4*)(p.out + row * 1024 + col);
            float4 o = make_float4(ALPHA * xv.x + acc[i][0], ALPHA * xv.y + acc[i][1], ALPHA * xv.z + acc[i][2], ALPHA * xv.w + acc[i][3]);
            *(float4*)(p.out + row * 1024 + col) = o;
        } else {
            float* O = (float*)(p.ws + WS_QP);
            *(float4*)(O + row * 1024 + col) = make_float4(acc[i][0], acc[i][1], acc[i][2], acc[i][3]);
        }
    }
}


using bf16x8 = __attribute__((ext_vector_type(8))) short;
using f32x4 = __attribute__((ext_vector_type(4))) float;
using u32x4 = __attribute__((ext_vector_type(4))) unsigned;

template <int MODE>
DEV void gemm_mfma_tile(const P& p, int tm, int tn, unsigned char* lds) {
    const bf16_t* A;
    const bf16_t* W;
    if (MODE == 0) { A = (const bf16_t*)(p.ws + WS_XB); W = (const bf16_t*)(p.ws + WS_WIN_T); }
    if (MODE == 1) { A = (const bf16_t*)(p.ws + WS_MEMB); W = (const bf16_t*)(p.ws + WS_WKV_T); }
    if (MODE == 2) { A = (const bf16_t*)(p.ws + WS_OM); W = (const bf16_t*)(p.ws + WS_WOUT_T); }
    if (MODE == 3) { A = (const bf16_t*)(p.ws + WS_XB); W = (const bf16_t*)(p.ws + WS_WQ_T); }
    if (MODE == 4) { A = (const bf16_t*)(p.ws + WS_OX); W = (const bf16_t*)(p.ws + WS_WO_T); }
    if (MODE == 5) { A = (const bf16_t*)(p.ws + WS_XB); W = (const bf16_t*)(p.ws + WS_PWQ_T); }
    const int tid = threadIdx.x, lane = tid & 63, wid = tid >> 6, wm = wid >> 1, wn = wid & 1;
    const int m0 = tm * 128, n0 = tn * 128;
    const bf16_t* ga[2];
    const bf16_t* gw[2];
#pragma unroll
    for (int i = 0; i < 2; ++i) {
        const int r = (wid * 2 + i) * 16 + (lane >> 2);
        const int gsw = (0x1320 >> (((r >> 2) & 3) * 4)) & 3;
        const int c = (lane & 3) ^ gsw;
        ga[i] = A + (size_t)(m0 + r) * 1024 + c * 8;
        gw[i] = W + (size_t)(n0 + r) * 1024 + c * 8;
    }
    unsigned char* lbase = lds + wid * 2048;
#define GEMM_STAGE(slot, kt)                                                                                                   \
    do {                                                                                                                       \
        _Pragma("unroll") for (int i = 0; i < 2; ++i) {                                                                        \
            __builtin_amdgcn_global_load_lds((const unsigned*)(ga[i] + (kt) * 32), (unsigned*)(lbase + (slot) * 16384 + i * 1024), 16, 0, 0);         \
            __builtin_amdgcn_global_load_lds((const unsigned*)(gw[i] + (kt) * 32), (unsigned*)(lbase + (slot) * 16384 + 8192 + i * 1024), 16, 0, 0);  \
        }                                                                                                                      \
    } while (0)
    asm volatile("s_waitcnt vmcnt(0)" ::: "memory");
    GEMM_STAGE(0, 0);
    GEMM_STAGE(1, 1);
    GEMM_STAGE(2, 2);
    f32x4 acc[4][4];
#pragma unroll
    for (int i = 0; i < 4; ++i)
#pragma unroll
        for (int j = 0; j < 4; ++j) acc[i][j] = (f32x4){0.f, 0.f, 0.f, 0.f};
    const int fr = lane & 15, fq = lane >> 4;
    const int fsw = (0x1320 >> (((fr >> 2) & 3) * 4)) & 3;
    const int aoff = (wm * 64 + fr) * 64 + ((fq ^ fsw) << 4);
    const int boff = 8192 + (wn * 64 + fr) * 64 + ((fq ^ fsw) << 4);
#define GEMM_COMPUTE(slot)                                                                                                     \
    do {                                                                                                                       \
        const unsigned char* sb = lds + (slot) * 16384;                                                                        \
        bf16x8 af[4], wf[4];                                                                                                   \
        _Pragma("unroll") for (int t = 0; t < 4; ++t) {                                                                        \
            af[t] = *(const bf16x8*)(sb + aoff + t * 1024);                                                                    \
            wf[t] = *(const bf16x8*)(sb + boff + t * 1024);                                                                    \
        }                                                                                                                      \
        _Pragma("unroll") for (int nt = 0; nt < 4; ++nt)                                                                       \
            _Pragma("unroll") for (int mt = 0; mt < 4; ++mt)                                                                   \
                acc[nt][mt] = __builtin_amdgcn_mfma_f32_16x16x32_bf16(wf[nt], af[mt], acc[nt][mt], 0, 0, 0);                   \
    } while (0)
#pragma unroll 1
    for (int kt = 0; kt < 29; ++kt) {
        asm volatile("s_waitcnt vmcnt(8)\n\ts_waitcnt lgkmcnt(0)" ::: "memory");
        __builtin_amdgcn_s_barrier(); asm volatile("" ::: "memory");
        GEMM_STAGE((kt + 3) & 3, kt + 3);
        GEMM_COMPUTE(kt & 3);
    }
    asm volatile("s_waitcnt vmcnt(8)\n\ts_waitcnt lgkmcnt(0)" ::: "memory");
    __builtin_amdgcn_s_barrier(); asm volatile("" ::: "memory");
    GEMM_COMPUTE(29 & 3);
    asm volatile("s_waitcnt vmcnt(4)\n\ts_waitcnt lgkmcnt(0)" ::: "memory");
    __builtin_amdgcn_s_barrier(); asm volatile("" ::: "memory");
    GEMM_COMPUTE(30 & 3);
    asm volatile("s_waitcnt vmcnt(0)\n\ts_waitcnt lgkmcnt(0)" ::: "memory");
    __builtin_amdgcn_s_barrier(); asm volatile("" ::: "memory");
    GEMM_COMPUTE(31 & 3);
    asm volatile("s_waitcnt lgkmcnt(0)" ::: "memory");
    __builtin_amdgcn_s_barrier(); asm volatile("" ::: "memory");
#undef GEMM_STAGE
#undef GEMM_COMPUTE
#pragma unroll
    for (int mt = 0; mt < 4; ++mt) {
        const size_t m = (size_t)m0 + wm * 64 + mt * 16 + fr;
#pragma unroll
        for (int nt = 0; nt < 4; ++nt) {
            const int n = n0 + wn * 64 + nt * 16 + fq * 4;
            const f32x4 c = acc[nt][mt];
            if (MODE == 0 || MODE == 1 || MODE == 3 || MODE == 5) {
                constexpr int NS = MODE == 0 ? INC : (MODE == 1 ? 2048 : 1024);
                bf16_t* O = (bf16_t*)(p.ws + (MODE == 0 ? WS_HB : (MODE == 1 ? WS_KVM : (MODE == 3 ? WS_QX : WS_QP))));
                if (MODE == 1 && tn >= 8) {
                    bf16_t* VMT = (bf16_t*)(p.ws + WS_VMT);
                    const int nn = n - 1024;
                    const size_t base = (((size_t)(m >> 8) * 4 + (nn >> 8)) * 256 + (nn & 255)) * 256 + (m & 255);
#pragma unroll
                    for (int i = 0; i < 4; ++i) VMT[base + (size_t)i * 256] = f2bf(c[i]);
                } else if (MODE == 0 && (tn == 7 || tn == 9)) {
                    bf16_t* VT = (bf16_t*)(p.ws + WS_VT);
                    const int which = tn == 9 ? 1 : 0;
                    const size_t base = ((((size_t)which * B_ + (m >> 11)) * 2 + wn) * 64 + nt * 16 + fq * 4) * 2048 + (m & 2047);
#pragma unroll
                    for (int i = 0; i < 4; ++i) VT[base + (size_t)i * 2048] = f2bf(c[i]);
                } else if (MODE != 0 || n < INC) {
                    uint2 u;
                    u.x = pk_bf16(c[0], c[1]);
                    u.y = pk_bf16(c[2], c[3]);
                    *(uint2*)(O + m * NS + n) = u;
                }
            } else if (MODE == 2) {
                const float4 xv = *(const float4*)(p.x + m * 1024 + n);
                *(float4*)(p.out + m * 1024 + n) = make_float4(ALPHA * xv.x + c[0], ALPHA * xv.y + c[1], ALPHA * xv.z + c[2], ALPHA * xv.w + c[3]);
            } else if (MODE == 4) {
                const float4 xv = *(const float4*)(p.out + m * 1024 + n);
                *(float4*)(p.out + m * 1024 + n) = make_float4(ALPHA * xv.x + c[0], ALPHA * xv.y + c[1], ALPHA * xv.z + c[2], ALPHA * xv.w + c[3]);
            }
        }
    }
}


template <int MODE>
DEV void gemm_mfma_tile256(const P& p, int tm, int tn, unsigned char* lds) {
    const bf16_t* A;
    const bf16_t* W;
    if (MODE == 0) { A = (const bf16_t*)(p.ws + WS_XB); W = (const bf16_t*)(p.ws + WS_WIN_T); }
    if (MODE == 1) { A = (const bf16_t*)(p.ws + WS_MEMB); W = (const bf16_t*)(p.ws + WS_WKV_T); }
    if (MODE == 2) { A = (const bf16_t*)(p.ws + WS_OM); W = (const bf16_t*)(p.ws + WS_WOUT_T); }
    if (MODE == 3) { A = (const bf16_t*)(p.ws + WS_XB); W = (const bf16_t*)(p.ws + WS_WQ_T); }
    if (MODE == 4) { A = (const bf16_t*)(p.ws + WS_OX); W = (const bf16_t*)(p.ws + WS_WO_T); }
    if (MODE == 5) { A = (const bf16_t*)(p.ws + WS_XB); W = (const bf16_t*)(p.ws + WS_PWQ_T); }
    const int tid = threadIdx.x, lane = tid & 63, wid = tid >> 6, wm = wid >> 1, wn = wid & 1;
    const int m0 = tm * 256, n0 = tn * 128;
    const bf16_t* ga[4];
    const bf16_t* gw[2];
#pragma unroll
    for (int i = 0; i < 4; ++i) {
        const int r = (wid * 4 + i) * 16 + (lane >> 2);
        const int gsw = (0x1320 >> (((r >> 2) & 3) * 4)) & 3;
        ga[i] = A + (size_t)(m0 + r) * 1024 + ((lane & 3) ^ gsw) * 8;
    }
#pragma unroll
    for (int i = 0; i < 2; ++i) {
        const int r = (wid * 2 + i) * 16 + (lane >> 2);
        const int gsw = (0x1320 >> (((r >> 2) & 3) * 4)) & 3;
        gw[i] = W + (size_t)(n0 + r) * 1024 + ((lane & 3) ^ gsw) * 8;
    }
    unsigned char* lbA = lds + wid * 4096;
    unsigned char* lbW = lds + 16384 + wid * 2048;
#define GEMM_STAGE(slot, kt)                                                                                                   \
    do {                                                                                                                       \
        _Pragma("unroll") for (int i = 0; i < 4; ++i)                                                                          \
            __builtin_amdgcn_global_load_lds((const unsigned*)(ga[i] + (kt) * 32), (unsigned*)(lbA + (slot) * 24576 + i * 1024), 16, 0, 0);  \
        _Pragma("unroll") for (int i = 0; i < 2; ++i)                                                                          \
            __builtin_amdgcn_global_load_lds((const unsigned*)(gw[i] + (kt) * 32), (unsigned*)(lbW + (slot) * 24576 + i * 1024), 16, 0, 0);  \
    } while (0)
    GEMM_STAGE(0, 0);
    f32x4 acc[4][8];
#pragma unroll
    for (int i = 0; i < 4; ++i)
#pragma unroll
        for (int j = 0; j < 8; ++j) acc[i][j] = (f32x4){0.f, 0.f, 0.f, 0.f};
    const int fr = lane & 15, fq = lane >> 4;
    const int fsw = (0x1320 >> (((fr >> 2) & 3) * 4)) & 3;
    const int aoff = (wm * 128 + fr) * 64 + ((fq ^ fsw) << 4);
    const int boff = 16384 + (wn * 64 + fr) * 64 + ((fq ^ fsw) << 4);
#pragma unroll 1
    for (int kt = 0; kt < 32; ++kt) {
        asm volatile("s_waitcnt vmcnt(0)\n\ts_waitcnt lgkmcnt(0)" ::: "memory");
        __builtin_amdgcn_s_barrier(); asm volatile("" ::: "memory");
        if (kt + 1 < 32) { if (kt & 1) GEMM_STAGE(0, kt + 1); else GEMM_STAGE(1, kt + 1); }
        const unsigned char* sb = lds + (kt & 1) * 24576;
        bf16x8 af[8], wf[4];
#pragma unroll
        for (int t = 0; t < 8; ++t) af[t] = *(const bf16x8*)(sb + aoff + t * 1024);
#pragma unroll
        for (int t = 0; t < 4; ++t) wf[t] = *(const bf16x8*)(sb + boff + t * 1024);
#pragma unroll
        for (int nt = 0; nt < 4; ++nt)
#pragma unroll
            for (int mt = 0; mt < 8; ++mt) acc[nt][mt] = __builtin_amdgcn_mfma_f32_16x16x32_bf16(wf[nt], af[mt], acc[nt][mt], 0, 0, 0);
    }
    asm volatile("s_waitcnt lgkmcnt(0)" ::: "memory");
    __builtin_amdgcn_s_barrier(); asm volatile("" ::: "memory");
#undef GEMM_STAGE
#pragma unroll
    for (int mt = 0; mt < 8; ++mt) {
        const size_t m = (size_t)m0 + wm * 128 + mt * 16 + fr;
#pragma unroll
        for (int nt = 0; nt < 4; ++nt) {
            const int n = n0 + wn * 64 + nt * 16 + fq * 4;
            const f32x4 c = acc[nt][mt];
            if (MODE == 0 || MODE == 1 || MODE == 3 || MODE == 5) {
                constexpr int NS = MODE == 0 ? INC : (MODE == 1 ? 2048 : 1024);
                bf16_t* O = (bf16_t*)(p.ws + (MODE == 0 ? WS_HB : (MODE == 1 ? WS_KVM : (MODE == 3 ? WS_QX : WS_QP))));
                if (MODE == 1 && tn >= 8) {
                    bf16_t* VMT = (bf16_t*)(p.ws + WS_VMT);
                    const int nn = n - 1024;
                    const size_t base = (((size_t)(m >> 8) * 4 + (nn >> 8)) * 256 + (nn & 255)) * 256 + (m & 255);
#pragma unroll
                    for (int i = 0; i < 4; ++i) VMT[base + (size_t)i * 256] = f2bf(c[i]);
                } else if (MODE == 0 && (tn == 7 || tn == 9)) {
                    bf16_t* VT = (bf16_t*)(p.ws + WS_VT);
                    const int which = tn == 9 ? 1 : 0;
                    const size_t base = ((((size_t)which * B_ + (m >> 11)) * 2 + wn) * 64 + nt * 16 + fq * 4) * 2048 + (m & 2047);
#pragma unroll
                    for (int i = 0; i < 4; ++i) VT[base + (size_t)i * 2048] = f2bf(c[i]);
                } else if (MODE != 0 || n < INC) {
                    uint2 u;
                    u.x = pk_bf16(c[0], c[1]);
                    u.y = pk_bf16(c[2], c[3]);
                    *(uint2*)(O + m * NS + n) = u;
                }
            } else if (MODE == 2) {
                const float4 xv = *(const float4*)(p.x + m * 1024 + n);
                *(float4*)(p.out + m * 1024 + n) = make_float4(ALPHA * xv.x + c[0], ALPHA * xv.y + c[1], ALPHA * xv.z + c[2], ALPHA * xv.w + c[3]);
            } else if (MODE == 4) {
                const float4 xv = *(const float4*)(p.out + m * 1024 + n);
                *(float4*)(p.out + m * 1024 + n) = make_float4(ALPHA * xv.x + c[0], ALPHA * xv.y + c[1], ALPHA * xv.z + c[2], ALPHA * xv.w + c[3]);
            }
        }
    }
}


template <int MODE>
DEV void gemm_item(const P& p, int q, int j, unsigned char* lds) {
    int tm, tn;
    if (MODE == 0) {
        tm = q * 8 + (j & 7);
        tn = j >> 3;
    } else if (MODE == 1) {
        tm = q; tn = j;
    } else {
        tm = q * 8 + (j & 7);
        tn = j >> 3;
    }
    gemm_mfma_tile256<MODE>(p, tm, tn, lds);
}

DEV void transpose_tile(const float* W, int N, bf16_t* Wt, int tk, int tn, float* s, int ldk = 1024) {
    const int tid = threadIdx.x;
    const int k0 = tk * 64, n0 = tn * 64;
#pragma unroll
    for (int i = 0; i < 4; ++i) {
        const int k = (tid >> 4) + 16 * i, n = (tid & 15) * 4;
        float4 v = make_float4(0.f, 0.f, 0.f, 0.f);
        if (n0 + n < N) v = *(const float4*)(W + (size_t)(k0 + k) * N + n0 + n);
        s[k * 65 + n + 0] = v.x; s[k * 65 + n + 1] = v.y; s[k * 65 + n + 2] = v.z; s[k * 65 + n + 3] = v.w;
    }
    __syncthreads();
    {
        const int n = tid >> 2, kc = (tid & 3) * 16;
        unsigned u[8];
#pragma unroll
        for (int j = 0; j < 8; ++j)
            u[j] = (unsigned)f2bf(s[(kc + 2 * j) * 65 + n]) | ((unsigned)f2bf(s[(kc + 2 * j + 1) * 65 + n]) << 16);
        bf16_t* dst = Wt + (size_t)(n0 + n) * ldk + k0 + kc;
        *(uint4*)dst = make_uint4(u[0], u[1], u[2], u[3]);
        *(uint4*)(dst + 8) = make_uint4(u[4], u[5], u[6], u[7]);
    }
    __syncthreads();
}
DEV void convert_chunk(const float* src, bf16_t* dst, int item) {
    float4 a[4], b[4];
#pragma unroll
    for (int j = 0; j < 4; ++j) {
        const size_t e = (((size_t)item * 4 + j) * 256 + threadIdx.x) * 8;
        a[j] = *(const float4*)(src + e);
        b[j] = *(const float4*)(src + e + 4);
    }
#pragma unroll
    for (int j = 0; j < 4; ++j) {
        const size_t e = (((size_t)item * 4 + j) * 256 + threadIdx.x) * 8;
        uint4 u;
        u.x = pk_bf16(a[j].x, a[j].y);
        u.y = pk_bf16(a[j].z, a[j].w);
        u.z = pk_bf16(b[j].x, b[j].y);
        u.w = pk_bf16(b[j].z, b[j].w);
        *(uint4*)(dst + e) = u;
    }
}
constexpr int PREP_T0 = 16 * 54, PREP_T3 = PREP_T0 + 512, PREP_T5 = PREP_T3, PREP_X = PREP_T5 + T_ * 1024 / 8192, PREP_M = PREP_X + 2048 * 1024 / 8192, PREP_K = PREP_M + 16 * 128 * 64 / 8192, PREP_W1 = PREP_K + 128, PREP_W2 = PREP_W1 + 4,
              PREP_END = PREP_W2;
DEV void prep_item(const P& p, int it, float* smem) {
    if (it < PREP_T0) transpose_tile(p.w_in, INC, (bf16_t*)(p.ws + WS_WIN_T), it / 54, it % 54, smem);
    else if (it < PREP_T3) { it -= PREP_T0; transpose_tile(p.xa_wkv, 2048, (bf16_t*)(p.ws + WS_WKV_T), it >> 5, it & 31, smem); }
    else if (it < PREP_X) convert_chunk(p.x, (bf16_t*)(p.ws + WS_XB), it - PREP_T5);
    else if (it < PREP_M) convert_chunk(p.mem, (bf16_t*)(p.ws + WS_MEMB), it - PREP_X);
    else if (it < PREP_K) convert_chunk(p.peer_keys, (bf16_t*)(p.ws + WS_PKEY), it - PREP_M);
    else if (it < PREP_W1) {
        it -= PREP_K;
        const int kind = it >> 6, r = it & 63;
        transpose_tile(p.cmp_w1 + (size_t)kind * 2048 * 128, 128, (bf16_t*)(p.ws + WS_W1T) + (size_t)kind * 128 * 2048, r >> 1, r & 1, smem, 2048);
    } else if (it < PREP_W2) {
        it -= PREP_W1;
        const int kind = it >> 1;
        transpose_tile(p.cmp_w2 + (size_t)kind * 128 * 64, 64, (bf16_t*)(p.ws + WS_W2T) + (size_t)kind * 64 * 128, it & 1, 0, smem, 128);
    }
}

DEV void compress_item(const P& p, int item, float* smem) {
    const int tid = threadIdx.x;
    const int g = item & 1;
    int r = item >> 1;
    const int n = r % NCMP;
    r /= NCMP;
    const int b = r & 7, kind = r >> 3;
    const bf16_t* HB = (const bf16_t*)(p.ws + WS_HB);
    float* KC = (float*)(p.ws + WS_KC);
    float* su = smem;
    float* sp = smem + 2048;
    float* sh = smem + 2304;
    const int col = (kind ? C_VC : C_KC) + g * 64;
    for (int i = tid; i < 2048; i += 256) {
        const int l = i >> 6, d = i & 63;
        su[i] = bf2f(HB[(size_t)(b * S_ + 16 * n + l) * INC + col + d]) + p.cmp_pos[(kind * 32 + l) * 64 + d];
    }
    __syncthreads();
    {
        const int j = tid & 127, hf = tid >> 7;
        const float* w1 = p.cmp_w1 + (size_t)kind * 2048 * 128;
        float acc = 0.f;
        for (int i = hf * 1024; i < hf * 1024 + 1024; ++i) acc += su[i] * w1[(size_t)i * 128 + j];
        sp[hf * 128 + j] = acc;
    }
    __syncthreads();
    if (tid < 128) {
        const float v = sp[tid] + sp[128 + tid];
        const float u = 0.7978845608028654f * (v + 0.044715f * v * v * v);
        sh[tid] = 0.5f * v * (1.f + tanhf(u));
    }
    __syncthreads();
    if (tid < 64) {
        const float* w2 = p.cmp_w2 + (size_t)kind * 128 * 64;
        float acc = 0.f;
        for (int j = 0; j < 128; ++j) acc += sh[j] * w2[j * 64 + tid];
        KC[((((size_t)kind * B_ + b) * NCMP + n) * 2 + g) * 64 + tid] = acc;
    }
    __syncthreads();
}

DEV void load_q64_bf(float (&q)[64], const bf16_t* src) {
    const uint4* s4 = (const uint4*)src;
#pragma unroll
    for (int i = 0; i < 8; ++i) {
        const uint4 u = s4[i];
        q[i * 8 + 0] = bflo(u.x); q[i * 8 + 1] = bfhi(u.x); q[i * 8 + 2] = bflo(u.y); q[i * 8 + 3] = bfhi(u.y);
        q[i * 8 + 4] = bflo(u.z); q[i * 8 + 5] = bfhi(u.z); q[i * 8 + 6] = bflo(u.w); q[i * 8 + 7] = bfhi(u.w);
    }
}
DEV float dot64_bf(const float (&q)[64], const bf16_t* kr) {
    const uint4* k4 = (const uint4*)kr;
    float acc = 0.f;
#pragma unroll
    for (int i = 0; i < 8; ++i) {
        const uint4 u = k4[i];
        acc += q[i * 8 + 0] * bflo(u.x) + q[i * 8 + 1] * bfhi(u.x) + q[i * 8 + 2] * bflo(u.y) + q[i * 8 + 3] * bfhi(u.y) +
               q[i * 8 + 4] * bflo(u.z) + q[i * 8 + 5] * bfhi(u.z) + q[i * 8 + 6] * bflo(u.w) + q[i * 8 + 7] * bfhi(u.w);
    }
    return acc;
}
DEV float dot64_f(const float (&q)[64], const float* kr) {
    const float4* k4 = (const float4*)kr;
    float acc = 0.f;
#pragma unroll
    for (int i = 0; i < 16; ++i) {
        const float4 u = k4[i];
        acc += q[i * 4 + 0] * u.x + q[i * 4 + 1] * u.y + q[i * 4 + 2] * u.z + q[i * 4 + 3] * u.w;
    }
    return acc;
}

DEV void attn_block(const float (&q)[64], const bf16_t* krow_lane, const bf16_t* vbase_lane, bool valid, float& m, float& l, float& o) {
    float sc = dot64_bf(q, krow_lane) * 0.125f;
    sc = valid ? sc : -1e30f;
    const float mb = wmax(sc);
    const float mn = fmaxf(m, mb);
    const float corr = expf(m - mn);
    const float e = valid ? expf(sc - mn) : 0.f;
    l = l * corr + wsum(e);
    o *= corr;
#pragma unroll 8
    for (int k = 0; k < 64; ++k) o += __shfl(e, k) * bf2f(vbase_lane[(size_t)k * INC]);
    m = mn;
}

DEV void nsa_item(const P& p, int item) {
    const int lane = threadIdx.x & 63;
    const int g = item & 1;
    const int t = item >> 1;
    const int b = t >> 11, s = t & 2047;
    const bf16_t* HB = (const bf16_t*)(p.ws + WS_HB);
    const float* KC = (const float*)(p.ws + WS_KC);
    bf16_t* OM = (bf16_t*)(p.ws + WS_OM);
    const int cur = s >> 6;
    const int nvalid = (s >= 31) ? (((s - 31) >> 4) + 1) : 0;
    const size_t rowt = (size_t)t * INC;
    float ocmp0 = 0.f, ocmp1 = 0.f, ocmp2 = 0.f, ocmp3 = 0.f;
    float psum0 = 0.f, psum1 = 0.f;
    if (nvalid > 0) {
#pragma unroll 1
        for (int r = 0; r < 4; ++r) {
            const int h = g * 4 + r;
            float q[64];
            load_q64_bf(q, HB + rowt + C_QA + h * 64);
            float sc0 = -1e30f, sc1 = -1e30f;
            if (lane < nvalid) sc0 = dot64_f(q, KC + ((((size_t)0 * B_ + b) * NCMP + lane) * 2 + g) * 64) * 0.125f;
            if (lane + 64 < nvalid) sc1 = dot64_f(q, KC + ((((size_t)0 * B_ + b) * NCMP + lane + 64) * 2 + g) * 64) * 0.125f;
            const float m = wmax(fmaxf(sc0, sc1));
            const float e0 = (lane < nvalid) ? expf(sc0 - m) : 0.f;
            const float e1 = (lane + 64 < nvalid) ? expf(sc1 - m) : 0.f;
            const float l = wsum(e0 + e1);
            const float p0 = e0 / l, p1 = e1 / l;
            psum0 += p0;
            psum1 += p1;
            float oc = 0.f;
            const float* vcb = KC + ((((size_t)1 * B_ + b) * NCMP) * 2 + g) * 64 + lane;
            for (int n = 0; n < nvalid; ++n) {
                const float pn = (n < 64) ? __shfl(p0, n) : __shfl(p1, n - 64);
                oc += pn * vcb[(size_t)n * 128];
            }
            if (r == 0) ocmp0 = oc;
            if (r == 1) ocmp1 = oc;
            if (r == 2) ocmp2 = oc;
            if (r == 3) ocmp3 = oc;
        }
    }
    float imp = 0.f;
#pragma unroll
    for (int dn = -1; dn <= 3; ++dn) {
        const int n = 4 * lane + dn;
        const int nn = n < 0 ? 0 : (n > 127 ? 127 : n);
        const float v0 = __shfl(psum0, nn & 63);
        const float v1 = __shfl(psum1, nn & 63);
        const float v = (nn < 64) ? v0 : v1;
        if (n >= 0 && n <= 126) imp += v;
    }
    float score;
    if (lane > cur) score = -INFINITY;
    else if (lane == 0 || lane == cur || lane == cur - 1) score = 1e4f;
    else score = imp;
    int rank = 0;
#pragma unroll 8
    for (int i = 0; i < 32; ++i) {
        const float si = __shfl(score, i);
        rank += ((si > score) || (si == score && i < lane)) ? 1 : 0;
    }
    const bool sel = (lane <= cur) && (rank < 16);
    const unsigned mask = (unsigned)(__ballot(sel) & 0xffffffffull);
    const int wlo = (s - 511) > 0 ? (s - 511) : 0;
#pragma unroll 1
    for (int r = 0; r < 4; ++r) {
        const int h = g * 4 + r;
        float q[64];
        load_q64_bf(q, HB + rowt + C_QA + h * 64);
        float m = -1e30f, l = 0.f, o = 0.f;
        for (unsigned mm = mask; mm; mm &= mm - 1) {
            const int j = __builtin_ctz(mm);
            const int kpos = j * 64 + lane;
            attn_block(q, HB + (size_t)(b * S_ + kpos) * INC + C_KS + g * 64, HB + (size_t)(b * S_ + j * 64) * INC + C_VS + g * 64 + lane,
                       kpos <= s, m, l, o);
        }
        const float oslc = o / l;
        m = -1e30f; l = 0.f; o = 0.f;
        for (int j = wlo >> 6; j <= cur; ++j) {
            const int kpos = j * 64 + lane;
            attn_block(q, HB + (size_t)(b * S_ + kpos) * INC + C_KW + g * 64, HB + (size_t)(b * S_ + j * 64) * INC + C_VW + g * 64 + lane,
                       (kpos <= s) && (kpos >= wlo), m, l, o);
        }
        const float owin = o / l;
        const float oc = r == 0 ? ocmp0 : (r == 1 ? ocmp1 : (r == 2 ? ocmp2 : ocmp3));
        const float g0 = sigmoidf_(bf2f(HB[rowt + C_GATE + h * 3 + 0]));
        const float g1 = sigmoidf_(bf2f(HB[rowt + C_GATE + h * 3 + 1]));
        const float g2 = sigmoidf_(bf2f(HB[rowt + C_GATE + h * 3 + 2]));
        OM[(size_t)t * 1024 + h * 64 + lane] = f2bf(g0 * oc + g1 * oslc + g2 * owin);
    }
}

DEV void hgrn_item(const P& p, int item, float* smem) {
    const int b = item >> 2, hh = item & 3;
    const int tid = threadIdx.x, dv = tid & 127, half = tid >> 7;
    const bf16_t* HB = (const bf16_t*)(p.ws + WS_HB);
    bf16_t* OM = (bf16_t*)(p.ws + WS_OM);
    float* sf = smem;
    float* sq = smem + 1024;
    float* so = smem + 2048;
    float Sreg[64];
#pragma unroll
    for (int i = 0; i < 64; ++i) Sreg[i] = 0.f;
    const int d = tid & 127;
    float lbv;
    {
        const float l0 = p.lb_logits[hh * 128 + d], l1 = p.lb_logits[512 + hh * 128 + d];
        const float mx = fmaxf(l0, l1);
        const float e0 = expf(l0 - mx), e1 = expf(l1 - mx);
        lbv = e0 / (e0 + e1);
    }
    const int wave = tid >> 6, lane = tid & 63;
    const float nw0 = p.hg_norm_w[hh * 128 + lane], nw1 = p.hg_norm_w[hh * 128 + lane + 64];
    for (int t0 = 0; t0 < S_; t0 += 8) {
#pragma unroll
        for (int i = 0; i < 4; ++i) {
            const int st = (tid >> 7) + 2 * i;
            const size_t tt = (size_t)b * S_ + t0 + st;
            const float fl = bf2f(HB[tt * INC + C_HF + hh * 128 + d]);
            sf[st * 128 + d] = lbv + (1.f - lbv) * sigmoidf_(fl);
            sq[st * 128 + d] = bf2f(HB[tt * INC + C_HQ + hh * 128 + d]);
        }
        float vv[8];
#pragma unroll
        for (int st = 0; st < 8; ++st) vv[st] = bf2f(HB[((size_t)b * S_ + t0 + st) * INC + C_HI + hh * 128 + dv]);
        __syncthreads();
#pragma unroll
        for (int st = 0; st < 8; ++st) {
            float oacc = 0.f;
            const float* pf = sf + st * 128 + half * 64;
            const float* pq = sq + st * 128 + half * 64;
#pragma unroll
            for (int dk = 0; dk < 64; ++dk) {
                const float f = pf[dk];
                Sreg[dk] = f * Sreg[dk] + (1.f - f) * vv[st];
                oacc += pq[dk] * Sreg[dk];
            }
            so[(st * 2 + half) * 128 + dv] = oacc;
        }
        __syncthreads();
#pragma unroll
        for (int u = 0; u < 2; ++u) {
            const int st = wave * 2 + u;
            const float o0 = so[(st * 2 + 0) * 128 + lane] + so[(st * 2 + 1) * 128 + lane];
            const float o1 = so[(st * 2 + 0) * 128 + lane + 64] + so[(st * 2 + 1) * 128 + lane + 64];
            const float ss = wsum(o0 * o0 + o1 * o1);
            const float rs = rsqrtf(ss * (1.f / 128.f) + LN_EPS);
            const size_t tt = (size_t)b * S_ + t0 + st;
            const float gg0 = bf2f(HB[tt * INC + C_HG + hh * 128 + lane]);
            const float gg1 = bf2f(HB[tt * INC + C_HG + hh * 128 + lane + 64]);
            OM[tt * 1024 + 512 + hh * 128 + lane] = f2bf(o0 * rs * nw0 * (gg0 * sigmoidf_(gg0)));
            OM[tt * 1024 + 512 + hh * 128 + lane + 64] = f2bf(o1 * rs * nw1 * (gg1 * sigmoidf_(gg1)));
        }
    }
    __syncthreads();
}

DEV void ln_item(const P& p, int t, int which, int lane) {
    float* row = p.out + (size_t)t * 1024;
    float4 v[4];
    float s = 0.f;
#pragma unroll
    for (int i = 0; i < 4; ++i) {
        v[i] = *(const float4*)(row + (i * 64 + lane) * 4);
        s += v[i].x + v[i].y + v[i].z + v[i].w;
    }
    const float mean = wsum(s) * (1.f / 1024.f);
    float ss = 0.f;
#pragma unroll
    for (int i = 0; i < 4; ++i) {
        v[i].x -= mean; v[i].y -= mean; v[i].z -= mean; v[i].w -= mean;
        ss += v[i].x * v[i].x + v[i].y * v[i].y + v[i].z * v[i].z + v[i].w * v[i].w;
    }
    const float rs = rsqrtf(wsum(ss) * (1.f / 1024.f) + LN_EPS);
#pragma unroll
    for (int i = 0; i < 4; ++i) {
        const int c = (i * 64 + lane) * 4;
        const float4 gg = *(const float4*)(p.ln_g + which * 1024 + c);
        const float4 bb = *(const float4*)(p.ln_b + which * 1024 + c);
        float4 o;
        o.x = v[i].x * rs * gg.x + bb.x; o.y = v[i].y * rs * gg.y + bb.y; o.z = v[i].z * rs * gg.z + bb.z; o.w = v[i].w * rs * gg.w + bb.w;
        *(float4*)(row + c) = o;
        uint2 u;
        u.x = (unsigned)f2bf(o.x) | ((unsigned)f2bf(o.y) << 16);
        u.y = (unsigned)f2bf(o.z) | ((unsigned)f2bf(o.w) << 16);
        *(uint2*)((bf16_t*)(p.ws + WS_XB) + (size_t)t * 1024 + c) = u;
    }
}

DEV void xattn_item(const P& p, int item) {
    const int lane = threadIdx.x & 63;
    const int hh = item & 3, t = item >> 2, b = t >> 11;
    const bf16_t* QX = (const bf16_t*)(p.ws + WS_QX);
    const bf16_t* KVM = (const bf16_t*)(p.ws + WS_KVM);
    bf16_t* OX = (bf16_t*)(p.ws + WS_OX);
    float sc[4] = {0.f, 0.f, 0.f, 0.f};
#pragma unroll 1
    for (int c = 0; c < 4; ++c) {
        float q[64];
        load_q64_bf(q, QX + (size_t)t * 1024 + hh * 256 + c * 64);
#pragma unroll
        for (int k = 0; k < 4; ++k) sc[k] += dot64_bf(q, KVM + (size_t)(b * ML_ + lane + 64 * k) * 2048 + hh * 256 + c * 64);
    }
    float mx = -1e30f;
#pragma unroll
    for (int k = 0; k < 4; ++k) { sc[k] *= 0.0625f; mx = fmaxf(mx, sc[k]); }
    mx = wmax(mx);
    float pr[4], ls = 0.f;
#pragma unroll
    for (int k = 0; k < 4; ++k) { pr[k] = expf(sc[k] - mx); ls += pr[k]; }
    ls = wsum(ls);
    const float inv = 1.f / ls;
    float o[4] = {0.f, 0.f, 0.f, 0.f};
#pragma unroll
    for (int k = 0; k < 4; ++k) {
        const bf16_t* vb = KVM + (size_t)(b * ML_ + k * 64) * 2048 + 1024 + hh * 256 + lane;
#pragma unroll 4
        for (int mm = 0; mm < 64; ++mm) {
            const float pm = __shfl(pr[k], mm);
#pragma unroll
            for (int c = 0; c < 4; ++c) o[c] += pm * bf2f(vb[(size_t)mm * 2048 + c * 64]);
        }
    }
#pragma unroll
    for (int c = 0; c < 4; ++c) OX[(size_t)t * 1024 + hh * 256 + c * 64 + lane] = f2bf(o[c] * inv);
}

DEV void wave_argmax(float v, int i, float& bv, int& bi) {
#pragma unroll
    for (int o = 32; o > 0; o >>= 1) {
        const float ov = __shfl_xor(v, o);
        const int oi = __shfl_xor(i, o);
        if (ov > v || (ov == v && oi < i)) { v = ov; i = oi; }
    }
    bv = v; bi = i;
}

DEV void peer_item(const P& p, int t) {
    const int lane = threadIdx.x & 63;
    const float* QP = (const float*)(p.ws + WS_QP);
    float* row = p.out + (size_t)t * 1024;
    float4 xr[4], oacc[4];
#pragma unroll
    for (int i = 0; i < 4; ++i) {
        xr[i] = *(const float4*)(row + (i * 64 + lane) * 4);
        oacc[i] = make_float4(0.f, 0.f, 0.f, 0.f);
    }
#pragma unroll 1
    for (int hh = 0; hh < 8; ++hh) {
        float ts1 = 0.f, ts2 = 0.f;
        int ti1 = 0, ti2 = 0;
#pragma unroll 1
        for (int c = 0; c < 2; ++c) {
            float q[64];
            {
                const float4* q4 = (const float4*)(QP + (size_t)t * 1024 + hh * 128 + c * 64);
#pragma unroll
                for (int i = 0; i < 16; ++i) { const float4 u = q4[i]; q[i * 4] = u.x; q[i * 4 + 1] = u.y; q[i * 4 + 2] = u.z; q[i * 4 + 3] = u.w; }
            }
            const float* kb = p.peer_keys + ((size_t)(hh * 2 + c) * 128) * 64;
            float a0 = dot64_f(q, kb + (size_t)lane * 64);
            float a1 = dot64_f(q, kb + (size_t)(lane + 64) * 64);
            float ts = 0.f;
            int ti = 0;
#pragma unroll 1
            for (int k = 0; k < 16; ++k) {
                float v; int i;
                if (a0 >= a1) { v = a0; i = lane; } else { v = a1; i = lane + 64; }
                float bv; int bi;
                wave_argmax(v, i, bv, bi);
                if (lane == k) { ts = bv; ti = bi; }
                if (bi == lane) a0 = -INFINITY;
                if (bi == lane + 64) a1 = -INFINITY;
            }
            if (c == 0) { ts1 = ts; ti1 = ti; } else { ts2 = ts; ti2 = ti; }
        }
        float cs[4];
        const float s1v = __shfl(ts1, lane >> 2);
#pragma unroll
        for (int u = 0; u < 4; ++u) cs[u] = s1v + __shfl(ts2, (lane & 3) * 4 + u);
        float fs = 0.f;
        int fidx = 0;
#pragma unroll 1
        for (int k = 0; k < 16; ++k) {
            float v = cs[0]; int i = lane * 4;
#pragma unroll
            for (int u = 1; u < 4; ++u) if (cs[u] > v) { v = cs[u]; i = lane * 4 + u; }
            float bv; int bi;
            wave_argmax(v, i, bv, bi);
            if (lane == k) { fs = bv; fidx = bi; }
#pragma unroll
            for (int u = 0; u < 4; ++u) if (bi == lane * 4 + u) cs[u] = -INFINITY;
        }
        const int e1i = __shfl(ti1, fidx >> 4);
        const int e2i = __shfl(ti2, fidx & 15);
        const int eid = e1i * 128 + e2i;
        const float mx = __shfl(fs, 0);
        const float w = (lane < 16) ? expf(fs - mx) : 0.f;
        const float gate = w / wsum(w);
#pragma unroll 1
        for (int k = 0; k < 16; ++k) {
            const int e = __shfl(eid, k);
            const float gt = __shfl(gate, k);
            const float* dr = p.peer_down + (size_t)e * 1024;
            const float* ur = p.peer_up + (size_t)e * 1024;
            float hd = 0.f;
#pragma unroll
            for (int i = 0; i < 4; ++i) {
                const float4 dvv = *(const float4*)(dr + (i * 64 + lane) * 4);
                hd += dvv.x * xr[i].x + dvv.y * xr[i].y + dvv.z * xr[i].z + dvv.w * xr[i].w;
            }
            hd = wsum(hd);
            const float a = 0.5f * hd * (1.f + erff(hd * 0.7071067811865476f)) * gt;
#pragma unroll
            for (int i = 0; i < 4; ++i) {
                const float4 uv = *(const float4*)(ur + (i * 64 + lane) * 4);
                oacc[i].x += a * uv.x; oacc[i].y += a * uv.y; oacc[i].z += a * uv.z; oacc[i].w += a * uv.w;
            }
        }
    }
    float s = 0.f;
    float4 v[4];
#pragma unroll
    for (int i = 0; i < 4; ++i) {
        v[i].x = ALPHA * xr[i].x + oacc[i].x; v[i].y = ALPHA * xr[i].y + oacc[i].y;
        v[i].z = ALPHA * xr[i].z + oacc[i].z; v[i].w = ALPHA * xr[i].w + oacc[i].w;
        s += v[i].x + v[i].y + v[i].z + v[i].w;
    }
    const float mean = wsum(s) * (1.f / 1024.f);
    float ss = 0.f;
#pragma unroll
    for (int i = 0; i < 4; ++i) {
        v[i].x -= mean; v[i].y -= mean; v[i].z -= mean; v[i].w -= mean;
        ss += v[i].x * v[i].x + v[i].y * v[i].y + v[i].z * v[i].z + v[i].w * v[i].w;
    }
    const float rs = rsqrtf(wsum(ss) * (1.f / 1024.f) + LN_EPS);
#pragma unroll
    for (int i = 0; i < 4; ++i) {
        const int c = (i * 64 + lane) * 4;
        const float4 gg = *(const float4*)(p.ln_g + 2 * 1024 + c);
        const float4 bb = *(const float4*)(p.ln_b + 2 * 1024 + c);
        float4 o;
        o.x = v[i].x * rs * gg.x + bb.x; o.y = v[i].y * rs * gg.y + bb.y; o.z = v[i].z * rs * gg.z + bb.z; o.w = v[i].w * rs * gg.w + bb.w;
        *(float4*)(row + c) = o;
    }
}


DEV void compress_item2(const P& p, int item, unsigned char* lds) {
    const int nt8 = item & 7, g = (item >> 3) & 1, b = (item >> 4) & 7, kind = item >> 7;
    const int tid = threadIdx.x, lane = tid & 63, wid = tid >> 6, fr = lane & 15, fq = lane >> 4;
    const bf16_t* HB = (const bf16_t*)(p.ws + WS_HB);
    const bf16_t* W1T = (const bf16_t*)(p.ws + WS_W1T) + (size_t)kind * 128 * 2048;
    const bf16_t* W2T = (const bf16_t*)(p.ws + WS_W2T) + (size_t)kind * 64 * 128;
    const float* posb = p.cmp_pos + (size_t)kind * 2048 + fq * 8;
    const int n0 = nt8 * 16;
    const int kcol = (kind ? C_VC : C_KC) + g * 64;
    const bf16_t* abase = HB + (size_t)(b * S_ + 16 * (n0 + fr)) * INC + kcol + fq * 8;
    const bf16_t* wbase = W1T + (size_t)fr * 2048 + fq * 8;
    f32x4 acc[8];
#pragma unroll
    for (int jt = 0; jt < 8; ++jt) acc[jt] = (f32x4){0.f, 0.f, 0.f, 0.f};
#pragma unroll 4
    for (int k2 = 0; k2 < 16; ++k2) {
        const int ks = wid * 16 + k2;
        bf16x8 af;
        {
            const u32x4 raw = *(const u32x4*)(abase + (size_t)(ks >> 1) * INC + (ks & 1) * 32);
            const float* pp = posb + (ks >> 1) * 64 + (ks & 1) * 32;
            const float4 p0 = *(const float4*)pp, p1 = *(const float4*)(pp + 4);
            u32x4 w;
            w[0] = pk_bf16(bflo(raw[0]) + p0.x, bfhi(raw[0]) + p0.y);
            w[1] = pk_bf16(bflo(raw[1]) + p0.z, bfhi(raw[1]) + p0.w);
            w[2] = pk_bf16(bflo(raw[2]) + p1.x, bfhi(raw[2]) + p1.y);
            w[3] = pk_bf16(bflo(raw[3]) + p1.z, bfhi(raw[3]) + p1.w);
            af = __builtin_bit_cast(bf16x8, w);
        }
#pragma unroll
        for (int jt = 0; jt < 8; ++jt) {
            const bf16x8 wf = *(const bf16x8*)(wbase + (size_t)jt * 16 * 2048 + ks * 32);
            acc[jt] = __builtin_amdgcn_mfma_f32_16x16x32_bf16(wf, af, acc[jt], 0, 0, 0);
        }
    }
    float* PS = (float*)lds;
    bf16_t* HS = (bf16_t*)(lds + 4 * 16 * 132 * 4);
#pragma unroll
    for (int jt = 0; jt < 8; ++jt)
        *(float4*)(PS + (wid * 16 + fr) * 132 + jt * 16 + fq * 4) = make_float4(acc[jt][0], acc[jt][1], acc[jt][2], acc[jt][3]);
    __syncthreads();
    {
        const int r = tid >> 4, jb = (tid & 15) * 8;
        float hv[8];
#pragma unroll
        for (int h2 = 0; h2 < 2; ++h2) {
            float4 s = make_float4(0.f, 0.f, 0.f, 0.f);
#pragma unroll
            for (int w = 0; w < 4; ++w) {
                const float4 v = *(const float4*)(PS + (w * 16 + r) * 132 + jb + h2 * 4);
                s.x += v.x; s.y += v.y; s.z += v.z; s.w += v.w;
            }
            hv[h2 * 4 + 0] = s.x; hv[h2 * 4 + 1] = s.y; hv[h2 * 4 + 2] = s.z; hv[h2 * 4 + 3] = s.w;
        }
#pragma unroll
        for (int i = 0; i < 8; ++i) {
            const float v = hv[i];
            const float u = 0.7978845608028654f * (v + 0.044715f * v * v * v);
            hv[i] = 0.5f * v * (1.f + tanhf(u));
        }
        u32x4 w;
        w[0] = pk_bf16(hv[0], hv[1]); w[1] = pk_bf16(hv[2], hv[3]); w[2] = pk_bf16(hv[4], hv[5]); w[3] = pk_bf16(hv[6], hv[7]);
        *(u32x4*)(HS + r * 136 + jb) = w;
    }
    __syncthreads();
    f32x4 o = (f32x4){0.f, 0.f, 0.f, 0.f};
#pragma unroll
    for (int ks = 0; ks < 4; ++ks) {
        const bf16x8 hf = *(const bf16x8*)(HS + fr * 136 + ks * 32 + fq * 8);
        const bf16x8 wf = *(const bf16x8*)(W2T + (size_t)(wid * 16 + fr) * 128 + ks * 32 + fq * 8);
        if (kind == 0) o = __builtin_amdgcn_mfma_f32_16x16x32_bf16(wf, hf, o, 0, 0, 0);
        else o = __builtin_amdgcn_mfma_f32_16x16x32_bf16(hf, wf, o, 0, 0, 0);
    }
    if (kind == 0) {
        const int n = n0 + fr, e = wid * 16 + fq * 4;
        uint2 u2;
        u2.x = pk_bf16(o[0], o[1]);
        u2.y = pk_bf16(o[2], o[3]);
        if (n == 127) u2 = make_uint2(0u, 0u);
        *(uint2*)((bf16_t*)(p.ws + WS_KCB) + ((size_t)(b * 2 + g) * 128 + n) * 64 + e) = u2;
    } else {
        const int e = wid * 16 + fr, n = n0 + fq * 4;
        const float o3 = (n + 3 == 127) ? 0.f : o[3];
        uint2 u2;
        u2.x = pk_bf16(o[0], o[1]);
        u2.y = pk_bf16(o[2], o3);
        *(uint2*)((bf16_t*)(p.ws + WS_VCT) + ((size_t)(b * 2 + g) * 64 + e) * 128 + n) = u2;
    }
    __syncthreads();
}

constexpr int NSA_IMP = 32768;
constexpr int NSA_SCORE = 49152;
constexpr int NSA_SELM = NSA_SCORE + 4224;

struct NsaTileRegs { u32x4 k[2], v[2]; };
DEV void nsa_load_tile(NsaTileRegs& r, const bf16_t* kbase, size_t kstride, const bf16_t* vbase, size_t vstride, int tid) {
    const int lc = tid & 7, lr = tid >> 3;
#pragma unroll
    for (int i = 0; i < 2; ++i) {
        r.k[i] = *(const u32x4*)(kbase + (size_t)(lr + 32 * i) * kstride + lc * 8);
        r.v[i] = *(const u32x4*)(vbase + (size_t)(lr + 32 * i) * vstride + lc * 8);
    }
}
DEV void nsa_store_tile(const NsaTileRegs& r, unsigned char* stage, int tid) {
    const int lc = tid & 7, lr = tid >> 3;
    const int woff = lr * 128 + ((lc ^ ((lr >> 1) & 7)) << 4);
#pragma unroll
    for (int i = 0; i < 2; ++i) {
        *(u32x4*)(stage + woff + i * 4096) = r.k[i];
        *(u32x4*)(stage + 8192 + woff + i * 4096) = r.v[i];
    }
}
DEV void nsa_dma_tile(const bf16_t* kbase, size_t kstride, const bf16_t* vbase, size_t vstride, unsigned char* stage, int lane, int wid) {
#pragma unroll
    for (int i = 0; i < 2; ++i) {
        const int pc = wid * 2 + i;
        const int r = pc * 8 + (lane >> 3);
        const int c = (lane & 7) ^ ((r >> 1) & 7);
        __builtin_amdgcn_global_load_lds((const unsigned*)(kbase + (size_t)r * kstride + c * 8), (unsigned*)(stage + pc * 1024), 16, 0, 0);
        __builtin_amdgcn_global_load_lds((const unsigned*)(vbase + (size_t)r * vstride + c * 8), (unsigned*)(stage + 8192 + pc * 1024), 16, 0, 0);
    }
}
DEV void nsa_scores(const unsigned char* stage, const bf16x8 (&qf)[2][2], f32x4 (&sc)[4][2], int fr, int fq) {
    const int sw = (fr >> 1) & 7;
    const int c0 = (fq ^ sw) << 4;
    const unsigned char* rowp = stage + fr * 128;
    const unsigned char* p0 = rowp + c0;
    const unsigned char* p1 = rowp + (c0 ^ 64);
#pragma unroll
    for (int kt = 0; kt < 4; ++kt) {
        const bf16x8 k0 = *(const bf16x8*)(p0 + kt * 2048);
        const bf16x8 k1 = *(const bf16x8*)(p1 + kt * 2048);
#pragma unroll
        for (int qt = 0; qt < 2; ++qt) {
            f32x4 a = (f32x4){0.f, 0.f, 0.f, 0.f};
            a = __builtin_amdgcn_mfma_f32_16x16x32_bf16(k0, qf[qt][0], a, 0, 0, 0);
            a = __builtin_amdgcn_mfma_f32_16x16x32_bf16(k1, qf[qt][1], a, 0, 0, 0);
            sc[kt][qt] = a;
        }
    }
}
DEV void nsa_pv(const unsigned char* stage, const f32x4 (&sc)[4][2], f32x4 (&o)[4][2], int fr, int fq) {
    const int sw = (fr >> 1) & 7;
    const int v0 = (((fq >> 1) ^ sw) << 4) + 8 * (fq & 1);
    const unsigned char* rowp = stage + 8192 + fr * 128;
#pragma unroll
    for (int s = 0; s < 2; ++s) {
        u32x4 pf[2];
#pragma unroll
        for (int qt = 0; qt < 2; ++qt) {
            pf[qt][0] = pk_bf16(sc[2 * s][qt][0], sc[2 * s][qt][1]);
            pf[qt][1] = pk_bf16(sc[2 * s][qt][2], sc[2 * s][qt][3]);
            pf[qt][2] = pk_bf16(sc[2 * s + 1][qt][0], sc[2 * s + 1][qt][1]);
            pf[qt][3] = pk_bf16(sc[2 * s + 1][qt][2], sc[2 * s + 1][qt][3]);
        }
        const unsigned char* plo = rowp + (v0 ^ (64 * s));
        const unsigned char* phi = rowp + (v0 ^ (64 * s) ^ 32);
#pragma unroll
        for (int dt = 0; dt < 4; ++dt) {
            const uint2 lo = *(const uint2*)(plo + dt * 2048);
            const uint2 hi = *(const uint2*)(phi + dt * 2048);
            u32x4 vv;
            vv[0] = lo.x; vv[1] = lo.y; vv[2] = hi.x; vv[3] = hi.y;
            const bf16x8 vf = __builtin_bit_cast(bf16x8, vv);
#pragma unroll
            for (int qt = 0; qt < 2; ++qt)
                o[dt][qt] = __builtin_amdgcn_mfma_f32_16x16x32_bf16(vf, __builtin_bit_cast(bf16x8, pf[qt]), o[dt][qt], 0, 0, 0);
        }
    }
}
DEV float xmax4(float v) { v = fmaxf(v, __shfl_xor(v, 16)); return fmaxf(v, __shfl_xor(v, 32)); }
DEV float xsum4(float v) { v += __shfl_xor(v, 16); return v + __shfl_xor(v, 32); }

DEV void nsa_branch(const int mode, const int BR, const int q0v, const unsigned char* wsb, unsigned char* lds, int b, int g, unsigned blocks, const bf16x8 (&qf)[2][2], const int (&qpos)[2],
                    const unsigned (&selm)[2], const float (&gate)[2], f32x4 (&fin)[4][2], int tid) {
    asm volatile("" : "+v"(tid));
    const int fr = tid & 15, fq = (tid >> 4) & 3;
    const bf16_t* HB = (const bf16_t*)(wsb + WS_HB);
    const bf16_t* VT = (const bf16_t*)(wsb + WS_VT);
    const bf16_t* kb0 = HB + (size_t)(b * S_) * INC + (BR == 0 ? C_KS : C_KW) + g * 64;
    const bf16_t* vb0 = VT + ((((size_t)BR * B_ + b) * 2 + g) * 64) * 2048;
    const bool fake = mode == 1;
    float m[2] = {-1e30f, -1e30f}, l[2] = {0.f, 0.f};
    f32x4 o[4][2];
#pragma unroll
    for (int dt = 0; dt < 4; ++dt)
#pragma unroll
        for (int qt = 0; qt < 2; ++qt) o[dt][qt] = (f32x4){0.f, 0.f, 0.f, 0.f};
    const int lane64 = tid & 63, widx = __builtin_amdgcn_readfirstlane(tid >> 6);
    int kb = __builtin_ctz(blocks);
    blocks &= blocks - 1;
    int kb1 = blocks ? __builtin_ctz(blocks) : -1;
    if (kb1 >= 0) blocks &= blocks - 1;
    nsa_dma_tile(kb0 + (size_t)(fake ? 0 : kb) * 64 * INC, INC, vb0 + (fake ? 0 : kb) * 64, 2048, lds, lane64, widx);
    if (kb1 >= 0) nsa_dma_tile(kb0 + (size_t)(fake ? 0 : kb1) * 64 * INC, INC, vb0 + (fake ? 0 : kb1) * 64, 2048, lds + 16384, lane64, widx);
    int slot = 0;
    while (true) {
        if (kb1 >= 0) asm volatile("s_waitcnt vmcnt(4)\n\ts_waitcnt lgkmcnt(0)" ::: "memory");
        else asm volatile("s_waitcnt vmcnt(0)\n\ts_waitcnt lgkmcnt(0)" ::: "memory");
        __builtin_amdgcn_s_barrier(); asm volatile("" ::: "memory");
        const int kb2 = blocks ? __builtin_ctz(blocks) : -1;
        if (kb2 >= 0) {
            blocks &= blocks - 1;
            const int s2 = slot >= 1 ? slot - 1 : 2;
            nsa_dma_tile(kb0 + (size_t)(fake ? 0 : kb2) * 64 * INC, INC, vb0 + (fake ? 0 : kb2) * 64, 2048, lds + s2 * 16384, lane64, widx);
        }
        const unsigned char* stage = lds + slot * 16384;
        f32x4 sc[4][2];
        nsa_scores(stage, qf, sc, fr, fq);
        constexpr float C1 = 0.125f * 1.4426950408889634f;
        const bool need_mask = (BR == 0) ? (kb == (q0v >> 6)) : !((kb * 64 + 63 <= q0v) && (kb * 64 + 511 >= q0v + 31));
        float alpha[2];
        if (!need_mask) {
#pragma unroll
            for (int qt = 0; qt < 2; ++qt) {
                const bool sel = BR == 0 ? ((selm[qt] >> kb) & 1u) != 0u : true;
                float bm = -1e30f;
#pragma unroll
                for (int kt = 0; kt < 4; ++kt)
#pragma unroll
                    for (int i = 0; i < 4; ++i) {
                        const float s = sel ? sc[kt][qt][i] * C1 : -1e30f;
                        sc[kt][qt][i] = s;
                        bm = fmaxf(bm, s);
                    }
                bm = xmax4(bm);
                const float mn = fmaxf(m[qt], bm);
                alpha[qt] = __builtin_amdgcn_exp2f(m[qt] - mn);
                float ps = 0.f;
#pragma unroll
                for (int kt = 0; kt < 4; ++kt)
#pragma unroll
                    for (int i = 0; i < 4; ++i) {
                        const float s = sc[kt][qt][i];
                        const float e = (s > -1e29f) ? __builtin_amdgcn_exp2f(s - mn) : 0.f;
                        sc[kt][qt][i] = e;
                        ps += e;
                    }
                l[qt] = l[qt] * alpha[qt] + ps;
                m[qt] = mn;
            }
        } else {
#pragma unroll
            for (int qt = 0; qt < 2; ++qt) {
                const bool sel = BR == 0 ? ((selm[qt] >> kb) & 1u) != 0u : true;
                float bm = -1e30f;
#pragma unroll
                for (int kt = 0; kt < 4; ++kt)
#pragma unroll
                    for (int i = 0; i < 4; ++i) {
                        const int key = kb * 64 + kt * 16 + fq * 4 + i;
                        bool valid = sel && (key <= qpos[qt]);
                        if (BR == 1) valid = valid && (key + 511 >= qpos[qt]);
                        const float s = valid ? sc[kt][qt][i] * C1 : -1e30f;
                        sc[kt][qt][i] = s;
                        bm = fmaxf(bm, s);
                    }
                bm = xmax4(bm);
                const float mn = fmaxf(m[qt], bm);
                alpha[qt] = __builtin_amdgcn_exp2f(m[qt] - mn);
                float ps = 0.f;
#pragma unroll
                for (int kt = 0; kt < 4; ++kt)
#pragma unroll
                    for (int i = 0; i < 4; ++i) {
                        const float s = sc[kt][qt][i];
                        const float e = (s > -1e29f) ? __builtin_amdgcn_exp2f(s - mn) : 0.f;
                        sc[kt][qt][i] = e;
                        ps += e;
                    }
                l[qt] = l[qt] * alpha[qt] + ps;
                m[qt] = mn;
            }
        }
        {
#pragma unroll
            for (int qt = 0; qt < 2; ++qt)
#pragma unroll
                for (int dt = 0; dt < 4; ++dt) o[dt][qt] *= alpha[qt];
        }
        if (mode != 3) nsa_pv(stage, sc, o, fr, fq);
        else { asm volatile("" :: "v"(sc[0][0][0]), "v"(sc[1][1][1]), "v"(sc[2][0][2]), "v"(sc[3][1][3])); }
        if (kb1 < 0) break;
        kb = kb1;
        kb1 = kb2;
        slot = slot == 2 ? 0 : slot + 1;
    }
#pragma unroll
    for (int qt = 0; qt < 2; ++qt) {
        const float lt = xsum4(l[qt]);
        const float sc2 = lt > 0.f ? gate[qt] / lt : 0.f;
#pragma unroll
        for (int dt = 0; dt < 4; ++dt) fin[dt][qt] += o[dt][qt] * sc2;
    }
    asm volatile("s_waitcnt lgkmcnt(0)" ::: "memory");
    __builtin_amdgcn_s_barrier(); asm volatile("" ::: "memory");
}

DEV void nsa_item2(const P& p, int b, int g, int qblk, unsigned char* lds, int fake = 0) {
    int tid = threadIdx.x;
    asm volatile("" : "+v"(tid));
    const int lane = tid & 63, wid = tid >> 6, fr = lane & 15, fq = lane >> 4;
    const int q0 = qblk * 32, cur = q0 >> 6, h = g * 4 + wid;
    unsigned char* wsb = p.ws;
    asm volatile("" : "+s"(wsb));
    const bf16_t* HB = (const bf16_t*)(wsb + WS_HB);
    float* IMPW = (float*)(lds + NSA_IMP);
    float* SCORE = (float*)(lds + NSA_SCORE);
    unsigned* SELM = (unsigned*)(lds + NSA_SELM);
    bf16x8 qf[2][2];
    int qpos[2];
#pragma unroll
    for (int qt = 0; qt < 2; ++qt) {
        qpos[qt] = q0 + qt * 16 + fr;
        const bf16_t* rowp = HB + (size_t)(b * S_ + qpos[qt]) * INC;
#pragma unroll
        for (int ks = 0; ks < 2; ++ks) qf[qt][ks] = *(const bf16x8*)(rowp + C_QA + h * 64 + ks * 32 + fq * 8);
    }
    if (tid < 33) SELM[tid] = 0u;
    f32x4 fin[4][2];
#pragma unroll
    for (int dt = 0; dt < 4; ++dt)
#pragma unroll
        for (int qt = 0; qt < 2; ++qt) fin[dt][qt] = (f32x4){0.f, 0.f, 0.f, 0.f};
    {
        const bf16_t* KCB = (const bf16_t*)(wsb + WS_KCB) + (size_t)(b * 2 + g) * 128 * 64;
        const bf16_t* VCT = (const bf16_t*)(wsb + WS_VCT) + (size_t)(b * 2 + g) * 64 * 128;
        {
            const int widx = __builtin_amdgcn_readfirstlane(wid);
            nsa_dma_tile(KCB, 64, VCT, 128, lds, lane, widx);
            nsa_dma_tile(KCB + 64 * 64, 64, VCT + 64, 128, lds + 16384, lane, widx);
            asm volatile("s_waitcnt vmcnt(0)" ::: "memory");
        }
        __syncthreads();
        int nv[2];
        float mx[2] = {-1e30f, -1e30f}, inv[2];
#pragma unroll
        for (int qt = 0; qt < 2; ++qt) nv[qt] = qpos[qt] >= 31 ? (((qpos[qt] - 31) >> 4) + 1) : 0;
#pragma unroll 1
        for (int kb = 0; kb < 2; ++kb) {
            f32x4 sc[4][2];
            nsa_scores(lds + kb * 16384, qf, sc, fr, fq);
#pragma unroll
            for (int qt = 0; qt < 2; ++qt)
#pragma unroll
                for (int kt = 0; kt < 4; ++kt)
#pragma unroll
                    for (int i = 0; i < 4; ++i) {
                        const int n = kb * 64 + kt * 16 + fq * 4 + i;
                        mx[qt] = fmaxf(mx[qt], (n < nv[qt]) ? sc[kt][qt][i] * 0.125f : -1e30f);
                    }
        }
        float ps[2] = {0.f, 0.f};
#pragma unroll
        for (int qt = 0; qt < 2; ++qt) mx[qt] = xmax4(mx[qt]);
#pragma unroll 1
        for (int kb = 0; kb < 2; ++kb) {
            f32x4 sc[4][2];
            nsa_scores(lds + kb * 16384, qf, sc, fr, fq);
#pragma unroll
            for (int qt = 0; qt < 2; ++qt)
#pragma unroll
                for (int kt = 0; kt < 4; ++kt)
#pragma unroll
                    for (int i = 0; i < 4; ++i) {
                        const int n = kb * 64 + kt * 16 + fq * 4 + i;
                        ps[qt] += (n < nv[qt]) ? __expf(sc[kt][qt][i] * 0.125f - mx[qt]) : 0.f;
                    }
        }
#pragma unroll
        for (int qt = 0; qt < 2; ++qt) {
            ps[qt] = xsum4(ps[qt]);
            inv[qt] = ps[qt] > 0.f ? 1.f / ps[qt] : 0.f;
        }
        float prev3[2] = {0.f, 0.f};
#pragma unroll 1
        for (int kb = 0; kb < 2; ++kb) {
            f32x4 sc[4][2];
            nsa_scores(lds + kb * 16384, qf, sc, fr, fq);
#pragma unroll
            for (int qt = 0; qt < 2; ++qt) {
                float* impw = IMPW + (wid * 32 + qt * 16 + fr) * 32 + kb * 16 + fq;
#pragma unroll
                for (int kt = 0; kt < 4; ++kt) {
                    f32x4 pv;
#pragma unroll
                    for (int i = 0; i < 4; ++i) {
                        const int n = kb * 64 + kt * 16 + fq * 4 + i;
                        pv[i] = (n < nv[qt]) ? __expf(sc[kt][qt][i] * 0.125f - mx[qt]) * inv[qt] : 0.f;
                    }
                    sc[kt][qt] = pv;
                    const float c1 = __shfl_up(pv[3], 16);
                    const float c0 = __shfl(prev3[qt], fr + 48);
                    impw[kt * 4] = pv[0] + pv[1] + pv[2] + pv[3] + (fq > 0 ? c1 : c0);
                    prev3[qt] = pv[3];
                }
            }
            nsa_pv(lds + kb * 16384, sc, fin, fr, fq);
        }
#pragma unroll
        for (int qt = 0; qt < 2; ++qt) {
            const float gc = fsigmoid(bf2f(HB[(size_t)(b * S_ + qpos[qt]) * INC + C_GATE + h * 3 + 0]));
#pragma unroll
            for (int dt = 0; dt < 4; ++dt) fin[dt][qt] *= gc;
        }
    }
    __syncthreads();
    {
        const int q = tid >> 3, jg = tid & 7;
#pragma unroll
        for (int u = 0; u < 4; ++u) {
            const int j = jg * 4 + u;
            const float imp = IMPW[(0 * 32 + q) * 32 + j] + IMPW[(1 * 32 + q) * 32 + j] + IMPW[(2 * 32 + q) * 32 + j] + IMPW[(3 * 32 + q) * 32 + j];
            float score;
            if (j > cur) score = -INFINITY;
            else if (j == 0 || j == cur || j == cur - 1) score = 1e4f;
            else score = imp;
            SCORE[q * 33 + j] = score;
        }
        __syncthreads();
        unsigned bits = 0u;
#pragma unroll
        for (int u = 0; u < 4; ++u) {
            const int j = jg * 4 + u;
            const float sj = SCORE[q * 33 + j];
            int rank = 0;
#pragma unroll 8
            for (int i = 0; i < 32; ++i) {
                const float si = SCORE[q * 33 + i];
                rank += ((si > sj) || (si == sj && i < j)) ? 1 : 0;
            }
            if (j <= cur && rank < 16) bits |= 1u << j;
        }
        atomicOr(&SELM[q], bits);
        atomicOr(&SELM[32], bits);
        __syncthreads();
    }
    unsigned selm[2];
    selm[0] = SELM[fr];
    selm[1] = SELM[16 + fr];
    const unsigned um = SELM[32];
    __syncthreads();
#pragma unroll 1
    for (int br = 0; br < 2; ++br) {
        const int wlo = (q0 - 511) > 0 ? ((q0 - 511) >> 6) : 0;
        const unsigned wmask = ((2u << cur) - 1u) & ~((1u << wlo) - 1u);
        float gs[2];
#pragma unroll
        for (int qt = 0; qt < 2; ++qt) gs[qt] = fsigmoid(bf2f(HB[(size_t)(b * S_ + qpos[qt]) * INC + C_GATE + h * 3 + 1 + br]));
        if (fake != 2) nsa_branch(fake, br, q0, wsb, lds, b, g, br ? wmask : um, qf, qpos, selm, gs, fin, tid);
    }
    bf16_t* OM = (bf16_t*)(wsb + WS_OM);
#pragma unroll
    for (int qt = 0; qt < 2; ++qt)
#pragma unroll
        for (int dt = 0; dt < 4; ++dt) {
            uint2 u2;
            u2.x = pk_bf16(fin[dt][qt][0], fin[dt][qt][1]);
            u2.y = pk_bf16(fin[dt][qt][2], fin[dt][qt][3]);
            *(uint2*)(OM + (size_t)(b * S_ + qpos[qt]) * 1024 + h * 64 + dt * 16 + fq * 4) = u2;
        }
}

DEV void hgrn_prep_item(const P& p, int item, float* smem) {
    const int c = item & 31, bh = item >> 5, hh = bh & 3, b = bh >> 2;
    const int tid = threadIdx.x, d = tid & 127, th = tid >> 7;
    const bf16_t* HB = (const bf16_t*)(p.ws + WS_HB);
    unsigned char* hs = (unsigned char*)p.out;
    bf16_t* QT = (bf16_t*)(hs + HS_QT);
    bf16_t* KT = (bf16_t*)(hs + HS_KT);
    bf16_t* KHT = (bf16_t*)(hs + HS_KHT);
    bf16_t* VIT = (bf16_t*)(hs + HS_VIT);
    float lbv;
    {
        const float l0 = p.lb_logits[hh * 128 + d], l1 = p.lb_logits[512 + hh * 128 + d];
        const float mx = fmaxf(l0, l1);
        const float e0 = expf(l0 - mx), e1 = expf(l1 - mx);
        lbv = e0 / (e0 + e1);
    }
    const size_t trow0 = (size_t)b * S_ + c * 64 + th * 32;
    float kk[32], bl[32];
    float run = 0.f;
#pragma unroll
    for (int i = 0; i < 32; ++i) {
        const float fl = bf2f(HB[(trow0 + i) * INC + C_HF + hh * 128 + d]);
        const float f = lbv + (1.f - lbv) * fsigmoid(fl);
        kk[i] = 1.f - f;
        run += __logf(f);
        bl[i] = run;
    }
    smem[th * 128 + d] = run;
    __syncthreads();
    const float off = th ? smem[d] : 0.f;
    const float blast = smem[d] + smem[128 + d];
    unsigned kh[16], vi[16];
#pragma unroll
    for (int i = 0; i < 32; i += 2) {
        float qv[2], kt[2], khv[2], vv[2];
#pragma unroll
        for (int u = 0; u < 2; ++u) {
            const float bb = bl[i + u] + off;
            const size_t tr = trow0 + i + u;
            const float q = bf2f(HB[tr * INC + C_HQ + hh * 128 + d]);
            vv[u] = bf2f(HB[tr * INC + C_HI + hh * 128 + d]);
            qv[u] = q * __expf(bb);
            kt[u] = kk[i + u] * __expf(fminf(-bb, 80.f));
            khv[u] = kk[i + u] * __expf(blast - bb);
            const size_t o = ((size_t)bh * 2048 + c * 64 + th * 32 + i + u) * 128 + d;
            QT[o] = f2bf(qv[u]);
            KT[o] = f2bf(kt[u]);
        }
        kh[i >> 1] = pk_bf16(khv[0], khv[1]);
        vi[i >> 1] = pk_bf16(vv[0], vv[1]);
    }
    {
        const size_t o = ((size_t)bh * 128 + d) * 2048 + c * 64 + th * 32;
#pragma unroll
        for (int j = 0; j < 4; ++j) {
            u32x4 a, bq;
            a[0] = kh[4 * j]; a[1] = kh[4 * j + 1]; a[2] = kh[4 * j + 2]; a[3] = kh[4 * j + 3];
            bq[0] = vi[4 * j]; bq[1] = vi[4 * j + 1]; bq[2] = vi[4 * j + 2]; bq[3] = vi[4 * j + 3];
            *(u32x4*)(KHT + o + j * 8) = a;
            *(u32x4*)(VIT + o + j * 8) = bq;
        }
    }
    if (th == 0) ((float*)(p.ws + WS_EB))[((size_t)bh * 32 + c) * 128 + d] = expf(blast);
    __syncthreads();
}

DEV bf16x8 ld2x8(const bf16_t* p0, const bf16_t* p1) {
    const uint2 lo = *(const uint2*)p0, hi = *(const uint2*)p1;
    u32x4 v;
    v[0] = lo.x; v[1] = lo.y; v[2] = hi.x; v[3] = hi.y;
    return __builtin_bit_cast(bf16x8, v);
}
struct HgRegs { u32x4 a[4], b[4]; };
DEV void hg_loadA(HgRegs& r, const bf16_t* KT, const bf16_t* QT, int s0, int tid) {
    const unsigned off = (unsigned)(((tid >> 4) * 128 + (tid & 15) * 8) * 2);
    const char* kb = (const char*)(KT + (size_t)s0 * 128);
    const char* qb = (const char*)(QT + (size_t)s0 * 128);
#pragma unroll
    for (int i = 0; i < 4; ++i) {
        r.a[i] = *(const u32x4*)(kb + i * 4096 + off);
        r.b[i] = *(const u32x4*)(qb + i * 4096 + off);
    }
}
DEV void hg_storeA(const HgRegs& r, unsigned char* lds, int tid) {
    const int c16 = tid & 15, r16 = tid >> 4;
    const int o16 = r16 * 256 + ((c16 ^ (r16 & 15)) << 4);
#pragma unroll
    for (int i = 0; i < 4; ++i) {
        *(u32x4*)(lds + o16 + i * 4096) = r.a[i];
        *(u32x4*)(lds + 16384 + o16 + i * 4096) = r.b[i];
    }
}
DEV void hg_loadB(HgRegs& r, const bf16_t* KHT, const bf16_t* VIT, int s0, int tid) {
    const unsigned off = (unsigned)(((tid >> 3) * 2048 + (tid & 7) * 8) * 2);
    const char* kb = (const char*)(KHT + s0);
    const char* vb = (const char*)(VIT + s0);
#pragma unroll
    for (int i = 0; i < 4; ++i) {
        r.a[i] = *(const u32x4*)(kb + (size_t)i * 131072 + off);
        r.b[i] = *(const u32x4*)(vb + (size_t)i * 131072 + off);
    }
}
DEV void hg_storeB(const HgRegs& r, unsigned char* lds, int tid) {
    const int c8 = tid & 7, r8 = tid >> 3;
    const int o8 = r8 * 128 + ((c8 ^ ((r8 >> 1) & 7)) << 4);
#pragma unroll
    for (int i = 0; i < 4; ++i) {
        *(u32x4*)(lds + 32768 + o8 + i * 4096) = r.a[i];
        *(u32x4*)(lds + 49152 + o8 + i * 4096) = r.b[i];
    }
}
DEV void hgrn_chain_item(const P& p, int bh, unsigned char* lds) {
    const int hh = bh & 3, b = bh >> 2;
    int tid = threadIdx.x;
    asm volatile("" : "+v"(tid));
    const int lane = tid & 63, wid = tid >> 6, fr = lane & 15, fq = lane >> 4;
    const unsigned char* hs = (const unsigned char*)p.out;
    const bf16_t* QT = (const bf16_t*)(hs + HS_QT) + (size_t)bh * 2048 * 128;
    const bf16_t* KT = (const bf16_t*)(hs + HS_KT) + (size_t)bh * 2048 * 128;
    const bf16_t* KHT = (const bf16_t*)(hs + HS_KHT) + (size_t)bh * 128 * 2048;
    const bf16_t* VIT = (const bf16_t*)(hs + HS_VIT) + (size_t)bh * 128 * 2048;
    const float* EB = (const float*)(p.ws + WS_EB) + (size_t)bh * 32 * 128;
    const bf16_t* HB = (const bf16_t*)(p.ws + WS_HB);
    bf16_t* OM = (bf16_t*)(p.ws + WS_OM);
    const unsigned char* sKT = lds;
    const unsigned char* sQT = lds + 16384;
    const unsigned char* sKH = lds + 32768;
    const unsigned char* sVI = lds + 49152;
    bf16_t* AT = (bf16_t*)lds;
    float* SS = (float*)(lds + 65536);
    f32x4 S[8][2];
#pragma unroll
    for (int i = 0; i < 8; ++i)
#pragma unroll
        for (int j = 0; j < 2; ++j) S[i][j] = (f32x4){0.f, 0.f, 0.f, 0.f};
    const int dv0 = wid * 32;
    const int sw8 = (fr >> 1) & 7;
    int b256[4];
#pragma unroll
    for (int ks = 0; ks < 4; ++ks) b256[ks] = fr * 256 + (((4 * ks + fq) ^ fr) << 4);
    int p256[4][2];
#pragma unroll
    for (int u = 0; u < 4; ++u)
#pragma unroll
        for (int h = 0; h < 2; ++h) p256[u][h] = fr * 256 + (((4 * u + 2 * h + (fq >> 1)) ^ fr) << 4) + 8 * (fq & 1);
    int b128[2];
#pragma unroll
    for (int ks = 0; ks < 2; ++ks) b128[ks] = fr * 128 + (((4 * ks + fq) ^ sw8) << 4);
    {
        HgRegs r;
        hg_loadA(r, KT, QT, 0, tid);
        hg_storeA(r, lds, tid);
        hg_loadB(r, KHT, VIT, 0, tid);
        hg_storeB(r, lds, tid);
    }
    __syncthreads();
#pragma unroll 1
    for (int c = 0; c < 32; ++c) {
        const int s0 = c * 64;
        HgRegs nx;
        if (c + 1 < 32) hg_loadA(nx, KT, QT, s0 + 64, tid);
        uint2 atp[4];
        {
            bf16x8 qf[4];
#pragma unroll
            for (int ks = 0; ks < 4; ++ks) qf[ks] = *(const bf16x8*)(sQT + wid * 4096 + b256[ks]);
#pragma unroll
            for (int st = 0; st < 4; ++st) {
                f32x4 a = (f32x4){0.f, 0.f, 0.f, 0.f};
#pragma unroll
                for (int ks = 0; ks < 4; ++ks) {
                    const bf16x8 kf = *(const bf16x8*)(sKT + st * 4096 + b256[ks]);
                    a = __builtin_amdgcn_mfma_f32_16x16x32_bf16(kf, qf[ks], a, 0, 0, 0);
                }
                const int t = wid * 16 + fr;
                float av[4];
#pragma unroll
                for (int i = 0; i < 4; ++i) av[i] = (st * 16 + fq * 4 + i <= t) ? a[i] : 0.f;
                atp[st].x = pk_bf16(av[0], av[1]);
                atp[st].y = pk_bf16(av[2], av[3]);
            }
        }
        __syncthreads();
#pragma unroll
        for (int st = 0; st < 4; ++st) *(uint2*)(AT + (wid * 16 + fr) * 72 + st * 16 + fq * 4) = atp[st];
        __syncthreads();
        f32x4 o[2][4];
#pragma unroll
        for (int i = 0; i < 2; ++i)
#pragma unroll
            for (int j = 0; j < 4; ++j) o[i][j] = (f32x4){0.f, 0.f, 0.f, 0.f};
        bf16x8 vf[2][2];
#pragma unroll
        for (int dvt = 0; dvt < 2; ++dvt)
#pragma unroll
            for (int ks = 0; ks < 2; ++ks) vf[dvt][ks] = *(const bf16x8*)(sVI + wid * 4096 + dvt * 2048 + b128[ks]);
#pragma unroll
        for (int ks = 0; ks < 2; ++ks)
#pragma unroll
            for (int tt = 0; tt < 4; ++tt) {
                const bf16x8 af = *(const bf16x8*)(AT + (tt * 16 + fr) * 72 + ks * 32 + fq * 8);
#pragma unroll
                for (int dvt = 0; dvt < 2; ++dvt) o[dvt][tt] = __builtin_amdgcn_mfma_f32_16x16x32_bf16(vf[dvt][ks], af, o[dvt][tt], 0, 0, 0);
            }
#pragma unroll
        for (int u = 0; u < 4; ++u) {
            bf16x8 sf[2];
#pragma unroll
            for (int dvt = 0; dvt < 2; ++dvt) {
                u32x4 w;
                w[0] = pk_bf16(S[2 * u][dvt][0], S[2 * u][dvt][1]);
                w[1] = pk_bf16(S[2 * u][dvt][2], S[2 * u][dvt][3]);
                w[2] = pk_bf16(S[2 * u + 1][dvt][0], S[2 * u + 1][dvt][1]);
                w[3] = pk_bf16(S[2 * u + 1][dvt][2], S[2 * u + 1][dvt][3]);
                sf[dvt] = __builtin_bit_cast(bf16x8, w);
            }
#pragma unroll
            for (int tt = 0; tt < 4; ++tt) {
                const uint2 lo = *(const uint2*)(sQT + tt * 4096 + p256[u][0]);
                const uint2 hi = *(const uint2*)(sQT + tt * 4096 + p256[u][1]);
                u32x4 w;
                w[0] = lo.x; w[1] = lo.y; w[2] = hi.x; w[3] = hi.y;
                const bf16x8 qf2 = __builtin_bit_cast(bf16x8, w);
#pragma unroll
                for (int dvt = 0; dvt < 2; ++dvt) o[dvt][tt] = __builtin_amdgcn_mfma_f32_16x16x32_bf16(sf[dvt], qf2, o[dvt][tt], 0, 0, 0);
            }
        }
        u32x4 op[4];
#pragma unroll
        for (int tt = 0; tt < 4; ++tt) {
            float ss = 0.f;
#pragma unroll
            for (int dvt = 0; dvt < 2; ++dvt)
#pragma unroll
                for (int i = 0; i < 4; ++i) ss += o[dvt][tt][i] * o[dvt][tt][i];
            ss = xsum4(ss);
            if (fq == 0) SS[wid * 64 + tt * 16 + fr] = ss;
            op[tt][0] = pk_bf16(o[0][tt][0], o[0][tt][1]);
            op[tt][1] = pk_bf16(o[0][tt][2], o[0][tt][3]);
            op[tt][2] = pk_bf16(o[1][tt][0], o[1][tt][1]);
            op[tt][3] = pk_bf16(o[1][tt][2], o[1][tt][3]);
        }
        __syncthreads();
        if (c + 1 < 32) { hg_storeA(nx, lds, tid); hg_loadB(nx, KHT, VIT, s0 + 64, tid); }
        uint2 gg[4][2];
#pragma unroll
        for (int tt = 0; tt < 4; ++tt)
#pragma unroll
            for (int dvt = 0; dvt < 2; ++dvt)
                gg[tt][dvt] = *(const uint2*)(HB + ((size_t)b * S_ + s0 + tt * 16 + fr) * INC + C_HG + hh * 128 + dv0 + dvt * 16 + fq * 4);
        {
            bf16x8 vf3[2][2];
#pragma unroll
            for (int dvt = 0; dvt < 2; ++dvt)
#pragma unroll
                for (int ks = 0; ks < 2; ++ks) vf3[dvt][ks] = *(const bf16x8*)(sVI + wid * 4096 + dvt * 2048 + b128[ks]);
#pragma unroll
            for (int dkt = 0; dkt < 8; ++dkt) {
                const float4 eb = *(const float4*)(EB + c * 128 + dkt * 16 + fq * 4);
                bf16x8 kf[2];
#pragma unroll
                for (int ks = 0; ks < 2; ++ks) kf[ks] = *(const bf16x8*)(sKH + dkt * 2048 + b128[ks]);
#pragma unroll
                for (int dvt = 0; dvt < 2; ++dvt) {
                    f32x4 a = S[dkt][dvt];
                    a[0] *= eb.x; a[1] *= eb.y; a[2] *= eb.z; a[3] *= eb.w;
                    a = __builtin_amdgcn_mfma_f32_16x16x32_bf16(kf[0], vf3[dvt][0], a, 0, 0, 0);
                    a = __builtin_amdgcn_mfma_f32_16x16x32_bf16(kf[1], vf3[dvt][1], a, 0, 0, 0);
                    S[dkt][dvt] = a;
                }
            }
        }
        __syncthreads();
        if (c + 1 < 32) hg_storeB(nx, lds, tid);
#pragma unroll
        for (int tt = 0; tt < 4; ++tt) {
            const int t = tt * 16 + fr;
            const float tot = SS[t] + SS[64 + t] + SS[128 + t] + SS[192 + t];
            const float rs = rsqrtf(tot * (1.f / 128.f) + LN_EPS);
            const size_t tg = (size_t)b * S_ + s0 + t;
#pragma unroll
            for (int dvt = 0; dvt < 2; ++dvt) {
                const int dv = dv0 + dvt * 16 + fq * 4;
                const float g0 = bflo(gg[tt][dvt].x), g1 = bfhi(gg[tt][dvt].x), g2 = bflo(gg[tt][dvt].y), g3 = bfhi(gg[tt][dvt].y);
                const float4 nwv = *(const float4*)(p.hg_norm_w + hh * 128 + dv);
                const unsigned w0 = op[tt][2 * dvt], w1 = op[tt][2 * dvt + 1];
                const float r0 = bflo(w0) * rs * nwv.x * (g0 * fsigmoid(g0));
                const float r1 = bfhi(w0) * rs * nwv.y * (g1 * fsigmoid(g1));
                const float r2 = bflo(w1) * rs * nwv.z * (g2 * fsigmoid(g2));
                const float r3 = bfhi(w1) * rs * nwv.w * (g3 * fsigmoid(g3));
                uint2 u2;
                u2.x = pk_bf16(r0, r1);
                u2.y = pk_bf16(r2, r3);
                *(uint2*)(OM + tg * 1024 + 512 + hh * 128 + dv) = u2;
            }
        }
        __syncthreads();
    }
}


DEV void hgrn_prep_item2(const P& p, int item, unsigned char* lds) {
    const int c = item & 31, bh = item >> 5, hh = bh & 3, b = bh >> 2;
    int tid = threadIdx.x;
    asm volatile("" : "+v"(tid));
    const int d = tid & 127, th = tid >> 7;
    const int lane = tid & 63, wid = tid >> 6, fr = lane & 15, fq = lane >> 4;
    const bf16_t* HB = (const bf16_t*)(p.ws + WS_HB);
    unsigned char* hs = (unsigned char*)p.out;
    bf16_t* QTg = (bf16_t*)(hs + HS_QT);
    bf16_t* OIg = (bf16_t*)(hs + HS_OI);
    uint2* DSg = (uint2*)(hs + HS_DS);
    float* tots = (float*)(lds + 65536);
    unsigned char* sKT = lds;
    unsigned char* sQT = lds + 16384;
    unsigned char* sKH = lds + 32768;
    unsigned char* sVI = lds + 49152;
    float lbv;
    {
        const float l0 = p.lb_logits[hh * 128 + d], l1 = p.lb_logits[512 + hh * 128 + d];
        const float mx = fmaxf(l0, l1);
        const float e0 = expf(l0 - mx), e1 = expf(l1 - mx);
        lbv = e0 / (e0 + e1);
    }
    const size_t trow0 = (size_t)b * S_ + c * 64 + th * 32;
    const float nwd = p.hg_norm_w[hh * 128 + d];
    float bl[32];
    float run = 0.f;
#pragma unroll
    for (int i = 0; i < 32; ++i) {
        const float fl = bf2f(HB[(trow0 + i) * INC + C_HF + hh * 128 + d]);
        const float f = lbv + (1.f - lbv) * fsigmoid(fl);
        run += __logf(f);
        bl[i] = run;
    }
    tots[th * 128 + d] = run;
    __syncthreads();
    const float off = th ? tots[d] : 0.f;
    const float blast = tots[d] + tots[128 + d];
#pragma unroll
    for (int j = 0; j < 4; ++j) {
        u32x4 a, bq;
#pragma unroll
        for (int i2 = 0; i2 < 4; ++i2) {
            float khv[2], vv[2];
#pragma unroll
            for (int u = 0; u < 2; ++u) {
                const int i = j * 8 + i2 * 2 + u;
                const float bb = bl[i] + off;
                const float kki = 1.f - __expf(bl[i] - (i ? bl[i > 0 ? i - 1 : 0] : 0.f));
                const size_t tr = trow0 + i;
                const float q = bf2f(HB[tr * INC + C_HQ + hh * 128 + d]);
                vv[u] = bf2f(HB[tr * INC + C_HI + hh * 128 + d]);
                const bf16_t qv = f2bf(q * __expf(bb));
                const bf16_t kt = f2bf(kki * __expf(fminf(-bb, 80.f)));
                khv[u] = kki * __expf(blast - bb);
                const int t = th * 32 + i;
                QTg[((size_t)bh * 2048 + c * 64 + t) * 128 + d] = qv;
                {
                    const float gv = bf2f(HB[tr * INC + C_HG + hh * 128 + d]);
                    ((bf16_t*)(p.ws + WS_XB))[((size_t)bh * 2048 + c * 64 + t) * 128 + d] = f2bf(nwd * gv * fsigmoid(gv));
                }
                const int off256 = t * 256 + ((((d >> 3) ^ (t & 15))) << 4) + (d & 7) * 2;
                *(bf16_t*)(sQT + off256) = qv;
                *(bf16_t*)(sKT + off256) = kt;
            }
            a[i2] = pk_bf16(khv[0], khv[1]);
            bq[i2] = pk_bf16(vv[0], vv[1]);
        }
        const int off128 = d * 128 + (((th * 4 + j) ^ ((d >> 1) & 7)) << 4);
        *(u32x4*)(sKH + off128) = a;
        *(u32x4*)(sVI + off128) = bq;
    }
    if (th == 0) ((float*)(p.ws + WS_EB))[((size_t)bh * 32 + c) * 128 + d] = __expf(blast);
    __syncthreads();
    const int sw8 = (fr >> 1) & 7;
    int b256[4];
#pragma unroll
    for (int ks = 0; ks < 4; ++ks) b256[ks] = fr * 256 + (((4 * ks + fq) ^ fr) << 4);
    int b128[2];
#pragma unroll
    for (int ks = 0; ks < 2; ++ks) b128[ks] = fr * 128 + (((4 * ks + fq) ^ sw8) << 4);
    uint2 atp[4];
    {
        bf16x8 qf[4];
#pragma unroll
        for (int ks = 0; ks < 4; ++ks) qf[ks] = *(const bf16x8*)(sQT + wid * 4096 + b256[ks]);
#pragma unroll
        for (int st = 0; st < 4; ++st) {
            f32x4 a = (f32x4){0.f, 0.f, 0.f, 0.f};
#pragma unroll
            for (int ks = 0; ks < 4; ++ks) {
                const bf16x8 kf = *(const bf16x8*)(sKT + st * 4096 + b256[ks]);
                a = __builtin_amdgcn_mfma_f32_16x16x32_bf16(kf, qf[ks], a, 0, 0, 0);
            }
            const int t = wid * 16 + fr;
            float av[4];
#pragma unroll
            for (int i = 0; i < 4; ++i) av[i] = (st * 16 + fq * 4 + i <= t) ? a[i] : 0.f;
            atp[st].x = pk_bf16(av[0], av[1]);
            atp[st].y = pk_bf16(av[2], av[3]);
        }
    }
    __syncthreads();
    bf16_t* AT = (bf16_t*)lds;
#pragma unroll
    for (int st = 0; st < 4; ++st) *(uint2*)(AT + (wid * 16 + fr) * 72 + st * 16 + fq * 4) = atp[st];
    __syncthreads();
    const int dv0 = wid * 32;
    bf16x8 vf[2][2];
#pragma unroll
    for (int dvt = 0; dvt < 2; ++dvt)
#pragma unroll
        for (int ks = 0; ks < 2; ++ks) vf[dvt][ks] = *(const bf16x8*)(sVI + wid * 4096 + dvt * 2048 + b128[ks]);
#pragma unroll
    for (int tt = 0; tt < 4; ++tt) {
        f32x4 o0 = (f32x4){0.f, 0.f, 0.f, 0.f}, o1 = (f32x4){0.f, 0.f, 0.f, 0.f};
#pragma unroll
        for (int ks = 0; ks < 2; ++ks) {
            const bf16x8 af = *(const bf16x8*)(AT + (tt * 16 + fr) * 72 + ks * 32 + fq * 8);
            o0 = __builtin_amdgcn_mfma_f32_16x16x32_bf16(vf[0][ks], af, o0, 0, 0, 0);
            o1 = __builtin_amdgcn_mfma_f32_16x16x32_bf16(vf[1][ks], af, o1, 0, 0, 0);
        }
        bf16_t* op = OIg + ((size_t)bh * 2048 + c * 64 + tt * 16 + fr) * 128 + dv0 + fq * 4;
        *(uint2*)op = make_uint2(pk_bf16(o0[0], o0[1]), pk_bf16(o0[2], o0[3]));
        *(uint2*)(op + 16) = make_uint2(pk_bf16(o1[0], o1[1]), pk_bf16(o1[2], o1[3]));
    }
    uint2* dsp = DSg + ((((size_t)bh * 32 + c) * 4 + wid) * 16) * 64 + lane;
#pragma unroll
    for (int dkt = 0; dkt < 8; ++dkt) {
        bf16x8 kf[2];
#pragma unroll
        for (int ks = 0; ks < 2; ++ks) kf[ks] = *(const bf16x8*)(sKH + dkt * 2048 + b128[ks]);
#pragma unroll
        for (int dvt = 0; dvt < 2; ++dvt) {
            f32x4 a = (f32x4){0.f, 0.f, 0.f, 0.f};
            a = __builtin_amdgcn_mfma_f32_16x16x32_bf16(kf[0], vf[dvt][0], a, 0, 0, 0);
            a = __builtin_amdgcn_mfma_f32_16x16x32_bf16(kf[1], vf[dvt][1], a, 0, 0, 0);
            dsp[(dkt * 2 + dvt) * 64] = make_uint2(pk_bf16(a[0], a[1]), pk_bf16(a[2], a[3]));
        }
    }
    __syncthreads();
}

DEV void hgrn_chain_item2(const P& p, int bh, unsigned char* lds) {
    const int hh = bh & 3, b = bh >> 2;
    int tid = threadIdx.x;
    asm volatile("" : "+v"(tid));
    const int lane = tid & 63, wid = __builtin_amdgcn_readfirstlane(tid >> 6), fr = lane & 15, fq = lane >> 4;
    const unsigned char* hs = (const unsigned char*)p.out;
    const bf16_t* QTg = (const bf16_t*)(hs + HS_QT) + (size_t)bh * 2048 * 128;
    const char* OIb = (const char*)(hs + HS_OI) + ((size_t)bh * 2048 * 128 + wid * 32) * 2;
    const unsigned oioff = (unsigned)((fr * 128 + fq * 4) * 2);
    const char* DSb = (const char*)(hs + HS_DS) + (((size_t)bh * 32 * 4 + wid) * 16 * 64) * 8;
    const unsigned dsoff = (unsigned)(lane * 8);
    const char* GGb = (const char*)(p.ws + WS_XB) + ((size_t)bh * 2048 * 128 + wid * 32) * 2;
    const unsigned ggoff = oioff;
    const float* EB = (const float*)(p.ws + WS_EB) + (size_t)bh * 32 * 128;
    bf16_t* OM = (bf16_t*)(p.ws + WS_OM);
    float* EBL = (float*)(lds + 16384);
    float* SS = (float*)(lds + 16896);
    const int dv0 = wid * 32;
    int p256[4][2];
#pragma unroll
    for (int u = 0; u < 4; ++u)
#pragma unroll
        for (int h = 0; h < 2; ++h) p256[u][h] = fr * 256 + (((4 * u + 2 * h + (fq >> 1)) ^ fr) << 4) + 8 * (fq & 1);
    const int c16 = tid & 15, r16 = tid >> 4;
    const int o16 = r16 * 256 + ((c16 ^ (r16 & 15)) << 4);
    const unsigned qoff = (unsigned)((r16 * 128 + c16 * 8) * 2);
    f32x4 S[2][2];
    f32x4* SL = (f32x4*)(lds + 17920) + wid * 768 + lane;
#pragma unroll
    for (int i = 0; i < 2; ++i)
#pragma unroll
        for (int j = 0; j < 2; ++j) S[i][j] = (f32x4){0.f, 0.f, 0.f, 0.f};
#pragma unroll
    for (int i = 0; i < 12; ++i) SL[i * 64] = (f32x4){0.f, 0.f, 0.f, 0.f};
    uint2 oi[4][2], dsr[8][2];
    {
        const char* qb = (const char*)QTg;
#pragma unroll
        for (int i = 0; i < 4; ++i) *(u32x4*)(lds + o16 + i * 4096) = *(const u32x4*)(qb + i * 4096 + qoff);
        if (tid < 32) *(u32x4*)(EBL + tid * 4) = *(const u32x4*)(EB + tid * 4);
#pragma unroll
        for (int tt = 0; tt < 4; ++tt)
#pragma unroll
            for (int dvt = 0; dvt < 2; ++dvt) {
                oi[tt][dvt] = *(const uint2*)(OIb + tt * 4096 + dvt * 32 + oioff);
            }
#pragma unroll
        for (int dkt = 0; dkt < 8; ++dkt)
#pragma unroll
            for (int dvt = 0; dvt < 2; ++dvt) dsr[dkt][dvt] = *(const uint2*)(DSb + (dkt * 2 + dvt) * 512 + dsoff);
    }
    __syncthreads();
#pragma unroll 1
    for (int c = 0; c < 32; ++c) {
        const int s0 = c * 64;
        const bool more = c + 1 < 32;
        uint2 gg[4][2];
#pragma unroll
        for (int tt = 0; tt < 4; ++tt)
#pragma unroll
            for (int dvt = 0; dvt < 2; ++dvt) gg[tt][dvt] = *(const uint2*)(GGb + (size_t)s0 * 256 + tt * 4096 + dvt * 32 + ggoff);
        f32x4 o[2][4];
#pragma unroll
        for (int tt = 0; tt < 4; ++tt)
#pragma unroll
            for (int dvt = 0; dvt < 2; ++dvt) {
                o[dvt][tt] = (f32x4){bflo(oi[tt][dvt].x), bfhi(oi[tt][dvt].x), bflo(oi[tt][dvt].y), bfhi(oi[tt][dvt].y)};
                if (more) oi[tt][dvt] = *(const uint2*)(OIb + (size_t)(s0 + 64) * 256 + tt * 4096 + dvt * 32 + oioff);
            }
        const unsigned char* sQ = lds;
#pragma unroll
        for (int u = 0; u < 4; ++u) {
            bf16x8 sf[2];
#pragma unroll
            for (int dvt = 0; dvt < 2; ++dvt) {
                const f32x4 sa = u < 1 ? S[0][dvt] : SL[((2 * u - 2) * 2 + dvt) * 64];
                const f32x4 sb = u < 1 ? S[1][dvt] : SL[((2 * u - 1) * 2 + dvt) * 64];
                u32x4 w;
                w[0] = pk_bf16(sa[0], sa[1]);
                w[1] = pk_bf16(sa[2], sa[3]);
                w[2] = pk_bf16(sb[0], sb[1]);
                w[3] = pk_bf16(sb[2], sb[3]);
                sf[dvt] = __builtin_bit_cast(bf16x8, w);
            }
#pragma unroll
            for (int tt = 0; tt < 4; ++tt) {
                const uint2 lo = *(const uint2*)(sQ + tt * 4096 + p256[u][0]);
                const uint2 hi = *(const uint2*)(sQ + tt * 4096 + p256[u][1]);
                u32x4 w;
                w[0] = lo.x; w[1] = lo.y; w[2] = hi.x; w[3] = hi.y;
                const bf16x8 qf2 = __builtin_bit_cast(bf16x8, w);
#pragma unroll
                for (int dvt = 0; dvt < 2; ++dvt) o[dvt][tt] = __builtin_amdgcn_mfma_f32_16x16x32_bf16(sf[dvt], qf2, o[dvt][tt], 0, 0, 0);
            }
        }
        u32x4 qn[4], ebn;
        if (more) {
            const char* qb = (const char*)(QTg + (size_t)(s0 + 64) * 128);
#pragma unroll
            for (int i = 0; i < 4; ++i) qn[i] = *(const u32x4*)(qb + i * 4096 + qoff);
            if (tid < 32) ebn = *(const u32x4*)(EB + (c + 1) * 128 + tid * 4);
        }
#pragma unroll
        for (int dkt = 0; dkt < 8; ++dkt) {
            const float4 eb = *(const float4*)(EBL + dkt * 16 + fq * 4);
#pragma unroll
            for (int dvt = 0; dvt < 2; ++dvt) {
                const uint2 dd = dsr[dkt][dvt];
                f32x4 sv = dkt < 2 ? S[dkt < 2 ? dkt : 0][dvt] : SL[((dkt - 2) * 2 + dvt) * 64];
                sv[0] = fmaf(sv[0], eb.x, bflo(dd.x));
                sv[1] = fmaf(sv[1], eb.y, bfhi(dd.x));
                sv[2] = fmaf(sv[2], eb.z, bflo(dd.y));
                sv[3] = fmaf(sv[3], eb.w, bfhi(dd.y));
                if (dkt < 2) S[dkt < 2 ? dkt : 0][dvt] = sv; else SL[((dkt - 2) * 2 + dvt) * 64] = sv;
                if (more) dsr[dkt][dvt] = *(const uint2*)(DSb + (size_t)(c + 1) * 32768 + (dkt * 2 + dvt) * 512 + dsoff);
            }
        }
#pragma unroll
        for (int tt = 0; tt < 4; ++tt) {
            float ss = 0.f;
#pragma unroll
            for (int dvt = 0; dvt < 2; ++dvt)
#pragma unroll
                for (int i = 0; i < 4; ++i) ss += o[dvt][tt][i] * o[dvt][tt][i];
            ss = xsum4(ss);
            if (fq == 0) SS[wid * 64 + tt * 16 + fr] = ss;
        }
        __syncthreads();
#pragma unroll
        for (int tt = 0; tt < 4; ++tt) {
            const int t = tt * 16 + fr;
            const float tot = SS[t] + SS[64 + t] + SS[128 + t] + SS[192 + t];
            const float rs = rsqrtf(tot * (1.f / 128.f) + LN_EPS);
            const size_t tg = (size_t)b * S_ + s0 + t;
#pragma unroll
            for (int dvt = 0; dvt < 2; ++dvt) {
                const int dv = dv0 + dvt * 16 + fq * 4;
                const float r0 = o[dvt][tt][0] * rs * bflo(gg[tt][dvt].x);
                const float r1 = o[dvt][tt][1] * rs * bfhi(gg[tt][dvt].x);
                const float r2 = o[dvt][tt][2] * rs * bflo(gg[tt][dvt].y);
                const float r3 = o[dvt][tt][3] * rs * bfhi(gg[tt][dvt].y);
                *(uint2*)(OM + tg * 1024 + 512 + hh * 128 + dv) = make_uint2(pk_bf16(r0, r1), pk_bf16(r2, r3));
            }
        }
        if (more) {
#pragma unroll
            for (int i = 0; i < 4; ++i) *(u32x4*)(lds + o16 + i * 4096) = qn[i];
            if (tid < 32) *(u32x4*)(EBL + tid * 4) = ebn;
        }
        __syncthreads();
    }
}

DEV void xattn_item2(const P& p, int item) {
    const int qt64 = item & 31, hh = (item >> 5) & 3, b = item >> 7;
    const int lane = threadIdx.x & 63, wid = threadIdx.x >> 6, fr = lane & 15, fq = lane >> 4;
    const bf16_t* QX = (const bf16_t*)(p.ws + WS_QX);
    const bf16_t* KVM = (const bf16_t*)(p.ws + WS_KVM);
    const bf16_t* VMT = (const bf16_t*)(p.ws + WS_VMT) + (size_t)(b * 4 + hh) * 256 * 256;
    bf16_t* OX = (bf16_t*)(p.ws + WS_OX);
    const size_t tq = (size_t)b * S_ + qt64 * 64 + wid * 16 + fr;
    bf16x8 qf[8];
#pragma unroll
    for (int ks = 0; ks < 8; ++ks) qf[ks] = *(const bf16x8*)(QX + tq * 1024 + hh * 256 + ks * 32 + fq * 8);
    f32x4 sc[16];
#pragma unroll
    for (int kt = 0; kt < 16; ++kt) {
        f32x4 a = (f32x4){0.f, 0.f, 0.f, 0.f};
        const bf16_t* kp = KVM + (size_t)(b * ML_ + kt * 16 + fr) * 2048 + hh * 256 + fq * 8;
#pragma unroll
        for (int ks = 0; ks < 8; ++ks) a = __builtin_amdgcn_mfma_f32_16x16x32_bf16(*(const bf16x8*)(kp + ks * 32), qf[ks], a, 0, 0, 0);
        sc[kt] = a;
    }
    float mx = -1e30f;
#pragma unroll
    for (int kt = 0; kt < 16; ++kt)
#pragma unroll
        for (int i = 0; i < 4; ++i) { sc[kt][i] *= 0.0625f; mx = fmaxf(mx, sc[kt][i]); }
    mx = xmax4(mx);
    float ps = 0.f;
#pragma unroll
    for (int kt = 0; kt < 16; ++kt)
#pragma unroll
        for (int i = 0; i < 4; ++i) { sc[kt][i] = __expf(sc[kt][i] - mx); ps += sc[kt][i]; }
    ps = xsum4(ps);
    const float inv = 1.f / ps;
    u32x4 pf[8];
#pragma unroll
    for (int s = 0; s < 8; ++s) {
        pf[s][0] = pk_bf16(sc[2 * s][0] * inv, sc[2 * s][1] * inv);
        pf[s][1] = pk_bf16(sc[2 * s][2] * inv, sc[2 * s][3] * inv);
        pf[s][2] = pk_bf16(sc[2 * s + 1][0] * inv, sc[2 * s + 1][1] * inv);
        pf[s][3] = pk_bf16(sc[2 * s + 1][2] * inv, sc[2 * s + 1][3] * inv);
    }
#pragma unroll 1
    for (int dh = 0; dh < 2; ++dh) {
        f32x4 o[8];
#pragma unroll
        for (int dt = 0; dt < 8; ++dt) o[dt] = (f32x4){0.f, 0.f, 0.f, 0.f};
#pragma unroll
        for (int s = 0; s < 8; ++s) {
#pragma unroll
            for (int dt = 0; dt < 8; ++dt) {
                const bf16_t* vp = VMT + (size_t)(dh * 128 + dt * 16 + fr) * 256 + 32 * s + 4 * fq;
                o[dt] = __builtin_amdgcn_mfma_f32_16x16x32_bf16(ld2x8(vp, vp + 16), __builtin_bit_cast(bf16x8, pf[s]), o[dt], 0, 0, 0);
            }
        }
#pragma unroll
        for (int dt = 0; dt < 8; ++dt) {
            uint2 u2;
            u2.x = pk_bf16(o[dt][0], o[dt][1]);
            u2.y = pk_bf16(o[dt][2], o[dt][3]);
            *(uint2*)(OX + tq * 1024 + hh * 256 + dh * 128 + dt * 16 + fq * 4) = u2;
        }
    }
}


struct XaRegs { u32x4 r[8]; };
DEV void xa_loadK(XaRegs& x, const bf16_t* kbase, int tid) {
    const int c = tid & 31, r0 = tid >> 5;
#pragma unroll
    for (int i = 0; i < 8; ++i) x.r[i] = *(const u32x4*)(kbase + (size_t)(r0 + 8 * i) * 2048 + c * 8);
}
DEV void xa_storeK(const XaRegs& x, unsigned char* lds, int tid) {
    const int c = tid & 31, r0 = tid >> 5;
#pragma unroll
    for (int i = 0; i < 8; ++i) {
        const int row = r0 + 8 * i;
        *(u32x4*)(lds + row * 512 + ((c ^ (row & 15)) << 4)) = x.r[i];
    }
}
DEV void xa_loadV(XaRegs& x, const bf16_t* vbase, int tid) {
    const int c = tid & 7, r0 = tid >> 3;
#pragma unroll
    for (int i = 0; i < 8; ++i) x.r[i] = *(const u32x4*)(vbase + (size_t)(r0 + 32 * i) * 256 + c * 8);
}
DEV void xa_storeV(const XaRegs& x, unsigned char* lds, int tid) {
    const int c = tid & 7, r0 = tid >> 3;
    const int o = r0 * 128 + ((c ^ ((r0 >> 1) & 7)) << 4);
#pragma unroll
    for (int i = 0; i < 8; ++i) *(u32x4*)(lds + 32768 + o + i * 4096) = x.r[i];
}
DEV void xattn_item3(const P& p, int item, unsigned char* lds) {
    const int qt64 = item & 31, hh = (item >> 5) & 3, b = item >> 7;
    int tid = threadIdx.x;
    asm volatile("" : "+v"(tid));
    const int lane = tid & 63, wid = tid >> 6, fr = lane & 15, fq = lane >> 4;
    const bf16_t* QX = (const bf16_t*)(p.ws + WS_QX);
    const bf16_t* KB = (const bf16_t*)(p.ws + WS_KVM) + (size_t)(b * ML_) * 2048 + hh * 256;
    const bf16_t* VB = (const bf16_t*)(p.ws + WS_VMT) + (size_t)(b * 4 + hh) * 256 * 256;
    bf16_t* OX = (bf16_t*)(p.ws + WS_OX);
    const size_t tq = (size_t)b * S_ + qt64 * 64 + wid * 16 + fr;
    bf16x8 qf[8];
#pragma unroll
    for (int ks = 0; ks < 8; ++ks) qf[ks] = *(const bf16x8*)(QX + tq * 1024 + hh * 256 + ks * 32 + fq * 8);
    f32x4 o[16];
#pragma unroll
    for (int dt = 0; dt < 16; ++dt) o[dt] = (f32x4){0.f, 0.f, 0.f, 0.f};
    float m = -1e30f, l = 0.f;
    {
        XaRegs x;
        xa_loadK(x, KB, tid);
        xa_storeK(x, lds, tid);
        xa_loadV(x, VB, tid);
        xa_storeV(x, lds, tid);
    }
    __syncthreads();
    const int sw8 = (fr >> 1) & 7;
#pragma unroll 1
    for (int j = 0; j < 4; ++j) {
        XaRegs nx;
        if (j + 1 < 4) xa_loadK(nx, KB + (size_t)(j + 1) * 64 * 2048, tid);
        f32x4 sc[4];
#pragma unroll
        for (int kt = 0; kt < 4; ++kt) {
            f32x4 a = (f32x4){0.f, 0.f, 0.f, 0.f};
            const unsigned char* rp = lds + (kt * 16 + fr) * 512;
#pragma unroll
            for (int ks = 0; ks < 8; ++ks) a = __builtin_amdgcn_mfma_f32_16x16x32_bf16(*(const bf16x8*)(rp + (((4 * ks + fq) ^ fr) << 4)), qf[ks], a, 0, 0, 0);
            sc[kt] = a;
        }
        __syncthreads();
        if (j + 1 < 4) { xa_storeK(nx, lds, tid); xa_loadV(nx, VB + (j + 1) * 64, tid); }
        float bm = -1e30f;
#pragma unroll
        for (int kt = 0; kt < 4; ++kt)
#pragma unroll
            for (int i = 0; i < 4; ++i) { sc[kt][i] *= 0.0625f; bm = fmaxf(bm, sc[kt][i]); }
        bm = xmax4(bm);
        const float mn = fmaxf(m, bm);
        const float alpha = __expf(m - mn);
        float ps = 0.f;
#pragma unroll
        for (int kt = 0; kt < 4; ++kt)
#pragma unroll
            for (int i = 0; i < 4; ++i) { sc[kt][i] = __expf(sc[kt][i] - mn); ps += sc[kt][i]; }
        l = l * alpha + ps;
        m = mn;
#pragma unroll
        for (int dt = 0; dt < 16; ++dt) o[dt] *= alpha;
#pragma unroll
        for (int s = 0; s < 2; ++s) {
            u32x4 w;
            w[0] = pk_bf16(sc[2 * s][0], sc[2 * s][1]);
            w[1] = pk_bf16(sc[2 * s][2], sc[2 * s][3]);
            w[2] = pk_bf16(sc[2 * s + 1][0], sc[2 * s + 1][1]);
            w[3] = pk_bf16(sc[2 * s + 1][2], sc[2 * s + 1][3]);
            const bf16x8 pf = __builtin_bit_cast(bf16x8, w);
#pragma unroll
            for (int dt = 0; dt < 16; ++dt) {
                const unsigned char* rp = lds + 32768 + (dt * 16 + fr) * 128 + 8 * (fq & 1);
                const uint2 lo = *(const uint2*)(rp + (((4 * s + (fq >> 1)) ^ sw8) << 4));
                const uint2 hi = *(const uint2*)(rp + (((4 * s + 2 + (fq >> 1)) ^ sw8) << 4));
                u32x4 vv;
                vv[0] = lo.x; vv[1] = lo.y; vv[2] = hi.x; vv[3] = hi.y;
                o[dt] = __builtin_amdgcn_mfma_f32_16x16x32_bf16(__builtin_bit_cast(bf16x8, vv), pf, o[dt], 0, 0, 0);
            }
        }
        __syncthreads();
        if (j + 1 < 4) xa_storeV(nx, lds, tid);
        __syncthreads();
    }
    const float inv = 1.f / xsum4(l);
#pragma unroll
    for (int dt = 0; dt < 16; ++dt) {
        uint2 u2;
        u2.x = pk_bf16(o[dt][0] * inv, o[dt][1] * inv);
        u2.y = pk_bf16(o[dt][2] * inv, o[dt][3] * inv);
        *(uint2*)(OX + tq * 1024 + hh * 256 + dt * 16 + fq * 4) = u2;
    }
}


DEV void peer_quant_row(const float* src, unsigned char* dst, float* scl, int row, int* rsum = nullptr) {
    const int lane = threadIdx.x & 63;
    const float* r = src + (size_t)row * 1024 + lane * 16;
    float v[16];
#pragma unroll
    for (int i = 0; i < 4; ++i) {
        const float4 a = *(const float4*)(r + 4 * i);
        v[4 * i] = a.x; v[4 * i + 1] = a.y; v[4 * i + 2] = a.z; v[4 * i + 3] = a.w;
    }
    float mx = 0.f;
#pragma unroll
    for (int i = 0; i < 16; ++i) mx = fmaxf(mx, fabsf(v[i]));
    mx = wmax(mx);
    const float q = mx > 0.f ? 127.f / mx : 0.f;
    u32x4 w;
    int usum = 0;
#pragma unroll
    for (int i = 0; i < 4; ++i) {
        unsigned pk = 0u;
#pragma unroll
        for (int k = 0; k < 4; ++k) {
            int qi = (int)rintf(v[4 * i + k] * q);
            qi = qi < -127 ? -127 : (qi > 127 ? 127 : qi);
            pk |= (unsigned)(qi + 128) << (8 * k);
            usum += qi + 128;
        }
        w[i] = pk;
    }
    *(u32x4*)(dst + ((size_t)(lane >> 3) * 16384 + row) * 128 + (lane & 7) * 16) = w;
    if (rsum) {
#pragma unroll
        for (int o = 32; o > 0; o >>= 1) usum += __shfl_xor(usum, o);
        if (lane == 0) rsum[row] = usum;
    }
    if (lane == 0) scl[row] = mx * (1.f / 127.f);
}

DEV unsigned f2ord(float f) { const unsigned b = __float_as_uint(f); return b ^ ((b >> 31) ? 0xffffffffu : 0x80000000u); }
DEV float ord2f(unsigned o) { return __uint_as_float((o & 0x80000000u) ? (o ^ 0x80000000u) : ~o); }
DEV void ins16(unsigned (&v)[16], unsigned x) {
#pragma unroll
    for (int k = 0; k < 16; ++k) {
        const unsigned t = v[k] > x ? v[k] : x;
        x = v[k] > x ? x : v[k];
        v[k] = t;
    }
}
constexpr int PEER_SC = 0;
constexpr int PEER_LST = 0;
constexpr int PEER_EID = 16384;
constexpr int PEER_GATE = 16384 + 4096;
DEV void peer_route_item(const P& p, int item, unsigned char* lds) {
    const int tid = threadIdx.x, lane = tid & 63, wid = tid >> 6;
    const int t0 = item * 16;
    const bf16_t* QP = (const bf16_t*)(p.ws + WS_QP);
    const bf16_t* PK = (const bf16_t*)(p.ws + WS_PKEY);
    unsigned* SC = (unsigned*)(lds + PEER_SC);
    const int fr = lane & 15, fq = lane >> 4;
    unsigned lst[16];
#pragma unroll
    for (int k = 0; k < 16; ++k) lst[k] = 0u;
    bf16x8 qf[4][2];
#pragma unroll
    for (int ci = 0; ci < 4; ++ci)
#pragma unroll
        for (int ks = 0; ks < 2; ++ks)
            qf[ci][ks] = *(const bf16x8*)(QP + (size_t)(t0 + fr) * 1024 + (4 * wid + ci) * 64 + ks * 32 + fq * 8);
#pragma unroll 1
    for (int pass = 0; pass < 2; ++pass) {
#pragma unroll
        for (int ci = 0; ci < 4; ++ci) {
            const int cb = 4 * wid + ci;
#pragma unroll
            for (int kt = 0; kt < 4; ++kt) {
                f32x4 acc = (f32x4){0.f, 0.f, 0.f, 0.f};
#pragma unroll
                for (int ks = 0; ks < 2; ++ks) {
                    const bf16x8 kf = *(const bf16x8*)(PK + ((size_t)cb * 128 + pass * 64 + kt * 16 + fr) * 64 + ks * 32 + fq * 8);
                    acc = __builtin_amdgcn_mfma_f32_16x16x32_bf16(kf, qf[ci][ks], acc, 0, 0, 0);
                }
                unsigned* dst = SC + (cb * 16 + fr) * 65 + kt * 16 + fq * 4;
#pragma unroll
                for (int i = 0; i < 4; ++i) {
                    const int kidx = pass * 64 + kt * 16 + fq * 4 + i;
                    dst[i] = (f2ord(acc[i]) & ~127u) | (unsigned)(127 - kidx);
                }
            }
        }
        __syncthreads();
        {
            const unsigned* row = SC + tid * 65;
#pragma unroll 4
            for (int k = 0; k < 64; ++k) ins16(lst, row[k]);
        }
        __syncthreads();
    }
    unsigned* LST = (unsigned*)(lds + PEER_LST);
#pragma unroll
    for (int k = 0; k < 16; ++k) LST[tid * 16 + k] = lst[k];
    __syncthreads();
    unsigned short* EID = (unsigned short*)(lds + PEER_EID);
    float* GATE = (float*)(lds + PEER_GATE);
    if (((tid >> 4) & 1) == 0) {
        const int tok = tid & 15, hh = tid >> 5;
        const unsigned* l2 = LST + (tid + 16) * 16;
        float s1[16], s2[16];
#pragma unroll
        for (int k = 0; k < 16; ++k) { s1[k] = ord2f(lst[k] & ~127u); s2[k] = ord2f(l2[k] & ~127u); }
        unsigned fin[16];
#pragma unroll
        for (int k = 0; k < 16; ++k) fin[k] = 0u;
#pragma unroll
        for (int i = 0; i < 16; ++i)
#pragma unroll
            for (int j = 0; j < 16; ++j)
                if ((i + 1) * (j + 1) <= 16) ins16(fin, (f2ord(s1[i] + s2[j]) & ~255u) | (unsigned)(255 - (i * 16 + j)));
        const float mx = ord2f(fin[0] & ~255u);
        float w[16], ws = 0.f;
#pragma unroll
        for (int k = 0; k < 16; ++k) { w[k] = expf(ord2f(fin[k] & ~255u) - mx); ws += w[k]; }
        const float inv = 1.f / ws;
#pragma unroll
        for (int k = 0; k < 16; ++k) {
            const int flat = 255 - (int)(fin[k] & 255u);
            const int i1 = 127 - (int)(LST[tid * 16 + (flat >> 4)] & 127u);
            const int i2 = 127 - (int)(l2[flat & 15] & 127u);
            EID[tok * 128 + hh * 16 + k] = (unsigned short)(i1 * 128 + i2);
            GATE[tok * 128 + hh * 16 + k] = w[k] * inv;
        }
    }
    __syncthreads();
    {
        unsigned short* EIDP = (unsigned short*)(p.ws + WS_EIDP);
        float* GATEP = (float*)(p.ws + WS_GATEP);
        for (int i = tid; i < 16 * 128; i += 256) {
            const int tok = i >> 7, pi = i & 127, eg = pi >> 4, k = pi & 15, slot = 8 * k + eg;
            EIDP[(size_t)(t0 + tok) * 128 + pi] = EID[tok * 128 + slot];
            GATEP[(size_t)(t0 + tok) * 128 + pi] = GATE[tok * 128 + slot];
        }
        unsigned char* XQ = p.ws + WS_XQ;
#pragma unroll 1
        for (int tt = 0; tt < 4; ++tt) {
            const size_t t = (size_t)t0 + wid * 4 + tt;
            const float* row = p.out + t * 1024 + lane * 16;
            float xr[16];
            float amax = 0.f;
#pragma unroll
            for (int i = 0; i < 4; ++i) {
                const float4 a4 = *(const float4*)(row + 4 * i);
                xr[4 * i] = a4.x; xr[4 * i + 1] = a4.y; xr[4 * i + 2] = a4.z; xr[4 * i + 3] = a4.w;
                amax = fmaxf(amax, fmaxf(fmaxf(fabsf(a4.x), fabsf(a4.y)), fmaxf(fabsf(a4.z), fabsf(a4.w))));
            }
            amax = wmax(amax);
            const float qx = amax > 0.f ? 127.f / amax : 0.f;
            u32x4 w;
            int s_ = 0;
#pragma unroll
            for (int i = 0; i < 4; ++i) {
                unsigned pk = 0u;
#pragma unroll
                for (int k = 0; k < 4; ++k) {
                    int qi = (int)rintf(xr[4 * i + k] * qx);
                    qi = qi < -127 ? -127 : (qi > 127 ? 127 : qi);
                    pk |= (unsigned)(qi + 128) << (8 * k);
                    s_ += qi + 128;
                }
                w[i] = pk;
            }
#pragma unroll
            for (int o = 32; o > 0; o >>= 1) s_ += __shfl_xor(s_, o);
            *(u32x4*)(XQ + t * 1024 + lane * 16) = w;
            if (lane == 0) {
                ((float*)(p.ws + WS_SXF))[t] = amax * (1.f / 127.f);
                ((int*)(p.ws + WS_SXI))[t] = s_;
            }
        }
    }
    __syncthreads();
}

DEV void peer_down_item(const P& p, int s, int tile, int lane, int wid) {
    const unsigned char* PD = p.ws + WS_PD + (size_t)s * 16384 * 128;
    const unsigned short* EIDP = (const unsigned short*)(p.ws + WS_EIDP);
    int* DP = (int*)(p.ws + WS_DP) + (size_t)s * T_ * 128;
    const int eg = lane >> 3, cg = lane & 7;
#pragma unroll 1
    for (int tt = 0; tt < 4; ++tt) {
        const size_t t = (size_t)tile * 16 + wid * 4 + tt;
        const u32x4 xu = *(const u32x4*)(p.ws + WS_XQ + t * 1024 + s * 128 + cg * 16);
        const u32x4 e0 = *(const u32x4*)(EIDP + t * 128 + eg * 16);
        const u32x4 e1 = *(const u32x4*)(EIDP + t * 128 + eg * 16 + 8);
        u32x4 rows[16];
#pragma unroll
        for (int k = 0; k < 16; ++k) {
            const unsigned ew = k < 8 ? e0[k >> 1] : e1[(k - 8) >> 1];
            const unsigned e = (k & 1) ? (ew >> 16) : (ew & 0xffffu);
            rows[k] = *(const u32x4*)(PD + (size_t)e * 128 + cg * 16);
        }
        unsigned v[16];
#pragma unroll
        for (int k = 0; k < 16; ++k) {
            unsigned a_ = 0u;
#pragma unroll
            for (int q = 0; q < 4; ++q) a_ = __builtin_amdgcn_udot4(rows[k][q], xu[q], a_, false);
            v[k] = a_;
        }
        unsigned w8[8], w4[4], w2[2];
        {
            const bool hi = (cg & 4) != 0;
#pragma unroll
            for (int j = 0; j < 8; ++j) {
                const unsigned send = hi ? v[j] : v[j + 8];
                const unsigned keep = hi ? v[j + 8] : v[j];
                w8[j] = keep + (unsigned)__shfl_xor((int)send, 4);
            }
        }
        {
            const bool hi = (cg & 2) != 0;
#pragma unroll
            for (int j = 0; j < 4; ++j) {
                const unsigned send = hi ? w8[j] : w8[j + 4];
                const unsigned keep = hi ? w8[j + 4] : w8[j];
                w4[j] = keep + (unsigned)__shfl_xor((int)send, 2);
            }
        }
        {
            const bool hi = (cg & 1) != 0;
#pragma unroll
            for (int j = 0; j < 2; ++j) {
                const unsigned send = hi ? w4[j] : w4[j + 2];
                const unsigned keep = hi ? w4[j + 2] : w4[j];
                w2[j] = keep + (unsigned)__shfl_xor((int)send, 1);
            }
        }
        *(uint2*)(DP + t * 128 + eg * 16 + 2 * cg) = make_uint2(w2[0], w2[1]);
    }
}

DEV void peer_coef_item(const P& p, int t, int lane) {
    const int* DP = (const int*)(p.ws + WS_DP);
    const unsigned short* EIDP = (const unsigned short*)(p.ws + WS_EIDP);
    const float* GATEP = (const float*)(p.ws + WS_GATEP);
    const float sx = ((const float*)(p.ws + WS_SXF))[t];
    const int sxu = ((const int*)(p.ws + WS_SXI))[t];
    float cs = 0.f;
#pragma unroll
    for (int h = 0; h < 2; ++h) {
        const int pi = lane + 64 * h;
        int tot = 0;
#pragma unroll
        for (int s = 0; s < 8; ++s) tot += DP[((size_t)s * T_ + t) * 128 + pi];
        const int e = EIDP[(size_t)t * 128 + pi];
        const int dotq = tot - 128 * ((const int*)(p.ws + WS_PRS))[e] - 128 * sxu + 128 * 128 * 1024;
        const float hv = ((const float*)(p.ws + WS_PSD))[e] * sx * (float)dotq;
        const float coef = 0.5f * hv * (1.f + erff(hv * 0.7071067811865476f)) * GATEP[(size_t)t * 128 + pi] * ((const float*)(p.ws + WS_PSU))[e];
        ((float*)(p.ws + WS_COEFP))[(size_t)t * 128 + pi] = coef;
        cs += coef;
    }
    cs = wsum(cs);
    if (lane == 0) ((float*)(p.ws + WS_ASUM))[t] = cs;
}

DEV void peer_up_item(const P& p, int s, int tile, int lane, int wid, bool dostore = true) {
    const unsigned char* PU = p.ws + WS_PU + (size_t)s * 16384 * 128;
    const unsigned short* EIDP = (const unsigned short*)(p.ws + WS_EIDP);
    const float* COEFP = (const float*)(p.ws + WS_COEFP);
    const int eg = lane >> 3, cg = lane & 7;
#pragma unroll 1
    for (int tt = 0; tt < 4; ++tt) {
        const size_t t = (size_t)tile * 16 + wid * 4 + tt;
        const u32x4 e0 = *(const u32x4*)(EIDP + t * 128 + eg * 16);
        const u32x4 e1 = *(const u32x4*)(EIDP + t * 128 + eg * 16 + 8);
        float cf[16];
#pragma unroll
        for (int i = 0; i < 4; ++i) {
            const float4 c4 = *(const float4*)(COEFP + t * 128 + eg * 16 + 4 * i);
            cf[4 * i] = c4.x; cf[4 * i + 1] = c4.y; cf[4 * i + 2] = c4.z; cf[4 * i + 3] = c4.w;
        }
        u32x4 rows[16];
#pragma unroll
        for (int k = 0; k < 16; ++k) {
            const unsigned ew = k < 8 ? e0[k >> 1] : e1[(k - 8) >> 1];
            const unsigned e = (k & 1) ? (ew >> 16) : (ew & 0xffffu);
            rows[k] = *(const u32x4*)(PU + (size_t)e * 128 + cg * 16);
        }
        float acc[16];
#pragma unroll
        for (int i = 0; i < 16; ++i) acc[i] = 0.f;
#pragma unroll
        for (int k = 0; k < 16; ++k)
#pragma unroll
            for (int q = 0; q < 4; ++q) {
                const unsigned w_ = rows[k][q];
                acc[4 * q] += cf[k] * (float)(w_ & 0xffu);
                acc[4 * q + 1] += cf[k] * (float)((w_ >> 8) & 0xffu);
                acc[4 * q + 2] += cf[k] * (float)((w_ >> 16) & 0xffu);
                acc[4 * q + 3] += cf[k] * (float)(w_ >> 24);
            }
        float a8[8], a4[4], a2[2];
        {
            const bool hi = (eg & 4) != 0;
#pragma unroll
            for (int j = 0; j < 8; ++j) {
                const float send = hi ? acc[j] : acc[j + 8];
                const float keep = hi ? acc[j + 8] : acc[j];
                a8[j] = keep + __shfl_xor(send, 32);
            }
        }
        {
            const bool hi = (eg & 2) != 0;
#pragma unroll
            for (int j = 0; j < 4; ++j) {
                const float send = hi ? a8[j] : a8[j + 4];
                const float keep = hi ? a8[j + 4] : a8[j];
                a4[j] = keep + __shfl_xor(send, 16);
            }
        }
        {
            const bool hi = (eg & 1) != 0;
#pragma unroll
            for (int j = 0; j < 2; ++j) {
                const float send = hi ? a4[j] : a4[j + 2];
                const float keep = hi ? a4[j + 2] : a4[j];
                a2[j] = keep + __shfl_xor(send, 8);
            }
        }
        const float asum = ((const float*)(p.ws + WS_ASUM))[t];
        float* yp = p.out + t * 1024 + s * 128 + cg * 16 + 2 * eg;
        const float2 xv = *(const float2*)yp;
        if (dostore) *(float2*)yp = make_float2(ALPHA * xv.x + (a2[0] - 128.f * asum), ALPHA * xv.y + (a2[1] - 128.f * asum));
    }
}

DEV void ln3_item(const P& p, int t, int lane) {
    float* row = p.out + (size_t)t * 1024;
    float4 v[4];
    float s = 0.f;
#pragma unroll
    for (int i = 0; i < 4; ++i) {
        v[i] = *(const float4*)(row + (i * 64 + lane) * 4);
        s += v[i].x + v[i].y + v[i].z + v[i].w;
    }
    const float mean = wsum(s) * (1.f / 1024.f);
    float ss = 0.f;
#pragma unroll
    for (int i = 0; i < 4; ++i) {
        v[i].x -= mean; v[i].y -= mean; v[i].z -= mean; v[i].w -= mean;
        ss += v[i].x * v[i].x + v[i].y * v[i].y + v[i].z * v[i].z + v[i].w * v[i].w;
    }
    const float rs = rsqrtf(wsum(ss) * (1.f / 1024.f) + LN_EPS);
#pragma unroll
    for (int i = 0; i < 4; ++i) {
        const int c = (i * 64 + lane) * 4;
        const float4 gg = *(const float4*)(p.ln_g + 2 * 1024 + c);
        const float4 bb = *(const float4*)(p.ln_b + 2 * 1024 + c);
        float4 o;
        o.x = v[i].x * rs * gg.x + bb.x; o.y = v[i].y * rs * gg.y + bb.y; o.z = v[i].z * rs * gg.z + bb.z; o.w = v[i].w * rs * gg.w + bb.w;
        *(float4*)(row + c) = o;
    }
}

#define XB_TMO      128
#define XB_XCNT(j)  (256  + 64 * (j))
#define XB_XSUB(j)  (1280 + 64 * (j))
#define XB_XGEN(j)  (2304 + 64 * (j))
#define XB_TOP      3328
#define XB_TOPGEN   3392
#define XCD_BAR_WORDS 3456
#define XB_SPIN_CAP (1u << 20)
#define LAS __attribute__((address_space(3)))
DEV unsigned xb_ld(unsigned* p) { return __hip_atomic_load(p, __ATOMIC_RELAXED, __HIP_MEMORY_SCOPE_AGENT); }
DEV unsigned xb_add(unsigned* p, unsigned v) { return __hip_atomic_fetch_add(p, v, __ATOMIC_RELAXED, __HIP_MEMORY_SCOPE_AGENT); }
DEV unsigned xb_xcc_id() { return (unsigned)__builtin_amdgcn_s_getreg((3 << 11) | 20) & 0xFu; }
#define XB_SPIN(cond, bar) do { unsigned _sp = 0; while (cond) { __builtin_amdgcn_s_sleep(1); \
    if ((++_sp & 255u) == 0u) { if (xb_ld(&(bar)[XB_TMO])) break; if (_sp > XB_SPIN_CAP) { atomicAdd(&(bar)[XB_TMO], 1u); break; } } } } while (0)
struct XcdBarrier { unsigned* bar; unsigned x; volatile LAS unsigned* st; };
DEV XcdBarrier xcd_barrier_post(unsigned* bar, volatile LAS unsigned* st) {
    XcdBarrier b; b.bar = bar; b.x = xb_xcc_id(); b.st = st;
    if (threadIdx.x == 0) (void)xb_add(&bar[XB_XCNT(b.x)], 1u);
    return b;
}
DEV void xcd_barrier_complete(unsigned* bar, unsigned x, unsigned& nloc, unsigned& nx) {
    const unsigned G = gridDim.x * gridDim.y * gridDim.z;
    unsigned sum, cnt, mine, sp = 0u;
    for (;;) {
        sum = 0u; cnt = 0u; mine = 0u;
#pragma unroll
        for (unsigned j = 0; j < 16; ++j) { const unsigned c = xb_ld(&bar[XB_XCNT(j)]); sum += c; cnt += (c > 0u) ? 1u : 0u; mine = (j == x) ? c : mine; }
        if (sum == G) break;
        __builtin_amdgcn_s_sleep(1);
        if ((++sp & 255u) == 0u) { if (xb_ld(&bar[XB_TMO])) break; if (sp > XB_SPIN_CAP) { atomicAdd(&bar[XB_TMO], 1u); break; } }
    }
    nloc = mine > 0u ? mine : 1u; nx = cnt > 0u ? cnt : 1u;
}
DEV void xcd_barrier(const XcdBarrier& b) {
    asm volatile("s_waitcnt vmcnt(0)" ::: "memory");
    __syncthreads();
    if (threadIdx.x == 0) {
        unsigned* bar = b.bar;
        __builtin_amdgcn_s_waitcnt(0);
        unsigned nloc = b.st[0], nx = b.st[1];
        if (nloc == 0u) { xcd_barrier_complete(bar, b.x, nloc, nx); b.st[0] = nloc; b.st[1] = nx; }
        const unsigned old = xb_add(&bar[XB_XSUB(b.x)], 1u);
        const unsigned gen = old / nloc;
        if (old + 1u == (gen + 1u) * nloc) {
            __builtin_amdgcn_fence(__ATOMIC_RELEASE, "agent");
            asm volatile("s_waitcnt vmcnt(0)" ::: "memory");
            const unsigned og = xb_add(&bar[XB_TOP], 1u);
            const unsigned tg = og / nx;
            if (og + 1u == (tg + 1u) * nx) xb_add(&bar[XB_TOPGEN], 1u);
            else XB_SPIN(xb_ld(&bar[XB_TOPGEN]) == tg, bar);
            __builtin_amdgcn_fence(__ATOMIC_ACQUIRE, "agent");
            xb_add(&bar[XB_XGEN(b.x)], 1u);
            asm volatile("s_waitcnt vmcnt(0)" ::: "memory");
        } else {
            XB_SPIN(xb_ld(&bar[XB_XGEN(b.x)]) == gen, bar);
            __builtin_amdgcn_fence(__ATOMIC_ACQUIRE, "agent");
            asm volatile("s_waitcnt vmcnt(0)" ::: "memory");
        }
    }
    __syncthreads();
}


DEV void late_transpose_item(const P& p, int it, float* smem) {
    const int m = it >> 8, t = it & 255;
    const float* W = m == 0 ? p.w_out : (m == 1 ? p.xa_wq : (m == 2 ? p.xa_wo : p.peer_wq));
    const size_t off = m == 0 ? WS_WOUT_T : (m == 1 ? WS_WQ_T : (m == 2 ? WS_WO_T : WS_PWQ_T));
    transpose_tile(W, 1024, (bf16_t*)(p.ws + off), t >> 4, t & 15, smem);
}

constexpr int WQ_WORD0 = 4096;
DEV int wq_next(unsigned* cnt, int nper, int xcc, unsigned char* lds) {
    volatile unsigned* slot = (volatile unsigned*)(lds + LDS_BYTES - 16);
    __syncthreads();
    if (threadIdx.x == 0) {
        int res = -1;
        int off = (int)slot[1];
        while (off < 8) {
            const int q = (xcc + off) & 7;
            const unsigned idx = atomicAdd(&cnt[q * 64], 1u);
            if (idx < (unsigned)nper) { res = q * nper + (int)idx; break; }
            ++off;
        }
        slot[0] = (unsigned)res;
        slot[1] = (unsigned)off;
    }
    __syncthreads();
    return (int)slot[0];
}
DEV void wq_begin(unsigned char* lds) {
    __syncthreads();
    if (threadIdx.x == 0) ((volatile unsigned*)(lds + LDS_BYTES - 16))[1] = 0u;
}

constexpr int NSTAGES = 12;
template <int ST>
DEV void run_stage(const P& p, unsigned char* lds, int xcc) {
    float* smem = (float*)lds;
    const int nb = gridDim.x, bid = blockIdx.x;
    int tidl = threadIdx.x;
    asm volatile("" : "+v"(tidl));
    const int wave = tidl >> 6;
    unsigned* wqc = (unsigned*)(p.ws + WS_BAR) + WQ_WORD0;
    if (ST == 0) {
        for (int it = bid; it < PREP_END; it += nb) prep_item(p, it, smem);
    } else if (ST == 1) {
        for (int it = bid; it < 1536 + 384 + 128; it += nb) {
            if (it < 1536) gemm_item<0>(p, it & 7, it >> 3, lds);
            else if (it < 1920) { const int i2 = it - 1536, q = i2 & 7, j = i2 >> 3; gemm_mfma_tile<0>(p, q * 16 + (j & 15), 24 + (j >> 4), lds); }
            else gemm_item<1>(p, (it - 1920) & 7, (it - 1920) >> 3, lds);
        }
    } else if (ST == 2) {
        if (PROBE_REP == 21) for (int it = bid; it < 256; it += nb) compress_item2(p, it, lds);
        if (PROBE_REP == 22) for (int it = bid; it < 1024; it += nb) hgrn_prep_item(p, it, smem);
        for (int it = bid; it < 256 + 1024; it += nb) {
            if (it < 256) compress_item2(p, it, lds);
            else hgrn_prep_item2(p, it - 256, lds);
        }
    } else if (ST == 3) {
        if (PROBE_REP == 31) { for (int it = bid; it < 32; it += nb) hgrn_chain_item(p, it, lds); }
        if (PROBE_REP == 32) {
            volatile unsigned* qs2 = (volatile unsigned*)(lds + LDS_BYTES - 16);
            for (;;) {
                __syncthreads();
                if (threadIdx.x == 0) *qs2 = atomicAdd(wqc + 64, 1u);
                __syncthreads();
                const int j = (int)*qs2;
                if (j >= 1024) break;
                nsa_item2(p, (j & 15) >> 1, j & 1, 63 - (j >> 4), lds, p.out != nullptr ? 4 : 0);
            }
        }
        volatile unsigned* qslot = (volatile unsigned*)(lds + LDS_BYTES - 16);
        for (;;) {
            __syncthreads();
            if (threadIdx.x == 0) *qslot = atomicAdd(wqc, 1u);
            __syncthreads();
            const int it = (int)*qslot;
            if (it >= 32 + 1024) break;
            if (it < 32) hgrn_chain_item2(p, it, lds);
            else { const int j = it - 32; nsa_item2(p, (j & 15) >> 1, j & 1, 63 - (j >> 4), lds); }
        }
        for (;;) {
            __syncthreads();
            if (threadIdx.x == 0) *qslot = atomicAdd(wqc + 128, 1u);
            __syncthreads();
            const int it = (int)*qslot;
            if (it >= 2048) break;
            if (it < 1024) late_transpose_item(p, it, smem);
            else {
                const int j = it - 1024, tb = j >> 9, r0 = (j & 511) * 32 + wave * 8;
                for (int r = 0; r < 8; ++r) {
                    if (tb == 0) peer_quant_row(p.peer_down, p.ws + WS_PD, (float*)(p.ws + WS_PSD), r0 + r, (int*)(p.ws + WS_PRS));
                    else peer_quant_row(p.peer_up, p.ws + WS_PU, (float*)(p.ws + WS_PSU), r0 + r);
                }
            }
        }
    } else if (ST == 4) {
        for (int it = bid; it < 512; it += nb) gemm_item<2>(p, it & 7, it >> 3, lds);
    } else if (ST == 5) {
        for (int it = bid; it < T_ / 4; it += nb) ln_item(p, it * 4 + wave, 0, tidl & 63);
    } else if (ST == 9) {
        for (int it = bid; it < T_ / 4; it += nb) ln_item(p, it * 4 + wave, 1, tidl & 63);
    } else if (ST == 6) {
        for (int it = bid; it < 512; it += nb) gemm_item<3>(p, it & 7, it >> 3, lds);
    } else if (ST == 7) {
        for (int it = bid; it < 1024; it += nb) xattn_item3(p, it, lds);
    } else if (ST == 8) {
        for (int it = bid; it < 512; it += nb) gemm_item<4>(p, it & 7, it >> 3, lds);
    } else if (ST == 10) {
        for (int it = bid; it < 512; it += nb) gemm_item<5>(p, it & 7, it >> 3, lds);
    } else if (ST == 11) {
        if (PROBE_REP == 11) for (int it = bid; it < T_ / 16; it += nb) peer_route_item(p, it, lds);
        for (int it = bid; it < T_ / 16; it += nb) peer_route_item(p, it, lds);
    } else if (ST == 12) {
        if (PROBE_REP == 12) { wq_begin(lds); for (int it; (it = wq_next(wqc + 4 * 512, 1024, xcc, lds)) >= 0;) peer_down_item(p, it >> 10, it & 1023, tidl & 63, wave); }
        wq_begin(lds);
        for (int it; (it = wq_next(wqc + 2 * 512, 1024, xcc, lds)) >= 0;) peer_down_item(p, it >> 10, it & 1023, tidl & 63, wave);
    } else if (ST == 13) {
        if (PROBE_REP == 13) for (int it = bid; it < T_ / 4; it += nb) peer_coef_item(p, it * 4 + wave, tidl & 63);
        for (int it = bid; it < T_ / 4; it += nb) peer_coef_item(p, it * 4 + wave, tidl & 63);
    } else if (ST == 14) {
        if (PROBE_REP == 14) { wq_begin(lds); for (int it; (it = wq_next(wqc + 5 * 512, 1024, xcc, lds)) >= 0;) peer_up_item(p, it >> 10, it & 1023, tidl & 63, wave, p.out == nullptr); }
        wq_begin(lds);
        for (int it; (it = wq_next(wqc + 3 * 512, 1024, xcc, lds)) >= 0;) peer_up_item(p, it >> 10, it & 1023, tidl & 63, wave);
    } else if (ST == 15) {
        for (int it = bid; it < T_ / 4; it += nb) ln3_item(p, it * 4 + wave, tidl & 63);
    }
}

template <int ST>
__global__ void __launch_bounds__(256, 2) stage_kernel(P p) {
    __shared__ __attribute__((aligned(16))) unsigned char lds[LDS_BYTES + 16];
    run_stage<ST>(p, lds, (int)xb_xcc_id() & 7);
}

__global__ void __launch_bounds__(256, 2) mega_kernel(P p) {
    __shared__ __attribute__((aligned(16))) unsigned char lds[LDS_BYTES + 16];
    if (threadIdx.x == 0) *(uint4*)(lds + LDS_BYTES) = make_uint4(0u, 0u, 0u, 0u);
    __syncthreads();
    const XcdBarrier xb = xcd_barrier_post((unsigned*)(p.ws + WS_BAR), (volatile LAS unsigned*)(lds + LDS_BYTES));
    const int xcc = (int)xb.x & 7;
    run_stage<0>(p, lds, xcc); xcd_barrier(xb);
    if (PROBE_REP == 0) { run_stage<0>(p, lds, xcc); xcd_barrier(xb); }
    run_stage<1>(p, lds, xcc); xcd_barrier(xb);
    if (PROBE_REP == 1) { run_stage<1>(p, lds, xcc); xcd_barrier(xb); }
    run_stage<2>(p, lds, xcc); xcd_barrier(xb);
    if (PROBE_REP == 2) { run_stage<2>(p, lds, xcc); xcd_barrier(xb); }
    if (PROBE_REP == 35) { if (blockIdx.x < 32) hgrn_chain_item2(p, blockIdx.x, lds); xcd_barrier(xb); }
    run_stage<3>(p, lds, xcc); xcd_barrier(xb);
    run_stage<4>(p, lds, xcc); xcd_barrier(xb);
    if (PROBE_REP == 4) { run_stage<4>(p, lds, xcc); xcd_barrier(xb); }
    if (PROBE_REP == 50) { xcd_barrier(xb); xcd_barrier(xb); xcd_barrier(xb); xcd_barrier(xb); xcd_barrier(xb); xcd_barrier(xb); xcd_barrier(xb); xcd_barrier(xb); }
    run_stage<5>(p, lds, xcc); xcd_barrier(xb);
    run_stage<6>(p, lds, xcc); xcd_barrier(xb);
    if (PROBE_REP == 6) { run_stage<6>(p, lds, xcc); xcd_barrier(xb); }
    run_stage<7>(p, lds, xcc); xcd_barrier(xb);
    if (PROBE_REP == 7) { run_stage<7>(p, lds, xcc); xcd_barrier(xb); }
    run_stage<8>(p, lds, xcc); xcd_barrier(xb);
    run_stage<9>(p, lds, xcc); xcd_barrier(xb);
    run_stage<10>(p, lds, xcc); xcd_barrier(xb);
    if (PROBE_REP == 10) { run_stage<10>(p, lds, xcc); xcd_barrier(xb); }
    run_stage<11>(p, lds, xcc); xcd_barrier(xb);
    run_stage<12>(p, lds, xcc); xcd_barrier(xb);
    run_stage<13>(p, lds, xcc); xcd_barrier(xb);
    run_stage<14>(p, lds, xcc); xcd_barrier(xb);
    run_stage<15>(p, lds, xcc);
}

extern "C" void kernel_launch(void* const* d_in, const int* in_sizes, int n_in, void* d_out, int out_size, void* d_ws, size_t ws_size,
                              hipStream_t stream) {
    if (n_in != 18 || ws_size < WS_END) {
        fprintf(stderr, "kernel_launch: unexpected inputs (n_in %d, ws %zu, need %zu)\n", n_in, ws_size, (size_t)WS_END);
        return;
    }
    P p{};
    p.x = (const float*)d_in[0]; p.mem = (const float*)d_in[1]; p.w_in = (const float*)d_in[2]; p.cmp_pos = (const float*)d_in[3];
    p.cmp_w1 = (const float*)d_in[4]; p.cmp_w2 = (const float*)d_in[5]; p.lb_logits = (const float*)d_in[6];
    p.hg_norm_w = (const float*)d_in[7]; p.w_out = (const float*)d_in[8]; p.xa_wq = (const float*)d_in[9];
    p.xa_wkv = (const float*)d_in[10]; p.xa_wo = (const float*)d_in[11]; p.peer_wq = (const float*)d_in[12];
    p.peer_keys = (const float*)d_in[13]; p.peer_down = (const float*)d_in[14]; p.peer_up = (const float*)d_in[15];
    p.ln_g = (const float*)d_in[16]; p.ln_b = (const float*)d_in[17];
    p.out = (float*)d_out; p.ws = (unsigned char*)d_ws;
#if ONE_LAUNCH
    static int grid_blocks = 0;
    if (!grid_blocks) {
        int dev = 0, cus = 0, per_cu = 0;
        hipGetDevice(&dev);
        hipDeviceGetAttribute(&cus, hipDeviceAttributeMultiprocessorCount, dev);
        hipOccupancyMaxActiveBlocksPerMultiprocessor(&per_cu, mega_kernel, 256, 0);
        if (per_cu > 2) per_cu = 2;
        if (per_cu < 1) per_cu = 1;
        grid_blocks = cus * per_cu;
    }
    (void)hipMemsetAsync((unsigned char*)d_ws + WS_BAR, 0, 65536, stream);
    void* args[] = {&p};
    hipError_t e = hipLaunchCooperativeKernel((void*)mega_kernel, dim3(grid_blocks), dim3(256), args, 0, stream);
    if (e != hipSuccess) fprintf(stderr, "cooperative launch failed: %s (grid %d)\n", hipGetErrorString(e), grid_blocks);
#else
    const int G = 2048;
    stage_kernel<0><<<G, 256, 0, stream>>>(p);
    stage_kernel<1><<<G, 256, 0, stream>>>(p);
    stage_kernel<2><<<G, 256, 0, stream>>>(p);
    stage_kernel<3><<<G, 256, 0, stream>>>(p);
    stage_kernel<4><<<G, 256, 0, stream>>>(p);
    stage_kernel<5><<<G, 256, 0, stream>>>(p);
    stage_kernel<6><<<G, 256, 0, stream>>>(p);
    stage_kernel<7><<<G, 256, 0, stream>>>(p);
    stage_kernel<8><<<G, 256, 0, stream>>>(p);
    stage_kernel<9><<<G, 256, 0, stream>>>(p);
    stage_kernel<10><<<G, 256, 0, stream>>>(p);
    stage_kernel<11><<<G, 256, 0, stream>>>(p);
#endif
}
```

```cpp
#include <hip/hip_runtime.h>
#include <hip/hip_cooperative_groups.h>
#include <cstdio>
#include <cstdint>
namespace cg = cooperative_groups;

#ifndef PROBE_REP
#define PROBE_REP -1
#endif
#ifndef ONE_LAUNCH
#define ONE_LAUNCH 1
#endif

typedef unsigned short bf16_t;
#define DEV __device__ __forceinline__

constexpr int D_ = 1024, B_ = 8, S_ = 2048, T_ = B_ * S_, ML_ = 256, INC = 3352;
constexpr int NCMP = 127;
constexpr int LDS_BYTES = 67584;
constexpr float ALPHA = 1.189207115002721f;
constexpr float LN_EPS = 1e-5f;
constexpr int C_QA = 0, C_KC = 512, C_VC = 640, C_KS = 768, C_VS = 896, C_KW = 1024, C_VW = 1152, C_GATE = 1280,
              C_HQ = 1304, C_HF = 1816, C_HI = 2328, C_HG = 2840;
constexpr size_t WS_HB = 0;
constexpr size_t SZ_HB = (size_t)T_ * INC * 2;
constexpr size_t WS_OM = WS_HB + SZ_HB;
constexpr size_t WS_KVM = WS_OM + (size_t)T_ * 1024 * 2;
constexpr size_t WS_KC = WS_KVM + (size_t)2048 * 2048 * 2;
constexpr size_t WS_XB = WS_KC + (1u << 20);
constexpr size_t WS_WIN_T = WS_XB + (size_t)T_ * 1024 * 2;
constexpr size_t WS_WOUT_T = WS_WIN_T + (size_t)3456 * 1024 * 2;
constexpr size_t WS_WQ_T = WS_WOUT_T + (size_t)1024 * 1024 * 2;
constexpr size_t WS_WKV_T = WS_WQ_T + (size_t)1024 * 1024 * 2;
constexpr size_t WS_WO_T = WS_WKV_T + (size_t)2048 * 1024 * 2;
constexpr size_t WS_PWQ_T = WS_WO_T + (size_t)1024 * 1024 * 2;
constexpr size_t WS_MEMB = WS_PWQ_T + (size_t)1024 * 1024 * 2;
constexpr size_t WS_PKEY = WS_MEMB + (size_t)2048 * 1024 * 2;
constexpr size_t WS_VT = WS_PKEY + (size_t)16 * 128 * 64 * 2;
constexpr size_t WS_KCB = WS_VT + (size_t)2 * B_ * 2 * 64 * 2048 * 2;
constexpr size_t WS_VCT = WS_KCB + (size_t)B_ * 2 * 128 * 64 * 2;
constexpr size_t WS_W1T = WS_VCT + (size_t)B_ * 2 * 128 * 64 * 2;
constexpr size_t WS_W2T = WS_W1T + (size_t)2 * 128 * 2048 * 2;
constexpr size_t WS_CB = WS_W2T + (size_t)2 * 64 * 128 * 2;
constexpr size_t WS_VMT = WS_CB + 1024;
constexpr size_t WS_BAR = WS_VMT + (size_t)B_ * 4 * 256 * 256 * 2;
constexpr size_t WS_PD = WS_BAR + 65536;
constexpr size_t WS_PU = WS_PD + (size_t)16384 * 1024;
constexpr size_t WS_PSD = WS_PU + (size_t)16384 * 1024;
constexpr size_t WS_PSU = WS_PSD + 65536;
constexpr size_t WS_PRS = WS_PSU + 65536;
constexpr size_t WS_END = WS_PRS + 65536;
static_assert(WS_END <= (size_t)268435456, "workspace budget");
constexpr size_t WS_EB = WS_KC;
constexpr size_t HS_QT = 0;
constexpr size_t HS_KT = (size_t)B_ * 4 * 2048 * 128 * 2;
constexpr size_t HS_KHT = 2 * HS_KT;
constexpr size_t HS_VIT = 3 * HS_KT;
constexpr size_t HS_DS = HS_KT;
constexpr size_t HS_OI = 3 * HS_KT;
constexpr size_t WS_QX = 0;
constexpr size_t WS_OX = (size_t)T_ * 1024 * 2;
constexpr size_t WS_QP = 0;
constexpr size_t WS_YB = 0;
constexpr size_t WS_EIDP = (size_t)T_ * 1024 * 2;
constexpr size_t WS_GATEP = WS_EIDP + (size_t)T_ * 128 * 2;
constexpr size_t WS_COEFP = WS_GATEP + (size_t)T_ * 128 * 4;
constexpr size_t WS_XQ = WS_COEFP + (size_t)T_ * 128 * 4;
constexpr size_t WS_SXF = WS_XQ + (size_t)T_ * 1024;
constexpr size_t WS_SXI = WS_SXF + (size_t)T_ * 4;
constexpr size_t WS_ASUM = WS_SXI + (size_t)T_ * 4;
constexpr size_t WS_DP = WS_ASUM + (size_t)T_ * 4;
static_assert(WS_DP + (size_t)8 * T_ * 128 * 4 <= WS_KVM, "PEER intermediates must fit in the dead h/OM region");

struct P {
    const float *x, *mem, *w_in, *cmp_pos, *cmp_w1, *cmp_w2, *lb_logits, *hg_norm_w, *w_out, *xa_wq, *xa_wkv, *xa_wo,
        *peer_wq, *peer_keys, *peer_down, *peer_up, *ln_g, *ln_b;
    float* out;
    unsigned char* ws;
};

DEV unsigned short f2bf(float f) {
    unsigned u = __float_as_uint(f);
    u += 0x7fffu + ((u >> 16) & 1u);
    return (unsigned short)(u >> 16);
}
DEV float bf2f(unsigned short h) { return __uint_as_float(((unsigned)h) << 16); }
DEV float bflo(unsigned u) { return __uint_as_float(u << 16); }
DEV float bfhi(unsigned u) { return __uint_as_float(u & 0xffff0000u); }
typedef __bf16 bf16x2_t __attribute__((ext_vector_type(2)));
typedef float f32x2_t __attribute__((ext_vector_type(2)));
DEV unsigned pk_bf16(float a, float b) {
    f32x2_t v = {a, b};
    bf16x2_t r = __builtin_convertvector(v, bf16x2_t);
    return __builtin_bit_cast(unsigned, r);
}
DEV float wsum(float v) {
#pragma unroll
    for (int o = 32; o > 0; o >>= 1) v += __shfl_xor(v, o);
    return v;
}
DEV float wmax(float v) {
#pragma unroll
    for (int o = 32; o > 0; o >>= 1) v = fmaxf(v, __shfl_xor(v, o));
    return v;
}
DEV float sigmoidf_(float x) { return 1.f / (1.f + expf(-x)); }
DEV float fsigmoid(float x) { return __fdividef(1.f, 1.f + __expf(-x)); }

template <int MODE>
DEV void gemm_tile(const P& p, int tile, float* smem) {
    constexpr bool ABF = (MODE == 2 || MODE == 4);
    constexpr int K = 1024;
    constexpr int N = MODE == 0 ? INC : (MODE == 1 ? 2048 : 1024);
    constexpr int NTN = (N + 63) / 64;
    const int tm = tile / NTN, tn = tile % NTN;
    const float* Af = nullptr;
    const bf16_t* Ab = nullptr;
    const float* Bm = nullptr;
    if (MODE == 0) { Af = p.x; Bm = p.w_in; }
    if (MODE == 1) { Af = p.mem; Bm = p.xa_wkv; }
    if (MODE == 2) { Ab = (const bf16_t*)(p.ws + WS_OM); Bm = p.w_out; }
    if (MODE == 3) { Af = p.out; Bm = p.xa_wq; }
    if (MODE == 4) { Ab = (const bf16_t*)(p.ws + WS_OX); Bm = p.xa_wo; }
    if (MODE == 5) { Af = p.out; Bm = p.peer_wq; }
    float(*sA)[68] = (float(*)[68])smem;
    float(*sB)[68] = (float(*)[68])(smem + 16 * 68);
    const int tid = threadIdx.x, tx = tid & 15, ty = tid >> 4;
    const int ar = tid >> 2, ak = (tid & 3) * 4;
    const int bk = tid >> 4, bn = (tid & 15) * 4;
    float acc[4][4];
#pragma unroll
    for (int i = 0; i < 4; ++i)
#pragma unroll
        for (int j = 0; j < 4; ++j) acc[i][j] = 0.f;
    const int gn = tn * 64 + bn;
    for (int k0 = 0; k0 < K; k0 += 16) {
        float4 av;
        if (ABF) {
            uint2 u = *(const uint2*)(Ab + (size_t)(tm * 64 + ar) * K + k0 + ak);
            av.x = bflo(u.x); av.y = bfhi(u.x); av.z = bflo(u.y); av.w = bfhi(u.y);
        } else {
            av = *(const float4*)(Af + (size_t)(tm * 64 + ar) * K + k0 + ak);
        }
        float4 bv = make_float4(0.f, 0.f, 0.f, 0.f);
        if (gn < N) bv = *(const float4*)(Bm + (size_t)(k0 + bk) * N + gn);
        sA[ak + 0][ar] = av.x; sA[ak + 1][ar] = av.y; sA[ak + 2][ar] = av.z; sA[ak + 3][ar] = av.w;
        *(float4*)&sB[bk][bn] = bv;
        __syncthreads();
#pragma unroll
        for (int kk = 0; kk < 16; ++kk) {
            float4 a = *(const float4*)&sA[kk][ty * 4];
            float4 b = *(const float4*)&sB[kk][tx * 4];
            float aa[4] = {a.x, a.y, a.z, a.w}, bb[4] = {b.x, b.y, b.z, b.w};
#pragma unroll
            for (int i = 0; i < 4; ++i)
#pragma unroll
                for (int j = 0; j < 4; ++j) acc[i][j] += aa[i] * bb[j];
        }
        __syncthreads();
    }
    const int col = tn * 64 + tx * 4;
#pragma unroll
    for (int i = 0; i < 4; ++i) {
        const size_t row = (size_t)tm * 64 + ty * 4 + i;
        if (MODE == 0 || MODE == 1 || MODE == 3) {
            bf16_t* O = (bf16_t*)(p.ws + (MODE == 0 ? WS_HB : (MODE == 1 ? WS_KVM : WS_QX)));
            if (col < N) {
                uint2 u;
                u.x = (unsigned)f2bf(acc[i][0]) | ((unsigned)f2bf(acc[i][1]) << 16);
                u.y = (unsigned)f2bf(acc[i][2]) | ((unsigned)f2bf(acc[i][3]) << 16);
                *(uint2*)(O + row * N + col) = u;
            }
        } else if (MODE == 2) {
            float4 xv = *(const float4*)(p.x + row * 1024 + col);
            float4 o = make_float4(ALPHA * xv.x + acc[i][0], ALPHA * xv.y + acc[i][1], ALPHA * xv.z + acc[i][2], ALPHA * xv.w + acc[i][3]);
            *(float4*)(p.out + row * 1024 + col) = o;
        } else if (MODE == 4) {
            float4 xv = *(const float4*)(p.out + row * 1024 + col);
            float4 o = make_float4(ALPHA * xv.x + acc[i][0], ALPHA * xv.y + acc[i][1], ALPHA * xv.z + acc[i][2], ALPHA * xv.w + acc[i][3]);
            *(float4*)(p.out + row * 1024 + col) = o;
        } else {
            float* O = (float*)(p.ws + WS_QP);
            *(float4*)(O + row * 1024 + col) = make_float4(acc[i][0], acc[i][1], acc[i][2], acc[i][3]);
        }
    }
}


using bf16x8 = __attribute__((ext_vector_type(8))) short;
using f32x4 = __attribute__((ext_vector_type(4))) float;
using u32x4 = __attribute__((ext_vector_type(4))) unsigned;

template <int MODE>
DEV void gemm_mfma_tile(const P& p, int tm, int tn, unsigned char* lds) {
    const bf16_t* A;
    const bf16_t* W;
    if (MODE == 0) { A = (const bf16_t*)(p.ws + WS_XB); W = (const bf16_t*)(p.ws + WS_WIN_T); }
    if (MODE == 1) { A = (const bf16_t*)(p.ws + WS_MEMB); W = (const bf16_t*)(p.ws + WS_WKV_T); }
    if (MODE == 2) { A = (const bf16_t*)(p.ws + WS_OM); W = (const bf16_t*)(p.ws + WS_WOUT_T); }
    if (MODE == 3) { A = (const bf16_t*)(p.ws + WS_XB); W = (const bf16_t*)(p.ws + WS_WQ_T); }
    if (MODE == 4) { A = (const bf16_t*)(p.ws + WS_OX); W = (const bf16_t*)(p.ws + WS_WO_T); }
    if (MODE == 5) { A = (const bf16_t*)(p.ws + WS_XB); W = (const bf16_t*)(p.ws + WS_PWQ_T); }
    const int tid = threadIdx.x, lane = tid & 63, wid = tid >> 6, wm = wid >> 1, wn = wid & 1;
    const int m0 = tm * 128, n0 = tn * 128;
    const bf16_t* ga[2];
    const bf16_t* gw[2];
#pragma unroll
    for (int i = 0; i < 2; ++i) {
        const int r = (wid * 2 + i) * 16 + (lane >> 2);
        const int gsw = (0x1320 >> (((r >> 2) & 3) * 4)) & 3;
        const int c = (lane & 3) ^ gsw;
        ga[i] = A + (size_t)(m0 + r) * 1024 + c * 8;
        gw[i] = W + (size_t)(n0 + r) * 1024 + c * 8;
    }
    unsigned char* lbase = lds + wid * 2048;
#define GEMM_STAGE(slot, kt)                                                                                                   \
    do {                                                                                                                       \
        _Pragma("unroll") for (int i = 0; i < 2; ++i) {                                                                        \
            __builtin_amdgcn_global_load_lds((const unsigned*)(ga[i] + (kt) * 32), (unsigned*)(lbase + (slot) * 16384 + i * 1024), 16, 0, 0);         \
            __builtin_amdgcn_global_load_lds((const unsigned*)(gw[i] + (kt) * 32), (unsigned*)(lbase + (slot) * 16384 + 8192 + i * 1024), 16, 0, 0);  \
        }                                                                                                                      \
    } while (0)
    asm volatile("s_waitcnt vmcnt(0)" ::: "memory");
    GEMM_STAGE(0, 0);
    GEMM_STAGE(1, 1);
    GEMM_STAGE(2, 2);
    f32x4 acc[4][4];
#pragma unroll
    for (int i = 0; i < 4; ++i)
#pragma unroll
        for (int j = 0; j < 4; ++j) acc[i][j] = (f32x4){0.f, 0.f, 0.f, 0.f};
    const int fr = lane & 15, fq = lane >> 4;
    const int fsw = (0x1320 >> (((fr >> 2) & 3) * 4)) & 3;
    const int aoff = (wm * 64 + fr) * 64 + ((fq ^ fsw) << 4);
    const int boff = 8192 + (wn * 64 + fr) * 64 + ((fq ^ fsw) << 4);
#define GEMM_COMPUTE(slot)                                                                                                     \
    do {                                                                                                                       \
        const unsigned char* sb = lds + (slot) * 16384;                                                                        \
        bf16x8 af[4], wf[4];                                                                                                   \
        _Pragma("unroll") for (int t = 0; t < 4; ++t) {                                                                        \
            af[t] = *(const bf16x8*)(sb + aoff + t * 1024);                                                                    \
            wf[t] = *(const bf16x8*)(sb + boff + t * 1024);                                                                    \
        }                                                                                                                      \
        _Pragma("unroll") for (int nt = 0; nt < 4; ++nt)                                                                       \
            _Pragma("unroll") for (int mt = 0; mt < 4; ++mt)                                                                   \
                acc[nt][mt] = __builtin_amdgcn_mfma_f32_16x16x32_bf16(wf[nt], af[mt], acc[nt][mt], 0, 0, 0);                   \
    } while (0)
#pragma unroll 1
    for (int kt = 0; kt < 29; ++kt) {
        asm volatile("s_waitcnt vmcnt(8)\n\ts_waitcnt lgkmcnt(0)" ::: "memory");
        __builtin_amdgcn_s_barrier(); asm volatile("" ::: "memory");
        GEMM_STAGE((kt + 3) & 3, kt + 3);
        GEMM_COMPUTE(kt & 3);
    }
    asm volatile("s_waitcnt vmcnt(8)\n\ts_waitcnt lgkmcnt(0)" ::: "memory");
    __builtin_amdgcn_s_barrier(); asm volatile("" ::: "memory");
    GEMM_COMPUTE(29 & 3);
    asm volatile("s_waitcnt vmcnt(4)\n\ts_waitcnt lgkmcnt(0)" ::: "memory");
    __builtin_amdgcn_s_barrier(); asm volatile("" ::: "memory");
    GEMM_COMPUTE(30 & 3);
    asm volatile("s_waitcnt vmcnt(0)\n\ts_waitcnt lgkmcnt(0)" ::: "memory");
    __builtin_amdgcn_s_barrier(); asm volatile("" ::: "memory");
    GEMM_COMPUTE(31 & 3);
    asm volatile("s_waitcnt lgkmcnt(0)" ::: "memory");
    __builtin_amdgcn_s_barrier(); asm volatile("" ::: "memory");
#undef GEMM_STAGE
#undef GEMM_COMPUTE
#pragma unroll
    for (int mt = 0; mt < 4; ++mt) {
        const size_t m = (size_t)m0 + wm * 64 + mt * 16 + fr;
#pragma unroll
        for (int nt = 0; nt < 4; ++nt) {
            const int n = n0 + wn * 64 + nt * 16 + fq * 4;
            const f32x4 c = acc[nt][mt];
            if (MODE == 0 || MODE == 1 || MODE == 3 || MODE == 5) {
                constexpr int NS = MODE == 0 ? INC : (MODE == 1 ? 2048 : 1024);
                bf16_t* O = (bf16_t*)(p.ws + (MODE == 0 ? WS_HB : (MODE == 1 ? WS_KVM : (MODE == 3 ? WS_QX : WS_QP))));
                if (MODE == 1 && tn >= 8) {
                    bf16_t* VMT = (bf16_t*)(p.ws + WS_VMT);
                    const int nn = n - 1024;
                    const size_t base = (((size_t)(m >> 8) * 4 + (nn >> 8)) * 256 + (nn & 255)) * 256 + (m & 255);
#pragma unroll
                    for (int i = 0; i < 4; ++i) VMT[base + (size_t)i * 256] = f2bf(c[i]);
                } else if (MODE == 0 && (tn == 7 || tn == 9)) {
                    bf16_t* VT = (bf16_t*)(p.ws + WS_VT);
                    const int which = tn == 9 ? 1 : 0;
                    const size_t base = ((((size_t)which * B_ + (m >> 11)) * 2 + wn) * 64 + nt * 16 + fq * 4) * 2048 + (m & 2047);
#pragma unroll
                    for (int i = 0; i < 4; ++i) VT[base + (size_t)i * 2048] = f2bf(c[i]);
                } else if (MODE != 0 || n < INC) {
                    uint2 u;
                    u.x = pk_bf16(c[0], c[1]);
                    u.y = pk_bf16(c[2], c[3]);
                    *(uint2*)(O + m * NS + n) = u;
                }
            } else if (MODE == 2) {
                const float4 xv = *(const float4*)(p.x + m * 1024 + n);
                *(uint2*)((bf16_t*)(p.ws + WS_YB) + m * 1024 + n) = make_uint2(pk_bf16(ALPHA * xv.x + c[0], ALPHA * xv.y + c[1]), pk_bf16(ALPHA * xv.z + c[2], ALPHA * xv.w + c[3]));
            } else if (MODE == 4) {
                const uint2 xb = *(const uint2*)((const bf16_t*)(p.ws + WS_XB) + m * 1024 + n);
                *(uint2*)((bf16_t*)(p.ws + WS_YB) + m * 1024 + n) = make_uint2(pk_bf16(ALPHA * bflo(xb.x) + c[0], ALPHA * bfhi(xb.x) + c[1]), pk_bf16(ALPHA * bflo(xb.y) + c[2], ALPHA * bfhi(xb.y) + c[3]));
            }
        }
    }
}


template <int MODE>
DEV void gemm_mfma_tile256(const P& p, int tm, int tn, unsigned char* lds) {
    const bf16_t* A;
    const bf16_t* W;
    if (MODE == 0) { A = (const bf16_t*)(p.ws + WS_XB); W = (const bf16_t*)(p.ws + WS_WIN_T); }
    if (MODE == 1) { A = (const bf16_t*)(p.ws + WS_MEMB); W = (const bf16_t*)(p.ws + WS_WKV_T); }
    if (MODE == 2) { A = (const bf16_t*)(p.ws + WS_OM); W = (const bf16_t*)(p.ws + WS_WOUT_T); }
    if (MODE == 3) { A = (const bf16_t*)(p.ws + WS_XB); W = (const bf16_t*)(p.ws + WS_WQ_T); }
    if (MODE == 4) { A = (const bf16_t*)(p.ws + WS_OX); W = (const bf16_t*)(p.ws + WS_WO_T); }
    if (MODE == 5) { A = (const bf16_t*)(p.ws + WS_XB); W = (const bf16_t*)(p.ws + WS_PWQ_T); }
    const int tid = threadIdx.x, lane = tid & 63, wid = tid >> 6, wm = wid >> 1, wn = wid & 1;
    const int m0 = tm * 256, n0 = tn * 128;
    const bf16_t* ga[4];
    const bf16_t* gw[2];
#pragma unroll
    for (int i = 0; i < 4; ++i) {
        const int r = (wid * 4 + i) * 16 + (lane >> 2);
        const int gsw = (0x1320 >> (((r >> 2) & 3) * 4)) & 3;
        ga[i] = A + (size_t)(m0 + r) * 1024 + ((lane & 3) ^ gsw) * 8;
    }
#pragma unroll
    for (int i = 0; i < 2; ++i) {
        const int r = (wid * 2 + i) * 16 + (lane >> 2);
        const int gsw = (0x1320 >> (((r >> 2) & 3) * 4)) & 3;
        gw[i] = W + (size_t)(n0 + r) * 1024 + ((lane & 3) ^ gsw) * 8;
    }
    unsigned char* lbA = lds + wid * 4096;
    unsigned char* lbW = lds + 16384 + wid * 2048;
#define GEMM_STAGE(slot, kt)                                                                                                   \
    do {                                                                                                                       \
        _Pragma("unroll") for (int i = 0; i < 4; ++i)                                                                          \
            __builtin_amdgcn_global_load_lds((const unsigned*)(ga[i] + (kt) * 32), (unsigned*)(lbA + (slot) * 24576 + i * 1024), 16, 0, 0);  \
        _Pragma("unroll") for (int i = 0; i < 2; ++i)                                                                          \
            __builtin_amdgcn_global_load_lds((const unsigned*)(gw[i] + (kt) * 32), (unsigned*)(lbW + (slot) * 24576 + i * 1024), 16, 0, 0);  \
    } while (0)
    GEMM_STAGE(0, 0);
    f32x4 acc[4][8];
#pragma unroll
    for (int i = 0; i < 4; ++i)
#pragma unroll
        for (int j = 0; j < 8; ++j) acc[i][j] = (f32x4){0.f, 0.f, 0.f, 0.f};
    const int fr = lane & 15, fq = lane >> 4;
    const int fsw = (0x1320 >> (((fr >> 2) & 3) * 4)) & 3;
    const int aoff = (wm * 128 + fr) * 64 + ((fq ^ fsw) << 4);
    const int boff = 16384 + (wn * 64 + fr) * 64 + ((fq ^ fsw) << 4);
#pragma unroll 1
    for (int kt = 0; kt < 32; ++kt) {
        asm volatile("s_waitcnt vmcnt(0)\n\ts_waitcnt lgkmcnt(0)" ::: "memory");
        __builtin_amdgcn_s_barrier(); asm volatile("" ::: "memory");
        if (kt + 1 < 32) { if (kt & 1) GEMM_STAGE(0, kt + 1); else GEMM_STAGE(1, kt + 1); }
        const unsigned char* sb = lds + (kt & 1) * 24576;
        bf16x8 af[8], wf[4];
#pragma unroll
        for (int t = 0; t < 8; ++t) af[t] = *(const bf16x8*)(sb + aoff + t * 1024);
#pragma unroll
        for (int t = 0; t < 4; ++t) wf[t] = *(const bf16x8*)(sb + boff + t * 1024);
#pragma unroll
        for (int nt = 0; nt < 4; ++nt)
#pragma unroll
            for (int mt = 0; mt < 8; ++mt) acc[nt][mt] = __builtin_amdgcn_mfma_f32_16x16x32_bf16(wf[nt], af[mt], acc[nt][mt], 0, 0, 0);
    }
    asm volatile("s_waitcnt lgkmcnt(0)" ::: "memory");
    __builtin_amdgcn_s_barrier(); asm volatile("" ::: "memory");
#undef GEMM_STAGE
#pragma unroll
    for (int mt = 0; mt < 8; ++mt) {
        const size_t m = (size_t)m0 + wm * 128 + mt * 16 + fr;
#pragma unroll
        for (int nt = 0; nt < 4; ++nt) {
            const int n = n0 + wn * 64 + nt * 16 + fq * 4;
            const f32x4 c = acc[nt][mt];
            if (MODE == 0 || MODE == 1 || MODE == 3 || MODE == 5) {
                constexpr int NS = MODE == 0 ? INC : (MODE == 1 ? 2048 : 1024);
                bf16_t* O = (bf16_t*)(p.ws + (MODE == 0 ? WS_HB : (MODE == 1 ? WS_KVM : (MODE == 3 ? WS_QX : WS_QP))));
                if (MODE == 1 && tn >= 8) {
                    bf16_t* VMT = (bf16_t*)(p.ws + WS_VMT);
                    const int nn = n - 1024;
                    const size_t base = (((size_t)(m >> 8) * 4 + (nn >> 8)) * 256 + (nn & 255)) * 256 + (m & 255);
#pragma unroll
                    for (int i = 0; i < 4; ++i) VMT[base + (size_t)i * 256] = f2bf(c[i]);
                } else if (MODE == 0 && (tn == 7 || tn == 9)) {
                    bf16_t* VT = (bf16_t*)(p.ws + WS_VT);
                    const int which = tn == 9 ? 1 : 0;
                    const size_t base = ((((size_t)which * B_ + (m >> 11)) * 2 + wn) * 64 + nt * 16 + fq * 4) * 2048 + (m & 2047);
#pragma unroll
                    for (int i = 0; i < 4; ++i) VT[base + (size_t)i * 2048] = f2bf(c[i]);
                } else if (MODE != 0 || n < INC) {
                    uint2 u;
                    u.x = pk_bf16(c[0], c[1]);
                    u.y = pk_bf16(c[2], c[3]);
                    *(uint2*)(O + m * NS + n) = u;
                }
            } else if (MODE == 2) {
                const float4 xv = *(const float4*)(p.x + m * 1024 + n);
                *(uint2*)((bf16_t*)(p.ws + WS_YB) + m * 1024 + n) = make_uint2(pk_bf16(ALPHA * xv.x + c[0], ALPHA * xv.y + c[1]), pk_bf16(ALPHA * xv.z + c[2], ALPHA * xv.w + c[3]));
            } else if (MODE == 4) {
                const uint2 xb = *(const uint2*)((const bf16_t*)(p.ws + WS_XB) + m * 1024 + n);
                *(uint2*)((bf16_t*)(p.ws + WS_YB) + m * 1024 + n) = make_uint2(pk_bf16(ALPHA * bflo(xb.x) + c[0], ALPHA * bfhi(xb.x) + c[1]), pk_bf16(ALPHA * bflo(xb.y) + c[2], ALPHA * bfhi(xb.y) + c[3]));
            }
        }
    }
}


template <int MODE>
DEV void gemm_item(const P& p, int q, int j, unsigned char* lds) {
    int tm, tn;
    if (MODE == 0) {
        tm = q * 8 + (j & 7);
        tn = j >> 3;
    } else if (MODE == 1) {
        tm = q; tn = j;
    } else {
        tm = q * 8 + (j & 7);
        tn = j >> 3;
    }
    gemm_mfma_tile256<MODE>(p, tm, tn, lds);
}

DEV void transpose_tile(const float* W, int N, bf16_t* Wt, int tk, int tn, float* s, int ldk = 1024) {
    const int tid = threadIdx.x;
    const int k0 = tk * 64, n0 = tn * 64;
#pragma unroll
    for (int i = 0; i < 4; ++i) {
        const int k = (tid >> 4) + 16 * i, n = (tid & 15) * 4;
        float4 v = make_float4(0.f, 0.f, 0.f, 0.f);
        if (n0 + n < N) v = *(const float4*)(W + (size_t)(k0 + k) * N + n0 + n);
        s[k * 65 + n + 0] = v.x; s[k * 65 + n + 1] = v.y; s[k * 65 + n + 2] = v.z; s[k * 65 + n + 3] = v.w;
    }
    __syncthreads();
    {
        const int n = tid >> 2, kc = (tid & 3) * 16;
        unsigned u[8];
#pragma unroll
        for (int j = 0; j < 8; ++j)
            u[j] = (unsigned)f2bf(s[(kc + 2 * j) * 65 + n]) | ((unsigned)f2bf(s[(kc + 2 * j + 1) * 65 + n]) << 16);
        bf16_t* dst = Wt + (size_t)(n0 + n) * ldk + k0 + kc;
        *(uint4*)dst = make_uint4(u[0], u[1], u[2], u[3]);
        *(uint4*)(dst + 8) = make_uint4(u[4], u[5], u[6], u[7]);
    }
    __syncthreads();
}
DEV void convert_chunk(const float* src, bf16_t* dst, int item) {
    float4 a[4], b[4];
#pragma unroll
    for (int j = 0; j < 4; ++j) {
        const size_t e = (((size_t)item * 4 + j) * 256 + threadIdx.x) * 8;
        a[j] = *(const float4*)(src + e);
        b[j] = *(const float4*)(src + e + 4);
    }
#pragma unroll
    for (int j = 0; j < 4; ++j) {
        const size_t e = (((size_t)item * 4 + j) * 256 + threadIdx.x) * 8;
        uint4 u;
        u.x = pk_bf16(a[j].x, a[j].y);
        u.y = pk_bf16(a[j].z, a[j].w);
        u.z = pk_bf16(b[j].x, b[j].y);
        u.w = pk_bf16(b[j].z, b[j].w);
        *(uint4*)(dst + e) = u;
    }
}
constexpr int PREP_T0 = 16 * 54, PREP_T3 = PREP_T0 + 512, PREP_T5 = PREP_T3, PREP_X = PREP_T5 + T_ * 1024 / 8192, PREP_M = PREP_X + 2048 * 1024 / 8192, PREP_K = PREP_M + 16 * 128 * 64 / 8192, PREP_W1 = PREP_K + 128, PREP_W2 = PREP_W1 + 4,
              PREP_END = PREP_W2;
DEV void prep_item(const P& p, int it, float* smem) {
    if (it < PREP_T0) transpose_tile(p.w_in, INC, (bf16_t*)(p.ws + WS_WIN_T), it / 54, it % 54, smem);
    else if (it < PREP_T3) { it -= PREP_T0; transpose_tile(p.xa_wkv, 2048, (bf16_t*)(p.ws + WS_WKV_T), it >> 5, it & 31, smem); }
    else if (it < PREP_X) convert_chunk(p.x, (bf16_t*)(p.ws + WS_XB), it - PREP_T5);
    else if (it < PREP_M) convert_chunk(p.mem, (bf16_t*)(p.ws + WS_MEMB), it - PREP_X);
    else if (it < PREP_K) convert_chunk(p.peer_keys, (bf16_t*)(p.ws + WS_PKEY), it - PREP_M);
    else if (it < PREP_W1) {
        it -= PREP_K;
        const int kind = it >> 6, r = it & 63;
        transpose_tile(p.cmp_w1 + (size_t)kind * 2048 * 128, 128, (bf16_t*)(p.ws + WS_W1T) + (size_t)kind * 128 * 2048, r >> 1, r & 1, smem, 2048);
    } else if (it < PREP_W2) {
        it -= PREP_W1;
        const int kind = it >> 1;
        transpose_tile(p.cmp_w2 + (size_t)kind * 128 * 64, 64, (bf16_t*)(p.ws + WS_W2T) + (size_t)kind * 64 * 128, it & 1, 0, smem, 128);
    }
}

DEV void compress_item(const P& p, int item, float* smem) {
    const int tid = threadIdx.x;
    const int g = item & 1;
    int r = item >> 1;
    const int n = r % NCMP;
    r /= NCMP;
    const int b = r & 7, kind = r >> 3;
    const bf16_t* HB = (const bf16_t*)(p.ws + WS_HB);
    float* KC = (float*)(p.ws + WS_KC);
    float* su = smem;
    float* sp = smem + 2048;
    float* sh = smem + 2304;
    const int col = (kind ? C_VC : C_KC) + g * 64;
    for (int i = tid; i < 2048; i += 256) {
        const int l = i >> 6, d = i & 63;
        su[i] = bf2f(HB[(size_t)(b * S_ + 16 * n + l) * INC + col + d]) + p.cmp_pos[(kind * 32 + l) * 64 + d];
    }
    __syncthreads();
    {
        const int j = tid & 127, hf = tid >> 7;
        const float* w1 = p.cmp_w1 + (size_t)kind * 2048 * 128;
        float acc = 0.f;
        for (int i = hf * 1024; i < hf * 1024 + 1024; ++i) acc += su[i] * w1[(size_t)i * 128 + j];
        sp[hf * 128 + j] = acc;
    }
    __syncthreads();
    if (tid < 128) {
        const float v = sp[tid] + sp[128 + tid];
        const float u = 0.7978845608028654f * (v + 0.044715f * v * v * v);
        sh[tid] = 0.5f * v * (1.f + tanhf(u));
    }
    __syncthreads();
    if (tid < 64) {
        const float* w2 = p.cmp_w2 + (size_t)kind * 128 * 64;
        float acc = 0.f;
        for (int j = 0; j < 128; ++j) acc += sh[j] * w2[j * 64 + tid];
        KC[((((size_t)kind * B_ + b) * NCMP + n) * 2 + g) * 64 + tid] = acc;
    }
    __syncthreads();
}

DEV void load_q64_bf(float (&q)[64], const bf16_t* src) {
    const uint4* s4 = (const uint4*)src;
#pragma unroll
    for (int i = 0; i < 8; ++i) {
        const uint4 u = s4[i];
        q[i * 8 + 0] = bflo(u.x); q[i * 8 + 1] = bfhi(u.x); q[i * 8 + 2] = bflo(u.y); q[i * 8 + 3] = bfhi(u.y);
        q[i * 8 + 4] = bflo(u.z); q[i * 8 + 5] = bfhi(u.z); q[i * 8 + 6] = bflo(u.w); q[i * 8 + 7] = bfhi(u.w);
    }
}
DEV float dot64_bf(const float (&q)[64], const bf16_t* kr) {
    const uint4* k4 = (const uint4*)kr;
    float acc = 0.f;
#pragma unroll
    for (int i = 0; i < 8; ++i) {
        const uint4 u = k4[i];
        acc += q[i * 8 + 0] * bflo(u.x) + q[i * 8 + 1] * bfhi(u.x) + q[i * 8 + 2] * bflo(u.y) + q[i * 8 + 3] * bfhi(u.y) +
               q[i * 8 + 4] * bflo(u.z) + q[i * 8 + 5] * bfhi(u.z) + q[i * 8 + 6] * bflo(u.w) + q[i * 8 + 7] * bfhi(u.w);
    }
    return acc;
}
DEV float dot64_f(const float (&q)[64], const float* kr) {
    const float4* k4 = (const float4*)kr;
    float acc = 0.f;
#pragma unroll
    for (int i = 0; i < 16; ++i) {
        const float4 u = k4[i];
        acc += q[i * 4 + 0] * u.x + q[i * 4 + 1] * u.y + q[i * 4 + 2] * u.z + q[i * 4 + 3] * u.w;
    }
    return acc;
}

DEV void attn_block(const float (&q)[64], const bf16_t* krow_lane, const bf16_t* vbase_lane, bool valid, float& m, float& l, float& o) {
    float sc = dot64_bf(q, krow_lane) * 0.125f;
    sc = valid ? sc : -1e30f;
    const float mb = wmax(sc);
    const float mn = fmaxf(m, mb);
    const float corr = expf(m - mn);
    const float e = valid ? expf(sc - mn) : 0.f;
    l = l * corr + wsum(e);
    o *= corr;
#pragma unroll 8
    for (int k = 0; k < 64; ++k) o += __shfl(e, k) * bf2f(vbase_lane[(size_t)k * INC]);
    m = mn;
}

DEV void nsa_item(const P& p, int item) {
    const int lane = threadIdx.x & 63;
    const int g = item & 1;
    const int t = item >> 1;
    const int b = t >> 11, s = t & 2047;
    const bf16_t* HB = (const bf16_t*)(p.ws + WS_HB);
    const float* KC = (const float*)(p.ws + WS_KC);
    bf16_t* OM = (bf16_t*)(p.ws + WS_OM);
    const int cur = s >> 6;
    const int nvalid = (s >= 31) ? (((s - 31) >> 4) + 1) : 0;
    const size_t rowt = (size_t)t * INC;
    float ocmp0 = 0.f, ocmp1 = 0.f, ocmp2 = 0.f, ocmp3 = 0.f;
    float psum0 = 0.f, psum1 = 0.f;
    if (nvalid > 0) {
#pragma unroll 1
        for (int r = 0; r < 4; ++r) {
            const int h = g * 4 + r;
            float q[64];
            load_q64_bf(q, HB + rowt + C_QA + h * 64);
            float sc0 = -1e30f, sc1 = -1e30f;
            if (lane < nvalid) sc0 = dot64_f(q, KC + ((((size_t)0 * B_ + b) * NCMP + lane) * 2 + g) * 64) * 0.125f;
            if (lane + 64 < nvalid) sc1 = dot64_f(q, KC + ((((size_t)0 * B_ + b) * NCMP + lane + 64) * 2 + g) * 64) * 0.125f;
            const float m = wmax(fmaxf(sc0, sc1));
            const float e0 = (lane < nvalid) ? expf(sc0 - m) : 0.f;
            const float e1 = (lane + 64 < nvalid) ? expf(sc1 - m) : 0.f;
            const float l = wsum(e0 + e1);
            const float p0 = e0 / l, p1 = e1 / l;
            psum0 += p0;
            psum1 += p1;
            float oc = 0.f;
            const float* vcb = KC + ((((size_t)1 * B_ + b) * NCMP) * 2 + g) * 64 + lane;
            for (int n = 0; n < nvalid; ++n) {
                const float pn = (n < 64) ? __shfl(p0, n) : __shfl(p1, n - 64);
                oc += pn * vcb[(size_t)n * 128];
            }
            if (r == 0) ocmp0 = oc;
            if (r == 1) ocmp1 = oc;
            if (r == 2) ocmp2 = oc;
            if (r == 3) ocmp3 = oc;
        }
    }
    float imp = 0.f;
#pragma unroll
    for (int dn = -1; dn <= 3; ++dn) {
        const int n = 4 * lane + dn;
        const int nn = n < 0 ? 0 : (n > 127 ? 127 : n);
        const float v0 = __shfl(psum0, nn & 63);
        const float v1 = __shfl(psum1, nn & 63);
        const float v = (nn < 64) ? v0 : v1;
        if (n >= 0 && n <= 126) imp += v;
    }
    float score;
    if (lane > cur) score = -INFINITY;
    else if (lane == 0 || lane == cur || lane == cur - 1) score = 1e4f;
    else score = imp;
    int rank = 0;
#pragma unroll 8
    for (int i = 0; i < 32; ++i) {
        const float si = __shfl(score, i);
        rank += ((si > score) || (si == score && i < lane)) ? 1 : 0;
    }
    const bool sel = (lane <= cur) && (rank < 16);
    const unsigned mask = (unsigned)(__ballot(sel) & 0xffffffffull);
    const int wlo = (s - 511) > 0 ? (s - 511) : 0;
#pragma unroll 1
    for (int r = 0; r < 4; ++r) {
        const int h = g * 4 + r;
        float q[64];
        load_q64_bf(q, HB + rowt + C_QA + h * 64);
        float m = -1e30f, l = 0.f, o = 0.f;
        for (unsigned mm = mask; mm; mm &= mm - 1) {
            const int j = __builtin_ctz(mm);
            const int kpos = j * 64 + lane;
            attn_block(q, HB + (size_t)(b * S_ + kpos) * INC + C_KS + g * 64, HB + (size_t)(b * S_ + j * 64) * INC + C_VS + g * 64 + lane,
                       kpos <= s, m, l, o);
        }
        const float oslc = o / l;
        m = -1e30f; l = 0.f; o = 0.f;
        for (int j = wlo >> 6; j <= cur; ++j) {
            const int kpos = j * 64 + lane;
            attn_block(q, HB + (size_t)(b * S_ + kpos) * INC + C_KW + g * 64, HB + (size_t)(b * S_ + j * 64) * INC + C_VW + g * 64 + lane,
                       (kpos <= s) && (kpos >= wlo), m, l, o);
        }
        const float owin = o / l;
        const float oc = r == 0 ? ocmp0 : (r == 1 ? ocmp1 : (r == 2 ? ocmp2 : ocmp3));
        const float g0 = sigmoidf_(bf2f(HB[rowt + C_GATE + h * 3 + 0]));
        const float g1 = sigmoidf_(bf2f(HB[rowt + C_GATE + h * 3 + 1]));
        const float g2 = sigmoidf_(bf2f(HB[rowt + C_GATE + h * 3 + 2]));
        OM[(size_t)t * 1024 + h * 64 + lane] = f2bf(g0 * oc + g1 * oslc + g2 * owin);
    }
}

DEV void hgrn_item(const P& p, int item, float* smem) {
    const int b = item >> 2, hh = item & 3;
    const int tid = threadIdx.x, dv = tid & 127, half = tid >> 7;
    const bf16_t* HB = (const bf16_t*)(p.ws + WS_HB);
    bf16_t* OM = (bf16_t*)(p.ws + WS_OM);
    float* sf = smem;
    float* sq = smem + 1024;
    float* so = smem + 2048;
    float Sreg[64];
#pragma unroll
    for (int i = 0; i < 64; ++i) Sreg[i] = 0.f;
    const int d = tid & 127;
    float lbv;
    {
        const float l0 = p.lb_logits[hh * 128 + d], l1 = p.lb_logits[512 + hh * 128 + d];
        const float mx = fmaxf(l0, l1);
        const float e0 = expf(l0 - mx), e1 = expf(l1 - mx);
        lbv = e0 / (e0 + e1);
    }
    const int wave = tid >> 6, lane = tid & 63;
    const float nw0 = p.hg_norm_w[hh * 128 + lane], nw1 = p.hg_norm_w[hh * 128 + lane + 64];
    for (int t0 = 0; t0 < S_; t0 += 8) {
#pragma unroll
        for (int i = 0; i < 4; ++i) {
            const int st = (tid >> 7) + 2 * i;
            const size_t tt = (size_t)b * S_ + t0 + st;
            const float fl = bf2f(HB[tt * INC + C_HF + hh * 128 + d]);
            sf[st * 128 + d] = lbv + (1.f - lbv) * sigmoidf_(fl);
            sq[st * 128 + d] = bf2f(HB[tt * INC + C_HQ + hh * 128 + d]);
        }
        float vv[8];
#pragma unroll
        for (int st = 0; st < 8; ++st) vv[st] = bf2f(HB[((size_t)b * S_ + t0 + st) * INC + C_HI + hh * 128 + dv]);
        __syncthreads();
#pragma unroll
        for (int st = 0; st < 8; ++st) {
            float oacc = 0.f;
            const float* pf = sf + st * 128 + half * 64;
            const float* pq = sq + st * 128 + half * 64;
#pragma unroll
            for (int dk = 0; dk < 64; ++dk) {
                const float f = pf[dk];
                Sreg[dk] = f * Sreg[dk] + (1.f - f) * vv[st];
                oacc += pq[dk] * Sreg[dk];
            }
            so[(st * 2 + half) * 128 + dv] = oacc;
        }
        __syncthreads();
#pragma unroll
        for (int u = 0; u < 2; ++u) {
            const int st = wave * 2 + u;
            const float o0 = so[(st * 2 + 0) * 128 + lane] + so[(st * 2 + 1) * 128 + lane];
            const float o1 = so[(st * 2 + 0) * 128 + lane + 64] + so[(st * 2 + 1) * 128 + lane + 64];
            const float ss = wsum(o0 * o0 + o1 * o1);
            const float rs = rsqrtf(ss * (1.f / 128.f) + LN_EPS);
            const size_t tt = (size_t)b * S_ + t0 + st;
            const float gg0 = bf2f(HB[tt * INC + C_HG + hh * 128 + lane]);
            const float gg1 = bf2f(HB[tt * INC + C_HG + hh * 128 + lane + 64]);
            OM[tt * 1024 + 512 + hh * 128 + lane] = f2bf(o0 * rs * nw0 * (gg0 * sigmoidf_(gg0)));
            OM[tt * 1024 + 512 + hh * 128 + lane + 64] = f2bf(o1 * rs * nw1 * (gg1 * sigmoidf_(gg1)));
        }
    }
    __syncthreads();
}

DEV void ln_item(const P& p, int t, int which, int lane) {
    const bf16_t* row = (const bf16_t*)(p.ws + WS_YB) + (size_t)t * 1024;
    float4 v[4];
    float s = 0.f;
#pragma unroll
    for (int i = 0; i < 4; ++i) {
        const uint2 u = *(const uint2*)(row + (i * 64 + lane) * 4);
        v[i] = make_float4(bflo(u.x), bfhi(u.x), bflo(u.y), bfhi(u.y));
        s += v[i].x + v[i].y + v[i].z + v[i].w;
    }
    const float mean = wsum(s) * (1.f / 1024.f);
    float ss = 0.f;
#pragma unroll
    for (int i = 0; i < 4; ++i) {
        v[i].x -= mean; v[i].y -= mean; v[i].z -= mean; v[i].w -= mean;
        ss += v[i].x * v[i].x + v[i].y * v[i].y + v[i].z * v[i].z + v[i].w * v[i].w;
    }
    const float rs = rsqrtf(wsum(ss) * (1.f / 1024.f) + LN_EPS);
#pragma unroll
    for (int i = 0; i < 4; ++i) {
        const int c = (i * 64 + lane) * 4;
        const float4 gg = *(const float4*)(p.ln_g + which * 1024 + c);
        const float4 bb = *(const float4*)(p.ln_b + which * 1024 + c);
        float4 o;
        o.x = v[i].x * rs * gg.x + bb.x; o.y = v[i].y * rs * gg.y + bb.y; o.z = v[i].z * rs * gg.z + bb.z; o.w = v[i].w * rs * gg.w + bb.w;
        uint2 u;
        u.x = pk_bf16(o.x, o.y);
        u.y = pk_bf16(o.z, o.w);
        *(uint2*)((bf16_t*)(p.ws + WS_XB) + (size_t)t * 1024 + c) = u;
    }
}

DEV void xattn_item(const P& p, int item) {
    const int lane = threadIdx.x & 63;
    const int hh = item & 3, t = item >> 2, b = t >> 11;
    const bf16_t* QX = (const bf16_t*)(p.ws + WS_QX);
    const bf16_t* KVM = (const bf16_t*)(p.ws + WS_KVM);
    bf16_t* OX = (bf16_t*)(p.ws + WS_OX);
    float sc[4] = {0.f, 0.f, 0.f, 0.f};
#pragma unroll 1
    for (int c = 0; c < 4; ++c) {
        float q[64];
        load_q64_bf(q, QX + (size_t)t * 1024 + hh * 256 + c * 64);
#pragma unroll
        for (int k = 0; k < 4; ++k) sc[k] += dot64_bf(q, KVM + (size_t)(b * ML_ + lane + 64 * k) * 2048 + hh * 256 + c * 64);
    }
    float mx = -1e30f;
#pragma unroll
    for (int k = 0; k < 4; ++k) { sc[k] *= 0.0625f; mx = fmaxf(mx, sc[k]); }
    mx = wmax(mx);
    float pr[4], ls = 0.f;
#pragma unroll
    for (int k = 0; k < 4; ++k) { pr[k] = expf(sc[k] - mx); ls += pr[k]; }
    ls = wsum(ls);
    const float inv = 1.f / ls;
    float o[4] = {0.f, 0.f, 0.f, 0.f};
#pragma unroll
    for (int k = 0; k < 4; ++k) {
        const bf16_t* vb = KVM + (size_t)(b * ML_ + k * 64) * 2048 + 1024 + hh * 256 + lane;
#pragma unroll 4
        for (int mm = 0; mm < 64; ++mm) {
            const float pm = __shfl(pr[k], mm);
#pragma unroll
            for (int c = 0; c < 4; ++c) o[c] += pm * bf2f(vb[(size_t)mm * 2048 + c * 64]);
        }
    }
#pragma unroll
    for (int c = 0; c < 4; ++c) OX[(size_t)t * 1024 + hh * 256 + c * 64 + lane] = f2bf(o[c] * inv);
}

DEV void wave_argmax(float v, int i, float& bv, int& bi) {
#pragma unroll
    for (int o = 32; o > 0; o >>= 1) {
        const float ov = __shfl_xor(v, o);
        const int oi = __shfl_xor(i, o);
        if (ov > v || (ov == v && oi < i)) { v = ov; i = oi; }
    }
    bv = v; bi = i;
}

DEV void peer_item(const P& p, int t) {
    const int lane = threadIdx.x & 63;
    const float* QP = (const float*)(p.ws + WS_QP);
    float* row = p.out + (size_t)t * 1024;
    float4 xr[4], oacc[4];
#pragma unroll
    for (int i = 0; i < 4; ++i) {
        xr[i] = *(const float4*)(row + (i * 64 + lane) * 4);
        oacc[i] = make_float4(0.f, 0.f, 0.f, 0.f);
    }
#pragma unroll 1
    for (int hh = 0; hh < 8; ++hh) {
        float ts1 = 0.f, ts2 = 0.f;
        int ti1 = 0, ti2 = 0;
#pragma unroll 1
        for (int c = 0; c < 2; ++c) {
            float q[64];
            {
                const float4* q4 = (const float4*)(QP + (size_t)t * 1024 + hh * 128 + c * 64);
#pragma unroll
                for (int i = 0; i < 16; ++i) { const float4 u = q4[i]; q[i * 4] = u.x; q[i * 4 + 1] = u.y; q[i * 4 + 2] = u.z; q[i * 4 + 3] = u.w; }
            }
            const float* kb = p.peer_keys + ((size_t)(hh * 2 + c) * 128) * 64;
            float a0 = dot64_f(q, kb + (size_t)lane * 64);
            float a1 = dot64_f(q, kb + (size_t)(lane + 64) * 64);
            float ts = 0.f;
            int ti = 0;
#pragma unroll 1
            for (int k = 0; k < 16; ++k) {
                float v; int i;
                if (a0 >= a1) { v = a0; i = lane; } else { v = a1; i = lane + 64; }
                float bv; int bi;
                wave_argmax(v, i, bv, bi);
                if (lane == k) { ts = bv; ti = bi; }
                if (bi == lane) a0 = -INFINITY;
                if (bi == lane + 64) a1 = -INFINITY;
            }
            if (c == 0) { ts1 = ts; ti1 = ti; } else { ts2 = ts; ti2 = ti; }
        }
        float cs[4];
        const float s1v = __shfl(ts1, lane >> 2);
#pragma unroll
        for (int u = 0; u < 4; ++u) cs[u] = s1v + __shfl(ts2, (lane & 3) * 4 + u);
        float fs = 0.f;
        int fidx = 0;
#pragma unroll 1
        for (int k = 0; k < 16; ++k) {
            float v = cs[0]; int i = lane * 4;
#pragma unroll
            for (int u = 1; u < 4; ++u) if (cs[u] > v) { v = cs[u]; i = lane * 4 + u; }
            float bv; int bi;
            wave_argmax(v, i, bv, bi);
            if (lane == k) { fs = bv; fidx = bi; }
#pragma unroll
            for (int u = 0; u < 4; ++u) if (bi == lane * 4 + u) cs[u] = -INFINITY;
        }
        const int e1i = __shfl(ti1, fidx >> 4);
        const int e2i = __shfl(ti2, fidx & 15);
        const int eid = e1i * 128 + e2i;
        const float mx = __shfl(fs, 0);
        const float w = (lane < 16) ? expf(fs - mx) : 0.f;
        const float gate = w / wsum(w);
#pragma unroll 1
        for (int k = 0; k < 16; ++k) {
            const int e = __shfl(eid, k);
            const float gt = __shfl(gate, k);
            const float* dr = p.peer_down + (size_t)e * 1024;
            const float* ur = p.peer_up + (size_t)e * 1024;
            float hd = 0.f;
#pragma unroll
            for (int i = 0; i < 4; ++i) {
                const float4 dvv = *(const float4*)(dr + (i * 64 + lane) * 4);
                hd += dvv.x * xr[i].x + dvv.y * xr[i].y + dvv.z * xr[i].z + dvv.w * xr[i].w;
            }
            hd = wsum(hd);
            const float a = 0.5f * hd * (1.f + erff(hd * 0.7071067811865476f)) * gt;
#pragma unroll
            for (int i = 0; i < 4; ++i) {
                const float4 uv = *(const float4*)(ur + (i * 64 + lane) * 4);
                oacc[i].x += a * uv.x; oacc[i].y += a * uv.y; oacc[i].z += a * uv.z; oacc[i].w += a * uv.w;
            }
        }
    }
    float s = 0.f;
    float4 v[4];
#pragma unroll
    for (int i = 0; i < 4; ++i) {
        v[i].x = ALPHA * xr[i].x + oacc[i].x; v[i].y = ALPHA * xr[i].y + oacc[i].y;
        v[i].z = ALPHA * xr[i].z + oacc[i].z; v[i].w = ALPHA * xr[i].w + oacc[i].w;
        s += v[i].x + v[i].y + v[i].z + v[i].w;
    }
    const float mean = wsum(s) * (1.f / 1024.f);
    float ss = 0.f;
#pragma unroll
    for (int i = 0; i < 4; ++i) {
        v[i].x -= mean; v[i].y -= mean; v[i].z -= mean; v[i].w -= mean;
        ss += v[i].x * v[i].x + v[i].y * v[i].y + v[i].z * v[i].z + v[i].w * v[i].w;
    }
    const float rs = rsqrtf(wsum(ss) * (1.f / 1024.f) + LN_EPS);
#pragma unroll
    for (int i = 0; i < 4; ++i) {
        const int c = (i * 64 + lane) * 4;
        const float4 gg = *(const float4*)(p.ln_g + 2 * 1024 + c);
        const float4 bb = *(const float4*)(p.ln_b + 2 * 1024 + c);
        float4 o;
        o.x = v[i].x * rs * gg.x + bb.x; o.y = v[i].y * rs * gg.y + bb.y; o.z = v[i].z * rs * gg.z + bb.z; o.w = v[i].w * rs * gg.w + bb.w;
        *(float4*)(row + c) = o;
    }
}


DEV void compress_item2(const P& p, int item, unsigned char* lds) {
    const int nt8 = item & 7, g = (item >> 3) & 1, b = (item >> 4) & 7, kind = item >> 7;
    const int tid = threadIdx.x, lane = tid & 63, wid = tid >> 6, fr = lane & 15, fq = lane >> 4;
    const bf16_t* HB = (const bf16_t*)(p.ws + WS_HB);
    const bf16_t* W1T = (const bf16_t*)(p.ws + WS_W1T) + (size_t)kind * 128 * 2048;
    const bf16_t* W2T = (const bf16_t*)(p.ws + WS_W2T) + (size_t)kind * 64 * 128;
    const float* posb = p.cmp_pos + (size_t)kind * 2048 + fq * 8;
    const int n0 = nt8 * 16;
    const int kcol = (kind ? C_VC : C_KC) + g * 64;
    const bf16_t* abase = HB + (size_t)(b * S_ + 16 * (n0 + fr)) * INC + kcol + fq * 8;
    const bf16_t* wbase = W1T + (size_t)fr * 2048 + fq * 8;
    f32x4 acc[8];
#pragma unroll
    for (int jt = 0; jt < 8; ++jt) acc[jt] = (f32x4){0.f, 0.f, 0.f, 0.f};
#pragma unroll 4
    for (int k2 = 0; k2 < 16; ++k2) {
        const int ks = wid * 16 + k2;
        bf16x8 af;
        {
            const u32x4 raw = *(const u32x4*)(abase + (size_t)(ks >> 1) * INC + (ks & 1) * 32);
            const float* pp = posb + (ks >> 1) * 64 + (ks & 1) * 32;
            const float4 p0 = *(const float4*)pp, p1 = *(const float4*)(pp + 4);
            u32x4 w;
            w[0] = pk_bf16(bflo(raw[0]) + p0.x, bfhi(raw[0]) + p0.y);
            w[1] = pk_bf16(bflo(raw[1]) + p0.z, bfhi(raw[1]) + p0.w);
            w[2] = pk_bf16(bflo(raw[2]) + p1.x, bfhi(raw[2]) + p1.y);
            w[3] = pk_bf16(bflo(raw[3]) + p1.z, bfhi(raw[3]) + p1.w);
            af = __builtin_bit_cast(bf16x8, w);
        }
#pragma unroll
        for (int jt = 0; jt < 8; ++jt) {
            const bf16x8 wf = *(const bf16x8*)(wbase + (size_t)jt * 16 * 2048 + ks * 32);
            acc[jt] = __builtin_amdgcn_mfma_f32_16x16x32_bf16(wf, af, acc[jt], 0, 0, 0);
        }
    }
    float* PS = (float*)lds;
    bf16_t* HS = (bf16_t*)(lds + 4 * 16 * 132 * 4);
#pragma unroll
    for (int jt = 0; jt < 8; ++jt)
        *(float4*)(PS + (wid * 16 + fr) * 132 + jt * 16 + fq * 4) = make_float4(acc[jt][0], acc[jt][1], acc[jt][2], acc[jt][3]);
    __syncthreads();
    {
        const int r = tid >> 4, jb = (tid & 15) * 8;
        float hv[8];
#pragma unroll
        for (int h2 = 0; h2 < 2; ++h2) {
            float4 s = make_float4(0.f, 0.f, 0.f, 0.f);
#pragma unroll
            for (int w = 0; w < 4; ++w) {
                const float4 v = *(const float4*)(PS + (w * 16 + r) * 132 + jb + h2 * 4);
                s.x += v.x; s.y += v.y; s.z += v.z; s.w += v.w;
            }
            hv[h2 * 4 + 0] = s.x; hv[h2 * 4 + 1] = s.y; hv[h2 * 4 + 2] = s.z; hv[h2 * 4 + 3] = s.w;
        }
#pragma unroll
        for (int i = 0; i < 8; ++i) {
            const float v = hv[i];
            const float u = 0.7978845608028654f * (v + 0.044715f * v * v * v);
            hv[i] = 0.5f * v * (1.f + tanhf(u));
        }
        u32x4 w;
        w[0] = pk_bf16(hv[0], hv[1]); w[1] = pk_bf16(hv[2], hv[3]); w[2] = pk_bf16(hv[4], hv[5]); w[3] = pk_bf16(hv[6], hv[7]);
        *(u32x4*)(HS + r * 136 + jb) = w;
    }
    __syncthreads();
    f32x4 o = (f32x4){0.f, 0.f, 0.f, 0.f};
#pragma unroll
    for (int ks = 0; ks < 4; ++ks) {
        const bf16x8 hf = *(const bf16x8*)(HS + fr * 136 + ks * 32 + fq * 8);
        const bf16x8 wf = *(const bf16x8*)(W2T + (size_t)(wid * 16 + fr) * 128 + ks * 32 + fq * 8);
        if (kind == 0) o = __builtin_amdgcn_mfma_f32_16x16x32_bf16(wf, hf, o, 0, 0, 0);
        else o = __builtin_amdgcn_mfma_f32_16x16x32_bf16(hf, wf, o, 0, 0, 0);
    }
    if (kind == 0) {
        const int n = n0 + fr, e = wid * 16 + fq * 4;
        uint2 u2;
        u2.x = pk_bf16(o[0], o[1]);
        u2.y = pk_bf16(o[2], o[3]);
        if (n == 127) u2 = make_uint2(0u, 0u);
        *(uint2*)((bf16_t*)(p.ws + WS_KCB) + ((size_t)(b * 2 + g) * 128 + n) * 64 + e) = u2;
    } else {
        const int e = wid * 16 + fr, n = n0 + fq * 4;
        const float o3 = (n + 3 == 127) ? 0.f : o[3];
        uint2 u2;
        u2.x = pk_bf16(o[0], o[1]);
        u2.y = pk_bf16(o[2], o3);
        *(uint2*)((bf16_t*)(p.ws + WS_VCT) + ((size_t)(b * 2 + g) * 64 + e) * 128 + n) = u2;
    }
    __syncthreads();
}

constexpr int NSA_IMP = 32768;
constexpr int NSA_SCORE = 49152;
constexpr int NSA_SELM = NSA_SCORE + 4224;

struct NsaTileRegs { u32x4 k[2], v[2]; };
DEV void nsa_load_tile(NsaTileRegs& r, const bf16_t* kbase, size_t kstride, const bf16_t* vbase, size_t vstride, int tid) {
    const int lc = tid & 7, lr = tid >> 3;
#pragma unroll
    for (int i = 0; i < 2; ++i) {
        r.k[i] = *(const u32x4*)(kbase + (size_t)(lr + 32 * i) * kstride + lc * 8);
        r.v[i] = *(const u32x4*)(vbase + (size_t)(lr + 32 * i) * vstride + lc * 8);
    }
}
DEV void nsa_store_tile(const NsaTileRegs& r, unsigned char* stage, int tid) {
    const int lc = tid & 7, lr = tid >> 3;
    const int woff = lr * 128 + ((lc ^ ((lr >> 1) & 7)) << 4);
#pragma unroll
    for (int i = 0; i < 2; ++i) {
        *(u32x4*)(stage + woff + i * 4096) = r.k[i];
        *(u32x4*)(stage + 8192 + woff + i * 4096) = r.v[i];
    }
}
DEV void nsa_dma_tile(const bf16_t* kbase, size_t kstride, const bf16_t* vbase, size_t vstride, unsigned char* stage, int lane, int wid) {
#pragma unroll
    for (int i = 0; i < 2; ++i) {
        const int pc = wid * 2 + i;
        const int r = pc * 8 + (lane >> 3);
        const int c = (lane & 7) ^ ((r >> 1) & 7);
        __builtin_amdgcn_global_load_lds((const unsigned*)(kbase + (size_t)r * kstride + c * 8), (unsigned*)(stage + pc * 1024), 16, 0, 0);
        __builtin_amdgcn_global_load_lds((const unsigned*)(vbase + (size_t)r * vstride + c * 8), (unsigned*)(stage + 8192 + pc * 1024), 16, 0, 0);
    }
}
DEV void nsa_scores(const unsigned char* stage, const bf16x8 (&qf)[2][2], f32x4 (&sc)[4][2], int fr, int fq) {
    const int sw = (fr >> 1) & 7;
    const int c0 = (fq ^ sw) << 4;
    const unsigned char* rowp = stage + fr * 128;
    const unsigned char* p0 = rowp + c0;
    const unsigned char* p1 = rowp + (c0 ^ 64);
#pragma unroll
    for (int kt = 0; kt < 4; ++kt) {
        const bf16x8 k0 = *(const bf16x8*)(p0 + kt * 2048);
        const bf16x8 k1 = *(const bf16x8*)(p1 + kt * 2048);
#pragma unroll
        for (int qt = 0; qt < 2; ++qt) {
            f32x4 a = (f32x4){0.f, 0.f, 0.f, 0.f};
            a = __builtin_amdgcn_mfma_f32_16x16x32_bf16(k0, qf[qt][0], a, 0, 0, 0);
            a = __builtin_amdgcn_mfma_f32_16x16x32_bf16(k1, qf[qt][1], a, 0, 0, 0);
            sc[kt][qt] = a;
        }
    }
}
DEV void nsa_pv(const unsigned char* stage, const f32x4 (&sc)[4][2], f32x4 (&o)[4][2], int fr, int fq) {
    const int sw = (fr >> 1) & 7;
    const int v0 = (((fq >> 1) ^ sw) << 4) + 8 * (fq & 1);
    const unsigned char* rowp = stage + 8192 + fr * 128;
#pragma unroll
    for (int s = 0; s < 2; ++s) {
        u32x4 pf[2];
#pragma unroll
        for (int qt = 0; qt < 2; ++qt) {
            pf[qt][0] = pk_bf16(sc[2 * s][qt][0], sc[2 * s][qt][1]);
            pf[qt][1] = pk_bf16(sc[2 * s][qt][2], sc[2 * s][qt][3]);
            pf[qt][2] = pk_bf16(sc[2 * s + 1][qt][0], sc[2 * s + 1][qt][1]);
            pf[qt][3] = pk_bf16(sc[2 * s + 1][qt][2], sc[2 * s + 1][qt][3]);
        }
        const unsigned char* plo = rowp + (v0 ^ (64 * s));
        const unsigned char* phi = rowp + (v0 ^ (64 * s) ^ 32);
#pragma unroll
        for (int dt = 0; dt < 4; ++dt) {
            const uint2 lo = *(const uint2*)(plo + dt * 2048);
            const uint2 hi = *(const uint2*)(phi + dt * 2048);
            u32x4 vv;
            vv[0] = lo.x; vv[1] = lo.y; vv[2] = hi.x; vv[3] = hi.y;
            const bf16x8 vf = __builtin_bit_cast(bf16x8, vv);
#pragma unroll
            for (int qt = 0; qt < 2; ++qt)
                o[dt][qt] = __builtin_amdgcn_mfma_f32_16x16x32_bf16(vf, __builtin_bit_cast(bf16x8, pf[qt]), o[dt][qt], 0, 0, 0);
        }
    }
}
DEV float xmax4(float v) { v = fmaxf(v, __shfl_xor(v, 16)); return fmaxf(v, __shfl_xor(v, 32)); }
DEV float xsum4(float v) { v += __shfl_xor(v, 16); return v + __shfl_xor(v, 32); }

DEV void nsa_branch(const int mode, const int BR, const int q0v, const unsigned char* wsb, unsigned char* lds, int b, int g, unsigned blocks, const bf16x8 (&qf)[2][2], const int (&qpos)[2],
                    const unsigned (&selm)[2], const float (&gate)[2], f32x4 (&fin)[4][2], int tid) {
    asm volatile("" : "+v"(tid));
    const int fr = tid & 15, fq = (tid >> 4) & 3;
    const bf16_t* HB = (const bf16_t*)(wsb + WS_HB);
    const bf16_t* VT = (const bf16_t*)(wsb + WS_VT);
    const bf16_t* kb0 = HB + (size_t)(b * S_) * INC + (BR == 0 ? C_KS : C_KW) + g * 64;
    const bf16_t* vb0 = VT + ((((size_t)BR * B_ + b) * 2 + g) * 64) * 2048;
    const bool fake = mode == 1;
    float m[2] = {-1e30f, -1e30f}, l[2] = {0.f, 0.f};
    f32x4 o[4][2];
#pragma unroll
    for (int dt = 0; dt < 4; ++dt)
#pragma unroll
        for (int qt = 0; qt < 2; ++qt) o[dt][qt] = (f32x4){0.f, 0.f, 0.f, 0.f};
    const int lane64 = tid & 63, widx = __builtin_amdgcn_readfirstlane(tid >> 6);
    int kb = __builtin_ctz(blocks);
    blocks &= blocks - 1;
    int kb1 = blocks ? __builtin_ctz(blocks) : -1;
    if (kb1 >= 0) blocks &= blocks - 1;
    nsa_dma_tile(kb0 + (size_t)(fake ? 0 : kb) * 64 * INC, INC, vb0 + (fake ? 0 : kb) * 64, 2048, lds, lane64, widx);
    if (kb1 >= 0) nsa_dma_tile(kb0 + (size_t)(fake ? 0 : kb1) * 64 * INC, INC, vb0 + (fake ? 0 : kb1) * 64, 2048, lds + 16384, lane64, widx);
    int slot = 0;
    while (true) {
        if (kb1 >= 0) asm volatile("s_waitcnt vmcnt(4)\n\ts_waitcnt lgkmcnt(0)" ::: "memory");
        else asm volatile("s_waitcnt vmcnt(0)\n\ts_waitcnt lgkmcnt(0)" ::: "memory");
        __builtin_amdgcn_s_barrier(); asm volatile("" ::: "memory");
        const int kb2 = blocks ? __builtin_ctz(blocks) : -1;
        if (kb2 >= 0) {
            blocks &= blocks - 1;
            const int s2 = slot >= 1 ? slot - 1 : 2;
            nsa_dma_tile(kb0 + (size_t)(fake ? 0 : kb2) * 64 * INC, INC, vb0 + (fake ? 0 : kb2) * 64, 2048, lds + s2 * 16384, lane64, widx);
        }
        const unsigned char* stage = lds + slot * 16384;
        f32x4 sc[4][2];
        nsa_scores(stage, qf, sc, fr, fq);
        constexpr float C1 = 0.125f * 1.4426950408889634f;
        const bool need_mask = (BR == 0) ? (kb == (q0v >> 6)) : !((kb * 64 + 63 <= q0v) && (kb * 64 + 511 >= q0v + 31));
        float alpha[2];
        if (!need_mask) {
#pragma unroll
            for (int qt = 0; qt < 2; ++qt) {
                const bool sel = BR == 0 ? ((selm[qt] >> kb) & 1u) != 0u : true;
                float bm = -1e30f;
#pragma unroll
                for (int kt = 0; kt < 4; ++kt)
#pragma unroll
                    for (int i = 0; i < 4; ++i) {
                        const float s = sel ? sc[kt][qt][i] * C1 : -1e30f;
                        sc[kt][qt][i] = s;
                        bm = fmaxf(bm, s);
                    }
                bm = xmax4(bm);
                const float mn = fmaxf(m[qt], bm);
                alpha[qt] = __builtin_amdgcn_exp2f(m[qt] - mn);
                float ps = 0.f;
#pragma unroll
                for (int kt = 0; kt < 4; ++kt)
#pragma unroll
                    for (int i = 0; i < 4; ++i) {
                        const float s = sc[kt][qt][i];
                        const float e = (s > -1e29f) ? __builtin_amdgcn_exp2f(s - mn) : 0.f;
                        sc[kt][qt][i] = e;
                        ps += e;
                    }
                l[qt] = l[qt] * alpha[qt] + ps;
                m[qt] = mn;
            }
        } else {
#pragma unroll
            for (int qt = 0; qt < 2; ++qt) {
                const bool sel = BR == 0 ? ((selm[qt] >> kb) & 1u) != 0u : true;
                float bm = -1e30f;
#pragma unroll
                for (int kt = 0; kt < 4; ++kt)
#pragma unroll
                    for (int i = 0; i < 4; ++i) {
                        const int key = kb * 64 + kt * 16 + fq * 4 + i;
                        bool valid = sel && (key <= qpos[qt]);
                        if (BR == 1) valid = valid && (key + 511 >= qpos[qt]);
                        const float s = valid ? sc[kt][qt][i] * C1 : -1e30f;
                        sc[kt][qt][i] = s;
                        bm = fmaxf(bm, s);
                    }
                bm = xmax4(bm);
                const float mn = fmaxf(m[qt], bm);
                alpha[qt] = __builtin_amdgcn_exp2f(m[qt] - mn);
                float ps = 0.f;
#pragma unroll
                for (int kt = 0; kt < 4; ++kt)
#pragma unroll
                    for (int i = 0; i < 4; ++i) {
                        const float s = sc[kt][qt][i];
                        const float e = (s > -1e29f) ? __builtin_amdgcn_exp2f(s - mn) : 0.f;
                        sc[kt][qt][i] = e;
                        ps += e;
                    }
                l[qt] = l[qt] * alpha[qt] + ps;
                m[qt] = mn;
            }
        }
        {
#pragma unroll
            for (int qt = 0; qt < 2; ++qt)
#pragma unroll
                for (int dt = 0; dt < 4; ++dt) o[dt][qt] *= alpha[qt];
        }
        if (mode != 3) nsa_pv(stage, sc, o, fr, fq);
        else { asm volatile("" :: "v"(sc[0][0][0]), "v"(sc[1][1][1]), "v"(sc[2][0][2]), "v"(sc[3][1][3])); }
        if (kb1 < 0) break;
        kb = kb1;
        kb1 = kb2;
        slot = slot == 2 ? 0 : slot + 1;
    }
#pragma unroll
    for (int qt = 0; qt < 2; ++qt) {
        const float lt = xsum4(l[qt]);
        const float sc2 = lt > 0.f ? gate[qt] / lt : 0.f;
#pragma unroll
        for (int dt = 0; dt < 4; ++dt) fin[dt][qt] += o[dt][qt] * sc2;
    }
    asm volatile("s_waitcnt lgkmcnt(0)" ::: "memory");
    __builtin_amdgcn_s_barrier(); asm volatile("" ::: "memory");
}

DEV void nsa_item2(const P& p, int b, int g, int qblk, unsigned char* lds, int fake = 0) {
    int tid = threadIdx.x;
    asm volatile("" : "+v"(tid));
    const int lane = tid & 63, wid = tid >> 6, fr = lane & 15, fq = lane >> 4;
    const int q0 = qblk * 32, cur = q0 >> 6, h = g * 4 + wid;
    unsigned char* wsb = p.ws;
    asm volatile("" : "+s"(wsb));
    const bf16_t* HB = (const bf16_t*)(wsb + WS_HB);
    float* IMPW = (float*)(lds + NSA_IMP);
    float* SCORE = (float*)(lds + NSA_SCORE);
    unsigned* SELM = (unsigned*)(lds + NSA_SELM);
    bf16x8 qf[2][2];
    int qpos[2];
#pragma unroll
    for (int qt = 0; qt < 2; ++qt) {
        qpos[qt] = q0 + qt * 16 + fr;
        const bf16_t* rowp = HB + (size_t)(b * S_ + qpos[qt]) * INC;
#pragma unroll
        for (int ks = 0; ks < 2; ++ks) qf[qt][ks] = *(const bf16x8*)(rowp + C_QA + h * 64 + ks * 32 + fq * 8);
    }
    if (tid < 33) SELM[tid] = 0u;
    f32x4 fin[4][2];
#pragma unroll
    for (int dt = 0; dt < 4; ++dt)
#pragma unroll
        for (int qt = 0; qt < 2; ++qt) fin[dt][qt] = (f32x4){0.f, 0.f, 0.f, 0.f};
    {
        const bf16_t* KCB = (const bf16_t*)(wsb + WS_KCB) + (size_t)(b * 2 + g) * 128 * 64;
        const bf16_t* VCT = (const bf16_t*)(wsb + WS_VCT) + (size_t)(b * 2 + g) * 64 * 128;
        {
            const int widx = __builtin_amdgcn_readfirstlane(wid);
            nsa_dma_tile(KCB, 64, VCT, 128, lds, lane, widx);
            nsa_dma_tile(KCB + 64 * 64, 64, VCT + 64, 128, lds + 16384, lane, widx);
            asm volatile("s_waitcnt vmcnt(0)" ::: "memory");
        }
        __syncthreads();
        int nv[2];
        float mx[2] = {-1e30f, -1e30f}, inv[2];
#pragma unroll
        for (int qt = 0; qt < 2; ++qt) nv[qt] = qpos[qt] >= 31 ? (((qpos[qt] - 31) >> 4) + 1) : 0;
#pragma unroll 1
        for (int kb = 0; kb < 2; ++kb) {
            f32x4 sc[4][2];
            nsa_scores(lds + kb * 16384, qf, sc, fr, fq);
#pragma unroll
            for (int qt = 0; qt < 2; ++qt)
#pragma unroll
                for (int kt = 0; kt < 4; ++kt)
#pragma unroll
                    for (int i = 0; i < 4; ++i) {
                        const int n = kb * 64 + kt * 16 + fq * 4 + i;
                        mx[qt] = fmaxf(mx[qt], (n < nv[qt]) ? sc[kt][qt][i] * 0.125f : -1e30f);
                    }
        }
        float ps[2] = {0.f, 0.f};
#pragma unroll
        for (int qt = 0; qt < 2; ++qt) mx[qt] = xmax4(mx[qt]);
#pragma unroll 1
        for (int kb = 0; kb < 2; ++kb) {
            f32x4 sc[4][2];
            nsa_scores(lds + kb * 16384, qf, sc, fr, fq);
#pragma unroll
            for (int qt = 0; qt < 2; ++qt)
#pragma unroll
                for (int kt = 0; kt < 4; ++kt)
#pragma unroll
                    for (int i = 0; i < 4; ++i) {
                        const int n = kb * 64 + kt * 16 + fq * 4 + i;
                        ps[qt] += (n < nv[qt]) ? __expf(sc[kt][qt][i] * 0.125f - mx[qt]) : 0.f;
                    }
        }
#pragma unroll
        for (int qt = 0; qt < 2; ++qt) {
            ps[qt] = xsum4(ps[qt]);
            inv[qt] = ps[qt] > 0.f ? 1.f / ps[qt] : 0.f;
        }
        float prev3[2] = {0.f, 0.f};
#pragma unroll 1
        for (int kb = 0; kb < 2; ++kb) {
            f32x4 sc[4][2];
            nsa_scores(lds + kb * 16384, qf, sc, fr, fq);
#pragma unroll
            for (int qt = 0; qt < 2; ++qt) {
                float* impw = IMPW + (wid * 32 + qt * 16 + fr) * 32 + kb * 16 + fq;
#pragma unroll
                for (int kt = 0; kt < 4; ++kt) {
                    f32x4 pv;
#pragma unroll
                    for (int i = 0; i < 4; ++i) {
                        const int n = kb * 64 + kt * 16 + fq * 4 + i;
                        pv[i] = (n < nv[qt]) ? __expf(sc[kt][qt][i] * 0.125f - mx[qt]) * inv[qt] : 0.f;
                    }
                    sc[kt][qt] = pv;
                    const float c1 = __shfl_up(pv[3], 16);
                    const float c0 = __shfl(prev3[qt], fr + 48);
                    impw[kt * 4] = pv[0] + pv[1] + pv[2] + pv[3] + (fq > 0 ? c1 : c0);
                    prev3[qt] = pv[3];
                }
            }
            nsa_pv(lds + kb * 16384, sc, fin, fr, fq);
        }
#pragma unroll
        for (int qt = 0; qt < 2; ++qt) {
            const float gc = fsigmoid(bf2f(HB[(size_t)(b * S_ + qpos[qt]) * INC + C_GATE + h * 3 + 0]));
#pragma unroll
            for (int dt = 0; dt < 4; ++dt) fin[dt][qt] *= gc;
        }
    }
    __syncthreads();
    {
        const int q = tid >> 3, jg = tid & 7;
#pragma unroll
        for (int u = 0; u < 4; ++u) {
            const int j = jg * 4 + u;
            const float imp = IMPW[(0 * 32 + q) * 32 + j] + IMPW[(1 * 32 + q) * 32 + j] + IMPW[(2 * 32 + q) * 32 + j] + IMPW[(3 * 32 + q) * 32 + j];
            float score;
            if (j > cur) score = -INFINITY;
            else if (j == 0 || j == cur || j == cur - 1) score = 1e4f;
            else score = imp;
            SCORE[q * 33 + j] = score;
        }
        __syncthreads();
        unsigned bits = 0u;
#pragma unroll
        for (int u = 0; u < 4; ++u) {
            const int j = jg * 4 + u;
            const float sj = SCORE[q * 33 + j];
            int rank = 0;
#pragma unroll 8
            for (int i = 0; i < 32; ++i) {
                const float si = SCORE[q * 33 + i];
                rank += ((si > sj) || (si == sj && i < j)) ? 1 : 0;
            }
            if (j <= cur && rank < 16) bits |= 1u << j;
        }
        atomicOr(&SELM[q], bits);
        atomicOr(&SELM[32], bits);
        __syncthreads();
    }
    unsigned selm[2];
    selm[0] = SELM[fr];
    selm[1] = SELM[16 + fr];
    const unsigned um = SELM[32];
    __syncthreads();
#pragma unroll 1
    for (int br = 0; br < 2; ++br) {
        const int wlo = (q0 - 511) > 0 ? ((q0 - 511) >> 6) : 0;
        const unsigned wmask = ((2u << cur) - 1u) & ~((1u << wlo) - 1u);
        float gs[2];
#pragma unroll
        for (int qt = 0; qt < 2; ++qt) gs[qt] = fsigmoid(bf2f(HB[(size_t)(b * S_ + qpos[qt]) * INC + C_GATE + h * 3 + 1 + br]));
        if (fake != 2) nsa_branch(fake, br, q0, wsb, lds, b, g, br ? wmask : um, qf, qpos, selm, gs, fin, tid);
    }
    bf16_t* OM = (bf16_t*)(wsb + WS_OM);
#pragma unroll
    for (int qt = 0; qt < 2; ++qt)
#pragma unroll
        for (int dt = 0; dt < 4; ++dt) {
            uint2 u2;
            u2.x = pk_bf16(fin[dt][qt][0], fin[dt][qt][1]);
            u2.y = pk_bf16(fin[dt][qt][2], fin[dt][qt][3]);
            *(uint2*)(OM + (size_t)(b * S_ + qpos[qt]) * 1024 + h * 64 + dt * 16 + fq * 4) = u2;
        }
}

DEV void hgrn_prep_item(const P& p, int item, float* smem) {
    const int c = item & 31, bh = item >> 5, hh = bh & 3, b = bh >> 2;
    const int tid = threadIdx.x, d = tid & 127, th = tid >> 7;
    const bf16_t* HB = (const bf16_t*)(p.ws + WS_HB);
    unsigned char* hs = (unsigned char*)p.out;
    bf16_t* QT = (bf16_t*)(hs + HS_QT);
    bf16_t* KT = (bf16_t*)(hs + HS_KT);
    bf16_t* KHT = (bf16_t*)(hs + HS_KHT);
    bf16_t* VIT = (bf16_t*)(hs + HS_VIT);
    float lbv;
    {
        const float l0 = p.lb_logits[hh * 128 + d], l1 = p.lb_logits[512 + hh * 128 + d];
        const float mx = fmaxf(l0, l1);
        const float e0 = expf(l0 - mx), e1 = expf(l1 - mx);
        lbv = e0 / (e0 + e1);
    }
    const size_t trow0 = (size_t)b * S_ + c * 64 + th * 32;
    float kk[32], bl[32];
    float run = 0.f;
#pragma unroll
    for (int i = 0; i < 32; ++i) {
        const float fl = bf2f(HB[(trow0 + i) * INC + C_HF + hh * 128 + d]);
        const float f = lbv + (1.f - lbv) * fsigmoid(fl);
        kk[i] = 1.f - f;
        run += __logf(f);
        bl[i] = run;
    }
    smem[th * 128 + d] = run;
    __syncthreads();
    const float off = th ? smem[d] : 0.f;
    const float blast = smem[d] + smem[128 + d];
    unsigned kh[16], vi[16];
#pragma unroll
    for (int i = 0; i < 32; i += 2) {
        float qv[2], kt[2], khv[2], vv[2];
#pragma unroll
        for (int u = 0; u < 2; ++u) {
            const float bb = bl[i + u] + off;
            const size_t tr = trow0 + i + u;
            const float q = bf2f(HB[tr * INC + C_HQ + hh * 128 + d]);
            vv[u] = bf2f(HB[tr * INC + C_HI + hh * 128 + d]);
            qv[u] = q * __expf(bb);
            kt[u] = kk[i + u] * __expf(fminf(-bb, 80.f));
            khv[u] = kk[i + u] * __expf(blast - bb);
            const size_t o = ((size_t)bh * 2048 + c * 64 + th * 32 + i + u) * 128 + d;
            QT[o] = f2bf(qv[u]);
            KT[o] = f2bf(kt[u]);
        }
        kh[i >> 1] = pk_bf16(khv[0], khv[1]);
        vi[i >> 1] = pk_bf16(vv[0], vv[1]);
    }
    {
        const size_t o = ((size_t)bh * 128 + d) * 2048 + c * 64 + th * 32;
#pragma unroll
        for (int j = 0; j < 4; ++j) {
            u32x4 a, bq;
            a[0] = kh[4 * j]; a[1] = kh[4 * j + 1]; a[2] = kh[4 * j + 2]; a[3] = kh[4 * j + 3];
            bq[0] = vi[4 * j]; bq[1] = vi[4 * j + 1]; bq[2] = vi[4 * j + 2]; bq[3] = vi[4 * j + 3];
            *(u32x4*)(KHT + o + j * 8) = a;
            *(u32x4*)(VIT + o + j * 8) = bq;
        }
    }
    if (th == 0) ((float*)(p.ws + WS_EB))[((size_t)bh * 32 + c) * 128 + d] = expf(blast);
    __syncthreads();
}

DEV bf16x8 ld2x8(const bf16_t* p0, const bf16_t* p1) {
    const uint2 lo = *(const uint2*)p0, hi = *(const uint2*)p1;
    u32x4 v;
    v[0] = lo.x; v[1] = lo.y; v[2] = hi.x; v[3] = hi.y;
    return __builtin_bit_cast(bf16x8, v);
}
struct HgRegs { u32x4 a[4], b[4]; };
DEV void hg_loadA(HgRegs& r, const bf16_t* KT, const bf16_t* QT, int s0, int tid) {
    const unsigned off = (unsigned)(((tid >> 4) * 128 + (tid & 15) * 8) * 2);
    const char* kb = (const char*)(KT + (size_t)s0 * 128);
    const char* qb = (const char*)(QT + (size_t)s0 * 128);
#pragma unroll
    for (int i = 0; i < 4; ++i) {
        r.a[i] = *(const u32x4*)(kb + i * 4096 + off);
        r.b[i] = *(const u32x4*)(qb + i * 4096 + off);
    }
}
DEV void hg_storeA(const HgRegs& r, unsigned char* lds, int tid) {
    const int c16 = tid & 15, r16 = tid >> 4;
    const int o16 = r16 * 256 + ((c16 ^ (r16 & 15)) << 4);
#pragma unroll
    for (int i = 0; i < 4; ++i) {
        *(u32x4*)(lds + o16 + i * 4096) = r.a[i];
        *(u32x4*)(lds + 16384 + o16 + i * 4096) = r.b[i];
    }
}
DEV void hg_loadB(HgRegs& r, const bf16_t* KHT, const bf16_t* VIT, int s0, int tid) {
    const unsigned off = (unsigned)(((tid >> 3) * 2048 + (tid & 7) * 8) * 2);
    const char* kb = (const char*)(KHT + s0);
    const char* vb = (const char*)(VIT + s0);
#pragma unroll
    for (int i = 0; i < 4; ++i) {
        r.a[i] = *(const u32x4*)(kb + (size_t)i * 131072 + off);
        r.b[i] = *(const u32x4*)(vb + (size_t)i * 131072 + off);
    }
}
DEV void hg_storeB(const HgRegs& r, unsigned char* lds, int tid) {
    const int c8 = tid & 7, r8 = tid >> 3;
    const int o8 = r8 * 128 + ((c8 ^ ((r8 >> 1) & 7)) << 4);
#pragma unroll
    for (int i = 0; i < 4; ++i) {
        *(u32x4*)(lds + 32768 + o8 + i * 4096) = r.a[i];
        *(u32x4*)(lds + 49152 + o8 + i * 4096) = r.b[i];
    }
}
DEV void hgrn_chain_item(const P& p, int bh, unsigned char* lds) {
    const int hh = bh & 3, b = bh >> 2;
    int tid = threadIdx.x;
    asm volatile("" : "+v"(tid));
    const int lane = tid & 63, wid = tid >> 6, fr = lane & 15, fq = lane >> 4;
    const unsigned char* hs = (const unsigned char*)p.out;
    const bf16_t* QT = (const bf16_t*)(hs + HS_QT) + (size_t)bh * 2048 * 128;
    const bf16_t* KT = (const bf16_t*)(hs + HS_KT) + (size_t)bh * 2048 * 128;
    const bf16_t* KHT = (const bf16_t*)(hs + HS_KHT) + (size_t)bh * 128 * 2048;
    const bf16_t* VIT = (const bf16_t*)(hs + HS_VIT) + (size_t)bh * 128 * 2048;
    const float* EB = (const float*)(p.ws + WS_EB) + (size_t)bh * 32 * 128;
    const bf16_t* HB = (const bf16_t*)(p.ws + WS_HB);
    bf16_t* OM = (bf16_t*)(p.ws + WS_OM);
    const unsigned char* sKT = lds;
    const unsigned char* sQT = lds + 16384;
    const unsigned char* sKH = lds + 32768;
    const unsigned char* sVI = lds + 49152;
    bf16_t* AT = (bf16_t*)lds;
    float* SS = (float*)(lds + 65536);
    f32x4 S[8][2];
#pragma unroll
    for (int i = 0; i < 8; ++i)
#pragma unroll
        for (int j = 0; j < 2; ++j) S[i][j] = (f32x4){0.f, 0.f, 0.f, 0.f};
    const int dv0 = wid * 32;
    const int sw8 = (fr >> 1) & 7;
    int b256[4];
#pragma unroll
    for (int ks = 0; ks < 4; ++ks) b256[ks] = fr * 256 + (((4 * ks + fq) ^ fr) << 4);
    int p256[4][2];
#pragma unroll
    for (int u = 0; u < 4; ++u)
#pragma unroll
        for (int h = 0; h < 2; ++h) p256[u][h] = fr * 256 + (((4 * u + 2 * h + (fq >> 1)) ^ fr) << 4) + 8 * (fq & 1);
    int b128[2];
#pragma unroll
    for (int ks = 0; ks < 2; ++ks) b128[ks] = fr * 128 + (((4 * ks + fq) ^ sw8) << 4);
    {
        HgRegs r;
        hg_loadA(r, KT, QT, 0, tid);
        hg_storeA(r, lds, tid);
        hg_loadB(r, KHT, VIT, 0, tid);
        hg_storeB(r, lds, tid);
    }
    __syncthreads();
#pragma unroll 1
    for (int c = 0; c < 32; ++c) {
        const int s0 = c * 64;
        HgRegs nx;
        if (c + 1 < 32) hg_loadA(nx, KT, QT, s0 + 64, tid);
        uint2 atp[4];
        {
            bf16x8 qf[4];
#pragma unroll
            for (int ks = 0; ks < 4; ++ks) qf[ks] = *(const bf16x8*)(sQT + wid * 4096 + b256[ks]);
#pragma unroll
            for (int st = 0; st < 4; ++st) {
                f32x4 a = (f32x4){0.f, 0.f, 0.f, 0.f};
#pragma unroll
                for (int ks = 0; ks < 4; ++ks) {
                    const bf16x8 kf = *(const bf16x8*)(sKT + st * 4096 + b256[ks]);
                    a = __builtin_amdgcn_mfma_f32_16x16x32_bf16(kf, qf[ks], a, 0, 0, 0);
                }
                const int t = wid * 16 + fr;
                float av[4];
#pragma unroll
                for (int i = 0; i < 4; ++i) av[i] = (st * 16 + fq * 4 + i <= t) ? a[i] : 0.f;
                atp[st].x = pk_bf16(av[0], av[1]);
                atp[st].y = pk_bf16(av[2], av[3]);
            }
        }
        __syncthreads();
#pragma unroll
        for (int st = 0; st < 4; ++st) *(uint2*)(AT + (wid * 16 + fr) * 72 + st * 16 + fq * 4) = atp[st];
        __syncthreads();
        f32x4 o[2][4];
#pragma unroll
        for (int i = 0; i < 2; ++i)
#pragma unroll
            for (int j = 0; j < 4; ++j) o[i][j] = (f32x4){0.f, 0.f, 0.f, 0.f};
        bf16x8 vf[2][2];
#pragma unroll
        for (int dvt = 0; dvt < 2; ++dvt)
#pragma unroll
            for (int ks = 0; ks < 2; ++ks) vf[dvt][ks] = *(const bf16x8*)(sVI + wid * 4096 + dvt * 2048 + b128[ks]);
#pragma unroll
        for (int ks = 0; ks < 2; ++ks)
#pragma unroll
            for (int tt = 0; tt < 4; ++tt) {
                const bf16x8 af = *(const bf16x8*)(AT + (tt * 16 + fr) * 72 + ks * 32 + fq * 8);
#pragma unroll
                for (int dvt = 0; dvt < 2; ++dvt) o[dvt][tt] = __builtin_amdgcn_mfma_f32_16x16x32_bf16(vf[dvt][ks], af, o[dvt][tt], 0, 0, 0);
            }
#pragma unroll
        for (int u = 0; u < 4; ++u) {
            bf16x8 sf[2];
#pragma unroll
            for (int dvt = 0; dvt < 2; ++dvt) {
                u32x4 w;
                w[0] = pk_bf16(S[2 * u][dvt][0], S[2 * u][dvt][1]);
                w[1] = pk_bf16(S[2 * u][dvt][2], S[2 * u][dvt][3]);
                w[2] = pk_bf16(S[2 * u + 1][dvt][0], S[2 * u + 1][dvt][1]);
                w[3] = pk_bf16(S[2 * u + 1][dvt][2], S[2 * u + 1][dvt][3]);
                sf[dvt] = __builtin_bit_cast(bf16x8, w);
            }
#pragma unroll
            for (int tt = 0; tt < 4; ++tt) {
                const uint2 lo = *(const uint2*)(sQT + tt * 4096 + p256[u][0]);
                const uint2 hi = *(const uint2*)(sQT + tt * 4096 + p256[u][1]);
                u32x4 w;
                w[0] = lo.x; w[1] = lo.y; w[2] = hi.x; w[3] = hi.y;
                const bf16x8 qf2 = __builtin_bit_cast(bf16x8, w);
#pragma unroll
                for (int dvt = 0; dvt < 2; ++dvt) o[dvt][tt] = __builtin_amdgcn_mfma_f32_16x16x32_bf16(sf[dvt], qf2, o[dvt][tt], 0, 0, 0);
            }
        }
        u32x4 op[4];
#pragma unroll
        for (int tt = 0; tt < 4; ++tt) {
            float ss = 0.f;
#pragma unroll
            for (int dvt = 0; dvt < 2; ++dvt)
#pragma unroll
                for (int i = 0; i < 4; ++i) ss += o[dvt][tt][i] * o[dvt][tt][i];
            ss = xsum4(ss);
            if (fq == 0) SS[wid * 64 + tt * 16 + fr] = ss;
            op[tt][0] = pk_bf16(o[0][tt][0], o[0][tt][1]);
            op[tt][1] = pk_bf16(o[0][tt][2], o[0][tt][3]);
            op[tt][2] = pk_bf16(o[1][tt][0], o[1][tt][1]);
            op[tt][3] = pk_bf16(o[1][tt][2], o[1][tt][3]);
        }
        __syncthreads();
        if (c + 1 < 32) { hg_storeA(nx, lds, tid); hg_loadB(nx, KHT, VIT, s0 + 64, tid); }
        uint2 gg[4][2];
#pragma unroll
        for (int tt = 0; tt < 4; ++tt)
#pragma unroll
            for (int dvt = 0; dvt < 2; ++dvt)
                gg[tt][dvt] = *(const uint2*)(HB + ((size_t)b * S_ + s0 + tt * 16 + fr) * INC + C_HG + hh * 128 + dv0 + dvt * 16 + fq * 4);
        {
            bf16x8 vf3[2][2];
#pragma unroll
            for (int dvt = 0; dvt < 2; ++dvt)
#pragma unroll
                for (int ks = 0; ks < 2; ++ks) vf3[dvt][ks] = *(const bf16x8*)(sVI + wid * 4096 + dvt * 2048 + b128[ks]);
#pragma unroll
            for (int dkt = 0; dkt < 8; ++dkt) {
                const float4 eb = *(const float4*)(EB + c * 128 + dkt * 16 + fq * 4);
                bf16x8 kf[2];
#pragma unroll
                for (int ks = 0; ks < 2; ++ks) kf[ks] = *(const bf16x8*)(sKH + dkt * 2048 + b128[ks]);
#pragma unroll
                for (int dvt = 0; dvt < 2; ++dvt) {
                    f32x4 a = S[dkt][dvt];
                    a[0] *= eb.x; a[1] *= eb.y; a[2] *= eb.z; a[3] *= eb.w;
                    a = __builtin_amdgcn_mfma_f32_16x16x32_bf16(kf[0], vf3[dvt][0], a, 0, 0, 0);
                    a = __builtin_amdgcn_mfma_f32_16x16x32_bf16(kf[1], vf3[dvt][1], a, 0, 0, 0);
                    S[dkt][dvt] = a;
                }
            }
        }
        __syncthreads();
        if (c + 1 < 32) hg_storeB(nx, lds, tid);
#pragma unroll
        for (int tt = 0; tt < 4; ++tt) {
            const int t = tt * 16 + fr;
            const float tot = SS[t] + SS[64 + t] + SS[128 + t] + SS[192 + t];
            const float rs = rsqrtf(tot * (1.f / 128.f) + LN_EPS);
            const size_t tg = (size_t)b * S_ + s0 + t;
#pragma unroll
            for (int dvt = 0; dvt < 2; ++dvt) {
                const int dv = dv0 + dvt * 16 + fq * 4;
                const float g0 = bflo(gg[tt][dvt].x), g1 = bfhi(gg[tt][dvt].x), g2 = bflo(gg[tt][dvt].y), g3 = bfhi(gg[tt][dvt].y);
                const float4 nwv = *(const float4*)(p.hg_norm_w + hh * 128 + dv);
                const unsigned w0 = op[tt][2 * dvt], w1 = op[tt][2 * dvt + 1];
                const float r0 = bflo(w0) * rs * nwv.x * (g0 * fsigmoid(g0));
                const float r1 = bfhi(w0) * rs * nwv.y * (g1 * fsigmoid(g1));
                const float r2 = bflo(w1) * rs * nwv.z * (g2 * fsigmoid(g2));
                const float r3 = bfhi(w1) * rs * nwv.w * (g3 * fsigmoid(g3));
                uint2 u2;
                u2.x = pk_bf16(r0, r1);
                u2.y = pk_bf16(r2, r3);
                *(uint2*)(OM + tg * 1024 + 512 + hh * 128 + dv) = u2;
            }
        }
        __syncthreads();
    }
}


DEV void hgrn_prep_item2(const P& p, int item, unsigned char* lds) {
    const int c = item & 31, bh = item >> 5, hh = bh & 3, b = bh >> 2;
    int tid = threadIdx.x;
    asm volatile("" : "+v"(tid));
    const int d = tid & 127, th = tid >> 7;
    const int lane = tid & 63, wid = tid >> 6, fr = lane & 15, fq = lane >> 4;
    const bf16_t* HB = (const bf16_t*)(p.ws + WS_HB);
    unsigned char* hs = (unsigned char*)p.out;
    bf16_t* QTg = (bf16_t*)(hs + HS_QT);
    bf16_t* OIg = (bf16_t*)(hs + HS_OI);
    uint2* DSg = (uint2*)(hs + HS_DS);
    float* tots = (float*)(lds + 65536);
    unsigned char* sKT = lds;
    unsigned char* sQT = lds + 16384;
    unsigned char* sKH = lds + 32768;
    unsigned char* sVI = lds + 49152;
    float lbv;
    {
        const float l0 = p.lb_logits[hh * 128 + d], l1 = p.lb_logits[512 + hh * 128 + d];
        const float mx = fmaxf(l0, l1);
        const float e0 = expf(l0 - mx), e1 = expf(l1 - mx);
        lbv = e0 / (e0 + e1);
    }
    const size_t trow0 = (size_t)b * S_ + c * 64 + th * 32;
    const float nwd = p.hg_norm_w[hh * 128 + d];
    float bl[32];
    float run = 0.f;
#pragma unroll
    for (int i = 0; i < 32; ++i) {
        const float fl = bf2f(HB[(trow0 + i) * INC + C_HF + hh * 128 + d]);
        const float f = lbv + (1.f - lbv) * fsigmoid(fl);
        run += __logf(f);
        bl[i] = run;
    }
    tots[th * 128 + d] = run;
    __syncthreads();
    const float off = th ? tots[d] : 0.f;
    const float blast = tots[d] + tots[128 + d];
#pragma unroll
    for (int j = 0; j < 4; ++j) {
        u32x4 a, bq;
#pragma unroll
        for (int i2 = 0; i2 < 4; ++i2) {
            float khv[2], vv[2];
#pragma unroll
            for (int u = 0; u < 2; ++u) {
                const int i = j * 8 + i2 * 2 + u;
                const float bb = bl[i] + off;
                const float kki = 1.f - __expf(bl[i] - (i ? bl[i > 0 ? i - 1 : 0] : 0.f));
                const size_t tr = trow0 + i;
                const float q = bf2f(HB[tr * INC + C_HQ + hh * 128 + d]);
                vv[u] = bf2f(HB[tr * INC + C_HI + hh * 128 + d]);
                const bf16_t qv = f2bf(q * __expf(bb));
                const bf16_t kt = f2bf(kki * __expf(fminf(-bb, 80.f)));
                khv[u] = kki * __expf(blast - bb);
                const int t = th * 32 + i;
                QTg[((size_t)bh * 2048 + c * 64 + t) * 128 + d] = qv;
                {
                    const float gv = bf2f(HB[tr * INC + C_HG + hh * 128 + d]);
                    ((bf16_t*)(p.ws + WS_XB))[((size_t)bh * 2048 + c * 64 + t) * 128 + d] = f2bf(nwd * gv * fsigmoid(gv));
                }
                const int off256 = t * 256 + ((((d >> 3) ^ (t & 15))) << 4) + (d & 7) * 2;
                *(bf16_t*)(sQT + off256) = qv;
                *(bf16_t*)(sKT + off256) = kt;
            }
            a[i2] = pk_bf16(khv[0], khv[1]);
            bq[i2] = pk_bf16(vv[0], vv[1]);
        }
        const int off128 = d * 128 + (((th * 4 + j) ^ ((d >> 1) & 7)) << 4);
        *(u32x4*)(sKH + off128) = a;
        *(u32x4*)(sVI + off128) = bq;
    }
    if (th == 0) ((float*)(p.ws + WS_EB))[((size_t)bh * 32 + c) * 128 + d] = __expf(blast);
    __syncthreads();
    const int sw8 = (fr >> 1) & 7;
    int b256[4];
#pragma unroll
    for (int ks = 0; ks < 4; ++ks) b256[ks] = fr * 256 + (((4 * ks + fq) ^ fr) << 4);
    int b128[2];
#pragma unroll
    for (int ks = 0; ks < 2; ++ks) b128[ks] = fr * 128 + (((4 * ks + fq) ^ sw8) << 4);
    uint2 atp[4];
    {
        bf16x8 qf[4];
#pragma unroll
        for (int ks = 0; ks < 4; ++ks) qf[ks] = *(const bf16x8*)(sQT + wid * 4096 + b256[ks]);
#pragma unroll
        for (int st = 0; st < 4; ++st) {
            f32x4 a = (f32x4){0.f, 0.f, 0.f, 0.f};
#pragma unroll
            for (int ks = 0; ks < 4; ++ks) {
                const bf16x8 kf = *(const bf16x8*)(sKT + st * 4096 + b256[ks]);
                a = __builtin_amdgcn_mfma_f32_16x16x32_bf16(kf, qf[ks], a, 0, 0, 0);
            }
            const int t = wid * 16 + fr;
            float av[4];
#pragma unroll
            for (int i = 0; i < 4; ++i) av[i] = (st * 16 + fq * 4 + i <= t) ? a[i] : 0.f;
            atp[st].x = pk_bf16(av[0], av[1]);
            atp[st].y = pk_bf16(av[2], av[3]);
        }
    }
    __syncthreads();
    bf16_t* AT = (bf16_t*)lds;
#pragma unroll
    for (int st = 0; st < 4; ++st) *(uint2*)(AT + (wid * 16 + fr) * 72 + st * 16 + fq * 4) = atp[st];
    __syncthreads();
    const int dv0 = wid * 32;
    bf16x8 vf[2][2];
#pragma unroll
    for (int dvt = 0; dvt < 2; ++dvt)
#pragma unroll
        for (int ks = 0; ks < 2; ++ks) vf[dvt][ks] = *(const bf16x8*)(sVI + wid * 4096 + dvt * 2048 + b128[ks]);
#pragma unroll
    for (int tt = 0; tt < 4; ++tt) {
        f32x4 o0 = (f32x4){0.f, 0.f, 0.f, 0.f}, o1 = (f32x4){0.f, 0.f, 0.f, 0.f};
#pragma unroll
        for (int ks = 0; ks < 2; ++ks) {
            const bf16x8 af = *(const bf16x8*)(AT + (tt * 16 + fr) * 72 + ks * 32 + fq * 8);
            o0 = __builtin_amdgcn_mfma_f32_16x16x32_bf16(vf[0][ks], af, o0, 0, 0, 0);
            o1 = __builtin_amdgcn_mfma_f32_16x16x32_bf16(vf[1][ks], af, o1, 0, 0, 0);
        }
        bf16_t* op = OIg + ((size_t)bh * 2048 + c * 64 + tt * 16 + fr) * 128 + dv0 + fq * 4;
        *(uint2*)op = make_uint2(pk_bf16(o0[0], o0[1]), pk_bf16(o0[2], o0[3]));
        *(uint2*)(op + 16) = make_uint2(pk_bf16(o1[0], o1[1]), pk_bf16(o1[2], o1[3]));
    }
    uint2* dsp = DSg + ((((size_t)bh * 32 + c) * 4 + wid) * 16) * 64 + lane;
#pragma unroll
    for (int dkt = 0; dkt < 8; ++dkt) {
        bf16x8 kf[2];
#pragma unroll
        for (int ks = 0; ks < 2; ++ks) kf[ks] = *(const bf16x8*)(sKH + dkt * 2048 + b128[ks]);
#pragma unroll
        for (int dvt = 0; dvt < 2; ++dvt) {
            f32x4 a = (f32x4){0.f, 0.f, 0.f, 0.f};
            a = __builtin_amdgcn_mfma_f32_16x16x32_bf16(kf[0], vf[dvt][0], a, 0, 0, 0);
            a = __builtin_amdgcn_mfma_f32_16x16x32_bf16(kf[1], vf[dvt][1], a, 0, 0, 0);
            dsp[(dkt * 2 + dvt) * 64] = make_uint2(pk_bf16(a[0], a[1]), pk_bf16(a[2], a[3]));
        }
    }
    __syncthreads();
}

DEV void hgrn_chain_item2(const P& p, int bh, unsigned char* lds) {
    const int hh = bh & 3, b = bh >> 2;
    int tid = threadIdx.x;
    asm volatile("" : "+v"(tid));
    const int lane = tid & 63, wid = __builtin_amdgcn_readfirstlane(tid >> 6), fr = lane & 15, fq = lane >> 4;
    const unsigned char* hs = (const unsigned char*)p.out;
    const bf16_t* QTg = (const bf16_t*)(hs + HS_QT) + (size_t)bh * 2048 * 128;
    const char* OIb = (const char*)(hs + HS_OI) + ((size_t)bh * 2048 * 128 + wid * 32) * 2;
    const unsigned oioff = (unsigned)((fr * 128 + fq * 4) * 2);
    const char* DSb = (const char*)(hs + HS_DS) + (((size_t)bh * 32 * 4 + wid) * 16 * 64) * 8;
    const unsigned dsoff = (unsigned)(lane * 8);
    const char* GGb = (const char*)(p.ws + WS_XB) + ((size_t)bh * 2048 * 128 + wid * 32) * 2;
    const unsigned ggoff = oioff;
    const float* EB = (const float*)(p.ws + WS_EB) + (size_t)bh * 32 * 128;
    bf16_t* OM = (bf16_t*)(p.ws + WS_OM);
    float* EBL = (float*)(lds + 16384);
    float* SS = (float*)(lds + 16896);
    const int dv0 = wid * 32;
    int p256[4][2];
#pragma unroll
    for (int u = 0; u < 4; ++u)
#pragma unroll
        for (int h = 0; h < 2; ++h) p256[u][h] = fr * 256 + (((4 * u + 2 * h + (fq >> 1)) ^ fr) << 4) + 8 * (fq & 1);
    const int c16 = tid & 15, r16 = tid >> 4;
    const int o16 = r16 * 256 + ((c16 ^ (r16 & 15)) << 4);
    const unsigned qoff = (unsigned)((r16 * 128 + c16 * 8) * 2);
    f32x4 S[2][2];
    f32x4* SL = (f32x4*)(lds + 17920) + wid * 768 + lane;
#pragma unroll
    for (int i = 0; i < 2; ++i)
#pragma unroll
        for (int j = 0; j < 2; ++j) S[i][j] = (f32x4){0.f, 0.f, 0.f, 0.f};
#pragma unroll
    for (int i = 0; i < 12; ++i) SL[i * 64] = (f32x4){0.f, 0.f, 0.f, 0.f};
    uint2 oi[4][2], dsr[8][2];
    {
        const char* qb = (const char*)QTg;
#pragma unroll
        for (int i = 0; i < 4; ++i) *(u32x4*)(lds + o16 + i * 4096) = *(const u32x4*)(qb + i * 4096 + qoff);
        if (tid < 32) *(u32x4*)(EBL + tid * 4) = *(const u32x4*)(EB + tid * 4);
#pragma unroll
        for (int tt = 0; tt < 4; ++tt)
#pragma unroll
            for (int dvt = 0; dvt < 2; ++dvt) {
                oi[tt][dvt] = *(const uint2*)(OIb + tt * 4096 + dvt * 32 + oioff);
            }
#pragma unroll
        for (int dkt = 0; dkt < 8; ++dkt)
#pragma unroll
            for (int dvt = 0; dvt < 2; ++dvt) dsr[dkt][dvt] = *(const uint2*)(DSb + (dkt * 2 + dvt) * 512 + dsoff);
    }
    __syncthreads();
#pragma unroll 1
    for (int c = 0; c < 32; ++c) {
        const int s0 = c * 64;
        const bool more = c + 1 < 32;
        uint2 gg[4][2];
#pragma unroll
        for (int tt = 0; tt < 4; ++tt)
#pragma unroll
            for (int dvt = 0; dvt < 2; ++dvt) gg[tt][dvt] = *(const uint2*)(GGb + (size_t)s0 * 256 + tt * 4096 + dvt * 32 + ggoff);
        f32x4 o[2][4];
#pragma unroll
        for (int tt = 0; tt < 4; ++tt)
#pragma unroll
            for (int dvt = 0; dvt < 2; ++dvt) {
                o[dvt][tt] = (f32x4){bflo(oi[tt][dvt].x), bfhi(oi[tt][dvt].x), bflo(oi[tt][dvt].y), bfhi(oi[tt][dvt].y)};
                if (more) oi[tt][dvt] = *(const uint2*)(OIb + (size_t)(s0 + 64) * 256 + tt * 4096 + dvt * 32 + oioff);
            }
        const unsigned char* sQ = lds;
#pragma unroll
        for (int u = 0; u < 4; ++u) {
            bf16x8 sf[2];
#pragma unroll
            for (int dvt = 0; dvt < 2; ++dvt) {
                const f32x4 sa = u < 1 ? S[0][dvt] : SL[((2 * u - 2) * 2 + dvt) * 64];
                const f32x4 sb = u < 1 ? S[1][dvt] : SL[((2 * u - 1) * 2 + dvt) * 64];
                u32x4 w;
                w[0] = pk_bf16(sa[0], sa[1]);
                w[1] = pk_bf16(sa[2], sa[3]);
                w[2] = pk_bf16(sb[0], sb[1]);
                w[3] = pk_bf16(sb[2], sb[3]);
                sf[dvt] = __builtin_bit_cast(bf16x8, w);
            }
#pragma unroll
            for (int tt = 0; tt < 4; ++tt) {
                const uint2 lo = *(const uint2*)(sQ + tt * 4096 + p256[u][0]);
                const uint2 hi = *(const uint2*)(sQ + tt * 4096 + p256[u][1]);
                u32x4 w;
                w[0] = lo.x; w[1] = lo.y; w[2] = hi.x; w[3] = hi.y;
                const bf16x8 qf2 = __builtin_bit_cast(bf16x8, w);
#pragma unroll
                for (int dvt = 0; dvt < 2; ++dvt) o[dvt][tt] = __builtin_amdgcn_mfma_f32_16x16x32_bf16(sf[dvt], qf2, o[dvt][tt], 0, 0, 0);
            }
        }
        u32x4 qn[4], ebn;
        if (more) {
            const char* qb = (const char*)(QTg + (size_t)(s0 + 64) * 128);
#pragma unroll
            for (int i = 0; i < 4; ++i) qn[i] = *(const u32x4*)(qb + i * 4096 + qoff);
            if (tid < 32) ebn = *(const u32x4*)(EB + (c + 1) * 128 + tid * 4);
        }
#pragma unroll
        for (int dkt = 0; dkt < 8; ++dkt) {
            const float4 eb = *(const float4*)(EBL + dkt * 16 + fq * 4);
#pragma unroll
            for (int dvt = 0; dvt < 2; ++dvt) {
                const uint2 dd = dsr[dkt][dvt];
                f32x4 sv = dkt < 2 ? S[dkt < 2 ? dkt : 0][dvt] : SL[((dkt - 2) * 2 + dvt) * 64];
                sv[0] = fmaf(sv[0], eb.x, bflo(dd.x));
                sv[1] = fmaf(sv[1], eb.y, bfhi(dd.x));
                sv[2] = fmaf(sv[2], eb.z, bflo(dd.y));
                sv[3] = fmaf(sv[3], eb.w, bfhi(dd.y));
                if (dkt < 2) S[dkt < 2 ? dkt : 0][dvt] = sv; else SL[((dkt - 2) * 2 + dvt) * 64] = sv;
                if (more) dsr[dkt][dvt] = *(const uint2*)(DSb + (size_t)(c + 1) * 32768 + (dkt * 2 + dvt) * 512 + dsoff);
            }
        }
#pragma unroll
        for (int tt = 0; tt < 4; ++tt) {
            float ss = 0.f;
#pragma unroll
            for (int dvt = 0; dvt < 2; ++dvt)
#pragma unroll
                for (int i = 0; i < 4; ++i) ss += o[dvt][tt][i] * o[dvt][tt][i];
            ss = xsum4(ss);
            if (fq == 0) SS[wid * 64 + tt * 16 + fr] = ss;
        }
        __syncthreads();
#pragma unroll
        for (int tt = 0; tt < 4; ++tt) {
            const int t = tt * 16 + fr;
            const float tot = SS[t] + SS[64 + t] + SS[128 + t] + SS[192 + t];
            const float rs = rsqrtf(tot * (1.f / 128.f) + LN_EPS);
            const size_t tg = (size_t)b * S_ + s0 + t;
#pragma unroll
            for (int dvt = 0; dvt < 2; ++dvt) {
                const int dv = dv0 + dvt * 16 + fq * 4;
                const float r0 = o[dvt][tt][0] * rs * bflo(gg[tt][dvt].x);
                const float r1 = o[dvt][tt][1] * rs * bfhi(gg[tt][dvt].x);
                const float r2 = o[dvt][tt][2] * rs * bflo(gg[tt][dvt].y);
                const float r3 = o[dvt][tt][3] * rs * bfhi(gg[tt][dvt].y);
                *(uint2*)(OM + tg * 1024 + 512 + hh * 128 + dv) = make_uint2(pk_bf16(r0, r1), pk_bf16(r2, r3));
            }
        }
        if (more) {
#pragma unroll
            for (int i = 0; i < 4; ++i) *(u32x4*)(lds + o16 + i * 4096) = qn[i];
            if (tid < 32) *(u32x4*)(EBL + tid * 4) = ebn;
        }
        __syncthreads();
    }
}

DEV void xattn_item2(const P& p, int item) {
    const int qt64 = item & 31, hh = (item >> 5) & 3, b = item >> 7;
    const int lane = threadIdx.x & 63, wid = threadIdx.x >> 6, fr = lane & 15, fq = lane >> 4;
    const bf16_t* QX = (const bf16_t*)(p.ws + WS_QX);
    const bf16_t* KVM = (const bf16_t*)(p.ws + WS_KVM);
    const bf16_t* VMT = (const bf16_t*)(p.ws + WS_VMT) + (size_t)(b * 4 + hh) * 256 * 256;
    bf16_t* OX = (bf16_t*)(p.ws + WS_OX);
    const size_t tq = (size_t)b * S_ + qt64 * 64 + wid * 16 + fr;
    bf16x8 qf[8];
#pragma unroll
    for (int ks = 0; ks < 8; ++ks) qf[ks] = *(const bf16x8*)(QX + tq * 1024 + hh * 256 + ks * 32 + fq * 8);
    f32x4 sc[16];
#pragma unroll
    for (int kt = 0; kt < 16; ++kt) {
        f32x4 a = (f32x4){0.f, 0.f, 0.f, 0.f};
        const bf16_t* kp = KVM + (size_t)(b * ML_ + kt * 16 + fr) * 2048 + hh * 256 + fq * 8;
#pragma unroll
        for (int ks = 0; ks < 8; ++ks) a = __builtin_amdgcn_mfma_f32_16x16x32_bf16(*(const bf16x8*)(kp + ks * 32), qf[ks], a, 0, 0, 0);
        sc[kt] = a;
    }
    float mx = -1e30f;
#pragma unroll
    for (int kt = 0; kt < 16; ++kt)
#pragma unroll
        for (int i = 0; i < 4; ++i) { sc[kt][i] *= 0.0625f; mx = fmaxf(mx, sc[kt][i]); }
    mx = xmax4(mx);
    float ps = 0.f;
#pragma unroll
    for (int kt = 0; kt < 16; ++kt)
#pragma unroll
        for (int i = 0; i < 4; ++i) { sc[kt][i] = __expf(sc[kt][i] - mx); ps += sc[kt][i]; }
    ps = xsum4(ps);
    const float inv = 1.f / ps;
    u32x4 pf[8];
#pragma unroll
    for (int s = 0; s < 8; ++s) {
        pf[s][0] = pk_bf16(sc[2 * s][0] * inv, sc[2 * s][1] * inv);
        pf[s][1] = pk_bf16(sc[2 * s][2] * inv, sc[2 * s][3] * inv);
        pf[s][2] = pk_bf16(sc[2 * s + 1][0] * inv, sc[2 * s + 1][1] * inv);
        pf[s][3] = pk_bf16(sc[2 * s + 1][2] * inv, sc[2 * s + 1][3] * inv);
    }
#pragma unroll 1
    for (int dh = 0; dh < 2; ++dh) {
        f32x4 o[8];
#pragma unroll
        for (int dt = 0; dt < 8; ++dt) o[dt] = (f32x4){0.f, 0.f, 0.f, 0.f};
#pragma unroll
        for (int s = 0; s < 8; ++s) {
#pragma unroll
            for (int dt = 0; dt < 8; ++dt) {
                const bf16_t* vp = VMT + (size_t)(dh * 128 + dt * 16 + fr) * 256 + 32 * s + 4 * fq;
                o[dt] = __builtin_amdgcn_mfma_f32_16x16x32_bf16(ld2x8(vp, vp + 16), __builtin_bit_cast(bf16x8, pf[s]), o[dt], 0, 0, 0);
            }
        }
#pragma unroll
        for (int dt = 0; dt < 8; ++dt) {
            uint2 u2;
            u2.x = pk_bf16(o[dt][0], o[dt][1]);
            u2.y = pk_bf16(o[dt][2], o[dt][3]);
            *(uint2*)(OX + tq * 1024 + hh * 256 + dh * 128 + dt * 16 + fq * 4) = u2;
        }
    }
}


struct XaRegs { u32x4 r[8]; };
DEV void xa_loadK(XaRegs& x, const bf16_t* kbase, int tid) {
    const int c = tid & 31, r0 = tid >> 5;
#pragma unroll
    for (int i = 0; i < 8; ++i) x.r[i] = *(const u32x4*)(kbase + (size_t)(r0 + 8 * i) * 2048 + c * 8);
}
DEV void xa_storeK(const XaRegs& x, unsigned char* lds, int tid) {
    const int c = tid & 31, r0 = tid >> 5;
#pragma unroll
    for (int i = 0; i < 8; ++i) {
        const int row = r0 + 8 * i;
        *(u32x4*)(lds + row * 512 + ((c ^ (row & 15)) << 4)) = x.r[i];
    }
}
DEV void xa_loadV(XaRegs& x, const bf16_t* vbase, int tid) {
    const int c = tid & 7, r0 = tid >> 3;
#pragma unroll
    for (int i = 0; i < 8; ++i) x.r[i] = *(const u32x4*)(vbase + (size_t)(r0 + 32 * i) * 256 + c * 8);
}
DEV void xa_storeV(const XaRegs& x, unsigned char* lds, int tid) {
    const int c = tid & 7, r0 = tid >> 3;
    const int o = r0 * 128 + ((c ^ ((r0 >> 1) & 7)) << 4);
#pragma unroll
    for (int i = 0; i < 8; ++i) *(u32x4*)(lds + 32768 + o + i * 4096) = x.r[i];
}
DEV void xattn_item3(const P& p, int item, unsigned char* lds) {
    const int qt64 = item & 31, hh = (item >> 5) & 3, b = item >> 7;
    int tid = threadIdx.x;
    asm volatile("" : "+v"(tid));
    const int lane = tid & 63, wid = tid >> 6, fr = lane & 15, fq = lane >> 4;
    const bf16_t* QX = (const bf16_t*)(p.ws + WS_QX);
    const bf16_t* KB = (const bf16_t*)(p.ws + WS_KVM) + (size_t)(b * ML_) * 2048 + hh * 256;
    const bf16_t* VB = (const bf16_t*)(p.ws + WS_VMT) + (size_t)(b * 4 + hh) * 256 * 256;
    bf16_t* OX = (bf16_t*)(p.ws + WS_OX);
    const size_t tq = (size_t)b * S_ + qt64 * 64 + wid * 16 + fr;
    bf16x8 qf[8];
#pragma unroll
    for (int ks = 0; ks < 8; ++ks) qf[ks] = *(const bf16x8*)(QX + tq * 1024 + hh * 256 + ks * 32 + fq * 8);
    f32x4 o[16];
#pragma unroll
    for (int dt = 0; dt < 16; ++dt) o[dt] = (f32x4){0.f, 0.f, 0.f, 0.f};
    float m = -1e30f, l = 0.f;
    {
        XaRegs x;
        xa_loadK(x, KB, tid);
        xa_storeK(x, lds, tid);
        xa_loadV(x, VB, tid);
        xa_storeV(x, lds, tid);
    }
    __syncthreads();
    const int sw8 = (fr >> 1) & 7;
#pragma unroll 1
    for (int j = 0; j < 4; ++j) {
        XaRegs nx;
        if (j + 1 < 4) xa_loadK(nx, KB + (size_t)(j + 1) * 64 * 2048, tid);
        f32x4 sc[4];
#pragma unroll
        for (int kt = 0; kt < 4; ++kt) {
            f32x4 a = (f32x4){0.f, 0.f, 0.f, 0.f};
            const unsigned char* rp = lds + (kt * 16 + fr) * 512;
#pragma unroll
            for (int ks = 0; ks < 8; ++ks) a = __builtin_amdgcn_mfma_f32_16x16x32_bf16(*(const bf16x8*)(rp + (((4 * ks + fq) ^ fr) << 4)), qf[ks], a, 0, 0, 0);
            sc[kt] = a;
        }
        __syncthreads();
        if (j + 1 < 4) { xa_storeK(nx, lds, tid); xa_loadV(nx, VB + (j + 1) * 64, tid); }
        float bm = -1e30f;
#pragma unroll
        for (int kt = 0; kt < 4; ++kt)
#pragma unroll
            for (int i = 0; i < 4; ++i) { sc[kt][i] *= 0.0625f; bm = fmaxf(bm, sc[kt][i]); }
        bm = xmax4(bm);
        const float mn = fmaxf(m, bm);
        const float alpha = __expf(m - mn);
        float ps = 0.f;
#pragma unroll
        for (int kt = 0; kt < 4; ++kt)
#pragma unroll
            for (int i = 0; i < 4; ++i) { sc[kt][i] = __expf(sc[kt][i] - mn); ps += sc[kt][i]; }
        l = l * alpha + ps;
        m = mn;
#pragma unroll
        for (int dt = 0; dt < 16; ++dt) o[dt] *= alpha;
#pragma unroll
        for (int s = 0; s < 2; ++s) {
            u32x4 w;
            w[0] = pk_bf16(sc[2 * s][0], sc[2 * s][1]);
            w[1] = pk_bf16(sc[2 * s][2], sc[2 * s][3]);
            w[2] = pk_bf16(sc[2 * s + 1][0], sc[2 * s + 1][1]);
            w[3] = pk_bf16(sc[2 * s + 1][2], sc[2 * s + 1][3]);
            const bf16x8 pf = __builtin_bit_cast(bf16x8, w);
#pragma unroll
            for (int dt = 0; dt < 16; ++dt) {
                const unsigned char* rp = lds + 32768 + (dt * 16 + fr) * 128 + 8 * (fq & 1);
                const uint2 lo = *(const uint2*)(rp + (((4 * s + (fq >> 1)) ^ sw8) << 4));
                const uint2 hi = *(const uint2*)(rp + (((4 * s + 2 + (fq >> 1)) ^ sw8) << 4));
                u32x4 vv;
                vv[0] = lo.x; vv[1] = lo.y; vv[2] = hi.x; vv[3] = hi.y;
                o[dt] = __builtin_amdgcn_mfma_f32_16x16x32_bf16(__builtin_bit_cast(bf16x8, vv), pf, o[dt], 0, 0, 0);
            }
        }
        __syncthreads();
        if (j + 1 < 4) xa_storeV(nx, lds, tid);
        __syncthreads();
    }
    const float inv = 1.f / xsum4(l);
#pragma unroll
    for (int dt = 0; dt < 16; ++dt) {
        uint2 u2;
        u2.x = pk_bf16(o[dt][0] * inv, o[dt][1] * inv);
        u2.y = pk_bf16(o[dt][2] * inv, o[dt][3] * inv);
        *(uint2*)(OX + tq * 1024 + hh * 256 + dt * 16 + fq * 4) = u2;
    }
}


DEV void peer_quant_row(const float* src, unsigned char* dst, float* scl, int row, int* rsum = nullptr) {
    const int lane = threadIdx.x & 63;
    const float* r = src + (size_t)row * 1024 + lane * 16;
    float v[16];
#pragma unroll
    for (int i = 0; i < 4; ++i) {
        const float4 a = *(const float4*)(r + 4 * i);
        v[4 * i] = a.x; v[4 * i + 1] = a.y; v[4 * i + 2] = a.z; v[4 * i + 3] = a.w;
    }
    float mx = 0.f;
#pragma unroll
    for (int i = 0; i < 16; ++i) mx = fmaxf(mx, fabsf(v[i]));
    mx = wmax(mx);
    const float q = mx > 0.f ? 127.f / mx : 0.f;
    u32x4 w;
    int usum = 0;
#pragma unroll
    for (int i = 0; i < 4; ++i) {
        unsigned pk = 0u;
#pragma unroll
        for (int k = 0; k < 4; ++k) {
            int qi = (int)rintf(v[4 * i + k] * q);
            qi = qi < -127 ? -127 : (qi > 127 ? 127 : qi);
            pk |= (unsigned)(qi + 128) << (8 * k);
            usum += qi + 128;
        }
        w[i] = pk;
    }
    *(u32x4*)(dst + ((size_t)(lane >> 3) * 16384 + row) * 128 + (lane & 7) * 16) = w;
    if (rsum) {
#pragma unroll
        for (int o = 32; o > 0; o >>= 1) usum += __shfl_xor(usum, o);
        if (lane == 0) rsum[row] = usum;
    }
    if (lane == 0) scl[row] = mx * (1.f / 127.f);
}

DEV unsigned f2ord(float f) { const unsigned b = __float_as_uint(f); return b ^ ((b >> 31) ? 0xffffffffu : 0x80000000u); }
DEV float ord2f(unsigned o) { return __uint_as_float((o & 0x80000000u) ? (o ^ 0x80000000u) : ~o); }
DEV void ins16(unsigned (&v)[16], unsigned x) {
#pragma unroll
    for (int k = 0; k < 16; ++k) {
        const unsigned t = v[k] > x ? v[k] : x;
        x = v[k] > x ? x : v[k];
        v[k] = t;
    }
}
constexpr int PEER_SC = 0;
constexpr int PEER_LST = 0;
constexpr int PEER_EID = 16384;
constexpr int PEER_GATE = 16384 + 4096;
DEV void peer_route_item(const P& p, int item, unsigned char* lds) {
    const int tid = threadIdx.x, lane = tid & 63, wid = tid >> 6;
    const int t0 = item * 16;
    const bf16_t* QP = (const bf16_t*)(p.ws + WS_QP);
    const bf16_t* PK = (const bf16_t*)(p.ws + WS_PKEY);
    unsigned* SC = (unsigned*)(lds + PEER_SC);
    const int fr = lane & 15, fq = lane >> 4;
    unsigned lst[16];
#pragma unroll
    for (int k = 0; k < 16; ++k) lst[k] = 0u;
    bf16x8 qf[4][2];
#pragma unroll
    for (int ci = 0; ci < 4; ++ci)
#pragma unroll
        for (int ks = 0; ks < 2; ++ks)
            qf[ci][ks] = *(const bf16x8*)(QP + (size_t)(t0 + fr) * 1024 + (4 * wid + ci) * 64 + ks * 32 + fq * 8);
#pragma unroll 1
    for (int pass = 0; pass < 2; ++pass) {
#pragma unroll
        for (int ci = 0; ci < 4; ++ci) {
            const int cb = 4 * wid + ci;
#pragma unroll
            for (int kt = 0; kt < 4; ++kt) {
                f32x4 acc = (f32x4){0.f, 0.f, 0.f, 0.f};
#pragma unroll
                for (int ks = 0; ks < 2; ++ks) {
                    const bf16x8 kf = *(const bf16x8*)(PK + ((size_t)cb * 128 + pass * 64 + kt * 16 + fr) * 64 + ks * 32 + fq * 8);
                    acc = __builtin_amdgcn_mfma_f32_16x16x32_bf16(kf, qf[ci][ks], acc, 0, 0, 0);
                }
                unsigned* dst = SC + (cb * 16 + fr) * 65 + kt * 16 + fq * 4;
#pragma unroll
                for (int i = 0; i < 4; ++i) {
                    const int kidx = pass * 64 + kt * 16 + fq * 4 + i;
                    dst[i] = (f2ord(acc[i]) & ~127u) | (unsigned)(127 - kidx);
                }
            }
        }
        __syncthreads();
        {
            const unsigned* row = SC + tid * 65;
#pragma unroll 4
            for (int k = 0; k < 64; ++k) ins16(lst, row[k]);
        }
        __syncthreads();
    }
    unsigned* LST = (unsigned*)(lds + PEER_LST);
#pragma unroll
    for (int k = 0; k < 16; ++k) LST[tid * 16 + k] = lst[k];
    __syncthreads();
    unsigned short* EID = (unsigned short*)(lds + PEER_EID);
    float* GATE = (float*)(lds + PEER_GATE);
    if (((tid >> 4) & 1) == 0) {
        const int tok = tid & 15, hh = tid >> 5;
        const unsigned* l2 = LST + (tid + 16) * 16;
        float s1[16], s2[16];
#pragma unroll
        for (int k = 0; k < 16; ++k) { s1[k] = ord2f(lst[k] & ~127u); s2[k] = ord2f(l2[k] & ~127u); }
        unsigned fin[16];
#pragma unroll
        for (int k = 0; k < 16; ++k) fin[k] = 0u;
#pragma unroll
        for (int i = 0; i < 16; ++i)
#pragma unroll
            for (int j = 0; j < 16; ++j)
                if ((i + 1) * (j + 1) <= 16) ins16(fin, (f2ord(s1[i] + s2[j]) & ~255u) | (unsigned)(255 - (i * 16 + j)));
        const float mx = ord2f(fin[0] & ~255u);
        float w[16], ws = 0.f;
#pragma unroll
        for (int k = 0; k < 16; ++k) { w[k] = expf(ord2f(fin[k] & ~255u) - mx); ws += w[k]; }
        const float inv = 1.f / ws;
#pragma unroll
        for (int k = 0; k < 16; ++k) {
            const int flat = 255 - (int)(fin[k] & 255u);
            const int i1 = 127 - (int)(LST[tid * 16 + (flat >> 4)] & 127u);
            const int i2 = 127 - (int)(l2[flat & 15] & 127u);
            EID[tok * 128 + hh * 16 + k] = (unsigned short)(i1 * 128 + i2);
            GATE[tok * 128 + hh * 16 + k] = w[k] * inv;
        }
    }
    __syncthreads();
    {
        unsigned short* EIDP = (unsigned short*)(p.ws + WS_EIDP);
        float* GATEP = (float*)(p.ws + WS_GATEP);
        for (int i = tid; i < 16 * 128; i += 256) {
            const int tok = i >> 7, pi = i & 127, eg = pi >> 4, k = pi & 15, slot = 8 * k + eg;
            EIDP[(size_t)(t0 + tok) * 128 + pi] = EID[tok * 128 + slot];
            GATEP[(size_t)(t0 + tok) * 128 + pi] = GATE[tok * 128 + slot];
        }
        unsigned char* XQ = p.ws + WS_XQ;
#pragma unroll 1
        for (int tt = 0; tt < 4; ++tt) {
            const size_t t = (size_t)t0 + wid * 4 + tt;
            const bf16_t* row = (const bf16_t*)(p.ws + WS_XB) + t * 1024 + lane * 16;
            float xr[16];
            float amax = 0.f;
#pragma unroll
            for (int i = 0; i < 2; ++i) {
                const u32x4 a4 = *(const u32x4*)(row + 8 * i);
#pragma unroll
                for (int q = 0; q < 4; ++q) {
                    xr[8 * i + 2 * q] = bflo(a4[q]);
                    xr[8 * i + 2 * q + 1] = bfhi(a4[q]);
                    amax = fmaxf(amax, fmaxf(fabsf(xr[8 * i + 2 * q]), fabsf(xr[8 * i + 2 * q + 1])));
                }
            }
            amax = wmax(amax);
            const float qx = amax > 0.f ? 127.f / amax : 0.f;
            u32x4 w;
            int s_ = 0;
#pragma unroll
            for (int i = 0; i < 4; ++i) {
                unsigned pk = 0u;
#pragma unroll
                for (int k = 0; k < 4; ++k) {
                    int qi = (int)rintf(xr[4 * i + k] * qx);
                    qi = qi < -127 ? -127 : (qi > 127 ? 127 : qi);
                    pk |= (unsigned)(qi + 128) << (8 * k);
                    s_ += qi + 128;
                }
                w[i] = pk;
            }
#pragma unroll
            for (int o = 32; o > 0; o >>= 1) s_ += __shfl_xor(s_, o);
            *(u32x4*)(XQ + t * 1024 + lane * 16) = w;
            if (lane == 0) {
                ((float*)(p.ws + WS_SXF))[t] = amax * (1.f / 127.f);
                ((int*)(p.ws + WS_SXI))[t] = s_;
            }
        }
    }
    __syncthreads();
}

DEV void peer_down_item(const P& p, int s, int tile, int lane, int wid) {
    const unsigned char* PD = p.ws + WS_PD + (size_t)s * 16384 * 128;
    const unsigned short* EIDP = (const unsigned short*)(p.ws + WS_EIDP);
    int* DP = (int*)(p.ws + WS_DP) + (size_t)s * T_ * 128;
    const int eg = lane >> 3, cg = lane & 7;
#pragma unroll 1
    for (int tt = 0; tt < 8; ++tt) {
        const size_t t = (size_t)tile * 32 + wid * 8 + tt;
        const u32x4 xu = *(const u32x4*)(p.ws + WS_XQ + t * 1024 + s * 128 + cg * 16);
        const u32x4 e0 = *(const u32x4*)(EIDP + t * 128 + eg * 16);
        const u32x4 e1 = *(const u32x4*)(EIDP + t * 128 + eg * 16 + 8);
        u32x4 rows[16];
#pragma unroll
        for (int k = 0; k < 16; ++k) {
            const unsigned ew = k < 8 ? e0[k >> 1] : e1[(k - 8) >> 1];
            const unsigned e = (k & 1) ? (ew >> 16) : (ew & 0xffffu);
            rows[k] = *(const u32x4*)(PD + (size_t)e * 128 + cg * 16);
        }
        unsigned v[16];
#pragma unroll
        for (int k = 0; k < 16; ++k) {
            unsigned a_ = 0u;
#pragma unroll
            for (int q = 0; q < 4; ++q) a_ = __builtin_amdgcn_udot4(rows[k][q], xu[q], a_, false);
            v[k] = a_;
        }
        unsigned w8[8], w4[4], w2[2];
        {
            const bool hi = (cg & 4) != 0;
#pragma unroll
            for (int j = 0; j < 8; ++j) {
                const unsigned send = hi ? v[j] : v[j + 8];
                const unsigned keep = hi ? v[j + 8] : v[j];
                w8[j] = keep + (unsigned)__shfl_xor((int)send, 4);
            }
        }
        {
            const bool hi = (cg & 2) != 0;
#pragma unroll
            for (int j = 0; j < 4; ++j) {
                const unsigned send = hi ? w8[j] : w8[j + 4];
                const unsigned keep = hi ? w8[j + 4] : w8[j];
                w4[j] = keep + (unsigned)__shfl_xor((int)send, 2);
            }
        }
        {
            const bool hi = (cg & 1) != 0;
#pragma unroll
            for (int j = 0; j < 2; ++j) {
                const unsigned send = hi ? w4[j] : w4[j + 2];
                const unsigned keep = hi ? w4[j + 2] : w4[j];
                w2[j] = keep + (unsigned)__shfl_xor((int)send, 1);
            }
        }
        *(uint2*)(DP + t * 128 + eg * 16 + 2 * cg) = make_uint2(w2[0], w2[1]);
    }
}

DEV void peer_coef_item(const P& p, int t, int lane) {
    const int* DP = (const int*)(p.ws + WS_DP);
    const unsigned short* EIDP = (const unsigned short*)(p.ws + WS_EIDP);
    const float* GATEP = (const float*)(p.ws + WS_GATEP);
    const float sx = ((const float*)(p.ws + WS_SXF))[t];
    const int sxu = ((const int*)(p.ws + WS_SXI))[t];
    float cs = 0.f;
#pragma unroll
    for (int h = 0; h < 2; ++h) {
        const int pi = lane + 64 * h;
        int tot = 0;
#pragma unroll
        for (int s = 0; s < 8; ++s) tot += DP[((size_t)s * T_ + t) * 128 + pi];
        const int e = EIDP[(size_t)t * 128 + pi];
        const int dotq = tot - 128 * ((const int*)(p.ws + WS_PRS))[e] - 128 * sxu + 128 * 128 * 1024;
        const float hv = ((const float*)(p.ws + WS_PSD))[e] * sx * (float)dotq;
        const float coef = 0.5f * hv * (1.f + erff(hv * 0.7071067811865476f)) * GATEP[(size_t)t * 128 + pi] * ((const float*)(p.ws + WS_PSU))[e];
        ((float*)(p.ws + WS_COEFP))[(size_t)t * 128 + pi] = coef;
        cs += coef;
    }
    cs = wsum(cs);
    if (lane == 0) ((float*)(p.ws + WS_ASUM))[t] = cs;
}

DEV void peer_up_item(const P& p, int s, int tile, int lane, int wid, bool dostore = true) {
    const unsigned char* PU = p.ws + WS_PU + (size_t)s * 16384 * 128;
    const unsigned short* EIDP = (const unsigned short*)(p.ws + WS_EIDP);
    const float* COEFP = (const float*)(p.ws + WS_COEFP);
    const int eg = lane >> 3, cg = lane & 7;
#pragma unroll 1
    for (int tt = 0; tt < 8; ++tt) {
        const size_t t = (size_t)tile * 32 + wid * 8 + tt;
        const u32x4 e0 = *(const u32x4*)(EIDP + t * 128 + eg * 16);
        const u32x4 e1 = *(const u32x4*)(EIDP + t * 128 + eg * 16 + 8);
        float cf[16];
#pragma unroll
        for (int i = 0; i < 4; ++i) {
            const float4 c4 = *(const float4*)(COEFP + t * 128 + eg * 16 + 4 * i);
            cf[4 * i] = c4.x; cf[4 * i + 1] = c4.y; cf[4 * i + 2] = c4.z; cf[4 * i + 3] = c4.w;
        }
        u32x4 rows[16];
#pragma unroll
        for (int k = 0; k < 16; ++k) {
            const unsigned ew = k < 8 ? e0[k >> 1] : e1[(k - 8) >> 1];
            const unsigned e = (k & 1) ? (ew >> 16) : (ew & 0xffffu);
            rows[k] = *(const u32x4*)(PU + (size_t)e * 128 + cg * 16);
        }
        float acc[16];
#pragma unroll
        for (int i = 0; i < 16; ++i) acc[i] = 0.f;
#pragma unroll
        for (int k = 0; k < 16; ++k)
#pragma unroll
            for (int q = 0; q < 4; ++q) {
                const unsigned w_ = rows[k][q];
                acc[4 * q] += cf[k] * (float)(w_ & 0xffu);
                acc[4 * q + 1] += cf[k] * (float)((w_ >> 8) & 0xffu);
                acc[4 * q + 2] += cf[k] * (float)((w_ >> 16) & 0xffu);
                acc[4 * q + 3] += cf[k] * (float)(w_ >> 24);
            }
        float a8[8], a4[4], a2[2];
        {
            const bool hi = (eg & 4) != 0;
#pragma unroll
            for (int j = 0; j < 8; ++j) {
                const float send = hi ? acc[j] : acc[j + 8];
                const float keep = hi ? acc[j + 8] : acc[j];
                a8[j] = keep + __shfl_xor(send, 32);
            }
        }
        {
            const bool hi = (eg & 2) != 0;
#pragma unroll
            for (int j = 0; j < 4; ++j) {
                const float send = hi ? a8[j] : a8[j + 4];
                const float keep = hi ? a8[j + 4] : a8[j];
                a4[j] = keep + __shfl_xor(send, 16);
            }
        }
        {
            const bool hi = (eg & 1) != 0;
#pragma unroll
            for (int j = 0; j < 2; ++j) {
                const float send = hi ? a4[j] : a4[j + 2];
                const float keep = hi ? a4[j + 2] : a4[j];
                a2[j] = keep + __shfl_xor(send, 8);
            }
        }
        const float asum = ((const float*)(p.ws + WS_ASUM))[t];
        const unsigned xb = *(const unsigned*)((const bf16_t*)(p.ws + WS_XB) + t * 1024 + s * 128 + cg * 16 + 2 * eg);
        if (dostore) *(unsigned*)((bf16_t*)(p.ws + WS_XB) + t * 1024 + s * 128 + cg * 16 + 2 * eg) = pk_bf16(ALPHA * bflo(xb) + (a2[0] - 128.f * asum), ALPHA * bfhi(xb) + (a2[1] - 128.f * asum));
    }
}

DEV void ln3_item(const P& p, int t, int lane) {
    float* row = p.out + (size_t)t * 1024;
    const bf16_t* yrow = (const bf16_t*)(p.ws + WS_XB) + (size_t)t * 1024;
    float4 v[4];
    float s = 0.f;
#pragma unroll
    for (int i = 0; i < 4; ++i) {
        const uint2 u = *(const uint2*)(yrow + (i * 64 + lane) * 4);
        v[i] = make_float4(bflo(u.x), bfhi(u.x), bflo(u.y), bfhi(u.y));
        s += v[i].x + v[i].y + v[i].z + v[i].w;
    }
    const float mean = wsum(s) * (1.f / 1024.f);
    float ss = 0.f;
#pragma unroll
    for (int i = 0; i < 4; ++i) {
        v[i].x -= mean; v[i].y -= mean; v[i].z -= mean; v[i].w -= mean;
        ss += v[i].x * v[i].x + v[i].y * v[i].y + v[i].z * v[i].z + v[i].w * v[i].w;
    }
    const float rs = rsqrtf(wsum(ss) * (1.f / 1024.f) + LN_EPS);
#pragma unroll
    for (int i = 0; i < 4; ++i) {
        const int c = (i * 64 + lane) * 4;
        const float4 gg = *(const float4*)(p.ln_g + 2 * 1024 + c);
        const float4 bb = *(const float4*)(p.ln_b + 2 * 1024 + c);
        float4 o;
        o.x = v[i].x * rs * gg.x + bb.x; o.y = v[i].y * rs * gg.y + bb.y; o.z = v[i].z * rs * gg.z + bb.z; o.w = v[i].w * rs * gg.w + bb.w;
        *(float4*)(row + c) = o;
    }
}

#define XB_TMO      128
#define XB_XCNT(j)  (256  + 64 * (j))
#define XB_XSUB(j)  (1280 + 64 * (j))
#define XB_XGEN(j)  (2304 + 64 * (j))
#define XB_TOP      3328
#define XB_TOPGEN   3392
#define XCD_BAR_WORDS 3456
#define XB_SPIN_CAP (1u << 20)
#define LAS __attribute__((address_space(3)))
DEV unsigned xb_ld(unsigned* p) { return __hip_atomic_load(p, __ATOMIC_RELAXED, __HIP_MEMORY_SCOPE_AGENT); }
DEV unsigned xb_add(unsigned* p, unsigned v) { return __hip_atomic_fetch_add(p, v, __ATOMIC_RELAXED, __HIP_MEMORY_SCOPE_AGENT); }
DEV unsigned xb_xcc_id() { return (unsigned)__builtin_amdgcn_s_getreg((3 << 11) | 20) & 0xFu; }
#define XB_SPIN(cond, bar) do { unsigned _sp = 0; while (cond) { __builtin_amdgcn_s_sleep(1); \
    if ((++_sp & 255u) == 0u) { if (xb_ld(&(bar)[XB_TMO])) break; if (_sp > XB_SPIN_CAP) { atomicAdd(&(bar)[XB_TMO], 1u); break; } } } } while (0)
struct XcdBarrier { unsigned* bar; unsigned x; volatile LAS unsigned* st; };
DEV XcdBarrier xcd_barrier_post(unsigned* bar, volatile LAS unsigned* st) {
    XcdBarrier b; b.bar = bar; b.x = xb_xcc_id(); b.st = st;
    if (threadIdx.x == 0) (void)xb_add(&bar[XB_XCNT(b.x)], 1u);
    return b;
}
DEV void xcd_barrier_complete(unsigned* bar, unsigned x, unsigned& nloc, unsigned& nx) {
    const unsigned G = gridDim.x * gridDim.y * gridDim.z;
    unsigned sum, cnt, mine, sp = 0u;
    for (;;) {
        sum = 0u; cnt = 0u; mine = 0u;
#pragma unroll
        for (unsigned j = 0; j < 16; ++j) { const unsigned c = xb_ld(&bar[XB_XCNT(j)]); sum += c; cnt += (c > 0u) ? 1u : 0u; mine = (j == x) ? c : mine; }
        if (sum == G) break;
        __builtin_amdgcn_s_sleep(1);
        if ((++sp & 255u) == 0u) { if (xb_ld(&bar[XB_TMO])) break; if (sp > XB_SPIN_CAP) { atomicAdd(&bar[XB_TMO], 1u); break; } }
    }
    nloc = mine > 0u ? mine : 1u; nx = cnt > 0u ? cnt : 1u;
}
DEV void xcd_barrier(const XcdBarrier& b) {
    asm volatile("s_waitcnt vmcnt(0)" ::: "memory");
    __syncthreads();
    if (threadIdx.x == 0) {
        unsigned* bar = b.bar;
        __builtin_amdgcn_s_waitcnt(0);
        unsigned nloc = b.st[0], nx = b.st[1];
        if (nloc == 0u) { xcd_barrier_complete(bar, b.x, nloc, nx); b.st[0] = nloc; b.st[1] = nx; }
        const unsigned old = xb_add(&bar[XB_XSUB(b.x)], 1u);
        const unsigned gen = old / nloc;
        if (old + 1u == (gen + 1u) * nloc) {
            __builtin_amdgcn_fence(__ATOMIC_RELEASE, "agent");
            asm volatile("s_waitcnt vmcnt(0)" ::: "memory");
            const unsigned og = xb_add(&bar[XB_TOP], 1u);
            const unsigned tg = og / nx;
            if (og + 1u == (tg + 1u) * nx) xb_add(&bar[XB_TOPGEN], 1u);
            else XB_SPIN(xb_ld(&bar[XB_TOPGEN]) == tg, bar);
            __builtin_amdgcn_fence(__ATOMIC_ACQUIRE, "agent");
            xb_add(&bar[XB_XGEN(b.x)], 1u);
            asm volatile("s_waitcnt vmcnt(0)" ::: "memory");
        } else {
            XB_SPIN(xb_ld(&bar[XB_XGEN(b.x)]) == gen, bar);
            __builtin_amdgcn_fence(__ATOMIC_ACQUIRE, "agent");
            asm volatile("s_waitcnt vmcnt(0)" ::: "memory");
        }
    }
    __syncthreads();
}


DEV void late_transpose_item(const P& p, int it, float* smem) {
    const int m = it >> 8, t = it & 255;
    const float* W = m == 0 ? p.w_out : (m == 1 ? p.xa_wq : (m == 2 ? p.xa_wo : p.peer_wq));
    const size_t off = m == 0 ? WS_WOUT_T : (m == 1 ? WS_WQ_T : (m == 2 ? WS_WO_T : WS_PWQ_T));
    transpose_tile(W, 1024, (bf16_t*)(p.ws + off), t >> 4, t & 15, smem);
}

constexpr int WQ_WORD0 = 4096;
DEV int wq_next(unsigned* cnt, int nper, int xcc, unsigned char* lds) {
    volatile unsigned* slot = (volatile unsigned*)(lds + LDS_BYTES - 16);
    __syncthreads();
    if (threadIdx.x == 0) {
        int res = -1;
        int off = (int)slot[1];
        while (off < 8) {
            const int q = (xcc + off) & 7;
            const unsigned idx = atomicAdd(&cnt[q * 64], 1u);
            if (idx < (unsigned)nper) { res = q * nper + (int)idx; break; }
            ++off;
        }
        slot[0] = (unsigned)res;
        slot[1] = (unsigned)off;
    }
    __syncthreads();
    return (int)slot[0];
}
DEV void wq_begin(unsigned char* lds) {
    __syncthreads();
    if (threadIdx.x == 0) ((volatile unsigned*)(lds + LDS_BYTES - 16))[1] = 0u;
}

constexpr int NSTAGES = 12;
template <int ST>
DEV void run_stage(const P& p, unsigned char* lds, int xcc) {
    float* smem = (float*)lds;
    const int nb = gridDim.x, bid = blockIdx.x;
    int tidl = threadIdx.x;
    asm volatile("" : "+v"(tidl));
    const int wave = tidl >> 6;
    unsigned* wqc = (unsigned*)(p.ws + WS_BAR) + WQ_WORD0;
    if (ST == 0) {
        for (int it = bid; it < PREP_END; it += nb) prep_item(p, it, smem);
    } else if (ST == 1) {
        for (int it = bid; it < 1536 + 384 + 128; it += nb) {
            if (it < 1536) gemm_item<0>(p, it & 7, it >> 3, lds);
            else if (it < 1920) { const int i2 = it - 1536, q = i2 & 7, j = i2 >> 3; gemm_mfma_tile<0>(p, q * 16 + (j & 15), 24 + (j >> 4), lds); }
            else gemm_item<1>(p, (it - 1920) & 7, (it - 1920) >> 3, lds);
        }
    } else if (ST == 2) {
        if (PROBE_REP == 21) for (int it = bid; it < 256; it += nb) compress_item2(p, it, lds);
        if (PROBE_REP == 22) for (int it = bid; it < 1024; it += nb) hgrn_prep_item(p, it, smem);
        for (int it = bid; it < 256 + 1024; it += nb) {
            if (it < 256) compress_item2(p, it, lds);
            else hgrn_prep_item2(p, it - 256, lds);
        }
    } else if (ST == 3) {
        if (PROBE_REP == 31) { for (int it = bid; it < 32; it += nb) hgrn_chain_item(p, it, lds); }
        if (PROBE_REP == 32) {
            volatile unsigned* qs2 = (volatile unsigned*)(lds + LDS_BYTES - 16);
            for (;;) {
                __syncthreads();
                if (threadIdx.x == 0) *qs2 = atomicAdd(wqc + 64, 1u);
                __syncthreads();
                const int j = (int)*qs2;
                if (j >= 1024) break;
                nsa_item2(p, (j & 15) >> 1, j & 1, 63 - (j >> 4), lds, p.out != nullptr ? 4 : 0);
            }
        }
        volatile unsigned* qslot = (volatile unsigned*)(lds + LDS_BYTES - 16);
        for (;;) {
            __syncthreads();
            if (threadIdx.x == 0) *qslot = atomicAdd(wqc, 1u);
            __syncthreads();
            const int it = (int)*qslot;
            if (it >= 32 + 1024) break;
            if (it < 32) hgrn_chain_item2(p, it, lds);
            else { const int j = it - 32; nsa_item2(p, (j & 15) >> 1, j & 1, 63 - (j >> 4), lds); }
        }
        for (;;) {
            __syncthreads();
            if (threadIdx.x == 0) *qslot = atomicAdd(wqc + 128, 1u);
            __syncthreads();
            const int it = (int)*qslot;
            if (it >= 2048) break;
            if (it < 1024) late_transpose_item(p, it, smem);
            else {
                const int j = it - 1024, tb = j >> 9, r0 = (j & 511) * 32 + wave * 8;
                for (int r = 0; r < 8; ++r) {
                    if (tb == 0) peer_quant_row(p.peer_down, p.ws + WS_PD, (float*)(p.ws + WS_PSD), r0 + r, (int*)(p.ws + WS_PRS));
                    else peer_quant_row(p.peer_up, p.ws + WS_PU, (float*)(p.ws + WS_PSU), r0 + r);
                }
            }
        }
    } else if (ST == 4) {
        for (int it = bid; it < 512; it += nb) gemm_item<2>(p, it & 7, it >> 3, lds);
    } else if (ST == 5) {
        for (int it = bid; it < T_ / 4; it += nb) ln_item(p, it * 4 + wave, 0, tidl & 63);
    } else if (ST == 9) {
        for (int it = bid; it < T_ / 4; it += nb) ln_item(p, it * 4 + wave, 1, tidl & 63);
    } else if (ST == 6) {
        for (int it = bid; it < 512; it += nb) gemm_item<3>(p, it & 7, it >> 3, lds);
    } else if (ST == 7) {
        for (int it = bid; it < 1024; it += nb) xattn_item3(p, it, lds);
    } else if (ST == 8) {
        for (int it = bid; it < 512; it += nb) gemm_item<4>(p, it & 7, it >> 3, lds);
    } else if (ST == 10) {
        for (int it = bid; it < 512; it += nb) gemm_item<5>(p, it & 7, it >> 3, lds);
    } else if (ST == 11) {
        if (PROBE_REP == 11) for (int it = bid; it < T_ / 16; it += nb) peer_route_item(p, it, lds);
        for (int it = bid; it < T_ / 16; it += nb) peer_route_item(p, it, lds);
    } else if (ST == 12) {
        if (PROBE_REP == 12) { wq_begin(lds); for (int it; (it = wq_next(wqc + 4 * 512, 1024, xcc, lds)) >= 0;) peer_down_item(p, it >> 10, it & 1023, tidl & 63, wave); }
        wq_begin(lds);
        for (int it; (it = wq_next(wqc + 2 * 512, 512, xcc, lds)) >= 0;) peer_down_item(p, it >> 9, it & 511, tidl & 63, wave);
    } else if (ST == 13) {
        if (PROBE_REP == 13) for (int it = bid; it < T_ / 4; it += nb) peer_coef_item(p, it * 4 + wave, tidl & 63);
        for (int it = bid; it < T_ / 4; it += nb) peer_coef_item(p, it * 4 + wave, tidl & 63);
    } else if (ST == 14) {
        if (PROBE_REP == 14) { wq_begin(lds); for (int it; (it = wq_next(wqc + 5 * 512, 1024, xcc, lds)) >= 0;) peer_up_item(p, it >> 10, it & 1023, tidl & 63, wave, p.out == nullptr); }
        wq_begin(lds);
        for (int it; (it = wq_next(wqc + 3 * 512, 512, xcc, lds)) >= 0;) peer_up_item(p, it >> 9, it & 511, tidl & 63, wave);
    } else if (ST == 15) {
        for (int it = bid; it < T_ / 4; it += nb) ln3_item(p, it * 4 + wave, tidl & 63);
    }
}

template <int ST>
__global__ void __launch_bounds__(256, 2) stage_kernel(P p) {
    __shared__ __attribute__((aligned(16))) unsigned char lds[LDS_BYTES + 16];
    run_stage<ST>(p, lds, (int)xb_xcc_id() & 7);
}

__global__ void __launch_bounds__(256, 2) mega_kernel(P p) {
    __shared__ __attribute__((aligned(16))) unsigned char lds[LDS_BYTES + 16];
    if (threadIdx.x == 0) *(uint4*)(lds + LDS_BYTES) = make_uint4(0u, 0u, 0u, 0u);
    __syncthreads();
    const XcdBarrier xb = xcd_barrier_post((unsigned*)(p.ws + WS_BAR), (volatile LAS unsigned*)(lds + LDS_BYTES));
    const int xcc = (int)xb.x & 7;
    run_stage<0>(p, lds, xcc); xcd_barrier(xb);
    if (PROBE_REP == 0) { run_stage<0>(p, lds, xcc); xcd_barrier(xb); }
    run_stage<1>(p, lds, xcc); xcd_barrier(xb);
    if (PROBE_REP == 1) { run_stage<1>(p, lds, xcc); xcd_barrier(xb); }
    run_stage<2>(p, lds, xcc); xcd_barrier(xb);
    if (PROBE_REP == 2) { run_stage<2>(p, lds, xcc); xcd_barrier(xb); }
    if (PROBE_REP == 35) { if (blockIdx.x < 32) hgrn_chain_item2(p, blockIdx.x, lds); xcd_barrier(xb); }
    run_stage<3>(p, lds, xcc); xcd_barrier(xb);
    run_stage<4>(p, lds, xcc); xcd_barrier(xb);
    if (PROBE_REP == 4) { run_stage<4>(p, lds, xcc); xcd_barrier(xb); }
    if (PROBE_REP == 50) { xcd_barrier(xb); xcd_barrier(xb); xcd_barrier(xb); xcd_barrier(xb); xcd_barrier(xb); xcd_barrier(xb); xcd_barrier(xb); xcd_barrier(xb); }
    run_stage<5>(p, lds, xcc); xcd_barrier(xb);
    run_stage<6>(p, lds, xcc); xcd_barrier(xb);
    if (PROBE_REP == 6) { run_stage<6>(p, lds, xcc); xcd_barrier(xb); }
    run_stage<7>(p, lds, xcc); xcd_barrier(xb);
    if (PROBE_REP == 7) { run_stage<7>(p, lds, xcc); xcd_barrier(xb); }
    run_stage<8>(p, lds, xcc); xcd_barrier(xb);
    run_stage<9>(p, lds, xcc); xcd_barrier(xb);
    run_stage<10>(p, lds, xcc); xcd_barrier(xb);
    if (PROBE_REP == 10) { run_stage<10>(p, lds, xcc); xcd_barrier(xb); }
    run_stage<11>(p, lds, xcc); xcd_barrier(xb);
    run_stage<12>(p, lds, xcc); xcd_barrier(xb);
    run_stage<13>(p, lds, xcc); xcd_barrier(xb);
    run_stage<14>(p, lds, xcc); xcd_barrier(xb);
    run_stage<15>(p, lds, xcc);
}

extern "C" void kernel_launch(void* const* d_in, const int* in_sizes, int n_in, void* d_out, int out_size, void* d_ws, size_t ws_size,
                              hipStream_t stream) {
    if (n_in != 18 || ws_size < WS_END) {
        fprintf(stderr, "kernel_launch: unexpected inputs (n_in %d, ws %zu, need %zu)\n", n_in, ws_size, (size_t)WS_END);
        return;
    }
    P p{};
    p.x = (const float*)d_in[0]; p.mem = (const float*)d_in[1]; p.w_in = (const float*)d_in[2]; p.cmp_pos = (const float*)d_in[3];
    p.cmp_w1 = (const float*)d_in[4]; p.cmp_w2 = (const float*)d_in[5]; p.lb_logits = (const float*)d_in[6];
    p.hg_norm_w = (const float*)d_in[7]; p.w_out = (const float*)d_in[8]; p.xa_wq = (const float*)d_in[9];
    p.xa_wkv = (const float*)d_in[10]; p.xa_wo = (const float*)d_in[11]; p.peer_wq = (const float*)d_in[12];
    p.peer_keys = (const float*)d_in[13]; p.peer_down = (const float*)d_in[14]; p.peer_up = (const float*)d_in[15];
    p.ln_g = (const float*)d_in[16]; p.ln_b = (const float*)d_in[17];
    p.out = (float*)d_out; p.ws = (unsigned char*)d_ws;
#if ONE_LAUNCH
    static int grid_blocks = 0;
    if (!grid_blocks) {
        int dev = 0, cus = 0, per_cu = 0;
        hipGetDevice(&dev);
        hipDeviceGetAttribute(&cus, hipDeviceAttributeMultiprocessorCount, dev);
        hipOccupancyMaxActiveBlocksPerMultiprocessor(&per_cu, mega_kernel, 256, 0);
        if (per_cu > 2) per_cu = 2;
        if (per_cu < 1) per_cu = 1;
        grid_blocks = cus * per_cu;
    }
    (void)hipMemsetAsync((unsigned char*)d_ws + WS_BAR, 0, 65536, stream);
    void* args[] = {&p};
    hipError_t e = hipLaunchCooperativeKernel((void*)mega_kernel, dim3(grid_blocks), dim3(256), args, 0, stream);
    if (e != hipSuccess) fprintf(stderr, "cooperative launch failed: %s (grid %d)\n", hipGetErrorString(e), grid_blocks);
#else
    const int G = 2048;
    stage_kernel<0><<<G, 256, 0, stream>>>(p);
    stage_kernel<1><<<G, 256, 0, stream>>>(p);
    stage_kernel<2><<<G, 256, 0, stream>>>(p);
    stage_kernel<3><<<G, 256, 0, stream>>>(p);
    stage_kernel<4><<<G, 256, 0, stream>>>(p);
    stage_kernel<5><<<G, 256, 0, stream>>>(p);
    stage_kernel<6><<<G, 256, 0, stream>>>(p);
    stage_kernel<7><<<G, 256, 0, stream>>>(p);
    stage_kernel<8><<<G, 256, 0, stream>>>(p);
    stage_kernel<9><<<G, 256, 0, stream>>>(p);
    stage_kernel<10><<<G, 256, 0, stream>>>(p);
    stage_kernel<11><<<G, 256, 0, stream>>>(p);
#endif
}
```

```cpp
#include <hip/hip_runtime.h>
#include <hip/hip_cooperative_groups.h>
#include <cstdio>
#include <cstdint>
namespace cg = cooperative_groups;

#ifndef PROBE_REP
#define PROBE_REP -1
#endif
#ifndef ONE_LAUNCH
#define ONE_LAUNCH 1
#endif

typedef unsigned short bf16_t;
#define DEV __device__ __forceinline__

constexpr int D_ = 1024, B_ = 8, S_ = 2048, T_ = B_ * S_, ML_ = 256, INC = 3352;
constexpr int NCMP = 127;
constexpr int LDS_BYTES = 67584;
constexpr float ALPHA = 1.189207115002721f;
constexpr float LN_EPS = 1e-5f;
constexpr int C_QA = 0, C_KC = 512, C_VC = 640, C_KS = 768, C_VS = 896, C_KW = 1024, C_VW = 1152, C_GATE = 1280,
              C_HQ = 1304, C_HF = 1816, C_HI = 2328, C_HG = 2840;
constexpr size_t WS_HB = 0;
constexpr size_t SZ_HB = (size_t)T_ * INC * 2;
constexpr size_t WS_OM = WS_HB + SZ_HB;
constexpr size_t WS_KVM = WS_OM + (size_t)T_ * 1024 * 2;
constexpr size_t WS_KC = WS_KVM + (size_t)2048 * 2048 * 2;
constexpr size_t WS_XB = WS_KC + (1u << 20);
constexpr size_t WS_WIN_T = WS_XB + (size_t)T_ * 1024 * 2;
constexpr size_t WS_WOUT_T = WS_WIN_T + (size_t)3456 * 1024 * 2;
constexpr size_t WS_WQ_T = WS_WOUT_T + (size_t)1024 * 1024 * 2;
constexpr size_t WS_WKV_T = WS_WQ_T + (size_t)1024 * 1024 * 2;
constexpr size_t WS_WO_T = WS_WKV_T + (size_t)2048 * 1024 * 2;
constexpr size_t WS_PWQ_T = WS_WO_T + (size_t)1024 * 1024 * 2;
constexpr size_t WS_MEMB = WS_PWQ_T + (size_t)1024 * 1024 * 2;
constexpr size_t WS_PKEY = WS_MEMB + (size_t)2048 * 1024 * 2;
constexpr size_t WS_VT = WS_PKEY + (size_t)16 * 128 * 64 * 2;
constexpr size_t WS_KCB = WS_VT + (size_t)2 * B_ * 2 * 64 * 2048 * 2;
constexpr size_t WS_VCT = WS_KCB + (size_t)B_ * 2 * 128 * 64 * 2;
constexpr size_t WS_W1T = WS_VCT + (size_t)B_ * 2 * 128 * 64 * 2;
constexpr size_t WS_W2T = WS_W1T + (size_t)2 * 128 * 2048 * 2;
constexpr size_t WS_CB = WS_W2T + (size_t)2 * 64 * 128 * 2;
constexpr size_t WS_VMT = WS_CB + 1024;
constexpr size_t WS_BAR = WS_VMT + (size_t)B_ * 4 * 256 * 256 * 2;
constexpr size_t WS_PD = WS_BAR + 65536;
constexpr size_t WS_PU = WS_PD + (size_t)16384 * 1024;
constexpr size_t WS_PSD = WS_PU + (size_t)16384 * 1024;
constexpr size_t WS_PSU = WS_PSD + 65536;
constexpr size_t WS_PRS = WS_PSU + 65536;
constexpr size_t WS_END = WS_PRS + 65536;
static_assert(WS_END <= (size_t)268435456, "workspace budget");
constexpr size_t WS_EB = WS_KC;
constexpr size_t HS_QT = 0;
constexpr size_t HS_KT = (size_t)B_ * 4 * 2048 * 128 * 2;
constexpr size_t HS_KHT = 2 * HS_KT;
constexpr size_t HS_VIT = 3 * HS_KT;
constexpr size_t HS_DS = HS_KT;
constexpr size_t HS_OI = 3 * HS_KT;
constexpr size_t WS_QX = 0;
constexpr size_t WS_OX = (size_t)T_ * 1024 * 2;
constexpr size_t WS_QP = 0;
constexpr size_t WS_YB = 0;
constexpr size_t WS_EIDP = (size_t)T_ * 1024 * 2;
constexpr size_t WS_GATEP = WS_EIDP + (size_t)T_ * 128 * 2;
constexpr size_t WS_COEFP = WS_GATEP + (size_t)T_ * 128 * 4;
constexpr size_t WS_XQ = WS_COEFP + (size_t)T_ * 128 * 4;
constexpr size_t WS_SXF = WS_XQ + (size_t)T_ * 1024;
constexpr size_t WS_SXI = WS_SXF + (size_t)T_ * 4;
constexpr size_t WS_ASUM = WS_SXI + (size_t)T_ * 4;
constexpr size_t WS_DP = WS_ASUM + (size_t)T_ * 4;
static_assert(WS_DP + (size_t)8 * T_ * 128 * 4 <= WS_KVM, "PEER intermediates must fit in the dead h/OM region");

struct P {
    const float *x, *mem, *w_in, *cmp_pos, *cmp_w1, *cmp_w2, *lb_logits, *hg_norm_w, *w_out, *xa_wq, *xa_wkv, *xa_wo,
        *peer_wq, *peer_keys, *peer_down, *peer_up, *ln_g, *ln_b;
    float* out;
    unsigned char* ws;
};

DEV unsigned short f2bf(float f) {
    unsigned u = __float_as_uint(f);
    u += 0x7fffu + ((u >> 16) & 1u);
    return (unsigned short)(u >> 16);
}
DEV float bf2f(unsigned short h) { return __uint_as_float(((unsigned)h) << 16); }
DEV float bflo(unsigned u) { return __uint_as_float(u << 16); }
DEV float bfhi(unsigned u) { return __uint_as_float(u & 0xffff0000u); }
typedef __bf16 bf16x2_t __attribute__((ext_vector_type(2)));
typedef float f32x2_t __attribute__((ext_vector_type(2)));
DEV unsigned pk_bf16(float a, float b) {
    f32x2_t v = {a, b};
    bf16x2_t r = __builtin_convertvector(v, bf16x2_t);
    return __builtin_bit_cast(unsigned, r);
}
DEV float wsum(float v) {
#pragma unroll
    for (int o = 32; o > 0; o >>= 1) v += __shfl_xor(v, o);
    return v;
}
DEV float wmax(float v) {
#pragma unroll
    for (int o = 32; o > 0; o >>= 1) v = fmaxf(v, __shfl_xor(v, o));
    return v;
}
DEV float sigmoidf_(float x) { return 1.f / (1.f + expf(-x)); }
DEV float fsigmoid(float x) { return __fdividef(1.f, 1.f + __expf(-x)); }

template <int MODE>
DEV void gemm_tile(const P& p, int tile, float* smem) {
    constexpr bool ABF = (MODE == 2 || MODE == 4);
    constexpr int K = 1024;
    constexpr int N = MODE == 0 ? INC : (MODE == 1 ? 2048 : 1024);
    constexpr int NTN = (N + 63) / 64;
    const int tm = tile / NTN, tn = tile % NTN;
    const float* Af = nullptr;
    const bf16_t* Ab = nullptr;
    const float* Bm = nullptr;
    if (MODE == 0) { Af = p.x; Bm = p.w_in; }
    if (MODE == 1) { Af = p.mem; Bm = p.xa_wkv; }
    if (MODE == 2) { Ab = (const bf16_t*)(p.ws + WS_OM); Bm = p.w_out; }
    if (MODE == 3) { Af = p.out; Bm = p.xa_wq; }
    if (MODE == 4) { Ab = (const bf16_t*)(p.ws + WS_OX); Bm = p.xa_wo; }
    if (MODE == 5) { Af = p.out; Bm = p.peer_wq; }
    float(*sA)[68] = (float(*)[68])smem;
    float(*sB)[68] = (float(*)[68])(smem + 16 * 68);
    const int tid = threadIdx.x, tx = tid & 15, ty = tid >> 4;
    const int ar = tid >> 2, ak = (tid & 3) * 4;
    const int bk = tid >> 4, bn = (tid & 15) * 4;
    float acc[4][4];
#pragma unroll
    for (int i = 0; i < 4; ++i)
#pragma unroll
        for (int j = 0; j < 4; ++j) acc[i][j] = 0.f;
    const int gn = tn * 64 + bn;
    for (int k0 = 0; k0 < K; k0 += 16) {
        float4 av;
        if (ABF) {
            uint2 u = *(const uint2*)(Ab + (size_t)(tm * 64 + ar) * K + k0 + ak);
            av.x = bflo(u.x); av.y = bfhi(u.x); av.z = bflo(u.y); av.w = bfhi(u.y);
        } else {
            av = *(const float4*)(Af + (size_t)(tm * 64 + ar) * K + k0 + ak);
        }
        float4 bv = make_float4(0.f, 0.f, 0.f, 0.f);
        if (gn < N) bv = *(const float4*)(Bm + (size_t)(k0 + bk) * N + gn);
        sA[ak + 0][ar] = av.x; sA[ak + 1][ar] = av.y; sA[ak + 2][ar] = av.z; sA[ak + 3][ar] = av.w;
        *(float4*)&sB[bk][bn] = bv;
        __syncthreads();
#pragma unroll
        for (int kk = 0; kk < 16; ++kk) {
            float4 a = *(const float4*)&sA[kk][ty * 4];
            float4 b = *(const float4*)&sB[kk][tx * 4];
            float aa[4] = {a.x, a.y, a.z, a.w}, bb[4] = {b.x, b.y, b.z, b.w};
#pragma unroll
            for (int i = 0; i < 4; ++i)
#pragma unroll
                for (int j = 0; j < 4; ++j) acc[i][j] += aa[i] * bb[j];
        }
        __syncthreads();
    }
    const int col = tn * 64 + tx * 4;
#pragma unroll
    for (int i = 0; i < 4; ++i) {
        const size_t row = (size_t)tm * 64 + ty * 4 + i;
        if (MODE == 0 || MODE == 1 || MODE == 3) {
            bf16_t* O = (bf16_t*)(p.ws + (MODE == 0 ? WS_HB : (MODE == 1 ? WS_KVM : WS_QX)));
            if (col < N) {
                uint2 u;
                u.x = (unsigned)f2bf(acc[i][0]) | ((unsigned)f2bf(acc[i][1]) << 16);
                u.y = (unsigned)f2bf(acc[i][2]) | ((unsigned)f2bf(acc[i][3]) << 16);
                *(uint2*)(O + row * N + col) = u;
            }
        } else if (MODE == 2) {
            float4 xv = *(const float4*)(p.x + row * 1024 + col);
            float4 o = make_float4(ALPHA * xv.x + acc[i][0], ALPHA * xv.y + acc[i][1], ALPHA * xv.z + acc[i][2], ALPHA * xv.w + acc[i][3]);
            *(float4*)(p.out + row * 1024 + col) = o;
        } else if (MODE == 4) {
            float4 xv = *(const float4*)(p.out + row * 1024 + col);
            float4 o = make_float4(ALPHA * xv.x + acc[i][0], ALPHA * xv.y + acc[i][1], ALPHA * xv.z + acc[i][2], ALPHA * xv.w + acc[i][3]);
            *(float4*)(p.out + row * 1024 + col) = o;
        } else {
            float* O = (float*)(p.ws + WS_QP);
            *(float4*)(O + row * 1024 + col) = make_float4(acc[i][0], acc[i][1], acc[i][2], acc[i][3]);
        }
    }
}


using bf16x8 = __attribute__((ext_vector_type(8))) short;
using f32x4 = __attribute__((ext_vector_type(4))) float;
using u32x4 = __attribute__((ext_vector_type(4))) unsigned;

template <int MODE>
DEV void gemm_mfma_tile(const P& p, int tm, int tn, unsigned char* lds) {
    const bf16_t* A;
    const bf16_t* W;
    if (MODE == 0) { A = (const bf16_t*)(p.ws + WS_XB); W = (const bf16_t*)(p.ws + WS_WIN_T); }
    if (MODE == 1) { A = (const bf16_t*)(p.ws + WS_MEMB); W = (const bf16_t*)(p.ws + WS_WKV_T); }
    if (MODE == 2) { A = (const bf16_t*)(p.ws + WS_OM); W = (const bf16_t*)(p.ws + WS_WOUT_T); }
    if (MODE == 3) { A = (const bf16_t*)(p.ws + WS_XB); W = (const bf16_t*)(p.ws + WS_WQ_T); }
    if (MODE == 4) { A = (const bf16_t*)(p.ws + WS_OX); W = (const bf16_t*)(p.ws + WS_WO_T); }
    if (MODE == 5) { A = (const bf16_t*)(p.ws + WS_XB); W = (const bf16_t*)(p.ws + WS_PWQ_T); }
    const int tid = threadIdx.x, lane = tid & 63, wid = tid >> 6, wm = wid >> 1, wn = wid & 1;
    const int m0 = tm * 128, n0 = tn * 128;
    const bf16_t* ga[2];
    const bf16_t* gw[2];
#pragma unroll
    for (int i = 0; i < 2; ++i) {
        const int r = (wid * 2 + i) * 16 + (lane >> 2);
        const int gsw = (0x1320 >> (((r >> 2) & 3) * 4)) & 3;
        const int c = (lane & 3) ^ gsw;
        ga[i] = A + (size_t)(m0 + r) * 1024 + c * 8;
        gw[i] = W + (size_t)(n0 + r) * 1024 + c * 8;
    }
    unsigned char* lbase = lds + wid * 2048;
#define GEMM_STAGE(slot, kt)                                                                                                   \
    do {                                                                                                                       \
        _Pragma("unroll") for (int i = 0; i < 2; ++i) {                                                                        \
            __builtin_amdgcn_global_load_lds((const unsigned*)(ga[i] + (kt) * 32), (unsigned*)(lbase + (slot) * 16384 + i * 1024), 16, 0, 0);         \
            __builtin_amdgcn_global_load_lds((const unsigned*)(gw[i] + (kt) * 32), (unsigned*)(lbase + (slot) * 16384 + 8192 + i * 1024), 16, 0, 0);  \
        }                                                                                                                      \
    } while (0)
    asm volatile("s_waitcnt vmcnt(0)" ::: "memory");
    GEMM_STAGE(0, 0);
    GEMM_STAGE(1, 1);
    GEMM_STAGE(2, 2);
    f32x4 acc[4][4];
#pragma unroll
    for (int i = 0; i < 4; ++i)
#pragma unroll
        for (int j = 0; j < 4; ++j) acc[i][j] = (f32x4){0.f, 0.f, 0.f, 0.f};
    const int fr = lane & 15, fq = lane >> 4;
    const int fsw = (0x1320 >> (((fr >> 2) & 3) * 4)) & 3;
    const int aoff = (wm * 64 + fr) * 64 + ((fq ^ fsw) << 4);
    const int boff = 8192 + (wn * 64 + fr) * 64 + ((fq ^ fsw) << 4);
#define GEMM_COMPUTE(slot)                                                                                                     \
    do {                                                                                                                       \
        const unsigned char* sb = lds + (slot) * 16384;                                                                        \
        bf16x8 af[4], wf[4];                                                                                                   \
        _Pragma("unroll") for (int t = 0; t < 4; ++t) {                                                                        \
            af[t] = *(const bf16x8*)(sb + aoff + t * 1024);                                                                    \
            wf[t] = *(const bf16x8*)(sb + boff + t * 1024);                                                                    \
        }                                                                                                                      \
        _Pragma("unroll") for (int nt = 0; nt < 4; ++nt)                                                                       \
            _Pragma("unroll") for (int mt = 0; mt < 4; ++mt)                                                                   \
                acc[nt][mt] = __builtin_amdgcn_mfma_f32_16x16x32_bf16(wf[nt], af[mt], acc[nt][mt], 0, 0, 0);                   \
    } while (0)
#pragma unroll 1
    for (int kt = 0; kt < 29; ++kt) {
        asm volatile("s_waitcnt vmcnt(8)\n\ts_waitcnt lgkmcnt(0)" ::: "memory");
        __builtin_amdgcn_s_barrier(); asm volatile("" ::: "memory");
        GEMM_STAGE((kt + 3) & 3, kt + 3);
        GEMM_COMPUTE(kt & 3);
    }
    asm volatile("s_waitcnt vmcnt(8)\n\ts_waitcnt lgkmcnt(0)" ::: "memory");
    __builtin_amdgcn_s_barrier(); asm volatile("" ::: "memory");
    GEMM_COMPUTE(29 & 3);
    asm volatile("s_waitcnt vmcnt(4)\n\ts_waitcnt lgkmcnt(0)" ::: "memory");
    __builtin_amdgcn_s_barrier(); asm volatile("" ::: "memory");
    GEMM_COMPUTE(30 & 3);
    asm volatile("s_waitcnt vmcnt(0)\n\ts_waitcnt lgkmcnt(0)" ::: "memory");
    __builtin_amdgcn_s_barrier(); asm volatile("" ::: "memory");
    GEMM_COMPUTE(31 & 3);
    asm volatile("s_waitcnt lgkmcnt(0)" ::: "memory");
    __builtin_amdgcn_s_barrier(); asm volatile("" ::: "memory");
#undef GEMM_STAGE
#undef GEMM_COMPUTE
#pragma unroll
    for (int mt = 0; mt < 4; ++mt) {
        const size_t m = (size_t)m0 + wm * 64 + mt * 16 + fr;
#pragma unroll
        for (int nt = 0; nt < 4; ++nt) {
            const int n = n0 + wn * 64 + nt * 16 + fq * 4;
            const f32x4 c = acc[nt][mt];
            if (MODE == 0 || MODE == 1 || MODE == 3 || MODE == 5) {
                constexpr int NS = MODE == 0 ? INC : (MODE == 1 ? 2048 : 1024);
                bf16_t* O = (bf16_t*)(p.ws + (MODE == 0 ? WS_HB : (MODE == 1 ? WS_KVM : (MODE == 3 ? WS_QX : WS_QP))));
                if (MODE == 1 && tn >= 8) {
                    bf16_t* VMT = (bf16_t*)(p.ws + WS_VMT);
                    const int nn = n - 1024;
                    const size_t base = (((size_t)(m >> 8) * 4 + (nn >> 8)) * 256 + (nn & 255)) * 256 + (m & 255);
#pragma unroll
                    for (int i = 0; i < 4; ++i) VMT[base + (size_t)i * 256] = f2bf(c[i]);
                } else if (MODE == 0 && (tn == 7 || tn == 9)) {
                    bf16_t* VT = (bf16_t*)(p.ws + WS_VT);
                    const int which = tn == 9 ? 1 : 0;
                    const size_t base = ((((size_t)which * B_ + (m >> 11)) * 2 + wn) * 64 + nt * 16 + fq * 4) * 2048 + (m & 2047);
#pragma unroll
                    for (int i = 0; i < 4; ++i) VT[base + (size_t)i * 2048] = f2bf(c[i]);
                } else if (MODE != 0 || n < INC) {
                    uint2 u;
                    u.x = pk_bf16(c[0], c[1]);
                    u.y = pk_bf16(c[2], c[3]);
                    *(uint2*)(O + m * NS + n) = u;
                }
            } else if (MODE == 2) {
                const float4 xv = *(const float4*)(p.x + m * 1024 + n);
                *(uint2*)((bf16_t*)(p.ws + WS_YB) + m * 1024 + n) = make_uint2(pk_bf16(ALPHA * xv.x + c[0], ALPHA * xv.y + c[1]), pk_bf16(ALPHA * xv.z + c[2], ALPHA * xv.w + c[3]));
            } else if (MODE == 4) {
                const uint2 xb = *(const uint2*)((const bf16_t*)(p.ws + WS_XB) + m * 1024 + n);
                *(uint2*)((bf16_t*)(p.ws + WS_YB) + m * 1024 + n) = make_uint2(pk_bf16(ALPHA * bflo(xb.x) + c[0], ALPHA * bfhi(xb.x) + c[1]), pk_bf16(ALPHA * bflo(xb.y) + c[2], ALPHA * bfhi(xb.y) + c[3]));
            }
        }
    }
}


template <int MODE>
DEV void gemm_mfma_tile256(const P& p, int tm, int tn, unsigned char* lds) {
    const bf16_t* A;
    const bf16_t* W;
    if (MODE == 0) { A = (const bf16_t*)(p.ws + WS_XB); W = (const bf16_t*)(p.ws + WS_WIN_T); }
    if (MODE == 1) { A = (const bf16_t*)(p.ws + WS_MEMB); W = (const bf16_t*)(p.ws + WS_WKV_T); }
    if (MODE == 2) { A = (const bf16_t*)(p.ws + WS_OM); W = (const bf16_t*)(p.ws + WS_WOUT_T); }
    if (MODE == 3) { A = (const bf16_t*)(p.ws + WS_XB); W = (const bf16_t*)(p.ws + WS_WQ_T); }
    if (MODE == 4) { A = (const bf16_t*)(p.ws + WS_OX); W = (const bf16_t*)(p.ws + WS_WO_T); }
    if (MODE == 5) { A = (const bf16_t*)(p.ws + WS_XB); W = (const bf16_t*)(p.ws + WS_PWQ_T); }
    const int tid = threadIdx.x, lane = tid & 63, wid = tid >> 6, wm = wid >> 1, wn = wid & 1;
    const int m0 = tm * 256, n0 = tn * 128;
    const bf16_t* ga[4];
    const bf16_t* gw[2];
#pragma unroll
    for (int i = 0; i < 4; ++i) {
        const int r = (wid * 4 + i) * 16 + (lane >> 2);
        const int gsw = (0x1320 >> (((r >> 2) & 3) * 4)) & 3;
        ga[i] = A + (size_t)(m0 + r) * 1024 + ((lane & 3) ^ gsw) * 8;
    }
#pragma unroll
    for (int i = 0; i < 2; ++i) {
        const int r = (wid * 2 + i) * 16 + (lane >> 2);
        const int gsw = (0x1320 >> (((r >> 2) & 3) * 4)) & 3;
        gw[i] = W + (size_t)(n0 + r) * 1024 + ((lane & 3) ^ gsw) * 8;
    }
    unsigned char* lbA = lds + wid * 4096;
    unsigned char* lbW = lds + 16384 + wid * 2048;
#define GEMM_STAGE(slot, kt)                                                                                                   \
    do {                                                                                                                       \
        _Pragma("unroll") for (int i = 0; i < 4; ++i)                                                                          \
            __builtin_amdgcn_global_load_lds((const unsigned*)(ga[i] + (kt) * 32), (unsigned*)(lbA + (slot) * 24576 + i * 1024), 16, 0, 0);  \
        _Pragma("unroll") for (int i = 0; i < 2; ++i)                                                                          \
            __builtin_amdgcn_global_load_lds((const unsigned*)(gw[i] + (kt) * 32), (unsigned*)(lbW + (slot) * 24576 + i * 1024), 16, 0, 0);  \
    } while (0)
    GEMM_STAGE(0, 0);
    f32x4 acc[4][8];
#pragma unroll
    for (int i = 0; i < 4; ++i)
#pragma unroll
        for (int j = 0; j < 8; ++j) acc[i][j] = (f32x4){0.f, 0.f, 0.f, 0.f};
    const int fr = lane & 15, fq = lane >> 4;
    const int fsw = (0x1320 >> (((fr >> 2) & 3) * 4)) & 3;
    const int aoff = (wm * 128 + fr) * 64 + ((fq ^ fsw) << 4);
    const int boff = 16384 + (wn * 64 + fr) * 64 + ((fq ^ fsw) << 4);
#pragma unroll 1
    for (int kt = 0; kt < 32; ++kt) {
        asm volatile("s_waitcnt vmcnt(0)\n\ts_waitcnt lgkmcnt(0)" ::: "memory");
        __builtin_amdgcn_s_barrier(); asm volatile("" ::: "memory");
        if (kt + 1 < 32) { if (kt & 1) GEMM_STAGE(0, kt + 1); else GEMM_STAGE(1, kt + 1); }
        const unsigned char* sb = lds + (kt & 1) * 24576;
        bf16x8 af[8], wf[4];
#pragma unroll
        for (int t = 0; t < 8; ++t) af[t] = *(const bf16x8*)(sb + aoff + t * 1024);
#pragma unroll
        for (int t = 0; t < 4; ++t) wf[t] = *(const bf16x8*)(sb + boff + t * 1024);
#pragma unroll
        for (int nt = 0; nt < 4; ++nt)
#pragma unroll
            for (int mt = 0; mt < 8; ++mt) acc[nt][mt] = __builtin_amdgcn_mfma_f32_16x16x32_bf16(wf[nt], af[mt], acc[nt][mt], 0, 0, 0);
    }
    asm volatile("s_waitcnt lgkmcnt(0)" ::: "memory");
    __builtin_amdgcn_s_barrier(); asm volatile("" ::: "memory");
#undef GEMM_STAGE
#pragma unroll
    for (int mt = 0; mt < 8; ++mt) {
        const size_t m = (size_t)m0 + wm * 128 + mt * 16 + fr;
#pragma unroll
        for (int nt = 0; nt < 4; ++nt) {
            const int n = n0 + wn * 64 + nt * 16 + fq * 4;
            const f32x4 c = acc[nt][mt];
            if (MODE == 0 || MODE == 1 || MODE == 3 || MODE == 5) {
                constexpr int NS = MODE == 0 ? INC : (MODE == 1 ? 2048 : 1024);
                bf16_t* O = (bf16_t*)(p.ws + (MODE == 0 ? WS_HB : (MODE == 1 ? WS_KVM : (MODE == 3 ? WS_QX : WS_QP))));
                if (MODE == 1 && tn >= 8) {
                    bf16_t* VMT = (bf16_t*)(p.ws + WS_VMT);
                    const int nn = n - 1024;
                    const size_t base = (((size_t)(m >> 8) * 4 + (nn >> 8)) * 256 + (nn & 255)) * 256 + (m & 255);
#pragma unroll
                    for (int i = 0; i < 4; ++i) VMT[base + (size_t)i * 256] = f2bf(c[i]);
                } else if (MODE == 0 && (tn == 7 || tn == 9)) {
                    bf16_t* VT = (bf16_t*)(p.ws + WS_VT);
                    const int which = tn == 9 ? 1 : 0;
                    const size_t base = ((((size_t)which * B_ + (m >> 11)) * 2 + wn) * 64 + nt * 16 + fq * 4) * 2048 + (m & 2047);
#pragma unroll
                    for (int i = 0; i < 4; ++i) VT[base + (size_t)i * 2048] = f2bf(c[i]);
                } else if (MODE != 0 || n < INC) {
                    uint2 u;
                    u.x = pk_bf16(c[0], c[1]);
                    u.y = pk_bf16(c[2], c[3]);
                    *(uint2*)(O + m * NS + n) = u;
                }
            } else if (MODE == 2) {
                const float4 xv = *(const float4*)(p.x + m * 1024 + n);
                *(uint2*)((bf16_t*)(p.ws + WS_YB) + m * 1024 + n) = make_uint2(pk_bf16(ALPHA * xv.x + c[0], ALPHA * xv.y + c[1]), pk_bf16(ALPHA * xv.z + c[2], ALPHA * xv.w + c[3]));
            } else if (MODE == 4) {
                const uint2 xb = *(const uint2*)((const bf16_t*)(p.ws + WS_XB) + m * 1024 + n);
                *(uint2*)((bf16_t*)(p.ws + WS_YB) + m * 1024 + n) = make_uint2(pk_bf16(ALPHA * bflo(xb.x) + c[0], ALPHA * bfhi(xb.x) + c[1]), pk_bf16(ALPHA * bflo(xb.y) + c[2], ALPHA * bfhi(xb.y) + c[3]));
            }
        }
    }
}


template <int MODE>
DEV void gemm_item(const P& p, int q, int j, unsigned char* lds) {
    int tm, tn;
    if (MODE == 0) {
        tm = q * 8 + (j & 7);
        tn = j >> 3;
    } else if (MODE == 1) {
        tm = q; tn = j;
    } else {
        tm = q * 8 + (j & 7);
        tn = j >> 3;
    }
    gemm_mfma_tile256<MODE>(p, tm, tn, lds);
}

DEV void transpose_tile(const float* W, int N, bf16_t* Wt, int tk, int tn, float* s, int ldk = 1024) {
    const int tid = threadIdx.x;
    const int k0 = tk * 64, n0 = tn * 64;
#pragma unroll
    for (int i = 0; i < 4; ++i) {
        const int k = (tid >> 4) + 16 * i, n = (tid & 15) * 4;
        float4 v = make_float4(0.f, 0.f, 0.f, 0.f);
        if (n0 + n < N) v = *(const float4*)(W + (size_t)(k0 + k) * N + n0 + n);
        s[k * 65 + n + 0] = v.x; s[k * 65 + n + 1] = v.y; s[k * 65 + n + 2] = v.z; s[k * 65 + n + 3] = v.w;
    }
    __syncthreads();
    {
        const int n = tid >> 2, kc = (tid & 3) * 16;
        unsigned u[8];
#pragma unroll
        for (int j = 0; j < 8; ++j)
            u[j] = (unsigned)f2bf(s[(kc + 2 * j) * 65 + n]) | ((unsigned)f2bf(s[(kc + 2 * j + 1) * 65 + n]) << 16);
        bf16_t* dst = Wt + (size_t)(n0 + n) * ldk + k0 + kc;
        *(uint4*)dst = make_uint4(u[0], u[1], u[2], u[3]);
        *(uint4*)(dst + 8) = make_uint4(u[4], u[5], u[6], u[7]);
    }
    __syncthreads();
}
DEV void convert_chunk(const float* src, bf16_t* dst, int item) {
    float4 a[4], b[4];
#pragma unroll
    for (int j = 0; j < 4; ++j) {
        const size_t e = (((size_t)item * 4 + j) * 256 + threadIdx.x) * 8;
        a[j] = *(const float4*)(src + e);
        b[j] = *(const float4*)(src + e + 4);
    }
#pragma unroll
    for (int j = 0; j < 4; ++j) {
        const size_t e = (((size_t)item * 4 + j) * 256 + threadIdx.x) * 8;
        uint4 u;
        u.x = pk_bf16(a[j].x, a[j].y);
        u.y = pk_bf16(a[j].z, a[j].w);
        u.z = pk_bf16(b[j].x, b[j].y);
        u.w = pk_bf16(b[j].z, b[j].w);
        *(uint4*)(dst + e) = u;
    }
}
constexpr int PREP_T0 = 16 * 54, PREP_T3 = PREP_T0 + 512, PREP_T5 = PREP_T3, PREP_X = PREP_T5 + T_ * 1024 / 8192, PREP_M = PREP_X + 2048 * 1024 / 8192, PREP_K = PREP_M + 16 * 128 * 64 / 8192, PREP_W1 = PREP_K + 128, PREP_W2 = PREP_W1 + 4,
              PREP_END = PREP_W2;
DEV void prep_item(const P& p, int it, float* smem) {
    if (it < PREP_T0) transpose_tile(p.w_in, INC, (bf16_t*)(p.ws + WS_WIN_T), it / 54, it % 54, smem);
    else if (it < PREP_T3) { it -= PREP_T0; transpose_tile(p.xa_wkv, 2048, (bf16_t*)(p.ws + WS_WKV_T), it >> 5, it & 31, smem); }
    else if (it < PREP_X) convert_chunk(p.x, (bf16_t*)(p.ws + WS_XB), it - PREP_T5);
    else if (it < PREP_M) convert_chunk(p.mem, (bf16_t*)(p.ws + WS_MEMB), it - PREP_X);
    else if (it < PREP_K) convert_chunk(p.peer_keys, (bf16_t*)(p.ws + WS_PKEY), it - PREP_M);
    else if (it < PREP_W1) {
        it -= PREP_K;
        const int kind = it >> 6, r = it & 63;
        transpose_tile(p.cmp_w1 + (size_t)kind * 2048 * 128, 128, (bf16_t*)(p.ws + WS_W1T) + (size_t)kind * 128 * 2048, r >> 1, r & 1, smem, 2048);
    } else if (it < PREP_W2) {
        it -= PREP_W1;
        const int kind = it >> 1;
        transpose_tile(p.cmp_w2 + (size_t)kind * 128 * 64, 64, (bf16_t*)(p.ws + WS_W2T) + (size_t)kind * 64 * 128, it & 1, 0, smem, 128);
    }
}

DEV void compress_item(const P& p, int item, float* smem) {
    const int tid = threadIdx.x;
    const int g = item & 1;
    int r = item >> 1;
    const int n = r % NCMP;
    r /= NCMP;
    const int b = r & 7, kind = r >> 3;
    const bf16_t* HB = (const bf16_t*)(p.ws + WS_HB);
    float* KC = (float*)(p.ws + WS_KC);
    float* su = smem;
    float* sp = smem + 2048;
    float* sh = smem + 2304;
    const int col = (kind ? C_VC : C_KC) + g * 64;
    for (int i = tid; i < 2048; i += 256) {
        const int l = i >> 6, d = i & 63;
        su[i] = bf2f(HB[(size_t)(b * S_ + 16 * n + l) * INC + col + d]) + p.cmp_pos[(kind * 32 + l) * 64 + d];
    }
    __syncthreads();
    {
        const int j = tid & 127, hf = tid >> 7;
        const float* w1 = p.cmp_w1 + (size_t)kind * 2048 * 128;
        float acc = 0.f;
        for (int i = hf * 1024; i < hf * 1024 + 1024; ++i) acc += su[i] * w1[(size_t)i * 128 + j];
        sp[hf * 128 + j] = acc;
    }
    __syncthreads();
    if (tid < 128) {
        const float v = sp[tid] + sp[128 + tid];
        const float u = 0.7978845608028654f * (v + 0.044715f * v * v * v);
        sh[tid] = 0.5f * v * (1.f + tanhf(u));
    }
    __syncthreads();
    if (tid < 64) {
        const float* w2 = p.cmp_w2 + (size_t)kind * 128 * 64;
        float acc = 0.f;
        for (int j = 0; j < 128; ++j) acc += sh[j] * w2[j * 64 + tid];
        KC[((((size_t)kind * B_ + b) * NCMP + n) * 2 + g) * 64 + tid] = acc;
    }
    __syncthreads();
}

DEV void load_q64_bf(float (&q)[64], const bf16_t* src) {
    const uint4* s4 = (const uint4*)src;
#pragma unroll
    for (int i = 0; i < 8; ++i) {
        const uint4 u = s4[i];
        q[i * 8 + 0] = bflo(u.x); q[i * 8 + 1] = bfhi(u.x); q[i * 8 + 2] = bflo(u.y); q[i * 8 + 3] = bfhi(u.y);
        q[i * 8 + 4] = bflo(u.z); q[i * 8 + 5] = bfhi(u.z); q[i * 8 + 6] = bflo(u.w); q[i * 8 + 7] = bfhi(u.w);
    }
}
DEV float dot64_bf(const float (&q)[64], const bf16_t* kr) {
    const uint4* k4 = (const uint4*)kr;
    float acc = 0.f;
#pragma unroll
    for (int i = 0; i < 8; ++i) {
        const uint4 u = k4[i];
        acc += q[i * 8 + 0] * bflo(u.x) + q[i * 8 + 1] * bfhi(u.x) + q[i * 8 + 2] * bflo(u.y) + q[i * 8 + 3] * bfhi(u.y) +
               q[i * 8 + 4] * bflo(u.z) + q[i * 8 + 5] * bfhi(u.z) + q[i * 8 + 6] * bflo(u.w) + q[i * 8 + 7] * bfhi(u.w);
    }
    return acc;
}
DEV float dot64_f(const float (&q)[64], const float* kr) {
    const float4* k4 = (const float4*)kr;
    float acc = 0.f;
#pragma unroll
    for (int i = 0; i < 16; ++i) {
        const float4 u = k4[i];
        acc += q[i * 4 + 0] * u.x + q[i * 4 + 1] * u.y + q[i * 4 + 2] * u.z + q[i * 4 + 3] * u.w;
    }
    return acc;
}

DEV void attn_block(const float (&q)[64], const bf16_t* krow_lane, const bf16_t* vbase_lane, bool valid, float& m, float& l, float& o) {
    float sc = dot64_bf(q, krow_lane) * 0.125f;
    sc = valid ? sc : -1e30f;
    const float mb = wmax(sc);
    const float mn = fmaxf(m, mb);
    const float corr = expf(m - mn);
    const float e = valid ? expf(sc - mn) : 0.f;
    l = l * corr + wsum(e);
    o *= corr;
#pragma unroll 8
    for (int k = 0; k < 64; ++k) o += __shfl(e, k) * bf2f(vbase_lane[(size_t)k * INC]);
    m = mn;
}

DEV void nsa_item(const P& p, int item) {
    const int lane = threadIdx.x & 63;
    const int g = item & 1;
    const int t = item >> 1;
    const int b = t >> 11, s = t & 2047;
    const bf16_t* HB = (const bf16_t*)(p.ws + WS_HB);
    const float* KC = (const float*)(p.ws + WS_KC);
    bf16_t* OM = (bf16_t*)(p.ws + WS_OM);
    const int cur = s >> 6;
    const int nvalid = (s >= 31) ? (((s - 31) >> 4) + 1) : 0;
    const size_t rowt = (size_t)t * INC;
    float ocmp0 = 0.f, ocmp1 = 0.f, ocmp2 = 0.f, ocmp3 = 0.f;
    float psum0 = 0.f, psum1 = 0.f;
    if (nvalid > 0) {
#pragma unroll 1
        for (int r = 0; r < 4; ++r) {
            const int h = g * 4 + r;
            float q[64];
            load_q64_bf(q, HB + rowt + C_QA + h * 64);
            float sc0 = -1e30f, sc1 = -1e30f;
            if (lane < nvalid) sc0 = dot64_f(q, KC + ((((size_t)0 * B_ + b) * NCMP + lane) * 2 + g) * 64) * 0.125f;
            if (lane + 64 < nvalid) sc1 = dot64_f(q, KC + ((((size_t)0 * B_ + b) * NCMP + lane + 64) * 2 + g) * 64) * 0.125f;
            const float m = wmax(fmaxf(sc0, sc1));
            const float e0 = (lane < nvalid) ? expf(sc0 - m) : 0.f;
            const float e1 = (lane + 64 < nvalid) ? expf(sc1 - m) : 0.f;
            const float l = wsum(e0 + e1);
            const float p0 = e0 / l, p1 = e1 / l;
            psum0 += p0;
            psum1 += p1;
            float oc = 0.f;
            const float* vcb = KC + ((((size_t)1 * B_ + b) * NCMP) * 2 + g) * 64 + lane;
            for (int n = 0; n < nvalid; ++n) {
                const float pn = (n < 64) ? __shfl(p0, n) : __shfl(p1, n - 64);
                oc += pn * vcb[(size_t)n * 128];
            }
            if (r == 0) ocmp0 = oc;
            if (r == 1) ocmp1 = oc;
            if (r == 2) ocmp2 = oc;
            if (r == 3) ocmp3 = oc;
        }
    }
    float imp = 0.f;
#pragma unroll
    for (int dn = -1; dn <= 3; ++dn) {
        const int n = 4 * lane + dn;
        const int nn = n < 0 ? 0 : (n > 127 ? 127 : n);
        const float v0 = __shfl(psum0, nn & 63);
        const float v1 = __shfl(psum1, nn & 63);
        const float v = (nn < 64) ? v0 : v1;
        if (n >= 0 && n <= 126) imp += v;
    }
    float score;
    if (lane > cur) score = -INFINITY;
    else if (lane == 0 || lane == cur || lane == cur - 1) score = 1e4f;
    else score = imp;
    int rank = 0;
#pragma unroll 8
    for (int i = 0; i < 32; ++i) {
        const float si = __shfl(score, i);
        rank += ((si > score) || (si == score && i < lane)) ? 1 : 0;
    }
    const bool sel = (lane <= cur) && (rank < 16);
    const unsigned mask = (unsigned)(__ballot(sel) & 0xffffffffull);
    const int wlo = (s - 511) > 0 ? (s - 511) : 0;
#pragma unroll 1
    for (int r = 0; r < 4; ++r) {
        const int h = g * 4 + r;
        float q[64];
        load_q64_bf(q, HB + rowt + C_QA + h * 64);
        float m = -1e30f, l = 0.f, o = 0.f;
        for (unsigned mm = mask; mm; mm &= mm - 1) {
            const int j = __builtin_ctz(mm);
            const int kpos = j * 64 + lane;
            attn_block(q, HB + (size_t)(b * S_ + kpos) * INC + C_KS + g * 64, HB + (size_t)(b * S_ + j * 64) * INC + C_VS + g * 64 + lane,
                       kpos <= s, m, l, o);
        }
        const float oslc = o / l;
        m = -1e30f; l = 0.f; o = 0.f;
        for (int j = wlo >> 6; j <= cur; ++j) {
            const int kpos = j * 64 + lane;
            attn_block(q, HB + (size_t)(b * S_ + kpos) * INC + C_KW + g * 64, HB + (size_t)(b * S_ + j * 64) * INC + C_VW + g * 64 + lane,
                       (kpos <= s) && (kpos >= wlo), m, l, o);
        }
        const float owin = o / l;
        const float oc = r == 0 ? ocmp0 : (r == 1 ? ocmp1 : (r == 2 ? ocmp2 : ocmp3));
        const float g0 = sigmoidf_(bf2f(HB[rowt + C_GATE + h * 3 + 0]));
        const float g1 = sigmoidf_(bf2f(HB[rowt + C_GATE + h * 3 + 1]));
        const float g2 = sigmoidf_(bf2f(HB[rowt + C_GATE + h * 3 + 2]));
        OM[(size_t)t * 1024 + h * 64 + lane] = f2bf(g0 * oc + g1 * oslc + g2 * owin);
    }
}

DEV void hgrn_item(const P& p, int item, float* smem) {
    const int b = item >> 2, hh = item & 3;
    const int tid = threadIdx.x, dv = tid & 127, half = tid >> 7;
    const bf16_t* HB = (const bf16_t*)(p.ws + WS_HB);
    bf16_t* OM = (bf16_t*)(p.ws + WS_OM);
    float* sf = smem;
    float* sq = smem + 1024;
    float* so = smem + 2048;
    float Sreg[64];
#pragma unroll
    for (int i = 0; i < 64; ++i) Sreg[i] = 0.f;
    const int d = tid & 127;
    float lbv;
    {
        const float l0 = p.lb_logits[hh * 128 + d], l1 = p.lb_logits[512 + hh * 128 + d];
        const float mx = fmaxf(l0, l1);
        const float e0 = expf(l0 - mx), e1 = expf(l1 - mx);
        lbv = e0 / (e0 + e1);
    }
    const int wave = tid >> 6, lane = tid & 63;
    const float nw0 = p.hg_norm_w[hh * 128 + lane], nw1 = p.hg_norm_w[hh * 128 + lane + 64];
    for (int t0 = 0; t0 < S_; t0 += 8) {
#pragma unroll
        for (int i = 0; i < 4; ++i) {
            const int st = (tid >> 7) + 2 * i;
            const size_t tt = (size_t)b * S_ + t0 + st;
            const float fl = bf2f(HB[tt * INC + C_HF + hh * 128 + d]);
            sf[st * 128 + d] = lbv + (1.f - lbv) * sigmoidf_(fl);
            sq[st * 128 + d] = bf2f(HB[tt * INC + C_HQ + hh * 128 + d]);
        }
        float vv[8];
#pragma unroll
        for (int st = 0; st < 8; ++st) vv[st] = bf2f(HB[((size_t)b * S_ + t0 + st) * INC + C_HI + hh * 128 + dv]);
        __syncthreads();
#pragma unroll
        for (int st = 0; st < 8; ++st) {
            float oacc = 0.f;
            const float* pf = sf + st * 128 + half * 64;
            const float* pq = sq + st * 128 + half * 64;
#pragma unroll
            for (int dk = 0; dk < 64; ++dk) {
                const float f = pf[dk];
                Sreg[dk] = f * Sreg[dk] + (1.f - f) * vv[st];
                oacc += pq[dk] * Sreg[dk];
            }
            so[(st * 2 + half) * 128 + dv] = oacc;
        }
        __syncthreads();
#pragma unroll
        for (int u = 0; u < 2; ++u) {
            const int st = wave * 2 + u;
            const float o0 = so[(st * 2 + 0) * 128 + lane] + so[(st * 2 + 1) * 128 + lane];
            const float o1 = so[(st * 2 + 0) * 128 + lane + 64] + so[(st * 2 + 1) * 128 + lane + 64];
            const float ss = wsum(o0 * o0 + o1 * o1);
            const float rs = rsqrtf(ss * (1.f / 128.f) + LN_EPS);
            const size_t tt = (size_t)b * S_ + t0 + st;
            const float gg0 = bf2f(HB[tt * INC + C_HG + hh * 128 + lane]);
            const float gg1 = bf2f(HB[tt * INC + C_HG + hh * 128 + lane + 64]);
            OM[tt * 1024 + 512 + hh * 128 + lane] = f2bf(o0 * rs * nw0 * (gg0 * sigmoidf_(gg0)));
            OM[tt * 1024 + 512 + hh * 128 + lane + 64] = f2bf(o1 * rs * nw1 * (gg1 * sigmoidf_(gg1)));
        }
    }
    __syncthreads();
}

DEV void ln_item(const P& p, int t, int which, int lane) {
    const bf16_t* row = (const bf16_t*)(p.ws + WS_YB) + (size_t)t * 1024;
    float4 v[4];
    float s = 0.f;
#pragma unroll
    for (int i = 0; i < 4; ++i) {
        const uint2 u = *(const uint2*)(row + (i * 64 + lane) * 4);
        v[i] = make_float4(bflo(u.x), bfhi(u.x), bflo(u.y), bfhi(u.y));
        s += v[i].x + v[i].y + v[i].z + v[i].w;
    }
    const float mean = wsum(s) * (1.f / 1024.f);
    float ss = 0.f;
#pragma unroll
    for (int i = 0; i < 4; ++i) {
        v[i].x -= mean; v[i].y -= mean; v[i].z -= mean; v[i].w -= mean;
        ss += v[i].x * v[i].x + v[i].y * v[i].y + v[i].z * v[i].z + v[i].w * v[i].w;
    }
    const float rs = rsqrtf(wsum(ss) * (1.f / 1024.f) + LN_EPS);
#pragma unroll
    for (int i = 0; i < 4; ++i) {
        const int c = (i * 64 + lane) * 4;
        const float4 gg = *(const float4*)(p.ln_g + which * 1024 + c);
        const float4 bb = *(const float4*)(p.ln_b + which * 1024 + c);
        float4 o;
        o.x = v[i].x * rs * gg.x + bb.x; o.y = v[i].y * rs * gg.y + bb.y; o.z = v[i].z * rs * gg.z + bb.z; o.w = v[i].w * rs * gg.w + bb.w;
        uint2 u;
        u.x = pk_bf16(o.x, o.y);
        u.y = pk_bf16(o.z, o.w);
        *(uint2*)((bf16_t*)(p.ws + WS_XB) + (size_t)t * 1024 + c) = u;
    }
}

DEV void xattn_item(const P& p, int item) {
    const int lane = threadIdx.x & 63;
    const int hh = item & 3, t = item >> 2, b = t >> 11;
    const bf16_t* QX = (const bf16_t*)(p.ws + WS_QX);
    const bf16_t* KVM = (const bf16_t*)(p.ws + WS_KVM);
    bf16_t* OX = (bf16_t*)(p.ws + WS_OX);
    float sc[4] = {0.f, 0.f, 0.f, 0.f};
#pragma unroll 1
    for (int c = 0; c < 4; ++c) {
        float q[64];
        load_q64_bf(q, QX + (size_t)t * 1024 + hh * 256 + c * 64);
#pragma unroll
        for (int k = 0; k < 4; ++k) sc[k] += dot64_bf(q, KVM + (size_t)(b * ML_ + lane + 64 * k) * 2048 + hh * 256 + c * 64);
    }
    float mx = -1e30f;
#pragma unroll
    for (int k = 0; k < 4; ++k) { sc[k] *= 0.0625f; mx = fmaxf(mx, sc[k]); }
    mx = wmax(mx);
    float pr[4], ls = 0.f;
#pragma unroll
    for (int k = 0; k < 4; ++k) { pr[k] = expf(sc[k] - mx); ls += pr[k]; }
    ls = wsum(ls);
    const float inv = 1.f / ls;
    float o[4] = {0.f, 0.f, 0.f, 0.f};
#pragma unroll
    for (int k = 0; k < 4; ++k) {
        const bf16_t* vb = KVM + (size_t)(b * ML_ + k * 64) * 2048 + 1024 + hh * 256 + lane;
#pragma unroll 4
        for (int mm = 0; mm < 64; ++mm) {
            const float pm = __shfl(pr[k], mm);
#pragma unroll
            for (int c = 0; c < 4; ++c) o[c] += pm * bf2f(vb[(size_t)mm * 2048 + c * 64]);
        }
    }
#pragma unroll
    for (int c = 0; c < 4; ++c) OX[(size_t)t * 1024 + hh * 256 + c * 64 + lane] = f2bf(o[c] * inv);
}

DEV void wave_argmax(float v, int i, float& bv, int& bi) {
#pragma unroll
    for (int o = 32; o > 0; o >>= 1) {
        const float ov = __shfl_xor(v, o);
        const int oi = __shfl_xor(i, o);
        if (ov > v || (ov == v && oi < i)) { v = ov; i = oi; }
    }
    bv = v; bi = i;
}

DEV void peer_item(const P& p, int t) {
    const int lane = threadIdx.x & 63;
    const float* QP = (const float*)(p.ws + WS_QP);
    float* row = p.out + (size_t)t * 1024;
    float4 xr[4], oacc[4];
#pragma unroll
    for (int i = 0; i < 4; ++i) {
        xr[i] = *(const float4*)(row + (i * 64 + lane) * 4);
        oacc[i] = make_float4(0.f, 0.f, 0.f, 0.f);
    }
#pragma unroll 1
    for (int hh = 0; hh < 8; ++hh) {
        float ts1 = 0.f, ts2 = 0.f;
        int ti1 = 0, ti2 = 0;
#pragma unroll 1
        for (int c = 0; c < 2; ++c) {
            float q[64];
            {
                const float4* q4 = (const float4*)(QP + (size_t)t * 1024 + hh * 128 + c * 64);
#pragma unroll
                for (int i = 0; i < 16; ++i) { const float4 u = q4[i]; q[i * 4] = u.x; q[i * 4 + 1] = u.y; q[i * 4 + 2] = u.z; q[i * 4 + 3] = u.w; }
            }
            const float* kb = p.peer_keys + ((size_t)(hh * 2 + c) * 128) * 64;
            float a0 = dot64_f(q, kb + (size_t)lane * 64);
            float a1 = dot64_f(q, kb + (size_t)(lane + 64) * 64);
            float ts = 0.f;
            int ti = 0;
#pragma unroll 1
            for (int k = 0; k < 16; ++k) {
                float v; int i;
                if (a0 >= a1) { v = a0; i = lane; } else { v = a1; i = lane + 64; }
                float bv; int bi;
                wave_argmax(v, i, bv, bi);
                if (lane == k) { ts = bv; ti = bi; }
                if (bi == lane) a0 = -INFINITY;
                if (bi == lane + 64) a1 = -INFINITY;
            }
            if (c == 0) { ts1 = ts; ti1 = ti; } else { ts2 = ts; ti2 = ti; }
        }
        float cs[4];
        const float s1v = __shfl(ts1, lane >> 2);
#pragma unroll
        for (int u = 0; u < 4; ++u) cs[u] = s1v + __shfl(ts2, (lane & 3) * 4 + u);
        float fs = 0.f;
        int fidx = 0;
#pragma unroll 1
        for (int k = 0; k < 16; ++k) {
            float v = cs[0]; int i = lane * 4;
#pragma unroll
            for (int u = 1; u < 4; ++u) if (cs[u] > v) { v = cs[u]; i = lane * 4 + u; }
            float bv; int bi;
            wave_argmax(v, i, bv, bi);
            if (lane == k) { fs = bv; fidx = bi; }
#pragma unroll
            for (int u = 0; u < 4; ++u) if (bi == lane * 4 + u) cs[u] = -INFINITY;
        }
        const int e1i = __shfl(ti1, fidx >> 4);
        const int e2i = __shfl(ti2, fidx & 15);
        const int eid = e1i * 128 + e2i;
        const float mx = __shfl(fs, 0);
        const float w = (lane < 16) ? expf(fs - mx) : 0.f;
        const float gate = w / wsum(w);
#pragma unroll 1
        for (int k = 0; k < 16; ++k) {
            const int e = __shfl(eid, k);
            const float gt = __shfl(gate, k);
            const float* dr = p.peer_down + (size_t)e * 1024;
            const float* ur = p.peer_up + (size_t)e * 1024;
            float hd = 0.f;
#pragma unroll
            for (int i = 0; i < 4; ++i) {
                const float4 dvv = *(const float4*)(dr + (i * 64 + lane) * 4);
                hd += dvv.x * xr[i].x + dvv.y * xr[i].y + dvv.z * xr[i].z + dvv.w * xr[i].w;
            }
            hd = wsum(hd);
            const float a = 0.5f * hd * (1.f + erff(hd * 0.7071067811865476f)) * gt;
#pragma unroll
            for (int i = 0; i < 4; ++i) {
                const float4 uv = *(const float4*)(ur + (i * 64 + lane) * 4);
                oacc[i].x += a * uv.x; oacc[i].y += a * uv.y; oacc[i].z += a * uv.z; oacc[i].w += a * uv.w;
            }
        }
    }
    float s = 0.f;
    float4 v[4];
#pragma unroll
    for (int i = 0; i < 4; ++i) {
        v[i].x = ALPHA * xr[i].x + oacc[i].x; v[i].y = ALPHA * xr[i].y + oacc[i].y;
        v[i].z = ALPHA * xr[i].z + oacc[i].z; v[i].w = ALPHA * xr[i].w + oacc[i].w;
        s += v[i].x + v[i].y + v[i].z + v[i].w;
    }
    const float mean = wsum(s) * (1.f / 1024.f);
    float ss = 0.f;
#pragma unroll
    for (int i = 0; i < 4; ++i) {
        v[i].x -= mean; v[i].y -= mean; v[i].z -= mean; v[i].w -= mean;
        ss += v[i].x * v[i].x + v[i].y * v[i].y + v[i].z * v[i].z + v[i].w * v[i].w;
    }
    const float rs = rsqrtf(wsum(ss) * (1.f / 1024.f) + LN_EPS);
#pragma unroll
    for (int i = 0; i < 4; ++i) {
        const int c = (i * 64 + lane) * 4;
        const float4 gg = *(const float4*)(p.ln_g + 2 * 1024 + c);
        const float4 bb = *(const float4*)(p.ln_b + 2 * 1024 + c);
        float4 o;
        o.x = v[i].x * rs * gg.x + bb.x; o.y = v[i].y * rs * gg.y + bb.y; o.z = v[i].z * rs * gg.z + bb.z; o.w = v[i].w * rs * gg.w + bb.w;
        *(float4*)(row + c) = o;
    }
}


DEV void compress_item2(const P& p, int item, unsigned char* lds) {
    const int nt8 = item & 7, g = (item >> 3) & 1, b = (item >> 4) & 7, kind = item >> 7;
    const int tid = threadIdx.x, lane = tid & 63, wid = tid >> 6, fr = lane & 15, fq = lane >> 4;
    const bf16_t* HB = (const bf16_t*)(p.ws + WS_HB);
    const bf16_t* W1T = (const bf16_t*)(p.ws + WS_W1T) + (size_t)kind * 128 * 2048;
    const bf16_t* W2T = (const bf16_t*)(p.ws + WS_W2T) + (size_t)kind * 64 * 128;
    const float* posb = p.cmp_pos + (size_t)kind * 2048 + fq * 8;
    const int n0 = nt8 * 16;
    const int kcol = (kind ? C_VC : C_KC) + g * 64;
    const bf16_t* abase = HB + (size_t)(b * S_ + 16 * (n0 + fr)) * INC + kcol + fq * 8;
    const bf16_t* wbase = W1T + (size_t)fr * 2048 + fq * 8;
    f32x4 acc[8];
#pragma unroll
    for (int jt = 0; jt < 8; ++jt) acc[jt] = (f32x4){0.f, 0.f, 0.f, 0.f};
#pragma unroll 4
    for (int k2 = 0; k2 < 16; ++k2) {
        const int ks = wid * 16 + k2;
        bf16x8 af;
        {
            const u32x4 raw = *(const u32x4*)(abase + (size_t)(ks >> 1) * INC + (ks & 1) * 32);
            const float* pp = posb + (ks >> 1) * 64 + (ks & 1) * 32;
            const float4 p0 = *(const float4*)pp, p1 = *(const float4*)(pp + 4);
            u32x4 w;
            w[0] = pk_bf16(bflo(raw[0]) + p0.x, bfhi(raw[0]) + p0.y);
            w[1] = pk_bf16(bflo(raw[1]) + p0.z, bfhi(raw[1]) + p0.w);
            w[2] = pk_bf16(bflo(raw[2]) + p1.x, bfhi(raw[2]) + p1.y);
            w[3] = pk_bf16(bflo(raw[3]) + p1.z, bfhi(raw[3]) + p1.w);
            af = __builtin_bit_cast(bf16x8, w);
        }
#pragma unroll
        for (int jt = 0; jt < 8; ++jt) {
            const bf16x8 wf = *(const bf16x8*)(wbase + (size_t)jt * 16 * 2048 + ks * 32);
            acc[jt] = __builtin_amdgcn_mfma_f32_16x16x32_bf16(wf, af, acc[jt], 0, 0, 0);
        }
    }
    float* PS = (float*)lds;
    bf16_t* HS = (bf16_t*)(lds + 4 * 16 * 132 * 4);
#pragma unroll
    for (int jt = 0; jt < 8; ++jt)
        *(float4*)(PS + (wid * 16 + fr) * 132 + jt * 16 + fq * 4) = make_float4(acc[jt][0], acc[jt][1], acc[jt][2], acc[jt][3]);
    __syncthreads();
    {
        const int r = tid >> 4, jb = (tid & 15) * 8;
        float hv[8];
#pragma unroll
        for (int h2 = 0; h2 < 2; ++h2) {
            float4 s = make_float4(0.f, 0.f, 0.f, 0.f);
#pragma unroll
            for (int w = 0; w < 4; ++w) {
                const float4 v = *(const float4*)(PS + (w * 16 + r) * 132 + jb + h2 * 4);
                s.x += v.x; s.y += v.y; s.z += v.z; s.w += v.w;
            }
            hv[h2 * 4 + 0] = s.x; hv[h2 * 4 + 1] = s.y; hv[h2 * 4 + 2] = s.z; hv[h2 * 4 + 3] = s.w;
        }
#pragma unroll
        for (int i = 0; i < 8; ++i) {
            const float v = hv[i];
            const float u = 0.7978845608028654f * (v + 0.044715f * v * v * v);
            hv[i] = 0.5f * v * (1.f + tanhf(u));
        }
        u32x4 w;
        w[0] = pk_bf16(hv[0], hv[1]); w[1] = pk_bf16(hv[2], hv[3]); w[2] = pk_bf16(hv[4], hv[5]); w[3] = pk_bf16(hv[6], hv[7]);
        *(u32x4*)(HS + r * 136 + jb) = w;
    }
    __syncthreads();
    f32x4 o = (f32x4){0.f, 0.f, 0.f, 0.f};
#pragma unroll
    for (int ks = 0; ks < 4; ++ks) {
        const bf16x8 hf = *(const bf16x8*)(HS + fr * 136 + ks * 32 + fq * 8);
        const bf16x8 wf = *(const bf16x8*)(W2T + (size_t)(wid * 16 + fr) * 128 + ks * 32 + fq * 8);
        if (kind == 0) o = __builtin_amdgcn_mfma_f32_16x16x32_bf16(wf, hf, o, 0, 0, 0);
        else o = __builtin_amdgcn_mfma_f32_16x16x32_bf16(hf, wf, o, 0, 0, 0);
    }
    if (kind == 0) {
        const int n = n0 + fr, e = wid * 16 + fq * 4;
        uint2 u2;
        u2.x = pk_bf16(o[0], o[1]);
        u2.y = pk_bf16(o[2], o[3]);
        if (n == 127) u2 = make_uint2(0u, 0u);
        *(uint2*)((bf16_t*)(p.ws + WS_KCB) + ((size_t)(b * 2 + g) * 128 + n) * 64 + e) = u2;
    } else {
        const int e = wid * 16 + fr, n = n0 + fq * 4;
        const float o3 = (n + 3 == 127) ? 0.f : o[3];
        uint2 u2;
        u2.x = pk_bf16(o[0], o[1]);
        u2.y = pk_bf16(o[2], o3);
        *(uint2*)((bf16_t*)(p.ws + WS_VCT) + ((size_t)(b * 2 + g) * 64 + e) * 128 + n) = u2;
    }
    __syncthreads();
}

constexpr int NSA_IMP = 32768;
constexpr int NSA_SCORE = 49152;
constexpr int NSA_SELM = NSA_SCORE + 4224;

struct NsaTileRegs { u32x4 k[2], v[2]; };
DEV void nsa_load_tile(NsaTileRegs& r, const bf16_t* kbase, size_t kstride, const bf16_t* vbase, size_t vstride, int tid) {
    const int lc = tid & 7, lr = tid >> 3;
#pragma unroll
    for (int i = 0; i < 2; ++i) {
        r.k[i] = *(const u32x4*)(kbase + (size_t)(lr + 32 * i) * kstride + lc * 8);
        r.v[i] = *(const u32x4*)(vbase + (size_t)(lr + 32 * i) * vstride + lc * 8);
    }
}
DEV void nsa_store_tile(const NsaTileRegs& r, unsigned char* stage, int tid) {
    const int lc = tid & 7, lr = tid >> 3;
    const int woff = lr * 128 + ((lc ^ ((lr >> 1) & 7)) << 4);
#pragma unroll
    for (int i = 0; i < 2; ++i) {
        *(u32x4*)(stage + woff + i * 4096) = r.k[i];
        *(u32x4*)(stage + 8192 + woff + i * 4096) = r.v[i];
    }
}
DEV void nsa_dma_tile(const bf16_t* kbase, size_t kstride, const bf16_t* vbase, size_t vstride, unsigned char* stage, int lane, int wid) {
#pragma unroll
    for (int i = 0; i < 2; ++i) {
        const int pc = wid * 2 + i;
        const int r = pc * 8 + (lane >> 3);
        const int c = (lane & 7) ^ ((r >> 1) & 7);
        __builtin_amdgcn_global_load_lds((const unsigned*)(kbase + (size_t)r * kstride + c * 8), (unsigned*)(stage + pc * 1024), 16, 0, 0);
        __builtin_amdgcn_global_load_lds((const unsigned*)(vbase + (size_t)r * vstride + c * 8), (unsigned*)(stage + 8192 + pc * 1024), 16, 0, 0);
    }
}
DEV void nsa_scores(const unsigned char* stage, const bf16x8 (&qf)[2][2], f32x4 (&sc)[4][2], int fr, int fq) {
    const int sw = (fr >> 1) & 7;
    const int c0 = (fq ^ sw) << 4;
    const unsigned char* rowp = stage + fr * 128;
    const unsigned char* p0 = rowp + c0;
    const unsigned char* p1 = rowp + (c0 ^ 64);
#pragma unroll
    for (int kt = 0; kt < 4; ++kt) {
        const bf16x8 k0 = *(const bf16x8*)(p0 + kt * 2048);
        const bf16x8 k1 = *(const bf16x8*)(p1 + kt * 2048);
#pragma unroll
        for (int qt = 0; qt < 2; ++qt) {
            f32x4 a = (f32x4){0.f, 0.f, 0.f, 0.f};
            a = __builtin_amdgcn_mfma_f32_16x16x32_bf16(k0, qf[qt][0], a, 0, 0, 0);
            a = __builtin_amdgcn_mfma_f32_16x16x32_bf16(k1, qf[qt][1], a, 0, 0, 0);
            sc[kt][qt] = a;
        }
    }
}
DEV void nsa_pv(const unsigned char* stage, const f32x4 (&sc)[4][2], f32x4 (&o)[4][2], int fr, int fq) {
    const int sw = (fr >> 1) & 7;
    const int v0 = (((fq >> 1) ^ sw) << 4) + 8 * (fq & 1);
    const unsigned char* rowp = stage + 8192 + fr * 128;
#pragma unroll
    for (int s = 0; s < 2; ++s) {
        u32x4 pf[2];
#pragma unroll
        for (int qt = 0; qt < 2; ++qt) {
            pf[qt][0] = pk_bf16(sc[2 * s][qt][0], sc[2 * s][qt][1]);
            pf[qt][1] = pk_bf16(sc[2 * s][qt][2], sc[2 * s][qt][3]);
            pf[qt][2] = pk_bf16(sc[2 * s + 1][qt][0], sc[2 * s + 1][qt][1]);
            pf[qt][3] = pk_bf16(sc[2 * s + 1][qt][2], sc[2 * s + 1][qt][3]);
        }
        const unsigned char* plo = rowp + (v0 ^ (64 * s));
        const unsigned char* phi = rowp + (v0 ^ (64 * s) ^ 32);
#pragma unroll
        for (int dt = 0; dt < 4; ++dt) {
            const uint2 lo = *(const uint2*)(plo + dt * 2048);
            const uint2 hi = *(const uint2*)(phi + dt * 2048);
            u32x4 vv;
            vv[0] = lo.x; vv[1] = lo.y; vv[2] = hi.x; vv[3] = hi.y;
            const bf16x8 vf = __builtin_bit_cast(bf16x8, vv);
#pragma unroll
            for (int qt = 0; qt < 2; ++qt)
                o[dt][qt] = __builtin_amdgcn_mfma_f32_16x16x32_bf16(vf, __builtin_bit_cast(bf16x8, pf[qt]), o[dt][qt], 0, 0, 0);
        }
    }
}
DEV float xmax4(float v) { v = fmaxf(v, __shfl_xor(v, 16)); return fmaxf(v, __shfl_xor(v, 32)); }
DEV float xsum4(float v) { v += __shfl_xor(v, 16); return v + __shfl_xor(v, 32); }

DEV void nsa_branch(const int mode, const int BR, const int q0v, const unsigned char* wsb, unsigned char* lds, int b, int g, unsigned blocks, const bf16x8 (&qf)[2][2], const int (&qpos)[2],
                    const unsigned (&selm)[2], const float (&gate)[2], f32x4 (&fin)[4][2], int tid) {
    asm volatile("" : "+v"(tid));
    const int fr = tid & 15, fq = (tid >> 4) & 3;
    const bf16_t* HB = (const bf16_t*)(wsb + WS_HB);
    const bf16_t* VT = (const bf16_t*)(wsb + WS_VT);
    const bf16_t* kb0 = HB + (size_t)(b * S_) * INC + (BR == 0 ? C_KS : C_KW) + g * 64;
    const bf16_t* vb0 = VT + ((((size_t)BR * B_ + b) * 2 + g) * 64) * 2048;
    const bool fake = mode == 1;
    float m[2] = {-1e30f, -1e30f}, l[2] = {0.f, 0.f};
    f32x4 o[4][2];
#pragma unroll
    for (int dt = 0; dt < 4; ++dt)
#pragma unroll
        for (int qt = 0; qt < 2; ++qt) o[dt][qt] = (f32x4){0.f, 0.f, 0.f, 0.f};
    const int lane64 = tid & 63, widx = __builtin_amdgcn_readfirstlane(tid >> 6);
    int kb = __builtin_ctz(blocks);
    blocks &= blocks - 1;
    int kb1 = blocks ? __builtin_ctz(blocks) : -1;
    if (kb1 >= 0) blocks &= blocks - 1;
    nsa_dma_tile(kb0 + (size_t)(fake ? 0 : kb) * 64 * INC, INC, vb0 + (fake ? 0 : kb) * 64, 2048, lds, lane64, widx);
    if (kb1 >= 0) nsa_dma_tile(kb0 + (size_t)(fake ? 0 : kb1) * 64 * INC, INC, vb0 + (fake ? 0 : kb1) * 64, 2048, lds + 16384, lane64, widx);
    int slot = 0;
    while (true) {
        if (kb1 >= 0) asm volatile("s_waitcnt vmcnt(4)\n\ts_waitcnt lgkmcnt(0)" ::: "memory");
        else asm volatile("s_waitcnt vmcnt(0)\n\ts_waitcnt lgkmcnt(0)" ::: "memory");
        __builtin_amdgcn_s_barrier(); asm volatile("" ::: "memory");
        const int kb2 = blocks ? __builtin_ctz(blocks) : -1;
        if (kb2 >= 0) {
            blocks &= blocks - 1;
            const int s2 = slot >= 1 ? slot - 1 : 2;
            nsa_dma_tile(kb0 + (size_t)(fake ? 0 : kb2) * 64 * INC, INC, vb0 + (fake ? 0 : kb2) * 64, 2048, lds + s2 * 16384, lane64, widx);
        }
        const unsigned char* stage = lds + slot * 16384;
        f32x4 sc[4][2];
        nsa_scores(stage, qf, sc, fr, fq);
        constexpr float C1 = 0.125f * 1.4426950408889634f;
        const bool need_mask = (BR == 0) ? (kb == (q0v >> 6)) : !((kb * 64 + 63 <= q0v) && (kb * 64 + 511 >= q0v + 31));
        float alpha[2];
        if (!need_mask) {
#pragma unroll
            for (int qt = 0; qt < 2; ++qt) {
                const bool sel = BR == 0 ? ((selm[qt] >> kb) & 1u) != 0u : true;
                float bm = -1e30f;
#pragma unroll
                for (int kt = 0; kt < 4; ++kt)
#pragma unroll
                    for (int i = 0; i < 4; ++i) {
                        const float s = sel ? sc[kt][qt][i] * C1 : -1e30f;
                        sc[kt][qt][i] = s;
                        bm = fmaxf(bm, s);
                    }
                bm = xmax4(bm);
                const float mn = fmaxf(m[qt], bm);
                alpha[qt] = __builtin_amdgcn_exp2f(m[qt] - mn);
                float ps = 0.f;
#pragma unroll
                for (int kt = 0; kt < 4; ++kt)
#pragma unroll
                    for (int i = 0; i < 4; ++i) {
                        const float s = sc[kt][qt][i];
                        const float e = (s > -1e29f) ? __builtin_amdgcn_exp2f(s - mn) : 0.f;
                        sc[kt][qt][i] = e;
                        ps += e;
                    }
                l[qt] = l[qt] * alpha[qt] + ps;
                m[qt] = mn;
            }
        } else {
#pragma unroll
            for (int qt = 0; qt < 2; ++qt) {
                const bool sel = BR == 0 ? ((selm[qt] >> kb) & 1u) != 0u : true;
                float bm = -1e30f;
#pragma unroll
                for (int kt = 0; kt < 4; ++kt)
#pragma unroll
                    for (int i = 0; i < 4; ++i) {
                        const int key = kb * 64 + kt * 16 + fq * 4 + i;
                        bool valid = sel && (key <= qpos[qt]);
                        if (BR == 1) valid = valid && (key + 511 >= qpos[qt]);
                        const float s = valid ? sc[kt][qt][i] * C1 : -1e30f;
                        sc[kt][qt][i] = s;
                        bm = fmaxf(bm, s);
                    }
                bm = xmax4(bm);
                const float mn = fmaxf(m[qt], bm);
                alpha[qt] = __builtin_amdgcn_exp2f(m[qt] - mn);
                float ps = 0.f;
#pragma unroll
                for (int kt = 0; kt < 4; ++kt)
#pragma unroll
                    for (int i = 0; i < 4; ++i) {
                        const float s = sc[kt][qt][i];
                        const float e = (s > -1e29f) ? __builtin_amdgcn_exp2f(s - mn) : 0.f;
                        sc[kt][qt][i] = e;
                        ps += e;
                    }
                l[qt] = l[qt] * alpha[qt] + ps;
                m[qt] = mn;
            }
        }
        {
#pragma unroll
            for (int qt = 0; qt < 2; ++qt)
#pragma unroll
                for (int dt = 0; dt < 4; ++dt) o[dt][qt] *= alpha[qt];
        }
        if (mode != 3) nsa_pv(stage, sc, o, fr, fq);
        else { asm volatile("" :: "v"(sc[0][0][0]), "v"(sc[1][1][1]), "v"(sc[2][0][2]), "v"(sc[3][1][3])); }
        if (kb1 < 0) break;
        kb = kb1;
        kb1 = kb2;
        slot = slot == 2 ? 0 : slot + 1;
    }
#pragma unroll
    for (int qt = 0; qt < 2; ++qt) {
        const float lt = xsum4(l[qt]);
        const float sc2 = lt > 0.f ? gate[qt] / lt : 0.f;
#pragma unroll
        for (int dt = 0; dt < 4; ++dt) fin[dt][qt] += o[dt][qt] * sc2;
    }
    asm volatile("s_waitcnt lgkmcnt(0)" ::: "memory");
    __builtin_amdgcn_s_barrier(); asm volatile("" ::: "memory");
}

DEV void nsa_item2(const P& p, int b, int g, int qblk, unsigned char* lds, int fake = 0) {
    int tid = threadIdx.x;
    asm volatile("" : "+v"(tid));
    const int lane = tid & 63, wid = tid >> 6, fr = lane & 15, fq = lane >> 4;
    const int q0 = qblk * 32, cur = q0 >> 6, h = g * 4 + wid;
    unsigned char* wsb = p.ws;
    asm volatile("" : "+s"(wsb));
    const bf16_t* HB = (const bf16_t*)(wsb + WS_HB);
    float* IMPW = (float*)(lds + NSA_IMP);
    float* SCORE = (float*)(lds + NSA_SCORE);
    unsigned* SELM = (unsigned*)(lds + NSA_SELM);
    bf16x8 qf[2][2];
    int qpos[2];
#pragma unroll
    for (int qt = 0; qt < 2; ++qt) {
        qpos[qt] = q0 + qt * 16 + fr;
        const bf16_t* rowp = HB + (size_t)(b * S_ + qpos[qt]) * INC;
#pragma unroll
        for (int ks = 0; ks < 2; ++ks) qf[qt][ks] = *(const bf16x8*)(rowp + C_QA + h * 64 + ks * 32 + fq * 8);
    }
    if (tid < 33) SELM[tid] = 0u;
    f32x4 fin[4][2];
#pragma unroll
    for (int dt = 0; dt < 4; ++dt)
#pragma unroll
        for (int qt = 0; qt < 2; ++qt) fin[dt][qt] = (f32x4){0.f, 0.f, 0.f, 0.f};
    {
        const bf16_t* KCB = (const bf16_t*)(wsb + WS_KCB) + (size_t)(b * 2 + g) * 128 * 64;
        const bf16_t* VCT = (const bf16_t*)(wsb + WS_VCT) + (size_t)(b * 2 + g) * 64 * 128;
        {
            const int widx = __builtin_amdgcn_readfirstlane(wid);
            nsa_dma_tile(KCB, 64, VCT, 128, lds, lane, widx);
            nsa_dma_tile(KCB + 64 * 64, 64, VCT + 64, 128, lds + 16384, lane, widx);
            asm volatile("s_waitcnt vmcnt(0)" ::: "memory");
        }
        __syncthreads();
        int nv[2];
        float mx[2] = {-1e30f, -1e30f}, inv[2];
#pragma unroll
        for (int qt = 0; qt < 2; ++qt) nv[qt] = qpos[qt] >= 31 ? (((qpos[qt] - 31) >> 4) + 1) : 0;
#pragma unroll 1
        for (int kb = 0; kb < 2; ++kb) {
            f32x4 sc[4][2];
            nsa_scores(lds + kb * 16384, qf, sc, fr, fq);
#pragma unroll
            for (int qt = 0; qt < 2; ++qt)
#pragma unroll
                for (int kt = 0; kt < 4; ++kt)
#pragma unroll
                    for (int i = 0; i < 4; ++i) {
                        const int n = kb * 64 + kt * 16 + fq * 4 + i;
                        mx[qt] = fmaxf(mx[qt], (n < nv[qt]) ? sc[kt][qt][i] * 0.125f : -1e30f);
                    }
        }
        float ps[2] = {0.f, 0.f};
#pragma unroll
        for (int qt = 0; qt < 2; ++qt) mx[qt] = xmax4(mx[qt]);
#pragma unroll 1
        for (int kb = 0; kb < 2; ++kb) {
            f32x4 sc[4][2];
            nsa_scores(lds + kb * 16384, qf, sc, fr, fq);
#pragma unroll
            for (int qt = 0; qt < 2; ++qt)
#pragma unroll
                for (int kt = 0; kt < 4; ++kt)
#pragma unroll
                    for (int i = 0; i < 4; ++i) {
                        const int n = kb * 64 + kt * 16 + fq * 4 + i;
                        ps[qt] += (n < nv[qt]) ? __expf(sc[kt][qt][i] * 0.125f - mx[qt]) : 0.f;
                    }
        }
#pragma unroll
        for (int qt = 0; qt < 2; ++qt) {
            ps[qt] = xsum4(ps[qt]);
            inv[qt] = ps[qt] > 0.f ? 1.f / ps[qt] : 0.f;
        }
        float prev3[2] = {0.f, 0.f};
#pragma unroll 1
        for (int kb = 0; kb < 2; ++kb) {
            f32x4 sc[4][2];
            nsa_scores(lds + kb * 16384, qf, sc, fr, fq);
#pragma unroll
            for (int qt = 0; qt < 2; ++qt) {
                float* impw = IMPW + (wid * 32 + qt * 16 + fr) * 32 + kb * 16 + fq;
#pragma unroll
                for (int kt = 0; kt < 4; ++kt) {
                    f32x4 pv;
#pragma unroll
                    for (int i = 0; i < 4; ++i) {
                        const int n = kb * 64 + kt * 16 + fq * 4 + i;
                        pv[i] = (n < nv[qt]) ? __expf(sc[kt][qt][i] * 0.125f - mx[qt]) * inv[qt] : 0.f;
                    }
                    sc[kt][qt] = pv;
                    const float c1 = __shfl_up(pv[3], 16);
                    const float c0 = __shfl(prev3[qt], fr + 48);
                    impw[kt * 4] = pv[0] + pv[1] + pv[2] + pv[3] + (fq > 0 ? c1 : c0);
                    prev3[qt] = pv[3];
                }
            }
            nsa_pv(lds + kb * 16384, sc, fin, fr, fq);
        }
#pragma unroll
        for (int qt = 0; qt < 2; ++qt) {
            const float gc = fsigmoid(bf2f(HB[(size_t)(b * S_ + qpos[qt]) * INC + C_GATE + h * 3 + 0]));
#pragma unroll
            for (int dt = 0; dt < 4; ++dt) fin[dt][qt] *= gc;
        }
    }
    __syncthreads();
    {
        const int q = tid >> 3, jg = tid & 7;
#pragma unroll
        for (int u = 0; u < 4; ++u) {
            const int j = jg * 4 + u;
            const float imp = IMPW[(0 * 32 + q) * 32 + j] + IMPW[(1 * 32 + q) * 32 + j] + IMPW[(2 * 32 + q) * 32 + j] + IMPW[(3 * 32 + q) * 32 + j];
            float score;
            if (j > cur) score = -INFINITY;
            else if (j == 0 || j == cur || j == cur - 1) score = 1e4f;
            else score = imp;
            SCORE[q * 33 + j] = score;
        }
        __syncthreads();
        unsigned bits = 0u;
#pragma unroll
        for (int u = 0; u < 4; ++u) {
            const int j = jg * 4 + u;
            const float sj = SCORE[q * 33 + j];
            int rank = 0;
#pragma unroll 8
            for (int i = 0; i < 32; ++i) {
                const float si = SCORE[q * 33 + i];
                rank += ((si > sj) || (si == sj && i < j)) ? 1 : 0;
            }
            if (j <= cur && rank < 16) bits |= 1u << j;
        }
        atomicOr(&SELM[q], bits);
        atomicOr(&SELM[32], bits);
        __syncthreads();
    }
    unsigned selm[2];
    selm[0] = SELM[fr];
    selm[1] = SELM[16 + fr];
    const unsigned um = SELM[32];
    __syncthreads();
#pragma unroll 1
    for (int br = 0; br < 2; ++br) {
        const int wlo = (q0 - 511) > 0 ? ((q0 - 511) >> 6) : 0;
        const unsigned wmask = ((2u << cur) - 1u) & ~((1u << wlo) - 1u);
        float gs[2];
#pragma unroll
        for (int qt = 0; qt < 2; ++qt) gs[qt] = fsigmoid(bf2f(HB[(size_t)(b * S_ + qpos[qt]) * INC + C_GATE + h * 3 + 1 + br]));
        if (fake != 2) nsa_branch(fake, br, q0, wsb, lds, b, g, br ? wmask : um, qf, qpos, selm, gs, fin, tid);
    }
    bf16_t* OM = (bf16_t*)(wsb + WS_OM);
#pragma unroll
    for (int qt = 0; qt < 2; ++qt)
#pragma unroll
        for (int dt = 0; dt < 4; ++dt) {
            uint2 u2;
            u2.x = pk_bf16(fin[dt][qt][0], fin[dt][qt][1]);
            u2.y = pk_bf16(fin[dt][qt][2], fin[dt][qt][3]);
            *(uint2*)(OM + (size_t)(b * S_ + qpos[qt]) * 1024 + h * 64 + dt * 16 + fq * 4) = u2;
        }
}

DEV void hgrn_prep_item(const P& p, int item, float* smem) {
    const int c = item & 31, bh = item >> 5, hh = bh & 3, b = bh >> 2;
    const int tid = threadIdx.x, d = tid & 127, th = tid >> 7;
    const bf16_t* HB = (const bf16_t*)(p.ws + WS_HB);
    unsigned char* hs = (unsigned char*)p.out;
    bf16_t* QT = (bf16_t*)(hs + HS_QT);
    bf16_t* KT = (bf16_t*)(hs + HS_KT);
    bf16_t* KHT = (bf16_t*)(hs + HS_KHT);
    bf16_t* VIT = (bf16_t*)(hs + HS_VIT);
    float lbv;
    {
        const float l0 = p.lb_logits[hh * 128 + d], l1 = p.lb_logits[512 + hh * 128 + d];
        const float mx = fmaxf(l0, l1);
        const float e0 = expf(l0 - mx), e1 = expf(l1 - mx);
        lbv = e0 / (e0 + e1);
    }
    const size_t trow0 = (size_t)b * S_ + c * 64 + th * 32;
    float kk[32], bl[32];
    float run = 0.f;
#pragma unroll
    for (int i = 0; i < 32; ++i) {
        const float fl = bf2f(HB[(trow0 + i) * INC + C_HF + hh * 128 + d]);
        const float f = lbv + (1.f - lbv) * fsigmoid(fl);
        kk[i] = 1.f - f;
        run += __logf(f);
        bl[i] = run;
    }
    smem[th * 128 + d] = run;
    __syncthreads();
    const float off = th ? smem[d] : 0.f;
    const float blast = smem[d] + smem[128 + d];
    unsigned kh[16], vi[16];
#pragma unroll
    for (int i = 0; i < 32; i += 2) {
        float qv[2], kt[2], khv[2], vv[2];
#pragma unroll
        for (int u = 0; u < 2; ++u) {
            const float bb = bl[i + u] + off;
            const size_t tr = trow0 + i + u;
            const float q = bf2f(HB[tr * INC + C_HQ + hh * 128 + d]);
            vv[u] = bf2f(HB[tr * INC + C_HI + hh * 128 + d]);
            qv[u] = q * __expf(bb);
            kt[u] = kk[i + u] * __expf(fminf(-bb, 80.f));
            khv[u] = kk[i + u] * __expf(blast - bb);
            const size_t o = ((size_t)bh * 2048 + c * 64 + th * 32 + i + u) * 128 + d;
            QT[o] = f2bf(qv[u]);
            KT[o] = f2bf(kt[u]);
        }
        kh[i >> 1] = pk_bf16(khv[0], khv[1]);
        vi[i >> 1] = pk_bf16(vv[0], vv[1]);
    }
    {
        const size_t o = ((size_t)bh * 128 + d) * 2048 + c * 64 + th * 32;
#pragma unroll
        for (int j = 0; j < 4; ++j) {
            u32x4 a, bq;
            a[0] = kh[4 * j]; a[1] = kh[4 * j + 1]; a[2] = kh[4 * j + 2]; a[3] = kh[4 * j + 3];
            bq[0] = vi[4 * j]; bq[1] = vi[4 * j + 1]; bq[2] = vi[4 * j + 2]; bq[3] = vi[4 * j + 3];
            *(u32x4*)(KHT + o + j * 8) = a;
            *(u32x4*)(VIT + o + j * 8) = bq;
        }
    }
    if (th == 0) ((float*)(p.ws + WS_EB))[((size_t)bh * 32 + c) * 128 + d] = expf(blast);
    __syncthreads();
}

DEV bf16x8 ld2x8(const bf16_t* p0, const bf16_t* p1) {
    const uint2 lo = *(const uint2*)p0, hi = *(const uint2*)p1;
    u32x4 v;
    v[0] = lo.x; v[1] = lo.y; v[2] = hi.x; v[3] = hi.y;
    return __builtin_bit_cast(bf16x8, v);
}
struct HgRegs { u32x4 a[4], b[4]; };
DEV void hg_loadA(HgRegs& r, const bf16_t* KT, const bf16_t* QT, int s0, int tid) {
    const unsigned off = (unsigned)(((tid >> 4) * 128 + (tid & 15) * 8) * 2);
    const char* kb = (const char*)(KT + (size_t)s0 * 128);
    const char* qb = (const char*)(QT + (size_t)s0 * 128);
#pragma unroll
    for (int i = 0; i < 4; ++i) {
        r.a[i] = *(const u32x4*)(kb + i * 4096 + off);
        r.b[i] = *(const u32x4*)(qb + i * 4096 + off);
    }
}
DEV void hg_storeA(const HgRegs& r, unsigned char* lds, int tid) {
    const int c16 = tid & 15, r16 = tid >> 4;
    const int o16 = r16 * 256 + ((c16 ^ (r16 & 15)) << 4);
#pragma unroll
    for (int i = 0; i < 4; ++i) {
        *(u32x4*)(lds + o16 + i * 4096) = r.a[i];
        *(u32x4*)(lds + 16384 + o16 + i * 4096) = r.b[i];
    }
}
DEV void hg_loadB(HgRegs& r, const bf16_t* KHT, const bf16_t* VIT, int s0, int tid) {
    const unsigned off = (unsigned)(((tid >> 3) * 2048 + (tid & 7) * 8) * 2);
    const char* kb = (const char*)(KHT + s0);
    const char* vb = (const char*)(VIT + s0);
#pragma unroll
    for (int i = 0; i < 4; ++i) {
        r.a[i] = *(const u32x4*)(kb + (size_t)i * 131072 + off);
        r.b[i] = *(const u32x4*)(vb + (size_t)i * 131072 + off);
    }
}
DEV void hg_storeB(const HgRegs& r, unsigned char* lds, int tid) {
    const int c8 = tid & 7, r8 = tid >> 3;
    const int o8 = r8 * 128 + ((c8 ^ ((r8 >> 1) & 7)) << 4);
#pragma unroll
    for (int i = 0; i < 4; ++i) {
        *(u32x4*)(lds + 32768 + o8 + i * 4096) = r.a[i];
        *(u32x4*)(lds + 49152 + o8 + i * 4096) = r.b[i];
    }
}
DEV void hgrn_chain_item(const P& p, int bh, unsigned char* lds) {
    const int hh = bh & 3, b = bh >> 2;
    int tid = threadIdx.x;
    asm volatile("" : "+v"(tid));
    const int lane = tid & 63, wid = tid >> 6, fr = lane & 15, fq = lane >> 4;
    const unsigned char* hs = (const unsigned char*)p.out;
    const bf16_t* QT = (const bf16_t*)(hs + HS_QT) + (size_t)bh * 2048 * 128;
    const bf16_t* KT = (const bf16_t*)(hs + HS_KT) + (size_t)bh * 2048 * 128;
    const bf16_t* KHT = (const bf16_t*)(hs + HS_KHT) + (size_t)bh * 128 * 2048;
    const bf16_t* VIT = (const bf16_t*)(hs + HS_VIT) + (size_t)bh * 128 * 2048;
    const float* EB = (const float*)(p.ws + WS_EB) + (size_t)bh * 32 * 128;
    const bf16_t* HB = (const bf16_t*)(p.ws + WS_HB);
    bf16_t* OM = (bf16_t*)(p.ws + WS_OM);
    const unsigned char* sKT = lds;
    const unsigned char* sQT = lds + 16384;
    const unsigned char* sKH = lds + 32768;
    const unsigned char* sVI = lds + 49152;
    bf16_t* AT = (bf16_t*)lds;
    float* SS = (float*)(lds + 65536);
    f32x4 S[8][2];
#pragma unroll
    for (int i = 0; i < 8; ++i)
#pragma unroll
        for (int j = 0; j < 2; ++j) S[i][j] = (f32x4){0.f, 0.f, 0.f, 0.f};
    const int dv0 = wid * 32;
    const int sw8 = (fr >> 1) & 7;
    int b256[4];
#pragma unroll
    for (int ks = 0; ks < 4; ++ks) b256[ks] = fr * 256 + (((4 * ks + fq) ^ fr) << 4);
    int p256[4][2];
#pragma unroll
    for (int u = 0; u < 4; ++u)
#pragma unroll
        for (int h = 0; h < 2; ++h) p256[u][h] = fr * 256 + (((4 * u + 2 * h + (fq >> 1)) ^ fr) << 4) + 8 * (fq & 1);
    int b128[2];
#pragma unroll
    for (int ks = 0; ks < 2; ++ks) b128[ks] = fr * 128 + (((4 * ks + fq) ^ sw8) << 4);
    {
        HgRegs r;
        hg_loadA(r, KT, QT, 0, tid);
        hg_storeA(r, lds, tid);
        hg_loadB(r, KHT, VIT, 0, tid);
        hg_storeB(r, lds, tid);
    }
    __syncthreads();
#pragma unroll 1
    for (int c = 0; c < 32; ++c) {
        const int s0 = c * 64;
        HgRegs nx;
        if (c + 1 < 32) hg_loadA(nx, KT, QT, s0 + 64, tid);
        uint2 atp[4];
        {
            bf16x8 qf[4];
#pragma unroll
            for (int ks = 0; ks < 4; ++ks) qf[ks] = *(const bf16x8*)(sQT + wid * 4096 + b256[ks]);
#pragma unroll
            for (int st = 0; st < 4; ++st) {
                f32x4 a = (f32x4){0.f, 0.f, 0.f, 0.f};
#pragma unroll
                for (int ks = 0; ks < 4; ++ks) {
                    const bf16x8 kf = *(const bf16x8*)(sKT + st * 4096 + b256[ks]);
                    a = __builtin_amdgcn_mfma_f32_16x16x32_bf16(kf, qf[ks], a, 0, 0, 0);
                }
                const int t = wid * 16 + fr;
                float av[4];
#pragma unroll
                for (int i = 0; i < 4; ++i) av[i] = (st * 16 + fq * 4 + i <= t) ? a[i] : 0.f;
                atp[st].x = pk_bf16(av[0], av[1]);
                atp[st].y = pk_bf16(av[2], av[3]);
            }
        }
        __syncthreads();
#pragma unroll
        for (int st = 0; st < 4; ++st) *(uint2*)(AT + (wid * 16 + fr) * 72 + st * 16 + fq * 4) = atp[st];
        __syncthreads();
        f32x4 o[2][4];
#pragma unroll
        for (int i = 0; i < 2; ++i)
#pragma unroll
            for (int j = 0; j < 4; ++j) o[i][j] = (f32x4){0.f, 0.f, 0.f, 0.f};
        bf16x8 vf[2][2];
#pragma unroll
        for (int dvt = 0; dvt < 2; ++dvt)
#pragma unroll
            for (int ks = 0; ks < 2; ++ks) vf[dvt][ks] = *(const bf16x8*)(sVI + wid * 4096 + dvt * 2048 + b128[ks]);
#pragma unroll
        for (int ks = 0; ks < 2; ++ks)
#pragma unroll
            for (int tt = 0; tt < 4; ++tt) {
                const bf16x8 af = *(const bf16x8*)(AT + (tt * 16 + fr) * 72 + ks * 32 + fq * 8);
#pragma unroll
                for (int dvt = 0; dvt < 2; ++dvt) o[dvt][tt] = __builtin_amdgcn_mfma_f32_16x16x32_bf16(vf[dvt][ks], af, o[dvt][tt], 0, 0, 0);
            }
#pragma unroll
        for (int u = 0; u < 4; ++u) {
            bf16x8 sf[2];
#pragma unroll
            for (int dvt = 0; dvt < 2; ++dvt) {
                u32x4 w;
                w[0] = pk_bf16(S[2 * u][dvt][0], S[2 * u][dvt][1]);
                w[1] = pk_bf16(S[2 * u][dvt][2], S[2 * u][dvt][3]);
                w[2] = pk_bf16(S[2 * u + 1][dvt][0], S[2 * u + 1][dvt][1]);
                w[3] = pk_bf16(S[2 * u + 1][dvt][2], S[2 * u + 1][dvt][3]);
                sf[dvt] = __builtin_bit_cast(bf16x8, w);
            }
#pragma unroll
            for (int tt = 0; tt < 4; ++tt) {
                const uint2 lo = *(const uint2*)(sQT + tt * 4096 + p256[u][0]);
                const uint2 hi = *(const uint2*)(sQT + tt * 4096 + p256[u][1]);
                u32x4 w;
                w[0] = lo.x; w[1] = lo.y; w[2] = hi.x; w[3] = hi.y;
                const bf16x8 qf2 = __builtin_bit_cast(bf16x8, w);
#pragma unroll
                for (int dvt = 0; dvt < 2; ++dvt) o[dvt][tt] = __builtin_amdgcn_mfma_f32_16x16x32_bf16(sf[dvt], qf2, o[dvt][tt], 0, 0, 0);
            }
        }
        u32x4 op[4];
#pragma unroll
        for (int tt = 0; tt < 4; ++tt) {
            float ss = 0.f;
#pragma unroll
            for (int dvt = 0; dvt < 2; ++dvt)
#pragma unroll
                for (int i = 0; i < 4; ++i) ss += o[dvt][tt][i] * o[dvt][tt][i];
            ss = xsum4(ss);
            if (fq == 0) SS[wid * 64 + tt * 16 + fr] = ss;
            op[tt][0] = pk_bf16(o[0][tt][0], o[0][tt][1]);
            op[tt][1] = pk_bf16(o[0][tt][2], o[0][tt][3]);
            op[tt][2] = pk_bf16(o[1][tt][0], o[1][tt][1]);
            op[tt][3] = pk_bf16(o[1][tt][2], o[1][tt][3]);
        }
        __syncthreads();
        if (c + 1 < 32) { hg_storeA(nx, lds, tid); hg_loadB(nx, KHT, VIT, s0 + 64, tid); }
        uint2 gg[4][2];
#pragma unroll
        for (int tt = 0; tt < 4; ++tt)
#pragma unroll
            for (int dvt = 0; dvt < 2; ++dvt)
                gg[tt][dvt] = *(const uint2*)(HB + ((size_t)b * S_ + s0 + tt * 16 + fr) * INC + C_HG + hh * 128 + dv0 + dvt * 16 + fq * 4);
        {
            bf16x8 vf3[2][2];
#pragma unroll
            for (int dvt = 0; dvt < 2; ++dvt)
#pragma unroll
                for (int ks = 0; ks < 2; ++ks) vf3[dvt][ks] = *(const bf16x8*)(sVI + wid * 4096 + dvt * 2048 + b128[ks]);
#pragma unroll
            for (int dkt = 0; dkt < 8; ++dkt) {
                const float4 eb = *(const float4*)(EB + c * 128 + dkt * 16 + fq * 4);
                bf16x8 kf[2];
#pragma unroll
                for (int ks = 0; ks < 2; ++ks) kf[ks] = *(const bf16x8*)(sKH + dkt * 2048 + b128[ks]);
#pragma unroll
                for (int dvt = 0; dvt < 2; ++dvt) {
                    f32x4 a = S[dkt][dvt];
                    a[0] *= eb.x; a[1] *= eb.y; a[2] *= eb.z; a[3] *= eb.w;
                    a = __builtin_amdgcn_mfma_f32_16x16x32_bf16(kf[0], vf3[dvt][0], a, 0, 0, 0);
                    a = __builtin_amdgcn_mfma_f32_16x16x32_bf16(kf[1], vf3[dvt][1], a, 0, 0, 0);
                    S[dkt][dvt] = a;
                }
            }
        }
        __syncthreads();
        if (c + 1 < 32) hg_storeB(nx, lds, tid);
#pragma unroll
        for (int tt = 0; tt < 4; ++tt) {
            const int t = tt * 16 + fr;
            const float tot = SS[t] + SS[64 + t] + SS[128 + t] + SS[192 + t];
            const float rs = rsqrtf(tot * (1.f / 128.f) + LN_EPS);
            const size_t tg = (size_t)b * S_ + s0 + t;
#pragma unroll
            for (int dvt = 0; dvt < 2; ++dvt) {
                const int dv = dv0 + dvt * 16 + fq * 4;
                const float g0 = bflo(gg[tt][dvt].x), g1 = bfhi(gg[tt][dvt].x), g2 = bflo(gg[tt][dvt].y), g3 = bfhi(gg[tt][dvt].y);
                const float4 nwv = *(const float4*)(p.hg_norm_w + hh * 128 + dv);
                const unsigned w0 = op[tt][2 * dvt], w1 = op[tt][2 * dvt + 1];
                const float r0 = bflo(w0) * rs * nwv.x * (g0 * fsigmoid(g0));
                const float r1 = bfhi(w0) * rs * nwv.y * (g1 * fsigmoid(g1));
                const float r2 = bflo(w1) * rs * nwv.z * (g2 * fsigmoid(g2));
                const float r3 = bfhi(w1) * rs * nwv.w * (g3 * fsigmoid(g3));
                uint2 u2;
                u2.x = pk_bf16(r0, r1);
                u2.y = pk_bf16(r2, r3);
                *(uint2*)(OM + tg * 1024 + 512 + hh * 128 + dv) = u2;
            }
        }
        __syncthreads();
    }
}


DEV void hgrn_prep_item2(const P& p, int item, unsigned char* lds) {
    const int c = item & 31, bh = item >> 5, hh = bh & 3, b = bh >> 2;
    int tid = threadIdx.x;
    asm volatile("" : "+v"(tid));
    const int d = tid & 127, th = tid >> 7;
    const int lane = tid & 63, wid = tid >> 6, fr = lane & 15, fq = lane >> 4;
    const bf16_t* HB = (const bf16_t*)(p.ws + WS_HB);
    unsigned char* hs = (unsigned char*)p.out;
    bf16_t* QTg = (bf16_t*)(hs + HS_QT);
    bf16_t* OIg = (bf16_t*)(hs + HS_OI);
    uint2* DSg = (uint2*)(hs + HS_DS);
    float* tots = (float*)(lds + 65536);
    unsigned char* sKT = lds;
    unsigned char* sQT = lds + 16384;
    unsigned char* sKH = lds + 32768;
    unsigned char* sVI = lds + 49152;
    float lbv;
    {
        const float l0 = p.lb_logits[hh * 128 + d], l1 = p.lb_logits[512 + hh * 128 + d];
        const float mx = fmaxf(l0, l1);
        const float e0 = expf(l0 - mx), e1 = expf(l1 - mx);
        lbv = e0 / (e0 + e1);
    }
    const size_t trow0 = (size_t)b * S_ + c * 64 + th * 32;
    const float nwd = p.hg_norm_w[hh * 128 + d];
    float bl[32];
    float run = 0.f;
#pragma unroll
    for (int i = 0; i < 32; ++i) {
        const float fl = bf2f(HB[(trow0 + i) * INC + C_HF + hh * 128 + d]);
        const float f = lbv + (1.f - lbv) * fsigmoid(fl);
        run += __logf(f);
        bl[i] = run;
    }
    tots[th * 128 + d] = run;
    __syncthreads();
    const float off = th ? tots[d] : 0.f;
    const float blast = tots[d] + tots[128 + d];
#pragma unroll
    for (int j = 0; j < 4; ++j) {
        u32x4 a, bq;
#pragma unroll
        for (int i2 = 0; i2 < 4; ++i2) {
            float khv[2], vv[2];
#pragma unroll
            for (int u = 0; u < 2; ++u) {
                const int i = j * 8 + i2 * 2 + u;
                const float bb = bl[i] + off;
                const float kki = 1.f - __expf(bl[i] - (i ? bl[i > 0 ? i - 1 : 0] : 0.f));
                const size_t tr = trow0 + i;
                const float q = bf2f(HB[tr * INC + C_HQ + hh * 128 + d]);
                vv[u] = bf2f(HB[tr * INC + C_HI + hh * 128 + d]);
                const bf16_t qv = f2bf(q * __expf(bb));
                const bf16_t kt = f2bf(kki * __expf(fminf(-bb, 80.f)));
                khv[u] = kki * __expf(blast - bb);
                const int t = th * 32 + i;
                QTg[((size_t)bh * 2048 + c * 64 + t) * 128 + d] = qv;
                {
                    const float gv = bf2f(HB[tr * INC + C_HG + hh * 128 + d]);
                    ((bf16_t*)(p.ws + WS_XB))[((size_t)bh * 2048 + c * 64 + t) * 128 + d] = f2bf(nwd * gv * fsigmoid(gv));
                }
                const int off256 = t * 256 + ((((d >> 3) ^ (t & 15))) << 4) + (d & 7) * 2;
                *(bf16_t*)(sQT + off256) = qv;
                *(bf16_t*)(sKT + off256) = kt;
            }
            a[i2] = pk_bf16(khv[0], khv[1]);
            bq[i2] = pk_bf16(vv[0], vv[1]);
        }
        const int off128 = d * 128 + (((th * 4 + j) ^ ((d >> 1) & 7)) << 4);
        *(u32x4*)(sKH + off128) = a;
        *(u32x4*)(sVI + off128) = bq;
    }
    if (th == 0) ((float*)(p.ws + WS_EB))[((size_t)bh * 32 + c) * 128 + d] = __expf(blast);
    __syncthreads();
    const int sw8 = (fr >> 1) & 7;
    int b256[4];
#pragma unroll
    for (int ks = 0; ks < 4; ++ks) b256[ks] = fr * 256 + (((4 * ks + fq) ^ fr) << 4);
    int b128[2];
#pragma unroll
    for (int ks = 0; ks < 2; ++ks) b128[ks] = fr * 128 + (((4 * ks + fq) ^ sw8) << 4);
    uint2 atp[4];
    {
        bf16x8 qf[4];
#pragma unroll
        for (int ks = 0; ks < 4; ++ks) qf[ks] = *(const bf16x8*)(sQT + wid * 4096 + b256[ks]);
#pragma unroll
        for (int st = 0; st < 4; ++st) {
            f32x4 a = (f32x4){0.f, 0.f, 0.f, 0.f};
#pragma unroll
            for (int ks = 0; ks < 4; ++ks) {
                const bf16x8 kf = *(const bf16x8*)(sKT + st * 4096 + b256[ks]);
                a = __builtin_amdgcn_mfma_f32_16x16x32_bf16(kf, qf[ks], a, 0, 0, 0);
            }
            const int t = wid * 16 + fr;
            float av[4];
#pragma unroll
            for (int i = 0; i < 4; ++i) av[i] = (st * 16 + fq * 4 + i <= t) ? a[i] : 0.f;
            atp[st].x = pk_bf16(av[0], av[1]);
            atp[st].y = pk_bf16(av[2], av[3]);
        }
    }
    __syncthreads();
    bf16_t* AT = (bf16_t*)lds;
#pragma unroll
    for (int st = 0; st < 4; ++st) *(uint2*)(AT + (wid * 16 + fr) * 72 + st * 16 + fq * 4) = atp[st];
    __syncthreads();
    const int dv0 = wid * 32;
    bf16x8 vf[2][2];
#pragma unroll
    for (int dvt = 0; dvt < 2; ++dvt)
#pragma unroll
        for (int ks = 0; ks < 2; ++ks) vf[dvt][ks] = *(const bf16x8*)(sVI + wid * 4096 + dvt * 2048 + b128[ks]);
#pragma unroll
    for (int tt = 0; tt < 4; ++tt) {
        f32x4 o0 = (f32x4){0.f, 0.f, 0.f, 0.f}, o1 = (f32x4){0.f, 0.f, 0.f, 0.f};
#pragma unroll
        for (int ks = 0; ks < 2; ++ks) {
            const bf16x8 af = *(const bf16x8*)(AT + (tt * 16 + fr) * 72 + ks * 32 + fq * 8);
            o0 = __builtin_amdgcn_mfma_f32_16x16x32_bf16(vf[0][ks], af, o0, 0, 0, 0);
            o1 = __builtin_amdgcn_mfma_f32_16x16x32_bf16(vf[1][ks], af, o1, 0, 0, 0);
        }
        bf16_t* op = OIg + ((size_t)bh * 2048 + c * 64 + tt * 16 + fr) * 128 + dv0 + fq * 4;
        *(uint2*)op = make_uint2(pk_bf16(o0[0], o0[1]), pk_bf16(o0[2], o0[3]));
        *(uint2*)(op + 16) = make_uint2(pk_bf16(o1[0], o1[1]), pk_bf16(o1[2], o1[3]));
    }
    uint2* dsp = DSg + ((((size_t)bh * 32 + c) * 4 + wid) * 16) * 64 + lane;
#pragma unroll
    for (int dkt = 0; dkt < 8; ++dkt) {
        bf16x8 kf[2];
#pragma unroll
        for (int ks = 0; ks < 2; ++ks) kf[ks] = *(const bf16x8*)(sKH + dkt * 2048 + b128[ks]);
#pragma unroll
        for (int dvt = 0; dvt < 2; ++dvt) {
            f32x4 a = (f32x4){0.f, 0.f, 0.f, 0.f};
            a = __builtin_amdgcn_mfma_f32_16x16x32_bf16(kf[0], vf[dvt][0], a, 0, 0, 0);
            a = __builtin_amdgcn_mfma_f32_16x16x32_bf16(kf[1], vf[dvt][1], a, 0, 0, 0);
            dsp[(dkt * 2 + dvt) * 64] = make_uint2(pk_bf16(a[0], a[1]), pk_bf16(a[2], a[3]));
        }
    }
    __syncthreads();
}

DEV void hgrn_chain_item2(const P& p, int bh, unsigned char* lds) {
    const int hh = bh & 3, b = bh >> 2;
    int tid = threadIdx.x;
    asm volatile("" : "+v"(tid));
    const int lane = tid & 63, wid = __builtin_amdgcn_readfirstlane(tid >> 6), fr = lane & 15, fq = lane >> 4;
    const unsigned char* hs = (const unsigned char*)p.out;
    const bf16_t* QTg = (const bf16_t*)(hs + HS_QT) + (size_t)bh * 2048 * 128;
    const char* OIb = (const char*)(hs + HS_OI) + ((size_t)bh * 2048 * 128 + wid * 32) * 2;
    const unsigned oioff = (unsigned)((fr * 128 + fq * 4) * 2);
    const char* DSb = (const char*)(hs + HS_DS) + (((size_t)bh * 32 * 4 + wid) * 16 * 64) * 8;
    const unsigned dsoff = (unsigned)(lane * 8);
    const char* GGb = (const char*)(p.ws + WS_XB) + ((size_t)bh * 2048 * 128 + wid * 32) * 2;
    const unsigned ggoff = oioff;
    const float* EB = (const float*)(p.ws + WS_EB) + (size_t)bh * 32 * 128;
    bf16_t* OM = (bf16_t*)(p.ws + WS_OM);
    float* EBL = (float*)(lds + 16384);
    float* SS = (float*)(lds + 16896);
    const int dv0 = wid * 32;
    int p256[4][2];
#pragma unroll
    for (int u = 0; u < 4; ++u)
#pragma unroll
        for (int h = 0; h < 2; ++h) p256[u][h] = fr * 256 + (((4 * u + 2 * h + (fq >> 1)) ^ fr) << 4) + 8 * (fq & 1);
    const int c16 = tid & 15, r16 = tid >> 4;
    const int o16 = r16 * 256 + ((c16 ^ (r16 & 15)) << 4);
    const unsigned qoff = (unsigned)((r16 * 128 + c16 * 8) * 2);
    f32x4 S[2][2];
    f32x4* SL = (f32x4*)(lds + 17920) + wid * 768 + lane;
#pragma unroll
    for (int i = 0; i < 2; ++i)
#pragma unroll
        for (int j = 0; j < 2; ++j) S[i][j] = (f32x4){0.f, 0.f, 0.f, 0.f};
#pragma unroll
    for (int i = 0; i < 12; ++i) SL[i * 64] = (f32x4){0.f, 0.f, 0.f, 0.f};
    uint2 oi[4][2], dsr[8][2];
    {
        const char* qb = (const char*)QTg;
#pragma unroll
        for (int i = 0; i < 4; ++i) *(u32x4*)(lds + o16 + i * 4096) = *(const u32x4*)(qb + i * 4096 + qoff);
        if (tid < 32) *(u32x4*)(EBL + tid * 4) = *(const u32x4*)(EB + tid * 4);
#pragma unroll
        for (int tt = 0; tt < 4; ++tt)
#pragma unroll
            for (int dvt = 0; dvt < 2; ++dvt) {
                oi[tt][dvt] = *(const uint2*)(OIb + tt * 4096 + dvt * 32 + oioff);
            }
#pragma unroll
        for (int dkt = 0; dkt < 8; ++dkt)
#pragma unroll
            for (int dvt = 0; dvt < 2; ++dvt) dsr[dkt][dvt] = *(const uint2*)(DSb + (dkt * 2 + dvt) * 512 + dsoff);
    }
    __syncthreads();
#pragma unroll 1
    for (int c = 0; c < 32; ++c) {
        const int s0 = c * 64;
        const bool more = c + 1 < 32;
        uint2 gg[4][2];
#pragma unroll
        for (int tt = 0; tt < 4; ++tt)
#pragma unroll
            for (int dvt = 0; dvt < 2; ++dvt) gg[tt][dvt] = *(const uint2*)(GGb + (size_t)s0 * 256 + tt * 4096 + dvt * 32 + ggoff);
        f32x4 o[2][4];
#pragma unroll
        for (int tt = 0; tt < 4; ++tt)
#pragma unroll
            for (int dvt = 0; dvt < 2; ++dvt) {
                o[dvt][tt] = (f32x4){bflo(oi[tt][dvt].x), bfhi(oi[tt][dvt].x), bflo(oi[tt][dvt].y), bfhi(oi[tt][dvt].y)};
                if (more) oi[tt][dvt] = *(const uint2*)(OIb + (size_t)(s0 + 64) * 256 + tt * 4096 + dvt * 32 + oioff);
            }
        const unsigned char* sQ = lds;
#pragma unroll
        for (int u = 0; u < 4; ++u) {
            bf16x8 sf[2];
#pragma unroll
            for (int dvt = 0; dvt < 2; ++dvt) {
                const f32x4 sa = u < 1 ? S[0][dvt] : SL[((2 * u - 2) * 2 + dvt) * 64];
                const f32x4 sb = u < 1 ? S[1][dvt] : SL[((2 * u - 1) * 2 + dvt) * 64];
                u32x4 w;
                w[0] = pk_bf16(sa[0], sa[1]);
                w[1] = pk_bf16(sa[2], sa[3]);
                w[2] = pk_bf16(sb[0], sb[1]);
                w[3] = pk_bf16(sb[2], sb[3]);
                sf[dvt] = __builtin_bit_cast(bf16x8, w);
            }
#pragma unroll
            for (int tt = 0; tt < 4; ++tt) {
                const uint2 lo = *(const uint2*)(sQ + tt * 4096 + p256[u][0]);
                const uint2 hi = *(const uint2*)(sQ + tt * 4096 + p256[u][1]);
                u32x4 w;
                w[0] = lo.x; w[1] = lo.y; w[2] = hi.x; w[3] = hi.y;
                const bf16x8 qf2 = __builtin_bit_cast(bf16x8, w);
#pragma unroll
                for (int dvt = 0; dvt < 2; ++dvt) o[dvt][tt] = __builtin_amdgcn_mfma_f32_16x16x32_bf16(sf[dvt], qf2, o[dvt][tt], 0, 0, 0);
            }
        }
        u32x4 qn[4], ebn;
        if (more) {
            const char* qb = (const char*)(QTg + (size_t)(s0 + 64) * 128);
#pragma unroll
            for (int i = 0; i < 4; ++i) qn[i] = *(const u32x4*)(qb + i * 4096 + qoff);
            if (tid < 32) ebn = *(const u32x4*)(EB + (c + 1) * 128 + tid * 4);
        }
#pragma unroll
        for (int dkt = 0; dkt < 8; ++dkt) {
            const float4 eb = *(const float4*)(EBL + dkt * 16 + fq * 4);
#pragma unroll
            for (int dvt = 0; dvt < 2; ++dvt) {
                const uint2 dd = dsr[dkt][dvt];
                f32x4 sv = dkt < 2 ? S[dkt < 2 ? dkt : 0][dvt] : SL[((dkt - 2) * 2 + dvt) * 64];
                sv[0] = fmaf(sv[0], eb.x, bflo(dd.x));
                sv[1] = fmaf(sv[1], eb.y, bfhi(dd.x));
                sv[2] = fmaf(sv[2], eb.z, bflo(dd.y));
                sv[3] = fmaf(sv[3], eb.w, bfhi(dd.y));
                if (dkt < 2) S[dkt < 2 ? dkt : 0][dvt] = sv; else SL[((dkt - 2) * 2 + dvt) * 64] = sv;
                if (more) dsr[dkt][dvt] = *(const uint2*)(DSb + (size_t)(c + 1) * 32768 + (dkt * 2 + dvt) * 512 + dsoff);
            }
        }
#pragma unroll
        for (int tt = 0; tt < 4; ++tt) {
            float ss = 0.f;
#pragma unroll
            for (int dvt = 0; dvt < 2; ++dvt)
#pragma unroll
                for (int i = 0; i < 4; ++i) ss += o[dvt][tt][i] * o[dvt][tt][i];
            ss = xsum4(ss);
            if (fq == 0) SS[wid * 64 + tt * 16 + fr] = ss;
        }
        __syncthreads();
#pragma unroll
        for (int tt = 0; tt < 4; ++tt) {
            const int t = tt * 16 + fr;
            const float tot = SS[t] + SS[64 + t] + SS[128 + t] + SS[192 + t];
            const float rs = rsqrtf(tot * (1.f / 128.f) + LN_EPS);
            const size_t tg = (size_t)b * S_ + s0 + t;
#pragma unroll
            for (int dvt = 0; dvt < 2; ++dvt) {
                const int dv = dv0 + dvt * 16 + fq * 4;
                const float r0 = o[dvt][tt][0] * rs * bflo(gg[tt][dvt].x);
                const float r1 = o[dvt][tt][1] * rs * bfhi(gg[tt][dvt].x);
                const float r2 = o[dvt][tt][2] * rs * bflo(gg[tt][dvt].y);
                const float r3 = o[dvt][tt][3] * rs * bfhi(gg[tt][dvt].y);
                *(uint2*)(OM + tg * 1024 + 512 + hh * 128 + dv) = make_uint2(pk_bf16(r0, r1), pk_bf16(r2, r3));
            }
        }
        if (more) {
#pragma unroll
            for (int i = 0; i < 4; ++i) *(u32x4*)(lds + o16 + i * 4096) = qn[i];
            if (tid < 32) *(u32x4*)(EBL + tid * 4) = ebn;
        }
        __syncthreads();
    }
}

DEV void xattn_item2(const P& p, int item) {
    const int qt64 = item & 31, hh = (item >> 5) & 3, b = item >> 7;
    const int lane = threadIdx.x & 63, wid = threadIdx.x >> 6, fr = lane & 15, fq = lane >> 4;
    const bf16_t* QX = (const bf16_t*)(p.ws + WS_QX);
    const bf16_t* KVM = (const bf16_t*)(p.ws + WS_KVM);
    const bf16_t* VMT = (const bf16_t*)(p.ws + WS_VMT) + (size_t)(b * 4 + hh) * 256 * 256;
    bf16_t* OX = (bf16_t*)(p.ws + WS_OX);
    const size_t tq = (size_t)b * S_ + qt64 * 64 + wid * 16 + fr;
    bf16x8 qf[8];
#pragma unroll
    for (int ks = 0; ks < 8; ++ks) qf[ks] = *(const bf16x8*)(QX + tq * 1024 + hh * 256 + ks * 32 + fq * 8);
    f32x4 sc[16];
#pragma unroll
    for (int kt = 0; kt < 16; ++kt) {
        f32x4 a = (f32x4){0.f, 0.f, 0.f, 0.f};
        const bf16_t* kp = KVM + (size_t)(b * ML_ + kt * 16 + fr) * 2048 + hh * 256 + fq * 8;
#pragma unroll
        for (int ks = 0; ks < 8; ++ks) a = __builtin_amdgcn_mfma_f32_16x16x32_bf16(*(const bf16x8*)(kp + ks * 32), qf[ks], a, 0, 0, 0);
        sc[kt] = a;
    }
    float mx = -1e30f;
#pragma unroll
    for (int kt = 0; kt < 16; ++kt)
#pragma unroll
        for (int i = 0; i < 4; ++i) { sc[kt][i] *= 0.0625f; mx = fmaxf(mx, sc[kt][i]); }
    mx = xmax4(mx);
    float ps = 0.f;
#pragma unroll
    for (int kt = 0; kt < 16; ++kt)
#pragma unroll
        for (int i = 0; i < 4; ++i) { sc[kt][i] = __expf(sc[kt][i] - mx); ps += sc[kt][i]; }
    ps = xsum4(ps);
    const float inv = 1.f / ps;
    u32x4 pf[8];
#pragma unroll
    for (int s = 0; s < 8; ++s) {
        pf[s][0] = pk_bf16(sc[2 * s][0] * inv, sc[2 * s][1] * inv);
        pf[s][1] = pk_bf16(sc[2 * s][2] * inv, sc[2 * s][3] * inv);
        pf[s][2] = pk_bf16(sc[2 * s + 1][0] * inv, sc[2 * s + 1][1] * inv);
        pf[s][3] = pk_bf16(sc[2 * s + 1][2] * inv, sc[2 * s + 1][3] * inv);
    }
#pragma unroll 1
    for (int dh = 0; dh < 2; ++dh) {
        f32x4 o[8];
#pragma unroll
        for (int dt = 0; dt < 8; ++dt) o[dt] = (f32x4){0.f, 0.f, 0.f, 0.f};
#pragma unroll
        for (int s = 0; s < 8; ++s) {
#pragma unroll
            for (int dt = 0; dt < 8; ++dt) {
                const bf16_t* vp = VMT + (size_t)(dh * 128 + dt * 16 + fr) * 256 + 32 * s + 4 * fq;
                o[dt] = __builtin_amdgcn_mfma_f32_16x16x32_bf16(ld2x8(vp, vp + 16), __builtin_bit_cast(bf16x8, pf[s]), o[dt], 0, 0, 0);
            }
        }
#pragma unroll
        for (int dt = 0; dt < 8; ++dt) {
            uint2 u2;
            u2.x = pk_bf16(o[dt][0], o[dt][1]);
            u2.y = pk_bf16(o[dt][2], o[dt][3]);
            *(uint2*)(OX + tq * 1024 + hh * 256 + dh * 128 + dt * 16 + fq * 4) = u2;
        }
    }
}


struct XaRegs { u32x4 r[8]; };
DEV void xa_loadK(XaRegs& x, const bf16_t* kbase, int tid) {
    const int c = tid & 31, r0 = tid >> 5;
#pragma unroll
    for (int i = 0; i < 8; ++i) x.r[i] = *(const u32x4*)(kbase + (size_t)(r0 + 8 * i) * 2048 + c * 8);
}
DEV void xa_storeK(const XaRegs& x, unsigned char* lds, int tid) {
    const int c = tid & 31, r0 = tid >> 5;
#pragma unroll
    for (int i = 0; i < 8; ++i) {
        const int row = r0 + 8 * i;
        *(u32x4*)(lds + row * 512 + ((c ^ (row & 15)) << 4)) = x.r[i];
    }
}
DEV void xa_loadV(XaRegs& x, const bf16_t* vbase, int tid) {
    const int c = tid & 7, r0 = tid >> 3;
#pragma unroll
    for (int i = 0; i < 8; ++i) x.r[i] = *(const u32x4*)(vbase + (size_t)(r0 + 32 * i) * 256 + c * 8);
}
DEV void xa_storeV(const XaRegs& x, unsigned char* lds, int tid) {
    const int c = tid & 7, r0 = tid >> 3;
    const int o = r0 * 128 + ((c ^ ((r0 >> 1) & 7)) << 4);
#pragma unroll
    for (int i = 0; i < 8; ++i) *(u32x4*)(lds + 32768 + o + i * 4096) = x.r[i];
}
DEV void xattn_item3(const P& p, int item, unsigned char* lds) {
    const int qt64 = item & 31, hh = (item >> 5) & 3, b = item >> 7;
    int tid = threadIdx.x;
    asm volatile("" : "+v"(tid));
    const int lane = tid & 63, wid = tid >> 6, fr = lane & 15, fq = lane >> 4;
    const bf16_t* QX = (const bf16_t*)(p.ws + WS_QX);
    const bf16_t* KB = (const bf16_t*)(p.ws + WS_KVM) + (size_t)(b * ML_) * 2048 + hh * 256;
    const bf16_t* VB = (const bf16_t*)(p.ws + WS_VMT) + (size_t)(b * 4 + hh) * 256 * 256;
    bf16_t* OX = (bf16_t*)(p.ws + WS_OX);
    const size_t tq = (size_t)b * S_ + qt64 * 64 + wid * 16 + fr;
    bf16x8 qf[8];
#pragma unroll
    for (int ks = 0; ks < 8; ++ks) qf[ks] = *(const bf16x8*)(QX + tq * 1024 + hh * 256 + ks * 32 + fq * 8);
    f32x4 o[16];
#pragma unroll
    for (int dt = 0; dt < 16; ++dt) o[dt] = (f32x4){0.f, 0.f, 0.f, 0.f};
    float m = -1e30f, l = 0.f;
    {
        XaRegs x;
        xa_loadK(x, KB, tid);
        xa_storeK(x, lds, tid);
        xa_loadV(x, VB, tid);
        xa_storeV(x, lds, tid);
    }
    __syncthreads();
    const int sw8 = (fr >> 1) & 7;
#pragma unroll 1
    for (int j = 0; j < 4; ++j) {
        XaRegs nx;
        if (j + 1 < 4) xa_loadK(nx, KB + (size_t)(j + 1) * 64 * 2048, tid);
        f32x4 sc[4];
#pragma unroll
        for (int kt = 0; kt < 4; ++kt) {
            f32x4 a = (f32x4){0.f, 0.f, 0.f, 0.f};
            const unsigned char* rp = lds + (kt * 16 + fr) * 512;
#pragma unroll
            for (int ks = 0; ks < 8; ++ks) a = __builtin_amdgcn_mfma_f32_16x16x32_bf16(*(const bf16x8*)(rp + (((4 * ks + fq) ^ fr) << 4)), qf[ks], a, 0, 0, 0);
            sc[kt] = a;
        }
        __syncthreads();
        if (j + 1 < 4) { xa_storeK(nx, lds, tid); xa_loadV(nx, VB + (j + 1) * 64, tid); }
        float bm = -1e30f;
#pragma unroll
        for (int kt = 0; kt < 4; ++kt)
#pragma unroll
            for (int i = 0; i < 4; ++i) { sc[kt][i] *= 0.0625f; bm = fmaxf(bm, sc[kt][i]); }
        bm = xmax4(bm);
        const float mn = fmaxf(m, bm);
        const float alpha = __expf(m - mn);
        float ps = 0.f;
#pragma unroll
        for (int kt = 0; kt < 4; ++kt)
#pragma unroll
            for (int i = 0; i < 4; ++i) { sc[kt][i] = __expf(sc[kt][i] - mn); ps += sc[kt][i]; }
        l = l * alpha + ps;
        m = mn;
#pragma unroll
        for (int dt = 0; dt < 16; ++dt) o[dt] *= alpha;
#pragma unroll
        for (int s = 0; s < 2; ++s) {
            u32x4 w;
            w[0] = pk_bf16(sc[2 * s][0], sc[2 * s][1]);
            w[1] = pk_bf16(sc[2 * s][2], sc[2 * s][3]);
            w[2] = pk_bf16(sc[2 * s + 1][0], sc[2 * s + 1][1]);
            w[3] = pk_bf16(sc[2 * s + 1][2], sc[2 * s + 1][3]);
            const bf16x8 pf = __builtin_bit_cast(bf16x8, w);
#pragma unroll
            for (int dt = 0; dt < 16; ++dt) {
                const unsigned char* rp = lds + 32768 + (dt * 16 + fr) * 128 + 8 * (fq & 1);
                const uint2 lo = *(const uint2*)(rp + (((4 * s + (fq >> 1)) ^ sw8) << 4));
                const uint2 hi = *(const uint2*)(rp + (((4 * s + 2 + (fq >> 1)) ^ sw8) << 4));
                u32x4 vv;
                vv[0] = lo.x; vv[1] = lo.y; vv[2] = hi.x; vv[3] = hi.y;
                o[dt] = __builtin_amdgcn_mfma_f32_16x16x32_bf16(__builtin_bit_cast(bf16x8, vv), pf, o[dt], 0, 0, 0);
            }
        }
        __syncthreads();
        if (j + 1 < 4) xa_storeV(nx, lds, tid);
        __syncthreads();
    }
    const float inv = 1.f / xsum4(l);
#pragma unroll
    for (int dt = 0; dt < 16; ++dt) {
        uint2 u2;
        u2.x = pk_bf16(o[dt][0] * inv, o[dt][1] * inv);
        u2.y = pk_bf16(o[dt][2] * inv, o[dt][3] * inv);
        *(uint2*)(OX + tq * 1024 + hh * 256 + dt * 16 + fq * 4) = u2;
    }
}


DEV void peer_quant_row(const float* src, unsigned char* dst, float* scl, int row, int* rsum = nullptr, int bias = 128) {
    const int lane = threadIdx.x & 63;
    const float* r = src + (size_t)row * 1024 + lane * 16;
    float v[16];
#pragma unroll
    for (int i = 0; i < 4; ++i) {
        const float4 a = *(const float4*)(r + 4 * i);
        v[4 * i] = a.x; v[4 * i + 1] = a.y; v[4 * i + 2] = a.z; v[4 * i + 3] = a.w;
    }
    float mx = 0.f;
#pragma unroll
    for (int i = 0; i < 16; ++i) mx = fmaxf(mx, fabsf(v[i]));
    mx = wmax(mx);
    const float q = mx > 0.f ? 127.f / mx : 0.f;
    u32x4 w;
    int usum = 0;
#pragma unroll
    for (int i = 0; i < 4; ++i) {
        unsigned pk = 0u;
#pragma unroll
        for (int k = 0; k < 4; ++k) {
            int qi = (int)rintf(v[4 * i + k] * q);
            qi = qi < -127 ? -127 : (qi > 127 ? 127 : qi);
            pk |= (unsigned)((qi + bias) & 0xff) << (8 * k);
            usum += qi + 128;
        }
        w[i] = pk;
    }
    *(u32x4*)(dst + ((size_t)(lane >> 3) * 16384 + row) * 128 + (lane & 7) * 16) = w;
    if (rsum) {
#pragma unroll
        for (int o = 32; o > 0; o >>= 1) usum += __shfl_xor(usum, o);
        if (lane == 0) rsum[row] = usum;
    }
    if (lane == 0) scl[row] = mx * (1.f / 127.f);
}

DEV unsigned f2ord(float f) { const unsigned b = __float_as_uint(f); return b ^ ((b >> 31) ? 0xffffffffu : 0x80000000u); }
DEV float ord2f(unsigned o) { return __uint_as_float((o & 0x80000000u) ? (o ^ 0x80000000u) : ~o); }
DEV void ins16(unsigned (&v)[16], unsigned x) {
#pragma unroll
    for (int k = 0; k < 16; ++k) {
        const unsigned t = v[k] > x ? v[k] : x;
        x = v[k] > x ? x : v[k];
        v[k] = t;
    }
}
constexpr int PEER_SC = 0;
constexpr int PEER_LST = 0;
constexpr int PEER_EID = 16384;
constexpr int PEER_GATE = 16384 + 4096;
DEV void peer_route_item(const P& p, int item, unsigned char* lds) {
    const int tid = threadIdx.x, lane = tid & 63, wid = tid >> 6;
    const int t0 = item * 16;
    const bf16_t* QP = (const bf16_t*)(p.ws + WS_QP);
    const bf16_t* PK = (const bf16_t*)(p.ws + WS_PKEY);
    unsigned* SC = (unsigned*)(lds + PEER_SC);
    const int fr = lane & 15, fq = lane >> 4;
    unsigned lst[16];
#pragma unroll
    for (int k = 0; k < 16; ++k) lst[k] = 0u;
    bf16x8 qf[4][2];
#pragma unroll
    for (int ci = 0; ci < 4; ++ci)
#pragma unroll
        for (int ks = 0; ks < 2; ++ks)
            qf[ci][ks] = *(const bf16x8*)(QP + (size_t)(t0 + fr) * 1024 + (4 * wid + ci) * 64 + ks * 32 + fq * 8);
#pragma unroll 1
    for (int pass = 0; pass < 2; ++pass) {
#pragma unroll
        for (int ci = 0; ci < 4; ++ci) {
            const int cb = 4 * wid + ci;
#pragma unroll
            for (int kt = 0; kt < 4; ++kt) {
                f32x4 acc = (f32x4){0.f, 0.f, 0.f, 0.f};
#pragma unroll
                for (int ks = 0; ks < 2; ++ks) {
                    const bf16x8 kf = *(const bf16x8*)(PK + ((size_t)cb * 128 + pass * 64 + kt * 16 + fr) * 64 + ks * 32 + fq * 8);
                    acc = __builtin_amdgcn_mfma_f32_16x16x32_bf16(kf, qf[ci][ks], acc, 0, 0, 0);
                }
                unsigned* dst = SC + (cb * 16 + fr) * 65 + kt * 16 + fq * 4;
#pragma unroll
                for (int i = 0; i < 4; ++i) {
                    const int kidx = pass * 64 + kt * 16 + fq * 4 + i;
                    dst[i] = (f2ord(acc[i]) & ~127u) | (unsigned)(127 - kidx);
                }
            }
        }
        __syncthreads();
        {
            const unsigned* row = SC + tid * 65;
#pragma unroll 4
            for (int k = 0; k < 64; ++k) ins16(lst, row[k]);
        }
        __syncthreads();
    }
    unsigned* LST = (unsigned*)(lds + PEER_LST);
#pragma unroll
    for (int k = 0; k < 16; ++k) LST[tid * 16 + k] = lst[k];
    __syncthreads();
    unsigned short* EID = (unsigned short*)(lds + PEER_EID);
    float* GATE = (float*)(lds + PEER_GATE);
    if (((tid >> 4) & 1) == 0) {
        const int tok = tid & 15, hh = tid >> 5;
        const unsigned* l2 = LST + (tid + 16) * 16;
        float s1[16], s2[16];
#pragma unroll
        for (int k = 0; k < 16; ++k) { s1[k] = ord2f(lst[k] & ~127u); s2[k] = ord2f(l2[k] & ~127u); }
        unsigned fin[16];
#pragma unroll
        for (int k = 0; k < 16; ++k) fin[k] = 0u;
#pragma unroll
        for (int i = 0; i < 16; ++i)
#pragma unroll
            for (int j = 0; j < 16; ++j)
                if ((i + 1) * (j + 1) <= 16) ins16(fin, (f2ord(s1[i] + s2[j]) & ~255u) | (unsigned)(255 - (i * 16 + j)));
        const float mx = ord2f(fin[0] & ~255u);
        float w[16], ws = 0.f;
#pragma unroll
        for (int k = 0; k < 16; ++k) { w[k] = expf(ord2f(fin[k] & ~255u) - mx); ws += w[k]; }
        const float inv = 1.f / ws;
#pragma unroll
        for (int k = 0; k < 16; ++k) {
            const int flat = 255 - (int)(fin[k] & 255u);
            const int i1 = 127 - (int)(LST[tid * 16 + (flat >> 4)] & 127u);
            const int i2 = 127 - (int)(l2[flat & 15] & 127u);
            EID[tok * 128 + hh * 16 + k] = (unsigned short)(i1 * 128 + i2);
            GATE[tok * 128 + hh * 16 + k] = w[k] * inv;
        }
    }
    __syncthreads();
    {
        unsigned short* EIDP = (unsigned short*)(p.ws + WS_EIDP);
        float* GATEP = (float*)(p.ws + WS_GATEP);
        for (int i = tid; i < 16 * 128; i += 256) {
            const int tok = i >> 7, pi = i & 127, eg = pi >> 4, k = pi & 15, slot = 8 * k + eg;
            EIDP[(size_t)(t0 + tok) * 128 + pi] = EID[tok * 128 + slot];
            GATEP[(size_t)(t0 + tok) * 128 + pi] = GATE[tok * 128 + slot];
        }
        unsigned char* XQ = p.ws + WS_XQ;
#pragma unroll 1
        for (int tt = 0; tt < 4; ++tt) {
            const size_t t = (size_t)t0 + wid * 4 + tt;
            const bf16_t* row = (const bf16_t*)(p.ws + WS_XB) + t * 1024 + lane * 16;
            float xr[16];
            float amax = 0.f;
#pragma unroll
            for (int i = 0; i < 2; ++i) {
                const u32x4 a4 = *(const u32x4*)(row + 8 * i);
#pragma unroll
                for (int q = 0; q < 4; ++q) {
                    xr[8 * i + 2 * q] = bflo(a4[q]);
                    xr[8 * i + 2 * q + 1] = bfhi(a4[q]);
                    amax = fmaxf(amax, fmaxf(fabsf(xr[8 * i + 2 * q]), fabsf(xr[8 * i + 2 * q + 1])));
                }
            }
            amax = wmax(amax);
            const float qx = amax > 0.f ? 127.f / amax : 0.f;
            u32x4 w;
            int s_ = 0;
#pragma unroll
            for (int i = 0; i < 4; ++i) {
                unsigned pk = 0u;
#pragma unroll
                for (int k = 0; k < 4; ++k) {
                    int qi = (int)rintf(xr[4 * i + k] * qx);
                    qi = qi < -127 ? -127 : (qi > 127 ? 127 : qi);
                    pk |= (unsigned)(qi + 128) << (8 * k);
                    s_ += qi + 128;
                }
                w[i] = pk;
            }
#pragma unroll
            for (int o = 32; o > 0; o >>= 1) s_ += __shfl_xor(s_, o);
            *(u32x4*)(XQ + t * 1024 + lane * 16) = w;
            if (lane == 0) {
                ((float*)(p.ws + WS_SXF))[t] = amax * (1.f / 127.f);
                ((int*)(p.ws + WS_SXI))[t] = s_;
            }
        }
    }
    __syncthreads();
}

DEV void peer_down_item(const P& p, int s, int tile, int lane, int wid) {
    const unsigned char* PD = p.ws + WS_PD + (size_t)s * 16384 * 128;
    const unsigned short* EIDP = (const unsigned short*)(p.ws + WS_EIDP);
    int* DP = (int*)(p.ws + WS_DP) + (size_t)s * T_ * 128;
    const int eg = lane >> 3, cg = lane & 7;
#pragma unroll 1
    for (int tt = 0; tt < 8; ++tt) {
        const size_t t = (size_t)tile * 32 + wid * 8 + tt;
        const u32x4 xu = *(const u32x4*)(p.ws + WS_XQ + t * 1024 + s * 128 + cg * 16);
        const u32x4 e0 = *(const u32x4*)(EIDP + t * 128 + eg * 16);
        const u32x4 e1 = *(const u32x4*)(EIDP + t * 128 + eg * 16 + 8);
        u32x4 rows[16];
#pragma unroll
        for (int k = 0; k < 16; ++k) {
            const unsigned ew = k < 8 ? e0[k >> 1] : e1[(k - 8) >> 1];
            const unsigned e = (k & 1) ? (ew >> 16) : (ew & 0xffffu);
            rows[k] = *(const u32x4*)(PD + (size_t)e * 128 + cg * 16);
        }
        unsigned v[16];
#pragma unroll
        for (int k = 0; k < 16; ++k) {
            unsigned a_ = 0u;
#pragma unroll
            for (int q = 0; q < 4; ++q) a_ = __builtin_amdgcn_udot4(rows[k][q], xu[q], a_, false);
            v[k] = a_;
        }
        unsigned w8[8], w4[4], w2[2];
        {
            const bool hi = (cg & 4) != 0;
#pragma unroll
            for (int j = 0; j < 8; ++j) {
                const unsigned send = hi ? v[j] : v[j + 8];
                const unsigned keep = hi ? v[j + 8] : v[j];
                w8[j] = keep + (unsigned)__shfl_xor((int)send, 4);
            }
        }
        {
            const bool hi = (cg & 2) != 0;
#pragma unroll
            for (int j = 0; j < 4; ++j) {
                const unsigned send = hi ? w8[j] : w8[j + 4];
                const unsigned keep = hi ? w8[j + 4] : w8[j];
                w4[j] = keep + (unsigned)__shfl_xor((int)send, 2);
            }
        }
        {
            const bool hi = (cg & 1) != 0;
#pragma unroll
            for (int j = 0; j < 2; ++j) {
                const unsigned send = hi ? w4[j] : w4[j + 2];
                const unsigned keep = hi ? w4[j + 2] : w4[j];
                w2[j] = keep + (unsigned)__shfl_xor((int)send, 1);
            }
        }
        *(uint2*)(DP + t * 128 + eg * 16 + 2 * cg) = make_uint2(w2[0], w2[1]);
    }
}

DEV void peer_coef_item(const P& p, int t, int lane) {
    const int* DP = (const int*)(p.ws + WS_DP);
    const unsigned short* EIDP = (const unsigned short*)(p.ws + WS_EIDP);
    const float* GATEP = (const float*)(p.ws + WS_GATEP);
    const float sx = ((const float*)(p.ws + WS_SXF))[t];
    const int sxu = ((const int*)(p.ws + WS_SXI))[t];
    float cf[2];
    float cm = 0.f;
#pragma unroll
    for (int h = 0; h < 2; ++h) {
        const int pi = lane + 64 * h;
        int tot = 0;
#pragma unroll
        for (int s = 0; s < 8; ++s) tot += DP[((size_t)s * T_ + t) * 128 + pi];
        const int e = EIDP[(size_t)t * 128 + pi];
        const int dotq = tot - 128 * ((const int*)(p.ws + WS_PRS))[e] - 128 * sxu + 128 * 128 * 1024;
        const float hv = ((const float*)(p.ws + WS_PSD))[e] * sx * (float)dotq;
        cf[h] = 0.5f * hv * (1.f + erff(hv * 0.7071067811865476f)) * GATEP[(size_t)t * 128 + pi] * ((const float*)(p.ws + WS_PSU))[e];
        cm = fmaxf(cm, fabsf(cf[h]));
    }
    cm = wmax(cm);
    const float qs = cm > 0.f ? 127.f / cm : 0.f;
#pragma unroll
    for (int h = 0; h < 2; ++h) {
        int qi = (int)rintf(cf[h] * qs);
        qi = qi < -127 ? -127 : (qi > 127 ? 127 : qi);
        (p.ws + WS_COEFP)[(size_t)t * 128 + lane + 64 * h] = (unsigned char)(qi & 0xff);
    }
    if (lane == 0) ((float*)(p.ws + WS_ASUM))[t] = cm * (1.f / 127.f);
}

DEV void peer_up_item(const P& p, int s, int tile, int lane, int wid, bool dostore = true) {
    const unsigned char* PU = p.ws + WS_PU + (size_t)s * 16384 * 128;
    const unsigned short* EIDP = (const unsigned short*)(p.ws + WS_EIDP);
    const unsigned char* COEFQ = p.ws + WS_COEFP;
    const int eg = lane >> 3, cg = lane & 7;
#pragma unroll 1
    for (int tt = 0; tt < 8; ++tt) {
        const size_t t = (size_t)tile * 32 + wid * 8 + tt;
        const u32x4 e0 = *(const u32x4*)(EIDP + t * 128 + eg * 16);
        const u32x4 e1 = *(const u32x4*)(EIDP + t * 128 + eg * 16 + 8);
        const u32x4 cq = *(const u32x4*)(COEFQ + t * 128 + eg * 16);
        u32x4 rows[16];
#pragma unroll
        for (int k = 0; k < 16; ++k) {
            const unsigned ew = k < 8 ? e0[k >> 1] : e1[(k - 8) >> 1];
            const unsigned e = (k & 1) ? (ew >> 16) : (ew & 0xffffu);
            rows[k] = *(const u32x4*)(PU + (size_t)e * 128 + cg * 16);
        }
        int acc[16];
#pragma unroll
        for (int i = 0; i < 16; ++i) acc[i] = 0;
#pragma unroll
        for (int g = 0; g < 4; ++g)
#pragma unroll
            for (int q = 0; q < 4; ++q) {
                const unsigned r0 = rows[4 * g][q], r1 = rows[4 * g + 1][q], r2 = rows[4 * g + 2][q], r3 = rows[4 * g + 3][q];
                const unsigned a0 = __builtin_amdgcn_perm(r1, r0, 0x05010400u), a1 = __builtin_amdgcn_perm(r1, r0, 0x07030602u);
                const unsigned b0 = __builtin_amdgcn_perm(r3, r2, 0x05010400u), b1 = __builtin_amdgcn_perm(r3, r2, 0x07030602u);
                const unsigned t0 = __builtin_amdgcn_perm(b0, a0, 0x05040100u), t1 = __builtin_amdgcn_perm(b0, a0, 0x07060302u);
                const unsigned t2 = __builtin_amdgcn_perm(b1, a1, 0x05040100u), t3 = __builtin_amdgcn_perm(b1, a1, 0x07060302u);
                acc[4 * q] = __builtin_amdgcn_sdot4((int)t0, (int)cq[g], acc[4 * q], false);
                acc[4 * q + 1] = __builtin_amdgcn_sdot4((int)t1, (int)cq[g], acc[4 * q + 1], false);
                acc[4 * q + 2] = __builtin_amdgcn_sdot4((int)t2, (int)cq[g], acc[4 * q + 2], false);
                acc[4 * q + 3] = __builtin_amdgcn_sdot4((int)t3, (int)cq[g], acc[4 * q + 3], false);
            }
        int a8[8], a4[4], a2[2];
        {
            const bool hi = (eg & 4) != 0;
#pragma unroll
            for (int j = 0; j < 8; ++j) {
                const int send = hi ? acc[j] : acc[j + 8];
                const int keep = hi ? acc[j + 8] : acc[j];
                a8[j] = keep + __shfl_xor(send, 32);
            }
        }
        {
            const bool hi = (eg & 2) != 0;
#pragma unroll
            for (int j = 0; j < 4; ++j) {
                const int send = hi ? a8[j] : a8[j + 4];
                const int keep = hi ? a8[j + 4] : a8[j];
                a4[j] = keep + __shfl_xor(send, 16);
            }
        }
        {
            const bool hi = (eg & 1) != 0;
#pragma unroll
            for (int j = 0; j < 2; ++j) {
                const int send = hi ? a4[j] : a4[j + 2];
                const int keep = hi ? a4[j + 2] : a4[j];
                a2[j] = keep + __shfl_xor(send, 8);
            }
        }
        const float cs = ((const float*)(p.ws + WS_ASUM))[t];
        const unsigned xb = *(const unsigned*)((const bf16_t*)(p.ws + WS_XB) + t * 1024 + s * 128 + cg * 16 + 2 * eg);
        if (dostore) *(unsigned*)((bf16_t*)(p.ws + WS_XB) + t * 1024 + s * 128 + cg * 16 + 2 * eg) = pk_bf16(ALPHA * bflo(xb) + cs * (float)a2[0], ALPHA * bfhi(xb) + cs * (float)a2[1]);
    }
}

DEV void ln3_item(const P& p, int t, int lane) {
    float* row = p.out + (size_t)t * 1024;
    const bf16_t* yrow = (const bf16_t*)(p.ws + WS_XB) + (size_t)t * 1024;
    float4 v[4];
    float s = 0.f;
#pragma unroll
    for (int i = 0; i < 4; ++i) {
        const uint2 u = *(const uint2*)(yrow + (i * 64 + lane) * 4);
        v[i] = make_float4(bflo(u.x), bfhi(u.x), bflo(u.y), bfhi(u.y));
        s += v[i].x + v[i].y + v[i].z + v[i].w;
    }
    const float mean = wsum(s) * (1.f / 1024.f);
    float ss = 0.f;
#pragma unroll
    for (int i = 0; i < 4; ++i) {
        v[i].x -= mean; v[i].y -= mean; v[i].z -= mean; v[i].w -= mean;
        ss += v[i].x * v[i].x + v[i].y * v[i].y + v[i].z * v[i].z + v[i].w * v[i].w;
    }
    const float rs = rsqrtf(wsum(ss) * (1.f / 1024.f) + LN_EPS);
#pragma unroll
    for (int i = 0; i < 4; ++i) {
        const int c = (i * 64 + lane) * 4;
        const float4 gg = *(const float4*)(p.ln_g + 2 * 1024 + c);
        const float4 bb = *(const float4*)(p.ln_b + 2 * 1024 + c);
        float4 o;
        o.x = v[i].x * rs * gg.x + bb.x; o.y = v[i].y * rs * gg.y + bb.y; o.z = v[i].z * rs * gg.z + bb.z; o.w = v[i].w * rs * gg.w + bb.w;
        *(float4*)(row + c) = o;
    }
}

#define XB_TMO      128
#define XB_XCNT(j)  (256  + 64 * (j))
#define XB_XSUB(j)  (1280 + 64 * (j))
#define XB_XGEN(j)  (2304 + 64 * (j))
#define XB_TOP      3328
#define XB_TOPGEN   3392
#define XCD_BAR_WORDS 3456
#define XB_SPIN_CAP (1u << 20)
#define LAS __attribute__((address_space(3)))
DEV unsigned xb_ld(unsigned* p) { return __hip_atomic_load(p, __ATOMIC_RELAXED, __HIP_MEMORY_SCOPE_AGENT); }
DEV unsigned xb_add(unsigned* p, unsigned v) { return __hip_atomic_fetch_add(p, v, __ATOMIC_RELAXED, __HIP_MEMORY_SCOPE_AGENT); }
DEV unsigned xb_xcc_id() { return (unsigned)__builtin_amdgcn_s_getreg((3 << 11) | 20) & 0xFu; }
#define XB_SPIN(cond, bar) do { unsigned _sp = 0; while (cond) { __builtin_amdgcn_s_sleep(1); \
    if ((++_sp & 255u) == 0u) { if (xb_ld(&(bar)[XB_TMO])) break; if (_sp > XB_SPIN_CAP) { atomicAdd(&(bar)[XB_TMO], 1u); break; } } } } while (0)
struct XcdBarrier { unsigned* bar; unsigned x; volatile LAS unsigned* st; };
DEV XcdBarrier xcd_barrier_post(unsigned* bar, volatile LAS unsigned* st) {
    XcdBarrier b; b.bar = bar; b.x = xb_xcc_id(); b.st = st;
    if (threadIdx.x == 0) (void)xb_add(&bar[XB_XCNT(b.x)], 1u);
    return b;
}
DEV void xcd_barrier_complete(unsigned* bar, unsigned x, unsigned& nloc, unsigned& nx) {
    const unsigned G = gridDim.x * gridDim.y * gridDim.z;
    unsigned sum, cnt, mine, sp = 0u;
    for (;;) {
        sum = 0u; cnt = 0u; mine = 0u;
#pragma unroll
        for (unsigned j = 0; j < 16; ++j) { const unsigned c = xb_ld(&bar[XB_XCNT(j)]); sum += c; cnt += (c > 0u) ? 1u : 0u; mine = (j == x) ? c : mine; }
        if (sum == G) break;
        __builtin_amdgcn_s_sleep(1);
        if ((++sp & 255u) == 0u) { if (xb_ld(&bar[XB_TMO])) break; if (sp > XB_SPIN_CAP) { atomicAdd(&bar[XB_TMO], 1u); break; } }
    }
    nloc = mine > 0u ? mine : 1u; nx = cnt > 0u ? cnt : 1u;
}
DEV void xcd_barrier(const XcdBarrier& b) {
    asm volatile("s_waitcnt vmcnt(0)" ::: "memory");
    __syncthreads();
    if (threadIdx.x == 0) {
        unsigned* bar = b.bar;
        __builtin_amdgcn_s_waitcnt(0);
        unsigned nloc = b.st[0], nx = b.st[1];
        if (nloc == 0u) { xcd_barrier_complete(bar, b.x, nloc, nx); b.st[0] = nloc; b.st[1] = nx; }
        const unsigned old = xb_add(&bar[XB_XSUB(b.x)], 1u);
        const unsigned gen = old / nloc;
        if (old + 1u == (gen + 1u) * nloc) {
            __builtin_amdgcn_fence(__ATOMIC_RELEASE, "agent");
            asm volatile("s_waitcnt vmcnt(0)" ::: "memory");
            const unsigned og = xb_add(&bar[XB_TOP], 1u);
            const unsigned tg = og / nx;
            if (og + 1u == (tg + 1u) * nx) xb_add(&bar[XB_TOPGEN], 1u);
            else XB_SPIN(xb_ld(&bar[XB_TOPGEN]) == tg, bar);
            __builtin_amdgcn_fence(__ATOMIC_ACQUIRE, "agent");
            xb_add(&bar[XB_XGEN(b.x)], 1u);
            asm volatile("s_waitcnt vmcnt(0)" ::: "memory");
        } else {
            XB_SPIN(xb_ld(&bar[XB_XGEN(b.x)]) == gen, bar);
            __builtin_amdgcn_fence(__ATOMIC_ACQUIRE, "agent");
            asm volatile("s_waitcnt vmcnt(0)" ::: "memory");
        }
    }
    __syncthreads();
}


DEV void late_transpose_item(const P& p, int it, float* smem) {
    const int m = it >> 8, t = it & 255;
    const float* W = m == 0 ? p.w_out : (m == 1 ? p.xa_wq : (m == 2 ? p.xa_wo : p.peer_wq));
    const size_t off = m == 0 ? WS_WOUT_T : (m == 1 ? WS_WQ_T : (m == 2 ? WS_WO_T : WS_PWQ_T));
    transpose_tile(W, 1024, (bf16_t*)(p.ws + off), t >> 4, t & 15, smem);
}

constexpr int WQ_WORD0 = 4096;
DEV int wq_next(unsigned* cnt, int nper, int xcc, unsigned char* lds) {
    volatile unsigned* slot = (volatile unsigned*)(lds + LDS_BYTES - 16);
    __syncthreads();
    if (threadIdx.x == 0) {
        int res = -1;
        int off = (int)slot[1];
        while (off < 8) {
            const int q = (xcc + off) & 7;
            const unsigned idx = atomicAdd(&cnt[q * 64], 1u);
            if (idx < (unsigned)nper) { res = q * nper + (int)idx; break; }
            ++off;
        }
        slot[0] = (unsigned)res;
        slot[1] = (unsigned)off;
    }
    __syncthreads();
    return (int)slot[0];
}
DEV void wq_begin(unsigned char* lds) {
    __syncthreads();
    if (threadIdx.x == 0) ((volatile unsigned*)(lds + LDS_BYTES - 16))[1] = 0u;
}

constexpr int NSTAGES = 12;
template <int ST>
DEV void run_stage(const P& p, unsigned char* lds, int xcc) {
    float* smem = (float*)lds;
    const int nb = gridDim.x, bid = blockIdx.x;
    int tidl = threadIdx.x;
    asm volatile("" : "+v"(tidl));
    const int wave = tidl >> 6;
    unsigned* wqc = (unsigned*)(p.ws + WS_BAR) + WQ_WORD0;
    if (ST == 0) {
        for (int it = bid; it < PREP_END; it += nb) prep_item(p, it, smem);
    } else if (ST == 1) {
        for (int it = bid; it < 1536 + 384 + 128; it += nb) {
            if (it < 1536) gemm_item<0>(p, it & 7, it >> 3, lds);
            else if (it < 1920) { const int i2 = it - 1536, q = i2 & 7, j = i2 >> 3; gemm_mfma_tile<0>(p, q * 16 + (j & 15), 24 + (j >> 4), lds); }
            else gemm_item<1>(p, (it - 1920) & 7, (it - 1920) >> 3, lds);
        }
    } else if (ST == 2) {
        if (PROBE_REP == 21) for (int it = bid; it < 256; it += nb) compress_item2(p, it, lds);
        if (PROBE_REP == 22) for (int it = bid; it < 1024; it += nb) hgrn_prep_item(p, it, smem);
        for (int it = bid; it < 256 + 1024; it += nb) {
            if (it < 256) compress_item2(p, it, lds);
            else hgrn_prep_item2(p, it - 256, lds);
        }
    } else if (ST == 3) {
        if (PROBE_REP == 31) { for (int it = bid; it < 32; it += nb) hgrn_chain_item(p, it, lds); }
        if (PROBE_REP == 32) {
            volatile unsigned* qs2 = (volatile unsigned*)(lds + LDS_BYTES - 16);
            for (;;) {
                __syncthreads();
                if (threadIdx.x == 0) *qs2 = atomicAdd(wqc + 64, 1u);
                __syncthreads();
                const int j = (int)*qs2;
                if (j >= 1024) break;
                nsa_item2(p, (j & 15) >> 1, j & 1, 63 - (j >> 4), lds, p.out != nullptr ? 4 : 0);
            }
        }
        volatile unsigned* qslot = (volatile unsigned*)(lds + LDS_BYTES - 16);
        for (;;) {
            __syncthreads();
            if (threadIdx.x == 0) *qslot = atomicAdd(wqc, 1u);
            __syncthreads();
            const int it = (int)*qslot;
            if (it >= 32 + 1024) break;
            if (it < 32) hgrn_chain_item2(p, it, lds);
            else { const int j = it - 32; nsa_item2(p, (j & 15) >> 1, j & 1, 63 - (j >> 4), lds); }
        }
        for (;;) {
            __syncthreads();
            if (threadIdx.x == 0) *qslot = atomicAdd(wqc + 128, 1u);
            __syncthreads();
            const int it = (int)*qslot;
            if (it >= 2048) break;
            if (it < 1024) late_transpose_item(p, it, smem);
            else {
                const int j = it - 1024, tb = j >> 9, r0 = (j & 511) * 32 + wave * 8;
                for (int r = 0; r < 8; ++r) {
                    if (tb == 0) peer_quant_row(p.peer_down, p.ws + WS_PD, (float*)(p.ws + WS_PSD), r0 + r, (int*)(p.ws + WS_PRS));
                    else peer_quant_row(p.peer_up, p.ws + WS_PU, (float*)(p.ws + WS_PSU), r0 + r, nullptr, 0);
                }
            }
        }
    } else if (ST == 4) {
        for (int it = bid; it < 512; it += nb) gemm_item<2>(p, it & 7, it >> 3, lds);
    } else if (ST == 5) {
        for (int it = bid; it < T_ / 4; it += nb) ln_item(p, it * 4 + wave, 0, tidl & 63);
    } else if (ST == 9) {
        for (int it = bid; it < T_ / 4; it += nb) ln_item(p, it * 4 + wave, 1, tidl & 63);
    } else if (ST == 6) {
        for (int it = bid; it < 512; it += nb) gemm_item<3>(p, it & 7, it >> 3, lds);
    } else if (ST == 7) {
        for (int it = bid; it < 1024; it += nb) xattn_item3(p, it, lds);
    } else if (ST == 8) {
        for (int it = bid; it < 512; it += nb) gemm_item<4>(p, it & 7, it >> 3, lds);
    } else if (ST == 10) {
        for (int it = bid; it < 512; it += nb) gemm_item<5>(p, it & 7, it >> 3, lds);
    } else if (ST == 11) {
        if (PROBE_REP == 11) for (int it = bid; it < T_ / 16; it += nb) peer_route_item(p, it, lds);
        for (int it = bid; it < T_ / 16; it += nb) peer_route_item(p, it, lds);
    } else if (ST == 12) {
        if (PROBE_REP == 12) { wq_begin(lds); for (int it; (it = wq_next(wqc + 4 * 512, 1024, xcc, lds)) >= 0;) peer_down_item(p, it >> 10, it & 1023, tidl & 63, wave); }
        wq_begin(lds);
        for (int it; (it = wq_next(wqc + 2 * 512, 512, xcc, lds)) >= 0;) peer_down_item(p, it >> 9, it & 511, tidl & 63, wave);
    } else if (ST == 13) {
        if (PROBE_REP == 13) for (int it = bid; it < T_ / 4; it += nb) peer_coef_item(p, it * 4 + wave, tidl & 63);
        for (int it = bid; it < T_ / 4; it += nb) peer_coef_item(p, it * 4 + wave, tidl & 63);
    } else if (ST == 14) {
        if (PROBE_REP == 14) { wq_begin(lds); for (int it; (it = wq_next(wqc + 5 * 512, 1024, xcc, lds)) >= 0;) peer_up_item(p, it >> 10, it & 1023, tidl & 63, wave, p.out == nullptr); }
        wq_begin(lds);
        for (int it; (it = wq_next(wqc + 3 * 512, 512, xcc, lds)) >= 0;) peer_up_item(p, it >> 9, it & 511, tidl & 63, wave);
    } else if (ST == 15) {
        for (int it = bid; it < T_ / 4; it += nb) ln3_item(p, it * 4 + wave, tidl & 63);
    }
}

template <int ST>
__global__ void __launch_bounds__(256, 2) stage_kernel(P p) {
    __shared__ __attribute__((aligned(16))) unsigned char lds[LDS_BYTES + 16];
    run_stage<ST>(p, lds, (int)xb_xcc_id() & 7);
}

__global__ void __launch_bounds__(256, 2) mega_kernel(P p) {
    __shared__ __attribute__((aligned(16))) unsigned char lds[LDS_BYTES + 16];
    if (threadIdx.x == 0) *(uint4*)(lds + LDS_BYTES) = make_uint4(0u, 0u, 0u, 0u);
    __syncthreads();
    const XcdBarrier xb = xcd_barrier_post((unsigned*)(p.ws + WS_BAR), (volatile LAS unsigned*)(lds + LDS_BYTES));
    const int xcc = (int)xb.x & 7;
    run_stage<0>(p, lds, xcc); xcd_barrier(xb);
    if (PROBE_REP == 0) { run_stage<0>(p, lds, xcc); xcd_barrier(xb); }
    run_stage<1>(p, lds, xcc); xcd_barrier(xb);
    if (PROBE_REP == 1) { run_stage<1>(p, lds, xcc); xcd_barrier(xb); }
    run_stage<2>(p, lds, xcc); xcd_barrier(xb);
    if (PROBE_REP == 2) { run_stage<2>(p, lds, xcc); xcd_barrier(xb); }
    if (PROBE_REP == 35) { if (blockIdx.x < 32) hgrn_chain_item2(p, blockIdx.x, lds); xcd_barrier(xb); }
    run_stage<3>(p, lds, xcc); xcd_barrier(xb);
    run_stage<4>(p, lds, xcc); xcd_barrier(xb);
    if (PROBE_REP == 4) { run_stage<4>(p, lds, xcc); xcd_barrier(xb); }
    if (PROBE_REP == 50) { xcd_barrier(xb); xcd_barrier(xb); xcd_barrier(xb); xcd_barrier(xb); xcd_barrier(xb); xcd_barrier(xb); xcd_barrier(xb); xcd_barrier(xb); }
    run_stage<5>(p, lds, xcc); xcd_barrier(xb);
    run_stage<6>(p, lds, xcc); xcd_barrier(xb);
    if (PROBE_REP == 6) { run_stage<6>(p, lds, xcc); xcd_barrier(xb); }
    run_stage<7>(p, lds, xcc); xcd_barrier(xb);
    if (PROBE_REP == 7) { run_stage<7>(p, lds, xcc); xcd_barrier(xb); }
    run_stage<8>(p, lds, xcc); xcd_barrier(xb);
    run_stage<9>(p, lds, xcc); xcd_barrier(xb);
    run_stage<10>(p, lds, xcc); xcd_barrier(xb);
    if (PROBE_REP == 10) { run_stage<10>(p, lds, xcc); xcd_barrier(xb); }
    run_stage<11>(p, lds, xcc); xcd_barrier(xb);
    run_stage<12>(p, lds, xcc); xcd_barrier(xb);
    run_stage<13>(p, lds, xcc); xcd_barrier(xb);
    run_stage<14>(p, lds, xcc); xcd_barrier(xb);
    run_stage<15>(p, lds, xcc);
}

extern "C" void kernel_launch(void* const* d_in, const int* in_sizes, int n_in, void* d_out, int out_size, void* d_ws, size_t ws_size,
                              hipStream_t stream) {
    if (n_in != 18 || ws_size < WS_END) {
        fprintf(stderr, "kernel_launch: unexpected inputs (n_in %d, ws %zu, need %zu)\n", n_in, ws_size, (size_t)WS_END);
        return;
    }
    P p{};
    p.x = (const float*)d_in[0]; p.mem = (const float*)d_in[1]; p.w_in = (const float*)d_in[2]; p.cmp_pos = (const float*)d_in[3];
    p.cmp_w1 = (const float*)d_in[4]; p.cmp_w2 = (const float*)d_in[5]; p.lb_logits = (const float*)d_in[6];
    p.hg_norm_w = (const float*)d_in[7]; p.w_out = (const float*)d_in[8]; p.xa_wq = (const float*)d_in[9];
    p.xa_wkv = (const float*)d_in[10]; p.xa_wo = (const float*)d_in[11]; p.peer_wq = (const float*)d_in[12];
    p.peer_keys = (const float*)d_in[13]; p.peer_down = (const float*)d_in[14]; p.peer_up = (const float*)d_in[15];
    p.ln_g = (const float*)d_in[16]; p.ln_b = (const float*)d_in[17];
    p.out = (float*)d_out; p.ws = (unsigned char*)d_ws;
#if ONE_LAUNCH
    static int grid_blocks = 0;
    if (!grid_blocks) {
        int dev = 0, cus = 0, per_cu = 0;
        hipGetDevice(&dev);
        hipDeviceGetAttribute(&cus, hipDeviceAttributeMultiprocessorCount, dev);
        hipOccupancyMaxActiveBlocksPerMultiprocessor(&per_cu, mega_kernel, 256, 0);
        if (per_cu > 2) per_cu = 2;
        if (per_cu < 1) per_cu = 1;
        grid_blocks = cus * per_cu;
    }
    (void)hipMemsetAsync((unsigned char*)d_ws + WS_BAR, 0, 65536, stream);
    void* args[] = {&p};
    hipError_t e = hipLaunchCooperativeKernel((void*)mega_kernel, dim3(grid_blocks), dim3(256), args, 0, stream);
    if (e != hipSuccess) fprintf(stderr, "cooperative launch failed: %s (grid %d)\n", hipGetErrorString(e), grid_blocks);
#else
    const int G = 2048;
    stage_kernel<0><<<G, 256, 0, stream>>>(p);
    stage_kernel<1><<<G, 256, 0, stream>>>(p);
    stage_kernel<2><<<G, 256, 0, stream>>>(p);
    stage_kernel<3><<<G, 256, 0, stream>>>(p);
    stage_kernel<4><<<G, 256, 0, stream>>>(p);
    stage_kernel<5><<<G, 256, 0, stream>>>(p);
    stage_kernel<6><<<G, 256, 0, stream>>>(p);
    stage_kernel<7><<<G, 256, 0, stream>>>(p);
    stage_kernel<8><<<G, 256, 0, stream>>>(p);
    stage_kernel<9><<<G, 256, 0, stream>>>(p);
    stage_kernel<10><<<G, 256, 0, stream>>>(p);
    stage_kernel<11><<<G, 256, 0, stream>>>(p);
#endif
}
```

```cpp
#include <hip/hip_runtime.h>
#include <hip/hip_cooperative_groups.h>
#include <cstdio>
#include <cstdint>
namespace cg = cooperative_groups;

#ifndef PROBE_REP
#define PROBE_REP -1
#endif
#ifndef ONE_LAUNCH
#define ONE_LAUNCH 1
#endif

typedef unsigned short bf16_t;
#define DEV __device__ __forceinline__

constexpr int D_ = 1024, B_ = 8, S_ = 2048, T_ = B_ * S_, ML_ = 256, INC = 3352;
constexpr int NCMP = 127;
constexpr int LDS_BYTES = 67584;
constexpr float ALPHA = 1.189207115002721f;
constexpr float LN_EPS = 1e-5f;
constexpr int C_QA = 0, C_KC = 512, C_VC = 640, C_KS = 768, C_VS = 896, C_KW = 1024, C_VW = 1152, C_GATE = 1280,
              C_HQ = 1304, C_HF = 1816, C_HI = 2328, C_HG = 2840;
constexpr size_t WS_HB = 0;
constexpr size_t SZ_HB = (size_t)T_ * INC * 2;
constexpr size_t WS_OM = WS_HB + SZ_HB;
constexpr size_t WS_KVM = WS_OM + (size_t)T_ * 1024 * 2;
constexpr size_t WS_KC = WS_KVM + (size_t)2048 * 2048 * 2;
constexpr size_t WS_XB = WS_KC + (1u << 20);
constexpr size_t WS_WIN_T = WS_XB + (size_t)T_ * 1024 * 2;
constexpr size_t WS_WOUT_T = WS_WIN_T + (size_t)3456 * 1024 * 2;
constexpr size_t WS_WQ_T = WS_WOUT_T + (size_t)1024 * 1024 * 2;
constexpr size_t WS_WKV_T = WS_WQ_T + (size_t)1024 * 1024 * 2;
constexpr size_t WS_WO_T = WS_WKV_T + (size_t)2048 * 1024 * 2;
constexpr size_t WS_PWQ_T = WS_WO_T + (size_t)1024 * 1024 * 2;
constexpr size_t WS_MEMB = WS_PWQ_T + (size_t)1024 * 1024 * 2;
constexpr size_t WS_PKEY = WS_MEMB + (size_t)2048 * 1024 * 2;
constexpr size_t WS_VT = WS_PKEY + (size_t)16 * 128 * 64 * 2;
constexpr size_t WS_KCB = WS_VT + (size_t)2 * B_ * 2 * 64 * 2048 * 2;
constexpr size_t WS_VCT = WS_KCB + (size_t)B_ * 2 * 128 * 64 * 2;
constexpr size_t WS_W1T = WS_VCT + (size_t)B_ * 2 * 128 * 64 * 2;
constexpr size_t WS_W2T = WS_W1T + (size_t)2 * 128 * 2048 * 2;
constexpr size_t WS_CB = WS_W2T + (size_t)2 * 64 * 128 * 2;
constexpr size_t WS_VMT = WS_CB + 1024;
constexpr size_t WS_BAR = WS_VMT + (size_t)B_ * 4 * 256 * 256 * 2;
constexpr size_t WS_PD = WS_BAR + 65536;
constexpr size_t WS_PU = WS_PD + (size_t)16384 * 1024;
constexpr size_t WS_PSD = WS_PU + (size_t)16384 * 1024;
constexpr size_t WS_PSU = WS_PSD + 65536;
constexpr size_t WS_PRS = WS_PSU + 65536;
constexpr size_t WS_LNP1 = WS_PRS + 65536;
constexpr size_t WS_LNP2 = WS_LNP1 + (size_t)T_ * 16 * 8;
constexpr size_t WS_ST2 = WS_LNP2 + (size_t)T_ * 16 * 8;
constexpr size_t WS_C12 = WS_ST2 + (size_t)T_ * 8;
constexpr size_t WS_END = WS_C12 + 262144;
static_assert(WS_END <= (size_t)268435456, "workspace budget");
constexpr size_t WS_EB = WS_KC;
constexpr size_t HS_QT = 0;
constexpr size_t HS_KT = (size_t)B_ * 4 * 2048 * 128 * 2;
constexpr size_t HS_KHT = 2 * HS_KT;
constexpr size_t HS_VIT = 3 * HS_KT;
constexpr size_t HS_DS = HS_KT;
constexpr size_t HS_OI = 3 * HS_KT;
constexpr size_t WS_QX = 67108864;
constexpr size_t WS_OX = (size_t)T_ * 1024 * 2;
constexpr size_t WS_QP = 104857600;
constexpr size_t WS_YB = 0;
constexpr size_t WS_EIDP = (size_t)T_ * 1024 * 2;
constexpr size_t WS_GATEP = WS_EIDP + (size_t)T_ * 128 * 2;
constexpr size_t WS_COEFP = WS_GATEP + (size_t)T_ * 128 * 4;
constexpr size_t WS_XQ = WS_COEFP + (size_t)T_ * 128 * 4;
constexpr size_t WS_SXF = WS_XQ + (size_t)T_ * 1024;
constexpr size_t WS_SXI = WS_SXF + (size_t)T_ * 4;
constexpr size_t WS_ASUM = WS_SXI + (size_t)T_ * 4;
constexpr size_t WS_DP = WS_ASUM + (size_t)T_ * 4;
static_assert(WS_DP + (size_t)8 * T_ * 128 * 4 <= WS_KVM, "PEER intermediates must fit in the dead h/OM region");

struct P {
    const float *x, *mem, *w_in, *cmp_pos, *cmp_w1, *cmp_w2, *lb_logits, *hg_norm_w, *w_out, *xa_wq, *xa_wkv, *xa_wo,
        *peer_wq, *peer_keys, *peer_down, *peer_up, *ln_g, *ln_b;
    float* out;
    unsigned char* ws;
};

DEV unsigned short f2bf(float f) {
    unsigned u = __float_as_uint(f);
    u += 0x7fffu + ((u >> 16) & 1u);
    return (unsigned short)(u >> 16);
}
DEV float bf2f(unsigned short h) { return __uint_as_float(((unsigned)h) << 16); }
DEV float bflo(unsigned u) { return __uint_as_float(u << 16); }
DEV float bfhi(unsigned u) { return __uint_as_float(u & 0xffff0000u); }
typedef __bf16 bf16x2_t __attribute__((ext_vector_type(2)));
typedef float f32x2_t __attribute__((ext_vector_type(2)));
DEV unsigned pk_bf16(float a, float b) {
    f32x2_t v = {a, b};
    bf16x2_t r = __builtin_convertvector(v, bf16x2_t);
    return __builtin_bit_cast(unsigned, r);
}
DEV float wsum(float v) {
#pragma unroll
    for (int o = 32; o > 0; o >>= 1) v += __shfl_xor(v, o);
    return v;
}
DEV float wmax(float v) {
#pragma unroll
    for (int o = 32; o > 0; o >>= 1) v = fmaxf(v, __shfl_xor(v, o));
    return v;
}
DEV float sigmoidf_(float x) { return 1.f / (1.f + expf(-x)); }
DEV float fsigmoid(float x) { return __fdividef(1.f, 1.f + __expf(-x)); }

template <int MODE>
DEV void gemm_tile(const P& p, int tile, float* smem) {
    constexpr bool ABF = (MODE == 2 || MODE == 4);
    constexpr int K = 1024;
    constexpr int N = MODE == 0 ? INC : (MODE == 1 ? 2048 : 1024);
    constexpr int NTN = (N + 63) / 64;
    const int tm = tile / NTN, tn = tile % NTN;
    const float* Af = nullptr;
    const bf16_t* Ab = nullptr;
    const float* Bm = nullptr;
    if (MODE == 0) { Af = p.x; Bm = p.w_in; }
    if (MODE == 1) { Af = p.mem; Bm = p.xa_wkv; }
    if (MODE == 2) { Ab = (const bf16_t*)(p.ws + WS_OM); Bm = p.w_out; }
    if (MODE == 3) { Af = p.out; Bm = p.xa_wq; }
    if (MODE == 4) { Ab = (const bf16_t*)(p.ws + WS_OX); Bm = p.xa_wo; }
    if (MODE == 5) { Af = p.out; Bm = p.peer_wq; }
    float(*sA)[68] = (float(*)[68])smem;
    float(*sB)[68] = (float(*)[68])(smem + 16 * 68);
    const int tid = threadIdx.x, tx = tid & 15, ty = tid >> 4;
    const int ar = tid >> 2, ak = (tid & 3) * 4;
    const int bk = tid >> 4, bn = (tid & 15) * 4;
    float acc[4][4];
#pragma unroll
    for (int i = 0; i < 4; ++i)
#pragma unroll
        for (int j = 0; j < 4; ++j) acc[i][j] = 0.f;
    const int gn = tn * 64 + bn;
    for (int k0 = 0; k0 < K; k0 += 16) {
        float4 av;
        if (ABF) {
            uint2 u = *(const uint2*)(Ab + (size_t)(tm * 64 + ar) * K + k0 + ak);
            av.x = bflo(u.x); av.y = bfhi(u.x); av.z = bflo(u.y); av.w = bfhi(u.y);
        } else {
            av = *(const float4*)(Af + (size_t)(tm * 64 + ar) * K + k0 + ak);
        }
        float4 bv = make_float4(0.f, 0.f, 0.f, 0.f);
        if (gn < N) bv = *(const float4*)(Bm + (size_t)(k0 + bk) * N + gn);
        sA[ak + 0][ar] = av.x; sA[ak + 1][ar] = av.y; sA[ak + 2][ar] = av.z; sA[ak + 3][ar] = av.w;
        *(float4*)&sB[bk][bn] = bv;
        __syncthreads();
#pragma unroll
        for (int kk = 0; kk < 16; ++kk) {
            float4 a = *(const float4*)&sA[kk][ty * 4];
            float4 b = *(const float4*)&sB[kk][tx * 4];
            float aa[4] = {a.x, a.y, a.z, a.w}, bb[4] = {b.x, b.y, b.z, b.w};
#pragma unroll
            for (int i = 0; i < 4; ++i)
#pragma unroll
                for (int j = 0; j < 4; ++j) acc[i][j] += aa[i] * bb[j];
        }
        __syncthreads();
    }
    const int col = tn * 64 + tx * 4;
#pragma unroll
    for (int i = 0; i < 4; ++i) {
        const size_t row = (size_t)tm * 64 + ty * 4 + i;
        if (MODE == 0 || MODE == 1 || MODE == 3) {
            bf16_t* O = (bf16_t*)(p.ws + (MODE == 0 ? WS_HB : (MODE == 1 ? WS_KVM : WS_QX)));
            if (col < N) {
                uint2 u;
                u.x = (unsigned)f2bf(acc[i][0]) | ((unsigned)f2bf(acc[i][1]) << 16);
                u.y = (unsigned)f2bf(acc[i][2]) | ((unsigned)f2bf(acc[i][3]) << 16);
                *(uint2*)(O + row * N + col) = u;
            }
        } else if (MODE == 2) {
            float4 xv = *(const float4*)(p.x + row * 1024 + col);
            float4 o = make_float4(ALPHA * xv.x + acc[i][0], ALPHA * xv.y + acc[i][1], ALPHA * xv.z + acc[i][2], ALPHA * xv.w + acc[i][3]);
            *(float4*)(p.out + row * 1024 + col) = o;
        } else if (MODE == 4) {
            float4 xv = *(const float4*)(p.out + row * 1024 + col);
            float4 o = make_float4(ALPHA * xv.x + acc[i][0], ALPHA * xv.y + acc[i][1], ALPHA * xv.z + acc[i][2], ALPHA * xv.w + acc[i][3]);
            *(float4*)(p.out + row * 1024 + col) = o;
        } else {
            float* O = (float*)(p.ws + WS_QP);
            *(float4*)(O + row * 1024 + col) = make_float4(acc[i][0], acc[i][1], acc[i][2], acc[i][3]);
        }
    }
}


using bf16x8 = __attribute__((ext_vector_type(8))) short;
using f32x4 = __attribute__((ext_vector_type(4))) float;
using u32x4 = __attribute__((ext_vector_type(4))) unsigned;

template <int MODE>
DEV void gemm_mfma_tile(const P& p, int tm, int tn, unsigned char* lds) {
    const bf16_t* A;
    const bf16_t* W;
    if (MODE == 0) { A = (const bf16_t*)(p.ws + WS_XB); W = (const bf16_t*)(p.ws + WS_WIN_T); }
    if (MODE == 1) { A = (const bf16_t*)(p.ws + WS_MEMB); W = (const bf16_t*)(p.ws + WS_WKV_T); }
    if (MODE == 2) { A = (const bf16_t*)(p.ws + WS_OM); W = (const bf16_t*)(p.ws + WS_WOUT_T); }
    if (MODE == 3) { A = (const bf16_t*)(p.ws + WS_XB); W = (const bf16_t*)(p.ws + WS_WQ_T); }
    if (MODE == 4) { A = (const bf16_t*)(p.ws + WS_OX); W = (const bf16_t*)(p.ws + WS_WO_T); }
    if (MODE == 5) { A = (const bf16_t*)(p.ws + WS_XB); W = (const bf16_t*)(p.ws + WS_PWQ_T); }
    const int tid = threadIdx.x, lane = tid & 63, wid = tid >> 6, wm = wid >> 1, wn = wid & 1;
    const int m0 = tm * 128, n0 = tn * 128;
    const bf16_t* ga[2];
    const bf16_t* gw[2];
#pragma unroll
    for (int i = 0; i < 2; ++i) {
        const int r = (wid * 2 + i) * 16 + (lane >> 2);
        const int gsw = (0x1320 >> (((r >> 2) & 3) * 4)) & 3;
        const int c = (lane & 3) ^ gsw;
        ga[i] = A + (size_t)(m0 + r) * 1024 + c * 8;
        gw[i] = W + (size_t)(n0 + r) * 1024 + c * 8;
    }
    unsigned char* lbase = lds + wid * 2048;
#define GEMM_STAGE(slot, kt)                                                                                                   \
    do {                                                                                                                       \
        _Pragma("unroll") for (int i = 0; i < 2; ++i) {                                                                        \
            __builtin_amdgcn_global_load_lds((const unsigned*)(ga[i] + (kt) * 32), (unsigned*)(lbase + (slot) * 16384 + i * 1024), 16, 0, 0);         \
            __builtin_amdgcn_global_load_lds((const unsigned*)(gw[i] + (kt) * 32), (unsigned*)(lbase + (slot) * 16384 + 8192 + i * 1024), 16, 0, 0);  \
        }                                                                                                                      \
    } while (0)
    asm volatile("s_waitcnt vmcnt(0)" ::: "memory");
    GEMM_STAGE(0, 0);
    GEMM_STAGE(1, 1);
    GEMM_STAGE(2, 2);
    f32x4 acc[4][4];
#pragma unroll
    for (int i = 0; i < 4; ++i)
#pragma unroll
        for (int j = 0; j < 4; ++j) acc[i][j] = (f32x4){0.f, 0.f, 0.f, 0.f};
    const int fr = lane & 15, fq = lane >> 4;
    const int fsw = (0x1320 >> (((fr >> 2) & 3) * 4)) & 3;
    const int aoff = (wm * 64 + fr) * 64 + ((fq ^ fsw) << 4);
    const int boff = 8192 + (wn * 64 + fr) * 64 + ((fq ^ fsw) << 4);
#define GEMM_COMPUTE(slot)                                                                                                     \
    do {                                                                                                                       \
        const unsigned char* sb = lds + (slot) * 16384;                                                                        \
        bf16x8 af[4], wf[4];                                                                                                   \
        _Pragma("unroll") for (int t = 0; t < 4; ++t) {                                                                        \
            af[t] = *(const bf16x8*)(sb + aoff + t * 1024);                                                                    \
            wf[t] = *(const bf16x8*)(sb + boff + t * 1024);                                                                    \
        }                                                                                                                      \
        _Pragma("unroll") for (int nt = 0; nt < 4; ++nt)                                                                       \
            _Pragma("unroll") for (int mt = 0; mt < 4; ++mt)                                                                   \
                acc[nt][mt] = __builtin_amdgcn_mfma_f32_16x16x32_bf16(wf[nt], af[mt], acc[nt][mt], 0, 0, 0);                   \
    } while (0)
#pragma unroll 1
    for (int kt = 0; kt < 29; ++kt) {
        asm volatile("s_waitcnt vmcnt(8)\n\ts_waitcnt lgkmcnt(0)" ::: "memory");
        __builtin_amdgcn_s_barrier(); asm volatile("" ::: "memory");
        GEMM_STAGE((kt + 3) & 3, kt + 3);
        GEMM_COMPUTE(kt & 3);
    }
    asm volatile("s_waitcnt vmcnt(8)\n\ts_waitcnt lgkmcnt(0)" ::: "memory");
    __builtin_amdgcn_s_barrier(); asm volatile("" ::: "memory");
    GEMM_COMPUTE(29 & 3);
    asm volatile("s_waitcnt vmcnt(4)\n\ts_waitcnt lgkmcnt(0)" ::: "memory");
    __builtin_amdgcn_s_barrier(); asm volatile("" ::: "memory");
    GEMM_COMPUTE(30 & 3);
    asm volatile("s_waitcnt vmcnt(0)\n\ts_waitcnt lgkmcnt(0)" ::: "memory");
    __builtin_amdgcn_s_barrier(); asm volatile("" ::: "memory");
    GEMM_COMPUTE(31 & 3);
    asm volatile("s_waitcnt lgkmcnt(0)" ::: "memory");
    __builtin_amdgcn_s_barrier(); asm volatile("" ::: "memory");
#undef GEMM_STAGE
#undef GEMM_COMPUTE
#pragma unroll
    for (int mt = 0; mt < 4; ++mt) {
        const size_t m = (size_t)m0 + wm * 64 + mt * 16 + fr;
#pragma unroll
        for (int nt = 0; nt < 4; ++nt) {
            const int n = n0 + wn * 64 + nt * 16 + fq * 4;
            const f32x4 c = acc[nt][mt];
            if (MODE == 0 || MODE == 1 || MODE == 3 || MODE == 5) {
                constexpr int NS = MODE == 0 ? INC : (MODE == 1 ? 2048 : 1024);
                bf16_t* O = (bf16_t*)(p.ws + (MODE == 0 ? WS_HB : (MODE == 1 ? WS_KVM : (MODE == 3 ? WS_QX : WS_QP))));
                if (MODE == 1 && tn >= 8) {
                    bf16_t* VMT = (bf16_t*)(p.ws + WS_VMT);
                    const int nn = n - 1024;
                    const size_t base = (((size_t)(m >> 8) * 4 + (nn >> 8)) * 256 + (nn & 255)) * 256 + (m & 255);
#pragma unroll
                    for (int i = 0; i < 4; ++i) VMT[base + (size_t)i * 256] = f2bf(c[i]);
                } else if (MODE == 0 && (tn == 7 || tn == 9)) {
                    bf16_t* VT = (bf16_t*)(p.ws + WS_VT);
                    const int which = tn == 9 ? 1 : 0;
                    const size_t base = ((((size_t)which * B_ + (m >> 11)) * 2 + wn) * 64 + nt * 16 + fq * 4) * 2048 + (m & 2047);
#pragma unroll
                    for (int i = 0; i < 4; ++i) VT[base + (size_t)i * 2048] = f2bf(c[i]);
                } else if (MODE != 0 || n < INC) {
                    uint2 u;
                    u.x = pk_bf16(c[0], c[1]);
                    u.y = pk_bf16(c[2], c[3]);
                    *(uint2*)(O + m * NS + n) = u;
                }
            } else if (MODE == 2) {
                const float4 xv = *(const float4*)(p.x + m * 1024 + n);
                *(uint2*)((bf16_t*)(p.ws + WS_YB) + m * 1024 + n) = make_uint2(pk_bf16(ALPHA * xv.x + c[0], ALPHA * xv.y + c[1]), pk_bf16(ALPHA * xv.z + c[2], ALPHA * xv.w + c[3]));
            } else if (MODE == 4) {
                const uint2 xb = *(const uint2*)((const bf16_t*)(p.ws + WS_XB) + m * 1024 + n);
                *(uint2*)((bf16_t*)(p.ws + WS_YB) + m * 1024 + n) = make_uint2(pk_bf16(ALPHA * bflo(xb.x) + c[0], ALPHA * bfhi(xb.x) + c[1]), pk_bf16(ALPHA * bflo(xb.y) + c[2], ALPHA * bfhi(xb.y) + c[3]));
            }
        }
    }
}


template <int MODE>
DEV void gemm_mfma_tile256(const P& p, int tm, int tn, unsigned char* lds) {
    const bf16_t* A;
    const bf16_t* W;
    if (MODE == 0) { A = (const bf16_t*)(p.ws + WS_XB); W = (const bf16_t*)(p.ws + WS_WIN_T); }
    if (MODE == 1) { A = (const bf16_t*)(p.ws + WS_MEMB); W = (const bf16_t*)(p.ws + WS_WKV_T); }
    if (MODE == 2) { A = (const bf16_t*)(p.ws + WS_OM); W = (const bf16_t*)(p.ws + WS_WOUT_T); }
    if (MODE == 3) { A = (const bf16_t*)(p.ws + WS_YB); W = (const bf16_t*)(p.ws + WS_WQ_T); }
    if (MODE == 4) { A = (const bf16_t*)(p.ws + WS_OX); W = (const bf16_t*)(p.ws + WS_WO_T); }
    if (MODE == 5) { A = (const bf16_t*)(p.ws + WS_YB); W = (const bf16_t*)(p.ws + WS_PWQ_T); }
    const int tid = threadIdx.x, lane = tid & 63, wid = tid >> 6, wm = wid >> 1, wn = wid & 1;
    const int m0 = tm * 256, n0 = tn * 128;
    float2* STL = (float2*)(lds + 49152);
    const bf16_t* ga[4];
    const bf16_t* gw[2];
#pragma unroll
    for (int i = 0; i < 4; ++i) {
        const int r = (wid * 4 + i) * 16 + (lane >> 2);
        const int gsw = (0x1320 >> (((r >> 2) & 3) * 4)) & 3;
        ga[i] = A + (size_t)(m0 + r) * 1024 + ((lane & 3) ^ gsw) * 8;
    }
#pragma unroll
    for (int i = 0; i < 2; ++i) {
        const int r = (wid * 2 + i) * 16 + (lane >> 2);
        const int gsw = (0x1320 >> (((r >> 2) & 3) * 4)) & 3;
        gw[i] = W + (size_t)(n0 + r) * 1024 + ((lane & 3) ^ gsw) * 8;
    }
    unsigned char* lbA = lds + wid * 4096;
    unsigned char* lbW = lds + 16384 + wid * 2048;
#define GEMM_STAGE(slot, kt)                                                                                                   \
    do {                                                                                                                       \
        _Pragma("unroll") for (int i = 0; i < 4; ++i)                                                                          \
            __builtin_amdgcn_global_load_lds((const unsigned*)(ga[i] + (kt) * 32), (unsigned*)(lbA + (slot) * 24576 + i * 1024), 16, 0, 0);  \
        _Pragma("unroll") for (int i = 0; i < 2; ++i)                                                                          \
            __builtin_amdgcn_global_load_lds((const unsigned*)(gw[i] + (kt) * 32), (unsigned*)(lbW + (slot) * 24576 + i * 1024), 16, 0, 0);  \
    } while (0)
    GEMM_STAGE(0, 0);
    if (MODE == 3 || MODE == 4 || MODE == 5) {
        __syncthreads();
        const float4* pp = (const float4*)(p.ws + (MODE == 5 ? WS_LNP2 : WS_LNP1)) + (size_t)(m0 + tid) * 8;
        float s1 = 0.f, s2 = 0.f;
#pragma unroll
        for (int i = 0; i < 8; ++i) { const float4 v = pp[i]; s1 += v.x + v.z; s2 += v.y + v.w; }
        const float mean = s1 * (1.f / 1024.f);
        const float var = fmaxf(s2 * (1.f / 1024.f) - mean * mean, 0.f);
        STL[tid] = make_float2(mean, rsqrtf(var + LN_EPS));
        if (MODE != 4) {
            const float* pp = (const float*)(p.ws + WS_C12) + (size_t)((MODE == 5 ? 16 : 0) * 2 + (tid >> 7)) * 1024 + n0 + (tid & 127);
            float t = 0.f;
#pragma unroll
            for (int i = 0; i < 16; ++i) t += pp[i * 2048];
            ((float*)(lds + 49152 + 2048))[tid] = t;
        }
    }
    f32x4 acc[4][8];
#pragma unroll
    for (int i = 0; i < 4; ++i)
#pragma unroll
        for (int j = 0; j < 8; ++j) acc[i][j] = (f32x4){0.f, 0.f, 0.f, 0.f};
    const int fr = lane & 15, fq = lane >> 4;
    const int fsw = (0x1320 >> (((fr >> 2) & 3) * 4)) & 3;
    const int aoff = (wm * 128 + fr) * 64 + ((fq ^ fsw) << 4);
    const int boff = 16384 + (wn * 64 + fr) * 64 + ((fq ^ fsw) << 4);
#pragma unroll 1
    for (int kt = 0; kt < 32; ++kt) {
        asm volatile("s_waitcnt vmcnt(0)\n\ts_waitcnt lgkmcnt(0)" ::: "memory");
        __builtin_amdgcn_s_barrier(); asm volatile("" ::: "memory");
        if (kt + 1 < 32) { if (kt & 1) GEMM_STAGE(0, kt + 1); else GEMM_STAGE(1, kt + 1); }
        const unsigned char* sb = lds + (kt & 1) * 24576;
        bf16x8 af[8], wf[4];
#pragma unroll
        for (int t = 0; t < 8; ++t) af[t] = *(const bf16x8*)(sb + aoff + t * 1024);
#pragma unroll
        for (int t = 0; t < 4; ++t) wf[t] = *(const bf16x8*)(sb + boff + t * 1024);
#pragma unroll
        for (int nt = 0; nt < 4; ++nt)
#pragma unroll
            for (int mt = 0; mt < 8; ++mt) acc[nt][mt] = __builtin_amdgcn_mfma_f32_16x16x32_bf16(wf[nt], af[mt], acc[nt][mt], 0, 0, 0);
    }
    asm volatile("s_waitcnt lgkmcnt(0)" ::: "memory");
    __builtin_amdgcn_s_barrier(); asm volatile("" ::: "memory");
#undef GEMM_STAGE
    if (MODE == 3 || MODE == 5) {
        bf16_t* O = (bf16_t*)(p.ws + (MODE == 3 ? WS_QX : WS_QP));
        const float* C12L = (const float*)(lds + 49152 + 2048);
#pragma unroll
        for (int nt = 0; nt < 4; ++nt) {
            const int n = n0 + wn * 64 + nt * 16 + fq * 4;
            const float4 c1 = *(const float4*)(C12L + (n - n0)), c2 = *(const float4*)(C12L + 128 + (n - n0));
#pragma unroll
            for (int mt = 0; mt < 8; ++mt) {
                const int ml = wm * 128 + mt * 16 + fr;
                const float2 st = STL[ml];
                const f32x4 c = acc[nt][mt];
                uint2 u;
                u.x = pk_bf16(st.y * (c[0] - st.x * c1.x) + c2.x, st.y * (c[1] - st.x * c1.y) + c2.y);
                u.y = pk_bf16(st.y * (c[2] - st.x * c1.z) + c2.z, st.y * (c[3] - st.x * c1.w) + c2.w);
                *(uint2*)(O + (size_t)(m0 + ml) * 1024 + n) = u;
            }
        }
    } else if (MODE == 4) {
        bf16_t* YB = (bf16_t*)(p.ws + WS_YB);
        float4 g4[4], b4[4];
#pragma unroll
        for (int nt = 0; nt < 4; ++nt) {
            const int n = n0 + wn * 64 + nt * 16 + fq * 4;
            g4[nt] = *(const float4*)(p.ln_g + n);
            b4[nt] = *(const float4*)(p.ln_b + n);
        }
#pragma unroll
        for (int mt = 0; mt < 8; ++mt) {
            const int ml = wm * 128 + mt * 16 + fr;
            const float2 st = STL[ml];
            bf16_t* yrow = YB + (size_t)(m0 + ml) * 1024 + n0 + wn * 64 + fq * 4;
            float s1 = 0.f, s2 = 0.f;
#pragma unroll
            for (int nt = 0; nt < 4; ++nt) {
                const f32x4 c = acc[nt][mt];
                const uint2 yb = *(const uint2*)(yrow + nt * 16);
                const float y0 = ALPHA * ((bflo(yb.x) - st.x) * st.y * g4[nt].x + b4[nt].x) + c[0];
                const float y1 = ALPHA * ((bfhi(yb.x) - st.x) * st.y * g4[nt].y + b4[nt].y) + c[1];
                const float y2 = ALPHA * ((bflo(yb.y) - st.x) * st.y * g4[nt].z + b4[nt].z) + c[2];
                const float y3 = ALPHA * ((bfhi(yb.y) - st.x) * st.y * g4[nt].w + b4[nt].w) + c[3];
                s1 += (y0 + y1) + (y2 + y3);
                s2 += (y0 * y0 + y1 * y1) + (y2 * y2 + y3 * y3);
                *(uint2*)(yrow + nt * 16) = make_uint2(pk_bf16(y0, y1), pk_bf16(y2, y3));
            }
            s1 += __shfl_xor(s1, 16); s2 += __shfl_xor(s2, 16);
            s1 += __shfl_xor(s1, 32); s2 += __shfl_xor(s2, 32);
            if (fq == 0) ((float2*)(p.ws + WS_LNP2))[(size_t)(m0 + ml) * 16 + tn * 2 + wn] = make_float2(s1, s2);
            asm volatile("" ::: "memory");
        }
    } else {
#pragma unroll
    for (int mt = 0; mt < 8; ++mt) {
        const size_t m = (size_t)m0 + wm * 128 + mt * 16 + fr;
        float s1 = 0.f, s2 = 0.f;
#pragma unroll
        for (int nt = 0; nt < 4; ++nt) {
            const int n = n0 + wn * 64 + nt * 16 + fq * 4;
            const f32x4 c = acc[nt][mt];
            if (MODE == 0 || MODE == 1) {
                constexpr int NS = MODE == 0 ? INC : 2048;
                bf16_t* O = (bf16_t*)(p.ws + (MODE == 0 ? WS_HB : WS_KVM));
                if (MODE == 1 && tn >= 8) {
                    bf16_t* VMT = (bf16_t*)(p.ws + WS_VMT);
                    const int nn = n - 1024;
                    const size_t base = (((size_t)(m >> 8) * 4 + (nn >> 8)) * 256 + (nn & 255)) * 256 + (m & 255);
#pragma unroll
                    for (int i = 0; i < 4; ++i) VMT[base + (size_t)i * 256] = f2bf(c[i]);
                } else if (MODE == 0 && (tn == 7 || tn == 9)) {
                    bf16_t* VT = (bf16_t*)(p.ws + WS_VT);
                    const int which = tn == 9 ? 1 : 0;
                    const size_t base = ((((size_t)which * B_ + (m >> 11)) * 2 + wn) * 64 + nt * 16 + fq * 4) * 2048 + (m & 2047);
#pragma unroll
                    for (int i = 0; i < 4; ++i) VT[base + (size_t)i * 2048] = f2bf(c[i]);
                } else if (MODE != 0 || n < INC) {
                    uint2 u;
                    u.x = pk_bf16(c[0], c[1]);
                    u.y = pk_bf16(c[2], c[3]);
                    *(uint2*)(O + m * NS + n) = u;
                }
            } else if (MODE == 2) {
                const float4 xv = *(const float4*)(p.x + m * 1024 + n);
                const float y0 = ALPHA * xv.x + c[0], y1 = ALPHA * xv.y + c[1], y2 = ALPHA * xv.z + c[2], y3 = ALPHA * xv.w + c[3];
                s1 += (y0 + y1) + (y2 + y3);
                s2 += (y0 * y0 + y1 * y1) + (y2 * y2 + y3 * y3);
                *(uint2*)((bf16_t*)(p.ws + WS_YB) + m * 1024 + n) = make_uint2(pk_bf16(y0, y1), pk_bf16(y2, y3));
            }
        }
        if (MODE == 2) {
            s1 += __shfl_xor(s1, 16); s2 += __shfl_xor(s2, 16);
            s1 += __shfl_xor(s1, 32); s2 += __shfl_xor(s2, 32);
            if (fq == 0) ((float2*)(p.ws + WS_LNP1))[m * 16 + tn * 2 + wn] = make_float2(s1, s2);
        }
    }
    }
}


template <int MODE>
DEV void gemm_item(const P& p, int q, int j, unsigned char* lds) {
    int tm, tn;
    if (MODE == 0) {
        tm = q * 8 + (j & 7);
        tn = j >> 3;
    } else if (MODE == 1) {
        tm = q; tn = j;
    } else {
        tm = q * 8 + (j & 7);
        tn = j >> 3;
    }
    gemm_mfma_tile256<MODE>(p, tm, tn, lds);
}

DEV void transpose_tile(const float* W, int N, bf16_t* Wt, int tk, int tn, float* s, int ldk = 1024, const float* gk = nullptr,
                        const float* bk = nullptr, float* part = nullptr) {
    const int tid = threadIdx.x;
    const int k0 = tk * 64, n0 = tn * 64;
    float* s2 = s + 64 * 65;
#pragma unroll
    for (int i = 0; i < 4; ++i) {
        const int k = (tid >> 4) + 16 * i, n = (tid & 15) * 4;
        float4 v = make_float4(0.f, 0.f, 0.f, 0.f);
        if (n0 + n < N) v = *(const float4*)(W + (size_t)(k0 + k) * N + n0 + n);
        if (gk) {
            const float g = gk[k0 + k], bb = bk[k0 + k];
            s2[k * 65 + n + 0] = bb * v.x; s2[k * 65 + n + 1] = bb * v.y; s2[k * 65 + n + 2] = bb * v.z; s2[k * 65 + n + 3] = bb * v.w;
            v.x *= g; v.y *= g; v.z *= g; v.w *= g;
        }
        s[k * 65 + n + 0] = v.x; s[k * 65 + n + 1] = v.y; s[k * 65 + n + 2] = v.z; s[k * 65 + n + 3] = v.w;
    }
    __syncthreads();
    {
        const int n = tid >> 2, kc = (tid & 3) * 16;
        unsigned u[8];
#pragma unroll
        for (int j = 0; j < 8; ++j)
            u[j] = (unsigned)f2bf(s[(kc + 2 * j) * 65 + n]) | ((unsigned)f2bf(s[(kc + 2 * j + 1) * 65 + n]) << 16);
        bf16_t* dst = Wt + (size_t)(n0 + n) * ldk + k0 + kc;
        *(uint4*)dst = make_uint4(u[0], u[1], u[2], u[3]);
        *(uint4*)(dst + 8) = make_uint4(u[4], u[5], u[6], u[7]);
    }
    if (part && tid < 128) {
        const int which = tid >> 6, n = tid & 63;
        float t = 0.f;
#pragma unroll 8
        for (int k = 0; k < 64; ++k) t += which ? s2[k * 65 + n] : bf2f(f2bf(s[k * 65 + n]));
        part[which * 1024 + n0 + n] = t;
    }
    __syncthreads();
}
DEV void convert_chunk(const float* src, bf16_t* dst, int item) {
    float4 a[4], b[4];
#pragma unroll
    for (int j = 0; j < 4; ++j) {
        const size_t e = (((size_t)item * 4 + j) * 256 + threadIdx.x) * 8;
        a[j] = *(const float4*)(src + e);
        b[j] = *(const float4*)(src + e + 4);
    }
#pragma unroll
    for (int j = 0; j < 4; ++j) {
        const size_t e = (((size_t)item * 4 + j) * 256 + threadIdx.x) * 8;
        uint4 u;
        u.x = pk_bf16(a[j].x, a[j].y);
        u.y = pk_bf16(a[j].z, a[j].w);
        u.z = pk_bf16(b[j].x, b[j].y);
        u.w = pk_bf16(b[j].z, b[j].w);
        *(uint4*)(dst + e) = u;
    }
}
constexpr int PREP_T0 = 16 * 54, PREP_T3 = PREP_T0 + 512, PREP_T5 = PREP_T3, PREP_X = PREP_T5 + T_ * 1024 / 8192, PREP_M = PREP_X + 2048 * 1024 / 8192, PREP_K = PREP_M + 16 * 128 * 64 / 8192, PREP_W1 = PREP_K + 128, PREP_W2 = PREP_W1 + 4,
              PREP_END = PREP_W2;
DEV void prep_item(const P& p, int it, float* smem) {
    if (it < PREP_T0) transpose_tile(p.w_in, INC, (bf16_t*)(p.ws + WS_WIN_T), it / 54, it % 54, smem);
    else if (it < PREP_T3) { it -= PREP_T0; transpose_tile(p.xa_wkv, 2048, (bf16_t*)(p.ws + WS_WKV_T), it >> 5, it & 31, smem); }
    else if (it < PREP_X) convert_chunk(p.x, (bf16_t*)(p.ws + WS_XB), it - PREP_T5);
    else if (it < PREP_M) convert_chunk(p.mem, (bf16_t*)(p.ws + WS_MEMB), it - PREP_X);
    else if (it < PREP_K) convert_chunk(p.peer_keys, (bf16_t*)(p.ws + WS_PKEY), it - PREP_M);
    else if (it < PREP_W1) {
        it -= PREP_K;
        const int kind = it >> 6, r = it & 63;
        transpose_tile(p.cmp_w1 + (size_t)kind * 2048 * 128, 128, (bf16_t*)(p.ws + WS_W1T) + (size_t)kind * 128 * 2048, r >> 1, r & 1, smem, 2048);
    } else if (it < PREP_W2) {
        it -= PREP_W1;
        const int kind = it >> 1;
        transpose_tile(p.cmp_w2 + (size_t)kind * 128 * 64, 64, (bf16_t*)(p.ws + WS_W2T) + (size_t)kind * 64 * 128, it & 1, 0, smem, 128);
    }
}

DEV void compress_item(const P& p, int item, float* smem) {
    const int tid = threadIdx.x;
    const int g = item & 1;
    int r = item >> 1;
    const int n = r % NCMP;
    r /= NCMP;
    const int b = r & 7, kind = r >> 3;
    const bf16_t* HB = (const bf16_t*)(p.ws + WS_HB);
    float* KC = (float*)(p.ws + WS_KC);
    float* su = smem;
    float* sp = smem + 2048;
    float* sh = smem + 2304;
    const int col = (kind ? C_VC : C_KC) + g * 64;
    for (int i = tid; i < 2048; i += 256) {
        const int l = i >> 6, d = i & 63;
        su[i] = bf2f(HB[(size_t)(b * S_ + 16 * n + l) * INC + col + d]) + p.cmp_pos[(kind * 32 + l) * 64 + d];
    }
    __syncthreads();
    {
        const int j = tid & 127, hf = tid >> 7;
        const float* w1 = p.cmp_w1 + (size_t)kind * 2048 * 128;
        float acc = 0.f;
        for (int i = hf * 1024; i < hf * 1024 + 1024; ++i) acc += su[i] * w1[(size_t)i * 128 + j];
        sp[hf * 128 + j] = acc;
    }
    __syncthreads();
    if (tid < 128) {
        const float v = sp[tid] + sp[128 + tid];
        const float u = 0.7978845608028654f * (v + 0.044715f * v * v * v);
        sh[tid] = 0.5f * v * (1.f + tanhf(u));
    }
    __syncthreads();
    if (tid < 64) {
        const float* w2 = p.cmp_w2 + (size_t)kind * 128 * 64;
        float acc = 0.f;
        for (int j = 0; j < 128; ++j) acc += sh[j] * w2[j * 64 + tid];
        KC[((((size_t)kind * B_ + b) * NCMP + n) * 2 + g) * 64 + tid] = acc;
    }
    __syncthreads();
}

DEV void load_q64_bf(float (&q)[64], const bf16_t* src) {
    const uint4* s4 = (const uint4*)src;
#pragma unroll
    for (int i = 0; i < 8; ++i) {
        const uint4 u = s4[i];
        q[i * 8 + 0] = bflo(u.x); q[i * 8 + 1] = bfhi(u.x); q[i * 8 + 2] = bflo(u.y); q[i * 8 + 3] = bfhi(u.y);
        q[i * 8 + 4] = bflo(u.z); q[i * 8 + 5] = bfhi(u.z); q[i * 8 + 6] = bflo(u.w); q[i * 8 + 7] = bfhi(u.w);
    }
}
DEV float dot64_bf(const float (&q)[64], const bf16_t* kr) {
    const uint4* k4 = (const uint4*)kr;
    float acc = 0.f;
#pragma unroll
    for (int i = 0; i < 8; ++i) {
        const uint4 u = k4[i];
        acc += q[i * 8 + 0] * bflo(u.x) + q[i * 8 + 1] * bfhi(u.x) + q[i * 8 + 2] * bflo(u.y) + q[i * 8 + 3] * bfhi(u.y) +
               q[i * 8 + 4] * bflo(u.z) + q[i * 8 + 5] * bfhi(u.z) + q[i * 8 + 6] * bflo(u.w) + q[i * 8 + 7] * bfhi(u.w);
    }
    return acc;
}
DEV float dot64_f(const float (&q)[64], const float* kr) {
    const float4* k4 = (const float4*)kr;
    float acc = 0.f;
#pragma unroll
    for (int i = 0; i < 16; ++i) {
        const float4 u = k4[i];
        acc += q[i * 4 + 0] * u.x + q[i * 4 + 1] * u.y + q[i * 4 + 2] * u.z + q[i * 4 + 3] * u.w;
    }
    return acc;
}

DEV void attn_block(const float (&q)[64], const bf16_t* krow_lane, const bf16_t* vbase_lane, bool valid, float& m, float& l, float& o) {
    float sc = dot64_bf(q, krow_lane) * 0.125f;
    sc = valid ? sc : -1e30f;
    const float mb = wmax(sc);
    const float mn = fmaxf(m, mb);
    const float corr = expf(m - mn);
    const float e = valid ? expf(sc - mn) : 0.f;
    l = l * corr + wsum(e);
    o *= corr;
#pragma unroll 8
    for (int k = 0; k < 64; ++k) o += __shfl(e, k) * bf2f(vbase_lane[(size_t)k * INC]);
    m = mn;
}

DEV void nsa_item(const P& p, int item) {
    const int lane = threadIdx.x & 63;
    const int g = item & 1;
    const int t = item >> 1;
    const int b = t >> 11, s = t & 2047;
    const bf16_t* HB = (const bf16_t*)(p.ws + WS_HB);
    const float* KC = (const float*)(p.ws + WS_KC);
    bf16_t* OM = (bf16_t*)(p.ws + WS_OM);
    const int cur = s >> 6;
    const int nvalid = (s >= 31) ? (((s - 31) >> 4) + 1) : 0;
    const size_t rowt = (size_t)t * INC;
    float ocmp0 = 0.f, ocmp1 = 0.f, ocmp2 = 0.f, ocmp3 = 0.f;
    float psum0 = 0.f, psum1 = 0.f;
    if (nvalid > 0) {
#pragma unroll 1
        for (int r = 0; r < 4; ++r) {
            const int h = g * 4 + r;
            float q[64];
            load_q64_bf(q, HB + rowt + C_QA + h * 64);
            float sc0 = -1e30f, sc1 = -1e30f;
            if (lane < nvalid) sc0 = dot64_f(q, KC + ((((size_t)0 * B_ + b) * NCMP + lane) * 2 + g) * 64) * 0.125f;
            if (lane + 64 < nvalid) sc1 = dot64_f(q, KC + ((((size_t)0 * B_ + b) * NCMP + lane + 64) * 2 + g) * 64) * 0.125f;
            const float m = wmax(fmaxf(sc0, sc1));
            const float e0 = (lane < nvalid) ? expf(sc0 - m) : 0.f;
            const float e1 = (lane + 64 < nvalid) ? expf(sc1 - m) : 0.f;
            const float l = wsum(e0 + e1);
            const float p0 = e0 / l, p1 = e1 / l;
            psum0 += p0;
            psum1 += p1;
            float oc = 0.f;
            const float* vcb = KC + ((((size_t)1 * B_ + b) * NCMP) * 2 + g) * 64 + lane;
            for (int n = 0; n < nvalid; ++n) {
                const float pn = (n < 64) ? __shfl(p0, n) : __shfl(p1, n - 64);
                oc += pn * vcb[(size_t)n * 128];
            }
            if (r == 0) ocmp0 = oc;
            if (r == 1) ocmp1 = oc;
            if (r == 2) ocmp2 = oc;
            if (r == 3) ocmp3 = oc;
        }
    }
    float imp = 0.f;
#pragma unroll
    for (int dn = -1; dn <= 3; ++dn) {
        const int n = 4 * lane + dn;
        const int nn = n < 0 ? 0 : (n > 127 ? 127 : n);
        const float v0 = __shfl(psum0, nn & 63);
        const float v1 = __shfl(psum1, nn & 63);
        const float v = (nn < 64) ? v0 : v1;
        if (n >= 0 && n <= 126) imp += v;
    }
    float score;
    if (lane > cur) score = -INFINITY;
    else if (lane == 0 || lane == cur || lane == cur - 1) score = 1e4f;
    else score = imp;
    int rank = 0;
#pragma unroll 8
    for (int i = 0; i < 32; ++i) {
        const float si = __shfl(score, i);
        rank += ((si > score) || (si == score && i < lane)) ? 1 : 0;
    }
    const bool sel = (lane <= cur) && (rank < 16);
    const unsigned mask = (unsigned)(__ballot(sel) & 0xffffffffull);
    const int wlo = (s - 511) > 0 ? (s - 511) : 0;
#pragma unroll 1
    for (int r = 0; r < 4; ++r) {
        const int h = g * 4 + r;
        float q[64];
        load_q64_bf(q, HB + rowt + C_QA + h * 64);
        float m = -1e30f, l = 0.f, o = 0.f;
        for (unsigned mm = mask; mm; mm &= mm - 1) {
            const int j = __builtin_ctz(mm);
            const int kpos = j * 64 + lane;
            attn_block(q, HB + (size_t)(b * S_ + kpos) * INC + C_KS + g * 64, HB + (size_t)(b * S_ + j * 64) * INC + C_VS + g * 64 + lane,
                       kpos <= s, m, l, o);
        }
        const float oslc = o / l;
        m = -1e30f; l = 0.f; o = 0.f;
        for (int j = wlo >> 6; j <= cur; ++j) {
            const int kpos = j * 64 + lane;
            attn_block(q, HB + (size_t)(b * S_ + kpos) * INC + C_KW + g * 64, HB + (size_t)(b * S_ + j * 64) * INC + C_VW + g * 64 + lane,
                       (kpos <= s) && (kpos >= wlo), m, l, o);
        }
        const float owin = o / l;
        const float oc = r == 0 ? ocmp0 : (r == 1 ? ocmp1 : (r == 2 ? ocmp2 : ocmp3));
        const float g0 = sigmoidf_(bf2f(HB[rowt + C_GATE + h * 3 + 0]));
        const float g1 = sigmoidf_(bf2f(HB[rowt + C_GATE + h * 3 + 1]));
        const float g2 = sigmoidf_(bf2f(HB[rowt + C_GATE + h * 3 + 2]));
        OM[(size_t)t * 1024 + h * 64 + lane] = f2bf(g0 * oc + g1 * oslc + g2 * owin);
    }
}

DEV void hgrn_item(const P& p, int item, float* smem) {
    const int b = item >> 2, hh = item & 3;
    const int tid = threadIdx.x, dv = tid & 127, half = tid >> 7;
    const bf16_t* HB = (const bf16_t*)(p.ws + WS_HB);
    bf16_t* OM = (bf16_t*)(p.ws + WS_OM);
    float* sf = smem;
    float* sq = smem + 1024;
    float* so = smem + 2048;
    float Sreg[64];
#pragma unroll
    for (int i = 0; i < 64; ++i) Sreg[i] = 0.f;
    const int d = tid & 127;
    float lbv;
    {
        const float l0 = p.lb_logits[hh * 128 + d], l1 = p.lb_logits[512 + hh * 128 + d];
        const float mx = fmaxf(l0, l1);
        const float e0 = expf(l0 - mx), e1 = expf(l1 - mx);
        lbv = e0 / (e0 + e1);
    }
    const int wave = tid >> 6, lane = tid & 63;
    const float nw0 = p.hg_norm_w[hh * 128 + lane], nw1 = p.hg_norm_w[hh * 128 + lane + 64];
    for (int t0 = 0; t0 < S_; t0 += 8) {
#pragma unroll
        for (int i = 0; i < 4; ++i) {
            const int st = (tid >> 7) + 2 * i;
            const size_t tt = (size_t)b * S_ + t0 + st;
            const float fl = bf2f(HB[tt * INC + C_HF + hh * 128 + d]);
            sf[st * 128 + d] = lbv + (1.f - lbv) * sigmoidf_(fl);
            sq[st * 128 + d] = bf2f(HB[tt * INC + C_HQ + hh * 128 + d]);
        }
        float vv[8];
#pragma unroll
        for (int st = 0; st < 8; ++st) vv[st] = bf2f(HB[((size_t)b * S_ + t0 + st) * INC + C_HI + hh * 128 + dv]);
        __syncthreads();
#pragma unroll
        for (int st = 0; st < 8; ++st) {
            float oacc = 0.f;
            const float* pf = sf + st * 128 + half * 64;
            const float* pq = sq + st * 128 + half * 64;
#pragma unroll
            for (int dk = 0; dk < 64; ++dk) {
                const float f = pf[dk];
                Sreg[dk] = f * Sreg[dk] + (1.f - f) * vv[st];
                oacc += pq[dk] * Sreg[dk];
            }
            so[(st * 2 + half) * 128 + dv] = oacc;
        }
        __syncthreads();
#pragma unroll
        for (int u = 0; u < 2; ++u) {
            const int st = wave * 2 + u;
            const float o0 = so[(st * 2 + 0) * 128 + lane] + so[(st * 2 + 1) * 128 + lane];
            const float o1 = so[(st * 2 + 0) * 128 + lane + 64] + so[(st * 2 + 1) * 128 + lane + 64];
            const float ss = wsum(o0 * o0 + o1 * o1);
            const float rs = rsqrtf(ss * (1.f / 128.f) + LN_EPS);
            const size_t tt = (size_t)b * S_ + t0 + st;
            const float gg0 = bf2f(HB[tt * INC + C_HG + hh * 128 + lane]);
            const float gg1 = bf2f(HB[tt * INC + C_HG + hh * 128 + lane + 64]);
            OM[tt * 1024 + 512 + hh * 128 + lane] = f2bf(o0 * rs * nw0 * (gg0 * sigmoidf_(gg0)));
            OM[tt * 1024 + 512 + hh * 128 + lane + 64] = f2bf(o1 * rs * nw1 * (gg1 * sigmoidf_(gg1)));
        }
    }
    __syncthreads();
}

DEV void ln_item(const P& p, int t, int which, int lane) {
    const bf16_t* row = (const bf16_t*)(p.ws + WS_YB) + (size_t)t * 1024;
    float4 v[4];
    float s = 0.f;
#pragma unroll
    for (int i = 0; i < 4; ++i) {
        const uint2 u = *(const uint2*)(row + (i * 64 + lane) * 4);
        v[i] = make_float4(bflo(u.x), bfhi(u.x), bflo(u.y), bfhi(u.y));
        s += v[i].x + v[i].y + v[i].z + v[i].w;
    }
    const float mean = wsum(s) * (1.f / 1024.f);
    float ss = 0.f;
#pragma unroll
    for (int i = 0; i < 4; ++i) {
        v[i].x -= mean; v[i].y -= mean; v[i].z -= mean; v[i].w -= mean;
        ss += v[i].x * v[i].x + v[i].y * v[i].y + v[i].z * v[i].z + v[i].w * v[i].w;
    }
    const float rs = rsqrtf(wsum(ss) * (1.f / 1024.f) + LN_EPS);
#pragma unroll
    for (int i = 0; i < 4; ++i) {
        const int c = (i * 64 + lane) * 4;
        const float4 gg = *(const float4*)(p.ln_g + which * 1024 + c);
        const float4 bb = *(const float4*)(p.ln_b + which * 1024 + c);
        float4 o;
        o.x = v[i].x * rs * gg.x + bb.x; o.y = v[i].y * rs * gg.y + bb.y; o.z = v[i].z * rs * gg.z + bb.z; o.w = v[i].w * rs * gg.w + bb.w;
        uint2 u;
        u.x = pk_bf16(o.x, o.y);
        u.y = pk_bf16(o.z, o.w);
        *(uint2*)((bf16_t*)(p.ws + WS_XB) + (size_t)t * 1024 + c) = u;
    }
}

DEV void xattn_item(const P& p, int item) {
    const int lane = threadIdx.x & 63;
    const int hh = item & 3, t = item >> 2, b = t >> 11;
    const bf16_t* QX = (const bf16_t*)(p.ws + WS_QX);
    const bf16_t* KVM = (const bf16_t*)(p.ws + WS_KVM);
    bf16_t* OX = (bf16_t*)(p.ws + WS_OX);
    float sc[4] = {0.f, 0.f, 0.f, 0.f};
#pragma unroll 1
    for (int c = 0; c < 4; ++c) {
        float q[64];
        load_q64_bf(q, QX + (size_t)t * 1024 + hh * 256 + c * 64);
#pragma unroll
        for (int k = 0; k < 4; ++k) sc[k] += dot64_bf(q, KVM + (size_t)(b * ML_ + lane + 64 * k) * 2048 + hh * 256 + c * 64);
    }
    float mx = -1e30f;
#pragma unroll
    for (int k = 0; k < 4; ++k) { sc[k] *= 0.0625f; mx = fmaxf(mx, sc[k]); }
    mx = wmax(mx);
    float pr[4], ls = 0.f;
#pragma unroll
    for (int k = 0; k < 4; ++k) { pr[k] = expf(sc[k] - mx); ls += pr[k]; }
    ls = wsum(ls);
    const float inv = 1.f / ls;
    float o[4] = {0.f, 0.f, 0.f, 0.f};
#pragma unroll
    for (int k = 0; k < 4; ++k) {
        const bf16_t* vb = KVM + (size_t)(b * ML_ + k * 64) * 2048 + 1024 + hh * 256 + lane;
#pragma unroll 4
        for (int mm = 0; mm < 64; ++mm) {
            const float pm = __shfl(pr[k], mm);
#pragma unroll
            for (int c = 0; c < 4; ++c) o[c] += pm * bf2f(vb[(size_t)mm * 2048 + c * 64]);
        }
    }
#pragma unroll
    for (int c = 0; c < 4; ++c) OX[(size_t)t * 1024 + hh * 256 + c * 64 + lane] = f2bf(o[c] * inv);
}

DEV void wave_argmax(float v, int i, float& bv, int& bi) {
#pragma unroll
    for (int o = 32; o > 0; o >>= 1) {
        const float ov = __shfl_xor(v, o);
        const int oi = __shfl_xor(i, o);
        if (ov > v || (ov == v && oi < i)) { v = ov; i = oi; }
    }
    bv = v; bi = i;
}

DEV void peer_item(const P& p, int t) {
    const int lane = threadIdx.x & 63;
    const float* QP = (const float*)(p.ws + WS_QP);
    float* row = p.out + (size_t)t * 1024;
    float4 xr[4], oacc[4];
#pragma unroll
    for (int i = 0; i < 4; ++i) {
        xr[i] = *(const float4*)(row + (i * 64 + lane) * 4);
        oacc[i] = make_float4(0.f, 0.f, 0.f, 0.f);
    }
#pragma unroll 1
    for (int hh = 0; hh < 8; ++hh) {
        float ts1 = 0.f, ts2 = 0.f;
        int ti1 = 0, ti2 = 0;
#pragma unroll 1
        for (int c = 0; c < 2; ++c) {
            float q[64];
            {
                const float4* q4 = (const float4*)(QP + (size_t)t * 1024 + hh * 128 + c * 64);
#pragma unroll
                for (int i = 0; i < 16; ++i) { const float4 u = q4[i]; q[i * 4] = u.x; q[i * 4 + 1] = u.y; q[i * 4 + 2] = u.z; q[i * 4 + 3] = u.w; }
            }
            const float* kb = p.peer_keys + ((size_t)(hh * 2 + c) * 128) * 64;
            float a0 = dot64_f(q, kb + (size_t)lane * 64);
            float a1 = dot64_f(q, kb + (size_t)(lane + 64) * 64);
            float ts = 0.f;
            int ti = 0;
#pragma unroll 1
            for (int k = 0; k < 16; ++k) {
                float v; int i;
                if (a0 >= a1) { v = a0; i = lane; } else { v = a1; i = lane + 64; }
                float bv; int bi;
                wave_argmax(v, i, bv, bi);
                if (lane == k) { ts = bv; ti = bi; }
                if (bi == lane) a0 = -INFINITY;
                if (bi == lane + 64) a1 = -INFINITY;
            }
            if (c == 0) { ts1 = ts; ti1 = ti; } else { ts2 = ts; ti2 = ti; }
        }
        float cs[4];
        const float s1v = __shfl(ts1, lane >> 2);
#pragma unroll
        for (int u = 0; u < 4; ++u) cs[u] = s1v + __shfl(ts2, (lane & 3) * 4 + u);
        float fs = 0.f;
        int fidx = 0;
#pragma unroll 1
        for (int k = 0; k < 16; ++k) {
            float v = cs[0]; int i = lane * 4;
#pragma unroll
            for (int u = 1; u < 4; ++u) if (cs[u] > v) { v = cs[u]; i = lane * 4 + u; }
            float bv; int bi;
            wave_argmax(v, i, bv, bi);
            if (lane == k) { fs = bv; fidx = bi; }
#pragma unroll
            for (int u = 0; u < 4; ++u) if (bi == lane * 4 + u) cs[u] = -INFINITY;
        }
        const int e1i = __shfl(ti1, fidx >> 4);
        const int e2i = __shfl(ti2, fidx & 15);
        const int eid = e1i * 128 + e2i;
        const float mx = __shfl(fs, 0);
        const float w = (lane < 16) ? expf(fs - mx) : 0.f;
        const float gate = w / wsum(w);
#pragma unroll 1
        for (int k = 0; k < 16; ++k) {
            const int e = __shfl(eid, k);
            const float gt = __shfl(gate, k);
            const float* dr = p.peer_down + (size_t)e * 1024;
            const float* ur = p.peer_up + (size_t)e * 1024;
            float hd = 0.f;
#pragma unroll
            for (int i = 0; i < 4; ++i) {
                const float4 dvv = *(const float4*)(dr + (i * 64 + lane) * 4);
                hd += dvv.x * xr[i].x + dvv.y * xr[i].y + dvv.z * xr[i].z + dvv.w * xr[i].w;
            }
            hd = wsum(hd);
            const float a = 0.5f * hd * (1.f + erff(hd * 0.7071067811865476f)) * gt;
#pragma unroll
            for (int i = 0; i < 4; ++i) {
                const float4 uv = *(const float4*)(ur + (i * 64 + lane) * 4);
                oacc[i].x += a * uv.x; oacc[i].y += a * uv.y; oacc[i].z += a * uv.z; oacc[i].w += a * uv.w;
            }
        }
    }
    float s = 0.f;
    float4 v[4];
#pragma unroll
    for (int i = 0; i < 4; ++i) {
        v[i].x = ALPHA * xr[i].x + oacc[i].x; v[i].y = ALPHA * xr[i].y + oacc[i].y;
        v[i].z = ALPHA * xr[i].z + oacc[i].z; v[i].w = ALPHA * xr[i].w + oacc[i].w;
        s += v[i].x + v[i].y + v[i].z + v[i].w;
    }
    const float mean = wsum(s) * (1.f / 1024.f);
    float ss = 0.f;
#pragma unroll
    for (int i = 0; i < 4; ++i) {
        v[i].x -= mean; v[i].y -= mean; v[i].z -= mean; v[i].w -= mean;
        ss += v[i].x * v[i].x + v[i].y * v[i].y + v[i].z * v[i].z + v[i].w * v[i].w;
    }
    const float rs = rsqrtf(wsum(ss) * (1.f / 1024.f) + LN_EPS);
#pragma unroll
    for (int i = 0; i < 4; ++i) {
        const int c = (i * 64 + lane) * 4;
        const float4 gg = *(const float4*)(p.ln_g + 2 * 1024 + c);
        const float4 bb = *(const float4*)(p.ln_b + 2 * 1024 + c);
        float4 o;
        o.x = v[i].x * rs * gg.x + bb.x; o.y = v[i].y * rs * gg.y + bb.y; o.z = v[i].z * rs * gg.z + bb.z; o.w = v[i].w * rs * gg.w + bb.w;
        *(float4*)(row + c) = o;
    }
}


DEV void compress_item2(const P& p, int item, unsigned char* lds) {
    const int nt8 = item & 7, g = (item >> 3) & 1, b = (item >> 4) & 7, kind = item >> 7;
    const int tid = threadIdx.x, lane = tid & 63, wid = tid >> 6, fr = lane & 15, fq = lane >> 4;
    const bf16_t* HB = (const bf16_t*)(p.ws + WS_HB);
    const bf16_t* W1T = (const bf16_t*)(p.ws + WS_W1T) + (size_t)kind * 128 * 2048;
    const bf16_t* W2T = (const bf16_t*)(p.ws + WS_W2T) + (size_t)kind * 64 * 128;
    const float* posb = p.cmp_pos + (size_t)kind * 2048 + fq * 8;
    const int n0 = nt8 * 16;
    const int kcol = (kind ? C_VC : C_KC) + g * 64;
    const bf16_t* abase = HB + (size_t)(b * S_ + 16 * (n0 + fr)) * INC + kcol + fq * 8;
    const bf16_t* wbase = W1T + (size_t)fr * 2048 + fq * 8;
    f32x4 acc[8];
#pragma unroll
    for (int jt = 0; jt < 8; ++jt) acc[jt] = (f32x4){0.f, 0.f, 0.f, 0.f};
#pragma unroll 4
    for (int k2 = 0; k2 < 16; ++k2) {
        const int ks = wid * 16 + k2;
        bf16x8 af;
        {
            const u32x4 raw = *(const u32x4*)(abase + (size_t)(ks >> 1) * INC + (ks & 1) * 32);
            const float* pp = posb + (ks >> 1) * 64 + (ks & 1) * 32;
            const float4 p0 = *(const float4*)pp, p1 = *(const float4*)(pp + 4);
            u32x4 w;
            w[0] = pk_bf16(bflo(raw[0]) + p0.x, bfhi(raw[0]) + p0.y);
            w[1] = pk_bf16(bflo(raw[1]) + p0.z, bfhi(raw[1]) + p0.w);
            w[2] = pk_bf16(bflo(raw[2]) + p1.x, bfhi(raw[2]) + p1.y);
            w[3] = pk_bf16(bflo(raw[3]) + p1.z, bfhi(raw[3]) + p1.w);
            af = __builtin_bit_cast(bf16x8, w);
        }
#pragma unroll
        for (int jt = 0; jt < 8; ++jt) {
            const bf16x8 wf = *(const bf16x8*)(wbase + (size_t)jt * 16 * 2048 + ks * 32);
            acc[jt] = __builtin_amdgcn_mfma_f32_16x16x32_bf16(wf, af, acc[jt], 0, 0, 0);
        }
    }
    float* PS = (float*)lds;
    bf16_t* HS = (bf16_t*)(lds + 4 * 16 * 132 * 4);
#pragma unroll
    for (int jt = 0; jt < 8; ++jt)
        *(float4*)(PS + (wid * 16 + fr) * 132 + jt * 16 + fq * 4) = make_float4(acc[jt][0], acc[jt][1], acc[jt][2], acc[jt][3]);
    __syncthreads();
    {
        const int r = tid >> 4, jb = (tid & 15) * 8;
        float hv[8];
#pragma unroll
        for (int h2 = 0; h2 < 2; ++h2) {
            float4 s = make_float4(0.f, 0.f, 0.f, 0.f);
#pragma unroll
            for (int w = 0; w < 4; ++w) {
                const float4 v = *(const float4*)(PS + (w * 16 + r) * 132 + jb + h2 * 4);
                s.x += v.x; s.y += v.y; s.z += v.z; s.w += v.w;
            }
            hv[h2 * 4 + 0] = s.x; hv[h2 * 4 + 1] = s.y; hv[h2 * 4 + 2] = s.z; hv[h2 * 4 + 3] = s.w;
        }
#pragma unroll
        for (int i = 0; i < 8; ++i) {
            const float v = hv[i];
            const float u = 0.7978845608028654f * (v + 0.044715f * v * v * v);
            hv[i] = 0.5f * v * (1.f + tanhf(u));
        }
        u32x4 w;
        w[0] = pk_bf16(hv[0], hv[1]); w[1] = pk_bf16(hv[2], hv[3]); w[2] = pk_bf16(hv[4], hv[5]); w[3] = pk_bf16(hv[6], hv[7]);
        *(u32x4*)(HS + r * 136 + jb) = w;
    }
    __syncthreads();
    f32x4 o = (f32x4){0.f, 0.f, 0.f, 0.f};
#pragma unroll
    for (int ks = 0; ks < 4; ++ks) {
        const bf16x8 hf = *(const bf16x8*)(HS + fr * 136 + ks * 32 + fq * 8);
        const bf16x8 wf = *(const bf16x8*)(W2T + (size_t)(wid * 16 + fr) * 128 + ks * 32 + fq * 8);
        if (kind == 0) o = __builtin_amdgcn_mfma_f32_16x16x32_bf16(wf, hf, o, 0, 0, 0);
        else o = __builtin_amdgcn_mfma_f32_16x16x32_bf16(hf, wf, o, 0, 0, 0);
    }
    if (kind == 0) {
        const int n = n0 + fr, e = wid * 16 + fq * 4;
        uint2 u2;
        u2.x = pk_bf16(o[0], o[1]);
        u2.y = pk_bf16(o[2], o[3]);
        if (n == 127) u2 = make_uint2(0u, 0u);
        *(uint2*)((bf16_t*)(p.ws + WS_KCB) + ((size_t)(b * 2 + g) * 128 + n) * 64 + e) = u2;
    } else {
        const int e = wid * 16 + fr, n = n0 + fq * 4;
        const float o3 = (n + 3 == 127) ? 0.f : o[3];
        uint2 u2;
        u2.x = pk_bf16(o[0], o[1]);
        u2.y = pk_bf16(o[2], o3);
        *(uint2*)((bf16_t*)(p.ws + WS_VCT) + ((size_t)(b * 2 + g) * 64 + e) * 128 + n) = u2;
    }
    __syncthreads();
}

constexpr int NSA_IMP = 32768;
constexpr int NSA_SCORE = 49152;
constexpr int NSA_SELM = NSA_SCORE + 4224;

struct NsaTileRegs { u32x4 k[2], v[2]; };
DEV void nsa_load_tile(NsaTileRegs& r, const bf16_t* kbase, size_t kstride, const bf16_t* vbase, size_t vstride, int tid) {
    const int lc = tid & 7, lr = tid >> 3;
#pragma unroll
    for (int i = 0; i < 2; ++i) {
        r.k[i] = *(const u32x4*)(kbase + (size_t)(lr + 32 * i) * kstride + lc * 8);
        r.v[i] = *(const u32x4*)(vbase + (size_t)(lr + 32 * i) * vstride + lc * 8);
    }
}
DEV void nsa_store_tile(const NsaTileRegs& r, unsigned char* stage, int tid) {
    const int lc = tid & 7, lr = tid >> 3;
    const int woff = lr * 128 + ((lc ^ ((lr >> 1) & 7)) << 4);
#pragma unroll
    for (int i = 0; i < 2; ++i) {
        *(u32x4*)(stage + woff + i * 4096) = r.k[i];
        *(u32x4*)(stage + 8192 + woff + i * 4096) = r.v[i];
    }
}
DEV void nsa_dma_tile(const bf16_t* kbase, size_t kstride, const bf16_t* vbase, size_t vstride, unsigned char* stage, int lane, int wid) {
#pragma unroll
    for (int i = 0; i < 2; ++i) {
        const int pc = wid * 2 + i;
        const int r = pc * 8 + (lane >> 3);
        const int c = (lane & 7) ^ ((r >> 1) & 7);
        __builtin_amdgcn_global_load_lds((const unsigned*)(kbase + (size_t)r * kstride + c * 8), (unsigned*)(stage + pc * 1024), 16, 0, 0);
        __builtin_amdgcn_global_load_lds((const unsigned*)(vbase + (size_t)r * vstride + c * 8), (unsigned*)(stage + 8192 + pc * 1024), 16, 0, 0);
    }
}
DEV void nsa_scores(const unsigned char* stage, const bf16x8 (&qf)[2][2], f32x4 (&sc)[4][2], int fr, int fq) {
    const int sw = (fr >> 1) & 7;
    const int c0 = (fq ^ sw) << 4;
    const unsigned char* rowp = stage + fr * 128;
    const unsigned char* p0 = rowp + c0;
    const unsigned char* p1 = rowp + (c0 ^ 64);
#pragma unroll
    for (int kt = 0; kt < 4; ++kt) {
        const bf16x8 k0 = *(const bf16x8*)(p0 + kt * 2048);
        const bf16x8 k1 = *(const bf16x8*)(p1 + kt * 2048);
#pragma unroll
        for (int qt = 0; qt < 2; ++qt) {
            f32x4 a = (f32x4){0.f, 0.f, 0.f, 0.f};
            a = __builtin_amdgcn_mfma_f32_16x16x32_bf16(k0, qf[qt][0], a, 0, 0, 0);
            a = __builtin_amdgcn_mfma_f32_16x16x32_bf16(k1, qf[qt][1], a, 0, 0, 0);
            sc[kt][qt] = a;
        }
    }
}
DEV void nsa_pv(const unsigned char* stage, const f32x4 (&sc)[4][2], f32x4 (&o)[4][2], int fr, int fq) {
    const int sw = (fr >> 1) & 7;
    const int v0 = (((fq >> 1) ^ sw) << 4) + 8 * (fq & 1);
    const unsigned char* rowp = stage + 8192 + fr * 128;
#pragma unroll
    for (int s = 0; s < 2; ++s) {
        u32x4 pf[2];
#pragma unroll
        for (int qt = 0; qt < 2; ++qt) {
            pf[qt][0] = pk_bf16(sc[2 * s][qt][0], sc[2 * s][qt][1]);
            pf[qt][1] = pk_bf16(sc[2 * s][qt][2], sc[2 * s][qt][3]);
            pf[qt][2] = pk_bf16(sc[2 * s + 1][qt][0], sc[2 * s + 1][qt][1]);
            pf[qt][3] = pk_bf16(sc[2 * s + 1][qt][2], sc[2 * s + 1][qt][3]);
        }
        const unsigned char* plo = rowp + (v0 ^ (64 * s));
        const unsigned char* phi = rowp + (v0 ^ (64 * s) ^ 32);
#pragma unroll
        for (int dt = 0; dt < 4; ++dt) {
            const uint2 lo = *(const uint2*)(plo + dt * 2048);
            const uint2 hi = *(const uint2*)(phi + dt * 2048);
            u32x4 vv;
            vv[0] = lo.x; vv[1] = lo.y; vv[2] = hi.x; vv[3] = hi.y;
            const bf16x8 vf = __builtin_bit_cast(bf16x8, vv);
#pragma unroll
            for (int qt = 0; qt < 2; ++qt)
                o[dt][qt] = __builtin_amdgcn_mfma_f32_16x16x32_bf16(vf, __builtin_bit_cast(bf16x8, pf[qt]), o[dt][qt], 0, 0, 0);
        }
    }
}
DEV float xmax4(float v) { v = fmaxf(v, __shfl_xor(v, 16)); return fmaxf(v, __shfl_xor(v, 32)); }
DEV float xsum4(float v) { v += __shfl_xor(v, 16); return v + __shfl_xor(v, 32); }

DEV void nsa_branch(const int mode, const int BR, const int q0v, const unsigned char* wsb, unsigned char* lds, int b, int g, unsigned blocks, const bf16x8 (&qf)[2][2], const int (&qpos)[2],
                    const unsigned (&selm)[2], const float (&gate)[2], f32x4 (&fin)[4][2], int tid) {
    asm volatile("" : "+v"(tid));
    const int fr = tid & 15, fq = (tid >> 4) & 3;
    const bf16_t* HB = (const bf16_t*)(wsb + WS_HB);
    const bf16_t* VT = (const bf16_t*)(wsb + WS_VT);
    const bf16_t* kb0 = HB + (size_t)(b * S_) * INC + (BR == 0 ? C_KS : C_KW) + g * 64;
    const bf16_t* vb0 = VT + ((((size_t)BR * B_ + b) * 2 + g) * 64) * 2048;
    const bool fake = mode == 1;
    float m[2] = {-1e30f, -1e30f}, l[2] = {0.f, 0.f};
    f32x4 o[4][2];
#pragma unroll
    for (int dt = 0; dt < 4; ++dt)
#pragma unroll
        for (int qt = 0; qt < 2; ++qt) o[dt][qt] = (f32x4){0.f, 0.f, 0.f, 0.f};
    const int lane64 = tid & 63, widx = __builtin_amdgcn_readfirstlane(tid >> 6);
    int kb = __builtin_ctz(blocks);
    blocks &= blocks - 1;
    int kb1 = blocks ? __builtin_ctz(blocks) : -1;
    if (kb1 >= 0) blocks &= blocks - 1;
    nsa_dma_tile(kb0 + (size_t)(fake ? 0 : kb) * 64 * INC, INC, vb0 + (fake ? 0 : kb) * 64, 2048, lds, lane64, widx);
    if (kb1 >= 0) nsa_dma_tile(kb0 + (size_t)(fake ? 0 : kb1) * 64 * INC, INC, vb0 + (fake ? 0 : kb1) * 64, 2048, lds + 16384, lane64, widx);
    int slot = 0;
    while (true) {
        if (kb1 >= 0) asm volatile("s_waitcnt vmcnt(4)\n\ts_waitcnt lgkmcnt(0)" ::: "memory");
        else asm volatile("s_waitcnt vmcnt(0)\n\ts_waitcnt lgkmcnt(0)" ::: "memory");
        __builtin_amdgcn_s_barrier(); asm volatile("" ::: "memory");
        const int kb2 = blocks ? __builtin_ctz(blocks) : -1;
        if (kb2 >= 0) {
            blocks &= blocks - 1;
            const int s2 = slot >= 1 ? slot - 1 : 2;
            nsa_dma_tile(kb0 + (size_t)(fake ? 0 : kb2) * 64 * INC, INC, vb0 + (fake ? 0 : kb2) * 64, 2048, lds + s2 * 16384, lane64, widx);
        }
        const unsigned char* stage = lds + slot * 16384;
        f32x4 sc[4][2];
        nsa_scores(stage, qf, sc, fr, fq);
        constexpr float C1 = 0.125f * 1.4426950408889634f;
        const bool need_mask = (BR == 0) ? (kb == (q0v >> 6)) : !((kb * 64 + 63 <= q0v) && (kb * 64 + 511 >= q0v + 31));
        float alpha[2];
        if (!need_mask) {
#pragma unroll
            for (int qt = 0; qt < 2; ++qt) {
                const bool sel = BR == 0 ? ((selm[qt] >> kb) & 1u) != 0u : true;
                float bm = -1e30f;
#pragma unroll
                for (int kt = 0; kt < 4; ++kt)
#pragma unroll
                    for (int i = 0; i < 4; ++i) {
                        const float s = sel ? sc[kt][qt][i] * C1 : -1e30f;
                        sc[kt][qt][i] = s;
                        bm = fmaxf(bm, s);
                    }
                bm = xmax4(bm);
                const float mn = fmaxf(m[qt], bm);
                alpha[qt] = __builtin_amdgcn_exp2f(m[qt] - mn);
                float ps = 0.f;
#pragma unroll
                for (int kt = 0; kt < 4; ++kt)
#pragma unroll
                    for (int i = 0; i < 4; ++i) {
                        const float s = sc[kt][qt][i];
                        const float e = (s > -1e29f) ? __builtin_amdgcn_exp2f(s - mn) : 0.f;
                        sc[kt][qt][i] = e;
                        ps += e;
                    }
                l[qt] = l[qt] * alpha[qt] + ps;
                m[qt] = mn;
            }
        } else {
#pragma unroll
            for (int qt = 0; qt < 2; ++qt) {
                const bool sel = BR == 0 ? ((selm[qt] >> kb) & 1u) != 0u : true;
                float bm = -1e30f;
#pragma unroll
                for (int kt = 0; kt < 4; ++kt)
#pragma unroll
                    for (int i = 0; i < 4; ++i) {
                        const int key = kb * 64 + kt * 16 + fq * 4 + i;
                        bool valid = sel && (key <= qpos[qt]);
                        if (BR == 1) valid = valid && (key + 511 >= qpos[qt]);
                        const float s = valid ? sc[kt][qt][i] * C1 : -1e30f;
                        sc[kt][qt][i] = s;
                        bm = fmaxf(bm, s);
                    }
                bm = xmax4(bm);
                const float mn = fmaxf(m[qt], bm);
                alpha[qt] = __builtin_amdgcn_exp2f(m[qt] - mn);
                float ps = 0.f;
#pragma unroll
                for (int kt = 0; kt < 4; ++kt)
#pragma unroll
                    for (int i = 0; i < 4; ++i) {
                        const float s = sc[kt][qt][i];
                        const float e = (s > -1e29f) ? __builtin_amdgcn_exp2f(s - mn) : 0.f;
                        sc[kt][qt][i] = e;
                        ps += e;
                    }
                l[qt] = l[qt] * alpha[qt] + ps;
                m[qt] = mn;
            }
        }
        {
#pragma unroll
            for (int qt = 0; qt < 2; ++qt)
#pragma unroll
                for (int dt = 0; dt < 4; ++dt) o[dt][qt] *= alpha[qt];
        }
        if (mode != 3) nsa_pv(stage, sc, o, fr, fq);
        else { asm volatile("" :: "v"(sc[0][0][0]), "v"(sc[1][1][1]), "v"(sc[2][0][2]), "v"(sc[3][1][3])); }
        if (kb1 < 0) break;
        kb = kb1;
        kb1 = kb2;
        slot = slot == 2 ? 0 : slot + 1;
    }
#pragma unroll
    for (int qt = 0; qt < 2; ++qt) {
        const float lt = xsum4(l[qt]);
        const float sc2 = lt > 0.f ? gate[qt] / lt : 0.f;
#pragma unroll
        for (int dt = 0; dt < 4; ++dt) fin[dt][qt] += o[dt][qt] * sc2;
    }
    asm volatile("s_waitcnt lgkmcnt(0)" ::: "memory");
    __builtin_amdgcn_s_barrier(); asm volatile("" ::: "memory");
}

DEV void nsa_item2(const P& p, int b, int g, int qblk, unsigned char* lds, int fake = 0) {
    int tid = threadIdx.x;
    asm volatile("" : "+v"(tid));
    const int lane = tid & 63, wid = tid >> 6, fr = lane & 15, fq = lane >> 4;
    const int q0 = qblk * 32, cur = q0 >> 6, h = g * 4 + wid;
    unsigned char* wsb = p.ws;
    asm volatile("" : "+s"(wsb));
    const bf16_t* HB = (const bf16_t*)(wsb + WS_HB);
    float* IMPW = (float*)(lds + NSA_IMP);
    float* SCORE = (float*)(lds + NSA_SCORE);
    unsigned* SELM = (unsigned*)(lds + NSA_SELM);
    bf16x8 qf[2][2];
    int qpos[2];
#pragma unroll
    for (int qt = 0; qt < 2; ++qt) {
        qpos[qt] = q0 + qt * 16 + fr;
        const bf16_t* rowp = HB + (size_t)(b * S_ + qpos[qt]) * INC;
#pragma unroll
        for (int ks = 0; ks < 2; ++ks) qf[qt][ks] = *(const bf16x8*)(rowp + C_QA + h * 64 + ks * 32 + fq * 8);
    }
    if (tid < 33) SELM[tid] = 0u;
    f32x4 fin[4][2];
#pragma unroll
    for (int dt = 0; dt < 4; ++dt)
#pragma unroll
        for (int qt = 0; qt < 2; ++qt) fin[dt][qt] = (f32x4){0.f, 0.f, 0.f, 0.f};
    {
        const bf16_t* KCB = (const bf16_t*)(wsb + WS_KCB) + (size_t)(b * 2 + g) * 128 * 64;
        const bf16_t* VCT = (const bf16_t*)(wsb + WS_VCT) + (size_t)(b * 2 + g) * 64 * 128;
        {
            const int widx = __builtin_amdgcn_readfirstlane(wid);
            nsa_dma_tile(KCB, 64, VCT, 128, lds, lane, widx);
            nsa_dma_tile(KCB + 64 * 64, 64, VCT + 64, 128, lds + 16384, lane, widx);
            asm volatile("s_waitcnt vmcnt(0)" ::: "memory");
        }
        __syncthreads();
        int nv[2];
        float mx[2] = {-1e30f, -1e30f}, inv[2];
#pragma unroll
        for (int qt = 0; qt < 2; ++qt) nv[qt] = qpos[qt] >= 31 ? (((qpos[qt] - 31) >> 4) + 1) : 0;
#pragma unroll 1
        for (int kb = 0; kb < 2; ++kb) {
            f32x4 sc[4][2];
            nsa_scores(lds + kb * 16384, qf, sc, fr, fq);
#pragma unroll
            for (int qt = 0; qt < 2; ++qt)
#pragma unroll
                for (int kt = 0; kt < 4; ++kt)
#pragma unroll
                    for (int i = 0; i < 4; ++i) {
                        const int n = kb * 64 + kt * 16 + fq * 4 + i;
                        mx[qt] = fmaxf(mx[qt], (n < nv[qt]) ? sc[kt][qt][i] * 0.125f : -1e30f);
                    }
        }
        float ps[2] = {0.f, 0.f};
#pragma unroll
        for (int qt = 0; qt < 2; ++qt) mx[qt] = xmax4(mx[qt]);
#pragma unroll 1
        for (int kb = 0; kb < 2; ++kb) {
            f32x4 sc[4][2];
            nsa_scores(lds + kb * 16384, qf, sc, fr, fq);
#pragma unroll
            for (int qt = 0; qt < 2; ++qt)
#pragma unroll
                for (int kt = 0; kt < 4; ++kt)
#pragma unroll
                    for (int i = 0; i < 4; ++i) {
                        const int n = kb * 64 + kt * 16 + fq * 4 + i;
                        ps[qt] += (n < nv[qt]) ? __expf(sc[kt][qt][i] * 0.125f - mx[qt]) : 0.f;
                    }
        }
#pragma unroll
        for (int qt = 0; qt < 2; ++qt) {
            ps[qt] = xsum4(ps[qt]);
            inv[qt] = ps[qt] > 0.f ? 1.f / ps[qt] : 0.f;
        }
        float prev3[2] = {0.f, 0.f};
#pragma unroll 1
        for (int kb = 0; kb < 2; ++kb) {
            f32x4 sc[4][2];
            nsa_scores(lds + kb * 16384, qf, sc, fr, fq);
#pragma unroll
            for (int qt = 0; qt < 2; ++qt) {
                float* impw = IMPW + (wid * 32 + qt * 16 + fr) * 32 + kb * 16 + fq;
#pragma unroll
                for (int kt = 0; kt < 4; ++kt) {
                    f32x4 pv;
#pragma unroll
                    for (int i = 0; i < 4; ++i) {
                        const int n = kb * 64 + kt * 16 + fq * 4 + i;
                        pv[i] = (n < nv[qt]) ? __expf(sc[kt][qt][i] * 0.125f - mx[qt]) * inv[qt] : 0.f;
                    }
                    sc[kt][qt] = pv;
                    const float c1 = __shfl_up(pv[3], 16);
                    const float c0 = __shfl(prev3[qt], fr + 48);
                    impw[kt * 4] = pv[0] + pv[1] + pv[2] + pv[3] + (fq > 0 ? c1 : c0);
                    prev3[qt] = pv[3];
                }
            }
            nsa_pv(lds + kb * 16384, sc, fin, fr, fq);
        }
#pragma unroll
        for (int qt = 0; qt < 2; ++qt) {
            const float gc = fsigmoid(bf2f(HB[(size_t)(b * S_ + qpos[qt]) * INC + C_GATE + h * 3 + 0]));
#pragma unroll
            for (int dt = 0; dt < 4; ++dt) fin[dt][qt] *= gc;
        }
    }
    __syncthreads();
    {
        const int q = tid >> 3, jg = tid & 7;
#pragma unroll
        for (int u = 0; u < 4; ++u) {
            const int j = jg * 4 + u;
            const float imp = IMPW[(0 * 32 + q) * 32 + j] + IMPW[(1 * 32 + q) * 32 + j] + IMPW[(2 * 32 + q) * 32 + j] + IMPW[(3 * 32 + q) * 32 + j];
            float score;
            if (j > cur) score = -INFINITY;
            else if (j == 0 || j == cur || j == cur - 1) score = 1e4f;
            else score = imp;
            SCORE[q * 33 + j] = score;
        }
        __syncthreads();
        unsigned bits = 0u;
#pragma unroll
        for (int u = 0; u < 4; ++u) {
            const int j = jg * 4 + u;
            const float sj = SCORE[q * 33 + j];
            int rank = 0;
#pragma unroll 8
            for (int i = 0; i < 32; ++i) {
                const float si = SCORE[q * 33 + i];
                rank += ((si > sj) || (si == sj && i < j)) ? 1 : 0;
            }
            if (j <= cur && rank < 16) bits |= 1u << j;
        }
        atomicOr(&SELM[q], bits);
        atomicOr(&SELM[32], bits);
        __syncthreads();
    }
    unsigned selm[2];
    selm[0] = SELM[fr];
    selm[1] = SELM[16 + fr];
    const unsigned um = SELM[32];
    __syncthreads();
#pragma unroll 1
    for (int br = 0; br < 2; ++br) {
        const int wlo = (q0 - 511) > 0 ? ((q0 - 511) >> 6) : 0;
        const unsigned wmask = ((2u << cur) - 1u) & ~((1u << wlo) - 1u);
        float gs[2];
#pragma unroll
        for (int qt = 0; qt < 2; ++qt) gs[qt] = fsigmoid(bf2f(HB[(size_t)(b * S_ + qpos[qt]) * INC + C_GATE + h * 3 + 1 + br]));
        if (fake != 2) nsa_branch(fake, br, q0, wsb, lds, b, g, br ? wmask : um, qf, qpos, selm, gs, fin, tid);
    }
    bf16_t* OM = (bf16_t*)(wsb + WS_OM);
#pragma unroll
    for (int qt = 0; qt < 2; ++qt)
#pragma unroll
        for (int dt = 0; dt < 4; ++dt) {
            uint2 u2;
            u2.x = pk_bf16(fin[dt][qt][0], fin[dt][qt][1]);
            u2.y = pk_bf16(fin[dt][qt][2], fin[dt][qt][3]);
            *(uint2*)(OM + (size_t)(b * S_ + qpos[qt]) * 1024 + h * 64 + dt * 16 + fq * 4) = u2;
        }
}

DEV void hgrn_prep_item(const P& p, int item, float* smem) {
    const int c = item & 31, bh = item >> 5, hh = bh & 3, b = bh >> 2;
    const int tid = threadIdx.x, d = tid & 127, th = tid >> 7;
    const bf16_t* HB = (const bf16_t*)(p.ws + WS_HB);
    unsigned char* hs = (unsigned char*)p.out;
    bf16_t* QT = (bf16_t*)(hs + HS_QT);
    bf16_t* KT = (bf16_t*)(hs + HS_KT);
    bf16_t* KHT = (bf16_t*)(hs + HS_KHT);
    bf16_t* VIT = (bf16_t*)(hs + HS_VIT);
    float lbv;
    {
        const float l0 = p.lb_logits[hh * 128 + d], l1 = p.lb_logits[512 + hh * 128 + d];
        const float mx = fmaxf(l0, l1);
        const float e0 = expf(l0 - mx), e1 = expf(l1 - mx);
        lbv = e0 / (e0 + e1);
    }
    const size_t trow0 = (size_t)b * S_ + c * 64 + th * 32;
    float kk[32], bl[32];
    float run = 0.f;
#pragma unroll
    for (int i = 0; i < 32; ++i) {
        const float fl = bf2f(HB[(trow0 + i) * INC + C_HF + hh * 128 + d]);
        const float f = lbv + (1.f - lbv) * fsigmoid(fl);
        kk[i] = 1.f - f;
        run += __logf(f);
        bl[i] = run;
    }
    smem[th * 128 + d] = run;
    __syncthreads();
    const float off = th ? smem[d] : 0.f;
    const float blast = smem[d] + smem[128 + d];
    unsigned kh[16], vi[16];
#pragma unroll
    for (int i = 0; i < 32; i += 2) {
        float qv[2], kt[2], khv[2], vv[2];
#pragma unroll
        for (int u = 0; u < 2; ++u) {
            const float bb = bl[i + u] + off;
            const size_t tr = trow0 + i + u;
            const float q = bf2f(HB[tr * INC + C_HQ + hh * 128 + d]);
            vv[u] = bf2f(HB[tr * INC + C_HI + hh * 128 + d]);
            qv[u] = q * __expf(bb);
            kt[u] = kk[i + u] * __expf(fminf(-bb, 80.f));
            khv[u] = kk[i + u] * __expf(blast - bb);
            const size_t o = ((size_t)bh * 2048 + c * 64 + th * 32 + i + u) * 128 + d;
            QT[o] = f2bf(qv[u]);
            KT[o] = f2bf(kt[u]);
        }
        kh[i >> 1] = pk_bf16(khv[0], khv[1]);
        vi[i >> 1] = pk_bf16(vv[0], vv[1]);
    }
    {
        const size_t o = ((size_t)bh * 128 + d) * 2048 + c * 64 + th * 32;
#pragma unroll
        for (int j = 0; j < 4; ++j) {
            u32x4 a, bq;
            a[0] = kh[4 * j]; a[1] = kh[4 * j + 1]; a[2] = kh[4 * j + 2]; a[3] = kh[4 * j + 3];
            bq[0] = vi[4 * j]; bq[1] = vi[4 * j + 1]; bq[2] = vi[4 * j + 2]; bq[3] = vi[4 * j + 3];
            *(u32x4*)(KHT + o + j * 8) = a;
            *(u32x4*)(VIT + o + j * 8) = bq;
        }
    }
    if (th == 0) ((float*)(p.ws + WS_EB))[((size_t)bh * 32 + c) * 128 + d] = expf(blast);
    __syncthreads();
}

DEV bf16x8 ld2x8(const bf16_t* p0, const bf16_t* p1) {
    const uint2 lo = *(const uint2*)p0, hi = *(const uint2*)p1;
    u32x4 v;
    v[0] = lo.x; v[1] = lo.y; v[2] = hi.x; v[3] = hi.y;
    return __builtin_bit_cast(bf16x8, v);
}
struct HgRegs { u32x4 a[4], b[4]; };
DEV void hg_loadA(HgRegs& r, const bf16_t* KT, const bf16_t* QT, int s0, int tid) {
    const unsigned off = (unsigned)(((tid >> 4) * 128 + (tid & 15) * 8) * 2);
    const char* kb = (const char*)(KT + (size_t)s0 * 128);
    const char* qb = (const char*)(QT + (size_t)s0 * 128);
#pragma unroll
    for (int i = 0; i < 4; ++i) {
        r.a[i] = *(const u32x4*)(kb + i * 4096 + off);
        r.b[i] = *(const u32x4*)(qb + i * 4096 + off);
    }
}
DEV void hg_storeA(const HgRegs& r, unsigned char* lds, int tid) {
    const int c16 = tid & 15, r16 = tid >> 4;
    const int o16 = r16 * 256 + ((c16 ^ (r16 & 15)) << 4);
#pragma unroll
    for (int i = 0; i < 4; ++i) {
        *(u32x4*)(lds + o16 + i * 4096) = r.a[i];
        *(u32x4*)(lds + 16384 + o16 + i * 4096) = r.b[i];
    }
}
DEV void hg_loadB(HgRegs& r, const bf16_t* KHT, const bf16_t* VIT, int s0, int tid) {
    const unsigned off = (unsigned)(((tid >> 3) * 2048 + (tid & 7) * 8) * 2);
    const char* kb = (const char*)(KHT + s0);
    const char* vb = (const char*)(VIT + s0);
#pragma unroll
    for (int i = 0; i < 4; ++i) {
        r.a[i] = *(const u32x4*)(kb + (size_t)i * 131072 + off);
        r.b[i] = *(const u32x4*)(vb + (size_t)i * 131072 + off);
    }
}
DEV void hg_storeB(const HgRegs& r, unsigned char* lds, int tid) {
    const int c8 = tid & 7, r8 = tid >> 3;
    const int o8 = r8 * 128 + ((c8 ^ ((r8 >> 1) & 7)) << 4);
#pragma unroll
    for (int i = 0; i < 4; ++i) {
        *(u32x4*)(lds + 32768 + o8 + i * 4096) = r.a[i];
        *(u32x4*)(lds + 49152 + o8 + i * 4096) = r.b[i];
    }
}
DEV void hgrn_chain_item(const P& p, int bh, unsigned char* lds) {
    const int hh = bh & 3, b = bh >> 2;
    int tid = threadIdx.x;
    asm volatile("" : "+v"(tid));
    const int lane = tid & 63, wid = tid >> 6, fr = lane & 15, fq = lane >> 4;
    const unsigned char* hs = (const unsigned char*)p.out;
    const bf16_t* QT = (const bf16_t*)(hs + HS_QT) + (size_t)bh * 2048 * 128;
    const bf16_t* KT = (const bf16_t*)(hs + HS_KT) + (size_t)bh * 2048 * 128;
    const bf16_t* KHT = (const bf16_t*)(hs + HS_KHT) + (size_t)bh * 128 * 2048;
    const bf16_t* VIT = (const bf16_t*)(hs + HS_VIT) + (size_t)bh * 128 * 2048;
    const float* EB = (const float*)(p.ws + WS_EB) + (size_t)bh * 32 * 128;
    const bf16_t* HB = (const bf16_t*)(p.ws + WS_HB);
    bf16_t* OM = (bf16_t*)(p.ws + WS_OM);
    const unsigned char* sKT = lds;
    const unsigned char* sQT = lds + 16384;
    const unsigned char* sKH = lds + 32768;
    const unsigned char* sVI = lds + 49152;
    bf16_t* AT = (bf16_t*)lds;
    float* SS = (float*)(lds + 65536);
    f32x4 S[8][2];
#pragma unroll
    for (int i = 0; i < 8; ++i)
#pragma unroll
        for (int j = 0; j < 2; ++j) S[i][j] = (f32x4){0.f, 0.f, 0.f, 0.f};
    const int dv0 = wid * 32;
    const int sw8 = (fr >> 1) & 7;
    int b256[4];
#pragma unroll
    for (int ks = 0; ks < 4; ++ks) b256[ks] = fr * 256 + (((4 * ks + fq) ^ fr) << 4);
    int p256[4][2];
#pragma unroll
    for (int u = 0; u < 4; ++u)
#pragma unroll
        for (int h = 0; h < 2; ++h) p256[u][h] = fr * 256 + (((4 * u + 2 * h + (fq >> 1)) ^ fr) << 4) + 8 * (fq & 1);
    int b128[2];
#pragma unroll
    for (int ks = 0; ks < 2; ++ks) b128[ks] = fr * 128 + (((4 * ks + fq) ^ sw8) << 4);
    {
        HgRegs r;
        hg_loadA(r, KT, QT, 0, tid);
        hg_storeA(r, lds, tid);
        hg_loadB(r, KHT, VIT, 0, tid);
        hg_storeB(r, lds, tid);
    }
    __syncthreads();
#pragma unroll 1
    for (int c = 0; c < 32; ++c) {
        const int s0 = c * 64;
        HgRegs nx;
        if (c + 1 < 32) hg_loadA(nx, KT, QT, s0 + 64, tid);
        uint2 atp[4];
        {
            bf16x8 qf[4];
#pragma unroll
            for (int ks = 0; ks < 4; ++ks) qf[ks] = *(const bf16x8*)(sQT + wid * 4096 + b256[ks]);
#pragma unroll
            for (int st = 0; st < 4; ++st) {
                f32x4 a = (f32x4){0.f, 0.f, 0.f, 0.f};
#pragma unroll
                for (int ks = 0; ks < 4; ++ks) {
                    const bf16x8 kf = *(const bf16x8*)(sKT + st * 4096 + b256[ks]);
                    a = __builtin_amdgcn_mfma_f32_16x16x32_bf16(kf, qf[ks], a, 0, 0, 0);
                }
                const int t = wid * 16 + fr;
                float av[4];
#pragma unroll
                for (int i = 0; i < 4; ++i) av[i] = (st * 16 + fq * 4 + i <= t) ? a[i] : 0.f;
                atp[st].x = pk_bf16(av[0], av[1]);
                atp[st].y = pk_bf16(av[2], av[3]);
            }
        }
        __syncthreads();
#pragma unroll
        for (int st = 0; st < 4; ++st) *(uint2*)(AT + (wid * 16 + fr) * 72 + st * 16 + fq * 4) = atp[st];
        __syncthreads();
        f32x4 o[2][4];
#pragma unroll
        for (int i = 0; i < 2; ++i)
#pragma unroll
            for (int j = 0; j < 4; ++j) o[i][j] = (f32x4){0.f, 0.f, 0.f, 0.f};
        bf16x8 vf[2][2];
#pragma unroll
        for (int dvt = 0; dvt < 2; ++dvt)
#pragma unroll
            for (int ks = 0; ks < 2; ++ks) vf[dvt][ks] = *(const bf16x8*)(sVI + wid * 4096 + dvt * 2048 + b128[ks]);
#pragma unroll
        for (int ks = 0; ks < 2; ++ks)
#pragma unroll
            for (int tt = 0; tt < 4; ++tt) {
                const bf16x8 af = *(const bf16x8*)(AT + (tt * 16 + fr) * 72 + ks * 32 + fq * 8);
#pragma unroll
                for (int dvt = 0; dvt < 2; ++dvt) o[dvt][tt] = __builtin_amdgcn_mfma_f32_16x16x32_bf16(vf[dvt][ks], af, o[dvt][tt], 0, 0, 0);
            }
#pragma unroll
        for (int u = 0; u < 4; ++u) {
            bf16x8 sf[2];
#pragma unroll
            for (int dvt = 0; dvt < 2; ++dvt) {
                u32x4 w;
                w[0] = pk_bf16(S[2 * u][dvt][0], S[2 * u][dvt][1]);
                w[1] = pk_bf16(S[2 * u][dvt][2], S[2 * u][dvt][3]);
                w[2] = pk_bf16(S[2 * u + 1][dvt][0], S[2 * u + 1][dvt][1]);
                w[3] = pk_bf16(S[2 * u + 1][dvt][2], S[2 * u + 1][dvt][3]);
                sf[dvt] = __builtin_bit_cast(bf16x8, w);
            }
#pragma unroll
            for (int tt = 0; tt < 4; ++tt) {
                const uint2 lo = *(const uint2*)(sQT + tt * 4096 + p256[u][0]);
                const uint2 hi = *(const uint2*)(sQT + tt * 4096 + p256[u][1]);
                u32x4 w;
                w[0] = lo.x; w[1] = lo.y; w[2] = hi.x; w[3] = hi.y;
                const bf16x8 qf2 = __builtin_bit_cast(bf16x8, w);
#pragma unroll
                for (int dvt = 0; dvt < 2; ++dvt) o[dvt][tt] = __builtin_amdgcn_mfma_f32_16x16x32_bf16(sf[dvt], qf2, o[dvt][tt], 0, 0, 0);
            }
        }
        u32x4 op[4];
#pragma unroll
        for (int tt = 0; tt < 4; ++tt) {
            float ss = 0.f;
#pragma unroll
            for (int dvt = 0; dvt < 2; ++dvt)
#pragma unroll
                for (int i = 0; i < 4; ++i) ss += o[dvt][tt][i] * o[dvt][tt][i];
            ss = xsum4(ss);
            if (fq == 0) SS[wid * 64 + tt * 16 + fr] = ss;
            op[tt][0] = pk_bf16(o[0][tt][0], o[0][tt][1]);
            op[tt][1] = pk_bf16(o[0][tt][2], o[0][tt][3]);
            op[tt][2] = pk_bf16(o[1][tt][0], o[1][tt][1]);
            op[tt][3] = pk_bf16(o[1][tt][2], o[1][tt][3]);
        }
        __syncthreads();
        if (c + 1 < 32) { hg_storeA(nx, lds, tid); hg_loadB(nx, KHT, VIT, s0 + 64, tid); }
        uint2 gg[4][2];
#pragma unroll
        for (int tt = 0; tt < 4; ++tt)
#pragma unroll
            for (int dvt = 0; dvt < 2; ++dvt)
                gg[tt][dvt] = *(const uint2*)(HB + ((size_t)b * S_ + s0 + tt * 16 + fr) * INC + C_HG + hh * 128 + dv0 + dvt * 16 + fq * 4);
        {
            bf16x8 vf3[2][2];
#pragma unroll
            for (int dvt = 0; dvt < 2; ++dvt)
#pragma unroll
                for (int ks = 0; ks < 2; ++ks) vf3[dvt][ks] = *(const bf16x8*)(sVI + wid * 4096 + dvt * 2048 + b128[ks]);
#pragma unroll
            for (int dkt = 0; dkt < 8; ++dkt) {
                const float4 eb = *(const float4*)(EB + c * 128 + dkt * 16 + fq * 4);
                bf16x8 kf[2];
#pragma unroll
                for (int ks = 0; ks < 2; ++ks) kf[ks] = *(const bf16x8*)(sKH + dkt * 2048 + b128[ks]);
#pragma unroll
                for (int dvt = 0; dvt < 2; ++dvt) {
                    f32x4 a = S[dkt][dvt];
                    a[0] *= eb.x; a[1] *= eb.y; a[2] *= eb.z; a[3] *= eb.w;
                    a = __builtin_amdgcn_mfma_f32_16x16x32_bf16(kf[0], vf3[dvt][0], a, 0, 0, 0);
                    a = __builtin_amdgcn_mfma_f32_16x16x32_bf16(kf[1], vf3[dvt][1], a, 0, 0, 0);
                    S[dkt][dvt] = a;
                }
            }
        }
        __syncthreads();
        if (c + 1 < 32) hg_storeB(nx, lds, tid);
#pragma unroll
        for (int tt = 0; tt < 4; ++tt) {
            const int t = tt * 16 + fr;
            const float tot = SS[t] + SS[64 + t] + SS[128 + t] + SS[192 + t];
            const float rs = rsqrtf(tot * (1.f / 128.f) + LN_EPS);
            const size_t tg = (size_t)b * S_ + s0 + t;
#pragma unroll
            for (int dvt = 0; dvt < 2; ++dvt) {
                const int dv = dv0 + dvt * 16 + fq * 4;
                const float g0 = bflo(gg[tt][dvt].x), g1 = bfhi(gg[tt][dvt].x), g2 = bflo(gg[tt][dvt].y), g3 = bfhi(gg[tt][dvt].y);
                const float4 nwv = *(const float4*)(p.hg_norm_w + hh * 128 + dv);
                const unsigned w0 = op[tt][2 * dvt], w1 = op[tt][2 * dvt + 1];
                const float r0 = bflo(w0) * rs * nwv.x * (g0 * fsigmoid(g0));
                const float r1 = bfhi(w0) * rs * nwv.y * (g1 * fsigmoid(g1));
                const float r2 = bflo(w1) * rs * nwv.z * (g2 * fsigmoid(g2));
                const float r3 = bfhi(w1) * rs * nwv.w * (g3 * fsigmoid(g3));
                uint2 u2;
                u2.x = pk_bf16(r0, r1);
                u2.y = pk_bf16(r2, r3);
                *(uint2*)(OM + tg * 1024 + 512 + hh * 128 + dv) = u2;
            }
        }
        __syncthreads();
    }
}


DEV void hgrn_prep_item2(const P& p, int item, unsigned char* lds) {
    const int c = item & 31, bh = item >> 5, hh = bh & 3, b = bh >> 2;
    int tid = threadIdx.x;
    asm volatile("" : "+v"(tid));
    const int d = tid & 127, th = tid >> 7;
    const int lane = tid & 63, wid = tid >> 6, fr = lane & 15, fq = lane >> 4;
    const bf16_t* HB = (const bf16_t*)(p.ws + WS_HB);
    unsigned char* hs = (unsigned char*)p.out;
    bf16_t* QTg = (bf16_t*)(hs + HS_QT);
    bf16_t* OIg = (bf16_t*)(hs + HS_OI);
    uint2* DSg = (uint2*)(hs + HS_DS);
    float* tots = (float*)(lds + 65536);
    unsigned char* sKT = lds;
    unsigned char* sQT = lds + 16384;
    unsigned char* sKH = lds + 32768;
    unsigned char* sVI = lds + 49152;
    float lbv;
    {
        const float l0 = p.lb_logits[hh * 128 + d], l1 = p.lb_logits[512 + hh * 128 + d];
        const float mx = fmaxf(l0, l1);
        const float e0 = expf(l0 - mx), e1 = expf(l1 - mx);
        lbv = e0 / (e0 + e1);
    }
    const size_t trow0 = (size_t)b * S_ + c * 64 + th * 32;
    const float nwd = p.hg_norm_w[hh * 128 + d];
    float bl[32];
    float run = 0.f;
#pragma unroll
    for (int i = 0; i < 32; ++i) {
        const float fl = bf2f(HB[(trow0 + i) * INC + C_HF + hh * 128 + d]);
        const float f = lbv + (1.f - lbv) * fsigmoid(fl);
        run += __logf(f);
        bl[i] = run;
    }
    tots[th * 128 + d] = run;
    __syncthreads();
    const float off = th ? tots[d] : 0.f;
    const float blast = tots[d] + tots[128 + d];
#pragma unroll
    for (int j = 0; j < 4; ++j) {
        u32x4 a, bq;
#pragma unroll
        for (int i2 = 0; i2 < 4; ++i2) {
            float khv[2], vv[2];
#pragma unroll
            for (int u = 0; u < 2; ++u) {
                const int i = j * 8 + i2 * 2 + u;
                const float bb = bl[i] + off;
                const float kki = 1.f - __expf(bl[i] - (i ? bl[i > 0 ? i - 1 : 0] : 0.f));
                const size_t tr = trow0 + i;
                const float q = bf2f(HB[tr * INC + C_HQ + hh * 128 + d]);
                vv[u] = bf2f(HB[tr * INC + C_HI + hh * 128 + d]);
                const bf16_t qv = f2bf(q * __expf(bb));
                const bf16_t kt = f2bf(kki * __expf(fminf(-bb, 80.f)));
                khv[u] = kki * __expf(blast - bb);
                const int t = th * 32 + i;
                QTg[((size_t)bh * 2048 + c * 64 + t) * 128 + d] = qv;
                {
                    const float gv = bf2f(HB[tr * INC + C_HG + hh * 128 + d]);
                    ((bf16_t*)(p.ws + WS_XB))[((size_t)bh * 2048 + c * 64 + t) * 128 + d] = f2bf(nwd * gv * fsigmoid(gv));
                }
                const int off256 = t * 256 + ((((d >> 3) ^ (t & 15))) << 4) + (d & 7) * 2;
                *(bf16_t*)(sQT + off256) = qv;
                *(bf16_t*)(sKT + off256) = kt;
            }
            a[i2] = pk_bf16(khv[0], khv[1]);
            bq[i2] = pk_bf16(vv[0], vv[1]);
        }
        const int off128 = d * 128 + (((th * 4 + j) ^ ((d >> 1) & 7)) << 4);
        *(u32x4*)(sKH + off128) = a;
        *(u32x4*)(sVI + off128) = bq;
    }
    if (th == 0) ((float*)(p.ws + WS_EB))[((size_t)bh * 32 + c) * 128 + d] = __expf(blast);
    __syncthreads();
    const int sw8 = (fr >> 1) & 7;
    int b256[4];
#pragma unroll
    for (int ks = 0; ks < 4; ++ks) b256[ks] = fr * 256 + (((4 * ks + fq) ^ fr) << 4);
    int b128[2];
#pragma unroll
    for (int ks = 0; ks < 2; ++ks) b128[ks] = fr * 128 + (((4 * ks + fq) ^ sw8) << 4);
    uint2 atp[4];
    {
        bf16x8 qf[4];
#pragma unroll
        for (int ks = 0; ks < 4; ++ks) qf[ks] = *(const bf16x8*)(sQT + wid * 4096 + b256[ks]);
#pragma unroll
        for (int st = 0; st < 4; ++st) {
            f32x4 a = (f32x4){0.f, 0.f, 0.f, 0.f};
#pragma unroll
            for (int ks = 0; ks < 4; ++ks) {
                const bf16x8 kf = *(const bf16x8*)(sKT + st * 4096 + b256[ks]);
                a = __builtin_amdgcn_mfma_f32_16x16x32_bf16(kf, qf[ks], a, 0, 0, 0);
            }
            const int t = wid * 16 + fr;
            float av[4];
#pragma unroll
            for (int i = 0; i < 4; ++i) av[i] = (st * 16 + fq * 4 + i <= t) ? a[i] : 0.f;
            atp[st].x = pk_bf16(av[0], av[1]);
            atp[st].y = pk_bf16(av[2], av[3]);
        }
    }
    __syncthreads();
    bf16_t* AT = (bf16_t*)lds;
#pragma unroll
    for (int st = 0; st < 4; ++st) *(uint2*)(AT + (wid * 16 + fr) * 72 + st * 16 + fq * 4) = atp[st];
    __syncthreads();
    const int dv0 = wid * 32;
    bf16x8 vf[2][2];
#pragma unroll
    for (int dvt = 0; dvt < 2; ++dvt)
#pragma unroll
        for (int ks = 0; ks < 2; ++ks) vf[dvt][ks] = *(const bf16x8*)(sVI + wid * 4096 + dvt * 2048 + b128[ks]);
#pragma unroll
    for (int tt = 0; tt < 4; ++tt) {
        f32x4 o0 = (f32x4){0.f, 0.f, 0.f, 0.f}, o1 = (f32x4){0.f, 0.f, 0.f, 0.f};
#pragma unroll
        for (int ks = 0; ks < 2; ++ks) {
            const bf16x8 af = *(const bf16x8*)(AT + (tt * 16 + fr) * 72 + ks * 32 + fq * 8);
            o0 = __builtin_amdgcn_mfma_f32_16x16x32_bf16(vf[0][ks], af, o0, 0, 0, 0);
            o1 = __builtin_amdgcn_mfma_f32_16x16x32_bf16(vf[1][ks], af, o1, 0, 0, 0);
        }
        bf16_t* op = OIg + ((size_t)bh * 2048 + c * 64 + tt * 16 + fr) * 128 + dv0 + fq * 4;
        *(uint2*)op = make_uint2(pk_bf16(o0[0], o0[1]), pk_bf16(o0[2], o0[3]));
        *(uint2*)(op + 16) = make_uint2(pk_bf16(o1[0], o1[1]), pk_bf16(o1[2], o1[3]));
    }
    uint2* dsp = DSg + ((((size_t)bh * 32 + c) * 4 + wid) * 16) * 64 + lane;
#pragma unroll
    for (int dkt = 0; dkt < 8; ++dkt) {
        bf16x8 kf[2];
#pragma unroll
        for (int ks = 0; ks < 2; ++ks) kf[ks] = *(const bf16x8*)(sKH + dkt * 2048 + b128[ks]);
#pragma unroll
        for (int dvt = 0; dvt < 2; ++dvt) {
            f32x4 a = (f32x4){0.f, 0.f, 0.f, 0.f};
            a = __builtin_amdgcn_mfma_f32_16x16x32_bf16(kf[0], vf[dvt][0], a, 0, 0, 0);
            a = __builtin_amdgcn_mfma_f32_16x16x32_bf16(kf[1], vf[dvt][1], a, 0, 0, 0);
            dsp[(dkt * 2 + dvt) * 64] = make_uint2(pk_bf16(a[0], a[1]), pk_bf16(a[2], a[3]));
        }
    }
    __syncthreads();
}

DEV void hgrn_chain_item2(const P& p, int bh, unsigned char* lds) {
    const int hh = bh & 3, b = bh >> 2;
    int tid = threadIdx.x;
    asm volatile("" : "+v"(tid));
    const int lane = tid & 63, wid = __builtin_amdgcn_readfirstlane(tid >> 6), fr = lane & 15, fq = lane >> 4;
    const unsigned char* hs = (const unsigned char*)p.out;
    const bf16_t* QTg = (const bf16_t*)(hs + HS_QT) + (size_t)bh * 2048 * 128;
    const char* OIb = (const char*)(hs + HS_OI) + ((size_t)bh * 2048 * 128 + wid * 32) * 2;
    const unsigned oioff = (unsigned)((fr * 128 + fq * 4) * 2);
    const char* DSb = (const char*)(hs + HS_DS) + (((size_t)bh * 32 * 4 + wid) * 16 * 64) * 8;
    const unsigned dsoff = (unsigned)(lane * 8);
    const char* GGb = (const char*)(p.ws + WS_XB) + ((size_t)bh * 2048 * 128 + wid * 32) * 2;
    const unsigned ggoff = oioff;
    const float* EB = (const float*)(p.ws + WS_EB) + (size_t)bh * 32 * 128;
    bf16_t* OM = (bf16_t*)(p.ws + WS_OM);
    float* EBL = (float*)(lds + 16384);
    float* SS = (float*)(lds + 16896);
    const int dv0 = wid * 32;
    int p256[4][2];
#pragma unroll
    for (int u = 0; u < 4; ++u)
#pragma unroll
        for (int h = 0; h < 2; ++h) p256[u][h] = fr * 256 + (((4 * u + 2 * h + (fq >> 1)) ^ fr) << 4) + 8 * (fq & 1);
    const int c16 = tid & 15, r16 = tid >> 4;
    const int o16 = r16 * 256 + ((c16 ^ (r16 & 15)) << 4);
    const unsigned qoff = (unsigned)((r16 * 128 + c16 * 8) * 2);
    f32x4 S[2][2];
    f32x4* SL = (f32x4*)(lds + 17920) + wid * 768 + lane;
#pragma unroll
    for (int i = 0; i < 2; ++i)
#pragma unroll
        for (int j = 0; j < 2; ++j) S[i][j] = (f32x4){0.f, 0.f, 0.f, 0.f};
#pragma unroll
    for (int i = 0; i < 12; ++i) SL[i * 64] = (f32x4){0.f, 0.f, 0.f, 0.f};
    uint2 oi[4][2], dsr[8][2];
    {
        const char* qb = (const char*)QTg;
#pragma unroll
        for (int i = 0; i < 4; ++i) *(u32x4*)(lds + o16 + i * 4096) = *(const u32x4*)(qb + i * 4096 + qoff);
        if (tid < 32) *(u32x4*)(EBL + tid * 4) = *(const u32x4*)(EB + tid * 4);
#pragma unroll
        for (int tt = 0; tt < 4; ++tt)
#pragma unroll
            for (int dvt = 0; dvt < 2; ++dvt) {
                oi[tt][dvt] = *(const uint2*)(OIb + tt * 4096 + dvt * 32 + oioff);
            }
#pragma unroll
        for (int dkt = 0; dkt < 8; ++dkt)
#pragma unroll
            for (int dvt = 0; dvt < 2; ++dvt) dsr[dkt][dvt] = *(const uint2*)(DSb + (dkt * 2 + dvt) * 512 + dsoff);
    }
    __syncthreads();
#pragma unroll 1
    for (int c = 0; c < 32; ++c) {
        const int s0 = c * 64;
        const bool more = c + 1 < 32;
        uint2 gg[4][2];
#pragma unroll
        for (int tt = 0; tt < 4; ++tt)
#pragma unroll
            for (int dvt = 0; dvt < 2; ++dvt) gg[tt][dvt] = *(const uint2*)(GGb + (size_t)s0 * 256 + tt * 4096 + dvt * 32 + ggoff);
        f32x4 o[2][4];
#pragma unroll
        for (int tt = 0; tt < 4; ++tt)
#pragma unroll
            for (int dvt = 0; dvt < 2; ++dvt) {
                o[dvt][tt] = (f32x4){bflo(oi[tt][dvt].x), bfhi(oi[tt][dvt].x), bflo(oi[tt][dvt].y), bfhi(oi[tt][dvt].y)};
                if (more) oi[tt][dvt] = *(const uint2*)(OIb + (size_t)(s0 + 64) * 256 + tt * 4096 + dvt * 32 + oioff);
            }
        const unsigned char* sQ = lds;
#pragma unroll
        for (int u = 0; u < 4; ++u) {
            bf16x8 sf[2];
#pragma unroll
            for (int dvt = 0; dvt < 2; ++dvt) {
                const f32x4 sa = u < 1 ? S[0][dvt] : SL[((2 * u - 2) * 2 + dvt) * 64];
                const f32x4 sb = u < 1 ? S[1][dvt] : SL[((2 * u - 1) * 2 + dvt) * 64];
                u32x4 w;
                w[0] = pk_bf16(sa[0], sa[1]);
                w[1] = pk_bf16(sa[2], sa[3]);
                w[2] = pk_bf16(sb[0], sb[1]);
                w[3] = pk_bf16(sb[2], sb[3]);
                sf[dvt] = __builtin_bit_cast(bf16x8, w);
            }
#pragma unroll
            for (int tt = 0; tt < 4; ++tt) {
                const uint2 lo = *(const uint2*)(sQ + tt * 4096 + p256[u][0]);
                const uint2 hi = *(const uint2*)(sQ + tt * 4096 + p256[u][1]);
                u32x4 w;
                w[0] = lo.x; w[1] = lo.y; w[2] = hi.x; w[3] = hi.y;
                const bf16x8 qf2 = __builtin_bit_cast(bf16x8, w);
#pragma unroll
                for (int dvt = 0; dvt < 2; ++dvt) o[dvt][tt] = __builtin_amdgcn_mfma_f32_16x16x32_bf16(sf[dvt], qf2, o[dvt][tt], 0, 0, 0);
            }
        }
        u32x4 qn[4], ebn;
        if (more) {
            const char* qb = (const char*)(QTg + (size_t)(s0 + 64) * 128);
#pragma unroll
            for (int i = 0; i < 4; ++i) qn[i] = *(const u32x4*)(qb + i * 4096 + qoff);
            if (tid < 32) ebn = *(const u32x4*)(EB + (c + 1) * 128 + tid * 4);
        }
#pragma unroll
        for (int dkt = 0; dkt < 8; ++dkt) {
            const float4 eb = *(const float4*)(EBL + dkt * 16 + fq * 4);
#pragma unroll
            for (int dvt = 0; dvt < 2; ++dvt) {
                const uint2 dd = dsr[dkt][dvt];
                f32x4 sv = dkt < 2 ? S[dkt < 2 ? dkt : 0][dvt] : SL[((dkt - 2) * 2 + dvt) * 64];
                sv[0] = fmaf(sv[0], eb.x, bflo(dd.x));
                sv[1] = fmaf(sv[1], eb.y, bfhi(dd.x));
                sv[2] = fmaf(sv[2], eb.z, bflo(dd.y));
                sv[3] = fmaf(sv[3], eb.w, bfhi(dd.y));
                if (dkt < 2) S[dkt < 2 ? dkt : 0][dvt] = sv; else SL[((dkt - 2) * 2 + dvt) * 64] = sv;
                if (more) dsr[dkt][dvt] = *(const uint2*)(DSb + (size_t)(c + 1) * 32768 + (dkt * 2 + dvt) * 512 + dsoff);
            }
        }
#pragma unroll
        for (int tt = 0; tt < 4; ++tt) {
            float ss = 0.f;
#pragma unroll
            for (int dvt = 0; dvt < 2; ++dvt)
#pragma unroll
                for (int i = 0; i < 4; ++i) ss += o[dvt][tt][i] * o[dvt][tt][i];
            ss = xsum4(ss);
            if (fq == 0) SS[wid * 64 + tt * 16 + fr] = ss;
        }
        __syncthreads();
#pragma unroll
        for (int tt = 0; tt < 4; ++tt) {
            const int t = tt * 16 + fr;
            const float tot = SS[t] + SS[64 + t] + SS[128 + t] + SS[192 + t];
            const float rs = rsqrtf(tot * (1.f / 128.f) + LN_EPS);
            const size_t tg = (size_t)b * S_ + s0 + t;
#pragma unroll
            for (int dvt = 0; dvt < 2; ++dvt) {
                const int dv = dv0 + dvt * 16 + fq * 4;
                const float r0 = o[dvt][tt][0] * rs * bflo(gg[tt][dvt].x);
                const float r1 = o[dvt][tt][1] * rs * bfhi(gg[tt][dvt].x);
                const float r2 = o[dvt][tt][2] * rs * bflo(gg[tt][dvt].y);
                const float r3 = o[dvt][tt][3] * rs * bfhi(gg[tt][dvt].y);
                *(uint2*)(OM + tg * 1024 + 512 + hh * 128 + dv) = make_uint2(pk_bf16(r0, r1), pk_bf16(r2, r3));
            }
        }
        if (more) {
#pragma unroll
            for (int i = 0; i < 4; ++i) *(u32x4*)(lds + o16 + i * 4096) = qn[i];
            if (tid < 32) *(u32x4*)(EBL + tid * 4) = ebn;
        }
        __syncthreads();
    }
}

DEV void xattn_item2(const P& p, int item) {
    const int qt64 = item & 31, hh = (item >> 5) & 3, b = item >> 7;
    const int lane = threadIdx.x & 63, wid = threadIdx.x >> 6, fr = lane & 15, fq = lane >> 4;
    const bf16_t* QX = (const bf16_t*)(p.ws + WS_QX);
    const bf16_t* KVM = (const bf16_t*)(p.ws + WS_KVM);
    const bf16_t* VMT = (const bf16_t*)(p.ws + WS_VMT) + (size_t)(b * 4 + hh) * 256 * 256;
    bf16_t* OX = (bf16_t*)(p.ws + WS_OX);
    const size_t tq = (size_t)b * S_ + qt64 * 64 + wid * 16 + fr;
    bf16x8 qf[8];
#pragma unroll
    for (int ks = 0; ks < 8; ++ks) qf[ks] = *(const bf16x8*)(QX + tq * 1024 + hh * 256 + ks * 32 + fq * 8);
    f32x4 sc[16];
#pragma unroll
    for (int kt = 0; kt < 16; ++kt) {
        f32x4 a = (f32x4){0.f, 0.f, 0.f, 0.f};
        const bf16_t* kp = KVM + (size_t)(b * ML_ + kt * 16 + fr) * 2048 + hh * 256 + fq * 8;
#pragma unroll
        for (int ks = 0; ks < 8; ++ks) a = __builtin_amdgcn_mfma_f32_16x16x32_bf16(*(const bf16x8*)(kp + ks * 32), qf[ks], a, 0, 0, 0);
        sc[kt] = a;
    }
    float mx = -1e30f;
#pragma unroll
    for (int kt = 0; kt < 16; ++kt)
#pragma unroll
        for (int i = 0; i < 4; ++i) { sc[kt][i] *= 0.0625f; mx = fmaxf(mx, sc[kt][i]); }
    mx = xmax4(mx);
    float ps = 0.f;
#pragma unroll
    for (int kt = 0; kt < 16; ++kt)
#pragma unroll
        for (int i = 0; i < 4; ++i) { sc[kt][i] = __expf(sc[kt][i] - mx); ps += sc[kt][i]; }
    ps = xsum4(ps);
    const float inv = 1.f / ps;
    u32x4 pf[8];
#pragma unroll
    for (int s = 0; s < 8; ++s) {
        pf[s][0] = pk_bf16(sc[2 * s][0] * inv, sc[2 * s][1] * inv);
        pf[s][1] = pk_bf16(sc[2 * s][2] * inv, sc[2 * s][3] * inv);
        pf[s][2] = pk_bf16(sc[2 * s + 1][0] * inv, sc[2 * s + 1][1] * inv);
        pf[s][3] = pk_bf16(sc[2 * s + 1][2] * inv, sc[2 * s + 1][3] * inv);
    }
#pragma unroll 1
    for (int dh = 0; dh < 2; ++dh) {
        f32x4 o[8];
#pragma unroll
        for (int dt = 0; dt < 8; ++dt) o[dt] = (f32x4){0.f, 0.f, 0.f, 0.f};
#pragma unroll
        for (int s = 0; s < 8; ++s) {
#pragma unroll
            for (int dt = 0; dt < 8; ++dt) {
                const bf16_t* vp = VMT + (size_t)(dh * 128 + dt * 16 + fr) * 256 + 32 * s + 4 * fq;
                o[dt] = __builtin_amdgcn_mfma_f32_16x16x32_bf16(ld2x8(vp, vp + 16), __builtin_bit_cast(bf16x8, pf[s]), o[dt], 0, 0, 0);
            }
        }
#pragma unroll
        for (int dt = 0; dt < 8; ++dt) {
            uint2 u2;
            u2.x = pk_bf16(o[dt][0], o[dt][1]);
            u2.y = pk_bf16(o[dt][2], o[dt][3]);
            *(uint2*)(OX + tq * 1024 + hh * 256 + dh * 128 + dt * 16 + fq * 4) = u2;
        }
    }
}


struct XaRegs { u32x4 r[8]; };
DEV void xa_loadK(XaRegs& x, const bf16_t* kbase, int tid) {
    const int c = tid & 31, r0 = tid >> 5;
#pragma unroll
    for (int i = 0; i < 8; ++i) x.r[i] = *(const u32x4*)(kbase + (size_t)(r0 + 8 * i) * 2048 + c * 8);
}
DEV void xa_storeK(const XaRegs& x, unsigned char* lds, int tid) {
    const int c = tid & 31, r0 = tid >> 5;
#pragma unroll
    for (int i = 0; i < 8; ++i) {
        const int row = r0 + 8 * i;
        *(u32x4*)(lds + row * 512 + ((c ^ (row & 15)) << 4)) = x.r[i];
    }
}
DEV void xa_loadV(XaRegs& x, const bf16_t* vbase, int tid) {
    const int c = tid & 7, r0 = tid >> 3;
#pragma unroll
    for (int i = 0; i < 8; ++i) x.r[i] = *(const u32x4*)(vbase + (size_t)(r0 + 32 * i) * 256 + c * 8);
}
DEV void xa_storeV(const XaRegs& x, unsigned char* lds, int tid) {
    const int c = tid & 7, r0 = tid >> 3;
    const int o = r0 * 128 + ((c ^ ((r0 >> 1) & 7)) << 4);
#pragma unroll
    for (int i = 0; i < 8; ++i) *(u32x4*)(lds + 32768 + o + i * 4096) = x.r[i];
}
DEV void xattn_item3(const P& p, int item, unsigned char* lds) {
    const int qt64 = item & 31, hh = (item >> 5) & 3, b = item >> 7;
    int tid = threadIdx.x;
    asm volatile("" : "+v"(tid));
    const int lane = tid & 63, wid = tid >> 6, fr = lane & 15, fq = lane >> 4;
    const bf16_t* QX = (const bf16_t*)(p.ws + WS_QX);
    const bf16_t* KB = (const bf16_t*)(p.ws + WS_KVM) + (size_t)(b * ML_) * 2048 + hh * 256;
    const bf16_t* VB = (const bf16_t*)(p.ws + WS_VMT) + (size_t)(b * 4 + hh) * 256 * 256;
    bf16_t* OX = (bf16_t*)(p.ws + WS_OX);
    const size_t tq = (size_t)b * S_ + qt64 * 64 + wid * 16 + fr;
    bf16x8 qf[8];
#pragma unroll
    for (int ks = 0; ks < 8; ++ks) qf[ks] = *(const bf16x8*)(QX + tq * 1024 + hh * 256 + ks * 32 + fq * 8);
    f32x4 o[16];
#pragma unroll
    for (int dt = 0; dt < 16; ++dt) o[dt] = (f32x4){0.f, 0.f, 0.f, 0.f};
    float m = -1e30f, l = 0.f;
    {
        XaRegs x;
        xa_loadK(x, KB, tid);
        xa_storeK(x, lds, tid);
        xa_loadV(x, VB, tid);
        xa_storeV(x, lds, tid);
    }
    __syncthreads();
    const int sw8 = (fr >> 1) & 7;
#pragma unroll 1
    for (int j = 0; j < 4; ++j) {
        XaRegs nx;
        if (j + 1 < 4) xa_loadK(nx, KB + (size_t)(j + 1) * 64 * 2048, tid);
        f32x4 sc[4];
#pragma unroll
        for (int kt = 0; kt < 4; ++kt) {
            f32x4 a = (f32x4){0.f, 0.f, 0.f, 0.f};
            const unsigned char* rp = lds + (kt * 16 + fr) * 512;
#pragma unroll
            for (int ks = 0; ks < 8; ++ks) a = __builtin_amdgcn_mfma_f32_16x16x32_bf16(*(const bf16x8*)(rp + (((4 * ks + fq) ^ fr) << 4)), qf[ks], a, 0, 0, 0);
            sc[kt] = a;
        }
        __syncthreads();
        if (j + 1 < 4) { xa_storeK(nx, lds, tid); xa_loadV(nx, VB + (j + 1) * 64, tid); }
        float bm = -1e30f;
#pragma unroll
        for (int kt = 0; kt < 4; ++kt)
#pragma unroll
            for (int i = 0; i < 4; ++i) { sc[kt][i] *= 0.0625f; bm = fmaxf(bm, sc[kt][i]); }
        bm = xmax4(bm);
        const float mn = fmaxf(m, bm);
        const float alpha = __expf(m - mn);
        float ps = 0.f;
#pragma unroll
        for (int kt = 0; kt < 4; ++kt)
#pragma unroll
            for (int i = 0; i < 4; ++i) { sc[kt][i] = __expf(sc[kt][i] - mn); ps += sc[kt][i]; }
        l = l * alpha + ps;
        m = mn;
#pragma unroll
        for (int dt = 0; dt < 16; ++dt) o[dt] *= alpha;
#pragma unroll
        for (int s = 0; s < 2; ++s) {
            u32x4 w;
            w[0] = pk_bf16(sc[2 * s][0], sc[2 * s][1]);
            w[1] = pk_bf16(sc[2 * s][2], sc[2 * s][3]);
            w[2] = pk_bf16(sc[2 * s + 1][0], sc[2 * s + 1][1]);
            w[3] = pk_bf16(sc[2 * s + 1][2], sc[2 * s + 1][3]);
            const bf16x8 pf = __builtin_bit_cast(bf16x8, w);
#pragma unroll
            for (int dt = 0; dt < 16; ++dt) {
                const unsigned char* rp = lds + 32768 + (dt * 16 + fr) * 128 + 8 * (fq & 1);
                const uint2 lo = *(const uint2*)(rp + (((4 * s + (fq >> 1)) ^ sw8) << 4));
                const uint2 hi = *(const uint2*)(rp + (((4 * s + 2 + (fq >> 1)) ^ sw8) << 4));
                u32x4 vv;
                vv[0] = lo.x; vv[1] = lo.y; vv[2] = hi.x; vv[3] = hi.y;
                o[dt] = __builtin_amdgcn_mfma_f32_16x16x32_bf16(__builtin_bit_cast(bf16x8, vv), pf, o[dt], 0, 0, 0);
            }
        }
        __syncthreads();
        if (j + 1 < 4) xa_storeV(nx, lds, tid);
        __syncthreads();
    }
    const float inv = 1.f / xsum4(l);
#pragma unroll
    for (int dt = 0; dt < 16; ++dt) {
        uint2 u2;
        u2.x = pk_bf16(o[dt][0] * inv, o[dt][1] * inv);
        u2.y = pk_bf16(o[dt][2] * inv, o[dt][3] * inv);
        *(uint2*)(OX + tq * 1024 + hh * 256 + dt * 16 + fq * 4) = u2;
    }
}


DEV void peer_quant_row(const float* src, unsigned char* dst, float* scl, int row, int* rsum = nullptr, int bias = 128) {
    const int lane = threadIdx.x & 63;
    const float* r = src + (size_t)row * 1024 + lane * 16;
    float v[16];
#pragma unroll
    for (int i = 0; i < 4; ++i) {
        const float4 a = *(const float4*)(r + 4 * i);
        v[4 * i] = a.x; v[4 * i + 1] = a.y; v[4 * i + 2] = a.z; v[4 * i + 3] = a.w;
    }
    float mx = 0.f;
#pragma unroll
    for (int i = 0; i < 16; ++i) mx = fmaxf(mx, fabsf(v[i]));
    mx = wmax(mx);
    const float q = mx > 0.f ? 127.f / mx : 0.f;
    u32x4 w;
    int usum = 0;
#pragma unroll
    for (int i = 0; i < 4; ++i) {
        unsigned pk = 0u;
#pragma unroll
        for (int k = 0; k < 4; ++k) {
            int qi = (int)rintf(v[4 * i + k] * q);
            qi = qi < -127 ? -127 : (qi > 127 ? 127 : qi);
            pk |= (unsigned)((qi + bias) & 0xff) << (8 * k);
            usum += qi + 128;
        }
        w[i] = pk;
    }
    *(u32x4*)(dst + ((size_t)(lane >> 3) * 16384 + row) * 128 + (lane & 7) * 16) = w;
    if (rsum) {
#pragma unroll
        for (int o = 32; o > 0; o >>= 1) usum += __shfl_xor(usum, o);
        if (lane == 0) rsum[row] = usum;
    }
    if (lane == 0) scl[row] = mx * (1.f / 127.f);
}

DEV unsigned f2ord(float f) { const unsigned b = __float_as_uint(f); return b ^ ((b >> 31) ? 0xffffffffu : 0x80000000u); }
DEV float ord2f(unsigned o) { return __uint_as_float((o & 0x80000000u) ? (o ^ 0x80000000u) : ~o); }
DEV void ins16(unsigned (&v)[16], unsigned x) {
#pragma unroll
    for (int k = 0; k < 16; ++k) {
        const unsigned t = v[k] > x ? v[k] : x;
        x = v[k] > x ? x : v[k];
        v[k] = t;
    }
}
constexpr int PEER_SC = 0;
constexpr int PEER_LST = 0;
constexpr int PEER_EID = 16384;
constexpr int PEER_GATE = 16384 + 4096;
DEV void peer_route_item(const P& p, int item, unsigned char* lds) {
    const int tid = threadIdx.x, lane = tid & 63, wid = tid >> 6;
    const int t0 = item * 16;
    const bf16_t* QP = (const bf16_t*)(p.ws + WS_QP);
    const bf16_t* PK = (const bf16_t*)(p.ws + WS_PKEY);
    unsigned* SC = (unsigned*)(lds + PEER_SC);
    const int fr = lane & 15, fq = lane >> 4;
    unsigned lst[16];
#pragma unroll
    for (int k = 0; k < 16; ++k) lst[k] = 0u;
    bf16x8 qf[4][2];
#pragma unroll
    for (int ci = 0; ci < 4; ++ci)
#pragma unroll
        for (int ks = 0; ks < 2; ++ks)
            qf[ci][ks] = *(const bf16x8*)(QP + (size_t)(t0 + fr) * 1024 + (4 * wid + ci) * 64 + ks * 32 + fq * 8);
#pragma unroll 1
    for (int pass = 0; pass < 2; ++pass) {
#pragma unroll
        for (int ci = 0; ci < 4; ++ci) {
            const int cb = 4 * wid + ci;
#pragma unroll
            for (int kt = 0; kt < 4; ++kt) {
                f32x4 acc = (f32x4){0.f, 0.f, 0.f, 0.f};
#pragma unroll
                for (int ks = 0; ks < 2; ++ks) {
                    const bf16x8 kf = *(const bf16x8*)(PK + ((size_t)cb * 128 + pass * 64 + kt * 16 + fr) * 64 + ks * 32 + fq * 8);
                    acc = __builtin_amdgcn_mfma_f32_16x16x32_bf16(kf, qf[ci][ks], acc, 0, 0, 0);
                }
                unsigned* dst = SC + (cb * 16 + fr) * 65 + kt * 16 + fq * 4;
#pragma unroll
                for (int i = 0; i < 4; ++i) {
                    const int kidx = pass * 64 + kt * 16 + fq * 4 + i;
                    dst[i] = (f2ord(acc[i]) & ~127u) | (unsigned)(127 - kidx);
                }
            }
        }
        __syncthreads();
        {
            const unsigned* row = SC + tid * 65;
#pragma unroll 4
            for (int k = 0; k < 64; ++k) ins16(lst, row[k]);
        }
        __syncthreads();
    }
    unsigned* LST = (unsigned*)(lds + PEER_LST);
#pragma unroll
    for (int k = 0; k < 16; ++k) LST[tid * 16 + k] = lst[k];
    __syncthreads();
    unsigned short* EID = (unsigned short*)(lds + PEER_EID);
    float* GATE = (float*)(lds + PEER_GATE);
    if (((tid >> 4) & 1) == 0) {
        const int tok = tid & 15, hh = tid >> 5;
        const unsigned* l2 = LST + (tid + 16) * 16;
        float s1[16], s2[16];
#pragma unroll
        for (int k = 0; k < 16; ++k) { s1[k] = ord2f(lst[k] & ~127u); s2[k] = ord2f(l2[k] & ~127u); }
        unsigned fin[16];
#pragma unroll
        for (int k = 0; k < 16; ++k) fin[k] = 0u;
#pragma unroll
        for (int i = 0; i < 16; ++i)
#pragma unroll
            for (int j = 0; j < 16; ++j)
                if ((i + 1) * (j + 1) <= 16) ins16(fin, (f2ord(s1[i] + s2[j]) & ~255u) | (unsigned)(255 - (i * 16 + j)));
        const float mx = ord2f(fin[0] & ~255u);
        float w[16], ws = 0.f;
#pragma unroll
        for (int k = 0; k < 16; ++k) { w[k] = expf(ord2f(fin[k] & ~255u) - mx); ws += w[k]; }
        const float inv = 1.f / ws;
#pragma unroll
        for (int k = 0; k < 16; ++k) {
            const int flat = 255 - (int)(fin[k] & 255u);
            const int i1 = 127 - (int)(LST[tid * 16 + (flat >> 4)] & 127u);
            const int i2 = 127 - (int)(l2[flat & 15] & 127u);
            EID[tok * 128 + hh * 16 + k] = (unsigned short)(i1 * 128 + i2);
            GATE[tok * 128 + hh * 16 + k] = w[k] * inv;
        }
    }
    __syncthreads();
    {
        unsigned short* EIDP = (unsigned short*)(p.ws + WS_EIDP);
        float* GATEP = (float*)(p.ws + WS_GATEP);
        for (int i = tid; i < 16 * 128; i += 256) {
            const int tok = i >> 7, pi = i & 127, eg = pi >> 4, k = pi & 15, slot = 8 * k + eg;
            EIDP[(size_t)(t0 + tok) * 128 + pi] = EID[tok * 128 + slot];
            GATEP[(size_t)(t0 + tok) * 128 + pi] = GATE[tok * 128 + slot];
        }
        unsigned char* XQ = p.ws + WS_XQ;
#pragma unroll 1
        for (int tt = 0; tt < 4; ++tt) {
            const size_t t = (size_t)t0 + wid * 4 + tt;
            float mean, rs;
            {
                float2 pr = make_float2(0.f, 0.f);
                if (lane < 16) pr = ((const float2*)(p.ws + WS_LNP2))[t * 16 + lane];
                const float s1 = wsum(pr.x), s2 = wsum(pr.y);
                mean = s1 * (1.f / 1024.f);
                rs = rsqrtf(fmaxf(s2 * (1.f / 1024.f) - mean * mean, 0.f) + LN_EPS);
                if (lane == 0) ((float2*)(p.ws + WS_ST2))[t] = make_float2(mean, rs);
            }
            const bf16_t* row = (const bf16_t*)(p.ws + WS_YB) + t * 1024 + lane * 16;
            float xr[16];
            float amax = 0.f;
#pragma unroll
            for (int i = 0; i < 2; ++i) {
                const u32x4 a4 = *(const u32x4*)(row + 8 * i);
#pragma unroll
                for (int q = 0; q < 4; ++q) {
                    const float2 g2 = *(const float2*)(p.ln_g + 1024 + lane * 16 + 8 * i + 2 * q);
                    const float2 b2 = *(const float2*)(p.ln_b + 1024 + lane * 16 + 8 * i + 2 * q);
                    xr[8 * i + 2 * q] = (bflo(a4[q]) - mean) * rs * g2.x + b2.x;
                    xr[8 * i + 2 * q + 1] = (bfhi(a4[q]) - mean) * rs * g2.y + b2.y;
                    amax = fmaxf(amax, fmaxf(fabsf(xr[8 * i + 2 * q]), fabsf(xr[8 * i + 2 * q + 1])));
                }
            }
            amax = wmax(amax);
            const float qx = amax > 0.f ? 127.f / amax : 0.f;
            u32x4 w;
            int s_ = 0;
#pragma unroll
            for (int i = 0; i < 4; ++i) {
                unsigned pk = 0u;
#pragma unroll
                for (int k = 0; k < 4; ++k) {
                    int qi = (int)rintf(xr[4 * i + k] * qx);
                    qi = qi < -127 ? -127 : (qi > 127 ? 127 : qi);
                    pk |= (unsigned)(qi + 128) << (8 * k);
                    s_ += qi + 128;
                }
                w[i] = pk;
            }
#pragma unroll
            for (int o = 32; o > 0; o >>= 1) s_ += __shfl_xor(s_, o);
            *(u32x4*)(XQ + t * 1024 + lane * 16) = w;
            if (lane == 0) {
                ((float*)(p.ws + WS_SXF))[t] = amax * (1.f / 127.f);
                ((int*)(p.ws + WS_SXI))[t] = s_;
            }
        }
    }
    __syncthreads();
}

DEV void peer_down_item(const P& p, int s, int tile, int lane, int wid) {
    const unsigned char* PD = p.ws + WS_PD + (size_t)s * 16384 * 128;
    const unsigned short* EIDP = (const unsigned short*)(p.ws + WS_EIDP);
    int* DP = (int*)(p.ws + WS_DP) + (size_t)s * T_ * 128;
    const int eg = lane >> 3, cg = lane & 7;
#pragma unroll 1
    for (int tt = 0; tt < 8; ++tt) {
        const size_t t = (size_t)tile * 32 + wid * 8 + tt;
        const u32x4 xu = *(const u32x4*)(p.ws + WS_XQ + t * 1024 + s * 128 + cg * 16);
        const u32x4 e0 = *(const u32x4*)(EIDP + t * 128 + eg * 16);
        const u32x4 e1 = *(const u32x4*)(EIDP + t * 128 + eg * 16 + 8);
        u32x4 rows[16];
#pragma unroll
        for (int k = 0; k < 16; ++k) {
            const unsigned ew = k < 8 ? e0[k >> 1] : e1[(k - 8) >> 1];
            const unsigned e = (k & 1) ? (ew >> 16) : (ew & 0xffffu);
            rows[k] = *(const u32x4*)(PD + (size_t)e * 128 + cg * 16);
        }
        unsigned v[16];
#pragma unroll
        for (int k = 0; k < 16; ++k) {
            unsigned a_ = 0u;
#pragma unroll
            for (int q = 0; q < 4; ++q) a_ = __builtin_amdgcn_udot4(rows[k][q], xu[q], a_, false);
            v[k] = a_;
        }
        unsigned w8[8], w4[4], w2[2];
        {
            const bool hi = (cg & 4) != 0;
#pragma unroll
            for (int j = 0; j < 8; ++j) {
                const unsigned send = hi ? v[j] : v[j + 8];
                const unsigned keep = hi ? v[j + 8] : v[j];
                w8[j] = keep + (unsigned)__shfl_xor((int)send, 4);
            }
        }
        {
            const bool hi = (cg & 2) != 0;
#pragma unroll
            for (int j = 0; j < 4; ++j) {
                const unsigned send = hi ? w8[j] : w8[j + 4];
                const unsigned keep = hi ? w8[j + 4] : w8[j];
                w4[j] = keep + (unsigned)__shfl_xor((int)send, 2);
            }
        }
        {
            const bool hi = (cg & 1) != 0;
#pragma unroll
            for (int j = 0; j < 2; ++j) {
                const unsigned send = hi ? w4[j] : w4[j + 2];
                const unsigned keep = hi ? w4[j + 2] : w4[j];
                w2[j] = keep + (unsigned)__shfl_xor((int)send, 1);
            }
        }
        *(uint2*)(DP + t * 128 + eg * 16 + 2 * cg) = make_uint2(w2[0], w2[1]);
    }
}

DEV void peer_coef_item(const P& p, int t, int lane) {
    const int* DP = (const int*)(p.ws + WS_DP);
    const unsigned short* EIDP = (const unsigned short*)(p.ws + WS_EIDP);
    const float* GATEP = (const float*)(p.ws + WS_GATEP);
    const float sx = ((const float*)(p.ws + WS_SXF))[t];
    const int sxu = ((const int*)(p.ws + WS_SXI))[t];
    float cf[2];
    float cm = 0.f;
#pragma unroll
    for (int h = 0; h < 2; ++h) {
        const int pi = lane + 64 * h;
        int tot = 0;
#pragma unroll
        for (int s = 0; s < 8; ++s) tot += DP[((size_t)s * T_ + t) * 128 + pi];
        const int e = EIDP[(size_t)t * 128 + pi];
        const int dotq = tot - 128 * ((const int*)(p.ws + WS_PRS))[e] - 128 * sxu + 128 * 128 * 1024;
        const float hv = ((const float*)(p.ws + WS_PSD))[e] * sx * (float)dotq;
        cf[h] = 0.5f * hv * (1.f + erff(hv * 0.7071067811865476f)) * GATEP[(size_t)t * 128 + pi] * ((const float*)(p.ws + WS_PSU))[e];
        cm = fmaxf(cm, fabsf(cf[h]));
    }
    cm = wmax(cm);
    const float qs = cm > 0.f ? 127.f / cm : 0.f;
#pragma unroll
    for (int h = 0; h < 2; ++h) {
        int qi = (int)rintf(cf[h] * qs);
        qi = qi < -127 ? -127 : (qi > 127 ? 127 : qi);
        (p.ws + WS_COEFP)[(size_t)t * 128 + lane + 64 * h] = (unsigned char)(qi & 0xff);
    }
    if (lane == 0) ((float*)(p.ws + WS_ASUM))[t] = cm * (1.f / 127.f);
}

DEV void peer_up_item(const P& p, int s, int tile, int lane, int wid, bool dostore = true) {
    const unsigned char* PU = p.ws + WS_PU + (size_t)s * 16384 * 128;
    const unsigned short* EIDP = (const unsigned short*)(p.ws + WS_EIDP);
    const unsigned char* COEFQ = p.ws + WS_COEFP;
    const int eg = lane >> 3, cg = lane & 7;
#pragma unroll 1
    for (int tt = 0; tt < 8; ++tt) {
        const size_t t = (size_t)tile * 32 + wid * 8 + tt;
        const u32x4 e0 = *(const u32x4*)(EIDP + t * 128 + eg * 16);
        const u32x4 e1 = *(const u32x4*)(EIDP + t * 128 + eg * 16 + 8);
        const u32x4 cq = *(const u32x4*)(COEFQ + t * 128 + eg * 16);
        u32x4 rows[16];
#pragma unroll
        for (int k = 0; k < 16; ++k) {
            const unsigned ew = k < 8 ? e0[k >> 1] : e1[(k - 8) >> 1];
            const unsigned e = (k & 1) ? (ew >> 16) : (ew & 0xffffu);
            rows[k] = *(const u32x4*)(PU + (size_t)e * 128 + cg * 16);
        }
        int acc[16];
#pragma unroll
        for (int i = 0; i < 16; ++i) acc[i] = 0;
#pragma unroll
        for (int g = 0; g < 4; ++g)
#pragma unroll
            for (int q = 0; q < 4; ++q) {
                const unsigned r0 = rows[4 * g][q], r1 = rows[4 * g + 1][q], r2 = rows[4 * g + 2][q], r3 = rows[4 * g + 3][q];
                const unsigned a0 = __builtin_amdgcn_perm(r1, r0, 0x05010400u), a1 = __builtin_amdgcn_perm(r1, r0, 0x07030602u);
                const unsigned b0 = __builtin_amdgcn_perm(r3, r2, 0x05010400u), b1 = __builtin_amdgcn_perm(r3, r2, 0x07030602u);
                const unsigned t0 = __builtin_amdgcn_perm(b0, a0, 0x05040100u), t1 = __builtin_amdgcn_perm(b0, a0, 0x07060302u);
                const unsigned t2 = __builtin_amdgcn_perm(b1, a1, 0x05040100u), t3 = __builtin_amdgcn_perm(b1, a1, 0x07060302u);
                acc[4 * q] = __builtin_amdgcn_sdot4((int)t0, (int)cq[g], acc[4 * q], false);
                acc[4 * q + 1] = __builtin_amdgcn_sdot4((int)t1, (int)cq[g], acc[4 * q + 1], false);
                acc[4 * q + 2] = __builtin_amdgcn_sdot4((int)t2, (int)cq[g], acc[4 * q + 2], false);
                acc[4 * q + 3] = __builtin_amdgcn_sdot4((int)t3, (int)cq[g], acc[4 * q + 3], false);
            }
        int a8[8], a4[4], a2[2];
        {
            const bool hi = (eg & 4) != 0;
#pragma unroll
            for (int j = 0; j < 8; ++j) {
                const int send = hi ? acc[j] : acc[j + 8];
                const int keep = hi ? acc[j + 8] : acc[j];
                a8[j] = keep + __shfl_xor(send, 32);
            }
        }
        {
            const bool hi = (eg & 2) != 0;
#pragma unroll
            for (int j = 0; j < 4; ++j) {
                const int send = hi ? a8[j] : a8[j + 4];
                const int keep = hi ? a8[j + 4] : a8[j];
                a4[j] = keep + __shfl_xor(send, 16);
            }
        }
        {
            const bool hi = (eg & 1) != 0;
#pragma unroll
            for (int j = 0; j < 2; ++j) {
                const int send = hi ? a4[j] : a4[j + 2];
                const int keep = hi ? a4[j + 2] : a4[j];
                a2[j] = keep + __shfl_xor(send, 8);
            }
        }
        const float cs = ((const float*)(p.ws + WS_ASUM))[t];
        const int col = s * 128 + cg * 16 + 2 * eg;
        const float2 st = ((const float2*)(p.ws + WS_ST2))[t];
        const float2 g2 = *(const float2*)(p.ln_g + 1024 + col), b2 = *(const float2*)(p.ln_b + 1024 + col);
        const unsigned xb = *(const unsigned*)((const bf16_t*)(p.ws + WS_YB) + t * 1024 + col);
        const float x0 = (bflo(xb) - st.x) * st.y * g2.x + b2.x, x1 = (bfhi(xb) - st.x) * st.y * g2.y + b2.y;
        if (dostore) *(unsigned*)((bf16_t*)(p.ws + WS_YB) + t * 1024 + col) = pk_bf16(ALPHA * x0 + cs * (float)a2[0], ALPHA * x1 + cs * (float)a2[1]);
    }
}

DEV void ln3_item(const P& p, int t, int lane) {
    float* row = p.out + (size_t)t * 1024;
    const bf16_t* yrow = (const bf16_t*)(p.ws + WS_YB) + (size_t)t * 1024;
    float4 v[4];
    float s = 0.f;
#pragma unroll
    for (int i = 0; i < 4; ++i) {
        const uint2 u = *(const uint2*)(yrow + (i * 64 + lane) * 4);
        v[i] = make_float4(bflo(u.x), bfhi(u.x), bflo(u.y), bfhi(u.y));
        s += v[i].x + v[i].y + v[i].z + v[i].w;
    }
    const float mean = wsum(s) * (1.f / 1024.f);
    float ss = 0.f;
#pragma unroll
    for (int i = 0; i < 4; ++i) {
        v[i].x -= mean; v[i].y -= mean; v[i].z -= mean; v[i].w -= mean;
        ss += v[i].x * v[i].x + v[i].y * v[i].y + v[i].z * v[i].z + v[i].w * v[i].w;
    }
    const float rs = rsqrtf(wsum(ss) * (1.f / 1024.f) + LN_EPS);
#pragma unroll
    for (int i = 0; i < 4; ++i) {
        const int c = (i * 64 + lane) * 4;
        const float4 gg = *(const float4*)(p.ln_g + 2 * 1024 + c);
        const float4 bb = *(const float4*)(p.ln_b + 2 * 1024 + c);
        float4 o;
        o.x = v[i].x * rs * gg.x + bb.x; o.y = v[i].y * rs * gg.y + bb.y; o.z = v[i].z * rs * gg.z + bb.z; o.w = v[i].w * rs * gg.w + bb.w;
        *(float4*)(row + c) = o;
    }
}

#define XB_TMO      128
#define XB_XCNT(j)  (256  + 64 * (j))
#define XB_XSUB(j)  (1280 + 64 * (j))
#define XB_XGEN(j)  (2304 + 64 * (j))
#define XB_TOP      3328
#define XB_TOPGEN   3392
#define XCD_BAR_WORDS 3456
#define XB_SPIN_CAP (1u << 20)
#define LAS __attribute__((address_space(3)))
DEV unsigned xb_ld(unsigned* p) { return __hip_atomic_load(p, __ATOMIC_RELAXED, __HIP_MEMORY_SCOPE_AGENT); }
DEV unsigned xb_add(unsigned* p, unsigned v) { return __hip_atomic_fetch_add(p, v, __ATOMIC_RELAXED, __HIP_MEMORY_SCOPE_AGENT); }
DEV unsigned xb_xcc_id() { return (unsigned)__builtin_amdgcn_s_getreg((3 << 11) | 20) & 0xFu; }
#define XB_SPIN(cond, bar) do { unsigned _sp = 0; while (cond) { __builtin_amdgcn_s_sleep(1); \
    if ((++_sp & 255u) == 0u) { if (xb_ld(&(bar)[XB_TMO])) break; if (_sp > XB_SPIN_CAP) { atomicAdd(&(bar)[XB_TMO], 1u); break; } } } } while (0)
struct XcdBarrier { unsigned* bar; unsigned x; volatile LAS unsigned* st; };
DEV XcdBarrier xcd_barrier_post(unsigned* bar, volatile LAS unsigned* st) {
    XcdBarrier b; b.bar = bar; b.x = xb_xcc_id(); b.st = st;
    if (threadIdx.x == 0) (void)xb_add(&bar[XB_XCNT(b.x)], 1u);
    return b;
}
DEV void xcd_barrier_complete(unsigned* bar, unsigned x, unsigned& nloc, unsigned& nx) {
    const unsigned G = gridDim.x * gridDim.y * gridDim.z;
    unsigned sum, cnt, mine, sp = 0u;
    for (;;) {
        sum = 0u; cnt = 0u; mine = 0u;
#pragma unroll
        for (unsigned j = 0; j < 16; ++j) { const unsigned c = xb_ld(&bar[XB_XCNT(j)]); sum += c; cnt += (c > 0u) ? 1u : 0u; mine = (j == x) ? c : mine; }
        if (sum == G) break;
        __builtin_amdgcn_s_sleep(1);
        if ((++sp & 255u) == 0u) { if (xb_ld(&bar[XB_TMO])) break; if (sp > XB_SPIN_CAP) { atomicAdd(&bar[XB_TMO], 1u); break; } }
    }
    nloc = mine > 0u ? mine : 1u; nx = cnt > 0u ? cnt : 1u;
}
DEV void xcd_barrier(const XcdBarrier& b) {
    asm volatile("s_waitcnt vmcnt(0)" ::: "memory");
    __syncthreads();
    if (threadIdx.x == 0) {
        unsigned* bar = b.bar;
        __builtin_amdgcn_s_waitcnt(0);
        unsigned nloc = b.st[0], nx = b.st[1];
        if (nloc == 0u) { xcd_barrier_complete(bar, b.x, nloc, nx); b.st[0] = nloc; b.st[1] = nx; }
        const unsigned old = xb_add(&bar[XB_XSUB(b.x)], 1u);
        const unsigned gen = old / nloc;
        if (old + 1u == (gen + 1u) * nloc) {
            __builtin_amdgcn_fence(__ATOMIC_RELEASE, "agent");
            asm volatile("s_waitcnt vmcnt(0)" ::: "memory");
            const unsigned og = xb_add(&bar[XB_TOP], 1u);
            const unsigned tg = og / nx;
            if (og + 1u == (tg + 1u) * nx) xb_add(&bar[XB_TOPGEN], 1u);
            else XB_SPIN(xb_ld(&bar[XB_TOPGEN]) == tg, bar);
            __builtin_amdgcn_fence(__ATOMIC_ACQUIRE, "agent");
            xb_add(&bar[XB_XGEN(b.x)], 1u);
            asm volatile("s_waitcnt vmcnt(0)" ::: "memory");
        } else {
            XB_SPIN(xb_ld(&bar[XB_XGEN(b.x)]) == gen, bar);
            __builtin_amdgcn_fence(__ATOMIC_ACQUIRE, "agent");
            asm volatile("s_waitcnt vmcnt(0)" ::: "memory");
        }
    }
    __syncthreads();
}


DEV void late_transpose_item(const P& p, int it, float* smem) {
    const int m = it >> 8, t = it & 255;
    const float* W = m == 0 ? p.w_out : (m == 1 ? p.xa_wq : (m == 2 ? p.xa_wo : p.peer_wq));
    const size_t off = m == 0 ? WS_WOUT_T : (m == 1 ? WS_WQ_T : (m == 2 ? WS_WO_T : WS_PWQ_T));
    const int mat2 = m >> 1;
    if (m & 1) transpose_tile(W, 1024, (bf16_t*)(p.ws + off), t >> 4, t & 15, smem, 1024, p.ln_g + mat2 * 1024, p.ln_b + mat2 * 1024,
                              (float*)(p.ws + WS_C12) + (size_t)(mat2 * 16 + (t >> 4)) * 2048);
    else transpose_tile(W, 1024, (bf16_t*)(p.ws + off), t >> 4, t & 15, smem);
}

constexpr int WQ_WORD0 = 4096;
DEV int wq_next(unsigned* cnt, int nper, int xcc, unsigned char* lds) {
    volatile unsigned* slot = (volatile unsigned*)(lds + LDS_BYTES - 16);
    __syncthreads();
    if (threadIdx.x == 0) {
        int res = -1;
        int off = (int)slot[1];
        while (off < 8) {
            const int q = (xcc + off) & 7;
            const unsigned idx = atomicAdd(&cnt[q * 64], 1u);
            if (idx < (unsigned)nper) { res = q * nper + (int)idx; break; }
            ++off;
        }
        slot[0] = (unsigned)res;
        slot[1] = (unsigned)off;
    }
    __syncthreads();
    return (int)slot[0];
}
DEV void wq_begin(unsigned char* lds) {
    __syncthreads();
    if (threadIdx.x == 0) ((volatile unsigned*)(lds + LDS_BYTES - 16))[1] = 0u;
}

constexpr int NSTAGES = 12;
template <int ST>
DEV void run_stage(const P& p, unsigned char* lds, int xcc) {
    float* smem = (float*)lds;
    const int nb = gridDim.x, bid = blockIdx.x;
    int tidl = threadIdx.x;
    asm volatile("" : "+v"(tidl));
    const int wave = tidl >> 6;
    unsigned* wqc = (unsigned*)(p.ws + WS_BAR) + WQ_WORD0;
    if (ST == 0) {
        for (int it = bid; it < PREP_END; it += nb) prep_item(p, it, smem);
    } else if (ST == 1) {
        for (int it = bid; it < 1536 + 384 + 128; it += nb) {
            if (it < 1536) gemm_item<0>(p, it & 7, it >> 3, lds);
            else if (it < 1920) { const int i2 = it - 1536, q = i2 & 7, j = i2 >> 3; gemm_mfma_tile<0>(p, q * 16 + (j & 15), 24 + (j >> 4), lds); }
            else gemm_item<1>(p, (it - 1920) & 7, (it - 1920) >> 3, lds);
        }
    } else if (ST == 2) {
        if (PROBE_REP == 21) for (int it = bid; it < 256; it += nb) compress_item2(p, it, lds);
        if (PROBE_REP == 22) for (int it = bid; it < 1024; it += nb) hgrn_prep_item(p, it, smem);
        for (int it = bid; it < 256 + 1024; it += nb) {
            if (it < 256) compress_item2(p, it, lds);
            else hgrn_prep_item2(p, it - 256, lds);
        }
    } else if (ST == 3) {
        if (PROBE_REP == 31) { for (int it = bid; it < 32; it += nb) hgrn_chain_item(p, it, lds); }
        if (PROBE_REP == 32) {
            volatile unsigned* qs2 = (volatile unsigned*)(lds + LDS_BYTES - 16);
            for (;;) {
                __syncthreads();
                if (threadIdx.x == 0) *qs2 = atomicAdd(wqc + 64, 1u);
                __syncthreads();
                const int j = (int)*qs2;
                if (j >= 1024) break;
                nsa_item2(p, (j & 15) >> 1, j & 1, 63 - (j >> 4), lds, p.out != nullptr ? 4 : 0);
            }
        }
        volatile unsigned* qslot = (volatile unsigned*)(lds + LDS_BYTES - 16);
        for (;;) {
            __syncthreads();
            if (threadIdx.x == 0) *qslot = atomicAdd(wqc, 1u);
            __syncthreads();
            const int it = (int)*qslot;
            if (it >= 32 + 1024) break;
            if (it < 32) hgrn_chain_item2(p, it, lds);
            else { const int j = it - 32; nsa_item2(p, (j & 15) >> 1, j & 1, 63 - (j >> 4), lds); }
        }
        for (;;) {
            __syncthreads();
            if (threadIdx.x == 0) *qslot = atomicAdd(wqc + 128, 1u);
            __syncthreads();
            const int it = (int)*qslot;
            if (it >= 2048) break;
            if (it < 1024) late_transpose_item(p, it, smem);
            else {
                const int j = it - 1024, tb = j >> 9, r0 = (j & 511) * 32 + wave * 8;
                for (int r = 0; r < 8; ++r) {
                    if (tb == 0) peer_quant_row(p.peer_down, p.ws + WS_PD, (float*)(p.ws + WS_PSD), r0 + r, (int*)(p.ws + WS_PRS));
                    else peer_quant_row(p.peer_up, p.ws + WS_PU, (float*)(p.ws + WS_PSU), r0 + r, nullptr, 0);
                }
            }
        }
    } else if (ST == 4) {
        for (int it = bid; it < 512; it += nb) gemm_item<2>(p, it & 7, it >> 3, lds);
    } else if (ST == 5) {
        for (int it = bid; it < T_ / 4; it += nb) ln_item(p, it * 4 + wave, 0, tidl & 63);
    } else if (ST == 9) {
        for (int it = bid; it < T_ / 4; it += nb) ln_item(p, it * 4 + wave, 1, tidl & 63);
    } else if (ST == 6) {
        for (int it = bid; it < 512; it += nb) gemm_item<3>(p, it & 7, it >> 3, lds);
    } else if (ST == 7) {
        for (int it = bid; it < 1024; it += nb) xattn_item3(p, it, lds);
    } else if (ST == 8) {
        for (int it = bid; it < 512; it += nb) gemm_item<4>(p, it & 7, it >> 3, lds);
    } else if (ST == 10) {
        for (int it = bid; it < 512; it += nb) gemm_item<5>(p, it & 7, it >> 3, lds);
    } else if (ST == 11) {
        if (PROBE_REP == 11) for (int it = bid; it < T_ / 16; it += nb) peer_route_item(p, it, lds);
        for (int it = bid; it < T_ / 16; it += nb) peer_route_item(p, it, lds);
    } else if (ST == 12) {
        if (PROBE_REP == 12) { wq_begin(lds); for (int it; (it = wq_next(wqc + 4 * 512, 1024, xcc, lds)) >= 0;) peer_down_item(p, it >> 10, it & 1023, tidl & 63, wave); }
        wq_begin(lds);
        for (int it; (it = wq_next(wqc + 2 * 512, 512, xcc, lds)) >= 0;) peer_down_item(p, it >> 9, it & 511, tidl & 63, wave);
    } else if (ST == 13) {
        if (PROBE_REP == 13) for (int it = bid; it < T_ / 4; it += nb) peer_coef_item(p, it * 4 + wave, tidl & 63);
        for (int it = bid; it < T_ / 4; it += nb) peer_coef_item(p, it * 4 + wave, tidl & 63);
    } else if (ST == 14) {
        if (PROBE_REP == 14) { wq_begin(lds); for (int it; (it = wq_next(wqc + 5 * 512, 1024, xcc, lds)) >= 0;) peer_up_item(p, it >> 10, it & 1023, tidl & 63, wave, p.out == nullptr); }
        wq_begin(lds);
        for (int it; (it = wq_next(wqc + 3 * 512, 512, xcc, lds)) >= 0;) peer_up_item(p, it >> 9, it & 511, tidl & 63, wave);
    } else if (ST == 15) {
        for (int it = bid; it < T_ / 4; it += nb) ln3_item(p, it * 4 + wave, tidl & 63);
    }
}

template <int ST>
__global__ void __launch_bounds__(256, 2) stage_kernel(P p) {
    __shared__ __attribute__((aligned(16))) unsigned char lds[LDS_BYTES + 16];
    run_stage<ST>(p, lds, (int)xb_xcc_id() & 7);
}

__global__ void __launch_bounds__(256, 2) mega_kernel(P p) {
    __shared__ __attribute__((aligned(16))) unsigned char lds[LDS_BYTES + 16];
    if (threadIdx.x == 0) *(uint4*)(lds + LDS_BYTES) = make_uint4(0u, 0u, 0u, 0u);
    __syncthreads();
    const XcdBarrier xb = xcd_barrier_post((unsigned*)(p.ws + WS_BAR), (volatile LAS unsigned*)(lds + LDS_BYTES));
    const int xcc = (int)xb.x & 7;
    run_stage<0>(p, lds, xcc); xcd_barrier(xb);
    if (PROBE_REP == 0) { run_stage<0>(p, lds, xcc); xcd_barrier(xb); }
    run_stage<1>(p, lds, xcc); xcd_barrier(xb);
    if (PROBE_REP == 1) { run_stage<1>(p, lds, xcc); xcd_barrier(xb); }
    run_stage<2>(p, lds, xcc); xcd_barrier(xb);
    if (PROBE_REP == 2) { run_stage<2>(p, lds, xcc); xcd_barrier(xb); }
    if (PROBE_REP == 35) { if (blockIdx.x < 32) hgrn_chain_item2(p, blockIdx.x, lds); xcd_barrier(xb); }
    run_stage<3>(p, lds, xcc); xcd_barrier(xb);
    run_stage<4>(p, lds, xcc); xcd_barrier(xb);
    if (PROBE_REP == 4) { run_stage<4>(p, lds, xcc); xcd_barrier(xb); }
    if (PROBE_REP == 50) { xcd_barrier(xb); xcd_barrier(xb); xcd_barrier(xb); xcd_barrier(xb); xcd_barrier(xb); xcd_barrier(xb); xcd_barrier(xb); xcd_barrier(xb); }
    run_stage<6>(p, lds, xcc); xcd_barrier(xb);
    if (PROBE_REP == 6) { run_stage<6>(p, lds, xcc); xcd_barrier(xb); }
    run_stage<7>(p, lds, xcc); xcd_barrier(xb);
    if (PROBE_REP == 7) { run_stage<7>(p, lds, xcc); xcd_barrier(xb); }
    run_stage<8>(p, lds, xcc); xcd_barrier(xb);
    run_stage<10>(p, lds, xcc); xcd_barrier(xb);
    if (PROBE_REP == 10) { run_stage<10>(p, lds, xcc); xcd_barrier(xb); }
    run_stage<11>(p, lds, xcc); xcd_barrier(xb);
    run_stage<12>(p, lds, xcc); xcd_barrier(xb);
    run_stage<13>(p, lds, xcc); xcd_barrier(xb);
    run_stage<14>(p, lds, xcc); xcd_barrier(xb);
    run_stage<15>(p, lds, xcc);
}

extern "C" void kernel_launch(void* const* d_in, const int* in_sizes, int n_in, void* d_out, int out_size, void* d_ws, size_t ws_size,
                              hipStream_t stream) {
    if (n_in != 18 || ws_size < WS_END) {
        fprintf(stderr, "kernel_launch: unexpected inputs (n_in %d, ws %zu, need %zu)\n", n_in, ws_size, (size_t)WS_END);
        return;
    }
    P p{};
    p.x = (const float*)d_in[0]; p.mem = (const float*)d_in[1]; p.w_in = (const float*)d_in[2]; p.cmp_pos = (const float*)d_in[3];
    p.cmp_w1 = (const float*)d_in[4]; p.cmp_w2 = (const float*)d_in[5]; p.lb_logits = (const float*)d_in[6];
    p.hg_norm_w = (const float*)d_in[7]; p.w_out = (const float*)d_in[8]; p.xa_wq = (const float*)d_in[9];
    p.xa_wkv = (const float*)d_in[10]; p.xa_wo = (const float*)d_in[11]; p.peer_wq = (const float*)d_in[12];
    p.peer_keys = (const float*)d_in[13]; p.peer_down = (const float*)d_in[14]; p.peer_up = (const float*)d_in[15];
    p.ln_g = (const float*)d_in[16]; p.ln_b = (const float*)d_in[17];
    p.out = (float*)d_out; p.ws = (unsigned char*)d_ws;
#if ONE_LAUNCH
    static int grid_blocks = 0;
    if (!grid_blocks) {
        int dev = 0, cus = 0, per_cu = 0;
        hipGetDevice(&dev);
        hipDeviceGetAttribute(&cus, hipDeviceAttributeMultiprocessorCount, dev);
        hipOccupancyMaxActiveBlocksPerMultiprocessor(&per_cu, mega_kernel, 256, 0);
        if (per_cu > 2) per_cu = 2;
        if (per_cu < 1) per_cu = 1;
        grid_blocks = cus * per_cu;
    }
    (void)hipMemsetAsync((unsigned char*)d_ws + WS_BAR, 0, 65536, stream);
    void* args[] = {&p};
    hipError_t e = hipLaunchCooperativeKernel((void*)mega_kernel, dim3(grid_blocks), dim3(256), args, 0, stream);
    if (e != hipSuccess) fprintf(stderr, "cooperative launch failed: %s (grid %d)\n", hipGetErrorString(e), grid_blocks);
#else
    const int G = 2048;
    stage_kernel<0><<<G, 256, 0, stream>>>(p);
    stage_kernel<1><<<G, 256, 0, stream>>>(p);
    stage_kernel<2><<<G, 256, 0, stream>>>(p);
    stage_kernel<3><<<G, 256, 0, stream>>>(p);
    stage_kernel<4><<<G, 256, 0, stream>>>(p);
    stage_kernel<5><<<G, 256, 0, stream>>>(p);
    stage_kernel<6><<<G, 256, 0, stream>>>(p);
    stage_kernel<7><<<G, 256, 0, stream>>>(p);
    stage_kernel<8><<<G, 256, 0, stream>>>(p);
    stage_kernel<9><<<G, 256, 0, stream>>>(p);
    stage_kernel<10><<<G, 256, 0, stream>>>(p);
    stage_kernel<11><<<G, 256, 0, stream>>>(p);
#endif
}
```

```cpp
#include <hip/hip_runtime.h>
#include <hip/hip_cooperative_groups.h>
#include <cstdio>
#include <cstdint>
namespace cg = cooperative_groups;

#ifndef PROBE_REP
#define PROBE_REP -1
#endif
#ifndef ONE_LAUNCH
#define ONE_LAUNCH 1
#endif

typedef unsigned short bf16_t;
#define DEV __device__ __forceinline__

constexpr int D_ = 1024, B_ = 8, S_ = 2048, T_ = B_ * S_, ML_ = 256, INC = 3352;
constexpr int NCMP = 127;
constexpr int LDS_BYTES = 67584;
constexpr float ALPHA = 1.189207115002721f;
constexpr float LN_EPS = 1e-5f;
constexpr int C_QA = 0, C_KC = 512, C_VC = 640, C_KS = 768, C_VS = 896, C_KW = 1024, C_VW = 1152, C_GATE = 1280,
              C_HQ = 1304, C_HF = 1816, C_HI = 2328, C_HG = 2840;
constexpr size_t WS_HB = 0;
constexpr size_t SZ_HB = (size_t)T_ * INC * 2;
constexpr size_t WS_OM = WS_HB + SZ_HB;
constexpr size_t WS_KVM = WS_OM + (size_t)T_ * 1024 * 2;
constexpr size_t WS_KC = WS_KVM + (size_t)2048 * 2048 * 2;
constexpr size_t WS_XB = WS_KC + (1u << 20);
constexpr size_t WS_WIN_T = WS_XB + (size_t)T_ * 1024 * 2;
constexpr size_t WS_WOUT_T = WS_WIN_T + (size_t)3456 * 1024 * 2;
constexpr size_t WS_WQ_T = WS_WOUT_T + (size_t)1024 * 1024 * 2;
constexpr size_t WS_WKV_T = WS_WQ_T + (size_t)1024 * 1024 * 2;
constexpr size_t WS_WO_T = WS_WKV_T + (size_t)2048 * 1024 * 2;
constexpr size_t WS_PWQ_T = WS_WO_T + (size_t)1024 * 1024 * 2;
constexpr size_t WS_MEMB = WS_PWQ_T + (size_t)1024 * 1024 * 2;
constexpr size_t WS_PKEY = WS_MEMB + (size_t)2048 * 1024 * 2;
constexpr size_t WS_VT = WS_PKEY + (size_t)16 * 128 * 64 * 2;
constexpr size_t WS_KCB = WS_VT + (size_t)2 * B_ * 2 * 64 * 2048 * 2;
constexpr size_t WS_VCT = WS_KCB + (size_t)B_ * 2 * 128 * 64 * 2;
constexpr size_t WS_W1T = WS_VCT + (size_t)B_ * 2 * 128 * 64 * 2;
constexpr size_t WS_W2T = WS_W1T + (size_t)2 * 128 * 2048 * 2;
constexpr size_t WS_CB = WS_W2T + (size_t)2 * 64 * 128 * 2;
constexpr size_t WS_VMT = WS_CB + 1024;
constexpr size_t WS_BAR = WS_VMT + (size_t)B_ * 4 * 256 * 256 * 2;
constexpr size_t WS_PD = WS_BAR + 65536;
constexpr size_t WS_PU = WS_PD + (size_t)16384 * 1024;
constexpr size_t WS_PSD = WS_PU + (size_t)16384 * 1024;
constexpr size_t WS_PSU = WS_PSD + 65536;
constexpr size_t WS_PRS = WS_PSU + 65536;
constexpr size_t WS_LNP1 = WS_PRS + 65536;
constexpr size_t WS_LNP2 = WS_LNP1 + (size_t)T_ * 16 * 8;
constexpr size_t WS_ST2 = WS_LNP2 + (size_t)T_ * 16 * 8;
constexpr size_t WS_C12 = WS_ST2 + (size_t)T_ * 8;
constexpr size_t WS_END = WS_C12 + 262144;
static_assert(WS_END <= (size_t)268435456, "workspace budget");
constexpr size_t WS_EB = WS_KC;
constexpr size_t HS_QT = 0;
constexpr size_t HS_KT = (size_t)B_ * 4 * 2048 * 128 * 2;
constexpr size_t HS_KHT = 2 * HS_KT;
constexpr size_t HS_VIT = 3 * HS_KT;
constexpr size_t HS_DS = HS_KT;
constexpr size_t HS_OI = 3 * HS_KT;
constexpr size_t WS_QX = 67108864;
constexpr size_t WS_OX = (size_t)T_ * 1024 * 2;
constexpr size_t WS_QP = 104857600;
constexpr size_t WS_YB = 0;
constexpr size_t WS_EIDP = (size_t)T_ * 1024 * 2;
constexpr size_t WS_GATEP = WS_EIDP + (size_t)T_ * 128 * 2;
constexpr size_t WS_COEFP = WS_GATEP + (size_t)T_ * 128 * 4;
constexpr size_t WS_XQ = WS_COEFP + (size_t)T_ * 128 * 4;
constexpr size_t WS_SXF = WS_XQ + (size_t)T_ * 1024;
constexpr size_t WS_SXI = WS_SXF + (size_t)T_ * 4;
constexpr size_t WS_ASUM = WS_SXI + (size_t)T_ * 4;
constexpr size_t WS_DP = WS_ASUM + (size_t)T_ * 4;
static_assert(WS_DP + (size_t)8 * T_ * 128 * 4 <= WS_KVM, "PEER intermediates must fit in the dead h/OM region");

struct P {
    const float *x, *mem, *w_in, *cmp_pos, *cmp_w1, *cmp_w2, *lb_logits, *hg_norm_w, *w_out, *xa_wq, *xa_wkv, *xa_wo,
        *peer_wq, *peer_keys, *peer_down, *peer_up, *ln_g, *ln_b;
    float* out;
    unsigned char* ws;
};

DEV unsigned short f2bf(float f) {
    unsigned u = __float_as_uint(f);
    u += 0x7fffu + ((u >> 16) & 1u);
    return (unsigned short)(u >> 16);
}
DEV float bf2f(unsigned short h) { return __uint_as_float(((unsigned)h) << 16); }
DEV float bflo(unsigned u) { return __uint_as_float(u << 16); }
DEV float bfhi(unsigned u) { return __uint_as_float(u & 0xffff0000u); }
typedef __bf16 bf16x2_t __attribute__((ext_vector_type(2)));
typedef float f32x2_t __attribute__((ext_vector_type(2)));
DEV unsigned pk_bf16(float a, float b) {
    f32x2_t v = {a, b};
    bf16x2_t r = __builtin_convertvector(v, bf16x2_t);
    return __builtin_bit_cast(unsigned, r);
}
DEV float wsum(float v) {
#pragma unroll
    for (int o = 32; o > 0; o >>= 1) v += __shfl_xor(v, o);
    return v;
}
DEV float wmax(float v) {
#pragma unroll
    for (int o = 32; o > 0; o >>= 1) v = fmaxf(v, __shfl_xor(v, o));
    return v;
}
DEV float sigmoidf_(float x) { return 1.f / (1.f + expf(-x)); }
DEV float fsigmoid(float x) { return __fdividef(1.f, 1.f + __expf(-x)); }

template <int MODE>
DEV void gemm_tile(const P& p, int tile, float* smem) {
    constexpr bool ABF = (MODE == 2 || MODE == 4);
    constexpr int K = 1024;
    constexpr int N = MODE == 0 ? INC : (MODE == 1 ? 2048 : 1024);
    constexpr int NTN = (N + 63) / 64;
    const int tm = tile / NTN, tn = tile % NTN;
    const float* Af = nullptr;
    const bf16_t* Ab = nullptr;
    const float* Bm = nullptr;
    if (MODE == 0) { Af = p.x; Bm = p.w_in; }
    if (MODE == 1) { Af = p.mem; Bm = p.xa_wkv; }
    if (MODE == 2) { Ab = (const bf16_t*)(p.ws + WS_OM); Bm = p.w_out; }
    if (MODE == 3) { Af = p.out; Bm = p.xa_wq; }
    if (MODE == 4) { Ab = (const bf16_t*)(p.ws + WS_OX); Bm = p.xa_wo; }
    if (MODE == 5) { Af = p.out; Bm = p.peer_wq; }
    float(*sA)[68] = (float(*)[68])smem;
    float(*sB)[68] = (float(*)[68])(smem + 16 * 68);
    const int tid = threadIdx.x, tx = tid & 15, ty = tid >> 4;
    const int ar = tid >> 2, ak = (tid & 3) * 4;
    const int bk = tid >> 4, bn = (tid & 15) * 4;
    float acc[4][4];
#pragma unroll
    for (int i = 0; i < 4; ++i)
#pragma unroll
        for (int j = 0; j < 4; ++j) acc[i][j] = 0.f;
    const int gn = tn * 64 + bn;
    for (int k0 = 0; k0 < K; k0 += 16) {
        float4 av;
        if (ABF) {
            uint2 u = *(const uint2*)(Ab + (size_t)(tm * 64 + ar) * K + k0 + ak);
            av.x = bflo(u.x); av.y = bfhi(u.x); av.z = bflo(u.y); av.w = bfhi(u.y);
        } else {
            av = *(const float4*)(Af + (size_t)(tm * 64 + ar) * K + k0 + ak);
        }
        float4 bv = make_float4(0.f, 0.f, 0.f, 0.f);
        if (gn < N) bv = *(const float4*)(Bm + (size_t)(k0 + bk) * N + gn);
        sA[ak + 0][ar] = av.x; sA[ak + 1][ar] = av.y; sA[ak + 2][ar] = av.z; sA[ak + 3][ar] = av.w;
        *(float4*)&sB[bk][bn] = bv;
        __syncthreads();
#pragma unroll
        for (int kk = 0; kk < 16; ++kk) {
            float4 a = *(const float4*)&sA[kk][ty * 4];
            float4 b = *(const float4*)&sB[kk][tx * 4];
            float aa[4] = {a.x, a.y, a.z, a.w}, bb[4] = {b.x, b.y, b.z, b.w};
#pragma unroll
            for (int i = 0; i < 4; ++i)
#pragma unroll
                for (int j = 0; j < 4; ++j) acc[i][j] += aa[i] * bb[j];
        }
        __syncthreads();
    }
    const int col = tn * 64 + tx * 4;
#pragma unroll
    for (int i = 0; i < 4; ++i) {
        const size_t row = (size_t)tm * 64 + ty * 4 + i;
        if (MODE == 0 || MODE == 1 || MODE == 3) {
            bf16_t* O = (bf16_t*)(p.ws + (MODE == 0 ? WS_HB : (MODE == 1 ? WS_KVM : WS_QX)));
            if (col < N) {
                uint2 u;
                u.x = (unsigned)f2bf(acc[i][0]) | ((unsigned)f2bf(acc[i][1]) << 16);
                u.y = (unsigned)f2bf(acc[i][2]) | ((unsigned)f2bf(acc[i][3]) << 16);
                *(uint2*)(O + row * N + col) = u;
            }
        } else if (MODE == 2) {
            float4 xv = *(const float4*)(p.x + row * 1024 + col);
            float4 o = make_float4(ALPHA * xv.x + acc[i][0], ALPHA * xv.y + acc[i][1], ALPHA * xv.z + acc[i][2], ALPHA * xv.w + acc[i][3]);
            *(float4*)(p.out + row * 1024 + col) = o;
        } else if (MODE == 4) {
            float4 xv = *(const float4*)(p.out + row * 1024 + col);
            float4 o = make_float4(ALPHA * xv.x + acc[i][0], ALPHA * xv.y + acc[i][1], ALPHA * xv.z + acc[i][2], ALPHA * xv.w + acc[i][3]);
            *(float4*)(p.out + row * 1024 + col) = o;
        } else {
            float* O = (float*)(p.ws + WS_QP);
            *(float4*)(O + row * 1024 + col) = make_float4(acc[i][0], acc[i][1], acc[i][2], acc[i][3]);
        }
    }
}


using bf16x8 = __attribute__((ext_vector_type(8))) short;
using f32x4 = __attribute__((ext_vector_type(4))) float;
using u32x4 = __attribute__((ext_vector_type(4))) unsigned;

template <int MODE>
DEV void gemm_mfma_tile(const P& p, int tm, int tn, unsigned char* lds) {
    const bf16_t* A;
    const bf16_t* W;
    if (MODE == 0) { A = (const bf16_t*)(p.ws + WS_XB); W = (const bf16_t*)(p.ws + WS_WIN_T); }
    if (MODE == 1) { A = (const bf16_t*)(p.ws + WS_MEMB); W = (const bf16_t*)(p.ws + WS_WKV_T); }
    if (MODE == 2) { A = (const bf16_t*)(p.ws + WS_OM); W = (const bf16_t*)(p.ws + WS_WOUT_T); }
    if (MODE == 3) { A = (const bf16_t*)(p.ws + WS_XB); W = (const bf16_t*)(p.ws + WS_WQ_T); }
    if (MODE == 4) { A = (const bf16_t*)(p.ws + WS_OX); W = (const bf16_t*)(p.ws + WS_WO_T); }
    if (MODE == 5) { A = (const bf16_t*)(p.ws + WS_XB); W = (const bf16_t*)(p.ws + WS_PWQ_T); }
    const int tid = threadIdx.x, lane = tid & 63, wid = tid >> 6, wm = wid >> 1, wn = wid & 1;
    const int m0 = tm * 128, n0 = tn * 128;
    const bf16_t* ga[2];
    const bf16_t* gw[2];
#pragma unroll
    for (int i = 0; i < 2; ++i) {
        const int r = (wid * 2 + i) * 16 + (lane >> 2);
        const int gsw = (0x1320 >> (((r >> 2) & 3) * 4)) & 3;
        const int c = (lane & 3) ^ gsw;
        ga[i] = A + (size_t)(m0 + r) * 1024 + c * 8;
        gw[i] = W + (size_t)(n0 + r) * 1024 + c * 8;
    }
    unsigned char* lbase = lds + wid * 2048;
#define GEMM_STAGE(slot, kt)                                                                                                   \
    do {                                                                                                                       \
        _Pragma("unroll") for (int i = 0; i < 2; ++i) {                                                                        \
            __builtin_amdgcn_global_load_lds((const unsigned*)(ga[i] + (kt) * 32), (unsigned*)(lbase + (slot) * 16384 + i * 1024), 16, 0, 0);         \
            __builtin_amdgcn_global_load_lds((const unsigned*)(gw[i] + (kt) * 32), (unsigned*)(lbase + (slot) * 16384 + 8192 + i * 1024), 16, 0, 0);  \
        }                                                                                                                      \
    } while (0)
    asm volatile("s_waitcnt vmcnt(0)" ::: "memory");
    GEMM_STAGE(0, 0);
    GEMM_STAGE(1, 1);
    GEMM_STAGE(2, 2);
    f32x4 acc[4][4];
#pragma unroll
    for (int i = 0; i < 4; ++i)
#pragma unroll
        for (int j = 0; j < 4; ++j) acc[i][j] = (f32x4){0.f, 0.f, 0.f, 0.f};
    const int fr = lane & 15, fq = lane >> 4;
    const int fsw = (0x1320 >> (((fr >> 2) & 3) * 4)) & 3;
    const int aoff = (wm * 64 + fr) * 64 + ((fq ^ fsw) << 4);
    const int boff = 8192 + (wn * 64 + fr) * 64 + ((fq ^ fsw) << 4);
#define GEMM_COMPUTE(slot)                                                                                                     \
    do {                                                                                                                       \
        const unsigned char* sb = lds + (slot) * 16384;                                                                        \
        bf16x8 af[4], wf[4];                                                                                                   \
        _Pragma("unroll") for (int t = 0; t < 4; ++t) {                                                                        \
            af[t] = *(const bf16x8*)(sb + aoff + t * 1024);                                                                    \
            wf[t] = *(const bf16x8*)(sb + boff + t * 1024);                                                                    \
        }                                                                                                                      \
        _Pragma("unroll") for (int nt = 0; nt < 4; ++nt)                                                                       \
            _Pragma("unroll") for (int mt = 0; mt < 4; ++mt)                                                                   \
                acc[nt][mt] = __builtin_amdgcn_mfma_f32_16x16x32_bf16(wf[nt], af[mt], acc[nt][mt], 0, 0, 0);                   \
    } while (0)
#pragma unroll 1
    for (int kt = 0; kt < 29; ++kt) {
        asm volatile("s_waitcnt vmcnt(8)\n\ts_waitcnt lgkmcnt(0)" ::: "memory");
        __builtin_amdgcn_s_barrier(); asm volatile("" ::: "memory");
        GEMM_STAGE((kt + 3) & 3, kt + 3);
        GEMM_COMPUTE(kt & 3);
    }
    asm volatile("s_waitcnt vmcnt(8)\n\ts_waitcnt lgkmcnt(0)" ::: "memory");
    __builtin_amdgcn_s_barrier(); asm volatile("" ::: "memory");
    GEMM_COMPUTE(29 & 3);
    asm volatile("s_waitcnt vmcnt(4)\n\ts_waitcnt lgkmcnt(0)" ::: "memory");
    __builtin_amdgcn_s_barrier(); asm volatile("" ::: "memory");
    GEMM_COMPUTE(30 & 3);
    asm volatile("s_waitcnt vmcnt(0)\n\ts_waitcnt lgkmcnt(0)" ::: "memory");
    __builtin_amdgcn_s_barrier(); asm volatile("" ::: "memory");
    GEMM_COMPUTE(31 & 3);
    asm volatile("s_waitcnt lgkmcnt(0)" ::: "memory");
    __builtin_amdgcn_s_barrier(); asm volatile("" ::: "memory");
#undef GEMM_STAGE
#undef GEMM_COMPUTE
#pragma unroll
    for (int mt = 0; mt < 4; ++mt) {
        const size_t m = (size_t)m0 + wm * 64 + mt * 16 + fr;
#pragma unroll
        for (int nt = 0; nt < 4; ++nt) {
            const int n = n0 + wn * 64 + nt * 16 + fq * 4;
            const f32x4 c = acc[nt][mt];
            if (MODE == 0 || MODE == 1 || MODE == 3 || MODE == 5) {
                constexpr int NS = MODE == 0 ? INC : (MODE == 1 ? 2048 : 1024);
                bf16_t* O = (bf16_t*)(p.ws + (MODE == 0 ? WS_HB : (MODE == 1 ? WS_KVM : (MODE == 3 ? WS_QX : WS_QP))));
                if (MODE == 1 && tn >= 8) {
                    bf16_t* VMT = (bf16_t*)(p.ws + WS_VMT);
                    const int nn = n - 1024;
                    const size_t base = (((size_t)(m >> 8) * 4 + (nn >> 8)) * 256 + (nn & 255)) * 256 + (m & 255);
#pragma unroll
                    for (int i = 0; i < 4; ++i) VMT[base + (size_t)i * 256] = f2bf(c[i]);
                } else if (MODE == 0 && (tn == 7 || tn == 9)) {
                    bf16_t* VT = (bf16_t*)(p.ws + WS_VT);
                    const int which = tn == 9 ? 1 : 0;
                    const size_t base = ((((size_t)which * B_ + (m >> 11)) * 2 + wn) * 64 + nt * 16 + fq * 4) * 2048 + (m & 2047);
#pragma unroll
                    for (int i = 0; i < 4; ++i) VT[base + (size_t)i * 2048] = f2bf(c[i]);
                } else if (MODE != 0 || n < INC) {
                    uint2 u;
                    u.x = pk_bf16(c[0], c[1]);
                    u.y = pk_bf16(c[2], c[3]);
                    *(uint2*)(O + m * NS + n) = u;
                }
            } else if (MODE == 2) {
                const float4 xv = *(const float4*)(p.x + m * 1024 + n);
                *(uint2*)((bf16_t*)(p.ws + WS_YB) + m * 1024 + n) = make_uint2(pk_bf16(ALPHA * xv.x + c[0], ALPHA * xv.y + c[1]), pk_bf16(ALPHA * xv.z + c[2], ALPHA * xv.w + c[3]));
            } else if (MODE == 4) {
                const uint2 xb = *(const uint2*)((const bf16_t*)(p.ws + WS_XB) + m * 1024 + n);
                *(uint2*)((bf16_t*)(p.ws + WS_YB) + m * 1024 + n) = make_uint2(pk_bf16(ALPHA * bflo(xb.x) + c[0], ALPHA * bfhi(xb.x) + c[1]), pk_bf16(ALPHA * bflo(xb.y) + c[2], ALPHA * bfhi(xb.y) + c[3]));
            }
        }
    }
}


template <int MODE>
DEV void gemm_mfma_tile256(const P& p, int tm, int tn, unsigned char* lds) {
    const bf16_t* A;
    const bf16_t* W;
    if (MODE == 0) { A = (const bf16_t*)(p.ws + WS_XB); W = (const bf16_t*)(p.ws + WS_WIN_T); }
    if (MODE == 1) { A = (const bf16_t*)(p.ws + WS_MEMB); W = (const bf16_t*)(p.ws + WS_WKV_T); }
    if (MODE == 2) { A = (const bf16_t*)(p.ws + WS_OM); W = (const bf16_t*)(p.ws + WS_WOUT_T); }
    if (MODE == 3) { A = (const bf16_t*)(p.ws + WS_YB); W = (const bf16_t*)(p.ws + WS_WQ_T); }
    if (MODE == 4) { A = (const bf16_t*)(p.ws + WS_OX); W = (const bf16_t*)(p.ws + WS_WO_T); }
    if (MODE == 5) { A = (const bf16_t*)(p.ws + WS_YB); W = (const bf16_t*)(p.ws + WS_PWQ_T); }
    int tid = threadIdx.x;
    asm volatile("" : "+v"(tid));
    const int lane = tid & 63, wid = tid >> 6, wm = wid >> 1, wn = wid & 1;
    const int m0 = tm * 256, n0 = tn * 128;
    float2* STL = (float2*)(lds + 49152);
    const bf16_t* ga[4];
    const bf16_t* gw[2];
#pragma unroll
    for (int i = 0; i < 4; ++i) {
        const int r = (wid * 4 + i) * 16 + (lane >> 2);
        const int gsw = (0x1320 >> (((r >> 2) & 3) * 4)) & 3;
        ga[i] = A + (size_t)(m0 + r) * 1024 + ((lane & 3) ^ gsw) * 8;
    }
#pragma unroll
    for (int i = 0; i < 2; ++i) {
        const int r = (wid * 2 + i) * 16 + (lane >> 2);
        const int gsw = (0x1320 >> (((r >> 2) & 3) * 4)) & 3;
        gw[i] = W + (size_t)(n0 + r) * 1024 + ((lane & 3) ^ gsw) * 8;
    }
    unsigned char* lbA = lds + wid * 4096;
    unsigned char* lbW = lds + 16384 + wid * 2048;
#define GEMM_STAGE(slot, kt)                                                                                                   \
    do {                                                                                                                       \
        _Pragma("unroll") for (int i = 0; i < 4; ++i)                                                                          \
            __builtin_amdgcn_global_load_lds((const unsigned*)(ga[i] + (kt) * 32), (unsigned*)(lbA + (slot) * 24576 + i * 1024), 16, 0, 0);  \
        _Pragma("unroll") for (int i = 0; i < 2; ++i)                                                                          \
            __builtin_amdgcn_global_load_lds((const unsigned*)(gw[i] + (kt) * 32), (unsigned*)(lbW + (slot) * 24576 + i * 1024), 16, 0, 0);  \
    } while (0)
    float st_mean = 0.f, st_rs = 0.f, c12v = 0.f;
    if (MODE == 3 || MODE == 4 || MODE == 5) {
        float4 sv[8];
        float cv[16];
        if (MODE != 4) {
            const float* pc = (const float*)(p.ws + WS_C12) + (size_t)((MODE == 5 ? 16 : 0) * 2 + (tid >> 7)) * 1024 + n0 + (tid & 127);
#pragma unroll
            for (int i = 0; i < 16; ++i) cv[i] = pc[i * 2048];
        }
        const float4* pp = (const float4*)(p.ws + (MODE == 5 ? WS_LNP2 : WS_LNP1)) + (size_t)(m0 + tid) * 8;
#pragma unroll
        for (int i = 0; i < 8; ++i) sv[i] = pp[i];
        GEMM_STAGE(0, 0);
        if (MODE != 4) {
#pragma unroll
            for (int i = 0; i < 16; ++i) c12v += cv[i];
        }
        float s1 = 0.f, s2 = 0.f;
#pragma unroll
        for (int i = 0; i < 8; ++i) { s1 += sv[i].x + sv[i].z; s2 += sv[i].y + sv[i].w; }
        st_mean = s1 * (1.f / 1024.f);
        st_rs = rsqrtf(fmaxf(s2 * (1.f / 1024.f) - st_mean * st_mean, 0.f) + LN_EPS);
    } else {
        GEMM_STAGE(0, 0);
    }
    f32x4 acc[4][8];
#pragma unroll
    for (int i = 0; i < 4; ++i)
#pragma unroll
        for (int j = 0; j < 8; ++j) acc[i][j] = (f32x4){0.f, 0.f, 0.f, 0.f};
    const int fr = lane & 15, fq = lane >> 4;
    const int fsw = (0x1320 >> (((fr >> 2) & 3) * 4)) & 3;
    const int aoff = (wm * 128 + fr) * 64 + ((fq ^ fsw) << 4);
    const int boff = 16384 + (wn * 64 + fr) * 64 + ((fq ^ fsw) << 4);
#define GEMM_COMPUTE(kt)                                                                                                       \
    do {                                                                                                                       \
        const unsigned char* sb = lds + ((kt) & 1) * 24576;                                                                    \
        bf16x8 af[8], wf[4];                                                                                                   \
        _Pragma("unroll") for (int t = 0; t < 8; ++t) af[t] = *(const bf16x8*)(sb + aoff + t * 1024);                          \
        _Pragma("unroll") for (int t = 0; t < 4; ++t) wf[t] = *(const bf16x8*)(sb + boff + t * 1024);                          \
        _Pragma("unroll") for (int nt = 0; nt < 4; ++nt)                                                                       \
            _Pragma("unroll") for (int mt = 0; mt < 8; ++mt) acc[nt][mt] = __builtin_amdgcn_mfma_f32_16x16x32_bf16(wf[nt], af[mt], acc[nt][mt], 0, 0, 0); \
    } while (0)
    {
        asm volatile("s_waitcnt vmcnt(0)\n\ts_waitcnt lgkmcnt(0)" ::: "memory");
        __builtin_amdgcn_s_barrier(); asm volatile("" ::: "memory");
        GEMM_STAGE(1, 1);
        if (MODE == 3 || MODE == 4 || MODE == 5) {
            STL[tid] = make_float2(st_mean, st_rs);
            if (MODE == 5 && tn == 0) ((float2*)(p.ws + WS_ST2))[m0 + tid] = make_float2(st_mean, st_rs);
            if (MODE != 4) ((float*)(lds + 49152 + 2048))[tid] = c12v;
        }
        GEMM_COMPUTE(0);
    }
#pragma unroll 1
    for (int kt = 1; kt < 32; ++kt) {
        asm volatile("s_waitcnt vmcnt(0)\n\ts_waitcnt lgkmcnt(0)" ::: "memory");
        __builtin_amdgcn_s_barrier(); asm volatile("" ::: "memory");
        if (kt + 1 < 32) { if (kt & 1) GEMM_STAGE(0, kt + 1); else GEMM_STAGE(1, kt + 1); }
        GEMM_COMPUTE(kt);
    }
#undef GEMM_COMPUTE
    asm volatile("s_waitcnt lgkmcnt(0)" ::: "memory");
    __builtin_amdgcn_s_barrier(); asm volatile("" ::: "memory");
#undef GEMM_STAGE
    if (MODE == 3 || MODE == 5) {
        bf16_t* O = (bf16_t*)(p.ws + (MODE == 3 ? WS_QX : WS_QP));
        const float* C12L = (const float*)(lds + 49152 + 2048);
#pragma unroll
        for (int nt = 0; nt < 4; ++nt) {
            const int n = n0 + wn * 64 + nt * 16 + fq * 4;
            const float4 c1 = *(const float4*)(C12L + (n - n0)), c2 = *(const float4*)(C12L + 128 + (n - n0));
#pragma unroll
            for (int mt = 0; mt < 8; ++mt) {
                const int ml = wm * 128 + mt * 16 + fr;
                const float2 st = STL[ml];
                const f32x4 c = acc[nt][mt];
                uint2 u;
                u.x = pk_bf16(st.y * (c[0] - st.x * c1.x) + c2.x, st.y * (c[1] - st.x * c1.y) + c2.y);
                u.y = pk_bf16(st.y * (c[2] - st.x * c1.z) + c2.z, st.y * (c[3] - st.x * c1.w) + c2.w);
                *(uint2*)(O + (size_t)(m0 + ml) * 1024 + n) = u;
            }
        }
    } else if (MODE == 4) {
        bf16_t* YB = (bf16_t*)(p.ws + WS_YB);
        float4 g4[4], b4[4];
#pragma unroll
        for (int nt = 0; nt < 4; ++nt) {
            const int n = n0 + wn * 64 + nt * 16 + fq * 4;
            g4[nt] = *(const float4*)(p.ln_g + n);
            b4[nt] = *(const float4*)(p.ln_b + n);
        }
#pragma unroll
        for (int mt = 0; mt < 8; ++mt) {
            const int ml = wm * 128 + mt * 16 + fr;
            const float2 st = STL[ml];
            bf16_t* yrow = YB + (size_t)(m0 + ml) * 1024 + n0 + wn * 64 + fq * 4;
            float s1 = 0.f, s2 = 0.f;
#pragma unroll
            for (int nt = 0; nt < 4; ++nt) {
                const f32x4 c = acc[nt][mt];
                const uint2 yb = *(const uint2*)(yrow + nt * 16);
                const float y0 = ALPHA * ((bflo(yb.x) - st.x) * st.y * g4[nt].x + b4[nt].x) + c[0];
                const float y1 = ALPHA * ((bfhi(yb.x) - st.x) * st.y * g4[nt].y + b4[nt].y) + c[1];
                const float y2 = ALPHA * ((bflo(yb.y) - st.x) * st.y * g4[nt].z + b4[nt].z) + c[2];
                const float y3 = ALPHA * ((bfhi(yb.y) - st.x) * st.y * g4[nt].w + b4[nt].w) + c[3];
                s1 += (y0 + y1) + (y2 + y3);
                s2 += (y0 * y0 + y1 * y1) + (y2 * y2 + y3 * y3);
                *(uint2*)(yrow + nt * 16) = make_uint2(pk_bf16(y0, y1), pk_bf16(y2, y3));
            }
            s1 += __shfl_xor(s1, 16); s2 += __shfl_xor(s2, 16);
            s1 += __shfl_xor(s1, 32); s2 += __shfl_xor(s2, 32);
            if (fq == 0) ((float2*)(p.ws + WS_LNP2))[(size_t)(m0 + ml) * 16 + tn * 2 + wn] = make_float2(s1, s2);
            asm volatile("" ::: "memory");
        }
    } else {
#pragma unroll
    for (int mt = 0; mt < 8; ++mt) {
        const size_t m = (size_t)m0 + wm * 128 + mt * 16 + fr;
        float s1 = 0.f, s2 = 0.f;
#pragma unroll
        for (int nt = 0; nt < 4; ++nt) {
            const int n = n0 + wn * 64 + nt * 16 + fq * 4;
            const f32x4 c = acc[nt][mt];
            if (MODE == 0 || MODE == 1) {
                constexpr int NS = MODE == 0 ? INC : 2048;
                bf16_t* O = (bf16_t*)(p.ws + (MODE == 0 ? WS_HB : WS_KVM));
                if (MODE == 1 && tn >= 8) {
                    bf16_t* VMT = (bf16_t*)(p.ws + WS_VMT);
                    const int nn = n - 1024;
                    const size_t base = (((size_t)(m >> 8) * 4 + (nn >> 8)) * 256 + (nn & 255)) * 256 + (m & 255);
#pragma unroll
                    for (int i = 0; i < 4; ++i) VMT[base + (size_t)i * 256] = f2bf(c[i]);
                } else if (MODE == 0 && (tn == 7 || tn == 9)) {
                    bf16_t* VT = (bf16_t*)(p.ws + WS_VT);
                    const int which = tn == 9 ? 1 : 0;
                    const size_t base = ((((size_t)which * B_ + (m >> 11)) * 2 + wn) * 64 + nt * 16 + fq * 4) * 2048 + (m & 2047);
#pragma unroll
                    for (int i = 0; i < 4; ++i) VT[base + (size_t)i * 2048] = f2bf(c[i]);
                } else if (MODE != 0 || n < INC) {
                    uint2 u;
                    u.x = pk_bf16(c[0], c[1]);
                    u.y = pk_bf16(c[2], c[3]);
                    *(uint2*)(O + m * NS + n) = u;
                }
            } else if (MODE == 2) {
                const float4 xv = *(const float4*)(p.x + m * 1024 + n);
                const float y0 = ALPHA * xv.x + c[0], y1 = ALPHA * xv.y + c[1], y2 = ALPHA * xv.z + c[2], y3 = ALPHA * xv.w + c[3];
                s1 += (y0 + y1) + (y2 + y3);
                s2 += (y0 * y0 + y1 * y1) + (y2 * y2 + y3 * y3);
                *(uint2*)((bf16_t*)(p.ws + WS_YB) + m * 1024 + n) = make_uint2(pk_bf16(y0, y1), pk_bf16(y2, y3));
            }
        }
        if (MODE == 2) {
            s1 += __shfl_xor(s1, 16); s2 += __shfl_xor(s2, 16);
            s1 += __shfl_xor(s1, 32); s2 += __shfl_xor(s2, 32);
            if (fq == 0) ((float2*)(p.ws + WS_LNP1))[m * 16 + tn * 2 + wn] = make_float2(s1, s2);
        }
    }
    }
}


template <int MODE>
DEV void gemm_item(const P& p, int q, int j, unsigned char* lds) {
    int tm, tn;
    if (MODE == 0) {
        tm = q * 8 + (j & 7);
        tn = j >> 3;
    } else if (MODE == 1) {
        tm = q; tn = j;
    } else {
        tm = q * 8 + (j & 7);
        tn = j >> 3;
    }
    gemm_mfma_tile256<MODE>(p, tm, tn, lds);
}

DEV void transpose_tile(const float* W, int N, bf16_t* Wt, int tk, int tn, float* s, int ldk = 1024, const float* gk = nullptr,
                        const float* bk = nullptr, float* part = nullptr) {
    const int tid = threadIdx.x;
    const int k0 = tk * 64, n0 = tn * 64;
    float* s2 = s + 64 * 65;
#pragma unroll
    for (int i = 0; i < 4; ++i) {
        const int k = (tid >> 4) + 16 * i, n = (tid & 15) * 4;
        float4 v = make_float4(0.f, 0.f, 0.f, 0.f);
        if (n0 + n < N) v = *(const float4*)(W + (size_t)(k0 + k) * N + n0 + n);
        if (gk) {
            const float g = gk[k0 + k], bb = bk[k0 + k];
            s2[k * 65 + n + 0] = bb * v.x; s2[k * 65 + n + 1] = bb * v.y; s2[k * 65 + n + 2] = bb * v.z; s2[k * 65 + n + 3] = bb * v.w;
            v.x *= g; v.y *= g; v.z *= g; v.w *= g;
        }
        s[k * 65 + n + 0] = v.x; s[k * 65 + n + 1] = v.y; s[k * 65 + n + 2] = v.z; s[k * 65 + n + 3] = v.w;
    }
    __syncthreads();
    {
        const int n = tid >> 2, kc = (tid & 3) * 16;
        unsigned u[8];
#pragma unroll
        for (int j = 0; j < 8; ++j)
            u[j] = (unsigned)f2bf(s[(kc + 2 * j) * 65 + n]) | ((unsigned)f2bf(s[(kc + 2 * j + 1) * 65 + n]) << 16);
        bf16_t* dst = Wt + (size_t)(n0 + n) * ldk + k0 + kc;
        *(uint4*)dst = make_uint4(u[0], u[1], u[2], u[3]);
        *(uint4*)(dst + 8) = make_uint4(u[4], u[5], u[6], u[7]);
    }
    if (part && tid < 128) {
        const int which = tid >> 6, n = tid & 63;
        float t = 0.f;
#pragma unroll 8
        for (int k = 0; k < 64; ++k) t += which ? s2[k * 65 + n] : bf2f(f2bf(s[k * 65 + n]));
        part[which * 1024 + n0 + n] = t;
    }
    __syncthreads();
}
DEV void convert_chunk(const float* src, bf16_t* dst, int item) {
    float4 a[4], b[4];
#pragma unroll
    for (int j = 0; j < 4; ++j) {
        const size_t e = (((size_t)item * 4 + j) * 256 + threadIdx.x) * 8;
        a[j] = *(const float4*)(src + e);
        b[j] = *(const float4*)(src + e + 4);
    }
#pragma unroll
    for (int j = 0; j < 4; ++j) {
        const size_t e = (((size_t)item * 4 + j) * 256 + threadIdx.x) * 8;
        uint4 u;
        u.x = pk_bf16(a[j].x, a[j].y);
        u.y = pk_bf16(a[j].z, a[j].w);
        u.z = pk_bf16(b[j].x, b[j].y);
        u.w = pk_bf16(b[j].z, b[j].w);
        *(uint4*)(dst + e) = u;
    }
}
constexpr int PREP_T0 = 16 * 54, PREP_T3 = PREP_T0 + 512, PREP_T5 = PREP_T3, PREP_X = PREP_T5 + T_ * 1024 / 8192, PREP_M = PREP_X + 2048 * 1024 / 8192, PREP_K = PREP_M + 16 * 128 * 64 / 8192, PREP_W1 = PREP_K + 128, PREP_W2 = PREP_W1 + 4,
              PREP_END = PREP_W2;
DEV void prep_item(const P& p, int it, float* smem) {
    if (it < PREP_T0) transpose_tile(p.w_in, INC, (bf16_t*)(p.ws + WS_WIN_T), it / 54, it % 54, smem);
    else if (it < PREP_T3) { it -= PREP_T0; transpose_tile(p.xa_wkv, 2048, (bf16_t*)(p.ws + WS_WKV_T), it >> 5, it & 31, smem); }
    else if (it < PREP_X) convert_chunk(p.x, (bf16_t*)(p.ws + WS_XB), it - PREP_T5);
    else if (it < PREP_M) convert_chunk(p.mem, (bf16_t*)(p.ws + WS_MEMB), it - PREP_X);
    else if (it < PREP_K) convert_chunk(p.peer_keys, (bf16_t*)(p.ws + WS_PKEY), it - PREP_M);
    else if (it < PREP_W1) {
        it -= PREP_K;
        const int kind = it >> 6, r = it & 63;
        transpose_tile(p.cmp_w1 + (size_t)kind * 2048 * 128, 128, (bf16_t*)(p.ws + WS_W1T) + (size_t)kind * 128 * 2048, r >> 1, r & 1, smem, 2048);
    } else if (it < PREP_W2) {
        it -= PREP_W1;
        const int kind = it >> 1;
        transpose_tile(p.cmp_w2 + (size_t)kind * 128 * 64, 64, (bf16_t*)(p.ws + WS_W2T) + (size_t)kind * 64 * 128, it & 1, 0, smem, 128);
    }
}

DEV void compress_item(const P& p, int item, float* smem) {
    const int tid = threadIdx.x;
    const int g = item & 1;
    int r = item >> 1;
    const int n = r % NCMP;
    r /= NCMP;
    const int b = r & 7, kind = r >> 3;
    const bf16_t* HB = (const bf16_t*)(p.ws + WS_HB);
    float* KC = (float*)(p.ws + WS_KC);
    float* su = smem;
    float* sp = smem + 2048;
    float* sh = smem + 2304;
    const int col = (kind ? C_VC : C_KC) + g * 64;
    for (int i = tid; i < 2048; i += 256) {
        const int l = i >> 6, d = i & 63;
        su[i] = bf2f(HB[(size_t)(b * S_ + 16 * n + l) * INC + col + d]) + p.cmp_pos[(kind * 32 + l) * 64 + d];
    }
    __syncthreads();
    {
        const int j = tid & 127, hf = tid >> 7;
        const float* w1 = p.cmp_w1 + (size_t)kind * 2048 * 128;
        float acc = 0.f;
        for (int i = hf * 1024; i < hf * 1024 + 1024; ++i) acc += su[i] * w1[(size_t)i * 128 + j];
        sp[hf * 128 + j] = acc;
    }
    __syncthreads();
    if (tid < 128) {
        const float v = sp[tid] + sp[128 + tid];
        const float u = 0.7978845608028654f * (v + 0.044715f * v * v * v);
        sh[tid] = 0.5f * v * (1.f + tanhf(u));
    }
    __syncthreads();
    if (tid < 64) {
        const float* w2 = p.cmp_w2 + (size_t)kind * 128 * 64;
        float acc = 0.f;
        for (int j = 0; j < 128; ++j) acc += sh[j] * w2[j * 64 + tid];
        KC[((((size_t)kind * B_ + b) * NCMP + n) * 2 + g) * 64 + tid] = acc;
    }
    __syncthreads();
}

DEV void load_q64_bf(float (&q)[64], const bf16_t* src) {
    const uint4* s4 = (const uint4*)src;
#pragma unroll
    for (int i = 0; i < 8; ++i) {
        const uint4 u = s4[i];
        q[i * 8 + 0] = bflo(u.x); q[i * 8 + 1] = bfhi(u.x); q[i * 8 + 2] = bflo(u.y); q[i * 8 + 3] = bfhi(u.y);
        q[i * 8 + 4] = bflo(u.z); q[i * 8 + 5] = bfhi(u.z); q[i * 8 + 6] = bflo(u.w); q[i * 8 + 7] = bfhi(u.w);
    }
}
DEV float dot64_bf(const float (&q)[64], const bf16_t* kr) {
    const uint4* k4 = (const uint4*)kr;
    float acc = 0.f;
#pragma unroll
    for (int i = 0; i < 8; ++i) {
        const uint4 u = k4[i];
        acc += q[i * 8 + 0] * bflo(u.x) + q[i * 8 + 1] * bfhi(u.x) + q[i * 8 + 2] * bflo(u.y) + q[i * 8 + 3] * bfhi(u.y) +
               q[i * 8 + 4] * bflo(u.z) + q[i * 8 + 5] * bfhi(u.z) + q[i * 8 + 6] * bflo(u.w) + q[i * 8 + 7] * bfhi(u.w);
    }
    return acc;
}
DEV float dot64_f(const float (&q)[64], const float* kr) {
    const float4* k4 = (const float4*)kr;
    float acc = 0.f;
#pragma unroll
    for (int i = 0; i < 16; ++i) {
        const float4 u = k4[i];
        acc += q[i * 4 + 0] * u.x + q[i * 4 + 1] * u.y + q[i * 4 + 2] * u.z + q[i * 4 + 3] * u.w;
    }
    return acc;
}

DEV void attn_block(const float (&q)[64], const bf16_t* krow_lane, const bf16_t* vbase_lane, bool valid, float& m, float& l, float& o) {
    float sc = dot64_bf(q, krow_lane) * 0.125f;
    sc = valid ? sc : -1e30f;
    const float mb = wmax(sc);
    const float mn = fmaxf(m, mb);
    const float corr = expf(m - mn);
    const float e = valid ? expf(sc - mn) : 0.f;
    l = l * corr + wsum(e);
    o *= corr;
#pragma unroll 8
    for (int k = 0; k < 64; ++k) o += __shfl(e, k) * bf2f(vbase_lane[(size_t)k * INC]);
    m = mn;
}

DEV void nsa_item(const P& p, int item) {
    const int lane = threadIdx.x & 63;
    const int g = item & 1;
    const int t = item >> 1;
    const int b = t >> 11, s = t & 2047;
    const bf16_t* HB = (const bf16_t*)(p.ws + WS_HB);
    const float* KC = (const float*)(p.ws + WS_KC);
    bf16_t* OM = (bf16_t*)(p.ws + WS_OM);
    const int cur = s >> 6;
    const int nvalid = (s >= 31) ? (((s - 31) >> 4) + 1) : 0;
    const size_t rowt = (size_t)t * INC;
    float ocmp0 = 0.f, ocmp1 = 0.f, ocmp2 = 0.f, ocmp3 = 0.f;
    float psum0 = 0.f, psum1 = 0.f;
    if (nvalid > 0) {
#pragma unroll 1
        for (int r = 0; r < 4; ++r) {
            const int h = g * 4 + r;
            float q[64];
            load_q64_bf(q, HB + rowt + C_QA + h * 64);
            float sc0 = -1e30f, sc1 = -1e30f;
            if (lane < nvalid) sc0 = dot64_f(q, KC + ((((size_t)0 * B_ + b) * NCMP + lane) * 2 + g) * 64) * 0.125f;
            if (lane + 64 < nvalid) sc1 = dot64_f(q, KC + ((((size_t)0 * B_ + b) * NCMP + lane + 64) * 2 + g) * 64) * 0.125f;
            const float m = wmax(fmaxf(sc0, sc1));
            const float e0 = (lane < nvalid) ? expf(sc0 - m) : 0.f;
            const float e1 = (lane + 64 < nvalid) ? expf(sc1 - m) : 0.f;
            const float l = wsum(e0 + e1);
            const float p0 = e0 / l, p1 = e1 / l;
            psum0 += p0;
            psum1 += p1;
            float oc = 0.f;
            const float* vcb = KC + ((((size_t)1 * B_ + b) * NCMP) * 2 + g) * 64 + lane;
            for (int n = 0; n < nvalid; ++n) {
                const float pn = (n < 64) ? __shfl(p0, n) : __shfl(p1, n - 64);
                oc += pn * vcb[(size_t)n * 128];
            }
            if (r == 0) ocmp0 = oc;
            if (r == 1) ocmp1 = oc;
            if (r == 2) ocmp2 = oc;
            if (r == 3) ocmp3 = oc;
        }
    }
    float imp = 0.f;
#pragma unroll
    for (int dn = -1; dn <= 3; ++dn) {
        const int n = 4 * lane + dn;
        const int nn = n < 0 ? 0 : (n > 127 ? 127 : n);
        const float v0 = __shfl(psum0, nn & 63);
        const float v1 = __shfl(psum1, nn & 63);
        const float v = (nn < 64) ? v0 : v1;
        if (n >= 0 && n <= 126) imp += v;
    }
    float score;
    if (lane > cur) score = -INFINITY;
    else if (lane == 0 || lane == cur || lane == cur - 1) score = 1e4f;
    else score = imp;
    int rank = 0;
#pragma unroll 8
    for (int i = 0; i < 32; ++i) {
        const float si = __shfl(score, i);
        rank += ((si > score) || (si == score && i < lane)) ? 1 : 0;
    }
    const bool sel = (lane <= cur) && (rank < 16);
    const unsigned mask = (unsigned)(__ballot(sel) & 0xffffffffull);
    const int wlo = (s - 511) > 0 ? (s - 511) : 0;
#pragma unroll 1
    for (int r = 0; r < 4; ++r) {
        const int h = g * 4 + r;
        float q[64];
        load_q64_bf(q, HB + rowt + C_QA + h * 64);
        float m = -1e30f, l = 0.f, o = 0.f;
        for (unsigned mm = mask; mm; mm &= mm - 1) {
            const int j = __builtin_ctz(mm);
            const int kpos = j * 64 + lane;
            attn_block(q, HB + (size_t)(b * S_ + kpos) * INC + C_KS + g * 64, HB + (size_t)(b * S_ + j * 64) * INC + C_VS + g * 64 + lane,
                       kpos <= s, m, l, o);
        }
        const float oslc = o / l;
        m = -1e30f; l = 0.f; o = 0.f;
        for (int j = wlo >> 6; j <= cur; ++j) {
            const int kpos = j * 64 + lane;
            attn_block(q, HB + (size_t)(b * S_ + kpos) * INC + C_KW + g * 64, HB + (size_t)(b * S_ + j * 64) * INC + C_VW + g * 64 + lane,
                       (kpos <= s) && (kpos >= wlo), m, l, o);
        }
        const float owin = o / l;
        const float oc = r == 0 ? ocmp0 : (r == 1 ? ocmp1 : (r == 2 ? ocmp2 : ocmp3));
        const float g0 = sigmoidf_(bf2f(HB[rowt + C_GATE + h * 3 + 0]));
        const float g1 = sigmoidf_(bf2f(HB[rowt + C_GATE + h * 3 + 1]));
        const float g2 = sigmoidf_(bf2f(HB[rowt + C_GATE + h * 3 + 2]));
        OM[(size_t)t * 1024 + h * 64 + lane] = f2bf(g0 * oc + g1 * oslc + g2 * owin);
    }
}

DEV void hgrn_item(const P& p, int item, float* smem) {
    const int b = item >> 2, hh = item & 3;
    const int tid = threadIdx.x, dv = tid & 127, half = tid >> 7;
    const bf16_t* HB = (const bf16_t*)(p.ws + WS_HB);
    bf16_t* OM = (bf16_t*)(p.ws + WS_OM);
    float* sf = smem;
    float* sq = smem + 1024;
    float* so = smem + 2048;
    float Sreg[64];
#pragma unroll
    for (int i = 0; i < 64; ++i) Sreg[i] = 0.f;
    const int d = tid & 127;
    float lbv;
    {
        const float l0 = p.lb_logits[hh * 128 + d], l1 = p.lb_logits[512 + hh * 128 + d];
        const float mx = fmaxf(l0, l1);
        const float e0 = expf(l0 - mx), e1 = expf(l1 - mx);
        lbv = e0 / (e0 + e1);
    }
    const int wave = tid >> 6, lane = tid & 63;
    const float nw0 = p.hg_norm_w[hh * 128 + lane], nw1 = p.hg_norm_w[hh * 128 + lane + 64];
    for (int t0 = 0; t0 < S_; t0 += 8) {
#pragma unroll
        for (int i = 0; i < 4; ++i) {
            const int st = (tid >> 7) + 2 * i;
            const size_t tt = (size_t)b * S_ + t0 + st;
            const float fl = bf2f(HB[tt * INC + C_HF + hh * 128 + d]);
            sf[st * 128 + d] = lbv + (1.f - lbv) * sigmoidf_(fl);
            sq[st * 128 + d] = bf2f(HB[tt * INC + C_HQ + hh * 128 + d]);
        }
        float vv[8];
#pragma unroll
        for (int st = 0; st < 8; ++st) vv[st] = bf2f(HB[((size_t)b * S_ + t0 + st) * INC + C_HI + hh * 128 + dv]);
        __syncthreads();
#pragma unroll
        for (int st = 0; st < 8; ++st) {
            float oacc = 0.f;
            const float* pf = sf + st * 128 + half * 64;
            const float* pq = sq + st * 128 + half * 64;
#pragma unroll
            for (int dk = 0; dk < 64; ++dk) {
                const float f = pf[dk];
                Sreg[dk] = f * Sreg[dk] + (1.f - f) * vv[st];
                oacc += pq[dk] * Sreg[dk];
            }
            so[(st * 2 + half) * 128 + dv] = oacc;
        }
        __syncthreads();
#pragma unroll
        for (int u = 0; u < 2; ++u) {
            const int st = wave * 2 + u;
            const float o0 = so[(st * 2 + 0) * 128 + lane] + so[(st * 2 + 1) * 128 + lane];
            const float o1 = so[(st * 2 + 0) * 128 + lane + 64] + so[(st * 2 + 1) * 128 + lane + 64];
            const float ss = wsum(o0 * o0 + o1 * o1);
            const float rs = rsqrtf(ss * (1.f / 128.f) + LN_EPS);
            const size_t tt = (size_t)b * S_ + t0 + st;
            const float gg0 = bf2f(HB[tt * INC + C_HG + hh * 128 + lane]);
            const float gg1 = bf2f(HB[tt * INC + C_HG + hh * 128 + lane + 64]);
            OM[tt * 1024 + 512 + hh * 128 + lane] = f2bf(o0 * rs * nw0 * (gg0 * sigmoidf_(gg0)));
            OM[tt * 1024 + 512 + hh * 128 + lane + 64] = f2bf(o1 * rs * nw1 * (gg1 * sigmoidf_(gg1)));
        }
    }
    __syncthreads();
}

DEV void ln_item(const P& p, int t, int which, int lane) {
    const bf16_t* row = (const bf16_t*)(p.ws + WS_YB) + (size_t)t * 1024;
    float4 v[4];
    float s = 0.f;
#pragma unroll
    for (int i = 0; i < 4; ++i) {
        const uint2 u = *(const uint2*)(row + (i * 64 + lane) * 4);
        v[i] = make_float4(bflo(u.x), bfhi(u.x), bflo(u.y), bfhi(u.y));
        s += v[i].x + v[i].y + v[i].z + v[i].w;
    }
    const float mean = wsum(s) * (1.f / 1024.f);
    float ss = 0.f;
#pragma unroll
    for (int i = 0; i < 4; ++i) {
        v[i].x -= mean; v[i].y -= mean; v[i].z -= mean; v[i].w -= mean;
        ss += v[i].x * v[i].x + v[i].y * v[i].y + v[i].z * v[i].z + v[i].w * v[i].w;
    }
    const float rs = rsqrtf(wsum(ss) * (1.f / 1024.f) + LN_EPS);
#pragma unroll
    for (int i = 0; i < 4; ++i) {
        const int c = (i * 64 + lane) * 4;
        const float4 gg = *(const float4*)(p.ln_g + which * 1024 + c);
        const float4 bb = *(const float4*)(p.ln_b + which * 1024 + c);
        float4 o;
        o.x = v[i].x * rs * gg.x + bb.x; o.y = v[i].y * rs * gg.y + bb.y; o.z = v[i].z * rs * gg.z + bb.z; o.w = v[i].w * rs * gg.w + bb.w;
        uint2 u;
        u.x = pk_bf16(o.x, o.y);
        u.y = pk_bf16(o.z, o.w);
        *(uint2*)((bf16_t*)(p.ws + WS_XB) + (size_t)t * 1024 + c) = u;
    }
}

DEV void xattn_item(const P& p, int item) {
    const int lane = threadIdx.x & 63;
    const int hh = item & 3, t = item >> 2, b = t >> 11;
    const bf16_t* QX = (const bf16_t*)(p.ws + WS_QX);
    const bf16_t* KVM = (const bf16_t*)(p.ws + WS_KVM);
    bf16_t* OX = (bf16_t*)(p.ws + WS_OX);
    float sc[4] = {0.f, 0.f, 0.f, 0.f};
#pragma unroll 1
    for (int c = 0; c < 4; ++c) {
        float q[64];
        load_q64_bf(q, QX + (size_t)t * 1024 + hh * 256 + c * 64);
#pragma unroll
        for (int k = 0; k < 4; ++k) sc[k] += dot64_bf(q, KVM + (size_t)(b * ML_ + lane + 64 * k) * 2048 + hh * 256 + c * 64);
    }
    float mx = -1e30f;
#pragma unroll
    for (int k = 0; k < 4; ++k) { sc[k] *= 0.0625f; mx = fmaxf(mx, sc[k]); }
    mx = wmax(mx);
    float pr[4], ls = 0.f;
#pragma unroll
    for (int k = 0; k < 4; ++k) { pr[k] = expf(sc[k] - mx); ls += pr[k]; }
    ls = wsum(ls);
    const float inv = 1.f / ls;
    float o[4] = {0.f, 0.f, 0.f, 0.f};
#pragma unroll
    for (int k = 0; k < 4; ++k) {
        const bf16_t* vb = KVM + (size_t)(b * ML_ + k * 64) * 2048 + 1024 + hh * 256 + lane;
#pragma unroll 4
        for (int mm = 0; mm < 64; ++mm) {
            const float pm = __shfl(pr[k], mm);
#pragma unroll
            for (int c = 0; c < 4; ++c) o[c] += pm * bf2f(vb[(size_t)mm * 2048 + c * 64]);
        }
    }
#pragma unroll
    for (int c = 0; c < 4; ++c) OX[(size_t)t * 1024 + hh * 256 + c * 64 + lane] = f2bf(o[c] * inv);
}

DEV void wave_argmax(float v, int i, float& bv, int& bi) {
#pragma unroll
    for (int o = 32; o > 0; o >>= 1) {
        const float ov = __shfl_xor(v, o);
        const int oi = __shfl_xor(i, o);
        if (ov > v || (ov == v && oi < i)) { v = ov; i = oi; }
    }
    bv = v; bi = i;
}

DEV void peer_item(const P& p, int t) {
    const int lane = threadIdx.x & 63;
    const float* QP = (const float*)(p.ws + WS_QP);
    float* row = p.out + (size_t)t * 1024;
    float4 xr[4], oacc[4];
#pragma unroll
    for (int i = 0; i < 4; ++i) {
        xr[i] = *(const float4*)(row + (i * 64 + lane) * 4);
        oacc[i] = make_float4(0.f, 0.f, 0.f, 0.f);
    }
#pragma unroll 1
    for (int hh = 0; hh < 8; ++hh) {
        float ts1 = 0.f, ts2 = 0.f;
        int ti1 = 0, ti2 = 0;
#pragma unroll 1
        for (int c = 0; c < 2; ++c) {
            float q[64];
            {
                const float4* q4 = (const float4*)(QP + (size_t)t * 1024 + hh * 128 + c * 64);
#pragma unroll
                for (int i = 0; i < 16; ++i) { const float4 u = q4[i]; q[i * 4] = u.x; q[i * 4 + 1] = u.y; q[i * 4 + 2] = u.z; q[i * 4 + 3] = u.w; }
            }
            const float* kb = p.peer_keys + ((size_t)(hh * 2 + c) * 128) * 64;
            float a0 = dot64_f(q, kb + (size_t)lane * 64);
            float a1 = dot64_f(q, kb + (size_t)(lane + 64) * 64);
            float ts = 0.f;
            int ti = 0;
#pragma unroll 1
            for (int k = 0; k < 16; ++k) {
                float v; int i;
                if (a0 >= a1) { v = a0; i = lane; } else { v = a1; i = lane + 64; }
                float bv; int bi;
                wave_argmax(v, i, bv, bi);
                if (lane == k) { ts = bv; ti = bi; }
                if (bi == lane) a0 = -INFINITY;
                if (bi == lane + 64) a1 = -INFINITY;
            }
            if (c == 0) { ts1 = ts; ti1 = ti; } else { ts2 = ts; ti2 = ti; }
        }
        float cs[4];
        const float s1v = __shfl(ts1, lane >> 2);
#pragma unroll
        for (int u = 0; u < 4; ++u) cs[u] = s1v + __shfl(ts2, (lane & 3) * 4 + u);
        float fs = 0.f;
        int fidx = 0;
#pragma unroll 1
        for (int k = 0; k < 16; ++k) {
            float v = cs[0]; int i = lane * 4;
#pragma unroll
            for (int u = 1; u < 4; ++u) if (cs[u] > v) { v = cs[u]; i = lane * 4 + u; }
            float bv; int bi;
            wave_argmax(v, i, bv, bi);
            if (lane == k) { fs = bv; fidx = bi; }
#pragma unroll
            for (int u = 0; u < 4; ++u) if (bi == lane * 4 + u) cs[u] = -INFINITY;
        }
        const int e1i = __shfl(ti1, fidx >> 4);
        const int e2i = __shfl(ti2, fidx & 15);
        const int eid = e1i * 128 + e2i;
        const float mx = __shfl(fs, 0);
        const float w = (lane < 16) ? expf(fs - mx) : 0.f;
        const float gate = w / wsum(w);
#pragma unroll 1
        for (int k = 0; k < 16; ++k) {
            const int e = __shfl(eid, k);
            const float gt = __shfl(gate, k);
            const float* dr = p.peer_down + (size_t)e * 1024;
            const float* ur = p.peer_up + (size_t)e * 1024;
            float hd = 0.f;
#pragma unroll
            for (int i = 0; i < 4; ++i) {
                const float4 dvv = *(const float4*)(dr + (i * 64 + lane) * 4);
                hd += dvv.x * xr[i].x + dvv.y * xr[i].y + dvv.z * xr[i].z + dvv.w * xr[i].w;
            }
            hd = wsum(hd);
            const float a = 0.5f * hd * (1.f + erff(hd * 0.7071067811865476f)) * gt;
#pragma unroll
            for (int i = 0; i < 4; ++i) {
                const float4 uv = *(const float4*)(ur + (i * 64 + lane) * 4);
                oacc[i].x += a * uv.x; oacc[i].y += a * uv.y; oacc[i].z += a * uv.z; oacc[i].w += a * uv.w;
            }
        }
    }
    float s = 0.f;
    float4 v[4];
#pragma unroll
    for (int i = 0; i < 4; ++i) {
        v[i].x = ALPHA * xr[i].x + oacc[i].x; v[i].y = ALPHA * xr[i].y + oacc[i].y;
        v[i].z = ALPHA * xr[i].z + oacc[i].z; v[i].w = ALPHA * xr[i].w + oacc[i].w;
        s += v[i].x + v[i].y + v[i].z + v[i].w;
    }
    const float mean = wsum(s) * (1.f / 1024.f);
    float ss = 0.f;
#pragma unroll
    for (int i = 0; i < 4; ++i) {
        v[i].x -= mean; v[i].y -= mean; v[i].z -= mean; v[i].w -= mean;
        ss += v[i].x * v[i].x + v[i].y * v[i].y + v[i].z * v[i].z + v[i].w * v[i].w;
    }
    const float rs = rsqrtf(wsum(ss) * (1.f / 1024.f) + LN_EPS);
#pragma unroll
    for (int i = 0; i < 4; ++i) {
        const int c = (i * 64 + lane) * 4;
        const float4 gg = *(const float4*)(p.ln_g + 2 * 1024 + c);
        const float4 bb = *(const float4*)(p.ln_b + 2 * 1024 + c);
        float4 o;
        o.x = v[i].x * rs * gg.x + bb.x; o.y = v[i].y * rs * gg.y + bb.y; o.z = v[i].z * rs * gg.z + bb.z; o.w = v[i].w * rs * gg.w + bb.w;
        *(float4*)(row + c) = o;
    }
}


DEV void compress_item2(const P& p, int item, unsigned char* lds) {
    const int nt8 = item & 7, g = (item >> 3) & 1, b = (item >> 4) & 7, kind = item >> 7;
    const int tid = threadIdx.x, lane = tid & 63, wid = tid >> 6, fr = lane & 15, fq = lane >> 4;
    const bf16_t* HB = (const bf16_t*)(p.ws + WS_HB);
    const bf16_t* W1T = (const bf16_t*)(p.ws + WS_W1T) + (size_t)kind * 128 * 2048;
    const bf16_t* W2T = (const bf16_t*)(p.ws + WS_W2T) + (size_t)kind * 64 * 128;
    const float* posb = p.cmp_pos + (size_t)kind * 2048 + fq * 8;
    const int n0 = nt8 * 16;
    const int kcol = (kind ? C_VC : C_KC) + g * 64;
    const bf16_t* abase = HB + (size_t)(b * S_ + 16 * (n0 + fr)) * INC + kcol + fq * 8;
    const bf16_t* wbase = W1T + (size_t)fr * 2048 + fq * 8;
    f32x4 acc[8];
#pragma unroll
    for (int jt = 0; jt < 8; ++jt) acc[jt] = (f32x4){0.f, 0.f, 0.f, 0.f};
#pragma unroll 4
    for (int k2 = 0; k2 < 16; ++k2) {
        const int ks = wid * 16 + k2;
        bf16x8 af;
        {
            const u32x4 raw = *(const u32x4*)(abase + (size_t)(ks >> 1) * INC + (ks & 1) * 32);
            const float* pp = posb + (ks >> 1) * 64 + (ks & 1) * 32;
            const float4 p0 = *(const float4*)pp, p1 = *(const float4*)(pp + 4);
            u32x4 w;
            w[0] = pk_bf16(bflo(raw[0]) + p0.x, bfhi(raw[0]) + p0.y);
            w[1] = pk_bf16(bflo(raw[1]) + p0.z, bfhi(raw[1]) + p0.w);
            w[2] = pk_bf16(bflo(raw[2]) + p1.x, bfhi(raw[2]) + p1.y);
            w[3] = pk_bf16(bflo(raw[3]) + p1.z, bfhi(raw[3]) + p1.w);
            af = __builtin_bit_cast(bf16x8, w);
        }
#pragma unroll
        for (int jt = 0; jt < 8; ++jt) {
            const bf16x8 wf = *(const bf16x8*)(wbase + (size_t)jt * 16 * 2048 + ks * 32);
            acc[jt] = __builtin_amdgcn_mfma_f32_16x16x32_bf16(wf, af, acc[jt], 0, 0, 0);
        }
    }
    float* PS = (float*)lds;
    bf16_t* HS = (bf16_t*)(lds + 4 * 16 * 132 * 4);
#pragma unroll
    for (int jt = 0; jt < 8; ++jt)
        *(float4*)(PS + (wid * 16 + fr) * 132 + jt * 16 + fq * 4) = make_float4(acc[jt][0], acc[jt][1], acc[jt][2], acc[jt][3]);
    __syncthreads();
    {
        const int r = tid >> 4, jb = (tid & 15) * 8;
        float hv[8];
#pragma unroll
        for (int h2 = 0; h2 < 2; ++h2) {
            float4 s = make_float4(0.f, 0.f, 0.f, 0.f);
#pragma unroll
            for (int w = 0; w < 4; ++w) {
                const float4 v = *(const float4*)(PS + (w * 16 + r) * 132 + jb + h2 * 4);
                s.x += v.x; s.y += v.y; s.z += v.z; s.w += v.w;
            }
            hv[h2 * 4 + 0] = s.x; hv[h2 * 4 + 1] = s.y; hv[h2 * 4 + 2] = s.z; hv[h2 * 4 + 3] = s.w;
        }
#pragma unroll
        for (int i = 0; i < 8; ++i) {
            const float v = hv[i];
            const float u = 0.7978845608028654f * (v + 0.044715f * v * v * v);
            hv[i] = 0.5f * v * (1.f + tanhf(u));
        }
        u32x4 w;
        w[0] = pk_bf16(hv[0], hv[1]); w[1] = pk_bf16(hv[2], hv[3]); w[2] = pk_bf16(hv[4], hv[5]); w[3] = pk_bf16(hv[6], hv[7]);
        *(u32x4*)(HS + r * 136 + jb) = w;
    }
    __syncthreads();
    f32x4 o = (f32x4){0.f, 0.f, 0.f, 0.f};
#pragma unroll
    for (int ks = 0; ks < 4; ++ks) {
        const bf16x8 hf = *(const bf16x8*)(HS + fr * 136 + ks * 32 + fq * 8);
        const bf16x8 wf = *(const bf16x8*)(W2T + (size_t)(wid * 16 + fr) * 128 + ks * 32 + fq * 8);
        if (kind == 0) o = __builtin_amdgcn_mfma_f32_16x16x32_bf16(wf, hf, o, 0, 0, 0);
        else o = __builtin_amdgcn_mfma_f32_16x16x32_bf16(hf, wf, o, 0, 0, 0);
    }
    if (kind == 0) {
        const int n = n0 + fr, e = wid * 16 + fq * 4;
        uint2 u2;
        u2.x = pk_bf16(o[0], o[1]);
        u2.y = pk_bf16(o[2], o[3]);
        if (n == 127) u2 = make_uint2(0u, 0u);
        *(uint2*)((bf16_t*)(p.ws + WS_KCB) + ((size_t)(b * 2 + g) * 128 + n) * 64 + e) = u2;
    } else {
        const int e = wid * 16 + fr, n = n0 + fq * 4;
        const float o3 = (n + 3 == 127) ? 0.f : o[3];
        uint2 u2;
        u2.x = pk_bf16(o[0], o[1]);
        u2.y = pk_bf16(o[2], o3);
        *(uint2*)((bf16_t*)(p.ws + WS_VCT) + ((size_t)(b * 2 + g) * 64 + e) * 128 + n) = u2;
    }
    __syncthreads();
}

constexpr int NSA_IMP = 32768;
constexpr int NSA_SCORE = 49152;
constexpr int NSA_SELM = NSA_SCORE + 4224;

struct NsaTileRegs { u32x4 k[2], v[2]; };
DEV void nsa_load_tile(NsaTileRegs& r, const bf16_t* kbase, size_t kstride, const bf16_t* vbase, size_t vstride, int tid) {
    const int lc = tid & 7, lr = tid >> 3;
#pragma unroll
    for (int i = 0; i < 2; ++i) {
        r.k[i] = *(const u32x4*)(kbase + (size_t)(lr + 32 * i) * kstride + lc * 8);
        r.v[i] = *(const u32x4*)(vbase + (size_t)(lr + 32 * i) * vstride + lc * 8);
    }
}
DEV void nsa_store_tile(const NsaTileRegs& r, unsigned char* stage, int tid) {
    const int lc = tid & 7, lr = tid >> 3;
    const int woff = lr * 128 + ((lc ^ ((lr >> 1) & 7)) << 4);
#pragma unroll
    for (int i = 0; i < 2; ++i) {
        *(u32x4*)(stage + woff + i * 4096) = r.k[i];
        *(u32x4*)(stage + 8192 + woff + i * 4096) = r.v[i];
    }
}
DEV void nsa_dma_tile(const bf16_t* kbase, size_t kstride, const bf16_t* vbase, size_t vstride, unsigned char* stage, int lane, int wid) {
#pragma unroll
    for (int i = 0; i < 2; ++i) {
        const int pc = wid * 2 + i;
        const int r = pc * 8 + (lane >> 3);
        const int c = (lane & 7) ^ ((r >> 1) & 7);
        __builtin_amdgcn_global_load_lds((const unsigned*)(kbase + (size_t)r * kstride + c * 8), (unsigned*)(stage + pc * 1024), 16, 0, 0);
        __builtin_amdgcn_global_load_lds((const unsigned*)(vbase + (size_t)r * vstride + c * 8), (unsigned*)(stage + 8192 + pc * 1024), 16, 0, 0);
    }
}
DEV void nsa_scores(const unsigned char* stage, const bf16x8 (&qf)[2][2], f32x4 (&sc)[4][2], int fr, int fq) {
    const int sw = (fr >> 1) & 7;
    const int c0 = (fq ^ sw) << 4;
    const unsigned char* rowp = stage + fr * 128;
    const unsigned char* p0 = rowp + c0;
    const unsigned char* p1 = rowp + (c0 ^ 64);
#pragma unroll
    for (int kt = 0; kt < 4; ++kt) {
        const bf16x8 k0 = *(const bf16x8*)(p0 + kt * 2048);
        const bf16x8 k1 = *(const bf16x8*)(p1 + kt * 2048);
#pragma unroll
        for (int qt = 0; qt < 2; ++qt) {
            f32x4 a = (f32x4){0.f, 0.f, 0.f, 0.f};
            a = __builtin_amdgcn_mfma_f32_16x16x32_bf16(k0, qf[qt][0], a, 0, 0, 0);
            a = __builtin_amdgcn_mfma_f32_16x16x32_bf16(k1, qf[qt][1], a, 0, 0, 0);
            sc[kt][qt] = a;
        }
    }
}
DEV void nsa_pv(const unsigned char* stage, const f32x4 (&sc)[4][2], f32x4 (&o)[4][2], int fr, int fq) {
    const int sw = (fr >> 1) & 7;
    const int v0 = (((fq >> 1) ^ sw) << 4) + 8 * (fq & 1);
    const unsigned char* rowp = stage + 8192 + fr * 128;
#pragma unroll
    for (int s = 0; s < 2; ++s) {
        u32x4 pf[2];
#pragma unroll
        for (int qt = 0; qt < 2; ++qt) {
            pf[qt][0] = pk_bf16(sc[2 * s][qt][0], sc[2 * s][qt][1]);
            pf[qt][1] = pk_bf16(sc[2 * s][qt][2], sc[2 * s][qt][3]);
            pf[qt][2] = pk_bf16(sc[2 * s + 1][qt][0], sc[2 * s + 1][qt][1]);
            pf[qt][3] = pk_bf16(sc[2 * s + 1][qt][2], sc[2 * s + 1][qt][3]);
        }
        const unsigned char* plo = rowp + (v0 ^ (64 * s));
        const unsigned char* phi = rowp + (v0 ^ (64 * s) ^ 32);
#pragma unroll
        for (int dt = 0; dt < 4; ++dt) {
            const uint2 lo = *(const uint2*)(plo + dt * 2048);
            const uint2 hi = *(const uint2*)(phi + dt * 2048);
            u32x4 vv;
            vv[0] = lo.x; vv[1] = lo.y; vv[2] = hi.x; vv[3] = hi.y;
            const bf16x8 vf = __builtin_bit_cast(bf16x8, vv);
#pragma unroll
            for (int qt = 0; qt < 2; ++qt)
                o[dt][qt] = __builtin_amdgcn_mfma_f32_16x16x32_bf16(vf, __builtin_bit_cast(bf16x8, pf[qt]), o[dt][qt], 0, 0, 0);
        }
    }
}
DEV float xmax4(float v) { v = fmaxf(v, __shfl_xor(v, 16)); return fmaxf(v, __shfl_xor(v, 32)); }
DEV float xsum4(float v) { v += __shfl_xor(v, 16); return v + __shfl_xor(v, 32); }

DEV void nsa_branch(const int mode, const int BR, const int q0v, const unsigned char* wsb, unsigned char* lds, int b, int g, unsigned blocks, const bf16x8 (&qf)[2][2], const int (&qpos)[2],
                    const unsigned (&selm)[2], const float (&gate)[2], f32x4 (&fin)[4][2], int tid) {
    asm volatile("" : "+v"(tid));
    const int fr = tid & 15, fq = (tid >> 4) & 3;
    const bf16_t* HB = (const bf16_t*)(wsb + WS_HB);
    const bf16_t* VT = (const bf16_t*)(wsb + WS_VT);
    const bf16_t* kb0 = HB + (size_t)(b * S_) * INC + (BR == 0 ? C_KS : C_KW) + g * 64;
    const bf16_t* vb0 = VT + ((((size_t)BR * B_ + b) * 2 + g) * 64) * 2048;
    const bool fake = mode == 1;
    float m[2] = {-1e30f, -1e30f}, l[2] = {0.f, 0.f};
    f32x4 o[4][2];
#pragma unroll
    for (int dt = 0; dt < 4; ++dt)
#pragma unroll
        for (int qt = 0; qt < 2; ++qt) o[dt][qt] = (f32x4){0.f, 0.f, 0.f, 0.f};
    const int lane64 = tid & 63, widx = __builtin_amdgcn_readfirstlane(tid >> 6);
    int kb = __builtin_ctz(blocks);
    blocks &= blocks - 1;
    int kb1 = blocks ? __builtin_ctz(blocks) : -1;
    if (kb1 >= 0) blocks &= blocks - 1;
    nsa_dma_tile(kb0 + (size_t)(fake ? 0 : kb) * 64 * INC, INC, vb0 + (fake ? 0 : kb) * 64, 2048, lds, lane64, widx);
    if (kb1 >= 0) nsa_dma_tile(kb0 + (size_t)(fake ? 0 : kb1) * 64 * INC, INC, vb0 + (fake ? 0 : kb1) * 64, 2048, lds + 16384, lane64, widx);
    int slot = 0;
    while (true) {
        if (kb1 >= 0) asm volatile("s_waitcnt vmcnt(4)\n\ts_waitcnt lgkmcnt(0)" ::: "memory");
        else asm volatile("s_waitcnt vmcnt(0)\n\ts_waitcnt lgkmcnt(0)" ::: "memory");
        __builtin_amdgcn_s_barrier(); asm volatile("" ::: "memory");
        const int kb2 = blocks ? __builtin_ctz(blocks) : -1;
        if (kb2 >= 0) {
            blocks &= blocks - 1;
            const int s2 = slot >= 1 ? slot - 1 : 2;
            nsa_dma_tile(kb0 + (size_t)(fake ? 0 : kb2) * 64 * INC, INC, vb0 + (fake ? 0 : kb2) * 64, 2048, lds + s2 * 16384, lane64, widx);
        }
        const unsigned char* stage = lds + slot * 16384;
        f32x4 sc[4][2];
        nsa_scores(stage, qf, sc, fr, fq);
        constexpr float C1 = 0.125f * 1.4426950408889634f;
        const bool need_mask = (BR == 0) ? (kb == (q0v >> 6)) : !((kb * 64 + 63 <= q0v) && (kb * 64 + 511 >= q0v + 31));
        float alpha[2];
        if (!need_mask) {
#pragma unroll
            for (int qt = 0; qt < 2; ++qt) {
                const bool sel = BR == 0 ? ((selm[qt] >> kb) & 1u) != 0u : true;
                float bm = -1e30f;
#pragma unroll
                for (int kt = 0; kt < 4; ++kt)
#pragma unroll
                    for (int i = 0; i < 4; ++i) {
                        const float s = sel ? sc[kt][qt][i] * C1 : -1e30f;
                        sc[kt][qt][i] = s;
                        bm = fmaxf(bm, s);
                    }
                bm = xmax4(bm);
                const float mn = fmaxf(m[qt], bm);
                alpha[qt] = __builtin_amdgcn_exp2f(m[qt] - mn);
                float ps = 0.f;
#pragma unroll
                for (int kt = 0; kt < 4; ++kt)
#pragma unroll
                    for (int i = 0; i < 4; ++i) {
                        const float s = sc[kt][qt][i];
                        const float e = (s > -1e29f) ? __builtin_amdgcn_exp2f(s - mn) : 0.f;
                        sc[kt][qt][i] = e;
                        ps += e;
                    }
                l[qt] = l[qt] * alpha[qt] + ps;
                m[qt] = mn;
            }
        } else {
#pragma unroll
            for (int qt = 0; qt < 2; ++qt) {
                const bool sel = BR == 0 ? ((selm[qt] >> kb) & 1u) != 0u : true;
                float bm = -1e30f;
#pragma unroll
                for (int kt = 0; kt < 4; ++kt)
#pragma unroll
                    for (int i = 0; i < 4; ++i) {
                        const int key = kb * 64 + kt * 16 + fq * 4 + i;
                        bool valid = sel && (key <= qpos[qt]);
                        if (BR == 1) valid = valid && (key + 511 >= qpos[qt]);
                        const float s = valid ? sc[kt][qt][i] * C1 : -1e30f;
                        sc[kt][qt][i] = s;
                        bm = fmaxf(bm, s);
                    }
                bm = xmax4(bm);
                const float mn = fmaxf(m[qt], bm);
                alpha[qt] = __builtin_amdgcn_exp2f(m[qt] - mn);
                float ps = 0.f;
#pragma unroll
                for (int kt = 0; kt < 4; ++kt)
#pragma unroll
                    for (int i = 0; i < 4; ++i) {
                        const float s = sc[kt][qt][i];
                        const float e = (s > -1e29f) ? __builtin_amdgcn_exp2f(s - mn) : 0.f;
                        sc[kt][qt][i] = e;
                        ps += e;
                    }
                l[qt] = l[qt] * alpha[qt] + ps;
                m[qt] = mn;
            }
        }
        {
#pragma unroll
            for (int qt = 0; qt < 2; ++qt)
#pragma unroll
                for (int dt = 0; dt < 4; ++dt) o[dt][qt] *= alpha[qt];
        }
        if (mode != 3) nsa_pv(stage, sc, o, fr, fq);
        else { asm volatile("" :: "v"(sc[0][0][0]), "v"(sc[1][1][1]), "v"(sc[2][0][2]), "v"(sc[3][1][3])); }
        if (kb1 < 0) break;
        kb = kb1;
        kb1 = kb2;
        slot = slot == 2 ? 0 : slot + 1;
    }
#pragma unroll
    for (int qt = 0; qt < 2; ++qt) {
        const float lt = xsum4(l[qt]);
        const float sc2 = lt > 0.f ? gate[qt] / lt : 0.f;
#pragma unroll
        for (int dt = 0; dt < 4; ++dt) fin[dt][qt] += o[dt][qt] * sc2;
    }
    asm volatile("s_waitcnt lgkmcnt(0)" ::: "memory");
    __builtin_amdgcn_s_barrier(); asm volatile("" ::: "memory");
}

DEV void nsa_item2(const P& p, int b, int g, int qblk, unsigned char* lds, int fake = 0) {
    int tid = threadIdx.x;
    asm volatile("" : "+v"(tid));
    const int lane = tid & 63, wid = tid >> 6, fr = lane & 15, fq = lane >> 4;
    const int q0 = qblk * 32, cur = q0 >> 6, h = g * 4 + wid;
    unsigned char* wsb = p.ws;
    asm volatile("" : "+s"(wsb));
    const bf16_t* HB = (const bf16_t*)(wsb + WS_HB);
    float* IMPW = (float*)(lds + NSA_IMP);
    float* SCORE = (float*)(lds + NSA_SCORE);
    unsigned* SELM = (unsigned*)(lds + NSA_SELM);
    bf16x8 qf[2][2];
    int qpos[2];
#pragma unroll
    for (int qt = 0; qt < 2; ++qt) {
        qpos[qt] = q0 + qt * 16 + fr;
        const bf16_t* rowp = HB + (size_t)(b * S_ + qpos[qt]) * INC;
#pragma unroll
        for (int ks = 0; ks < 2; ++ks) qf[qt][ks] = *(const bf16x8*)(rowp + C_QA + h * 64 + ks * 32 + fq * 8);
    }
    if (tid < 33) SELM[tid] = 0u;
    f32x4 fin[4][2];
#pragma unroll
    for (int dt = 0; dt < 4; ++dt)
#pragma unroll
        for (int qt = 0; qt < 2; ++qt) fin[dt][qt] = (f32x4){0.f, 0.f, 0.f, 0.f};
    {
        const bf16_t* KCB = (const bf16_t*)(wsb + WS_KCB) + (size_t)(b * 2 + g) * 128 * 64;
        const bf16_t* VCT = (const bf16_t*)(wsb + WS_VCT) + (size_t)(b * 2 + g) * 64 * 128;
        {
            const int widx = __builtin_amdgcn_readfirstlane(wid);
            nsa_dma_tile(KCB, 64, VCT, 128, lds, lane, widx);
            nsa_dma_tile(KCB + 64 * 64, 64, VCT + 64, 128, lds + 16384, lane, widx);
            asm volatile("s_waitcnt vmcnt(0)" ::: "memory");
        }
        __syncthreads();
        int nv[2];
        float mx[2] = {-1e30f, -1e30f}, inv[2];
#pragma unroll
        for (int qt = 0; qt < 2; ++qt) nv[qt] = qpos[qt] >= 31 ? (((qpos[qt] - 31) >> 4) + 1) : 0;
#pragma unroll 1
        for (int kb = 0; kb < 2; ++kb) {
            f32x4 sc[4][2];
            nsa_scores(lds + kb * 16384, qf, sc, fr, fq);
#pragma unroll
            for (int qt = 0; qt < 2; ++qt)
#pragma unroll
                for (int kt = 0; kt < 4; ++kt)
#pragma unroll
                    for (int i = 0; i < 4; ++i) {
                        const int n = kb * 64 + kt * 16 + fq * 4 + i;
                        mx[qt] = fmaxf(mx[qt], (n < nv[qt]) ? sc[kt][qt][i] * 0.125f : -1e30f);
                    }
        }
        float ps[2] = {0.f, 0.f};
#pragma unroll
        for (int qt = 0; qt < 2; ++qt) mx[qt] = xmax4(mx[qt]);
#pragma unroll 1
        for (int kb = 0; kb < 2; ++kb) {
            f32x4 sc[4][2];
            nsa_scores(lds + kb * 16384, qf, sc, fr, fq);
#pragma unroll
            for (int qt = 0; qt < 2; ++qt)
#pragma unroll
                for (int kt = 0; kt < 4; ++kt)
#pragma unroll
                    for (int i = 0; i < 4; ++i) {
                        const int n = kb * 64 + kt * 16 + fq * 4 + i;
                        ps[qt] += (n < nv[qt]) ? __expf(sc[kt][qt][i] * 0.125f - mx[qt]) : 0.f;
                    }
        }
#pragma unroll
        for (int qt = 0; qt < 2; ++qt) {
            ps[qt] = xsum4(ps[qt]);
            inv[qt] = ps[qt] > 0.f ? 1.f / ps[qt] : 0.f;
        }
        float prev3[2] = {0.f, 0.f};
#pragma unroll 1
        for (int kb = 0; kb < 2; ++kb) {
            f32x4 sc[4][2];
            nsa_scores(lds + kb * 16384, qf, sc, fr, fq);
#pragma unroll
            for (int qt = 0; qt < 2; ++qt) {
                float* impw = IMPW + (wid * 32 + qt * 16 + fr) * 32 + kb * 16 + fq;
#pragma unroll
                for (int kt = 0; kt < 4; ++kt) {
                    f32x4 pv;
#pragma unroll
                    for (int i = 0; i < 4; ++i) {
                        const int n = kb * 64 + kt * 16 + fq * 4 + i;
                        pv[i] = (n < nv[qt]) ? __expf(sc[kt][qt][i] * 0.125f - mx[qt]) * inv[qt] : 0.f;
                    }
                    sc[kt][qt] = pv;
                    const float c1 = __shfl_up(pv[3], 16);
                    const float c0 = __shfl(prev3[qt], fr + 48);
                    impw[kt * 4] = pv[0] + pv[1] + pv[2] + pv[3] + (fq > 0 ? c1 : c0);
                    prev3[qt] = pv[3];
                }
            }
            nsa_pv(lds + kb * 16384, sc, fin, fr, fq);
        }
#pragma unroll
        for (int qt = 0; qt < 2; ++qt) {
            const float gc = fsigmoid(bf2f(HB[(size_t)(b * S_ + qpos[qt]) * INC + C_GATE + h * 3 + 0]));
#pragma unroll
            for (int dt = 0; dt < 4; ++dt) fin[dt][qt] *= gc;
        }
    }
    __syncthreads();
    {
        const int q = tid >> 3, jg = tid & 7;
#pragma unroll
        for (int u = 0; u < 4; ++u) {
            const int j = jg * 4 + u;
            const float imp = IMPW[(0 * 32 + q) * 32 + j] + IMPW[(1 * 32 + q) * 32 + j] + IMPW[(2 * 32 + q) * 32 + j] + IMPW[(3 * 32 + q) * 32 + j];
            float score;
            if (j > cur) score = -INFINITY;
            else if (j == 0 || j == cur || j == cur - 1) score = 1e4f;
            else score = imp;
            SCORE[q * 33 + j] = score;
        }
        __syncthreads();
        unsigned bits = 0u;
#pragma unroll
        for (int u = 0; u < 4; ++u) {
            const int j = jg * 4 + u;
            const float sj = SCORE[q * 33 + j];
            int rank = 0;
#pragma unroll 8
            for (int i = 0; i < 32; ++i) {
                const float si = SCORE[q * 33 + i];
                rank += ((si > sj) || (si == sj && i < j)) ? 1 : 0;
            }
            if (j <= cur && rank < 16) bits |= 1u << j;
        }
        atomicOr(&SELM[q], bits);
        atomicOr(&SELM[32], bits);
        __syncthreads();
    }
    unsigned selm[2];
    selm[0] = SELM[fr];
    selm[1] = SELM[16 + fr];
    const unsigned um = SELM[32];
    __syncthreads();
#pragma unroll 1
    for (int br = 0; br < 2; ++br) {
        const int wlo = (q0 - 511) > 0 ? ((q0 - 511) >> 6) : 0;
        const unsigned wmask = ((2u << cur) - 1u) & ~((1u << wlo) - 1u);
        float gs[2];
#pragma unroll
        for (int qt = 0; qt < 2; ++qt) gs[qt] = fsigmoid(bf2f(HB[(size_t)(b * S_ + qpos[qt]) * INC + C_GATE + h * 3 + 1 + br]));
        if (fake != 2) nsa_branch(fake, br, q0, wsb, lds, b, g, br ? wmask : um, qf, qpos, selm, gs, fin, tid);
    }
    bf16_t* OM = (bf16_t*)(wsb + WS_OM);
#pragma unroll
    for (int qt = 0; qt < 2; ++qt)
#pragma unroll
        for (int dt = 0; dt < 4; ++dt) {
            uint2 u2;
            u2.x = pk_bf16(fin[dt][qt][0], fin[dt][qt][1]);
            u2.y = pk_bf16(fin[dt][qt][2], fin[dt][qt][3]);
            *(uint2*)(OM + (size_t)(b * S_ + qpos[qt]) * 1024 + h * 64 + dt * 16 + fq * 4) = u2;
        }
}

DEV void hgrn_prep_item(const P& p, int item, float* smem) {
    const int c = item & 31, bh = item >> 5, hh = bh & 3, b = bh >> 2;
    const int tid = threadIdx.x, d = tid & 127, th = tid >> 7;
    const bf16_t* HB = (const bf16_t*)(p.ws + WS_HB);
    unsigned char* hs = (unsigned char*)p.out;
    bf16_t* QT = (bf16_t*)(hs + HS_QT);
    bf16_t* KT = (bf16_t*)(hs + HS_KT);
    bf16_t* KHT = (bf16_t*)(hs + HS_KHT);
    bf16_t* VIT = (bf16_t*)(hs + HS_VIT);
    float lbv;
    {
        const float l0 = p.lb_logits[hh * 128 + d], l1 = p.lb_logits[512 + hh * 128 + d];
        const float mx = fmaxf(l0, l1);
        const float e0 = expf(l0 - mx), e1 = expf(l1 - mx);
        lbv = e0 / (e0 + e1);
    }
    const size_t trow0 = (size_t)b * S_ + c * 64 + th * 32;
    float kk[32], bl[32];
    float run = 0.f;
#pragma unroll
    for (int i = 0; i < 32; ++i) {
        const float fl = bf2f(HB[(trow0 + i) * INC + C_HF + hh * 128 + d]);
        const float f = lbv + (1.f - lbv) * fsigmoid(fl);
        kk[i] = 1.f - f;
        run += __logf(f);
        bl[i] = run;
    }
    smem[th * 128 + d] = run;
    __syncthreads();
    const float off = th ? smem[d] : 0.f;
    const float blast = smem[d] + smem[128 + d];
    unsigned kh[16], vi[16];
#pragma unroll
    for (int i = 0; i < 32; i += 2) {
        float qv[2], kt[2], khv[2], vv[2];
#pragma unroll
        for (int u = 0; u < 2; ++u) {
            const float bb = bl[i + u] + off;
            const size_t tr = trow0 + i + u;
            const float q = bf2f(HB[tr * INC + C_HQ + hh * 128 + d]);
            vv[u] = bf2f(HB[tr * INC + C_HI + hh * 128 + d]);
            qv[u] = q * __expf(bb);
            kt[u] = kk[i + u] * __expf(fminf(-bb, 80.f));
            khv[u] = kk[i + u] * __expf(blast - bb);
            const size_t o = ((size_t)bh * 2048 + c * 64 + th * 32 + i + u) * 128 + d;
            QT[o] = f2bf(qv[u]);
            KT[o] = f2bf(kt[u]);
        }
        kh[i >> 1] = pk_bf16(khv[0], khv[1]);
        vi[i >> 1] = pk_bf16(vv[0], vv[1]);
    }
    {
        const size_t o = ((size_t)bh * 128 + d) * 2048 + c * 64 + th * 32;
#pragma unroll
        for (int j = 0; j < 4; ++j) {
            u32x4 a, bq;
            a[0] = kh[4 * j]; a[1] = kh[4 * j + 1]; a[2] = kh[4 * j + 2]; a[3] = kh[4 * j + 3];
            bq[0] = vi[4 * j]; bq[1] = vi[4 * j + 1]; bq[2] = vi[4 * j + 2]; bq[3] = vi[4 * j + 3];
            *(u32x4*)(KHT + o + j * 8) = a;
            *(u32x4*)(VIT + o + j * 8) = bq;
        }
    }
    if (th == 0) ((float*)(p.ws + WS_EB))[((size_t)bh * 32 + c) * 128 + d] = expf(blast);
    __syncthreads();
}

DEV bf16x8 ld2x8(const bf16_t* p0, const bf16_t* p1) {
    const uint2 lo = *(const uint2*)p0, hi = *(const uint2*)p1;
    u32x4 v;
    v[0] = lo.x; v[1] = lo.y; v[2] = hi.x; v[3] = hi.y;
    return __builtin_bit_cast(bf16x8, v);
}
struct HgRegs { u32x4 a[4], b[4]; };
DEV void hg_loadA(HgRegs& r, const bf16_t* KT, const bf16_t* QT, int s0, int tid) {
    const unsigned off = (unsigned)(((tid >> 4) * 128 + (tid & 15) * 8) * 2);
    const char* kb = (const char*)(KT + (size_t)s0 * 128);
    const char* qb = (const char*)(QT + (size_t)s0 * 128);
#pragma unroll
    for (int i = 0; i < 4; ++i) {
        r.a[i] = *(const u32x4*)(kb + i * 4096 + off);
        r.b[i] = *(const u32x4*)(qb + i * 4096 + off);
    }
}
DEV void hg_storeA(const HgRegs& r, unsigned char* lds, int tid) {
    const int c16 = tid & 15, r16 = tid >> 4;
    const int o16 = r16 * 256 + ((c16 ^ (r16 & 15)) << 4);
#pragma unroll
    for (int i = 0; i < 4; ++i) {
        *(u32x4*)(lds + o16 + i * 4096) = r.a[i];
        *(u32x4*)(lds + 16384 + o16 + i * 4096) = r.b[i];
    }
}
DEV void hg_loadB(HgRegs& r, const bf16_t* KHT, const bf16_t* VIT, int s0, int tid) {
    const unsigned off = (unsigned)(((tid >> 3) * 2048 + (tid & 7) * 8) * 2);
    const char* kb = (const char*)(KHT + s0);
    const char* vb = (const char*)(VIT + s0);
#pragma unroll
    for (int i = 0; i < 4; ++i) {
        r.a[i] = *(const u32x4*)(kb + (size_t)i * 131072 + off);
        r.b[i] = *(const u32x4*)(vb + (size_t)i * 131072 + off);
    }
}
DEV void hg_storeB(const HgRegs& r, unsigned char* lds, int tid) {
    const int c8 = tid & 7, r8 = tid >> 3;
    const int o8 = r8 * 128 + ((c8 ^ ((r8 >> 1) & 7)) << 4);
#pragma unroll
    for (int i = 0; i < 4; ++i) {
        *(u32x4*)(lds + 32768 + o8 + i * 4096) = r.a[i];
        *(u32x4*)(lds + 49152 + o8 + i * 4096) = r.b[i];
    }
}
DEV void hgrn_chain_item(const P& p, int bh, unsigned char* lds) {
    const int hh = bh & 3, b = bh >> 2;
    int tid = threadIdx.x;
    asm volatile("" : "+v"(tid));
    const int lane = tid & 63, wid = tid >> 6, fr = lane & 15, fq = lane >> 4;
    const unsigned char* hs = (const unsigned char*)p.out;
    const bf16_t* QT = (const bf16_t*)(hs + HS_QT) + (size_t)bh * 2048 * 128;
    const bf16_t* KT = (const bf16_t*)(hs + HS_KT) + (size_t)bh * 2048 * 128;
    const bf16_t* KHT = (const bf16_t*)(hs + HS_KHT) + (size_t)bh * 128 * 2048;
    const bf16_t* VIT = (const bf16_t*)(hs + HS_VIT) + (size_t)bh * 128 * 2048;
    const float* EB = (const float*)(p.ws + WS_EB) + (size_t)bh * 32 * 128;
    const bf16_t* HB = (const bf16_t*)(p.ws + WS_HB);
    bf16_t* OM = (bf16_t*)(p.ws + WS_OM);
    const unsigned char* sKT = lds;
    const unsigned char* sQT = lds + 16384;
    const unsigned char* sKH = lds + 32768;
    const unsigned char* sVI = lds + 49152;
    bf16_t* AT = (bf16_t*)lds;
    float* SS = (float*)(lds + 65536);
    f32x4 S[8][2];
#pragma unroll
    for (int i = 0; i < 8; ++i)
#pragma unroll
        for (int j = 0; j < 2; ++j) S[i][j] = (f32x4){0.f, 0.f, 0.f, 0.f};
    const int dv0 = wid * 32;
    const int sw8 = (fr >> 1) & 7;
    int b256[4];
#pragma unroll
    for (int ks = 0; ks < 4; ++ks) b256[ks] = fr * 256 + (((4 * ks + fq) ^ fr) << 4);
    int p256[4][2];
#pragma unroll
    for (int u = 0; u < 4; ++u)
#pragma unroll
        for (int h = 0; h < 2; ++h) p256[u][h] = fr * 256 + (((4 * u + 2 * h + (fq >> 1)) ^ fr) << 4) + 8 * (fq & 1);
    int b128[2];
#pragma unroll
    for (int ks = 0; ks < 2; ++ks) b128[ks] = fr * 128 + (((4 * ks + fq) ^ sw8) << 4);
    {
        HgRegs r;
        hg_loadA(r, KT, QT, 0, tid);
        hg_storeA(r, lds, tid);
        hg_loadB(r, KHT, VIT, 0, tid);
        hg_storeB(r, lds, tid);
    }
    __syncthreads();
#pragma unroll 1
    for (int c = 0; c < 32; ++c) {
        const int s0 = c * 64;
        HgRegs nx;
        if (c + 1 < 32) hg_loadA(nx, KT, QT, s0 + 64, tid);
        uint2 atp[4];
        {
            bf16x8 qf[4];
#pragma unroll
            for (int ks = 0; ks < 4; ++ks) qf[ks] = *(const bf16x8*)(sQT + wid * 4096 + b256[ks]);
#pragma unroll
            for (int st = 0; st < 4; ++st) {
                f32x4 a = (f32x4){0.f, 0.f, 0.f, 0.f};
#pragma unroll
                for (int ks = 0; ks < 4; ++ks) {
                    const bf16x8 kf = *(const bf16x8*)(sKT + st * 4096 + b256[ks]);
                    a = __builtin_amdgcn_mfma_f32_16x16x32_bf16(kf, qf[ks], a, 0, 0, 0);
                }
                const int t = wid * 16 + fr;
                float av[4];
#pragma unroll
                for (int i = 0; i < 4; ++i) av[i] = (st * 16 + fq * 4 + i <= t) ? a[i] : 0.f;
                atp[st].x = pk_bf16(av[0], av[1]);
                atp[st].y = pk_bf16(av[2], av[3]);
            }
        }
        __syncthreads();
#pragma unroll
        for (int st = 0; st < 4; ++st) *(uint2*)(AT + (wid * 16 + fr) * 72 + st * 16 + fq * 4) = atp[st];
        __syncthreads();
        f32x4 o[2][4];
#pragma unroll
        for (int i = 0; i < 2; ++i)
#pragma unroll
            for (int j = 0; j < 4; ++j) o[i][j] = (f32x4){0.f, 0.f, 0.f, 0.f};
        bf16x8 vf[2][2];
#pragma unroll
        for (int dvt = 0; dvt < 2; ++dvt)
#pragma unroll
            for (int ks = 0; ks < 2; ++ks) vf[dvt][ks] = *(const bf16x8*)(sVI + wid * 4096 + dvt * 2048 + b128[ks]);
#pragma unroll
        for (int ks = 0; ks < 2; ++ks)
#pragma unroll
            for (int tt = 0; tt < 4; ++tt) {
                const bf16x8 af = *(const bf16x8*)(AT + (tt * 16 + fr) * 72 + ks * 32 + fq * 8);
#pragma unroll
                for (int dvt = 0; dvt < 2; ++dvt) o[dvt][tt] = __builtin_amdgcn_mfma_f32_16x16x32_bf16(vf[dvt][ks], af, o[dvt][tt], 0, 0, 0);
            }
#pragma unroll
        for (int u = 0; u < 4; ++u) {
            bf16x8 sf[2];
#pragma unroll
            for (int dvt = 0; dvt < 2; ++dvt) {
                u32x4 w;
                w[0] = pk_bf16(S[2 * u][dvt][0], S[2 * u][dvt][1]);
                w[1] = pk_bf16(S[2 * u][dvt][2], S[2 * u][dvt][3]);
                w[2] = pk_bf16(S[2 * u + 1][dvt][0], S[2 * u + 1][dvt][1]);
                w[3] = pk_bf16(S[2 * u + 1][dvt][2], S[2 * u + 1][dvt][3]);
                sf[dvt] = __builtin_bit_cast(bf16x8, w);
            }
#pragma unroll
            for (int tt = 0; tt < 4; ++tt) {
                const uint2 lo = *(const uint2*)(sQT + tt * 4096 + p256[u][0]);
                const uint2 hi = *(const uint2*)(sQT + tt * 4096 + p256[u][1]);
                u32x4 w;
                w[0] = lo.x; w[1] = lo.y; w[2] = hi.x; w[3] = hi.y;
                const bf16x8 qf2 = __builtin_bit_cast(bf16x8, w);
#pragma unroll
                for (int dvt = 0; dvt < 2; ++dvt) o[dvt][tt] = __builtin_amdgcn_mfma_f32_16x16x32_bf16(sf[dvt], qf2, o[dvt][tt], 0, 0, 0);
            }
        }
        u32x4 op[4];
#pragma unroll
        for (int tt = 0; tt < 4; ++tt) {
            float ss = 0.f;
#pragma unroll
            for (int dvt = 0; dvt < 2; ++dvt)
#pragma unroll
                for (int i = 0; i < 4; ++i) ss += o[dvt][tt][i] * o[dvt][tt][i];
            ss = xsum4(ss);
            if (fq == 0) SS[wid * 64 + tt * 16 + fr] = ss;
            op[tt][0] = pk_bf16(o[0][tt][0], o[0][tt][1]);
            op[tt][1] = pk_bf16(o[0][tt][2], o[0][tt][3]);
            op[tt][2] = pk_bf16(o[1][tt][0], o[1][tt][1]);
            op[tt][3] = pk_bf16(o[1][tt][2], o[1][tt][3]);
        }
        __syncthreads();
        if (c + 1 < 32) { hg_storeA(nx, lds, tid); hg_loadB(nx, KHT, VIT, s0 + 64, tid); }
        uint2 gg[4][2];
#pragma unroll
        for (int tt = 0; tt < 4; ++tt)
#pragma unroll
            for (int dvt = 0; dvt < 2; ++dvt)
                gg[tt][dvt] = *(const uint2*)(HB + ((size_t)b * S_ + s0 + tt * 16 + fr) * INC + C_HG + hh * 128 + dv0 + dvt * 16 + fq * 4);
        {
            bf16x8 vf3[2][2];
#pragma unroll
            for (int dvt = 0; dvt < 2; ++dvt)
#pragma unroll
                for (int ks = 0; ks < 2; ++ks) vf3[dvt][ks] = *(const bf16x8*)(sVI + wid * 4096 + dvt * 2048 + b128[ks]);
#pragma unroll
            for (int dkt = 0; dkt < 8; ++dkt) {
                const float4 eb = *(const float4*)(EB + c * 128 + dkt * 16 + fq * 4);
                bf16x8 kf[2];
#pragma unroll
                for (int ks = 0; ks < 2; ++ks) kf[ks] = *(const bf16x8*)(sKH + dkt * 2048 + b128[ks]);
#pragma unroll
                for (int dvt = 0; dvt < 2; ++dvt) {
                    f32x4 a = S[dkt][dvt];
                    a[0] *= eb.x; a[1] *= eb.y; a[2] *= eb.z; a[3] *= eb.w;
                    a = __builtin_amdgcn_mfma_f32_16x16x32_bf16(kf[0], vf3[dvt][0], a, 0, 0, 0);
                    a = __builtin_amdgcn_mfma_f32_16x16x32_bf16(kf[1], vf3[dvt][1], a, 0, 0, 0);
                    S[dkt][dvt] = a;
                }
            }
        }
        __syncthreads();
        if (c + 1 < 32) hg_storeB(nx, lds, tid);
#pragma unroll
        for (int tt = 0; tt < 4; ++tt) {
            const int t = tt * 16 + fr;
            const float tot = SS[t] + SS[64 + t] + SS[128 + t] + SS[192 + t];
            const float rs = rsqrtf(tot * (1.f / 128.f) + LN_EPS);
            const size_t tg = (size_t)b * S_ + s0 + t;
#pragma unroll
            for (int dvt = 0; dvt < 2; ++dvt) {
                const int dv = dv0 + dvt * 16 + fq * 4;
                const float g0 = bflo(gg[tt][dvt].x), g1 = bfhi(gg[tt][dvt].x), g2 = bflo(gg[tt][dvt].y), g3 = bfhi(gg[tt][dvt].y);
                const float4 nwv = *(const float4*)(p.hg_norm_w + hh * 128 + dv);
                const unsigned w0 = op[tt][2 * dvt], w1 = op[tt][2 * dvt + 1];
                const float r0 = bflo(w0) * rs * nwv.x * (g0 * fsigmoid(g0));
                const float r1 = bfhi(w0) * rs * nwv.y * (g1 * fsigmoid(g1));
                const float r2 = bflo(w1) * rs * nwv.z * (g2 * fsigmoid(g2));
                const float r3 = bfhi(w1) * rs * nwv.w * (g3 * fsigmoid(g3));
                uint2 u2;
                u2.x = pk_bf16(r0, r1);
                u2.y = pk_bf16(r2, r3);
                *(uint2*)(OM + tg * 1024 + 512 + hh * 128 + dv) = u2;
            }
        }
        __syncthreads();
    }
}


DEV void hgrn_prep_item2(const P& p, int item, unsigned char* lds) {
    const int c = item & 31, bh = item >> 5, hh = bh & 3, b = bh >> 2;
    int tid = threadIdx.x;
    asm volatile("" : "+v"(tid));
    const int d = tid & 127, th = tid >> 7;
    const int lane = tid & 63, wid = tid >> 6, fr = lane & 15, fq = lane >> 4;
    const bf16_t* HB = (const bf16_t*)(p.ws + WS_HB);
    unsigned char* hs = (unsigned char*)p.out;
    bf16_t* QTg = (bf16_t*)(hs + HS_QT);
    bf16_t* OIg = (bf16_t*)(hs + HS_OI);
    uint2* DSg = (uint2*)(hs + HS_DS);
    float* tots = (float*)(lds + 65536);
    unsigned char* sKT = lds;
    unsigned char* sQT = lds + 16384;
    unsigned char* sKH = lds + 32768;
    unsigned char* sVI = lds + 49152;
    float lbv;
    {
        const float l0 = p.lb_logits[hh * 128 + d], l1 = p.lb_logits[512 + hh * 128 + d];
        const float mx = fmaxf(l0, l1);
        const float e0 = expf(l0 - mx), e1 = expf(l1 - mx);
        lbv = e0 / (e0 + e1);
    }
    const size_t trow0 = (size_t)b * S_ + c * 64 + th * 32;
    const float nwd = p.hg_norm_w[hh * 128 + d];
    float bl[32];
    float run = 0.f;
#pragma unroll
    for (int i = 0; i < 32; ++i) {
        const float fl = bf2f(HB[(trow0 + i) * INC + C_HF + hh * 128 + d]);
        const float f = lbv + (1.f - lbv) * fsigmoid(fl);
        run += __logf(f);
        bl[i] = run;
    }
    tots[th * 128 + d] = run;
    __syncthreads();
    const float off = th ? tots[d] : 0.f;
    const float blast = tots[d] + tots[128 + d];
#pragma unroll
    for (int j = 0; j < 4; ++j) {
        u32x4 a, bq;
#pragma unroll
        for (int i2 = 0; i2 < 4; ++i2) {
            float khv[2], vv[2];
#pragma unroll
            for (int u = 0; u < 2; ++u) {
                const int i = j * 8 + i2 * 2 + u;
                const float bb = bl[i] + off;
                const float kki = 1.f - __expf(bl[i] - (i ? bl[i > 0 ? i - 1 : 0] : 0.f));
                const size_t tr = trow0 + i;
                const float q = bf2f(HB[tr * INC + C_HQ + hh * 128 + d]);
                vv[u] = bf2f(HB[tr * INC + C_HI + hh * 128 + d]);
                const bf16_t qv = f2bf(q * __expf(bb));
                const bf16_t kt = f2bf(kki * __expf(fminf(-bb, 80.f)));
                khv[u] = kki * __expf(blast - bb);
                const int t = th * 32 + i;
                QTg[((size_t)bh * 2048 + c * 64 + t) * 128 + d] = qv;
                {
                    const float gv = bf2f(HB[tr * INC + C_HG + hh * 128 + d]);
                    ((bf16_t*)(p.ws + WS_XB))[((size_t)bh * 2048 + c * 64 + t) * 128 + d] = f2bf(nwd * gv * fsigmoid(gv));
                }
                const int off256 = t * 256 + ((((d >> 3) ^ (t & 15))) << 4) + (d & 7) * 2;
                *(bf16_t*)(sQT + off256) = qv;
                *(bf16_t*)(sKT + off256) = kt;
            }
            a[i2] = pk_bf16(khv[0], khv[1]);
            bq[i2] = pk_bf16(vv[0], vv[1]);
        }
        const int off128 = d * 128 + (((th * 4 + j) ^ ((d >> 1) & 7)) << 4);
        *(u32x4*)(sKH + off128) = a;
        *(u32x4*)(sVI + off128) = bq;
    }
    if (th == 0) ((float*)(p.ws + WS_EB))[((size_t)bh * 32 + c) * 128 + d] = __expf(blast);
    __syncthreads();
    const int sw8 = (fr >> 1) & 7;
    int b256[4];
#pragma unroll
    for (int ks = 0; ks < 4; ++ks) b256[ks] = fr * 256 + (((4 * ks + fq) ^ fr) << 4);
    int b128[2];
#pragma unroll
    for (int ks = 0; ks < 2; ++ks) b128[ks] = fr * 128 + (((4 * ks + fq) ^ sw8) << 4);
    uint2 atp[4];
    {
        bf16x8 qf[4];
#pragma unroll
        for (int ks = 0; ks < 4; ++ks) qf[ks] = *(const bf16x8*)(sQT + wid * 4096 + b256[ks]);
#pragma unroll
        for (int st = 0; st < 4; ++st) {
            f32x4 a = (f32x4){0.f, 0.f, 0.f, 0.f};
#pragma unroll
            for (int ks = 0; ks < 4; ++ks) {
                const bf16x8 kf = *(const bf16x8*)(sKT + st * 4096 + b256[ks]);
                a = __builtin_amdgcn_mfma_f32_16x16x32_bf16(kf, qf[ks], a, 0, 0, 0);
            }
            const int t = wid * 16 + fr;
            float av[4];
#pragma unroll
            for (int i = 0; i < 4; ++i) av[i] = (st * 16 + fq * 4 + i <= t) ? a[i] : 0.f;
            atp[st].x = pk_bf16(av[0], av[1]);
            atp[st].y = pk_bf16(av[2], av[3]);
        }
    }
    __syncthreads();
    bf16_t* AT = (bf16_t*)lds;
#pragma unroll
    for (int st = 0; st < 4; ++st) *(uint2*)(AT + (wid * 16 + fr) * 72 + st * 16 + fq * 4) = atp[st];
    __syncthreads();
    const int dv0 = wid * 32;
    bf16x8 vf[2][2];
#pragma unroll
    for (int dvt = 0; dvt < 2; ++dvt)
#pragma unroll
        for (int ks = 0; ks < 2; ++ks) vf[dvt][ks] = *(const bf16x8*)(sVI + wid * 4096 + dvt * 2048 + b128[ks]);
#pragma unroll
    for (int tt = 0; tt < 4; ++tt) {
        f32x4 o0 = (f32x4){0.f, 0.f, 0.f, 0.f}, o1 = (f32x4){0.f, 0.f, 0.f, 0.f};
#pragma unroll
        for (int ks = 0; ks < 2; ++ks) {
            const bf16x8 af = *(const bf16x8*)(AT + (tt * 16 + fr) * 72 + ks * 32 + fq * 8);
            o0 = __builtin_amdgcn_mfma_f32_16x16x32_bf16(vf[0][ks], af, o0, 0, 0, 0);
            o1 = __builtin_amdgcn_mfma_f32_16x16x32_bf16(vf[1][ks], af, o1, 0, 0, 0);
        }
        bf16_t* op = OIg + ((size_t)bh * 2048 + c * 64 + tt * 16 + fr) * 128 + dv0 + fq * 4;
        *(uint2*)op = make_uint2(pk_bf16(o0[0], o0[1]), pk_bf16(o0[2], o0[3]));
        *(uint2*)(op + 16) = make_uint2(pk_bf16(o1[0], o1[1]), pk_bf16(o1[2], o1[3]));
    }
    uint2* dsp = DSg + ((((size_t)bh * 32 + c) * 4 + wid) * 16) * 64 + lane;
#pragma unroll
    for (int dkt = 0; dkt < 8; ++dkt) {
        bf16x8 kf[2];
#pragma unroll
        for (int ks = 0; ks < 2; ++ks) kf[ks] = *(const bf16x8*)(sKH + dkt * 2048 + b128[ks]);
#pragma unroll
        for (int dvt = 0; dvt < 2; ++dvt) {
            f32x4 a = (f32x4){0.f, 0.f, 0.f, 0.f};
            a = __builtin_amdgcn_mfma_f32_16x16x32_bf16(kf[0], vf[dvt][0], a, 0, 0, 0);
            a = __builtin_amdgcn_mfma_f32_16x16x32_bf16(kf[1], vf[dvt][1], a, 0, 0, 0);
            dsp[(dkt * 2 + dvt) * 64] = make_uint2(pk_bf16(a[0], a[1]), pk_bf16(a[2], a[3]));
        }
    }
    __syncthreads();
}

DEV void hgrn_chain_item2(const P& p, int bh, unsigned char* lds) {
    const int hh = bh & 3, b = bh >> 2;
    int tid = threadIdx.x;
    asm volatile("" : "+v"(tid));
    const int lane = tid & 63, wid = __builtin_amdgcn_readfirstlane(tid >> 6), fr = lane & 15, fq = lane >> 4;
    const unsigned char* hs = (const unsigned char*)p.out;
    const bf16_t* QTg = (const bf16_t*)(hs + HS_QT) + (size_t)bh * 2048 * 128;
    const char* OIb = (const char*)(hs + HS_OI) + ((size_t)bh * 2048 * 128 + wid * 32) * 2;
    const unsigned oioff = (unsigned)((fr * 128 + fq * 4) * 2);
    const char* DSb = (const char*)(hs + HS_DS) + (((size_t)bh * 32 * 4 + wid) * 16 * 64) * 8;
    const unsigned dsoff = (unsigned)(lane * 8);
    const char* GGb = (const char*)(p.ws + WS_XB) + ((size_t)bh * 2048 * 128 + wid * 32) * 2;
    const unsigned ggoff = oioff;
    const float* EB = (const float*)(p.ws + WS_EB) + (size_t)bh * 32 * 128;
    bf16_t* OM = (bf16_t*)(p.ws + WS_OM);
    float* EBL = (float*)(lds + 16384);
    float* SS = (float*)(lds + 16896);
    const int dv0 = wid * 32;
    int p256[4][2];
#pragma unroll
    for (int u = 0; u < 4; ++u)
#pragma unroll
        for (int h = 0; h < 2; ++h) p256[u][h] = fr * 256 + (((4 * u + 2 * h + (fq >> 1)) ^ fr) << 4) + 8 * (fq & 1);
    const int c16 = tid & 15, r16 = tid >> 4;
    const int o16 = r16 * 256 + ((c16 ^ (r16 & 15)) << 4);
    const unsigned qoff = (unsigned)((r16 * 128 + c16 * 8) * 2);
    f32x4 S[2][2];
    f32x4* SL = (f32x4*)(lds + 17920) + wid * 768 + lane;
#pragma unroll
    for (int i = 0; i < 2; ++i)
#pragma unroll
        for (int j = 0; j < 2; ++j) S[i][j] = (f32x4){0.f, 0.f, 0.f, 0.f};
#pragma unroll
    for (int i = 0; i < 12; ++i) SL[i * 64] = (f32x4){0.f, 0.f, 0.f, 0.f};
    uint2 oi[4][2], dsr[8][2];
    {
        const char* qb = (const char*)QTg;
#pragma unroll
        for (int i = 0; i < 4; ++i) *(u32x4*)(lds + o16 + i * 4096) = *(const u32x4*)(qb + i * 4096 + qoff);
        if (tid < 32) *(u32x4*)(EBL + tid * 4) = *(const u32x4*)(EB + tid * 4);
#pragma unroll
        for (int tt = 0; tt < 4; ++tt)
#pragma unroll
            for (int dvt = 0; dvt < 2; ++dvt) {
                oi[tt][dvt] = *(const uint2*)(OIb + tt * 4096 + dvt * 32 + oioff);
            }
#pragma unroll
        for (int dkt = 0; dkt < 8; ++dkt)
#pragma unroll
            for (int dvt = 0; dvt < 2; ++dvt) dsr[dkt][dvt] = *(const uint2*)(DSb + (dkt * 2 + dvt) * 512 + dsoff);
    }
    __syncthreads();
#pragma unroll 1
    for (int c = 0; c < 32; ++c) {
        const int s0 = c * 64;
        const bool more = c + 1 < 32;
        uint2 gg[4][2];
#pragma unroll
        for (int tt = 0; tt < 4; ++tt)
#pragma unroll
            for (int dvt = 0; dvt < 2; ++dvt) gg[tt][dvt] = *(const uint2*)(GGb + (size_t)s0 * 256 + tt * 4096 + dvt * 32 + ggoff);
        f32x4 o[2][4];
#pragma unroll
        for (int tt = 0; tt < 4; ++tt)
#pragma unroll
            for (int dvt = 0; dvt < 2; ++dvt) {
                o[dvt][tt] = (f32x4){bflo(oi[tt][dvt].x), bfhi(oi[tt][dvt].x), bflo(oi[tt][dvt].y), bfhi(oi[tt][dvt].y)};
                if (more) oi[tt][dvt] = *(const uint2*)(OIb + (size_t)(s0 + 64) * 256 + tt * 4096 + dvt * 32 + oioff);
            }
        const unsigned char* sQ = lds;
#pragma unroll
        for (int u = 0; u < 4; ++u) {
            bf16x8 sf[2];
#pragma unroll
            for (int dvt = 0; dvt < 2; ++dvt) {
                const f32x4 sa = u < 1 ? S[0][dvt] : SL[((2 * u - 2) * 2 + dvt) * 64];
                const f32x4 sb = u < 1 ? S[1][dvt] : SL[((2 * u - 1) * 2 + dvt) * 64];
                u32x4 w;
                w[0] = pk_bf16(sa[0], sa[1]);
                w[1] = pk_bf16(sa[2], sa[3]);
                w[2] = pk_bf16(sb[0], sb[1]);
                w[3] = pk_bf16(sb[2], sb[3]);
                sf[dvt] = __builtin_bit_cast(bf16x8, w);
            }
#pragma unroll
            for (int tt = 0; tt < 4; ++tt) {
                const uint2 lo = *(const uint2*)(sQ + tt * 4096 + p256[u][0]);
                const uint2 hi = *(const uint2*)(sQ + tt * 4096 + p256[u][1]);
                u32x4 w;
                w[0] = lo.x; w[1] = lo.y; w[2] = hi.x; w[3] = hi.y;
                const bf16x8 qf2 = __builtin_bit_cast(bf16x8, w);
#pragma unroll
                for (int dvt = 0; dvt < 2; ++dvt) o[dvt][tt] = __builtin_amdgcn_mfma_f32_16x16x32_bf16(sf[dvt], qf2, o[dvt][tt], 0, 0, 0);
            }
        }
        u32x4 qn[4], ebn;
        if (more) {
            const char* qb = (const char*)(QTg + (size_t)(s0 + 64) * 128);
#pragma unroll
            for (int i = 0; i < 4; ++i) qn[i] = *(const u32x4*)(qb + i * 4096 + qoff);
            if (tid < 32) ebn = *(const u32x4*)(EB + (c + 1) * 128 + tid * 4);
        }
#pragma unroll
        for (int dkt = 0; dkt < 8; ++dkt) {
            const float4 eb = *(const float4*)(EBL + dkt * 16 + fq * 4);
#pragma unroll
            for (int dvt = 0; dvt < 2; ++dvt) {
                const uint2 dd = dsr[dkt][dvt];
                f32x4 sv = dkt < 2 ? S[dkt < 2 ? dkt : 0][dvt] : SL[((dkt - 2) * 2 + dvt) * 64];
                sv[0] = fmaf(sv[0], eb.x, bflo(dd.x));
                sv[1] = fmaf(sv[1], eb.y, bfhi(dd.x));
                sv[2] = fmaf(sv[2], eb.z, bflo(dd.y));
                sv[3] = fmaf(sv[3], eb.w, bfhi(dd.y));
                if (dkt < 2) S[dkt < 2 ? dkt : 0][dvt] = sv; else SL[((dkt - 2) * 2 + dvt) * 64] = sv;
                if (more) dsr[dkt][dvt] = *(const uint2*)(DSb + (size_t)(c + 1) * 32768 + (dkt * 2 + dvt) * 512 + dsoff);
            }
        }
#pragma unroll
        for (int tt = 0; tt < 4; ++tt) {
            float ss = 0.f;
#pragma unroll
            for (int dvt = 0; dvt < 2; ++dvt)
#pragma unroll
                for (int i = 0; i < 4; ++i) ss += o[dvt][tt][i] * o[dvt][tt][i];
            ss = xsum4(ss);
            if (fq == 0) SS[wid * 64 + tt * 16 + fr] = ss;
        }
        __syncthreads();
#pragma unroll
        for (int tt = 0; tt < 4; ++tt) {
            const int t = tt * 16 + fr;
            const float tot = SS[t] + SS[64 + t] + SS[128 + t] + SS[192 + t];
            const float rs = rsqrtf(tot * (1.f / 128.f) + LN_EPS);
            const size_t tg = (size_t)b * S_ + s0 + t;
#pragma unroll
            for (int dvt = 0; dvt < 2; ++dvt) {
                const int dv = dv0 + dvt * 16 + fq * 4;
                const float r0 = o[dvt][tt][0] * rs * bflo(gg[tt][dvt].x);
                const float r1 = o[dvt][tt][1] * rs * bfhi(gg[tt][dvt].x);
                const float r2 = o[dvt][tt][2] * rs * bflo(gg[tt][dvt].y);
                const float r3 = o[dvt][tt][3] * rs * bfhi(gg[tt][dvt].y);
                *(uint2*)(OM + tg * 1024 + 512 + hh * 128 + dv) = make_uint2(pk_bf16(r0, r1), pk_bf16(r2, r3));
            }
        }
        if (more) {
#pragma unroll
            for (int i = 0; i < 4; ++i) *(u32x4*)(lds + o16 + i * 4096) = qn[i];
            if (tid < 32) *(u32x4*)(EBL + tid * 4) = ebn;
        }
        __syncthreads();
    }
}

DEV void xattn_item2(const P& p, int item) {
    const int qt64 = item & 31, hh = (item >> 5) & 3, b = item >> 7;
    const int lane = threadIdx.x & 63, wid = threadIdx.x >> 6, fr = lane & 15, fq = lane >> 4;
    const bf16_t* QX = (const bf16_t*)(p.ws + WS_QX);
    const bf16_t* KVM = (const bf16_t*)(p.ws + WS_KVM);
    const bf16_t* VMT = (const bf16_t*)(p.ws + WS_VMT) + (size_t)(b * 4 + hh) * 256 * 256;
    bf16_t* OX = (bf16_t*)(p.ws + WS_OX);
    const size_t tq = (size_t)b * S_ + qt64 * 64 + wid * 16 + fr;
    bf16x8 qf[8];
#pragma unroll
    for (int ks = 0; ks < 8; ++ks) qf[ks] = *(const bf16x8*)(QX + tq * 1024 + hh * 256 + ks * 32 + fq * 8);
    f32x4 sc[16];
#pragma unroll
    for (int kt = 0; kt < 16; ++kt) {
        f32x4 a = (f32x4){0.f, 0.f, 0.f, 0.f};
        const bf16_t* kp = KVM + (size_t)(b * ML_ + kt * 16 + fr) * 2048 + hh * 256 + fq * 8;
#pragma unroll
        for (int ks = 0; ks < 8; ++ks) a = __builtin_amdgcn_mfma_f32_16x16x32_bf16(*(const bf16x8*)(kp + ks * 32), qf[ks], a, 0, 0, 0);
        sc[kt] = a;
    }
    float mx = -1e30f;
#pragma unroll
    for (int kt = 0; kt < 16; ++kt)
#pragma unroll
        for (int i = 0; i < 4; ++i) { sc[kt][i] *= 0.0625f; mx = fmaxf(mx, sc[kt][i]); }
    mx = xmax4(mx);
    float ps = 0.f;
#pragma unroll
    for (int kt = 0; kt < 16; ++kt)
#pragma unroll
        for (int i = 0; i < 4; ++i) { sc[kt][i] = __expf(sc[kt][i] - mx); ps += sc[kt][i]; }
    ps = xsum4(ps);
    const float inv = 1.f / ps;
    u32x4 pf[8];
#pragma unroll
    for (int s = 0; s < 8; ++s) {
        pf[s][0] = pk_bf16(sc[2 * s][0] * inv, sc[2 * s][1] * inv);
        pf[s][1] = pk_bf16(sc[2 * s][2] * inv, sc[2 * s][3] * inv);
        pf[s][2] = pk_bf16(sc[2 * s + 1][0] * inv, sc[2 * s + 1][1] * inv);
        pf[s][3] = pk_bf16(sc[2 * s + 1][2] * inv, sc[2 * s + 1][3] * inv);
    }
#pragma unroll 1
    for (int dh = 0; dh < 2; ++dh) {
        f32x4 o[8];
#pragma unroll
        for (int dt = 0; dt < 8; ++dt) o[dt] = (f32x4){0.f, 0.f, 0.f, 0.f};
#pragma unroll
        for (int s = 0; s < 8; ++s) {
#pragma unroll
            for (int dt = 0; dt < 8; ++dt) {
                const bf16_t* vp = VMT + (size_t)(dh * 128 + dt * 16 + fr) * 256 + 32 * s + 4 * fq;
                o[dt] = __builtin_amdgcn_mfma_f32_16x16x32_bf16(ld2x8(vp, vp + 16), __builtin_bit_cast(bf16x8, pf[s]), o[dt], 0, 0, 0);
            }
        }
#pragma unroll
        for (int dt = 0; dt < 8; ++dt) {
            uint2 u2;
            u2.x = pk_bf16(o[dt][0], o[dt][1]);
            u2.y = pk_bf16(o[dt][2], o[dt][3]);
            *(uint2*)(OX + tq * 1024 + hh * 256 + dh * 128 + dt * 16 + fq * 4) = u2;
        }
    }
}


struct XaRegs { u32x4 r[8]; };
DEV void xa_loadK(XaRegs& x, const bf16_t* kbase, int tid) {
    const int c = tid & 31, r0 = tid >> 5;
#pragma unroll
    for (int i = 0; i < 8; ++i) x.r[i] = *(const u32x4*)(kbase + (size_t)(r0 + 8 * i) * 2048 + c * 8);
}
DEV void xa_storeK(const XaRegs& x, unsigned char* lds, int tid) {
    const int c = tid & 31, r0 = tid >> 5;
#pragma unroll
    for (int i = 0; i < 8; ++i) {
        const int row = r0 + 8 * i;
        *(u32x4*)(lds + row * 512 + ((c ^ (row & 15)) << 4)) = x.r[i];
    }
}
DEV void xa_loadV(XaRegs& x, const bf16_t* vbase, int tid) {
    const int c = tid & 7, r0 = tid >> 3;
#pragma unroll
    for (int i = 0; i < 8; ++i) x.r[i] = *(const u32x4*)(vbase + (size_t)(r0 + 32 * i) * 256 + c * 8);
}
DEV void xa_storeV(const XaRegs& x, unsigned char* lds, int tid) {
    const int c = tid & 7, r0 = tid >> 3;
    const int o = r0 * 128 + ((c ^ ((r0 >> 1) & 7)) << 4);
#pragma unroll
    for (int i = 0; i < 8; ++i) *(u32x4*)(lds + 32768 + o + i * 4096) = x.r[i];
}
DEV void xattn_item3(const P& p, int item, unsigned char* lds) {
    const int qt64 = item & 31, hh = (item >> 5) & 3, b = item >> 7;
    int tid = threadIdx.x;
    asm volatile("" : "+v"(tid));
    const int lane = tid & 63, wid = tid >> 6, fr = lane & 15, fq = lane >> 4;
    const bf16_t* QX = (const bf16_t*)(p.ws + WS_QX);
    const bf16_t* KB = (const bf16_t*)(p.ws + WS_KVM) + (size_t)(b * ML_) * 2048 + hh * 256;
    const bf16_t* VB = (const bf16_t*)(p.ws + WS_VMT) + (size_t)(b * 4 + hh) * 256 * 256;
    bf16_t* OX = (bf16_t*)(p.ws + WS_OX);
    const size_t tq = (size_t)b * S_ + qt64 * 64 + wid * 16 + fr;
    bf16x8 qf[8];
#pragma unroll
    for (int ks = 0; ks < 8; ++ks) qf[ks] = *(const bf16x8*)(QX + tq * 1024 + hh * 256 + ks * 32 + fq * 8);
    f32x4 o[16];
#pragma unroll
    for (int dt = 0; dt < 16; ++dt) o[dt] = (f32x4){0.f, 0.f, 0.f, 0.f};
    float m = -1e30f, l = 0.f;
    {
        XaRegs x;
        xa_loadK(x, KB, tid);
        xa_storeK(x, lds, tid);
        xa_loadV(x, VB, tid);
        xa_storeV(x, lds, tid);
    }
    __syncthreads();
    const int sw8 = (fr >> 1) & 7;
#pragma unroll 1
    for (int j = 0; j < 4; ++j) {
        XaRegs nx;
        if (j + 1 < 4) xa_loadK(nx, KB + (size_t)(j + 1) * 64 * 2048, tid);
        f32x4 sc[4];
#pragma unroll
        for (int kt = 0; kt < 4; ++kt) {
            f32x4 a = (f32x4){0.f, 0.f, 0.f, 0.f};
            const unsigned char* rp = lds + (kt * 16 + fr) * 512;
#pragma unroll
            for (int ks = 0; ks < 8; ++ks) a = __builtin_amdgcn_mfma_f32_16x16x32_bf16(*(const bf16x8*)(rp + (((4 * ks + fq) ^ fr) << 4)), qf[ks], a, 0, 0, 0);
            sc[kt] = a;
        }
        __syncthreads();
        if (j + 1 < 4) { xa_storeK(nx, lds, tid); xa_loadV(nx, VB + (j + 1) * 64, tid); }
        float bm = -1e30f;
#pragma unroll
        for (int kt = 0; kt < 4; ++kt)
#pragma unroll
            for (int i = 0; i < 4; ++i) { sc[kt][i] *= 0.0625f; bm = fmaxf(bm, sc[kt][i]); }
        bm = xmax4(bm);
        const float mn = fmaxf(m, bm);
        const float alpha = __expf(m - mn);
        float ps = 0.f;
#pragma unroll
        for (int kt = 0; kt < 4; ++kt)
#pragma unroll
            for (int i = 0; i < 4; ++i) { sc[kt][i] = __expf(sc[kt][i] - mn); ps += sc[kt][i]; }
        l = l * alpha + ps;
        m = mn;
#pragma unroll
        for (int dt = 0; dt < 16; ++dt) o[dt] *= alpha;
#pragma unroll
        for (int s = 0; s < 2; ++s) {
            u32x4 w;
            w[0] = pk_bf16(sc[2 * s][0], sc[2 * s][1]);
            w[1] = pk_bf16(sc[2 * s][2], sc[2 * s][3]);
            w[2] = pk_bf16(sc[2 * s + 1][0], sc[2 * s + 1][1]);
            w[3] = pk_bf16(sc[2 * s + 1][2], sc[2 * s + 1][3]);
            const bf16x8 pf = __builtin_bit_cast(bf16x8, w);
#pragma unroll
            for (int dt = 0; dt < 16; ++dt) {
                const unsigned char* rp = lds + 32768 + (dt * 16 + fr) * 128 + 8 * (fq & 1);
                const uint2 lo = *(const uint2*)(rp + (((4 * s + (fq >> 1)) ^ sw8) << 4));
                const uint2 hi = *(const uint2*)(rp + (((4 * s + 2 + (fq >> 1)) ^ sw8) << 4));
                u32x4 vv;
                vv[0] = lo.x; vv[1] = lo.y; vv[2] = hi.x; vv[3] = hi.y;
                o[dt] = __builtin_amdgcn_mfma_f32_16x16x32_bf16(__builtin_bit_cast(bf16x8, vv), pf, o[dt], 0, 0, 0);
            }
        }
        __syncthreads();
        if (j + 1 < 4) xa_storeV(nx, lds, tid);
        __syncthreads();
    }
    const float inv = 1.f / xsum4(l);
#pragma unroll
    for (int dt = 0; dt < 16; ++dt) {
        uint2 u2;
        u2.x = pk_bf16(o[dt][0] * inv, o[dt][1] * inv);
        u2.y = pk_bf16(o[dt][2] * inv, o[dt][3] * inv);
        *(uint2*)(OX + tq * 1024 + hh * 256 + dt * 16 + fq * 4) = u2;
    }
}


DEV void peer_quant_row(const float* src, unsigned char* dst, float* scl, int row, int* rsum = nullptr, int bias = 128) {
    const int lane = threadIdx.x & 63;
    const float* r = src + (size_t)row * 1024 + lane * 16;
    float v[16];
#pragma unroll
    for (int i = 0; i < 4; ++i) {
        const float4 a = *(const float4*)(r + 4 * i);
        v[4 * i] = a.x; v[4 * i + 1] = a.y; v[4 * i + 2] = a.z; v[4 * i + 3] = a.w;
    }
    float mx = 0.f;
#pragma unroll
    for (int i = 0; i < 16; ++i) mx = fmaxf(mx, fabsf(v[i]));
    mx = wmax(mx);
    const float q = mx > 0.f ? 127.f / mx : 0.f;
    u32x4 w;
    int usum = 0;
#pragma unroll
    for (int i = 0; i < 4; ++i) {
        unsigned pk = 0u;
#pragma unroll
        for (int k = 0; k < 4; ++k) {
            int qi = (int)rintf(v[4 * i + k] * q);
            qi = qi < -127 ? -127 : (qi > 127 ? 127 : qi);
            pk |= (unsigned)((qi + bias) & 0xff) << (8 * k);
            usum += qi + 128;
        }
        w[i] = pk;
    }
    *(u32x4*)(dst + ((size_t)(lane >> 3) * 16384 + row) * 128 + (lane & 7) * 16) = w;
    if (rsum) {
#pragma unroll
        for (int o = 32; o > 0; o >>= 1) usum += __shfl_xor(usum, o);
        if (lane == 0) rsum[row] = usum;
    }
    if (lane == 0) scl[row] = mx * (1.f / 127.f);
}

DEV unsigned f2ord(float f) { const unsigned b = __float_as_uint(f); return b ^ ((b >> 31) ? 0xffffffffu : 0x80000000u); }
DEV float ord2f(unsigned o) { return __uint_as_float((o & 0x80000000u) ? (o ^ 0x80000000u) : ~o); }
DEV void ins16(unsigned (&v)[16], unsigned x) {
#pragma unroll
    for (int k = 0; k < 16; ++k) {
        const unsigned t = v[k] > x ? v[k] : x;
        x = v[k] > x ? x : v[k];
        v[k] = t;
    }
}
constexpr int PEER_SC = 0;
constexpr int PEER_LST = 0;
constexpr int PEER_EID = 16384;
constexpr int PEER_GATE = 16384 + 4096;
DEV void peer_route_item(const P& p, int item, unsigned char* lds) {
    const int tid = threadIdx.x, lane = tid & 63, wid = tid >> 6;
    const int t0 = item * 16;
    const bf16_t* QP = (const bf16_t*)(p.ws + WS_QP);
    const bf16_t* PK = (const bf16_t*)(p.ws + WS_PKEY);
    unsigned* SC = (unsigned*)(lds + PEER_SC);
    const int fr = lane & 15, fq = lane >> 4;
    unsigned lst[16];
#pragma unroll
    for (int k = 0; k < 16; ++k) lst[k] = 0u;
    bf16x8 qf[4][2];
#pragma unroll
    for (int ci = 0; ci < 4; ++ci)
#pragma unroll
        for (int ks = 0; ks < 2; ++ks)
            qf[ci][ks] = *(const bf16x8*)(QP + (size_t)(t0 + fr) * 1024 + (4 * wid + ci) * 64 + ks * 32 + fq * 8);
#pragma unroll 1
    for (int pass = 0; pass < 2; ++pass) {
#pragma unroll
        for (int ci = 0; ci < 4; ++ci) {
            const int cb = 4 * wid + ci;
#pragma unroll
            for (int kt = 0; kt < 4; ++kt) {
                f32x4 acc = (f32x4){0.f, 0.f, 0.f, 0.f};
#pragma unroll
                for (int ks = 0; ks < 2; ++ks) {
                    const bf16x8 kf = *(const bf16x8*)(PK + ((size_t)cb * 128 + pass * 64 + kt * 16 + fr) * 64 + ks * 32 + fq * 8);
                    acc = __builtin_amdgcn_mfma_f32_16x16x32_bf16(kf, qf[ci][ks], acc, 0, 0, 0);
                }
                unsigned* dst = SC + (cb * 16 + fr) * 65 + kt * 16 + fq * 4;
#pragma unroll
                for (int i = 0; i < 4; ++i) {
                    const int kidx = pass * 64 + kt * 16 + fq * 4 + i;
                    dst[i] = (f2ord(acc[i]) & ~127u) | (unsigned)(127 - kidx);
                }
            }
        }
        __syncthreads();
        {
            const unsigned* row = SC + tid * 65;
#pragma unroll 4
            for (int k = 0; k < 64; ++k) ins16(lst, row[k]);
        }
        __syncthreads();
    }
    unsigned* LST = (unsigned*)(lds + PEER_LST);
#pragma unroll
    for (int k = 0; k < 16; ++k) LST[tid * 16 + k] = lst[k];
    __syncthreads();
    unsigned short* EID = (unsigned short*)(lds + PEER_EID);
    float* GATE = (float*)(lds + PEER_GATE);
    if (((tid >> 4) & 1) == 0) {
        const int tok = tid & 15, hh = tid >> 5;
        const unsigned* l2 = LST + (tid + 16) * 16;
        float s1[16], s2[16];
#pragma unroll
        for (int k = 0; k < 16; ++k) { s1[k] = ord2f(lst[k] & ~127u); s2[k] = ord2f(l2[k] & ~127u); }
        unsigned fin[16];
#pragma unroll
        for (int k = 0; k < 16; ++k) fin[k] = 0u;
#pragma unroll
        for (int i = 0; i < 16; ++i)
#pragma unroll
            for (int j = 0; j < 16; ++j)
                if ((i + 1) * (j + 1) <= 16) ins16(fin, (f2ord(s1[i] + s2[j]) & ~255u) | (unsigned)(255 - (i * 16 + j)));
        const float mx = ord2f(fin[0] & ~255u);
        float w[16], ws = 0.f;
#pragma unroll
        for (int k = 0; k < 16; ++k) { w[k] = expf(ord2f(fin[k] & ~255u) - mx); ws += w[k]; }
        const float inv = 1.f / ws;
#pragma unroll
        for (int k = 0; k < 16; ++k) {
            const int flat = 255 - (int)(fin[k] & 255u);
            const int i1 = 127 - (int)(LST[tid * 16 + (flat >> 4)] & 127u);
            const int i2 = 127 - (int)(l2[flat & 15] & 127u);
            EID[tok * 128 + hh * 16 + k] = (unsigned short)(i1 * 128 + i2);
            GATE[tok * 128 + hh * 16 + k] = w[k] * inv;
        }
    }
    __syncthreads();
    {
        unsigned short* EIDP = (unsigned short*)(p.ws + WS_EIDP);
        float* GATEP = (float*)(p.ws + WS_GATEP);
        for (int i = tid; i < 16 * 128; i += 256) {
            const int tok = i >> 7, pi = i & 127, eg = pi >> 4, k = pi & 15, slot = 8 * k + eg;
            EIDP[(size_t)(t0 + tok) * 128 + pi] = EID[tok * 128 + slot];
            GATEP[(size_t)(t0 + tok) * 128 + pi] = GATE[tok * 128 + slot];
        }
        unsigned char* XQ = p.ws + WS_XQ;
        const size_t tb = (size_t)t0 + wid * 4;
        float2 st4[4];
        u32x4 ya[4][2];
#pragma unroll
        for (int tt = 0; tt < 4; ++tt) {
            st4[tt] = ((const float2*)(p.ws + WS_ST2))[tb + tt];
            const bf16_t* row = (const bf16_t*)(p.ws + WS_YB) + (tb + tt) * 1024 + lane * 16;
            ya[tt][0] = *(const u32x4*)row;
            ya[tt][1] = *(const u32x4*)(row + 8);
        }
        float gv[16], bv[16];
#pragma unroll
        for (int i = 0; i < 4; ++i) {
            const float4 g4 = *(const float4*)(p.ln_g + 1024 + lane * 16 + 4 * i);
            const float4 b4 = *(const float4*)(p.ln_b + 1024 + lane * 16 + 4 * i);
            gv[4 * i] = g4.x; gv[4 * i + 1] = g4.y; gv[4 * i + 2] = g4.z; gv[4 * i + 3] = g4.w;
            bv[4 * i] = b4.x; bv[4 * i + 1] = b4.y; bv[4 * i + 2] = b4.z; bv[4 * i + 3] = b4.w;
        }
#pragma unroll
        for (int tt = 0; tt < 4; ++tt) {
            const size_t t = tb + tt;
            const float mean = st4[tt].x, rs = st4[tt].y;
            float xr[16];
            float amax = 0.f;
#pragma unroll
            for (int i = 0; i < 2; ++i)
#pragma unroll
                for (int q = 0; q < 4; ++q) {
                    const int j = 8 * i + 2 * q;
                    xr[j] = (bflo(ya[tt][i][q]) - mean) * rs * gv[j] + bv[j];
                    xr[j + 1] = (bfhi(ya[tt][i][q]) - mean) * rs * gv[j + 1] + bv[j + 1];
                    amax = fmaxf(amax, fmaxf(fabsf(xr[j]), fabsf(xr[j + 1])));
                }
            amax = wmax(amax);
            const float qx = amax > 0.f ? 127.f / amax : 0.f;
            u32x4 w;
            int s_ = 0;
#pragma unroll
            for (int i = 0; i < 4; ++i) {
                unsigned pk = 0u;
#pragma unroll
                for (int k = 0; k < 4; ++k) {
                    int qi = (int)rintf(xr[4 * i + k] * qx);
                    qi = qi < -127 ? -127 : (qi > 127 ? 127 : qi);
                    pk |= (unsigned)(qi + 128) << (8 * k);
                    s_ += qi + 128;
                }
                w[i] = pk;
            }
#pragma unroll
            for (int o = 32; o > 0; o >>= 1) s_ += __shfl_xor(s_, o);
            *(u32x4*)(XQ + t * 1024 + lane * 16) = w;
            if (lane == 0) {
                ((float*)(p.ws + WS_SXF))[t] = amax * (1.f / 127.f);
                ((int*)(p.ws + WS_SXI))[t] = s_;
            }
        }
    }
    __syncthreads();
}

DEV void peer_down_item(const P& p, int s, int tile, int lane, int wid) {
    const unsigned char* PD = p.ws + WS_PD + (size_t)s * 16384 * 128;
    const unsigned short* EIDP = (const unsigned short*)(p.ws + WS_EIDP);
    int* DP = (int*)(p.ws + WS_DP) + (size_t)s * T_ * 128;
    const int eg = lane >> 3, cg = lane & 7;
#pragma unroll 1
    for (int tt = 0; tt < 8; ++tt) {
        const size_t t = (size_t)tile * 32 + wid * 8 + tt;
        const u32x4 xu = *(const u32x4*)(p.ws + WS_XQ + t * 1024 + s * 128 + cg * 16);
        const u32x4 e0 = *(const u32x4*)(EIDP + t * 128 + eg * 16);
        const u32x4 e1 = *(const u32x4*)(EIDP + t * 128 + eg * 16 + 8);
        u32x4 rows[16];
#pragma unroll
        for (int k = 0; k < 16; ++k) {
            const unsigned ew = k < 8 ? e0[k >> 1] : e1[(k - 8) >> 1];
            const unsigned e = (k & 1) ? (ew >> 16) : (ew & 0xffffu);
            rows[k] = *(const u32x4*)(PD + (size_t)e * 128 + cg * 16);
        }
        unsigned v[16];
#pragma unroll
        for (int k = 0; k < 16; ++k) {
            unsigned a_ = 0u;
#pragma unroll
            for (int q = 0; q < 4; ++q) a_ = __builtin_amdgcn_udot4(rows[k][q], xu[q], a_, false);
            v[k] = a_;
        }
        unsigned w8[8], w4[4], w2[2];
        {
            const bool hi = (cg & 4) != 0;
#pragma unroll
            for (int j = 0; j < 8; ++j) {
                const unsigned send = hi ? v[j] : v[j + 8];
                const unsigned keep = hi ? v[j + 8] : v[j];
                w8[j] = keep + (unsigned)__shfl_xor((int)send, 4);
            }
        }
        {
            const bool hi = (cg & 2) != 0;
#pragma unroll
            for (int j = 0; j < 4; ++j) {
                const unsigned send = hi ? w8[j] : w8[j + 4];
                const unsigned keep = hi ? w8[j + 4] : w8[j];
                w4[j] = keep + (unsigned)__shfl_xor((int)send, 2);
            }
        }
        {
            const bool hi = (cg & 1) != 0;
#pragma unroll
            for (int j = 0; j < 2; ++j) {
                const unsigned send = hi ? w4[j] : w4[j + 2];
                const unsigned keep = hi ? w4[j + 2] : w4[j];
                w2[j] = keep + (unsigned)__shfl_xor((int)send, 1);
            }
        }
        *(uint2*)(DP + t * 128 + eg * 16 + 2 * cg) = make_uint2(w2[0], w2[1]);
    }
}

DEV void peer_coef_item(const P& p, int t, int lane) {
    const int* DP = (const int*)(p.ws + WS_DP);
    const unsigned short* EIDP = (const unsigned short*)(p.ws + WS_EIDP);
    const float* GATEP = (const float*)(p.ws + WS_GATEP);
    const float sx = ((const float*)(p.ws + WS_SXF))[t];
    const int sxu = ((const int*)(p.ws + WS_SXI))[t];
    float cf[2];
    float cm = 0.f;
#pragma unroll
    for (int h = 0; h < 2; ++h) {
        const int pi = lane + 64 * h;
        int tot = 0;
#pragma unroll
        for (int s = 0; s < 8; ++s) tot += DP[((size_t)s * T_ + t) * 128 + pi];
        const int e = EIDP[(size_t)t * 128 + pi];
        const int dotq = tot - 128 * ((const int*)(p.ws + WS_PRS))[e] - 128 * sxu + 128 * 128 * 1024;
        const float hv = ((const float*)(p.ws + WS_PSD))[e] * sx * (float)dotq;
        cf[h] = 0.5f * hv * (1.f + erff(hv * 0.7071067811865476f)) * GATEP[(size_t)t * 128 + pi] * ((const float*)(p.ws + WS_PSU))[e];
        cm = fmaxf(cm, fabsf(cf[h]));
    }
    cm = wmax(cm);
    const float qs = cm > 0.f ? 127.f / cm : 0.f;
#pragma unroll
    for (int h = 0; h < 2; ++h) {
        int qi = (int)rintf(cf[h] * qs);
        qi = qi < -127 ? -127 : (qi > 127 ? 127 : qi);
        (p.ws + WS_COEFP)[(size_t)t * 128 + lane + 64 * h] = (unsigned char)(qi & 0xff);
    }
    if (lane == 0) ((float*)(p.ws + WS_ASUM))[t] = cm * (1.f / 127.f);
}

DEV void peer_up_item(const P& p, int s, int tile, int lane, int wid, bool dostore = true) {
    const unsigned char* PU = p.ws + WS_PU + (size_t)s * 16384 * 128;
    const unsigned short* EIDP = (const unsigned short*)(p.ws + WS_EIDP);
    const unsigned char* COEFQ = p.ws + WS_COEFP;
    const int eg = lane >> 3, cg = lane & 7;
#pragma unroll 1
    for (int tt = 0; tt < 8; ++tt) {
        const size_t t = (size_t)tile * 32 + wid * 8 + tt;
        const u32x4 e0 = *(const u32x4*)(EIDP + t * 128 + eg * 16);
        const u32x4 e1 = *(const u32x4*)(EIDP + t * 128 + eg * 16 + 8);
        const u32x4 cq = *(const u32x4*)(COEFQ + t * 128 + eg * 16);
        u32x4 rows[16];
#pragma unroll
        for (int k = 0; k < 16; ++k) {
            const unsigned ew = k < 8 ? e0[k >> 1] : e1[(k - 8) >> 1];
            const unsigned e = (k & 1) ? (ew >> 16) : (ew & 0xffffu);
            rows[k] = *(const u32x4*)(PU + (size_t)e * 128 + cg * 16);
        }
        int acc[16];
#pragma unroll
        for (int i = 0; i < 16; ++i) acc[i] = 0;
#pragma unroll
        for (int g = 0; g < 4; ++g)
#pragma unroll
            for (int q = 0; q < 4; ++q) {
                const unsigned r0 = rows[4 * g][q], r1 = rows[4 * g + 1][q], r2 = rows[4 * g + 2][q], r3 = rows[4 * g + 3][q];
                const unsigned a0 = __builtin_amdgcn_perm(r1, r0, 0x05010400u), a1 = __builtin_amdgcn_perm(r1, r0, 0x07030602u);
                const unsigned b0 = __builtin_amdgcn_perm(r3, r2, 0x05010400u), b1 = __builtin_amdgcn_perm(r3, r2, 0x07030602u);
                const unsigned t0 = __builtin_amdgcn_perm(b0, a0, 0x05040100u), t1 = __builtin_amdgcn_perm(b0, a0, 0x07060302u);
                const unsigned t2 = __builtin_amdgcn_perm(b1, a1, 0x05040100u), t3 = __builtin_amdgcn_perm(b1, a1, 0x07060302u);
                acc[4 * q] = __builtin_amdgcn_sdot4((int)t0, (int)cq[g], acc[4 * q], false);
                acc[4 * q + 1] = __builtin_amdgcn_sdot4((int)t1, (int)cq[g], acc[4 * q + 1], false);
                acc[4 * q + 2] = __builtin_amdgcn_sdot4((int)t2, (int)cq[g], acc[4 * q + 2], false);
                acc[4 * q + 3] = __builtin_amdgcn_sdot4((int)t3, (int)cq[g], acc[4 * q + 3], false);
            }
        int a8[8], a4[4], a2[2];
        {
            const bool hi = (eg & 4) != 0;
#pragma unroll
            for (int j = 0; j < 8; ++j) {
                const int send = hi ? acc[j] : acc[j + 8];
                const int keep = hi ? acc[j + 8] : acc[j];
                a8[j] = keep + __shfl_xor(send, 32);
            }
        }
        {
            const bool hi = (eg & 2) != 0;
#pragma unroll
            for (int j = 0; j < 4; ++j) {
                const int send = hi ? a8[j] : a8[j + 4];
                const int keep = hi ? a8[j + 4] : a8[j];
                a4[j] = keep + __shfl_xor(send, 16);
            }
        }
        {
            const bool hi = (eg & 1) != 0;
#pragma unroll
            for (int j = 0; j < 2; ++j) {
                const int send = hi ? a4[j] : a4[j + 2];
                const int keep = hi ? a4[j + 2] : a4[j];
                a2[j] = keep + __shfl_xor(send, 8);
            }
        }
        const float cs = ((const float*)(p.ws + WS_ASUM))[t];
        const int col = s * 128 + cg * 16 + 2 * eg;
        const float2 st = ((const float2*)(p.ws + WS_ST2))[t];
        const float2 g2 = *(const float2*)(p.ln_g + 1024 + col), b2 = *(const float2*)(p.ln_b + 1024 + col);
        const unsigned xb = *(const unsigned*)((const bf16_t*)(p.ws + WS_YB) + t * 1024 + col);
        const float x0 = (bflo(xb) - st.x) * st.y * g2.x + b2.x, x1 = (bfhi(xb) - st.x) * st.y * g2.y + b2.y;
        if (dostore) *(unsigned*)((bf16_t*)(p.ws + WS_YB) + t * 1024 + col) = pk_bf16(ALPHA * x0 + cs * (float)a2[0], ALPHA * x1 + cs * (float)a2[1]);
    }
}

DEV void ln3_item(const P& p, int t, int lane) {
    float* row = p.out + (size_t)t * 1024;
    const bf16_t* yrow = (const bf16_t*)(p.ws + WS_YB) + (size_t)t * 1024;
    float4 v[4];
    float s = 0.f;
#pragma unroll
    for (int i = 0; i < 4; ++i) {
        const uint2 u = *(const uint2*)(yrow + (i * 64 + lane) * 4);
        v[i] = make_float4(bflo(u.x), bfhi(u.x), bflo(u.y), bfhi(u.y));
        s += v[i].x + v[i].y + v[i].z + v[i].w;
    }
    const float mean = wsum(s) * (1.f / 1024.f);
    float ss = 0.f;
#pragma unroll
    for (int i = 0; i < 4; ++i) {
        v[i].x -= mean; v[i].y -= mean; v[i].z -= mean; v[i].w -= mean;
        ss += v[i].x * v[i].x + v[i].y * v[i].y + v[i].z * v[i].z + v[i].w * v[i].w;
    }
    const float rs = rsqrtf(wsum(ss) * (1.f / 1024.f) + LN_EPS);
#pragma unroll
    for (int i = 0; i < 4; ++i) {
        const int c = (i * 64 + lane) * 4;
        const float4 gg = *(const float4*)(p.ln_g + 2 * 1024 + c);
        const float4 bb = *(const float4*)(p.ln_b + 2 * 1024 + c);
        float4 o;
        o.x = v[i].x * rs * gg.x + bb.x; o.y = v[i].y * rs * gg.y + bb.y; o.z = v[i].z * rs * gg.z + bb.z; o.w = v[i].w * rs * gg.w + bb.w;
        *(float4*)(row + c) = o;
    }
}

#define XB_TMO      128
#define XB_XCNT(j)  (256  + 64 * (j))
#define XB_XSUB(j)  (1280 + 64 * (j))
#define XB_XGEN(j)  (2304 + 64 * (j))
#define XB_TOP      3328
#define XB_TOPGEN   3392
#define XCD_BAR_WORDS 3456
#define XB_SPIN_CAP (1u << 20)
#define LAS __attribute__((address_space(3)))
DEV unsigned xb_ld(unsigned* p) { return __hip_atomic_load(p, __ATOMIC_RELAXED, __HIP_MEMORY_SCOPE_AGENT); }
DEV unsigned xb_add(unsigned* p, unsigned v) { return __hip_atomic_fetch_add(p, v, __ATOMIC_RELAXED, __HIP_MEMORY_SCOPE_AGENT); }
DEV unsigned xb_xcc_id() { return (unsigned)__builtin_amdgcn_s_getreg((3 << 11) | 20) & 0xFu; }
#define XB_SPIN(cond, bar) do { unsigned _sp = 0; while (cond) { __builtin_amdgcn_s_sleep(1); \
    if ((++_sp & 255u) == 0u) { if (xb_ld(&(bar)[XB_TMO])) break; if (_sp > XB_SPIN_CAP) { atomicAdd(&(bar)[XB_TMO], 1u); break; } } } } while (0)
struct XcdBarrier { unsigned* bar; unsigned x; volatile LAS unsigned* st; };
DEV XcdBarrier xcd_barrier_post(unsigned* bar, volatile LAS unsigned* st) {
    XcdBarrier b; b.bar = bar; b.x = xb_xcc_id(); b.st = st;
    if (threadIdx.x == 0) (void)xb_add(&bar[XB_XCNT(b.x)], 1u);
    return b;
}
DEV void xcd_barrier_complete(unsigned* bar, unsigned x, unsigned& nloc, unsigned& nx) {
    const unsigned G = gridDim.x * gridDim.y * gridDim.z;
    unsigned sum, cnt, mine, sp = 0u;
    for (;;) {
        sum = 0u; cnt = 0u; mine = 0u;
#pragma unroll
        for (unsigned j = 0; j < 16; ++j) { const unsigned c = xb_ld(&bar[XB_XCNT(j)]); sum += c; cnt += (c > 0u) ? 1u : 0u; mine = (j == x) ? c : mine; }
        if (sum == G) break;
        __builtin_amdgcn_s_sleep(1);
        if ((++sp & 255u) == 0u) { if (xb_ld(&bar[XB_TMO])) break; if (sp > XB_SPIN_CAP) { atomicAdd(&bar[XB_TMO], 1u); break; } }
    }
    nloc = mine > 0u ? mine : 1u; nx = cnt > 0u ? cnt : 1u;
}
DEV void xcd_barrier(const XcdBarrier& b) {
    asm volatile("s_waitcnt vmcnt(0)" ::: "memory");
    __syncthreads();
    if (threadIdx.x == 0) {
        unsigned* bar = b.bar;
        __builtin_amdgcn_s_waitcnt(0);
        unsigned nloc = b.st[0], nx = b.st[1];
        if (nloc == 0u) { xcd_barrier_complete(bar, b.x, nloc, nx); b.st[0] = nloc; b.st[1] = nx; }
        const unsigned old = xb_add(&bar[XB_XSUB(b.x)], 1u);
        const unsigned gen = old / nloc;
        if (old + 1u == (gen + 1u) * nloc) {
            __builtin_amdgcn_fence(__ATOMIC_RELEASE, "agent");
            asm volatile("s_waitcnt vmcnt(0)" ::: "memory");
            const unsigned og = xb_add(&bar[XB_TOP], 1u);
            const unsigned tg = og / nx;
            if (og + 1u == (tg + 1u) * nx) xb_add(&bar[XB_TOPGEN], 1u);
            else XB_SPIN(xb_ld(&bar[XB_TOPGEN]) == tg, bar);
            __builtin_amdgcn_fence(__ATOMIC_ACQUIRE, "agent");
            xb_add(&bar[XB_XGEN(b.x)], 1u);
            asm volatile("s_waitcnt vmcnt(0)" ::: "memory");
        } else {
            XB_SPIN(xb_ld(&bar[XB_XGEN(b.x)]) == gen, bar);
            __builtin_amdgcn_fence(__ATOMIC_ACQUIRE, "agent");
            asm volatile("s_waitcnt vmcnt(0)" ::: "memory");
        }
    }
    __syncthreads();
}


DEV void late_transpose_item(const P& p, int it, float* smem) {
    const int m = it >> 8, t = it & 255;
    const float* W = m == 0 ? p.w_out : (m == 1 ? p.xa_wq : (m == 2 ? p.xa_wo : p.peer_wq));
    const size_t off = m == 0 ? WS_WOUT_T : (m == 1 ? WS_WQ_T : (m == 2 ? WS_WO_T : WS_PWQ_T));
    const int mat2 = m >> 1;
    if (m & 1) transpose_tile(W, 1024, (bf16_t*)(p.ws + off), t >> 4, t & 15, smem, 1024, p.ln_g + mat2 * 1024, p.ln_b + mat2 * 1024,
                              (float*)(p.ws + WS_C12) + (size_t)(mat2 * 16 + (t >> 4)) * 2048);
    else transpose_tile(W, 1024, (bf16_t*)(p.ws + off), t >> 4, t & 15, smem);
}

constexpr int WQ_WORD0 = 4096;
DEV int wq_next(unsigned* cnt, int nper, int xcc, unsigned char* lds) {
    volatile unsigned* slot = (volatile unsigned*)(lds + LDS_BYTES - 16);
    __syncthreads();
    if (threadIdx.x == 0) {
        int res = -1;
        int off = (int)slot[1];
        while (off < 8) {
            const int q = (xcc + off) & 7;
            const unsigned idx = atomicAdd(&cnt[q * 64], 1u);
            if (idx < (unsigned)nper) { res = q * nper + (int)idx; break; }
            ++off;
        }
        slot[0] = (unsigned)res;
        slot[1] = (unsigned)off;
    }
    __syncthreads();
    return (int)slot[0];
}
DEV void wq_begin(unsigned char* lds) {
    __syncthreads();
    if (threadIdx.x == 0) ((volatile unsigned*)(lds + LDS_BYTES - 16))[1] = 0u;
}

constexpr int NSTAGES = 12;
template <int ST>
DEV void run_stage(const P& p, unsigned char* lds, int xcc) {
    float* smem = (float*)lds;
    const int nb = gridDim.x, bid = blockIdx.x;
    int tidl = threadIdx.x;
    asm volatile("" : "+v"(tidl));
    const int wave = tidl >> 6;
    unsigned* wqc = (unsigned*)(p.ws + WS_BAR) + WQ_WORD0;
    if (ST == 0) {
        for (int it = bid; it < PREP_END; it += nb) prep_item(p, it, smem);
    } else if (ST == 1) {
        for (int it = bid; it < 1536 + 384 + 128; it += nb) {
            if (it < 1536) gemm_item<0>(p, it & 7, it >> 3, lds);
            else if (it < 1920) { const int i2 = it - 1536, q = i2 & 7, j = i2 >> 3; gemm_mfma_tile<0>(p, q * 16 + (j & 15), 24 + (j >> 4), lds); }
            else gemm_item<1>(p, (it - 1920) & 7, (it - 1920) >> 3, lds);
        }
    } else if (ST == 2) {
        if (PROBE_REP == 21) for (int it = bid; it < 256; it += nb) compress_item2(p, it, lds);
        if (PROBE_REP == 22) for (int it = bid; it < 1024; it += nb) hgrn_prep_item(p, it, smem);
        for (int it = bid; it < 256 + 1024; it += nb) {
            if (it < 256) compress_item2(p, it, lds);
            else hgrn_prep_item2(p, it - 256, lds);
        }
    } else if (ST == 3) {
        if (PROBE_REP == 31) { for (int it = bid; it < 32; it += nb) hgrn_chain_item(p, it, lds); }
        if (PROBE_REP == 32) {
            volatile unsigned* qs2 = (volatile unsigned*)(lds + LDS_BYTES - 16);
            for (;;) {
                __syncthreads();
                if (threadIdx.x == 0) *qs2 = atomicAdd(wqc + 64, 1u);
                __syncthreads();
                const int j = (int)*qs2;
                if (j >= 1024) break;
                nsa_item2(p, (j & 15) >> 1, j & 1, 63 - (j >> 4), lds, p.out != nullptr ? 4 : 0);
            }
        }
        volatile unsigned* qslot = (volatile unsigned*)(lds + LDS_BYTES - 16);
        for (;;) {
            __syncthreads();
            if (threadIdx.x == 0) *qslot = atomicAdd(wqc, 1u);
            __syncthreads();
            const int it = (int)*qslot;
            if (it >= 32 + 1024) break;
            if (it < 32) hgrn_chain_item2(p, it, lds);
            else { const int j = it - 32; nsa_item2(p, (j & 15) >> 1, j & 1, 63 - (j >> 4), lds); }
        }
        for (;;) {
            __syncthreads();
            if (threadIdx.x == 0) *qslot = atomicAdd(wqc + 128, 1u);
            __syncthreads();
            const int it = (int)*qslot;
            if (it >= 2048) break;
            if (it < 1024) late_transpose_item(p, it, smem);
            else {
                const int j = it - 1024, tb = j >> 9, r0 = (j & 511) * 32 + wave * 8;
                for (int r = 0; r < 8; ++r) {
                    if (tb == 0) peer_quant_row(p.peer_down, p.ws + WS_PD, (float*)(p.ws + WS_PSD), r0 + r, (int*)(p.ws + WS_PRS));
                    else peer_quant_row(p.peer_up, p.ws + WS_PU, (float*)(p.ws + WS_PSU), r0 + r, nullptr, 0);
                }
            }
        }
    } else if (ST == 4) {
        for (int it = bid; it < 512; it += nb) gemm_item<2>(p, it & 7, it >> 3, lds);
    } else if (ST == 5) {
        for (int it = bid; it < T_ / 4; it += nb) ln_item(p, it * 4 + wave, 0, tidl & 63);
    } else if (ST == 9) {
        for (int it = bid; it < T_ / 4; it += nb) ln_item(p, it * 4 + wave, 1, tidl & 63);
    } else if (ST == 6) {
        for (int it = bid; it < 512; it += nb) gemm_item<3>(p, it & 7, it >> 3, lds);
    } else if (ST == 7) {
        for (int it = bid; it < 1024; it += nb) xattn_item3(p, it, lds);
    } else if (ST == 8) {
        for (int it = bid; it < 512; it += nb) gemm_item<4>(p, it & 7, it >> 3, lds);
    } else if (ST == 10) {
        for (int it = bid; it < 512; it += nb) gemm_item<5>(p, it & 7, it >> 3, lds);
    } else if (ST == 11) {
        if (PROBE_REP == 11) for (int it = bid; it < T_ / 16; it += nb) peer_route_item(p, it, lds);
        for (int it = bid; it < T_ / 16; it += nb) peer_route_item(p, it, lds);
    } else if (ST == 12) {
        if (PROBE_REP == 12) { wq_begin(lds); for (int it; (it = wq_next(wqc + 4 * 512, 1024, xcc, lds)) >= 0;) peer_down_item(p, it >> 10, it & 1023, tidl & 63, wave); }
        wq_begin(lds);
        for (int it; (it = wq_next(wqc + 2 * 512, 512, xcc, lds)) >= 0;) peer_down_item(p, it >> 9, it & 511, tidl & 63, wave);
    } else if (ST == 13) {
        if (PROBE_REP == 13) for (int it = bid; it < T_ / 4; it += nb) peer_coef_item(p, it * 4 + wave, tidl & 63);
        for (int it = bid; it < T_ / 4; it += nb) peer_coef_item(p, it * 4 + wave, tidl & 63);
    } else if (ST == 14) {
        if (PROBE_REP == 14) { wq_begin(lds); for (int it; (it = wq_next(wqc + 5 * 512, 1024, xcc, lds)) >= 0;) peer_up_item(p, it >> 10, it & 1023, tidl & 63, wave, p.out == nullptr); }
        wq_begin(lds);
        for (int it; (it = wq_next(wqc + 3 * 512, 512, xcc, lds)) >= 0;) peer_up_item(p, it >> 9, it & 511, tidl & 63, wave);
    } else if (ST == 15) {
        for (int it = bid; it < T_ / 4; it += nb) ln3_item(p, it * 4 + wave, tidl & 63);
    }
}

template <int ST>
__global__ void __launch_bounds__(256, 2) stage_kernel(P p) {
    __shared__ __attribute__((aligned(16))) unsigned char lds[LDS_BYTES + 16];
    run_stage<ST>(p, lds, (int)xb_xcc_id() & 7);
}

__global__ void __launch_bounds__(256, 2) mega_kernel(P p) {
    __shared__ __attribute__((aligned(16))) unsigned char lds[LDS_BYTES + 16];
    if (threadIdx.x == 0) *(uint4*)(lds + LDS_BYTES) = make_uint4(0u, 0u, 0u, 0u);
    __syncthreads();
    const XcdBarrier xb = xcd_barrier_post((unsigned*)(p.ws + WS_BAR), (volatile LAS unsigned*)(lds + LDS_BYTES));
    const int xcc = (int)xb.x & 7;
    run_stage<0>(p, lds, xcc); xcd_barrier(xb);
    if (PROBE_REP == 0) { run_stage<0>(p, lds, xcc); xcd_barrier(xb); }
    run_stage<1>(p, lds, xcc); xcd_barrier(xb);
    if (PROBE_REP == 1) { run_stage<1>(p, lds, xcc); xcd_barrier(xb); }
    run_stage<2>(p, lds, xcc); xcd_barrier(xb);
    if (PROBE_REP == 2) { run_stage<2>(p, lds, xcc); xcd_barrier(xb); }
    if (PROBE_REP == 35) { if (blockIdx.x < 32) hgrn_chain_item2(p, blockIdx.x, lds); xcd_barrier(xb); }
    run_stage<3>(p, lds, xcc); xcd_barrier(xb);
    run_stage<4>(p, lds, xcc); xcd_barrier(xb);
    if (PROBE_REP == 4) { run_stage<4>(p, lds, xcc); xcd_barrier(xb); }
    if (PROBE_REP == 50) { xcd_barrier(xb); xcd_barrier(xb); xcd_barrier(xb); xcd_barrier(xb); xcd_barrier(xb); xcd_barrier(xb); xcd_barrier(xb); xcd_barrier(xb); }
    run_stage<6>(p, lds, xcc); xcd_barrier(xb);
    if (PROBE_REP == 6) { run_stage<6>(p, lds, xcc); xcd_barrier(xb); }
    run_stage<7>(p, lds, xcc); xcd_barrier(xb);
    if (PROBE_REP == 7) { run_stage<7>(p, lds, xcc); xcd_barrier(xb); }
    run_stage<8>(p, lds, xcc); xcd_barrier(xb);
    run_stage<10>(p, lds, xcc); xcd_barrier(xb);
    if (PROBE_REP == 10) { run_stage<10>(p, lds, xcc); xcd_barrier(xb); }
    run_stage<11>(p, lds, xcc); xcd_barrier(xb);
    run_stage<12>(p, lds, xcc); xcd_barrier(xb);
    run_stage<13>(p, lds, xcc); xcd_barrier(xb);
    run_stage<14>(p, lds, xcc); xcd_barrier(xb);
    run_stage<15>(p, lds, xcc);
}

extern "C" void kernel_launch(void* const* d_in, const int* in_sizes, int n_in, void* d_out, int out_size, void* d_ws, size_t ws_size,
                              hipStream_t stream) {
    if (n_in != 18 || ws_size < WS_END) {
        fprintf(stderr, "kernel_launch: unexpected inputs (n_in %d, ws %zu, need %zu)\n", n_in, ws_size, (size_t)WS_END);
        return;
    }
    P p{};
    p.x = (const float*)d_in[0]; p.mem = (const float*)d_in[1]; p.w_in = (const float*)d_in[2]; p.cmp_pos = (const float*)d_in[3];
    p.cmp_w1 = (const float*)d_in[4]; p.cmp_w2 = (const float*)d_in[5]; p.lb_logits = (const float*)d_in[6];
    p.hg_norm_w = (const float*)d_in[7]; p.w_out = (const float*)d_in[8]; p.xa_wq = (const float*)d_in[9];
    p.xa_wkv = (const float*)d_in[10]; p.xa_wo = (const float*)d_in[11]; p.peer_wq = (const float*)d_in[12];
    p.peer_keys = (const float*)d_in[13]; p.peer_down = (const float*)d_in[14]; p.peer_up = (const float*)d_in[15];
    p.ln_g = (const float*)d_in[16]; p.ln_b = (const float*)d_in[17];
    p.out = (float*)d_out; p.ws = (unsigned char*)d_ws;
#if ONE_LAUNCH
    static int grid_blocks = 0;
    if (!grid_blocks) {
        int dev = 0, cus = 0, per_cu = 0;
        hipGetDevice(&dev);
        hipDeviceGetAttribute(&cus, hipDeviceAttributeMultiprocessorCount, dev);
        hipOccupancyMaxActiveBlocksPerMultiprocessor(&per_cu, mega_kernel, 256, 0);
        if (per_cu > 2) per_cu = 2;
        if (per_cu < 1) per_cu = 1;
        grid_blocks = cus * per_cu;
    }
    (void)hipMemsetAsync((unsigned char*)d_ws + WS_BAR, 0, 65536, stream);
    void* args[] = {&p};
    hipError_t e = hipLaunchCooperativeKernel((void*)mega_kernel, dim3(grid_blocks), dim3(256), args, 0, stream);
    if (e != hipSuccess) fprintf(stderr, "cooperative launch failed: %s (grid %d)\n", hipGetErrorString(e), grid_blocks);
#else
    const int G = 2048;
    stage_kernel<0><<<G, 256, 0, stream>>>(p);
    stage_kernel<1><<<G, 256, 0, stream>>>(p);
    stage_kernel<2><<<G, 256, 0, stream>>>(p);
    stage_kernel<3><<<G, 256, 0, stream>>>(p);
    stage_kernel<4><<<G, 256, 0, stream>>>(p);
    stage_kernel<5><<<G, 256, 0, stream>>>(p);
    stage_kernel<6><<<G, 256, 0, stream>>>(p);
    stage_kernel<7><<<G, 256, 0, stream>>>(p);
    stage_kernel<8><<<G, 256, 0, stream>>>(p);
    stage_kernel<9><<<G, 256, 0, stream>>>(p);
    stage_kernel<10><<<G, 256, 0, stream>>>(p);
    stage_kernel<11><<<G, 256, 0, stream>>>(p);
#endif
}
```

```cpp
#include <hip/hip_runtime.h>
#include <hip/hip_cooperative_groups.h>
#include <cstdio>
#include <cstdint>
namespace cg = cooperative_groups;

#ifndef PROBE_REP
#define PROBE_REP -1
#endif
#ifndef ONE_LAUNCH
#define ONE_LAUNCH 1
#endif

typedef unsigned short bf16_t;
#define DEV __device__ __forceinline__

constexpr int D_ = 1024, B_ = 8, S_ = 2048, T_ = B_ * S_, ML_ = 256, INC = 3352;
constexpr int NCMP = 127;
constexpr int LDS_BYTES = 67584;
constexpr float ALPHA = 1.189207115002721f;
constexpr float LN_EPS = 1e-5f;
constexpr int C_QA = 0, C_KC = 512, C_VC = 640, C_KS = 768, C_VS = 896, C_KW = 1024, C_VW = 1152, C_GATE = 1280,
              C_HQ = 1304, C_HF = 1816, C_HI = 2328, C_HG = 2840;
constexpr size_t WS_HB = 0;
constexpr size_t SZ_HB = (size_t)T_ * INC * 2;
constexpr size_t WS_OM = WS_HB + SZ_HB;
constexpr size_t WS_KVM = WS_OM + (size_t)T_ * 1024 * 2;
constexpr size_t WS_KC = WS_KVM + (size_t)2048 * 2048 * 2;
constexpr size_t WS_XB = WS_KC + (1u << 20);
constexpr size_t WS_WIN_T = WS_XB + (size_t)T_ * 1024 * 2;
constexpr size_t WS_WOUT_T = WS_WIN_T + (size_t)3456 * 1024 * 2;
constexpr size_t WS_WQ_T = WS_WOUT_T + (size_t)1024 * 1024 * 2;
constexpr size_t WS_WKV_T = WS_WQ_T + (size_t)1024 * 1024 * 2;
constexpr size_t WS_WO_T = WS_WKV_T + (size_t)2048 * 1024 * 2;
constexpr size_t WS_PWQ_T = WS_WO_T + (size_t)1024 * 1024 * 2;
constexpr size_t WS_MEMB = WS_PWQ_T + (size_t)1024 * 1024 * 2;
constexpr size_t WS_PKEY = WS_MEMB + (size_t)2048 * 1024 * 2;
constexpr size_t WS_VT = WS_PKEY + (size_t)16 * 128 * 64 * 2;
constexpr size_t WS_KCB = WS_VT + (size_t)2 * B_ * 2 * 64 * 2048 * 2;
constexpr size_t WS_VCT = WS_KCB + (size_t)B_ * 2 * 128 * 64 * 2;
constexpr size_t WS_W1T = WS_VCT + (size_t)B_ * 2 * 128 * 64 * 2;
constexpr size_t WS_W2T = WS_W1T + (size_t)2 * 128 * 2048 * 2;
constexpr size_t WS_CB = WS_W2T + (size_t)2 * 64 * 128 * 2;
constexpr size_t WS_VMT = WS_CB + 1024;
constexpr size_t WS_BAR = WS_VMT + (size_t)B_ * 4 * 256 * 256 * 2;
constexpr size_t WS_PD = WS_BAR + 65536;
constexpr size_t WS_PU = WS_PD + (size_t)16384 * 1024;
constexpr size_t WS_PSD = WS_PU + (size_t)16384 * 1024;
constexpr size_t WS_PSU = WS_PSD + 65536;
constexpr size_t WS_PRS = WS_PSU + 65536;
constexpr size_t WS_LNP1 = WS_PRS + 65536;
constexpr size_t WS_LNP2 = WS_LNP1 + (size_t)T_ * 16 * 8;
constexpr size_t WS_ST2 = WS_LNP2 + (size_t)T_ * 16 * 8;
constexpr size_t WS_C12 = WS_ST2 + (size_t)T_ * 8;
constexpr size_t WS_END = WS_C12 + 262144;
static_assert(WS_END <= (size_t)268435456, "workspace budget");
constexpr size_t WS_EB = WS_KC;
constexpr size_t HS_QT = 0;
constexpr size_t HS_KT = (size_t)B_ * 4 * 2048 * 128 * 2;
constexpr size_t HS_KHT = 2 * HS_KT;
constexpr size_t HS_VIT = 3 * HS_KT;
constexpr size_t HS_DS = HS_KT;
constexpr size_t HS_OI = 3 * HS_KT;
constexpr size_t WS_QX = 67108864;
constexpr size_t WS_OX = (size_t)T_ * 1024 * 2;
constexpr size_t WS_QP = 104857600;
constexpr size_t WS_YB = 0;
constexpr size_t WS_EIDP = (size_t)T_ * 1024 * 2;
constexpr size_t WS_GATEP = WS_EIDP + (size_t)T_ * 128 * 2;
constexpr size_t WS_COEFP = WS_GATEP + (size_t)T_ * 128 * 4;
constexpr size_t WS_XQ = WS_COEFP + (size_t)T_ * 128 * 4;
constexpr size_t WS_SXF = WS_XQ + (size_t)T_ * 1024;
constexpr size_t WS_SXI = WS_SXF + (size_t)T_ * 4;
constexpr size_t WS_ASUM = WS_SXI + (size_t)T_ * 4;
constexpr size_t WS_DP = WS_ASUM + (size_t)T_ * 4;
static_assert(WS_DP + (size_t)8 * T_ * 128 * 4 <= WS_KVM, "PEER intermediates must fit in the dead h/OM region");

struct P {
    const float *x, *mem, *w_in, *cmp_pos, *cmp_w1, *cmp_w2, *lb_logits, *hg_norm_w, *w_out, *xa_wq, *xa_wkv, *xa_wo,
        *peer_wq, *peer_keys, *peer_down, *peer_up, *ln_g, *ln_b;
    float* out;
    unsigned char* ws;
};

DEV unsigned short f2bf(float f) {
    unsigned u = __float_as_uint(f);
    u += 0x7fffu + ((u >> 16) & 1u);
    return (unsigned short)(u >> 16);
}
DEV float bf2f(unsigned short h) { return __uint_as_float(((unsigned)h) << 16); }
DEV float bflo(unsigned u) { return __uint_as_float(u << 16); }
DEV float bfhi(unsigned u) { return __uint_as_float(u & 0xffff0000u); }
typedef __bf16 bf16x2_t __attribute__((ext_vector_type(2)));
typedef float f32x2_t __attribute__((ext_vector_type(2)));
DEV unsigned pk_bf16(float a, float b) {
    f32x2_t v = {a, b};
    bf16x2_t r = __builtin_convertvector(v, bf16x2_t);
    return __builtin_bit_cast(unsigned, r);
}
DEV float wsum(float v) {
#pragma unroll
    for (int o = 32; o > 0; o >>= 1) v += __shfl_xor(v, o);
    return v;
}
DEV float wmax(float v) {
#pragma unroll
    for (int o = 32; o > 0; o >>= 1) v = fmaxf(v, __shfl_xor(v, o));
    return v;
}
DEV float sigmoidf_(float x) { return 1.f / (1.f + expf(-x)); }
DEV float fsigmoid(float x) { return __fdividef(1.f, 1.f + __expf(-x)); }

template <int MODE>
DEV void gemm_tile(const P& p, int tile, float* smem) {
    constexpr bool ABF = (MODE == 2 || MODE == 4);
    constexpr int K = 1024;
    constexpr int N = MODE == 0 ? INC : (MODE == 1 ? 2048 : 1024);
    constexpr int NTN = (N + 63) / 64;
    const int tm = tile / NTN, tn = tile % NTN;
    const float* Af = nullptr;
    const bf16_t* Ab = nullptr;
    const float* Bm = nullptr;
    if (MODE == 0) { Af = p.x; Bm = p.w_in; }
    if (MODE == 1) { Af = p.mem; Bm = p.xa_wkv; }
    if (MODE == 2) { Ab = (const bf16_t*)(p.ws + WS_OM); Bm = p.w_out; }
    if (MODE == 3) { Af = p.out; Bm = p.xa_wq; }
    if (MODE == 4) { Ab = (const bf16_t*)(p.ws + WS_OX); Bm = p.xa_wo; }
    if (MODE == 5) { Af = p.out; Bm = p.peer_wq; }
    float(*sA)[68] = (float(*)[68])smem;
    float(*sB)[68] = (float(*)[68])(smem + 16 * 68);
    const int tid = threadIdx.x, tx = tid & 15, ty = tid >> 4;
    const int ar = tid >> 2, ak = (tid & 3) * 4;
    const int bk = tid >> 4, bn = (tid & 15) * 4;
    float acc[4][4];
#pragma unroll
    for (int i = 0; i < 4; ++i)
#pragma unroll
        for (int j = 0; j < 4; ++j) acc[i][j] = 0.f;
    const int gn = tn * 64 + bn;
    for (int k0 = 0; k0 < K; k0 += 16) {
        float4 av;
        if (ABF) {
            uint2 u = *(const uint2*)(Ab + (size_t)(tm * 64 + ar) * K + k0 + ak);
            av.x = bflo(u.x); av.y = bfhi(u.x); av.z = bflo(u.y); av.w = bfhi(u.y);
        } else {
            av = *(const float4*)(Af + (size_t)(tm * 64 + ar) * K + k0 + ak);
        }
        float4 bv = make_float4(0.f, 0.f, 0.f, 0.f);
        if (gn < N) bv = *(const float4*)(Bm + (size_t)(k0 + bk) * N + gn);
        sA[ak + 0][ar] = av.x; sA[ak + 1][ar] = av.y; sA[ak + 2][ar] = av.z; sA[ak + 3][ar] = av.w;
        *(float4*)&sB[bk][bn] = bv;
        __syncthreads();
#pragma unroll
        for (int kk = 0; kk < 16; ++kk) {
            float4 a = *(const float4*)&sA[kk][ty * 4];
            float4 b = *(const float4*)&sB[kk][tx * 4];
            float aa[4] = {a.x, a.y, a.z, a.w}, bb[4] = {b.x, b.y, b.z, b.w};
#pragma unroll
            for (int i = 0; i < 4; ++i)
#pragma unroll
                for (int j = 0; j < 4; ++j) acc[i][j] += aa[i] * bb[j];
        }
        __syncthreads();
    }
    const int col = tn * 64 + tx * 4;
#pragma unroll
    for (int i = 0; i < 4; ++i) {
        const size_t row = (size_t)tm * 64 + ty * 4 + i;
        if (MODE == 0 || MODE == 1 || MODE == 3) {
            bf16_t* O = (bf16_t*)(p.ws + (MODE == 0 ? WS_HB : (MODE == 1 ? WS_KVM : WS_QX)));
            if (col < N) {
                uint2 u;
                u.x = (unsigned)f2bf(acc[i][0]) | ((unsigned)f2bf(acc[i][1]) << 16);
                u.y = (unsigned)f2bf(acc[i][2]) | ((unsigned)f2bf(acc[i][3]) << 16);
                *(uint2*)(O + row * N + col) = u;
            }
        } else if (MODE == 2) {
            float4 xv = *(const float4*)(p.x + row * 1024 + col);
            float4 o = make_float4(ALPHA * xv.x + acc[i][0], ALPHA * xv.y + acc[i][1], ALPHA * xv.z + acc[i][2], ALPHA * xv.w + acc[i][3]);
            *(float4*)(p.out + row * 1024 + col) = o;
        } else if (MODE == 4) {
            float4 xv = *(const float4*)(p.out + row * 1024 + col);
            float4 o = make_float4(ALPHA * xv.x + acc[i][0], ALPHA * xv.y + acc[i][1], ALPHA * xv.z + acc[i][2], ALPHA * xv.w + acc[i][3]);
            *(float4*)(p.out + row * 1024 + col) = o;
        } else {
            float* O = (float*)(p.ws + WS_QP);
            *(float4*)(O + row * 1024 + col) = make_float4(acc[i][0], acc[i][1], acc[i][2], acc[i][3]);
        }
    }
}


using bf16x8 = __attribute__((ext_vector_type(8))) short;
using f32x4 = __attribute__((ext_vector_type(4))) float;
using u32x4 = __attribute__((ext_vector_type(4))) unsigned;

template <int MODE>
DEV void gemm_mfma_tile(const P& p, int tm, int tn, unsigned char* lds) {
    const bf16_t* A;
    const bf16_t* W;
    if (MODE == 0) { A = (const bf16_t*)(p.ws + WS_XB); W = (const bf16_t*)(p.ws + WS_WIN_T); }
    if (MODE == 1) { A = (const bf16_t*)(p.ws + WS_MEMB); W = (const bf16_t*)(p.ws + WS_WKV_T); }
    if (MODE == 2) { A = (const bf16_t*)(p.ws + WS_OM); W = (const bf16_t*)(p.ws + WS_WOUT_T); }
    if (MODE == 3) { A = (const bf16_t*)(p.ws + WS_XB); W = (const bf16_t*)(p.ws + WS_WQ_T); }
    if (MODE == 4) { A = (const bf16_t*)(p.ws + WS_OX); W = (const bf16_t*)(p.ws + WS_WO_T); }
    if (MODE == 5) { A = (const bf16_t*)(p.ws + WS_XB); W = (const bf16_t*)(p.ws + WS_PWQ_T); }
    const int tid = threadIdx.x, lane = tid & 63, wid = tid >> 6, wm = wid >> 1, wn = wid & 1;
    const int m0 = tm * 128, n0 = tn * 128;
    const bf16_t* ga[2];
    const bf16_t* gw[2];
#pragma unroll
    for (int i = 0; i < 2; ++i) {
        const int r = (wid * 2 + i) * 16 + (lane >> 2);
        const int gsw = (0x1320 >> (((r >> 2) & 3) * 4)) & 3;
        const int c = (lane & 3) ^ gsw;
        ga[i] = A + (size_t)(m0 + r) * 1024 + c * 8;
        gw[i] = W + (size_t)(n0 + r) * 1024 + c * 8;
    }
    unsigned char* lbase = lds + wid * 2048;
#define GEMM_STAGE(slot, kt)                                                                                                   \
    do {                                                                                                                       \
        _Pragma("unroll") for (int i = 0; i < 2; ++i) {                                                                        \
            __builtin_amdgcn_global_load_lds((const unsigned*)(ga[i] + (kt) * 32), (unsigned*)(lbase + (slot) * 16384 + i * 1024), 16, 0, 0);         \
            __builtin_amdgcn_global_load_lds((const unsigned*)(gw[i] + (kt) * 32), (unsigned*)(lbase + (slot) * 16384 + 8192 + i * 1024), 16, 0, 0);  \
        }                                                                                                                      \
    } while (0)
    asm volatile("s_waitcnt vmcnt(0)" ::: "memory");
    GEMM_STAGE(0, 0);
    GEMM_STAGE(1, 1);
    GEMM_STAGE(2, 2);
    f32x4 acc[4][4];
#pragma unroll
    for (int i = 0; i < 4; ++i)
#pragma unroll
        for (int j = 0; j < 4; ++j) acc[i][j] = (f32x4){0.f, 0.f, 0.f, 0.f};
    const int fr = lane & 15, fq = lane >> 4;
    const int fsw = (0x1320 >> (((fr >> 2) & 3) * 4)) & 3;
    const int aoff = (wm * 64 + fr) * 64 + ((fq ^ fsw) << 4);
    const int boff = 8192 + (wn * 64 + fr) * 64 + ((fq ^ fsw) << 4);
#define GEMM_COMPUTE(slot)                                                                                                     \
    do {                                                                                                                       \
        const unsigned char* sb = lds + (slot) * 16384;                                                                        \
        bf16x8 af[4], wf[4];                                                                                                   \
        _Pragma("unroll") for (int t = 0; t < 4; ++t) {                                                                        \
            af[t] = *(const bf16x8*)(sb + aoff + t * 1024);                                                                    \
            wf[t] = *(const bf16x8*)(sb + boff + t * 1024);                                                                    \
        }                                                                                                                      \
        _Pragma("unroll") for (int nt = 0; nt < 4; ++nt)                                                                       \
            _Pragma("unroll") for (int mt = 0; mt < 4; ++mt)                                                                   \
                acc[nt][mt] = __builtin_amdgcn_mfma_f32_16x16x32_bf16(wf[nt], af[mt], acc[nt][mt], 0, 0, 0);                   \
    } while (0)
#pragma unroll 1
    for (int kt = 0; kt < 29; ++kt) {
        asm volatile("s_waitcnt vmcnt(8)\n\ts_waitcnt lgkmcnt(0)" ::: "memory");
        __builtin_amdgcn_s_barrier(); asm volatile("" ::: "memory");
        GEMM_STAGE((kt + 3) & 3, kt + 3);
        GEMM_COMPUTE(kt & 3);
    }
    asm volatile("s_waitcnt vmcnt(8)\n\ts_waitcnt lgkmcnt(0)" ::: "memory");
    __builtin_amdgcn_s_barrier(); asm volatile("" ::: "memory");
    GEMM_COMPUTE(29 & 3);
    asm volatile("s_waitcnt vmcnt(4)\n\ts_waitcnt lgkmcnt(0)" ::: "memory");
    __builtin_amdgcn_s_barrier(); asm volatile("" ::: "memory");
    GEMM_COMPUTE(30 & 3);
    asm volatile("s_waitcnt vmcnt(0)\n\ts_waitcnt lgkmcnt(0)" ::: "memory");
    __builtin_amdgcn_s_barrier(); asm volatile("" ::: "memory");
    GEMM_COMPUTE(31 & 3);
    asm volatile("s_waitcnt lgkmcnt(0)" ::: "memory");
    __builtin_amdgcn_s_barrier(); asm volatile("" ::: "memory");
#undef GEMM_STAGE
#undef GEMM_COMPUTE
#pragma unroll
    for (int mt = 0; mt < 4; ++mt) {
        const size_t m = (size_t)m0 + wm * 64 + mt * 16 + fr;
#pragma unroll
        for (int nt = 0; nt < 4; ++nt) {
            const int n = n0 + wn * 64 + nt * 16 + fq * 4;
            const f32x4 c = acc[nt][mt];
            if (MODE == 0 || MODE == 1 || MODE == 3 || MODE == 5) {
                constexpr int NS = MODE == 0 ? INC : (MODE == 1 ? 2048 : 1024);
                bf16_t* O = (bf16_t*)(p.ws + (MODE == 0 ? WS_HB : (MODE == 1 ? WS_KVM : (MODE == 3 ? WS_QX : WS_QP))));
                if (MODE == 1 && tn >= 8) {
                    bf16_t* VMT = (bf16_t*)(p.ws + WS_VMT);
                    const int nn = n - 1024;
                    const size_t base = (((size_t)(m >> 8) * 4 + (nn >> 8)) * 256 + (nn & 255)) * 256 + (m & 255);
#pragma unroll
                    for (int i = 0; i < 4; ++i) VMT[base + (size_t)i * 256] = f2bf(c[i]);
                } else if (MODE == 0 && (tn == 7 || tn == 9)) {
                    bf16_t* VT = (bf16_t*)(p.ws + WS_VT);
                    const int which = tn == 9 ? 1 : 0;
                    const size_t base = ((((size_t)which * B_ + (m >> 11)) * 2 + wn) * 64 + nt * 16 + fq * 4) * 2048 + (m & 2047);
#pragma unroll
                    for (int i = 0; i < 4; ++i) VT[base + (size_t)i * 2048] = f2bf(c[i]);
                } else if (MODE != 0 || n < INC) {
                    uint2 u;
                    u.x = pk_bf16(c[0], c[1]);
                    u.y = pk_bf16(c[2], c[3]);
                    *(uint2*)(O + m * NS + n) = u;
                }
            } else if (MODE == 2) {
                const float4 xv = *(const float4*)(p.x + m * 1024 + n);
                *(uint2*)((bf16_t*)(p.ws + WS_YB) + m * 1024 + n) = make_uint2(pk_bf16(ALPHA * xv.x + c[0], ALPHA * xv.y + c[1]), pk_bf16(ALPHA * xv.z + c[2], ALPHA * xv.w + c[3]));
            } else if (MODE == 4) {
                const uint2 xb = *(const uint2*)((const bf16_t*)(p.ws + WS_XB) + m * 1024 + n);
                *(uint2*)((bf16_t*)(p.ws + WS_YB) + m * 1024 + n) = make_uint2(pk_bf16(ALPHA * bflo(xb.x) + c[0], ALPHA * bfhi(xb.x) + c[1]), pk_bf16(ALPHA * bflo(xb.y) + c[2], ALPHA * bfhi(xb.y) + c[3]));
            }
        }
    }
}


template <int MODE>
DEV void gemm_mfma_tile256(const P& p, int tm, int tn, unsigned char* lds) {
    const bf16_t* A;
    const bf16_t* W;
    if (MODE == 0) { A = (const bf16_t*)(p.ws + WS_XB); W = (const bf16_t*)(p.ws + WS_WIN_T); }
    if (MODE == 1) { A = (const bf16_t*)(p.ws + WS_MEMB); W = (const bf16_t*)(p.ws + WS_WKV_T); }
    if (MODE == 2) { A = (const bf16_t*)(p.ws + WS_OM); W = (const bf16_t*)(p.ws + WS_WOUT_T); }
    if (MODE == 3) { A = (const bf16_t*)(p.ws + WS_YB); W = (const bf16_t*)(p.ws + WS_WQ_T); }
    if (MODE == 4) { A = (const bf16_t*)(p.ws + WS_OX); W = (const bf16_t*)(p.ws + WS_WO_T); }
    if (MODE == 5) { A = (const bf16_t*)(p.ws + WS_YB); W = (const bf16_t*)(p.ws + WS_PWQ_T); }
    int tid = threadIdx.x;
    asm volatile("" : "+v"(tid));
    const int lane = tid & 63, wid = tid >> 6, wm = wid >> 1, wn = wid & 1;
    const int m0 = tm * 256, n0 = tn * 128;
    float2* STL = (float2*)(lds + 49152);
    const bf16_t* ga[4];
    const bf16_t* gw[2];
#pragma unroll
    for (int i = 0; i < 4; ++i) {
        const int r = (wid * 4 + i) * 16 + (lane >> 2);
        const int gsw = (0x1320 >> (((r >> 2) & 3) * 4)) & 3;
        ga[i] = A + (size_t)(m0 + r) * 1024 + ((lane & 3) ^ gsw) * 8;
    }
#pragma unroll
    for (int i = 0; i < 2; ++i) {
        const int r = (wid * 2 + i) * 16 + (lane >> 2);
        const int gsw = (0x1320 >> (((r >> 2) & 3) * 4)) & 3;
        gw[i] = W + (size_t)(n0 + r) * 1024 + ((lane & 3) ^ gsw) * 8;
    }
    unsigned char* lbA = lds + wid * 4096;
    unsigned char* lbW = lds + 16384 + wid * 2048;
#define GEMM_STAGE(slot, kt)                                                                                                   \
    do {                                                                                                                       \
        _Pragma("unroll") for (int i = 0; i < 4; ++i)                                                                          \
            __builtin_amdgcn_global_load_lds((const unsigned*)(ga[i] + (kt) * 32), (unsigned*)(lbA + (slot) * 24576 + i * 1024), 16, 0, 0);  \
        _Pragma("unroll") for (int i = 0; i < 2; ++i)                                                                          \
            __builtin_amdgcn_global_load_lds((const unsigned*)(gw[i] + (kt) * 32), (unsigned*)(lbW + (slot) * 24576 + i * 1024), 16, 0, 0);  \
    } while (0)
    float st_mean = 0.f, st_rs = 0.f, c12v = 0.f;
    if (MODE == 3 || MODE == 4 || MODE == 5) {
        float4 sv[8];
        float cv[16];
        if (MODE != 4) {
            const float* pc = (const float*)(p.ws + WS_C12) + (size_t)((MODE == 5 ? 16 : 0) * 2 + (tid >> 7)) * 1024 + n0 + (tid & 127);
#pragma unroll
            for (int i = 0; i < 16; ++i) cv[i] = pc[i * 2048];
        }
        const float4* pp = (const float4*)(p.ws + (MODE == 5 ? WS_LNP2 : WS_LNP1)) + (size_t)(m0 + tid) * 8;
#pragma unroll
        for (int i = 0; i < 8; ++i) sv[i] = pp[i];
        GEMM_STAGE(0, 0);
        if (MODE != 4) {
#pragma unroll
            for (int i = 0; i < 16; ++i) c12v += cv[i];
        }
        float s1 = 0.f, s2 = 0.f;
#pragma unroll
        for (int i = 0; i < 8; ++i) { s1 += sv[i].x + sv[i].z; s2 += sv[i].y + sv[i].w; }
        st_mean = s1 * (1.f / 1024.f);
        st_rs = rsqrtf(fmaxf(s2 * (1.f / 1024.f) - st_mean * st_mean, 0.f) + LN_EPS);
    } else {
        GEMM_STAGE(0, 0);
    }
    f32x4 acc[4][8];
#pragma unroll
    for (int i = 0; i < 4; ++i)
#pragma unroll
        for (int j = 0; j < 8; ++j) acc[i][j] = (f32x4){0.f, 0.f, 0.f, 0.f};
    const int fr = lane & 15, fq = lane >> 4;
    const int fsw = (0x1320 >> (((fr >> 2) & 3) * 4)) & 3;
    const int aoff = (wm * 128 + fr) * 64 + ((fq ^ fsw) << 4);
    const int boff = 16384 + (wn * 64 + fr) * 64 + ((fq ^ fsw) << 4);
#define GEMM_COMPUTE(kt)                                                                                                       \
    do {                                                                                                                       \
        const unsigned char* sb = lds + ((kt) & 1) * 24576;                                                                    \
        bf16x8 af[8], wf[4];                                                                                                   \
        _Pragma("unroll") for (int t = 0; t < 8; ++t) af[t] = *(const bf16x8*)(sb + aoff + t * 1024);                          \
        _Pragma("unroll") for (int t = 0; t < 4; ++t) wf[t] = *(const bf16x8*)(sb + boff + t * 1024);                          \
        _Pragma("unroll") for (int nt = 0; nt < 4; ++nt)                                                                       \
            _Pragma("unroll") for (int mt = 0; mt < 8; ++mt) acc[nt][mt] = __builtin_amdgcn_mfma_f32_16x16x32_bf16(wf[nt], af[mt], acc[nt][mt], 0, 0, 0); \
    } while (0)
    {
        asm volatile("s_waitcnt vmcnt(0)\n\ts_waitcnt lgkmcnt(0)" ::: "memory");
        __builtin_amdgcn_s_barrier(); asm volatile("" ::: "memory");
        GEMM_STAGE(1, 1);
        if (MODE == 3 || MODE == 4 || MODE == 5) {
            STL[tid] = make_float2(st_mean, st_rs);
            if (MODE == 5 && tn == 0) ((float2*)(p.ws + WS_ST2))[m0 + tid] = make_float2(st_mean, st_rs);
            if (MODE != 4) ((float*)(lds + 49152 + 2048))[tid] = c12v;
        }
        GEMM_COMPUTE(0);
    }
#pragma unroll 1
    for (int kt = 1; kt < 32; ++kt) {
        asm volatile("s_waitcnt vmcnt(0)\n\ts_waitcnt lgkmcnt(0)" ::: "memory");
        __builtin_amdgcn_s_barrier(); asm volatile("" ::: "memory");
        if (kt + 1 < 32) { if (kt & 1) GEMM_STAGE(0, kt + 1); else GEMM_STAGE(1, kt + 1); }
        GEMM_COMPUTE(kt);
    }
#undef GEMM_COMPUTE
    asm volatile("s_waitcnt lgkmcnt(0)" ::: "memory");
    __builtin_amdgcn_s_barrier(); asm volatile("" ::: "memory");
#undef GEMM_STAGE
    if (MODE == 3 || MODE == 5) {
        bf16_t* O = (bf16_t*)(p.ws + (MODE == 3 ? WS_QX : WS_QP));
        const float* C12L = (const float*)(lds + 49152 + 2048);
#pragma unroll
        for (int nt = 0; nt < 4; ++nt) {
            const int n = n0 + wn * 64 + nt * 16 + fq * 4;
            const float4 c1 = *(const float4*)(C12L + (n - n0)), c2 = *(const float4*)(C12L + 128 + (n - n0));
#pragma unroll
            for (int mt = 0; mt < 8; ++mt) {
                const int ml = wm * 128 + mt * 16 + fr;
                const float2 st = STL[ml];
                const f32x4 c = acc[nt][mt];
                uint2 u;
                u.x = pk_bf16(st.y * (c[0] - st.x * c1.x) + c2.x, st.y * (c[1] - st.x * c1.y) + c2.y);
                u.y = pk_bf16(st.y * (c[2] - st.x * c1.z) + c2.z, st.y * (c[3] - st.x * c1.w) + c2.w);
                *(uint2*)(O + (size_t)(m0 + ml) * 1024 + n) = u;
            }
        }
    } else if (MODE == 4) {
        bf16_t* YB = (bf16_t*)(p.ws + WS_YB);
        float4 g4[4], b4[4];
#pragma unroll
        for (int nt = 0; nt < 4; ++nt) {
            const int n = n0 + wn * 64 + nt * 16 + fq * 4;
            g4[nt] = *(const float4*)(p.ln_g + n);
            b4[nt] = *(const float4*)(p.ln_b + n);
        }
#pragma unroll
        for (int mt = 0; mt < 8; ++mt) {
            const int ml = wm * 128 + mt * 16 + fr;
            const float2 st = STL[ml];
            bf16_t* yrow = YB + (size_t)(m0 + ml) * 1024 + n0 + wn * 64 + fq * 4;
            float s1 = 0.f, s2 = 0.f;
#pragma unroll
            for (int nt = 0; nt < 4; ++nt) {
                const f32x4 c = acc[nt][mt];
                const uint2 yb = *(const uint2*)(yrow + nt * 16);
                const float y0 = ALPHA * ((bflo(yb.x) - st.x) * st.y * g4[nt].x + b4[nt].x) + c[0];
                const float y1 = ALPHA * ((bfhi(yb.x) - st.x) * st.y * g4[nt].y + b4[nt].y) + c[1];
                const float y2 = ALPHA * ((bflo(yb.y) - st.x) * st.y * g4[nt].z + b4[nt].z) + c[2];
                const float y3 = ALPHA * ((bfhi(yb.y) - st.x) * st.y * g4[nt].w + b4[nt].w) + c[3];
                s1 += (y0 + y1) + (y2 + y3);
                s2 += (y0 * y0 + y1 * y1) + (y2 * y2 + y3 * y3);
                *(uint2*)(yrow + nt * 16) = make_uint2(pk_bf16(y0, y1), pk_bf16(y2, y3));
            }
            s1 += __shfl_xor(s1, 16); s2 += __shfl_xor(s2, 16);
            s1 += __shfl_xor(s1, 32); s2 += __shfl_xor(s2, 32);
            if (fq == 0) ((float2*)(p.ws + WS_LNP2))[(size_t)(m0 + ml) * 16 + tn * 2 + wn] = make_float2(s1, s2);
            asm volatile("" ::: "memory");
        }
    } else {
#pragma unroll
    for (int mt = 0; mt < 8; ++mt) {
        const size_t m = (size_t)m0 + wm * 128 + mt * 16 + fr;
        float s1 = 0.f, s2 = 0.f;
#pragma unroll
        for (int nt = 0; nt < 4; ++nt) {
            const int n = n0 + wn * 64 + nt * 16 + fq * 4;
            const f32x4 c = acc[nt][mt];
            if (MODE == 0 || MODE == 1) {
                constexpr int NS = MODE == 0 ? INC : 2048;
                bf16_t* O = (bf16_t*)(p.ws + (MODE == 0 ? WS_HB : WS_KVM));
                if (MODE == 1 && tn >= 8) {
                    bf16_t* VMT = (bf16_t*)(p.ws + WS_VMT);
                    const int nn = n - 1024;
                    const size_t base = (((size_t)(m >> 8) * 4 + (nn >> 8)) * 256 + (nn & 255)) * 256 + (m & 255);
#pragma unroll
                    for (int i = 0; i < 4; ++i) VMT[base + (size_t)i * 256] = f2bf(c[i]);
                } else if (MODE == 0 && (tn == 7 || tn == 9)) {
                    bf16_t* VT = (bf16_t*)(p.ws + WS_VT);
                    const int which = tn == 9 ? 1 : 0;
                    const size_t base = ((((size_t)which * B_ + (m >> 11)) * 2 + wn) * 64 + nt * 16 + fq * 4) * 2048 + (m & 2047);
#pragma unroll
                    for (int i = 0; i < 4; ++i) VT[base + (size_t)i * 2048] = f2bf(c[i]);
                } else if (MODE != 0 || n < INC) {
                    uint2 u;
                    u.x = pk_bf16(c[0], c[1]);
                    u.y = pk_bf16(c[2], c[3]);
                    *(uint2*)(O + m * NS + n) = u;
                }
            } else if (MODE == 2) {
                const float4 xv = *(const float4*)(p.x + m * 1024 + n);
                const float y0 = ALPHA * xv.x + c[0], y1 = ALPHA * xv.y + c[1], y2 = ALPHA * xv.z + c[2], y3 = ALPHA * xv.w + c[3];
                s1 += (y0 + y1) + (y2 + y3);
                s2 += (y0 * y0 + y1 * y1) + (y2 * y2 + y3 * y3);
                *(uint2*)((bf16_t*)(p.ws + WS_YB) + m * 1024 + n) = make_uint2(pk_bf16(y0, y1), pk_bf16(y2, y3));
            }
        }
        if (MODE == 2) {
            s1 += __shfl_xor(s1, 16); s2 += __shfl_xor(s2, 16);
            s1 += __shfl_xor(s1, 32); s2 += __shfl_xor(s2, 32);
            if (fq == 0) ((float2*)(p.ws + WS_LNP1))[m * 16 + tn * 2 + wn] = make_float2(s1, s2);
        }
    }
    }
}


template <int MODE>
DEV void gemm_item(const P& p, int q, int j, unsigned char* lds) {
    int tm, tn;
    if (MODE == 0) {
        tm = q * 8 + (j & 7);
        tn = j >> 3;
    } else if (MODE == 1) {
        tm = q; tn = j;
    } else {
        tm = q * 8 + (j & 7);
        tn = j >> 3;
    }
    gemm_mfma_tile256<MODE>(p, tm, tn, lds);
}

DEV void transpose_tile(const float* W, int N, bf16_t* Wt, int tk, int tn, float* s, int ldk = 1024, const float* gk = nullptr,
                        const float* bk = nullptr, float* part = nullptr) {
    const int tid = threadIdx.x;
    const int k0 = tk * 64, n0 = tn * 64;
    float* s2 = s + 64 * 65;
#pragma unroll
    for (int i = 0; i < 4; ++i) {
        const int k = (tid >> 4) + 16 * i, n = (tid & 15) * 4;
        float4 v = make_float4(0.f, 0.f, 0.f, 0.f);
        if (n0 + n < N) v = *(const float4*)(W + (size_t)(k0 + k) * N + n0 + n);
        if (gk) {
            const float g = gk[k0 + k], bb = bk[k0 + k];
            s2[k * 65 + n + 0] = bb * v.x; s2[k * 65 + n + 1] = bb * v.y; s2[k * 65 + n + 2] = bb * v.z; s2[k * 65 + n + 3] = bb * v.w;
            v.x *= g; v.y *= g; v.z *= g; v.w *= g;
        }
        s[k * 65 + n + 0] = v.x; s[k * 65 + n + 1] = v.y; s[k * 65 + n + 2] = v.z; s[k * 65 + n + 3] = v.w;
    }
    __syncthreads();
    {
        const int n = tid >> 2, kc = (tid & 3) * 16;
        unsigned u[8];
#pragma unroll
        for (int j = 0; j < 8; ++j)
            u[j] = (unsigned)f2bf(s[(kc + 2 * j) * 65 + n]) | ((unsigned)f2bf(s[(kc + 2 * j + 1) * 65 + n]) << 16);
        bf16_t* dst = Wt + (size_t)(n0 + n) * ldk + k0 + kc;
        *(uint4*)dst = make_uint4(u[0], u[1], u[2], u[3]);
        *(uint4*)(dst + 8) = make_uint4(u[4], u[5], u[6], u[7]);
    }
    if (part && tid < 128) {
        const int which = tid >> 6, n = tid & 63;
        float t = 0.f;
#pragma unroll 8
        for (int k = 0; k < 64; ++k) t += which ? s2[k * 65 + n] : bf2f(f2bf(s[k * 65 + n]));
        part[which * 1024 + n0 + n] = t;
    }
    __syncthreads();
}
DEV void convert_chunk(const float* src, bf16_t* dst, int item) {
    float4 a[4], b[4];
#pragma unroll
    for (int j = 0; j < 4; ++j) {
        const size_t e = (((size_t)item * 4 + j) * 256 + threadIdx.x) * 8;
        a[j] = *(const float4*)(src + e);
        b[j] = *(const float4*)(src + e + 4);
    }
#pragma unroll
    for (int j = 0; j < 4; ++j) {
        const size_t e = (((size_t)item * 4 + j) * 256 + threadIdx.x) * 8;
        uint4 u;
        u.x = pk_bf16(a[j].x, a[j].y);
        u.y = pk_bf16(a[j].z, a[j].w);
        u.z = pk_bf16(b[j].x, b[j].y);
        u.w = pk_bf16(b[j].z, b[j].w);
        *(uint4*)(dst + e) = u;
    }
}
constexpr int PREP_T0 = 16 * 54, PREP_T3 = PREP_T0 + 512, PREP_T5 = PREP_T3, PREP_X = PREP_T5 + T_ * 1024 / 8192, PREP_M = PREP_X + 2048 * 1024 / 8192, PREP_K = PREP_M + 16 * 128 * 64 / 8192, PREP_W1 = PREP_K + 128, PREP_W2 = PREP_W1 + 4,
              PREP_END = PREP_W2;
DEV void prep_item(const P& p, int it, float* smem) {
    if (it < PREP_T0) transpose_tile(p.w_in, INC, (bf16_t*)(p.ws + WS_WIN_T), it / 54, it % 54, smem);
    else if (it < PREP_T3) { it -= PREP_T0; transpose_tile(p.xa_wkv, 2048, (bf16_t*)(p.ws + WS_WKV_T), it >> 5, it & 31, smem); }
    else if (it < PREP_X) convert_chunk(p.x, (bf16_t*)(p.ws + WS_XB), it - PREP_T5);
    else if (it < PREP_M) convert_chunk(p.mem, (bf16_t*)(p.ws + WS_MEMB), it - PREP_X);
    else if (it < PREP_K) convert_chunk(p.peer_keys, (bf16_t*)(p.ws + WS_PKEY), it - PREP_M);
    else if (it < PREP_W1) {
        it -= PREP_K;
        const int kind = it >> 6, r = it & 63;
        transpose_tile(p.cmp_w1 + (size_t)kind * 2048 * 128, 128, (bf16_t*)(p.ws + WS_W1T) + (size_t)kind * 128 * 2048, r >> 1, r & 1, smem, 2048);
    } else if (it < PREP_W2) {
        it -= PREP_W1;
        const int kind = it >> 1;
        transpose_tile(p.cmp_w2 + (size_t)kind * 128 * 64, 64, (bf16_t*)(p.ws + WS_W2T) + (size_t)kind * 64 * 128, it & 1, 0, smem, 128);
    }
}

DEV void compress_item(const P& p, int item, float* smem) {
    const int tid = threadIdx.x;
    const int g = item & 1;
    int r = item >> 1;
    const int n = r % NCMP;
    r /= NCMP;
    const int b = r & 7, kind = r >> 3;
    const bf16_t* HB = (const bf16_t*)(p.ws + WS_HB);
    float* KC = (float*)(p.ws + WS_KC);
    float* su = smem;
    float* sp = smem + 2048;
    float* sh = smem + 2304;
    const int col = (kind ? C_VC : C_KC) + g * 64;
    for (int i = tid; i < 2048; i += 256) {
        const int l = i >> 6, d = i & 63;
        su[i] = bf2f(HB[(size_t)(b * S_ + 16 * n + l) * INC + col + d]) + p.cmp_pos[(kind * 32 + l) * 64 + d];
    }
    __syncthreads();
    {
        const int j = tid & 127, hf = tid >> 7;
        const float* w1 = p.cmp_w1 + (size_t)kind * 2048 * 128;
        float acc = 0.f;
        for (int i = hf * 1024; i < hf * 1024 + 1024; ++i) acc += su[i] * w1[(size_t)i * 128 + j];
        sp[hf * 128 + j] = acc;
    }
    __syncthreads();
    if (tid < 128) {
        const float v = sp[tid] + sp[128 + tid];
        const float u = 0.7978845608028654f * (v + 0.044715f * v * v * v);
        sh[tid] = 0.5f * v * (1.f + tanhf(u));
    }
    __syncthreads();
    if (tid < 64) {
        const float* w2 = p.cmp_w2 + (size_t)kind * 128 * 64;
        float acc = 0.f;
        for (int j = 0; j < 128; ++j) acc += sh[j] * w2[j * 64 + tid];
        KC[((((size_t)kind * B_ + b) * NCMP + n) * 2 + g) * 64 + tid] = acc;
    }
    __syncthreads();
}

DEV void load_q64_bf(float (&q)[64], const bf16_t* src) {
    const uint4* s4 = (const uint4*)src;
#pragma unroll
    for (int i = 0; i < 8; ++i) {
        const uint4 u = s4[i];
        q[i * 8 + 0] = bflo(u.x); q[i * 8 + 1] = bfhi(u.x); q[i * 8 + 2] = bflo(u.y); q[i * 8 + 3] = bfhi(u.y);
        q[i * 8 + 4] = bflo(u.z); q[i * 8 + 5] = bfhi(u.z); q[i * 8 + 6] = bflo(u.w); q[i * 8 + 7] = bfhi(u.w);
    }
}
DEV float dot64_bf(const float (&q)[64], const bf16_t* kr) {
    const uint4* k4 = (const uint4*)kr;
    float acc = 0.f;
#pragma unroll
    for (int i = 0; i < 8; ++i) {
        const uint4 u = k4[i];
        acc += q[i * 8 + 0] * bflo(u.x) + q[i * 8 + 1] * bfhi(u.x) + q[i * 8 + 2] * bflo(u.y) + q[i * 8 + 3] * bfhi(u.y) +
               q[i * 8 + 4] * bflo(u.z) + q[i * 8 + 5] * bfhi(u.z) + q[i * 8 + 6] * bflo(u.w) + q[i * 8 + 7] * bfhi(u.w);
    }
    return acc;
}
DEV float dot64_f(const float (&q)[64], const float* kr) {
    const float4* k4 = (const float4*)kr;
    float acc = 0.f;
#pragma unroll
    for (int i = 0; i < 16; ++i) {
        const float4 u = k4[i];
        acc += q[i * 4 + 0] * u.x + q[i * 4 + 1] * u.y + q[i * 4 + 2] * u.z + q[i * 4 + 3] * u.w;
    }
    return acc;
}

DEV void attn_block(const float (&q)[64], const bf16_t* krow_lane, const bf16_t* vbase_lane, bool valid, float& m, float& l, float& o) {
    float sc = dot64_bf(q, krow_lane) * 0.125f;
    sc = valid ? sc : -1e30f;
    const float mb = wmax(sc);
    const float mn = fmaxf(m, mb);
    const float corr = expf(m - mn);
    const float e = valid ? expf(sc - mn) : 0.f;
    l = l * corr + wsum(e);
    o *= corr;
#pragma unroll 8
    for (int k = 0; k < 64; ++k) o += __shfl(e, k) * bf2f(vbase_lane[(size_t)k * INC]);
    m = mn;
}

DEV void nsa_item(const P& p, int item) {
    const int lane = threadIdx.x & 63;
    const int g = item & 1;
    const int t = item >> 1;
    const int b = t >> 11, s = t & 2047;
    const bf16_t* HB = (const bf16_t*)(p.ws + WS_HB);
    const float* KC = (const float*)(p.ws + WS_KC);
    bf16_t* OM = (bf16_t*)(p.ws + WS_OM);
    const int cur = s >> 6;
    const int nvalid = (s >= 31) ? (((s - 31) >> 4) + 1) : 0;
    const size_t rowt = (size_t)t * INC;
    float ocmp0 = 0.f, ocmp1 = 0.f, ocmp2 = 0.f, ocmp3 = 0.f;
    float psum0 = 0.f, psum1 = 0.f;
    if (nvalid > 0) {
#pragma unroll 1
        for (int r = 0; r < 4; ++r) {
            const int h = g * 4 + r;
            float q[64];
            load_q64_bf(q, HB + rowt + C_QA + h * 64);
            float sc0 = -1e30f, sc1 = -1e30f;
            if (lane < nvalid) sc0 = dot64_f(q, KC + ((((size_t)0 * B_ + b) * NCMP + lane) * 2 + g) * 64) * 0.125f;
            if (lane + 64 < nvalid) sc1 = dot64_f(q, KC + ((((size_t)0 * B_ + b) * NCMP + lane + 64) * 2 + g) * 64) * 0.125f;
            const float m = wmax(fmaxf(sc0, sc1));
            const float e0 = (lane < nvalid) ? expf(sc0 - m) : 0.f;
            const float e1 = (lane + 64 < nvalid) ? expf(sc1 - m) : 0.f;
            const float l = wsum(e0 + e1);
            const float p0 = e0 / l, p1 = e1 / l;
            psum0 += p0;
            psum1 += p1;
            float oc = 0.f;
            const float* vcb = KC + ((((size_t)1 * B_ + b) * NCMP) * 2 + g) * 64 + lane;
            for (int n = 0; n < nvalid; ++n) {
                const float pn = (n < 64) ? __shfl(p0, n) : __shfl(p1, n - 64);
                oc += pn * vcb[(size_t)n * 128];
            }
            if (r == 0) ocmp0 = oc;
            if (r == 1) ocmp1 = oc;
            if (r == 2) ocmp2 = oc;
            if (r == 3) ocmp3 = oc;
        }
    }
    float imp = 0.f;
#pragma unroll
    for (int dn = -1; dn <= 3; ++dn) {
        const int n = 4 * lane + dn;
        const int nn = n < 0 ? 0 : (n > 127 ? 127 : n);
        const float v0 = __shfl(psum0, nn & 63);
        const float v1 = __shfl(psum1, nn & 63);
        const float v = (nn < 64) ? v0 : v1;
        if (n >= 0 && n <= 126) imp += v;
    }
    float score;
    if (lane > cur) score = -INFINITY;
    else if (lane == 0 || lane == cur || lane == cur - 1) score = 1e4f;
    else score = imp;
    int rank = 0;
#pragma unroll 8
    for (int i = 0; i < 32; ++i) {
        const float si = __shfl(score, i);
        rank += ((si > score) || (si == score && i < lane)) ? 1 : 0;
    }
    const bool sel = (lane <= cur) && (rank < 16);
    const unsigned mask = (unsigned)(__ballot(sel) & 0xffffffffull);
    const int wlo = (s - 511) > 0 ? (s - 511) : 0;
#pragma unroll 1
    for (int r = 0; r < 4; ++r) {
        const int h = g * 4 + r;
        float q[64];
        load_q64_bf(q, HB + rowt + C_QA + h * 64);
        float m = -1e30f, l = 0.f, o = 0.f;
        for (unsigned mm = mask; mm; mm &= mm - 1) {
            const int j = __builtin_ctz(mm);
            const int kpos = j * 64 + lane;
            attn_block(q, HB + (size_t)(b * S_ + kpos) * INC + C_KS + g * 64, HB + (size_t)(b * S_ + j * 64) * INC + C_VS + g * 64 + lane,
                       kpos <= s, m, l, o);
        }
        const float oslc = o / l;
        m = -1e30f; l = 0.f; o = 0.f;
        for (int j = wlo >> 6; j <= cur; ++j) {
            const int kpos = j * 64 + lane;
            attn_block(q, HB + (size_t)(b * S_ + kpos) * INC + C_KW + g * 64, HB + (size_t)(b * S_ + j * 64) * INC + C_VW + g * 64 + lane,
                       (kpos <= s) && (kpos >= wlo), m, l, o);
        }
        const float owin = o / l;
        const float oc = r == 0 ? ocmp0 : (r == 1 ? ocmp1 : (r == 2 ? ocmp2 : ocmp3));
        const float g0 = sigmoidf_(bf2f(HB[rowt + C_GATE + h * 3 + 0]));
        const float g1 = sigmoidf_(bf2f(HB[rowt + C_GATE + h * 3 + 1]));
        const float g2 = sigmoidf_(bf2f(HB[rowt + C_GATE + h * 3 + 2]));
        OM[(size_t)t * 1024 + h * 64 + lane] = f2bf(g0 * oc + g1 * oslc + g2 * owin);
    }
}

DEV void hgrn_item(const P& p, int item, float* smem) {
    const int b = item >> 2, hh = item & 3;
    const int tid = threadIdx.x, dv = tid & 127, half = tid >> 7;
    const bf16_t* HB = (const bf16_t*)(p.ws + WS_HB);
    bf16_t* OM = (bf16_t*)(p.ws + WS_OM);
    float* sf = smem;
    float* sq = smem + 1024;
    float* so = smem + 2048;
    float Sreg[64];
#pragma unroll
    for (int i = 0; i < 64; ++i) Sreg[i] = 0.f;
    const int d = tid & 127;
    float lbv;
    {
        const float l0 = p.lb_logits[hh * 128 + d], l1 = p.lb_logits[512 + hh * 128 + d];
        const float mx = fmaxf(l0, l1);
        const float e0 = expf(l0 - mx), e1 = expf(l1 - mx);
        lbv = e0 / (e0 + e1);
    }
    const int wave = tid >> 6, lane = tid & 63;
    const float nw0 = p.hg_norm_w[hh * 128 + lane], nw1 = p.hg_norm_w[hh * 128 + lane + 64];
    for (int t0 = 0; t0 < S_; t0 += 8) {
#pragma unroll
        for (int i = 0; i < 4; ++i) {
            const int st = (tid >> 7) + 2 * i;
            const size_t tt = (size_t)b * S_ + t0 + st;
            const float fl = bf2f(HB[tt * INC + C_HF + hh * 128 + d]);
            sf[st * 128 + d] = lbv + (1.f - lbv) * sigmoidf_(fl);
            sq[st * 128 + d] = bf2f(HB[tt * INC + C_HQ + hh * 128 + d]);
        }
        float vv[8];
#pragma unroll
        for (int st = 0; st < 8; ++st) vv[st] = bf2f(HB[((size_t)b * S_ + t0 + st) * INC + C_HI + hh * 128 + dv]);
        __syncthreads();
#pragma unroll
        for (int st = 0; st < 8; ++st) {
            float oacc = 0.f;
            const float* pf = sf + st * 128 + half * 64;
            const float* pq = sq + st * 128 + half * 64;
#pragma unroll
            for (int dk = 0; dk < 64; ++dk) {
                const float f = pf[dk];
                Sreg[dk] = f * Sreg[dk] + (1.f - f) * vv[st];
                oacc += pq[dk] * Sreg[dk];
            }
            so[(st * 2 + half) * 128 + dv] = oacc;
        }
        __syncthreads();
#pragma unroll
        for (int u = 0; u < 2; ++u) {
            const int st = wave * 2 + u;
            const float o0 = so[(st * 2 + 0) * 128 + lane] + so[(st * 2 + 1) * 128 + lane];
            const float o1 = so[(st * 2 + 0) * 128 + lane + 64] + so[(st * 2 + 1) * 128 + lane + 64];
            const float ss = wsum(o0 * o0 + o1 * o1);
            const float rs = rsqrtf(ss * (1.f / 128.f) + LN_EPS);
            const size_t tt = (size_t)b * S_ + t0 + st;
            const float gg0 = bf2f(HB[tt * INC + C_HG + hh * 128 + lane]);
            const float gg1 = bf2f(HB[tt * INC + C_HG + hh * 128 + lane + 64]);
            OM[tt * 1024 + 512 + hh * 128 + lane] = f2bf(o0 * rs * nw0 * (gg0 * sigmoidf_(gg0)));
            OM[tt * 1024 + 512 + hh * 128 + lane + 64] = f2bf(o1 * rs * nw1 * (gg1 * sigmoidf_(gg1)));
        }
    }
    __syncthreads();
}

DEV void ln_item(const P& p, int t, int which, int lane) {
    const bf16_t* row = (const bf16_t*)(p.ws + WS_YB) + (size_t)t * 1024;
    float4 v[4];
    float s = 0.f;
#pragma unroll
    for (int i = 0; i < 4; ++i) {
        const uint2 u = *(const uint2*)(row + (i * 64 + lane) * 4);
        v[i] = make_float4(bflo(u.x), bfhi(u.x), bflo(u.y), bfhi(u.y));
        s += v[i].x + v[i].y + v[i].z + v[i].w;
    }
    const float mean = wsum(s) * (1.f / 1024.f);
    float ss = 0.f;
#pragma unroll
    for (int i = 0; i < 4; ++i) {
        v[i].x -= mean; v[i].y -= mean; v[i].z -= mean; v[i].w -= mean;
        ss += v[i].x * v[i].x + v[i].y * v[i].y + v[i].z * v[i].z + v[i].w * v[i].w;
    }
    const float rs = rsqrtf(wsum(ss) * (1.f / 1024.f) + LN_EPS);
#pragma unroll
    for (int i = 0; i < 4; ++i) {
        const int c = (i * 64 + lane) * 4;
        const float4 gg = *(const float4*)(p.ln_g + which * 1024 + c);
        const float4 bb = *(const float4*)(p.ln_b + which * 1024 + c);
        float4 o;
        o.x = v[i].x * rs * gg.x + bb.x; o.y = v[i].y * rs * gg.y + bb.y; o.z = v[i].z * rs * gg.z + bb.z; o.w = v[i].w * rs * gg.w + bb.w;
        uint2 u;
        u.x = pk_bf16(o.x, o.y);
        u.y = pk_bf16(o.z, o.w);
        *(uint2*)((bf16_t*)(p.ws + WS_XB) + (size_t)t * 1024 + c) = u;
    }
}

DEV void xattn_item(const P& p, int item) {
    const int lane = threadIdx.x & 63;
    const int hh = item & 3, t = item >> 2, b = t >> 11;
    const bf16_t* QX = (const bf16_t*)(p.ws + WS_QX);
    const bf16_t* KVM = (const bf16_t*)(p.ws + WS_KVM);
    bf16_t* OX = (bf16_t*)(p.ws + WS_OX);
    float sc[4] = {0.f, 0.f, 0.f, 0.f};
#pragma unroll 1
    for (int c = 0; c < 4; ++c) {
        float q[64];
        load_q64_bf(q, QX + (size_t)t * 1024 + hh * 256 + c * 64);
#pragma unroll
        for (int k = 0; k < 4; ++k) sc[k] += dot64_bf(q, KVM + (size_t)(b * ML_ + lane + 64 * k) * 2048 + hh * 256 + c * 64);
    }
    float mx = -1e30f;
#pragma unroll
    for (int k = 0; k < 4; ++k) { sc[k] *= 0.0625f; mx = fmaxf(mx, sc[k]); }
    mx = wmax(mx);
    float pr[4], ls = 0.f;
#pragma unroll
    for (int k = 0; k < 4; ++k) { pr[k] = expf(sc[k] - mx); ls += pr[k]; }
    ls = wsum(ls);
    const float inv = 1.f / ls;
    float o[4] = {0.f, 0.f, 0.f, 0.f};
#pragma unroll
    for (int k = 0; k < 4; ++k) {
        const bf16_t* vb = KVM + (size_t)(b * ML_ + k * 64) * 2048 + 1024 + hh * 256 + lane;
#pragma unroll 4
        for (int mm = 0; mm < 64; ++mm) {
            const float pm = __shfl(pr[k], mm);
#pragma unroll
            for (int c = 0; c < 4; ++c) o[c] += pm * bf2f(vb[(size_t)mm * 2048 + c * 64]);
        }
    }
#pragma unroll
    for (int c = 0; c < 4; ++c) OX[(size_t)t * 1024 + hh * 256 + c * 64 + lane] = f2bf(o[c] * inv);
}

DEV void wave_argmax(float v, int i, float& bv, int& bi) {
#pragma unroll
    for (int o = 32; o > 0; o >>= 1) {
        const float ov = __shfl_xor(v, o);
        const int oi = __shfl_xor(i, o);
        if (ov > v || (ov == v && oi < i)) { v = ov; i = oi; }
    }
    bv = v; bi = i;
}

DEV void peer_item(const P& p, int t) {
    const int lane = threadIdx.x & 63;
    const float* QP = (const float*)(p.ws + WS_QP);
    float* row = p.out + (size_t)t * 1024;
    float4 xr[4], oacc[4];
#pragma unroll
    for (int i = 0; i < 4; ++i) {
        xr[i] = *(const float4*)(row + (i * 64 + lane) * 4);
        oacc[i] = make_float4(0.f, 0.f, 0.f, 0.f);
    }
#pragma unroll 1
    for (int hh = 0; hh < 8; ++hh) {
        float ts1 = 0.f, ts2 = 0.f;
        int ti1 = 0, ti2 = 0;
#pragma unroll 1
        for (int c = 0; c < 2; ++c) {
            float q[64];
            {
                const float4* q4 = (const float4*)(QP + (size_t)t * 1024 + hh * 128 + c * 64);
#pragma unroll
                for (int i = 0; i < 16; ++i) { const float4 u = q4[i]; q[i * 4] = u.x; q[i * 4 + 1] = u.y; q[i * 4 + 2] = u.z; q[i * 4 + 3] = u.w; }
            }
            const float* kb = p.peer_keys + ((size_t)(hh * 2 + c) * 128) * 64;
            float a0 = dot64_f(q, kb + (size_t)lane * 64);
            float a1 = dot64_f(q, kb + (size_t)(lane + 64) * 64);
            float ts = 0.f;
            int ti = 0;
#pragma unroll 1
            for (int k = 0; k < 16; ++k) {
                float v; int i;
                if (a0 >= a1) { v = a0; i = lane; } else { v = a1; i = lane + 64; }
                float bv; int bi;
                wave_argmax(v, i, bv, bi);
                if (lane == k) { ts = bv; ti = bi; }
                if (bi == lane) a0 = -INFINITY;
                if (bi == lane + 64) a1 = -INFINITY;
            }
            if (c == 0) { ts1 = ts; ti1 = ti; } else { ts2 = ts; ti2 = ti; }
        }
        float cs[4];
        const float s1v = __shfl(ts1, lane >> 2);
#pragma unroll
        for (int u = 0; u < 4; ++u) cs[u] = s1v + __shfl(ts2, (lane & 3) * 4 + u);
        float fs = 0.f;
        int fidx = 0;
#pragma unroll 1
        for (int k = 0; k < 16; ++k) {
            float v = cs[0]; int i = lane * 4;
#pragma unroll
            for (int u = 1; u < 4; ++u) if (cs[u] > v) { v = cs[u]; i = lane * 4 + u; }
            float bv; int bi;
            wave_argmax(v, i, bv, bi);
            if (lane == k) { fs = bv; fidx = bi; }
#pragma unroll
            for (int u = 0; u < 4; ++u) if (bi == lane * 4 + u) cs[u] = -INFINITY;
        }
        const int e1i = __shfl(ti1, fidx >> 4);
        const int e2i = __shfl(ti2, fidx & 15);
        const int eid = e1i * 128 + e2i;
        const float mx = __shfl(fs, 0);
        const float w = (lane < 16) ? expf(fs - mx) : 0.f;
        const float gate = w / wsum(w);
#pragma unroll 1
        for (int k = 0; k < 16; ++k) {
            const int e = __shfl(eid, k);
            const float gt = __shfl(gate, k);
            const float* dr = p.peer_down + (size_t)e * 1024;
            const float* ur = p.peer_up + (size_t)e * 1024;
            float hd = 0.f;
#pragma unroll
            for (int i = 0; i < 4; ++i) {
                const float4 dvv = *(const float4*)(dr + (i * 64 + lane) * 4);
                hd += dvv.x * xr[i].x + dvv.y * xr[i].y + dvv.z * xr[i].z + dvv.w * xr[i].w;
            }
            hd = wsum(hd);
            const float a = 0.5f * hd * (1.f + erff(hd * 0.7071067811865476f)) * gt;
#pragma unroll
            for (int i = 0; i < 4; ++i) {
                const float4 uv = *(const float4*)(ur + (i * 64 + lane) * 4);
                oacc[i].x += a * uv.x; oacc[i].y += a * uv.y; oacc[i].z += a * uv.z; oacc[i].w += a * uv.w;
            }
        }
    }
    float s = 0.f;
    float4 v[4];
#pragma unroll
    for (int i = 0; i < 4; ++i) {
        v[i].x = ALPHA * xr[i].x + oacc[i].x; v[i].y = ALPHA * xr[i].y + oacc[i].y;
        v[i].z = ALPHA * xr[i].z + oacc[i].z; v[i].w = ALPHA * xr[i].w + oacc[i].w;
        s += v[i].x + v[i].y + v[i].z + v[i].w;
    }
    const float mean = wsum(s) * (1.f / 1024.f);
    float ss = 0.f;
#pragma unroll
    for (int i = 0; i < 4; ++i) {
        v[i].x -= mean; v[i].y -= mean; v[i].z -= mean; v[i].w -= mean;
        ss += v[i].x * v[i].x + v[i].y * v[i].y + v[i].z * v[i].z + v[i].w * v[i].w;
    }
    const float rs = rsqrtf(wsum(ss) * (1.f / 1024.f) + LN_EPS);
#pragma unroll
    for (int i = 0; i < 4; ++i) {
        const int c = (i * 64 + lane) * 4;
        const float4 gg = *(const float4*)(p.ln_g + 2 * 1024 + c);
        const float4 bb = *(const float4*)(p.ln_b + 2 * 1024 + c);
        float4 o;
        o.x = v[i].x * rs * gg.x + bb.x; o.y = v[i].y * rs * gg.y + bb.y; o.z = v[i].z * rs * gg.z + bb.z; o.w = v[i].w * rs * gg.w + bb.w;
        *(float4*)(row + c) = o;
    }
}


DEV void compress_item2(const P& p, int item, unsigned char* lds) {
    const int nt8 = item & 7, g = (item >> 3) & 1, b = (item >> 4) & 7, kind = item >> 7;
    const int tid = threadIdx.x, lane = tid & 63, wid = tid >> 6, fr = lane & 15, fq = lane >> 4;
    const bf16_t* HB = (const bf16_t*)(p.ws + WS_HB);
    const bf16_t* W1T = (const bf16_t*)(p.ws + WS_W1T) + (size_t)kind * 128 * 2048;
    const bf16_t* W2T = (const bf16_t*)(p.ws + WS_W2T) + (size_t)kind * 64 * 128;
    const float* posb = p.cmp_pos + (size_t)kind * 2048 + fq * 8;
    const int n0 = nt8 * 16;
    const int kcol = (kind ? C_VC : C_KC) + g * 64;
    const bf16_t* abase = HB + (size_t)(b * S_ + 16 * (n0 + fr)) * INC + kcol + fq * 8;
    const bf16_t* wbase = W1T + (size_t)fr * 2048 + fq * 8;
    f32x4 acc[8];
#pragma unroll
    for (int jt = 0; jt < 8; ++jt) acc[jt] = (f32x4){0.f, 0.f, 0.f, 0.f};
#pragma unroll 4
    for (int k2 = 0; k2 < 16; ++k2) {
        const int ks = wid * 16 + k2;
        bf16x8 af;
        {
            const u32x4 raw = *(const u32x4*)(abase + (size_t)(ks >> 1) * INC + (ks & 1) * 32);
            const float* pp = posb + (ks >> 1) * 64 + (ks & 1) * 32;
            const float4 p0 = *(const float4*)pp, p1 = *(const float4*)(pp + 4);
            u32x4 w;
            w[0] = pk_bf16(bflo(raw[0]) + p0.x, bfhi(raw[0]) + p0.y);
            w[1] = pk_bf16(bflo(raw[1]) + p0.z, bfhi(raw[1]) + p0.w);
            w[2] = pk_bf16(bflo(raw[2]) + p1.x, bfhi(raw[2]) + p1.y);
            w[3] = pk_bf16(bflo(raw[3]) + p1.z, bfhi(raw[3]) + p1.w);
            af = __builtin_bit_cast(bf16x8, w);
        }
#pragma unroll
        for (int jt = 0; jt < 8; ++jt) {
            const bf16x8 wf = *(const bf16x8*)(wbase + (size_t)jt * 16 * 2048 + ks * 32);
            acc[jt] = __builtin_amdgcn_mfma_f32_16x16x32_bf16(wf, af, acc[jt], 0, 0, 0);
        }
    }
    float* PS = (float*)lds;
    bf16_t* HS = (bf16_t*)(lds + 4 * 16 * 132 * 4);
#pragma unroll
    for (int jt = 0; jt < 8; ++jt)
        *(float4*)(PS + (wid * 16 + fr) * 132 + jt * 16 + fq * 4) = make_float4(acc[jt][0], acc[jt][1], acc[jt][2], acc[jt][3]);
    __syncthreads();
    {
        const int r = tid >> 4, jb = (tid & 15) * 8;
        float hv[8];
#pragma unroll
        for (int h2 = 0; h2 < 2; ++h2) {
            float4 s = make_float4(0.f, 0.f, 0.f, 0.f);
#pragma unroll
            for (int w = 0; w < 4; ++w) {
                const float4 v = *(const float4*)(PS + (w * 16 + r) * 132 + jb + h2 * 4);
                s.x += v.x; s.y += v.y; s.z += v.z; s.w += v.w;
            }
            hv[h2 * 4 + 0] = s.x; hv[h2 * 4 + 1] = s.y; hv[h2 * 4 + 2] = s.z; hv[h2 * 4 + 3] = s.w;
        }
#pragma unroll
        for (int i = 0; i < 8; ++i) {
            const float v = hv[i];
            const float u = 0.7978845608028654f * (v + 0.044715f * v * v * v);
            hv[i] = 0.5f * v * (1.f + tanhf(u));
        }
        u32x4 w;
        w[0] = pk_bf16(hv[0], hv[1]); w[1] = pk_bf16(hv[2], hv[3]); w[2] = pk_bf16(hv[4], hv[5]); w[3] = pk_bf16(hv[6], hv[7]);
        *(u32x4*)(HS + r * 136 + jb) = w;
    }
    __syncthreads();
    f32x4 o = (f32x4){0.f, 0.f, 0.f, 0.f};
#pragma unroll
    for (int ks = 0; ks < 4; ++ks) {
        const bf16x8 hf = *(const bf16x8*)(HS + fr * 136 + ks * 32 + fq * 8);
        const bf16x8 wf = *(const bf16x8*)(W2T + (size_t)(wid * 16 + fr) * 128 + ks * 32 + fq * 8);
        if (kind == 0) o = __builtin_amdgcn_mfma_f32_16x16x32_bf16(wf, hf, o, 0, 0, 0);
        else o = __builtin_amdgcn_mfma_f32_16x16x32_bf16(hf, wf, o, 0, 0, 0);
    }
    if (kind == 0) {
        const int n = n0 + fr, e = wid * 16 + fq * 4;
        uint2 u2;
        u2.x = pk_bf16(o[0], o[1]);
        u2.y = pk_bf16(o[2], o[3]);
        if (n == 127) u2 = make_uint2(0u, 0u);
        *(uint2*)((bf16_t*)(p.ws + WS_KCB) + ((size_t)(b * 2 + g) * 128 + n) * 64 + e) = u2;
    } else {
        const int e = wid * 16 + fr, n = n0 + fq * 4;
        const float o3 = (n + 3 == 127) ? 0.f : o[3];
        uint2 u2;
        u2.x = pk_bf16(o[0], o[1]);
        u2.y = pk_bf16(o[2], o3);
        *(uint2*)((bf16_t*)(p.ws + WS_VCT) + ((size_t)(b * 2 + g) * 64 + e) * 128 + n) = u2;
    }
    __syncthreads();
}

constexpr int NSA_IMP = 32768;
constexpr int NSA_SCORE = 49152;
constexpr int NSA_SELM = NSA_SCORE + 4224;

struct NsaTileRegs { u32x4 k[2], v[2]; };
DEV void nsa_load_tile(NsaTileRegs& r, const bf16_t* kbase, size_t kstride, const bf16_t* vbase, size_t vstride, int tid) {
    const int lc = tid & 7, lr = tid >> 3;
#pragma unroll
    for (int i = 0; i < 2; ++i) {
        r.k[i] = *(const u32x4*)(kbase + (size_t)(lr + 32 * i) * kstride + lc * 8);
        r.v[i] = *(const u32x4*)(vbase + (size_t)(lr + 32 * i) * vstride + lc * 8);
    }
}
DEV void nsa_store_tile(const NsaTileRegs& r, unsigned char* stage, int tid) {
    const int lc = tid & 7, lr = tid >> 3;
    const int woff = lr * 128 + ((lc ^ ((lr >> 1) & 7)) << 4);
#pragma unroll
    for (int i = 0; i < 2; ++i) {
        *(u32x4*)(stage + woff + i * 4096) = r.k[i];
        *(u32x4*)(stage + 8192 + woff + i * 4096) = r.v[i];
    }
}
DEV void nsa_dma_tile(const bf16_t* kbase, size_t kstride, const bf16_t* vbase, size_t vstride, unsigned char* stage, int lane, int wid) {
#pragma unroll
    for (int i = 0; i < 2; ++i) {
        const int pc = wid * 2 + i;
        const int r = pc * 8 + (lane >> 3);
        const int c = (lane & 7) ^ ((r >> 1) & 7);
        __builtin_amdgcn_global_load_lds((const unsigned*)(kbase + (size_t)r * kstride + c * 8), (unsigned*)(stage + pc * 1024), 16, 0, 0);
        __builtin_amdgcn_global_load_lds((const unsigned*)(vbase + (size_t)r * vstride + c * 8), (unsigned*)(stage + 8192 + pc * 1024), 16, 0, 0);
    }
}
DEV void nsa_scores(const unsigned char* stage, const bf16x8 (&qf)[2][2], f32x4 (&sc)[4][2], int fr, int fq) {
    const int sw = (fr >> 1) & 7;
    const int c0 = (fq ^ sw) << 4;
    const unsigned char* rowp = stage + fr * 128;
    const unsigned char* p0 = rowp + c0;
    const unsigned char* p1 = rowp + (c0 ^ 64);
#pragma unroll
    for (int kt = 0; kt < 4; ++kt) {
        const bf16x8 k0 = *(const bf16x8*)(p0 + kt * 2048);
        const bf16x8 k1 = *(const bf16x8*)(p1 + kt * 2048);
#pragma unroll
        for (int qt = 0; qt < 2; ++qt) {
            f32x4 a = (f32x4){0.f, 0.f, 0.f, 0.f};
            a = __builtin_amdgcn_mfma_f32_16x16x32_bf16(k0, qf[qt][0], a, 0, 0, 0);
            a = __builtin_amdgcn_mfma_f32_16x16x32_bf16(k1, qf[qt][1], a, 0, 0, 0);
            sc[kt][qt] = a;
        }
    }
}
DEV void nsa_pv(const unsigned char* stage, const f32x4 (&sc)[4][2], f32x4 (&o)[4][2], int fr, int fq) {
    const int sw = (fr >> 1) & 7;
    const int v0 = (((fq >> 1) ^ sw) << 4) + 8 * (fq & 1);
    const unsigned char* rowp = stage + 8192 + fr * 128;
#pragma unroll
    for (int s = 0; s < 2; ++s) {
        u32x4 pf[2];
#pragma unroll
        for (int qt = 0; qt < 2; ++qt) {
            pf[qt][0] = pk_bf16(sc[2 * s][qt][0], sc[2 * s][qt][1]);
            pf[qt][1] = pk_bf16(sc[2 * s][qt][2], sc[2 * s][qt][3]);
            pf[qt][2] = pk_bf16(sc[2 * s + 1][qt][0], sc[2 * s + 1][qt][1]);
            pf[qt][3] = pk_bf16(sc[2 * s + 1][qt][2], sc[2 * s + 1][qt][3]);
        }
        const unsigned char* plo = rowp + (v0 ^ (64 * s));
        const unsigned char* phi = rowp + (v0 ^ (64 * s) ^ 32);
#pragma unroll
        for (int dt = 0; dt < 4; ++dt) {
            const uint2 lo = *(const uint2*)(plo + dt * 2048);
            const uint2 hi = *(const uint2*)(phi + dt * 2048);
            u32x4 vv;
            vv[0] = lo.x; vv[1] = lo.y; vv[2] = hi.x; vv[3] = hi.y;
            const bf16x8 vf = __builtin_bit_cast(bf16x8, vv);
#pragma unroll
            for (int qt = 0; qt < 2; ++qt)
                o[dt][qt] = __builtin_amdgcn_mfma_f32_16x16x32_bf16(vf, __builtin_bit_cast(bf16x8, pf[qt]), o[dt][qt], 0, 0, 0);
        }
    }
}
DEV float xmax4(float v) { v = fmaxf(v, __shfl_xor(v, 16)); return fmaxf(v, __shfl_xor(v, 32)); }
DEV float xsum4(float v) { v += __shfl_xor(v, 16); return v + __shfl_xor(v, 32); }

DEV void nsa_branch(const int mode, const int BR, const int q0v, const unsigned char* wsb, unsigned char* lds, int b, int g, unsigned blocks, const bf16x8 (&qf)[2][2], const int (&qpos)[2],
                    const unsigned (&selm)[2], const float (&gate)[2], f32x4 (&fin)[4][2], int tid) {
    asm volatile("" : "+v"(tid));
    const int fr = tid & 15, fq = (tid >> 4) & 3;
    const bf16_t* HB = (const bf16_t*)(wsb + WS_HB);
    const bf16_t* VT = (const bf16_t*)(wsb + WS_VT);
    const bf16_t* kb0 = HB + (size_t)(b * S_) * INC + (BR == 0 ? C_KS : C_KW) + g * 64;
    const bf16_t* vb0 = VT + ((((size_t)BR * B_ + b) * 2 + g) * 64) * 2048;
    const bool fake = mode == 1;
    float m[2] = {-1e30f, -1e30f}, l[2] = {0.f, 0.f};
    f32x4 o[4][2];
#pragma unroll
    for (int dt = 0; dt < 4; ++dt)
#pragma unroll
        for (int qt = 0; qt < 2; ++qt) o[dt][qt] = (f32x4){0.f, 0.f, 0.f, 0.f};
    const int lane64 = tid & 63, widx = __builtin_amdgcn_readfirstlane(tid >> 6);
    int kb = __builtin_ctz(blocks);
    blocks &= blocks - 1;
    int kb1 = blocks ? __builtin_ctz(blocks) : -1;
    if (kb1 >= 0) blocks &= blocks - 1;
    nsa_dma_tile(kb0 + (size_t)(fake ? 0 : kb) * 64 * INC, INC, vb0 + (fake ? 0 : kb) * 64, 2048, lds, lane64, widx);
    if (kb1 >= 0) nsa_dma_tile(kb0 + (size_t)(fake ? 0 : kb1) * 64 * INC, INC, vb0 + (fake ? 0 : kb1) * 64, 2048, lds + 16384, lane64, widx);
    int slot = 0;
    while (true) {
        if (kb1 >= 0) asm volatile("s_waitcnt vmcnt(4)\n\ts_waitcnt lgkmcnt(0)" ::: "memory");
        else asm volatile("s_waitcnt vmcnt(0)\n\ts_waitcnt lgkmcnt(0)" ::: "memory");
        __builtin_amdgcn_s_barrier(); asm volatile("" ::: "memory");
        const int kb2 = blocks ? __builtin_ctz(blocks) : -1;
        if (kb2 >= 0) {
            blocks &= blocks - 1;
            const int s2 = slot >= 1 ? slot - 1 : 2;
            nsa_dma_tile(kb0 + (size_t)(fake ? 0 : kb2) * 64 * INC, INC, vb0 + (fake ? 0 : kb2) * 64, 2048, lds + s2 * 16384, lane64, widx);
        }
        const unsigned char* stage = lds + slot * 16384;
        f32x4 sc[4][2];
        nsa_scores(stage, qf, sc, fr, fq);
        constexpr float C1 = 0.125f * 1.4426950408889634f;
        const bool need_mask = (BR == 0) ? (kb == (q0v >> 6)) : !((kb * 64 + 63 <= q0v) && (kb * 64 + 511 >= q0v + 31));
        float alpha[2];
        if (!need_mask) {
#pragma unroll
            for (int qt = 0; qt < 2; ++qt) {
                const bool sel = BR == 0 ? ((selm[qt] >> kb) & 1u) != 0u : true;
                float bm = -1e30f;
#pragma unroll
                for (int kt = 0; kt < 4; ++kt)
#pragma unroll
                    for (int i = 0; i < 4; ++i) {
                        const float s = sel ? sc[kt][qt][i] * C1 : -1e30f;
                        sc[kt][qt][i] = s;
                        bm = fmaxf(bm, s);
                    }
                bm = xmax4(bm);
                const float mn = fmaxf(m[qt], bm);
                alpha[qt] = __builtin_amdgcn_exp2f(m[qt] - mn);
                float ps = 0.f;
#pragma unroll
                for (int kt = 0; kt < 4; ++kt)
#pragma unroll
                    for (int i = 0; i < 4; ++i) {
                        const float s = sc[kt][qt][i];
                        const float e = (s > -1e29f) ? __builtin_amdgcn_exp2f(s - mn) : 0.f;
                        sc[kt][qt][i] = e;
                        ps += e;
                    }
                l[qt] = l[qt] * alpha[qt] + ps;
                m[qt] = mn;
            }
        } else {
#pragma unroll
            for (int qt = 0; qt < 2; ++qt) {
                const bool sel = BR == 0 ? ((selm[qt] >> kb) & 1u) != 0u : true;
                float bm = -1e30f;
#pragma unroll
                for (int kt = 0; kt < 4; ++kt)
#pragma unroll
                    for (int i = 0; i < 4; ++i) {
                        const int key = kb * 64 + kt * 16 + fq * 4 + i;
                        bool valid = sel && (key <= qpos[qt]);
                        if (BR == 1) valid = valid && (key + 511 >= qpos[qt]);
                        const float s = valid ? sc[kt][qt][i] * C1 : -1e30f;
                        sc[kt][qt][i] = s;
                        bm = fmaxf(bm, s);
                    }
                bm = xmax4(bm);
                const float mn = fmaxf(m[qt], bm);
                alpha[qt] = __builtin_amdgcn_exp2f(m[qt] - mn);
                float ps = 0.f;
#pragma unroll
                for (int kt = 0; kt < 4; ++kt)
#pragma unroll
                    for (int i = 0; i < 4; ++i) {
                        const float s = sc[kt][qt][i];
                        const float e = (s > -1e29f) ? __builtin_amdgcn_exp2f(s - mn) : 0.f;
                        sc[kt][qt][i] = e;
                        ps += e;
                    }
                l[qt] = l[qt] * alpha[qt] + ps;
                m[qt] = mn;
            }
        }
        {
#pragma unroll
            for (int qt = 0; qt < 2; ++qt)
#pragma unroll
                for (int dt = 0; dt < 4; ++dt) o[dt][qt] *= alpha[qt];
        }
        if (mode != 3) nsa_pv(stage, sc, o, fr, fq);
        else { asm volatile("" :: "v"(sc[0][0][0]), "v"(sc[1][1][1]), "v"(sc[2][0][2]), "v"(sc[3][1][3])); }
        if (kb1 < 0) break;
        kb = kb1;
        kb1 = kb2;
        slot = slot == 2 ? 0 : slot + 1;
    }
#pragma unroll
    for (int qt = 0; qt < 2; ++qt) {
        const float lt = xsum4(l[qt]);
        const float sc2 = lt > 0.f ? gate[qt] / lt : 0.f;
#pragma unroll
        for (int dt = 0; dt < 4; ++dt) fin[dt][qt] += o[dt][qt] * sc2;
    }
    asm volatile("s_waitcnt lgkmcnt(0)" ::: "memory");
    __builtin_amdgcn_s_barrier(); asm volatile("" ::: "memory");
}

DEV void nsa_item2(const P& p, int b, int g, int qblk, unsigned char* lds, int fake = 0) {
    int tid = threadIdx.x;
    asm volatile("" : "+v"(tid));
    const int lane = tid & 63, wid = tid >> 6, fr = lane & 15, fq = lane >> 4;
    const int q0 = qblk * 32, cur = q0 >> 6, h = g * 4 + wid;
    unsigned char* wsb = p.ws;
    asm volatile("" : "+s"(wsb));
    const bf16_t* HB = (const bf16_t*)(wsb + WS_HB);
    float* IMPW = (float*)(lds + NSA_IMP);
    float* SCORE = (float*)(lds + NSA_SCORE);
    unsigned* SELM = (unsigned*)(lds + NSA_SELM);
    bf16x8 qf[2][2];
    int qpos[2];
#pragma unroll
    for (int qt = 0; qt < 2; ++qt) {
        qpos[qt] = q0 + qt * 16 + fr;
        const bf16_t* rowp = HB + (size_t)(b * S_ + qpos[qt]) * INC;
#pragma unroll
        for (int ks = 0; ks < 2; ++ks) qf[qt][ks] = *(const bf16x8*)(rowp + C_QA + h * 64 + ks * 32 + fq * 8);
    }
    if (tid < 33) SELM[tid] = 0u;
    f32x4 fin[4][2];
#pragma unroll
    for (int dt = 0; dt < 4; ++dt)
#pragma unroll
        for (int qt = 0; qt < 2; ++qt) fin[dt][qt] = (f32x4){0.f, 0.f, 0.f, 0.f};
    {
        const bf16_t* KCB = (const bf16_t*)(wsb + WS_KCB) + (size_t)(b * 2 + g) * 128 * 64;
        const bf16_t* VCT = (const bf16_t*)(wsb + WS_VCT) + (size_t)(b * 2 + g) * 64 * 128;
        {
            const int widx = __builtin_amdgcn_readfirstlane(wid);
            nsa_dma_tile(KCB, 64, VCT, 128, lds, lane, widx);
            nsa_dma_tile(KCB + 64 * 64, 64, VCT + 64, 128, lds + 16384, lane, widx);
            asm volatile("s_waitcnt vmcnt(0)" ::: "memory");
        }
        __syncthreads();
        int nv[2];
        float mx[2] = {-1e30f, -1e30f}, inv[2];
#pragma unroll
        for (int qt = 0; qt < 2; ++qt) nv[qt] = qpos[qt] >= 31 ? (((qpos[qt] - 31) >> 4) + 1) : 0;
#pragma unroll 1
        for (int kb = 0; kb < 2; ++kb) {
            f32x4 sc[4][2];
            nsa_scores(lds + kb * 16384, qf, sc, fr, fq);
#pragma unroll
            for (int qt = 0; qt < 2; ++qt)
#pragma unroll
                for (int kt = 0; kt < 4; ++kt)
#pragma unroll
                    for (int i = 0; i < 4; ++i) {
                        const int n = kb * 64 + kt * 16 + fq * 4 + i;
                        mx[qt] = fmaxf(mx[qt], (n < nv[qt]) ? sc[kt][qt][i] * 0.125f : -1e30f);
                    }
        }
        float ps[2] = {0.f, 0.f};
#pragma unroll
        for (int qt = 0; qt < 2; ++qt) mx[qt] = xmax4(mx[qt]);
#pragma unroll 1
        for (int kb = 0; kb < 2; ++kb) {
            f32x4 sc[4][2];
            nsa_scores(lds + kb * 16384, qf, sc, fr, fq);
#pragma unroll
            for (int qt = 0; qt < 2; ++qt)
#pragma unroll
                for (int kt = 0; kt < 4; ++kt)
#pragma unroll
                    for (int i = 0; i < 4; ++i) {
                        const int n = kb * 64 + kt * 16 + fq * 4 + i;
                        ps[qt] += (n < nv[qt]) ? __expf(sc[kt][qt][i] * 0.125f - mx[qt]) : 0.f;
                    }
        }
#pragma unroll
        for (int qt = 0; qt < 2; ++qt) {
            ps[qt] = xsum4(ps[qt]);
            inv[qt] = ps[qt] > 0.f ? 1.f / ps[qt] : 0.f;
        }
        float prev3[2] = {0.f, 0.f};
#pragma unroll 1
        for (int kb = 0; kb < 2; ++kb) {
            f32x4 sc[4][2];
            nsa_scores(lds + kb * 16384, qf, sc, fr, fq);
#pragma unroll
            for (int qt = 0; qt < 2; ++qt) {
                float* impw = IMPW + (wid * 32 + qt * 16 + fr) * 32 + kb * 16 + fq;
#pragma unroll
                for (int kt = 0; kt < 4; ++kt) {
                    f32x4 pv;
#pragma unroll
                    for (int i = 0; i < 4; ++i) {
                        const int n = kb * 64 + kt * 16 + fq * 4 + i;
                        pv[i] = (n < nv[qt]) ? __expf(sc[kt][qt][i] * 0.125f - mx[qt]) * inv[qt] : 0.f;
                    }
                    sc[kt][qt] = pv;
                    const float c1 = __shfl_up(pv[3], 16);
                    const float c0 = __shfl(prev3[qt], fr + 48);
                    impw[kt * 4] = pv[0] + pv[1] + pv[2] + pv[3] + (fq > 0 ? c1 : c0);
                    prev3[qt] = pv[3];
                }
            }
            nsa_pv(lds + kb * 16384, sc, fin, fr, fq);
        }
#pragma unroll
        for (int qt = 0; qt < 2; ++qt) {
            const float gc = fsigmoid(bf2f(HB[(size_t)(b * S_ + qpos[qt]) * INC + C_GATE + h * 3 + 0]));
#pragma unroll
            for (int dt = 0; dt < 4; ++dt) fin[dt][qt] *= gc;
        }
    }
    __syncthreads();
    {
        const int q = tid >> 3, jg = tid & 7;
#pragma unroll
        for (int u = 0; u < 4; ++u) {
            const int j = jg * 4 + u;
            const float imp = IMPW[(0 * 32 + q) * 32 + j] + IMPW[(1 * 32 + q) * 32 + j] + IMPW[(2 * 32 + q) * 32 + j] + IMPW[(3 * 32 + q) * 32 + j];
            float score;
            if (j > cur) score = -INFINITY;
            else if (j == 0 || j == cur || j == cur - 1) score = 1e4f;
            else score = imp;
            SCORE[q * 33 + j] = score;
        }
        __syncthreads();
        unsigned bits = 0u;
#pragma unroll
        for (int u = 0; u < 4; ++u) {
            const int j = jg * 4 + u;
            const float sj = SCORE[q * 33 + j];
            int rank = 0;
#pragma unroll 8
            for (int i = 0; i < 32; ++i) {
                const float si = SCORE[q * 33 + i];
                rank += ((si > sj) || (si == sj && i < j)) ? 1 : 0;
            }
            if (j <= cur && rank < 16) bits |= 1u << j;
        }
        atomicOr(&SELM[q], bits);
        atomicOr(&SELM[32], bits);
        __syncthreads();
    }
    unsigned selm[2];
    selm[0] = SELM[fr];
    selm[1] = SELM[16 + fr];
    const unsigned um = SELM[32];
    __syncthreads();
#pragma unroll 1
    for (int br = 0; br < 2; ++br) {
        const int wlo = (q0 - 511) > 0 ? ((q0 - 511) >> 6) : 0;
        const unsigned wmask = ((2u << cur) - 1u) & ~((1u << wlo) - 1u);
        float gs[2];
#pragma unroll
        for (int qt = 0; qt < 2; ++qt) gs[qt] = fsigmoid(bf2f(HB[(size_t)(b * S_ + qpos[qt]) * INC + C_GATE + h * 3 + 1 + br]));
        if (fake != 2) nsa_branch(fake, br, q0, wsb, lds, b, g, br ? wmask : um, qf, qpos, selm, gs, fin, tid);
    }
    bf16_t* OM = (bf16_t*)(wsb + WS_OM);
#pragma unroll
    for (int qt = 0; qt < 2; ++qt)
#pragma unroll
        for (int dt = 0; dt < 4; ++dt) {
            uint2 u2;
            u2.x = pk_bf16(fin[dt][qt][0], fin[dt][qt][1]);
            u2.y = pk_bf16(fin[dt][qt][2], fin[dt][qt][3]);
            *(uint2*)(OM + (size_t)(b * S_ + qpos[qt]) * 1024 + h * 64 + dt * 16 + fq * 4) = u2;
        }
}

DEV void hgrn_prep_item(const P& p, int item, float* smem) {
    const int c = item & 31, bh = item >> 5, hh = bh & 3, b = bh >> 2;
    const int tid = threadIdx.x, d = tid & 127, th = tid >> 7;
    const bf16_t* HB = (const bf16_t*)(p.ws + WS_HB);
    unsigned char* hs = (unsigned char*)p.out;
    bf16_t* QT = (bf16_t*)(hs + HS_QT);
    bf16_t* KT = (bf16_t*)(hs + HS_KT);
    bf16_t* KHT = (bf16_t*)(hs + HS_KHT);
    bf16_t* VIT = (bf16_t*)(hs + HS_VIT);
    float lbv;
    {
        const float l0 = p.lb_logits[hh * 128 + d], l1 = p.lb_logits[512 + hh * 128 + d];
        const float mx = fmaxf(l0, l1);
        const float e0 = expf(l0 - mx), e1 = expf(l1 - mx);
        lbv = e0 / (e0 + e1);
    }
    const size_t trow0 = (size_t)b * S_ + c * 64 + th * 32;
    float kk[32], bl[32];
    float run = 0.f;
#pragma unroll
    for (int i = 0; i < 32; ++i) {
        const float fl = bf2f(HB[(trow0 + i) * INC + C_HF + hh * 128 + d]);
        const float f = lbv + (1.f - lbv) * fsigmoid(fl);
        kk[i] = 1.f - f;
        run += __logf(f);
        bl[i] = run;
    }
    smem[th * 128 + d] = run;
    __syncthreads();
    const float off = th ? smem[d] : 0.f;
    const float blast = smem[d] + smem[128 + d];
    unsigned kh[16], vi[16];
#pragma unroll
    for (int i = 0; i < 32; i += 2) {
        float qv[2], kt[2], khv[2], vv[2];
#pragma unroll
        for (int u = 0; u < 2; ++u) {
            const float bb = bl[i + u] + off;
            const size_t tr = trow0 + i + u;
            const float q = bf2f(HB[tr * INC + C_HQ + hh * 128 + d]);
            vv[u] = bf2f(HB[tr * INC + C_HI + hh * 128 + d]);
            qv[u] = q * __expf(bb);
            kt[u] = kk[i + u] * __expf(fminf(-bb, 80.f));
            khv[u] = kk[i + u] * __expf(blast - bb);
            const size_t o = ((size_t)bh * 2048 + c * 64 + th * 32 + i + u) * 128 + d;
            QT[o] = f2bf(qv[u]);
            KT[o] = f2bf(kt[u]);
        }
        kh[i >> 1] = pk_bf16(khv[0], khv[1]);
        vi[i >> 1] = pk_bf16(vv[0], vv[1]);
    }
    {
        const size_t o = ((size_t)bh * 128 + d) * 2048 + c * 64 + th * 32;
#pragma unroll
        for (int j = 0; j < 4; ++j) {
            u32x4 a, bq;
            a[0] = kh[4 * j]; a[1] = kh[4 * j + 1]; a[2] = kh[4 * j + 2]; a[3] = kh[4 * j + 3];
            bq[0] = vi[4 * j]; bq[1] = vi[4 * j + 1]; bq[2] = vi[4 * j + 2]; bq[3] = vi[4 * j + 3];
            *(u32x4*)(KHT + o + j * 8) = a;
            *(u32x4*)(VIT + o + j * 8) = bq;
        }
    }
    if (th == 0) ((float*)(p.ws + WS_EB))[((size_t)bh * 32 + c) * 128 + d] = expf(blast);
    __syncthreads();
}

DEV bf16x8 ld2x8(const bf16_t* p0, const bf16_t* p1) {
    const uint2 lo = *(const uint2*)p0, hi = *(const uint2*)p1;
    u32x4 v;
    v[0] = lo.x; v[1] = lo.y; v[2] = hi.x; v[3] = hi.y;
    return __builtin_bit_cast(bf16x8, v);
}
struct HgRegs { u32x4 a[4], b[4]; };
DEV void hg_loadA(HgRegs& r, const bf16_t* KT, const bf16_t* QT, int s0, int tid) {
    const unsigned off = (unsigned)(((tid >> 4) * 128 + (tid & 15) * 8) * 2);
    const char* kb = (const char*)(KT + (size_t)s0 * 128);
    const char* qb = (const char*)(QT + (size_t)s0 * 128);
#pragma unroll
    for (int i = 0; i < 4; ++i) {
        r.a[i] = *(const u32x4*)(kb + i * 4096 + off);
        r.b[i] = *(const u32x4*)(qb + i * 4096 + off);
    }
}
DEV void hg_storeA(const HgRegs& r, unsigned char* lds, int tid) {
    const int c16 = tid & 15, r16 = tid >> 4;
    const int o16 = r16 * 256 + ((c16 ^ (r16 & 15)) << 4);
#pragma unroll
    for (int i = 0; i < 4; ++i) {
        *(u32x4*)(lds + o16 + i * 4096) = r.a[i];
        *(u32x4*)(lds + 16384 + o16 + i * 4096) = r.b[i];
    }
}
DEV void hg_loadB(HgRegs& r, const bf16_t* KHT, const bf16_t* VIT, int s0, int tid) {
    const unsigned off = (unsigned)(((tid >> 3) * 2048 + (tid & 7) * 8) * 2);
    const char* kb = (const char*)(KHT + s0);
    const char* vb = (const char*)(VIT + s0);
#pragma unroll
    for (int i = 0; i < 4; ++i) {
        r.a[i] = *(const u32x4*)(kb + (size_t)i * 131072 + off);
        r.b[i] = *(const u32x4*)(vb + (size_t)i * 131072 + off);
    }
}
DEV void hg_storeB(const HgRegs& r, unsigned char* lds, int tid) {
    const int c8 = tid & 7, r8 = tid >> 3;
    const int o8 = r8 * 128 + ((c8 ^ ((r8 >> 1) & 7)) << 4);
#pragma unroll
    for (int i = 0; i < 4; ++i) {
        *(u32x4*)(lds + 32768 + o8 + i * 4096) = r.a[i];
        *(u32x4*)(lds + 49152 + o8 + i * 4096) = r.b[i];
    }
}
DEV void hgrn_chain_item(const P& p, int bh, unsigned char* lds) {
    const int hh = bh & 3, b = bh >> 2;
    int tid = threadIdx.x;
    asm volatile("" : "+v"(tid));
    const int lane = tid & 63, wid = tid >> 6, fr = lane & 15, fq = lane >> 4;
    const unsigned char* hs = (const unsigned char*)p.out;
    const bf16_t* QT = (const bf16_t*)(hs + HS_QT) + (size_t)bh * 2048 * 128;
    const bf16_t* KT = (const bf16_t*)(hs + HS_KT) + (size_t)bh * 2048 * 128;
    const bf16_t* KHT = (const bf16_t*)(hs + HS_KHT) + (size_t)bh * 128 * 2048;
    const bf16_t* VIT = (const bf16_t*)(hs + HS_VIT) + (size_t)bh * 128 * 2048;
    const float* EB = (const float*)(p.ws + WS_EB) + (size_t)bh * 32 * 128;
    const bf16_t* HB = (const bf16_t*)(p.ws + WS_HB);
    bf16_t* OM = (bf16_t*)(p.ws + WS_OM);
    const unsigned char* sKT = lds;
    const unsigned char* sQT = lds + 16384;
    const unsigned char* sKH = lds + 32768;
    const unsigned char* sVI = lds + 49152;
    bf16_t* AT = (bf16_t*)lds;
    float* SS = (float*)(lds + 65536);
    f32x4 S[8][2];
#pragma unroll
    for (int i = 0; i < 8; ++i)
#pragma unroll
        for (int j = 0; j < 2; ++j) S[i][j] = (f32x4){0.f, 0.f, 0.f, 0.f};
    const int dv0 = wid * 32;
    const int sw8 = (fr >> 1) & 7;
    int b256[4];
#pragma unroll
    for (int ks = 0; ks < 4; ++ks) b256[ks] = fr * 256 + (((4 * ks + fq) ^ fr) << 4);
    int p256[4][2];
#pragma unroll
    for (int u = 0; u < 4; ++u)
#pragma unroll
        for (int h = 0; h < 2; ++h) p256[u][h] = fr * 256 + (((4 * u + 2 * h + (fq >> 1)) ^ fr) << 4) + 8 * (fq & 1);
    int b128[2];
#pragma unroll
    for (int ks = 0; ks < 2; ++ks) b128[ks] = fr * 128 + (((4 * ks + fq) ^ sw8) << 4);
    {
        HgRegs r;
        hg_loadA(r, KT, QT, 0, tid);
        hg_storeA(r, lds, tid);
        hg_loadB(r, KHT, VIT, 0, tid);
        hg_storeB(r, lds, tid);
    }
    __syncthreads();
#pragma unroll 1
    for (int c = 0; c < 32; ++c) {
        const int s0 = c * 64;
        HgRegs nx;
        if (c + 1 < 32) hg_loadA(nx, KT, QT, s0 + 64, tid);
        uint2 atp[4];
        {
            bf16x8 qf[4];
#pragma unroll
            for (int ks = 0; ks < 4; ++ks) qf[ks] = *(const bf16x8*)(sQT + wid * 4096 + b256[ks]);
#pragma unroll
            for (int st = 0; st < 4; ++st) {
                f32x4 a = (f32x4){0.f, 0.f, 0.f, 0.f};
#pragma unroll
                for (int ks = 0; ks < 4; ++ks) {
                    const bf16x8 kf = *(const bf16x8*)(sKT + st * 4096 + b256[ks]);
                    a = __builtin_amdgcn_mfma_f32_16x16x32_bf16(kf, qf[ks], a, 0, 0, 0);
                }
                const int t = wid * 16 + fr;
                float av[4];
#pragma unroll
                for (int i = 0; i < 4; ++i) av[i] = (st * 16 + fq * 4 + i <= t) ? a[i] : 0.f;
                atp[st].x = pk_bf16(av[0], av[1]);
                atp[st].y = pk_bf16(av[2], av[3]);
            }
        }
        __syncthreads();
#pragma unroll
        for (int st = 0; st < 4; ++st) *(uint2*)(AT + (wid * 16 + fr) * 72 + st * 16 + fq * 4) = atp[st];
        __syncthreads();
        f32x4 o[2][4];
#pragma unroll
        for (int i = 0; i < 2; ++i)
#pragma unroll
            for (int j = 0; j < 4; ++j) o[i][j] = (f32x4){0.f, 0.f, 0.f, 0.f};
        bf16x8 vf[2][2];
#pragma unroll
        for (int dvt = 0; dvt < 2; ++dvt)
#pragma unroll
            for (int ks = 0; ks < 2; ++ks) vf[dvt][ks] = *(const bf16x8*)(sVI + wid * 4096 + dvt * 2048 + b128[ks]);
#pragma unroll
        for (int ks = 0; ks < 2; ++ks)
#pragma unroll
            for (int tt = 0; tt < 4; ++tt) {
                const bf16x8 af = *(const bf16x8*)(AT + (tt * 16 + fr) * 72 + ks * 32 + fq * 8);
#pragma unroll
                for (int dvt = 0; dvt < 2; ++dvt) o[dvt][tt] = __builtin_amdgcn_mfma_f32_16x16x32_bf16(vf[dvt][ks], af, o[dvt][tt], 0, 0, 0);
            }
#pragma unroll
        for (int u = 0; u < 4; ++u) {
            bf16x8 sf[2];
#pragma unroll
            for (int dvt = 0; dvt < 2; ++dvt) {
                u32x4 w;
                w[0] = pk_bf16(S[2 * u][dvt][0], S[2 * u][dvt][1]);
                w[1] = pk_bf16(S[2 * u][dvt][2], S[2 * u][dvt][3]);
                w[2] = pk_bf16(S[2 * u + 1][dvt][0], S[2 * u + 1][dvt][1]);
                w[3] = pk_bf16(S[2 * u + 1][dvt][2], S[2 * u + 1][dvt][3]);
                sf[dvt] = __builtin_bit_cast(bf16x8, w);
            }
#pragma unroll
            for (int tt = 0; tt < 4; ++tt) {
                const uint2 lo = *(const uint2*)(sQT + tt * 4096 + p256[u][0]);
                const uint2 hi = *(const uint2*)(sQT + tt * 4096 + p256[u][1]);
                u32x4 w;
                w[0] = lo.x; w[1] = lo.y; w[2] = hi.x; w[3] = hi.y;
                const bf16x8 qf2 = __builtin_bit_cast(bf16x8, w);
#pragma unroll
                for (int dvt = 0; dvt < 2; ++dvt) o[dvt][tt] = __builtin_amdgcn_mfma_f32_16x16x32_bf16(sf[dvt], qf2, o[dvt][tt], 0, 0, 0);
            }
        }
        u32x4 op[4];
#pragma unroll
        for (int tt = 0; tt < 4; ++tt) {
            float ss = 0.f;
#pragma unroll
            for (int dvt = 0; dvt < 2; ++dvt)
#pragma unroll
                for (int i = 0; i < 4; ++i) ss += o[dvt][tt][i] * o[dvt][tt][i];
            ss = xsum4(ss);
            if (fq == 0) SS[wid * 64 + tt * 16 + fr] = ss;
            op[tt][0] = pk_bf16(o[0][tt][0], o[0][tt][1]);
            op[tt][1] = pk_bf16(o[0][tt][2], o[0][tt][3]);
            op[tt][2] = pk_bf16(o[1][tt][0], o[1][tt][1]);
            op[tt][3] = pk_bf16(o[1][tt][2], o[1][tt][3]);
        }
        __syncthreads();
        if (c + 1 < 32) { hg_storeA(nx, lds, tid); hg_loadB(nx, KHT, VIT, s0 + 64, tid); }
        uint2 gg[4][2];
#pragma unroll
        for (int tt = 0; tt < 4; ++tt)
#pragma unroll
            for (int dvt = 0; dvt < 2; ++dvt)
                gg[tt][dvt] = *(const uint2*)(HB + ((size_t)b * S_ + s0 + tt * 16 + fr) * INC + C_HG + hh * 128 + dv0 + dvt * 16 + fq * 4);
        {
            bf16x8 vf3[2][2];
#pragma unroll
            for (int dvt = 0; dvt < 2; ++dvt)
#pragma unroll
                for (int ks = 0; ks < 2; ++ks) vf3[dvt][ks] = *(const bf16x8*)(sVI + wid * 4096 + dvt * 2048 + b128[ks]);
#pragma unroll
            for (int dkt = 0; dkt < 8; ++dkt) {
                const float4 eb = *(const float4*)(EB + c * 128 + dkt * 16 + fq * 4);
                bf16x8 kf[2];
#pragma unroll
                for (int ks = 0; ks < 2; ++ks) kf[ks] = *(const bf16x8*)(sKH + dkt * 2048 + b128[ks]);
#pragma unroll
                for (int dvt = 0; dvt < 2; ++dvt) {
                    f32x4 a = S[dkt][dvt];
                    a[0] *= eb.x; a[1] *= eb.y; a[2] *= eb.z; a[3] *= eb.w;
                    a = __builtin_amdgcn_mfma_f32_16x16x32_bf16(kf[0], vf3[dvt][0], a, 0, 0, 0);
                    a = __builtin_amdgcn_mfma_f32_16x16x32_bf16(kf[1], vf3[dvt][1], a, 0, 0, 0);
                    S[dkt][dvt] = a;
                }
            }
        }
        __syncthreads();
        if (c + 1 < 32) hg_storeB(nx, lds, tid);
#pragma unroll
        for (int tt = 0; tt < 4; ++tt) {
            const int t = tt * 16 + fr;
            const float tot = SS[t] + SS[64 + t] + SS[128 + t] + SS[192 + t];
            const float rs = rsqrtf(tot * (1.f / 128.f) + LN_EPS);
            const size_t tg = (size_t)b * S_ + s0 + t;
#pragma unroll
            for (int dvt = 0; dvt < 2; ++dvt) {
                const int dv = dv0 + dvt * 16 + fq * 4;
                const float g0 = bflo(gg[tt][dvt].x), g1 = bfhi(gg[tt][dvt].x), g2 = bflo(gg[tt][dvt].y), g3 = bfhi(gg[tt][dvt].y);
                const float4 nwv = *(const float4*)(p.hg_norm_w + hh * 128 + dv);
                const unsigned w0 = op[tt][2 * dvt], w1 = op[tt][2 * dvt + 1];
                const float r0 = bflo(w0) * rs * nwv.x * (g0 * fsigmoid(g0));
                const float r1 = bfhi(w0) * rs * nwv.y * (g1 * fsigmoid(g1));
                const float r2 = bflo(w1) * rs * nwv.z * (g2 * fsigmoid(g2));
                const float r3 = bfhi(w1) * rs * nwv.w * (g3 * fsigmoid(g3));
                uint2 u2;
                u2.x = pk_bf16(r0, r1);
                u2.y = pk_bf16(r2, r3);
                *(uint2*)(OM + tg * 1024 + 512 + hh * 128 + dv) = u2;
            }
        }
        __syncthreads();
    }
}


DEV void hgrn_prep_item2(const P& p, int item, unsigned char* lds) {
    const int c = item & 31, bh = item >> 5, hh = bh & 3, b = bh >> 2;
    int tid = threadIdx.x;
    asm volatile("" : "+v"(tid));
    const int d = tid & 127, th = tid >> 7;
    const int lane = tid & 63, wid = tid >> 6, fr = lane & 15, fq = lane >> 4;
    const bf16_t* HB = (const bf16_t*)(p.ws + WS_HB);
    unsigned char* hs = (unsigned char*)p.out;
    bf16_t* QTg = (bf16_t*)(hs + HS_QT);
    bf16_t* OIg = (bf16_t*)(hs + HS_OI);
    uint2* DSg = (uint2*)(hs + HS_DS);
    float* tots = (float*)(lds + 65536);
    unsigned char* sKT = lds;
    unsigned char* sQT = lds + 16384;
    unsigned char* sKH = lds + 32768;
    unsigned char* sVI = lds + 49152;
    float lbv;
    {
        const float l0 = p.lb_logits[hh * 128 + d], l1 = p.lb_logits[512 + hh * 128 + d];
        const float mx = fmaxf(l0, l1);
        const float e0 = expf(l0 - mx), e1 = expf(l1 - mx);
        lbv = e0 / (e0 + e1);
    }
    const size_t trow0 = (size_t)b * S_ + c * 64 + th * 32;
    const float nwd = p.hg_norm_w[hh * 128 + d];
    float bl[32];
    float run = 0.f;
#pragma unroll
    for (int i = 0; i < 32; ++i) {
        const float fl = bf2f(HB[(trow0 + i) * INC + C_HF + hh * 128 + d]);
        const float f = lbv + (1.f - lbv) * fsigmoid(fl);
        run += __logf(f);
        bl[i] = run;
    }
    tots[th * 128 + d] = run;
    __syncthreads();
    const float off = th ? tots[d] : 0.f;
    const float blast = tots[d] + tots[128 + d];
#pragma unroll
    for (int j = 0; j < 4; ++j) {
        u32x4 a, bq;
#pragma unroll
        for (int i2 = 0; i2 < 4; ++i2) {
            float khv[2], vv[2];
#pragma unroll
            for (int u = 0; u < 2; ++u) {
                const int i = j * 8 + i2 * 2 + u;
                const float bb = bl[i] + off;
                const float kki = 1.f - __expf(bl[i] - (i ? bl[i > 0 ? i - 1 : 0] : 0.f));
                const size_t tr = trow0 + i;
                const float q = bf2f(HB[tr * INC + C_HQ + hh * 128 + d]);
                vv[u] = bf2f(HB[tr * INC + C_HI + hh * 128 + d]);
                const bf16_t qv = f2bf(q * __expf(bb));
                const bf16_t kt = f2bf(kki * __expf(fminf(-bb, 80.f)));
                khv[u] = kki * __expf(blast - bb);
                const int t = th * 32 + i;
                QTg[((size_t)bh * 2048 + c * 64 + t) * 128 + d] = qv;
                {
                    const float gv = bf2f(HB[tr * INC + C_HG + hh * 128 + d]);
                    ((bf16_t*)(p.ws + WS_XB))[((size_t)bh * 2048 + c * 64 + t) * 128 + d] = f2bf(nwd * gv * fsigmoid(gv));
                }
                const int off256 = t * 256 + ((((d >> 3) ^ (t & 15))) << 4) + (d & 7) * 2;
                *(bf16_t*)(sQT + off256) = qv;
                *(bf16_t*)(sKT + off256) = kt;
            }
            a[i2] = pk_bf16(khv[0], khv[1]);
            bq[i2] = pk_bf16(vv[0], vv[1]);
        }
        const int off128 = d * 128 + (((th * 4 + j) ^ ((d >> 1) & 7)) << 4);
        *(u32x4*)(sKH + off128) = a;
        *(u32x4*)(sVI + off128) = bq;
    }
    if (th == 0) ((float*)(p.ws + WS_EB))[((size_t)bh * 32 + c) * 128 + d] = __expf(blast);
    __syncthreads();
    const int sw8 = (fr >> 1) & 7;
    int b256[4];
#pragma unroll
    for (int ks = 0; ks < 4; ++ks) b256[ks] = fr * 256 + (((4 * ks + fq) ^ fr) << 4);
    int b128[2];
#pragma unroll
    for (int ks = 0; ks < 2; ++ks) b128[ks] = fr * 128 + (((4 * ks + fq) ^ sw8) << 4);
    uint2 atp[4];
    {
        bf16x8 qf[4];
#pragma unroll
        for (int ks = 0; ks < 4; ++ks) qf[ks] = *(const bf16x8*)(sQT + wid * 4096 + b256[ks]);
#pragma unroll
        for (int st = 0; st < 4; ++st) {
            f32x4 a = (f32x4){0.f, 0.f, 0.f, 0.f};
#pragma unroll
            for (int ks = 0; ks < 4; ++ks) {
                const bf16x8 kf = *(const bf16x8*)(sKT + st * 4096 + b256[ks]);
                a = __builtin_amdgcn_mfma_f32_16x16x32_bf16(kf, qf[ks], a, 0, 0, 0);
            }
            const int t = wid * 16 + fr;
            float av[4];
#pragma unroll
            for (int i = 0; i < 4; ++i) av[i] = (st * 16 + fq * 4 + i <= t) ? a[i] : 0.f;
            atp[st].x = pk_bf16(av[0], av[1]);
            atp[st].y = pk_bf16(av[2], av[3]);
        }
    }
    __syncthreads();
    bf16_t* AT = (bf16_t*)lds;
#pragma unroll
    for (int st = 0; st < 4; ++st) *(uint2*)(AT + (wid * 16 + fr) * 72 + st * 16 + fq * 4) = atp[st];
    __syncthreads();
    const int dv0 = wid * 32;
    bf16x8 vf[2][2];
#pragma unroll
    for (int dvt = 0; dvt < 2; ++dvt)
#pragma unroll
        for (int ks = 0; ks < 2; ++ks) vf[dvt][ks] = *(const bf16x8*)(sVI + wid * 4096 + dvt * 2048 + b128[ks]);
#pragma unroll
    for (int tt = 0; tt < 4; ++tt) {
        f32x4 o0 = (f32x4){0.f, 0.f, 0.f, 0.f}, o1 = (f32x4){0.f, 0.f, 0.f, 0.f};
#pragma unroll
        for (int ks = 0; ks < 2; ++ks) {
            const bf16x8 af = *(const bf16x8*)(AT + (tt * 16 + fr) * 72 + ks * 32 + fq * 8);
            o0 = __builtin_amdgcn_mfma_f32_16x16x32_bf16(vf[0][ks], af, o0, 0, 0, 0);
            o1 = __builtin_amdgcn_mfma_f32_16x16x32_bf16(vf[1][ks], af, o1, 0, 0, 0);
        }
        bf16_t* op = OIg + ((size_t)bh * 2048 + c * 64 + tt * 16 + fr) * 128 + dv0 + fq * 4;
        *(uint2*)op = make_uint2(pk_bf16(o0[0], o0[1]), pk_bf16(o0[2], o0[3]));
        *(uint2*)(op + 16) = make_uint2(pk_bf16(o1[0], o1[1]), pk_bf16(o1[2], o1[3]));
    }
    uint2* dsp = DSg + ((((size_t)bh * 32 + c) * 4 + wid) * 16) * 64 + lane;
#pragma unroll
    for (int dkt = 0; dkt < 8; ++dkt) {
        bf16x8 kf[2];
#pragma unroll
        for (int ks = 0; ks < 2; ++ks) kf[ks] = *(const bf16x8*)(sKH + dkt * 2048 + b128[ks]);
#pragma unroll
        for (int dvt = 0; dvt < 2; ++dvt) {
            f32x4 a = (f32x4){0.f, 0.f, 0.f, 0.f};
            a = __builtin_amdgcn_mfma_f32_16x16x32_bf16(kf[0], vf[dvt][0], a, 0, 0, 0);
            a = __builtin_amdgcn_mfma_f32_16x16x32_bf16(kf[1], vf[dvt][1], a, 0, 0, 0);
            dsp[(dkt * 2 + dvt) * 64] = make_uint2(pk_bf16(a[0], a[1]), pk_bf16(a[2], a[3]));
        }
    }
    __syncthreads();
}

DEV void hgrn_chain_item2(const P& p, int bh, unsigned char* lds) {
    const int hh = bh & 3, b = bh >> 2;
    int tid = threadIdx.x;
    asm volatile("" : "+v"(tid));
    const int lane = tid & 63, wid = __builtin_amdgcn_readfirstlane(tid >> 6), fr = lane & 15, fq = lane >> 4;
    const unsigned char* hs = (const unsigned char*)p.out;
    const bf16_t* QTg = (const bf16_t*)(hs + HS_QT) + (size_t)bh * 2048 * 128;
    const char* OIb = (const char*)(hs + HS_OI) + ((size_t)bh * 2048 * 128 + wid * 32) * 2;
    const unsigned oioff = (unsigned)((fr * 128 + fq * 4) * 2);
    const char* DSb = (const char*)(hs + HS_DS) + (((size_t)bh * 32 * 4 + wid) * 16 * 64) * 8;
    const unsigned dsoff = (unsigned)(lane * 8);
    const char* GGb = (const char*)(p.ws + WS_XB) + ((size_t)bh * 2048 * 128 + wid * 32) * 2;
    const unsigned ggoff = oioff;
    const float* EB = (const float*)(p.ws + WS_EB) + (size_t)bh * 32 * 128;
    bf16_t* OM = (bf16_t*)(p.ws + WS_OM);
    float* EBL = (float*)(lds + 16384);
    float* SS = (float*)(lds + 16896);
    const int dv0 = wid * 32;
    int p256[4][2];
#pragma unroll
    for (int u = 0; u < 4; ++u)
#pragma unroll
        for (int h = 0; h < 2; ++h) p256[u][h] = fr * 256 + (((4 * u + 2 * h + (fq >> 1)) ^ fr) << 4) + 8 * (fq & 1);
    const int c16 = tid & 15, r16 = tid >> 4;
    const int o16 = r16 * 256 + ((c16 ^ (r16 & 15)) << 4);
    const unsigned qoff = (unsigned)((r16 * 128 + c16 * 8) * 2);
    f32x4 S[2][2];
    f32x4* SL = (f32x4*)(lds + 17920) + wid * 768 + lane;
#pragma unroll
    for (int i = 0; i < 2; ++i)
#pragma unroll
        for (int j = 0; j < 2; ++j) S[i][j] = (f32x4){0.f, 0.f, 0.f, 0.f};
#pragma unroll
    for (int i = 0; i < 12; ++i) SL[i * 64] = (f32x4){0.f, 0.f, 0.f, 0.f};
    uint2 oi[4][2], dsr[8][2];
    {
        const char* qb = (const char*)QTg;
#pragma unroll
        for (int i = 0; i < 4; ++i) *(u32x4*)(lds + o16 + i * 4096) = *(const u32x4*)(qb + i * 4096 + qoff);
        if (tid < 32) *(u32x4*)(EBL + tid * 4) = *(const u32x4*)(EB + tid * 4);
#pragma unroll
        for (int tt = 0; tt < 4; ++tt)
#pragma unroll
            for (int dvt = 0; dvt < 2; ++dvt) {
                oi[tt][dvt] = *(const uint2*)(OIb + tt * 4096 + dvt * 32 + oioff);
            }
#pragma unroll
        for (int dkt = 0; dkt < 8; ++dkt)
#pragma unroll
            for (int dvt = 0; dvt < 2; ++dvt) dsr[dkt][dvt] = *(const uint2*)(DSb + (dkt * 2 + dvt) * 512 + dsoff);
    }
    __syncthreads();
#pragma unroll 1
    for (int c = 0; c < 32; ++c) {
        const int s0 = c * 64;
        const bool more = c + 1 < 32;
        uint2 gg[4][2];
#pragma unroll
        for (int tt = 0; tt < 4; ++tt)
#pragma unroll
            for (int dvt = 0; dvt < 2; ++dvt) gg[tt][dvt] = *(const uint2*)(GGb + (size_t)s0 * 256 + tt * 4096 + dvt * 32 + ggoff);
        f32x4 o[2][4];
#pragma unroll
        for (int tt = 0; tt < 4; ++tt)
#pragma unroll
            for (int dvt = 0; dvt < 2; ++dvt) {
                o[dvt][tt] = (f32x4){bflo(oi[tt][dvt].x), bfhi(oi[tt][dvt].x), bflo(oi[tt][dvt].y), bfhi(oi[tt][dvt].y)};
                if (more) oi[tt][dvt] = *(const uint2*)(OIb + (size_t)(s0 + 64) * 256 + tt * 4096 + dvt * 32 + oioff);
            }
        const unsigned char* sQ = lds;
#pragma unroll
        for (int u = 0; u < 4; ++u) {
            bf16x8 sf[2];
#pragma unroll
            for (int dvt = 0; dvt < 2; ++dvt) {
                const f32x4 sa = u < 1 ? S[0][dvt] : SL[((2 * u - 2) * 2 + dvt) * 64];
                const f32x4 sb = u < 1 ? S[1][dvt] : SL[((2 * u - 1) * 2 + dvt) * 64];
                u32x4 w;
                w[0] = pk_bf16(sa[0], sa[1]);
                w[1] = pk_bf16(sa[2], sa[3]);
                w[2] = pk_bf16(sb[0], sb[1]);
                w[3] = pk_bf16(sb[2], sb[3]);
                sf[dvt] = __builtin_bit_cast(bf16x8, w);
            }
#pragma unroll
            for (int tt = 0; tt < 4; ++tt) {
                const uint2 lo = *(const uint2*)(sQ + tt * 4096 + p256[u][0]);
                const uint2 hi = *(const uint2*)(sQ + tt * 4096 + p256[u][1]);
                u32x4 w;
                w[0] = lo.x; w[1] = lo.y; w[2] = hi.x; w[3] = hi.y;
                const bf16x8 qf2 = __builtin_bit_cast(bf16x8, w);
#pragma unroll
                for (int dvt = 0; dvt < 2; ++dvt) o[dvt][tt] = __builtin_amdgcn_mfma_f32_16x16x32_bf16(sf[dvt], qf2, o[dvt][tt], 0, 0, 0);
            }
        }
        u32x4 qn[4], ebn;
        if (more) {
            const char* qb = (const char*)(QTg + (size_t)(s0 + 64) * 128);
#pragma unroll
            for (int i = 0; i < 4; ++i) qn[i] = *(const u32x4*)(qb + i * 4096 + qoff);
            if (tid < 32) ebn = *(const u32x4*)(EB + (c + 1) * 128 + tid * 4);
        }
#pragma unroll
        for (int dkt = 0; dkt < 8; ++dkt) {
            const float4 eb = *(const float4*)(EBL + dkt * 16 + fq * 4);
#pragma unroll
            for (int dvt = 0; dvt < 2; ++dvt) {
                const uint2 dd = dsr[dkt][dvt];
                f32x4 sv = dkt < 2 ? S[dkt < 2 ? dkt : 0][dvt] : SL[((dkt - 2) * 2 + dvt) * 64];
                sv[0] = fmaf(sv[0], eb.x, bflo(dd.x));
                sv[1] = fmaf(sv[1], eb.y, bfhi(dd.x));
                sv[2] = fmaf(sv[2], eb.z, bflo(dd.y));
                sv[3] = fmaf(sv[3], eb.w, bfhi(dd.y));
                if (dkt < 2) S[dkt < 2 ? dkt : 0][dvt] = sv; else SL[((dkt - 2) * 2 + dvt) * 64] = sv;
                if (more) dsr[dkt][dvt] = *(const uint2*)(DSb + (size_t)(c + 1) * 32768 + (dkt * 2 + dvt) * 512 + dsoff);
            }
        }
#pragma unroll
        for (int tt = 0; tt < 4; ++tt) {
            float ss = 0.f;
#pragma unroll
            for (int dvt = 0; dvt < 2; ++dvt)
#pragma unroll
                for (int i = 0; i < 4; ++i) ss += o[dvt][tt][i] * o[dvt][tt][i];
            ss = xsum4(ss);
            if (fq == 0) SS[wid * 64 + tt * 16 + fr] = ss;
        }
        __syncthreads();
#pragma unroll
        for (int tt = 0; tt < 4; ++tt) {
            const int t = tt * 16 + fr;
            const float tot = SS[t] + SS[64 + t] + SS[128 + t] + SS[192 + t];
            const float rs = rsqrtf(tot * (1.f / 128.f) + LN_EPS);
            const size_t tg = (size_t)b * S_ + s0 + t;
#pragma unroll
            for (int dvt = 0; dvt < 2; ++dvt) {
                const int dv = dv0 + dvt * 16 + fq * 4;
                const float r0 = o[dvt][tt][0] * rs * bflo(gg[tt][dvt].x);
                const float r1 = o[dvt][tt][1] * rs * bfhi(gg[tt][dvt].x);
                const float r2 = o[dvt][tt][2] * rs * bflo(gg[tt][dvt].y);
                const float r3 = o[dvt][tt][3] * rs * bfhi(gg[tt][dvt].y);
                *(uint2*)(OM + tg * 1024 + 512 + hh * 128 + dv) = make_uint2(pk_bf16(r0, r1), pk_bf16(r2, r3));
            }
        }
        if (more) {
#pragma unroll
            for (int i = 0; i < 4; ++i) *(u32x4*)(lds + o16 + i * 4096) = qn[i];
            if (tid < 32) *(u32x4*)(EBL + tid * 4) = ebn;
        }
        __syncthreads();
    }
}

DEV void xattn_item2(const P& p, int item) {
    const int qt64 = item & 31, hh = (item >> 5) & 3, b = item >> 7;
    const int lane = threadIdx.x & 63, wid = threadIdx.x >> 6, fr = lane & 15, fq = lane >> 4;
    const bf16_t* QX = (const bf16_t*)(p.ws + WS_QX);
    const bf16_t* KVM = (const bf16_t*)(p.ws + WS_KVM);
    const bf16_t* VMT = (const bf16_t*)(p.ws + WS_VMT) + (size_t)(b * 4 + hh) * 256 * 256;
    bf16_t* OX = (bf16_t*)(p.ws + WS_OX);
    const size_t tq = (size_t)b * S_ + qt64 * 64 + wid * 16 + fr;
    bf16x8 qf[8];
#pragma unroll
    for (int ks = 0; ks < 8; ++ks) qf[ks] = *(const bf16x8*)(QX + tq * 1024 + hh * 256 + ks * 32 + fq * 8);
    f32x4 sc[16];
#pragma unroll
    for (int kt = 0; kt < 16; ++kt) {
        f32x4 a = (f32x4){0.f, 0.f, 0.f, 0.f};
        const bf16_t* kp = KVM + (size_t)(b * ML_ + kt * 16 + fr) * 2048 + hh * 256 + fq * 8;
#pragma unroll
        for (int ks = 0; ks < 8; ++ks) a = __builtin_amdgcn_mfma_f32_16x16x32_bf16(*(const bf16x8*)(kp + ks * 32), qf[ks], a, 0, 0, 0);
        sc[kt] = a;
    }
    float mx = -1e30f;
#pragma unroll
    for (int kt = 0; kt < 16; ++kt)
#pragma unroll
        for (int i = 0; i < 4; ++i) { sc[kt][i] *= 0.0625f; mx = fmaxf(mx, sc[kt][i]); }
    mx = xmax4(mx);
    float ps = 0.f;
#pragma unroll
    for (int kt = 0; kt < 16; ++kt)
#pragma unroll
        for (int i = 0; i < 4; ++i) { sc[kt][i] = __expf(sc[kt][i] - mx); ps += sc[kt][i]; }
    ps = xsum4(ps);
    const float inv = 1.f / ps;
    u32x4 pf[8];
#pragma unroll
    for (int s = 0; s < 8; ++s) {
        pf[s][0] = pk_bf16(sc[2 * s][0] * inv, sc[2 * s][1] * inv);
        pf[s][1] = pk_bf16(sc[2 * s][2] * inv, sc[2 * s][3] * inv);
        pf[s][2] = pk_bf16(sc[2 * s + 1][0] * inv, sc[2 * s + 1][1] * inv);
        pf[s][3] = pk_bf16(sc[2 * s + 1][2] * inv, sc[2 * s + 1][3] * inv);
    }
#pragma unroll 1
    for (int dh = 0; dh < 2; ++dh) {
        f32x4 o[8];
#pragma unroll
        for (int dt = 0; dt < 8; ++dt) o[dt] = (f32x4){0.f, 0.f, 0.f, 0.f};
#pragma unroll
        for (int s = 0; s < 8; ++s) {
#pragma unroll
            for (int dt = 0; dt < 8; ++dt) {
                const bf16_t* vp = VMT + (size_t)(dh * 128 + dt * 16 + fr) * 256 + 32 * s + 4 * fq;
                o[dt] = __builtin_amdgcn_mfma_f32_16x16x32_bf16(ld2x8(vp, vp + 16), __builtin_bit_cast(bf16x8, pf[s]), o[dt], 0, 0, 0);
            }
        }
#pragma unroll
        for (int dt = 0; dt < 8; ++dt) {
            uint2 u2;
            u2.x = pk_bf16(o[dt][0], o[dt][1]);
            u2.y = pk_bf16(o[dt][2], o[dt][3]);
            *(uint2*)(OX + tq * 1024 + hh * 256 + dh * 128 + dt * 16 + fq * 4) = u2;
        }
    }
}


struct XaRegs { u32x4 r[8]; };
DEV void xa_loadK(XaRegs& x, const bf16_t* kbase, int tid) {
    const int c = tid & 31, r0 = tid >> 5;
#pragma unroll
    for (int i = 0; i < 8; ++i) x.r[i] = *(const u32x4*)(kbase + (size_t)(r0 + 8 * i) * 2048 + c * 8);
}
DEV void xa_storeK(const XaRegs& x, unsigned char* lds, int tid) {
    const int c = tid & 31, r0 = tid >> 5;
#pragma unroll
    for (int i = 0; i < 8; ++i) {
        const int row = r0 + 8 * i;
        *(u32x4*)(lds + row * 512 + ((c ^ (row & 15)) << 4)) = x.r[i];
    }
}
DEV void xa_loadV(XaRegs& x, const bf16_t* vbase, int tid) {
    const int c = tid & 7, r0 = tid >> 3;
#pragma unroll
    for (int i = 0; i < 8; ++i) x.r[i] = *(const u32x4*)(vbase + (size_t)(r0 + 32 * i) * 256 + c * 8);
}
DEV void xa_storeV(const XaRegs& x, unsigned char* lds, int tid) {
    const int c = tid & 7, r0 = tid >> 3;
    const int o = r0 * 128 + ((c ^ ((r0 >> 1) & 7)) << 4);
#pragma unroll
    for (int i = 0; i < 8; ++i) *(u32x4*)(lds + 32768 + o + i * 4096) = x.r[i];
}
DEV void xattn_item3(const P& p, int item, unsigned char* lds) {
    const int qt64 = item & 31, hh = (item >> 5) & 3, b = item >> 7;
    int tid = threadIdx.x;
    asm volatile("" : "+v"(tid));
    const int lane = tid & 63, wid = tid >> 6, fr = lane & 15, fq = lane >> 4;
    const bf16_t* QX = (const bf16_t*)(p.ws + WS_QX);
    const bf16_t* KB = (const bf16_t*)(p.ws + WS_KVM) + (size_t)(b * ML_) * 2048 + hh * 256;
    const bf16_t* VB = (const bf16_t*)(p.ws + WS_VMT) + (size_t)(b * 4 + hh) * 256 * 256;
    bf16_t* OX = (bf16_t*)(p.ws + WS_OX);
    const size_t tq = (size_t)b * S_ + qt64 * 64 + wid * 16 + fr;
    bf16x8 qf[8];
#pragma unroll
    for (int ks = 0; ks < 8; ++ks) qf[ks] = *(const bf16x8*)(QX + tq * 1024 + hh * 256 + ks * 32 + fq * 8);
    f32x4 o[16];
#pragma unroll
    for (int dt = 0; dt < 16; ++dt) o[dt] = (f32x4){0.f, 0.f, 0.f, 0.f};
    float m = -1e30f, l = 0.f;
    {
        XaRegs x;
        xa_loadK(x, KB, tid);
        xa_storeK(x, lds, tid);
        xa_loadV(x, VB, tid);
        xa_storeV(x, lds, tid);
    }
    __syncthreads();
    const int sw8 = (fr >> 1) & 7;
#pragma unroll 1
    for (int j = 0; j < 4; ++j) {
        XaRegs nx;
        if (j + 1 < 4) xa_loadK(nx, KB + (size_t)(j + 1) * 64 * 2048, tid);
        f32x4 sc[4];
#pragma unroll
        for (int kt = 0; kt < 4; ++kt) {
            f32x4 a = (f32x4){0.f, 0.f, 0.f, 0.f};
            const unsigned char* rp = lds + (kt * 16 + fr) * 512;
#pragma unroll
            for (int ks = 0; ks < 8; ++ks) a = __builtin_amdgcn_mfma_f32_16x16x32_bf16(*(const bf16x8*)(rp + (((4 * ks + fq) ^ fr) << 4)), qf[ks], a, 0, 0, 0);
            sc[kt] = a;
        }
        __syncthreads();
        if (j + 1 < 4) { xa_storeK(nx, lds, tid); xa_loadV(nx, VB + (j + 1) * 64, tid); }
        float bm = -1e30f;
#pragma unroll
        for (int kt = 0; kt < 4; ++kt)
#pragma unroll
            for (int i = 0; i < 4; ++i) { sc[kt][i] *= 0.0625f; bm = fmaxf(bm, sc[kt][i]); }
        bm = xmax4(bm);
        const float mn = fmaxf(m, bm);
        const float alpha = __expf(m - mn);
        float ps = 0.f;
#pragma unroll
        for (int kt = 0; kt < 4; ++kt)
#pragma unroll
            for (int i = 0; i < 4; ++i) { sc[kt][i] = __expf(sc[kt][i] - mn); ps += sc[kt][i]; }
        l = l * alpha + ps;
        m = mn;
#pragma unroll
        for (int dt = 0; dt < 16; ++dt) o[dt] *= alpha;
#pragma unroll
        for (int s = 0; s < 2; ++s) {
            u32x4 w;
            w[0] = pk_bf16(sc[2 * s][0], sc[2 * s][1]);
            w[1] = pk_bf16(sc[2 * s][2], sc[2 * s][3]);
            w[2] = pk_bf16(sc[2 * s + 1][0], sc[2 * s + 1][1]);
            w[3] = pk_bf16(sc[2 * s + 1][2], sc[2 * s + 1][3]);
            const bf16x8 pf = __builtin_bit_cast(bf16x8, w);
#pragma unroll
            for (int dt = 0; dt < 16; ++dt) {
                const unsigned char* rp = lds + 32768 + (dt * 16 + fr) * 128 + 8 * (fq & 1);
                const uint2 lo = *(const uint2*)(rp + (((4 * s + (fq >> 1)) ^ sw8) << 4));
                const uint2 hi = *(const uint2*)(rp + (((4 * s + 2 + (fq >> 1)) ^ sw8) << 4));
                u32x4 vv;
                vv[0] = lo.x; vv[1] = lo.y; vv[2] = hi.x; vv[3] = hi.y;
                o[dt] = __builtin_amdgcn_mfma_f32_16x16x32_bf16(__builtin_bit_cast(bf16x8, vv), pf, o[dt], 0, 0, 0);
            }
        }
        __syncthreads();
        if (j + 1 < 4) xa_storeV(nx, lds, tid);
        __syncthreads();
    }
    const float inv = 1.f / xsum4(l);
#pragma unroll
    for (int dt = 0; dt < 16; ++dt) {
        uint2 u2;
        u2.x = pk_bf16(o[dt][0] * inv, o[dt][1] * inv);
        u2.y = pk_bf16(o[dt][2] * inv, o[dt][3] * inv);
        *(uint2*)(OX + tq * 1024 + hh * 256 + dt * 16 + fq * 4) = u2;
    }
}


DEV void peer_quant_rows4(const float* src, unsigned char* dst, float* scl, int row0, int* rsum = nullptr, int bias = 128) {
    const int lane = threadIdx.x & 63;
    float4 v[4][4];
#pragma unroll
    for (int r = 0; r < 4; ++r) {
        const float* rp = src + (size_t)(row0 + r) * 1024 + lane * 16;
#pragma unroll
        for (int i = 0; i < 4; ++i) v[r][i] = *(const float4*)(rp + 4 * i);
    }
#pragma unroll
    for (int r = 0; r < 4; ++r) {
        const int row = row0 + r;
        float mx = 0.f;
#pragma unroll
        for (int i = 0; i < 4; ++i) mx = fmaxf(fmaxf(mx, fmaxf(fabsf(v[r][i].x), fabsf(v[r][i].y))), fmaxf(fabsf(v[r][i].z), fabsf(v[r][i].w)));
        mx = wmax(mx);
        const float q = mx > 0.f ? 127.f / mx : 0.f;
        u32x4 w;
        int usum = 0;
#pragma unroll
        for (int i = 0; i < 4; ++i) {
            const float e[4] = {v[r][i].x, v[r][i].y, v[r][i].z, v[r][i].w};
            unsigned pk = 0u;
#pragma unroll
            for (int k = 0; k < 4; ++k) {
                int qi = (int)rintf(e[k] * q);
                qi = qi < -127 ? -127 : (qi > 127 ? 127 : qi);
                pk |= (unsigned)((qi + bias) & 0xff) << (8 * k);
                usum += qi + 128;
            }
            w[i] = pk;
        }
        *(u32x4*)(dst + ((size_t)(lane >> 3) * 16384 + row) * 128 + (lane & 7) * 16) = w;
        if (rsum) {
#pragma unroll
            for (int o = 32; o > 0; o >>= 1) usum += __shfl_xor(usum, o);
            if (lane == 0) rsum[row] = usum;
        }
        if (lane == 0) scl[row] = mx * (1.f / 127.f);
    }
}

DEV unsigned f2ord(float f) { const unsigned b = __float_as_uint(f); return b ^ ((b >> 31) ? 0xffffffffu : 0x80000000u); }
DEV float ord2f(unsigned o) { return __uint_as_float((o & 0x80000000u) ? (o ^ 0x80000000u) : ~o); }
DEV void ins16(unsigned (&v)[16], unsigned x) {
#pragma unroll
    for (int k = 0; k < 16; ++k) {
        const unsigned t = v[k] > x ? v[k] : x;
        x = v[k] > x ? x : v[k];
        v[k] = t;
    }
}
constexpr int PEER_SC = 0;
constexpr int PEER_LST = 0;
constexpr int PEER_EID = 16384;
constexpr int PEER_GATE = 16384 + 4096;
DEV void peer_route_item(const P& p, int item, unsigned char* lds) {
    const int tid = threadIdx.x, lane = tid & 63, wid = tid >> 6;
    const int t0 = item * 16;
    const bf16_t* QP = (const bf16_t*)(p.ws + WS_QP);
    const bf16_t* PK = (const bf16_t*)(p.ws + WS_PKEY);
    unsigned* SC = (unsigned*)(lds + PEER_SC);
    const int fr = lane & 15, fq = lane >> 4;
    unsigned lst[16];
#pragma unroll
    for (int k = 0; k < 16; ++k) lst[k] = 0u;
    bf16x8 qf[4][2];
#pragma unroll
    for (int ci = 0; ci < 4; ++ci)
#pragma unroll
        for (int ks = 0; ks < 2; ++ks)
            qf[ci][ks] = *(const bf16x8*)(QP + (size_t)(t0 + fr) * 1024 + (4 * wid + ci) * 64 + ks * 32 + fq * 8);
#pragma unroll 1
    for (int pass = 0; pass < 2; ++pass) {
#pragma unroll
        for (int ci = 0; ci < 4; ++ci) {
            const int cb = 4 * wid + ci;
#pragma unroll
            for (int kt = 0; kt < 4; ++kt) {
                f32x4 acc = (f32x4){0.f, 0.f, 0.f, 0.f};
#pragma unroll
                for (int ks = 0; ks < 2; ++ks) {
                    const bf16x8 kf = *(const bf16x8*)(PK + ((size_t)cb * 128 + pass * 64 + kt * 16 + fr) * 64 + ks * 32 + fq * 8);
                    acc = __builtin_amdgcn_mfma_f32_16x16x32_bf16(kf, qf[ci][ks], acc, 0, 0, 0);
                }
                unsigned* dst = SC + (cb * 16 + fr) * 65 + kt * 16 + fq * 4;
#pragma unroll
                for (int i = 0; i < 4; ++i) {
                    const int kidx = pass * 64 + kt * 16 + fq * 4 + i;
                    dst[i] = (f2ord(acc[i]) & ~127u) | (unsigned)(127 - kidx);
                }
            }
        }
        __syncthreads();
        {
            const unsigned* row = SC + tid * 65;
#pragma unroll 4
            for (int k = 0; k < 64; ++k) ins16(lst, row[k]);
        }
        __syncthreads();
    }
    unsigned* LST = (unsigned*)(lds + PEER_LST);
#pragma unroll
    for (int k = 0; k < 16; ++k) LST[tid * 16 + k] = lst[k];
    __syncthreads();
    unsigned short* EID = (unsigned short*)(lds + PEER_EID);
    float* GATE = (float*)(lds + PEER_GATE);
    if (((tid >> 4) & 1) == 0) {
        const int tok = tid & 15, hh = tid >> 5;
        const unsigned* l2 = LST + (tid + 16) * 16;
        float s1[16], s2[16];
#pragma unroll
        for (int k = 0; k < 16; ++k) { s1[k] = ord2f(lst[k] & ~127u); s2[k] = ord2f(l2[k] & ~127u); }
        unsigned fin[16];
#pragma unroll
        for (int k = 0; k < 16; ++k) fin[k] = 0u;
#pragma unroll
        for (int i = 0; i < 16; ++i)
#pragma unroll
            for (int j = 0; j < 16; ++j)
                if ((i + 1) * (j + 1) <= 16) ins16(fin, (f2ord(s1[i] + s2[j]) & ~255u) | (unsigned)(255 - (i * 16 + j)));
        const float mx = ord2f(fin[0] & ~255u);
        float w[16], ws = 0.f;
#pragma unroll
        for (int k = 0; k < 16; ++k) { w[k] = expf(ord2f(fin[k] & ~255u) - mx); ws += w[k]; }
        const float inv = 1.f / ws;
#pragma unroll
        for (int k = 0; k < 16; ++k) {
            const int flat = 255 - (int)(fin[k] & 255u);
            const int i1 = 127 - (int)(LST[tid * 16 + (flat >> 4)] & 127u);
            const int i2 = 127 - (int)(l2[flat & 15] & 127u);
            EID[tok * 128 + hh * 16 + k] = (unsigned short)(i1 * 128 + i2);
            GATE[tok * 128 + hh * 16 + k] = w[k] * inv;
        }
    }
    __syncthreads();
    {
        unsigned short* EIDP = (unsigned short*)(p.ws + WS_EIDP);
        float* GATEP = (float*)(p.ws + WS_GATEP);
        for (int i = tid; i < 16 * 128; i += 256) {
            const int tok = i >> 7, pi = i & 127, eg = pi >> 4, k = pi & 15, slot = 8 * k + eg;
            EIDP[(size_t)(t0 + tok) * 128 + pi] = EID[tok * 128 + slot];
            GATEP[(size_t)(t0 + tok) * 128 + pi] = GATE[tok * 128 + slot];
        }
        unsigned char* XQ = p.ws + WS_XQ;
        const size_t tb = (size_t)t0 + wid * 4;
        float2 st4[4];
        u32x4 ya[4][2];
#pragma unroll
        for (int tt = 0; tt < 4; ++tt) {
            st4[tt] = ((const float2*)(p.ws + WS_ST2))[tb + tt];
            const bf16_t* row = (const bf16_t*)(p.ws + WS_YB) + (tb + tt) * 1024 + lane * 16;
            ya[tt][0] = *(const u32x4*)row;
            ya[tt][1] = *(const u32x4*)(row + 8);
        }
        float gv[16], bv[16];
#pragma unroll
        for (int i = 0; i < 4; ++i) {
            const float4 g4 = *(const float4*)(p.ln_g + 1024 + lane * 16 + 4 * i);
            const float4 b4 = *(const float4*)(p.ln_b + 1024 + lane * 16 + 4 * i);
            gv[4 * i] = g4.x; gv[4 * i + 1] = g4.y; gv[4 * i + 2] = g4.z; gv[4 * i + 3] = g4.w;
            bv[4 * i] = b4.x; bv[4 * i + 1] = b4.y; bv[4 * i + 2] = b4.z; bv[4 * i + 3] = b4.w;
        }
#pragma unroll
        for (int tt = 0; tt < 4; ++tt) {
            const size_t t = tb + tt;
            const float mean = st4[tt].x, rs = st4[tt].y;
            float xr[16];
            float amax = 0.f;
#pragma unroll
            for (int i = 0; i < 2; ++i)
#pragma unroll
                for (int q = 0; q < 4; ++q) {
                    const int j = 8 * i + 2 * q;
                    xr[j] = (bflo(ya[tt][i][q]) - mean) * rs * gv[j] + bv[j];
                    xr[j + 1] = (bfhi(ya[tt][i][q]) - mean) * rs * gv[j + 1] + bv[j + 1];
                    amax = fmaxf(amax, fmaxf(fabsf(xr[j]), fabsf(xr[j + 1])));
                }
            amax = wmax(amax);
            const float qx = amax > 0.f ? 127.f / amax : 0.f;
            u32x4 w;
            int s_ = 0;
#pragma unroll
            for (int i = 0; i < 4; ++i) {
                unsigned pk = 0u;
#pragma unroll
                for (int k = 0; k < 4; ++k) {
                    int qi = (int)rintf(xr[4 * i + k] * qx);
                    qi = qi < -127 ? -127 : (qi > 127 ? 127 : qi);
                    pk |= (unsigned)(qi + 128) << (8 * k);
                    s_ += qi + 128;
                }
                w[i] = pk;
            }
#pragma unroll
            for (int o = 32; o > 0; o >>= 1) s_ += __shfl_xor(s_, o);
            *(u32x4*)(XQ + t * 1024 + lane * 16) = w;
            if (lane == 0) {
                ((float*)(p.ws + WS_SXF))[t] = amax * (1.f / 127.f);
                ((int*)(p.ws + WS_SXI))[t] = s_;
            }
        }
    }
    __syncthreads();
}

DEV void peer_gather16(u32x4 (&rows)[16], const unsigned char* tab, const u32x4& e0, const u32x4& e1) {
#pragma unroll
    for (int k = 0; k < 16; ++k) {
        const unsigned ew = k < 8 ? e0[k >> 1] : e1[(k - 8) >> 1];
        const unsigned e = (k & 1) ? (ew >> 16) : (ew & 0xffffu);
        rows[k] = *(const u32x4*)(tab + (size_t)e * 128);
    }
}
DEV void peer_down_compute(const u32x4 (&rows)[16], const u32x4& xu, int* dst, int cg) {
    unsigned v[16];
#pragma unroll
    for (int k = 0; k < 16; ++k) {
        unsigned a_ = 0u;
#pragma unroll
        for (int q = 0; q < 4; ++q) a_ = __builtin_amdgcn_udot4(rows[k][q], xu[q], a_, false);
        v[k] = a_;
    }
    unsigned w8[8], w4[4], w2[2];
    {
        const bool hi = (cg & 4) != 0;
#pragma unroll
        for (int j = 0; j < 8; ++j) {
            const unsigned send = hi ? v[j] : v[j + 8];
            const unsigned keep = hi ? v[j + 8] : v[j];
            w8[j] = keep + (unsigned)__shfl_xor((int)send, 4);
        }
    }
    {
        const bool hi = (cg & 2) != 0;
#pragma unroll
        for (int j = 0; j < 4; ++j) {
            const unsigned send = hi ? w8[j] : w8[j + 4];
            const unsigned keep = hi ? w8[j + 4] : w8[j];
            w4[j] = keep + (unsigned)__shfl_xor((int)send, 2);
        }
    }
    {
        const bool hi = (cg & 1) != 0;
#pragma unroll
        for (int j = 0; j < 2; ++j) {
            const unsigned send = hi ? w4[j] : w4[j + 2];
            const unsigned keep = hi ? w4[j + 2] : w4[j];
            w2[j] = keep + (unsigned)__shfl_xor((int)send, 1);
        }
    }
    *(uint2*)dst = make_uint2(w2[0], w2[1]);
}
DEV void peer_down_item(const P& p, int s, int tile, int lane, int wid) {
    const int eg = lane >> 3, cg = lane & 7;
    const unsigned char* PD = p.ws + WS_PD + (size_t)s * 16384 * 128 + cg * 16;
    const size_t t0 = (size_t)tile * 32 + wid * 8;
    const unsigned short* EI = (const unsigned short*)(p.ws + WS_EIDP) + t0 * 128 + eg * 16;
    const unsigned char* XQ = p.ws + WS_XQ + t0 * 1024 + s * 128 + cg * 16;
    int* DP = (int*)(p.ws + WS_DP) + (size_t)s * T_ * 128 + t0 * 128 + eg * 16 + 2 * cg;
    u32x4 rA[16], rB[16];
    u32x4 ea0 = *(const u32x4*)EI, ea1 = *(const u32x4*)(EI + 8);
    u32x4 eb0 = *(const u32x4*)(EI + 128), eb1 = *(const u32x4*)(EI + 128 + 8);
    u32x4 xa = *(const u32x4*)XQ, xb = *(const u32x4*)(XQ + 1024);
    peer_gather16(rA, PD, ea0, ea1);
#pragma unroll 1
    for (int tt = 0; tt < 8; tt += 2) {
        peer_gather16(rB, PD, eb0, eb1);
        if (tt + 2 < 8) { ea0 = *(const u32x4*)(EI + (tt + 2) * 128); ea1 = *(const u32x4*)(EI + (tt + 2) * 128 + 8); }
        peer_down_compute(rA, xa, DP + tt * 128, cg);
        if (tt + 2 < 8) {
            xa = *(const u32x4*)(XQ + (tt + 2) * 1024);
            peer_gather16(rA, PD, ea0, ea1);
            eb0 = *(const u32x4*)(EI + (tt + 3) * 128); eb1 = *(const u32x4*)(EI + (tt + 3) * 128 + 8);
        }
        peer_down_compute(rB, xb, DP + (tt + 1) * 128, cg);
        if (tt + 2 < 8) xb = *(const u32x4*)(XQ + (tt + 3) * 1024);
    }
}

DEV void peer_coef_item(const P& p, int t, int lane) {
    const int* DP = (const int*)(p.ws + WS_DP);
    const unsigned short* EIDP = (const unsigned short*)(p.ws + WS_EIDP);
    const float* GATEP = (const float*)(p.ws + WS_GATEP);
    const float sx = ((const float*)(p.ws + WS_SXF))[t];
    const int sxu = ((const int*)(p.ws + WS_SXI))[t];
    float cf[2];
    float cm = 0.f;
#pragma unroll
    for (int h = 0; h < 2; ++h) {
        const int pi = lane + 64 * h;
        int tot = 0;
#pragma unroll
        for (int s = 0; s < 8; ++s) tot += DP[((size_t)s * T_ + t) * 128 + pi];
        const int e = EIDP[(size_t)t * 128 + pi];
        const int dotq = tot - 128 * ((const int*)(p.ws + WS_PRS))[e] - 128 * sxu + 128 * 128 * 1024;
        const float hv = ((const float*)(p.ws + WS_PSD))[e] * sx * (float)dotq;
        cf[h] = 0.5f * hv * (1.f + erff(hv * 0.7071067811865476f)) * GATEP[(size_t)t * 128 + pi] * ((const float*)(p.ws + WS_PSU))[e];
        cm = fmaxf(cm, fabsf(cf[h]));
    }
    cm = wmax(cm);
    const float qs = cm > 0.f ? 127.f / cm : 0.f;
#pragma unroll
    for (int h = 0; h < 2; ++h) {
        int qi = (int)rintf(cf[h] * qs);
        qi = qi < -127 ? -127 : (qi > 127 ? 127 : qi);
        (p.ws + WS_COEFP)[(size_t)t * 128 + lane + 64 * h] = (unsigned char)(qi & 0xff);
    }
    if (lane == 0) ((float*)(p.ws + WS_ASUM))[t] = cm * (1.f / 127.f);
}

DEV void peer_up_compute(const P& p, const u32x4 (&rows)[16], const u32x4& cq, size_t t, int col, int eg, const float2& g2, const float2& b2, bool dostore) {
    int acc[16];
#pragma unroll
    for (int i = 0; i < 16; ++i) acc[i] = 0;
#pragma unroll
    for (int g = 0; g < 4; ++g)
#pragma unroll
        for (int q = 0; q < 4; ++q) {
            const unsigned r0 = rows[4 * g][q], r1 = rows[4 * g + 1][q], r2 = rows[4 * g + 2][q], r3 = rows[4 * g + 3][q];
            const unsigned a0 = __builtin_amdgcn_perm(r1, r0, 0x05010400u), a1 = __builtin_amdgcn_perm(r1, r0, 0x07030602u);
            const unsigned b0 = __builtin_amdgcn_perm(r3, r2, 0x05010400u), b1 = __builtin_amdgcn_perm(r3, r2, 0x07030602u);
            const unsigned t0 = __builtin_amdgcn_perm(b0, a0, 0x05040100u), t1 = __builtin_amdgcn_perm(b0, a0, 0x07060302u);
            const unsigned t2 = __builtin_amdgcn_perm(b1, a1, 0x05040100u), t3 = __builtin_amdgcn_perm(b1, a1, 0x07060302u);
            acc[4 * q] = __builtin_amdgcn_sdot4((int)t0, (int)cq[g], acc[4 * q], false);
            acc[4 * q + 1] = __builtin_amdgcn_sdot4((int)t1, (int)cq[g], acc[4 * q + 1], false);
            acc[4 * q + 2] = __builtin_amdgcn_sdot4((int)t2, (int)cq[g], acc[4 * q + 2], false);
            acc[4 * q + 3] = __builtin_amdgcn_sdot4((int)t3, (int)cq[g], acc[4 * q + 3], false);
        }
    int a8[8], a4[4], a2[2];
    {
        const bool hi = (eg & 4) != 0;
#pragma unroll
        for (int j = 0; j < 8; ++j) {
            const int send = hi ? acc[j] : acc[j + 8];
            const int keep = hi ? acc[j + 8] : acc[j];
            a8[j] = keep + __shfl_xor(send, 32);
        }
    }
    {
        const bool hi = (eg & 2) != 0;
#pragma unroll
        for (int j = 0; j < 4; ++j) {
            const int send = hi ? a8[j] : a8[j + 4];
            const int keep = hi ? a8[j + 4] : a8[j];
            a4[j] = keep + __shfl_xor(send, 16);
        }
    }
    {
        const bool hi = (eg & 1) != 0;
#pragma unroll
        for (int j = 0; j < 2; ++j) {
            const int send = hi ? a4[j] : a4[j + 2];
            const int keep = hi ? a4[j + 2] : a4[j];
            a2[j] = keep + __shfl_xor(send, 8);
        }
    }
    const float cs = ((const float*)(p.ws + WS_ASUM))[t];
    const float2 st = ((const float2*)(p.ws + WS_ST2))[t];
    const unsigned xb = *(const unsigned*)((const bf16_t*)(p.ws + WS_YB) + t * 1024 + col);
    const float x0 = (bflo(xb) - st.x) * st.y * g2.x + b2.x, x1 = (bfhi(xb) - st.x) * st.y * g2.y + b2.y;
    if (dostore) *(unsigned*)((bf16_t*)(p.ws + WS_YB) + t * 1024 + col) = pk_bf16(ALPHA * x0 + cs * (float)a2[0], ALPHA * x1 + cs * (float)a2[1]);
}
DEV void peer_up_item(const P& p, int s, int tile, int lane, int wid, bool dostore = true) {
    const int eg = lane >> 3, cg = lane & 7;
    const unsigned char* PU = p.ws + WS_PU + (size_t)s * 16384 * 128 + cg * 16;
    const size_t t0 = (size_t)tile * 32 + wid * 8;
    const unsigned short* EI = (const unsigned short*)(p.ws + WS_EIDP) + t0 * 128 + eg * 16;
    const unsigned char* CQ = p.ws + WS_COEFP + t0 * 128 + eg * 16;
    const int col = s * 128 + cg * 16 + 2 * eg;
    const float2 g2 = *(const float2*)(p.ln_g + 1024 + col), b2 = *(const float2*)(p.ln_b + 1024 + col);
    u32x4 rA[16], rB[16];
    u32x4 ea0 = *(const u32x4*)EI, ea1 = *(const u32x4*)(EI + 8);
    u32x4 eb0 = *(const u32x4*)(EI + 128), eb1 = *(const u32x4*)(EI + 128 + 8);
    u32x4 ca = *(const u32x4*)CQ, cb = *(const u32x4*)(CQ + 128);
    peer_gather16(rA, PU, ea0, ea1);
#pragma unroll 1
    for (int tt = 0; tt < 8; tt += 2) {
        peer_gather16(rB, PU, eb0, eb1);
        if (tt + 2 < 8) { ea0 = *(const u32x4*)(EI + (tt + 2) * 128); ea1 = *(const u32x4*)(EI + (tt + 2) * 128 + 8); }
        peer_up_compute(p, rA, ca, t0 + tt, col, eg, g2, b2, dostore);
        if (tt + 2 < 8) {
            ca = *(const u32x4*)(CQ + (tt + 2) * 128);
            peer_gather16(rA, PU, ea0, ea1);
            eb0 = *(const u32x4*)(EI + (tt + 3) * 128); eb1 = *(const u32x4*)(EI + (tt + 3) * 128 + 8);
        }
        peer_up_compute(p, rB, cb, t0 + tt + 1, col, eg, g2, b2, dostore);
        if (tt + 2 < 8) cb = *(const u32x4*)(CQ + (tt + 3) * 128);
    }
}

DEV void ln3_item(const P& p, int t, int lane) {
    float* row = p.out + (size_t)t * 1024;
    const bf16_t* yrow = (const bf16_t*)(p.ws + WS_YB) + (size_t)t * 1024;
    float4 v[4];
    float s = 0.f;
#pragma unroll
    for (int i = 0; i < 4; ++i) {
        const uint2 u = *(const uint2*)(yrow + (i * 64 + lane) * 4);
        v[i] = make_float4(bflo(u.x), bfhi(u.x), bflo(u.y), bfhi(u.y));
        s += v[i].x + v[i].y + v[i].z + v[i].w;
    }
    const float mean = wsum(s) * (1.f / 1024.f);
    float ss = 0.f;
#pragma unroll
    for (int i = 0; i < 4; ++i) {
        v[i].x -= mean; v[i].y -= mean; v[i].z -= mean; v[i].w -= mean;
        ss += v[i].x * v[i].x + v[i].y * v[i].y + v[i].z * v[i].z + v[i].w * v[i].w;
    }
    const float rs = rsqrtf(wsum(ss) * (1.f / 1024.f) + LN_EPS);
#pragma unroll
    for (int i = 0; i < 4; ++i) {
        const int c = (i * 64 + lane) * 4;
        const float4 gg = *(const float4*)(p.ln_g + 2 * 1024 + c);
        const float4 bb = *(const float4*)(p.ln_b + 2 * 1024 + c);
        float4 o;
        o.x = v[i].x * rs * gg.x + bb.x; o.y = v[i].y * rs * gg.y + bb.y; o.z = v[i].z * rs * gg.z + bb.z; o.w = v[i].w * rs * gg.w + bb.w;
        *(float4*)(row + c) = o;
    }
}

#define XB_TMO      128
#define XB_XCNT(j)  (256  + 64 * (j))
#define XB_XSUB(j)  (1280 + 64 * (j))
#define XB_XGEN(j)  (2304 + 64 * (j))
#define XB_TOP      3328
#define XB_TOPGEN   3392
#define XCD_BAR_WORDS 3456
#define XB_SPIN_CAP (1u << 20)
#define LAS __attribute__((address_space(3)))
DEV unsigned xb_ld(unsigned* p) { return __hip_atomic_load(p, __ATOMIC_RELAXED, __HIP_MEMORY_SCOPE_AGENT); }
DEV unsigned xb_add(unsigned* p, unsigned v) { return __hip_atomic_fetch_add(p, v, __ATOMIC_RELAXED, __HIP_MEMORY_SCOPE_AGENT); }
DEV unsigned xb_xcc_id() { return (unsigned)__builtin_amdgcn_s_getreg((3 << 11) | 20) & 0xFu; }
#define XB_SPIN(cond, bar) do { unsigned _sp = 0; while (cond) { __builtin_amdgcn_s_sleep(1); \
    if ((++_sp & 255u) == 0u) { if (xb_ld(&(bar)[XB_TMO])) break; if (_sp > XB_SPIN_CAP) { atomicAdd(&(bar)[XB_TMO], 1u); break; } } } } while (0)
struct XcdBarrier { unsigned* bar; unsigned x; volatile LAS unsigned* st; };
DEV XcdBarrier xcd_barrier_post(unsigned* bar, volatile LAS unsigned* st) {
    XcdBarrier b; b.bar = bar; b.x = xb_xcc_id(); b.st = st;
    if (threadIdx.x == 0) (void)xb_add(&bar[XB_XCNT(b.x)], 1u);
    return b;
}
DEV void xcd_barrier_complete(unsigned* bar, unsigned x, unsigned& nloc, unsigned& nx) {
    const unsigned G = gridDim.x * gridDim.y * gridDim.z;
    unsigned sum, cnt, mine, sp = 0u;
    for (;;) {
        sum = 0u; cnt = 0u; mine = 0u;
#pragma unroll
        for (unsigned j = 0; j < 16; ++j) { const unsigned c = xb_ld(&bar[XB_XCNT(j)]); sum += c; cnt += (c > 0u) ? 1u : 0u; mine = (j == x) ? c : mine; }
        if (sum == G) break;
        __builtin_amdgcn_s_sleep(1);
        if ((++sp & 255u) == 0u) { if (xb_ld(&bar[XB_TMO])) break; if (sp > XB_SPIN_CAP) { atomicAdd(&bar[XB_TMO], 1u); break; } }
    }
    nloc = mine > 0u ? mine : 1u; nx = cnt > 0u ? cnt : 1u;
}
DEV void xcd_barrier(const XcdBarrier& b) {
    asm volatile("s_waitcnt vmcnt(0)" ::: "memory");
    __syncthreads();
    if (threadIdx.x == 0) {
        unsigned* bar = b.bar;
        __builtin_amdgcn_s_waitcnt(0);
        unsigned nloc = b.st[0], nx = b.st[1];
        if (nloc == 0u) { xcd_barrier_complete(bar, b.x, nloc, nx); b.st[0] = nloc; b.st[1] = nx; }
        const unsigned old = xb_add(&bar[XB_XSUB(b.x)], 1u);
        const unsigned gen = old / nloc;
        if (old + 1u == (gen + 1u) * nloc) {
            __builtin_amdgcn_fence(__ATOMIC_RELEASE, "agent");
            asm volatile("s_waitcnt vmcnt(0)" ::: "memory");
            const unsigned og = xb_add(&bar[XB_TOP], 1u);
            const unsigned tg = og / nx;
            if (og + 1u == (tg + 1u) * nx) xb_add(&bar[XB_TOPGEN], 1u);
            else XB_SPIN(xb_ld(&bar[XB_TOPGEN]) == tg, bar);
            __builtin_amdgcn_fence(__ATOMIC_ACQUIRE, "agent");
            xb_add(&bar[XB_XGEN(b.x)], 1u);
            asm volatile("s_waitcnt vmcnt(0)" ::: "memory");
        } else {
            XB_SPIN(xb_ld(&bar[XB_XGEN(b.x)]) == gen, bar);
            __builtin_amdgcn_fence(__ATOMIC_ACQUIRE, "agent");
            asm volatile("s_waitcnt vmcnt(0)" ::: "memory");
        }
    }
    __syncthreads();
}


DEV void late_transpose_item(const P& p, int it, float* smem) {
    const int m = it >> 8, t = it & 255;
    const float* W = m == 0 ? p.w_out : (m == 1 ? p.xa_wq : (m == 2 ? p.xa_wo : p.peer_wq));
    const size_t off = m == 0 ? WS_WOUT_T : (m == 1 ? WS_WQ_T : (m == 2 ? WS_WO_T : WS_PWQ_T));
    const int mat2 = m >> 1;
    if (m & 1) transpose_tile(W, 1024, (bf16_t*)(p.ws + off), t >> 4, t & 15, smem, 1024, p.ln_g + mat2 * 1024, p.ln_b + mat2 * 1024,
                              (float*)(p.ws + WS_C12) + (size_t)(mat2 * 16 + (t >> 4)) * 2048);
    else transpose_tile(W, 1024, (bf16_t*)(p.ws + off), t >> 4, t & 15, smem);
}

constexpr int WQ_WORD0 = 4096;
DEV int wq_next(unsigned* cnt, int nper, int xcc, unsigned char* lds) {
    volatile unsigned* slot = (volatile unsigned*)(lds + LDS_BYTES - 16);
    __syncthreads();
    if (threadIdx.x == 0) {
        int res = -1;
        int off = (int)slot[1];
        while (off < 8) {
            const int q = (xcc + off) & 7;
            const unsigned idx = atomicAdd(&cnt[q * 64], 1u);
            if (idx < (unsigned)nper) { res = q * nper + (int)idx; break; }
            ++off;
        }
        slot[0] = (unsigned)res;
        slot[1] = (unsigned)off;
    }
    __syncthreads();
    return (int)slot[0];
}
DEV void wq_begin(unsigned char* lds) {
    __syncthreads();
    if (threadIdx.x == 0) ((volatile unsigned*)(lds + LDS_BYTES - 16))[1] = 0u;
}

constexpr int NSTAGES = 12;
template <int ST>
DEV void run_stage(const P& p, unsigned char* lds, int xcc) {
    float* smem = (float*)lds;
    const int nb = gridDim.x, bid = blockIdx.x;
    int tidl = threadIdx.x;
    asm volatile("" : "+v"(tidl));
    const int wave = tidl >> 6;
    unsigned* wqc = (unsigned*)(p.ws + WS_BAR) + WQ_WORD0;
    if (ST == 0) {
        for (int it = bid; it < PREP_END; it += nb) prep_item(p, it, smem);
    } else if (ST == 1) {
        for (int it = bid; it < 1536 + 384 + 128; it += nb) {
            if (it < 1536) gemm_item<0>(p, it & 7, it >> 3, lds);
            else if (it < 1920) { const int i2 = it - 1536, q = i2 & 7, j = i2 >> 3; gemm_mfma_tile<0>(p, q * 16 + (j & 15), 24 + (j >> 4), lds); }
            else gemm_item<1>(p, (it - 1920) & 7, (it - 1920) >> 3, lds);
        }
    } else if (ST == 2) {
        if (PROBE_REP == 21) for (int it = bid; it < 256; it += nb) compress_item2(p, it, lds);
        if (PROBE_REP == 22) for (int it = bid; it < 1024; it += nb) hgrn_prep_item(p, it, smem);
        for (int it = bid; it < 256 + 1024; it += nb) {
            if (it < 256) compress_item2(p, it, lds);
            else hgrn_prep_item2(p, it - 256, lds);
        }
    } else if (ST == 3) {
        if (PROBE_REP == 31) { for (int it = bid; it < 32; it += nb) hgrn_chain_item(p, it, lds); }
        if (PROBE_REP == 32) {
            volatile unsigned* qs2 = (volatile unsigned*)(lds + LDS_BYTES - 16);
            for (;;) {
                __syncthreads();
                if (threadIdx.x == 0) *qs2 = atomicAdd(wqc + 64, 1u);
                __syncthreads();
                const int j = (int)*qs2;
                if (j >= 1024) break;
                nsa_item2(p, (j & 15) >> 1, j & 1, 63 - (j >> 4), lds, p.out != nullptr ? 4 : 0);
            }
        }
        volatile unsigned* qslot = (volatile unsigned*)(lds + LDS_BYTES - 16);
        for (;;) {
            __syncthreads();
            if (threadIdx.x == 0) *qslot = atomicAdd(wqc, 1u);
            __syncthreads();
            const int it = (int)*qslot;
            if (it >= 32 + 1024) break;
            if (it < 32) hgrn_chain_item2(p, it, lds);
            else { const int j = it - 32; nsa_item2(p, (j & 15) >> 1, j & 1, 63 - (j >> 4), lds); }
        }
        for (;;) {
            __syncthreads();
            if (threadIdx.x == 0) *qslot = atomicAdd(wqc + 128, 1u);
            __syncthreads();
            const int it = (int)*qslot;
            if (it >= 2048) break;
            if (it < 1024) late_transpose_item(p, it, smem);
            else {
                const int j = it - 1024, tb = j >> 9, r0 = (j & 511) * 32 + wave * 8;
                for (int r = 0; r < 8; r += 4) {
                    if (tb == 0) peer_quant_rows4(p.peer_down, p.ws + WS_PD, (float*)(p.ws + WS_PSD), r0 + r, (int*)(p.ws + WS_PRS));
                    else peer_quant_rows4(p.peer_up, p.ws + WS_PU, (float*)(p.ws + WS_PSU), r0 + r, nullptr, 0);
                }
            }
        }
    } else if (ST == 4) {
        for (int it = bid; it < 512; it += nb) gemm_item<2>(p, it & 7, it >> 3, lds);
    } else if (ST == 5) {
        for (int it = bid; it < T_ / 4; it += nb) ln_item(p, it * 4 + wave, 0, tidl & 63);
    } else if (ST == 9) {
        for (int it = bid; it < T_ / 4; it += nb) ln_item(p, it * 4 + wave, 1, tidl & 63);
    } else if (ST == 6) {
        for (int it = bid; it < 512; it += nb) gemm_item<3>(p, it & 7, it >> 3, lds);
    } else if (ST == 7) {
        for (int it = bid; it < 1024; it += nb) xattn_item3(p, it, lds);
    } else if (ST == 8) {
        for (int it = bid; it < 512; it += nb) gemm_item<4>(p, it & 7, it >> 3, lds);
    } else if (ST == 10) {
        for (int it = bid; it < 512; it += nb) gemm_item<5>(p, it & 7, it >> 3, lds);
    } else if (ST == 11) {
        if (PROBE_REP == 11) for (int it = bid; it < T_ / 16; it += nb) peer_route_item(p, it, lds);
        for (int it = bid; it < T_ / 16; it += nb) peer_route_item(p, it, lds);
    } else if (ST == 12) {
        if (PROBE_REP == 12) { wq_begin(lds); for (int it; (it = wq_next(wqc + 4 * 512, 512, xcc, lds)) >= 0;) peer_down_item(p, it >> 9, it & 511, tidl & 63, wave); }
        wq_begin(lds);
        for (int it; (it = wq_next(wqc + 2 * 512, 512, xcc, lds)) >= 0;) peer_down_item(p, it >> 9, it & 511, tidl & 63, wave);
    } else if (ST == 13) {
        if (PROBE_REP == 13) for (int it = bid; it < T_ / 4; it += nb) peer_coef_item(p, it * 4 + wave, tidl & 63);
        for (int it = bid; it < T_ / 4; it += nb) peer_coef_item(p, it * 4 + wave, tidl & 63);
    } else if (ST == 14) {
        if (PROBE_REP == 14) { wq_begin(lds); for (int it; (it = wq_next(wqc + 5 * 512, 512, xcc, lds)) >= 0;) peer_up_item(p, it >> 9, it & 511, tidl & 63, wave, p.out == nullptr); }
        wq_begin(lds);
        for (int it; (it = wq_next(wqc + 3 * 512, 512, xcc, lds)) >= 0;) peer_up_item(p, it >> 9, it & 511, tidl & 63, wave);
    } else if (ST == 15) {
        for (int it = bid; it < T_ / 4; it += nb) ln3_item(p, it * 4 + wave, tidl & 63);
    }
}

template <int ST>
__global__ void __launch_bounds__(256, 2) stage_kernel(P p) {
    __shared__ __attribute__((aligned(16))) unsigned char lds[LDS_BYTES + 16];
    run_stage<ST>(p, lds, (int)xb_xcc_id() & 7);
}

__global__ void __launch_bounds__(256, 2) mega_kernel(P p) {
    __shared__ __attribute__((aligned(16))) unsigned char lds[LDS_BYTES + 16];
    if (threadIdx.x == 0) *(uint4*)(lds + LDS_BYTES) = make_uint4(0u, 0u, 0u, 0u);
    __syncthreads();
    const XcdBarrier xb = xcd_barrier_post((unsigned*)(p.ws + WS_BAR), (volatile LAS unsigned*)(lds + LDS_BYTES));
    const int xcc = (int)xb.x & 7;
    run_stage<0>(p, lds, xcc); xcd_barrier(xb);
    if (PROBE_REP == 0) { run_stage<0>(p, lds, xcc); xcd_barrier(xb); }
    run_stage<1>(p, lds, xcc); xcd_barrier(xb);
    if (PROBE_REP == 1) { run_stage<1>(p, lds, xcc); xcd_barrier(xb); }
    run_stage<2>(p, lds, xcc); xcd_barrier(xb);
    if (PROBE_REP == 2) { run_stage<2>(p, lds, xcc); xcd_barrier(xb); }
    if (PROBE_REP == 35) { if (blockIdx.x < 32) hgrn_chain_item2(p, blockIdx.x, lds); xcd_barrier(xb); }
    run_stage<3>(p, lds, xcc); xcd_barrier(xb);
    run_stage<4>(p, lds, xcc); xcd_barrier(xb);
    if (PROBE_REP == 4) { run_stage<4>(p, lds, xcc); xcd_barrier(xb); }
    if (PROBE_REP == 50) { xcd_barrier(xb); xcd_barrier(xb); xcd_barrier(xb); xcd_barrier(xb); xcd_barrier(xb); xcd_barrier(xb); xcd_barrier(xb); xcd_barrier(xb); }
    run_stage<6>(p, lds, xcc); xcd_barrier(xb);
    if (PROBE_REP == 6) { run_stage<6>(p, lds, xcc); xcd_barrier(xb); }
    run_stage<7>(p, lds, xcc); xcd_barrier(xb);
    if (PROBE_REP == 7) { run_stage<7>(p, lds, xcc); xcd_barrier(xb); }
    run_stage<8>(p, lds, xcc); xcd_barrier(xb);
    run_stage<10>(p, lds, xcc); xcd_barrier(xb);
    if (PROBE_REP == 10) { run_stage<10>(p, lds, xcc); xcd_barrier(xb); }
    run_stage<11>(p, lds, xcc); xcd_barrier(xb);
    run_stage<12>(p, lds, xcc); xcd_barrier(xb);
    run_stage<13>(p, lds, xcc); xcd_barrier(xb);
    run_stage<14>(p, lds, xcc); xcd_barrier(xb);
    run_stage<15>(p, lds, xcc);
}

extern "C" void kernel_launch(void* const* d_in, const int* in_sizes, int n_in, void* d_out, int out_size, void* d_ws, size_t ws_size,
                              hipStream_t stream) {
    if (n_in != 18 || ws_size < WS_END) {
        fprintf(stderr, "kernel_launch: unexpected inputs (n_in %d, ws %zu, need %zu)\n", n_in, ws_size, (size_t)WS_END);
        return;
    }
    P p{};
    p.x = (const float*)d_in[0]; p.mem = (const float*)d_in[1]; p.w_in = (const float*)d_in[2]; p.cmp_pos = (const float*)d_in[3];
    p.cmp_w1 = (const float*)d_in[4]; p.cmp_w2 = (const float*)d_in[5]; p.lb_logits = (const float*)d_in[6];
    p.hg_norm_w = (const float*)d_in[7]; p.w_out = (const float*)d_in[8]; p.xa_wq = (const float*)d_in[9];
    p.xa_wkv = (const float*)d_in[10]; p.xa_wo = (const float*)d_in[11]; p.peer_wq = (const float*)d_in[12];
    p.peer_keys = (const float*)d_in[13]; p.peer_down = (const float*)d_in[14]; p.peer_up = (const float*)d_in[15];
    p.ln_g = (const float*)d_in[16]; p.ln_b = (const float*)d_in[17];
    p.out = (float*)d_out; p.ws = (unsigned char*)d_ws;
#if ONE_LAUNCH
    static int grid_blocks = 0;
    if (!grid_blocks) {
        int dev = 0, cus = 0, per_cu = 0;
        hipGetDevice(&dev);
        hipDeviceGetAttribute(&cus, hipDeviceAttributeMultiprocessorCount, dev);
        hipOccupancyMaxActiveBlocksPerMultiprocessor(&per_cu, mega_kernel, 256, 0);
        if (per_cu > 2) per_cu = 2;
        if (per_cu < 1) per_cu = 1;
        grid_blocks = cus * per_cu;
    }
    (void)hipMemsetAsync((unsigned char*)d_ws + WS_BAR, 0, 65536, stream);
    void* args[] = {&p};
    hipError_t e = hipLaunchCooperativeKernel((void*)mega_kernel, dim3(grid_blocks), dim3(256), args, 0, stream);
    if (e != hipSuccess) fprintf(stderr, "cooperative launch failed: %s (grid %d)\n", hipGetErrorString(e), grid_blocks);
#else
    const int G = 2048;
    stage_kernel<0><<<G, 256, 0, stream>>>(p);
    stage_kernel<1><<<G, 256, 0, stream>>>(p);
    stage_kernel<2><<<G, 256, 0, stream>>>(p);
    stage_kernel<3><<<G, 256, 0, stream>>>(p);
    stage_kernel<4><<<G, 256, 0, stream>>>(p);
    stage_kernel<5><<<G, 256, 0, stream>>>(p);
    stage_kernel<6><<<G, 256, 0, stream>>>(p);
    stage_kernel<7><<<G, 256, 0, stream>>>(p);
    stage_kernel<8><<<G, 256, 0, stream>>>(p);
    stage_kernel<9><<<G, 256, 0, stream>>>(p);
    stage_kernel<10><<<G, 256, 0, stream>>>(p);
    stage_kernel<11><<<G, 256, 0, stream>>>(p);
#endif
}
```

```cpp
#include <hip/hip_runtime.h>
#include <hip/hip_cooperative_groups.h>
#include <cstdio>
#include <cstdint>
namespace cg = cooperative_groups;

#ifndef PROBE_REP
#define PROBE_REP -1
#endif
#ifndef ONE_LAUNCH
#define ONE_LAUNCH 1
#endif

typedef unsigned short bf16_t;
#define DEV __device__ __forceinline__

constexpr int D_ = 1024, B_ = 8, S_ = 2048, T_ = B_ * S_, ML_ = 256, INC = 3352;
constexpr int NCMP = 127;
constexpr int LDS_BYTES = 67584;
constexpr float ALPHA = 1.189207115002721f;
constexpr float LN_EPS = 1e-5f;
constexpr int C_QA = 0, C_KC = 512, C_VC = 640, C_KS = 768, C_VS = 896, C_KW = 1024, C_VW = 1152, C_GATE = 1280,
              C_HQ = 1304, C_HF = 1816, C_HI = 2328, C_HG = 2840;
constexpr size_t WS_HB = 0;
constexpr size_t SZ_HB = (size_t)T_ * INC * 2;
constexpr size_t WS_OM = WS_HB + SZ_HB;
constexpr size_t WS_KVM = WS_OM + (size_t)T_ * 1024 * 2;
constexpr size_t WS_KC = WS_KVM + (size_t)2048 * 2048 * 2;
constexpr size_t WS_XB = WS_KC + (1u << 20);
constexpr size_t WS_WIN_T = WS_XB + (size_t)T_ * 1024 * 2;
constexpr size_t WS_WOUT_T = WS_WIN_T + (size_t)3456 * 1024 * 2;
constexpr size_t WS_WQ_T = WS_WOUT_T + (size_t)1024 * 1024 * 2;
constexpr size_t WS_WKV_T = WS_WQ_T + (size_t)1024 * 1024 * 2;
constexpr size_t WS_WO_T = WS_WKV_T + (size_t)2048 * 1024 * 2;
constexpr size_t WS_PWQ_T = WS_WO_T + (size_t)1024 * 1024 * 2;
constexpr size_t WS_MEMB = WS_PWQ_T + (size_t)1024 * 1024 * 2;
constexpr size_t WS_PKEY = WS_MEMB + (size_t)2048 * 1024 * 2;
constexpr size_t WS_VT = WS_PKEY + (size_t)16 * 128 * 64 * 2;
constexpr size_t WS_KCB = WS_VT + (size_t)2 * B_ * 2 * 64 * 2048 * 2;
constexpr size_t WS_VCT = WS_KCB + (size_t)B_ * 2 * 128 * 64 * 2;
constexpr size_t WS_W1T = WS_VCT + (size_t)B_ * 2 * 128 * 64 * 2;
constexpr size_t WS_W2T = WS_W1T + (size_t)2 * 128 * 2048 * 2;
constexpr size_t WS_CB = WS_W2T + (size_t)2 * 64 * 128 * 2;
constexpr size_t WS_VMT = WS_CB + 1024;
constexpr size_t WS_BAR = WS_VMT + (size_t)B_ * 4 * 256 * 256 * 2;
constexpr size_t WS_PD = WS_BAR + 65536;
constexpr size_t WS_PU = WS_PD + (size_t)16384 * 1024;
constexpr size_t WS_PSD = WS_PU + (size_t)16384 * 1024;
constexpr size_t WS_PSU = WS_PSD + 65536;
constexpr size_t WS_PRS = WS_PSU + 65536;
constexpr size_t WS_LNP1 = WS_PRS + 65536;
constexpr size_t WS_LNP2 = WS_LNP1 + (size_t)T_ * 16 * 8;
constexpr size_t WS_ST2 = WS_LNP2 + (size_t)T_ * 16 * 8;
constexpr size_t WS_C12 = WS_ST2 + (size_t)T_ * 8;
constexpr size_t WS_SSP = WS_C12 + 262144;
constexpr size_t WS_END = WS_SSP + (size_t)32 * 8 * 2048 * 4;
static_assert(WS_END <= (size_t)268435456, "workspace budget");
constexpr size_t WS_EB = WS_KC;
constexpr size_t HS_QT = 0;
constexpr size_t HS_KT = (size_t)B_ * 4 * 2048 * 128 * 2;
constexpr size_t HS_KHT = 2 * HS_KT;
constexpr size_t HS_VIT = 3 * HS_KT;
constexpr size_t HS_DS = HS_KT;
constexpr size_t HS_OI = 3 * HS_KT;
constexpr size_t WS_QX = 67108864;
constexpr size_t WS_OX = (size_t)T_ * 1024 * 2;
constexpr size_t WS_QP = 104857600;
constexpr size_t WS_YB = 0;
constexpr size_t WS_EIDP = (size_t)T_ * 1024 * 2;
constexpr size_t WS_GATEP = WS_EIDP + (size_t)T_ * 128 * 2;
constexpr size_t WS_COEFP = WS_GATEP + (size_t)T_ * 128 * 4;
constexpr size_t WS_XQ = WS_COEFP + (size_t)T_ * 128 * 4;
constexpr size_t WS_SXF = WS_XQ + (size_t)T_ * 1024;
constexpr size_t WS_SXI = WS_SXF + (size_t)T_ * 4;
constexpr size_t WS_ASUM = WS_SXI + (size_t)T_ * 4;
constexpr size_t WS_DP = WS_ASUM + (size_t)T_ * 4;
static_assert(WS_DP + (size_t)8 * T_ * 128 * 4 <= WS_KVM, "PEER intermediates must fit in the dead h/OM region");

struct P {
    const float *x, *mem, *w_in, *cmp_pos, *cmp_w1, *cmp_w2, *lb_logits, *hg_norm_w, *w_out, *xa_wq, *xa_wkv, *xa_wo,
        *peer_wq, *peer_keys, *peer_down, *peer_up, *ln_g, *ln_b;
    float* out;
    unsigned char* ws;
};

DEV unsigned short f2bf(float f) {
    unsigned u = __float_as_uint(f);
    u += 0x7fffu + ((u >> 16) & 1u);
    return (unsigned short)(u >> 16);
}
DEV float bf2f(unsigned short h) { return __uint_as_float(((unsigned)h) << 16); }
DEV float bflo(unsigned u) { return __uint_as_float(u << 16); }
DEV float bfhi(unsigned u) { return __uint_as_float(u & 0xffff0000u); }
typedef __bf16 bf16x2_t __attribute__((ext_vector_type(2)));
typedef float f32x2_t __attribute__((ext_vector_type(2)));
DEV unsigned pk_bf16(float a, float b) {
    f32x2_t v = {a, b};
    bf16x2_t r = __builtin_convertvector(v, bf16x2_t);
    return __builtin_bit_cast(unsigned, r);
}
DEV float wsum(float v) {
#pragma unroll
    for (int o = 32; o > 0; o >>= 1) v += __shfl_xor(v, o);
    return v;
}
DEV float wmax(float v) {
#pragma unroll
    for (int o = 32; o > 0; o >>= 1) v = fmaxf(v, __shfl_xor(v, o));
    return v;
}
DEV float sigmoidf_(float x) { return 1.f / (1.f + expf(-x)); }
DEV float fsigmoid(float x) { return __fdividef(1.f, 1.f + __expf(-x)); }

template <int MODE>
DEV void gemm_tile(const P& p, int tile, float* smem) {
    constexpr bool ABF = (MODE == 2 || MODE == 4);
    constexpr int K = 1024;
    constexpr int N = MODE == 0 ? INC : (MODE == 1 ? 2048 : 1024);
    constexpr int NTN = (N + 63) / 64;
    const int tm = tile / NTN, tn = tile % NTN;
    const float* Af = nullptr;
    const bf16_t* Ab = nullptr;
    const float* Bm = nullptr;
    if (MODE == 0) { Af = p.x; Bm = p.w_in; }
    if (MODE == 1) { Af = p.mem; Bm = p.xa_wkv; }
    if (MODE == 2) { Ab = (const bf16_t*)(p.ws + WS_OM); Bm = p.w_out; }
    if (MODE == 3) { Af = p.out; Bm = p.xa_wq; }
    if (MODE == 4) { Ab = (const bf16_t*)(p.ws + WS_OX); Bm = p.xa_wo; }
    if (MODE == 5) { Af = p.out; Bm = p.peer_wq; }
    float(*sA)[68] = (float(*)[68])smem;
    float(*sB)[68] = (float(*)[68])(smem + 16 * 68);
    const int tid = threadIdx.x, tx = tid & 15, ty = tid >> 4;
    const int ar = tid >> 2, ak = (tid & 3) * 4;
    const int bk = tid >> 4, bn = (tid & 15) * 4;
    float acc[4][4];
#pragma unroll
    for (int i = 0; i < 4; ++i)
#pragma unroll
        for (int j = 0; j < 4; ++j) acc[i][j] = 0.f;
    const int gn = tn * 64 + bn;
    for (int k0 = 0; k0 < K; k0 += 16) {
        float4 av;
        if (ABF) {
            uint2 u = *(const uint2*)(Ab + (size_t)(tm * 64 + ar) * K + k0 + ak);
            av.x = bflo(u.x); av.y = bfhi(u.x); av.z = bflo(u.y); av.w = bfhi(u.y);
        } else {
            av = *(const float4*)(Af + (size_t)(tm * 64 + ar) * K + k0 + ak);
        }
        float4 bv = make_float4(0.f, 0.f, 0.f, 0.f);
        if (gn < N) bv = *(const float4*)(Bm + (size_t)(k0 + bk) * N + gn);
        sA[ak + 0][ar] = av.x; sA[ak + 1][ar] = av.y; sA[ak + 2][ar] = av.z; sA[ak + 3][ar] = av.w;
        *(float4*)&sB[bk][bn] = bv;
        __syncthreads();
#pragma unroll
        for (int kk = 0; kk < 16; ++kk) {
            float4 a = *(const float4*)&sA[kk][ty * 4];
            float4 b = *(const float4*)&sB[kk][tx * 4];
            float aa[4] = {a.x, a.y, a.z, a.w}, bb[4] = {b.x, b.y, b.z, b.w};
#pragma unroll
            for (int i = 0; i < 4; ++i)
#pragma unroll
                for (int j = 0; j < 4; ++j) acc[i][j] += aa[i] * bb[j];
        }
        __syncthreads();
    }
    const int col = tn * 64 + tx * 4;
#pragma unroll
    for (int i = 0; i < 4; ++i) {
        const size_t row = (size_t)tm * 64 + ty * 4 + i;
        if (MODE == 0 || MODE == 1 || MODE == 3) {
            bf16_t* O = (bf16_t*)(p.ws + (MODE == 0 ? WS_HB : (MODE == 1 ? WS_KVM : WS_QX)));
            if (col < N) {
                uint2 u;
                u.x = (unsigned)f2bf(acc[i][0]) | ((unsigned)f2bf(acc[i][1]) << 16);
                u.y = (unsigned)f2bf(acc[i][2]) | ((unsigned)f2bf(acc[i][3]) << 16);
                *(uint2*)(O + row * N + col) = u;
            }
        } else if (MODE == 2) {
            float4 xv = *(const float4*)(p.x + row * 1024 + col);
            float4 o = make_float4(ALPHA * xv.x + acc[i][0], ALPHA * xv.y + acc[i][1], ALPHA * xv.z + acc[i][2], ALPHA * xv.w + acc[i][3]);
            *(float4*)(p.out + row * 1024 + col) = o;
        } else if (MODE == 4) {
            float4 xv = *(const float4*)(p.out + row * 1024 + col);
            float4 o = make_float4(ALPHA * xv.x + acc[i][0], ALPHA * xv.y + acc[i][1], ALPHA * xv.z + acc[i][2], ALPHA * xv.w + acc[i][3]);
            *(float4*)(p.out + row * 1024 + col) = o;
        } else {
            float* O = (float*)(p.ws + WS_QP);
            *(float4*)(O + row * 1024 + col) = make_float4(acc[i][0], acc[i][1], acc[i][2], acc[i][3]);
        }
    }
}


using bf16x8 = __attribute__((ext_vector_type(8))) short;
using f32x4 = __attribute__((ext_vector_type(4))) float;
using u32x4 = __attribute__((ext_vector_type(4))) unsigned;

template <int MODE>
DEV void gemm_mfma_tile(const P& p, int tm, int tn, unsigned char* lds) {
    const bf16_t* A;
    const bf16_t* W;
    if (MODE == 0) { A = (const bf16_t*)(p.ws + WS_XB); W = (const bf16_t*)(p.ws + WS_WIN_T); }
    if (MODE == 1) { A = (const bf16_t*)(p.ws + WS_MEMB); W = (const bf16_t*)(p.ws + WS_WKV_T); }
    if (MODE == 2) { A = (const bf16_t*)(p.ws + WS_OM); W = (const bf16_t*)(p.ws + WS_WOUT_T); }
    if (MODE == 3) { A = (const bf16_t*)(p.ws + WS_XB); W = (const bf16_t*)(p.ws + WS_WQ_T); }
    if (MODE == 4) { A = (const bf16_t*)(p.ws + WS_OX); W = (const bf16_t*)(p.ws + WS_WO_T); }
    if (MODE == 5) { A = (const bf16_t*)(p.ws + WS_XB); W = (const bf16_t*)(p.ws + WS_PWQ_T); }
    const int tid = threadIdx.x, lane = tid & 63, wid = tid >> 6, wm = wid >> 1, wn = wid & 1;
    const int m0 = tm * 128, n0 = tn * 128;
    const bf16_t* ga[2];
    const bf16_t* gw[2];
#pragma unroll
    for (int i = 0; i < 2; ++i) {
        const int r = (wid * 2 + i) * 16 + (lane >> 2);
        const int gsw = (0x1320 >> (((r >> 2) & 3) * 4)) & 3;
        const int c = (lane & 3) ^ gsw;
        ga[i] = A + (size_t)(m0 + r) * 1024 + c * 8;
        gw[i] = W + (size_t)(n0 + r) * 1024 + c * 8;
    }
    unsigned char* lbase = lds + wid * 2048;
#define GEMM_STAGE(slot, kt)                                                                                                   \
    do {                                                                                                                       \
        _Pragma("unroll") for (int i = 0; i < 2; ++i) {                                                                        \
            __builtin_amdgcn_global_load_lds((const unsigned*)(ga[i] + (kt) * 32), (unsigned*)(lbase + (slot) * 16384 + i * 1024), 16, 0, 0);         \
            __builtin_amdgcn_global_load_lds((const unsigned*)(gw[i] + (kt) * 32), (unsigned*)(lbase + (slot) * 16384 + 8192 + i * 1024), 16, 0, 0);  \
        }                                                                                                                      \
    } while (0)
    asm volatile("s_waitcnt vmcnt(0)" ::: "memory");
    GEMM_STAGE(0, 0);
    GEMM_STAGE(1, 1);
    GEMM_STAGE(2, 2);
    f32x4 acc[4][4];
#pragma unroll
    for (int i = 0; i < 4; ++i)
#pragma unroll
        for (int j = 0; j < 4; ++j) acc[i][j] = (f32x4){0.f, 0.f, 0.f, 0.f};
    const int fr = lane & 15, fq = lane >> 4;
    const int fsw = (0x1320 >> (((fr >> 2) & 3) * 4)) & 3;
    const int aoff = (wm * 64 + fr) * 64 + ((fq ^ fsw) << 4);
    const int boff = 8192 + (wn * 64 + fr) * 64 + ((fq ^ fsw) << 4);
#define GEMM_COMPUTE(slot)                                                                                                     \
    do {                                                                                                                       \
        const unsigned char* sb = lds + (slot) * 16384;                                                                        \
        bf16x8 af[4], wf[4];                                                                                                   \
        _Pragma("unroll") for (int t = 0; t < 4; ++t) {                                                                        \
            af[t] = *(const bf16x8*)(sb + aoff + t * 1024);                                                                    \
            wf[t] = *(const bf16x8*)(sb + boff + t * 1024);                                                                    \
        }                                                                                                                      \
        _Pragma("unroll") for (int nt = 0; nt < 4; ++nt)                                                                       \
            _Pragma("unroll") for (int mt = 0; mt < 4; ++mt)                                                                   \
                acc[nt][mt] = __builtin_amdgcn_mfma_f32_16x16x32_bf16(wf[nt], af[mt], acc[nt][mt], 0, 0, 0);                   \
    } while (0)
#pragma unroll 1
    for (int kt = 0; kt < 29; ++kt) {
        asm volatile("s_waitcnt vmcnt(8)\n\ts_waitcnt lgkmcnt(0)" ::: "memory");
        __builtin_amdgcn_s_barrier(); asm volatile("" ::: "memory");
        GEMM_STAGE((kt + 3) & 3, kt + 3);
        GEMM_COMPUTE(kt & 3);
    }
    asm volatile("s_waitcnt vmcnt(8)\n\ts_waitcnt lgkmcnt(0)" ::: "memory");
    __builtin_amdgcn_s_barrier(); asm volatile("" ::: "memory");
    GEMM_COMPUTE(29 & 3);
    asm volatile("s_waitcnt vmcnt(4)\n\ts_waitcnt lgkmcnt(0)" ::: "memory");
    __builtin_amdgcn_s_barrier(); asm volatile("" ::: "memory");
    GEMM_COMPUTE(30 & 3);
    asm volatile("s_waitcnt vmcnt(0)\n\ts_waitcnt lgkmcnt(0)" ::: "memory");
    __builtin_amdgcn_s_barrier(); asm volatile("" ::: "memory");
    GEMM_COMPUTE(31 & 3);
    asm volatile("s_waitcnt lgkmcnt(0)" ::: "memory");
    __builtin_amdgcn_s_barrier(); asm volatile("" ::: "memory");
#undef GEMM_STAGE
#undef GEMM_COMPUTE
#pragma unroll
    for (int mt = 0; mt < 4; ++mt) {
        const size_t m = (size_t)m0 + wm * 64 + mt * 16 + fr;
#pragma unroll
        for (int nt = 0; nt < 4; ++nt) {
            const int n = n0 + wn * 64 + nt * 16 + fq * 4;
            const f32x4 c = acc[nt][mt];
            if (MODE == 0 || MODE == 1 || MODE == 3 || MODE == 5) {
                constexpr int NS = MODE == 0 ? INC : (MODE == 1 ? 2048 : 1024);
                bf16_t* O = (bf16_t*)(p.ws + (MODE == 0 ? WS_HB : (MODE == 1 ? WS_KVM : (MODE == 3 ? WS_QX : WS_QP))));
                if (MODE == 1 && tn >= 8) {
                    bf16_t* VMT = (bf16_t*)(p.ws + WS_VMT);
                    const int nn = n - 1024;
                    const size_t base = (((size_t)(m >> 8) * 4 + (nn >> 8)) * 256 + (nn & 255)) * 256 + (m & 255);
#pragma unroll
                    for (int i = 0; i < 4; ++i) VMT[base + (size_t)i * 256] = f2bf(c[i]);
                } else if (MODE == 0 && (tn == 7 || tn == 9)) {
                    bf16_t* VT = (bf16_t*)(p.ws + WS_VT);
                    const int which = tn == 9 ? 1 : 0;
                    const size_t base = ((((size_t)which * B_ + (m >> 11)) * 2 + wn) * 64 + nt * 16 + fq * 4) * 2048 + (m & 2047);
#pragma unroll
                    for (int i = 0; i < 4; ++i) VT[base + (size_t)i * 2048] = f2bf(c[i]);
                } else if (MODE != 0 || n < INC) {
                    uint2 u;
                    u.x = pk_bf16(c[0], c[1]);
                    u.y = pk_bf16(c[2], c[3]);
                    *(uint2*)(O + m * NS + n) = u;
                }
            } else if (MODE == 2) {
                const float4 xv = *(const float4*)(p.x + m * 1024 + n);
                *(uint2*)((bf16_t*)(p.ws + WS_YB) + m * 1024 + n) = make_uint2(pk_bf16(ALPHA * xv.x + c[0], ALPHA * xv.y + c[1]), pk_bf16(ALPHA * xv.z + c[2], ALPHA * xv.w + c[3]));
            } else if (MODE == 4) {
                const uint2 xb = *(const uint2*)((const bf16_t*)(p.ws + WS_XB) + m * 1024 + n);
                *(uint2*)((bf16_t*)(p.ws + WS_YB) + m * 1024 + n) = make_uint2(pk_bf16(ALPHA * bflo(xb.x) + c[0], ALPHA * bfhi(xb.x) + c[1]), pk_bf16(ALPHA * bflo(xb.y) + c[2], ALPHA * bfhi(xb.y) + c[3]));
            }
        }
    }
}


template <int MODE>
DEV void gemm_mfma_tile256(const P& p, int tm, int tn, unsigned char* lds) {
    const bf16_t* A;
    const bf16_t* W;
    if (MODE == 0) { A = (const bf16_t*)(p.ws + WS_XB); W = (const bf16_t*)(p.ws + WS_WIN_T); }
    if (MODE == 1) { A = (const bf16_t*)(p.ws + WS_MEMB); W = (const bf16_t*)(p.ws + WS_WKV_T); }
    if (MODE == 2) { A = (const bf16_t*)(p.ws + WS_OM); W = (const bf16_t*)(p.ws + WS_WOUT_T); }
    if (MODE == 3) { A = (const bf16_t*)(p.ws + WS_YB); W = (const bf16_t*)(p.ws + WS_WQ_T); }
    if (MODE == 4) { A = (const bf16_t*)(p.ws + WS_OX); W = (const bf16_t*)(p.ws + WS_WO_T); }
    if (MODE == 5) { A = (const bf16_t*)(p.ws + WS_YB); W = (const bf16_t*)(p.ws + WS_PWQ_T); }
    int tid = threadIdx.x;
    asm volatile("" : "+v"(tid));
    const int lane = tid & 63, wid = tid >> 6, wm = wid >> 1, wn = wid & 1;
    const int m0 = tm * 256, n0 = tn * 128;
    float2* STL = (float2*)(lds + 49152);
    const bf16_t* ga[4];
    const bf16_t* gw[2];
#pragma unroll
    for (int i = 0; i < 4; ++i) {
        const int r = (wid * 4 + i) * 16 + (lane >> 2);
        const int gsw = (0x1320 >> (((r >> 2) & 3) * 4)) & 3;
        ga[i] = A + (size_t)(m0 + r) * 1024 + ((lane & 3) ^ gsw) * 8;
    }
#pragma unroll
    for (int i = 0; i < 2; ++i) {
        const int r = (wid * 2 + i) * 16 + (lane >> 2);
        const int gsw = (0x1320 >> (((r >> 2) & 3) * 4)) & 3;
        gw[i] = W + (size_t)(n0 + r) * 1024 + ((lane & 3) ^ gsw) * 8;
    }
    unsigned char* lbA = lds + wid * 4096;
    unsigned char* lbW = lds + 16384 + wid * 2048;
#define GEMM_STAGE(slot, kt)                                                                                                   \
    do {                                                                                                                       \
        _Pragma("unroll") for (int i = 0; i < 4; ++i)                                                                          \
            __builtin_amdgcn_global_load_lds((const unsigned*)(ga[i] + (kt) * 32), (unsigned*)(lbA + (slot) * 24576 + i * 1024), 16, 0, 0);  \
        _Pragma("unroll") for (int i = 0; i < 2; ++i)                                                                          \
            __builtin_amdgcn_global_load_lds((const unsigned*)(gw[i] + (kt) * 32), (unsigned*)(lbW + (slot) * 24576 + i * 1024), 16, 0, 0);  \
    } while (0)
    float st_mean = 0.f, st_rs = 0.f, c12v = 0.f;
    float4 hq = make_float4(1.f, 1.f, 1.f, 1.f);
    if (MODE == 3 || MODE == 4 || MODE == 5) {
        float4 sv[8];
        float cv[16];
        if (MODE != 4) {
            const float* pc = (const float*)(p.ws + WS_C12) + (size_t)((MODE == 5 ? 16 : 0) * 2 + (tid >> 7)) * 1024 + n0 + (tid & 127);
#pragma unroll
            for (int i = 0; i < 16; ++i) cv[i] = pc[i * 2048];
        }
        const float4* pp = (const float4*)(p.ws + (MODE == 5 ? WS_LNP2 : WS_LNP1)) + (size_t)(m0 + tid) * 8;
#pragma unroll
        for (int i = 0; i < 8; ++i) sv[i] = pp[i];
        GEMM_STAGE(0, 0);
        if (MODE != 4) {
#pragma unroll
            for (int i = 0; i < 16; ++i) c12v += cv[i];
        }
        float s1 = 0.f, s2 = 0.f;
#pragma unroll
        for (int i = 0; i < 8; ++i) { s1 += sv[i].x + sv[i].z; s2 += sv[i].y + sv[i].w; }
        st_mean = s1 * (1.f / 1024.f);
        st_rs = rsqrtf(fmaxf(s2 * (1.f / 1024.f) - st_mean * st_mean, 0.f) + LN_EPS);
    } else if (MODE == 2) {
        const int mrow = m0 + tid, bb = mrow >> 11, tt_ = mrow & 2047;
        const float* sp = (const float*)(p.ws + WS_SSP) + (size_t)bb * 32 * 2048 + tt_;
        float sv32[32];
#pragma unroll
        for (int i = 0; i < 32; ++i) sv32[i] = sp[(size_t)i * 2048];
        GEMM_STAGE(0, 0);
        float rs[4];
#pragma unroll
        for (int h = 0; h < 4; ++h) {
            float t = 0.f;
#pragma unroll
            for (int g = 0; g < 8; ++g) t += sv32[h * 8 + g];
            rs[h] = rsqrtf(t * (1.f / 128.f) + LN_EPS);
        }
        hq = make_float4(1.f / rs[0], rs[0] / rs[1], rs[1] / rs[2], rs[2] / rs[3]);
        st_rs = rs[3];
    } else {
        GEMM_STAGE(0, 0);
    }
    f32x4 acc[4][8];
#pragma unroll
    for (int i = 0; i < 4; ++i)
#pragma unroll
        for (int j = 0; j < 8; ++j) acc[i][j] = (f32x4){0.f, 0.f, 0.f, 0.f};
    const int fr = lane & 15, fq = lane >> 4;
    const int fsw = (0x1320 >> (((fr >> 2) & 3) * 4)) & 3;
    const int aoff = (wm * 128 + fr) * 64 + ((fq ^ fsw) << 4);
    const int boff = 16384 + (wn * 64 + fr) * 64 + ((fq ^ fsw) << 4);
#define GEMM_COMPUTE(kt)                                                                                                       \
    do {                                                                                                                       \
        const unsigned char* sb = lds + ((kt) & 1) * 24576;                                                                    \
        bf16x8 af[8], wf[4];                                                                                                   \
        _Pragma("unroll") for (int t = 0; t < 8; ++t) af[t] = *(const bf16x8*)(sb + aoff + t * 1024);                          \
        _Pragma("unroll") for (int t = 0; t < 4; ++t) wf[t] = *(const bf16x8*)(sb + boff + t * 1024);                          \
        _Pragma("unroll") for (int nt = 0; nt < 4; ++nt)                                                                       \
            _Pragma("unroll") for (int mt = 0; mt < 8; ++mt) acc[nt][mt] = __builtin_amdgcn_mfma_f32_16x16x32_bf16(wf[nt], af[mt], acc[nt][mt], 0, 0, 0); \
    } while (0)
    {
        asm volatile("s_waitcnt vmcnt(0)\n\ts_waitcnt lgkmcnt(0)" ::: "memory");
        __builtin_amdgcn_s_barrier(); asm volatile("" ::: "memory");
        GEMM_STAGE(1, 1);
        if (MODE == 2) {
            ((float4*)(lds + 53248))[tid] = hq;
            ((float*)(lds + 57344))[tid] = st_rs;
        }
        if (MODE == 3 || MODE == 4 || MODE == 5) {
            STL[tid] = make_float2(st_mean, st_rs);
            if (MODE == 5 && tn == 0) ((float2*)(p.ws + WS_ST2))[m0 + tid] = make_float2(st_mean, st_rs);
            if (MODE != 4) ((float*)(lds + 49152 + 2048))[tid] = c12v;
        }
        GEMM_COMPUTE(0);
    }
#pragma unroll 1
    for (int kt = 1; kt < 32; ++kt) {
        asm volatile("s_waitcnt vmcnt(0)\n\ts_waitcnt lgkmcnt(0)" ::: "memory");
        __builtin_amdgcn_s_barrier(); asm volatile("" ::: "memory");
        if (kt + 1 < 32) { if (kt & 1) GEMM_STAGE(0, kt + 1); else GEMM_STAGE(1, kt + 1); }
        if (MODE == 2 && kt >= 16 && (kt & 3) == 0) {
            const float* rq = (const float*)(lds + 53248) + ((kt - 16) >> 2);
#pragma unroll
            for (int mt = 0; mt < 8; ++mt) {
                const float f = rq[(wm * 128 + mt * 16 + fr) * 4];
#pragma unroll
                for (int nt = 0; nt < 4; ++nt) { acc[nt][mt][0] *= f; acc[nt][mt][1] *= f; acc[nt][mt][2] *= f; acc[nt][mt][3] *= f; }
            }
        }
        GEMM_COMPUTE(kt);
    }
#undef GEMM_COMPUTE
    if (MODE == 2) {
        const float* r3 = (const float*)(lds + 57344);
#pragma unroll
        for (int mt = 0; mt < 8; ++mt) {
            const float f = r3[wm * 128 + mt * 16 + fr];
#pragma unroll
            for (int nt = 0; nt < 4; ++nt) { acc[nt][mt][0] *= f; acc[nt][mt][1] *= f; acc[nt][mt][2] *= f; acc[nt][mt][3] *= f; }
        }
    }
    asm volatile("s_waitcnt lgkmcnt(0)" ::: "memory");
    __builtin_amdgcn_s_barrier(); asm volatile("" ::: "memory");
#undef GEMM_STAGE
    if (MODE == 3 || MODE == 5) {
        bf16_t* O = (bf16_t*)(p.ws + (MODE == 3 ? WS_QX : WS_QP));
        const float* C12L = (const float*)(lds + 49152 + 2048);
#pragma unroll
        for (int nt = 0; nt < 4; ++nt) {
            const int n = n0 + wn * 64 + nt * 16 + fq * 4;
            const float4 c1 = *(const float4*)(C12L + (n - n0)), c2 = *(const float4*)(C12L + 128 + (n - n0));
#pragma unroll
            for (int mt = 0; mt < 8; ++mt) {
                const int ml = wm * 128 + mt * 16 + fr;
                const float2 st = STL[ml];
                const f32x4 c = acc[nt][mt];
                uint2 u;
                u.x = pk_bf16(st.y * (c[0] - st.x * c1.x) + c2.x, st.y * (c[1] - st.x * c1.y) + c2.y);
                u.y = pk_bf16(st.y * (c[2] - st.x * c1.z) + c2.z, st.y * (c[3] - st.x * c1.w) + c2.w);
                *(uint2*)(O + (size_t)(m0 + ml) * 1024 + n) = u;
            }
        }
    } else if (MODE == 4) {
        bf16_t* YB = (bf16_t*)(p.ws + WS_YB);
        float4 g4[4], b4[4];
#pragma unroll
        for (int nt = 0; nt < 4; ++nt) {
            const int n = n0 + wn * 64 + nt * 16 + fq * 4;
            g4[nt] = *(const float4*)(p.ln_g + n);
            b4[nt] = *(const float4*)(p.ln_b + n);
        }
#pragma unroll
        for (int mt = 0; mt < 8; ++mt) {
            const int ml = wm * 128 + mt * 16 + fr;
            const float2 st = STL[ml];
            bf16_t* yrow = YB + (size_t)(m0 + ml) * 1024 + n0 + wn * 64 + fq * 4;
            float s1 = 0.f, s2 = 0.f;
#pragma unroll
            for (int nt = 0; nt < 4; ++nt) {
                const f32x4 c = acc[nt][mt];
                const uint2 yb = *(const uint2*)(yrow + nt * 16);
                const float y0 = ALPHA * ((bflo(yb.x) - st.x) * st.y * g4[nt].x + b4[nt].x) + c[0];
                const float y1 = ALPHA * ((bfhi(yb.x) - st.x) * st.y * g4[nt].y + b4[nt].y) + c[1];
                const float y2 = ALPHA * ((bflo(yb.y) - st.x) * st.y * g4[nt].z + b4[nt].z) + c[2];
                const float y3 = ALPHA * ((bfhi(yb.y) - st.x) * st.y * g4[nt].w + b4[nt].w) + c[3];
                s1 += (y0 + y1) + (y2 + y3);
                s2 += (y0 * y0 + y1 * y1) + (y2 * y2 + y3 * y3);
                *(uint2*)(yrow + nt * 16) = make_uint2(pk_bf16(y0, y1), pk_bf16(y2, y3));
            }
            s1 += __shfl_xor(s1, 16); s2 += __shfl_xor(s2, 16);
            s1 += __shfl_xor(s1, 32); s2 += __shfl_xor(s2, 32);
            if (fq == 0) ((float2*)(p.ws + WS_LNP2))[(size_t)(m0 + ml) * 16 + tn * 2 + wn] = make_float2(s1, s2);
            asm volatile("" ::: "memory");
        }
    } else {
#pragma unroll
    for (int mt = 0; mt < 8; ++mt) {
        const size_t m = (size_t)m0 + wm * 128 + mt * 16 + fr;
        float s1 = 0.f, s2 = 0.f;
#pragma unroll
        for (int nt = 0; nt < 4; ++nt) {
            const int n = n0 + wn * 64 + nt * 16 + fq * 4;
            const f32x4 c = acc[nt][mt];
            if (MODE == 0 || MODE == 1) {
                constexpr int NS = MODE == 0 ? INC : 2048;
                bf16_t* O = (bf16_t*)(p.ws + (MODE == 0 ? WS_HB : WS_KVM));
                if (MODE == 1 && tn >= 8) {
                    bf16_t* VMT = (bf16_t*)(p.ws + WS_VMT);
                    const int nn = n - 1024;
                    const size_t base = (((size_t)(m >> 8) * 4 + (nn >> 8)) * 256 + (nn & 255)) * 256 + (m & 255);
#pragma unroll
                    for (int i = 0; i < 4; ++i) VMT[base + (size_t)i * 256] = f2bf(c[i]);
                } else if (MODE == 0 && (tn == 7 || tn == 9)) {
                    bf16_t* VT = (bf16_t*)(p.ws + WS_VT);
                    const int which = tn == 9 ? 1 : 0;
                    const size_t base = ((((size_t)which * B_ + (m >> 11)) * 2 + wn) * 64 + nt * 16 + fq * 4) * 2048 + (m & 2047);
#pragma unroll
                    for (int i = 0; i < 4; ++i) VT[base + (size_t)i * 2048] = f2bf(c[i]);
                } else if (MODE != 0 || n < INC) {
                    uint2 u;
                    u.x = pk_bf16(c[0], c[1]);
                    u.y = pk_bf16(c[2], c[3]);
                    *(uint2*)(O + m * NS + n) = u;
                }
            } else if (MODE == 2) {
                const float4 xv = *(const float4*)(p.x + m * 1024 + n);
                const float y0 = ALPHA * xv.x + c[0], y1 = ALPHA * xv.y + c[1], y2 = ALPHA * xv.z + c[2], y3 = ALPHA * xv.w + c[3];
                s1 += (y0 + y1) + (y2 + y3);
                s2 += (y0 * y0 + y1 * y1) + (y2 * y2 + y3 * y3);
                *(uint2*)((bf16_t*)(p.ws + WS_YB) + m * 1024 + n) = make_uint2(pk_bf16(y0, y1), pk_bf16(y2, y3));
            }
        }
        if (MODE == 2) {
            s1 += __shfl_xor(s1, 16); s2 += __shfl_xor(s2, 16);
            s1 += __shfl_xor(s1, 32); s2 += __shfl_xor(s2, 32);
            if (fq == 0) ((float2*)(p.ws + WS_LNP1))[m * 16 + tn * 2 + wn] = make_float2(s1, s2);
        }
    }
    }
}


template <int MODE>
DEV void gemm_item(const P& p, int q, int j, unsigned char* lds) {
    int tm, tn;
    if (MODE == 0) {
        tm = q * 8 + (j & 7);
        tn = j >> 3;
    } else if (MODE == 1) {
        tm = q; tn = j;
    } else {
        tm = q * 8 + (j & 7);
        tn = j >> 3;
    }
    gemm_mfma_tile256<MODE>(p, tm, tn, lds);
}

DEV void transpose_tile(const float* W, int N, bf16_t* Wt, int tk, int tn, float* s, int ldk = 1024, const float* gk = nullptr,
                        const float* bk = nullptr, float* part = nullptr) {
    const int tid = threadIdx.x;
    const int k0 = tk * 64, n0 = tn * 64;
    float* s2 = s + 64 * 65;
#pragma unroll
    for (int i = 0; i < 4; ++i) {
        const int k = (tid >> 4) + 16 * i, n = (tid & 15) * 4;
        float4 v = make_float4(0.f, 0.f, 0.f, 0.f);
        if (n0 + n < N) v = *(const float4*)(W + (size_t)(k0 + k) * N + n0 + n);
        if (gk) {
            const float g = gk[k0 + k], bb = bk[k0 + k];
            s2[k * 65 + n + 0] = bb * v.x; s2[k * 65 + n + 1] = bb * v.y; s2[k * 65 + n + 2] = bb * v.z; s2[k * 65 + n + 3] = bb * v.w;
            v.x *= g; v.y *= g; v.z *= g; v.w *= g;
        }
        s[k * 65 + n + 0] = v.x; s[k * 65 + n + 1] = v.y; s[k * 65 + n + 2] = v.z; s[k * 65 + n + 3] = v.w;
    }
    __syncthreads();
    {
        const int n = tid >> 2, kc = (tid & 3) * 16;
        unsigned u[8];
#pragma unroll
        for (int j = 0; j < 8; ++j)
            u[j] = (unsigned)f2bf(s[(kc + 2 * j) * 65 + n]) | ((unsigned)f2bf(s[(kc + 2 * j + 1) * 65 + n]) << 16);
        bf16_t* dst = Wt + (size_t)(n0 + n) * ldk + k0 + kc;
        *(uint4*)dst = make_uint4(u[0], u[1], u[2], u[3]);
        *(uint4*)(dst + 8) = make_uint4(u[4], u[5], u[6], u[7]);
    }
    if (part && tid < 128) {
        const int which = tid >> 6, n = tid & 63;
        float t = 0.f;
#pragma unroll 8
        for (int k = 0; k < 64; ++k) t += which ? s2[k * 65 + n] : bf2f(f2bf(s[k * 65 + n]));
        part[which * 1024 + n0 + n] = t;
    }
    __syncthreads();
}
DEV void convert_chunk(const float* src, bf16_t* dst, int item) {
    float4 a[4], b[4];
#pragma unroll
    for (int j = 0; j < 4; ++j) {
        const size_t e = (((size_t)item * 4 + j) * 256 + threadIdx.x) * 8;
        a[j] = *(const float4*)(src + e);
        b[j] = *(const float4*)(src + e + 4);
    }
#pragma unroll
    for (int j = 0; j < 4; ++j) {
        const size_t e = (((size_t)item * 4 + j) * 256 + threadIdx.x) * 8;
        uint4 u;
        u.x = pk_bf16(a[j].x, a[j].y);
        u.y = pk_bf16(a[j].z, a[j].w);
        u.z = pk_bf16(b[j].x, b[j].y);
        u.w = pk_bf16(b[j].z, b[j].w);
        *(uint4*)(dst + e) = u;
    }
}
constexpr int PREP_T0 = 16 * 54, PREP_T3 = PREP_T0 + 512, PREP_T5 = PREP_T3, PREP_X = PREP_T5 + T_ * 1024 / 8192, PREP_M = PREP_X + 2048 * 1024 / 8192, PREP_K = PREP_M + 16 * 128 * 64 / 8192, PREP_W1 = PREP_K + 128, PREP_W2 = PREP_W1 + 4,
              PREP_END = PREP_W2;
DEV void prep_item(const P& p, int it, float* smem) {
    if (it < PREP_T0) transpose_tile(p.w_in, INC, (bf16_t*)(p.ws + WS_WIN_T), it / 54, it % 54, smem);
    else if (it < PREP_T3) { it -= PREP_T0; transpose_tile(p.xa_wkv, 2048, (bf16_t*)(p.ws + WS_WKV_T), it >> 5, it & 31, smem); }
    else if (it < PREP_X) convert_chunk(p.x, (bf16_t*)(p.ws + WS_XB), it - PREP_T5);
    else if (it < PREP_M) convert_chunk(p.mem, (bf16_t*)(p.ws + WS_MEMB), it - PREP_X);
    else if (it < PREP_K) convert_chunk(p.peer_keys, (bf16_t*)(p.ws + WS_PKEY), it - PREP_M);
    else if (it < PREP_W1) {
        it -= PREP_K;
        const int kind = it >> 6, r = it & 63;
        transpose_tile(p.cmp_w1 + (size_t)kind * 2048 * 128, 128, (bf16_t*)(p.ws + WS_W1T) + (size_t)kind * 128 * 2048, r >> 1, r & 1, smem, 2048);
    } else if (it < PREP_W2) {
        it -= PREP_W1;
        const int kind = it >> 1;
        transpose_tile(p.cmp_w2 + (size_t)kind * 128 * 64, 64, (bf16_t*)(p.ws + WS_W2T) + (size_t)kind * 64 * 128, it & 1, 0, smem, 128);
    }
}

DEV void compress_item(const P& p, int item, float* smem) {
    const int tid = threadIdx.x;
    const int g = item & 1;
    int r = item >> 1;
    const int n = r % NCMP;
    r /= NCMP;
    const int b = r & 7, kind = r >> 3;
    const bf16_t* HB = (const bf16_t*)(p.ws + WS_HB);
    float* KC = (float*)(p.ws + WS_KC);
    float* su = smem;
    float* sp = smem + 2048;
    float* sh = smem + 2304;
    const int col = (kind ? C_VC : C_KC) + g * 64;
    for (int i = tid; i < 2048; i += 256) {
        const int l = i >> 6, d = i & 63;
        su[i] = bf2f(HB[(size_t)(b * S_ + 16 * n + l) * INC + col + d]) + p.cmp_pos[(kind * 32 + l) * 64 + d];
    }
    __syncthreads();
    {
        const int j = tid & 127, hf = tid >> 7;
        const float* w1 = p.cmp_w1 + (size_t)kind * 2048 * 128;
        float acc = 0.f;
        for (int i = hf * 1024; i < hf * 1024 + 1024; ++i) acc += su[i] * w1[(size_t)i * 128 + j];
        sp[hf * 128 + j] = acc;
    }
    __syncthreads();
    if (tid < 128) {
        const float v = sp[tid] + sp[128 + tid];
        const float u = 0.7978845608028654f * (v + 0.044715f * v * v * v);
        sh[tid] = 0.5f * v * (1.f + tanhf(u));
    }
    __syncthreads();
    if (tid < 64) {
        const float* w2 = p.cmp_w2 + (size_t)kind * 128 * 64;
        float acc = 0.f;
        for (int j = 0; j < 128; ++j) acc += sh[j] * w2[j * 64 + tid];
        KC[((((size_t)kind * B_ + b) * NCMP + n) * 2 + g) * 64 + tid] = acc;
    }
    __syncthreads();
}

DEV void load_q64_bf(float (&q)[64], const bf16_t* src) {
    const uint4* s4 = (const uint4*)src;
#pragma unroll
    for (int i = 0; i < 8; ++i) {
        const uint4 u = s4[i];
        q[i * 8 + 0] = bflo(u.x); q[i * 8 + 1] = bfhi(u.x); q[i * 8 + 2] = bflo(u.y); q[i * 8 + 3] = bfhi(u.y);
        q[i * 8 + 4] = bflo(u.z); q[i * 8 + 5] = bfhi(u.z); q[i * 8 + 6] = bflo(u.w); q[i * 8 + 7] = bfhi(u.w);
    }
}
DEV float dot64_bf(const float (&q)[64], const bf16_t* kr) {
    const uint4* k4 = (const uint4*)kr;
    float acc = 0.f;
#pragma unroll
    for (int i = 0; i < 8; ++i) {
        const uint4 u = k4[i];
        acc += q[i * 8 + 0] * bflo(u.x) + q[i * 8 + 1] * bfhi(u.x) + q[i * 8 + 2] * bflo(u.y) + q[i * 8 + 3] * bfhi(u.y) +
               q[i * 8 + 4] * bflo(u.z) + q[i * 8 + 5] * bfhi(u.z) + q[i * 8 + 6] * bflo(u.w) + q[i * 8 + 7] * bfhi(u.w);
    }
    return acc;
}
DEV float dot64_f(const float (&q)[64], const float* kr) {
    const float4* k4 = (const float4*)kr;
    float acc = 0.f;
#pragma unroll
    for (int i = 0; i < 16; ++i) {
        const float4 u = k4[i];
        acc += q[i * 4 + 0] * u.x + q[i * 4 + 1] * u.y + q[i * 4 + 2] * u.z + q[i * 4 + 3] * u.w;
    }
    return acc;
}

DEV void attn_block(const float (&q)[64], const bf16_t* krow_lane, const bf16_t* vbase_lane, bool valid, float& m, float& l, float& o) {
    float sc = dot64_bf(q, krow_lane) * 0.125f;
    sc = valid ? sc : -1e30f;
    const float mb = wmax(sc);
    const float mn = fmaxf(m, mb);
    const float corr = expf(m - mn);
    const float e = valid ? expf(sc - mn) : 0.f;
    l = l * corr + wsum(e);
    o *= corr;
#pragma unroll 8
    for (int k = 0; k < 64; ++k) o += __shfl(e, k) * bf2f(vbase_lane[(size_t)k * INC]);
    m = mn;
}

DEV void nsa_item(const P& p, int item) {
    const int lane = threadIdx.x & 63;
    const int g = item & 1;
    const int t = item >> 1;
    const int b = t >> 11, s = t & 2047;
    const bf16_t* HB = (const bf16_t*)(p.ws + WS_HB);
    const float* KC = (const float*)(p.ws + WS_KC);
    bf16_t* OM = (bf16_t*)(p.ws + WS_OM);
    const int cur = s >> 6;
    const int nvalid = (s >= 31) ? (((s - 31) >> 4) + 1) : 0;
    const size_t rowt = (size_t)t * INC;
    float ocmp0 = 0.f, ocmp1 = 0.f, ocmp2 = 0.f, ocmp3 = 0.f;
    float psum0 = 0.f, psum1 = 0.f;
    if (nvalid > 0) {
#pragma unroll 1
        for (int r = 0; r < 4; ++r) {
            const int h = g * 4 + r;
            float q[64];
            load_q64_bf(q, HB + rowt + C_QA + h * 64);
            float sc0 = -1e30f, sc1 = -1e30f;
            if (lane < nvalid) sc0 = dot64_f(q, KC + ((((size_t)0 * B_ + b) * NCMP + lane) * 2 + g) * 64) * 0.125f;
            if (lane + 64 < nvalid) sc1 = dot64_f(q, KC + ((((size_t)0 * B_ + b) * NCMP + lane + 64) * 2 + g) * 64) * 0.125f;
            const float m = wmax(fmaxf(sc0, sc1));
            const float e0 = (lane < nvalid) ? expf(sc0 - m) : 0.f;
            const float e1 = (lane + 64 < nvalid) ? expf(sc1 - m) : 0.f;
            const float l = wsum(e0 + e1);
            const float p0 = e0 / l, p1 = e1 / l;
            psum0 += p0;
            psum1 += p1;
            float oc = 0.f;
            const float* vcb = KC + ((((size_t)1 * B_ + b) * NCMP) * 2 + g) * 64 + lane;
            for (int n = 0; n < nvalid; ++n) {
                const float pn = (n < 64) ? __shfl(p0, n) : __shfl(p1, n - 64);
                oc += pn * vcb[(size_t)n * 128];
            }
            if (r == 0) ocmp0 = oc;
            if (r == 1) ocmp1 = oc;
            if (r == 2) ocmp2 = oc;
            if (r == 3) ocmp3 = oc;
        }
    }
    float imp = 0.f;
#pragma unroll
    for (int dn = -1; dn <= 3; ++dn) {
        const int n = 4 * lane + dn;
        const int nn = n < 0 ? 0 : (n > 127 ? 127 : n);
        const float v0 = __shfl(psum0, nn & 63);
        const float v1 = __shfl(psum1, nn & 63);
        const float v = (nn < 64) ? v0 : v1;
        if (n >= 0 && n <= 126) imp += v;
    }
    float score;
    if (lane > cur) score = -INFINITY;
    else if (lane == 0 || lane == cur || lane == cur - 1) score = 1e4f;
    else score = imp;
    int rank = 0;
#pragma unroll 8
    for (int i = 0; i < 32; ++i) {
        const float si = __shfl(score, i);
        rank += ((si > score) || (si == score && i < lane)) ? 1 : 0;
    }
    const bool sel = (lane <= cur) && (rank < 16);
    const unsigned mask = (unsigned)(__ballot(sel) & 0xffffffffull);
    const int wlo = (s - 511) > 0 ? (s - 511) : 0;
#pragma unroll 1
    for (int r = 0; r < 4; ++r) {
        const int h = g * 4 + r;
        float q[64];
        load_q64_bf(q, HB + rowt + C_QA + h * 64);
        float m = -1e30f, l = 0.f, o = 0.f;
        for (unsigned mm = mask; mm; mm &= mm - 1) {
            const int j = __builtin_ctz(mm);
            const int kpos = j * 64 + lane;
            attn_block(q, HB + (size_t)(b * S_ + kpos) * INC + C_KS + g * 64, HB + (size_t)(b * S_ + j * 64) * INC + C_VS + g * 64 + lane,
                       kpos <= s, m, l, o);
        }
        const float oslc = o / l;
        m = -1e30f; l = 0.f; o = 0.f;
        for (int j = wlo >> 6; j <= cur; ++j) {
            const int kpos = j * 64 + lane;
            attn_block(q, HB + (size_t)(b * S_ + kpos) * INC + C_KW + g * 64, HB + (size_t)(b * S_ + j * 64) * INC + C_VW + g * 64 + lane,
                       (kpos <= s) && (kpos >= wlo), m, l, o);
        }
        const float owin = o / l;
        const float oc = r == 0 ? ocmp0 : (r == 1 ? ocmp1 : (r == 2 ? ocmp2 : ocmp3));
        const float g0 = sigmoidf_(bf2f(HB[rowt + C_GATE + h * 3 + 0]));
        const float g1 = sigmoidf_(bf2f(HB[rowt + C_GATE + h * 3 + 1]));
        const float g2 = sigmoidf_(bf2f(HB[rowt + C_GATE + h * 3 + 2]));
        OM[(size_t)t * 1024 + h * 64 + lane] = f2bf(g0 * oc + g1 * oslc + g2 * owin);
    }
}

DEV void hgrn_item(const P& p, int item, float* smem) {
    const int b = item >> 2, hh = item & 3;
    const int tid = threadIdx.x, dv = tid & 127, half = tid >> 7;
    const bf16_t* HB = (const bf16_t*)(p.ws + WS_HB);
    bf16_t* OM = (bf16_t*)(p.ws + WS_OM);
    float* sf = smem;
    float* sq = smem + 1024;
    float* so = smem + 2048;
    float Sreg[64];
#pragma unroll
    for (int i = 0; i < 64; ++i) Sreg[i] = 0.f;
    const int d = tid & 127;
    float lbv;
    {
        const float l0 = p.lb_logits[hh * 128 + d], l1 = p.lb_logits[512 + hh * 128 + d];
        const float mx = fmaxf(l0, l1);
        const float e0 = expf(l0 - mx), e1 = expf(l1 - mx);
        lbv = e0 / (e0 + e1);
    }
    const int wave = tid >> 6, lane = tid & 63;
    const float nw0 = p.hg_norm_w[hh * 128 + lane], nw1 = p.hg_norm_w[hh * 128 + lane + 64];
    for (int t0 = 0; t0 < S_; t0 += 8) {
#pragma unroll
        for (int i = 0; i < 4; ++i) {
            const int st = (tid >> 7) + 2 * i;
            const size_t tt = (size_t)b * S_ + t0 + st;
            const float fl = bf2f(HB[tt * INC + C_HF + hh * 128 + d]);
            sf[st * 128 + d] = lbv + (1.f - lbv) * sigmoidf_(fl);
            sq[st * 128 + d] = bf2f(HB[tt * INC + C_HQ + hh * 128 + d]);
        }
        float vv[8];
#pragma unroll
        for (int st = 0; st < 8; ++st) vv[st] = bf2f(HB[((size_t)b * S_ + t0 + st) * INC + C_HI + hh * 128 + dv]);
        __syncthreads();
#pragma unroll
        for (int st = 0; st < 8; ++st) {
            float oacc = 0.f;
            const float* pf = sf + st * 128 + half * 64;
            const float* pq = sq + st * 128 + half * 64;
#pragma unroll
            for (int dk = 0; dk < 64; ++dk) {
                const float f = pf[dk];
                Sreg[dk] = f * Sreg[dk] + (1.f - f) * vv[st];
                oacc += pq[dk] * Sreg[dk];
            }
            so[(st * 2 + half) * 128 + dv] = oacc;
        }
        __syncthreads();
#pragma unroll
        for (int u = 0; u < 2; ++u) {
            const int st = wave * 2 + u;
            const float o0 = so[(st * 2 + 0) * 128 + lane] + so[(st * 2 + 1) * 128 + lane];
            const float o1 = so[(st * 2 + 0) * 128 + lane + 64] + so[(st * 2 + 1) * 128 + lane + 64];
            const float ss = wsum(o0 * o0 + o1 * o1);
            const float rs = rsqrtf(ss * (1.f / 128.f) + LN_EPS);
            const size_t tt = (size_t)b * S_ + t0 + st;
            const float gg0 = bf2f(HB[tt * INC + C_HG + hh * 128 + lane]);
            const float gg1 = bf2f(HB[tt * INC + C_HG + hh * 128 + lane + 64]);
            OM[tt * 1024 + 512 + hh * 128 + lane] = f2bf(o0 * rs * nw0 * (gg0 * sigmoidf_(gg0)));
            OM[tt * 1024 + 512 + hh * 128 + lane + 64] = f2bf(o1 * rs * nw1 * (gg1 * sigmoidf_(gg1)));
        }
    }
    __syncthreads();
}

DEV void ln_item(const P& p, int t, int which, int lane) {
    const bf16_t* row = (const bf16_t*)(p.ws + WS_YB) + (size_t)t * 1024;
    float4 v[4];
    float s = 0.f;
#pragma unroll
    for (int i = 0; i < 4; ++i) {
        const uint2 u = *(const uint2*)(row + (i * 64 + lane) * 4);
        v[i] = make_float4(bflo(u.x), bfhi(u.x), bflo(u.y), bfhi(u.y));
        s += v[i].x + v[i].y + v[i].z + v[i].w;
    }
    const float mean = wsum(s) * (1.f / 1024.f);
    float ss = 0.f;
#pragma unroll
    for (int i = 0; i < 4; ++i) {
        v[i].x -= mean; v[i].y -= mean; v[i].z -= mean; v[i].w -= mean;
        ss += v[i].x * v[i].x + v[i].y * v[i].y + v[i].z * v[i].z + v[i].w * v[i].w;
    }
    const float rs = rsqrtf(wsum(ss) * (1.f / 1024.f) + LN_EPS);
#pragma unroll
    for (int i = 0; i < 4; ++i) {
        const int c = (i * 64 + lane) * 4;
        const float4 gg = *(const float4*)(p.ln_g + which * 1024 + c);
        const float4 bb = *(const float4*)(p.ln_b + which * 1024 + c);
        float4 o;
        o.x = v[i].x * rs * gg.x + bb.x; o.y = v[i].y * rs * gg.y + bb.y; o.z = v[i].z * rs * gg.z + bb.z; o.w = v[i].w * rs * gg.w + bb.w;
        uint2 u;
        u.x = pk_bf16(o.x, o.y);
        u.y = pk_bf16(o.z, o.w);
        *(uint2*)((bf16_t*)(p.ws + WS_XB) + (size_t)t * 1024 + c) = u;
    }
}

DEV void xattn_item(const P& p, int item) {
    const int lane = threadIdx.x & 63;
    const int hh = item & 3, t = item >> 2, b = t >> 11;
    const bf16_t* QX = (const bf16_t*)(p.ws + WS_QX);
    const bf16_t* KVM = (const bf16_t*)(p.ws + WS_KVM);
    bf16_t* OX = (bf16_t*)(p.ws + WS_OX);
    float sc[4] = {0.f, 0.f, 0.f, 0.f};
#pragma unroll 1
    for (int c = 0; c < 4; ++c) {
        float q[64];
        load_q64_bf(q, QX + (size_t)t * 1024 + hh * 256 + c * 64);
#pragma unroll
        for (int k = 0; k < 4; ++k) sc[k] += dot64_bf(q, KVM + (size_t)(b * ML_ + lane + 64 * k) * 2048 + hh * 256 + c * 64);
    }
    float mx = -1e30f;
#pragma unroll
    for (int k = 0; k < 4; ++k) { sc[k] *= 0.0625f; mx = fmaxf(mx, sc[k]); }
    mx = wmax(mx);
    float pr[4], ls = 0.f;
#pragma unroll
    for (int k = 0; k < 4; ++k) { pr[k] = expf(sc[k] - mx); ls += pr[k]; }
    ls = wsum(ls);
    const float inv = 1.f / ls;
    float o[4] = {0.f, 0.f, 0.f, 0.f};
#pragma unroll
    for (int k = 0; k < 4; ++k) {
        const bf16_t* vb = KVM + (size_t)(b * ML_ + k * 64) * 2048 + 1024 + hh * 256 + lane;
#pragma unroll 4
        for (int mm = 0; mm < 64; ++mm) {
            const float pm = __shfl(pr[k], mm);
#pragma unroll
            for (int c = 0; c < 4; ++c) o[c] += pm * bf2f(vb[(size_t)mm * 2048 + c * 64]);
        }
    }
#pragma unroll
    for (int c = 0; c < 4; ++c) OX[(size_t)t * 1024 + hh * 256 + c * 64 + lane] = f2bf(o[c] * inv);
}

DEV void wave_argmax(float v, int i, float& bv, int& bi) {
#pragma unroll
    for (int o = 32; o > 0; o >>= 1) {
        const float ov = __shfl_xor(v, o);
        const int oi = __shfl_xor(i, o);
        if (ov > v || (ov == v && oi < i)) { v = ov; i = oi; }
    }
    bv = v; bi = i;
}

DEV void peer_item(const P& p, int t) {
    const int lane = threadIdx.x & 63;
    const float* QP = (const float*)(p.ws + WS_QP);
    float* row = p.out + (size_t)t * 1024;
    float4 xr[4], oacc[4];
#pragma unroll
    for (int i = 0; i < 4; ++i) {
        xr[i] = *(const float4*)(row + (i * 64 + lane) * 4);
        oacc[i] = make_float4(0.f, 0.f, 0.f, 0.f);
    }
#pragma unroll 1
    for (int hh = 0; hh < 8; ++hh) {
        float ts1 = 0.f, ts2 = 0.f;
        int ti1 = 0, ti2 = 0;
#pragma unroll 1
        for (int c = 0; c < 2; ++c) {
            float q[64];
            {
                const float4* q4 = (const float4*)(QP + (size_t)t * 1024 + hh * 128 + c * 64);
#pragma unroll
                for (int i = 0; i < 16; ++i) { const float4 u = q4[i]; q[i * 4] = u.x; q[i * 4 + 1] = u.y; q[i * 4 + 2] = u.z; q[i * 4 + 3] = u.w; }
            }
            const float* kb = p.peer_keys + ((size_t)(hh * 2 + c) * 128) * 64;
            float a0 = dot64_f(q, kb + (size_t)lane * 64);
            float a1 = dot64_f(q, kb + (size_t)(lane + 64) * 64);
            float ts = 0.f;
            int ti = 0;
#pragma unroll 1
            for (int k = 0; k < 16; ++k) {
                float v; int i;
                if (a0 >= a1) { v = a0; i = lane; } else { v = a1; i = lane + 64; }
                float bv; int bi;
                wave_argmax(v, i, bv, bi);
                if (lane == k) { ts = bv; ti = bi; }
                if (bi == lane) a0 = -INFINITY;
                if (bi == lane + 64) a1 = -INFINITY;
            }
            if (c == 0) { ts1 = ts; ti1 = ti; } else { ts2 = ts; ti2 = ti; }
        }
        float cs[4];
        const float s1v = __shfl(ts1, lane >> 2);
#pragma unroll
        for (int u = 0; u < 4; ++u) cs[u] = s1v + __shfl(ts2, (lane & 3) * 4 + u);
        float fs = 0.f;
        int fidx = 0;
#pragma unroll 1
        for (int k = 0; k < 16; ++k) {
            float v = cs[0]; int i = lane * 4;
#pragma unroll
            for (int u = 1; u < 4; ++u) if (cs[u] > v) { v = cs[u]; i = lane * 4 + u; }
            float bv; int bi;
            wave_argmax(v, i, bv, bi);
            if (lane == k) { fs = bv; fidx = bi; }
#pragma unroll
            for (int u = 0; u < 4; ++u) if (bi == lane * 4 + u) cs[u] = -INFINITY;
        }
        const int e1i = __shfl(ti1, fidx >> 4);
        const int e2i = __shfl(ti2, fidx & 15);
        const int eid = e1i * 128 + e2i;
        const float mx = __shfl(fs, 0);
        const float w = (lane < 16) ? expf(fs - mx) : 0.f;
        const float gate = w / wsum(w);
#pragma unroll 1
        for (int k = 0; k < 16; ++k) {
            const int e = __shfl(eid, k);
            const float gt = __shfl(gate, k);
            const float* dr = p.peer_down + (size_t)e * 1024;
            const float* ur = p.peer_up + (size_t)e * 1024;
            float hd = 0.f;
#pragma unroll
            for (int i = 0; i < 4; ++i) {
                const float4 dvv = *(const float4*)(dr + (i * 64 + lane) * 4);
                hd += dvv.x * xr[i].x + dvv.y * xr[i].y + dvv.z * xr[i].z + dvv.w * xr[i].w;
            }
            hd = wsum(hd);
            const float a = 0.5f * hd * (1.f + erff(hd * 0.7071067811865476f)) * gt;
#pragma unroll
            for (int i = 0; i < 4; ++i) {
                const float4 uv = *(const float4*)(ur + (i * 64 + lane) * 4);
                oacc[i].x += a * uv.x; oacc[i].y += a * uv.y; oacc[i].z += a * uv.z; oacc[i].w += a * uv.w;
            }
        }
    }
    float s = 0.f;
    float4 v[4];
#pragma unroll
    for (int i = 0; i < 4; ++i) {
        v[i].x = ALPHA * xr[i].x + oacc[i].x; v[i].y = ALPHA * xr[i].y + oacc[i].y;
        v[i].z = ALPHA * xr[i].z + oacc[i].z; v[i].w = ALPHA * xr[i].w + oacc[i].w;
        s += v[i].x + v[i].y + v[i].z + v[i].w;
    }
    const float mean = wsum(s) * (1.f / 1024.f);
    float ss = 0.f;
#pragma unroll
    for (int i = 0; i < 4; ++i) {
        v[i].x -= mean; v[i].y -= mean; v[i].z -= mean; v[i].w -= mean;
        ss += v[i].x * v[i].x + v[i].y * v[i].y + v[i].z * v[i].z + v[i].w * v[i].w;
    }
    const float rs = rsqrtf(wsum(ss) * (1.f / 1024.f) + LN_EPS);
#pragma unroll
    for (int i = 0; i < 4; ++i) {
        const int c = (i * 64 + lane) * 4;
        const float4 gg = *(const float4*)(p.ln_g + 2 * 1024 + c);
        const float4 bb = *(const float4*)(p.ln_b + 2 * 1024 + c);
        float4 o;
        o.x = v[i].x * rs * gg.x + bb.x; o.y = v[i].y * rs * gg.y + bb.y; o.z = v[i].z * rs * gg.z + bb.z; o.w = v[i].w * rs * gg.w + bb.w;
        *(float4*)(row + c) = o;
    }
}


DEV void compress_item2(const P& p, int item, unsigned char* lds) {
    const int nt8 = item & 7, g = (item >> 3) & 1, b = (item >> 4) & 7, kind = item >> 7;
    const int tid = threadIdx.x, lane = tid & 63, wid = tid >> 6, fr = lane & 15, fq = lane >> 4;
    const bf16_t* HB = (const bf16_t*)(p.ws + WS_HB);
    const bf16_t* W1T = (const bf16_t*)(p.ws + WS_W1T) + (size_t)kind * 128 * 2048;
    const bf16_t* W2T = (const bf16_t*)(p.ws + WS_W2T) + (size_t)kind * 64 * 128;
    const float* posb = p.cmp_pos + (size_t)kind * 2048 + fq * 8;
    const int n0 = nt8 * 16;
    const int kcol = (kind ? C_VC : C_KC) + g * 64;
    const bf16_t* abase = HB + (size_t)(b * S_ + 16 * (n0 + fr)) * INC + kcol + fq * 8;
    const bf16_t* wbase = W1T + (size_t)fr * 2048 + fq * 8;
    f32x4 acc[8];
#pragma unroll
    for (int jt = 0; jt < 8; ++jt) acc[jt] = (f32x4){0.f, 0.f, 0.f, 0.f};
#pragma unroll 4
    for (int k2 = 0; k2 < 16; ++k2) {
        const int ks = wid * 16 + k2;
        bf16x8 af;
        {
            const u32x4 raw = *(const u32x4*)(abase + (size_t)(ks >> 1) * INC + (ks & 1) * 32);
            const float* pp = posb + (ks >> 1) * 64 + (ks & 1) * 32;
            const float4 p0 = *(const float4*)pp, p1 = *(const float4*)(pp + 4);
            u32x4 w;
            w[0] = pk_bf16(bflo(raw[0]) + p0.x, bfhi(raw[0]) + p0.y);
            w[1] = pk_bf16(bflo(raw[1]) + p0.z, bfhi(raw[1]) + p0.w);
            w[2] = pk_bf16(bflo(raw[2]) + p1.x, bfhi(raw[2]) + p1.y);
            w[3] = pk_bf16(bflo(raw[3]) + p1.z, bfhi(raw[3]) + p1.w);
            af = __builtin_bit_cast(bf16x8, w);
        }
#pragma unroll
        for (int jt = 0; jt < 8; ++jt) {
            const bf16x8 wf = *(const bf16x8*)(wbase + (size_t)jt * 16 * 2048 + ks * 32);
            acc[jt] = __builtin_amdgcn_mfma_f32_16x16x32_bf16(wf, af, acc[jt], 0, 0, 0);
        }
    }
    float* PS = (float*)lds;
    bf16_t* HS = (bf16_t*)(lds + 4 * 16 * 132 * 4);
#pragma unroll
    for (int jt = 0; jt < 8; ++jt)
        *(float4*)(PS + (wid * 16 + fr) * 132 + jt * 16 + fq * 4) = make_float4(acc[jt][0], acc[jt][1], acc[jt][2], acc[jt][3]);
    __syncthreads();
    {
        const int r = tid >> 4, jb = (tid & 15) * 8;
        float hv[8];
#pragma unroll
        for (int h2 = 0; h2 < 2; ++h2) {
            float4 s = make_float4(0.f, 0.f, 0.f, 0.f);
#pragma unroll
            for (int w = 0; w < 4; ++w) {
                const float4 v = *(const float4*)(PS + (w * 16 + r) * 132 + jb + h2 * 4);
                s.x += v.x; s.y += v.y; s.z += v.z; s.w += v.w;
            }
            hv[h2 * 4 + 0] = s.x; hv[h2 * 4 + 1] = s.y; hv[h2 * 4 + 2] = s.z; hv[h2 * 4 + 3] = s.w;
        }
#pragma unroll
        for (int i = 0; i < 8; ++i) {
            const float v = hv[i];
            const float u = 0.7978845608028654f * (v + 0.044715f * v * v * v);
            hv[i] = 0.5f * v * (1.f + tanhf(u));
        }
        u32x4 w;
        w[0] = pk_bf16(hv[0], hv[1]); w[1] = pk_bf16(hv[2], hv[3]); w[2] = pk_bf16(hv[4], hv[5]); w[3] = pk_bf16(hv[6], hv[7]);
        *(u32x4*)(HS + r * 136 + jb) = w;
    }
    __syncthreads();
    f32x4 o = (f32x4){0.f, 0.f, 0.f, 0.f};
#pragma unroll
    for (int ks = 0; ks < 4; ++ks) {
        const bf16x8 hf = *(const bf16x8*)(HS + fr * 136 + ks * 32 + fq * 8);
        const bf16x8 wf = *(const bf16x8*)(W2T + (size_t)(wid * 16 + fr) * 128 + ks * 32 + fq * 8);
        if (kind == 0) o = __builtin_amdgcn_mfma_f32_16x16x32_bf16(wf, hf, o, 0, 0, 0);
        else o = __builtin_amdgcn_mfma_f32_16x16x32_bf16(hf, wf, o, 0, 0, 0);
    }
    if (kind == 0) {
        const int n = n0 + fr, e = wid * 16 + fq * 4;
        uint2 u2;
        u2.x = pk_bf16(o[0], o[1]);
        u2.y = pk_bf16(o[2], o[3]);
        if (n == 127) u2 = make_uint2(0u, 0u);
        *(uint2*)((bf16_t*)(p.ws + WS_KCB) + ((size_t)(b * 2 + g) * 128 + n) * 64 + e) = u2;
    } else {
        const int e = wid * 16 + fr, n = n0 + fq * 4;
        const float o3 = (n + 3 == 127) ? 0.f : o[3];
        uint2 u2;
        u2.x = pk_bf16(o[0], o[1]);
        u2.y = pk_bf16(o[2], o3);
        *(uint2*)((bf16_t*)(p.ws + WS_VCT) + ((size_t)(b * 2 + g) * 64 + e) * 128 + n) = u2;
    }
    __syncthreads();
}

constexpr int NSA_IMP = 32768;
constexpr int NSA_SCORE = 49152;
constexpr int NSA_SELM = NSA_SCORE + 4224;

struct NsaTileRegs { u32x4 k[2], v[2]; };
DEV void nsa_load_tile(NsaTileRegs& r, const bf16_t* kbase, size_t kstride, const bf16_t* vbase, size_t vstride, int tid) {
    const int lc = tid & 7, lr = tid >> 3;
#pragma unroll
    for (int i = 0; i < 2; ++i) {
        r.k[i] = *(const u32x4*)(kbase + (size_t)(lr + 32 * i) * kstride + lc * 8);
        r.v[i] = *(const u32x4*)(vbase + (size_t)(lr + 32 * i) * vstride + lc * 8);
    }
}
DEV void nsa_store_tile(const NsaTileRegs& r, unsigned char* stage, int tid) {
    const int lc = tid & 7, lr = tid >> 3;
    const int woff = lr * 128 + ((lc ^ ((lr >> 1) & 7)) << 4);
#pragma unroll
    for (int i = 0; i < 2; ++i) {
        *(u32x4*)(stage + woff + i * 4096) = r.k[i];
        *(u32x4*)(stage + 8192 + woff + i * 4096) = r.v[i];
    }
}
DEV void nsa_dma_tile(const bf16_t* kbase, size_t kstride, const bf16_t* vbase, size_t vstride, unsigned char* stage, int lane, int wid) {
#pragma unroll
    for (int i = 0; i < 2; ++i) {
        const int pc = wid * 2 + i;
        const int r = pc * 8 + (lane >> 3);
        const int c = (lane & 7) ^ ((r >> 1) & 7);
        __builtin_amdgcn_global_load_lds((const unsigned*)(kbase + (size_t)r * kstride + c * 8), (unsigned*)(stage + pc * 1024), 16, 0, 0);
        __builtin_amdgcn_global_load_lds((const unsigned*)(vbase + (size_t)r * vstride + c * 8), (unsigned*)(stage + 8192 + pc * 1024), 16, 0, 0);
    }
}
DEV void nsa_scores(const unsigned char* stage, const bf16x8 (&qf)[2][2], f32x4 (&sc)[4][2], int fr, int fq) {
    const int sw = (fr >> 1) & 7;
    const int c0 = (fq ^ sw) << 4;
    const unsigned char* rowp = stage + fr * 128;
    const unsigned char* p0 = rowp + c0;
    const unsigned char* p1 = rowp + (c0 ^ 64);
#pragma unroll
    for (int kt = 0; kt < 4; ++kt) {
        const bf16x8 k0 = *(const bf16x8*)(p0 + kt * 2048);
        const bf16x8 k1 = *(const bf16x8*)(p1 + kt * 2048);
#pragma unroll
        for (int qt = 0; qt < 2; ++qt) {
            f32x4 a = (f32x4){0.f, 0.f, 0.f, 0.f};
            a = __builtin_amdgcn_mfma_f32_16x16x32_bf16(k0, qf[qt][0], a, 0, 0, 0);
            a = __builtin_amdgcn_mfma_f32_16x16x32_bf16(k1, qf[qt][1], a, 0, 0, 0);
            sc[kt][qt] = a;
        }
    }
}
DEV void nsa_pv(const unsigned char* stage, const f32x4 (&sc)[4][2], f32x4 (&o)[4][2], int fr, int fq) {
    const int sw = (fr >> 1) & 7;
    const int v0 = (((fq >> 1) ^ sw) << 4) + 8 * (fq & 1);
    const unsigned char* rowp = stage + 8192 + fr * 128;
#pragma unroll
    for (int s = 0; s < 2; ++s) {
        u32x4 pf[2];
#pragma unroll
        for (int qt = 0; qt < 2; ++qt) {
            pf[qt][0] = pk_bf16(sc[2 * s][qt][0], sc[2 * s][qt][1]);
            pf[qt][1] = pk_bf16(sc[2 * s][qt][2], sc[2 * s][qt][3]);
            pf[qt][2] = pk_bf16(sc[2 * s + 1][qt][0], sc[2 * s + 1][qt][1]);
            pf[qt][3] = pk_bf16(sc[2 * s + 1][qt][2], sc[2 * s + 1][qt][3]);
        }
        const unsigned char* plo = rowp + (v0 ^ (64 * s));
        const unsigned char* phi = rowp + (v0 ^ (64 * s) ^ 32);
#pragma unroll
        for (int dt = 0; dt < 4; ++dt) {
            const uint2 lo = *(const uint2*)(plo + dt * 2048);
            const uint2 hi = *(const uint2*)(phi + dt * 2048);
            u32x4 vv;
            vv[0] = lo.x; vv[1] = lo.y; vv[2] = hi.x; vv[3] = hi.y;
            const bf16x8 vf = __builtin_bit_cast(bf16x8, vv);
#pragma unroll
            for (int qt = 0; qt < 2; ++qt)
                o[dt][qt] = __builtin_amdgcn_mfma_f32_16x16x32_bf16(vf, __builtin_bit_cast(bf16x8, pf[qt]), o[dt][qt], 0, 0, 0);
        }
    }
}
DEV float xmax4(float v) { v = fmaxf(v, __shfl_xor(v, 16)); return fmaxf(v, __shfl_xor(v, 32)); }
DEV float xsum4(float v) { v += __shfl_xor(v, 16); return v + __shfl_xor(v, 32); }

DEV void nsa_branch(const int mode, const int BR, const int q0v, const unsigned char* wsb, unsigned char* lds, int b, int g, unsigned blocks, const bf16x8 (&qf)[2][2], const int (&qpos)[2],
                    const unsigned (&selm)[2], const float (&gate)[2], f32x4 (&fin)[4][2], int tid) {
    asm volatile("" : "+v"(tid));
    const int fr = tid & 15, fq = (tid >> 4) & 3;
    const bf16_t* HB = (const bf16_t*)(wsb + WS_HB);
    const bf16_t* VT = (const bf16_t*)(wsb + WS_VT);
    const bf16_t* kb0 = HB + (size_t)(b * S_) * INC + (BR == 0 ? C_KS : C_KW) + g * 64;
    const bf16_t* vb0 = VT + ((((size_t)BR * B_ + b) * 2 + g) * 64) * 2048;
    const bool fake = mode == 1;
    float m[2] = {-1e30f, -1e30f}, l[2] = {0.f, 0.f};
    f32x4 o[4][2];
#pragma unroll
    for (int dt = 0; dt < 4; ++dt)
#pragma unroll
        for (int qt = 0; qt < 2; ++qt) o[dt][qt] = (f32x4){0.f, 0.f, 0.f, 0.f};
    const int lane64 = tid & 63, widx = __builtin_amdgcn_readfirstlane(tid >> 6);
    int kb = __builtin_ctz(blocks);
    blocks &= blocks - 1;
    int kb1 = blocks ? __builtin_ctz(blocks) : -1;
    if (kb1 >= 0) blocks &= blocks - 1;
    nsa_dma_tile(kb0 + (size_t)(fake ? 0 : kb) * 64 * INC, INC, vb0 + (fake ? 0 : kb) * 64, 2048, lds, lane64, widx);
    if (kb1 >= 0) nsa_dma_tile(kb0 + (size_t)(fake ? 0 : kb1) * 64 * INC, INC, vb0 + (fake ? 0 : kb1) * 64, 2048, lds + 16384, lane64, widx);
    int slot = 0;
    while (true) {
        if (kb1 >= 0) asm volatile("s_waitcnt vmcnt(4)\n\ts_waitcnt lgkmcnt(0)" ::: "memory");
        else asm volatile("s_waitcnt vmcnt(0)\n\ts_waitcnt lgkmcnt(0)" ::: "memory");
        __builtin_amdgcn_s_barrier(); asm volatile("" ::: "memory");
        const int kb2 = blocks ? __builtin_ctz(blocks) : -1;
        if (kb2 >= 0) {
            blocks &= blocks - 1;
            const int s2 = slot >= 1 ? slot - 1 : 2;
            nsa_dma_tile(kb0 + (size_t)(fake ? 0 : kb2) * 64 * INC, INC, vb0 + (fake ? 0 : kb2) * 64, 2048, lds + s2 * 16384, lane64, widx);
        }
        const unsigned char* stage = lds + slot * 16384;
        f32x4 sc[4][2];
        nsa_scores(stage, qf, sc, fr, fq);
        constexpr float C1 = 0.125f * 1.4426950408889634f;
        const bool need_mask = (BR == 0) ? (kb == (q0v >> 6)) : !((kb * 64 + 63 <= q0v) && (kb * 64 + 511 >= q0v + 31));
        float alpha[2];
        if (!need_mask) {
#pragma unroll
            for (int qt = 0; qt < 2; ++qt) {
                const bool sel = BR == 0 ? ((selm[qt] >> kb) & 1u) != 0u : true;
                float bm = -1e30f;
#pragma unroll
                for (int kt = 0; kt < 4; ++kt)
#pragma unroll
                    for (int i = 0; i < 4; ++i) {
                        const float s = sel ? sc[kt][qt][i] * C1 : -1e30f;
                        sc[kt][qt][i] = s;
                        bm = fmaxf(bm, s);
                    }
                bm = xmax4(bm);
                const float mn = fmaxf(m[qt], bm);
                alpha[qt] = __builtin_amdgcn_exp2f(m[qt] - mn);
                float ps = 0.f;
#pragma unroll
                for (int kt = 0; kt < 4; ++kt)
#pragma unroll
                    for (int i = 0; i < 4; ++i) {
                        const float s = sc[kt][qt][i];
                        const float e = (s > -1e29f) ? __builtin_amdgcn_exp2f(s - mn) : 0.f;
                        sc[kt][qt][i] = e;
                        ps += e;
                    }
                l[qt] = l[qt] * alpha[qt] + ps;
                m[qt] = mn;
            }
        } else {
#pragma unroll
            for (int qt = 0; qt < 2; ++qt) {
                const bool sel = BR == 0 ? ((selm[qt] >> kb) & 1u) != 0u : true;
                float bm = -1e30f;
#pragma unroll
                for (int kt = 0; kt < 4; ++kt)
#pragma unroll
                    for (int i = 0; i < 4; ++i) {
                        const int key = kb * 64 + kt * 16 + fq * 4 + i;
                        bool valid = sel && (key <= qpos[qt]);
                        if (BR == 1) valid = valid && (key + 511 >= qpos[qt]);
                        const float s = valid ? sc[kt][qt][i] * C1 : -1e30f;
                        sc[kt][qt][i] = s;
                        bm = fmaxf(bm, s);
                    }
                bm = xmax4(bm);
                const float mn = fmaxf(m[qt], bm);
                alpha[qt] = __builtin_amdgcn_exp2f(m[qt] - mn);
                float ps = 0.f;
#pragma unroll
                for (int kt = 0; kt < 4; ++kt)
#pragma unroll
                    for (int i = 0; i < 4; ++i) {
                        const float s = sc[kt][qt][i];
                        const float e = (s > -1e29f) ? __builtin_amdgcn_exp2f(s - mn) : 0.f;
                        sc[kt][qt][i] = e;
                        ps += e;
                    }
                l[qt] = l[qt] * alpha[qt] + ps;
                m[qt] = mn;
            }
        }
        {
#pragma unroll
            for (int qt = 0; qt < 2; ++qt)
#pragma unroll
                for (int dt = 0; dt < 4; ++dt) o[dt][qt] *= alpha[qt];
        }
        if (mode != 3) nsa_pv(stage, sc, o, fr, fq);
        else { asm volatile("" :: "v"(sc[0][0][0]), "v"(sc[1][1][1]), "v"(sc[2][0][2]), "v"(sc[3][1][3])); }
        if (kb1 < 0) break;
        kb = kb1;
        kb1 = kb2;
        slot = slot == 2 ? 0 : slot + 1;
    }
#pragma unroll
    for (int qt = 0; qt < 2; ++qt) {
        const float lt = xsum4(l[qt]);
        const float sc2 = lt > 0.f ? gate[qt] / lt : 0.f;
#pragma unroll
        for (int dt = 0; dt < 4; ++dt) fin[dt][qt] += o[dt][qt] * sc2;
    }
    asm volatile("s_waitcnt lgkmcnt(0)" ::: "memory");
    __builtin_amdgcn_s_barrier(); asm volatile("" ::: "memory");
}

DEV void nsa_item2(const P& p, int b, int g, int qblk, unsigned char* lds, int fake = 0) {
    int tid = threadIdx.x;
    asm volatile("" : "+v"(tid));
    const int lane = tid & 63, wid = tid >> 6, fr = lane & 15, fq = lane >> 4;
    const int q0 = qblk * 32, cur = q0 >> 6, h = g * 4 + wid;
    unsigned char* wsb = p.ws;
    asm volatile("" : "+s"(wsb));
    const bf16_t* HB = (const bf16_t*)(wsb + WS_HB);
    float* IMPW = (float*)(lds + NSA_IMP);
    float* SCORE = (float*)(lds + NSA_SCORE);
    unsigned* SELM = (unsigned*)(lds + NSA_SELM);
    bf16x8 qf[2][2];
    int qpos[2];
#pragma unroll
    for (int qt = 0; qt < 2; ++qt) {
        qpos[qt] = q0 + qt * 16 + fr;
        const bf16_t* rowp = HB + (size_t)(b * S_ + qpos[qt]) * INC;
#pragma unroll
        for (int ks = 0; ks < 2; ++ks) qf[qt][ks] = *(const bf16x8*)(rowp + C_QA + h * 64 + ks * 32 + fq * 8);
    }
    if (tid < 33) SELM[tid] = 0u;
    f32x4 fin[4][2];
#pragma unroll
    for (int dt = 0; dt < 4; ++dt)
#pragma unroll
        for (int qt = 0; qt < 2; ++qt) fin[dt][qt] = (f32x4){0.f, 0.f, 0.f, 0.f};
    {
        const bf16_t* KCB = (const bf16_t*)(wsb + WS_KCB) + (size_t)(b * 2 + g) * 128 * 64;
        const bf16_t* VCT = (const bf16_t*)(wsb + WS_VCT) + (size_t)(b * 2 + g) * 64 * 128;
        {
            const int widx = __builtin_amdgcn_readfirstlane(wid);
            nsa_dma_tile(KCB, 64, VCT, 128, lds, lane, widx);
            nsa_dma_tile(KCB + 64 * 64, 64, VCT + 64, 128, lds + 16384, lane, widx);
            asm volatile("s_waitcnt vmcnt(0)" ::: "memory");
        }
        __syncthreads();
        int nv[2];
        float mx[2] = {-1e30f, -1e30f}, inv[2];
#pragma unroll
        for (int qt = 0; qt < 2; ++qt) nv[qt] = qpos[qt] >= 31 ? (((qpos[qt] - 31) >> 4) + 1) : 0;
#pragma unroll 1
        for (int kb = 0; kb < 2; ++kb) {
            f32x4 sc[4][2];
            nsa_scores(lds + kb * 16384, qf, sc, fr, fq);
#pragma unroll
            for (int qt = 0; qt < 2; ++qt)
#pragma unroll
                for (int kt = 0; kt < 4; ++kt)
#pragma unroll
                    for (int i = 0; i < 4; ++i) {
                        const int n = kb * 64 + kt * 16 + fq * 4 + i;
                        mx[qt] = fmaxf(mx[qt], (n < nv[qt]) ? sc[kt][qt][i] * 0.125f : -1e30f);
                    }
        }
        float ps[2] = {0.f, 0.f};
#pragma unroll
        for (int qt = 0; qt < 2; ++qt) mx[qt] = xmax4(mx[qt]);
#pragma unroll 1
        for (int kb = 0; kb < 2; ++kb) {
            f32x4 sc[4][2];
            nsa_scores(lds + kb * 16384, qf, sc, fr, fq);
#pragma unroll
            for (int qt = 0; qt < 2; ++qt)
#pragma unroll
                for (int kt = 0; kt < 4; ++kt)
#pragma unroll
                    for (int i = 0; i < 4; ++i) {
                        const int n = kb * 64 + kt * 16 + fq * 4 + i;
                        ps[qt] += (n < nv[qt]) ? __expf(sc[kt][qt][i] * 0.125f - mx[qt]) : 0.f;
                    }
        }
#pragma unroll
        for (int qt = 0; qt < 2; ++qt) {
            ps[qt] = xsum4(ps[qt]);
            inv[qt] = ps[qt] > 0.f ? 1.f / ps[qt] : 0.f;
        }
        float prev3[2] = {0.f, 0.f};
#pragma unroll 1
        for (int kb = 0; kb < 2; ++kb) {
            f32x4 sc[4][2];
            nsa_scores(lds + kb * 16384, qf, sc, fr, fq);
#pragma unroll
            for (int qt = 0; qt < 2; ++qt) {
                float* impw = IMPW + (wid * 32 + qt * 16 + fr) * 32 + kb * 16 + fq;
#pragma unroll
                for (int kt = 0; kt < 4; ++kt) {
                    f32x4 pv;
#pragma unroll
                    for (int i = 0; i < 4; ++i) {
                        const int n = kb * 64 + kt * 16 + fq * 4 + i;
                        pv[i] = (n < nv[qt]) ? __expf(sc[kt][qt][i] * 0.125f - mx[qt]) * inv[qt] : 0.f;
                    }
                    sc[kt][qt] = pv;
                    const float c1 = __shfl_up(pv[3], 16);
                    const float c0 = __shfl(prev3[qt], fr + 48);
                    impw[kt * 4] = pv[0] + pv[1] + pv[2] + pv[3] + (fq > 0 ? c1 : c0);
                    prev3[qt] = pv[3];
                }
            }
            nsa_pv(lds + kb * 16384, sc, fin, fr, fq);
        }
#pragma unroll
        for (int qt = 0; qt < 2; ++qt) {
            const float gc = fsigmoid(bf2f(HB[(size_t)(b * S_ + qpos[qt]) * INC + C_GATE + h * 3 + 0]));
#pragma unroll
            for (int dt = 0; dt < 4; ++dt) fin[dt][qt] *= gc;
        }
    }
    __syncthreads();
    {
        const int q = tid >> 3, jg = tid & 7;
#pragma unroll
        for (int u = 0; u < 4; ++u) {
            const int j = jg * 4 + u;
            const float imp = IMPW[(0 * 32 + q) * 32 + j] + IMPW[(1 * 32 + q) * 32 + j] + IMPW[(2 * 32 + q) * 32 + j] + IMPW[(3 * 32 + q) * 32 + j];
            float score;
            if (j > cur) score = -INFINITY;
            else if (j == 0 || j == cur || j == cur - 1) score = 1e4f;
            else score = imp;
            SCORE[q * 33 + j] = score;
        }
        __syncthreads();
        unsigned bits = 0u;
#pragma unroll
        for (int u = 0; u < 4; ++u) {
            const int j = jg * 4 + u;
            const float sj = SCORE[q * 33 + j];
            int rank = 0;
#pragma unroll 8
            for (int i = 0; i < 32; ++i) {
                const float si = SCORE[q * 33 + i];
                rank += ((si > sj) || (si == sj && i < j)) ? 1 : 0;
            }
            if (j <= cur && rank < 16) bits |= 1u << j;
        }
        atomicOr(&SELM[q], bits);
        atomicOr(&SELM[32], bits);
        __syncthreads();
    }
    unsigned selm[2];
    selm[0] = SELM[fr];
    selm[1] = SELM[16 + fr];
    const unsigned um = SELM[32];
    __syncthreads();
#pragma unroll 1
    for (int br = 0; br < 2; ++br) {
        const int wlo = (q0 - 511) > 0 ? ((q0 - 511) >> 6) : 0;
        const unsigned wmask = ((2u << cur) - 1u) & ~((1u << wlo) - 1u);
        float gs[2];
#pragma unroll
        for (int qt = 0; qt < 2; ++qt) gs[qt] = fsigmoid(bf2f(HB[(size_t)(b * S_ + qpos[qt]) * INC + C_GATE + h * 3 + 1 + br]));
        if (fake != 2) nsa_branch(fake, br, q0, wsb, lds, b, g, br ? wmask : um, qf, qpos, selm, gs, fin, tid);
    }
    bf16_t* OM = (bf16_t*)(wsb + WS_OM);
#pragma unroll
    for (int qt = 0; qt < 2; ++qt)
#pragma unroll
        for (int dt = 0; dt < 4; ++dt) {
            uint2 u2;
            u2.x = pk_bf16(fin[dt][qt][0], fin[dt][qt][1]);
            u2.y = pk_bf16(fin[dt][qt][2], fin[dt][qt][3]);
            *(uint2*)(OM + (size_t)(b * S_ + qpos[qt]) * 1024 + h * 64 + dt * 16 + fq * 4) = u2;
        }
}

DEV void hgrn_prep_item(const P& p, int item, float* smem) {
    const int c = item & 31, bh = item >> 5, hh = bh & 3, b = bh >> 2;
    const int tid = threadIdx.x, d = tid & 127, th = tid >> 7;
    const bf16_t* HB = (const bf16_t*)(p.ws + WS_HB);
    unsigned char* hs = (unsigned char*)p.out;
    bf16_t* QT = (bf16_t*)(hs + HS_QT);
    bf16_t* KT = (bf16_t*)(hs + HS_KT);
    bf16_t* KHT = (bf16_t*)(hs + HS_KHT);
    bf16_t* VIT = (bf16_t*)(hs + HS_VIT);
    float lbv;
    {
        const float l0 = p.lb_logits[hh * 128 + d], l1 = p.lb_logits[512 + hh * 128 + d];
        const float mx = fmaxf(l0, l1);
        const float e0 = expf(l0 - mx), e1 = expf(l1 - mx);
        lbv = e0 / (e0 + e1);
    }
    const size_t trow0 = (size_t)b * S_ + c * 64 + th * 32;
    float kk[32], bl[32];
    float run = 0.f;
#pragma unroll
    for (int i = 0; i < 32; ++i) {
        const float fl = bf2f(HB[(trow0 + i) * INC + C_HF + hh * 128 + d]);
        const float f = lbv + (1.f - lbv) * fsigmoid(fl);
        kk[i] = 1.f - f;
        run += __logf(f);
        bl[i] = run;
    }
    smem[th * 128 + d] = run;
    __syncthreads();
    const float off = th ? smem[d] : 0.f;
    const float blast = smem[d] + smem[128 + d];
    unsigned kh[16], vi[16];
#pragma unroll
    for (int i = 0; i < 32; i += 2) {
        float qv[2], kt[2], khv[2], vv[2];
#pragma unroll
        for (int u = 0; u < 2; ++u) {
            const float bb = bl[i + u] + off;
            const size_t tr = trow0 + i + u;
            const float q = bf2f(HB[tr * INC + C_HQ + hh * 128 + d]);
            vv[u] = bf2f(HB[tr * INC + C_HI + hh * 128 + d]);
            qv[u] = q * __expf(bb);
            kt[u] = kk[i + u] * __expf(fminf(-bb, 80.f));
            khv[u] = kk[i + u] * __expf(blast - bb);
            const size_t o = ((size_t)bh * 2048 + c * 64 + th * 32 + i + u) * 128 + d;
            QT[o] = f2bf(qv[u]);
            KT[o] = f2bf(kt[u]);
        }
        kh[i >> 1] = pk_bf16(khv[0], khv[1]);
        vi[i >> 1] = pk_bf16(vv[0], vv[1]);
    }
    {
        const size_t o = ((size_t)bh * 128 + d) * 2048 + c * 64 + th * 32;
#pragma unroll
        for (int j = 0; j < 4; ++j) {
            u32x4 a, bq;
            a[0] = kh[4 * j]; a[1] = kh[4 * j + 1]; a[2] = kh[4 * j + 2]; a[3] = kh[4 * j + 3];
            bq[0] = vi[4 * j]; bq[1] = vi[4 * j + 1]; bq[2] = vi[4 * j + 2]; bq[3] = vi[4 * j + 3];
            *(u32x4*)(KHT + o + j * 8) = a;
            *(u32x4*)(VIT + o + j * 8) = bq;
        }
    }
    if (th == 0) ((float*)(p.ws + WS_EB))[((size_t)bh * 32 + c) * 128 + d] = expf(blast);
    __syncthreads();
}

DEV bf16x8 ld2x8(const bf16_t* p0, const bf16_t* p1) {
    const uint2 lo = *(const uint2*)p0, hi = *(const uint2*)p1;
    u32x4 v;
    v[0] = lo.x; v[1] = lo.y; v[2] = hi.x; v[3] = hi.y;
    return __builtin_bit_cast(bf16x8, v);
}
struct HgRegs { u32x4 a[4], b[4]; };
DEV void hg_loadA(HgRegs& r, const bf16_t* KT, const bf16_t* QT, int s0, int tid) {
    const unsigned off = (unsigned)(((tid >> 4) * 128 + (tid & 15) * 8) * 2);
    const char* kb = (const char*)(KT + (size_t)s0 * 128);
    const char* qb = (const char*)(QT + (size_t)s0 * 128);
#pragma unroll
    for (int i = 0; i < 4; ++i) {
        r.a[i] = *(const u32x4*)(kb + i * 4096 + off);
        r.b[i] = *(const u32x4*)(qb + i * 4096 + off);
    }
}
DEV void hg_storeA(const HgRegs& r, unsigned char* lds, int tid) {
    const int c16 = tid & 15, r16 = tid >> 4;
    const int o16 = r16 * 256 + ((c16 ^ (r16 & 15)) << 4);
#pragma unroll
    for (int i = 0; i < 4; ++i) {
        *(u32x4*)(lds + o16 + i * 4096) = r.a[i];
        *(u32x4*)(lds + 16384 + o16 + i * 4096) = r.b[i];
    }
}
DEV void hg_loadB(HgRegs& r, const bf16_t* KHT, const bf16_t* VIT, int s0, int tid) {
    const unsigned off = (unsigned)(((tid >> 3) * 2048 + (tid & 7) * 8) * 2);
    const char* kb = (const char*)(KHT + s0);
    const char* vb = (const char*)(VIT + s0);
#pragma unroll
    for (int i = 0; i < 4; ++i) {
        r.a[i] = *(const u32x4*)(kb + (size_t)i * 131072 + off);
        r.b[i] = *(const u32x4*)(vb + (size_t)i * 131072 + off);
    }
}
DEV void hg_storeB(const HgRegs& r, unsigned char* lds, int tid) {
    const int c8 = tid & 7, r8 = tid >> 3;
    const int o8 = r8 * 128 + ((c8 ^ ((r8 >> 1) & 7)) << 4);
#pragma unroll
    for (int i = 0; i < 4; ++i) {
        *(u32x4*)(lds + 32768 + o8 + i * 4096) = r.a[i];
        *(u32x4*)(lds + 49152 + o8 + i * 4096) = r.b[i];
    }
}
DEV void hgrn_chain_item(const P& p, int bh, unsigned char* lds) {
    const int hh = bh & 3, b = bh >> 2;
    int tid = threadIdx.x;
    asm volatile("" : "+v"(tid));
    const int lane = tid & 63, wid = tid >> 6, fr = lane & 15, fq = lane >> 4;
    const unsigned char* hs = (const unsigned char*)p.out;
    const bf16_t* QT = (const bf16_t*)(hs + HS_QT) + (size_t)bh * 2048 * 128;
    const bf16_t* KT = (const bf16_t*)(hs + HS_KT) + (size_t)bh * 2048 * 128;
    const bf16_t* KHT = (const bf16_t*)(hs + HS_KHT) + (size_t)bh * 128 * 2048;
    const bf16_t* VIT = (const bf16_t*)(hs + HS_VIT) + (size_t)bh * 128 * 2048;
    const float* EB = (const float*)(p.ws + WS_EB) + (size_t)bh * 32 * 128;
    const bf16_t* HB = (const bf16_t*)(p.ws + WS_HB);
    bf16_t* OM = (bf16_t*)(p.ws + WS_OM);
    const unsigned char* sKT = lds;
    const unsigned char* sQT = lds + 16384;
    const unsigned char* sKH = lds + 32768;
    const unsigned char* sVI = lds + 49152;
    bf16_t* AT = (bf16_t*)lds;
    float* SS = (float*)(lds + 65536);
    f32x4 S[8][2];
#pragma unroll
    for (int i = 0; i < 8; ++i)
#pragma unroll
        for (int j = 0; j < 2; ++j) S[i][j] = (f32x4){0.f, 0.f, 0.f, 0.f};
    const int dv0 = wid * 32;
    const int sw8 = (fr >> 1) & 7;
    int b256[4];
#pragma unroll
    for (int ks = 0; ks < 4; ++ks) b256[ks] = fr * 256 + (((4 * ks + fq) ^ fr) << 4);
    int p256[4][2];
#pragma unroll
    for (int u = 0; u < 4; ++u)
#pragma unroll
        for (int h = 0; h < 2; ++h) p256[u][h] = fr * 256 + (((4 * u + 2 * h + (fq >> 1)) ^ fr) << 4) + 8 * (fq & 1);
    int b128[2];
#pragma unroll
    for (int ks = 0; ks < 2; ++ks) b128[ks] = fr * 128 + (((4 * ks + fq) ^ sw8) << 4);
    {
        HgRegs r;
        hg_loadA(r, KT, QT, 0, tid);
        hg_storeA(r, lds, tid);
        hg_loadB(r, KHT, VIT, 0, tid);
        hg_storeB(r, lds, tid);
    }
    __syncthreads();
#pragma unroll 1
    for (int c = 0; c < 32; ++c) {
        const int s0 = c * 64;
        HgRegs nx;
        if (c + 1 < 32) hg_loadA(nx, KT, QT, s0 + 64, tid);
        uint2 atp[4];
        {
            bf16x8 qf[4];
#pragma unroll
            for (int ks = 0; ks < 4; ++ks) qf[ks] = *(const bf16x8*)(sQT + wid * 4096 + b256[ks]);
#pragma unroll
            for (int st = 0; st < 4; ++st) {
                f32x4 a = (f32x4){0.f, 0.f, 0.f, 0.f};
#pragma unroll
                for (int ks = 0; ks < 4; ++ks) {
                    const bf16x8 kf = *(const bf16x8*)(sKT + st * 4096 + b256[ks]);
                    a = __builtin_amdgcn_mfma_f32_16x16x32_bf16(kf, qf[ks], a, 0, 0, 0);
                }
                const int t = wid * 16 + fr;
                float av[4];
#pragma unroll
                for (int i = 0; i < 4; ++i) av[i] = (st * 16 + fq * 4 + i <= t) ? a[i] : 0.f;
                atp[st].x = pk_bf16(av[0], av[1]);
                atp[st].y = pk_bf16(av[2], av[3]);
            }
        }
        __syncthreads();
#pragma unroll
        for (int st = 0; st < 4; ++st) *(uint2*)(AT + (wid * 16 + fr) * 72 + st * 16 + fq * 4) = atp[st];
        __syncthreads();
        f32x4 o[2][4];
#pragma unroll
        for (int i = 0; i < 2; ++i)
#pragma unroll
            for (int j = 0; j < 4; ++j) o[i][j] = (f32x4){0.f, 0.f, 0.f, 0.f};
        bf16x8 vf[2][2];
#pragma unroll
        for (int dvt = 0; dvt < 2; ++dvt)
#pragma unroll
            for (int ks = 0; ks < 2; ++ks) vf[dvt][ks] = *(const bf16x8*)(sVI + wid * 4096 + dvt * 2048 + b128[ks]);
#pragma unroll
        for (int ks = 0; ks < 2; ++ks)
#pragma unroll
            for (int tt = 0; tt < 4; ++tt) {
                const bf16x8 af = *(const bf16x8*)(AT + (tt * 16 + fr) * 72 + ks * 32 + fq * 8);
#pragma unroll
                for (int dvt = 0; dvt < 2; ++dvt) o[dvt][tt] = __builtin_amdgcn_mfma_f32_16x16x32_bf16(vf[dvt][ks], af, o[dvt][tt], 0, 0, 0);
            }
#pragma unroll
        for (int u = 0; u < 4; ++u) {
            bf16x8 sf[2];
#pragma unroll
            for (int dvt = 0; dvt < 2; ++dvt) {
                u32x4 w;
                w[0] = pk_bf16(S[2 * u][dvt][0], S[2 * u][dvt][1]);
                w[1] = pk_bf16(S[2 * u][dvt][2], S[2 * u][dvt][3]);
                w[2] = pk_bf16(S[2 * u + 1][dvt][0], S[2 * u + 1][dvt][1]);
                w[3] = pk_bf16(S[2 * u + 1][dvt][2], S[2 * u + 1][dvt][3]);
                sf[dvt] = __builtin_bit_cast(bf16x8, w);
            }
#pragma unroll
            for (int tt = 0; tt < 4; ++tt) {
                const uint2 lo = *(const uint2*)(sQT + tt * 4096 + p256[u][0]);
                const uint2 hi = *(const uint2*)(sQT + tt * 4096 + p256[u][1]);
                u32x4 w;
                w[0] = lo.x; w[1] = lo.y; w[2] = hi.x; w[3] = hi.y;
                const bf16x8 qf2 = __builtin_bit_cast(bf16x8, w);
#pragma unroll
                for (int dvt = 0; dvt < 2; ++dvt) o[dvt][tt] = __builtin_amdgcn_mfma_f32_16x16x32_bf16(sf[dvt], qf2, o[dvt][tt], 0, 0, 0);
            }
        }
        u32x4 op[4];
#pragma unroll
        for (int tt = 0; tt < 4; ++tt) {
            float ss = 0.f;
#pragma unroll
            for (int dvt = 0; dvt < 2; ++dvt)
#pragma unroll
                for (int i = 0; i < 4; ++i) ss += o[dvt][tt][i] * o[dvt][tt][i];
            ss = xsum4(ss);
            if (fq == 0) SS[wid * 64 + tt * 16 + fr] = ss;
            op[tt][0] = pk_bf16(o[0][tt][0], o[0][tt][1]);
            op[tt][1] = pk_bf16(o[0][tt][2], o[0][tt][3]);
            op[tt][2] = pk_bf16(o[1][tt][0], o[1][tt][1]);
            op[tt][3] = pk_bf16(o[1][tt][2], o[1][tt][3]);
        }
        __syncthreads();
        if (c + 1 < 32) { hg_storeA(nx, lds, tid); hg_loadB(nx, KHT, VIT, s0 + 64, tid); }
        uint2 gg[4][2];
#pragma unroll
        for (int tt = 0; tt < 4; ++tt)
#pragma unroll
            for (int dvt = 0; dvt < 2; ++dvt)
                gg[tt][dvt] = *(const uint2*)(HB + ((size_t)b * S_ + s0 + tt * 16 + fr) * INC + C_HG + hh * 128 + dv0 + dvt * 16 + fq * 4);
        {
            bf16x8 vf3[2][2];
#pragma unroll
            for (int dvt = 0; dvt < 2; ++dvt)
#pragma unroll
                for (int ks = 0; ks < 2; ++ks) vf3[dvt][ks] = *(const bf16x8*)(sVI + wid * 4096 + dvt * 2048 + b128[ks]);
#pragma unroll
            for (int dkt = 0; dkt < 8; ++dkt) {
                const float4 eb = *(const float4*)(EB + c * 128 + dkt * 16 + fq * 4);
                bf16x8 kf[2];
#pragma unroll
                for (int ks = 0; ks < 2; ++ks) kf[ks] = *(const bf16x8*)(sKH + dkt * 2048 + b128[ks]);
#pragma unroll
                for (int dvt = 0; dvt < 2; ++dvt) {
                    f32x4 a = S[dkt][dvt];
                    a[0] *= eb.x; a[1] *= eb.y; a[2] *= eb.z; a[3] *= eb.w;
                    a = __builtin_amdgcn_mfma_f32_16x16x32_bf16(kf[0], vf3[dvt][0], a, 0, 0, 0);
                    a = __builtin_amdgcn_mfma_f32_16x16x32_bf16(kf[1], vf3[dvt][1], a, 0, 0, 0);
                    S[dkt][dvt] = a;
                }
            }
        }
        __syncthreads();
        if (c + 1 < 32) hg_storeB(nx, lds, tid);
#pragma unroll
        for (int tt = 0; tt < 4; ++tt) {
            const int t = tt * 16 + fr;
            const float tot = SS[t] + SS[64 + t] + SS[128 + t] + SS[192 + t];
            const float rs = rsqrtf(tot * (1.f / 128.f) + LN_EPS);
            const size_t tg = (size_t)b * S_ + s0 + t;
#pragma unroll
            for (int dvt = 0; dvt < 2; ++dvt) {
                const int dv = dv0 + dvt * 16 + fq * 4;
                const float g0 = bflo(gg[tt][dvt].x), g1 = bfhi(gg[tt][dvt].x), g2 = bflo(gg[tt][dvt].y), g3 = bfhi(gg[tt][dvt].y);
                const float4 nwv = *(const float4*)(p.hg_norm_w + hh * 128 + dv);
                const unsigned w0 = op[tt][2 * dvt], w1 = op[tt][2 * dvt + 1];
                const float r0 = bflo(w0) * rs * nwv.x * (g0 * fsigmoid(g0));
                const float r1 = bfhi(w0) * rs * nwv.y * (g1 * fsigmoid(g1));
                const float r2 = bflo(w1) * rs * nwv.z * (g2 * fsigmoid(g2));
                const float r3 = bfhi(w1) * rs * nwv.w * (g3 * fsigmoid(g3));
                uint2 u2;
                u2.x = pk_bf16(r0, r1);
                u2.y = pk_bf16(r2, r3);
                *(uint2*)(OM + tg * 1024 + 512 + hh * 128 + dv) = u2;
            }
        }
        __syncthreads();
    }
}


DEV void hgrn_prep_item2(const P& p, int item, unsigned char* lds) {
    const int c = item & 31, bh = item >> 5, hh = bh & 3, b = bh >> 2;
    int tid = threadIdx.x;
    asm volatile("" : "+v"(tid));
    const int d = tid & 127, th = tid >> 7;
    const int lane = tid & 63, wid = tid >> 6, fr = lane & 15, fq = lane >> 4;
    const bf16_t* HB = (const bf16_t*)(p.ws + WS_HB);
    unsigned char* hs = (unsigned char*)p.out;
    bf16_t* QTg = (bf16_t*)(hs + HS_QT);
    bf16_t* OIg = (bf16_t*)(hs + HS_OI);
    uint2* DSg = (uint2*)(hs + HS_DS);
    float* tots = (float*)(lds + 65536);
    unsigned char* sKT = lds;
    unsigned char* sQT = lds + 16384;
    unsigned char* sKH = lds + 32768;
    unsigned char* sVI = lds + 49152;
    float lbv;
    {
        const float l0 = p.lb_logits[hh * 128 + d], l1 = p.lb_logits[512 + hh * 128 + d];
        const float mx = fmaxf(l0, l1);
        const float e0 = expf(l0 - mx), e1 = expf(l1 - mx);
        lbv = e0 / (e0 + e1);
    }
    const size_t trow0 = (size_t)b * S_ + c * 64 + th * 32;
    const float nwd = p.hg_norm_w[hh * 128 + d];
    float bl[32];
    float run = 0.f;
#pragma unroll
    for (int i = 0; i < 32; ++i) {
        const float fl = bf2f(HB[(trow0 + i) * INC + C_HF + hh * 128 + d]);
        const float f = lbv + (1.f - lbv) * fsigmoid(fl);
        run += __logf(f);
        bl[i] = run;
    }
    tots[th * 128 + d] = run;
    __syncthreads();
    const float off = th ? tots[d] : 0.f;
    const float blast = tots[d] + tots[128 + d];
#pragma unroll
    for (int j = 0; j < 4; ++j) {
        u32x4 a, bq;
#pragma unroll
        for (int i2 = 0; i2 < 4; ++i2) {
            float khv[2], vv[2];
#pragma unroll
            for (int u = 0; u < 2; ++u) {
                const int i = j * 8 + i2 * 2 + u;
                const float bb = bl[i] + off;
                const float kki = 1.f - __expf(bl[i] - (i ? bl[i > 0 ? i - 1 : 0] : 0.f));
                const size_t tr = trow0 + i;
                const float q = bf2f(HB[tr * INC + C_HQ + hh * 128 + d]);
                vv[u] = bf2f(HB[tr * INC + C_HI + hh * 128 + d]);
                const bf16_t qv = f2bf(q * __expf(bb));
                const bf16_t kt = f2bf(kki * __expf(fminf(-bb, 80.f)));
                khv[u] = kki * __expf(blast - bb);
                const int t = th * 32 + i;
                QTg[((size_t)bh * 2048 + c * 64 + t) * 128 + d] = qv;
                {
                    const float gv = bf2f(HB[tr * INC + C_HG + hh * 128 + d]);
                    ((bf16_t*)(p.ws + WS_XB))[((size_t)bh * 2048 + c * 64 + t) * 128 + d] = f2bf(nwd * gv * fsigmoid(gv));
                }
                const int off256 = t * 256 + ((((d >> 3) ^ (t & 15))) << 4) + (d & 7) * 2;
                *(bf16_t*)(sQT + off256) = qv;
                *(bf16_t*)(sKT + off256) = kt;
            }
            a[i2] = pk_bf16(khv[0], khv[1]);
            bq[i2] = pk_bf16(vv[0], vv[1]);
        }
        const int off128 = d * 128 + (((th * 4 + j) ^ ((d >> 1) & 7)) << 4);
        *(u32x4*)(sKH + off128) = a;
        *(u32x4*)(sVI + off128) = bq;
    }
    if (th == 0) ((float*)(p.ws + WS_EB))[((size_t)bh * 32 + c) * 128 + d] = __expf(blast);
    __syncthreads();
    const int sw8 = (fr >> 1) & 7;
    int b256[4];
#pragma unroll
    for (int ks = 0; ks < 4; ++ks) b256[ks] = fr * 256 + (((4 * ks + fq) ^ fr) << 4);
    int b128[2];
#pragma unroll
    for (int ks = 0; ks < 2; ++ks) b128[ks] = fr * 128 + (((4 * ks + fq) ^ sw8) << 4);
    uint2 atp[4];
    {
        bf16x8 qf[4];
#pragma unroll
        for (int ks = 0; ks < 4; ++ks) qf[ks] = *(const bf16x8*)(sQT + wid * 4096 + b256[ks]);
#pragma unroll
        for (int st = 0; st < 4; ++st) {
            f32x4 a = (f32x4){0.f, 0.f, 0.f, 0.f};
#pragma unroll
            for (int ks = 0; ks < 4; ++ks) {
                const bf16x8 kf = *(const bf16x8*)(sKT + st * 4096 + b256[ks]);
                a = __builtin_amdgcn_mfma_f32_16x16x32_bf16(kf, qf[ks], a, 0, 0, 0);
            }
            const int t = wid * 16 + fr;
            float av[4];
#pragma unroll
            for (int i = 0; i < 4; ++i) av[i] = (st * 16 + fq * 4 + i <= t) ? a[i] : 0.f;
            atp[st].x = pk_bf16(av[0], av[1]);
            atp[st].y = pk_bf16(av[2], av[3]);
        }
    }
    __syncthreads();
    bf16_t* AT = (bf16_t*)lds;
#pragma unroll
    for (int st = 0; st < 4; ++st) *(uint2*)(AT + (wid * 16 + fr) * 72 + st * 16 + fq * 4) = atp[st];
    __syncthreads();
    const int dv0 = wid * 32;
    bf16x8 vf[2][2];
#pragma unroll
    for (int dvt = 0; dvt < 2; ++dvt)
#pragma unroll
        for (int ks = 0; ks < 2; ++ks) vf[dvt][ks] = *(const bf16x8*)(sVI + wid * 4096 + dvt * 2048 + b128[ks]);
#pragma unroll
    for (int tt = 0; tt < 4; ++tt) {
        f32x4 o0 = (f32x4){0.f, 0.f, 0.f, 0.f}, o1 = (f32x4){0.f, 0.f, 0.f, 0.f};
#pragma unroll
        for (int ks = 0; ks < 2; ++ks) {
            const bf16x8 af = *(const bf16x8*)(AT + (tt * 16 + fr) * 72 + ks * 32 + fq * 8);
            o0 = __builtin_amdgcn_mfma_f32_16x16x32_bf16(vf[0][ks], af, o0, 0, 0, 0);
            o1 = __builtin_amdgcn_mfma_f32_16x16x32_bf16(vf[1][ks], af, o1, 0, 0, 0);
        }
        bf16_t* op = OIg + ((size_t)bh * 2048 + c * 64 + tt * 16 + fr) * 128 + dv0 + fq * 4;
        *(uint2*)op = make_uint2(pk_bf16(o0[0], o0[1]), pk_bf16(o0[2], o0[3]));
        *(uint2*)(op + 16) = make_uint2(pk_bf16(o1[0], o1[1]), pk_bf16(o1[2], o1[3]));
    }
    uint2* dsp = DSg + ((((size_t)bh * 32 + c) * 4 + wid) * 16) * 64 + lane;
#pragma unroll
    for (int dkt = 0; dkt < 8; ++dkt) {
        bf16x8 kf[2];
#pragma unroll
        for (int ks = 0; ks < 2; ++ks) kf[ks] = *(const bf16x8*)(sKH + dkt * 2048 + b128[ks]);
#pragma unroll
        for (int dvt = 0; dvt < 2; ++dvt) {
            f32x4 a = (f32x4){0.f, 0.f, 0.f, 0.f};
            a = __builtin_amdgcn_mfma_f32_16x16x32_bf16(kf[0], vf[dvt][0], a, 0, 0, 0);
            a = __builtin_amdgcn_mfma_f32_16x16x32_bf16(kf[1], vf[dvt][1], a, 0, 0, 0);
            dsp[(dkt * 2 + dvt) * 64] = make_uint2(pk_bf16(a[0], a[1]), pk_bf16(a[2], a[3]));
        }
    }
    __syncthreads();
}

DEV void hgrn_chain_item3(const P& p, int item, unsigned char* lds) {
    const int bh = item >> 1, half = item & 1, hh = bh & 3, b = bh >> 2;
    int tid = threadIdx.x;
    asm volatile("" : "+v"(tid));
    const int lane = tid & 63, wid = __builtin_amdgcn_readfirstlane(tid >> 6), fr = lane & 15, fq = lane >> 4;
    const int gd = half * 4 + wid;
    const unsigned char* hs = (const unsigned char*)p.out;
    const bf16_t* QTg = (const bf16_t*)(hs + HS_QT) + (size_t)bh * 2048 * 128;
    const char* OIb = (const char*)(hs + HS_OI) + ((size_t)bh * 2048 * 128 + gd * 16) * 2;
    const unsigned oioff = (unsigned)((fr * 128 + fq * 4) * 2);
    const char* DSb = (const char*)(hs + HS_DS) + (((size_t)bh * 32 * 4 + (gd >> 1)) * 16 * 64) * 8 + (gd & 1) * 512;
    const unsigned dsoff = (unsigned)(lane * 8);
    const char* GGb = (const char*)(p.ws + WS_XB) + ((size_t)bh * 2048 * 128 + gd * 16) * 2;
    const float* EB = (const float*)(p.ws + WS_EB) + (size_t)bh * 32 * 128;
    float* SSP = (float*)(p.ws + WS_SSP) + ((size_t)bh * 8 + gd) * 2048;
    bf16_t* OM = (bf16_t*)(p.ws + WS_OM);
    int p256[4][2];
#pragma unroll
    for (int u = 0; u < 4; ++u)
#pragma unroll
        for (int h = 0; h < 2; ++h) p256[u][h] = fr * 256 + (((4 * u + 2 * h + (fq >> 1)) ^ fr) << 4) + 8 * (fq & 1);
    const int c16 = tid & 15, r16 = tid >> 4;
    const int o16 = r16 * 256 + ((c16 ^ (r16 & 15)) << 4);
    const unsigned qoff = (unsigned)((r16 * 128 + c16 * 8) * 2);
    f32x4 S[8];
#pragma unroll
    for (int i = 0; i < 8; ++i) S[i] = (f32x4){0.f, 0.f, 0.f, 0.f};
    uint2 oi[4], dsr[8];
    {
        const char* qb = (const char*)QTg;
#pragma unroll
        for (int i = 0; i < 4; ++i) *(u32x4*)(lds + o16 + i * 4096) = *(const u32x4*)(qb + i * 4096 + qoff);
        if (tid < 32) *(u32x4*)(lds + 32768 + tid * 16) = *(const u32x4*)(EB + tid * 4);
#pragma unroll
        for (int tt = 0; tt < 4; ++tt) oi[tt] = *(const uint2*)(OIb + tt * 4096 + oioff);
#pragma unroll
        for (int dkt = 0; dkt < 8; ++dkt) dsr[dkt] = *(const uint2*)(DSb + dkt * 1024 + dsoff);
    }
    __syncthreads();
#pragma unroll 1
    for (int c = 0; c < 32; ++c) {
        const int s0 = c * 64;
        const bool more = c + 1 < 32;
        const unsigned char* sQ = lds + (c & 1) * 16384;
        const float* EBL = (const float*)(lds + 32768 + (c & 1) * 512);
        u32x4 qn[4], ebn;
        if (more) {
            const char* qb = (const char*)(QTg + (size_t)(s0 + 64) * 128);
#pragma unroll
            for (int i = 0; i < 4; ++i) qn[i] = *(const u32x4*)(qb + i * 4096 + qoff);
            if (tid < 32) ebn = *(const u32x4*)(EB + (c + 1) * 128 + tid * 4);
        }
        uint2 gg[4];
#pragma unroll
        for (int tt = 0; tt < 4; ++tt) gg[tt] = *(const uint2*)(GGb + (size_t)s0 * 256 + tt * 4096 + oioff);
        f32x4 o[4];
#pragma unroll
        for (int tt = 0; tt < 4; ++tt) {
            o[tt] = (f32x4){bflo(oi[tt].x), bfhi(oi[tt].x), bflo(oi[tt].y), bfhi(oi[tt].y)};
            if (more) oi[tt] = *(const uint2*)(OIb + (size_t)(s0 + 64) * 256 + tt * 4096 + oioff);
        }
#pragma unroll
        for (int u = 0; u < 4; ++u) {
            u32x4 w;
            w[0] = pk_bf16(S[2 * u][0], S[2 * u][1]);
            w[1] = pk_bf16(S[2 * u][2], S[2 * u][3]);
            w[2] = pk_bf16(S[2 * u + 1][0], S[2 * u + 1][1]);
            w[3] = pk_bf16(S[2 * u + 1][2], S[2 * u + 1][3]);
            const bf16x8 sf = __builtin_bit_cast(bf16x8, w);
#pragma unroll
            for (int tt = 0; tt < 4; ++tt) {
                const uint2 lo = *(const uint2*)(sQ + tt * 4096 + p256[u][0]);
                const uint2 hi = *(const uint2*)(sQ + tt * 4096 + p256[u][1]);
                u32x4 q4;
                q4[0] = lo.x; q4[1] = lo.y; q4[2] = hi.x; q4[3] = hi.y;
                o[tt] = __builtin_amdgcn_mfma_f32_16x16x32_bf16(sf, __builtin_bit_cast(bf16x8, q4), o[tt], 0, 0, 0);
            }
        }
#pragma unroll
        for (int dkt = 0; dkt < 8; ++dkt) {
            const float4 eb = *(const float4*)(EBL + dkt * 16 + fq * 4);
            const uint2 dd = dsr[dkt];
            S[dkt][0] = fmaf(S[dkt][0], eb.x, bflo(dd.x));
            S[dkt][1] = fmaf(S[dkt][1], eb.y, bfhi(dd.x));
            S[dkt][2] = fmaf(S[dkt][2], eb.z, bflo(dd.y));
            S[dkt][3] = fmaf(S[dkt][3], eb.w, bfhi(dd.y));
            if (more) dsr[dkt] = *(const uint2*)(DSb + (size_t)(c + 1) * 32768 + dkt * 1024 + dsoff);
        }
#pragma unroll
        for (int tt = 0; tt < 4; ++tt) {
            float ss = o[tt][0] * o[tt][0] + o[tt][1] * o[tt][1] + o[tt][2] * o[tt][2] + o[tt][3] * o[tt][3];
            ss = xsum4(ss);
            if (fq == 0) SSP[s0 + tt * 16 + fr] = ss;
            const size_t tg = (size_t)b * S_ + s0 + tt * 16 + fr;
            const float r0 = o[tt][0] * bflo(gg[tt].x), r1 = o[tt][1] * bfhi(gg[tt].x), r2 = o[tt][2] * bflo(gg[tt].y), r3 = o[tt][3] * bfhi(gg[tt].y);
            *(uint2*)(OM + tg * 1024 + 512 + hh * 128 + gd * 16 + fq * 4) = make_uint2(pk_bf16(r0, r1), pk_bf16(r2, r3));
        }
        if (more) {
            unsigned char* nq = lds + ((c + 1) & 1) * 16384;
#pragma unroll
            for (int i = 0; i < 4; ++i) *(u32x4*)(nq + o16 + i * 4096) = qn[i];
            if (tid < 32) *(u32x4*)(lds + 32768 + ((c + 1) & 1) * 512 + tid * 16) = ebn;
        }
        __syncthreads();
    }
}

DEV void hgrn_chain_item2(const P& p, int bh, unsigned char* lds) {
    const int hh = bh & 3, b = bh >> 2;
    int tid = threadIdx.x;
    asm volatile("" : "+v"(tid));
    const int lane = tid & 63, wid = __builtin_amdgcn_readfirstlane(tid >> 6), fr = lane & 15, fq = lane >> 4;
    const unsigned char* hs = (const unsigned char*)p.out;
    const bf16_t* QTg = (const bf16_t*)(hs + HS_QT) + (size_t)bh * 2048 * 128;
    const char* OIb = (const char*)(hs + HS_OI) + ((size_t)bh * 2048 * 128 + wid * 32) * 2;
    const unsigned oioff = (unsigned)((fr * 128 + fq * 4) * 2);
    const char* DSb = (const char*)(hs + HS_DS) + (((size_t)bh * 32 * 4 + wid) * 16 * 64) * 8;
    const unsigned dsoff = (unsigned)(lane * 8);
    const char* GGb = (const char*)(p.ws + WS_XB) + ((size_t)bh * 2048 * 128 + wid * 32) * 2;
    const unsigned ggoff = oioff;
    const float* EB = (const float*)(p.ws + WS_EB) + (size_t)bh * 32 * 128;
    bf16_t* OM = (bf16_t*)(p.ws + WS_OM);
    float* EBL = (float*)(lds + 16384);
    float* SS = (float*)(lds + 16896);
    const int dv0 = wid * 32;
    int p256[4][2];
#pragma unroll
    for (int u = 0; u < 4; ++u)
#pragma unroll
        for (int h = 0; h < 2; ++h) p256[u][h] = fr * 256 + (((4 * u + 2 * h + (fq >> 1)) ^ fr) << 4) + 8 * (fq & 1);
    const int c16 = tid & 15, r16 = tid >> 4;
    const int o16 = r16 * 256 + ((c16 ^ (r16 & 15)) << 4);
    const unsigned qoff = (unsigned)((r16 * 128 + c16 * 8) * 2);
    f32x4 S[2][2];
    f32x4* SL = (f32x4*)(lds + 17920) + wid * 768 + lane;
#pragma unroll
    for (int i = 0; i < 2; ++i)
#pragma unroll
        for (int j = 0; j < 2; ++j) S[i][j] = (f32x4){0.f, 0.f, 0.f, 0.f};
#pragma unroll
    for (int i = 0; i < 12; ++i) SL[i * 64] = (f32x4){0.f, 0.f, 0.f, 0.f};
    uint2 oi[4][2], dsr[8][2];
    {
        const char* qb = (const char*)QTg;
#pragma unroll
        for (int i = 0; i < 4; ++i) *(u32x4*)(lds + o16 + i * 4096) = *(const u32x4*)(qb + i * 4096 + qoff);
        if (tid < 32) *(u32x4*)(EBL + tid * 4) = *(const u32x4*)(EB + tid * 4);
#pragma unroll
        for (int tt = 0; tt < 4; ++tt)
#pragma unroll
            for (int dvt = 0; dvt < 2; ++dvt) {
                oi[tt][dvt] = *(const uint2*)(OIb + tt * 4096 + dvt * 32 + oioff);
            }
#pragma unroll
        for (int dkt = 0; dkt < 8; ++dkt)
#pragma unroll
            for (int dvt = 0; dvt < 2; ++dvt) dsr[dkt][dvt] = *(const uint2*)(DSb + (dkt * 2 + dvt) * 512 + dsoff);
    }
    __syncthreads();
#pragma unroll 1
    for (int c = 0; c < 32; ++c) {
        const int s0 = c * 64;
        const bool more = c + 1 < 32;
        uint2 gg[4][2];
#pragma unroll
        for (int tt = 0; tt < 4; ++tt)
#pragma unroll
            for (int dvt = 0; dvt < 2; ++dvt) gg[tt][dvt] = *(const uint2*)(GGb + (size_t)s0 * 256 + tt * 4096 + dvt * 32 + ggoff);
        f32x4 o[2][4];
#pragma unroll
        for (int tt = 0; tt < 4; ++tt)
#pragma unroll
            for (int dvt = 0; dvt < 2; ++dvt) {
                o[dvt][tt] = (f32x4){bflo(oi[tt][dvt].x), bfhi(oi[tt][dvt].x), bflo(oi[tt][dvt].y), bfhi(oi[tt][dvt].y)};
                if (more) oi[tt][dvt] = *(const uint2*)(OIb + (size_t)(s0 + 64) * 256 + tt * 4096 + dvt * 32 + oioff);
            }
        const unsigned char* sQ = lds;
#pragma unroll
        for (int u = 0; u < 4; ++u) {
            bf16x8 sf[2];
#pragma unroll
            for (int dvt = 0; dvt < 2; ++dvt) {
                const f32x4 sa = u < 1 ? S[0][dvt] : SL[((2 * u - 2) * 2 + dvt) * 64];
                const f32x4 sb = u < 1 ? S[1][dvt] : SL[((2 * u - 1) * 2 + dvt) * 64];
                u32x4 w;
                w[0] = pk_bf16(sa[0], sa[1]);
                w[1] = pk_bf16(sa[2], sa[3]);
                w[2] = pk_bf16(sb[0], sb[1]);
                w[3] = pk_bf16(sb[2], sb[3]);
                sf[dvt] = __builtin_bit_cast(bf16x8, w);
            }
#pragma unroll
            for (int tt = 0; tt < 4; ++tt) {
                const uint2 lo = *(const uint2*)(sQ + tt * 4096 + p256[u][0]);
                const uint2 hi = *(const uint2*)(sQ + tt * 4096 + p256[u][1]);
                u32x4 w;
                w[0] = lo.x; w[1] = lo.y; w[2] = hi.x; w[3] = hi.y;
                const bf16x8 qf2 = __builtin_bit_cast(bf16x8, w);
#pragma unroll
                for (int dvt = 0; dvt < 2; ++dvt) o[dvt][tt] = __builtin_amdgcn_mfma_f32_16x16x32_bf16(sf[dvt], qf2, o[dvt][tt], 0, 0, 0);
            }
        }
        u32x4 qn[4], ebn;
        if (more) {
            const char* qb = (const char*)(QTg + (size_t)(s0 + 64) * 128);
#pragma unroll
            for (int i = 0; i < 4; ++i) qn[i] = *(const u32x4*)(qb + i * 4096 + qoff);
            if (tid < 32) ebn = *(const u32x4*)(EB + (c + 1) * 128 + tid * 4);
        }
#pragma unroll
        for (int dkt = 0; dkt < 8; ++dkt) {
            const float4 eb = *(const float4*)(EBL + dkt * 16 + fq * 4);
#pragma unroll
            for (int dvt = 0; dvt < 2; ++dvt) {
                const uint2 dd = dsr[dkt][dvt];
                f32x4 sv = dkt < 2 ? S[dkt < 2 ? dkt : 0][dvt] : SL[((dkt - 2) * 2 + dvt) * 64];
                sv[0] = fmaf(sv[0], eb.x, bflo(dd.x));
                sv[1] = fmaf(sv[1], eb.y, bfhi(dd.x));
                sv[2] = fmaf(sv[2], eb.z, bflo(dd.y));
                sv[3] = fmaf(sv[3], eb.w, bfhi(dd.y));
                if (dkt < 2) S[dkt < 2 ? dkt : 0][dvt] = sv; else SL[((dkt - 2) * 2 + dvt) * 64] = sv;
                if (more) dsr[dkt][dvt] = *(const uint2*)(DSb + (size_t)(c + 1) * 32768 + (dkt * 2 + dvt) * 512 + dsoff);
            }
        }
#pragma unroll
        for (int tt = 0; tt < 4; ++tt) {
            float ss = 0.f;
#pragma unroll
            for (int dvt = 0; dvt < 2; ++dvt)
#pragma unroll
                for (int i = 0; i < 4; ++i) ss += o[dvt][tt][i] * o[dvt][tt][i];
            ss = xsum4(ss);
            if (fq == 0) SS[wid * 64 + tt * 16 + fr] = ss;
        }
        __syncthreads();
#pragma unroll
        for (int tt = 0; tt < 4; ++tt) {
            const int t = tt * 16 + fr;
            const float tot = SS[t] + SS[64 + t] + SS[128 + t] + SS[192 + t];
            const float rs = rsqrtf(tot * (1.f / 128.f) + LN_EPS);
            const size_t tg = (size_t)b * S_ + s0 + t;
#pragma unroll
            for (int dvt = 0; dvt < 2; ++dvt) {
                const int dv = dv0 + dvt * 16 + fq * 4;
                const float r0 = o[dvt][tt][0] * rs * bflo(gg[tt][dvt].x);
                const float r1 = o[dvt][tt][1] * rs * bfhi(gg[tt][dvt].x);
                const float r2 = o[dvt][tt][2] * rs * bflo(gg[tt][dvt].y);
                const float r3 = o[dvt][tt][3] * rs * bfhi(gg[tt][dvt].y);
                *(uint2*)(OM + tg * 1024 + 512 + hh * 128 + dv) = make_uint2(pk_bf16(r0, r1), pk_bf16(r2, r3));
            }
        }
        if (more) {
#pragma unroll
            for (int i = 0; i < 4; ++i) *(u32x4*)(lds + o16 + i * 4096) = qn[i];
            if (tid < 32) *(u32x4*)(EBL + tid * 4) = ebn;
        }
        __syncthreads();
    }
}

DEV void xattn_item2(const P& p, int item) {
    const int qt64 = item & 31, hh = (item >> 5) & 3, b = item >> 7;
    const int lane = threadIdx.x & 63, wid = threadIdx.x >> 6, fr = lane & 15, fq = lane >> 4;
    const bf16_t* QX = (const bf16_t*)(p.ws + WS_QX);
    const bf16_t* KVM = (const bf16_t*)(p.ws + WS_KVM);
    const bf16_t* VMT = (const bf16_t*)(p.ws + WS_VMT) + (size_t)(b * 4 + hh) * 256 * 256;
    bf16_t* OX = (bf16_t*)(p.ws + WS_OX);
    const size_t tq = (size_t)b * S_ + qt64 * 64 + wid * 16 + fr;
    bf16x8 qf[8];
#pragma unroll
    for (int ks = 0; ks < 8; ++ks) qf[ks] = *(const bf16x8*)(QX + tq * 1024 + hh * 256 + ks * 32 + fq * 8);
    f32x4 sc[16];
#pragma unroll
    for (int kt = 0; kt < 16; ++kt) {
        f32x4 a = (f32x4){0.f, 0.f, 0.f, 0.f};
        const bf16_t* kp = KVM + (size_t)(b * ML_ + kt * 16 + fr) * 2048 + hh * 256 + fq * 8;
#pragma unroll
        for (int ks = 0; ks < 8; ++ks) a = __builtin_amdgcn_mfma_f32_16x16x32_bf16(*(const bf16x8*)(kp + ks * 32), qf[ks], a, 0, 0, 0);
        sc[kt] = a;
    }
    float mx = -1e30f;
#pragma unroll
    for (int kt = 0; kt < 16; ++kt)
#pragma unroll
        for (int i = 0; i < 4; ++i) { sc[kt][i] *= 0.0625f; mx = fmaxf(mx, sc[kt][i]); }
    mx = xmax4(mx);
    float ps = 0.f;
#pragma unroll
    for (int kt = 0; kt < 16; ++kt)
#pragma unroll
        for (int i = 0; i < 4; ++i) { sc[kt][i] = __expf(sc[kt][i] - mx); ps += sc[kt][i]; }
    ps = xsum4(ps);
    const float inv = 1.f / ps;
    u32x4 pf[8];
#pragma unroll
    for (int s = 0; s < 8; ++s) {
        pf[s][0] = pk_bf16(sc[2 * s][0] * inv, sc[2 * s][1] * inv);
        pf[s][1] = pk_bf16(sc[2 * s][2] * inv, sc[2 * s][3] * inv);
        pf[s][2] = pk_bf16(sc[2 * s + 1][0] * inv, sc[2 * s + 1][1] * inv);
        pf[s][3] = pk_bf16(sc[2 * s + 1][2] * inv, sc[2 * s + 1][3] * inv);
    }
#pragma unroll 1
    for (int dh = 0; dh < 2; ++dh) {
        f32x4 o[8];
#pragma unroll
        for (int dt = 0; dt < 8; ++dt) o[dt] = (f32x4){0.f, 0.f, 0.f, 0.f};
#pragma unroll
        for (int s = 0; s < 8; ++s) {
#pragma unroll
            for (int dt = 0; dt < 8; ++dt) {
                const bf16_t* vp = VMT + (size_t)(dh * 128 + dt * 16 + fr) * 256 + 32 * s + 4 * fq;
                o[dt] = __builtin_amdgcn_mfma_f32_16x16x32_bf16(ld2x8(vp, vp + 16), __builtin_bit_cast(bf16x8, pf[s]), o[dt], 0, 0, 0);
            }
        }
#pragma unroll
        for (int dt = 0; dt < 8; ++dt) {
            uint2 u2;
            u2.x = pk_bf16(o[dt][0], o[dt][1]);
            u2.y = pk_bf16(o[dt][2], o[dt][3]);
            *(uint2*)(OX + tq * 1024 + hh * 256 + dh * 128 + dt * 16 + fq * 4) = u2;
        }
    }
}


struct XaRegs { u32x4 r[8]; };
DEV void xa_loadK(XaRegs& x, const bf16_t* kbase, int tid) {
    const int c = tid & 31, r0 = tid >> 5;
#pragma unroll
    for (int i = 0; i < 8; ++i) x.r[i] = *(const u32x4*)(kbase + (size_t)(r0 + 8 * i) * 2048 + c * 8);
}
DEV void xa_storeK(const XaRegs& x, unsigned char* lds, int tid) {
    const int c = tid & 31, r0 = tid >> 5;
#pragma unroll
    for (int i = 0; i < 8; ++i) {
        const int row = r0 + 8 * i;
        *(u32x4*)(lds + row * 512 + ((c ^ (row & 15)) << 4)) = x.r[i];
    }
}
DEV void xa_loadV(XaRegs& x, const bf16_t* vbase, int tid) {
    const int c = tid & 7, r0 = tid >> 3;
#pragma unroll
    for (int i = 0; i < 8; ++i) x.r[i] = *(const u32x4*)(vbase + (size_t)(r0 + 32 * i) * 256 + c * 8);
}
DEV void xa_storeV(const XaRegs& x, unsigned char* lds, int tid) {
    const int c = tid & 7, r0 = tid >> 3;
    const int o = r0 * 128 + ((c ^ ((r0 >> 1) & 7)) << 4);
#pragma unroll
    for (int i = 0; i < 8; ++i) *(u32x4*)(lds + 32768 + o + i * 4096) = x.r[i];
}
DEV void xattn_item3(const P& p, int item, unsigned char* lds) {
    const int qt64 = item & 31, hh = (item >> 5) & 3, b = item >> 7;
    int tid = threadIdx.x;
    asm volatile("" : "+v"(tid));
    const int lane = tid & 63, wid = tid >> 6, fr = lane & 15, fq = lane >> 4;
    const bf16_t* QX = (const bf16_t*)(p.ws + WS_QX);
    const bf16_t* KB = (const bf16_t*)(p.ws + WS_KVM) + (size_t)(b * ML_) * 2048 + hh * 256;
    const bf16_t* VB = (const bf16_t*)(p.ws + WS_VMT) + (size_t)(b * 4 + hh) * 256 * 256;
    bf16_t* OX = (bf16_t*)(p.ws + WS_OX);
    const size_t tq = (size_t)b * S_ + qt64 * 64 + wid * 16 + fr;
    bf16x8 qf[8];
#pragma unroll
    for (int ks = 0; ks < 8; ++ks) qf[ks] = *(const bf16x8*)(QX + tq * 1024 + hh * 256 + ks * 32 + fq * 8);
    f32x4 o[16];
#pragma unroll
    for (int dt = 0; dt < 16; ++dt) o[dt] = (f32x4){0.f, 0.f, 0.f, 0.f};
    float m = -1e30f, l = 0.f;
    {
        XaRegs x;
        xa_loadK(x, KB, tid);
        xa_storeK(x, lds, tid);
        xa_loadV(x, VB, tid);
        xa_storeV(x, lds, tid);
    }
    __syncthreads();
    const int sw8 = (fr >> 1) & 7;
#pragma unroll 1
    for (int j = 0; j < 4; ++j) {
        XaRegs nx;
        if (j + 1 < 4) xa_loadK(nx, KB + (size_t)(j + 1) * 64 * 2048, tid);
        f32x4 sc[4];
#pragma unroll
        for (int kt = 0; kt < 4; ++kt) {
            f32x4 a = (f32x4){0.f, 0.f, 0.f, 0.f};
            const unsigned char* rp = lds + (kt * 16 + fr) * 512;
#pragma unroll
            for (int ks = 0; ks < 8; ++ks) a = __builtin_amdgcn_mfma_f32_16x16x32_bf16(*(const bf16x8*)(rp + (((4 * ks + fq) ^ fr) << 4)), qf[ks], a, 0, 0, 0);
            sc[kt] = a;
        }
        __syncthreads();
        if (j + 1 < 4) { xa_storeK(nx, lds, tid); xa_loadV(nx, VB + (j + 1) * 64, tid); }
        float bm = -1e30f;
#pragma unroll
        for (int kt = 0; kt < 4; ++kt)
#pragma unroll
            for (int i = 0; i < 4; ++i) { sc[kt][i] *= 0.0625f; bm = fmaxf(bm, sc[kt][i]); }
        bm = xmax4(bm);
        const float mn = fmaxf(m, bm);
        const float alpha = __expf(m - mn);
        float ps = 0.f;
#pragma unroll
        for (int kt = 0; kt < 4; ++kt)
#pragma unroll
            for (int i = 0; i < 4; ++i) { sc[kt][i] = __expf(sc[kt][i] - mn); ps += sc[kt][i]; }
        l = l * alpha + ps;
        m = mn;
#pragma unroll
        for (int dt = 0; dt < 16; ++dt) o[dt] *= alpha;
#pragma unroll
        for (int s = 0; s < 2; ++s) {
            u32x4 w;
            w[0] = pk_bf16(sc[2 * s][0], sc[2 * s][1]);
            w[1] = pk_bf16(sc[2 * s][2], sc[2 * s][3]);
            w[2] = pk_bf16(sc[2 * s + 1][0], sc[2 * s + 1][1]);
            w[3] = pk_bf16(sc[2 * s + 1][2], sc[2 * s + 1][3]);
            const bf16x8 pf = __builtin_bit_cast(bf16x8, w);
#pragma unroll
            for (int dt = 0; dt < 16; ++dt) {
                const unsigned char* rp = lds + 32768 + (dt * 16 + fr) * 128 + 8 * (fq & 1);
                const uint2 lo = *(const uint2*)(rp + (((4 * s + (fq >> 1)) ^ sw8) << 4));
                const uint2 hi = *(const uint2*)(rp + (((4 * s + 2 + (fq >> 1)) ^ sw8) << 4));
                u32x4 vv;
                vv[0] = lo.x; vv[1] = lo.y; vv[2] = hi.x; vv[3] = hi.y;
                o[dt] = __builtin_amdgcn_mfma_f32_16x16x32_bf16(__builtin_bit_cast(bf16x8, vv), pf, o[dt], 0, 0, 0);
            }
        }
        __syncthreads();
        if (j + 1 < 4) xa_storeV(nx, lds, tid);
        __syncthreads();
    }
    const float inv = 1.f / xsum4(l);
#pragma unroll
    for (int dt = 0; dt < 16; ++dt) {
        uint2 u2;
        u2.x = pk_bf16(o[dt][0] * inv, o[dt][1] * inv);
        u2.y = pk_bf16(o[dt][2] * inv, o[dt][3] * inv);
        *(uint2*)(OX + tq * 1024 + hh * 256 + dt * 16 + fq * 4) = u2;
    }
}


DEV void peer_quant_rows4(const float* src, unsigned char* dst, float* scl, int row0, int* rsum = nullptr, int bias = 128) {
    const int lane = threadIdx.x & 63;
    float4 v[4][4];
#pragma unroll
    for (int r = 0; r < 4; ++r) {
        const float* rp = src + (size_t)(row0 + r) * 1024 + lane * 16;
#pragma unroll
        for (int i = 0; i < 4; ++i) v[r][i] = *(const float4*)(rp + 4 * i);
    }
#pragma unroll
    for (int r = 0; r < 4; ++r) {
        const int row = row0 + r;
        float mx = 0.f;
#pragma unroll
        for (int i = 0; i < 4; ++i) mx = fmaxf(fmaxf(mx, fmaxf(fabsf(v[r][i].x), fabsf(v[r][i].y))), fmaxf(fabsf(v[r][i].z), fabsf(v[r][i].w)));
        mx = wmax(mx);
        const float q = mx > 0.f ? 127.f / mx : 0.f;
        u32x4 w;
        int usum = 0;
#pragma unroll
        for (int i = 0; i < 4; ++i) {
            const float e[4] = {v[r][i].x, v[r][i].y, v[r][i].z, v[r][i].w};
            unsigned pk = 0u;
#pragma unroll
            for (int k = 0; k < 4; ++k) {
                int qi = (int)rintf(e[k] * q);
                qi = qi < -127 ? -127 : (qi > 127 ? 127 : qi);
                pk |= (unsigned)((qi + bias) & 0xff) << (8 * k);
                usum += qi + 128;
            }
            w[i] = pk;
        }
        *(u32x4*)(dst + ((size_t)(lane >> 3) * 16384 + row) * 128 + (lane & 7) * 16) = w;
        if (rsum) {
#pragma unroll
            for (int o = 32; o > 0; o >>= 1) usum += __shfl_xor(usum, o);
            if (lane == 0) rsum[row] = usum;
        }
        if (lane == 0) scl[row] = mx * (1.f / 127.f);
    }
}

DEV unsigned f2ord(float f) { const unsigned b = __float_as_uint(f); return b ^ ((b >> 31) ? 0xffffffffu : 0x80000000u); }
DEV float ord2f(unsigned o) { return __uint_as_float((o & 0x80000000u) ? (o ^ 0x80000000u) : ~o); }
DEV void ins16(unsigned (&v)[16], unsigned x) {
#pragma unroll
    for (int k = 0; k < 16; ++k) {
        const unsigned t = v[k] > x ? v[k] : x;
        x = v[k] > x ? x : v[k];
        v[k] = t;
    }
}
constexpr int PEER_SC = 0;
constexpr int PEER_LST = 0;
constexpr int PEER_EID = 16384;
constexpr int PEER_GATE = 16384 + 4096;
DEV void peer_route_item(const P& p, int item, unsigned char* lds) {
    const int tid = threadIdx.x, lane = tid & 63, wid = tid >> 6;
    const int t0 = item * 16;
    const bf16_t* QP = (const bf16_t*)(p.ws + WS_QP);
    const bf16_t* PK = (const bf16_t*)(p.ws + WS_PKEY);
    unsigned* SC = (unsigned*)(lds + PEER_SC);
    const int fr = lane & 15, fq = lane >> 4;
    unsigned lst[16];
#pragma unroll
    for (int k = 0; k < 16; ++k) lst[k] = 0u;
    bf16x8 qf[4][2];
#pragma unroll
    for (int ci = 0; ci < 4; ++ci)
#pragma unroll
        for (int ks = 0; ks < 2; ++ks)
            qf[ci][ks] = *(const bf16x8*)(QP + (size_t)(t0 + fr) * 1024 + (4 * wid + ci) * 64 + ks * 32 + fq * 8);
#pragma unroll 1
    for (int pass = 0; pass < 2; ++pass) {
#pragma unroll
        for (int ci = 0; ci < 4; ++ci) {
            const int cb = 4 * wid + ci;
#pragma unroll
            for (int kt = 0; kt < 4; ++kt) {
                f32x4 acc = (f32x4){0.f, 0.f, 0.f, 0.f};
#pragma unroll
                for (int ks = 0; ks < 2; ++ks) {
                    const bf16x8 kf = *(const bf16x8*)(PK + ((size_t)cb * 128 + pass * 64 + kt * 16 + fr) * 64 + ks * 32 + fq * 8);
                    acc = __builtin_amdgcn_mfma_f32_16x16x32_bf16(kf, qf[ci][ks], acc, 0, 0, 0);
                }
                unsigned* dst = SC + (cb * 16 + fr) * 65 + kt * 16 + fq * 4;
#pragma unroll
                for (int i = 0; i < 4; ++i) {
                    const int kidx = pass * 64 + kt * 16 + fq * 4 + i;
                    dst[i] = (f2ord(acc[i]) & ~127u) | (unsigned)(127 - kidx);
                }
            }
        }
        __syncthreads();
        {
            const unsigned* row = SC + tid * 65;
#pragma unroll 4
            for (int k = 0; k < 64; ++k) ins16(lst, row[k]);
        }
        __syncthreads();
    }
    unsigned* LST = (unsigned*)(lds + PEER_LST);
#pragma unroll
    for (int k = 0; k < 16; ++k) LST[tid * 16 + k] = lst[k];
    __syncthreads();
    unsigned short* EID = (unsigned short*)(lds + PEER_EID);
    float* GATE = (float*)(lds + PEER_GATE);
    if (((tid >> 4) & 1) == 0) {
        const int tok = tid & 15, hh = tid >> 5;
        const unsigned* l2 = LST + (tid + 16) * 16;
        float s1[16], s2[16];
#pragma unroll
        for (int k = 0; k < 16; ++k) { s1[k] = ord2f(lst[k] & ~127u); s2[k] = ord2f(l2[k] & ~127u); }
        unsigned fin[16];
#pragma unroll
        for (int k = 0; k < 16; ++k) fin[k] = 0u;
#pragma unroll
        for (int i = 0; i < 16; ++i)
#pragma unroll
            for (int j = 0; j < 16; ++j)
                if ((i + 1) * (j + 1) <= 16) ins16(fin, (f2ord(s1[i] + s2[j]) & ~255u) | (unsigned)(255 - (i * 16 + j)));
        const float mx = ord2f(fin[0] & ~255u);
        float w[16], ws = 0.f;
#pragma unroll
        for (int k = 0; k < 16; ++k) { w[k] = expf(ord2f(fin[k] & ~255u) - mx); ws += w[k]; }
        const float inv = 1.f / ws;
#pragma unroll
        for (int k = 0; k < 16; ++k) {
            const int flat = 255 - (int)(fin[k] & 255u);
            const int i1 = 127 - (int)(LST[tid * 16 + (flat >> 4)] & 127u);
            const int i2 = 127 - (int)(l2[flat & 15] & 127u);
            EID[tok * 128 + hh * 16 + k] = (unsigned short)(i1 * 128 + i2);
            GATE[tok * 128 + hh * 16 + k] = w[k] * inv;
        }
    }
    __syncthreads();
    {
        unsigned short* EIDP = (unsigned short*)(p.ws + WS_EIDP);
        float* GATEP = (float*)(p.ws + WS_GATEP);
        for (int i = tid; i < 16 * 128; i += 256) {
            const int tok = i >> 7, pi = i & 127, eg = pi >> 4, k = pi & 15, slot = 8 * k + eg;
            EIDP[(size_t)(t0 + tok) * 128 + pi] = EID[tok * 128 + slot];
            GATEP[(size_t)(t0 + tok) * 128 + pi] = GATE[tok * 128 + slot];
        }
        unsigned char* XQ = p.ws + WS_XQ;
        const size_t tb = (size_t)t0 + wid * 4;
        float2 st4[4];
        u32x4 ya[4][2];
#pragma unroll
        for (int tt = 0; tt < 4; ++tt) {
            st4[tt] = ((const float2*)(p.ws + WS_ST2))[tb + tt];
            const bf16_t* row = (const bf16_t*)(p.ws + WS_YB) + (tb + tt) * 1024 + lane * 16;
            ya[tt][0] = *(const u32x4*)row;
            ya[tt][1] = *(const u32x4*)(row + 8);
        }
        float gv[16], bv[16];
#pragma unroll
        for (int i = 0; i < 4; ++i) {
            const float4 g4 = *(const float4*)(p.ln_g + 1024 + lane * 16 + 4 * i);
            const float4 b4 = *(const float4*)(p.ln_b + 1024 + lane * 16 + 4 * i);
            gv[4 * i] = g4.x; gv[4 * i + 1] = g4.y; gv[4 * i + 2] = g4.z; gv[4 * i + 3] = g4.w;
            bv[4 * i] = b4.x; bv[4 * i + 1] = b4.y; bv[4 * i + 2] = b4.z; bv[4 * i + 3] = b4.w;
        }
#pragma unroll
        for (int tt = 0; tt < 4; ++tt) {
            const size_t t = tb + tt;
            const float mean = st4[tt].x, rs = st4[tt].y;
            float xr[16];
            float amax = 0.f;
#pragma unroll
            for (int i = 0; i < 2; ++i)
#pragma unroll
                for (int q = 0; q < 4; ++q) {
                    const int j = 8 * i + 2 * q;
                    xr[j] = (bflo(ya[tt][i][q]) - mean) * rs * gv[j] + bv[j];
                    xr[j + 1] = (bfhi(ya[tt][i][q]) - mean) * rs * gv[j + 1] + bv[j + 1];
                    amax = fmaxf(amax, fmaxf(fabsf(xr[j]), fabsf(xr[j + 1])));
                }
            amax = wmax(amax);
            const float qx = amax > 0.f ? 127.f / amax : 0.f;
            u32x4 w;
            int s_ = 0;
#pragma unroll
            for (int i = 0; i < 4; ++i) {
                unsigned pk = 0u;
#pragma unroll
                for (int k = 0; k < 4; ++k) {
                    int qi = (int)rintf(xr[4 * i + k] * qx);
                    qi = qi < -127 ? -127 : (qi > 127 ? 127 : qi);
                    pk |= (unsigned)(qi + 128) << (8 * k);
                    s_ += qi + 128;
                }
                w[i] = pk;
            }
#pragma unroll
            for (int o = 32; o > 0; o >>= 1) s_ += __shfl_xor(s_, o);
            *(u32x4*)(XQ + t * 1024 + lane * 16) = w;
            if (lane == 0) {
                ((float*)(p.ws + WS_SXF))[t] = amax * (1.f / 127.f);
                ((int*)(p.ws + WS_SXI))[t] = s_;
            }
        }
    }
    __syncthreads();
}

DEV void peer_gather16(u32x4 (&rows)[16], const unsigned char* tab, const u32x4& e0, const u32x4& e1) {
#pragma unroll
    for (int k = 0; k < 16; ++k) {
        const unsigned ew = k < 8 ? e0[k >> 1] : e1[(k - 8) >> 1];
        const unsigned e = (k & 1) ? (ew >> 16) : (ew & 0xffffu);
        rows[k] = *(const u32x4*)(tab + (size_t)e * 128);
    }
}
DEV void peer_down_compute(const u32x4 (&rows)[16], const u32x4& xu, int* dst, int cg) {
    unsigned v[16];
#pragma unroll
    for (int k = 0; k < 16; ++k) {
        unsigned a_ = 0u;
#pragma unroll
        for (int q = 0; q < 4; ++q) a_ = __builtin_amdgcn_udot4(rows[k][q], xu[q], a_, false);
        v[k] = a_;
    }
    unsigned w8[8], w4[4], w2[2];
    {
        const bool hi = (cg & 4) != 0;
#pragma unroll
        for (int j = 0; j < 8; ++j) {
            const unsigned send = hi ? v[j] : v[j + 8];
            const unsigned keep = hi ? v[j + 8] : v[j];
            w8[j] = keep + (unsigned)__shfl_xor((int)send, 4);
        }
    }
    {
        const bool hi = (cg & 2) != 0;
#pragma unroll
        for (int j = 0; j < 4; ++j) {
            const unsigned send = hi ? w8[j] : w8[j + 4];
            const unsigned keep = hi ? w8[j + 4] : w8[j];
            w4[j] = keep + (unsigned)__shfl_xor((int)send, 2);
        }
    }
    {
        const bool hi = (cg & 1) != 0;
#pragma unroll
        for (int j = 0; j < 2; ++j) {
            const unsigned send = hi ? w4[j] : w4[j + 2];
            const unsigned keep = hi ? w4[j + 2] : w4[j];
            w2[j] = keep + (unsigned)__shfl_xor((int)send, 1);
        }
    }
    *(uint2*)dst = make_uint2(w2[0], w2[1]);
}
DEV void peer_down_item(const P& p, int s, int tile, int lane, int wid) {
    const int eg = lane >> 3, cg = lane & 7;
    const unsigned char* PD = p.ws + WS_PD + (size_t)s * 16384 * 128 + cg * 16;
    const size_t t0 = (size_t)tile * 32 + wid * 8;
    const unsigned short* EI = (const unsigned short*)(p.ws + WS_EIDP) + t0 * 128 + eg * 16;
    const unsigned char* XQ = p.ws + WS_XQ + t0 * 1024 + s * 128 + cg * 16;
    int* DP = (int*)(p.ws + WS_DP) + (size_t)s * T_ * 128 + t0 * 128 + eg * 16 + 2 * cg;
    u32x4 rA[16], rB[16];
    u32x4 ea0 = *(const u32x4*)EI, ea1 = *(const u32x4*)(EI + 8);
    u32x4 eb0 = *(const u32x4*)(EI + 128), eb1 = *(const u32x4*)(EI + 128 + 8);
    u32x4 xa = *(const u32x4*)XQ, xb = *(const u32x4*)(XQ + 1024);
    peer_gather16(rA, PD, ea0, ea1);
#pragma unroll 1
    for (int tt = 0; tt < 8; tt += 2) {
        peer_gather16(rB, PD, eb0, eb1);
        if (tt + 2 < 8) { ea0 = *(const u32x4*)(EI + (tt + 2) * 128); ea1 = *(const u32x4*)(EI + (tt + 2) * 128 + 8); }
        peer_down_compute(rA, xa, DP + tt * 128, cg);
        if (tt + 2 < 8) {
            xa = *(const u32x4*)(XQ + (tt + 2) * 1024);
            peer_gather16(rA, PD, ea0, ea1);
            eb0 = *(const u32x4*)(EI + (tt + 3) * 128); eb1 = *(const u32x4*)(EI + (tt + 3) * 128 + 8);
        }
        peer_down_compute(rB, xb, DP + (tt + 1) * 128, cg);
        if (tt + 2 < 8) xb = *(const u32x4*)(XQ + (tt + 3) * 1024);
    }
}

DEV void peer_coef_item(const P& p, int t, int lane) {
    const int* DP = (const int*)(p.ws + WS_DP);
    const unsigned short* EIDP = (const unsigned short*)(p.ws + WS_EIDP);
    const float* GATEP = (const float*)(p.ws + WS_GATEP);
    const float sx = ((const float*)(p.ws + WS_SXF))[t];
    const int sxu = ((const int*)(p.ws + WS_SXI))[t];
    float cf[2];
    float cm = 0.f;
#pragma unroll
    for (int h = 0; h < 2; ++h) {
        const int pi = lane + 64 * h;
        int tot = 0;
#pragma unroll
        for (int s = 0; s < 8; ++s) tot += DP[((size_t)s * T_ + t) * 128 + pi];
        const int e = EIDP[(size_t)t * 128 + pi];
        const int dotq = tot - 128 * ((const int*)(p.ws + WS_PRS))[e] - 128 * sxu + 128 * 128 * 1024;
        const float hv = ((const float*)(p.ws + WS_PSD))[e] * sx * (float)dotq;
        cf[h] = 0.5f * hv * (1.f + erff(hv * 0.7071067811865476f)) * GATEP[(size_t)t * 128 + pi] * ((const float*)(p.ws + WS_PSU))[e];
        cm = fmaxf(cm, fabsf(cf[h]));
    }
    cm = wmax(cm);
    const float qs = cm > 0.f ? 127.f / cm : 0.f;
#pragma unroll
    for (int h = 0; h < 2; ++h) {
        int qi = (int)rintf(cf[h] * qs);
        qi = qi < -127 ? -127 : (qi > 127 ? 127 : qi);
        (p.ws + WS_COEFP)[(size_t)t * 128 + lane + 64 * h] = (unsigned char)(qi & 0xff);
    }
    if (lane == 0) ((float*)(p.ws + WS_ASUM))[t] = cm * (1.f / 127.f);
}

DEV void peer_up_compute(const P& p, const u32x4 (&rows)[16], const u32x4& cq, size_t t, int col, int eg, const float2& g2, const float2& b2, bool dostore) {
    int acc[16];
#pragma unroll
    for (int i = 0; i < 16; ++i) acc[i] = 0;
#pragma unroll
    for (int g = 0; g < 4; ++g)
#pragma unroll
        for (int q = 0; q < 4; ++q) {
            const unsigned r0 = rows[4 * g][q], r1 = rows[4 * g + 1][q], r2 = rows[4 * g + 2][q], r3 = rows[4 * g + 3][q];
            const unsigned a0 = __builtin_amdgcn_perm(r1, r0, 0x05010400u), a1 = __builtin_amdgcn_perm(r1, r0, 0x07030602u);
            const unsigned b0 = __builtin_amdgcn_perm(r3, r2, 0x05010400u), b1 = __builtin_amdgcn_perm(r3, r2, 0x07030602u);
            const unsigned t0 = __builtin_amdgcn_perm(b0, a0, 0x05040100u), t1 = __builtin_amdgcn_perm(b0, a0, 0x07060302u);
            const unsigned t2 = __builtin_amdgcn_perm(b1, a1, 0x05040100u), t3 = __builtin_amdgcn_perm(b1, a1, 0x07060302u);
            acc[4 * q] = __builtin_amdgcn_sdot4((int)t0, (int)cq[g], acc[4 * q], false);
            acc[4 * q + 1] = __builtin_amdgcn_sdot4((int)t1, (int)cq[g], acc[4 * q + 1], false);
            acc[4 * q + 2] = __builtin_amdgcn_sdot4((int)t2, (int)cq[g], acc[4 * q + 2], false);
            acc[4 * q + 3] = __builtin_amdgcn_sdot4((int)t3, (int)cq[g], acc[4 * q + 3], false);
        }
    int a8[8], a4[4], a2[2];
    {
        const bool hi = (eg & 4) != 0;
#pragma unroll
        for (int j = 0; j < 8; ++j) {
            const int send = hi ? acc[j] : acc[j + 8];
            const int keep = hi ? acc[j + 8] : acc[j];
            a8[j] = keep + __shfl_xor(send, 32);
        }
    }
    {
        const bool hi = (eg & 2) != 0;
#pragma unroll
        for (int j = 0; j < 4; ++j) {
            const int send = hi ? a8[j] : a8[j + 4];
            const int keep = hi ? a8[j + 4] : a8[j];
            a4[j] = keep + __shfl_xor(send, 16);
        }
    }
    {
        const bool hi = (eg & 1) != 0;
#pragma unroll
        for (int j = 0; j < 2; ++j) {
            const int send = hi ? a4[j] : a4[j + 2];
            const int keep = hi ? a4[j + 2] : a4[j];
            a2[j] = keep + __shfl_xor(send, 8);
        }
    }
    const float cs = ((const float*)(p.ws + WS_ASUM))[t];
    const float2 st = ((const float2*)(p.ws + WS_ST2))[t];
    const unsigned xb = *(const unsigned*)((const bf16_t*)(p.ws + WS_YB) + t * 1024 + col);
    const float x0 = (bflo(xb) - st.x) * st.y * g2.x + b2.x, x1 = (bfhi(xb) - st.x) * st.y * g2.y + b2.y;
    if (dostore) *(unsigned*)((bf16_t*)(p.ws + WS_YB) + t * 1024 + col) = pk_bf16(ALPHA * x0 + cs * (float)a2[0], ALPHA * x1 + cs * (float)a2[1]);
}
DEV void peer_up_item(const P& p, int s, int tile, int lane, int wid, bool dostore = true) {
    const int eg = lane >> 3, cg = lane & 7;
    const unsigned char* PU = p.ws + WS_PU + (size_t)s * 16384 * 128 + cg * 16;
    const size_t t0 = (size_t)tile * 32 + wid * 8;
    const unsigned short* EI = (const unsigned short*)(p.ws + WS_EIDP) + t0 * 128 + eg * 16;
    const unsigned char* CQ = p.ws + WS_COEFP + t0 * 128 + eg * 16;
    const int col = s * 128 + cg * 16 + 2 * eg;
    const float2 g2 = *(const float2*)(p.ln_g + 1024 + col), b2 = *(const float2*)(p.ln_b + 1024 + col);
    u32x4 rA[16], rB[16];
    u32x4 ea0 = *(const u32x4*)EI, ea1 = *(const u32x4*)(EI + 8);
    u32x4 eb0 = *(const u32x4*)(EI + 128), eb1 = *(const u32x4*)(EI + 128 + 8);
    u32x4 ca = *(const u32x4*)CQ, cb = *(const u32x4*)(CQ + 128);
    peer_gather16(rA, PU, ea0, ea1);
#pragma unroll 1
    for (int tt = 0; tt < 8; tt += 2) {
        peer_gather16(rB, PU, eb0, eb1);
        if (tt + 2 < 8) { ea0 = *(const u32x4*)(EI + (tt + 2) * 128); ea1 = *(const u32x4*)(EI + (tt + 2) * 128 + 8); }
        peer_up_compute(p, rA, ca, t0 + tt, col, eg, g2, b2, dostore);
        if (tt + 2 < 8) {
            ca = *(const u32x4*)(CQ + (tt + 2) * 128);
            peer_gather16(rA, PU, ea0, ea1);
            eb0 = *(const u32x4*)(EI + (tt + 3) * 128); eb1 = *(const u32x4*)(EI + (tt + 3) * 128 + 8);
        }
        peer_up_compute(p, rB, cb, t0 + tt + 1, col, eg, g2, b2, dostore);
        if (tt + 2 < 8) cb = *(const u32x4*)(CQ + (tt + 3) * 128);
    }
}

DEV void ln3_item(const P& p, int t, int lane) {
    float* row = p.out + (size_t)t * 1024;
    const bf16_t* yrow = (const bf16_t*)(p.ws + WS_YB) + (size_t)t * 1024;
    float4 v[4];
    float s = 0.f;
#pragma unroll
    for (int i = 0; i < 4; ++i) {
        const uint2 u = *(const uint2*)(yrow + (i * 64 + lane) * 4);
        v[i] = make_float4(bflo(u.x), bfhi(u.x), bflo(u.y), bfhi(u.y));
        s += v[i].x + v[i].y + v[i].z + v[i].w;
    }
    const float mean = wsum(s) * (1.f / 1024.f);
    float ss = 0.f;
#pragma unroll
    for (int i = 0; i < 4; ++i) {
        v[i].x -= mean; v[i].y -= mean; v[i].z -= mean; v[i].w -= mean;
        ss += v[i].x * v[i].x + v[i].y * v[i].y + v[i].z * v[i].z + v[i].w * v[i].w;
    }
    const float rs = rsqrtf(wsum(ss) * (1.f / 1024.f) + LN_EPS);
#pragma unroll
    for (int i = 0; i < 4; ++i) {
        const int c = (i * 64 + lane) * 4;
        const float4 gg = *(const float4*)(p.ln_g + 2 * 1024 + c);
        const float4 bb = *(const float4*)(p.ln_b + 2 * 1024 + c);
        float4 o;
        o.x = v[i].x * rs * gg.x + bb.x; o.y = v[i].y * rs * gg.y + bb.y; o.z = v[i].z * rs * gg.z + bb.z; o.w = v[i].w * rs * gg.w + bb.w;
        *(float4*)(row + c) = o;
    }
}

#define XB_TMO      128
#define XB_XCNT(j)  (256  + 64 * (j))
#define XB_XSUB(j)  (1280 + 64 * (j))
#define XB_XGEN(j)  (2304 + 64 * (j))
#define XB_TOP      3328
#define XB_TOPGEN   3392
#define XCD_BAR_WORDS 3456
#define XB_SPIN_CAP (1u << 20)
#define LAS __attribute__((address_space(3)))
DEV unsigned xb_ld(unsigned* p) { return __hip_atomic_load(p, __ATOMIC_RELAXED, __HIP_MEMORY_SCOPE_AGENT); }
DEV unsigned xb_add(unsigned* p, unsigned v) { return __hip_atomic_fetch_add(p, v, __ATOMIC_RELAXED, __HIP_MEMORY_SCOPE_AGENT); }
DEV unsigned xb_xcc_id() { return (unsigned)__builtin_amdgcn_s_getreg((3 << 11) | 20) & 0xFu; }
#define XB_SPIN(cond, bar) do { unsigned _sp = 0; while (cond) { __builtin_amdgcn_s_sleep(1); \
    if ((++_sp & 255u) == 0u) { if (xb_ld(&(bar)[XB_TMO])) break; if (_sp > XB_SPIN_CAP) { atomicAdd(&(bar)[XB_TMO], 1u); break; } } } } while (0)
struct XcdBarrier { unsigned* bar; unsigned x; volatile LAS unsigned* st; };
DEV XcdBarrier xcd_barrier_post(unsigned* bar, volatile LAS unsigned* st) {
    XcdBarrier b; b.bar = bar; b.x = xb_xcc_id(); b.st = st;
    if (threadIdx.x == 0) (void)xb_add(&bar[XB_XCNT(b.x)], 1u);
    return b;
}
DEV void xcd_barrier_complete(unsigned* bar, unsigned x, unsigned& nloc, unsigned& nx) {
    const unsigned G = gridDim.x * gridDim.y * gridDim.z;
    unsigned sum, cnt, mine, sp = 0u;
    for (;;) {
        sum = 0u; cnt = 0u; mine = 0u;
#pragma unroll
        for (unsigned j = 0; j < 16; ++j) { const unsigned c = xb_ld(&bar[XB_XCNT(j)]); sum += c; cnt += (c > 0u) ? 1u : 0u; mine = (j == x) ? c : mine; }
        if (sum == G) break;
        __builtin_amdgcn_s_sleep(1);
        if ((++sp & 255u) == 0u) { if (xb_ld(&bar[XB_TMO])) break; if (sp > XB_SPIN_CAP) { atomicAdd(&bar[XB_TMO], 1u); break; } }
    }
    nloc = mine > 0u ? mine : 1u; nx = cnt > 0u ? cnt : 1u;
}
DEV void xcd_barrier(const XcdBarrier& b) {
    asm volatile("s_waitcnt vmcnt(0)" ::: "memory");
    __syncthreads();
    if (threadIdx.x == 0) {
        unsigned* bar = b.bar;
        __builtin_amdgcn_s_waitcnt(0);
        unsigned nloc = b.st[0], nx = b.st[1];
        if (nloc == 0u) { xcd_barrier_complete(bar, b.x, nloc, nx); b.st[0] = nloc; b.st[1] = nx; }
        const unsigned old = xb_add(&bar[XB_XSUB(b.x)], 1u);
        const unsigned gen = old / nloc;
        if (old + 1u == (gen + 1u) * nloc) {
            __builtin_amdgcn_fence(__ATOMIC_RELEASE, "agent");
            asm volatile("s_waitcnt vmcnt(0)" ::: "memory");
            const unsigned og = xb_add(&bar[XB_TOP], 1u);
            const unsigned tg = og / nx;
            if (og + 1u == (tg + 1u) * nx) xb_add(&bar[XB_TOPGEN], 1u);
            else XB_SPIN(xb_ld(&bar[XB_TOPGEN]) == tg, bar);
            __builtin_amdgcn_fence(__ATOMIC_ACQUIRE, "agent");
            xb_add(&bar[XB_XGEN(b.x)], 1u);
            asm volatile("s_waitcnt vmcnt(0)" ::: "memory");
        } else {
            XB_SPIN(xb_ld(&bar[XB_XGEN(b.x)]) == gen, bar);
            asm volatile("buffer_inv sc0\n\ts_waitcnt vmcnt(0)" ::: "memory");
        }
    }
    __syncthreads();
}


DEV void late_transpose_item(const P& p, int it, float* smem) {
    const int m = it >> 8, t = it & 255;
    const float* W = m == 0 ? p.w_out : (m == 1 ? p.xa_wq : (m == 2 ? p.xa_wo : p.peer_wq));
    const size_t off = m == 0 ? WS_WOUT_T : (m == 1 ? WS_WQ_T : (m == 2 ? WS_WO_T : WS_PWQ_T));
    const int mat2 = m >> 1;
    if (m & 1) transpose_tile(W, 1024, (bf16_t*)(p.ws + off), t >> 4, t & 15, smem, 1024, p.ln_g + mat2 * 1024, p.ln_b + mat2 * 1024,
                              (float*)(p.ws + WS_C12) + (size_t)(mat2 * 16 + (t >> 4)) * 2048);
    else transpose_tile(W, 1024, (bf16_t*)(p.ws + off), t >> 4, t & 15, smem);
}

constexpr int WQ_WORD0 = 4096;
DEV int wq_next(unsigned* cnt, int nper, int xcc, unsigned char* lds) {
    volatile unsigned* slot = (volatile unsigned*)(lds + LDS_BYTES - 16);
    __syncthreads();
    if (threadIdx.x == 0) {
        int res = -1;
        int off = (int)slot[1];
        while (off < 8) {
            const int q = (xcc + off) & 7;
            const unsigned idx = atomicAdd(&cnt[q * 64], 1u);
            if (idx < (unsigned)nper) { res = q * nper + (int)idx; break; }
            ++off;
        }
        slot[0] = (unsigned)res;
        slot[1] = (unsigned)off;
    }
    __syncthreads();
    return (int)slot[0];
}
DEV void wq_begin(unsigned char* lds) {
    __syncthreads();
    if (threadIdx.x == 0) ((volatile unsigned*)(lds + LDS_BYTES - 16))[1] = 0u;
}

constexpr int NSTAGES = 12;
template <int ST>
DEV void run_stage(const P& p, unsigned char* lds, int xcc) {
    float* smem = (float*)lds;
    const int nb = gridDim.x, bid = blockIdx.x;
    int tidl = threadIdx.x;
    asm volatile("" : "+v"(tidl));
    const int wave = tidl >> 6;
    unsigned* wqc = (unsigned*)(p.ws + WS_BAR) + WQ_WORD0;
    if (ST == 0) {
        for (int it = bid; it < PREP_END; it += nb) prep_item(p, it, smem);
    } else if (ST == 1) {
        for (int it = bid; it < 1536 + 384 + 128; it += nb) {
            if (it < 1536) gemm_item<0>(p, it & 7, it >> 3, lds);
            else if (it < 1920) { const int i2 = it - 1536, q = i2 & 7, j = i2 >> 3; gemm_mfma_tile<0>(p, q * 16 + (j & 15), 24 + (j >> 4), lds); }
            else gemm_item<1>(p, (it - 1920) & 7, (it - 1920) >> 3, lds);
        }
    } else if (ST == 2) {
        if (PROBE_REP == 21) for (int it = bid; it < 256; it += nb) compress_item2(p, it, lds);
        if (PROBE_REP == 22) for (int it = bid; it < 1024; it += nb) hgrn_prep_item(p, it, smem);
        for (int it = bid; it < 256 + 1024; it += nb) {
            if (it < 256) compress_item2(p, it, lds);
            else hgrn_prep_item2(p, it - 256, lds);
        }
    } else if (ST == 3) {
        if (PROBE_REP == 31) { for (int it = bid; it < 32; it += nb) hgrn_chain_item(p, it, lds); }
        if (PROBE_REP == 32) {
            volatile unsigned* qs2 = (volatile unsigned*)(lds + LDS_BYTES - 16);
            for (;;) {
                __syncthreads();
                if (threadIdx.x == 0) *qs2 = atomicAdd(wqc + 64, 1u);
                __syncthreads();
                const int j = (int)*qs2;
                if (j >= 1024) break;
                nsa_item2(p, (j & 15) >> 1, j & 1, 63 - (j >> 4), lds, p.out != nullptr ? 4 : 0);
            }
        }
        volatile unsigned* qslot = (volatile unsigned*)(lds + LDS_BYTES - 16);
        for (;;) {
            __syncthreads();
            if (threadIdx.x == 0) *qslot = atomicAdd(wqc, 1u);
            __syncthreads();
            const int it = (int)*qslot;
            if (it >= 64 + 2048) break;
            if (it < 64) hgrn_chain_item3(p, it, lds);
            else if (((it - 64) & 1) == 0) { const int j = (it - 64) >> 1; nsa_item2(p, (j & 15) >> 1, j & 1, 63 - (j >> 4), lds); }
            else {
                const int j = (it - 64) >> 1, tb = j >> 9, r0 = (j & 511) * 32 + wave * 8;
                for (int r = 0; r < 8; r += 4) {
                    if (tb == 0) peer_quant_rows4(p.peer_down, p.ws + WS_PD, (float*)(p.ws + WS_PSD), r0 + r, (int*)(p.ws + WS_PRS));
                    else peer_quant_rows4(p.peer_up, p.ws + WS_PU, (float*)(p.ws + WS_PSU), r0 + r, nullptr, 0);
                }
            }
        }
        for (;;) {
            __syncthreads();
            if (threadIdx.x == 0) *qslot = atomicAdd(wqc + 128, 1u);
            __syncthreads();
            const int it = (int)*qslot;
            if (it >= 1024) break;
            late_transpose_item(p, it, smem);
        }
    } else if (ST == 4) {
        for (int it = bid; it < 512; it += nb) gemm_item<2>(p, it & 7, it >> 3, lds);
    } else if (ST == 5) {
        for (int it = bid; it < T_ / 4; it += nb) ln_item(p, it * 4 + wave, 0, tidl & 63);
    } else if (ST == 9) {
        for (int it = bid; it < T_ / 4; it += nb) ln_item(p, it * 4 + wave, 1, tidl & 63);
    } else if (ST == 6) {
        for (int it = bid; it < 512; it += nb) gemm_item<3>(p, it & 7, it >> 3, lds);
    } else if (ST == 7) {
        for (int it = bid; it < 1024; it += nb) xattn_item3(p, it, lds);
    } else if (ST == 8) {
        for (int it = bid; it < 512; it += nb) gemm_item<4>(p, it & 7, it >> 3, lds);
    } else if (ST == 10) {
        for (int it = bid; it < 512; it += nb) gemm_item<5>(p, it & 7, it >> 3, lds);
    } else if (ST == 11) {
        if (PROBE_REP == 11) for (int it = bid; it < T_ / 16; it += nb) peer_route_item(p, it, lds);
        for (int it = bid; it < T_ / 16; it += nb) peer_route_item(p, it, lds);
    } else if (ST == 12) {
        if (PROBE_REP == 12) { wq_begin(lds); for (int it; (it = wq_next(wqc + 4 * 512, 512, xcc, lds)) >= 0;) peer_down_item(p, it >> 9, it & 511, tidl & 63, wave); }
        wq_begin(lds);
        for (int it; (it = wq_next(wqc + 2 * 512, 512, xcc, lds)) >= 0;) peer_down_item(p, it >> 9, it & 511, tidl & 63, wave);
    } else if (ST == 13) {
        if (PROBE_REP == 13) for (int it = bid; it < T_ / 4; it += nb) peer_coef_item(p, it * 4 + wave, tidl & 63);
        for (int it = bid; it < T_ / 4; it += nb) peer_coef_item(p, it * 4 + wave, tidl & 63);
    } else if (ST == 14) {
        if (PROBE_REP == 14) { wq_begin(lds); for (int it; (it = wq_next(wqc + 5 * 512, 512, xcc, lds)) >= 0;) peer_up_item(p, it >> 9, it & 511, tidl & 63, wave, p.out == nullptr); }
        wq_begin(lds);
        for (int it; (it = wq_next(wqc + 3 * 512, 512, xcc, lds)) >= 0;) peer_up_item(p, it >> 9, it & 511, tidl & 63, wave);
    } else if (ST == 15) {
        for (int it = bid; it < T_ / 4; it += nb) ln3_item(p, it * 4 + wave, tidl & 63);
    }
}

template <int ST>
__global__ void __launch_bounds__(256, 2) stage_kernel(P p) {
    __shared__ __attribute__((aligned(16))) unsigned char lds[LDS_BYTES + 16];
    run_stage<ST>(p, lds, (int)xb_xcc_id() & 7);
}

__global__ void __launch_bounds__(256, 2) mega_kernel(P p) {
    __shared__ __attribute__((aligned(16))) unsigned char lds[LDS_BYTES + 16];
    if (threadIdx.x == 0) *(uint4*)(lds + LDS_BYTES) = make_uint4(0u, 0u, 0u, 0u);
    __syncthreads();
    const XcdBarrier xb = xcd_barrier_post((unsigned*)(p.ws + WS_BAR), (volatile LAS unsigned*)(lds + LDS_BYTES));
    const int xcc = (int)xb.x & 7;
    run_stage<0>(p, lds, xcc); xcd_barrier(xb);
    if (PROBE_REP == 0) { run_stage<0>(p, lds, xcc); xcd_barrier(xb); }
    run_stage<1>(p, lds, xcc); xcd_barrier(xb);
    if (PROBE_REP == 1) { run_stage<1>(p, lds, xcc); xcd_barrier(xb); }
    run_stage<2>(p, lds, xcc); xcd_barrier(xb);
    if (PROBE_REP == 2) { run_stage<2>(p, lds, xcc); xcd_barrier(xb); }
    if (PROBE_REP == 35) { if (blockIdx.x < 32) hgrn_chain_item2(p, blockIdx.x, lds); xcd_barrier(xb); }
    run_stage<3>(p, lds, xcc); xcd_barrier(xb);
    run_stage<4>(p, lds, xcc); xcd_barrier(xb);
    if (PROBE_REP == 4) { run_stage<4>(p, lds, xcc); xcd_barrier(xb); }
    if (PROBE_REP == 50) { xcd_barrier(xb); xcd_barrier(xb); xcd_barrier(xb); xcd_barrier(xb); xcd_barrier(xb); xcd_barrier(xb); xcd_barrier(xb); xcd_barrier(xb); }
    run_stage<6>(p, lds, xcc); xcd_barrier(xb);
    if (PROBE_REP == 6) { run_stage<6>(p, lds, xcc); xcd_barrier(xb); }
    run_stage<7>(p, lds, xcc); xcd_barrier(xb);
    if (PROBE_REP == 7) { run_stage<7>(p, lds, xcc); xcd_barrier(xb); }
    run_stage<8>(p, lds, xcc); xcd_barrier(xb);
    run_stage<10>(p, lds, xcc); xcd_barrier(xb);
    if (PROBE_REP == 10) { run_stage<10>(p, lds, xcc); xcd_barrier(xb); }
    run_stage<11>(p, lds, xcc); xcd_barrier(xb);
    run_stage<12>(p, lds, xcc); xcd_barrier(xb);
    run_stage<13>(p, lds, xcc); xcd_barrier(xb);
    run_stage<14>(p, lds, xcc); xcd_barrier(xb);
    run_stage<15>(p, lds, xcc);
}

extern "C" void kernel_launch(void* const* d_in, const int* in_sizes, int n_in, void* d_out, int out_size, void* d_ws, size_t ws_size,
                              hipStream_t stream) {
    if (n_in != 18 || ws_size < WS_END) {
        fprintf(stderr, "kernel_launch: unexpected inputs (n_in %d, ws %zu, need %zu)\n", n_in, ws_size, (size_t)WS_END);
        return;
    }
    P p{};
    p.x = (const float*)d_in[0]; p.mem = (const float*)d_in[1]; p.w_in = (const float*)d_in[2]; p.cmp_pos = (const float*)d_in[3];
    p.cmp_w1 = (const float*)d_in[4]; p.cmp_w2 = (const float*)d_in[5]; p.lb_logits = (const float*)d_in[6];
    p.hg_norm_w = (const float*)d_in[7]; p.w_out = (const float*)d_in[8]; p.xa_wq = (const float*)d_in[9];
    p.xa_wkv = (const float*)d_in[10]; p.xa_wo = (const float*)d_in[11]; p.peer_wq = (const float*)d_in[12];
    p.peer_keys = (const float*)d_in[13]; p.peer_down = (const float*)d_in[14]; p.peer_up = (const float*)d_in[15];
    p.ln_g = (const float*)d_in[16]; p.ln_b = (const float*)d_in[17];
    p.out = (float*)d_out; p.ws = (unsigned char*)d_ws;
#if ONE_LAUNCH
    static int grid_blocks = 0;
    if (!grid_blocks) {
        int dev = 0, cus = 0, per_cu = 0;
        hipGetDevice(&dev);
        hipDeviceGetAttribute(&cus, hipDeviceAttributeMultiprocessorCount, dev);
        hipOccupancyMaxActiveBlocksPerMultiprocessor(&per_cu, mega_kernel, 256, 0);
        if (per_cu > 2) per_cu = 2;
        if (per_cu < 1) per_cu = 1;
        grid_blocks = cus * per_cu;
    }
    (void)hipMemsetAsync((unsigned char*)d_ws + WS_BAR, 0, 65536, stream);
    void* args[] = {&p};
    hipError_t e = hipLaunchCooperativeKernel((void*)mega_kernel, dim3(grid_blocks), dim3(256), args, 0, stream);
    if (e != hipSuccess) fprintf(stderr, "cooperative launch failed: %s (grid %d)\n", hipGetErrorString(e), grid_blocks);
#else
    const int G = 2048;
    stage_kernel<0><<<G, 256, 0, stream>>>(p);
    stage_kernel<1><<<G, 256, 0, stream>>>(p);
    stage_kernel<2><<<G, 256, 0, stream>>>(p);
    stage_kernel<3><<<G, 256, 0, stream>>>(p);
    stage_kernel<4><<<G, 256, 0, stream>>>(p);
    stage_kernel<5><<<G, 256, 0, stream>>>(p);
    stage_kernel<6><<<G, 256, 0, stream>>>(p);
    stage_kernel<7><<<G, 256, 0, stream>>>(p);
    stage_kernel<8><<<G, 256, 0, stream>>>(p);
    stage_kernel<9><<<G, 256, 0, stream>>>(p);
    stage_kernel<10><<<G, 256, 0, stream>>>(p);
    stage_kernel<11><<<G, 256, 0, stream>>>(p);
#endif
}
```

```cpp
#include <hip/hip_runtime.h>
#include <hip/hip_cooperative_groups.h>
#include <cstdio>
#include <cstdint>
namespace cg = cooperative_groups;

#ifndef PROBE_REP
#define PROBE_REP -1
#endif
#ifndef ONE_LAUNCH
#define ONE_LAUNCH 1
#endif

typedef unsigned short bf16_t;
#define DEV __device__ __forceinline__

constexpr int D_ = 1024, B_ = 8, S_ = 2048, T_ = B_ * S_, ML_ = 256, INC = 3352;
constexpr int NCMP = 127;
constexpr int LDS_BYTES = 67584;
constexpr float ALPHA = 1.189207115002721f;
constexpr float LN_EPS = 1e-5f;
constexpr int C_QA = 0, C_KC = 512, C_VC = 640, C_KS = 768, C_VS = 896, C_KW = 1024, C_VW = 1152, C_GATE = 1280,
              C_HQ = 1304, C_HF = 1816, C_HI = 2328, C_HG = 2840;
constexpr size_t WS_HB = 0;
constexpr size_t SZ_HB = (size_t)T_ * INC * 2;
constexpr size_t WS_OM = WS_HB + SZ_HB;
constexpr size_t WS_KVM = WS_OM + (size_t)T_ * 1024 * 2;
constexpr size_t WS_KC = WS_KVM + (size_t)2048 * 2048 * 2;
constexpr size_t WS_XB = WS_KC + (1u << 20);
constexpr size_t WS_WIN_T = WS_XB + (size_t)T_ * 1024 * 2;
constexpr size_t WS_WOUT_T = WS_WIN_T + (size_t)3456 * 1024 * 2;
constexpr size_t WS_WQ_T = WS_WOUT_T + (size_t)1024 * 1024 * 2;
constexpr size_t WS_WKV_T = WS_WQ_T + (size_t)1024 * 1024 * 2;
constexpr size_t WS_WO_T = WS_WKV_T + (size_t)2048 * 1024 * 2;
constexpr size_t WS_PWQ_T = WS_WO_T + (size_t)1024 * 1024 * 2;
constexpr size_t WS_MEMB = WS_PWQ_T + (size_t)1024 * 1024 * 2;
constexpr size_t WS_PKEY = WS_MEMB + (size_t)2048 * 1024 * 2;
constexpr size_t WS_VT = WS_PKEY + (size_t)16 * 128 * 64 * 2;
constexpr size_t WS_KCB = WS_VT + (size_t)2 * B_ * 2 * 64 * 2048 * 2;
constexpr size_t WS_VCT = WS_KCB + (size_t)B_ * 2 * 128 * 64 * 2;
constexpr size_t WS_W1T = WS_VCT + (size_t)B_ * 2 * 128 * 64 * 2;
constexpr size_t WS_W2T = WS_W1T + (size_t)2 * 128 * 2048 * 2;
constexpr size_t WS_CB = WS_W2T + (size_t)2 * 64 * 128 * 2;
constexpr size_t WS_VMT = WS_CB + 1024;
constexpr size_t WS_BAR = WS_VMT + (size_t)B_ * 4 * 256 * 256 * 2;
constexpr size_t WS_PD = WS_BAR + 65536;
constexpr size_t WS_PU = WS_PD + (size_t)16384 * 1024;
constexpr size_t WS_PSD = WS_PU + (size_t)16384 * 1024;
constexpr size_t WS_PSU = WS_PSD + 65536;
constexpr size_t WS_PRS = WS_PSU + 65536;
constexpr size_t WS_LNP1 = WS_PRS + 65536;
constexpr size_t WS_LNP2 = WS_LNP1 + (size_t)T_ * 16 * 8;
constexpr size_t WS_ST2 = WS_LNP2 + (size_t)T_ * 16 * 8;
constexpr size_t WS_C12 = WS_ST2 + (size_t)T_ * 8;
constexpr size_t WS_SSP = WS_C12 + 262144;
constexpr size_t WS_END = WS_SSP + (size_t)32 * 8 * 2048 * 4;
static_assert(WS_END <= (size_t)268435456, "workspace budget");
constexpr size_t WS_EB = WS_KC;
constexpr size_t HS_QT = 0;
constexpr size_t HS_KT = (size_t)B_ * 4 * 2048 * 128 * 2;
constexpr size_t HS_KHT = 2 * HS_KT;
constexpr size_t HS_VIT = 3 * HS_KT;
constexpr size_t HS_DS = HS_KT;
constexpr size_t HS_OI = 3 * HS_KT;
constexpr size_t WS_QX = 67108864;
constexpr size_t WS_OX = (size_t)T_ * 1024 * 2;
constexpr size_t WS_QP = 104857600;
constexpr size_t WS_YB = 0;
constexpr size_t WS_EIDP = (size_t)T_ * 1024 * 2;
constexpr size_t WS_GATEP = WS_EIDP + (size_t)T_ * 128 * 2;
constexpr size_t WS_COEFP = WS_GATEP + (size_t)T_ * 128 * 4;
constexpr size_t WS_XQ = WS_COEFP + (size_t)T_ * 128 * 4;
constexpr size_t WS_SXF = WS_XQ + (size_t)T_ * 1024;
constexpr size_t WS_SXI = WS_SXF + (size_t)T_ * 4;
constexpr size_t WS_ASUM = WS_SXI + (size_t)T_ * 4;
constexpr size_t WS_DP = WS_ASUM + (size_t)T_ * 4;
static_assert(WS_DP + (size_t)8 * T_ * 128 * 4 <= WS_KVM, "PEER intermediates must fit in the dead h/OM region");

struct P {
    const float *x, *mem, *w_in, *cmp_pos, *cmp_w1, *cmp_w2, *lb_logits, *hg_norm_w, *w_out, *xa_wq, *xa_wkv, *xa_wo,
        *peer_wq, *peer_keys, *peer_down, *peer_up, *ln_g, *ln_b;
    float* out;
    unsigned char* ws;
};

DEV unsigned short f2bf(float f) {
    unsigned u = __float_as_uint(f);
    u += 0x7fffu + ((u >> 16) & 1u);
    return (unsigned short)(u >> 16);
}
DEV float bf2f(unsigned short h) { return __uint_as_float(((unsigned)h) << 16); }
DEV float bflo(unsigned u) { return __uint_as_float(u << 16); }
DEV float bfhi(unsigned u) { return __uint_as_float(u & 0xffff0000u); }
typedef __bf16 bf16x2_t __attribute__((ext_vector_type(2)));
typedef float f32x2_t __attribute__((ext_vector_type(2)));
DEV unsigned pk_bf16(float a, float b) {
    f32x2_t v = {a, b};
    bf16x2_t r = __builtin_convertvector(v, bf16x2_t);
    return __builtin_bit_cast(unsigned, r);
}
DEV float wsum(float v) {
#pragma unroll
    for (int o = 32; o > 0; o >>= 1) v += __shfl_xor(v, o);
    return v;
}
DEV float wmax(float v) {
#pragma unroll
    for (int o = 32; o > 0; o >>= 1) v = fmaxf(v, __shfl_xor(v, o));
    return v;
}
DEV float sigmoidf_(float x) { return 1.f / (1.f + expf(-x)); }
DEV float fsigmoid(float x) { return __builtin_amdgcn_rcpf(1.f + __expf(-x)); }

template <int MODE>
DEV void gemm_tile(const P& p, int tile, float* smem) {
    constexpr bool ABF = (MODE == 2 || MODE == 4);
    constexpr int K = 1024;
    constexpr int N = MODE == 0 ? INC : (MODE == 1 ? 2048 : 1024);
    constexpr int NTN = (N + 63) / 64;
    const int tm = tile / NTN, tn = tile % NTN;
    const float* Af = nullptr;
    const bf16_t* Ab = nullptr;
    const float* Bm = nullptr;
    if (MODE == 0) { Af = p.x; Bm = p.w_in; }
    if (MODE == 1) { Af = p.mem; Bm = p.xa_wkv; }
    if (MODE == 2) { Ab = (const bf16_t*)(p.ws + WS_OM); Bm = p.w_out; }
    if (MODE == 3) { Af = p.out; Bm = p.xa_wq; }
    if (MODE == 4) { Ab = (const bf16_t*)(p.ws + WS_OX); Bm = p.xa_wo; }
    if (MODE == 5) { Af = p.out; Bm = p.peer_wq; }
    float(*sA)[68] = (float(*)[68])smem;
    float(*sB)[68] = (float(*)[68])(smem + 16 * 68);
    const int tid = threadIdx.x, tx = tid & 15, ty = tid >> 4;
    const int ar = tid >> 2, ak = (tid & 3) * 4;
    const int bk = tid >> 4, bn = (tid & 15) * 4;
    float acc[4][4];
#pragma unroll
    for (int i = 0; i < 4; ++i)
#pragma unroll
        for (int j = 0; j < 4; ++j) acc[i][j] = 0.f;
    const int gn = tn * 64 + bn;
    for (int k0 = 0; k0 < K; k0 += 16) {
        float4 av;
        if (ABF) {
            uint2 u = *(const uint2*)(Ab + (size_t)(tm * 64 + ar) * K + k0 + ak);
            av.x = bflo(u.x); av.y = bfhi(u.x); av.z = bflo(u.y); av.w = bfhi(u.y);
        } else {
            av = *(const float4*)(Af + (size_t)(tm * 64 + ar) * K + k0 + ak);
        }
        float4 bv = make_float4(0.f, 0.f, 0.f, 0.f);
        if (gn < N) bv = *(const float4*)(Bm + (size_t)(k0 + bk) * N + gn);
        sA[ak + 0][ar] = av.x; sA[ak + 1][ar] = av.y; sA[ak + 2][ar] = av.z; sA[ak + 3][ar] = av.w;
        *(float4*)&sB[bk][bn] = bv;
        __syncthreads();
#pragma unroll
        for (int kk = 0; kk < 16; ++kk) {
            float4 a = *(const float4*)&sA[kk][ty * 4];
            float4 b = *(const float4*)&sB[kk][tx * 4];
            float aa[4] = {a.x, a.y, a.z, a.w}, bb[4] = {b.x, b.y, b.z, b.w};
#pragma unroll
            for (int i = 0; i < 4; ++i)
#pragma unroll
                for (int j = 0; j < 4; ++j) acc[i][j] += aa[i] * bb[j];
        }
        __syncthreads();
    }
    const int col = tn * 64 + tx * 4;
#pragma unroll
    for (int i = 0; i < 4; ++i) {
        const size_t row = (size_t)tm * 64 + ty * 4 + i;
        if (MODE == 0 || MODE == 1 || MODE == 3) {
            bf16_t* O = (bf16_t*)(p.ws + (MODE == 0 ? WS_HB : (MODE == 1 ? WS_KVM : WS_QX)));
            if (col < N) {
                uint2 u;
                u.x = (unsigned)f2bf(acc[i][0]) | ((unsigned)f2bf(acc[i][1]) << 16);
                u.y = (unsigned)f2bf(acc[i][2]) | ((unsigned)f2bf(acc[i][3]) << 16);
                *(uint2*)(O + row * N + col) = u;
            }
        } else if (MODE == 2) {
            float4 xv = *(const float4*)(p.x + row * 1024 + col);
            float4 o = make_float4(ALPHA * xv.x + acc[i][0], ALPHA * xv.y + acc[i][1], ALPHA * xv.z + acc[i][2], ALPHA * xv.w + acc[i][3]);
            *(float4*)(p.out + row * 1024 + col) = o;
        } else if (MODE == 4) {
            float4 xv = *(const float4*)(p.out + row * 1024 + col);
            float4 o = make_float4(ALPHA * xv.x + acc[i][0], ALPHA * xv.y + acc[i][1], ALPHA * xv.z + acc[i][2], ALPHA * xv.w + acc[i][3]);
            *(float4*)(p.out + row * 1024 + col) = o;
        } else {
            float* O = (float*)(p.ws + WS_QP);
            *(float4*)(O + row * 1024 + col) = make_float4(acc[i][0], acc[i][1], acc[i][2], acc[i][3]);
        }
    }
}


using bf16x8 = __attribute__((ext_vector_type(8))) short;
using f32x4 = __attribute__((ext_vector_type(4))) float;
using u32x4 = __attribute__((ext_vector_type(4))) unsigned;

template <int MODE>
DEV void gemm_mfma_tile(const P& p, int tm, int tn, unsigned char* lds) {
    const bf16_t* A;
    const bf16_t* W;
    if (MODE == 0) { A = (const bf16_t*)(p.ws + WS_XB); W = (const bf16_t*)(p.ws + WS_WIN_T); }
    if (MODE == 1) { A = (const bf16_t*)(p.ws + WS_MEMB); W = (const bf16_t*)(p.ws + WS_WKV_T); }
    if (MODE == 2) { A = (const bf16_t*)(p.ws + WS_OM); W = (const bf16_t*)(p.ws + WS_WOUT_T); }
    if (MODE == 3) { A = (const bf16_t*)(p.ws + WS_XB); W = (const bf16_t*)(p.ws + WS_WQ_T); }
    if (MODE == 4) { A = (const bf16_t*)(p.ws + WS_OX); W = (const bf16_t*)(p.ws + WS_WO_T); }
    if (MODE == 5) { A = (const bf16_t*)(p.ws + WS_XB); W = (const bf16_t*)(p.ws + WS_PWQ_T); }
    const int tid = threadIdx.x, lane = tid & 63, wid = tid >> 6, wm = wid >> 1, wn = wid & 1;
    const int m0 = tm * 128, n0 = tn * 128;
    const bf16_t* ga[2];
    const bf16_t* gw[2];
#pragma unroll
    for (int i = 0; i < 2; ++i) {
        const int r = (wid * 2 + i) * 16 + (lane >> 2);
        const int gsw = (0x1320 >> (((r >> 2) & 3) * 4)) & 3;
        const int c = (lane & 3) ^ gsw;
        ga[i] = A + (size_t)(m0 + r) * 1024 + c * 8;
        gw[i] = W + (size_t)(n0 + r) * 1024 + c * 8;
    }
    unsigned char* lbase = lds + wid * 2048;
#define GEMM_STAGE(slot, kt)                                                                                                   \
    do {                                                                                                                       \
        _Pragma("unroll") for (int i = 0; i < 2; ++i) {                                                                        \
            __builtin_amdgcn_global_load_lds((const unsigned*)(ga[i] + (kt) * 32), (unsigned*)(lbase + (slot) * 16384 + i * 1024), 16, 0, 0);         \
            __builtin_amdgcn_global_load_lds((const unsigned*)(gw[i] + (kt) * 32), (unsigned*)(lbase + (slot) * 16384 + 8192 + i * 1024), 16, 0, 0);  \
        }                                                                                                                      \
    } while (0)
    asm volatile("s_waitcnt vmcnt(0)" ::: "memory");
    GEMM_STAGE(0, 0);
    GEMM_STAGE(1, 1);
    GEMM_STAGE(2, 2);
    f32x4 acc[4][4];
#pragma unroll
    for (int i = 0; i < 4; ++i)
#pragma unroll
        for (int j = 0; j < 4; ++j) acc[i][j] = (f32x4){0.f, 0.f, 0.f, 0.f};
    const int fr = lane & 15, fq = lane >> 4;
    const int fsw = (0x1320 >> (((fr >> 2) & 3) * 4)) & 3;
    const int aoff = (wm * 64 + fr) * 64 + ((fq ^ fsw) << 4);
    const int boff = 8192 + (wn * 64 + fr) * 64 + ((fq ^ fsw) << 4);
#define GEMM_COMPUTE(slot)                                                                                                     \
    do {                                                                                                                       \
        const unsigned char* sb = lds + (slot) * 16384;                                                                        \
        bf16x8 af[4], wf[4];                                                                                                   \
        _Pragma("unroll") for (int t = 0; t < 4; ++t) {                                                                        \
            af[t] = *(const bf16x8*)(sb + aoff + t * 1024);                                                                    \
            wf[t] = *(const bf16x8*)(sb + boff + t * 1024);                                                                    \
        }                                                                                                                      \
        _Pragma("unroll") for (int nt = 0; nt < 4; ++nt)                                                                       \
            _Pragma("unroll") for (int mt = 0; mt < 4; ++mt)                                                                   \
                acc[nt][mt] = __builtin_amdgcn_mfma_f32_16x16x32_bf16(wf[nt], af[mt], acc[nt][mt], 0, 0, 0);                   \
    } while (0)
#pragma unroll 1
    for (int kt = 0; kt < 29; ++kt) {
        asm volatile("s_waitcnt vmcnt(8)\n\ts_waitcnt lgkmcnt(0)" ::: "memory");
        __builtin_amdgcn_s_barrier(); asm volatile("" ::: "memory");
        GEMM_STAGE((kt + 3) & 3, kt + 3);
        GEMM_COMPUTE(kt & 3);
    }
    asm volatile("s_waitcnt vmcnt(8)\n\ts_waitcnt lgkmcnt(0)" ::: "memory");
    __builtin_amdgcn_s_barrier(); asm volatile("" ::: "memory");
    GEMM_COMPUTE(29 & 3);
    asm volatile("s_waitcnt vmcnt(4)\n\ts_waitcnt lgkmcnt(0)" ::: "memory");
    __builtin_amdgcn_s_barrier(); asm volatile("" ::: "memory");
    GEMM_COMPUTE(30 & 3);
    asm volatile("s_waitcnt vmcnt(0)\n\ts_waitcnt lgkmcnt(0)" ::: "memory");
    __builtin_amdgcn_s_barrier(); asm volatile("" ::: "memory");
    GEMM_COMPUTE(31 & 3);
    asm volatile("s_waitcnt lgkmcnt(0)" ::: "memory");
    __builtin_amdgcn_s_barrier(); asm volatile("" ::: "memory");
#undef GEMM_STAGE
#undef GEMM_COMPUTE
#pragma unroll
    for (int mt = 0; mt < 4; ++mt) {
        const size_t m = (size_t)m0 + wm * 64 + mt * 16 + fr;
#pragma unroll
        for (int nt = 0; nt < 4; ++nt) {
            const int n = n0 + wn * 64 + nt * 16 + fq * 4;
            const f32x4 c = acc[nt][mt];
            if (MODE == 0 || MODE == 1 || MODE == 3 || MODE == 5) {
                constexpr int NS = MODE == 0 ? INC : (MODE == 1 ? 2048 : 1024);
                bf16_t* O = (bf16_t*)(p.ws + (MODE == 0 ? WS_HB : (MODE == 1 ? WS_KVM : (MODE == 3 ? WS_QX : WS_QP))));
                if (MODE == 1 && tn >= 8) {
                    bf16_t* VMT = (bf16_t*)(p.ws + WS_VMT);
                    const int nn = n - 1024;
                    const size_t base = (((size_t)(m >> 8) * 4 + (nn >> 8)) * 256 + (nn & 255)) * 256 + (m & 255);
#pragma unroll
                    for (int i = 0; i < 4; ++i) VMT[base + (size_t)i * 256] = f2bf(c[i]);
                } else if (MODE == 0 && (tn == 7 || tn == 9)) {
                    bf16_t* VT = (bf16_t*)(p.ws + WS_VT);
                    const int which = tn == 9 ? 1 : 0;
                    const size_t base = ((((size_t)which * B_ + (m >> 11)) * 2 + wn) * 64 + nt * 16 + fq * 4) * 2048 + (m & 2047);
#pragma unroll
                    for (int i = 0; i < 4; ++i) VT[base + (size_t)i * 2048] = f2bf(c[i]);
                } else if (MODE != 0 || n < INC) {
                    uint2 u;
                    u.x = pk_bf16(c[0], c[1]);
                    u.y = pk_bf16(c[2], c[3]);
                    *(uint2*)(O + m * NS + n) = u;
                }
            } else if (MODE == 2) {
                const float4 xv = *(const float4*)(p.x + m * 1024 + n);
                *(uint2*)((bf16_t*)(p.ws + WS_YB) + m * 1024 + n) = make_uint2(pk_bf16(ALPHA * xv.x + c[0], ALPHA * xv.y + c[1]), pk_bf16(ALPHA * xv.z + c[2], ALPHA * xv.w + c[3]));
            } else if (MODE == 4) {
                const uint2 xb = *(const uint2*)((const bf16_t*)(p.ws + WS_XB) + m * 1024 + n);
                *(uint2*)((bf16_t*)(p.ws + WS_YB) + m * 1024 + n) = make_uint2(pk_bf16(ALPHA * bflo(xb.x) + c[0], ALPHA * bfhi(xb.x) + c[1]), pk_bf16(ALPHA * bflo(xb.y) + c[2], ALPHA * bfhi(xb.y) + c[3]));
            }
        }
    }
}


template <int MODE>
DEV void gemm_mfma_tile256(const P& p, int tm, int tn, unsigned char* lds) {
    const bf16_t* A;
    const bf16_t* W;
    if (MODE == 0) { A = (const bf16_t*)(p.ws + WS_XB); W = (const bf16_t*)(p.ws + WS_WIN_T); }
    if (MODE == 1) { A = (const bf16_t*)(p.ws + WS_MEMB); W = (const bf16_t*)(p.ws + WS_WKV_T); }
    if (MODE == 2) { A = (const bf16_t*)(p.ws + WS_OM); W = (const bf16_t*)(p.ws + WS_WOUT_T); }
    if (MODE == 3) { A = (const bf16_t*)(p.ws + WS_YB); W = (const bf16_t*)(p.ws + WS_WQ_T); }
    if (MODE == 4) { A = (const bf16_t*)(p.ws + WS_OX); W = (const bf16_t*)(p.ws + WS_WO_T); }
    if (MODE == 5) { A = (const bf16_t*)(p.ws + WS_YB); W = (const bf16_t*)(p.ws + WS_PWQ_T); }
    int tid = threadIdx.x;
    asm volatile("" : "+v"(tid));
    const int lane = tid & 63, wid = tid >> 6, wm = wid >> 1, wn = wid & 1;
    const int m0 = tm * 256, n0 = tn * 128;
    float2* STL = (float2*)(lds + 49152);
    const bf16_t* ga[4];
    const bf16_t* gw[2];
#pragma unroll
    for (int i = 0; i < 4; ++i) {
        const int r = (wid * 4 + i) * 16 + (lane >> 2);
        const int gsw = (0x1320 >> (((r >> 2) & 3) * 4)) & 3;
        ga[i] = A + (size_t)(m0 + r) * 1024 + ((lane & 3) ^ gsw) * 8;
    }
#pragma unroll
    for (int i = 0; i < 2; ++i) {
        const int r = (wid * 2 + i) * 16 + (lane >> 2);
        const int gsw = (0x1320 >> (((r >> 2) & 3) * 4)) & 3;
        gw[i] = W + (size_t)(n0 + r) * 1024 + ((lane & 3) ^ gsw) * 8;
    }
    unsigned char* lbA = lds + wid * 4096;
    unsigned char* lbW = lds + 16384 + wid * 2048;
#define GEMM_STAGE(slot, kt)                                                                                                   \
    do {                                                                                                                       \
        _Pragma("unroll") for (int i = 0; i < 4; ++i)                                                                          \
            __builtin_amdgcn_global_load_lds((const unsigned*)(ga[i] + (kt) * 32), (unsigned*)(lbA + (slot) * 24576 + i * 1024), 16, 0, 0);  \
        _Pragma("unroll") for (int i = 0; i < 2; ++i)                                                                          \
            __builtin_amdgcn_global_load_lds((const unsigned*)(gw[i] + (kt) * 32), (unsigned*)(lbW + (slot) * 24576 + i * 1024), 16, 0, 0);  \
    } while (0)
    float st_mean = 0.f, st_rs = 0.f, c12v = 0.f;
    float4 hq = make_float4(1.f, 1.f, 1.f, 1.f);
    if (MODE == 3 || MODE == 4 || MODE == 5) {
        float4 sv[8];
        float cv[16];
        if (MODE != 4) {
            const float* pc = (const float*)(p.ws + WS_C12) + (size_t)((MODE == 5 ? 16 : 0) * 2 + (tid >> 7)) * 1024 + n0 + (tid & 127);
#pragma unroll
            for (int i = 0; i < 16; ++i) cv[i] = pc[i * 2048];
        }
        const float4* pp = (const float4*)(p.ws + (MODE == 5 ? WS_LNP2 : WS_LNP1)) + (size_t)(m0 + tid) * 8;
#pragma unroll
        for (int i = 0; i < 8; ++i) sv[i] = pp[i];
        GEMM_STAGE(0, 0);
        if (MODE != 4) {
#pragma unroll
            for (int i = 0; i < 16; ++i) c12v += cv[i];
        }
        float s1 = 0.f, s2 = 0.f;
#pragma unroll
        for (int i = 0; i < 8; ++i) { s1 += sv[i].x + sv[i].z; s2 += sv[i].y + sv[i].w; }
        st_mean = s1 * (1.f / 1024.f);
        st_rs = rsqrtf(fmaxf(s2 * (1.f / 1024.f) - st_mean * st_mean, 0.f) + LN_EPS);
    } else if (MODE == 2) {
        const int mrow = m0 + tid, bb = mrow >> 11, tt_ = mrow & 2047;
        const float* sp = (const float*)(p.ws + WS_SSP) + (size_t)bb * 32 * 2048 + tt_;
        float sv32[32];
#pragma unroll
        for (int i = 0; i < 32; ++i) sv32[i] = sp[(size_t)i * 2048];
        GEMM_STAGE(0, 0);
        float rs[4];
#pragma unroll
        for (int h = 0; h < 4; ++h) {
            float t = 0.f;
#pragma unroll
            for (int g = 0; g < 8; ++g) t += sv32[h * 8 + g];
            rs[h] = rsqrtf(t * (1.f / 128.f) + LN_EPS);
        }
        hq = make_float4(1.f / rs[0], rs[0] / rs[1], rs[1] / rs[2], rs[2] / rs[3]);
        st_rs = rs[3];
    } else {
        GEMM_STAGE(0, 0);
    }
    f32x4 acc[4][8];
#pragma unroll
    for (int i = 0; i < 4; ++i)
#pragma unroll
        for (int j = 0; j < 8; ++j) acc[i][j] = (f32x4){0.f, 0.f, 0.f, 0.f};
    const int fr = lane & 15, fq = lane >> 4;
    const int fsw = (0x1320 >> (((fr >> 2) & 3) * 4)) & 3;
    const int aoff = (wm * 128 + fr) * 64 + ((fq ^ fsw) << 4);
    const int boff = 16384 + (wn * 64 + fr) * 64 + ((fq ^ fsw) << 4);
#define GEMM_COMPUTE(kt)                                                                                                       \
    do {                                                                                                                       \
        const unsigned char* sb = lds + ((kt) & 1) * 24576;                                                                    \
        bf16x8 af[8], wf[4];                                                                                                   \
        _Pragma("unroll") for (int t = 0; t < 8; ++t) af[t] = *(const bf16x8*)(sb + aoff + t * 1024);                          \
        _Pragma("unroll") for (int t = 0; t < 4; ++t) wf[t] = *(const bf16x8*)(sb + boff + t * 1024);                          \
        _Pragma("unroll") for (int nt = 0; nt < 4; ++nt)                                                                       \
            _Pragma("unroll") for (int mt = 0; mt < 8; ++mt) acc[nt][mt] = __builtin_amdgcn_mfma_f32_16x16x32_bf16(wf[nt], af[mt], acc[nt][mt], 0, 0, 0); \
    } while (0)
    {
        asm volatile("s_waitcnt vmcnt(0)\n\ts_waitcnt lgkmcnt(0)" ::: "memory");
        __builtin_amdgcn_s_barrier(); asm volatile("" ::: "memory");
        GEMM_STAGE(1, 1);
        if (MODE == 2) {
            ((float4*)(lds + 53248))[tid] = hq;
            ((float*)(lds + 57344))[tid] = st_rs;
        }
        if (MODE == 3 || MODE == 4 || MODE == 5) {
            STL[tid] = make_float2(st_mean, st_rs);
            if (MODE == 5 && tn == 0) ((float2*)(p.ws + WS_ST2))[m0 + tid] = make_float2(st_mean, st_rs);
            if (MODE != 4) ((float*)(lds + 49152 + 2048))[tid] = c12v;
        }
        GEMM_COMPUTE(0);
    }
#pragma unroll 1
    for (int kt = 1; kt < 32; ++kt) {
        asm volatile("s_waitcnt vmcnt(0)\n\ts_waitcnt lgkmcnt(0)" ::: "memory");
        __builtin_amdgcn_s_barrier(); asm volatile("" ::: "memory");
        if (kt + 1 < 32) { if (kt & 1) GEMM_STAGE(0, kt + 1); else GEMM_STAGE(1, kt + 1); }
        if (MODE == 2 && kt >= 16 && (kt & 3) == 0) {
            const float* rq = (const float*)(lds + 53248) + ((kt - 16) >> 2);
#pragma unroll
            for (int mt = 0; mt < 8; ++mt) {
                const float f = rq[(wm * 128 + mt * 16 + fr) * 4];
#pragma unroll
                for (int nt = 0; nt < 4; ++nt) { acc[nt][mt][0] *= f; acc[nt][mt][1] *= f; acc[nt][mt][2] *= f; acc[nt][mt][3] *= f; }
            }
        }
        GEMM_COMPUTE(kt);
    }
#undef GEMM_COMPUTE
    if (MODE == 2) {
        const float* r3 = (const float*)(lds + 57344);
#pragma unroll
        for (int mt = 0; mt < 8; ++mt) {
            const float f = r3[wm * 128 + mt * 16 + fr];
#pragma unroll
            for (int nt = 0; nt < 4; ++nt) { acc[nt][mt][0] *= f; acc[nt][mt][1] *= f; acc[nt][mt][2] *= f; acc[nt][mt][3] *= f; }
        }
    }
    asm volatile("s_waitcnt lgkmcnt(0)" ::: "memory");
    __builtin_amdgcn_s_barrier(); asm volatile("" ::: "memory");
#undef GEMM_STAGE
    if (MODE == 3 || MODE == 5) {
        bf16_t* O = (bf16_t*)(p.ws + (MODE == 3 ? WS_QX : WS_QP));
        const float* C12L = (const float*)(lds + 49152 + 2048);
#pragma unroll
        for (int nt = 0; nt < 4; ++nt) {
            const int n = n0 + wn * 64 + nt * 16 + fq * 4;
            const float4 c1 = *(const float4*)(C12L + (n - n0)), c2 = *(const float4*)(C12L + 128 + (n - n0));
#pragma unroll
            for (int mt = 0; mt < 8; ++mt) {
                const int ml = wm * 128 + mt * 16 + fr;
                const float2 st = STL[ml];
                const f32x4 c = acc[nt][mt];
                uint2 u;
                u.x = pk_bf16(st.y * (c[0] - st.x * c1.x) + c2.x, st.y * (c[1] - st.x * c1.y) + c2.y);
                u.y = pk_bf16(st.y * (c[2] - st.x * c1.z) + c2.z, st.y * (c[3] - st.x * c1.w) + c2.w);
                *(uint2*)(O + (size_t)(m0 + ml) * 1024 + n) = u;
            }
        }
    } else if (MODE == 4) {
        bf16_t* YB = (bf16_t*)(p.ws + WS_YB);
        float4 g4[4], b4[4];
#pragma unroll
        for (int nt = 0; nt < 4; ++nt) {
            const int n = n0 + wn * 64 + nt * 16 + fq * 4;
            g4[nt] = *(const float4*)(p.ln_g + n);
            b4[nt] = *(const float4*)(p.ln_b + n);
        }
        bf16_t* ybase = YB + (size_t)(m0 + wm * 128 + fr) * 1024 + n0 + wn * 64 + fq * 4;
        uint2 ycur[4], ynx[4];
#pragma unroll
        for (int nt = 0; nt < 4; ++nt) ycur[nt] = *(const uint2*)(ybase + nt * 16);
#pragma unroll
        for (int mt = 0; mt < 8; ++mt) {
            const int ml = wm * 128 + mt * 16 + fr;
            const float2 st = STL[ml];
            bf16_t* yrow = ybase + (size_t)mt * 16384;
            if (mt + 1 < 8) {
#pragma unroll
                for (int nt = 0; nt < 4; ++nt) ynx[nt] = *(const uint2*)(yrow + 16384 + nt * 16);
            }
            float s1 = 0.f, s2 = 0.f;
#pragma unroll
            for (int nt = 0; nt < 4; ++nt) {
                const f32x4 c = acc[nt][mt];
                const uint2 yb = ycur[nt];
                const float y0 = ALPHA * ((bflo(yb.x) - st.x) * st.y * g4[nt].x + b4[nt].x) + c[0];
                const float y1 = ALPHA * ((bfhi(yb.x) - st.x) * st.y * g4[nt].y + b4[nt].y) + c[1];
                const float y2 = ALPHA * ((bflo(yb.y) - st.x) * st.y * g4[nt].z + b4[nt].z) + c[2];
                const float y3 = ALPHA * ((bfhi(yb.y) - st.x) * st.y * g4[nt].w + b4[nt].w) + c[3];
                s1 += (y0 + y1) + (y2 + y3);
                s2 += (y0 * y0 + y1 * y1) + (y2 * y2 + y3 * y3);
                *(uint2*)(yrow + nt * 16) = make_uint2(pk_bf16(y0, y1), pk_bf16(y2, y3));
            }
            s1 += __shfl_xor(s1, 16); s2 += __shfl_xor(s2, 16);
            s1 += __shfl_xor(s1, 32); s2 += __shfl_xor(s2, 32);
            if (fq == 0) ((float2*)(p.ws + WS_LNP2))[(size_t)(m0 + ml) * 16 + tn * 2 + wn] = make_float2(s1, s2);
#pragma unroll
            for (int nt = 0; nt < 4; ++nt) ycur[nt] = ynx[nt];
        }
    } else {
    float4 xcur[4], xnx[4];
    const float* xbase = p.x + ((size_t)m0 + wm * 128 + fr) * 1024 + n0 + wn * 64 + fq * 4;
    if (MODE == 2) {
#pragma unroll
        for (int nt = 0; nt < 4; ++nt) xcur[nt] = *(const float4*)(xbase + nt * 16);
    }
#pragma unroll
    for (int mt = 0; mt < 8; ++mt) {
        const size_t m = (size_t)m0 + wm * 128 + mt * 16 + fr;
        float s1 = 0.f, s2 = 0.f;
        if (MODE == 2 && mt + 1 < 8) {
#pragma unroll
            for (int nt = 0; nt < 4; ++nt) xnx[nt] = *(const float4*)(xbase + (size_t)(mt + 1) * 16384 + nt * 16);
        }
#pragma unroll
        for (int nt = 0; nt < 4; ++nt) {
            const int n = n0 + wn * 64 + nt * 16 + fq * 4;
            const f32x4 c = acc[nt][mt];
            if (MODE == 0 || MODE == 1) {
                constexpr int NS = MODE == 0 ? INC : 2048;
                bf16_t* O = (bf16_t*)(p.ws + (MODE == 0 ? WS_HB : WS_KVM));
                if (MODE == 1 && tn >= 8) {
                    bf16_t* VMT = (bf16_t*)(p.ws + WS_VMT);
                    const int nn = n - 1024;
                    const size_t base = (((size_t)(m >> 8) * 4 + (nn >> 8)) * 256 + (nn & 255)) * 256 + (m & 255);
#pragma unroll
                    for (int i = 0; i < 4; ++i) VMT[base + (size_t)i * 256] = f2bf(c[i]);
                } else if (MODE == 0 && (tn == 7 || tn == 9)) {
                    bf16_t* VT = (bf16_t*)(p.ws + WS_VT);
                    const int which = tn == 9 ? 1 : 0;
                    const size_t base = ((((size_t)which * B_ + (m >> 11)) * 2 + wn) * 64 + nt * 16 + fq * 4) * 2048 + (m & 2047);
#pragma unroll
                    for (int i = 0; i < 4; ++i) VT[base + (size_t)i * 2048] = f2bf(c[i]);
                } else if (MODE != 0 || n < INC) {
                    uint2 u;
                    u.x = pk_bf16(c[0], c[1]);
                    u.y = pk_bf16(c[2], c[3]);
                    *(uint2*)(O + m * NS + n) = u;
                }
            } else if (MODE == 2) {
                const float4 xv = xcur[nt];
                const float y0 = ALPHA * xv.x + c[0], y1 = ALPHA * xv.y + c[1], y2 = ALPHA * xv.z + c[2], y3 = ALPHA * xv.w + c[3];
                s1 += (y0 + y1) + (y2 + y3);
                s2 += (y0 * y0 + y1 * y1) + (y2 * y2 + y3 * y3);
                *(uint2*)((bf16_t*)(p.ws + WS_YB) + m * 1024 + n) = make_uint2(pk_bf16(y0, y1), pk_bf16(y2, y3));
            }
        }
        if (MODE == 2) {
            s1 += __shfl_xor(s1, 16); s2 += __shfl_xor(s2, 16);
            s1 += __shfl_xor(s1, 32); s2 += __shfl_xor(s2, 32);
            if (fq == 0) ((float2*)(p.ws + WS_LNP1))[m * 16 + tn * 2 + wn] = make_float2(s1, s2);
        }
        if (MODE == 2) {
#pragma unroll
            for (int nt = 0; nt < 4; ++nt) xcur[nt] = xnx[nt];
        }
    }
    }
}


template <int MODE>
DEV void gemm_item(const P& p, int q, int j, unsigned char* lds) {
    int tm, tn;
    if (MODE == 0) {
        tm = q * 8 + (j & 7);
        tn = j >> 3;
    } else if (MODE == 1) {
        tm = q; tn = j;
    } else {
        tm = q * 8 + (j & 7);
        tn = j >> 3;
    }
    gemm_mfma_tile256<MODE>(p, tm, tn, lds);
}

DEV void transpose_tile(const float* W, int N, bf16_t* Wt, int tk, int tn, float* s, int ldk = 1024, const float* gk = nullptr,
                        const float* bk = nullptr, float* part = nullptr) {
    const int tid = threadIdx.x;
    const int k0 = tk * 64, n0 = tn * 64;
    float* s2 = s + 64 * 65;
#pragma unroll
    for (int i = 0; i < 4; ++i) {
        const int k = (tid >> 4) + 16 * i, n = (tid & 15) * 4;
        float4 v = make_float4(0.f, 0.f, 0.f, 0.f);
        if (n0 + n < N) v = *(const float4*)(W + (size_t)(k0 + k) * N + n0 + n);
        if (gk) {
            const float g = gk[k0 + k], bb = bk[k0 + k];
            s2[k * 65 + n + 0] = bb * v.x; s2[k * 65 + n + 1] = bb * v.y; s2[k * 65 + n + 2] = bb * v.z; s2[k * 65 + n + 3] = bb * v.w;
            v.x *= g; v.y *= g; v.z *= g; v.w *= g;
        }
        s[k * 65 + n + 0] = v.x; s[k * 65 + n + 1] = v.y; s[k * 65 + n + 2] = v.z; s[k * 65 + n + 3] = v.w;
    }
    __syncthreads();
    {
        const int n = tid >> 2, kc = (tid & 3) * 16;
        unsigned u[8];
#pragma unroll
        for (int j = 0; j < 8; ++j)
            u[j] = (unsigned)f2bf(s[(kc + 2 * j) * 65 + n]) | ((unsigned)f2bf(s[(kc + 2 * j + 1) * 65 + n]) << 16);
        bf16_t* dst = Wt + (size_t)(n0 + n) * ldk + k0 + kc;
        *(uint4*)dst = make_uint4(u[0], u[1], u[2], u[3]);
        *(uint4*)(dst + 8) = make_uint4(u[4], u[5], u[6], u[7]);
    }
    if (part && tid < 128) {
        const int which = tid >> 6, n = tid & 63;
        float t = 0.f;
#pragma unroll 8
        for (int k = 0; k < 64; ++k) t += which ? s2[k * 65 + n] : bf2f(f2bf(s[k * 65 + n]));
        part[which * 1024 + n0 + n] = t;
    }
    __syncthreads();
}
DEV void convert_chunk(const float* src, bf16_t* dst, int item) {
    float4 a[4], b[4];
#pragma unroll
    for (int j = 0; j < 4; ++j) {
        const size_t e = (((size_t)item * 4 + j) * 256 + threadIdx.x) * 8;
        a[j] = *(const float4*)(src + e);
        b[j] = *(const float4*)(src + e + 4);
    }
#pragma unroll
    for (int j = 0; j < 4; ++j) {
        const size_t e = (((size_t)item * 4 + j) * 256 + threadIdx.x) * 8;
        uint4 u;
        u.x = pk_bf16(a[j].x, a[j].y);
        u.y = pk_bf16(a[j].z, a[j].w);
        u.z = pk_bf16(b[j].x, b[j].y);
        u.w = pk_bf16(b[j].z, b[j].w);
        *(uint4*)(dst + e) = u;
    }
}
constexpr int PREP_T0 = 16 * 54, PREP_T3 = PREP_T0 + 512, PREP_T5 = PREP_T3, PREP_X = PREP_T5 + T_ * 1024 / 8192, PREP_M = PREP_X + 2048 * 1024 / 8192, PREP_K = PREP_M + 16 * 128 * 64 / 8192, PREP_W1 = PREP_K + 128, PREP_W2 = PREP_W1 + 4,
              PREP_END = PREP_W2;
DEV void prep_item(const P& p, int it, float* smem) {
    if (it < PREP_T0) transpose_tile(p.w_in, INC, (bf16_t*)(p.ws + WS_WIN_T), it / 54, it % 54, smem);
    else if (it < PREP_T3) { it -= PREP_T0; transpose_tile(p.xa_wkv, 2048, (bf16_t*)(p.ws + WS_WKV_T), it >> 5, it & 31, smem); }
    else if (it < PREP_X) convert_chunk(p.x, (bf16_t*)(p.ws + WS_XB), it - PREP_T5);
    else if (it < PREP_M) convert_chunk(p.mem, (bf16_t*)(p.ws + WS_MEMB), it - PREP_X);
    else if (it < PREP_K) convert_chunk(p.peer_keys, (bf16_t*)(p.ws + WS_PKEY), it - PREP_M);
    else if (it < PREP_W1) {
        it -= PREP_K;
        const int kind = it >> 6, r = it & 63;
        transpose_tile(p.cmp_w1 + (size_t)kind * 2048 * 128, 128, (bf16_t*)(p.ws + WS_W1T) + (size_t)kind * 128 * 2048, r >> 1, r & 1, smem, 2048);
    } else if (it < PREP_W2) {
        it -= PREP_W1;
        const int kind = it >> 1;
        transpose_tile(p.cmp_w2 + (size_t)kind * 128 * 64, 64, (bf16_t*)(p.ws + WS_W2T) + (size_t)kind * 64 * 128, it & 1, 0, smem, 128);
    }
}

DEV void compress_item(const P& p, int item, float* smem) {
    const int tid = threadIdx.x;
    const int g = item & 1;
    int r = item >> 1;
    const int n = r % NCMP;
    r /= NCMP;
    const int b = r & 7, kind = r >> 3;
    const bf16_t* HB = (const bf16_t*)(p.ws + WS_HB);
    float* KC = (float*)(p.ws + WS_KC);
    float* su = smem;
    float* sp = smem + 2048;
    float* sh = smem + 2304;
    const int col = (kind ? C_VC : C_KC) + g * 64;
    for (int i = tid; i < 2048; i += 256) {
        const int l = i >> 6, d = i & 63;
        su[i] = bf2f(HB[(size_t)(b * S_ + 16 * n + l) * INC + col + d]) + p.cmp_pos[(kind * 32 + l) * 64 + d];
    }
    __syncthreads();
    {
        const int j = tid & 127, hf = tid >> 7;
        const float* w1 = p.cmp_w1 + (size_t)kind * 2048 * 128;
        float acc = 0.f;
        for (int i = hf * 1024; i < hf * 1024 + 1024; ++i) acc += su[i] * w1[(size_t)i * 128 + j];
        sp[hf * 128 + j] = acc;
    }
    __syncthreads();
    if (tid < 128) {
        const float v = sp[tid] + sp[128 + tid];
        const float u = 0.7978845608028654f * (v + 0.044715f * v * v * v);
        sh[tid] = 0.5f * v * (1.f + tanhf(u));
    }
    __syncthreads();
    if (tid < 64) {
        const float* w2 = p.cmp_w2 + (size_t)kind * 128 * 64;
        float acc = 0.f;
        for (int j = 0; j < 128; ++j) acc += sh[j] * w2[j * 64 + tid];
        KC[((((size_t)kind * B_ + b) * NCMP + n) * 2 + g) * 64 + tid] = acc;
    }
    __syncthreads();
}

DEV void load_q64_bf(float (&q)[64], const bf16_t* src) {
    const uint4* s4 = (const uint4*)src;
#pragma unroll
    for (int i = 0; i < 8; ++i) {
        const uint4 u = s4[i];
        q[i * 8 + 0] = bflo(u.x); q[i * 8 + 1] = bfhi(u.x); q[i * 8 + 2] = bflo(u.y); q[i * 8 + 3] = bfhi(u.y);
        q[i * 8 + 4] = bflo(u.z); q[i * 8 + 5] = bfhi(u.z); q[i * 8 + 6] = bflo(u.w); q[i * 8 + 7] = bfhi(u.w);
    }
}
DEV float dot64_bf(const float (&q)[64], const bf16_t* kr) {
    const uint4* k4 = (const uint4*)kr;
    float acc = 0.f;
#pragma unroll
    for (int i = 0; i < 8; ++i) {
        const uint4 u = k4[i];
        acc += q[i * 8 + 0] * bflo(u.x) + q[i * 8 + 1] * bfhi(u.x) + q[i * 8 + 2] * bflo(u.y) + q[i * 8 + 3] * bfhi(u.y) +
               q[i * 8 + 4] * bflo(u.z) + q[i * 8 + 5] * bfhi(u.z) + q[i * 8 + 6] * bflo(u.w) + q[i * 8 + 7] * bfhi(u.w);
    }
    return acc;
}
DEV float dot64_f(const float (&q)[64], const float* kr) {
    const float4* k4 = (const float4*)kr;
    float acc = 0.f;
#pragma unroll
    for (int i = 0; i < 16; ++i) {
        const float4 u = k4[i];
        acc += q[i * 4 + 0] * u.x + q[i * 4 + 1] * u.y + q[i * 4 + 2] * u.z + q[i * 4 + 3] * u.w;
    }
    return acc;
}

DEV void attn_block(const float (&q)[64], const bf16_t* krow_lane, const bf16_t* vbase_lane, bool valid, float& m, float& l, float& o) {
    float sc = dot64_bf(q, krow_lane) * 0.125f;
    sc = valid ? sc : -1e30f;
    const float mb = wmax(sc);
    const float mn = fmaxf(m, mb);
    const float corr = expf(m - mn);
    const float e = valid ? expf(sc - mn) : 0.f;
    l = l * corr + wsum(e);
    o *= corr;
#pragma unroll 8
    for (int k = 0; k < 64; ++k) o += __shfl(e, k) * bf2f(vbase_lane[(size_t)k * INC]);
    m = mn;
}

DEV void nsa_item(const P& p, int item) {
    const int lane = threadIdx.x & 63;
    const int g = item & 1;
    const int t = item >> 1;
    const int b = t >> 11, s = t & 2047;
    const bf16_t* HB = (const bf16_t*)(p.ws + WS_HB);
    const float* KC = (const float*)(p.ws + WS_KC);
    bf16_t* OM = (bf16_t*)(p.ws + WS_OM);
    const int cur = s >> 6;
    const int nvalid = (s >= 31) ? (((s - 31) >> 4) + 1) : 0;
    const size_t rowt = (size_t)t * INC;
    float ocmp0 = 0.f, ocmp1 = 0.f, ocmp2 = 0.f, ocmp3 = 0.f;
    float psum0 = 0.f, psum1 = 0.f;
    if (nvalid > 0) {
#pragma unroll 1
        for (int r = 0; r < 4; ++r) {
            const int h = g * 4 + r;
            float q[64];
            load_q64_bf(q, HB + rowt + C_QA + h * 64);
            float sc0 = -1e30f, sc1 = -1e30f;
            if (lane < nvalid) sc0 = dot64_f(q, KC + ((((size_t)0 * B_ + b) * NCMP + lane) * 2 + g) * 64) * 0.125f;
            if (lane + 64 < nvalid) sc1 = dot64_f(q, KC + ((((size_t)0 * B_ + b) * NCMP + lane + 64) * 2 + g) * 64) * 0.125f;
            const float m = wmax(fmaxf(sc0, sc1));
            const float e0 = (lane < nvalid) ? expf(sc0 - m) : 0.f;
            const float e1 = (lane + 64 < nvalid) ? expf(sc1 - m) : 0.f;
            const float l = wsum(e0 + e1);
            const float p0 = e0 / l, p1 = e1 / l;
            psum0 += p0;
            psum1 += p1;
            float oc = 0.f;
            const float* vcb = KC + ((((size_t)1 * B_ + b) * NCMP) * 2 + g) * 64 + lane;
            for (int n = 0; n < nvalid; ++n) {
                const float pn = (n < 64) ? __shfl(p0, n) : __shfl(p1, n - 64);
                oc += pn * vcb[(size_t)n * 128];
            }
            if (r == 0) ocmp0 = oc;
            if (r == 1) ocmp1 = oc;
            if (r == 2) ocmp2 = oc;
            if (r == 3) ocmp3 = oc;
        }
    }
    float imp = 0.f;
#pragma unroll
    for (int dn = -1; dn <= 3; ++dn) {
        const int n = 4 * lane + dn;
        const int nn = n < 0 ? 0 : (n > 127 ? 127 : n);
        const float v0 = __shfl(psum0, nn & 63);
        const float v1 = __shfl(psum1, nn & 63);
        const float v = (nn < 64) ? v0 : v1;
        if (n >= 0 && n <= 126) imp += v;
    }
    float score;
    if (lane > cur) score = -INFINITY;
    else if (lane == 0 || lane == cur || lane == cur - 1) score = 1e4f;
    else score = imp;
    int rank = 0;
#pragma unroll 8
    for (int i = 0; i < 32; ++i) {
        const float si = __shfl(score, i);
        rank += ((si > score) || (si == score && i < lane)) ? 1 : 0;
    }
    const bool sel = (lane <= cur) && (rank < 16);
    const unsigned mask = (unsigned)(__ballot(sel) & 0xffffffffull);
    const int wlo = (s - 511) > 0 ? (s - 511) : 0;
#pragma unroll 1
    for (int r = 0; r < 4; ++r) {
        const int h = g * 4 + r;
        float q[64];
        load_q64_bf(q, HB + rowt + C_QA + h * 64);
        float m = -1e30f, l = 0.f, o = 0.f;
        for (unsigned mm = mask; mm; mm &= mm - 1) {
            const int j = __builtin_ctz(mm);
            const int kpos = j * 64 + lane;
            attn_block(q, HB + (size_t)(b * S_ + kpos) * INC + C_KS + g * 64, HB + (size_t)(b * S_ + j * 64) * INC + C_VS + g * 64 + lane,
                       kpos <= s, m, l, o);
        }
        const float oslc = o / l;
        m = -1e30f; l = 0.f; o = 0.f;
        for (int j = wlo >> 6; j <= cur; ++j) {
            const int kpos = j * 64 + lane;
            attn_block(q, HB + (size_t)(b * S_ + kpos) * INC + C_KW + g * 64, HB + (size_t)(b * S_ + j * 64) * INC + C_VW + g * 64 + lane,
                       (kpos <= s) && (kpos >= wlo), m, l, o);
        }
        const float owin = o / l;
        const float oc = r == 0 ? ocmp0 : (r == 1 ? ocmp1 : (r == 2 ? ocmp2 : ocmp3));
        const float g0 = sigmoidf_(bf2f(HB[rowt + C_GATE + h * 3 + 0]));
        const float g1 = sigmoidf_(bf2f(HB[rowt + C_GATE + h * 3 + 1]));
        const float g2 = sigmoidf_(bf2f(HB[rowt + C_GATE + h * 3 + 2]));
        OM[(size_t)t * 1024 + h * 64 + lane] = f2bf(g0 * oc + g1 * oslc + g2 * owin);
    }
}

DEV void hgrn_item(const P& p, int item, float* smem) {
    const int b = item >> 2, hh = item & 3;
    const int tid = threadIdx.x, dv = tid & 127, half = tid >> 7;
    const bf16_t* HB = (const bf16_t*)(p.ws + WS_HB);
    bf16_t* OM = (bf16_t*)(p.ws + WS_OM);
    float* sf = smem;
    float* sq = smem + 1024;
    float* so = smem + 2048;
    float Sreg[64];
#pragma unroll
    for (int i = 0; i < 64; ++i) Sreg[i] = 0.f;
    const int d = tid & 127;
    float lbv;
    {
        const float l0 = p.lb_logits[hh * 128 + d], l1 = p.lb_logits[512 + hh * 128 + d];
        const float mx = fmaxf(l0, l1);
        const float e0 = expf(l0 - mx), e1 = expf(l1 - mx);
        lbv = e0 / (e0 + e1);
    }
    const int wave = tid >> 6, lane = tid & 63;
    const float nw0 = p.hg_norm_w[hh * 128 + lane], nw1 = p.hg_norm_w[hh * 128 + lane + 64];
    for (int t0 = 0; t0 < S_; t0 += 8) {
#pragma unroll
        for (int i = 0; i < 4; ++i) {
            const int st = (tid >> 7) + 2 * i;
            const size_t tt = (size_t)b * S_ + t0 + st;
            const float fl = bf2f(HB[tt * INC + C_HF + hh * 128 + d]);
            sf[st * 128 + d] = lbv + (1.f - lbv) * sigmoidf_(fl);
            sq[st * 128 + d] = bf2f(HB[tt * INC + C_HQ + hh * 128 + d]);
        }
        float vv[8];
#pragma unroll
        for (int st = 0; st < 8; ++st) vv[st] = bf2f(HB[((size_t)b * S_ + t0 + st) * INC + C_HI + hh * 128 + dv]);
        __syncthreads();
#pragma unroll
        for (int st = 0; st < 8; ++st) {
            float oacc = 0.f;
            const float* pf = sf + st * 128 + half * 64;
            const float* pq = sq + st * 128 + half * 64;
#pragma unroll
            for (int dk = 0; dk < 64; ++dk) {
                const float f = pf[dk];
                Sreg[dk] = f * Sreg[dk] + (1.f - f) * vv[st];
                oacc += pq[dk] * Sreg[dk];
            }
            so[(st * 2 + half) * 128 + dv] = oacc;
        }
        __syncthreads();
#pragma unroll
        for (int u = 0; u < 2; ++u) {
            const int st = wave * 2 + u;
            const float o0 = so[(st * 2 + 0) * 128 + lane] + so[(st * 2 + 1) * 128 + lane];
            const float o1 = so[(st * 2 + 0) * 128 + lane + 64] + so[(st * 2 + 1) * 128 + lane + 64];
            const float ss = wsum(o0 * o0 + o1 * o1);
            const float rs = rsqrtf(ss * (1.f / 128.f) + LN_EPS);
            const size_t tt = (size_t)b * S_ + t0 + st;
            const float gg0 = bf2f(HB[tt * INC + C_HG + hh * 128 + lane]);
            const float gg1 = bf2f(HB[tt * INC + C_HG + hh * 128 + lane + 64]);
            OM[tt * 1024 + 512 + hh * 128 + lane] = f2bf(o0 * rs * nw0 * (gg0 * sigmoidf_(gg0)));
            OM[tt * 1024 + 512 + hh * 128 + lane + 64] = f2bf(o1 * rs * nw1 * (gg1 * sigmoidf_(gg1)));
        }
    }
    __syncthreads();
}

DEV void ln_item(const P& p, int t, int which, int lane) {
    const bf16_t* row = (const bf16_t*)(p.ws + WS_YB) + (size_t)t * 1024;
    float4 v[4];
    float s = 0.f;
#pragma unroll
    for (int i = 0; i < 4; ++i) {
        const uint2 u = *(const uint2*)(row + (i * 64 + lane) * 4);
        v[i] = make_float4(bflo(u.x), bfhi(u.x), bflo(u.y), bfhi(u.y));
        s += v[i].x + v[i].y + v[i].z + v[i].w;
    }
    const float mean = wsum(s) * (1.f / 1024.f);
    float ss = 0.f;
#pragma unroll
    for (int i = 0; i < 4; ++i) {
        v[i].x -= mean; v[i].y -= mean; v[i].z -= mean; v[i].w -= mean;
        ss += v[i].x * v[i].x + v[i].y * v[i].y + v[i].z * v[i].z + v[i].w * v[i].w;
    }
    const float rs = rsqrtf(wsum(ss) * (1.f / 1024.f) + LN_EPS);
#pragma unroll
    for (int i = 0; i < 4; ++i) {
        const int c = (i * 64 + lane) * 4;
        const float4 gg = *(const float4*)(p.ln_g + which * 1024 + c);
        const float4 bb = *(const float4*)(p.ln_b + which * 1024 + c);
        float4 o;
        o.x = v[i].x * rs * gg.x + bb.x; o.y = v[i].y * rs * gg.y + bb.y; o.z = v[i].z * rs * gg.z + bb.z; o.w = v[i].w * rs * gg.w + bb.w;
        uint2 u;
        u.x = pk_bf16(o.x, o.y);
        u.y = pk_bf16(o.z, o.w);
        *(uint2*)((bf16_t*)(p.ws + WS_XB) + (size_t)t * 1024 + c) = u;
    }
}

DEV void xattn_item(const P& p, int item) {
    const int lane = threadIdx.x & 63;
    const int hh = item & 3, t = item >> 2, b = t >> 11;
    const bf16_t* QX = (const bf16_t*)(p.ws + WS_QX);
    const bf16_t* KVM = (const bf16_t*)(p.ws + WS_KVM);
    bf16_t* OX = (bf16_t*)(p.ws + WS_OX);
    float sc[4] = {0.f, 0.f, 0.f, 0.f};
#pragma unroll 1
    for (int c = 0; c < 4; ++c) {
        float q[64];
        load_q64_bf(q, QX + (size_t)t * 1024 + hh * 256 + c * 64);
#pragma unroll
        for (int k = 0; k < 4; ++k) sc[k] += dot64_bf(q, KVM + (size_t)(b * ML_ + lane + 64 * k) * 2048 + hh * 256 + c * 64);
    }
    float mx = -1e30f;
#pragma unroll
    for (int k = 0; k < 4; ++k) { sc[k] *= 0.0625f; mx = fmaxf(mx, sc[k]); }
    mx = wmax(mx);
    float pr[4], ls = 0.f;
#pragma unroll
    for (int k = 0; k < 4; ++k) { pr[k] = expf(sc[k] - mx); ls += pr[k]; }
    ls = wsum(ls);
    const float inv = 1.f / ls;
    float o[4] = {0.f, 0.f, 0.f, 0.f};
#pragma unroll
    for (int k = 0; k < 4; ++k) {
        const bf16_t* vb = KVM + (size_t)(b * ML_ + k * 64) * 2048 + 1024 + hh * 256 + lane;
#pragma unroll 4
        for (int mm = 0; mm < 64; ++mm) {
            const float pm = __shfl(pr[k], mm);
#pragma unroll
            for (int c = 0; c < 4; ++c) o[c] += pm * bf2f(vb[(size_t)mm * 2048 + c * 64]);
        }
    }
#pragma unroll
    for (int c = 0; c < 4; ++c) OX[(size_t)t * 1024 + hh * 256 + c * 64 + lane] = f2bf(o[c] * inv);
}

DEV void wave_argmax(float v, int i, float& bv, int& bi) {
#pragma unroll
    for (int o = 32; o > 0; o >>= 1) {
        const float ov = __shfl_xor(v, o);
        const int oi = __shfl_xor(i, o);
        if (ov > v || (ov == v && oi < i)) { v = ov; i = oi; }
    }
    bv = v; bi = i;
}

DEV void peer_item(const P& p, int t) {
    const int lane = threadIdx.x & 63;
    const float* QP = (const float*)(p.ws + WS_QP);
    float* row = p.out + (size_t)t * 1024;
    float4 xr[4], oacc[4];
#pragma unroll
    for (int i = 0; i < 4; ++i) {
        xr[i] = *(const float4*)(row + (i * 64 + lane) * 4);
        oacc[i] = make_float4(0.f, 0.f, 0.f, 0.f);
    }
#pragma unroll 1
    for (int hh = 0; hh < 8; ++hh) {
        float ts1 = 0.f, ts2 = 0.f;
        int ti1 = 0, ti2 = 0;
#pragma unroll 1
        for (int c = 0; c < 2; ++c) {
            float q[64];
            {
                const float4* q4 = (const float4*)(QP + (size_t)t * 1024 + hh * 128 + c * 64);
#pragma unroll
                for (int i = 0; i < 16; ++i) { const float4 u = q4[i]; q[i * 4] = u.x; q[i * 4 + 1] = u.y; q[i * 4 + 2] = u.z; q[i * 4 + 3] = u.w; }
            }
            const float* kb = p.peer_keys + ((size_t)(hh * 2 + c) * 128) * 64;
            float a0 = dot64_f(q, kb + (size_t)lane * 64);
            float a1 = dot64_f(q, kb + (size_t)(lane + 64) * 64);
            float ts = 0.f;
            int ti = 0;
#pragma unroll 1
            for (int k = 0; k < 16; ++k) {
                float v; int i;
                if (a0 >= a1) { v = a0; i = lane; } else { v = a1; i = lane + 64; }
                float bv; int bi;
                wave_argmax(v, i, bv, bi);
                if (lane == k) { ts = bv; ti = bi; }
                if (bi == lane) a0 = -INFINITY;
                if (bi == lane + 64) a1 = -INFINITY;
            }
            if (c == 0) { ts1 = ts; ti1 = ti; } else { ts2 = ts; ti2 = ti; }
        }
        float cs[4];
        const float s1v = __shfl(ts1, lane >> 2);
#pragma unroll
        for (int u = 0; u < 4; ++u) cs[u] = s1v + __shfl(ts2, (lane & 3) * 4 + u);
        float fs = 0.f;
        int fidx = 0;
#pragma unroll 1
        for (int k = 0; k < 16; ++k) {
            float v = cs[0]; int i = lane * 4;
#pragma unroll
            for (int u = 1; u < 4; ++u) if (cs[u] > v) { v = cs[u]; i = lane * 4 + u; }
            float bv; int bi;
            wave_argmax(v, i, bv, bi);
            if (lane == k) { fs = bv; fidx = bi; }
#pragma unroll
            for (int u = 0; u < 4; ++u) if (bi == lane * 4 + u) cs[u] = -INFINITY;
        }
        const int e1i = __shfl(ti1, fidx >> 4);
        const int e2i = __shfl(ti2, fidx & 15);
        const int eid = e1i * 128 + e2i;
        const float mx = __shfl(fs, 0);
        const float w = (lane < 16) ? expf(fs - mx) : 0.f;
        const float gate = w / wsum(w);
#pragma unroll 1
        for (int k = 0; k < 16; ++k) {
            const int e = __shfl(eid, k);
            const float gt = __shfl(gate, k);
            const float* dr = p.peer_down + (size_t)e * 1024;
            const float* ur = p.peer_up + (size_t)e * 1024;
            float hd = 0.f;
#pragma unroll
            for (int i = 0; i < 4; ++i) {
                const float4 dvv = *(const float4*)(dr + (i * 64 + lane) * 4);
                hd += dvv.x * xr[i].x + dvv.y * xr[i].y + dvv.z * xr[i].z + dvv.w * xr[i].w;
            }
            hd = wsum(hd);
            const float a = 0.5f * hd * (1.f + erff(hd * 0.7071067811865476f)) * gt;
#pragma unroll
            for (int i = 0; i < 4; ++i) {
                const float4 uv = *(const float4*)(ur + (i * 64 + lane) * 4);
                oacc[i].x += a * uv.x; oacc[i].y += a * uv.y; oacc[i].z += a * uv.z; oacc[i].w += a * uv.w;
            }
        }
    }
    float s = 0.f;
    float4 v[4];
#pragma unroll
    for (int i = 0; i < 4; ++i) {
        v[i].x = ALPHA * xr[i].x + oacc[i].x; v[i].y = ALPHA * xr[i].y + oacc[i].y;
        v[i].z = ALPHA * xr[i].z + oacc[i].z; v[i].w = ALPHA * xr[i].w + oacc[i].w;
        s += v[i].x + v[i].y + v[i].z + v[i].w;
    }
    const float mean = wsum(s) * (1.f / 1024.f);
    float ss = 0.f;
#pragma unroll
    for (int i = 0; i < 4; ++i) {
        v[i].x -= mean; v[i].y -= mean; v[i].z -= mean; v[i].w -= mean;
        ss += v[i].x * v[i].x + v[i].y * v[i].y + v[i].z * v[i].z + v[i].w * v[i].w;
    }
    const float rs = rsqrtf(wsum(ss) * (1.f / 1024.f) + LN_EPS);
#pragma unroll
    for (int i = 0; i < 4; ++i) {
        const int c = (i * 64 + lane) * 4;
        const float4 gg = *(const float4*)(p.ln_g + 2 * 1024 + c);
        const float4 bb = *(const float4*)(p.ln_b + 2 * 1024 + c);
        float4 o;
        o.x = v[i].x * rs * gg.x + bb.x; o.y = v[i].y * rs * gg.y + bb.y; o.z = v[i].z * rs * gg.z + bb.z; o.w = v[i].w * rs * gg.w + bb.w;
        *(float4*)(row + c) = o;
    }
}


DEV void compress_item2(const P& p, int item, unsigned char* lds) {
    const int nt8 = item & 7, g = (item >> 3) & 1, b = (item >> 4) & 7, kind = item >> 7;
    const int tid = threadIdx.x, lane = tid & 63, wid = tid >> 6, fr = lane & 15, fq = lane >> 4;
    const bf16_t* HB = (const bf16_t*)(p.ws + WS_HB);
    const bf16_t* W1T = (const bf16_t*)(p.ws + WS_W1T) + (size_t)kind * 128 * 2048;
    const bf16_t* W2T = (const bf16_t*)(p.ws + WS_W2T) + (size_t)kind * 64 * 128;
    const float* posb = p.cmp_pos + (size_t)kind * 2048 + fq * 8;
    const int n0 = nt8 * 16;
    const int kcol = (kind ? C_VC : C_KC) + g * 64;
    const bf16_t* abase = HB + (size_t)(b * S_ + 16 * (n0 + fr)) * INC + kcol + fq * 8;
    const bf16_t* wbase = W1T + (size_t)fr * 2048 + fq * 8;
    f32x4 acc[8];
#pragma unroll
    for (int jt = 0; jt < 8; ++jt) acc[jt] = (f32x4){0.f, 0.f, 0.f, 0.f};
    bf16x8 wfA[8], wfB[8];
    u32x4 rawA, rawB;
    float4 pA0, pA1, pB0, pB1;
#define CMP_LOAD(wf8, raw, q0, q1, ks)                                                                              \
    do {                                                                                                            \
        _Pragma("unroll") for (int jt = 0; jt < 8; ++jt) wf8[jt] = *(const bf16x8*)(wbase + (size_t)jt * 16 * 2048 + (ks) * 32); \
        raw = *(const u32x4*)(abase + (size_t)((ks) >> 1) * INC + ((ks) & 1) * 32);                                 \
        const float* pp = posb + ((ks) >> 1) * 64 + ((ks) & 1) * 32;                                                \
        q0 = *(const float4*)pp; q1 = *(const float4*)(pp + 4);                                                     \
    } while (0)
#define CMP_MMA(wf8, raw, q0, q1)                                                                                   \
    do {                                                                                                            \
        u32x4 w;                                                                                                    \
        w[0] = pk_bf16(bflo(raw[0]) + q0.x, bfhi(raw[0]) + q0.y);                                                   \
        w[1] = pk_bf16(bflo(raw[1]) + q0.z, bfhi(raw[1]) + q0.w);                                                   \
        w[2] = pk_bf16(bflo(raw[2]) + q1.x, bfhi(raw[2]) + q1.y);                                                   \
        w[3] = pk_bf16(bflo(raw[3]) + q1.z, bfhi(raw[3]) + q1.w);                                                   \
        const bf16x8 af = __builtin_bit_cast(bf16x8, w);                                                            \
        _Pragma("unroll") for (int jt = 0; jt < 8; ++jt) acc[jt] = __builtin_amdgcn_mfma_f32_16x16x32_bf16(wf8[jt], af, acc[jt], 0, 0, 0); \
    } while (0)
    CMP_LOAD(wfA, rawA, pA0, pA1, wid * 16);
#pragma unroll 1
    for (int k2 = 0; k2 < 16; k2 += 2) {
        const int ks = wid * 16 + k2;
        CMP_LOAD(wfB, rawB, pB0, pB1, ks + 1);
        CMP_MMA(wfA, rawA, pA0, pA1);
        if (k2 + 2 < 16) CMP_LOAD(wfA, rawA, pA0, pA1, ks + 2);
        CMP_MMA(wfB, rawB, pB0, pB1);
    }
#undef CMP_LOAD
#undef CMP_MMA
    float* PS = (float*)lds;
    bf16_t* HS = (bf16_t*)(lds + 4 * 16 * 132 * 4);
#pragma unroll
    for (int jt = 0; jt < 8; ++jt)
        *(float4*)(PS + (wid * 16 + fr) * 132 + jt * 16 + fq * 4) = make_float4(acc[jt][0], acc[jt][1], acc[jt][2], acc[jt][3]);
    __syncthreads();
    {
        const int r = tid >> 4, jb = (tid & 15) * 8;
        float hv[8];
#pragma unroll
        for (int h2 = 0; h2 < 2; ++h2) {
            float4 s = make_float4(0.f, 0.f, 0.f, 0.f);
#pragma unroll
            for (int w = 0; w < 4; ++w) {
                const float4 v = *(const float4*)(PS + (w * 16 + r) * 132 + jb + h2 * 4);
                s.x += v.x; s.y += v.y; s.z += v.z; s.w += v.w;
            }
            hv[h2 * 4 + 0] = s.x; hv[h2 * 4 + 1] = s.y; hv[h2 * 4 + 2] = s.z; hv[h2 * 4 + 3] = s.w;
        }
#pragma unroll
        for (int i = 0; i < 8; ++i) {
            const float v = hv[i];
            const float u = 0.7978845608028654f * (v + 0.044715f * v * v * v);
            hv[i] = 0.5f * v * (1.f + tanhf(u));
        }
        u32x4 w;
        w[0] = pk_bf16(hv[0], hv[1]); w[1] = pk_bf16(hv[2], hv[3]); w[2] = pk_bf16(hv[4], hv[5]); w[3] = pk_bf16(hv[6], hv[7]);
        *(u32x4*)(HS + r * 136 + jb) = w;
    }
    __syncthreads();
    f32x4 o = (f32x4){0.f, 0.f, 0.f, 0.f};
#pragma unroll
    for (int ks = 0; ks < 4; ++ks) {
        const bf16x8 hf = *(const bf16x8*)(HS + fr * 136 + ks * 32 + fq * 8);
        const bf16x8 wf = *(const bf16x8*)(W2T + (size_t)(wid * 16 + fr) * 128 + ks * 32 + fq * 8);
        if (kind == 0) o = __builtin_amdgcn_mfma_f32_16x16x32_bf16(wf, hf, o, 0, 0, 0);
        else o = __builtin_amdgcn_mfma_f32_16x16x32_bf16(hf, wf, o, 0, 0, 0);
    }
    if (kind == 0) {
        const int n = n0 + fr, e = wid * 16 + fq * 4;
        uint2 u2;
        u2.x = pk_bf16(o[0], o[1]);
        u2.y = pk_bf16(o[2], o[3]);
        if (n == 127) u2 = make_uint2(0u, 0u);
        *(uint2*)((bf16_t*)(p.ws + WS_KCB) + ((size_t)(b * 2 + g) * 128 + n) * 64 + e) = u2;
    } else {
        const int e = wid * 16 + fr, n = n0 + fq * 4;
        const float o3 = (n + 3 == 127) ? 0.f : o[3];
        uint2 u2;
        u2.x = pk_bf16(o[0], o[1]);
        u2.y = pk_bf16(o[2], o3);
        *(uint2*)((bf16_t*)(p.ws + WS_VCT) + ((size_t)(b * 2 + g) * 64 + e) * 128 + n) = u2;
    }
    __syncthreads();
}

constexpr int NSA_IMP = 32768;
constexpr int NSA_SCORE = 49152;
constexpr int NSA_SELM = NSA_SCORE + 4224;

struct NsaTileRegs { u32x4 k[2], v[2]; };
DEV void nsa_load_tile(NsaTileRegs& r, const bf16_t* kbase, size_t kstride, const bf16_t* vbase, size_t vstride, int tid) {
    const int lc = tid & 7, lr = tid >> 3;
#pragma unroll
    for (int i = 0; i < 2; ++i) {
        r.k[i] = *(const u32x4*)(kbase + (size_t)(lr + 32 * i) * kstride + lc * 8);
        r.v[i] = *(const u32x4*)(vbase + (size_t)(lr + 32 * i) * vstride + lc * 8);
    }
}
DEV void nsa_store_tile(const NsaTileRegs& r, unsigned char* stage, int tid) {
    const int lc = tid & 7, lr = tid >> 3;
    const int woff = lr * 128 + ((lc ^ ((lr >> 1) & 7)) << 4);
#pragma unroll
    for (int i = 0; i < 2; ++i) {
        *(u32x4*)(stage + woff + i * 4096) = r.k[i];
        *(u32x4*)(stage + 8192 + woff + i * 4096) = r.v[i];
    }
}
DEV void nsa_dma_tile(const bf16_t* kbase, size_t kstride, const bf16_t* vbase, size_t vstride, unsigned char* stage, int lane, int wid) {
#pragma unroll
    for (int i = 0; i < 2; ++i) {
        const int pc = wid * 2 + i;
        const int r = pc * 8 + (lane >> 3);
        const int c = (lane & 7) ^ ((r >> 1) & 7);
        __builtin_amdgcn_global_load_lds((const unsigned*)(kbase + (size_t)r * kstride + c * 8), (unsigned*)(stage + pc * 1024), 16, 0, 0);
        __builtin_amdgcn_global_load_lds((const unsigned*)(vbase + (size_t)r * vstride + c * 8), (unsigned*)(stage + 8192 + pc * 1024), 16, 0, 0);
    }
}
DEV void nsa_scores(const unsigned char* stage, const bf16x8 (&qf)[2][2], f32x4 (&sc)[4][2], int fr, int fq) {
    const int sw = (fr >> 1) & 7;
    const int c0 = (fq ^ sw) << 4;
    const unsigned char* rowp = stage + fr * 128;
    const unsigned char* p0 = rowp + c0;
    const unsigned char* p1 = rowp + (c0 ^ 64);
#pragma unroll
    for (int kt = 0; kt < 4; ++kt) {
        const bf16x8 k0 = *(const bf16x8*)(p0 + kt * 2048);
        const bf16x8 k1 = *(const bf16x8*)(p1 + kt * 2048);
#pragma unroll
        for (int qt = 0; qt < 2; ++qt) {
            f32x4 a = (f32x4){0.f, 0.f, 0.f, 0.f};
            a = __builtin_amdgcn_mfma_f32_16x16x32_bf16(k0, qf[qt][0], a, 0, 0, 0);
            a = __builtin_amdgcn_mfma_f32_16x16x32_bf16(k1, qf[qt][1], a, 0, 0, 0);
            sc[kt][qt] = a;
        }
    }
}
DEV void nsa_pv(const unsigned char* stage, const f32x4 (&sc)[4][2], f32x4 (&o)[4][2], int fr, int fq) {
    const int sw = (fr >> 1) & 7;
    const int v0 = (((fq >> 1) ^ sw) << 4) + 8 * (fq & 1);
    const unsigned char* rowp = stage + 8192 + fr * 128;
#pragma unroll
    for (int s = 0; s < 2; ++s) {
        u32x4 pf[2];
#pragma unroll
        for (int qt = 0; qt < 2; ++qt) {
            pf[qt][0] = pk_bf16(sc[2 * s][qt][0], sc[2 * s][qt][1]);
            pf[qt][1] = pk_bf16(sc[2 * s][qt][2], sc[2 * s][qt][3]);
            pf[qt][2] = pk_bf16(sc[2 * s + 1][qt][0], sc[2 * s + 1][qt][1]);
            pf[qt][3] = pk_bf16(sc[2 * s + 1][qt][2], sc[2 * s + 1][qt][3]);
        }
        const unsigned char* plo = rowp + (v0 ^ (64 * s));
        const unsigned char* phi = rowp + (v0 ^ (64 * s) ^ 32);
#pragma unroll
        for (int dt = 0; dt < 4; ++dt) {
            const uint2 lo = *(const uint2*)(plo + dt * 2048);
            const uint2 hi = *(const uint2*)(phi + dt * 2048);
            u32x4 vv;
            vv[0] = lo.x; vv[1] = lo.y; vv[2] = hi.x; vv[3] = hi.y;
            const bf16x8 vf = __builtin_bit_cast(bf16x8, vv);
#pragma unroll
            for (int qt = 0; qt < 2; ++qt)
                o[dt][qt] = __builtin_amdgcn_mfma_f32_16x16x32_bf16(vf, __builtin_bit_cast(bf16x8, pf[qt]), o[dt][qt], 0, 0, 0);
        }
    }
}
DEV float xmax4(float v) { v = fmaxf(v, __shfl_xor(v, 16)); return fmaxf(v, __shfl_xor(v, 32)); }
DEV float xsum4(float v) { v += __shfl_xor(v, 16); return v + __shfl_xor(v, 32); }

DEV void nsa_branch(const int mode, const int BR, const int q0v, const unsigned char* wsb, unsigned char* lds, int b, int g, unsigned blocks, const bf16x8 (&qf)[2][2], const int (&qpos)[2],
                    const unsigned (&selm)[2], const float (&gate)[2], f32x4 (&fin)[4][2], int tid) {
    asm volatile("" : "+v"(tid));
    const int fr = tid & 15, fq = (tid >> 4) & 3;
    const bf16_t* HB = (const bf16_t*)(wsb + WS_HB);
    const bf16_t* VT = (const bf16_t*)(wsb + WS_VT);
    const bf16_t* kb0 = HB + (size_t)(b * S_) * INC + (BR == 0 ? C_KS : C_KW) + g * 64;
    const bf16_t* vb0 = VT + ((((size_t)BR * B_ + b) * 2 + g) * 64) * 2048;
    const bool fake = mode == 1;
    float m[2] = {-1e30f, -1e30f}, l[2] = {0.f, 0.f};
    f32x4 o[4][2];
#pragma unroll
    for (int dt = 0; dt < 4; ++dt)
#pragma unroll
        for (int qt = 0; qt < 2; ++qt) o[dt][qt] = (f32x4){0.f, 0.f, 0.f, 0.f};
    const int lane64 = tid & 63, widx = __builtin_amdgcn_readfirstlane(tid >> 6);
    int kb = __builtin_ctz(blocks);
    blocks &= blocks - 1;
    int kb1 = blocks ? __builtin_ctz(blocks) : -1;
    if (kb1 >= 0) blocks &= blocks - 1;
    nsa_dma_tile(kb0 + (size_t)(fake ? 0 : kb) * 64 * INC, INC, vb0 + (fake ? 0 : kb) * 64, 2048, lds, lane64, widx);
    if (kb1 >= 0) nsa_dma_tile(kb0 + (size_t)(fake ? 0 : kb1) * 64 * INC, INC, vb0 + (fake ? 0 : kb1) * 64, 2048, lds + 16384, lane64, widx);
    int slot = 0;
    while (true) {
        if (kb1 >= 0) asm volatile("s_waitcnt vmcnt(4)\n\ts_waitcnt lgkmcnt(0)" ::: "memory");
        else asm volatile("s_waitcnt vmcnt(0)\n\ts_waitcnt lgkmcnt(0)" ::: "memory");
        __builtin_amdgcn_s_barrier(); asm volatile("" ::: "memory");
        const int kb2 = blocks ? __builtin_ctz(blocks) : -1;
        if (kb2 >= 0) {
            blocks &= blocks - 1;
            const int s2 = slot >= 1 ? slot - 1 : 2;
            nsa_dma_tile(kb0 + (size_t)(fake ? 0 : kb2) * 64 * INC, INC, vb0 + (fake ? 0 : kb2) * 64, 2048, lds + s2 * 16384, lane64, widx);
        }
        const unsigned char* stage = lds + slot * 16384;
        f32x4 sc[4][2];
        nsa_scores(stage, qf, sc, fr, fq);
        constexpr float C1 = 0.125f * 1.4426950408889634f;
        const bool need_mask = (BR == 0) ? (kb == (q0v >> 6)) : !((kb * 64 + 63 <= q0v) && (kb * 64 + 511 >= q0v + 31));
        float alpha[2];
        if (!need_mask) {
#pragma unroll
            for (int qt = 0; qt < 2; ++qt) {
                const bool sel = BR == 0 ? ((selm[qt] >> kb) & 1u) != 0u : true;
                float bm = -1e30f;
#pragma unroll
                for (int kt = 0; kt < 4; ++kt)
#pragma unroll
                    for (int i = 0; i < 4; ++i) {
                        const float s = sel ? sc[kt][qt][i] * C1 : -1e30f;
                        sc[kt][qt][i] = s;
                        bm = fmaxf(bm, s);
                    }
                bm = xmax4(bm);
                const float mn = fmaxf(m[qt], bm);
                alpha[qt] = __builtin_amdgcn_exp2f(m[qt] - mn);
                float ps = 0.f;
#pragma unroll
                for (int kt = 0; kt < 4; ++kt)
#pragma unroll
                    for (int i = 0; i < 4; ++i) {
                        const float s = sc[kt][qt][i];
                        const float e = (s > -1e29f) ? __builtin_amdgcn_exp2f(s - mn) : 0.f;
                        sc[kt][qt][i] = e;
                        ps += e;
                    }
                l[qt] = l[qt] * alpha[qt] + ps;
                m[qt] = mn;
            }
        } else {
#pragma unroll
            for (int qt = 0; qt < 2; ++qt) {
                const bool sel = BR == 0 ? ((selm[qt] >> kb) & 1u) != 0u : true;
                float bm = -1e30f;
#pragma unroll
                for (int kt = 0; kt < 4; ++kt)
#pragma unroll
                    for (int i = 0; i < 4; ++i) {
                        const int key = kb * 64 + kt * 16 + fq * 4 + i;
                        bool valid = sel && (key <= qpos[qt]);
                        if (BR == 1) valid = valid && (key + 511 >= qpos[qt]);
                        const float s = valid ? sc[kt][qt][i] * C1 : -1e30f;
                        sc[kt][qt][i] = s;
                        bm = fmaxf(bm, s);
                    }
                bm = xmax4(bm);
                const float mn = fmaxf(m[qt], bm);
                alpha[qt] = __builtin_amdgcn_exp2f(m[qt] - mn);
                float ps = 0.f;
#pragma unroll
                for (int kt = 0; kt < 4; ++kt)
#pragma unroll
                    for (int i = 0; i < 4; ++i) {
                        const float s = sc[kt][qt][i];
                        const float e = (s > -1e29f) ? __builtin_amdgcn_exp2f(s - mn) : 0.f;
                        sc[kt][qt][i] = e;
                        ps += e;
                    }
                l[qt] = l[qt] * alpha[qt] + ps;
                m[qt] = mn;
            }
        }
        {
#pragma unroll
            for (int qt = 0; qt < 2; ++qt)
#pragma unroll
                for (int dt = 0; dt < 4; ++dt) o[dt][qt] *= alpha[qt];
        }
        if (mode != 3) nsa_pv(stage, sc, o, fr, fq);
        else { asm volatile("" :: "v"(sc[0][0][0]), "v"(sc[1][1][1]), "v"(sc[2][0][2]), "v"(sc[3][1][3])); }
        if (kb1 < 0) break;
        kb = kb1;
        kb1 = kb2;
        slot = slot == 2 ? 0 : slot + 1;
    }
#pragma unroll
    for (int qt = 0; qt < 2; ++qt) {
        const float lt = xsum4(l[qt]);
        const float sc2 = lt > 0.f ? gate[qt] / lt : 0.f;
#pragma unroll
        for (int dt = 0; dt < 4; ++dt) fin[dt][qt] += o[dt][qt] * sc2;
    }
    asm volatile("s_waitcnt lgkmcnt(0)" ::: "memory");
    __builtin_amdgcn_s_barrier(); asm volatile("" ::: "memory");
}

DEV void nsa_item2(const P& p, int b, int g, int qblk, unsigned char* lds, int fake = 0) {
    int tid = threadIdx.x;
    asm volatile("" : "+v"(tid));
    const int lane = tid & 63, wid = tid >> 6, fr = lane & 15, fq = lane >> 4;
    const int q0 = qblk * 32, cur = q0 >> 6, h = g * 4 + wid;
    unsigned char* wsb = p.ws;
    asm volatile("" : "+s"(wsb));
    const bf16_t* HB = (const bf16_t*)(wsb + WS_HB);
    float* IMPW = (float*)(lds + NSA_IMP);
    float* SCORE = (float*)(lds + NSA_SCORE);
    unsigned* SELM = (unsigned*)(lds + NSA_SELM);
    bf16x8 qf[2][2];
    int qpos[2];
#pragma unroll
    for (int qt = 0; qt < 2; ++qt) {
        qpos[qt] = q0 + qt * 16 + fr;
        const bf16_t* rowp = HB + (size_t)(b * S_ + qpos[qt]) * INC;
#pragma unroll
        for (int ks = 0; ks < 2; ++ks) qf[qt][ks] = *(const bf16x8*)(rowp + C_QA + h * 64 + ks * 32 + fq * 8);
    }
    if (tid < 33) SELM[tid] = 0u;
    f32x4 fin[4][2];
#pragma unroll
    for (int dt = 0; dt < 4; ++dt)
#pragma unroll
        for (int qt = 0; qt < 2; ++qt) fin[dt][qt] = (f32x4){0.f, 0.f, 0.f, 0.f};
    {
        const bf16_t* KCB = (const bf16_t*)(wsb + WS_KCB) + (size_t)(b * 2 + g) * 128 * 64;
        const bf16_t* VCT = (const bf16_t*)(wsb + WS_VCT) + (size_t)(b * 2 + g) * 64 * 128;
        {
            const int widx = __builtin_amdgcn_readfirstlane(wid);
            nsa_dma_tile(KCB, 64, VCT, 128, lds, lane, widx);
            nsa_dma_tile(KCB + 64 * 64, 64, VCT + 64, 128, lds + 16384, lane, widx);
            asm volatile("s_waitcnt vmcnt(0)" ::: "memory");
        }
        __syncthreads();
        int nv[2];
        float mx[2] = {-1e30f, -1e30f}, inv[2];
#pragma unroll
        for (int qt = 0; qt < 2; ++qt) nv[qt] = qpos[qt] >= 31 ? (((qpos[qt] - 31) >> 4) + 1) : 0;
#pragma unroll 1
        for (int kb = 0; kb < 2; ++kb) {
            f32x4 sc[4][2];
            nsa_scores(lds + kb * 16384, qf, sc, fr, fq);
#pragma unroll
            for (int qt = 0; qt < 2; ++qt)
#pragma unroll
                for (int kt = 0; kt < 4; ++kt)
#pragma unroll
                    for (int i = 0; i < 4; ++i) {
                        const int n = kb * 64 + kt * 16 + fq * 4 + i;
                        mx[qt] = fmaxf(mx[qt], (n < nv[qt]) ? sc[kt][qt][i] * 0.125f : -1e30f);
                    }
        }
        float ps[2] = {0.f, 0.f};
#pragma unroll
        for (int qt = 0; qt < 2; ++qt) mx[qt] = xmax4(mx[qt]);
#pragma unroll 1
        for (int kb = 0; kb < 2; ++kb) {
            f32x4 sc[4][2];
            nsa_scores(lds + kb * 16384, qf, sc, fr, fq);
#pragma unroll
            for (int qt = 0; qt < 2; ++qt)
#pragma unroll
                for (int kt = 0; kt < 4; ++kt)
#pragma unroll
                    for (int i = 0; i < 4; ++i) {
                        const int n = kb * 64 + kt * 16 + fq * 4 + i;
                        ps[qt] += (n < nv[qt]) ? __expf(sc[kt][qt][i] * 0.125f - mx[qt]) : 0.f;
                    }
        }
#pragma unroll
        for (int qt = 0; qt < 2; ++qt) {
            ps[qt] = xsum4(ps[qt]);
            inv[qt] = ps[qt] > 0.f ? 1.f / ps[qt] : 0.f;
        }
        float prev3[2] = {0.f, 0.f};
#pragma unroll 1
        for (int kb = 0; kb < 2; ++kb) {
            f32x4 sc[4][2];
            nsa_scores(lds + kb * 16384, qf, sc, fr, fq);
#pragma unroll
            for (int qt = 0; qt < 2; ++qt) {
                float* impw = IMPW + (wid * 32 + qt * 16 + fr) * 32 + kb * 16 + fq;
#pragma unroll
                for (int kt = 0; kt < 4; ++kt) {
                    f32x4 pv;
#pragma unroll
                    for (int i = 0; i < 4; ++i) {
                        const int n = kb * 64 + kt * 16 + fq * 4 + i;
                        pv[i] = (n < nv[qt]) ? __expf(sc[kt][qt][i] * 0.125f - mx[qt]) * inv[qt] : 0.f;
                    }
                    sc[kt][qt] = pv;
                    const float c1 = __shfl_up(pv[3], 16);
                    const float c0 = __shfl(prev3[qt], fr + 48);
                    impw[kt * 4] = pv[0] + pv[1] + pv[2] + pv[3] + (fq > 0 ? c1 : c0);
                    prev3[qt] = pv[3];
                }
            }
            nsa_pv(lds + kb * 16384, sc, fin, fr, fq);
        }
#pragma unroll
        for (int qt = 0; qt < 2; ++qt) {
            const float gc = fsigmoid(bf2f(HB[(size_t)(b * S_ + qpos[qt]) * INC + C_GATE + h * 3 + 0]));
#pragma unroll
            for (int dt = 0; dt < 4; ++dt) fin[dt][qt] *= gc;
        }
    }
    __syncthreads();
    {
        const int q = tid >> 3, jg = tid & 7;
#pragma unroll
        for (int u = 0; u < 4; ++u) {
            const int j = jg * 4 + u;
            const float imp = IMPW[(0 * 32 + q) * 32 + j] + IMPW[(1 * 32 + q) * 32 + j] + IMPW[(2 * 32 + q) * 32 + j] + IMPW[(3 * 32 + q) * 32 + j];
            float score;
            if (j > cur) score = -INFINITY;
            else if (j == 0 || j == cur || j == cur - 1) score = 1e4f;
            else score = imp;
            SCORE[q * 33 + j] = score;
        }
        __syncthreads();
        unsigned bits = 0u;
#pragma unroll
        for (int u = 0; u < 4; ++u) {
            const int j = jg * 4 + u;
            const float sj = SCORE[q * 33 + j];
            int rank = 0;
#pragma unroll 8
            for (int i = 0; i < 32; ++i) {
                const float si = SCORE[q * 33 + i];
                rank += ((si > sj) || (si == sj && i < j)) ? 1 : 0;
            }
            if (j <= cur && rank < 16) bits |= 1u << j;
        }
        atomicOr(&SELM[q], bits);
        atomicOr(&SELM[32], bits);
        __syncthreads();
    }
    unsigned selm[2];
    selm[0] = SELM[fr];
    selm[1] = SELM[16 + fr];
    const unsigned um = SELM[32];
    __syncthreads();
#pragma unroll 1
    for (int br = 0; br < 2; ++br) {
        const int wlo = (q0 - 511) > 0 ? ((q0 - 511) >> 6) : 0;
        const unsigned wmask = ((2u << cur) - 1u) & ~((1u << wlo) - 1u);
        float gs[2];
#pragma unroll
        for (int qt = 0; qt < 2; ++qt) gs[qt] = fsigmoid(bf2f(HB[(size_t)(b * S_ + qpos[qt]) * INC + C_GATE + h * 3 + 1 + br]));
        if (fake != 2) nsa_branch(fake, br, q0, wsb, lds, b, g, br ? wmask : um, qf, qpos, selm, gs, fin, tid);
    }
    bf16_t* OM = (bf16_t*)(wsb + WS_OM);
#pragma unroll
    for (int qt = 0; qt < 2; ++qt)
#pragma unroll
        for (int dt = 0; dt < 4; ++dt) {
            uint2 u2;
            u2.x = pk_bf16(fin[dt][qt][0], fin[dt][qt][1]);
            u2.y = pk_bf16(fin[dt][qt][2], fin[dt][qt][3]);
            *(uint2*)(OM + (size_t)(b * S_ + qpos[qt]) * 1024 + h * 64 + dt * 16 + fq * 4) = u2;
        }
}

DEV void hgrn_prep_item(const P& p, int item, float* smem) {
    const int c = item & 31, bh = item >> 5, hh = bh & 3, b = bh >> 2;
    const int tid = threadIdx.x, d = tid & 127, th = tid >> 7;
    const bf16_t* HB = (const bf16_t*)(p.ws + WS_HB);
    unsigned char* hs = (unsigned char*)p.out;
    bf16_t* QT = (bf16_t*)(hs + HS_QT);
    bf16_t* KT = (bf16_t*)(hs + HS_KT);
    bf16_t* KHT = (bf16_t*)(hs + HS_KHT);
    bf16_t* VIT = (bf16_t*)(hs + HS_VIT);
    float lbv;
    {
        const float l0 = p.lb_logits[hh * 128 + d], l1 = p.lb_logits[512 + hh * 128 + d];
        const float mx = fmaxf(l0, l1);
        const float e0 = expf(l0 - mx), e1 = expf(l1 - mx);
        lbv = e0 / (e0 + e1);
    }
    const size_t trow0 = (size_t)b * S_ + c * 64 + th * 32;
    float kk[32], bl[32];
    float run = 0.f;
#pragma unroll
    for (int i = 0; i < 32; ++i) {
        const float fl = bf2f(HB[(trow0 + i) * INC + C_HF + hh * 128 + d]);
        const float f = lbv + (1.f - lbv) * fsigmoid(fl);
        kk[i] = 1.f - f;
        run += __logf(f);
        bl[i] = run;
    }
    smem[th * 128 + d] = run;
    __syncthreads();
    const float off = th ? smem[d] : 0.f;
    const float blast = smem[d] + smem[128 + d];
    unsigned kh[16], vi[16];
#pragma unroll
    for (int i = 0; i < 32; i += 2) {
        float qv[2], kt[2], khv[2], vv[2];
#pragma unroll
        for (int u = 0; u < 2; ++u) {
            const float bb = bl[i + u] + off;
            const size_t tr = trow0 + i + u;
            const float q = bf2f(HB[tr * INC + C_HQ + hh * 128 + d]);
            vv[u] = bf2f(HB[tr * INC + C_HI + hh * 128 + d]);
            qv[u] = q * __expf(bb);
            kt[u] = kk[i + u] * __expf(fminf(-bb, 80.f));
            khv[u] = kk[i + u] * __expf(blast - bb);
            const size_t o = ((size_t)bh * 2048 + c * 64 + th * 32 + i + u) * 128 + d;
            QT[o] = f2bf(qv[u]);
            KT[o] = f2bf(kt[u]);
        }
        kh[i >> 1] = pk_bf16(khv[0], khv[1]);
        vi[i >> 1] = pk_bf16(vv[0], vv[1]);
    }
    {
        const size_t o = ((size_t)bh * 128 + d) * 2048 + c * 64 + th * 32;
#pragma unroll
        for (int j = 0; j < 4; ++j) {
            u32x4 a, bq;
            a[0] = kh[4 * j]; a[1] = kh[4 * j + 1]; a[2] = kh[4 * j + 2]; a[3] = kh[4 * j + 3];
            bq[0] = vi[4 * j]; bq[1] = vi[4 * j + 1]; bq[2] = vi[4 * j + 2]; bq[3] = vi[4 * j + 3];
            *(u32x4*)(KHT + o + j * 8) = a;
            *(u32x4*)(VIT + o + j * 8) = bq;
        }
    }
    if (th == 0) ((float*)(p.ws + WS_EB))[((size_t)bh * 32 + c) * 128 + d] = expf(blast);
    __syncthreads();
}

DEV bf16x8 ld2x8(const bf16_t* p0, const bf16_t* p1) {
    const uint2 lo = *(const uint2*)p0, hi = *(const uint2*)p1;
    u32x4 v;
    v[0] = lo.x; v[1] = lo.y; v[2] = hi.x; v[3] = hi.y;
    return __builtin_bit_cast(bf16x8, v);
}
struct HgRegs { u32x4 a[4], b[4]; };
DEV void hg_loadA(HgRegs& r, const bf16_t* KT, const bf16_t* QT, int s0, int tid) {
    const unsigned off = (unsigned)(((tid >> 4) * 128 + (tid & 15) * 8) * 2);
    const char* kb = (const char*)(KT + (size_t)s0 * 128);
    const char* qb = (const char*)(QT + (size_t)s0 * 128);
#pragma unroll
    for (int i = 0; i < 4; ++i) {
        r.a[i] = *(const u32x4*)(kb + i * 4096 + off);
        r.b[i] = *(const u32x4*)(qb + i * 4096 + off);
    }
}
DEV void hg_storeA(const HgRegs& r, unsigned char* lds, int tid) {
    const int c16 = tid & 15, r16 = tid >> 4;
    const int o16 = r16 * 256 + ((c16 ^ (r16 & 15)) << 4);
#pragma unroll
    for (int i = 0; i < 4; ++i) {
        *(u32x4*)(lds + o16 + i * 4096) = r.a[i];
        *(u32x4*)(lds + 16384 + o16 + i * 4096) = r.b[i];
    }
}
DEV void hg_loadB(HgRegs& r, const bf16_t* KHT, const bf16_t* VIT, int s0, int tid) {
    const unsigned off = (unsigned)(((tid >> 3) * 2048 + (tid & 7) * 8) * 2);
    const char* kb = (const char*)(KHT + s0);
    const char* vb = (const char*)(VIT + s0);
#pragma unroll
    for (int i = 0; i < 4; ++i) {
        r.a[i] = *(const u32x4*)(kb + (size_t)i * 131072 + off);
        r.b[i] = *(const u32x4*)(vb + (size_t)i * 131072 + off);
    }
}
DEV void hg_storeB(const HgRegs& r, unsigned char* lds, int tid) {
    const int c8 = tid & 7, r8 = tid >> 3;
    const int o8 = r8 * 128 + ((c8 ^ ((r8 >> 1) & 7)) << 4);
#pragma unroll
    for (int i = 0; i < 4; ++i) {
        *(u32x4*)(lds + 32768 + o8 + i * 4096) = r.a[i];
        *(u32x4*)(lds + 49152 + o8 + i * 4096) = r.b[i];
    }
}
DEV void hgrn_chain_item(const P& p, int bh, unsigned char* lds) {
    const int hh = bh & 3, b = bh >> 2;
    int tid = threadIdx.x;
    asm volatile("" : "+v"(tid));
    const int lane = tid & 63, wid = tid >> 6, fr = lane & 15, fq = lane >> 4;
    const unsigned char* hs = (const unsigned char*)p.out;
    const bf16_t* QT = (const bf16_t*)(hs + HS_QT) + (size_t)bh * 2048 * 128;
    const bf16_t* KT = (const bf16_t*)(hs + HS_KT) + (size_t)bh * 2048 * 128;
    const bf16_t* KHT = (const bf16_t*)(hs + HS_KHT) + (size_t)bh * 128 * 2048;
    const bf16_t* VIT = (const bf16_t*)(hs + HS_VIT) + (size_t)bh * 128 * 2048;
    const float* EB = (const float*)(p.ws + WS_EB) + (size_t)bh * 32 * 128;
    const bf16_t* HB = (const bf16_t*)(p.ws + WS_HB);
    bf16_t* OM = (bf16_t*)(p.ws + WS_OM);
    const unsigned char* sKT = lds;
    const unsigned char* sQT = lds + 16384;
    const unsigned char* sKH = lds + 32768;
    const unsigned char* sVI = lds + 49152;
    bf16_t* AT = (bf16_t*)lds;
    float* SS = (float*)(lds + 65536);
    f32x4 S[8][2];
#pragma unroll
    for (int i = 0; i < 8; ++i)
#pragma unroll
        for (int j = 0; j < 2; ++j) S[i][j] = (f32x4){0.f, 0.f, 0.f, 0.f};
    const int dv0 = wid * 32;
    const int sw8 = (fr >> 1) & 7;
    int b256[4];
#pragma unroll
    for (int ks = 0; ks < 4; ++ks) b256[ks] = fr * 256 + (((4 * ks + fq) ^ fr) << 4);
    int p256[4][2];
#pragma unroll
    for (int u = 0; u < 4; ++u)
#pragma unroll
        for (int h = 0; h < 2; ++h) p256[u][h] = fr * 256 + (((4 * u + 2 * h + (fq >> 1)) ^ fr) << 4) + 8 * (fq & 1);
    int b128[2];
#pragma unroll
    for (int ks = 0; ks < 2; ++ks) b128[ks] = fr * 128 + (((4 * ks + fq) ^ sw8) << 4);
    {
        HgRegs r;
        hg_loadA(r, KT, QT, 0, tid);
        hg_storeA(r, lds, tid);
        hg_loadB(r, KHT, VIT, 0, tid);
        hg_storeB(r, lds, tid);
    }
    __syncthreads();
#pragma unroll 1
    for (int c = 0; c < 32; ++c) {
        const int s0 = c * 64;
        HgRegs nx;
        if (c + 1 < 32) hg_loadA(nx, KT, QT, s0 + 64, tid);
        uint2 atp[4];
        {
            bf16x8 qf[4];
#pragma unroll
            for (int ks = 0; ks < 4; ++ks) qf[ks] = *(const bf16x8*)(sQT + wid * 4096 + b256[ks]);
#pragma unroll
            for (int st = 0; st < 4; ++st) {
                f32x4 a = (f32x4){0.f, 0.f, 0.f, 0.f};
#pragma unroll
                for (int ks = 0; ks < 4; ++ks) {
                    const bf16x8 kf = *(const bf16x8*)(sKT + st * 4096 + b256[ks]);
                    a = __builtin_amdgcn_mfma_f32_16x16x32_bf16(kf, qf[ks], a, 0, 0, 0);
                }
                const int t = wid * 16 + fr;
                float av[4];
#pragma unroll
                for (int i = 0; i < 4; ++i) av[i] = (st * 16 + fq * 4 + i <= t) ? a[i] : 0.f;
                atp[st].x = pk_bf16(av[0], av[1]);
                atp[st].y = pk_bf16(av[2], av[3]);
            }
        }
        __syncthreads();
#pragma unroll
        for (int st = 0; st < 4; ++st) *(uint2*)(AT + (wid * 16 + fr) * 72 + st * 16 + fq * 4) = atp[st];
        __syncthreads();
        f32x4 o[2][4];
#pragma unroll
        for (int i = 0; i < 2; ++i)
#pragma unroll
            for (int j = 0; j < 4; ++j) o[i][j] = (f32x4){0.f, 0.f, 0.f, 0.f};
        bf16x8 vf[2][2];
#pragma unroll
        for (int dvt = 0; dvt < 2; ++dvt)
#pragma unroll
            for (int ks = 0; ks < 2; ++ks) vf[dvt][ks] = *(const bf16x8*)(sVI + wid * 4096 + dvt * 2048 + b128[ks]);
#pragma unroll
        for (int ks = 0; ks < 2; ++ks)
#pragma unroll
            for (int tt = 0; tt < 4; ++tt) {
                const bf16x8 af = *(const bf16x8*)(AT + (tt * 16 + fr) * 72 + ks * 32 + fq * 8);
#pragma unroll
                for (int dvt = 0; dvt < 2; ++dvt) o[dvt][tt] = __builtin_amdgcn_mfma_f32_16x16x32_bf16(vf[dvt][ks], af, o[dvt][tt], 0, 0, 0);
            }
#pragma unroll
        for (int u = 0; u < 4; ++u) {
            bf16x8 sf[2];
#pragma unroll
            for (int dvt = 0; dvt < 2; ++dvt) {
                u32x4 w;
                w[0] = pk_bf16(S[2 * u][dvt][0], S[2 * u][dvt][1]);
                w[1] = pk_bf16(S[2 * u][dvt][2], S[2 * u][dvt][3]);
                w[2] = pk_bf16(S[2 * u + 1][dvt][0], S[2 * u + 1][dvt][1]);
                w[3] = pk_bf16(S[2 * u + 1][dvt][2], S[2 * u + 1][dvt][3]);
                sf[dvt] = __builtin_bit_cast(bf16x8, w);
            }
#pragma unroll
            for (int tt = 0; tt < 4; ++tt) {
                const uint2 lo = *(const uint2*)(sQT + tt * 4096 + p256[u][0]);
                const uint2 hi = *(const uint2*)(sQT + tt * 4096 + p256[u][1]);
                u32x4 w;
                w[0] = lo.x; w[1] = lo.y; w[2] = hi.x; w[3] = hi.y;
                const bf16x8 qf2 = __builtin_bit_cast(bf16x8, w);
#pragma unroll
                for (int dvt = 0; dvt < 2; ++dvt) o[dvt][tt] = __builtin_amdgcn_mfma_f32_16x16x32_bf16(sf[dvt], qf2, o[dvt][tt], 0, 0, 0);
            }
        }
        u32x4 op[4];
#pragma unroll
        for (int tt = 0; tt < 4; ++tt) {
            float ss = 0.f;
#pragma unroll
            for (int dvt = 0; dvt < 2; ++dvt)
#pragma unroll
                for (int i = 0; i < 4; ++i) ss += o[dvt][tt][i] * o[dvt][tt][i];
            ss = xsum4(ss);
            if (fq == 0) SS[wid * 64 + tt * 16 + fr] = ss;
            op[tt][0] = pk_bf16(o[0][tt][0], o[0][tt][1]);
            op[tt][1] = pk_bf16(o[0][tt][2], o[0][tt][3]);
            op[tt][2] = pk_bf16(o[1][tt][0], o[1][tt][1]);
            op[tt][3] = pk_bf16(o[1][tt][2], o[1][tt][3]);
        }
        __syncthreads();
        if (c + 1 < 32) { hg_storeA(nx, lds, tid); hg_loadB(nx, KHT, VIT, s0 + 64, tid); }
        uint2 gg[4][2];
#pragma unroll
        for (int tt = 0; tt < 4; ++tt)
#pragma unroll
            for (int dvt = 0; dvt < 2; ++dvt)
                gg[tt][dvt] = *(const uint2*)(HB + ((size_t)b * S_ + s0 + tt * 16 + fr) * INC + C_HG + hh * 128 + dv0 + dvt * 16 + fq * 4);
        {
            bf16x8 vf3[2][2];
#pragma unroll
            for (int dvt = 0; dvt < 2; ++dvt)
#pragma unroll
                for (int ks = 0; ks < 2; ++ks) vf3[dvt][ks] = *(const bf16x8*)(sVI + wid * 4096 + dvt * 2048 + b128[ks]);
#pragma unroll
            for (int dkt = 0; dkt < 8; ++dkt) {
                const float4 eb = *(const float4*)(EB + c * 128 + dkt * 16 + fq * 4);
                bf16x8 kf[2];
#pragma unroll
                for (int ks = 0; ks < 2; ++ks) kf[ks] = *(const bf16x8*)(sKH + dkt * 2048 + b128[ks]);
#pragma unroll
                for (int dvt = 0; dvt < 2; ++dvt) {
                    f32x4 a = S[dkt][dvt];
                    a[0] *= eb.x; a[1] *= eb.y; a[2] *= eb.z; a[3] *= eb.w;
                    a = __builtin_amdgcn_mfma_f32_16x16x32_bf16(kf[0], vf3[dvt][0], a, 0, 0, 0);
                    a = __builtin_amdgcn_mfma_f32_16x16x32_bf16(kf[1], vf3[dvt][1], a, 0, 0, 0);
                    S[dkt][dvt] = a;
                }
            }
        }
        __syncthreads();
        if (c + 1 < 32) hg_storeB(nx, lds, tid);
#pragma unroll
        for (int tt = 0; tt < 4; ++tt) {
            const int t = tt * 16 + fr;
            const float tot = SS[t] + SS[64 + t] + SS[128 + t] + SS[192 + t];
            const float rs = rsqrtf(tot * (1.f / 128.f) + LN_EPS);
            const size_t tg = (size_t)b * S_ + s0 + t;
#pragma unroll
            for (int dvt = 0; dvt < 2; ++dvt) {
                const int dv = dv0 + dvt * 16 + fq * 4;
                const float g0 = bflo(gg[tt][dvt].x), g1 = bfhi(gg[tt][dvt].x), g2 = bflo(gg[tt][dvt].y), g3 = bfhi(gg[tt][dvt].y);
                const float4 nwv = *(const float4*)(p.hg_norm_w + hh * 128 + dv);
                const unsigned w0 = op[tt][2 * dvt], w1 = op[tt][2 * dvt + 1];
                const float r0 = bflo(w0) * rs * nwv.x * (g0 * fsigmoid(g0));
                const float r1 = bfhi(w0) * rs * nwv.y * (g1 * fsigmoid(g1));
                const float r2 = bflo(w1) * rs * nwv.z * (g2 * fsigmoid(g2));
                const float r3 = bfhi(w1) * rs * nwv.w * (g3 * fsigmoid(g3));
                uint2 u2;
                u2.x = pk_bf16(r0, r1);
                u2.y = pk_bf16(r2, r3);
                *(uint2*)(OM + tg * 1024 + 512 + hh * 128 + dv) = u2;
            }
        }
        __syncthreads();
    }
}


DEV void hgrn_prep_item2(const P& p, int item, unsigned char* lds) {
    const int c = item & 31, bh = item >> 5, hh = bh & 3, b = bh >> 2;
    int tid = threadIdx.x;
    asm volatile("" : "+v"(tid));
    const int d = tid & 127, th = tid >> 7;
    const int lane = tid & 63, wid = tid >> 6, fr = lane & 15, fq = lane >> 4;
    const bf16_t* HB = (const bf16_t*)(p.ws + WS_HB);
    unsigned char* hs = (unsigned char*)p.out;
    bf16_t* QTg = (bf16_t*)(hs + HS_QT);
    bf16_t* OIg = (bf16_t*)(hs + HS_OI);
    uint2* DSg = (uint2*)(hs + HS_DS);
    float* tots = (float*)(lds + 65536);
    unsigned char* sKT = lds;
    unsigned char* sQT = lds + 16384;
    unsigned char* sKH = lds + 32768;
    unsigned char* sVI = lds + 49152;
    float lbv;
    {
        const float l0 = p.lb_logits[hh * 128 + d], l1 = p.lb_logits[512 + hh * 128 + d];
        const float mx = fmaxf(l0, l1);
        const float e0 = expf(l0 - mx), e1 = expf(l1 - mx);
        lbv = e0 / (e0 + e1);
    }
    const size_t trow0 = (size_t)b * S_ + c * 64 + th * 32;
    const float nwd = p.hg_norm_w[hh * 128 + d];
    float bl[32];
    float run = 0.f;
    {
        unsigned fraw[32];
#pragma unroll
        for (int i = 0; i < 32; ++i) fraw[i] = HB[(trow0 + i) * INC + C_HF + hh * 128 + d];
#pragma unroll
        for (int h = 0; h < 2; ++h)
            asm volatile("" : "+v"(fraw[16 * h + 0]), "+v"(fraw[16 * h + 1]), "+v"(fraw[16 * h + 2]), "+v"(fraw[16 * h + 3]), "+v"(fraw[16 * h + 4]),
                         "+v"(fraw[16 * h + 5]), "+v"(fraw[16 * h + 6]), "+v"(fraw[16 * h + 7]), "+v"(fraw[16 * h + 8]), "+v"(fraw[16 * h + 9]),
                         "+v"(fraw[16 * h + 10]), "+v"(fraw[16 * h + 11]), "+v"(fraw[16 * h + 12]), "+v"(fraw[16 * h + 13]), "+v"(fraw[16 * h + 14]),
                         "+v"(fraw[16 * h + 15]));
#pragma unroll
        for (int i = 0; i < 32; ++i) {
            const float f = lbv + (1.f - lbv) * fsigmoid(bf2f((bf16_t)fraw[i]));
            run += __builtin_amdgcn_logf(f) * 0.6931471805599453f;
            bl[i] = run;
        }
    }
    tots[th * 128 + d] = run;
    __syncthreads();
    const float off = th ? tots[d] : 0.f;
    const float blast = tots[d] + tots[128 + d];
#pragma unroll
    for (int j = 0; j < 4; ++j) {
        u32x4 a, bq;
        unsigned qraw[8], vraw[8], graw[8];
#pragma unroll
        for (int e = 0; e < 8; ++e) {
            const size_t tr = trow0 + j * 8 + e;
            qraw[e] = HB[tr * INC + C_HQ + hh * 128 + d];
            vraw[e] = HB[tr * INC + C_HI + hh * 128 + d];
            graw[e] = HB[tr * INC + C_HG + hh * 128 + d];
        }
        asm volatile("" : "+v"(qraw[0]), "+v"(qraw[1]), "+v"(qraw[2]), "+v"(qraw[3]), "+v"(qraw[4]), "+v"(qraw[5]), "+v"(qraw[6]), "+v"(qraw[7]),
                     "+v"(vraw[0]), "+v"(vraw[1]), "+v"(vraw[2]), "+v"(vraw[3]), "+v"(vraw[4]), "+v"(vraw[5]), "+v"(vraw[6]), "+v"(vraw[7]));
        asm volatile("" : "+v"(graw[0]), "+v"(graw[1]), "+v"(graw[2]), "+v"(graw[3]), "+v"(graw[4]), "+v"(graw[5]), "+v"(graw[6]), "+v"(graw[7]));
#pragma unroll
        for (int i2 = 0; i2 < 4; ++i2) {
            float khv[2], vv[2];
#pragma unroll
            for (int u = 0; u < 2; ++u) {
                const int i = j * 8 + i2 * 2 + u;
                const float bb = bl[i] + off;
                const float kki = 1.f - __expf(bl[i] - (i ? bl[i > 0 ? i - 1 : 0] : 0.f));
                const float q = bf2f((bf16_t)qraw[i2 * 2 + u]);
                vv[u] = bf2f((bf16_t)vraw[i2 * 2 + u]);
                const bf16_t qv = f2bf(q * __expf(bb));
                const bf16_t kt = f2bf(kki * __expf(fminf(-bb, 80.f)));
                khv[u] = kki * __expf(blast - bb);
                const int t = th * 32 + i;
                QTg[((size_t)bh * 2048 + c * 64 + t) * 128 + d] = qv;
                {
                    const float gv = bf2f((bf16_t)graw[i2 * 2 + u]);
                    ((bf16_t*)(p.ws + WS_XB))[((size_t)bh * 2048 + c * 64 + t) * 128 + d] = f2bf(nwd * gv * fsigmoid(gv));
                }
                const int off256 = t * 256 + ((((d >> 3) ^ (t & 15))) << 4) + (d & 7) * 2;
                *(bf16_t*)(sQT + off256) = qv;
                *(bf16_t*)(sKT + off256) = kt;
            }
            a[i2] = pk_bf16(khv[0], khv[1]);
            bq[i2] = pk_bf16(vv[0], vv[1]);
        }
        const int off128 = d * 128 + (((th * 4 + j) ^ ((d >> 1) & 7)) << 4);
        *(u32x4*)(sKH + off128) = a;
        *(u32x4*)(sVI + off128) = bq;
    }
    if (th == 0) ((float*)(p.ws + WS_EB))[((size_t)bh * 32 + c) * 128 + d] = __expf(blast);
    __syncthreads();
    const int sw8 = (fr >> 1) & 7;
    int b256[4];
#pragma unroll
    for (int ks = 0; ks < 4; ++ks) b256[ks] = fr * 256 + (((4 * ks + fq) ^ fr) << 4);
    int b128[2];
#pragma unroll
    for (int ks = 0; ks < 2; ++ks) b128[ks] = fr * 128 + (((4 * ks + fq) ^ sw8) << 4);
    uint2 atp[4];
    {
        bf16x8 qf[4];
#pragma unroll
        for (int ks = 0; ks < 4; ++ks) qf[ks] = *(const bf16x8*)(sQT + wid * 4096 + b256[ks]);
#pragma unroll
        for (int st = 0; st < 4; ++st) {
            f32x4 a = (f32x4){0.f, 0.f, 0.f, 0.f};
#pragma unroll
            for (int ks = 0; ks < 4; ++ks) {
                const bf16x8 kf = *(const bf16x8*)(sKT + st * 4096 + b256[ks]);
                a = __builtin_amdgcn_mfma_f32_16x16x32_bf16(kf, qf[ks], a, 0, 0, 0);
            }
            const int t = wid * 16 + fr;
            float av[4];
#pragma unroll
            for (int i = 0; i < 4; ++i) av[i] = (st * 16 + fq * 4 + i <= t) ? a[i] : 0.f;
            atp[st].x = pk_bf16(av[0], av[1]);
            atp[st].y = pk_bf16(av[2], av[3]);
        }
    }
    __syncthreads();
    bf16_t* AT = (bf16_t*)lds;
#pragma unroll
    for (int st = 0; st < 4; ++st) *(uint2*)(AT + (wid * 16 + fr) * 72 + st * 16 + fq * 4) = atp[st];
    __syncthreads();
    const int dv0 = wid * 32;
    bf16x8 vf[2][2];
#pragma unroll
    for (int dvt = 0; dvt < 2; ++dvt)
#pragma unroll
        for (int ks = 0; ks < 2; ++ks) vf[dvt][ks] = *(const bf16x8*)(sVI + wid * 4096 + dvt * 2048 + b128[ks]);
#pragma unroll
    for (int tt = 0; tt < 4; ++tt) {
        f32x4 o0 = (f32x4){0.f, 0.f, 0.f, 0.f}, o1 = (f32x4){0.f, 0.f, 0.f, 0.f};
#pragma unroll
        for (int ks = 0; ks < 2; ++ks) {
            const bf16x8 af = *(const bf16x8*)(AT + (tt * 16 + fr) * 72 + ks * 32 + fq * 8);
            o0 = __builtin_amdgcn_mfma_f32_16x16x32_bf16(vf[0][ks], af, o0, 0, 0, 0);
            o1 = __builtin_amdgcn_mfma_f32_16x16x32_bf16(vf[1][ks], af, o1, 0, 0, 0);
        }
        bf16_t* op = OIg + ((size_t)bh * 2048 + c * 64 + tt * 16 + fr) * 128 + dv0 + fq * 4;
        *(uint2*)op = make_uint2(pk_bf16(o0[0], o0[1]), pk_bf16(o0[2], o0[3]));
        *(uint2*)(op + 16) = make_uint2(pk_bf16(o1[0], o1[1]), pk_bf16(o1[2], o1[3]));
    }
    uint2* dsp = DSg + ((((size_t)bh * 32 + c) * 4 + wid) * 16) * 64 + lane;
#pragma unroll
    for (int dkt = 0; dkt < 8; ++dkt) {
        bf16x8 kf[2];
#pragma unroll
        for (int ks = 0; ks < 2; ++ks) kf[ks] = *(const bf16x8*)(sKH + dkt * 2048 + b128[ks]);
#pragma unroll
        for (int dvt = 0; dvt < 2; ++dvt) {
            f32x4 a = (f32x4){0.f, 0.f, 0.f, 0.f};
            a = __builtin_amdgcn_mfma_f32_16x16x32_bf16(kf[0], vf[dvt][0], a, 0, 0, 0);
            a = __builtin_amdgcn_mfma_f32_16x16x32_bf16(kf[1], vf[dvt][1], a, 0, 0, 0);
            dsp[(dkt * 2 + dvt) * 64] = make_uint2(pk_bf16(a[0], a[1]), pk_bf16(a[2], a[3]));
        }
    }
    __syncthreads();
}

DEV void hgrn_chain_item3(const P& p, int item, unsigned char* lds) {
    const int bh = item >> 1, half = item & 1, hh = bh & 3, b = bh >> 2;
    int tid = threadIdx.x;
    asm volatile("" : "+v"(tid));
    const int lane = tid & 63, wid = __builtin_amdgcn_readfirstlane(tid >> 6), fr = lane & 15, fq = lane >> 4;
    const int gd = half * 4 + wid;
    const unsigned char* hs = (const unsigned char*)p.out;
    const bf16_t* QTg = (const bf16_t*)(hs + HS_QT) + (size_t)bh * 2048 * 128;
    const char* OIb = (const char*)(hs + HS_OI) + ((size_t)bh * 2048 * 128 + gd * 16) * 2;
    const unsigned oioff = (unsigned)((fr * 128 + fq * 4) * 2);
    const char* DSb = (const char*)(hs + HS_DS) + (((size_t)bh * 32 * 4 + (gd >> 1)) * 16 * 64) * 8 + (gd & 1) * 512;
    const unsigned dsoff = (unsigned)(lane * 8);
    const char* GGb = (const char*)(p.ws + WS_XB) + ((size_t)bh * 2048 * 128 + gd * 16) * 2;
    const float* EB = (const float*)(p.ws + WS_EB) + (size_t)bh * 32 * 128;
    float* SSP = (float*)(p.ws + WS_SSP) + ((size_t)bh * 8 + gd) * 2048;
    bf16_t* OM = (bf16_t*)(p.ws + WS_OM);
    int p256[4][2];
#pragma unroll
    for (int u = 0; u < 4; ++u)
#pragma unroll
        for (int h = 0; h < 2; ++h) p256[u][h] = fr * 256 + (((4 * u + 2 * h + (fq >> 1)) ^ fr) << 4) + 8 * (fq & 1);
    const int c16 = tid & 15, r16 = tid >> 4;
    const int o16 = r16 * 256 + ((c16 ^ (r16 & 15)) << 4);
    const unsigned qoff = (unsigned)((r16 * 128 + c16 * 8) * 2);
    f32x4 S[8];
#pragma unroll
    for (int i = 0; i < 8; ++i) S[i] = (f32x4){0.f, 0.f, 0.f, 0.f};
    uint2 oi[4], dsr[8];
    {
        const char* qb = (const char*)QTg;
#pragma unroll
        for (int i = 0; i < 4; ++i) *(u32x4*)(lds + o16 + i * 4096) = *(const u32x4*)(qb + i * 4096 + qoff);
        if (tid < 32) *(u32x4*)(lds + 32768 + tid * 16) = *(const u32x4*)(EB + tid * 4);
#pragma unroll
        for (int tt = 0; tt < 4; ++tt) oi[tt] = *(const uint2*)(OIb + tt * 4096 + oioff);
#pragma unroll
        for (int dkt = 0; dkt < 8; ++dkt) dsr[dkt] = *(const uint2*)(DSb + dkt * 1024 + dsoff);
    }
    __syncthreads();
#pragma unroll 1
    for (int c = 0; c < 32; ++c) {
        const int s0 = c * 64;
        const bool more = c + 1 < 32;
        const unsigned char* sQ = lds + (c & 1) * 16384;
        const float* EBL = (const float*)(lds + 32768 + (c & 1) * 512);
        u32x4 qn[4], ebn;
        if (more) {
            const char* qb = (const char*)(QTg + (size_t)(s0 + 64) * 128);
#pragma unroll
            for (int i = 0; i < 4; ++i) qn[i] = *(const u32x4*)(qb + i * 4096 + qoff);
            if (tid < 32) ebn = *(const u32x4*)(EB + (c + 1) * 128 + tid * 4);
        }
        uint2 gg[4];
#pragma unroll
        for (int tt = 0; tt < 4; ++tt) gg[tt] = *(const uint2*)(GGb + (size_t)s0 * 256 + tt * 4096 + oioff);
        f32x4 o[4];
#pragma unroll
        for (int tt = 0; tt < 4; ++tt) {
            o[tt] = (f32x4){bflo(oi[tt].x), bfhi(oi[tt].x), bflo(oi[tt].y), bfhi(oi[tt].y)};
            if (more) oi[tt] = *(const uint2*)(OIb + (size_t)(s0 + 64) * 256 + tt * 4096 + oioff);
        }
#pragma unroll
        for (int u = 0; u < 4; ++u) {
            u32x4 w;
            w[0] = pk_bf16(S[2 * u][0], S[2 * u][1]);
            w[1] = pk_bf16(S[2 * u][2], S[2 * u][3]);
            w[2] = pk_bf16(S[2 * u + 1][0], S[2 * u + 1][1]);
            w[3] = pk_bf16(S[2 * u + 1][2], S[2 * u + 1][3]);
            const bf16x8 sf = __builtin_bit_cast(bf16x8, w);
#pragma unroll
            for (int tt = 0; tt < 4; ++tt) {
                const uint2 lo = *(const uint2*)(sQ + tt * 4096 + p256[u][0]);
                const uint2 hi = *(const uint2*)(sQ + tt * 4096 + p256[u][1]);
                u32x4 q4;
                q4[0] = lo.x; q4[1] = lo.y; q4[2] = hi.x; q4[3] = hi.y;
                o[tt] = __builtin_amdgcn_mfma_f32_16x16x32_bf16(sf, __builtin_bit_cast(bf16x8, q4), o[tt], 0, 0, 0);
            }
        }
#pragma unroll
        for (int dkt = 0; dkt < 8; ++dkt) {
            const float4 eb = *(const float4*)(EBL + dkt * 16 + fq * 4);
            const uint2 dd = dsr[dkt];
            S[dkt][0] = fmaf(S[dkt][0], eb.x, bflo(dd.x));
            S[dkt][1] = fmaf(S[dkt][1], eb.y, bfhi(dd.x));
            S[dkt][2] = fmaf(S[dkt][2], eb.z, bflo(dd.y));
            S[dkt][3] = fmaf(S[dkt][3], eb.w, bfhi(dd.y));
            if (more) dsr[dkt] = *(const uint2*)(DSb + (size_t)(c + 1) * 32768 + dkt * 1024 + dsoff);
        }
#pragma unroll
        for (int tt = 0; tt < 4; ++tt) {
            float ss = o[tt][0] * o[tt][0] + o[tt][1] * o[tt][1] + o[tt][2] * o[tt][2] + o[tt][3] * o[tt][3];
            ss = xsum4(ss);
            if (fq == 0) SSP[s0 + tt * 16 + fr] = ss;
            const size_t tg = (size_t)b * S_ + s0 + tt * 16 + fr;
            const float r0 = o[tt][0] * bflo(gg[tt].x), r1 = o[tt][1] * bfhi(gg[tt].x), r2 = o[tt][2] * bflo(gg[tt].y), r3 = o[tt][3] * bfhi(gg[tt].y);
            *(uint2*)(OM + tg * 1024 + 512 + hh * 128 + gd * 16 + fq * 4) = make_uint2(pk_bf16(r0, r1), pk_bf16(r2, r3));
        }
        if (more) {
            unsigned char* nq = lds + ((c + 1) & 1) * 16384;
#pragma unroll
            for (int i = 0; i < 4; ++i) *(u32x4*)(nq + o16 + i * 4096) = qn[i];
            if (tid < 32) *(u32x4*)(lds + 32768 + ((c + 1) & 1) * 512 + tid * 16) = ebn;
        }
        __syncthreads();
    }
}

DEV void hgrn_chain_item2(const P& p, int bh, unsigned char* lds) {
    const int hh = bh & 3, b = bh >> 2;
    int tid = threadIdx.x;
    asm volatile("" : "+v"(tid));
    const int lane = tid & 63, wid = __builtin_amdgcn_readfirstlane(tid >> 6), fr = lane & 15, fq = lane >> 4;
    const unsigned char* hs = (const unsigned char*)p.out;
    const bf16_t* QTg = (const bf16_t*)(hs + HS_QT) + (size_t)bh * 2048 * 128;
    const char* OIb = (const char*)(hs + HS_OI) + ((size_t)bh * 2048 * 128 + wid * 32) * 2;
    const unsigned oioff = (unsigned)((fr * 128 + fq * 4) * 2);
    const char* DSb = (const char*)(hs + HS_DS) + (((size_t)bh * 32 * 4 + wid) * 16 * 64) * 8;
    const unsigned dsoff = (unsigned)(lane * 8);
    const char* GGb = (const char*)(p.ws + WS_XB) + ((size_t)bh * 2048 * 128 + wid * 32) * 2;
    const unsigned ggoff = oioff;
    const float* EB = (const float*)(p.ws + WS_EB) + (size_t)bh * 32 * 128;
    bf16_t* OM = (bf16_t*)(p.ws + WS_OM);
    float* EBL = (float*)(lds + 16384);
    float* SS = (float*)(lds + 16896);
    const int dv0 = wid * 32;
    int p256[4][2];
#pragma unroll
    for (int u = 0; u < 4; ++u)
#pragma unroll
        for (int h = 0; h < 2; ++h) p256[u][h] = fr * 256 + (((4 * u + 2 * h + (fq >> 1)) ^ fr) << 4) + 8 * (fq & 1);
    const int c16 = tid & 15, r16 = tid >> 4;
    const int o16 = r16 * 256 + ((c16 ^ (r16 & 15)) << 4);
    const unsigned qoff = (unsigned)((r16 * 128 + c16 * 8) * 2);
    f32x4 S[2][2];
    f32x4* SL = (f32x4*)(lds + 17920) + wid * 768 + lane;
#pragma unroll
    for (int i = 0; i < 2; ++i)
#pragma unroll
        for (int j = 0; j < 2; ++j) S[i][j] = (f32x4){0.f, 0.f, 0.f, 0.f};
#pragma unroll
    for (int i = 0; i < 12; ++i) SL[i * 64] = (f32x4){0.f, 0.f, 0.f, 0.f};
    uint2 oi[4][2], dsr[8][2];
    {
        const char* qb = (const char*)QTg;
#pragma unroll
        for (int i = 0; i < 4; ++i) *(u32x4*)(lds + o16 + i * 4096) = *(const u32x4*)(qb + i * 4096 + qoff);
        if (tid < 32) *(u32x4*)(EBL + tid * 4) = *(const u32x4*)(EB + tid * 4);
#pragma unroll
        for (int tt = 0; tt < 4; ++tt)
#pragma unroll
            for (int dvt = 0; dvt < 2; ++dvt) {
                oi[tt][dvt] = *(const uint2*)(OIb + tt * 4096 + dvt * 32 + oioff);
            }
#pragma unroll
        for (int dkt = 0; dkt < 8; ++dkt)
#pragma unroll
            for (int dvt = 0; dvt < 2; ++dvt) dsr[dkt][dvt] = *(const uint2*)(DSb + (dkt * 2 + dvt) * 512 + dsoff);
    }
    __syncthreads();
#pragma unroll 1
    for (int c = 0; c < 32; ++c) {
        const int s0 = c * 64;
        const bool more = c + 1 < 32;
        uint2 gg[4][2];
#pragma unroll
        for (int tt = 0; tt < 4; ++tt)
#pragma unroll
            for (int dvt = 0; dvt < 2; ++dvt) gg[tt][dvt] = *(const uint2*)(GGb + (size_t)s0 * 256 + tt * 4096 + dvt * 32 + ggoff);
        f32x4 o[2][4];
#pragma unroll
        for (int tt = 0; tt < 4; ++tt)
#pragma unroll
            for (int dvt = 0; dvt < 2; ++dvt) {
                o[dvt][tt] = (f32x4){bflo(oi[tt][dvt].x), bfhi(oi[tt][dvt].x), bflo(oi[tt][dvt].y), bfhi(oi[tt][dvt].y)};
                if (more) oi[tt][dvt] = *(const uint2*)(OIb + (size_t)(s0 + 64) * 256 + tt * 4096 + dvt * 32 + oioff);
            }
        const unsigned char* sQ = lds;
#pragma unroll
        for (int u = 0; u < 4; ++u) {
            bf16x8 sf[2];
#pragma unroll
            for (int dvt = 0; dvt < 2; ++dvt) {
                const f32x4 sa = u < 1 ? S[0][dvt] : SL[((2 * u - 2) * 2 + dvt) * 64];
                const f32x4 sb = u < 1 ? S[1][dvt] : SL[((2 * u - 1) * 2 + dvt) * 64];
                u32x4 w;
                w[0] = pk_bf16(sa[0], sa[1]);
                w[1] = pk_bf16(sa[2], sa[3]);
                w[2] = pk_bf16(sb[0], sb[1]);
                w[3] = pk_bf16(sb[2], sb[3]);
                sf[dvt] = __builtin_bit_cast(bf16x8, w);
            }
#pragma unroll
            for (int tt = 0; tt < 4; ++tt) {
                const uint2 lo = *(const uint2*)(sQ + tt * 4096 + p256[u][0]);
                const uint2 hi = *(const uint2*)(sQ + tt * 4096 + p256[u][1]);
                u32x4 w;
                w[0] = lo.x; w[1] = lo.y; w[2] = hi.x; w[3] = hi.y;
                const bf16x8 qf2 = __builtin_bit_cast(bf16x8, w);
#pragma unroll
                for (int dvt = 0; dvt < 2; ++dvt) o[dvt][tt] = __builtin_amdgcn_mfma_f32_16x16x32_bf16(sf[dvt], qf2, o[dvt][tt], 0, 0, 0);
            }
        }
        u32x4 qn[4], ebn;
        if (more) {
            const char* qb = (const char*)(QTg + (size_t)(s0 + 64) * 128);
#pragma unroll
            for (int i = 0; i < 4; ++i) qn[i] = *(const u32x4*)(qb + i * 4096 + qoff);
            if (tid < 32) ebn = *(const u32x4*)(EB + (c + 1) * 128 + tid * 4);
        }
#pragma unroll
        for (int dkt = 0; dkt < 8; ++dkt) {
            const float4 eb = *(const float4*)(EBL + dkt * 16 + fq * 4);
#pragma unroll
            for (int dvt = 0; dvt < 2; ++dvt) {
                const uint2 dd = dsr[dkt][dvt];
                f32x4 sv = dkt < 2 ? S[dkt < 2 ? dkt : 0][dvt] : SL[((dkt - 2) * 2 + dvt) * 64];
                sv[0] = fmaf(sv[0], eb.x, bflo(dd.x));
                sv[1] = fmaf(sv[1], eb.y, bfhi(dd.x));
                sv[2] = fmaf(sv[2], eb.z, bflo(dd.y));
                sv[3] = fmaf(sv[3], eb.w, bfhi(dd.y));
                if (dkt < 2) S[dkt < 2 ? dkt : 0][dvt] = sv; else SL[((dkt - 2) * 2 + dvt) * 64] = sv;
                if (more) dsr[dkt][dvt] = *(const uint2*)(DSb + (size_t)(c + 1) * 32768 + (dkt * 2 + dvt) * 512 + dsoff);
            }
        }
#pragma unroll
        for (int tt = 0; tt < 4; ++tt) {
            float ss = 0.f;
#pragma unroll
            for (int dvt = 0; dvt < 2; ++dvt)
#pragma unroll
                for (int i = 0; i < 4; ++i) ss += o[dvt][tt][i] * o[dvt][tt][i];
            ss = xsum4(ss);
            if (fq == 0) SS[wid * 64 + tt * 16 + fr] = ss;
        }
        __syncthreads();
#pragma unroll
        for (int tt = 0; tt < 4; ++tt) {
            const int t = tt * 16 + fr;
            const float tot = SS[t] + SS[64 + t] + SS[128 + t] + SS[192 + t];
            const float rs = rsqrtf(tot * (1.f / 128.f) + LN_EPS);
            const size_t tg = (size_t)b * S_ + s0 + t;
#pragma unroll
            for (int dvt = 0; dvt < 2; ++dvt) {
                const int dv = dv0 + dvt * 16 + fq * 4;
                const float r0 = o[dvt][tt][0] * rs * bflo(gg[tt][dvt].x);
                const float r1 = o[dvt][tt][1] * rs * bfhi(gg[tt][dvt].x);
                const float r2 = o[dvt][tt][2] * rs * bflo(gg[tt][dvt].y);
                const float r3 = o[dvt][tt][3] * rs * bfhi(gg[tt][dvt].y);
                *(uint2*)(OM + tg * 1024 + 512 + hh * 128 + dv) = make_uint2(pk_bf16(r0, r1), pk_bf16(r2, r3));
            }
        }
        if (more) {
#pragma unroll
            for (int i = 0; i < 4; ++i) *(u32x4*)(lds + o16 + i * 4096) = qn[i];
            if (tid < 32) *(u32x4*)(EBL + tid * 4) = ebn;
        }
        __syncthreads();
    }
}

DEV void xattn_item2(const P& p, int item) {
    const int qt64 = item & 31, hh = (item >> 5) & 3, b = item >> 7;
    const int lane = threadIdx.x & 63, wid = threadIdx.x >> 6, fr = lane & 15, fq = lane >> 4;
    const bf16_t* QX = (const bf16_t*)(p.ws + WS_QX);
    const bf16_t* KVM = (const bf16_t*)(p.ws + WS_KVM);
    const bf16_t* VMT = (const bf16_t*)(p.ws + WS_VMT) + (size_t)(b * 4 + hh) * 256 * 256;
    bf16_t* OX = (bf16_t*)(p.ws + WS_OX);
    const size_t tq = (size_t)b * S_ + qt64 * 64 + wid * 16 + fr;
    bf16x8 qf[8];
#pragma unroll
    for (int ks = 0; ks < 8; ++ks) qf[ks] = *(const bf16x8*)(QX + tq * 1024 + hh * 256 + ks * 32 + fq * 8);
    f32x4 sc[16];
#pragma unroll
    for (int kt = 0; kt < 16; ++kt) {
        f32x4 a = (f32x4){0.f, 0.f, 0.f, 0.f};
        const bf16_t* kp = KVM + (size_t)(b * ML_ + kt * 16 + fr) * 2048 + hh * 256 + fq * 8;
#pragma unroll
        for (int ks = 0; ks < 8; ++ks) a = __builtin_amdgcn_mfma_f32_16x16x32_bf16(*(const bf16x8*)(kp + ks * 32), qf[ks], a, 0, 0, 0);
        sc[kt] = a;
    }
    float mx = -1e30f;
#pragma unroll
    for (int kt = 0; kt < 16; ++kt)
#pragma unroll
        for (int i = 0; i < 4; ++i) { sc[kt][i] *= 0.0625f; mx = fmaxf(mx, sc[kt][i]); }
    mx = xmax4(mx);
    float ps = 0.f;
#pragma unroll
    for (int kt = 0; kt < 16; ++kt)
#pragma unroll
        for (int i = 0; i < 4; ++i) { sc[kt][i] = __expf(sc[kt][i] - mx); ps += sc[kt][i]; }
    ps = xsum4(ps);
    const float inv = 1.f / ps;
    u32x4 pf[8];
#pragma unroll
    for (int s = 0; s < 8; ++s) {
        pf[s][0] = pk_bf16(sc[2 * s][0] * inv, sc[2 * s][1] * inv);
        pf[s][1] = pk_bf16(sc[2 * s][2] * inv, sc[2 * s][3] * inv);
        pf[s][2] = pk_bf16(sc[2 * s + 1][0] * inv, sc[2 * s + 1][1] * inv);
        pf[s][3] = pk_bf16(sc[2 * s + 1][2] * inv, sc[2 * s + 1][3] * inv);
    }
#pragma unroll 1
    for (int dh = 0; dh < 2; ++dh) {
        f32x4 o[8];
#pragma unroll
        for (int dt = 0; dt < 8; ++dt) o[dt] = (f32x4){0.f, 0.f, 0.f, 0.f};
#pragma unroll
        for (int s = 0; s < 8; ++s) {
#pragma unroll
            for (int dt = 0; dt < 8; ++dt) {
                const bf16_t* vp = VMT + (size_t)(dh * 128 + dt * 16 + fr) * 256 + 32 * s + 4 * fq;
                o[dt] = __builtin_amdgcn_mfma_f32_16x16x32_bf16(ld2x8(vp, vp + 16), __builtin_bit_cast(bf16x8, pf[s]), o[dt], 0, 0, 0);
            }
        }
#pragma unroll
        for (int dt = 0; dt < 8; ++dt) {
            uint2 u2;
            u2.x = pk_bf16(o[dt][0], o[dt][1]);
            u2.y = pk_bf16(o[dt][2], o[dt][3]);
            *(uint2*)(OX + tq * 1024 + hh * 256 + dh * 128 + dt * 16 + fq * 4) = u2;
        }
    }
}


struct XaRegs { u32x4 r[8]; };
DEV void xa_loadK(XaRegs& x, const bf16_t* kbase, int tid) {
    const int c = tid & 31, r0 = tid >> 5;
#pragma unroll
    for (int i = 0; i < 8; ++i) x.r[i] = *(const u32x4*)(kbase + (size_t)(r0 + 8 * i) * 2048 + c * 8);
}
DEV void xa_storeK(const XaRegs& x, unsigned char* lds, int tid) {
    const int c = tid & 31, r0 = tid >> 5;
#pragma unroll
    for (int i = 0; i < 8; ++i) {
        const int row = r0 + 8 * i;
        *(u32x4*)(lds + row * 512 + ((c ^ (row & 15)) << 4)) = x.r[i];
    }
}
DEV void xa_loadV(XaRegs& x, const bf16_t* vbase, int tid) {
    const int c = tid & 7, r0 = tid >> 3;
#pragma unroll
    for (int i = 0; i < 8; ++i) x.r[i] = *(const u32x4*)(vbase + (size_t)(r0 + 32 * i) * 256 + c * 8);
}
DEV void xa_storeV(const XaRegs& x, unsigned char* lds, int tid) {
    const int c = tid & 7, r0 = tid >> 3;
    const int o = r0 * 128 + ((c ^ ((r0 >> 1) & 7)) << 4);
#pragma unroll
    for (int i = 0; i < 8; ++i) *(u32x4*)(lds + 32768 + o + i * 4096) = x.r[i];
}
DEV void xattn_item3(const P& p, int item, unsigned char* lds) {
    const int qt64 = item & 31, hh = (item >> 5) & 3, b = item >> 7;
    int tid = threadIdx.x;
    asm volatile("" : "+v"(tid));
    const int lane = tid & 63, wid = tid >> 6, fr = lane & 15, fq = lane >> 4;
    const bf16_t* QX = (const bf16_t*)(p.ws + WS_QX);
    const bf16_t* KB = (const bf16_t*)(p.ws + WS_KVM) + (size_t)(b * ML_) * 2048 + hh * 256;
    const bf16_t* VB = (const bf16_t*)(p.ws + WS_VMT) + (size_t)(b * 4 + hh) * 256 * 256;
    bf16_t* OX = (bf16_t*)(p.ws + WS_OX);
    const size_t tq = (size_t)b * S_ + qt64 * 64 + wid * 16 + fr;
    bf16x8 qf[8];
#pragma unroll
    for (int ks = 0; ks < 8; ++ks) qf[ks] = *(const bf16x8*)(QX + tq * 1024 + hh * 256 + ks * 32 + fq * 8);
    f32x4 o[16];
#pragma unroll
    for (int dt = 0; dt < 16; ++dt) o[dt] = (f32x4){0.f, 0.f, 0.f, 0.f};
    float m = -1e30f, l = 0.f;
    {
        XaRegs x;
        xa_loadK(x, KB, tid);
        xa_storeK(x, lds, tid);
        xa_loadV(x, VB, tid);
        xa_storeV(x, lds, tid);
    }
    __syncthreads();
    const int sw8 = (fr >> 1) & 7;
#pragma unroll 1
    for (int j = 0; j < 4; ++j) {
        XaRegs nx;
        if (j + 1 < 4) xa_loadK(nx, KB + (size_t)(j + 1) * 64 * 2048, tid);
        f32x4 sc[4];
#pragma unroll
        for (int kt = 0; kt < 4; ++kt) {
            f32x4 a = (f32x4){0.f, 0.f, 0.f, 0.f};
            const unsigned char* rp = lds + (kt * 16 + fr) * 512;
#pragma unroll
            for (int ks = 0; ks < 8; ++ks) a = __builtin_amdgcn_mfma_f32_16x16x32_bf16(*(const bf16x8*)(rp + (((4 * ks + fq) ^ fr) << 4)), qf[ks], a, 0, 0, 0);
            sc[kt] = a;
        }
        __syncthreads();
        if (j + 1 < 4) { xa_storeK(nx, lds, tid); xa_loadV(nx, VB + (j + 1) * 64, tid); }
        float bm = -1e30f;
#pragma unroll
        for (int kt = 0; kt < 4; ++kt)
#pragma unroll
            for (int i = 0; i < 4; ++i) { sc[kt][i] *= 0.0625f; bm = fmaxf(bm, sc[kt][i]); }
        bm = xmax4(bm);
        const float mn = fmaxf(m, bm);
        const float alpha = __expf(m - mn);
        float ps = 0.f;
#pragma unroll
        for (int kt = 0; kt < 4; ++kt)
#pragma unroll
            for (int i = 0; i < 4; ++i) { sc[kt][i] = __expf(sc[kt][i] - mn); ps += sc[kt][i]; }
        l = l * alpha + ps;
        m = mn;
#pragma unroll
        for (int dt = 0; dt < 16; ++dt) o[dt] *= alpha;
#pragma unroll
        for (int s = 0; s < 2; ++s) {
            u32x4 w;
            w[0] = pk_bf16(sc[2 * s][0], sc[2 * s][1]);
            w[1] = pk_bf16(sc[2 * s][2], sc[2 * s][3]);
            w[2] = pk_bf16(sc[2 * s + 1][0], sc[2 * s + 1][1]);
            w[3] = pk_bf16(sc[2 * s + 1][2], sc[2 * s + 1][3]);
            const bf16x8 pf = __builtin_bit_cast(bf16x8, w);
#pragma unroll
            for (int dt = 0; dt < 16; ++dt) {
                const unsigned char* rp = lds + 32768 + (dt * 16 + fr) * 128 + 8 * (fq & 1);
                const uint2 lo = *(const uint2*)(rp + (((4 * s + (fq >> 1)) ^ sw8) << 4));
                const uint2 hi = *(const uint2*)(rp + (((4 * s + 2 + (fq >> 1)) ^ sw8) << 4));
                u32x4 vv;
                vv[0] = lo.x; vv[1] = lo.y; vv[2] = hi.x; vv[3] = hi.y;
                o[dt] = __builtin_amdgcn_mfma_f32_16x16x32_bf16(__builtin_bit_cast(bf16x8, vv), pf, o[dt], 0, 0, 0);
            }
        }
        __syncthreads();
        if (j + 1 < 4) xa_storeV(nx, lds, tid);
        __syncthreads();
    }
    const float inv = 1.f / xsum4(l);
#pragma unroll
    for (int dt = 0; dt < 16; ++dt) {
        uint2 u2;
        u2.x = pk_bf16(o[dt][0] * inv, o[dt][1] * inv);
        u2.y = pk_bf16(o[dt][2] * inv, o[dt][3] * inv);
        *(uint2*)(OX + tq * 1024 + hh * 256 + dt * 16 + fq * 4) = u2;
    }
}


DEV void peer_quant_rows4(const float* src, unsigned char* dst, float* scl, int row0, int* rsum = nullptr, int bias = 128) {
    const int lane = threadIdx.x & 63;
    float4 v[4][4];
#pragma unroll
    for (int r = 0; r < 4; ++r) {
        const float* rp = src + (size_t)(row0 + r) * 1024 + lane * 16;
#pragma unroll
        for (int i = 0; i < 4; ++i) v[r][i] = *(const float4*)(rp + 4 * i);
    }
#pragma unroll
    for (int r = 0; r < 4; ++r) {
        const int row = row0 + r;
        float mx = 0.f;
#pragma unroll
        for (int i = 0; i < 4; ++i) mx = fmaxf(fmaxf(mx, fmaxf(fabsf(v[r][i].x), fabsf(v[r][i].y))), fmaxf(fabsf(v[r][i].z), fabsf(v[r][i].w)));
        mx = wmax(mx);
        const float q = mx > 0.f ? 127.f / mx : 0.f;
        u32x4 w;
        int usum = 0;
#pragma unroll
        for (int i = 0; i < 4; ++i) {
            const float e[4] = {v[r][i].x, v[r][i].y, v[r][i].z, v[r][i].w};
            unsigned pk = 0u;
#pragma unroll
            for (int k = 0; k < 4; ++k) {
                int qi = (int)rintf(e[k] * q);
                qi = qi < -127 ? -127 : (qi > 127 ? 127 : qi);
                pk |= (unsigned)((qi + bias) & 0xff) << (8 * k);
                usum += qi + 128;
            }
            w[i] = pk;
        }
        *(u32x4*)(dst + ((size_t)(lane >> 3) * 16384 + row) * 128 + (lane & 7) * 16) = w;
        if (rsum) {
#pragma unroll
            for (int o = 32; o > 0; o >>= 1) usum += __shfl_xor(usum, o);
            if (lane == 0) rsum[row] = usum;
        }
        if (lane == 0) scl[row] = mx * (1.f / 127.f);
    }
}

DEV unsigned f2ord(float f) { const unsigned b = __float_as_uint(f); return b ^ ((b >> 31) ? 0xffffffffu : 0x80000000u); }
DEV float ord2f(unsigned o) { return __uint_as_float((o & 0x80000000u) ? (o ^ 0x80000000u) : ~o); }
DEV void ins16(unsigned (&v)[16], unsigned x) {
#pragma unroll
    for (int k = 0; k < 16; ++k) {
        const unsigned t = v[k] > x ? v[k] : x;
        x = v[k] > x ? x : v[k];
        v[k] = t;
    }
}
constexpr int PEER_SC = 0;
constexpr int PEER_LST = 0;
constexpr int PEER_EID = 16384;
constexpr int PEER_GATE = 16384 + 4096;
DEV void peer_route_item(const P& p, int item, unsigned char* lds) {
    const int tid = threadIdx.x, lane = tid & 63, wid = tid >> 6;
    const int t0 = item * 16;
    const bf16_t* QP = (const bf16_t*)(p.ws + WS_QP);
    const bf16_t* PK = (const bf16_t*)(p.ws + WS_PKEY);
    unsigned* SC = (unsigned*)(lds + PEER_SC);
    const int fr = lane & 15, fq = lane >> 4;
    unsigned lst[16];
#pragma unroll
    for (int k = 0; k < 16; ++k) lst[k] = 0u;
    bf16x8 qf[4][2];
#pragma unroll
    for (int ci = 0; ci < 4; ++ci)
#pragma unroll
        for (int ks = 0; ks < 2; ++ks)
            qf[ci][ks] = *(const bf16x8*)(QP + (size_t)(t0 + fr) * 1024 + (4 * wid + ci) * 64 + ks * 32 + fq * 8);
#pragma unroll 1
    for (int pass = 0; pass < 2; ++pass) {
#pragma unroll
        for (int ci = 0; ci < 4; ++ci) {
            const int cb = 4 * wid + ci;
#pragma unroll
            for (int kt = 0; kt < 4; ++kt) {
                f32x4 acc = (f32x4){0.f, 0.f, 0.f, 0.f};
#pragma unroll
                for (int ks = 0; ks < 2; ++ks) {
                    const bf16x8 kf = *(const bf16x8*)(PK + ((size_t)cb * 128 + pass * 64 + kt * 16 + fr) * 64 + ks * 32 + fq * 8);
                    acc = __builtin_amdgcn_mfma_f32_16x16x32_bf16(kf, qf[ci][ks], acc, 0, 0, 0);
                }
                unsigned* dst = SC + (cb * 16 + fr) * 65 + kt * 16 + fq * 4;
#pragma unroll
                for (int i = 0; i < 4; ++i) {
                    const int kidx = pass * 64 + kt * 16 + fq * 4 + i;
                    dst[i] = (f2ord(acc[i]) & ~127u) | (unsigned)(127 - kidx);
                }
            }
        }
        __syncthreads();
        {
            const unsigned* row = SC + tid * 65;
#pragma unroll 4
            for (int k = 0; k < 64; ++k) ins16(lst, row[k]);
        }
        __syncthreads();
    }
    unsigned* LST = (unsigned*)(lds + PEER_LST);
#pragma unroll
    for (int k = 0; k < 16; ++k) LST[tid * 16 + k] = lst[k];
    __syncthreads();
    unsigned short* EID = (unsigned short*)(lds + PEER_EID);
    float* GATE = (float*)(lds + PEER_GATE);
    if (((tid >> 4) & 1) == 0) {
        const int tok = tid & 15, hh = tid >> 5;
        const unsigned* l2 = LST + (tid + 16) * 16;
        float s1[16], s2[16];
#pragma unroll
        for (int k = 0; k < 16; ++k) { s1[k] = ord2f(lst[k] & ~127u); s2[k] = ord2f(l2[k] & ~127u); }
        unsigned fin[16];
#pragma unroll
        for (int k = 0; k < 16; ++k) fin[k] = 0u;
#pragma unroll
        for (int i = 0; i < 16; ++i)
#pragma unroll
            for (int j = 0; j < 16; ++j)
                if ((i + 1) * (j + 1) <= 16) ins16(fin, (f2ord(s1[i] + s2[j]) & ~255u) | (unsigned)(255 - (i * 16 + j)));
        const float mx = ord2f(fin[0] & ~255u);
        float w[16], ws = 0.f;
#pragma unroll
        for (int k = 0; k < 16; ++k) { w[k] = expf(ord2f(fin[k] & ~255u) - mx); ws += w[k]; }
        const float inv = 1.f / ws;
#pragma unroll
        for (int k = 0; k < 16; ++k) {
            const int flat = 255 - (int)(fin[k] & 255u);
            const int i1 = 127 - (int)(LST[tid * 16 + (flat >> 4)] & 127u);
            const int i2 = 127 - (int)(l2[flat & 15] & 127u);
            EID[tok * 128 + hh * 16 + k] = (unsigned short)(i1 * 128 + i2);
            GATE[tok * 128 + hh * 16 + k] = w[k] * inv;
        }
    }
    __syncthreads();
    {
        unsigned short* EIDP = (unsigned short*)(p.ws + WS_EIDP);
        float* GATEP = (float*)(p.ws + WS_GATEP);
        for (int i = tid; i < 16 * 128; i += 256) {
            const int tok = i >> 7, pi = i & 127, eg = pi >> 4, k = pi & 15, slot = 8 * k + eg;
            EIDP[(size_t)(t0 + tok) * 128 + pi] = EID[tok * 128 + slot];
            GATEP[(size_t)(t0 + tok) * 128 + pi] = GATE[tok * 128 + slot];
        }
        unsigned char* XQ = p.ws + WS_XQ;
        const size_t tb = (size_t)t0 + wid * 4;
        float2 st4[4];
        u32x4 ya[4][2];
#pragma unroll
        for (int tt = 0; tt < 4; ++tt) {
            st4[tt] = ((const float2*)(p.ws + WS_ST2))[tb + tt];
            const bf16_t* row = (const bf16_t*)(p.ws + WS_YB) + (tb + tt) * 1024 + lane * 16;
            ya[tt][0] = *(const u32x4*)row;
            ya[tt][1] = *(const u32x4*)(row + 8);
        }
        float gv[16], bv[16];
#pragma unroll
        for (int i = 0; i < 4; ++i) {
            const float4 g4 = *(const float4*)(p.ln_g + 1024 + lane * 16 + 4 * i);
            const float4 b4 = *(const float4*)(p.ln_b + 1024 + lane * 16 + 4 * i);
            gv[4 * i] = g4.x; gv[4 * i + 1] = g4.y; gv[4 * i + 2] = g4.z; gv[4 * i + 3] = g4.w;
            bv[4 * i] = b4.x; bv[4 * i + 1] = b4.y; bv[4 * i + 2] = b4.z; bv[4 * i + 3] = b4.w;
        }
#pragma unroll
        for (int tt = 0; tt < 4; ++tt) {
            const size_t t = tb + tt;
            const float mean = st4[tt].x, rs = st4[tt].y;
            float xr[16];
            float amax = 0.f;
#pragma unroll
            for (int i = 0; i < 2; ++i)
#pragma unroll
                for (int q = 0; q < 4; ++q) {
                    const int j = 8 * i + 2 * q;
                    xr[j] = (bflo(ya[tt][i][q]) - mean) * rs * gv[j] + bv[j];
                    xr[j + 1] = (bfhi(ya[tt][i][q]) - mean) * rs * gv[j + 1] + bv[j + 1];
                    amax = fmaxf(amax, fmaxf(fabsf(xr[j]), fabsf(xr[j + 1])));
                }
            amax = wmax(amax);
            const float qx = amax > 0.f ? 127.f / amax : 0.f;
            u32x4 w;
            int s_ = 0;
#pragma unroll
            for (int i = 0; i < 4; ++i) {
                unsigned pk = 0u;
#pragma unroll
                for (int k = 0; k < 4; ++k) {
                    int qi = (int)rintf(xr[4 * i + k] * qx);
                    qi = qi < -127 ? -127 : (qi > 127 ? 127 : qi);
                    pk |= (unsigned)(qi + 128) << (8 * k);
                    s_ += qi + 128;
                }
                w[i] = pk;
            }
#pragma unroll
            for (int o = 32; o > 0; o >>= 1) s_ += __shfl_xor(s_, o);
            *(u32x4*)(XQ + t * 1024 + lane * 16) = w;
            if (lane == 0) {
                ((float*)(p.ws + WS_SXF))[t] = amax * (1.f / 127.f);
                ((int*)(p.ws + WS_SXI))[t] = s_;
            }
        }
    }
    __syncthreads();
}

DEV void peer_gather16(u32x4 (&rows)[16], const unsigned char* tab, const u32x4& e0, const u32x4& e1) {
#pragma unroll
    for (int k = 0; k < 16; ++k) {
        const unsigned ew = k < 8 ? e0[k >> 1] : e1[(k - 8) >> 1];
        const unsigned e = (k & 1) ? (ew >> 16) : (ew & 0xffffu);
        rows[k] = *(const u32x4*)(tab + (size_t)e * 128);
    }
}
DEV void peer_down_compute(const u32x4 (&rows)[16], const u32x4& xu, int* dst, int cg) {
    unsigned v[16];
#pragma unroll
    for (int k = 0; k < 16; ++k) {
        unsigned a_ = 0u;
#pragma unroll
        for (int q = 0; q < 4; ++q) a_ = __builtin_amdgcn_udot4(rows[k][q], xu[q], a_, false);
        v[k] = a_;
    }
    unsigned w8[8], w4[4], w2[2];
    {
        const bool hi = (cg & 4) != 0;
#pragma unroll
        for (int j = 0; j < 8; ++j) {
            const unsigned send = hi ? v[j] : v[j + 8];
            const unsigned keep = hi ? v[j + 8] : v[j];
            w8[j] = keep + (unsigned)__shfl_xor((int)send, 4);
        }
    }
    {
        const bool hi = (cg & 2) != 0;
#pragma unroll
        for (int j = 0; j < 4; ++j) {
            const unsigned send = hi ? w8[j] : w8[j + 4];
            const unsigned keep = hi ? w8[j + 4] : w8[j];
            w4[j] = keep + (unsigned)__shfl_xor((int)send, 2);
        }
    }
    {
        const bool hi = (cg & 1) != 0;
#pragma unroll
        for (int j = 0; j < 2; ++j) {
            const unsigned send = hi ? w4[j] : w4[j + 2];
            const unsigned keep = hi ? w4[j + 2] : w4[j];
            w2[j] = keep + (unsigned)__shfl_xor((int)send, 1);
        }
    }
    *(uint2*)dst = make_uint2(w2[0], w2[1]);
}
DEV void peer_down_item(const P& p, int s, int tile, int lane, int wid) {
    const int eg = lane >> 3, cg = lane & 7;
    const unsigned char* PD = p.ws + WS_PD + (size_t)s * 16384 * 128 + cg * 16;
    const size_t t0 = (size_t)tile * 32 + wid * 8;
    const unsigned short* EI = (const unsigned short*)(p.ws + WS_EIDP) + t0 * 128 + eg * 16;
    const unsigned char* XQ = p.ws + WS_XQ + t0 * 1024 + s * 128 + cg * 16;
    int* DP = (int*)(p.ws + WS_DP) + (size_t)s * T_ * 128 + t0 * 128 + eg * 16 + 2 * cg;
    u32x4 rA[16], rB[16];
    u32x4 ea0 = *(const u32x4*)EI, ea1 = *(const u32x4*)(EI + 8);
    u32x4 eb0 = *(const u32x4*)(EI + 128), eb1 = *(const u32x4*)(EI + 128 + 8);
    u32x4 xa = *(const u32x4*)XQ, xb = *(const u32x4*)(XQ + 1024);
    peer_gather16(rA, PD, ea0, ea1);
#pragma unroll 1
    for (int tt = 0; tt < 8; tt += 2) {
        peer_gather16(rB, PD, eb0, eb1);
        if (tt + 2 < 8) { ea0 = *(const u32x4*)(EI + (tt + 2) * 128); ea1 = *(const u32x4*)(EI + (tt + 2) * 128 + 8); }
        peer_down_compute(rA, xa, DP + tt * 128, cg);
        if (tt + 2 < 8) {
            xa = *(const u32x4*)(XQ + (tt + 2) * 1024);
            peer_gather16(rA, PD, ea0, ea1);
            eb0 = *(const u32x4*)(EI + (tt + 3) * 128); eb1 = *(const u32x4*)(EI + (tt + 3) * 128 + 8);
        }
        peer_down_compute(rB, xb, DP + (tt + 1) * 128, cg);
        if (tt + 2 < 8) xb = *(const u32x4*)(XQ + (tt + 3) * 1024);
    }
}

DEV void peer_coef_item(const P& p, int t, int lane) {
    const int* DP = (const int*)(p.ws + WS_DP);
    const unsigned short* EIDP = (const unsigned short*)(p.ws + WS_EIDP);
    const float* GATEP = (const float*)(p.ws + WS_GATEP);
    const float sx = ((const float*)(p.ws + WS_SXF))[t];
    const int sxu = ((const int*)(p.ws + WS_SXI))[t];
    float cf[2];
    float cm = 0.f;
#pragma unroll
    for (int h = 0; h < 2; ++h) {
        const int pi = lane + 64 * h;
        int tot = 0;
#pragma unroll
        for (int s = 0; s < 8; ++s) tot += DP[((size_t)s * T_ + t) * 128 + pi];
        const int e = EIDP[(size_t)t * 128 + pi];
        const int dotq = tot - 128 * ((const int*)(p.ws + WS_PRS))[e] - 128 * sxu + 128 * 128 * 1024;
        const float hv = ((const float*)(p.ws + WS_PSD))[e] * sx * (float)dotq;
        cf[h] = 0.5f * hv * (1.f + erff(hv * 0.7071067811865476f)) * GATEP[(size_t)t * 128 + pi] * ((const float*)(p.ws + WS_PSU))[e];
        cm = fmaxf(cm, fabsf(cf[h]));
    }
    cm = wmax(cm);
    const float qs = cm > 0.f ? 127.f / cm : 0.f;
#pragma unroll
    for (int h = 0; h < 2; ++h) {
        int qi = (int)rintf(cf[h] * qs);
        qi = qi < -127 ? -127 : (qi > 127 ? 127 : qi);
        (p.ws + WS_COEFP)[(size_t)t * 128 + lane + 64 * h] = (unsigned char)(qi & 0xff);
    }
    if (lane == 0) ((float*)(p.ws + WS_ASUM))[t] = cm * (1.f / 127.f);
}

DEV void peer_up_compute(const P& p, const u32x4 (&rows)[16], const u32x4& cq, size_t t, int col, int eg, const float2& g2, const float2& b2, bool dostore) {
    int acc[16];
#pragma unroll
    for (int i = 0; i < 16; ++i) acc[i] = 0;
#pragma unroll
    for (int g = 0; g < 4; ++g)
#pragma unroll
        for (int q = 0; q < 4; ++q) {
            const unsigned r0 = rows[4 * g][q], r1 = rows[4 * g + 1][q], r2 = rows[4 * g + 2][q], r3 = rows[4 * g + 3][q];
            const unsigned a0 = __builtin_amdgcn_perm(r1, r0, 0x05010400u), a1 = __builtin_amdgcn_perm(r1, r0, 0x07030602u);
            const unsigned b0 = __builtin_amdgcn_perm(r3, r2, 0x05010400u), b1 = __builtin_amdgcn_perm(r3, r2, 0x07030602u);
            const unsigned t0 = __builtin_amdgcn_perm(b0, a0, 0x05040100u), t1 = __builtin_amdgcn_perm(b0, a0, 0x07060302u);
            const unsigned t2 = __builtin_amdgcn_perm(b1, a1, 0x05040100u), t3 = __builtin_amdgcn_perm(b1, a1, 0x07060302u);
            acc[4 * q] = __builtin_amdgcn_sdot4((int)t0, (int)cq[g], acc[4 * q], false);
            acc[4 * q + 1] = __builtin_amdgcn_sdot4((int)t1, (int)cq[g], acc[4 * q + 1], false);
            acc[4 * q + 2] = __builtin_amdgcn_sdot4((int)t2, (int)cq[g], acc[4 * q + 2], false);
            acc[4 * q + 3] = __builtin_amdgcn_sdot4((int)t3, (int)cq[g], acc[4 * q + 3], false);
        }
    int a8[8], a4[4], a2[2];
    {
        const bool hi = (eg & 4) != 0;
#pragma unroll
        for (int j = 0; j < 8; ++j) {
            const int send = hi ? acc[j] : acc[j + 8];
            const int keep = hi ? acc[j + 8] : acc[j];
            a8[j] = keep + __shfl_xor(send, 32);
        }
    }
    {
        const bool hi = (eg & 2) != 0;
#pragma unroll
        for (int j = 0; j < 4; ++j) {
            const int send = hi ? a8[j] : a8[j + 4];
            const int keep = hi ? a8[j + 4] : a8[j];
            a4[j] = keep + __shfl_xor(send, 16);
        }
    }
    {
        const bool hi = (eg & 1) != 0;
#pragma unroll
        for (int j = 0; j < 2; ++j) {
            const int send = hi ? a4[j] : a4[j + 2];
            const int keep = hi ? a4[j + 2] : a4[j];
            a2[j] = keep + __shfl_xor(send, 8);
        }
    }
    const float cs = ((const float*)(p.ws + WS_ASUM))[t];
    const float2 st = ((const float2*)(p.ws + WS_ST2))[t];
    const unsigned xb = *(const unsigned*)((const bf16_t*)(p.ws + WS_YB) + t * 1024 + col);
    const float x0 = (bflo(xb) - st.x) * st.y * g2.x + b2.x, x1 = (bfhi(xb) - st.x) * st.y * g2.y + b2.y;
    if (dostore) *(unsigned*)((bf16_t*)(p.ws + WS_YB) + t * 1024 + col) = pk_bf16(ALPHA * x0 + cs * (float)a2[0], ALPHA * x1 + cs * (float)a2[1]);
}
DEV void peer_up_item(const P& p, int s, int tile, int lane, int wid, bool dostore = true) {
    const int eg = lane >> 3, cg = lane & 7;
    const unsigned char* PU = p.ws + WS_PU + (size_t)s * 16384 * 128 + cg * 16;
    const size_t t0 = (size_t)tile * 32 + wid * 8;
    const unsigned short* EI = (const unsigned short*)(p.ws + WS_EIDP) + t0 * 128 + eg * 16;
    const unsigned char* CQ = p.ws + WS_COEFP + t0 * 128 + eg * 16;
    const int col = s * 128 + cg * 16 + 2 * eg;
    const float2 g2 = *(const float2*)(p.ln_g + 1024 + col), b2 = *(const float2*)(p.ln_b + 1024 + col);
    u32x4 rA[16], rB[16];
    u32x4 ea0 = *(const u32x4*)EI, ea1 = *(const u32x4*)(EI + 8);
    u32x4 eb0 = *(const u32x4*)(EI + 128), eb1 = *(const u32x4*)(EI + 128 + 8);
    u32x4 ca = *(const u32x4*)CQ, cb = *(const u32x4*)(CQ + 128);
    peer_gather16(rA, PU, ea0, ea1);
#pragma unroll 1
    for (int tt = 0; tt < 8; tt += 2) {
        peer_gather16(rB, PU, eb0, eb1);
        if (tt + 2 < 8) { ea0 = *(const u32x4*)(EI + (tt + 2) * 128); ea1 = *(const u32x4*)(EI + (tt + 2) * 128 + 8); }
        peer_up_compute(p, rA, ca, t0 + tt, col, eg, g2, b2, dostore);
        if (tt + 2 < 8) {
            ca = *(const u32x4*)(CQ + (tt + 2) * 128);
            peer_gather16(rA, PU, ea0, ea1);
            eb0 = *(const u32x4*)(EI + (tt + 3) * 128); eb1 = *(const u32x4*)(EI + (tt + 3) * 128 + 8);
        }
        peer_up_compute(p, rB, cb, t0 + tt + 1, col, eg, g2, b2, dostore);
        if (tt + 2 < 8) cb = *(const u32x4*)(CQ + (tt + 3) * 128);
    }
}

DEV void ln3_item(const P& p, int t, int lane) {
    float* row = p.out + (size_t)t * 1024;
    const bf16_t* yrow = (const bf16_t*)(p.ws + WS_YB) + (size_t)t * 1024;
    float4 v[4];
    float s = 0.f;
#pragma unroll
    for (int i = 0; i < 4; ++i) {
        const uint2 u = *(const uint2*)(yrow + (i * 64 + lane) * 4);
        v[i] = make_float4(bflo(u.x), bfhi(u.x), bflo(u.y), bfhi(u.y));
        s += v[i].x + v[i].y + v[i].z + v[i].w;
    }
    const float mean = wsum(s) * (1.f / 1024.f);
    float ss = 0.f;
#pragma unroll
    for (int i = 0; i < 4; ++i) {
        v[i].x -= mean; v[i].y -= mean; v[i].z -= mean; v[i].w -= mean;
        ss += v[i].x * v[i].x + v[i].y * v[i].y + v[i].z * v[i].z + v[i].w * v[i].w;
    }
    const float rs = rsqrtf(wsum(ss) * (1.f / 1024.f) + LN_EPS);
#pragma unroll
    for (int i = 0; i < 4; ++i) {
        const int c = (i * 64 + lane) * 4;
        const float4 gg = *(const float4*)(p.ln_g + 2 * 1024 + c);
        const float4 bb = *(const float4*)(p.ln_b + 2 * 1024 + c);
        float4 o;
        o.x = v[i].x * rs * gg.x + bb.x; o.y = v[i].y * rs * gg.y + bb.y; o.z = v[i].z * rs * gg.z + bb.z; o.w = v[i].w * rs * gg.w + bb.w;
        *(float4*)(row + c) = o;
    }
}

#define XB_TMO      128
#define XB_XCNT(j)  (256  + 64 * (j))
#define XB_XSUB(j)  (1280 + 64 * (j))
#define XB_XGEN(j)  (2304 + 64 * (j))
#define XB_TOP      3328
#define XB_TOPGEN   3392
#define XCD_BAR_WORDS 3456
#define XB_SPIN_CAP (1u << 20)
#define LAS __attribute__((address_space(3)))
DEV unsigned xb_ld(unsigned* p) { return __hip_atomic_load(p, __ATOMIC_RELAXED, __HIP_MEMORY_SCOPE_AGENT); }
DEV unsigned xb_add(unsigned* p, unsigned v) { return __hip_atomic_fetch_add(p, v, __ATOMIC_RELAXED, __HIP_MEMORY_SCOPE_AGENT); }
DEV unsigned xb_xcc_id() { return (unsigned)__builtin_amdgcn_s_getreg((3 << 11) | 20) & 0xFu; }
#define XB_SPIN(cond, bar) do { unsigned _sp = 0; while (cond) { __builtin_amdgcn_s_sleep(1); \
    if ((++_sp & 255u) == 0u) { if (xb_ld(&(bar)[XB_TMO])) break; if (_sp > XB_SPIN_CAP) { atomicAdd(&(bar)[XB_TMO], 1u); break; } } } } while (0)
struct XcdBarrier { unsigned* bar; unsigned x; volatile LAS unsigned* st; };
DEV XcdBarrier xcd_barrier_post(unsigned* bar, volatile LAS unsigned* st) {
    XcdBarrier b; b.bar = bar; b.x = xb_xcc_id(); b.st = st;
    if (threadIdx.x == 0) (void)xb_add(&bar[XB_XCNT(b.x)], 1u);
    return b;
}
DEV void xcd_barrier_complete(unsigned* bar, unsigned x, unsigned& nloc, unsigned& nx) {
    const unsigned G = gridDim.x * gridDim.y * gridDim.z;
    unsigned sum, cnt, mine, sp = 0u;
    for (;;) {
        sum = 0u; cnt = 0u; mine = 0u;
#pragma unroll
        for (unsigned j = 0; j < 16; ++j) { const unsigned c = xb_ld(&bar[XB_XCNT(j)]); sum += c; cnt += (c > 0u) ? 1u : 0u; mine = (j == x) ? c : mine; }
        if (sum == G) break;
        __builtin_amdgcn_s_sleep(1);
        if ((++sp & 255u) == 0u) { if (xb_ld(&bar[XB_TMO])) break; if (sp > XB_SPIN_CAP) { atomicAdd(&bar[XB_TMO], 1u); break; } }
    }
    nloc = mine > 0u ? mine : 1u; nx = cnt > 0u ? cnt : 1u;
}
DEV void xcd_barrier(const XcdBarrier& b) {
    asm volatile("s_waitcnt vmcnt(0)" ::: "memory");
    __syncthreads();
    if (threadIdx.x == 0) {
        unsigned* bar = b.bar;
        __builtin_amdgcn_s_waitcnt(0);
        unsigned nloc = b.st[0], nx = b.st[1];
        if (nloc == 0u) { xcd_barrier_complete(bar, b.x, nloc, nx); b.st[0] = nloc; b.st[1] = nx; }
        const unsigned old = xb_add(&bar[XB_XSUB(b.x)], 1u);
        const unsigned gen = old / nloc;
        if (old + 1u == (gen + 1u) * nloc) {
            __builtin_amdgcn_fence(__ATOMIC_RELEASE, "agent");
            asm volatile("s_waitcnt vmcnt(0)" ::: "memory");
            const unsigned og = xb_add(&bar[XB_TOP], 1u);
            const unsigned tg = og / nx;
            if (og + 1u == (tg + 1u) * nx) xb_add(&bar[XB_TOPGEN], 1u);
            else XB_SPIN(xb_ld(&bar[XB_TOPGEN]) == tg, bar);
            __builtin_amdgcn_fence(__ATOMIC_ACQUIRE, "agent");
            xb_add(&bar[XB_XGEN(b.x)], 1u);
            asm volatile("s_waitcnt vmcnt(0)" ::: "memory");
        } else {
            XB_SPIN(xb_ld(&bar[XB_XGEN(b.x)]) == gen, bar);
            asm volatile("buffer_inv sc0\n\ts_waitcnt vmcnt(0)" ::: "memory");
        }
    }
    __syncthreads();
}


DEV void late_transpose_item(const P& p, int it, float* smem) {
    const int m = it >> 8, t = it & 255;
    const float* W = m == 0 ? p.w_out : (m == 1 ? p.xa_wq : (m == 2 ? p.xa_wo : p.peer_wq));
    const size_t off = m == 0 ? WS_WOUT_T : (m == 1 ? WS_WQ_T : (m == 2 ? WS_WO_T : WS_PWQ_T));
    const int mat2 = m >> 1;
    if (m & 1) transpose_tile(W, 1024, (bf16_t*)(p.ws + off), t >> 4, t & 15, smem, 1024, p.ln_g + mat2 * 1024, p.ln_b + mat2 * 1024,
                              (float*)(p.ws + WS_C12) + (size_t)(mat2 * 16 + (t >> 4)) * 2048);
    else transpose_tile(W, 1024, (bf16_t*)(p.ws + off), t >> 4, t & 15, smem);
}

constexpr int WQ_WORD0 = 4096;
DEV int wq_next(unsigned* cnt, int nper, int xcc, unsigned char* lds) {
    volatile unsigned* slot = (volatile unsigned*)(lds + LDS_BYTES - 16);
    __syncthreads();
    if (threadIdx.x == 0) {
        int res = -1;
        int off = (int)slot[1];
        while (off < 8) {
            const int q = (xcc + off) & 7;
            const unsigned idx = atomicAdd(&cnt[q * 64], 1u);
            if (idx < (unsigned)nper) { res = q * nper + (int)idx; break; }
            ++off;
        }
        slot[0] = (unsigned)res;
        slot[1] = (unsigned)off;
    }
    __syncthreads();
    return (int)slot[0];
}
DEV void wq_begin(unsigned char* lds) {
    __syncthreads();
    if (threadIdx.x == 0) ((volatile unsigned*)(lds + LDS_BYTES - 16))[1] = 0u;
}

constexpr int NSTAGES = 12;
template <int ST>
DEV void run_stage(const P& p, unsigned char* lds, int xcc) {
    float* smem = (float*)lds;
    const int nb = gridDim.x, bid = blockIdx.x;
    int tidl = threadIdx.x;
    asm volatile("" : "+v"(tidl));
    const int wave = tidl >> 6;
    unsigned* wqc = (unsigned*)(p.ws + WS_BAR) + WQ_WORD0;
    if (ST == 0) {
        for (int it = bid; it < PREP_END; it += nb) prep_item(p, it, smem);
    } else if (ST == 1) {
        for (int it = bid; it < 1536 + 384 + 128; it += nb) {
            if (it < 1536) gemm_item<0>(p, it & 7, it >> 3, lds);
            else if (it < 1920) { const int i2 = it - 1536, q = i2 & 7, j = i2 >> 3; gemm_mfma_tile<0>(p, q * 16 + (j & 15), 24 + (j >> 4), lds); }
            else gemm_item<1>(p, (it - 1920) & 7, (it - 1920) >> 3, lds);
        }
    } else if (ST == 2) {
        if (PROBE_REP == 21) for (int it = bid; it < 256; it += nb) compress_item2(p, it, lds);
        if (PROBE_REP == 22) for (int it = bid; it < 1024; it += nb) hgrn_prep_item(p, it, smem);
        for (int it = bid; it < 256 + 1024; it += nb) {
            if (it < 256) compress_item2(p, it, lds);
            else hgrn_prep_item2(p, it - 256, lds);
        }
    } else if (ST == 3) {
        if (PROBE_REP == 31) { for (int it = bid; it < 32; it += nb) hgrn_chain_item(p, it, lds); }
        if (PROBE_REP == 32) {
            volatile unsigned* qs2 = (volatile unsigned*)(lds + LDS_BYTES - 16);
            for (;;) {
                __syncthreads();
                if (threadIdx.x == 0) *qs2 = atomicAdd(wqc + 64, 1u);
                __syncthreads();
                const int j = (int)*qs2;
                if (j >= 1024) break;
                nsa_item2(p, (j & 15) >> 1, j & 1, 63 - (j >> 4), lds, p.out != nullptr ? 4 : 0);
            }
        }
        volatile unsigned* qslot = (volatile unsigned*)(lds + LDS_BYTES - 16);
        for (;;) {
            __syncthreads();
            if (threadIdx.x == 0) *qslot = atomicAdd(wqc, 1u);
            __syncthreads();
            const int it = (int)*qslot;
            if (it >= 64 + 2048) break;
            if (it < 64) hgrn_chain_item3(p, it, lds);
            else if (((it - 64) & 1) == 0) { const int j = (it - 64) >> 1; nsa_item2(p, (j & 15) >> 1, j & 1, 63 - (j >> 4), lds); }
            else {
                const int j = (it - 64) >> 1, tb = j >> 9, r0 = (j & 511) * 32 + wave * 8;
                for (int r = 0; r < 8; r += 4) {
                    if (tb == 0) peer_quant_rows4(p.peer_down, p.ws + WS_PD, (float*)(p.ws + WS_PSD), r0 + r, (int*)(p.ws + WS_PRS));
                    else peer_quant_rows4(p.peer_up, p.ws + WS_PU, (float*)(p.ws + WS_PSU), r0 + r, nullptr, 0);
                }
            }
        }
        for (;;) {
            __syncthreads();
            if (threadIdx.x == 0) *qslot = atomicAdd(wqc + 128, 1u);
            __syncthreads();
            const int it = (int)*qslot;
            if (it >= 1024) break;
            late_transpose_item(p, it, smem);
        }
    } else if (ST == 4) {
        for (int it = bid; it < 512; it += nb) gemm_item<2>(p, it & 7, it >> 3, lds);
    } else if (ST == 5) {
        for (int it = bid; it < T_ / 4; it += nb) ln_item(p, it * 4 + wave, 0, tidl & 63);
    } else if (ST == 9) {
        for (int it = bid; it < T_ / 4; it += nb) ln_item(p, it * 4 + wave, 1, tidl & 63);
    } else if (ST == 6) {
        for (int it = bid; it < 512; it += nb) gemm_item<3>(p, it & 7, it >> 3, lds);
    } else if (ST == 7) {
        for (int it = bid; it < 1024; it += nb) xattn_item3(p, it, lds);
    } else if (ST == 8) {
        for (int it = bid; it < 512; it += nb) gemm_item<4>(p, it & 7, it >> 3, lds);
    } else if (ST == 10) {
        for (int it = bid; it < 512; it += nb) gemm_item<5>(p, it & 7, it >> 3, lds);
    } else if (ST == 11) {
        if (PROBE_REP == 11) for (int it = bid; it < T_ / 16; it += nb) peer_route_item(p, it, lds);
        for (int it = bid; it < T_ / 16; it += nb) peer_route_item(p, it, lds);
    } else if (ST == 12) {
        if (PROBE_REP == 12) { wq_begin(lds); for (int it; (it = wq_next(wqc + 4 * 512, 512, xcc, lds)) >= 0;) peer_down_item(p, it >> 9, it & 511, tidl & 63, wave); }
        wq_begin(lds);
        for (int it; (it = wq_next(wqc + 2 * 512, 512, xcc, lds)) >= 0;) peer_down_item(p, it >> 9, it & 511, tidl & 63, wave);
    } else if (ST == 13) {
        if (PROBE_REP == 13) for (int it = bid; it < T_ / 4; it += nb) peer_coef_item(p, it * 4 + wave, tidl & 63);
        for (int it = bid; it < T_ / 4; it += nb) peer_coef_item(p, it * 4 + wave, tidl & 63);
    } else if (ST == 14) {
        if (PROBE_REP == 14) { wq_begin(lds); for (int it; (it = wq_next(wqc + 5 * 512, 512, xcc, lds)) >= 0;) peer_up_item(p, it >> 9, it & 511, tidl & 63, wave, p.out == nullptr); }
        wq_begin(lds);
        for (int it; (it = wq_next(wqc + 3 * 512, 512, xcc, lds)) >= 0;) peer_up_item(p, it >> 9, it & 511, tidl & 63, wave);
    } else if (ST == 15) {
        for (int it = bid; it < T_ / 4; it += nb) ln3_item(p, it * 4 + wave, tidl & 63);
    }
}

template <int ST>
__global__ void __launch_bounds__(256, 2) stage_kernel(P p) {
    __shared__ __attribute__((aligned(16))) unsigned char lds[LDS_BYTES + 16];
    run_stage<ST>(p, lds, (int)xb_xcc_id() & 7);
}

__global__ void __launch_bounds__(256, 2) mega_kernel(P p) {
    __shared__ __attribute__((aligned(16))) unsigned char lds[LDS_BYTES + 16];
    if (threadIdx.x == 0) *(uint4*)(lds + LDS_BYTES) = make_uint4(0u, 0u, 0u, 0u);
    __syncthreads();
    const XcdBarrier xb = xcd_barrier_post((unsigned*)(p.ws + WS_BAR), (volatile LAS unsigned*)(lds + LDS_BYTES));
    const int xcc = (int)xb.x & 7;
    run_stage<0>(p, lds, xcc); xcd_barrier(xb);
    if (PROBE_REP == 0) { run_stage<0>(p, lds, xcc); xcd_barrier(xb); }
    run_stage<1>(p, lds, xcc); xcd_barrier(xb);
    if (PROBE_REP == 1) { run_stage<1>(p, lds, xcc); xcd_barrier(xb); }
    run_stage<2>(p, lds, xcc); xcd_barrier(xb);
    if (PROBE_REP == 2) { run_stage<2>(p, lds, xcc); xcd_barrier(xb); }
    if (PROBE_REP == 35) { if (blockIdx.x < 32) hgrn_chain_item2(p, blockIdx.x, lds); xcd_barrier(xb); }
    run_stage<3>(p, lds, xcc); xcd_barrier(xb);
    run_stage<4>(p, lds, xcc); xcd_barrier(xb);
    if (PROBE_REP == 4) { run_stage<4>(p, lds, xcc); xcd_barrier(xb); }
    if (PROBE_REP == 50) { xcd_barrier(xb); xcd_barrier(xb); xcd_barrier(xb); xcd_barrier(xb); xcd_barrier(xb); xcd_barrier(xb); xcd_barrier(xb); xcd_barrier(xb); }
    run_stage<6>(p, lds, xcc); xcd_barrier(xb);
    if (PROBE_REP == 6) { run_stage<6>(p, lds, xcc); xcd_barrier(xb); }
    run_stage<7>(p, lds, xcc); xcd_barrier(xb);
    if (PROBE_REP == 7) { run_stage<7>(p, lds, xcc); xcd_barrier(xb); }
    run_stage<8>(p, lds, xcc); xcd_barrier(xb);
    run_stage<10>(p, lds, xcc); xcd_barrier(xb);
    if (PROBE_REP == 10) { run_stage<10>(p, lds, xcc); xcd_barrier(xb); }
    run_stage<11>(p, lds, xcc); xcd_barrier(xb);
    run_stage<12>(p, lds, xcc); xcd_barrier(xb);
    run_stage<13>(p, lds, xcc); xcd_barrier(xb);
    run_stage<14>(p, lds, xcc); xcd_barrier(xb);
    run_stage<15>(p, lds, xcc);
}

extern "C" void kernel_launch(void* const* d_in, const int* in_sizes, int n_in, void* d_out, int out_size, void* d_ws, size_t ws_size,
                              hipStream_t stream) {
    if (n_in != 18 || ws_size < WS_END) {
        fprintf(stderr, "kernel_launch: unexpected inputs (n_in %d, ws %zu, need %zu)\n", n_in, ws_size, (size_t)WS_END);
        return;
    }
    P p{};
    p.x = (const float*)d_in[0]; p.mem = (const float*)d_in[1]; p.w_in = (const float*)d_in[2]; p.cmp_pos = (const float*)d_in[3];
    p.cmp_w1 = (const float*)d_in[4]; p.cmp_w2 = (const float*)d_in[5]; p.lb_logits = (const float*)d_in[6];
    p.hg_norm_w = (const float*)d_in[7]; p.w_out = (const float*)d_in[8]; p.xa_wq = (const float*)d_in[9];
    p.xa_wkv = (const float*)d_in[10]; p.xa_wo = (const float*)d_in[11]; p.peer_wq = (const float*)d_in[12];
    p.peer_keys = (const float*)d_in[13]; p.peer_down = (const float*)d_in[14]; p.peer_up = (const float*)d_in[15];
    p.ln_g = (const float*)d_in[16]; p.ln_b = (const float*)d_in[17];
    p.out = (float*)d_out; p.ws = (unsigned char*)d_ws;
#if ONE_LAUNCH
    static int grid_blocks = 0;
    if (!grid_blocks) {
        int dev = 0, cus = 0, per_cu = 0;
        hipGetDevice(&dev);
        hipDeviceGetAttribute(&cus, hipDeviceAttributeMultiprocessorCount, dev);
        hipOccupancyMaxActiveBlocksPerMultiprocessor(&per_cu, mega_kernel, 256, 0);
        if (per_cu > 2) per_cu = 2;
        if (per_cu < 1) per_cu = 1;
        grid_blocks = cus * per_cu;
    }
    (void)hipMemsetAsync((unsigned char*)d_ws + WS_BAR, 0, 65536, stream);
    void* args[] = {&p};
    hipError_t e = hipLaunchCooperativeKernel((void*)mega_kernel, dim3(grid_blocks), dim3(256), args, 0, stream);
    if (e != hipSuccess) fprintf(stderr, "cooperative launch failed: %s (grid %d)\n", hipGetErrorString(e), grid_blocks);
#else
    const int G = 2048;
    stage_kernel<0><<<G, 256, 0, stream>>>(p);
    stage_kernel<1><<<G, 256, 0, stream>>>(p);
    stage_kernel<2><<<G, 256, 0, stream>>>(p);
    stage_kernel<3><<<G, 256, 0, stream>>>(p);
    stage_kernel<4><<<G, 256, 0, stream>>>(p);
    stage_kernel<5><<<G, 256, 0, stream>>>(p);
    stage_kernel<6><<<G, 256, 0, stream>>>(p);
    stage_kernel<7><<<G, 256, 0, stream>>>(p);
    stage_kernel<8><<<G, 256, 0, stream>>>(p);
    stage_kernel<9><<<G, 256, 0, stream>>>(p);
    stage_kernel<10><<<G, 256, 0, stream>>>(p);
    stage_kernel<11><<<G, 256, 0, stream>>>(p);
#endif
}
```
